# Optimizing an MI355X kernel written in HIP

```python
import math
import jax
import jax.numpy as jnp
from jax import lax
import numpy as np

D_MODEL = 2048
BATCH = 2
SEQ = 4096
DEPTH = 2

HEAD_DIM = 128
LRU_BLOCKS = 6
LRU_BD = 128
LRU_W = LRU_BLOCKS * LRU_BD
LRU_C = 8.0
CONV_W = 4
SWA_HEADS = 6
SWA_W = SWA_HEADS * HEAD_DIM
DILATED_PATTERNS = ((128, 1), (512, 4), (2048, 16))
SB_HEADS = 4
SB_W = SB_HEADS * HEAD_DIM
MIX_W = LRU_W + SWA_W + SB_W
IN_W = 2 * LRU_W + 3 * SWA_W + 3 * SB_W
Q_BLOCK = 128
REL_BUCKETS = 32
REL_MAX_DIST = 2048
PEER_HEADS = 8
PEER_NKEYS = 128
PEER_EXPERTS = PEER_NKEYS * PEER_NKEYS
PEER_DQ = 256
PEER_TOPK = 16
TOK_BLOCK = 128
NEG_INF = -1e30
EPS = 1e-6

kernel_name = "hybrid_lru_dilated_stickbreak_peer_block"


def rms_norm(x, g):
    xf = x.astype(jnp.float32)
    y = xf * lax.rsqrt(jnp.mean(xf * xf, axis=-1, keepdims=True) + EPS)
    return (y * g.astype(jnp.float32)).astype(x.dtype)


def t5_bucket(dist):
    dist = np.asarray(dist, np.int32)
    max_exact = REL_BUCKETS // 2
    large = max_exact + (np.log(np.maximum(dist, 1) / max_exact)
                         / np.log(REL_MAX_DIST / max_exact)
                         * (REL_BUCKETS - max_exact)).astype(np.int32)
    large = np.minimum(large, REL_BUCKETS - 1)
    return np.where(dist < max_exact, dist, large).astype(np.int32)


def causal_depthwise_conv(x, w, b):
    C = x.shape[-1]
    y = lax.conv_general_dilated(x, w[:, None, :].astype(x.dtype), window_strides=(1,),
                                 padding=[(CONV_W - 1, 0)],
                                 dimension_numbers=('NWC', 'WIO', 'NWC'),
                                 feature_group_count=C)
    return y + b.astype(x.dtype)


def rg_lru(xa, w_rec, b_rec, w_in, b_in, lam):
    B, S, C = xa.shape
    xf = xa.astype(jnp.float32)
    xb = xf.reshape(B, S, LRU_BLOCKS, LRU_BD)
    r = jax.nn.sigmoid(jnp.einsum('bsnj,njk->bsnk', xb, w_rec.astype(jnp.float32)).reshape(B, S, C)
                       + b_rec.astype(jnp.float32))
    i = jax.nn.sigmoid(jnp.einsum('bsnj,njk->bsnk', xb, w_in.astype(jnp.float32)).reshape(B, S, C)
                       + b_in.astype(jnp.float32))
    log_a = -LRU_C * r * jax.nn.softplus(-lam.astype(jnp.float32))
    a = jnp.exp(log_a)
    u = jnp.sqrt(-jnp.expm1(2.0 * log_a)) * (i * xf)

    def combine(left, right):
        a_l, b_l = left
        a_r, b_r = right
        return a_l * a_r, a_r * b_l + b_r

    _, h = lax.associative_scan(combine, (a, u), axis=1)
    return h.astype(xa.dtype)


def dilated_attention(q, k, v, rel_bias):
    B, S, H, Dh = q.shape
    nb = S // Q_BLOCK
    scale = Dh ** -0.5
    pats = []
    for (w, d) in DILATED_PATTERNS:
        offs = d * np.arange(w // d + 1, dtype=np.int32)
        bias = rel_bias[t5_bucket(offs)].T.astype(jnp.float32)
        pats.append((jnp.asarray(offs), bias))

    def block(bi):
        t0 = bi * Q_BLOCK
        qb = lax.dynamic_slice_in_dim(q, t0, Q_BLOCK, axis=1)
        tpos = t0 + jnp.arange(Q_BLOCK)
        lses, outs = [], []
        for offs, bias in pats:
            pos = tpos[:, None] - offs[None, :]
            valid = pos >= 0
            posc = jnp.maximum(pos, 0)
            kg = jnp.take(k, posc, axis=1)
            vg = jnp.take(v, posc, axis=1)
            logits = jnp.einsum('bqhd,bqkhd->bhqk', qb, kg).astype(jnp.float32) * scale
            logits = logits + bias[None, :, None, :]
            logits = jnp.where(valid[None, None], logits, NEG_INF)
            m = jnp.max(logits, axis=-1, keepdims=True)
            p = jnp.exp(logits - m)
            s = jnp.sum(p, axis=-1, keepdims=True)
            o = jnp.einsum('bhqk,bqkhd->bqhd', (p / s).astype(vg.dtype), vg).astype(jnp.float32)
            lses.append((m + jnp.log(s))[..., 0])
            outs.append(o)
        wts = jax.nn.softmax(jnp.stack(lses, axis=0), axis=0)
        wts = jnp.transpose(wts, (0, 1, 3, 2))[..., None]
        return jnp.sum(wts * jnp.stack(outs, axis=0), axis=0).astype(q.dtype)

    out = lax.map(block, jnp.arange(nb))
    return jnp.transpose(out, (1, 0, 2, 3, 4)).reshape(B, S, H, Dh)


def stick_breaking_attention(q, k, v):
    B, S, H, Dh = q.shape
    nb = S // Q_BLOCK
    scale = Dh ** -0.5
    spos = jnp.arange(S)

    def block(bi):
        t0 = bi * Q_BLOCK
        qb = lax.dynamic_slice_in_dim(q, t0, Q_BLOCK, axis=1)
        z = jnp.einsum('bqhd,bshd->bhqs', qb, k).astype(jnp.float32) * scale
        tpos = t0 + jnp.arange(Q_BLOCK)
        causal = spos[None, :] < tpos[:, None]
        log1m = jnp.where(causal, jax.nn.log_sigmoid(-z), 0.0)
        after = lax.cumsum(log1m, axis=3, reverse=True) - log1m
        A = jnp.where(causal, jnp.exp(jax.nn.log_sigmoid(z) + after), 0.0)
        return jnp.einsum('bhqs,bshd->bqhd', A.astype(v.dtype), v)

    out = lax.map(block, jnp.arange(nb))
    return jnp.transpose(out, (1, 0, 2, 3, 4)).reshape(B, S, H, Dh)


def hybrid_mixer(h, w_in, conv_w, conv_b, w_rec, b_rec, w_gi, b_gi, lam, rel_bias,
                 g_lru, g_swa, g_sb, w_out):
    B, S, _ = h.shape
    z = h @ w_in
    cuts = np.cumsum([LRU_W, LRU_W, SWA_W, SWA_W, SWA_W, SB_W, SB_W]).tolist()
    xa, ga, qb, kb, vb, qc, kc, vc = jnp.split(z, cuts, axis=-1)
    xa = causal_depthwise_conv(xa, conv_w, conv_b)
    ya = rg_lru(xa, w_rec, b_rec, w_gi, b_gi, lam) * jax.nn.gelu(ga)
    hs = lambda t, n: t.reshape(B, S, n, HEAD_DIM)
    yb = dilated_attention(hs(qb, SWA_HEADS), hs(kb, SWA_HEADS), hs(vb, SWA_HEADS),
                           rel_bias).reshape(B, S, SWA_W)
    yc = stick_breaking_attention(hs(qc, SB_HEADS), hs(kc, SB_HEADS),
                                  hs(vc, SB_HEADS)).reshape(B, S, SB_W)
    y = jnp.concatenate([rms_norm(ya, g_lru), rms_norm(yb, g_swa), rms_norm(yc, g_sb)], axis=-1)
    return y @ w_out


def peer_ffn(h, wq, subkeys, u_tab, v_tab):
    B, S, D = h.shape
    T = B * S
    hf = h.reshape(T, D)
    q = (hf @ wq).reshape(T, PEER_HEADS, 2, PEER_DQ // 2)
    s = jnp.einsum('thcd,hckd->thck', q, subkeys).astype(jnp.float32)
    v_top, i_top = lax.top_k(s, PEER_TOPK)
    cand_s = (v_top[:, :, 0, :, None] + v_top[:, :, 1, None, :]).reshape(T, PEER_HEADS, -1)
    cand_i = (i_top[:, :, 0, :, None] * PEER_NKEYS + i_top[:, :, 1, None, :]).reshape(T, PEER_HEADS, -1)
    best_s, best_pos = lax.top_k(cand_s, PEER_TOPK)
    ids = jnp.take_along_axis(cand_i, best_pos, axis=-1)
    g = jax.nn.softmax(best_s, axis=-1)
    nblk = T // TOK_BLOCK
    HK = PEER_HEADS * PEER_TOPK

    def block(args):
        xb, idb, gb = args
        ub = jnp.take(u_tab, idb, axis=0)
        act = jax.nn.gelu(jnp.einsum('tkd,td->tk', ub, xb).astype(jnp.float32))
        vb = jnp.take(v_tab, idb, axis=0)
        return jnp.einsum('tk,tkd->td', (gb * act).astype(xb.dtype), vb)

    y = lax.map(block, (hf.reshape(nblk, TOK_BLOCK, D), ids.reshape(nblk, TOK_BLOCK, HK),
                        g.reshape(nblk, TOK_BLOCK, HK)))
    return y.reshape(B, S, D)


def setup_inputs(seed: int = 0) -> dict:
    key = jax.random.key(seed)
    ks = jax.random.split(key, 24)
    D = D_MODEL
    f32 = jnp.float32

    def nrm(k, shape, s):
        return jax.random.normal(k, shape, f32) * s

    u = jax.random.uniform(ks[13], (DEPTH, LRU_W), f32, minval=0.9, maxval=0.999)
    sig = u ** (1.0 / LRU_C)
    lam = jnp.log(sig) - jnp.log1p(-sig)
    return {
        "x": nrm(ks[0], (BATCH, SEQ, D), 1.0),
        "c": nrm(ks[1], (BATCH, D), 1.0),
        "w_mod": nrm(ks[2], (DEPTH, D, 6 * D), 0.5 * D ** -0.5),
        "b_mod": nrm(ks[3], (DEPTH, 6 * D), 0.02),
        "norm_mix": 1.0 + nrm(ks[4], (DEPTH, D), 0.02),
        "norm_ffn": 1.0 + nrm(ks[5], (DEPTH, D), 0.02),
        "w_in": nrm(ks[6], (DEPTH, D, IN_W), D ** -0.5),
        "conv_w": nrm(ks[7], (DEPTH, CONV_W, LRU_W), CONV_W ** -0.5),
        "conv_b": nrm(ks[8], (DEPTH, LRU_W), 0.02),
        "lru_w_rec": nrm(ks[9], (DEPTH, LRU_BLOCKS, LRU_BD, LRU_BD), LRU_BD ** -0.5),
        "lru_b_rec": nrm(ks[10], (DEPTH, LRU_W), 0.02),
        "lru_w_in": nrm(ks[11], (DEPTH, LRU_BLOCKS, LRU_BD, LRU_BD), LRU_BD ** -0.5),
        "lru_b_in": nrm(ks[12], (DEPTH, LRU_W), 0.02),
        "lru_lambda": lam,
        "rel_bias": nrm(ks[14], (REL_BUCKETS, SWA_HEADS), 0.1),
        "gnorm_lru": 1.0 + nrm(ks[15], (DEPTH, LRU_W), 0.02),
        "gnorm_swa": 1.0 + nrm(ks[16], (DEPTH, SWA_W), 0.02),
        "gnorm_sb": 1.0 + nrm(ks[17], (DEPTH, SB_W), 0.02),
        "w_out": nrm(ks[18], (DEPTH, MIX_W, D), MIX_W ** -0.5),
        "peer_wq": nrm(ks[19], (DEPTH, D, PEER_HEADS * PEER_DQ), D ** -0.5),
        "peer_subkeys": nrm(ks[20], (DEPTH, PEER_HEADS, 2, PEER_NKEYS, PEER_DQ // 2), (PEER_DQ // 2) ** -0.5),
        "peer_u": nrm(ks[21], (DEPTH, PEER_EXPERTS, D), D ** -0.5),
        "peer_v": nrm(ks[22], (DEPTH, PEER_EXPERTS, D), 1.0),
        "final_norm": 1.0 + nrm(ks[23], (D,), 0.02),
    }


def reference(x, c, w_mod, b_mod, norm_mix, norm_ffn, w_in, conv_w, conv_b,
              lru_w_rec, lru_b_rec, lru_w_in, lru_b_in, lru_lambda, rel_bias,
              gnorm_lru, gnorm_swa, gnorm_sb, w_out, peer_wq, peer_subkeys,
              peer_u, peer_v, final_norm):
    cs = jax.nn.silu(c)
    for l in range(DEPTH):
        mod = cs @ w_mod[l] + b_mod[l]
        sh1, sc1, g1, sh2, sc2, g2 = [m[:, None, :] for m in jnp.split(mod, 6, axis=-1)]
        h = rms_norm(x, norm_mix[l]) * (1.0 + sc1) + sh1
        x = x + g1 * hybrid_mixer(h, w_in[l], conv_w[l], conv_b[l], lru_w_rec[l], lru_b_rec[l],
                                  lru_w_in[l], lru_b_in[l], lru_lambda[l], rel_bias,
                                  gnorm_lru[l], gnorm_swa[l], gnorm_sb[l], w_out[l])
        h = rms_norm(x, norm_ffn[l]) * (1.0 + sc2) + sh2
        x = x + g2 * peer_ffn(h, peer_wq[l], peer_subkeys[l], peer_u[l], peer_v[l])
    return rms_norm(x, final_norm)
```

```cpp
#include <hip/hip_runtime.h>
#include <cstdio>
#include <cstdint>
#define MK_DBG 0
#define MK_N_LAUNCHES 1
#define MK_CHECK 0
namespace pg8 {
#define PG8_LAS __attribute__((address_space(3)))
typedef unsigned short bf16_t;
typedef short bf16x8 __attribute__((ext_vector_type(8)));
typedef float f32x4 __attribute__((ext_vector_type(4)));
typedef unsigned u32x4 __attribute__((ext_vector_type(4)));
constexpr int BM = 256, BK = 64, HALF = 128, HTB = HALF * BK * 2  , STAGE_BYTES = 8 * HTB, NXCD = 8, WGM = 8;

__host__ __device__ __forceinline__ int lds_byte(int r, int c) { const int st = (r >> 4) * 2 + (c >> 5), rr = r & 15, cc = c & 31, ob = rr * 64 + cc * 2; return st * 1024 + (ob ^ (((ob >> 9) & 1) << 5)); }
__host__ __device__ __forceinline__ void stage_rc(int b, int& R, int& C) { const int st = b / 1024, sb = b % 1024, swz = sb ^ (((sb >> 9) & 1) << 5); R = (st >> 1) * 16 + swz / 64; C = (st & 1) * 32 + (swz % 64) / 2; }
__host__ __device__ __forceinline__ int perm32(int rho) { const int n = rho >> 4, i = rho & 15; return 8 * (i >> 2) + 4 * n + (i & 3); }

struct Unit { int pm, pn; };
struct Gemm { const bf16_t* A; const bf16_t* Bt; int M, N, K; };

struct StaticOrder {
    int nM, nN, nwg, G, c;
    __host__ __device__ void init(int M, int N, int G_, int c_) { nM = M / BM; nN = N / BM; nwg = nM * nN; G = G_; c = c_; }
    __host__ __device__ bool next(int i, Unit& u) const {
        const long L = (long)i * G + c; if (L >= nwg) return false;
        int wgid = (int)L; { const int q = nwg / NXCD, r = nwg % NXCD, xcd = wgid % NXCD, off = wgid / NXCD; wgid = (xcd < r ? xcd * (q + 1) : r * (q + 1) + (xcd - r) * q) + off; }
        const int nig = WGM * nN, gid = wgid / nig, fm = gid * WGM, gsz = (nM - fm) < WGM ? (nM - fm) : WGM;
        u.pm = fm + ((wgid % nig) % gsz); u.pn = (wgid % nig) / gsz; return true;
    }
    __device__ __forceinline__ void a_ready(const Unit&) const {}
    __device__ __forceinline__ void done(const Unit&) const {}
};
struct CountedOrder : StaticOrder {
    const unsigned* ready; unsigned need; unsigned* tmo;
    __device__ __forceinline__ void a_ready(const Unit& u) const {
        if (threadIdx.x < 64) {
            const unsigned long long t0 = __builtin_amdgcn_s_memrealtime(); unsigned polls = 0;
            while ((unsigned)__builtin_amdgcn_readfirstlane(__hip_atomic_load(ready + 64 * u.pm, __ATOMIC_RELAXED, __HIP_MEMORY_SCOPE_AGENT)) < need) {
                if ((++polls & 255u) == 0u && __builtin_amdgcn_readfirstlane(__hip_atomic_load(tmo, __ATOMIC_RELAXED, __HIP_MEMORY_SCOPE_AGENT)) != 0u) break;
                if (__builtin_amdgcn_s_memrealtime() - t0 > 2000000ull) {
                    if (threadIdx.x == 0) { unsigned expect = 0u; __hip_atomic_compare_exchange_strong(tmo + 1, &expect, 0x600u | (unsigned)(u.pm & 0xff), __ATOMIC_RELAXED, __ATOMIC_RELAXED, __HIP_MEMORY_SCOPE_AGENT); __hip_atomic_store(tmo, 1u, __ATOMIC_RELAXED, __HIP_MEMORY_SCOPE_AGENT); }
                    break; }
                __builtin_amdgcn_s_sleep(2); }
            __builtin_amdgcn_fence(__ATOMIC_ACQUIRE, "agent");
            asm volatile("s_waitcnt vmcnt(0)" ::: "memory");
        }
#if !defined(BROKEN_HOOK_NO_BARRIER)
        asm volatile("" ::: "memory"); __builtin_amdgcn_s_barrier(); asm volatile("" ::: "memory");
#endif
    }
};

__device__ __forceinline__ unsigned cvt_pk_bf16(float lo, float hi) { unsigned r; asm volatile("v_cvt_pk_bf16_f32 %0, %1, %2" : "=v"(r) : "v"(lo), "v"(hi)); return r; }
typedef float f32x2 __attribute__((ext_vector_type(2)));
__device__ __forceinline__ f32x2 gelu_pk(f32x2 v) {
    const f32x2 av = __builtin_elementwise_abs(v), d = av * 0.2316418882f + 1.0f;
    f32x2 t; t.x = __builtin_amdgcn_rcpf(d.x); t.y = __builtin_amdgcn_rcpf(d.y);
    f32x2 q = t * 0.5307027145f + (-0.7265760135f); q = q * t + 0.7107068705f; q = q * t + (-0.142248368f); q = q * t + 0.127414796f; q = q * t;
    const f32x2 s = (v * v) * (-0.72134752044f);
    f32x2 e; e.x = __builtin_amdgcn_exp2f(s.x); e.y = __builtin_amdgcn_exp2f(s.y);
    const f32x2 m = v * (q * e), r = v - m;
    f32x2 o; o.x = v.x < 0.f ? m.x : r.x; o.y = v.y < 0.f ? m.y : r.y; return o;
}

struct EpiF32 {
    static constexpr bool PERM = false, AFTER_DRAIN = false;
    float* C; int ldc; const float* bias;
    __device__ __forceinline__ void operator()(const f32x4 (&acc)[2][2][4][2], const Unit& u, int wr, int wc, int fr, int fq) const {
        const int row0 = u.pm * BM + wr * 64 + fr, col0 = u.pn * BM + wc * 32 + 4 * fq;
        f32x4 bv[2][2];
#pragma unroll
        for (int bj = 0; bj < 2; ++bj)
#pragma unroll
            for (int n = 0; n < 2; ++n) bv[bj][n] = bias ? *(const f32x4*)(bias + col0 + bj * HALF + n * 16) : (f32x4){0.f, 0.f, 0.f, 0.f};
#pragma unroll
        for (int ai = 0; ai < 2; ++ai)
#pragma unroll
            for (int m = 0; m < 4; ++m) { float* rowp = C + (size_t)(row0 + ai * HALF + m * 16) * ldc + col0;
#pragma unroll
                for (int bj = 0; bj < 2; ++bj)
#pragma unroll
                    for (int n = 0; n < 2; ++n) *(f32x4*)(rowp + bj * HALF + n * 16) = acc[ai][bj][m][n] + bv[bj][n]; }
    }
};
template <int ACT  > struct EpiBf16 {
    static constexpr bool PERM = true, AFTER_DRAIN = false;
    bf16_t* O; int ldc; const float* bias; int split_cols; size_t split_stride;
    __device__ __forceinline__ void operator()(const f32x4 (&acc)[2][2][4][2], const Unit& u, int wr, int wc, int fr, int fq) const {
        const int row0 = u.pm * BM + wr * 64 + fr; int colt = u.pn * BM; bf16_t* base = O;
        if (split_cols) { const int t = colt / split_cols; base += (size_t)t * split_stride; colt -= t * split_cols; }
        const int col0 = colt + wc * 32 + 8 * fq, bcol0 = u.pn * BM + wc * 32 + 8 * fq;
        f32x4 bv[2][2];
#pragma unroll
        for (int bj = 0; bj < 2; ++bj)
#pragma unroll
            for (int n = 0; n < 2; ++n) bv[bj][n] = bias ? *(const f32x4*)(bias + bcol0 + bj * HALF + 4 * n) : (f32x4){0.f, 0.f, 0.f, 0.f};
#pragma unroll
        for (int ai = 0; ai < 2; ++ai)
#pragma unroll
            for (int m = 0; m < 4; ++m) { bf16_t* rowp = base + (size_t)(row0 + ai * HALF + m * 16) * ldc + col0;
#pragma unroll
                for (int bj = 0; bj < 2; ++bj) { f32x4 v0 = acc[ai][bj][m][0] + bv[bj][0], v1 = acc[ai][bj][m][1] + bv[bj][1];
                    if (ACT == 1) { f32x2 a = gelu_pk((f32x2){v0[0], v0[1]}), b = gelu_pk((f32x2){v0[2], v0[3]}), c = gelu_pk((f32x2){v1[0], v1[1]}), d = gelu_pk((f32x2){v1[2], v1[3]});
                        v0 = (f32x4){a.x, a.y, b.x, b.y}; v1 = (f32x4){c.x, c.y, d.x, d.y}; }
                    if (ACT == 2) {
#pragma unroll
                        for (int j = 0; j < 4; ++j) { v0[j] = 0.5f * v0[j] * (1.0f + erff(v0[j] * 0.70710678f)); v1[j] = 0.5f * v1[j] * (1.0f + erff(v1[j] * 0.70710678f)); } }
                    u32x4 w; w.x = cvt_pk_bf16(v0[0], v0[1]); w.y = cvt_pk_bf16(v0[2], v0[3]); w.z = cvt_pk_bf16(v1[0], v1[1]); w.w = cvt_pk_bf16(v1[2], v1[3]);
                    *(u32x4*)(rowp + bj * HALF) = w; } }
    }
};
template <class Epi, class Sched, bool STAMP = false>
__device__ __forceinline__ void gemm_phase(PG8_LAS unsigned char* lds, const Gemm g, const Sched& S, const Epi& E, unsigned long long* stamps) {
    const int tid = threadIdx.x, wid = __builtin_amdgcn_readfirstlane(tid >> 6), lane = tid & 63, wr = wid >> 2, wc = wid & 3, fr = lane & 15, fq = lane >> 4;
    constexpr int K = 2048, nt = K / BK;
    int ts_lo = 0, ts_hi = 0, nts = 0; const unsigned long long rt_entry = STAMP ? (unsigned long long)wall_clock64() : 0ull;
#define PG8_STAMP() do { if (STAMP && wid == 0 && nts < 64) { const unsigned long long _c = (unsigned long long)clock64(); \
        ts_lo = (lane == nts) ? (int)(unsigned)_c : ts_lo; ts_hi = (lane == nts) ? (int)(unsigned)(_c >> 32) : ts_hi; ++nts; } } while (0)
    PG8_STAMP();
    unsigned voffA[2], voffB[2];
#pragma unroll
    for (int i = 0; i < 2; ++i) { int R, C; stage_rc(tid * 16 + i * 8192, R, C); const int Rb = Epi::PERM ? ((R & ~31) + perm32(R & 31)) : R;
        voffA[i] = (unsigned)(R * K + C) * 2u; voffB[i] = (unsigned)(Rb * K + C) * 2u; }
    const size_t kstep = (size_t)(BK * 2);
    const size_t hstep = (size_t)HALF * K * 2;
    const size_t tstep = 2 * hstep;
    const unsigned ldsw = (unsigned)wid * 1024u;
    const int aoff = lds_byte(wr * 64 + fr, fq * 8), boff = lds_byte(wc * 32 + fr, fq * 8);
#define PG8_SA(b, h) (((b) * 2 + (h)) * HTB)
#define PG8_SB(b, h) ((4 + (b) * 2 + (h)) * HTB)
#define PG8_STAGE(bufoff, gbase, voff) do { _Pragma("unroll") for (int _i = 0; _i < 2; ++_i) \
        __builtin_amdgcn_global_load_lds((const unsigned*)((const char*)(gbase) + (voff)[_i]), (PG8_LAS unsigned*)(lds + (bufoff) + ldsw + _i * 8192), 16, 0, 0); } while (0)
#define PG8_LDA(dst, b, h) do { _Pragma("unroll") for (int m = 0; m < 4; ++m) _Pragma("unroll") for (int k = 0; k < 2; ++k) dst[m][k] = *(const PG8_LAS bf16x8*)(lds + PG8_SA(b, h) + aoff + m * 2048 + k * 1024); } while (0)
#define PG8_LDB(dst, b, h) do { _Pragma("unroll") for (int n = 0; n < 2; ++n) _Pragma("unroll") for (int k = 0; k < 2; ++k) dst[n][k] = *(const PG8_LAS bf16x8*)(lds + PG8_SB(b, h) + boff + n * 2048 + k * 1024); } while (0)
#define PG8_MMA(ai, bj, At, Bt) do { __builtin_amdgcn_s_setprio(1); _Pragma("unroll") for (int m = 0; m < 4; ++m) _Pragma("unroll") for (int n = 0; n < 2; ++n) _Pragma("unroll") for (int k = 0; k < 2; ++k) \
        acc[ai][bj][m][n] = __builtin_amdgcn_mfma_f32_16x16x32_bf16(Bt[n][k], At[m][k], acc[ai][bj][m][n], 0, 0, 0); __builtin_amdgcn_s_setprio(0); } while (0)
#define PG8_WAIT_V(n) asm volatile("s_waitcnt vmcnt(" #n ")" ::: "memory")
#define PG8_WAIT_L(n) asm volatile("s_waitcnt lgkmcnt(" #n ")" ::: "memory")
#define PG8_BAR __builtin_amdgcn_s_barrier()
#define PG8_SCHED __builtin_amdgcn_sched_barrier(0)
    Unit cur, nxt; int ui = 0;
    if (!S.next(0, cur)) return;
    f32x4 acc[2][2][4][2];
#pragma unroll
    for (int a = 0; a < 2; ++a)
#pragma unroll
        for (int b = 0; b < 2; ++b)
#pragma unroll
            for (int m = 0; m < 4; ++m)
#pragma unroll
                for (int n = 0; n < 2; ++n) acc[a][b][m][n] = (f32x4){0.f, 0.f, 0.f, 0.f};
    bf16x8 At[4][2], B0[2][2], B1[2][2];
    const char* cA = (const char*)g.A + (size_t)cur.pm * tstep; const char* cB = (const char*)g.Bt + (size_t)cur.pn * tstep;
    S.a_ready(cur);
    PG8_STAGE(PG8_SB(0, 0), cB, voffB); PG8_STAGE(PG8_SA(0, 0), cA, voffA); PG8_STAGE(PG8_SB(0, 1), cB + hstep, voffB); PG8_STAGE(PG8_SA(0, 1), cA + hstep, voffA);
    if (wr == 1) PG8_BAR;
    PG8_WAIT_V(4); PG8_BAR;
    PG8_STAGE(PG8_SB(1, 0), cB + kstep, voffB); PG8_STAGE(PG8_SA(1, 0), cA + kstep, voffA); PG8_STAGE(PG8_SB(1, 1), cB + hstep + kstep, voffB);
    PG8_WAIT_V(6); PG8_BAR;
    PG8_STAMP();
    for (;;) {
        const bool has_next = S.next(ui + 1, nxt);
        const char* nA = has_next ? (const char*)g.A + (size_t)nxt.pm * tstep : cA; const char* nB = has_next ? (const char*)g.Bt + (size_t)nxt.pn * tstep : cB;
        for (int t = 0; t < nt; t += 2) {
            const bool last = (t == nt - 2);
            const char* a1 = cA + (size_t)(t + 1) * kstep;
            const char* a2 = last ? nA : cA + (size_t)(t + 2) * kstep; const char* b2 = last ? nB : cB + (size_t)(t + 2) * kstep;
            const char* a3 = a2 + kstep; const char* b3 = b2 + kstep;
            if (last && has_next) S.a_ready(nxt);
            PG8_LDB(B0, 0, 0); PG8_SCHED; PG8_LDA(At, 0, 0); PG8_STAGE(PG8_SA(1, 1), a1 + hstep, voffA);
            PG8_WAIT_L(8); PG8_BAR; PG8_WAIT_L(0); PG8_MMA(0, 0, At, B0); PG8_BAR; PG8_SCHED;
            PG8_LDB(B1, 0, 1); PG8_STAGE(PG8_SB(0, 0), b2, voffB);
            PG8_BAR; PG8_WAIT_L(0); PG8_MMA(0, 1, At, B1); PG8_BAR;
            PG8_LDA(At, 0, 1); PG8_STAGE(PG8_SA(0, 0), a2, voffA);
            PG8_BAR; PG8_WAIT_L(0); PG8_MMA(1, 0, At, B0); PG8_BAR; PG8_SCHED;
            PG8_STAGE(PG8_SB(0, 1), b2 + hstep, voffB);
            PG8_WAIT_V(6); PG8_BAR; PG8_MMA(1, 1, At, B1); PG8_BAR;
            PG8_LDB(B0, 1, 0); PG8_SCHED; PG8_LDA(At, 1, 0); PG8_STAGE(PG8_SA(0, 1), a2 + hstep, voffA);
            PG8_WAIT_L(8); PG8_BAR; PG8_WAIT_L(0); PG8_MMA(0, 0, At, B0); PG8_BAR; PG8_SCHED;
            PG8_LDB(B1, 1, 1); PG8_STAGE(PG8_SB(1, 0), b3, voffB);
            PG8_BAR; PG8_WAIT_L(0); PG8_MMA(0, 1, At, B1); PG8_BAR;
            PG8_LDA(At, 1, 1); PG8_STAGE(PG8_SA(1, 0), a3, voffA);
            PG8_BAR; PG8_WAIT_L(0); PG8_MMA(1, 0, At, B0); PG8_BAR; PG8_SCHED;
            PG8_STAGE(PG8_SB(1, 1), b3 + hstep, voffB);
            PG8_WAIT_V(6); PG8_BAR; PG8_MMA(1, 1, At, B1); PG8_BAR;
        }
        PG8_STAMP();
        if constexpr (!Epi::AFTER_DRAIN) { E(acc, cur, wr, wc, fr, fq); S.done(cur); }
        PG8_STAMP();
        if (!has_next) break;
#pragma unroll
        for (int a = 0; a < 2; ++a)
#pragma unroll
            for (int b = 0; b < 2; ++b)
#pragma unroll
                for (int m = 0; m < 4; ++m)
#pragma unroll
                    for (int n = 0; n < 2; ++n) acc[a][b][m][n] = (f32x4){0.f, 0.f, 0.f, 0.f};
        cur = nxt; cA = nA; cB = nB; ++ui;
    }
    PG8_WAIT_V(0);
    if (wr == 0) PG8_BAR;
    PG8_BAR;
    if constexpr (Epi::AFTER_DRAIN) { E.fused(acc, cur, wr, wc, fr, fq, lds, wid, lane); S.done(cur); }
    PG8_STAMP();
    if (STAMP && wid == 0) { stamps[lane] = lane < nts ? (((unsigned long long)(unsigned)ts_hi << 32) | (unsigned)ts_lo) : 0ull;
        if (lane == 62) stamps[62] = rt_entry; if (lane == 63) stamps[63] = (unsigned long long)wall_clock64(); }
#undef PG8_STAMP
#undef PG8_SA
#undef PG8_SB
#undef PG8_STAGE
#undef PG8_LDA
#undef PG8_LDB
#undef PG8_MMA
#undef PG8_WAIT_V
#undef PG8_WAIT_L
#undef PG8_BAR
#undef PG8_SCHED
}
}

namespace mk {
#define GAS __attribute__((address_space(1)))
#define LAS __attribute__((address_space(3)))
#define DEV __device__ __forceinline__
typedef unsigned short bf16;
typedef unsigned v4u __attribute__((ext_vector_type(4)));
typedef float f32x4 __attribute__((ext_vector_type(4)));
typedef float f32x2 __attribute__((ext_vector_type(2)));

#ifndef MK_DBG
#define MK_DBG 0
#endif
#ifndef MK_CHECK
#define MK_CHECK 0
#endif
#ifndef MK_N_LAUNCHES
#define MK_N_LAUNCHES 19
#endif

constexpr int D = 2048, SEQ = 4096, M = 8192, NL = 2;
constexpr int LRU_W = 768, SWA_W = 768, SB_W = 512, IN_W = 5376;
constexpr int ZO_XA = 0, ZO_GA = 768, ZO_QB = 1536, ZO_KB = 2304, ZO_VB = 3072, ZO_QC = 3840, ZO_KC = 4352, ZO_VC = 4864;
constexpr int NEXP = 16384, MODW = 12288;
constexpr int MO_SH1 = 0, MO_SC1 = 2048, MO_G1 = 4096, MO_SH2 = 6144, MO_SC2 = 8192, MO_G2 = 10240;
constexpr float EPS = 1e-6f;
constexpr float QSCALE = 0.08838834764831845f;
constexpr float NEGBIG = -3.0e38f;
constexpr int NPHASE = 19 + 2 * (MK_CHECK != 0);

constexpr size_t MiB = 1u << 20;
constexpr size_t WS_CTL = 0, CTL_ZERO_BYTES = 1 * MiB;
constexpr size_t WS_MOD = 512 * 1024;
constexpr size_t WS_WIN_T = 2 * MiB, WS_WOUT_T = 44 * MiB, WS_WQ_T = 60 * MiB, WS_SUBK = 76 * MiB, WS_U = 80 * MiB, WS_V = 208 * MiB,
                 WS_H = 336 * MiB, WS_Z = 368 * MiB, WS_HLOC = 452 * MiB, WS_P = 476 * MiB, WS_YB = 500 * MiB, WS_YC = 524 * MiB,
                 WS_SUMA = 540 * MiB, WS_SUMB = 541 * MiB, WS_X1 = 544 * MiB, WS_X2 = 608 * MiB, WS_Q = 672 * MiB, WS_IDS = 704 * MiB,
                 WS_G = 708 * MiB, WS_END = 712 * MiB;
constexpr int CW_BAR = 4096;

constexpr int LDS_BYTES = 147456;
constexpr int LDS_MISC = 131072;

__device__ const unsigned char T5B[3][132] = {
 {0,1,2,3,4,5,6,7,8,9,10,11,12,13,14,15,16,16,16,16,16,16,17,17,17,17,17,17,17,17,18,18,18,18,18,18,18,18,18,18,19,19,19,19,19,19,19,19,19,19,19,19,19,19,20,20,20,20,20,20,20,20,20,20,20,20,20,20,20,20,20,20,20,21,21,21,21,21,21,21,21,21,21,21,21,21,21,21,21,21,21,21,21,21,21,21,21,21,21,22,22,22,22,22,22,22,22,22,22,22,22,22,22,22,22,22,22,22,22,22,22,22,22,22,22,22,22,22,22,0,0,0},
 {0,4,8,12,16,16,17,17,18,18,19,19,19,19,20,20,20,20,20,21,21,21,21,21,21,22,22,22,22,22,22,22,22,22,23,23,23,23,23,23,23,23,23,23,23,23,24,24,24,24,24,24,24,24,24,24,24,24,24,24,24,24,25,25,25,25,25,25,25,25,25,25,25,25,25,25,25,25,25,25,25,25,25,26,26,26,26,26,26,26,26,26,26,26,26,26,26,26,26,26,26,26,26,26,26,26,26,26,26,26,26,26,26,27,27,27,27,27,27,27,27,27,27,27,27,27,27,27,27,0,0,0},
 {0,16,18,19,20,21,21,22,22,23,23,23,24,24,24,24,25,25,25,25,25,26,26,26,26,26,26,26,26,27,27,27,27,27,27,27,27,27,27,28,28,28,28,28,28,28,28,28,28,28,28,28,29,29,29,29,29,29,29,29,29,29,29,29,29,29,29,29,29,29,30,30,30,30,30,30,30,30,30,30,30,30,30,30,30,30,30,30,30,30,30,30,30,30,30,31,31,31,31,31,31,31,31,31,31,31,31,31,31,31,31,31,31,31,31,31,31,31,31,31,31,31,31,31,31,31,31,31,31,0,0,0}};

#define LDS_WAIT() asm volatile("s_waitcnt lgkmcnt(0)" ::: "memory")
DEV unsigned f2bf(float f) { unsigned u = __builtin_bit_cast(unsigned, f); return (u + 0x7fffu + ((u >> 16) & 1u)) >> 16; }
DEV unsigned pk2(float lo, float hi) { return f2bf(lo) | (f2bf(hi) << 16); }
DEV float bf_lo(unsigned w) { return __builtin_bit_cast(float, w << 16); }
DEV float bf_hi(unsigned w) { return __builtin_bit_cast(float, w & 0xffff0000u); }
DEV float bf1(bf16 h) { return __builtin_bit_cast(float, ((unsigned)h) << 16); }
DEV float wave_sum(float v) {
#pragma unroll
    for (int o = 1; o < 64; o <<= 1) v += __shfl_xor(v, o);
    return v;
}
DEV float wave_max(float v) {
#pragma unroll
    for (int o = 1; o < 64; o <<= 1) v = fmaxf(v, __shfl_xor(v, o));
    return v;
}
DEV float sigmoid_f(float x) { return 1.f / (1.f + __expf(-x)); }
DEV float softplus_f(float x) { return fmaxf(x, 0.f) + log1pf(__expf(-fabsf(x))); }
DEV float gelu_tanh(float x) { const float u = 0.7978845608028654f * (x + 0.044715f * x * x * x); const float t = 1.f - 2.f / (1.f + __expf(2.f * u)); return 0.5f * x * (1.f + t); }
DEV float dot8(const v4u a, const v4u b) {
    float s = bf_lo(a.x) * bf_lo(b.x); s += bf_hi(a.x) * bf_hi(b.x);
    s += bf_lo(a.y) * bf_lo(b.y); s += bf_hi(a.y) * bf_hi(b.y);
    s += bf_lo(a.z) * bf_lo(b.z); s += bf_hi(a.z) * bf_hi(b.z);
    s += bf_lo(a.w) * bf_lo(b.w); s += bf_hi(a.w) * bf_hi(b.w);
    return s;
}

#define XB_TMO      128
#define XB_XCNT(j)  (256  + 64 * (j))
#define XB_XSUB(j)  (1280 + 64 * (j))
#define XB_XGEN(j)  (2304 + 64 * (j))
#define XB_TOP      3328
#define XB_TOPGEN   3392
#define XCD_BAR_WORDS 3456
#define XB_SPIN_CAP (1u << 18)

__device__ __forceinline__ unsigned xb_ld(unsigned* p)              { return __hip_atomic_load(p, __ATOMIC_RELAXED, __HIP_MEMORY_SCOPE_AGENT); }
__device__ __forceinline__ unsigned xb_add(unsigned* p, unsigned v) { return __hip_atomic_fetch_add(p, v, __ATOMIC_RELAXED, __HIP_MEMORY_SCOPE_AGENT); }
__device__ __forceinline__ unsigned xb_xcc_id() { return (unsigned)__builtin_amdgcn_s_getreg((3 << 11) | 20) & 0xFu; }
#define XB_SPIN(cond, bar) do { unsigned _sp = 0; while (cond) { __builtin_amdgcn_s_sleep(1); \
    if ((++_sp & 255u) == 0u) { if (xb_ld(&(bar)[XB_TMO])) break; if (_sp > XB_SPIN_CAP) { atomicAdd(&(bar)[XB_TMO], 1u); break; } } } } while (0)

struct XcdBarrier {
    unsigned* bar; unsigned x;
    volatile LAS unsigned* st;
};
__device__ __forceinline__ XcdBarrier xcd_barrier_post(unsigned* bar, volatile LAS unsigned* st) {
    XcdBarrier b; b.bar = bar; b.x = xb_xcc_id(); b.st = st;
    if (threadIdx.x == 0) (void)xb_add(&bar[XB_XCNT(b.x)], 1u);
    return b;
}
__device__ __forceinline__ void xcd_barrier_complete(unsigned* bar, unsigned x, unsigned& nloc, unsigned& nx) {
    const unsigned G = gridDim.x * gridDim.y * gridDim.z;
    unsigned sum, cnt, mine, sp = 0u;
    for (;;) {
        sum = 0u; cnt = 0u; mine = 0u;
#pragma unroll
        for (unsigned j = 0; j < 16; ++j) { const unsigned c = xb_ld(&bar[XB_XCNT(j)]); sum += c; cnt += (c > 0u) ? 1u : 0u; mine = (j == x) ? c : mine; }
        if (sum == G) break;
        __builtin_amdgcn_s_sleep(1);
        if ((++sp & 255u) == 0u) { if (xb_ld(&bar[XB_TMO])) break; if (sp > XB_SPIN_CAP) { atomicAdd(&bar[XB_TMO], 1u); break; } }
    }
    nloc = mine > 0u ? mine : 1u; nx = cnt > 0u ? cnt : 1u;
}
__device__ __forceinline__ void xcd_barrier(const XcdBarrier& b) {
    asm volatile("s_waitcnt vmcnt(0)" ::: "memory");
    __syncthreads();
    if (threadIdx.x == 0) {
        unsigned* bar = b.bar;
        __builtin_amdgcn_s_waitcnt(0);
        unsigned nloc = b.st[0], nx = b.st[1];
        if (nloc == 0u) { xcd_barrier_complete(bar, b.x, nloc, nx); b.st[0] = nloc; b.st[1] = nx; }
        const unsigned old = xb_add(&bar[XB_XSUB(b.x)], 1u);
        const unsigned gen = old / nloc;
        if (old + 1u == (gen + 1u) * nloc) {
            __builtin_amdgcn_fence(__ATOMIC_RELEASE, "agent");
            asm volatile("s_waitcnt vmcnt(0)" ::: "memory");
            const unsigned og = xb_add(&bar[XB_TOP], 1u);
            const unsigned tg = og / nx;
            if (og + 1u == (tg + 1u) * nx) xb_add(&bar[XB_TOPGEN], 1u);
            else XB_SPIN(xb_ld(&bar[XB_TOPGEN]) == tg, bar);
            __builtin_amdgcn_fence(__ATOMIC_ACQUIRE, "agent");
            xb_add(&bar[XB_XGEN(b.x)], 1u);
            asm volatile("s_waitcnt vmcnt(0)" ::: "memory");
        } else {
            XB_SPIN(xb_ld(&bar[XB_XGEN(b.x)]) == gen, bar);
            __builtin_amdgcn_fence(__ATOMIC_ACQUIRE, "agent");
            asm volatile("s_waitcnt vmcnt(0)" ::: "memory");
        }
    }
    __syncthreads();
}

struct EpiResGate {
    static constexpr bool PERM = false, AFTER_DRAIN = false;
    const float* X; float* O; const float* gate; float gscale;
    __device__ __forceinline__ void operator()(const pg8::f32x4 (&acc)[2][2][4][2], const pg8::Unit& u, int wr, int wc, int fr, int fq) const {
        const int row0 = u.pm * 256 + wr * 64 + fr, col0 = u.pn * 256 + wc * 32 + 4 * fq;
        const float* gp = gate + (size_t)((u.pm * 256) >> 12) * MODW;
        pg8::f32x4 gv[2][2];
#pragma unroll
        for (int bj = 0; bj < 2; ++bj)
#pragma unroll
            for (int n = 0; n < 2; ++n) gv[bj][n] = *(const pg8::f32x4*)(gp + col0 + bj * 128 + n * 16) * gscale;
#pragma unroll
        for (int ai = 0; ai < 2; ++ai)
#pragma unroll
            for (int m = 0; m < 4; ++m) {
                const size_t ro = (size_t)(row0 + ai * 128 + m * 16) * D + col0;
#pragma unroll
                for (int bj = 0; bj < 2; ++bj)
#pragma unroll
                    for (int n = 0; n < 2; ++n) {
                        const pg8::f32x4 xv = *(const pg8::f32x4*)(X + ro + bj * 128 + n * 16);
                        *(pg8::f32x4*)(O + ro + bj * 128 + n * 16) = xv + gv[bj][n] * acc[ai][bj][m][n];
                    }
            }
    }
};

DEV void ph_mod(const float* __restrict__ c, const float* __restrict__ w_mod, const float* __restrict__ b_mod, float* __restrict__ mod, LAS float* red, int vcu, int G, int tid) {
    const int lane = tid & 63, wave = tid >> 6;
    for (int it = vcu; it < 2 * 192; it += G) {
        const int l = it / 192, cb = it % 192;
        const int k0 = wave * 256;
        const float* W = w_mod + ((size_t)l * D + k0) * MODW + cb * 64 + lane;
        float a0 = 0.f, a1 = 0.f;
#pragma unroll 16
        for (int k = 0; k < 256; ++k) {
            const float w = W[(size_t)k * MODW];
            const float c0 = c[k0 + k], c1 = c[D + k0 + k];
            a0 += (c0 * sigmoid_f(c0)) * w; a1 += (c1 * sigmoid_f(c1)) * w;
        }
        red[(wave * 2 + 0) * 64 + lane] = a0; red[(wave * 2 + 1) * 64 + lane] = a1;
        __syncthreads();
        if (tid < 128) {
            const int b = tid >> 6, ln = tid & 63; float s = 0.f;
#pragma unroll
            for (int w = 0; w < 8; ++w) s += red[(w * 2 + b) * 64 + ln];
            const int col = cb * 64 + ln;
            mod[(size_t)(l * 2 + b) * MODW + col] = s + b_mod[l * MODW + col];
        }
        __syncthreads();
    }
}
DEV void transpose_item(const float* __restrict__ W, int K, int N, bf16* __restrict__ WT, LAS float* scr, int item, int lane) {
    const int nblk = N / 32, kb = item / nblk, nb = item % nblk, k0 = 64 * kb, n0 = 32 * nb;
#pragma unroll 8
    for (int i = 0; i < 32; ++i) { const int kk = 2 * i + (lane >> 5); scr[kk * 33 + (lane & 31)] = W[(size_t)(k0 + kk) * N + n0 + (lane & 31)]; }
    LDS_WAIT();
    const int c = lane & 7;
#pragma unroll
    for (int j = 0; j < 4; ++j) { const int n = (lane >> 3) + 8 * j; const LAS float* s = scr + (8 * c) * 33 + n;
        v4u o; o.x = pk2(s[0 * 33], s[1 * 33]); o.y = pk2(s[2 * 33], s[3 * 33]); o.z = pk2(s[4 * 33], s[5 * 33]); o.w = pk2(s[6 * 33], s[7 * 33]);
        *(v4u*)(WT + (size_t)(n0 + n) * K + k0 + 8 * c) = o; }
    LDS_WAIT();
}
DEV void convert_copy(const float* __restrict__ src, bf16* __restrict__ dst, size_t ngroups8, size_t gtid, size_t gstride) {
    for (size_t g = gtid; g < ngroups8; g += gstride) {
        const f32x4 a = *(const f32x4*)(src + g * 8), b = *(const f32x4*)(src + g * 8 + 4);
        v4u o; o.x = pk2(a.x, a.y); o.y = pk2(a.z, a.w); o.z = pk2(b.x, b.y); o.w = pk2(b.z, b.w);
        *(v4u*)(dst + g * 8) = o;
    }
}

DEV void modnorm_rows(const float* __restrict__ X, const float* __restrict__ gain, const float* __restrict__ modl, int sh_off, int sc_off, bf16* __restrict__ H, int gw, int NGW, int lane) {
    for (int m = gw; m < M; m += NGW) {
        const int b = m >> 12;
        const f32x4* xr = (const f32x4*)(X + (size_t)m * D) + lane;
        f32x4 v[8]; float s = 0.f;
#pragma unroll
        for (int j = 0; j < 8; ++j) { v[j] = xr[64 * j]; s += (v[j].x * v[j].x + v[j].y * v[j].y) + (v[j].z * v[j].z + v[j].w * v[j].w); }
        const float r = rsqrtf(wave_sum(s) * (1.f / D) + EPS);
        const f32x4* g4 = (const f32x4*)gain + lane;
        const f32x4* sc4 = (const f32x4*)(modl + (size_t)b * MODW + sc_off) + lane;
        const f32x4* sh4 = (const f32x4*)(modl + (size_t)b * MODW + sh_off) + lane;
        unsigned long long* o8 = (unsigned long long*)(H + (size_t)m * D) + lane;
#pragma unroll
        for (int j = 0; j < 8; ++j) {
            const f32x4 g = g4[64 * j], sc = sc4[64 * j], sh = sh4[64 * j];
            const f32x4 y = (v[j] * r) * g * (sc + 1.f) + sh;
            o8[64 * j] = (unsigned long long)pk2(y.x, y.y) | ((unsigned long long)pk2(y.z, y.w) << 32);
        }
    }
}

DEV void lru_item(int l, int b, int j, int n, const bf16* __restrict__ Z, const float* __restrict__ conv_w, const float* __restrict__ conv_b,
                  const float* __restrict__ w_rec, const float* __restrict__ b_rec, const float* __restrict__ w_gi, const float* __restrict__ b_gi, const float* __restrict__ lam,
                  float* __restrict__ HLOC, float* __restrict__ PP, float* __restrict__ SUMA, float* __restrict__ SUMB, LAS float* xc, LAS float* aL, LAS float* uL, int tid) {
    const int ch = tid & 127, tq = tid >> 7, c = n * 128 + ch;
    {
        const float cw0 = conv_w[(l * 4 + 0) * LRU_W + c], cw1 = conv_w[(l * 4 + 1) * LRU_W + c], cw2 = conv_w[(l * 4 + 2) * LRU_W + c], cw3 = conv_w[(l * 4 + 3) * LRU_W + c];
        const float cb = conv_b[l * LRU_W + c];
#pragma unroll 4
        for (int i = 0; i < 16; ++i) {
            const int tok = tq + 4 * i, t = j * 64 + tok;
            const bf16* zp = Z + ((size_t)b * SEQ + t) * IN_W + ZO_XA + c;
            float s = cb + cw3 * bf1(zp[0]);
            if (t >= 1) s += cw2 * bf1(zp[-(ptrdiff_t)IN_W]);
            if (t >= 2) s += cw1 * bf1(zp[-(ptrdiff_t)2 * IN_W]);
            if (t >= 3) s += cw0 * bf1(zp[-(ptrdiff_t)3 * IN_W]);
            xc[tok * 128 + ch] = s;
        }
    }
    __syncthreads();
    float accr[16], acci[16];
#pragma unroll
    for (int i = 0; i < 16; ++i) { accr[i] = 0.f; acci[i] = 0.f; }
    const float* Wr = w_rec + ((size_t)(l * 6 + n) * 128) * 128 + ch;
    const float* Wi = w_gi + ((size_t)(l * 6 + n) * 128) * 128 + ch;
#pragma unroll 2
    for (int jj = 0; jj < 128; ++jj) {
        const float wr = Wr[jj * 128], wi = Wi[jj * 128];
#pragma unroll
        for (int i = 0; i < 16; ++i) { const float x = xc[(tq + 4 * i) * 128 + jj]; accr[i] += x * wr; acci[i] += x * wi; }
    }
    {
        const float br = b_rec[l * LRU_W + c], bi = b_gi[l * LRU_W + c], sp = softplus_f(-lam[l * LRU_W + c]);
#pragma unroll
        for (int i = 0; i < 16; ++i) {
            const int tok = tq + 4 * i;
            const float r = sigmoid_f(accr[i] + br), ig = sigmoid_f(acci[i] + bi);
            const float log_a = -8.0f * r * sp;
            const float av = __expf(log_a);
            const float x = xc[tok * 128 + ch];
            const float uv = sqrtf(fmaxf(-expm1f(2.f * log_a), 0.f)) * (ig * x);
            aL[tok * 128 + ch] = av; uL[tok * 128 + ch] = uv;
        }
    }
    __syncthreads();
    if (tid < 128) {
        float h = 0.f, P = 1.f;
        const size_t rb = ((size_t)b * SEQ + j * 64) * LRU_W + n * 128 + tid;
        for (int tok = 0; tok < 64; ++tok) {
            const float av = aL[tok * 128 + tid];
            h = av * h + uL[tok * 128 + tid]; P *= av;
            HLOC[rb + (size_t)tok * LRU_W] = h; PP[rb + (size_t)tok * LRU_W] = P;
        }
        SUMA[(size_t)(b * 64 + j) * LRU_W + n * 128 + tid] = P; SUMB[(size_t)(b * 64 + j) * LRU_W + n * 128 + tid] = h;
    }
    __syncthreads();
}

DEV void dil_item(int b, int h, int t, const bf16* __restrict__ Z, const float* __restrict__ rel_bias, float* __restrict__ YB, LAS float* qs, LAS float* lg, int lane) {
    const size_t row = (size_t)b * SEQ + t;
    { const unsigned w = *(const unsigned*)(Z + row * IN_W + ZO_QB + h * 128 + 2 * lane); qs[2 * lane] = bf_lo(w) * QSCALE; qs[2 * lane + 1] = bf_hi(w) * QSCALE; }
    LDS_WAIT();
    float mx = NEGBIG;
#pragma unroll
    for (int p = 0; p < 3; ++p) {
        const int d = 1 << (2 * p);
        for (int jj = lane; jj < 129; jj += 64) {
            const int pos = t - jj * d; float lgt = NEGBIG;
            if (pos >= 0) {
                const v4u* kr = (const v4u*)(Z + ((size_t)b * SEQ + pos) * IN_W + ZO_KB + h * 128);
                float s = 0.f;
#pragma unroll 4
                for (int c8 = 0; c8 < 16; ++c8) { const v4u kv = kr[c8]; const LAS float* q = qs + c8 * 8;
                    s += q[0] * bf_lo(kv.x) + q[1] * bf_hi(kv.x) + q[2] * bf_lo(kv.y) + q[3] * bf_hi(kv.y) + q[4] * bf_lo(kv.z) + q[5] * bf_hi(kv.z) + q[6] * bf_lo(kv.w) + q[7] * bf_hi(kv.w); }
                lgt = s + rel_bias[(int)T5B[p][jj] * 6 + h];
            }
            lg[p * 129 + jj] = lgt; mx = fmaxf(mx, lgt);
        }
    }
    mx = wave_max(mx);
    LDS_WAIT();
    float sum = 0.f;
    for (int idx = lane; idx < 387; idx += 64) { const float v = lg[idx]; const float pv = (v > -1.0e37f) ? __expf(v - mx) : 0.f; lg[idx] = pv; sum += pv; }
    sum = wave_sum(sum);
    LDS_WAIT();
    float a0 = 0.f, a1 = 0.f;
#pragma unroll
    for (int p = 0; p < 3; ++p) {
        const int d = 1 << (2 * p);
        int nk = t / d + 1; nk = nk > 129 ? 129 : nk;
        const bf16* vb = Z + row * IN_W + ZO_VB + h * 128 + 2 * lane;
#pragma unroll 4
        for (int jj = 0; jj < nk; ++jj) {
            const float pv = lg[p * 129 + jj];
            const unsigned w = *(const unsigned*)(vb - (size_t)jj * d * IN_W);
            a0 += pv * bf_lo(w); a1 += pv * bf_hi(w);
        }
    }
    const float inv = 1.f / sum;
    *(f32x2*)(YB + row * SWA_W + h * 128 + 2 * lane) = (f32x2){a0 * inv, a1 * inv};
    LDS_WAIT();
}

DEV void sb_item(int b, int h, int t, const bf16* __restrict__ Z, float* __restrict__ YC, LAS float* qs, LAS float* pA, int lane) {
    const size_t row = (size_t)b * SEQ + t;
    { const unsigned w = *(const unsigned*)(Z + row * IN_W + ZO_QC + h * 128 + 2 * lane); qs[2 * lane] = bf_lo(w) * QSCALE; qs[2 * lane + 1] = bf_hi(w) * QSCALE; }
    LDS_WAIT();
    float carry = 0.f, a0 = 0.f, a1 = 0.f;
    for (int shi = t - 1; shi >= 0; shi -= 64) {
        const int s = shi - lane; const bool valid = s >= 0;
        float z = 0.f;
        if (valid) {
            const v4u* kr = (const v4u*)(Z + ((size_t)b * SEQ + s) * IN_W + ZO_KC + h * 128);
#pragma unroll 4
            for (int c8 = 0; c8 < 16; ++c8) { const v4u kv = kr[c8]; const LAS float* q = qs + c8 * 8;
                z += q[0] * bf_lo(kv.x) + q[1] * bf_hi(kv.x) + q[2] * bf_lo(kv.y) + q[3] * bf_hi(kv.y) + q[4] * bf_lo(kv.z) + q[5] * bf_hi(kv.z) + q[6] * bf_lo(kv.w) + q[7] * bf_hi(kv.w); }
        }
        const float l1m = valid ? -softplus_f(z) : 0.f;
        float inc = l1m;
#pragma unroll
        for (int o = 1; o < 64; o <<= 1) { const float tmp = __shfl_up(inc, o); if (lane >= o) inc += tmp; }
        const float A = valid ? __expf(-softplus_f(-z) + carry + (inc - l1m)) : 0.f;
        carry += __shfl(inc, 63);
        pA[lane] = A;
        LDS_WAIT();
        const int nk = (shi + 1) < 64 ? (shi + 1) : 64;
        const bf16* vb = Z + ((size_t)b * SEQ + shi) * IN_W + ZO_VC + h * 128 + 2 * lane;
#pragma unroll 4
        for (int i = 0; i < nk; ++i) {
            const float pv = pA[i];
            const unsigned w = *(const unsigned*)(vb - (size_t)i * IN_W);
            a0 += pv * bf_lo(w); a1 += pv * bf_hi(w);
        }
        LDS_WAIT();
    }
    *(f32x2*)(YC + row * SB_W + h * 128 + 2 * lane) = (f32x2){a0, a1};
}

DEV void combine_item(int l, int b, int j, int half, const bf16* __restrict__ Z, const float* __restrict__ HLOC, const float* __restrict__ PP, const float* __restrict__ SUMA, const float* __restrict__ SUMB,
                      const float* __restrict__ YB, const float* __restrict__ YC, const float* __restrict__ g_lru, const float* __restrict__ g_swa, const float* __restrict__ g_sb,
                      bf16* __restrict__ Y, LAS float* carryL, int tid) {
    const int lane = tid & 63, wave = tid >> 6;
    for (int c = tid; c < LRU_W; c += 512) {
        float cr = 0.f;
        for (int i = 0; i < j; ++i) cr = SUMA[(size_t)(b * 64 + i) * LRU_W + c] * cr + SUMB[(size_t)(b * 64 + i) * LRU_W + c];
        carryL[c] = cr;
    }
    __syncthreads();
    for (int i = 0; i < 4; ++i) {
        const int tok = half * 32 + wave * 4 + i;
        const size_t row = (size_t)b * SEQ + j * 64 + tok;
        bf16* yo = Y + row * D;
        {
            float ya[12]; float ssq = 0.f;
#pragma unroll
            for (int e = 0; e < 12; ++e) { const int c = lane + 64 * e;
                const float hv = HLOC[row * LRU_W + c] + PP[row * LRU_W + c] * carryL[c];
                const float ga = bf1(Z[row * IN_W + ZO_GA + c]);
                ya[e] = hv * gelu_tanh(ga); ssq += ya[e] * ya[e]; }
            const float r = rsqrtf(wave_sum(ssq) * (1.f / LRU_W) + EPS);
#pragma unroll
            for (int e = 0; e < 12; ++e) { const int c = lane + 64 * e; yo[c] = (MK_DBG & 16) ? (bf16)0 : (bf16)f2bf(ya[e] * r * g_lru[l * LRU_W + c]); }
        }
        {
            float yb[12]; float ssq = 0.f;
#pragma unroll
            for (int e = 0; e < 12; ++e) { const int c = lane + 64 * e; yb[e] = YB[row * SWA_W + c]; ssq += yb[e] * yb[e]; }
            const float r = rsqrtf(wave_sum(ssq) * (1.f / SWA_W) + EPS);
#pragma unroll
            for (int e = 0; e < 12; ++e) { const int c = lane + 64 * e; yo[LRU_W + c] = (MK_DBG & 32) ? (bf16)0 : (bf16)f2bf(yb[e] * r * g_swa[l * SWA_W + c]); }
        }
        {
            float yc[8]; float ssq = 0.f;
#pragma unroll
            for (int e = 0; e < 8; ++e) { const int c = lane + 64 * e; yc[e] = YC[row * SB_W + c]; ssq += yc[e] * yc[e]; }
            const float r = rsqrtf(wave_sum(ssq) * (1.f / SB_W) + EPS);
#pragma unroll
            for (int e = 0; e < 8; ++e) { const int c = lane + 64 * e; yo[LRU_W + SWA_W + c] = (MK_DBG & 64) ? (bf16)0 : (bf16)f2bf(yc[e] * r * g_sb[l * SB_W + c]); }
        }
    }
    __syncthreads();
}

constexpr int RT_SK = 0, RT_Q = 128 * 129 * 4, RT_SC = RT_Q + 32 * 128 * 4, RT_TV = RT_SC + 64 * 129 * 4, RT_TI = RT_TV + 64 * 16 * 4, RT_END = RT_TI + 64 * 16 * 4;
static_assert(RT_END <= LDS_MISC, "routing LDS");
DEV void route_item(int l, int tile, int h, const bf16* __restrict__ Q, const bf16* __restrict__ SK, int* __restrict__ IDS, float* __restrict__ GG, LAS unsigned char* lds, int tid, unsigned* DBGW = nullptr) {
    LAS float* skL = (LAS float*)(lds + RT_SK); LAS float* qL = (LAS float*)(lds + RT_Q); LAS float* sc = (LAS float*)(lds + RT_SC);
    LAS float* topv = (LAS float*)(lds + RT_TV); LAS int* topi = (LAS int*)(lds + RT_TI);
    const int lane = tid & 63, wave = tid >> 6, row0 = tile * 32;
    for (int c = 0; c < 2; ++c) {
        const bf16* skp = SK + ((size_t)((l * 8 + h) * 2 + c)) * 128 * 128;
#pragma unroll 4
        for (int i = 0; i < 16; ++i) { const int idx2 = tid + 512 * i; const int k = idx2 >> 6, d2 = idx2 & 63; const unsigned w = *(const unsigned*)(skp + k * 128 + 2 * d2); skL[k * 129 + 2 * d2] = bf_lo(w); skL[k * 129 + 2 * d2 + 1] = bf_hi(w); }
#pragma unroll
        for (int i = 0; i < 4; ++i) { const int idx2 = tid + 512 * i; const int tok = idx2 >> 6, d2 = idx2 & 63; const unsigned w = *(const unsigned*)(Q + (size_t)(row0 + tok) * D + h * 256 + c * 128 + 2 * d2); qL[tok * 128 + 2 * d2] = bf_lo(w); qL[tok * 128 + 2 * d2 + 1] = bf_hi(w); }
        __syncthreads();
        {
            const int k = tid & 127, tg = tid >> 7;
            float acc[8];
#pragma unroll
            for (int i = 0; i < 8; ++i) acc[i] = 0.f;
#pragma unroll 4
            for (int d = 0; d < 128; ++d) { const float s = skL[k * 129 + d];
#pragma unroll
                for (int i = 0; i < 8; ++i) acc[i] += s * qL[(tg * 8 + i) * 128 + d]; }
#pragma unroll
            for (int i = 0; i < 8; ++i) sc[(c * 32 + tg * 8 + i) * 129 + k] = acc[i];
        }
        __syncthreads();
    }
    for (int q = 0; q < 8; ++q) {
        const int L = wave * 8 + q;
        float v0 = sc[L * 129 + lane], v1 = sc[L * 129 + 64 + lane];
        for (int r = 0; r < 16; ++r) {
            const float m = wave_max(fmaxf(v0, v1));
            const unsigned long long b0 = __ballot(v0 == m);
            int idx;
            if (b0) { const int ln = __ffsll((long long)b0) - 1; idx = ln; if (lane == ln) v0 = NEGBIG; }
            else { const unsigned long long b1 = __ballot(v1 == m); const int ln = __ffsll((long long)b1) - 1; idx = 64 + ln; if (lane == ln) v1 = NEGBIG; }
            if (lane == 0) { topv[L * 16 + r] = m; topi[L * 16 + r] = idx; }
        }
    }
    __syncthreads();
#if MK_CHECK == 16
    { for (int q = 0; q < 8; ++q) { const int L = wave * 8 + q; const int mi = topi[L * 16 + (lane & 15)]; int dup = 0;
          for (int e = 0; e < 16; ++e) { const int oi = __shfl(mi, e); if (lane < 16 && e != lane && oi == mi) dup = 1; }
          if (dup) atomicAdd((unsigned*)DBGW, 1u); } }
#endif
    for (int q = 0; q < 4; ++q) {
        const int tok = wave * 4 + q;
        float cv[4];
#pragma unroll
        for (int e = 0; e < 4; ++e) cv[e] = topv[tok * 16 + (lane >> 2)] + topv[(32 + tok) * 16 + (lane & 3) * 4 + e];
        float mysc = NEGBIG; int myid = 0;
        for (int r = 0; r < 16; ++r) {
            const float lm = fmaxf(fmaxf(cv[0], cv[1]), fmaxf(cv[2], cv[3]));
            const float m = wave_max(lm);
            const unsigned long long bb = __ballot(lm == m);
            const int ln = __ffsll((long long)bb) - 1;
            const int se = (cv[0] == m) ? 0 : (cv[1] == m) ? 1 : (cv[2] == m) ? 2 : 3;
            const int sel = __shfl(se, ln);
            { const bool me = (lane == ln);
              cv[0] = (me && sel == 0) ? NEGBIG : cv[0]; cv[1] = (me && sel == 1) ? NEGBIG : cv[1];
              cv[2] = (me && sel == 2) ? NEGBIG : cv[2]; cv[3] = (me && sel == 3) ? NEGBIG : cv[3]; }
            const int ci = ln * 4 + sel;
            const int id = topi[tok * 16 + (ci >> 4)] * 128 + topi[(32 + tok) * 16 + (ci & 15)];
            if (lane == r) { mysc = m; myid = id; }
        }
#if MK_CHECK == 16
        { int dup = 0; for (int e = 0; e < 16; ++e) { const int oi = __shfl(myid, e); if (lane < 16 && e != lane && oi == myid) dup = 1; } if (dup) atomicAdd((unsigned*)DBGW + 1, 1u); }
#endif
        const float s0 = __shfl(mysc, 0);
        const float ev = (lane < 16) ? __expf(mysc - s0) : 0.f;
        const float sum = wave_sum(ev);
        if (lane < 16) { IDS[(size_t)(row0 + tok) * 128 + h * 16 + lane] = myid; GG[(size_t)(row0 + tok) * 128 + h * 16 + lane] = ev / sum; }
    }
    __syncthreads();
}

DEV void expert_row(int l, int row, const bf16* __restrict__ H, const int* __restrict__ IDS, const float* __restrict__ GG, const bf16* __restrict__ U, const bf16* __restrict__ V,
                    const float* __restrict__ X1, const float* __restrict__ g2, const float* __restrict__ fnorm, float* __restrict__ XO, int lane, float pscale, float* STATP = nullptr) {
    v4u xv[4];
#pragma unroll
    for (int j = 0; j < 4; ++j) xv[j] = *(const v4u*)(H + (size_t)row * D + lane * 8 + 512 * j);
    const int id0 = IDS[(size_t)row * 128 + lane], id1 = IDS[(size_t)row * 128 + 64 + lane];
    const float gg0 = GG[(size_t)row * 128 + lane], gg1 = GG[(size_t)row * 128 + 64 + lane];
    float y[32];
#pragma unroll
    for (int i = 0; i < 32; ++i) y[i] = 0.f;
    const bf16* Ul = U + (size_t)l * NEXP * D + lane * 8;
    const bf16* Vl = V + (size_t)l * NEXP * D + lane * 8;
    for (int e0 = 0; e0 < 128; e0 += 2) {
        int id[2]; float gq[2];
#pragma unroll
        for (int q = 0; q < 2; ++q) { const int e = e0 + q;
            id[q] = (e < 64) ? __builtin_amdgcn_readlane(id0, e & 63) : __builtin_amdgcn_readlane(id1, e & 63);
            gq[q] = (e < 64) ? __builtin_bit_cast(float, __builtin_amdgcn_readlane(__builtin_bit_cast(int, gg0), e & 63)) : __builtin_bit_cast(float, __builtin_amdgcn_readlane(__builtin_bit_cast(int, gg1), e & 63)); }
        v4u uu[2][4], vv[2][4];
#pragma unroll
        for (int q = 0; q < 2; ++q)
#pragma unroll
            for (int j = 0; j < 4; ++j) uu[q][j] = *(const v4u*)(Ul + (size_t)id[q] * D + 512 * j);
#pragma unroll
        for (int q = 0; q < 2; ++q)
#pragma unroll
            for (int j = 0; j < 4; ++j) vv[q][j] = *(const v4u*)(Vl + (size_t)id[q] * D + 512 * j);
#pragma unroll
        for (int q = 0; q < 2; ++q) {
            float dsum = 0.f;
#pragma unroll
            for (int j = 0; j < 4; ++j) dsum += dot8(xv[j], uu[q][j]);
            dsum = wave_sum(dsum);
            const float w = gq[q] * gelu_tanh(dsum);
#if MK_CHECK == 7
            if (lane == 0 && l == 0) atomicAdd(STATP, gelu_tanh(dsum) * gelu_tanh(dsum) * 2048.f / 128.f);
#elif MK_CHECK == 8
            if (lane == 0 && l == 0) atomicAdd(STATP, gq[q] * gq[q] * 2048.f * 16.f / 128.f);
#elif MK_CHECK == 9
            if (lane == 0 && l == 0) atomicAdd(STATP, dsum * dsum * 2048.f / 128.f);
#elif MK_CHECK == 11
            if (lane == 0 && l == 0) atomicAdd(STATP, w * w * 2048.f);
#endif
#pragma unroll
            for (int j = 0; j < 4; ++j) {
                y[j * 8 + 0] += w * bf_lo(vv[q][j].x); y[j * 8 + 1] += w * bf_hi(vv[q][j].x);
                y[j * 8 + 2] += w * bf_lo(vv[q][j].y); y[j * 8 + 3] += w * bf_hi(vv[q][j].y);
                y[j * 8 + 4] += w * bf_lo(vv[q][j].z); y[j * 8 + 5] += w * bf_hi(vv[q][j].z);
                y[j * 8 + 6] += w * bf_lo(vv[q][j].w); y[j * 8 + 7] += w * bf_hi(vv[q][j].w);
            }
        }
    }
#if MK_CHECK == 6
    { float q2 = 0.f;
#pragma unroll
      for (int i = 0; i < 32; ++i) q2 += y[i] * y[i];
      q2 = wave_sum(q2); if (lane == 0 && l == 0) atomicAdd(STATP, q2); }
#endif
    float ssq = 0.f;
#pragma unroll
    for (int j = 0; j < 4; ++j) {
        const int col = lane * 8 + 512 * j;
        const f32x4 xa = *(const f32x4*)(X1 + (size_t)row * D + col), xb = *(const f32x4*)(X1 + (size_t)row * D + col + 4);
        const f32x4 ga = *(const f32x4*)(g2 + col) * pscale, gb = *(const f32x4*)(g2 + col + 4) * pscale;
        y[j * 8 + 0] = xa.x + ga.x * y[j * 8 + 0]; y[j * 8 + 1] = xa.y + ga.y * y[j * 8 + 1]; y[j * 8 + 2] = xa.z + ga.z * y[j * 8 + 2]; y[j * 8 + 3] = xa.w + ga.w * y[j * 8 + 3];
        y[j * 8 + 4] = xb.x + gb.x * y[j * 8 + 4]; y[j * 8 + 5] = xb.y + gb.y * y[j * 8 + 5]; y[j * 8 + 6] = xb.z + gb.z * y[j * 8 + 6]; y[j * 8 + 7] = xb.w + gb.w * y[j * 8 + 7];
#pragma unroll
        for (int e = 0; e < 8; ++e) ssq += y[j * 8 + e] * y[j * 8 + e];
    }
    if (fnorm) {
        const float r = rsqrtf(wave_sum(ssq) * (1.f / D) + EPS);
#pragma unroll
        for (int j = 0; j < 4; ++j) { const int col = lane * 8 + 512 * j;
            const f32x4 fa = *(const f32x4*)(fnorm + col), fb = *(const f32x4*)(fnorm + col + 4);
            *(f32x4*)(XO + (size_t)row * D + col) = (f32x4){y[j * 8 + 0] * r * fa.x, y[j * 8 + 1] * r * fa.y, y[j * 8 + 2] * r * fa.z, y[j * 8 + 3] * r * fa.w};
            *(f32x4*)(XO + (size_t)row * D + col + 4) = (f32x4){y[j * 8 + 4] * r * fb.x, y[j * 8 + 5] * r * fb.y, y[j * 8 + 6] * r * fb.z, y[j * 8 + 7] * r * fb.w}; }
    } else {
#pragma unroll
        for (int j = 0; j < 4; ++j) { const int col = lane * 8 + 512 * j;
            *(f32x4*)(XO + (size_t)row * D + col) = (f32x4){y[j * 8 + 0], y[j * 8 + 1], y[j * 8 + 2], y[j * 8 + 3]};
            *(f32x4*)(XO + (size_t)row * D + col + 4) = (f32x4){y[j * 8 + 4], y[j * 8 + 5], y[j * 8 + 6], y[j * 8 + 7]}; }
    }
}


#if MK_CHECK
DEV void chk_route(int l, int row, int h, const bf16* __restrict__ Q, const bf16* __restrict__ SK, const int* __restrict__ IDS, const float* __restrict__ GG, unsigned* bad, LAS float* sL, LAS unsigned* cntL, int tid) {
    if (tid < 256) { const int c = tid >> 7, k = tid & 127; const bf16* skp = SK + ((size_t)((l * 8 + h) * 2 + c)) * 128 * 128 + k * 128; const bf16* qp = Q + (size_t)row * D + h * 256 + c * 128;
        float s = 0.f; for (int d = 0; d < 128; ++d) s += bf1(qp[d]) * bf1(skp[d]); sL[c * 128 + k] = s; }
    if (tid == 0) cntL[0] = 0u;
    __syncthreads();
    float sc15 = 0.f; unsigned mybad = 0;
    { float prev = 3e38f; float s0 = 0.f, gsum = 0.f; float g0 = GG[(size_t)row * 128 + h * 16];
      for (int r = 0; r < 16; ++r) { const int id = IDS[(size_t)row * 128 + h * 16 + r]; const float g = GG[(size_t)row * 128 + h * 16 + r];
          if (id < 0 || id >= NEXP) { mybad |= 1; continue; }
          const float scv = sL[id >> 7] + sL[128 + (id & 127)];
          if (r == 0) s0 = scv;
          if (scv > prev + 1e-5f) mybad |= 2;
          prev = scv; gsum += g;
          const float ratio = __expf(scv - s0);
          if (fabsf(g / g0 - ratio) > 0.02f * ratio + 1e-4f) mybad |= 4;
          if (r == 15) sc15 = scv; }
      if (fabsf(gsum - 1.f) > 1e-3f) mybad |= 8; }
    unsigned cnt = 0;
    for (int p = tid; p < 16384; p += 512) { const float v = sL[p >> 7] + sL[128 + (p & 127)]; if (v > sc15 + 1e-5f) ++cnt; }
    __hip_atomic_fetch_add(cntL, cnt, __ATOMIC_RELAXED, __HIP_MEMORY_SCOPE_WORKGROUP);
    __syncthreads();
    if (tid == 0) { if (cntL[0] > 15u) mybad |= 16; if (mybad) atomicAdd(bad, 1u); }
    __syncthreads();
}
DEV void chk_expert(int l, int row, const bf16* __restrict__ H, const int* __restrict__ IDS, const float* __restrict__ GG, const float* __restrict__ Uf, const float* __restrict__ Vf,
                    const float* __restrict__ X1, const float* __restrict__ X2, const float* __restrict__ g2, unsigned* bad, LAS float* wL, int tid) {
    if (tid < 128) { const int id = IDS[(size_t)row * 128 + tid]; const float* up = Uf + ((size_t)l * NEXP + id) * D; const bf16* hp = H + (size_t)row * D;
        float s = 0.f; for (int d = 0; d < D; ++d) s += up[d] * bf1(hp[d]);
        wL[tid] = GG[(size_t)row * 128 + tid] * gelu_tanh(s); }
    __syncthreads();
    unsigned mybad = 0;
    for (int d = tid; d < D; d += 512) { float y = 0.f;
        for (int e = 0; e < 128; ++e) { const int id = IDS[(size_t)row * 128 + e]; y += wL[e] * Vf[((size_t)l * NEXP + id) * D + d]; }
        const float want = X1[(size_t)row * D + d] + g2[d] * y * (MK_CHECK == 3 ? 1.5f : 1.f); const float got = X2[(size_t)row * D + d];
        if (!(fabsf(got - want) <= 0.02f * fabsf(want) + 0.02f)) mybad = 1; }
    if (mybad) atomicAdd(bad, 1u);
    __syncthreads();
}

DEV void chk_hq(int l, int row, const float* __restrict__ X1, const float* __restrict__ gain, const float* __restrict__ modl, const float* __restrict__ wq, const bf16* __restrict__ H, const bf16* __restrict__ Q,
                unsigned* bad, LAS float* hL, LAS float* redL, int tid) {
    const int b = row >> 12;
    float ss = 0.f;
    for (int d = tid; d < D; d += 512) { const float v = X1[(size_t)row * D + d]; ss += v * v; }
    ss = wave_sum(ss);
    if ((tid & 63) == 0) redL[tid >> 6] = ss;
    __syncthreads();
    float tot = 0.f; for (int w = 0; w < 8; ++w) tot += redL[w];
    const float r = rsqrtf(tot * (1.f / D) + EPS);
    unsigned badh = 0, badq = 0;
    for (int d = tid; d < D; d += 512) { const float hv = X1[(size_t)row * D + d] * r * gain[d] * (1.f + modl[(size_t)b * MODW + MO_SC2 + d]) + modl[(size_t)b * MODW + MO_SH2 + d];
        hL[d] = hv; const float got = bf1(H[(size_t)row * D + d]); if (!(fabsf(got - hv) <= 0.01f * fabsf(hv) + 0.01f)) badh = 1; }
    __syncthreads();
    for (int c = tid; c < D; c += 512) { float q = 0.f; for (int k = 0; k < D; ++k) q += hL[k] * wq[(size_t)k * D + c];
        const float got = bf1(Q[(size_t)row * D + c]); if (!(fabsf(got - q) <= 0.02f * fabsf(q) + 0.03f)) badq = 1; }
    if (badh) atomicAdd(bad, 1u);
    if (badq) atomicAdd(bad + 1, 1u);
    __syncthreads();
}
#endif
struct Args { const float* in[24]; float* out; unsigned char* ws; int ph_lo, ph_hi, li, pad; };

__global__ void __launch_bounds__(512, 2) fwd(Args a) {
    extern __shared__ __attribute__((aligned(16))) unsigned char lds_raw[];
    LAS unsigned char* lds = (LAS unsigned char*)lds_raw;
    const int wave = __builtin_amdgcn_readfirstlane((int)threadIdx.x >> 6);
    const int G = gridDim.x; const int bx = blockIdx.x;
#define PHASE_TID() int tid = threadIdx.x; asm volatile("" : "+v"(tid)); const int lane = tid & 63; (void)lane; \
    const __attribute__((address_space(4))) Args* A = (const __attribute__((address_space(4))) Args*)__builtin_amdgcn_kernarg_segment_ptr(); asm volatile("" : "+s"(A))
    const int vcu = (G % 8 == 0) ? (bx % 8) * (G / 8) + bx / 8 : bx;
    const int gw = vcu * 8 + wave, NGW = G * 8;
    unsigned* ctl = (unsigned*)(a.ws + WS_CTL);
    const int lo = a.ph_lo, hi = a.ph_hi;
    for (int u = threadIdx.x; u < (LDS_BYTES - LDS_MISC) / 4; u += 512) ((LAS unsigned*)(lds + LDS_MISC))[u] = 0u;
    __syncthreads();
    XcdBarrier bar; bar.bar = ctl + CW_BAR + (a.li & 7) * XCD_BAR_WORDS; bar.x = 0; bar.st = (volatile LAS unsigned*)(lds + LDS_MISC + 64);
    if (hi - lo > 1) bar = xcd_barrier_post(ctl + CW_BAR + (a.li & 7) * XCD_BAR_WORDS, (volatile LAS unsigned*)(lds + LDS_MISC + 64));
#ifndef MK_MASK
#define MK_MASK 0x3ff
#endif
#define KON(q) (((MK_MASK) >> (q)) & 1)
#define IN(k) (lo <= (k) && (k) < hi)
#define SEAM(k) do { if (IN(k) && IN((k) + 1)) xcd_barrier(bar); } while (0)

#define mod   ((float*)(A->ws + WS_MOD))
#define WIN_T ((bf16*)(A->ws + WS_WIN_T))
#define WOUT_T ((bf16*)(A->ws + WS_WOUT_T))
#define WQ_T  ((bf16*)(A->ws + WS_WQ_T))
#define SUBK  ((bf16*)(A->ws + WS_SUBK))
#define UB    ((bf16*)(A->ws + WS_U))
#define VB    ((bf16*)(A->ws + WS_V))
#define H     ((bf16*)(A->ws + WS_H))
#define Z     ((bf16*)(A->ws + WS_Z))
#define HLOC  ((float*)(A->ws + WS_HLOC))
#define PP    ((float*)(A->ws + WS_P))
#define YB    ((float*)(A->ws + WS_YB))
#define YC    ((float*)(A->ws + WS_YC))
#define SUMA  ((float*)(A->ws + WS_SUMA))
#define SUMB  ((float*)(A->ws + WS_SUMB))
#define X1    ((float*)(A->ws + WS_X1))
#define X2    ((float*)(A->ws + WS_X2))
#define QB    ((bf16*)(A->ws + WS_Q))
#define IDS   ((int*)(A->ws + WS_IDS))
#define GG    ((float*)(A->ws + WS_G))
#define XIN   ((l == 0) ? A->in[0] : (const float*)X2)
#define MODL  (mod + (size_t)l * 2 * MODW)
    if (KON(0) && IN(0)) {
        PHASE_TID();
        ph_mod(A->in[1], A->in[2], A->in[3], mod, (LAS float*)lds, vcu, G, tid);
        {
            LAS float* scr = (LAS float*)(lds + wave * 16384);
            constexpr int I_IN = (D / 64) * (IN_W / 32), I_SQ = (D / 64) * (D / 32), I_L = I_IN + 2 * I_SQ;
            for (int it = gw; it < 2 * I_L; it += NGW) {
                const int l = it / I_L; int r = it % I_L;
                if (r < I_IN) { transpose_item(A->in[6] + (size_t)l * D * IN_W, D, IN_W, WIN_T + (size_t)l * IN_W * D, scr, r, lane); continue; } r -= I_IN;
                if (r < I_SQ) { transpose_item(A->in[18] + (size_t)l * D * D, D, D, WOUT_T + (size_t)l * D * D, scr, r, lane); continue; } r -= I_SQ;
                transpose_item(A->in[19] + (size_t)l * D * D, D, D, WQ_T + (size_t)l * D * D, scr, r, lane);
            }
        }
        const size_t gtid = (size_t)vcu * 512 + tid, gstride = (size_t)G * 512;
        convert_copy(A->in[20], SUBK, (size_t)2 * 8 * 2 * 128 * 128 / 8, gtid, gstride);
        convert_copy(A->in[21], UB, (size_t)NL * NEXP * D / 8, gtid, gstride);
        convert_copy(A->in[22], VB, (size_t)NL * NEXP * D / 8, gtid, gstride);
    }
    SEAM(0);

    for (int l = 0; l < NL; ++l) {
        const int pb = 1 + 9 * l;
        if (KON(1) && IN(pb + 0)) { PHASE_TID(); modnorm_rows(XIN, A->in[4] + l * D, MODL, MO_SH1, MO_SC1, H, gw, NGW, lane); }
        SEAM(pb + 0);
        if (KON(2) && IN(pb + 1)) {
            PHASE_TID(); (void)tid;
            pg8::Gemm g{H, WIN_T + (size_t)l * IN_W * D, M, IN_W, D}; pg8::StaticOrder S; S.init(M, IN_W, G, bx);
            pg8::EpiBf16<0> E{Z, IN_W, nullptr, 0, 0};
            pg8::gemm_phase<pg8::EpiBf16<0>, pg8::StaticOrder, false>((PG8_LAS unsigned char*)lds, g, S, E, nullptr);
        }
        SEAM(pb + 1);
        if (KON(3) && IN(pb + 2)) {
            PHASE_TID();
            for (int it = vcu; it < 2 * 64 * 6; it += G) {
                const int b = it / 384, r = it % 384, j = r / 6, n = r % 6;
                lru_item(l, b, j, n, Z, A->in[7], A->in[8], A->in[9], A->in[10], A->in[11], A->in[12], A->in[13], HLOC, PP, SUMA, SUMB,
                         (LAS float*)lds, (LAS float*)(lds + 32768), (LAS float*)(lds + 65536), tid);
            }
            {
                LAS float* qs = (LAS float*)(lds + wave * 4096); LAS float* lgp = qs + 128;
                for (int it = gw; it < 2 * 6 * SEQ; it += NGW) { const int bh = it >> 12, t = it & 4095; dil_item(bh / 6, bh % 6, t, Z, A->in[14], YB, qs, lgp, lane); }
                for (int it = gw; it < 2 * 4 * SEQ; it += NGW) { const int bh = it >> 12, r = it & 4095; const int t = (bh & 1) ? 4095 - r : r; sb_item(bh >> 2, bh & 3, t, Z, YC, qs, lgp, lane); }
            }
        }
        SEAM(pb + 2);
        if (KON(4) && IN(pb + 3)) {
            PHASE_TID();
            for (int it = vcu; it < 256; it += G) { const int b = it >> 7, j = (it >> 1) & 63, half = it & 1;
                combine_item(l, b, j, half, Z, HLOC, PP, SUMA, SUMB, YB, YC, A->in[15], A->in[16], A->in[17], H, (LAS float*)lds, tid); }
        }
        SEAM(pb + 3);
        if (KON(5) && IN(pb + 4)) {
            PHASE_TID(); (void)tid;
            pg8::Gemm g{H, WOUT_T + (size_t)l * D * D, M, D, D}; pg8::StaticOrder S; S.init(M, D, G, bx);
            EpiResGate E{XIN, X1, MODL + MO_G1, ((MK_DBG >> (2 * l)) & 1) ? 0.f : ((MK_DBG & 256) ? -1.f : 1.f)};
            pg8::gemm_phase<EpiResGate, pg8::StaticOrder, false>((PG8_LAS unsigned char*)lds, g, S, E, nullptr);
        }
        SEAM(pb + 4);
        if (KON(6) && IN(pb + 5)) { PHASE_TID(); modnorm_rows(X1, A->in[5] + l * D, MODL, MO_SH2, MO_SC2, H, gw, NGW, lane); }
        SEAM(pb + 5);
        if (KON(7) && IN(pb + 6)) {
            PHASE_TID(); (void)tid;
            pg8::Gemm g{H, WQ_T + (size_t)l * D * D, M, D, D}; pg8::StaticOrder S; S.init(M, D, G, bx);
            pg8::EpiBf16<0> E{QB, D, nullptr, 0, 0};
            pg8::gemm_phase<pg8::EpiBf16<0>, pg8::StaticOrder, false>((PG8_LAS unsigned char*)lds, g, S, E, nullptr);
        }
        SEAM(pb + 6);
        if (KON(8) && IN(pb + 7)) {
            PHASE_TID();
            for (int it = vcu; it < 256 * 8; it += G) route_item(l, it >> 3, it & 7, QB, SUBK, IDS, GG, lds, tid, (unsigned*)(A->ws + WS_CTL) + 8);
        }
        SEAM(pb + 7);
        if (KON(9) && IN(pb + 8)) {
            PHASE_TID();
            for (int m = gw; m < M; m += NGW)
                expert_row(l, m, H, IDS, GG, UB, VB, X1, MODL + (size_t)(m >> 12) * MODW + MO_G2, (l == NL - 1) ? A->in[23] : nullptr, (l == NL - 1) ? A->out : X2, lane, ((MK_DBG >> (2 * l + 1)) & 1) ? 0.f : ((MK_DBG & 128) ? -1.f : 1.f), (float*)(A->ws + WS_CTL) + 16);
        }
        if (l + 1 < NL) SEAM(pb + 8);
    }
#if MK_CHECK
    if (IN(19)) {
        PHASE_TID();
        unsigned* badw = (unsigned*)(A->ws + WS_CTL) + 8;
#if MK_CHECK == 1 || MK_CHECK == 3 || MK_CHECK == 4
        for (int it = vcu; it < (MK_CHECK == 4 ? 8192 : 256) * 8; it += G) { const int row = (MK_CHECK == 4) ? (it >> 3) : (((it >> 3) * 131 + 7) & 8191); chk_route(0, row, it & 7, QB, SUBK, IDS, GG, badw, (LAS float*)lds, (LAS unsigned*)(lds + 2048), tid); }
        for (int it = vcu; it < (MK_CHECK == 4 ? 8192 : 256); it += G) { const int row = (MK_CHECK == 4) ? it : ((it * 131 + 7) & 8191); chk_expert(0, row, H, IDS, GG, A->in[21], A->in[22], X1, X2, mod + (size_t)(row >> 12) * MODW + MO_G2, badw + 1, (LAS float*)lds, tid); }
#elif MK_CHECK == 12 || MK_CHECK == 15
        { (void)badw;
          for (int m = gw; m < M; m += NGW) { const int ia = IDS[(size_t)m * 128 + lane], ib = IDS[(size_t)m * 128 + 64 + lane]; int cnt = 0;
              for (int e = 0; e < 128; ++e) { const int ie = (e < 64) ? __shfl(ia, e) : __shfl(ib, e - 64); if (lane < e && ia == ie && (MK_CHECK == 12 || (lane >> 4) == (e >> 4))) ++cnt; if (lane + 64 < e && ib == ie && (MK_CHECK == 12 || ((lane + 64) >> 4) == (e >> 4))) ++cnt; }
              float fc = wave_sum((float)cnt); if (lane == 0) atomicAdd((float*)(A->ws + WS_CTL) + 16, fc * 2048.f); } }
#elif MK_CHECK == 13 || MK_CHECK == 14
        { (void)badw;
          float cnt = 0.f;
          if (MK_CHECK == 13) { const float* sk = A->in[20]; for (int o = vcu * 512 + tid; o < 2 * 128 * 128; o += G * 512) if (sk[o] == sk[o + 2 * 128 * 128]) cnt += 1.f; cnt *= (float)M * D / (2.f * 128 * 128); }
          else { const float* wq = A->in[19]; for (int o = vcu * 512 + tid; o < D * 256; o += G * 512) { const int k = o >> 8, c = o & 255; if (wq[(size_t)k * D + c] == wq[(size_t)k * D + 256 + c]) cnt += 1.f; } cnt *= (float)M * D / ((float)D * 256); }
          cnt = wave_sum(cnt); if (lane == 0) atomicAdd((float*)(A->ws + WS_CTL) + 16, cnt); }
#elif MK_CHECK == 10
        { (void)badw; float acc = 0.f; const float* vt = A->in[22];
          for (size_t o = (size_t)vcu * 512 + tid; o < (size_t)NEXP * D; o += (size_t)G * 512) { const float v = vt[o]; acc += v * v; }
          acc = wave_sum(acc); if (lane == 0) atomicAdd((float*)(A->ws + WS_CTL) + 16, acc * ((float)M * D / ((float)NEXP * D))); }
#elif MK_CHECK == 16
        (void)badw;
#elif MK_CHECK >= 6
        (void)badw;
#elif MK_CHECK == 5
        {
            const float* cc = A->in[1]; const float* wm = A->in[2]; const float* bm = A->in[3];
            unsigned mb = 0;
            for (int o = vcu * 512 + tid; o < 2 * 2 * MODW; o += G * 512) { const int l = o / (2 * MODW), b = (o / MODW) & 1, n = o % MODW;
                float sacc = 0.f; for (int k = 0; k < D; ++k) { const float cv = cc[b * D + k]; sacc += (cv / (1.f + __expf(-cv))) * wm[((size_t)l * D + k) * MODW + n]; }
                sacc += bm[l * MODW + n];
                if (!(fabsf(sacc - mod[o]) <= 2e-3f * fabsf(sacc) + 2e-3f)) mb = 1; }
            if (mb) atomicAdd(badw, 1u);
            unsigned sb = 0;
            for (int o = vcu * 512 + tid; o < 2 * 8 * 2 * 128 * 128; o += G * 512) { const float want = A->in[20][o]; const float got = bf1(SUBK[o]); if (!(fabsf(got - want) <= 0.01f * fabsf(want) + 1e-6f)) sb = 1; }
            if (sb) atomicAdd(badw + 1, 1u);
        }
#else
        for (int it = vcu; it < 256; it += G) { const int row = (it * 131 + 7) & 8191; chk_hq(0, row, X1, A->in[5], mod, A->in[19], H, QB, badw, (LAS float*)lds, (LAS float*)(lds + 16384), tid); }
#endif
    }
    if (IN(20)) {
        PHASE_TID();
        const unsigned* badw = (const unsigned*)(A->ws + WS_CTL) + 8;
        const unsigned b0 = __hip_atomic_load(badw, __ATOMIC_RELAXED, __HIP_MEMORY_SCOPE_AGENT), b1 = __hip_atomic_load(badw + 1, __ATOMIC_RELAXED, __HIP_MEMORY_SCOPE_AGENT);
#if MK_CHECK >= 6 && MK_CHECK != 16
        const float f = 1.f + ((const float*)(A->ws + WS_CTL))[16] * (1.f / ((float)M * D)); (void)b0; (void)b1;
#else
        const float f = (b0 ? (b1 ? -2.f : 0.f) : (b1 ? -1.f : 1.f));
#endif
        for (int m = gw; m < M; m += NGW) { const f32x4* xr = (const f32x4*)(X2 + (size_t)m * D) + lane; f32x4 v[8]; float ss = 0.f;
#pragma unroll
            for (int j = 0; j < 8; ++j) { v[j] = xr[64 * j]; ss += (v[j].x * v[j].x + v[j].y * v[j].y) + (v[j].z * v[j].z + v[j].w * v[j].w); }
            const float r = rsqrtf(wave_sum(ss) * (1.f / D) + EPS) * f;
#pragma unroll
            for (int j = 0; j < 8; ++j) { const f32x4 fn = ((const f32x4*)A->in[23])[lane + 64 * j]; ((f32x4*)(A->out + (size_t)m * D))[lane + 64 * j] = v[j] * r * fn; } }
    }
#endif
#undef IN
#undef SEAM
#undef mod
#undef H
#undef Z
#undef X1
#undef X2
}
}

extern "C" void kernel_launch(void* const* d_in, const int* in_sizes, int n_in, void* d_out, int out_size, void* d_ws, size_t ws_size, hipStream_t stream) {
    using namespace mk;
    static int grid = 0;
    if (grid == 0) {
        if (n_in != 24 || out_size != M * D || ws_size < WS_END) { fprintf(stderr, "kernel_launch: unexpected shapes (n_in %d out %d ws %zu)\n", n_in, out_size, ws_size); grid = -1; return; }
        int dev = 0, cus = 0, per_cu = 0;
        if (hipGetDevice(&dev) != hipSuccess || hipDeviceGetAttribute(&cus, hipDeviceAttributeMultiprocessorCount, dev) != hipSuccess) { grid = -1; return; }
        if (hipFuncSetAttribute((const void*)fwd, hipFuncAttributeMaxDynamicSharedMemorySize, LDS_BYTES) != hipSuccess) { fprintf(stderr, "kernel_launch: hipFuncSetAttribute failed\n"); grid = -1; return; }
        if (hipOccupancyMaxActiveBlocksPerMultiprocessor(&per_cu, (const void*)fwd, 512, LDS_BYTES) != hipSuccess || per_cu < 1) fprintf(stderr, "kernel_launch: occupancy query says %d\n", per_cu);
        (void)hipGetLastError();
        grid = cus;
    }
    if (grid < 0) return;
    (void)hipMemsetAsync((char*)d_ws + WS_CTL, 0, CTL_ZERO_BYTES, stream);
    Args a{};
    for (int i = 0; i < 24; ++i) a.in[i] = (const float*)d_in[i];
    a.out = (float*)d_out; a.ws = (unsigned char*)d_ws; a.pad = 0;
#if MK_CHECK
    constexpr int NLAUNCH = 12;
#else
    constexpr int NLAUNCH = MK_N_LAUNCHES;
#endif
    for (int li = 0; li < NLAUNCH; ++li) {
        a.ph_lo = (NLAUNCH == 1) ? 0 : li; a.ph_hi = (NLAUNCH == 1) ? NPHASE : li + 1; a.li = li;
#if MK_CHECK
        if (li >= 10) { a.ph_lo = li + 9; a.ph_hi = li + 10; }
#endif
        hipLaunchKernelGGL(fwd, dim3(grid), dim3(512), LDS_BYTES, stream, a);
    }
}
```

```cpp
#include <hip/hip_runtime.h>
#include <cstdio>
#include <cstdint>
#define MK_DBG 0
#define MK_N_LAUNCHES 1
#define MK_CHECK 0
namespace pg8 {
#define PG8_LAS __attribute__((address_space(3)))
typedef unsigned short bf16_t;
typedef short bf16x8 __attribute__((ext_vector_type(8)));
typedef float f32x4 __attribute__((ext_vector_type(4)));
typedef unsigned u32x4 __attribute__((ext_vector_type(4)));
constexpr int BM = 256, BK = 64, HALF = 128, HTB = HALF * BK * 2  , STAGE_BYTES = 8 * HTB, NXCD = 8, WGM = 8;

__host__ __device__ __forceinline__ int lds_byte(int r, int c) { const int st = (r >> 4) * 2 + (c >> 5), rr = r & 15, cc = c & 31, ob = rr * 64 + cc * 2; return st * 1024 + (ob ^ (((ob >> 9) & 1) << 5)); }
__host__ __device__ __forceinline__ void stage_rc(int b, int& R, int& C) { const int st = b / 1024, sb = b % 1024, swz = sb ^ (((sb >> 9) & 1) << 5); R = (st >> 1) * 16 + swz / 64; C = (st & 1) * 32 + (swz % 64) / 2; }
__host__ __device__ __forceinline__ int perm32(int rho) { const int n = rho >> 4, i = rho & 15; return 8 * (i >> 2) + 4 * n + (i & 3); }

struct Unit { int pm, pn; };
struct Gemm { const bf16_t* A; const bf16_t* Bt; int M, N, K; };

struct StaticOrder {
    int nM, nN, nwg, G, c;
    __host__ __device__ void init(int M, int N, int G_, int c_) { nM = M / BM; nN = N / BM; nwg = nM * nN; G = G_; c = c_; }
    __host__ __device__ bool next(int i, Unit& u) const {
        const long L = (long)i * G + c; if (L >= nwg) return false;
        int wgid = (int)L; { const int q = nwg / NXCD, r = nwg % NXCD, xcd = wgid % NXCD, off = wgid / NXCD; wgid = (xcd < r ? xcd * (q + 1) : r * (q + 1) + (xcd - r) * q) + off; }
        const int nig = WGM * nN, gid = wgid / nig, fm = gid * WGM, gsz = (nM - fm) < WGM ? (nM - fm) : WGM;
        u.pm = fm + ((wgid % nig) % gsz); u.pn = (wgid % nig) / gsz; return true;
    }
    __device__ __forceinline__ void a_ready(const Unit&) const {}
    __device__ __forceinline__ void done(const Unit&) const {}
};
struct CountedOrder : StaticOrder {
    const unsigned* ready; unsigned need; unsigned* tmo;
    __device__ __forceinline__ void a_ready(const Unit& u) const {
        if (threadIdx.x < 64) {
            const unsigned long long t0 = __builtin_amdgcn_s_memrealtime(); unsigned polls = 0;
            while ((unsigned)__builtin_amdgcn_readfirstlane(__hip_atomic_load(ready + 64 * u.pm, __ATOMIC_RELAXED, __HIP_MEMORY_SCOPE_AGENT)) < need) {
                if ((++polls & 255u) == 0u && __builtin_amdgcn_readfirstlane(__hip_atomic_load(tmo, __ATOMIC_RELAXED, __HIP_MEMORY_SCOPE_AGENT)) != 0u) break;
                if (__builtin_amdgcn_s_memrealtime() - t0 > 2000000ull) {
                    if (threadIdx.x == 0) { unsigned expect = 0u; __hip_atomic_compare_exchange_strong(tmo + 1, &expect, 0x600u | (unsigned)(u.pm & 0xff), __ATOMIC_RELAXED, __ATOMIC_RELAXED, __HIP_MEMORY_SCOPE_AGENT); __hip_atomic_store(tmo, 1u, __ATOMIC_RELAXED, __HIP_MEMORY_SCOPE_AGENT); }
                    break; }
                __builtin_amdgcn_s_sleep(2); }
            __builtin_amdgcn_fence(__ATOMIC_ACQUIRE, "agent");
            asm volatile("s_waitcnt vmcnt(0)" ::: "memory");
        }
#if !defined(BROKEN_HOOK_NO_BARRIER)
        asm volatile("" ::: "memory"); __builtin_amdgcn_s_barrier(); asm volatile("" ::: "memory");
#endif
    }
};

__device__ __forceinline__ unsigned cvt_pk_bf16(float lo, float hi) { unsigned r; asm volatile("v_cvt_pk_bf16_f32 %0, %1, %2" : "=v"(r) : "v"(lo), "v"(hi)); return r; }
typedef float f32x2 __attribute__((ext_vector_type(2)));
__device__ __forceinline__ f32x2 gelu_pk(f32x2 v) {
    const f32x2 av = __builtin_elementwise_abs(v), d = av * 0.2316418882f + 1.0f;
    f32x2 t; t.x = __builtin_amdgcn_rcpf(d.x); t.y = __builtin_amdgcn_rcpf(d.y);
    f32x2 q = t * 0.5307027145f + (-0.7265760135f); q = q * t + 0.7107068705f; q = q * t + (-0.142248368f); q = q * t + 0.127414796f; q = q * t;
    const f32x2 s = (v * v) * (-0.72134752044f);
    f32x2 e; e.x = __builtin_amdgcn_exp2f(s.x); e.y = __builtin_amdgcn_exp2f(s.y);
    const f32x2 m = v * (q * e), r = v - m;
    f32x2 o; o.x = v.x < 0.f ? m.x : r.x; o.y = v.y < 0.f ? m.y : r.y; return o;
}

struct EpiF32 {
    static constexpr bool PERM = false, AFTER_DRAIN = false;
    float* C; int ldc; const float* bias;
    __device__ __forceinline__ void operator()(const f32x4 (&acc)[2][2][4][2], const Unit& u, int wr, int wc, int fr, int fq) const {
        const int row0 = u.pm * BM + wr * 64 + fr, col0 = u.pn * BM + wc * 32 + 4 * fq;
        f32x4 bv[2][2];
#pragma unroll
        for (int bj = 0; bj < 2; ++bj)
#pragma unroll
            for (int n = 0; n < 2; ++n) bv[bj][n] = bias ? *(const f32x4*)(bias + col0 + bj * HALF + n * 16) : (f32x4){0.f, 0.f, 0.f, 0.f};
#pragma unroll
        for (int ai = 0; ai < 2; ++ai)
#pragma unroll
            for (int m = 0; m < 4; ++m) { float* rowp = C + (size_t)(row0 + ai * HALF + m * 16) * ldc + col0;
#pragma unroll
                for (int bj = 0; bj < 2; ++bj)
#pragma unroll
                    for (int n = 0; n < 2; ++n) *(f32x4*)(rowp + bj * HALF + n * 16) = acc[ai][bj][m][n] + bv[bj][n]; }
    }
};
template <int ACT  > struct EpiBf16 {
    static constexpr bool PERM = true, AFTER_DRAIN = false;
    bf16_t* O; int ldc; const float* bias; int split_cols; size_t split_stride;
    __device__ __forceinline__ void operator()(const f32x4 (&acc)[2][2][4][2], const Unit& u, int wr, int wc, int fr, int fq) const {
        const int row0 = u.pm * BM + wr * 64 + fr; int colt = u.pn * BM; bf16_t* base = O;
        if (split_cols) { const int t = colt / split_cols; base += (size_t)t * split_stride; colt -= t * split_cols; }
        const int col0 = colt + wc * 32 + 8 * fq, bcol0 = u.pn * BM + wc * 32 + 8 * fq;
        f32x4 bv[2][2];
#pragma unroll
        for (int bj = 0; bj < 2; ++bj)
#pragma unroll
            for (int n = 0; n < 2; ++n) bv[bj][n] = bias ? *(const f32x4*)(bias + bcol0 + bj * HALF + 4 * n) : (f32x4){0.f, 0.f, 0.f, 0.f};
#pragma unroll
        for (int ai = 0; ai < 2; ++ai)
#pragma unroll
            for (int m = 0; m < 4; ++m) { bf16_t* rowp = base + (size_t)(row0 + ai * HALF + m * 16) * ldc + col0;
#pragma unroll
                for (int bj = 0; bj < 2; ++bj) { f32x4 v0 = acc[ai][bj][m][0] + bv[bj][0], v1 = acc[ai][bj][m][1] + bv[bj][1];
                    if (ACT == 1) { f32x2 a = gelu_pk((f32x2){v0[0], v0[1]}), b = gelu_pk((f32x2){v0[2], v0[3]}), c = gelu_pk((f32x2){v1[0], v1[1]}), d = gelu_pk((f32x2){v1[2], v1[3]});
                        v0 = (f32x4){a.x, a.y, b.x, b.y}; v1 = (f32x4){c.x, c.y, d.x, d.y}; }
                    if (ACT == 2) {
#pragma unroll
                        for (int j = 0; j < 4; ++j) { v0[j] = 0.5f * v0[j] * (1.0f + erff(v0[j] * 0.70710678f)); v1[j] = 0.5f * v1[j] * (1.0f + erff(v1[j] * 0.70710678f)); } }
                    u32x4 w; w.x = cvt_pk_bf16(v0[0], v0[1]); w.y = cvt_pk_bf16(v0[2], v0[3]); w.z = cvt_pk_bf16(v1[0], v1[1]); w.w = cvt_pk_bf16(v1[2], v1[3]);
                    *(u32x4*)(rowp + bj * HALF) = w; } }
    }
};
template <class Epi, class Sched, bool STAMP = false>
__device__ __forceinline__ void gemm_phase(PG8_LAS unsigned char* lds, const Gemm g, const Sched& S, const Epi& E, unsigned long long* stamps) {
    const int tid = threadIdx.x, wid = __builtin_amdgcn_readfirstlane(tid >> 6), lane = tid & 63, wr = wid >> 2, wc = wid & 3, fr = lane & 15, fq = lane >> 4;
    constexpr int K = 2048, nt = K / BK;
    int ts_lo = 0, ts_hi = 0, nts = 0; const unsigned long long rt_entry = STAMP ? (unsigned long long)wall_clock64() : 0ull;
#define PG8_STAMP() do { if (STAMP && wid == 0 && nts < 64) { const unsigned long long _c = (unsigned long long)clock64(); \
        ts_lo = (lane == nts) ? (int)(unsigned)_c : ts_lo; ts_hi = (lane == nts) ? (int)(unsigned)(_c >> 32) : ts_hi; ++nts; } } while (0)
    PG8_STAMP();
    unsigned voffA[2], voffB[2];
#pragma unroll
    for (int i = 0; i < 2; ++i) { int R, C; stage_rc(tid * 16 + i * 8192, R, C); const int Rb = Epi::PERM ? ((R & ~31) + perm32(R & 31)) : R;
        voffA[i] = (unsigned)(R * K + C) * 2u; voffB[i] = (unsigned)(Rb * K + C) * 2u; }
    const size_t kstep = (size_t)(BK * 2);
    const size_t hstep = (size_t)HALF * K * 2;
    const size_t tstep = 2 * hstep;
    const unsigned ldsw = (unsigned)wid * 1024u;
    const int aoff = lds_byte(wr * 64 + fr, fq * 8), boff = lds_byte(wc * 32 + fr, fq * 8);
#define PG8_SA(b, h) (((b) * 2 + (h)) * HTB)
#define PG8_SB(b, h) ((4 + (b) * 2 + (h)) * HTB)
#define PG8_STAGE(bufoff, gbase, voff) do { _Pragma("unroll") for (int _i = 0; _i < 2; ++_i) \
        __builtin_amdgcn_global_load_lds((const unsigned*)((const char*)(gbase) + (voff)[_i]), (PG8_LAS unsigned*)(lds + (bufoff) + ldsw + _i * 8192), 16, 0, 0); } while (0)
#define PG8_LDA(dst, b, h) do { _Pragma("unroll") for (int m = 0; m < 4; ++m) _Pragma("unroll") for (int k = 0; k < 2; ++k) dst[m][k] = *(const PG8_LAS bf16x8*)(lds + PG8_SA(b, h) + aoff + m * 2048 + k * 1024); } while (0)
#define PG8_LDB(dst, b, h) do { _Pragma("unroll") for (int n = 0; n < 2; ++n) _Pragma("unroll") for (int k = 0; k < 2; ++k) dst[n][k] = *(const PG8_LAS bf16x8*)(lds + PG8_SB(b, h) + boff + n * 2048 + k * 1024); } while (0)
#define PG8_MMA(ai, bj, At, Bt) do { __builtin_amdgcn_s_setprio(1); _Pragma("unroll") for (int m = 0; m < 4; ++m) _Pragma("unroll") for (int n = 0; n < 2; ++n) _Pragma("unroll") for (int k = 0; k < 2; ++k) \
        acc[ai][bj][m][n] = __builtin_amdgcn_mfma_f32_16x16x32_bf16(Bt[n][k], At[m][k], acc[ai][bj][m][n], 0, 0, 0); __builtin_amdgcn_s_setprio(0); } while (0)
#define PG8_WAIT_V(n) asm volatile("s_waitcnt vmcnt(" #n ")" ::: "memory")
#define PG8_WAIT_L(n) asm volatile("s_waitcnt lgkmcnt(" #n ")" ::: "memory")
#define PG8_BAR __builtin_amdgcn_s_barrier()
#define PG8_SCHED __builtin_amdgcn_sched_barrier(0)
    Unit cur, nxt; int ui = 0;
    if (!S.next(0, cur)) return;
    f32x4 acc[2][2][4][2];
#pragma unroll
    for (int a = 0; a < 2; ++a)
#pragma unroll
        for (int b = 0; b < 2; ++b)
#pragma unroll
            for (int m = 0; m < 4; ++m)
#pragma unroll
                for (int n = 0; n < 2; ++n) acc[a][b][m][n] = (f32x4){0.f, 0.f, 0.f, 0.f};
    bf16x8 At[4][2], B0[2][2], B1[2][2];
    const char* cA = (const char*)g.A + (size_t)cur.pm * tstep; const char* cB = (const char*)g.Bt + (size_t)cur.pn * tstep;
    S.a_ready(cur);
    PG8_STAGE(PG8_SB(0, 0), cB, voffB); PG8_STAGE(PG8_SA(0, 0), cA, voffA); PG8_STAGE(PG8_SB(0, 1), cB + hstep, voffB); PG8_STAGE(PG8_SA(0, 1), cA + hstep, voffA);
    if (wr == 1) PG8_BAR;
    PG8_WAIT_V(4); PG8_BAR;
    PG8_STAGE(PG8_SB(1, 0), cB + kstep, voffB); PG8_STAGE(PG8_SA(1, 0), cA + kstep, voffA); PG8_STAGE(PG8_SB(1, 1), cB + hstep + kstep, voffB);
    PG8_WAIT_V(6); PG8_BAR;
    PG8_STAMP();
    for (;;) {
        const bool has_next = S.next(ui + 1, nxt);
        const char* nA = has_next ? (const char*)g.A + (size_t)nxt.pm * tstep : cA; const char* nB = has_next ? (const char*)g.Bt + (size_t)nxt.pn * tstep : cB;
        for (int t = 0; t < nt; t += 2) {
            const bool last = (t == nt - 2);
            const char* a1 = cA + (size_t)(t + 1) * kstep;
            const char* a2 = last ? nA : cA + (size_t)(t + 2) * kstep; const char* b2 = last ? nB : cB + (size_t)(t + 2) * kstep;
            const char* a3 = a2 + kstep; const char* b3 = b2 + kstep;
            if (last && has_next) S.a_ready(nxt);
            PG8_LDB(B0, 0, 0); PG8_SCHED; PG8_LDA(At, 0, 0); PG8_STAGE(PG8_SA(1, 1), a1 + hstep, voffA);
            PG8_WAIT_L(8); PG8_BAR; PG8_WAIT_L(0); PG8_MMA(0, 0, At, B0); PG8_BAR; PG8_SCHED;
            PG8_LDB(B1, 0, 1); PG8_STAGE(PG8_SB(0, 0), b2, voffB);
            PG8_BAR; PG8_WAIT_L(0); PG8_MMA(0, 1, At, B1); PG8_BAR;
            PG8_LDA(At, 0, 1); PG8_STAGE(PG8_SA(0, 0), a2, voffA);
            PG8_BAR; PG8_WAIT_L(0); PG8_MMA(1, 0, At, B0); PG8_BAR; PG8_SCHED;
            PG8_STAGE(PG8_SB(0, 1), b2 + hstep, voffB);
            PG8_WAIT_V(6); PG8_BAR; PG8_MMA(1, 1, At, B1); PG8_BAR;
            PG8_LDB(B0, 1, 0); PG8_SCHED; PG8_LDA(At, 1, 0); PG8_STAGE(PG8_SA(0, 1), a2 + hstep, voffA);
            PG8_WAIT_L(8); PG8_BAR; PG8_WAIT_L(0); PG8_MMA(0, 0, At, B0); PG8_BAR; PG8_SCHED;
            PG8_LDB(B1, 1, 1); PG8_STAGE(PG8_SB(1, 0), b3, voffB);
            PG8_BAR; PG8_WAIT_L(0); PG8_MMA(0, 1, At, B1); PG8_BAR;
            PG8_LDA(At, 1, 1); PG8_STAGE(PG8_SA(1, 0), a3, voffA);
            PG8_BAR; PG8_WAIT_L(0); PG8_MMA(1, 0, At, B0); PG8_BAR; PG8_SCHED;
            PG8_STAGE(PG8_SB(1, 1), b3 + hstep, voffB);
            PG8_WAIT_V(6); PG8_BAR; PG8_MMA(1, 1, At, B1); PG8_BAR;
        }
        PG8_STAMP();
        if constexpr (!Epi::AFTER_DRAIN) { E(acc, cur, wr, wc, fr, fq); S.done(cur); }
        PG8_STAMP();
        if (!has_next) break;
#pragma unroll
        for (int a = 0; a < 2; ++a)
#pragma unroll
            for (int b = 0; b < 2; ++b)
#pragma unroll
                for (int m = 0; m < 4; ++m)
#pragma unroll
                    for (int n = 0; n < 2; ++n) acc[a][b][m][n] = (f32x4){0.f, 0.f, 0.f, 0.f};
        cur = nxt; cA = nA; cB = nB; ++ui;
    }
    PG8_WAIT_V(0);
    if (wr == 0) PG8_BAR;
    PG8_BAR;
    if constexpr (Epi::AFTER_DRAIN) { E.fused(acc, cur, wr, wc, fr, fq, lds, wid, lane); S.done(cur); }
    PG8_STAMP();
    if (STAMP && wid == 0) { stamps[lane] = lane < nts ? (((unsigned long long)(unsigned)ts_hi << 32) | (unsigned)ts_lo) : 0ull;
        if (lane == 62) stamps[62] = rt_entry; if (lane == 63) stamps[63] = (unsigned long long)wall_clock64(); }
#undef PG8_STAMP
#undef PG8_SA
#undef PG8_SB
#undef PG8_STAGE
#undef PG8_LDA
#undef PG8_LDB
#undef PG8_MMA
#undef PG8_WAIT_V
#undef PG8_WAIT_L
#undef PG8_BAR
#undef PG8_SCHED
}
}

namespace mk {
#define GAS __attribute__((address_space(1)))
#define LAS __attribute__((address_space(3)))
#define DEV __device__ __forceinline__
typedef unsigned short bf16;
typedef unsigned v4u __attribute__((ext_vector_type(4)));
typedef float f32x4 __attribute__((ext_vector_type(4)));
typedef float f32x2 __attribute__((ext_vector_type(2)));
typedef short bf16x8 __attribute__((ext_vector_type(8)));
typedef float f32x16 __attribute__((ext_vector_type(16)));
typedef __bf16 bf16x2_t __attribute__((ext_vector_type(2)));

#ifndef MK_DBG
#define MK_DBG 0
#endif
#ifndef MK_CHECK
#define MK_CHECK 0
#endif
#ifndef MK_N_LAUNCHES
#define MK_N_LAUNCHES 19
#endif

constexpr int D = 2048, SEQ = 4096, M = 8192, NL = 2;
constexpr int LRU_W = 768, SWA_W = 768, SB_W = 512, IN_W = 5376;
constexpr int ZO_XA = 0, ZO_GA = 768, ZO_QB = 1536, ZO_KB = 2304, ZO_VB = 3072, ZO_QC = 3840, ZO_KC = 4352, ZO_VC = 4864;
constexpr int NEXP = 16384, MODW = 12288;
constexpr int MO_SH1 = 0, MO_SC1 = 2048, MO_G1 = 4096, MO_SH2 = 6144, MO_SC2 = 8192, MO_G2 = 10240;
constexpr float EPS = 1e-6f;
constexpr float QSCALE = 0.08838834764831845f;
constexpr float NEGBIG = -3.0e38f;
constexpr int NPHASE = 19 + 2 * (MK_CHECK != 0);

constexpr size_t MiB = 1u << 20;
constexpr size_t WS_CTL = 0, CTL_ZERO_BYTES = 1 * MiB;
constexpr size_t WS_MOD = 512 * 1024;
constexpr size_t WS_WIN_T = 2 * MiB, WS_WOUT_T = 44 * MiB, WS_WQ_T = 60 * MiB, WS_SUBK = 76 * MiB, WS_U = 80 * MiB, WS_V = 208 * MiB,
                 WS_H = 336 * MiB, WS_Z = 368 * MiB, WS_HLOC = 452 * MiB, WS_P = 476 * MiB, WS_YB = 500 * MiB, WS_YC = 524 * MiB,
                 WS_SUMA = 540 * MiB, WS_SUMB = 541 * MiB, WS_X1 = 544 * MiB, WS_X2 = 608 * MiB, WS_Q = 672 * MiB, WS_IDS = 704 * MiB,
                 WS_G = 708 * MiB, WS_PART = 712 * MiB, WS_LSE = 784 * MiB, WS_END = 785 * MiB;
constexpr int CW_BAR = 4096;

constexpr int LDS_BYTES = 147456;
constexpr int LDS_MISC = 131072;

__device__ const unsigned char T5B[3][132] = {
 {0,1,2,3,4,5,6,7,8,9,10,11,12,13,14,15,16,16,16,16,16,16,17,17,17,17,17,17,17,17,18,18,18,18,18,18,18,18,18,18,19,19,19,19,19,19,19,19,19,19,19,19,19,19,20,20,20,20,20,20,20,20,20,20,20,20,20,20,20,20,20,20,20,21,21,21,21,21,21,21,21,21,21,21,21,21,21,21,21,21,21,21,21,21,21,21,21,21,21,22,22,22,22,22,22,22,22,22,22,22,22,22,22,22,22,22,22,22,22,22,22,22,22,22,22,22,22,22,22,0,0,0},
 {0,4,8,12,16,16,17,17,18,18,19,19,19,19,20,20,20,20,20,21,21,21,21,21,21,22,22,22,22,22,22,22,22,22,23,23,23,23,23,23,23,23,23,23,23,23,24,24,24,24,24,24,24,24,24,24,24,24,24,24,24,24,25,25,25,25,25,25,25,25,25,25,25,25,25,25,25,25,25,25,25,25,25,26,26,26,26,26,26,26,26,26,26,26,26,26,26,26,26,26,26,26,26,26,26,26,26,26,26,26,26,26,26,27,27,27,27,27,27,27,27,27,27,27,27,27,27,27,27,0,0,0},
 {0,16,18,19,20,21,21,22,22,23,23,23,24,24,24,24,25,25,25,25,25,26,26,26,26,26,26,26,26,27,27,27,27,27,27,27,27,27,27,28,28,28,28,28,28,28,28,28,28,28,28,28,29,29,29,29,29,29,29,29,29,29,29,29,29,29,29,29,29,29,30,30,30,30,30,30,30,30,30,30,30,30,30,30,30,30,30,30,30,30,30,30,30,30,30,31,31,31,31,31,31,31,31,31,31,31,31,31,31,31,31,31,31,31,31,31,31,31,31,31,31,31,31,31,31,31,31,31,31,0,0,0}};

#define LDS_WAIT() asm volatile("s_waitcnt lgkmcnt(0)" ::: "memory")
DEV unsigned f2bf(float f) { unsigned u = __builtin_bit_cast(unsigned, f); return (u + 0x7fffu + ((u >> 16) & 1u)) >> 16; }
DEV unsigned pk2(float lo, float hi) { return f2bf(lo) | (f2bf(hi) << 16); }
DEV float bf_lo(unsigned w) { return __builtin_bit_cast(float, w << 16); }
DEV float bf_hi(unsigned w) { return __builtin_bit_cast(float, w & 0xffff0000u); }
DEV float bf1(bf16 h) { return __builtin_bit_cast(float, ((unsigned)h) << 16); }
DEV float wave_sum(float v) {
#pragma unroll
    for (int o = 1; o < 64; o <<= 1) v += __shfl_xor(v, o);
    return v;
}
DEV float wave_max(float v) {
#pragma unroll
    for (int o = 1; o < 64; o <<= 1) v = fmaxf(v, __shfl_xor(v, o));
    return v;
}
DEV float sigmoid_f(float x) { return 1.f / (1.f + __expf(-x)); }
DEV float softplus_f(float x) { return fmaxf(x, 0.f) + log1pf(__expf(-fabsf(x))); }
DEV float gelu_tanh(float x) { const float u = 0.7978845608028654f * (x + 0.044715f * x * x * x); const float t = 1.f - 2.f / (1.f + __expf(2.f * u)); return 0.5f * x * (1.f + t); }
DEV float dot8(const v4u a, const v4u b) {
    float s = bf_lo(a.x) * bf_lo(b.x); s += bf_hi(a.x) * bf_hi(b.x);
    s += bf_lo(a.y) * bf_lo(b.y); s += bf_hi(a.y) * bf_hi(b.y);
    s += bf_lo(a.z) * bf_lo(b.z); s += bf_hi(a.z) * bf_hi(b.z);
    s += bf_lo(a.w) * bf_lo(b.w); s += bf_hi(a.w) * bf_hi(b.w);
    return s;
}

#define XB_TMO      128
#define XB_XCNT(j)  (256  + 64 * (j))
#define XB_XSUB(j)  (1280 + 64 * (j))
#define XB_XGEN(j)  (2304 + 64 * (j))
#define XB_TOP      3328
#define XB_TOPGEN   3392
#define XCD_BAR_WORDS 3456
#define XB_SPIN_CAP (1u << 18)

__device__ __forceinline__ unsigned xb_ld(unsigned* p)              { return __hip_atomic_load(p, __ATOMIC_RELAXED, __HIP_MEMORY_SCOPE_AGENT); }
__device__ __forceinline__ unsigned xb_add(unsigned* p, unsigned v) { return __hip_atomic_fetch_add(p, v, __ATOMIC_RELAXED, __HIP_MEMORY_SCOPE_AGENT); }
__device__ __forceinline__ unsigned xb_xcc_id() { return (unsigned)__builtin_amdgcn_s_getreg((3 << 11) | 20) & 0xFu; }
#define XB_SPIN(cond, bar) do { unsigned _sp = 0; while (cond) { __builtin_amdgcn_s_sleep(1); \
    if ((++_sp & 255u) == 0u) { if (xb_ld(&(bar)[XB_TMO])) break; if (_sp > XB_SPIN_CAP) { atomicAdd(&(bar)[XB_TMO], 1u); break; } } } } while (0)

struct XcdBarrier {
    unsigned* bar; unsigned x;
    volatile LAS unsigned* st;
};
__device__ __forceinline__ XcdBarrier xcd_barrier_post(unsigned* bar, volatile LAS unsigned* st) {
    XcdBarrier b; b.bar = bar; b.x = xb_xcc_id(); b.st = st;
    if (threadIdx.x == 0) (void)xb_add(&bar[XB_XCNT(b.x)], 1u);
    return b;
}
__device__ __forceinline__ void xcd_barrier_complete(unsigned* bar, unsigned x, unsigned& nloc, unsigned& nx) {
    const unsigned G = gridDim.x * gridDim.y * gridDim.z;
    unsigned sum, cnt, mine, sp = 0u;
    for (;;) {
        sum = 0u; cnt = 0u; mine = 0u;
#pragma unroll
        for (unsigned j = 0; j < 16; ++j) { const unsigned c = xb_ld(&bar[XB_XCNT(j)]); sum += c; cnt += (c > 0u) ? 1u : 0u; mine = (j == x) ? c : mine; }
        if (sum == G) break;
        __builtin_amdgcn_s_sleep(1);
        if ((++sp & 255u) == 0u) { if (xb_ld(&bar[XB_TMO])) break; if (sp > XB_SPIN_CAP) { atomicAdd(&bar[XB_TMO], 1u); break; } }
    }
    nloc = mine > 0u ? mine : 1u; nx = cnt > 0u ? cnt : 1u;
}
__device__ __forceinline__ void xcd_barrier(const XcdBarrier& b) {
    asm volatile("s_waitcnt vmcnt(0)" ::: "memory");
    __syncthreads();
    if (threadIdx.x == 0) {
        unsigned* bar = b.bar;
        __builtin_amdgcn_s_waitcnt(0);
        unsigned nloc = b.st[0], nx = b.st[1];
        if (nloc == 0u) { xcd_barrier_complete(bar, b.x, nloc, nx); b.st[0] = nloc; b.st[1] = nx; }
        const unsigned old = xb_add(&bar[XB_XSUB(b.x)], 1u);
        const unsigned gen = old / nloc;
        if (old + 1u == (gen + 1u) * nloc) {
            __builtin_amdgcn_fence(__ATOMIC_RELEASE, "agent");
            asm volatile("s_waitcnt vmcnt(0)" ::: "memory");
            const unsigned og = xb_add(&bar[XB_TOP], 1u);
            const unsigned tg = og / nx;
            if (og + 1u == (tg + 1u) * nx) xb_add(&bar[XB_TOPGEN], 1u);
            else XB_SPIN(xb_ld(&bar[XB_TOPGEN]) == tg, bar);
            __builtin_amdgcn_fence(__ATOMIC_ACQUIRE, "agent");
            xb_add(&bar[XB_XGEN(b.x)], 1u);
            asm volatile("s_waitcnt vmcnt(0)" ::: "memory");
        } else {
            XB_SPIN(xb_ld(&bar[XB_XGEN(b.x)]) == gen, bar);
            __builtin_amdgcn_fence(__ATOMIC_ACQUIRE, "agent");
            asm volatile("s_waitcnt vmcnt(0)" ::: "memory");
        }
    }
    __syncthreads();
}

struct EpiResGate {
    static constexpr bool PERM = false, AFTER_DRAIN = false;
    const float* X; float* O; const float* gate; float gscale;
    __device__ __forceinline__ void operator()(const pg8::f32x4 (&acc)[2][2][4][2], const pg8::Unit& u, int wr, int wc, int fr, int fq) const {
        const int row0 = u.pm * 256 + wr * 64 + fr, col0 = u.pn * 256 + wc * 32 + 4 * fq;
        const float* gp = gate + (size_t)((u.pm * 256) >> 12) * MODW;
        pg8::f32x4 gv[2][2];
#pragma unroll
        for (int bj = 0; bj < 2; ++bj)
#pragma unroll
            for (int n = 0; n < 2; ++n) gv[bj][n] = *(const pg8::f32x4*)(gp + col0 + bj * 128 + n * 16) * gscale;
#pragma unroll
        for (int ai = 0; ai < 2; ++ai)
#pragma unroll
            for (int m = 0; m < 4; ++m) {
                const size_t ro = (size_t)(row0 + ai * 128 + m * 16) * D + col0;
#pragma unroll
                for (int bj = 0; bj < 2; ++bj)
#pragma unroll
                    for (int n = 0; n < 2; ++n) {
                        const pg8::f32x4 xv = *(const pg8::f32x4*)(X + ro + bj * 128 + n * 16);
                        *(pg8::f32x4*)(O + ro + bj * 128 + n * 16) = xv + gv[bj][n] * acc[ai][bj][m][n];
                    }
            }
    }
};

DEV void ph_mod(const float* __restrict__ c, const float* __restrict__ w_mod, const float* __restrict__ b_mod, float* __restrict__ mod, LAS float* red, int vcu, int G, int tid) {
    const int lane = tid & 63, wave = tid >> 6;
    for (int it = vcu; it < 2 * 192; it += G) {
        const int l = it / 192, cb = it % 192;
        const int k0 = wave * 256;
        const float* W = w_mod + ((size_t)l * D + k0) * MODW + cb * 64 + lane;
        float a0 = 0.f, a1 = 0.f;
#pragma unroll 16
        for (int k = 0; k < 256; ++k) {
            const float w = W[(size_t)k * MODW];
            const float c0 = c[k0 + k], c1 = c[D + k0 + k];
            a0 += (c0 * sigmoid_f(c0)) * w; a1 += (c1 * sigmoid_f(c1)) * w;
        }
        red[(wave * 2 + 0) * 64 + lane] = a0; red[(wave * 2 + 1) * 64 + lane] = a1;
        __syncthreads();
        if (tid < 128) {
            const int b = tid >> 6, ln = tid & 63; float s = 0.f;
#pragma unroll
            for (int w = 0; w < 8; ++w) s += red[(w * 2 + b) * 64 + ln];
            const int col = cb * 64 + ln;
            mod[(size_t)(l * 2 + b) * MODW + col] = s + b_mod[l * MODW + col];
        }
        __syncthreads();
    }
}
DEV void transpose_item(const float* __restrict__ W, int K, int N, bf16* __restrict__ WT, LAS float* scr, int item, int lane) {
    const int nblk = N / 32, kb = item / nblk, nb = item % nblk, k0 = 64 * kb, n0 = 32 * nb;
#pragma unroll 8
    for (int i = 0; i < 32; ++i) { const int kk = 2 * i + (lane >> 5); scr[kk * 33 + (lane & 31)] = W[(size_t)(k0 + kk) * N + n0 + (lane & 31)]; }
    LDS_WAIT();
    const int c = lane & 7;
#pragma unroll
    for (int j = 0; j < 4; ++j) { const int n = (lane >> 3) + 8 * j; const LAS float* s = scr + (8 * c) * 33 + n;
        v4u o; o.x = pk2(s[0 * 33], s[1 * 33]); o.y = pk2(s[2 * 33], s[3 * 33]); o.z = pk2(s[4 * 33], s[5 * 33]); o.w = pk2(s[6 * 33], s[7 * 33]);
        *(v4u*)(WT + (size_t)(n0 + n) * K + k0 + 8 * c) = o; }
    LDS_WAIT();
}
DEV void convert_copy(const float* __restrict__ src, bf16* __restrict__ dst, size_t ngroups8, size_t gtid, size_t gstride) {
    for (size_t g = gtid; g < ngroups8; g += gstride) {
        const f32x4 a = *(const f32x4*)(src + g * 8), b = *(const f32x4*)(src + g * 8 + 4);
        v4u o; o.x = pk2(a.x, a.y); o.y = pk2(a.z, a.w); o.z = pk2(b.x, b.y); o.w = pk2(b.z, b.w);
        *(v4u*)(dst + g * 8) = o;
    }
}

DEV void modnorm_rows(const float* __restrict__ X, const float* __restrict__ gain, const float* __restrict__ modl, int sh_off, int sc_off, bf16* __restrict__ H, int gw, int NGW, int lane) {
    for (int m = gw; m < M; m += NGW) {
        const int b = m >> 12;
        const f32x4* xr = (const f32x4*)(X + (size_t)m * D) + lane;
        f32x4 v[8]; float s = 0.f;
#pragma unroll
        for (int j = 0; j < 8; ++j) { v[j] = xr[64 * j]; s += (v[j].x * v[j].x + v[j].y * v[j].y) + (v[j].z * v[j].z + v[j].w * v[j].w); }
        const float r = rsqrtf(wave_sum(s) * (1.f / D) + EPS);
        const f32x4* g4 = (const f32x4*)gain + lane;
        const f32x4* sc4 = (const f32x4*)(modl + (size_t)b * MODW + sc_off) + lane;
        const f32x4* sh4 = (const f32x4*)(modl + (size_t)b * MODW + sh_off) + lane;
        unsigned long long* o8 = (unsigned long long*)(H + (size_t)m * D) + lane;
#pragma unroll
        for (int j = 0; j < 8; ++j) {
            const f32x4 g = g4[64 * j], sc = sc4[64 * j], sh = sh4[64 * j];
            const f32x4 y = (v[j] * r) * g * (sc + 1.f) + sh;
            o8[64 * j] = (unsigned long long)pk2(y.x, y.y) | ((unsigned long long)pk2(y.z, y.w) << 32);
        }
    }
}

DEV void lru_item(int l, int b, int j, int n, const bf16* __restrict__ Z, const float* __restrict__ conv_w, const float* __restrict__ conv_b,
                  const float* __restrict__ w_rec, const float* __restrict__ b_rec, const float* __restrict__ w_gi, const float* __restrict__ b_gi, const float* __restrict__ lam,
                  float* __restrict__ HLOC, float* __restrict__ PP, float* __restrict__ SUMA, float* __restrict__ SUMB, LAS float* xc, LAS float* aL, LAS float* uL, int tid) {
    const int ch = tid & 127, tq = tid >> 7, c = n * 128 + ch;
    {
        const float cw0 = conv_w[(l * 4 + 0) * LRU_W + c], cw1 = conv_w[(l * 4 + 1) * LRU_W + c], cw2 = conv_w[(l * 4 + 2) * LRU_W + c], cw3 = conv_w[(l * 4 + 3) * LRU_W + c];
        const float cb = conv_b[l * LRU_W + c];
#pragma unroll 4
        for (int i = 0; i < 16; ++i) {
            const int tok = tq + 4 * i, t = j * 64 + tok;
            const bf16* zp = Z + ((size_t)b * SEQ + t) * IN_W + ZO_XA + c;
            float s = cb + cw3 * bf1(zp[0]);
            if (t >= 1) s += cw2 * bf1(zp[-(ptrdiff_t)IN_W]);
            if (t >= 2) s += cw1 * bf1(zp[-(ptrdiff_t)2 * IN_W]);
            if (t >= 3) s += cw0 * bf1(zp[-(ptrdiff_t)3 * IN_W]);
            xc[tok * 128 + ch] = s;
        }
    }
    __syncthreads();
    float accr[16], acci[16];
#pragma unroll
    for (int i = 0; i < 16; ++i) { accr[i] = 0.f; acci[i] = 0.f; }
    const float* Wr = w_rec + ((size_t)(l * 6 + n) * 128) * 128 + ch;
    const float* Wi = w_gi + ((size_t)(l * 6 + n) * 128) * 128 + ch;
#pragma unroll 2
    for (int jj = 0; jj < 128; ++jj) {
        const float wr = Wr[jj * 128], wi = Wi[jj * 128];
#pragma unroll
        for (int i = 0; i < 16; ++i) { const float x = xc[(tq + 4 * i) * 128 + jj]; accr[i] += x * wr; acci[i] += x * wi; }
    }
    {
        const float br = b_rec[l * LRU_W + c], bi = b_gi[l * LRU_W + c], sp = softplus_f(-lam[l * LRU_W + c]);
#pragma unroll
        for (int i = 0; i < 16; ++i) {
            const int tok = tq + 4 * i;
            const float r = sigmoid_f(accr[i] + br), ig = sigmoid_f(acci[i] + bi);
            const float log_a = -8.0f * r * sp;
            const float av = __expf(log_a);
            const float x = xc[tok * 128 + ch];
            const float uv = sqrtf(fmaxf(-expm1f(2.f * log_a), 0.f)) * (ig * x);
            aL[tok * 128 + ch] = av; uL[tok * 128 + ch] = uv;
        }
    }
    __syncthreads();
    if (tid < 128) {
        float h = 0.f, P = 1.f;
        const size_t rb = ((size_t)b * SEQ + j * 64) * LRU_W + n * 128 + tid;
        for (int tok = 0; tok < 64; ++tok) {
            const float av = aL[tok * 128 + tid];
            h = av * h + uL[tok * 128 + tid]; P *= av;
            HLOC[rb + (size_t)tok * LRU_W] = h; PP[rb + (size_t)tok * LRU_W] = P;
        }
        SUMA[(size_t)(b * 64 + j) * LRU_W + n * 128 + tid] = P; SUMB[(size_t)(b * 64 + j) * LRU_W + n * 128 + tid] = h;
    }
    __syncthreads();
}

DEV void dil_item(int b, int h, int t, const bf16* __restrict__ Z, const float* __restrict__ rel_bias, float* __restrict__ YB, LAS float* qs, LAS float* lg, int lane) {
    const size_t row = (size_t)b * SEQ + t;
    { const unsigned w = *(const unsigned*)(Z + row * IN_W + ZO_QB + h * 128 + 2 * lane); qs[2 * lane] = bf_lo(w) * QSCALE; qs[2 * lane + 1] = bf_hi(w) * QSCALE; }
    LDS_WAIT();
    float mx = NEGBIG;
#pragma unroll
    for (int p = 0; p < 3; ++p) {
        const int d = 1 << (2 * p);
        for (int jj = lane; jj < 129; jj += 64) {
            const int pos = t - jj * d; float lgt = NEGBIG;
            if (pos >= 0) {
                const v4u* kr = (const v4u*)(Z + ((size_t)b * SEQ + pos) * IN_W + ZO_KB + h * 128);
                float s = 0.f;
#pragma unroll 4
                for (int c8 = 0; c8 < 16; ++c8) { const v4u kv = kr[c8]; const LAS float* q = qs + c8 * 8;
                    s += q[0] * bf_lo(kv.x) + q[1] * bf_hi(kv.x) + q[2] * bf_lo(kv.y) + q[3] * bf_hi(kv.y) + q[4] * bf_lo(kv.z) + q[5] * bf_hi(kv.z) + q[6] * bf_lo(kv.w) + q[7] * bf_hi(kv.w); }
                lgt = s + rel_bias[(int)T5B[p][jj] * 6 + h];
            }
            lg[p * 129 + jj] = lgt; mx = fmaxf(mx, lgt);
        }
    }
    mx = wave_max(mx);
    LDS_WAIT();
    float sum = 0.f;
    for (int idx = lane; idx < 387; idx += 64) { const float v = lg[idx]; const float pv = (v > -1.0e37f) ? __expf(v - mx) : 0.f; lg[idx] = pv; sum += pv; }
    sum = wave_sum(sum);
    LDS_WAIT();
    float a0 = 0.f, a1 = 0.f;
#pragma unroll
    for (int p = 0; p < 3; ++p) {
        const int d = 1 << (2 * p);
        int nk = t / d + 1; nk = nk > 129 ? 129 : nk;
        const bf16* vb = Z + row * IN_W + ZO_VB + h * 128 + 2 * lane;
#pragma unroll 4
        for (int jj = 0; jj < nk; ++jj) {
            const float pv = lg[p * 129 + jj];
            const unsigned w = *(const unsigned*)(vb - (size_t)jj * d * IN_W);
            a0 += pv * bf_lo(w); a1 += pv * bf_hi(w);
        }
    }
    const float inv = 1.f / sum;
    *(f32x2*)(YB + row * SWA_W + h * 128 + 2 * lane) = (f32x2){a0 * inv, a1 * inv};
    LDS_WAIT();
}


DEV unsigned cvtpk_bf16(float lo, float hi) { f32x2 v = {lo, hi}; bf16x2_t b = __builtin_convertvector(v, bf16x2_t); return __builtin_bit_cast(unsigned, b); }
constexpr int DIL_VSTR = 272;
constexpr int DIL_WLDS = 32 * DIL_VSTR + 132 * 4;
DEV void dil_mfma_item(int b, int h, int p, int rr, int i0, const bf16* __restrict__ Z, const float* __restrict__ rel_bias, float* __restrict__ PART, float* __restrict__ LSE, LAS unsigned char* wl, int lane) {
    const int r = lane & 31, hh = lane >> 5;
    const int d = 1 << (2 * p);
    LAS float* biasL = (LAS float*)(wl + 32 * DIL_VSTR);
    for (int dd = lane; dd < 129; dd += 64) biasL[dd] = rel_bias[(int)T5B[p][dd] * 6 + h];
    const size_t rowq = (size_t)b * SEQ + rr + d * (i0 + r);
    bf16x8 qf[8];
    { const bf16* qrow = Z + rowq * IN_W + ZO_QB + h * 128 + 8 * hh;
#pragma unroll
      for (int ks = 0; ks < 8; ++ks) qf[ks] = *(const bf16x8*)(qrow + 16 * ks); }
    float m_run = NEGBIG, l_run = 0.f;
    f32x16 o[4];
#pragma unroll
    for (int dt = 0; dt < 4; ++dt)
#pragma unroll
        for (int e = 0; e < 16; ++e) o[dt][e] = 0.f;
    const int kap = (r & 0x13) | ((r & 4) << 1) | ((r & 8) >> 1);
    LDS_WAIT();
    for (int jt = 0; jt < 5; ++jt) {
        const int j0 = i0 - 128 + 32 * jt;
        if (j0 + 31 < 0) continue;
        {
            v4u vr[8];
#pragma unroll
            for (int q = 0; q < 8; ++q) { const int pi = lane + 64 * q, kl = pi >> 4, c = pi & 15; int j = j0 + kl; j = j < 0 ? 0 : j;
                vr[q] = *(const v4u*)(Z + ((size_t)b * SEQ + rr + d * j) * IN_W + ZO_VB + h * 128 + 8 * c); }
#pragma unroll
            for (int q = 0; q < 8; ++q) { const int pi = lane + 64 * q, kl = pi >> 4, c = pi & 15; *(LAS v4u*)(wl + kl * DIL_VSTR + c * 16) = vr[q]; }
        }
        f32x16 sacc;
#pragma unroll
        for (int e = 0; e < 16; ++e) sacc[e] = 0.f;
        { int jk = j0 + kap; jk = jk < 0 ? 0 : jk;
          const bf16* krow = Z + ((size_t)b * SEQ + rr + d * jk) * IN_W + ZO_KB + h * 128 + 8 * hh;
          bf16x8 kf[8];
#pragma unroll
          for (int ks = 0; ks < 8; ++ks) kf[ks] = *(const bf16x8*)(krow + 16 * ks);
#pragma unroll
          for (int ks = 0; ks < 8; ++ks) sacc = __builtin_amdgcn_mfma_f32_32x32x16_bf16(kf[ks], qf[ks], sacc, 0, 0, 0); }
        float tm = NEGBIG;
#pragma unroll
        for (int e = 0; e < 16; ++e) {
            const int j = j0 + 16 * (e >> 3) + 8 * hh + (e & 7);
            const int dist = (i0 + r) - j;
            const bool valid = (j >= 0) && (dist >= 0) && (dist <= 128);
            const int dc = dist < 0 ? 0 : (dist > 128 ? 128 : dist);
            const float lg = valid ? sacc[e] * QSCALE + biasL[dc] : NEGBIG;
            sacc[e] = lg; tm = fmaxf(tm, lg);
        }
        tm = fmaxf(tm, __shfl_xor(tm, 32));
        const float m_new = fmaxf(m_run, tm);
        const float alpha = __expf(m_run - m_new);
        float ps = 0.f;
#pragma unroll
        for (int e = 0; e < 16; ++e) { const float pv = (sacc[e] > -1.0e37f) ? __expf(sacc[e] - m_new) : 0.f; sacc[e] = pv; ps += pv; }
        ps += __shfl_xor(ps, 32);
        l_run = l_run * alpha + ps; m_run = m_new;
#pragma unroll
        for (int dt = 0; dt < 4; ++dt)
#pragma unroll
            for (int e = 0; e < 16; ++e) o[dt][e] *= alpha;
        bf16x8 pf[2];
#pragma unroll
        for (int s2 = 0; s2 < 2; ++s2) { v4u w; w.x = cvtpk_bf16(sacc[8 * s2 + 0], sacc[8 * s2 + 1]); w.y = cvtpk_bf16(sacc[8 * s2 + 2], sacc[8 * s2 + 3]);
            w.z = cvtpk_bf16(sacc[8 * s2 + 4], sacc[8 * s2 + 5]); w.w = cvtpk_bf16(sacc[8 * s2 + 6], sacc[8 * s2 + 7]); pf[s2] = __builtin_bit_cast(bf16x8, w); }
        LDS_WAIT();
#pragma unroll
        for (int dt = 0; dt < 4; ++dt)
#pragma unroll
            for (int s2 = 0; s2 < 2; ++s2) {
                const LAS unsigned short* vp = (const LAS unsigned short*)(wl + (16 * s2 + 8 * hh) * DIL_VSTR + (32 * dt + r) * 2);
                v4u w;
                w.x = (unsigned)vp[0 * (DIL_VSTR / 2)] | ((unsigned)vp[1 * (DIL_VSTR / 2)] << 16);
                w.y = (unsigned)vp[2 * (DIL_VSTR / 2)] | ((unsigned)vp[3 * (DIL_VSTR / 2)] << 16);
                w.z = (unsigned)vp[4 * (DIL_VSTR / 2)] | ((unsigned)vp[5 * (DIL_VSTR / 2)] << 16);
                w.w = (unsigned)vp[6 * (DIL_VSTR / 2)] | ((unsigned)vp[7 * (DIL_VSTR / 2)] << 16);
                o[dt] = __builtin_amdgcn_mfma_f32_32x32x16_bf16(__builtin_bit_cast(bf16x8, w), pf[s2], o[dt], 0, 0, 0);
            }
        LDS_WAIT();
    }
    const float inv = 1.f / l_run;
    float* po = PART + ((size_t)p * M + rowq) * SWA_W + h * 128;
#pragma unroll
    for (int dt = 0; dt < 4; ++dt)
#pragma unroll
        for (int g = 0; g < 4; ++g)
            *(f32x4*)(po + 32 * dt + 8 * g + 4 * hh) = (f32x4){o[dt][4 * g + 0] * inv, o[dt][4 * g + 1] * inv, o[dt][4 * g + 2] * inv, o[dt][4 * g + 3] * inv};
    if (hh == 0) LSE[((size_t)p * M + rowq) * 6 + h] = m_run + __logf(l_run);
}

DEV void sb_item(int b, int h, int t, const bf16* __restrict__ Z, float* __restrict__ YC, LAS float* qs, LAS float* pA, int lane) {
    const size_t row = (size_t)b * SEQ + t;
    { const unsigned w = *(const unsigned*)(Z + row * IN_W + ZO_QC + h * 128 + 2 * lane); qs[2 * lane] = bf_lo(w) * QSCALE; qs[2 * lane + 1] = bf_hi(w) * QSCALE; }
    LDS_WAIT();
    float carry = 0.f, a0 = 0.f, a1 = 0.f;
    for (int shi = t - 1; shi >= 0; shi -= 64) {
        const int s = shi - lane; const bool valid = s >= 0;
        float z = 0.f;
        if (valid) {
            const v4u* kr = (const v4u*)(Z + ((size_t)b * SEQ + s) * IN_W + ZO_KC + h * 128);
#pragma unroll 4
            for (int c8 = 0; c8 < 16; ++c8) { const v4u kv = kr[c8]; const LAS float* q = qs + c8 * 8;
                z += q[0] * bf_lo(kv.x) + q[1] * bf_hi(kv.x) + q[2] * bf_lo(kv.y) + q[3] * bf_hi(kv.y) + q[4] * bf_lo(kv.z) + q[5] * bf_hi(kv.z) + q[6] * bf_lo(kv.w) + q[7] * bf_hi(kv.w); }
        }
        const float l1m = valid ? -softplus_f(z) : 0.f;
        float inc = l1m;
#pragma unroll
        for (int o = 1; o < 64; o <<= 1) { const float tmp = __shfl_up(inc, o); if (lane >= o) inc += tmp; }
        const float A = valid ? __expf(-softplus_f(-z) + carry + (inc - l1m)) : 0.f;
        carry += __shfl(inc, 63);
        pA[lane] = A;
        const bool done = carry < -105.0f;
        LDS_WAIT();
        const int nk = (shi + 1) < 64 ? (shi + 1) : 64;
        const bf16* vb = Z + ((size_t)b * SEQ + shi) * IN_W + ZO_VC + h * 128 + 2 * lane;
#pragma unroll 4
        for (int i = 0; i < nk; ++i) {
            const float pv = pA[i];
            const unsigned w = *(const unsigned*)(vb - (size_t)i * IN_W);
            a0 += pv * bf_lo(w); a1 += pv * bf_hi(w);
        }
        LDS_WAIT();
        if (done) break;
    }
    *(f32x2*)(YC + row * SB_W + h * 128 + 2 * lane) = (f32x2){a0, a1};
}

DEV void combine_item(int l, int b, int j, int half, const bf16* __restrict__ Z, const float* __restrict__ HLOC, const float* __restrict__ PP, const float* __restrict__ SUMA, const float* __restrict__ SUMB,
                      const float* __restrict__ PART, const float* __restrict__ LSE, const float* __restrict__ YC, const float* __restrict__ g_lru, const float* __restrict__ g_swa, const float* __restrict__ g_sb,
                      bf16* __restrict__ Y, LAS float* carryL, int tid) {
    const int lane = tid & 63, wave = tid >> 6;
    for (int c = tid; c < LRU_W; c += 512) {
        float cr = 0.f;
        for (int i = 0; i < j; ++i) cr = SUMA[(size_t)(b * 64 + i) * LRU_W + c] * cr + SUMB[(size_t)(b * 64 + i) * LRU_W + c];
        carryL[c] = cr;
    }
    __syncthreads();
    for (int i = 0; i < 4; ++i) {
        const int tok = half * 32 + wave * 4 + i;
        const size_t row = (size_t)b * SEQ + j * 64 + tok;
        bf16* yo = Y + row * D;
        {
            float ya[12]; float ssq = 0.f;
#pragma unroll
            for (int e = 0; e < 12; ++e) { const int c = lane + 64 * e;
                const float hv = HLOC[row * LRU_W + c] + PP[row * LRU_W + c] * carryL[c];
                const float ga = bf1(Z[row * IN_W + ZO_GA + c]);
                ya[e] = hv * gelu_tanh(ga); ssq += ya[e] * ya[e]; }
            const float r = rsqrtf(wave_sum(ssq) * (1.f / LRU_W) + EPS);
#pragma unroll
            for (int e = 0; e < 12; ++e) { const int c = lane + 64 * e; yo[c] = (MK_DBG & 16) ? (bf16)0 : (bf16)f2bf(ya[e] * r * g_lru[l * LRU_W + c]); }
        }
        {
            float yb[12]; float ssq = 0.f;
            float wgt[3][2];
            (void)wgt;
#pragma unroll
            for (int e = 0; e < 12; ++e) { const int c = lane + 64 * e; const int hd = c >> 7;
                const float l0 = LSE[((size_t)0 * M + row) * 6 + hd], l1 = LSE[((size_t)1 * M + row) * 6 + hd], l2 = LSE[((size_t)2 * M + row) * 6 + hd];
                const float mx = fmaxf(l0, fmaxf(l1, l2)); const float e0 = __expf(l0 - mx), e1 = __expf(l1 - mx), e2 = __expf(l2 - mx); const float iz = 1.f / (e0 + e1 + e2);
                yb[e] = (e0 * PART[((size_t)0 * M + row) * SWA_W + c] + e1 * PART[((size_t)1 * M + row) * SWA_W + c] + e2 * PART[((size_t)2 * M + row) * SWA_W + c]) * iz;
                ssq += yb[e] * yb[e]; }
            const float r = rsqrtf(wave_sum(ssq) * (1.f / SWA_W) + EPS);
#pragma unroll
            for (int e = 0; e < 12; ++e) { const int c = lane + 64 * e; yo[LRU_W + c] = (MK_DBG & 32) ? (bf16)0 : (bf16)f2bf(yb[e] * r * g_swa[l * SWA_W + c]); }
        }
        {
            float yc[8]; float ssq = 0.f;
#pragma unroll
            for (int e = 0; e < 8; ++e) { const int c = lane + 64 * e; yc[e] = YC[row * SB_W + c]; ssq += yc[e] * yc[e]; }
            const float r = rsqrtf(wave_sum(ssq) * (1.f / SB_W) + EPS);
#pragma unroll
            for (int e = 0; e < 8; ++e) { const int c = lane + 64 * e; yo[LRU_W + SWA_W + c] = (MK_DBG & 64) ? (bf16)0 : (bf16)f2bf(yc[e] * r * g_sb[l * SB_W + c]); }
        }
    }
    __syncthreads();
}

constexpr int RT_SK = 0, RT_Q = 128 * 129 * 4, RT_SC = RT_Q + 32 * 128 * 4, RT_TV = RT_SC + 64 * 129 * 4, RT_TI = RT_TV + 64 * 16 * 4, RT_END = RT_TI + 64 * 16 * 4;
static_assert(RT_END <= LDS_MISC, "routing LDS");
DEV void route_item(int l, int tile, int h, const bf16* __restrict__ Q, const bf16* __restrict__ SK, int* __restrict__ IDS, float* __restrict__ GG, LAS unsigned char* lds, int tid, unsigned* DBGW = nullptr) {
    LAS float* skL = (LAS float*)(lds + RT_SK); LAS float* qL = (LAS float*)(lds + RT_Q); LAS float* sc = (LAS float*)(lds + RT_SC);
    LAS float* topv = (LAS float*)(lds + RT_TV); LAS int* topi = (LAS int*)(lds + RT_TI);
    const int lane = tid & 63, wave = tid >> 6, row0 = tile * 32;
    for (int c = 0; c < 2; ++c) {
        const bf16* skp = SK + ((size_t)((l * 8 + h) * 2 + c)) * 128 * 128;
#pragma unroll 4
        for (int i = 0; i < 16; ++i) { const int idx2 = tid + 512 * i; const int k = idx2 >> 6, d2 = idx2 & 63; const unsigned w = *(const unsigned*)(skp + k * 128 + 2 * d2); skL[k * 129 + 2 * d2] = bf_lo(w); skL[k * 129 + 2 * d2 + 1] = bf_hi(w); }
#pragma unroll
        for (int i = 0; i < 4; ++i) { const int idx2 = tid + 512 * i; const int tok = idx2 >> 6, d2 = idx2 & 63; const unsigned w = *(const unsigned*)(Q + (size_t)(row0 + tok) * D + h * 256 + c * 128 + 2 * d2); qL[tok * 128 + 2 * d2] = bf_lo(w); qL[tok * 128 + 2 * d2 + 1] = bf_hi(w); }
        __syncthreads();
        {
            const int k = tid & 127, tg = tid >> 7;
            float acc[8];
#pragma unroll
            for (int i = 0; i < 8; ++i) acc[i] = 0.f;
#pragma unroll 4
            for (int d = 0; d < 128; ++d) { const float s = skL[k * 129 + d];
#pragma unroll
                for (int i = 0; i < 8; ++i) acc[i] += s * qL[(tg * 8 + i) * 128 + d]; }
#pragma unroll
            for (int i = 0; i < 8; ++i) sc[(c * 32 + tg * 8 + i) * 129 + k] = acc[i];
        }
        __syncthreads();
    }
    for (int q = 0; q < 8; ++q) {
        const int L = wave * 8 + q;
        float v0 = sc[L * 129 + lane], v1 = sc[L * 129 + 64 + lane];
        for (int r = 0; r < 16; ++r) {
            const float m = wave_max(fmaxf(v0, v1));
            const unsigned long long b0 = __ballot(v0 == m);
            int idx;
            if (b0) { const int ln = __ffsll((long long)b0) - 1; idx = ln; if (lane == ln) v0 = NEGBIG; }
            else { const unsigned long long b1 = __ballot(v1 == m); const int ln = __ffsll((long long)b1) - 1; idx = 64 + ln; if (lane == ln) v1 = NEGBIG; }
            if (lane == 0) { topv[L * 16 + r] = m; topi[L * 16 + r] = idx; }
        }
    }
    __syncthreads();
#if MK_CHECK == 16
    { for (int q = 0; q < 8; ++q) { const int L = wave * 8 + q; const int mi = topi[L * 16 + (lane & 15)]; int dup = 0;
          for (int e = 0; e < 16; ++e) { const int oi = __shfl(mi, e); if (lane < 16 && e != lane && oi == mi) dup = 1; }
          if (dup) atomicAdd((unsigned*)DBGW, 1u); } }
#endif
    for (int q = 0; q < 4; ++q) {
        const int tok = wave * 4 + q;
        float cv[4];
#pragma unroll
        for (int e = 0; e < 4; ++e) cv[e] = topv[tok * 16 + (lane >> 2)] + topv[(32 + tok) * 16 + (lane & 3) * 4 + e];
        float mysc = NEGBIG; int myid = 0;
        for (int r = 0; r < 16; ++r) {
            const float lm = fmaxf(fmaxf(cv[0], cv[1]), fmaxf(cv[2], cv[3]));
            const float m = wave_max(lm);
            const unsigned long long bb = __ballot(lm == m);
            const int ln = __ffsll((long long)bb) - 1;
            const int se = (cv[0] == m) ? 0 : (cv[1] == m) ? 1 : (cv[2] == m) ? 2 : 3;
            const int sel = __shfl(se, ln);
            { const bool me = (lane == ln);
              cv[0] = (me && sel == 0) ? NEGBIG : cv[0]; cv[1] = (me && sel == 1) ? NEGBIG : cv[1];
              cv[2] = (me && sel == 2) ? NEGBIG : cv[2]; cv[3] = (me && sel == 3) ? NEGBIG : cv[3]; }
            const int ci = ln * 4 + sel;
            const int id = topi[tok * 16 + (ci >> 4)] * 128 + topi[(32 + tok) * 16 + (ci & 15)];
            if (lane == r) { mysc = m; myid = id; }
        }
#if MK_CHECK == 16
        { int dup = 0; for (int e = 0; e < 16; ++e) { const int oi = __shfl(myid, e); if (lane < 16 && e != lane && oi == myid) dup = 1; } if (dup) atomicAdd((unsigned*)DBGW + 1, 1u); }
#endif
        const float s0 = __shfl(mysc, 0);
        const float ev = (lane < 16) ? __expf(mysc - s0) : 0.f;
        const float sum = wave_sum(ev);
        if (lane < 16) { IDS[(size_t)(row0 + tok) * 128 + h * 16 + lane] = myid; GG[(size_t)(row0 + tok) * 128 + h * 16 + lane] = ev / sum; }
    }
    __syncthreads();
}

DEV void expert_row(int l, int row, const bf16* __restrict__ H, const int* __restrict__ IDS, const float* __restrict__ GG, const bf16* __restrict__ U, const bf16* __restrict__ V,
                    const float* __restrict__ X1, const float* __restrict__ g2, const float* __restrict__ fnorm, float* __restrict__ XO, int lane, float pscale, float* STATP = nullptr) {
    v4u xv[4];
#pragma unroll
    for (int j = 0; j < 4; ++j) xv[j] = *(const v4u*)(H + (size_t)row * D + lane * 8 + 512 * j);
    const int id0 = IDS[(size_t)row * 128 + lane], id1 = IDS[(size_t)row * 128 + 64 + lane];
    const float gg0 = GG[(size_t)row * 128 + lane], gg1 = GG[(size_t)row * 128 + 64 + lane];
    float y[32];
#pragma unroll
    for (int i = 0; i < 32; ++i) y[i] = 0.f;
    const bf16* Ul = U + (size_t)l * NEXP * D + lane * 8;
    const bf16* Vl = V + (size_t)l * NEXP * D + lane * 8;
    for (int e0 = 0; e0 < 128; e0 += 2) {
        int id[2]; float gq[2];
#pragma unroll
        for (int q = 0; q < 2; ++q) { const int e = e0 + q;
            id[q] = (e < 64) ? __builtin_amdgcn_readlane(id0, e & 63) : __builtin_amdgcn_readlane(id1, e & 63);
            gq[q] = (e < 64) ? __builtin_bit_cast(float, __builtin_amdgcn_readlane(__builtin_bit_cast(int, gg0), e & 63)) : __builtin_bit_cast(float, __builtin_amdgcn_readlane(__builtin_bit_cast(int, gg1), e & 63)); }
        v4u uu[2][4], vv[2][4];
#pragma unroll
        for (int q = 0; q < 2; ++q)
#pragma unroll
            for (int j = 0; j < 4; ++j) uu[q][j] = *(const v4u*)(Ul + (size_t)id[q] * D + 512 * j);
#pragma unroll
        for (int q = 0; q < 2; ++q)
#pragma unroll
            for (int j = 0; j < 4; ++j) vv[q][j] = *(const v4u*)(Vl + (size_t)id[q] * D + 512 * j);
#pragma unroll
        for (int q = 0; q < 2; ++q) {
            float dsum = 0.f;
#pragma unroll
            for (int j = 0; j < 4; ++j) dsum += dot8(xv[j], uu[q][j]);
            dsum = wave_sum(dsum);
            const float w = gq[q] * gelu_tanh(dsum);
#if MK_CHECK == 7
            if (lane == 0 && l == 0) atomicAdd(STATP, gelu_tanh(dsum) * gelu_tanh(dsum) * 2048.f / 128.f);
#elif MK_CHECK == 8
            if (lane == 0 && l == 0) atomicAdd(STATP, gq[q] * gq[q] * 2048.f * 16.f / 128.f);
#elif MK_CHECK == 9
            if (lane == 0 && l == 0) atomicAdd(STATP, dsum * dsum * 2048.f / 128.f);
#elif MK_CHECK == 11
            if (lane == 0 && l == 0) atomicAdd(STATP, w * w * 2048.f);
#endif
#pragma unroll
            for (int j = 0; j < 4; ++j) {
                y[j * 8 + 0] += w * bf_lo(vv[q][j].x); y[j * 8 + 1] += w * bf_hi(vv[q][j].x);
                y[j * 8 + 2] += w * bf_lo(vv[q][j].y); y[j * 8 + 3] += w * bf_hi(vv[q][j].y);
                y[j * 8 + 4] += w * bf_lo(vv[q][j].z); y[j * 8 + 5] += w * bf_hi(vv[q][j].z);
                y[j * 8 + 6] += w * bf_lo(vv[q][j].w); y[j * 8 + 7] += w * bf_hi(vv[q][j].w);
            }
        }
    }
#if MK_CHECK == 6
    { float q2 = 0.f;
#pragma unroll
      for (int i = 0; i < 32; ++i) q2 += y[i] * y[i];
      q2 = wave_sum(q2); if (lane == 0 && l == 0) atomicAdd(STATP, q2); }
#endif
    float ssq = 0.f;
#pragma unroll
    for (int j = 0; j < 4; ++j) {
        const int col = lane * 8 + 512 * j;
        const f32x4 xa = *(const f32x4*)(X1 + (size_t)row * D + col), xb = *(const f32x4*)(X1 + (size_t)row * D + col + 4);
        const f32x4 ga = *(const f32x4*)(g2 + col) * pscale, gb = *(const f32x4*)(g2 + col + 4) * pscale;
        y[j * 8 + 0] = xa.x + ga.x * y[j * 8 + 0]; y[j * 8 + 1] = xa.y + ga.y * y[j * 8 + 1]; y[j * 8 + 2] = xa.z + ga.z * y[j * 8 + 2]; y[j * 8 + 3] = xa.w + ga.w * y[j * 8 + 3];
        y[j * 8 + 4] = xb.x + gb.x * y[j * 8 + 4]; y[j * 8 + 5] = xb.y + gb.y * y[j * 8 + 5]; y[j * 8 + 6] = xb.z + gb.z * y[j * 8 + 6]; y[j * 8 + 7] = xb.w + gb.w * y[j * 8 + 7];
#pragma unroll
        for (int e = 0; e < 8; ++e) ssq += y[j * 8 + e] * y[j * 8 + e];
    }
    if (fnorm) {
        const float r = rsqrtf(wave_sum(ssq) * (1.f / D) + EPS);
#pragma unroll
        for (int j = 0; j < 4; ++j) { const int col = lane * 8 + 512 * j;
            const f32x4 fa = *(const f32x4*)(fnorm + col), fb = *(const f32x4*)(fnorm + col + 4);
            *(f32x4*)(XO + (size_t)row * D + col) = (f32x4){y[j * 8 + 0] * r * fa.x, y[j * 8 + 1] * r * fa.y, y[j * 8 + 2] * r * fa.z, y[j * 8 + 3] * r * fa.w};
            *(f32x4*)(XO + (size_t)row * D + col + 4) = (f32x4){y[j * 8 + 4] * r * fb.x, y[j * 8 + 5] * r * fb.y, y[j * 8 + 6] * r * fb.z, y[j * 8 + 7] * r * fb.w}; }
    } else {
#pragma unroll
        for (int j = 0; j < 4; ++j) { const int col = lane * 8 + 512 * j;
            *(f32x4*)(XO + (size_t)row * D + col) = (f32x4){y[j * 8 + 0], y[j * 8 + 1], y[j * 8 + 2], y[j * 8 + 3]};
            *(f32x4*)(XO + (size_t)row * D + col + 4) = (f32x4){y[j * 8 + 4], y[j * 8 + 5], y[j * 8 + 6], y[j * 8 + 7]}; }
    }
}


#if MK_CHECK
DEV void chk_route(int l, int row, int h, const bf16* __restrict__ Q, const bf16* __restrict__ SK, const int* __restrict__ IDS, const float* __restrict__ GG, unsigned* bad, LAS float* sL, LAS unsigned* cntL, int tid) {
    if (tid < 256) { const int c = tid >> 7, k = tid & 127; const bf16* skp = SK + ((size_t)((l * 8 + h) * 2 + c)) * 128 * 128 + k * 128; const bf16* qp = Q + (size_t)row * D + h * 256 + c * 128;
        float s = 0.f; for (int d = 0; d < 128; ++d) s += bf1(qp[d]) * bf1(skp[d]); sL[c * 128 + k] = s; }
    if (tid == 0) cntL[0] = 0u;
    __syncthreads();
    float sc15 = 0.f; unsigned mybad = 0;
    { float prev = 3e38f; float s0 = 0.f, gsum = 0.f; float g0 = GG[(size_t)row * 128 + h * 16];
      for (int r = 0; r < 16; ++r) { const int id = IDS[(size_t)row * 128 + h * 16 + r]; const float g = GG[(size_t)row * 128 + h * 16 + r];
          if (id < 0 || id >= NEXP) { mybad |= 1; continue; }
          const float scv = sL[id >> 7] + sL[128 + (id & 127)];
          if (r == 0) s0 = scv;
          if (scv > prev + 1e-5f) mybad |= 2;
          prev = scv; gsum += g;
          const float ratio = __expf(scv - s0);
          if (fabsf(g / g0 - ratio) > 0.02f * ratio + 1e-4f) mybad |= 4;
          if (r == 15) sc15 = scv; }
      if (fabsf(gsum - 1.f) > 1e-3f) mybad |= 8; }
    unsigned cnt = 0;
    for (int p = tid; p < 16384; p += 512) { const float v = sL[p >> 7] + sL[128 + (p & 127)]; if (v > sc15 + 1e-5f) ++cnt; }
    __hip_atomic_fetch_add(cntL, cnt, __ATOMIC_RELAXED, __HIP_MEMORY_SCOPE_WORKGROUP);
    __syncthreads();
    if (tid == 0) { if (cntL[0] > 15u) mybad |= 16; if (mybad) atomicAdd(bad, 1u); }
    __syncthreads();
}
DEV void chk_expert(int l, int row, const bf16* __restrict__ H, const int* __restrict__ IDS, const float* __restrict__ GG, const float* __restrict__ Uf, const float* __restrict__ Vf,
                    const float* __restrict__ X1, const float* __restrict__ X2, const float* __restrict__ g2, unsigned* bad, LAS float* wL, int tid) {
    if (tid < 128) { const int id = IDS[(size_t)row * 128 + tid]; const float* up = Uf + ((size_t)l * NEXP + id) * D; const bf16* hp = H + (size_t)row * D;
        float s = 0.f; for (int d = 0; d < D; ++d) s += up[d] * bf1(hp[d]);
        wL[tid] = GG[(size_t)row * 128 + tid] * gelu_tanh(s); }
    __syncthreads();
    unsigned mybad = 0;
    for (int d = tid; d < D; d += 512) { float y = 0.f;
        for (int e = 0; e < 128; ++e) { const int id = IDS[(size_t)row * 128 + e]; y += wL[e] * Vf[((size_t)l * NEXP + id) * D + d]; }
        const float want = X1[(size_t)row * D + d] + g2[d] * y * (MK_CHECK == 3 ? 1.5f : 1.f); const float got = X2[(size_t)row * D + d];
        if (!(fabsf(got - want) <= 0.02f * fabsf(want) + 0.02f)) mybad = 1; }
    if (mybad) atomicAdd(bad, 1u);
    __syncthreads();
}

DEV void chk_hq(int l, int row, const float* __restrict__ X1, const float* __restrict__ gain, const float* __restrict__ modl, const float* __restrict__ wq, const bf16* __restrict__ H, const bf16* __restrict__ Q,
                unsigned* bad, LAS float* hL, LAS float* redL, int tid) {
    const int b = row >> 12;
    float ss = 0.f;
    for (int d = tid; d < D; d += 512) { const float v = X1[(size_t)row * D + d]; ss += v * v; }
    ss = wave_sum(ss);
    if ((tid & 63) == 0) redL[tid >> 6] = ss;
    __syncthreads();
    float tot = 0.f; for (int w = 0; w < 8; ++w) tot += redL[w];
    const float r = rsqrtf(tot * (1.f / D) + EPS);
    unsigned badh = 0, badq = 0;
    for (int d = tid; d < D; d += 512) { const float hv = X1[(size_t)row * D + d] * r * gain[d] * (1.f + modl[(size_t)b * MODW + MO_SC2 + d]) + modl[(size_t)b * MODW + MO_SH2 + d];
        hL[d] = hv; const float got = bf1(H[(size_t)row * D + d]); if (!(fabsf(got - hv) <= 0.01f * fabsf(hv) + 0.01f)) badh = 1; }
    __syncthreads();
    for (int c = tid; c < D; c += 512) { float q = 0.f; for (int k = 0; k < D; ++k) q += hL[k] * wq[(size_t)k * D + c];
        const float got = bf1(Q[(size_t)row * D + c]); if (!(fabsf(got - q) <= 0.02f * fabsf(q) + 0.03f)) badq = 1; }
    if (badh) atomicAdd(bad, 1u);
    if (badq) atomicAdd(bad + 1, 1u);
    __syncthreads();
}
#endif
struct Args { const float* in[24]; float* out; unsigned char* ws; int ph_lo, ph_hi, li, pad; };

__global__ void __launch_bounds__(512, 2) fwd(Args a) {
    extern __shared__ __attribute__((aligned(16))) unsigned char lds_raw[];
    LAS unsigned char* lds = (LAS unsigned char*)lds_raw;
    const int wave = __builtin_amdgcn_readfirstlane((int)threadIdx.x >> 6);
    const int G = gridDim.x; const int bx = blockIdx.x;
#define PHASE_TID() int tid = threadIdx.x; asm volatile("" : "+v"(tid)); const int lane = tid & 63; (void)lane; \
    const __attribute__((address_space(4))) Args* A = (const __attribute__((address_space(4))) Args*)__builtin_amdgcn_kernarg_segment_ptr(); asm volatile("" : "+s"(A))
    const int vcu = (G % 8 == 0) ? (bx % 8) * (G / 8) + bx / 8 : bx;
    const int gw = vcu * 8 + wave, NGW = G * 8;
    unsigned* ctl = (unsigned*)(a.ws + WS_CTL);
    const int lo = a.ph_lo, hi = a.ph_hi;
    for (int u = threadIdx.x; u < (LDS_BYTES - LDS_MISC) / 4; u += 512) ((LAS unsigned*)(lds + LDS_MISC))[u] = 0u;
    __syncthreads();
    XcdBarrier bar; bar.bar = ctl + CW_BAR + (a.li & 7) * XCD_BAR_WORDS; bar.x = 0; bar.st = (volatile LAS unsigned*)(lds + LDS_MISC + 64);
    if (hi - lo > 1) bar = xcd_barrier_post(ctl + CW_BAR + (a.li & 7) * XCD_BAR_WORDS, (volatile LAS unsigned*)(lds + LDS_MISC + 64));
#ifndef MK_MASK
#define MK_MASK 0x3ff
#endif
#define KON(q) (((MK_MASK) >> (q)) & 1)
#define IN(k) (lo <= (k) && (k) < hi)
#define SEAM(k) do { if (IN(k) && IN((k) + 1)) xcd_barrier(bar); } while (0)

#define mod   ((float*)(A->ws + WS_MOD))
#define WIN_T ((bf16*)(A->ws + WS_WIN_T))
#define WOUT_T ((bf16*)(A->ws + WS_WOUT_T))
#define WQ_T  ((bf16*)(A->ws + WS_WQ_T))
#define SUBK  ((bf16*)(A->ws + WS_SUBK))
#define UB    ((bf16*)(A->ws + WS_U))
#define VB    ((bf16*)(A->ws + WS_V))
#define H     ((bf16*)(A->ws + WS_H))
#define Z     ((bf16*)(A->ws + WS_Z))
#define HLOC  ((float*)(A->ws + WS_HLOC))
#define PP    ((float*)(A->ws + WS_P))
#define YB    ((float*)(A->ws + WS_YB))
#define YC    ((float*)(A->ws + WS_YC))
#define SUMA  ((float*)(A->ws + WS_SUMA))
#define SUMB  ((float*)(A->ws + WS_SUMB))
#define X1    ((float*)(A->ws + WS_X1))
#define X2    ((float*)(A->ws + WS_X2))
#define QB    ((bf16*)(A->ws + WS_Q))
#define IDS   ((int*)(A->ws + WS_IDS))
#define GG    ((float*)(A->ws + WS_G))
#define PARTB ((float*)(A->ws + WS_PART))
#define LSEB  ((float*)(A->ws + WS_LSE))
#define XIN   ((l == 0) ? A->in[0] : (const float*)X2)
#define MODL  (mod + (size_t)l * 2 * MODW)
    if (KON(0) && IN(0)) {
        PHASE_TID();
        ph_mod(A->in[1], A->in[2], A->in[3], mod, (LAS float*)lds, vcu, G, tid);
        {
            LAS float* scr = (LAS float*)(lds + wave * 16384);
            constexpr int I_IN = (D / 64) * (IN_W / 32), I_SQ = (D / 64) * (D / 32), I_L = I_IN + 2 * I_SQ;
            for (int it = gw; it < 2 * I_L; it += NGW) {
                const int l = it / I_L; int r = it % I_L;
                if (r < I_IN) { transpose_item(A->in[6] + (size_t)l * D * IN_W, D, IN_W, WIN_T + (size_t)l * IN_W * D, scr, r, lane); continue; } r -= I_IN;
                if (r < I_SQ) { transpose_item(A->in[18] + (size_t)l * D * D, D, D, WOUT_T + (size_t)l * D * D, scr, r, lane); continue; } r -= I_SQ;
                transpose_item(A->in[19] + (size_t)l * D * D, D, D, WQ_T + (size_t)l * D * D, scr, r, lane);
            }
        }
        const size_t gtid = (size_t)vcu * 512 + tid, gstride = (size_t)G * 512;
        convert_copy(A->in[20], SUBK, (size_t)2 * 8 * 2 * 128 * 128 / 8, gtid, gstride);
        convert_copy(A->in[21], UB, (size_t)NL * NEXP * D / 8, gtid, gstride);
        convert_copy(A->in[22], VB, (size_t)NL * NEXP * D / 8, gtid, gstride);
    }
    SEAM(0);

    for (int l = 0; l < NL; ++l) {
        const int pb = 1 + 9 * l;
        if (KON(1) && IN(pb + 0)) { PHASE_TID(); modnorm_rows(XIN, A->in[4] + l * D, MODL, MO_SH1, MO_SC1, H, gw, NGW, lane); }
        SEAM(pb + 0);
        if (KON(2) && IN(pb + 1)) {
            PHASE_TID(); (void)tid;
            pg8::Gemm g{H, WIN_T + (size_t)l * IN_W * D, M, IN_W, D}; pg8::StaticOrder S; S.init(M, IN_W, G, bx);
            pg8::EpiBf16<0> E{Z, IN_W, nullptr, 0, 0};
            pg8::gemm_phase<pg8::EpiBf16<0>, pg8::StaticOrder, false>((PG8_LAS unsigned char*)lds, g, S, E, nullptr);
        }
        SEAM(pb + 1);
        if (KON(3) && IN(pb + 2)) {
            PHASE_TID();
            for (int it = vcu; it < 2 * 64 * 6; it += G) {
                const int b = it / 384, r = it % 384, j = r / 6, n = r % 6;
                lru_item(l, b, j, n, Z, A->in[7], A->in[8], A->in[9], A->in[10], A->in[11], A->in[12], A->in[13], HLOC, PP, SUMA, SUMB,
                         (LAS float*)lds, (LAS float*)(lds + 32768), (LAS float*)(lds + 65536), tid);
            }
            {
                LAS float* qs = (LAS float*)(lds + wave * 16384 + 12288); LAS float* lgp = qs + 128;
                {
                    LAS unsigned char* wl = lds + wave * 16384;
                    for (int it = gw; it < 2 * 6 * 3 * 128; it += NGW) { const int tl = it & 127, p = (it >> 7) % 3, bh = it / 384; const int d = 1 << (2 * p);
                        dil_mfma_item(bh / 6, bh % 6, p, tl % d, 32 * (tl / d), Z, A->in[14], PARTB, LSEB, wl, lane); }
                }
                for (int it = gw; it < 2 * 4 * SEQ; it += NGW) { const int bh = it >> 12, r = it & 4095; const int t = (bh & 1) ? 4095 - r : r; sb_item(bh >> 2, bh & 3, t, Z, YC, qs, lgp, lane); }
            }
        }
        SEAM(pb + 2);
        if (KON(4) && IN(pb + 3)) {
            PHASE_TID();
            for (int it = vcu; it < 256; it += G) { const int b = it >> 7, j = (it >> 1) & 63, half = it & 1;
                combine_item(l, b, j, half, Z, HLOC, PP, SUMA, SUMB, PARTB, LSEB, YC, A->in[15], A->in[16], A->in[17], H, (LAS float*)lds, tid); }
        }
        SEAM(pb + 3);
        if (KON(5) && IN(pb + 4)) {
            PHASE_TID(); (void)tid;
            pg8::Gemm g{H, WOUT_T + (size_t)l * D * D, M, D, D}; pg8::StaticOrder S; S.init(M, D, G, bx);
            EpiResGate E{XIN, X1, MODL + MO_G1, ((MK_DBG >> (2 * l)) & 1) ? 0.f : ((MK_DBG & 256) ? -1.f : 1.f)};
            pg8::gemm_phase<EpiResGate, pg8::StaticOrder, false>((PG8_LAS unsigned char*)lds, g, S, E, nullptr);
        }
        SEAM(pb + 4);
        if (KON(6) && IN(pb + 5)) { PHASE_TID(); modnorm_rows(X1, A->in[5] + l * D, MODL, MO_SH2, MO_SC2, H, gw, NGW, lane); }
        SEAM(pb + 5);
        if (KON(7) && IN(pb + 6)) {
            PHASE_TID(); (void)tid;
            pg8::Gemm g{H, WQ_T + (size_t)l * D * D, M, D, D}; pg8::StaticOrder S; S.init(M, D, G, bx);
            pg8::EpiBf16<0> E{QB, D, nullptr, 0, 0};
            pg8::gemm_phase<pg8::EpiBf16<0>, pg8::StaticOrder, false>((PG8_LAS unsigned char*)lds, g, S, E, nullptr);
        }
        SEAM(pb + 6);
        if (KON(8) && IN(pb + 7)) {
            PHASE_TID();
            for (int it = vcu; it < 256 * 8; it += G) route_item(l, it >> 3, it & 7, QB, SUBK, IDS, GG, lds, tid, (unsigned*)(A->ws + WS_CTL) + 8);
        }
        SEAM(pb + 7);
        if (KON(9) && IN(pb + 8)) {
            PHASE_TID();
            for (int m = gw; m < M; m += NGW)
                expert_row(l, m, H, IDS, GG, UB, VB, X1, MODL + (size_t)(m >> 12) * MODW + MO_G2, (l == NL - 1) ? A->in[23] : nullptr, (l == NL - 1) ? A->out : X2, lane, ((MK_DBG >> (2 * l + 1)) & 1) ? 0.f : ((MK_DBG & 128) ? -1.f : 1.f), (float*)(A->ws + WS_CTL) + 16);
        }
        if (l + 1 < NL) SEAM(pb + 8);
    }
#if MK_CHECK
    if (IN(19)) {
        PHASE_TID();
        unsigned* badw = (unsigned*)(A->ws + WS_CTL) + 8;
#if MK_CHECK == 1 || MK_CHECK == 3 || MK_CHECK == 4
        for (int it = vcu; it < (MK_CHECK == 4 ? 8192 : 256) * 8; it += G) { const int row = (MK_CHECK == 4) ? (it >> 3) : (((it >> 3) * 131 + 7) & 8191); chk_route(0, row, it & 7, QB, SUBK, IDS, GG, badw, (LAS float*)lds, (LAS unsigned*)(lds + 2048), tid); }
        for (int it = vcu; it < (MK_CHECK == 4 ? 8192 : 256); it += G) { const int row = (MK_CHECK == 4) ? it : ((it * 131 + 7) & 8191); chk_expert(0, row, H, IDS, GG, A->in[21], A->in[22], X1, X2, mod + (size_t)(row >> 12) * MODW + MO_G2, badw + 1, (LAS float*)lds, tid); }
#elif MK_CHECK == 12 || MK_CHECK == 15
        { (void)badw;
          for (int m = gw; m < M; m += NGW) { const int ia = IDS[(size_t)m * 128 + lane], ib = IDS[(size_t)m * 128 + 64 + lane]; int cnt = 0;
              for (int e = 0; e < 128; ++e) { const int ie = (e < 64) ? __shfl(ia, e) : __shfl(ib, e - 64); if (lane < e && ia == ie && (MK_CHECK == 12 || (lane >> 4) == (e >> 4))) ++cnt; if (lane + 64 < e && ib == ie && (MK_CHECK == 12 || ((lane + 64) >> 4) == (e >> 4))) ++cnt; }
              float fc = wave_sum((float)cnt); if (lane == 0) atomicAdd((float*)(A->ws + WS_CTL) + 16, fc * 2048.f); } }
#elif MK_CHECK == 13 || MK_CHECK == 14
        { (void)badw;
          float cnt = 0.f;
          if (MK_CHECK == 13) { const float* sk = A->in[20]; for (int o = vcu * 512 + tid; o < 2 * 128 * 128; o += G * 512) if (sk[o] == sk[o + 2 * 128 * 128]) cnt += 1.f; cnt *= (float)M * D / (2.f * 128 * 128); }
          else { const float* wq = A->in[19]; for (int o = vcu * 512 + tid; o < D * 256; o += G * 512) { const int k = o >> 8, c = o & 255; if (wq[(size_t)k * D + c] == wq[(size_t)k * D + 256 + c]) cnt += 1.f; } cnt *= (float)M * D / ((float)D * 256); }
          cnt = wave_sum(cnt); if (lane == 0) atomicAdd((float*)(A->ws + WS_CTL) + 16, cnt); }
#elif MK_CHECK == 10
        { (void)badw; float acc = 0.f; const float* vt = A->in[22];
          for (size_t o = (size_t)vcu * 512 + tid; o < (size_t)NEXP * D; o += (size_t)G * 512) { const float v = vt[o]; acc += v * v; }
          acc = wave_sum(acc); if (lane == 0) atomicAdd((float*)(A->ws + WS_CTL) + 16, acc * ((float)M * D / ((float)NEXP * D))); }
#elif MK_CHECK == 16
        (void)badw;
#elif MK_CHECK >= 6
        (void)badw;
#elif MK_CHECK == 5
        {
            const float* cc = A->in[1]; const float* wm = A->in[2]; const float* bm = A->in[3];
            unsigned mb = 0;
            for (int o = vcu * 512 + tid; o < 2 * 2 * MODW; o += G * 512) { const int l = o / (2 * MODW), b = (o / MODW) & 1, n = o % MODW;
                float sacc = 0.f; for (int k = 0; k < D; ++k) { const float cv = cc[b * D + k]; sacc += (cv / (1.f + __expf(-cv))) * wm[((size_t)l * D + k) * MODW + n]; }
                sacc += bm[l * MODW + n];
                if (!(fabsf(sacc - mod[o]) <= 2e-3f * fabsf(sacc) + 2e-3f)) mb = 1; }
            if (mb) atomicAdd(badw, 1u);
            unsigned sb = 0;
            for (int o = vcu * 512 + tid; o < 2 * 8 * 2 * 128 * 128; o += G * 512) { const float want = A->in[20][o]; const float got = bf1(SUBK[o]); if (!(fabsf(got - want) <= 0.01f * fabsf(want) + 1e-6f)) sb = 1; }
            if (sb) atomicAdd(badw + 1, 1u);
        }
#else
        for (int it = vcu; it < 256; it += G) { const int row = (it * 131 + 7) & 8191; chk_hq(0, row, X1, A->in[5], mod, A->in[19], H, QB, badw, (LAS float*)lds, (LAS float*)(lds + 16384), tid); }
#endif
    }
    if (IN(20)) {
        PHASE_TID();
        const unsigned* badw = (const unsigned*)(A->ws + WS_CTL) + 8;
        const unsigned b0 = __hip_atomic_load(badw, __ATOMIC_RELAXED, __HIP_MEMORY_SCOPE_AGENT), b1 = __hip_atomic_load(badw + 1, __ATOMIC_RELAXED, __HIP_MEMORY_SCOPE_AGENT);
#if MK_CHECK >= 6 && MK_CHECK != 16
        const float f = 1.f + ((const float*)(A->ws + WS_CTL))[16] * (1.f / ((float)M * D)); (void)b0; (void)b1;
#else
        const float f = (b0 ? (b1 ? -2.f : 0.f) : (b1 ? -1.f : 1.f));
#endif
        for (int m = gw; m < M; m += NGW) { const f32x4* xr = (const f32x4*)(X2 + (size_t)m * D) + lane; f32x4 v[8]; float ss = 0.f;
#pragma unroll
            for (int j = 0; j < 8; ++j) { v[j] = xr[64 * j]; ss += (v[j].x * v[j].x + v[j].y * v[j].y) + (v[j].z * v[j].z + v[j].w * v[j].w); }
            const float r = rsqrtf(wave_sum(ss) * (1.f / D) + EPS) * f;
#pragma unroll
            for (int j = 0; j < 8; ++j) { const f32x4 fn = ((const f32x4*)A->in[23])[lane + 64 * j]; ((f32x4*)(A->out + (size_t)m * D))[lane + 64 * j] = v[j] * r * fn; } }
    }
#endif
#undef IN
#undef SEAM
#undef mod
#undef H
#undef Z
#undef X1
#undef X2
}
}

extern "C" void kernel_launch(void* const* d_in, const int* in_sizes, int n_in, void* d_out, int out_size, void* d_ws, size_t ws_size, hipStream_t stream) {
    using namespace mk;
    static int grid = 0;
    if (grid == 0) {
        if (n_in != 24 || out_size != M * D || ws_size < WS_END) { fprintf(stderr, "kernel_launch: unexpected shapes (n_in %d out %d ws %zu)\n", n_in, out_size, ws_size); grid = -1; return; }
        int dev = 0, cus = 0, per_cu = 0;
        if (hipGetDevice(&dev) != hipSuccess || hipDeviceGetAttribute(&cus, hipDeviceAttributeMultiprocessorCount, dev) != hipSuccess) { grid = -1; return; }
        if (hipFuncSetAttribute((const void*)fwd, hipFuncAttributeMaxDynamicSharedMemorySize, LDS_BYTES) != hipSuccess) { fprintf(stderr, "kernel_launch: hipFuncSetAttribute failed\n"); grid = -1; return; }
        if (hipOccupancyMaxActiveBlocksPerMultiprocessor(&per_cu, (const void*)fwd, 512, LDS_BYTES) != hipSuccess || per_cu < 1) fprintf(stderr, "kernel_launch: occupancy query says %d\n", per_cu);
        (void)hipGetLastError();
        grid = cus;
    }
    if (grid < 0) return;
    (void)hipMemsetAsync((char*)d_ws + WS_CTL, 0, CTL_ZERO_BYTES, stream);
    Args a{};
    for (int i = 0; i < 24; ++i) a.in[i] = (const float*)d_in[i];
    a.out = (float*)d_out; a.ws = (unsigned char*)d_ws; a.pad = 0;
#if MK_CHECK
    constexpr int NLAUNCH = 12;
#else
    constexpr int NLAUNCH = MK_N_LAUNCHES;
#endif
    for (int li = 0; li < NLAUNCH; ++li) {
        a.ph_lo = (NLAUNCH == 1) ? 0 : li; a.ph_hi = (NLAUNCH == 1) ? NPHASE : li + 1; a.li = li;
#if MK_CHECK
        if (li >= 10) { a.ph_lo = li + 9; a.ph_hi = li + 10; }
#endif
        hipLaunchKernelGGL(fwd, dim3(grid), dim3(512), LDS_BYTES, stream, a);
    }
}
```

```cpp
#include <hip/hip_runtime.h>
#include <cstdio>
#include <cstdint>
#define MK_DBG 0
#define MK_N_LAUNCHES 1
#define MK_CHECK 0
namespace pg8 {
#define PG8_LAS __attribute__((address_space(3)))
typedef unsigned short bf16_t;
typedef short bf16x8 __attribute__((ext_vector_type(8)));
typedef float f32x4 __attribute__((ext_vector_type(4)));
typedef unsigned u32x4 __attribute__((ext_vector_type(4)));
constexpr int BM = 256, BK = 64, HALF = 128, HTB = HALF * BK * 2  , STAGE_BYTES = 8 * HTB, NXCD = 8, WGM = 8;

__host__ __device__ __forceinline__ int lds_byte(int r, int c) { const int st = (r >> 4) * 2 + (c >> 5), rr = r & 15, cc = c & 31, ob = rr * 64 + cc * 2; return st * 1024 + (ob ^ (((ob >> 9) & 1) << 5)); }
__host__ __device__ __forceinline__ void stage_rc(int b, int& R, int& C) { const int st = b / 1024, sb = b % 1024, swz = sb ^ (((sb >> 9) & 1) << 5); R = (st >> 1) * 16 + swz / 64; C = (st & 1) * 32 + (swz % 64) / 2; }
__host__ __device__ __forceinline__ int perm32(int rho) { const int n = rho >> 4, i = rho & 15; return 8 * (i >> 2) + 4 * n + (i & 3); }

struct Unit { int pm, pn; };
struct Gemm { const bf16_t* A; const bf16_t* Bt; int M, N, K; };

struct StaticOrder {
    int nM, nN, nwg, G, c;
    __host__ __device__ void init(int M, int N, int G_, int c_) { nM = M / BM; nN = N / BM; nwg = nM * nN; G = G_; c = c_; }
    __host__ __device__ bool next(int i, Unit& u) const {
        const long L = (long)i * G + c; if (L >= nwg) return false;
        int wgid = (int)L; { const int q = nwg / NXCD, r = nwg % NXCD, xcd = wgid % NXCD, off = wgid / NXCD; wgid = (xcd < r ? xcd * (q + 1) : r * (q + 1) + (xcd - r) * q) + off; }
        const int nig = WGM * nN, gid = wgid / nig, fm = gid * WGM, gsz = (nM - fm) < WGM ? (nM - fm) : WGM;
        u.pm = fm + ((wgid % nig) % gsz); u.pn = (wgid % nig) / gsz; return true;
    }
    __device__ __forceinline__ void a_ready(const Unit&) const {}
    __device__ __forceinline__ void done(const Unit&) const {}
};
struct CountedOrder : StaticOrder {
    const unsigned* ready; unsigned need; unsigned* tmo;
    __device__ __forceinline__ void a_ready(const Unit& u) const {
        if (threadIdx.x < 64) {
            const unsigned long long t0 = __builtin_amdgcn_s_memrealtime(); unsigned polls = 0;
            while ((unsigned)__builtin_amdgcn_readfirstlane(__hip_atomic_load(ready + 64 * u.pm, __ATOMIC_RELAXED, __HIP_MEMORY_SCOPE_AGENT)) < need) {
                if ((++polls & 255u) == 0u && __builtin_amdgcn_readfirstlane(__hip_atomic_load(tmo, __ATOMIC_RELAXED, __HIP_MEMORY_SCOPE_AGENT)) != 0u) break;
                if (__builtin_amdgcn_s_memrealtime() - t0 > 2000000ull) {
                    if (threadIdx.x == 0) { unsigned expect = 0u; __hip_atomic_compare_exchange_strong(tmo + 1, &expect, 0x600u | (unsigned)(u.pm & 0xff), __ATOMIC_RELAXED, __ATOMIC_RELAXED, __HIP_MEMORY_SCOPE_AGENT); __hip_atomic_store(tmo, 1u, __ATOMIC_RELAXED, __HIP_MEMORY_SCOPE_AGENT); }
                    break; }
                __builtin_amdgcn_s_sleep(2); }
            __builtin_amdgcn_fence(__ATOMIC_ACQUIRE, "agent");
            asm volatile("s_waitcnt vmcnt(0)" ::: "memory");
        }
#if !defined(BROKEN_HOOK_NO_BARRIER)
        asm volatile("" ::: "memory"); __builtin_amdgcn_s_barrier(); asm volatile("" ::: "memory");
#endif
    }
};

__device__ __forceinline__ unsigned cvt_pk_bf16(float lo, float hi) { unsigned r; asm volatile("v_cvt_pk_bf16_f32 %0, %1, %2" : "=v"(r) : "v"(lo), "v"(hi)); return r; }
typedef float f32x2 __attribute__((ext_vector_type(2)));
__device__ __forceinline__ f32x2 gelu_pk(f32x2 v) {
    const f32x2 av = __builtin_elementwise_abs(v), d = av * 0.2316418882f + 1.0f;
    f32x2 t; t.x = __builtin_amdgcn_rcpf(d.x); t.y = __builtin_amdgcn_rcpf(d.y);
    f32x2 q = t * 0.5307027145f + (-0.7265760135f); q = q * t + 0.7107068705f; q = q * t + (-0.142248368f); q = q * t + 0.127414796f; q = q * t;
    const f32x2 s = (v * v) * (-0.72134752044f);
    f32x2 e; e.x = __builtin_amdgcn_exp2f(s.x); e.y = __builtin_amdgcn_exp2f(s.y);
    const f32x2 m = v * (q * e), r = v - m;
    f32x2 o; o.x = v.x < 0.f ? m.x : r.x; o.y = v.y < 0.f ? m.y : r.y; return o;
}

struct EpiF32 {
    static constexpr bool PERM = false, AFTER_DRAIN = false;
    float* C; int ldc; const float* bias;
    __device__ __forceinline__ void operator()(const f32x4 (&acc)[2][2][4][2], const Unit& u, int wr, int wc, int fr, int fq) const {
        const int row0 = u.pm * BM + wr * 64 + fr, col0 = u.pn * BM + wc * 32 + 4 * fq;
        f32x4 bv[2][2];
#pragma unroll
        for (int bj = 0; bj < 2; ++bj)
#pragma unroll
            for (int n = 0; n < 2; ++n) bv[bj][n] = bias ? *(const f32x4*)(bias + col0 + bj * HALF + n * 16) : (f32x4){0.f, 0.f, 0.f, 0.f};
#pragma unroll
        for (int ai = 0; ai < 2; ++ai)
#pragma unroll
            for (int m = 0; m < 4; ++m) { float* rowp = C + (size_t)(row0 + ai * HALF + m * 16) * ldc + col0;
#pragma unroll
                for (int bj = 0; bj < 2; ++bj)
#pragma unroll
                    for (int n = 0; n < 2; ++n) *(f32x4*)(rowp + bj * HALF + n * 16) = acc[ai][bj][m][n] + bv[bj][n]; }
    }
};
template <int ACT  > struct EpiBf16 {
    static constexpr bool PERM = true, AFTER_DRAIN = false;
    bf16_t* O; int ldc; const float* bias; int split_cols; size_t split_stride;
    __device__ __forceinline__ void operator()(const f32x4 (&acc)[2][2][4][2], const Unit& u, int wr, int wc, int fr, int fq) const {
        const int row0 = u.pm * BM + wr * 64 + fr; int colt = u.pn * BM; bf16_t* base = O;
        if (split_cols) { const int t = colt / split_cols; base += (size_t)t * split_stride; colt -= t * split_cols; }
        const int col0 = colt + wc * 32 + 8 * fq, bcol0 = u.pn * BM + wc * 32 + 8 * fq;
        f32x4 bv[2][2];
#pragma unroll
        for (int bj = 0; bj < 2; ++bj)
#pragma unroll
            for (int n = 0; n < 2; ++n) bv[bj][n] = bias ? *(const f32x4*)(bias + bcol0 + bj * HALF + 4 * n) : (f32x4){0.f, 0.f, 0.f, 0.f};
#pragma unroll
        for (int ai = 0; ai < 2; ++ai)
#pragma unroll
            for (int m = 0; m < 4; ++m) { bf16_t* rowp = base + (size_t)(row0 + ai * HALF + m * 16) * ldc + col0;
#pragma unroll
                for (int bj = 0; bj < 2; ++bj) { f32x4 v0 = acc[ai][bj][m][0] + bv[bj][0], v1 = acc[ai][bj][m][1] + bv[bj][1];
                    if (ACT == 1) { f32x2 a = gelu_pk((f32x2){v0[0], v0[1]}), b = gelu_pk((f32x2){v0[2], v0[3]}), c = gelu_pk((f32x2){v1[0], v1[1]}), d = gelu_pk((f32x2){v1[2], v1[3]});
                        v0 = (f32x4){a.x, a.y, b.x, b.y}; v1 = (f32x4){c.x, c.y, d.x, d.y}; }
                    if (ACT == 2) {
#pragma unroll
                        for (int j = 0; j < 4; ++j) { v0[j] = 0.5f * v0[j] * (1.0f + erff(v0[j] * 0.70710678f)); v1[j] = 0.5f * v1[j] * (1.0f + erff(v1[j] * 0.70710678f)); } }
                    u32x4 w; w.x = cvt_pk_bf16(v0[0], v0[1]); w.y = cvt_pk_bf16(v0[2], v0[3]); w.z = cvt_pk_bf16(v1[0], v1[1]); w.w = cvt_pk_bf16(v1[2], v1[3]);
                    *(u32x4*)(rowp + bj * HALF) = w; } }
    }
};
template <class Epi, class Sched, bool STAMP = false>
__device__ __forceinline__ void gemm_phase(PG8_LAS unsigned char* lds, const Gemm g, const Sched& S, const Epi& E, unsigned long long* stamps) {
    const int tid = threadIdx.x, wid = __builtin_amdgcn_readfirstlane(tid >> 6), lane = tid & 63, wr = wid >> 2, wc = wid & 3, fr = lane & 15, fq = lane >> 4;
    constexpr int K = 2048, nt = K / BK;
    int ts_lo = 0, ts_hi = 0, nts = 0; const unsigned long long rt_entry = STAMP ? (unsigned long long)wall_clock64() : 0ull;
#define PG8_STAMP() do { if (STAMP && wid == 0 && nts < 64) { const unsigned long long _c = (unsigned long long)clock64(); \
        ts_lo = (lane == nts) ? (int)(unsigned)_c : ts_lo; ts_hi = (lane == nts) ? (int)(unsigned)(_c >> 32) : ts_hi; ++nts; } } while (0)
    PG8_STAMP();
    unsigned voffA[2], voffB[2];
#pragma unroll
    for (int i = 0; i < 2; ++i) { int R, C; stage_rc(tid * 16 + i * 8192, R, C); const int Rb = Epi::PERM ? ((R & ~31) + perm32(R & 31)) : R;
        voffA[i] = (unsigned)(R * K + C) * 2u; voffB[i] = (unsigned)(Rb * K + C) * 2u; }
    const size_t kstep = (size_t)(BK * 2);
    const size_t hstep = (size_t)HALF * K * 2;
    const size_t tstep = 2 * hstep;
    const unsigned ldsw = (unsigned)wid * 1024u;
    const int aoff = lds_byte(wr * 64 + fr, fq * 8), boff = lds_byte(wc * 32 + fr, fq * 8);
#define PG8_SA(b, h) (((b) * 2 + (h)) * HTB)
#define PG8_SB(b, h) ((4 + (b) * 2 + (h)) * HTB)
#define PG8_STAGE(bufoff, gbase, voff) do { _Pragma("unroll") for (int _i = 0; _i < 2; ++_i) \
        __builtin_amdgcn_global_load_lds((const unsigned*)((const char*)(gbase) + (voff)[_i]), (PG8_LAS unsigned*)(lds + (bufoff) + ldsw + _i * 8192), 16, 0, 0); } while (0)
#define PG8_LDA(dst, b, h) do { _Pragma("unroll") for (int m = 0; m < 4; ++m) _Pragma("unroll") for (int k = 0; k < 2; ++k) dst[m][k] = *(const PG8_LAS bf16x8*)(lds + PG8_SA(b, h) + aoff + m * 2048 + k * 1024); } while (0)
#define PG8_LDB(dst, b, h) do { _Pragma("unroll") for (int n = 0; n < 2; ++n) _Pragma("unroll") for (int k = 0; k < 2; ++k) dst[n][k] = *(const PG8_LAS bf16x8*)(lds + PG8_SB(b, h) + boff + n * 2048 + k * 1024); } while (0)
#define PG8_MMA(ai, bj, At, Bt) do { __builtin_amdgcn_s_setprio(1); _Pragma("unroll") for (int m = 0; m < 4; ++m) _Pragma("unroll") for (int n = 0; n < 2; ++n) _Pragma("unroll") for (int k = 0; k < 2; ++k) \
        acc[ai][bj][m][n] = __builtin_amdgcn_mfma_f32_16x16x32_bf16(Bt[n][k], At[m][k], acc[ai][bj][m][n], 0, 0, 0); __builtin_amdgcn_s_setprio(0); } while (0)
#define PG8_WAIT_V(n) asm volatile("s_waitcnt vmcnt(" #n ")" ::: "memory")
#define PG8_WAIT_L(n) asm volatile("s_waitcnt lgkmcnt(" #n ")" ::: "memory")
#define PG8_BAR __builtin_amdgcn_s_barrier()
#define PG8_SCHED __builtin_amdgcn_sched_barrier(0)
    Unit cur, nxt; int ui = 0;
    if (!S.next(0, cur)) return;
    f32x4 acc[2][2][4][2];
#pragma unroll
    for (int a = 0; a < 2; ++a)
#pragma unroll
        for (int b = 0; b < 2; ++b)
#pragma unroll
            for (int m = 0; m < 4; ++m)
#pragma unroll
                for (int n = 0; n < 2; ++n) acc[a][b][m][n] = (f32x4){0.f, 0.f, 0.f, 0.f};
    bf16x8 At[4][2], B0[2][2], B1[2][2];
    const char* cA = (const char*)g.A + (size_t)cur.pm * tstep; const char* cB = (const char*)g.Bt + (size_t)cur.pn * tstep;
    S.a_ready(cur);
    PG8_STAGE(PG8_SB(0, 0), cB, voffB); PG8_STAGE(PG8_SA(0, 0), cA, voffA); PG8_STAGE(PG8_SB(0, 1), cB + hstep, voffB); PG8_STAGE(PG8_SA(0, 1), cA + hstep, voffA);
    if (wr == 1) PG8_BAR;
    PG8_WAIT_V(4); PG8_BAR;
    PG8_STAGE(PG8_SB(1, 0), cB + kstep, voffB); PG8_STAGE(PG8_SA(1, 0), cA + kstep, voffA); PG8_STAGE(PG8_SB(1, 1), cB + hstep + kstep, voffB);
    PG8_WAIT_V(6); PG8_BAR;
    PG8_STAMP();
    for (;;) {
        const bool has_next = S.next(ui + 1, nxt);
        const char* nA = has_next ? (const char*)g.A + (size_t)nxt.pm * tstep : cA; const char* nB = has_next ? (const char*)g.Bt + (size_t)nxt.pn * tstep : cB;
        for (int t = 0; t < nt; t += 2) {
            const bool last = (t == nt - 2);
            const char* a1 = cA + (size_t)(t + 1) * kstep;
            const char* a2 = last ? nA : cA + (size_t)(t + 2) * kstep; const char* b2 = last ? nB : cB + (size_t)(t + 2) * kstep;
            const char* a3 = a2 + kstep; const char* b3 = b2 + kstep;
            if (last && has_next) S.a_ready(nxt);
            PG8_LDB(B0, 0, 0); PG8_SCHED; PG8_LDA(At, 0, 0); PG8_STAGE(PG8_SA(1, 1), a1 + hstep, voffA);
            PG8_WAIT_L(8); PG8_BAR; PG8_WAIT_L(0); PG8_MMA(0, 0, At, B0); PG8_BAR; PG8_SCHED;
            PG8_LDB(B1, 0, 1); PG8_STAGE(PG8_SB(0, 0), b2, voffB);
            PG8_BAR; PG8_WAIT_L(0); PG8_MMA(0, 1, At, B1); PG8_BAR;
            PG8_LDA(At, 0, 1); PG8_STAGE(PG8_SA(0, 0), a2, voffA);
            PG8_BAR; PG8_WAIT_L(0); PG8_MMA(1, 0, At, B0); PG8_BAR; PG8_SCHED;
            PG8_STAGE(PG8_SB(0, 1), b2 + hstep, voffB);
            PG8_WAIT_V(6); PG8_BAR; PG8_MMA(1, 1, At, B1); PG8_BAR;
            PG8_LDB(B0, 1, 0); PG8_SCHED; PG8_LDA(At, 1, 0); PG8_STAGE(PG8_SA(0, 1), a2 + hstep, voffA);
            PG8_WAIT_L(8); PG8_BAR; PG8_WAIT_L(0); PG8_MMA(0, 0, At, B0); PG8_BAR; PG8_SCHED;
            PG8_LDB(B1, 1, 1); PG8_STAGE(PG8_SB(1, 0), b3, voffB);
            PG8_BAR; PG8_WAIT_L(0); PG8_MMA(0, 1, At, B1); PG8_BAR;
            PG8_LDA(At, 1, 1); PG8_STAGE(PG8_SA(1, 0), a3, voffA);
            PG8_BAR; PG8_WAIT_L(0); PG8_MMA(1, 0, At, B0); PG8_BAR; PG8_SCHED;
            PG8_STAGE(PG8_SB(1, 1), b3 + hstep, voffB);
            PG8_WAIT_V(6); PG8_BAR; PG8_MMA(1, 1, At, B1); PG8_BAR;
        }
        PG8_STAMP();
        if constexpr (!Epi::AFTER_DRAIN) { E(acc, cur, wr, wc, fr, fq); S.done(cur); }
        PG8_STAMP();
        if (!has_next) break;
#pragma unroll
        for (int a = 0; a < 2; ++a)
#pragma unroll
            for (int b = 0; b < 2; ++b)
#pragma unroll
                for (int m = 0; m < 4; ++m)
#pragma unroll
                    for (int n = 0; n < 2; ++n) acc[a][b][m][n] = (f32x4){0.f, 0.f, 0.f, 0.f};
        cur = nxt; cA = nA; cB = nB; ++ui;
    }
    PG8_WAIT_V(0);
    if (wr == 0) PG8_BAR;
    PG8_BAR;
    if constexpr (Epi::AFTER_DRAIN) { E.fused(acc, cur, wr, wc, fr, fq, lds, wid, lane); S.done(cur); }
    PG8_STAMP();
    if (STAMP && wid == 0) { stamps[lane] = lane < nts ? (((unsigned long long)(unsigned)ts_hi << 32) | (unsigned)ts_lo) : 0ull;
        if (lane == 62) stamps[62] = rt_entry; if (lane == 63) stamps[63] = (unsigned long long)wall_clock64(); }
#undef PG8_STAMP
#undef PG8_SA
#undef PG8_SB
#undef PG8_STAGE
#undef PG8_LDA
#undef PG8_LDB
#undef PG8_MMA
#undef PG8_WAIT_V
#undef PG8_WAIT_L
#undef PG8_BAR
#undef PG8_SCHED
}
}

namespace mk {
#define GAS __attribute__((address_space(1)))
#define LAS __attribute__((address_space(3)))
#define DEV __device__ __forceinline__
typedef unsigned short bf16;
typedef unsigned v4u __attribute__((ext_vector_type(4)));
typedef float f32x4 __attribute__((ext_vector_type(4)));
typedef float f32x2 __attribute__((ext_vector_type(2)));
typedef short bf16x8 __attribute__((ext_vector_type(8)));
typedef float f32x16 __attribute__((ext_vector_type(16)));
typedef __bf16 bf16x2_t __attribute__((ext_vector_type(2)));

#ifndef MK_DBG
#define MK_DBG 0
#endif
#ifndef MK_CHECK
#define MK_CHECK 0
#endif
#ifndef MK_DUP
#define MK_DUP (-1)
#endif
#ifndef MK_N_LAUNCHES
#define MK_N_LAUNCHES 19
#endif

constexpr int D = 2048, SEQ = 4096, M = 8192, NL = 2;
constexpr int LRU_W = 768, SWA_W = 768, SB_W = 512, IN_W = 5376;
constexpr int ZO_XA = 0, ZO_GA = 768, ZO_QB = 1536, ZO_KB = 2304, ZO_VB = 3072, ZO_QC = 3840, ZO_KC = 4352, ZO_VC = 4864;
constexpr int NEXP = 16384, MODW = 12288;
constexpr int MO_SH1 = 0, MO_SC1 = 2048, MO_G1 = 4096, MO_SH2 = 6144, MO_SC2 = 8192, MO_G2 = 10240;
constexpr float EPS = 1e-6f;
constexpr float QSCALE = 0.08838834764831845f;
constexpr float NEGBIG = -3.0e38f;
constexpr int NPHASE = 19 + 2 * (MK_CHECK != 0);

constexpr size_t MiB = 1u << 20;
constexpr size_t WS_CTL = 0, CTL_ZERO_BYTES = 1 * MiB;
constexpr size_t WS_MOD = 512 * 1024;
constexpr size_t WS_WIN_T = 2 * MiB, WS_WOUT_T = 44 * MiB, WS_WQ_T = 60 * MiB, WS_SUBK = 76 * MiB, WS_U = 80 * MiB, WS_V = 208 * MiB,
                 WS_H = 336 * MiB, WS_Z = 368 * MiB, WS_HLOC = 452 * MiB, WS_P = 476 * MiB, WS_YB = 500 * MiB, WS_YC = 524 * MiB,
                 WS_SUMA = 540 * MiB, WS_SUMB = 541 * MiB, WS_X1 = 544 * MiB, WS_X2 = 608 * MiB, WS_Q = 672 * MiB, WS_IDS = 704 * MiB,
                 WS_G = 708 * MiB, WS_PART = 712 * MiB, WS_LSE = 784 * MiB, WS_END = 785 * MiB;
constexpr int CW_BAR = 4096;

constexpr int LDS_BYTES = 147456;
constexpr int LDS_MISC = 131072;

__device__ const unsigned char T5B[3][132] = {
 {0,1,2,3,4,5,6,7,8,9,10,11,12,13,14,15,16,16,16,16,16,16,17,17,17,17,17,17,17,17,18,18,18,18,18,18,18,18,18,18,19,19,19,19,19,19,19,19,19,19,19,19,19,19,20,20,20,20,20,20,20,20,20,20,20,20,20,20,20,20,20,20,20,21,21,21,21,21,21,21,21,21,21,21,21,21,21,21,21,21,21,21,21,21,21,21,21,21,21,22,22,22,22,22,22,22,22,22,22,22,22,22,22,22,22,22,22,22,22,22,22,22,22,22,22,22,22,22,22,0,0,0},
 {0,4,8,12,16,16,17,17,18,18,19,19,19,19,20,20,20,20,20,21,21,21,21,21,21,22,22,22,22,22,22,22,22,22,23,23,23,23,23,23,23,23,23,23,23,23,24,24,24,24,24,24,24,24,24,24,24,24,24,24,24,24,25,25,25,25,25,25,25,25,25,25,25,25,25,25,25,25,25,25,25,25,25,26,26,26,26,26,26,26,26,26,26,26,26,26,26,26,26,26,26,26,26,26,26,26,26,26,26,26,26,26,26,27,27,27,27,27,27,27,27,27,27,27,27,27,27,27,27,0,0,0},
 {0,16,18,19,20,21,21,22,22,23,23,23,24,24,24,24,25,25,25,25,25,26,26,26,26,26,26,26,26,27,27,27,27,27,27,27,27,27,27,28,28,28,28,28,28,28,28,28,28,28,28,28,29,29,29,29,29,29,29,29,29,29,29,29,29,29,29,29,29,29,30,30,30,30,30,30,30,30,30,30,30,30,30,30,30,30,30,30,30,30,30,30,30,30,30,31,31,31,31,31,31,31,31,31,31,31,31,31,31,31,31,31,31,31,31,31,31,31,31,31,31,31,31,31,31,31,31,31,31,0,0,0}};

#define LDS_WAIT() asm volatile("s_waitcnt lgkmcnt(0)" ::: "memory")
DEV unsigned f2bf(float f) { unsigned u = __builtin_bit_cast(unsigned, f); return (u + 0x7fffu + ((u >> 16) & 1u)) >> 16; }
DEV unsigned pk2(float lo, float hi) { return f2bf(lo) | (f2bf(hi) << 16); }
DEV float bf_lo(unsigned w) { return __builtin_bit_cast(float, w << 16); }
DEV float bf_hi(unsigned w) { return __builtin_bit_cast(float, w & 0xffff0000u); }
DEV float bf1(bf16 h) { return __builtin_bit_cast(float, ((unsigned)h) << 16); }
DEV float wave_sum(float v) {
#pragma unroll
    for (int o = 1; o < 64; o <<= 1) v += __shfl_xor(v, o);
    return v;
}
DEV float wave_max(float v) {
#pragma unroll
    for (int o = 1; o < 64; o <<= 1) v = fmaxf(v, __shfl_xor(v, o));
    return v;
}
DEV float sigmoid_f(float x) { return 1.f / (1.f + __expf(-x)); }
DEV float softplus_f(float x) { return fmaxf(x, 0.f) + log1pf(__expf(-fabsf(x))); }
DEV float gelu_tanh(float x) { const float u = 0.7978845608028654f * (x + 0.044715f * x * x * x); const float t = 1.f - 2.f / (1.f + __expf(2.f * u)); return 0.5f * x * (1.f + t); }
DEV float dot8(const v4u a, const v4u b) {
    float s = bf_lo(a.x) * bf_lo(b.x); s += bf_hi(a.x) * bf_hi(b.x);
    s += bf_lo(a.y) * bf_lo(b.y); s += bf_hi(a.y) * bf_hi(b.y);
    s += bf_lo(a.z) * bf_lo(b.z); s += bf_hi(a.z) * bf_hi(b.z);
    s += bf_lo(a.w) * bf_lo(b.w); s += bf_hi(a.w) * bf_hi(b.w);
    return s;
}

#define XB_TMO      128
#define XB_XCNT(j)  (256  + 64 * (j))
#define XB_XSUB(j)  (1280 + 64 * (j))
#define XB_XGEN(j)  (2304 + 64 * (j))
#define XB_TOP      3328
#define XB_TOPGEN   3392
#define XCD_BAR_WORDS 3456
#define XB_SPIN_CAP (1u << 18)

__device__ __forceinline__ unsigned xb_ld(unsigned* p)              { return __hip_atomic_load(p, __ATOMIC_RELAXED, __HIP_MEMORY_SCOPE_AGENT); }
__device__ __forceinline__ unsigned xb_add(unsigned* p, unsigned v) { return __hip_atomic_fetch_add(p, v, __ATOMIC_RELAXED, __HIP_MEMORY_SCOPE_AGENT); }
__device__ __forceinline__ unsigned xb_xcc_id() { return (unsigned)__builtin_amdgcn_s_getreg((3 << 11) | 20) & 0xFu; }
#define XB_SPIN(cond, bar) do { unsigned _sp = 0; while (cond) { __builtin_amdgcn_s_sleep(1); \
    if ((++_sp & 255u) == 0u) { if (xb_ld(&(bar)[XB_TMO])) break; if (_sp > XB_SPIN_CAP) { atomicAdd(&(bar)[XB_TMO], 1u); break; } } } } while (0)

struct XcdBarrier {
    unsigned* bar; unsigned x;
    volatile LAS unsigned* st;
};
__device__ __forceinline__ XcdBarrier xcd_barrier_post(unsigned* bar, volatile LAS unsigned* st) {
    XcdBarrier b; b.bar = bar; b.x = xb_xcc_id(); b.st = st;
    if (threadIdx.x == 0) (void)xb_add(&bar[XB_XCNT(b.x)], 1u);
    return b;
}
__device__ __forceinline__ void xcd_barrier_complete(unsigned* bar, unsigned x, unsigned& nloc, unsigned& nx) {
    const unsigned G = gridDim.x * gridDim.y * gridDim.z;
    unsigned sum, cnt, mine, sp = 0u;
    for (;;) {
        sum = 0u; cnt = 0u; mine = 0u;
#pragma unroll
        for (unsigned j = 0; j < 16; ++j) { const unsigned c = xb_ld(&bar[XB_XCNT(j)]); sum += c; cnt += (c > 0u) ? 1u : 0u; mine = (j == x) ? c : mine; }
        if (sum == G) break;
        __builtin_amdgcn_s_sleep(1);
        if ((++sp & 255u) == 0u) { if (xb_ld(&bar[XB_TMO])) break; if (sp > XB_SPIN_CAP) { atomicAdd(&bar[XB_TMO], 1u); break; } }
    }
    nloc = mine > 0u ? mine : 1u; nx = cnt > 0u ? cnt : 1u;
}
__device__ __forceinline__ void xcd_barrier(const XcdBarrier& b) {
    asm volatile("s_waitcnt vmcnt(0)" ::: "memory");
    __syncthreads();
    if (threadIdx.x == 0) {
        unsigned* bar = b.bar;
        __builtin_amdgcn_s_waitcnt(0);
        unsigned nloc = b.st[0], nx = b.st[1];
        if (nloc == 0u) { xcd_barrier_complete(bar, b.x, nloc, nx); b.st[0] = nloc; b.st[1] = nx; }
        const unsigned old = xb_add(&bar[XB_XSUB(b.x)], 1u);
        const unsigned gen = old / nloc;
        if (old + 1u == (gen + 1u) * nloc) {
            __builtin_amdgcn_fence(__ATOMIC_RELEASE, "agent");
            asm volatile("s_waitcnt vmcnt(0)" ::: "memory");
            const unsigned og = xb_add(&bar[XB_TOP], 1u);
            const unsigned tg = og / nx;
            if (og + 1u == (tg + 1u) * nx) xb_add(&bar[XB_TOPGEN], 1u);
            else XB_SPIN(xb_ld(&bar[XB_TOPGEN]) == tg, bar);
            __builtin_amdgcn_fence(__ATOMIC_ACQUIRE, "agent");
            xb_add(&bar[XB_XGEN(b.x)], 1u);
            asm volatile("s_waitcnt vmcnt(0)" ::: "memory");
        } else {
            XB_SPIN(xb_ld(&bar[XB_XGEN(b.x)]) == gen, bar);
            __builtin_amdgcn_fence(__ATOMIC_ACQUIRE, "agent");
            asm volatile("s_waitcnt vmcnt(0)" ::: "memory");
        }
    }
    __syncthreads();
}

struct EpiResGate {
    static constexpr bool PERM = false, AFTER_DRAIN = false;
    const float* X; float* O; const float* gate; float gscale;
    __device__ __forceinline__ void operator()(const pg8::f32x4 (&acc)[2][2][4][2], const pg8::Unit& u, int wr, int wc, int fr, int fq) const {
        const int row0 = u.pm * 256 + wr * 64 + fr, col0 = u.pn * 256 + wc * 32 + 4 * fq;
        const float* gp = gate + (size_t)((u.pm * 256) >> 12) * MODW;
        pg8::f32x4 gv[2][2];
#pragma unroll
        for (int bj = 0; bj < 2; ++bj)
#pragma unroll
            for (int n = 0; n < 2; ++n) gv[bj][n] = *(const pg8::f32x4*)(gp + col0 + bj * 128 + n * 16) * gscale;
#pragma unroll
        for (int ai = 0; ai < 2; ++ai)
#pragma unroll
            for (int m = 0; m < 4; ++m) {
                const size_t ro = (size_t)(row0 + ai * 128 + m * 16) * D + col0;
#pragma unroll
                for (int bj = 0; bj < 2; ++bj)
#pragma unroll
                    for (int n = 0; n < 2; ++n) {
                        const pg8::f32x4 xv = *(const pg8::f32x4*)(X + ro + bj * 128 + n * 16);
                        *(pg8::f32x4*)(O + ro + bj * 128 + n * 16) = xv + gv[bj][n] * acc[ai][bj][m][n];
                    }
            }
    }
};

DEV void ph_mod(const float* __restrict__ c, const float* __restrict__ w_mod, const float* __restrict__ b_mod, float* __restrict__ mod, LAS float* red, int vcu, int G, int tid) {
    const int lane = tid & 63, wave = tid >> 6;
    for (int it = vcu; it < 2 * 192; it += G) {
        const int l = it / 192, cb = it % 192;
        const int k0 = wave * 256;
        const float* W = w_mod + ((size_t)l * D + k0) * MODW + cb * 64 + lane;
        float a0 = 0.f, a1 = 0.f;
#pragma unroll 16
        for (int k = 0; k < 256; ++k) {
            const float w = W[(size_t)k * MODW];
            const float c0 = c[k0 + k], c1 = c[D + k0 + k];
            a0 += (c0 * sigmoid_f(c0)) * w; a1 += (c1 * sigmoid_f(c1)) * w;
        }
        red[(wave * 2 + 0) * 64 + lane] = a0; red[(wave * 2 + 1) * 64 + lane] = a1;
        __syncthreads();
        if (tid < 128) {
            const int b = tid >> 6, ln = tid & 63; float s = 0.f;
#pragma unroll
            for (int w = 0; w < 8; ++w) s += red[(w * 2 + b) * 64 + ln];
            const int col = cb * 64 + ln;
            mod[(size_t)(l * 2 + b) * MODW + col] = s + b_mod[l * MODW + col];
        }
        __syncthreads();
    }
}
DEV void transpose_item(const float* __restrict__ W, int K, int N, bf16* __restrict__ WT, LAS float* scr, int item, int lane) {
    const int nblk = N / 32, kb = item / nblk, nb = item % nblk, k0 = 64 * kb, n0 = 32 * nb;
#pragma unroll 8
    for (int i = 0; i < 32; ++i) { const int kk = 2 * i + (lane >> 5); scr[kk * 33 + (lane & 31)] = W[(size_t)(k0 + kk) * N + n0 + (lane & 31)]; }
    LDS_WAIT();
    const int c = lane & 7;
#pragma unroll
    for (int j = 0; j < 4; ++j) { const int n = (lane >> 3) + 8 * j; const LAS float* s = scr + (8 * c) * 33 + n;
        v4u o; o.x = pk2(s[0 * 33], s[1 * 33]); o.y = pk2(s[2 * 33], s[3 * 33]); o.z = pk2(s[4 * 33], s[5 * 33]); o.w = pk2(s[6 * 33], s[7 * 33]);
        *(v4u*)(WT + (size_t)(n0 + n) * K + k0 + 8 * c) = o; }
    LDS_WAIT();
}
DEV void convert_copy(const float* __restrict__ src, bf16* __restrict__ dst, size_t ngroups8, size_t gtid, size_t gstride) {
    for (size_t g = gtid; g < ngroups8; g += gstride) {
        const f32x4 a = *(const f32x4*)(src + g * 8), b = *(const f32x4*)(src + g * 8 + 4);
        v4u o; o.x = pk2(a.x, a.y); o.y = pk2(a.z, a.w); o.z = pk2(b.x, b.y); o.w = pk2(b.z, b.w);
        *(v4u*)(dst + g * 8) = o;
    }
}

DEV void modnorm_rows(const float* __restrict__ X, const float* __restrict__ gain, const float* __restrict__ modl, int sh_off, int sc_off, bf16* __restrict__ H, int gw, int NGW, int lane) {
    for (int m = gw; m < M; m += NGW) {
        const int b = m >> 12;
        const f32x4* xr = (const f32x4*)(X + (size_t)m * D) + lane;
        f32x4 v[8]; float s = 0.f;
#pragma unroll
        for (int j = 0; j < 8; ++j) { v[j] = xr[64 * j]; s += (v[j].x * v[j].x + v[j].y * v[j].y) + (v[j].z * v[j].z + v[j].w * v[j].w); }
        const float r = rsqrtf(wave_sum(s) * (1.f / D) + EPS);
        const f32x4* g4 = (const f32x4*)gain + lane;
        const f32x4* sc4 = (const f32x4*)(modl + (size_t)b * MODW + sc_off) + lane;
        const f32x4* sh4 = (const f32x4*)(modl + (size_t)b * MODW + sh_off) + lane;
        unsigned long long* o8 = (unsigned long long*)(H + (size_t)m * D) + lane;
#pragma unroll
        for (int j = 0; j < 8; ++j) {
            const f32x4 g = g4[64 * j], sc = sc4[64 * j], sh = sh4[64 * j];
            const f32x4 y = (v[j] * r) * g * (sc + 1.f) + sh;
            o8[64 * j] = (unsigned long long)pk2(y.x, y.y) | ((unsigned long long)pk2(y.z, y.w) << 32);
        }
    }
}

DEV void lru_item(int l, int b, int j, int n, const bf16* __restrict__ Z, const float* __restrict__ conv_w, const float* __restrict__ conv_b,
                  const float* __restrict__ w_rec, const float* __restrict__ b_rec, const float* __restrict__ w_gi, const float* __restrict__ b_gi, const float* __restrict__ lam,
                  float* __restrict__ HLOC, float* __restrict__ PP, float* __restrict__ SUMA, float* __restrict__ SUMB, LAS float* xc, LAS float* aL, LAS float* uL, int tid) {
    const int ch = tid & 127, tq = tid >> 7, c = n * 128 + ch;
    {
        const float cw0 = conv_w[(l * 4 + 0) * LRU_W + c], cw1 = conv_w[(l * 4 + 1) * LRU_W + c], cw2 = conv_w[(l * 4 + 2) * LRU_W + c], cw3 = conv_w[(l * 4 + 3) * LRU_W + c];
        const float cb = conv_b[l * LRU_W + c];
#pragma unroll 4
        for (int i = 0; i < 16; ++i) {
            const int tok = tq + 4 * i, t = j * 64 + tok;
            const bf16* zp = Z + ((size_t)b * SEQ + t) * IN_W + ZO_XA + c;
            float s = cb + cw3 * bf1(zp[0]);
            if (t >= 1) s += cw2 * bf1(zp[-(ptrdiff_t)IN_W]);
            if (t >= 2) s += cw1 * bf1(zp[-(ptrdiff_t)2 * IN_W]);
            if (t >= 3) s += cw0 * bf1(zp[-(ptrdiff_t)3 * IN_W]);
            xc[tok * 128 + ch] = s;
        }
    }
    __syncthreads();
    float accr[16], acci[16];
#pragma unroll
    for (int i = 0; i < 16; ++i) { accr[i] = 0.f; acci[i] = 0.f; }
    const float* Wr = w_rec + ((size_t)(l * 6 + n) * 128) * 128 + ch;
    const float* Wi = w_gi + ((size_t)(l * 6 + n) * 128) * 128 + ch;
#pragma unroll 2
    for (int jj = 0; jj < 128; ++jj) {
        const float wr = Wr[jj * 128], wi = Wi[jj * 128];
#pragma unroll
        for (int i = 0; i < 16; ++i) { const float x = xc[(tq + 4 * i) * 128 + jj]; accr[i] += x * wr; acci[i] += x * wi; }
    }
    {
        const float br = b_rec[l * LRU_W + c], bi = b_gi[l * LRU_W + c], sp = softplus_f(-lam[l * LRU_W + c]);
#pragma unroll
        for (int i = 0; i < 16; ++i) {
            const int tok = tq + 4 * i;
            const float r = sigmoid_f(accr[i] + br), ig = sigmoid_f(acci[i] + bi);
            const float log_a = -8.0f * r * sp;
            const float av = __expf(log_a);
            const float x = xc[tok * 128 + ch];
            const float uv = sqrtf(fmaxf(-expm1f(2.f * log_a), 0.f)) * (ig * x);
            aL[tok * 128 + ch] = av; uL[tok * 128 + ch] = uv;
        }
    }
    __syncthreads();
    if (tid < 128) {
        float h = 0.f, P = 1.f;
        const size_t rb = ((size_t)b * SEQ + j * 64) * LRU_W + n * 128 + tid;
        for (int tok = 0; tok < 64; ++tok) {
            const float av = aL[tok * 128 + tid];
            h = av * h + uL[tok * 128 + tid]; P *= av;
            HLOC[rb + (size_t)tok * LRU_W] = h; PP[rb + (size_t)tok * LRU_W] = P;
        }
        SUMA[(size_t)(b * 64 + j) * LRU_W + n * 128 + tid] = P; SUMB[(size_t)(b * 64 + j) * LRU_W + n * 128 + tid] = h;
    }
    __syncthreads();
}

DEV void dil_item(int b, int h, int t, const bf16* __restrict__ Z, const float* __restrict__ rel_bias, float* __restrict__ YB, LAS float* qs, LAS float* lg, int lane) {
    const size_t row = (size_t)b * SEQ + t;
    { const unsigned w = *(const unsigned*)(Z + row * IN_W + ZO_QB + h * 128 + 2 * lane); qs[2 * lane] = bf_lo(w) * QSCALE; qs[2 * lane + 1] = bf_hi(w) * QSCALE; }
    LDS_WAIT();
    float mx = NEGBIG;
#pragma unroll
    for (int p = 0; p < 3; ++p) {
        const int d = 1 << (2 * p);
        for (int jj = lane; jj < 129; jj += 64) {
            const int pos = t - jj * d; float lgt = NEGBIG;
            if (pos >= 0) {
                const v4u* kr = (const v4u*)(Z + ((size_t)b * SEQ + pos) * IN_W + ZO_KB + h * 128);
                float s = 0.f;
#pragma unroll 4
                for (int c8 = 0; c8 < 16; ++c8) { const v4u kv = kr[c8]; const LAS float* q = qs + c8 * 8;
                    s += q[0] * bf_lo(kv.x) + q[1] * bf_hi(kv.x) + q[2] * bf_lo(kv.y) + q[3] * bf_hi(kv.y) + q[4] * bf_lo(kv.z) + q[5] * bf_hi(kv.z) + q[6] * bf_lo(kv.w) + q[7] * bf_hi(kv.w); }
                lgt = s + rel_bias[(int)T5B[p][jj] * 6 + h];
            }
            lg[p * 129 + jj] = lgt; mx = fmaxf(mx, lgt);
        }
    }
    mx = wave_max(mx);
    LDS_WAIT();
    float sum = 0.f;
    for (int idx = lane; idx < 387; idx += 64) { const float v = lg[idx]; const float pv = (v > -1.0e37f) ? __expf(v - mx) : 0.f; lg[idx] = pv; sum += pv; }
    sum = wave_sum(sum);
    LDS_WAIT();
    float a0 = 0.f, a1 = 0.f;
#pragma unroll
    for (int p = 0; p < 3; ++p) {
        const int d = 1 << (2 * p);
        int nk = t / d + 1; nk = nk > 129 ? 129 : nk;
        const bf16* vb = Z + row * IN_W + ZO_VB + h * 128 + 2 * lane;
#pragma unroll 4
        for (int jj = 0; jj < nk; ++jj) {
            const float pv = lg[p * 129 + jj];
            const unsigned w = *(const unsigned*)(vb - (size_t)jj * d * IN_W);
            a0 += pv * bf_lo(w); a1 += pv * bf_hi(w);
        }
    }
    const float inv = 1.f / sum;
    *(f32x2*)(YB + row * SWA_W + h * 128 + 2 * lane) = (f32x2){a0 * inv, a1 * inv};
    LDS_WAIT();
}


DEV unsigned cvtpk_bf16(float lo, float hi) { f32x2 v = {lo, hi}; bf16x2_t b = __builtin_convertvector(v, bf16x2_t); return __builtin_bit_cast(unsigned, b); }
constexpr int DIL_VSTR = 272;
constexpr int DIL_WLDS = 32 * DIL_VSTR + 132 * 4;
DEV void dil_mfma_item(int b, int h, int p, int rr, int i0, const bf16* __restrict__ Z, const float* __restrict__ rel_bias, float* __restrict__ PART, float* __restrict__ LSE, LAS unsigned char* wl, int lane) {
    const int r = lane & 31, hh = lane >> 5;
    const int d = 1 << (2 * p);
    LAS float* biasL = (LAS float*)(wl + 32 * DIL_VSTR);
    for (int dd = lane; dd < 129; dd += 64) biasL[dd] = rel_bias[(int)T5B[p][dd] * 6 + h];
    const size_t rowq = (size_t)b * SEQ + rr + d * (i0 + r);
    bf16x8 qf[8];
    { const bf16* qrow = Z + rowq * IN_W + ZO_QB + h * 128 + 8 * hh;
#pragma unroll
      for (int ks = 0; ks < 8; ++ks) qf[ks] = *(const bf16x8*)(qrow + 16 * ks); }
    float m_run = NEGBIG, l_run = 0.f;
    f32x16 o[4];
#pragma unroll
    for (int dt = 0; dt < 4; ++dt)
#pragma unroll
        for (int e = 0; e < 16; ++e) o[dt][e] = 0.f;
    const int kap = (r & 0x13) | ((r & 4) << 1) | ((r & 8) >> 1);
    LDS_WAIT();
    for (int jt = 0; jt < 5; ++jt) {
        const int j0 = i0 - 128 + 32 * jt;
        if (j0 + 31 < 0) continue;
        {
            v4u vr[8];
#pragma unroll
            for (int q = 0; q < 8; ++q) { const int pi = lane + 64 * q, kl = pi >> 4, c = pi & 15; int j = j0 + kl; j = j < 0 ? 0 : j;
                vr[q] = *(const v4u*)(Z + ((size_t)b * SEQ + rr + d * j) * IN_W + ZO_VB + h * 128 + 8 * c); }
#pragma unroll
            for (int q = 0; q < 8; ++q) { const int pi = lane + 64 * q, kl = pi >> 4, c = pi & 15; *(LAS v4u*)(wl + kl * DIL_VSTR + c * 16) = vr[q]; }
        }
        f32x16 sacc;
#pragma unroll
        for (int e = 0; e < 16; ++e) sacc[e] = 0.f;
        { int jk = j0 + kap; jk = jk < 0 ? 0 : jk;
          const bf16* krow = Z + ((size_t)b * SEQ + rr + d * jk) * IN_W + ZO_KB + h * 128 + 8 * hh;
          bf16x8 kf[8];
#pragma unroll
          for (int ks = 0; ks < 8; ++ks) kf[ks] = *(const bf16x8*)(krow + 16 * ks);
#pragma unroll
          for (int ks = 0; ks < 8; ++ks) sacc = __builtin_amdgcn_mfma_f32_32x32x16_bf16(kf[ks], qf[ks], sacc, 0, 0, 0); }
        float tm = NEGBIG;
#pragma unroll
        for (int e = 0; e < 16; ++e) {
            const int j = j0 + 16 * (e >> 3) + 8 * hh + (e & 7);
            const int dist = (i0 + r) - j;
            const bool valid = (j >= 0) && (dist >= 0) && (dist <= 128);
            const int dc = dist < 0 ? 0 : (dist > 128 ? 128 : dist);
            const float lg = valid ? sacc[e] * QSCALE + biasL[dc] : NEGBIG;
            sacc[e] = lg; tm = fmaxf(tm, lg);
        }
        tm = fmaxf(tm, __shfl_xor(tm, 32));
        const float m_new = fmaxf(m_run, tm);
        const float alpha = __expf(m_run - m_new);
        float ps = 0.f;
#pragma unroll
        for (int e = 0; e < 16; ++e) { const float pv = (sacc[e] > -1.0e37f) ? __expf(sacc[e] - m_new) : 0.f; sacc[e] = pv; ps += pv; }
        ps += __shfl_xor(ps, 32);
        l_run = l_run * alpha + ps; m_run = m_new;
#pragma unroll
        for (int dt = 0; dt < 4; ++dt)
#pragma unroll
            for (int e = 0; e < 16; ++e) o[dt][e] *= alpha;
        bf16x8 pf[2];
#pragma unroll
        for (int s2 = 0; s2 < 2; ++s2) { v4u w; w.x = cvtpk_bf16(sacc[8 * s2 + 0], sacc[8 * s2 + 1]); w.y = cvtpk_bf16(sacc[8 * s2 + 2], sacc[8 * s2 + 3]);
            w.z = cvtpk_bf16(sacc[8 * s2 + 4], sacc[8 * s2 + 5]); w.w = cvtpk_bf16(sacc[8 * s2 + 6], sacc[8 * s2 + 7]); pf[s2] = __builtin_bit_cast(bf16x8, w); }
        LDS_WAIT();
#pragma unroll
        for (int dt = 0; dt < 4; ++dt)
#pragma unroll
            for (int s2 = 0; s2 < 2; ++s2) {
                const LAS unsigned short* vp = (const LAS unsigned short*)(wl + (16 * s2 + 8 * hh) * DIL_VSTR + (32 * dt + r) * 2);
                v4u w;
                w.x = (unsigned)vp[0 * (DIL_VSTR / 2)] | ((unsigned)vp[1 * (DIL_VSTR / 2)] << 16);
                w.y = (unsigned)vp[2 * (DIL_VSTR / 2)] | ((unsigned)vp[3 * (DIL_VSTR / 2)] << 16);
                w.z = (unsigned)vp[4 * (DIL_VSTR / 2)] | ((unsigned)vp[5 * (DIL_VSTR / 2)] << 16);
                w.w = (unsigned)vp[6 * (DIL_VSTR / 2)] | ((unsigned)vp[7 * (DIL_VSTR / 2)] << 16);
                o[dt] = __builtin_amdgcn_mfma_f32_32x32x16_bf16(__builtin_bit_cast(bf16x8, w), pf[s2], o[dt], 0, 0, 0);
            }
        LDS_WAIT();
    }
    const float inv = 1.f / l_run;
    float* po = PART + ((size_t)p * M + rowq) * SWA_W + h * 128;
#pragma unroll
    for (int dt = 0; dt < 4; ++dt)
#pragma unroll
        for (int g = 0; g < 4; ++g)
            *(f32x4*)(po + 32 * dt + 8 * g + 4 * hh) = (f32x4){o[dt][4 * g + 0] * inv, o[dt][4 * g + 1] * inv, o[dt][4 * g + 2] * inv, o[dt][4 * g + 3] * inv};
    if (hh == 0) LSE[((size_t)p * M + rowq) * 6 + h] = m_run + __logf(l_run);
}

DEV void sb_item(int b, int h, int t, const bf16* __restrict__ Z, float* __restrict__ YC, LAS float* qs, LAS float* pA, int lane) {
    const size_t row = (size_t)b * SEQ + t;
    { const unsigned w = *(const unsigned*)(Z + row * IN_W + ZO_QC + h * 128 + 2 * lane); qs[2 * lane] = bf_lo(w) * QSCALE; qs[2 * lane + 1] = bf_hi(w) * QSCALE; }
    LDS_WAIT();
    float carry = 0.f, a0 = 0.f, a1 = 0.f;
    for (int shi = t - 1; shi >= 0; shi -= 64) {
        const int s = shi - lane; const bool valid = s >= 0;
        float z = 0.f;
        if (valid) {
            const v4u* kr = (const v4u*)(Z + ((size_t)b * SEQ + s) * IN_W + ZO_KC + h * 128);
#pragma unroll 4
            for (int c8 = 0; c8 < 16; ++c8) { const v4u kv = kr[c8]; const LAS float* q = qs + c8 * 8;
                z += q[0] * bf_lo(kv.x) + q[1] * bf_hi(kv.x) + q[2] * bf_lo(kv.y) + q[3] * bf_hi(kv.y) + q[4] * bf_lo(kv.z) + q[5] * bf_hi(kv.z) + q[6] * bf_lo(kv.w) + q[7] * bf_hi(kv.w); }
        }
        const float l1m = valid ? -softplus_f(z) : 0.f;
        float inc = l1m;
#pragma unroll
        for (int o = 1; o < 64; o <<= 1) { const float tmp = __shfl_up(inc, o); if (lane >= o) inc += tmp; }
        const float A = valid ? __expf(-softplus_f(-z) + carry + (inc - l1m)) : 0.f;
        carry += __shfl(inc, 63);
        pA[lane] = A;
        const bool done = carry < -105.0f;
        LDS_WAIT();
        const int nk = (shi + 1) < 64 ? (shi + 1) : 64;
        const bf16* vb = Z + ((size_t)b * SEQ + shi) * IN_W + ZO_VC + h * 128 + 2 * lane;
#pragma unroll 4
        for (int i = 0; i < nk; ++i) {
            const float pv = pA[i];
            const unsigned w = *(const unsigned*)(vb - (size_t)i * IN_W);
            a0 += pv * bf_lo(w); a1 += pv * bf_hi(w);
        }
        LDS_WAIT();
        if (done) break;
    }
    *(f32x2*)(YC + row * SB_W + h * 128 + 2 * lane) = (f32x2){a0, a1};
}


DEV void sb_mfma_item(int b, int h, int t0, const bf16* __restrict__ Z, float* __restrict__ YC, LAS unsigned char* wl, int lane) {
    const int r = lane & 31, hh = lane >> 5;
    const size_t rowq = (size_t)b * SEQ + t0 + r;
    bf16x8 qf[8];
    { const bf16* qrow = Z + rowq * IN_W + ZO_QC + h * 128 + 8 * hh;
#pragma unroll
      for (int ks = 0; ks < 8; ++ks) qf[ks] = *(const bf16x8*)(qrow + 16 * ks); }
    f32x16 o[4];
#pragma unroll
    for (int dt = 0; dt < 4; ++dt)
#pragma unroll
        for (int e = 0; e < 16; ++e) o[dt][e] = 0.f;
    const int kap = (r & 0x13) | ((r & 4) << 1) | ((r & 8) >> 1);
    float carry = 0.f;
    for (int k0 = t0; k0 >= 0; k0 -= 32) {
        {
            v4u vr[8];
#pragma unroll
            for (int q = 0; q < 8; ++q) { const int pi = lane + 64 * q, kl = pi >> 4, c = pi & 15;
                vr[q] = *(const v4u*)(Z + ((size_t)b * SEQ + k0 + kl) * IN_W + ZO_VC + h * 128 + 8 * c); }
#pragma unroll
            for (int q = 0; q < 8; ++q) { const int pi = lane + 64 * q, kl = pi >> 4, c = pi & 15; *(LAS v4u*)(wl + kl * DIL_VSTR + c * 16) = vr[q]; }
        }
        f32x16 sacc;
#pragma unroll
        for (int e = 0; e < 16; ++e) sacc[e] = 0.f;
        { const bf16* krow = Z + ((size_t)b * SEQ + k0 + kap) * IN_W + ZO_KC + h * 128 + 8 * hh;
          bf16x8 kf[8];
#pragma unroll
          for (int ks = 0; ks < 8; ++ks) kf[ks] = *(const bf16x8*)(krow + 16 * ks);
#pragma unroll
          for (int ks = 0; ks < 8; ++ks) sacc = __builtin_amdgcn_mfma_f32_32x32x16_bf16(kf[ks], qf[ks], sacc, 0, 0, 0); }
        float l1[16]; float T0 = 0.f, T1 = 0.f;
#pragma unroll
        for (int e = 0; e < 16; ++e) {
            const int key = k0 + 16 * (e >> 3) + 8 * hh + (e & 7);
            const bool valid = key < t0 + r;
            const float z = sacc[e] * QSCALE;
            sacc[e] = z;
            l1[e] = valid ? -softplus_f(z) : 0.f;
        }
#pragma unroll
        for (int e = 0; e < 8; ++e) { T0 += l1[e]; T1 += l1[8 + e]; }
        const float PT0 = __shfl_xor(T0, 32), PT1 = __shfl_xor(T1, 32);
        const float base1 = carry + (hh ? 0.f : PT1);
        const float base0 = carry + (hh ? (T1 + PT1) : (PT1 + T1 + PT0));
        float run1 = base1, run0 = base0;
#pragma unroll
        for (int e = 7; e >= 0; --e) {
            { const int key = k0 + 16 + 8 * hh + e; const bool valid = key < t0 + r; const float a = valid ? __expf(sacc[8 + e] + l1[8 + e] + run1) : 0.f; run1 += l1[8 + e]; sacc[8 + e] = a; }
            { const int key = k0 + 8 * hh + e; const bool valid = key < t0 + r; const float a = valid ? __expf(sacc[e] + l1[e] + run0) : 0.f; run0 += l1[e]; sacc[e] = a; }
        }
        carry += (T0 + T1) + (PT0 + PT1);
        bf16x8 pf[2];
#pragma unroll
        for (int s2 = 0; s2 < 2; ++s2) { v4u w; w.x = cvtpk_bf16(sacc[8 * s2 + 0], sacc[8 * s2 + 1]); w.y = cvtpk_bf16(sacc[8 * s2 + 2], sacc[8 * s2 + 3]);
            w.z = cvtpk_bf16(sacc[8 * s2 + 4], sacc[8 * s2 + 5]); w.w = cvtpk_bf16(sacc[8 * s2 + 6], sacc[8 * s2 + 7]); pf[s2] = __builtin_bit_cast(bf16x8, w); }
        LDS_WAIT();
#pragma unroll
        for (int dt = 0; dt < 4; ++dt)
#pragma unroll
            for (int s2 = 0; s2 < 2; ++s2) {
                const LAS unsigned short* vp = (const LAS unsigned short*)(wl + (16 * s2 + 8 * hh) * DIL_VSTR + (32 * dt + r) * 2);
                v4u w;
                w.x = (unsigned)vp[0 * (DIL_VSTR / 2)] | ((unsigned)vp[1 * (DIL_VSTR / 2)] << 16);
                w.y = (unsigned)vp[2 * (DIL_VSTR / 2)] | ((unsigned)vp[3 * (DIL_VSTR / 2)] << 16);
                w.z = (unsigned)vp[4 * (DIL_VSTR / 2)] | ((unsigned)vp[5 * (DIL_VSTR / 2)] << 16);
                w.w = (unsigned)vp[6 * (DIL_VSTR / 2)] | ((unsigned)vp[7 * (DIL_VSTR / 2)] << 16);
                o[dt] = __builtin_amdgcn_mfma_f32_32x32x16_bf16(__builtin_bit_cast(bf16x8, w), pf[s2], o[dt], 0, 0, 0);
            }
        LDS_WAIT();
        if (__all(carry < -105.0f)) break;
    }
    float* po = YC + rowq * SB_W + h * 128;
#pragma unroll
    for (int dt = 0; dt < 4; ++dt)
#pragma unroll
        for (int g = 0; g < 4; ++g)
            *(f32x4*)(po + 32 * dt + 8 * g + 4 * hh) = (f32x4){o[dt][4 * g + 0], o[dt][4 * g + 1], o[dt][4 * g + 2], o[dt][4 * g + 3]};
}

DEV void combine_item(int l, int b, int j, int half, const bf16* __restrict__ Z, const float* __restrict__ HLOC, const float* __restrict__ PP, const float* __restrict__ SUMA, const float* __restrict__ SUMB,
                      const float* __restrict__ PART, const float* __restrict__ LSE, const float* __restrict__ YC, const float* __restrict__ g_lru, const float* __restrict__ g_swa, const float* __restrict__ g_sb,
                      bf16* __restrict__ Y, LAS float* carryL, int tid) {
    const int lane = tid & 63, wave = tid >> 6;
    for (int c = tid; c < LRU_W; c += 512) {
        float cr = 0.f;
        for (int i = 0; i < j; ++i) cr = SUMA[(size_t)(b * 64 + i) * LRU_W + c] * cr + SUMB[(size_t)(b * 64 + i) * LRU_W + c];
        carryL[c] = cr;
    }
    __syncthreads();
    for (int i = 0; i < 4; ++i) {
        const int tok = half * 32 + wave * 4 + i;
        const size_t row = (size_t)b * SEQ + j * 64 + tok;
        bf16* yo = Y + row * D;
        {
            float ya[12]; float ssq = 0.f;
#pragma unroll
            for (int e = 0; e < 12; ++e) { const int c = lane + 64 * e;
                const float hv = HLOC[row * LRU_W + c] + PP[row * LRU_W + c] * carryL[c];
                const float ga = bf1(Z[row * IN_W + ZO_GA + c]);
                ya[e] = hv * gelu_tanh(ga); ssq += ya[e] * ya[e]; }
            const float r = rsqrtf(wave_sum(ssq) * (1.f / LRU_W) + EPS);
#pragma unroll
            for (int e = 0; e < 12; ++e) { const int c = lane + 64 * e; yo[c] = (MK_DBG & 16) ? (bf16)0 : (bf16)f2bf(ya[e] * r * g_lru[l * LRU_W + c]); }
        }
        {
            float yb[12]; float ssq = 0.f;
            float wgt[3][2];
            (void)wgt;
#pragma unroll
            for (int e = 0; e < 12; ++e) { const int c = lane + 64 * e; const int hd = c >> 7;
                const float l0 = LSE[((size_t)0 * M + row) * 6 + hd], l1 = LSE[((size_t)1 * M + row) * 6 + hd], l2 = LSE[((size_t)2 * M + row) * 6 + hd];
                const float mx = fmaxf(l0, fmaxf(l1, l2)); const float e0 = __expf(l0 - mx), e1 = __expf(l1 - mx), e2 = __expf(l2 - mx); const float iz = 1.f / (e0 + e1 + e2);
                yb[e] = (e0 * PART[((size_t)0 * M + row) * SWA_W + c] + e1 * PART[((size_t)1 * M + row) * SWA_W + c] + e2 * PART[((size_t)2 * M + row) * SWA_W + c]) * iz;
                ssq += yb[e] * yb[e]; }
            const float r = rsqrtf(wave_sum(ssq) * (1.f / SWA_W) + EPS);
#pragma unroll
            for (int e = 0; e < 12; ++e) { const int c = lane + 64 * e; yo[LRU_W + c] = (MK_DBG & 32) ? (bf16)0 : (bf16)f2bf(yb[e] * r * g_swa[l * SWA_W + c]); }
        }
        {
            float yc[8]; float ssq = 0.f;
#pragma unroll
            for (int e = 0; e < 8; ++e) { const int c = lane + 64 * e; yc[e] = YC[row * SB_W + c]; ssq += yc[e] * yc[e]; }
            const float r = rsqrtf(wave_sum(ssq) * (1.f / SB_W) + EPS);
#pragma unroll
            for (int e = 0; e < 8; ++e) { const int c = lane + 64 * e; yo[LRU_W + SWA_W + c] = (MK_DBG & 64) ? (bf16)0 : (bf16)f2bf(yc[e] * r * g_sb[l * SB_W + c]); }
        }
    }
    __syncthreads();
}

constexpr int RT_SK = 0, RT_Q = 128 * 129 * 4, RT_SC = RT_Q + 32 * 128 * 4, RT_TV = RT_SC + 64 * 129 * 4, RT_TI = RT_TV + 64 * 16 * 4, RT_END = RT_TI + 64 * 16 * 4;
static_assert(RT_END <= LDS_MISC, "routing LDS");
DEV void route_item(int l, int tile, int h, const bf16* __restrict__ Q, const bf16* __restrict__ SK, int* __restrict__ IDS, float* __restrict__ GG, LAS unsigned char* lds, int tid, unsigned* DBGW = nullptr) {
    LAS float* skL = (LAS float*)(lds + RT_SK); LAS float* qL = (LAS float*)(lds + RT_Q); LAS float* sc = (LAS float*)(lds + RT_SC);
    LAS float* topv = (LAS float*)(lds + RT_TV); LAS int* topi = (LAS int*)(lds + RT_TI);
    const int lane = tid & 63, wave = tid >> 6, row0 = tile * 32;
    for (int c = 0; c < 2; ++c) {
        const bf16* skp = SK + ((size_t)((l * 8 + h) * 2 + c)) * 128 * 128;
#pragma unroll 4
        for (int i = 0; i < 16; ++i) { const int idx2 = tid + 512 * i; const int k = idx2 >> 6, d2 = idx2 & 63; const unsigned w = *(const unsigned*)(skp + k * 128 + 2 * d2); skL[k * 129 + 2 * d2] = bf_lo(w); skL[k * 129 + 2 * d2 + 1] = bf_hi(w); }
#pragma unroll
        for (int i = 0; i < 4; ++i) { const int idx2 = tid + 512 * i; const int tok = idx2 >> 6, d2 = idx2 & 63; const unsigned w = *(const unsigned*)(Q + (size_t)(row0 + tok) * D + h * 256 + c * 128 + 2 * d2); qL[tok * 128 + 2 * d2] = bf_lo(w); qL[tok * 128 + 2 * d2 + 1] = bf_hi(w); }
        __syncthreads();
        {
            const int k = tid & 127, tg = tid >> 7;
            float acc[8];
#pragma unroll
            for (int i = 0; i < 8; ++i) acc[i] = 0.f;
#pragma unroll 4
            for (int d = 0; d < 128; ++d) { const float s = skL[k * 129 + d];
#pragma unroll
                for (int i = 0; i < 8; ++i) acc[i] += s * qL[(tg * 8 + i) * 128 + d]; }
#pragma unroll
            for (int i = 0; i < 8; ++i) sc[(c * 32 + tg * 8 + i) * 129 + k] = acc[i];
        }
        __syncthreads();
    }
    for (int q = 0; q < 8; ++q) {
        const int L = wave * 8 + q;
        float v0 = sc[L * 129 + lane], v1 = sc[L * 129 + 64 + lane];
        for (int r = 0; r < 16; ++r) {
            const float m = wave_max(fmaxf(v0, v1));
            const unsigned long long b0 = __ballot(v0 == m);
            int idx;
            if (b0) { const int ln = __ffsll((long long)b0) - 1; idx = ln; if (lane == ln) v0 = NEGBIG; }
            else { const unsigned long long b1 = __ballot(v1 == m); const int ln = __ffsll((long long)b1) - 1; idx = 64 + ln; if (lane == ln) v1 = NEGBIG; }
            if (lane == 0) { topv[L * 16 + r] = m; topi[L * 16 + r] = idx; }
        }
    }
    __syncthreads();
#if MK_CHECK == 16
    { for (int q = 0; q < 8; ++q) { const int L = wave * 8 + q; const int mi = topi[L * 16 + (lane & 15)]; int dup = 0;
          for (int e = 0; e < 16; ++e) { const int oi = __shfl(mi, e); if (lane < 16 && e != lane && oi == mi) dup = 1; }
          if (dup) atomicAdd((unsigned*)DBGW, 1u); } }
#endif
    for (int q = 0; q < 4; ++q) {
        const int tok = wave * 4 + q;
        float cv[4];
#pragma unroll
        for (int e = 0; e < 4; ++e) cv[e] = topv[tok * 16 + (lane >> 2)] + topv[(32 + tok) * 16 + (lane & 3) * 4 + e];
        float mysc = NEGBIG; int myid = 0;
        for (int r = 0; r < 16; ++r) {
            const float lm = fmaxf(fmaxf(cv[0], cv[1]), fmaxf(cv[2], cv[3]));
            const float m = wave_max(lm);
            const unsigned long long bb = __ballot(lm == m);
            const int ln = __ffsll((long long)bb) - 1;
            const int se = (cv[0] == m) ? 0 : (cv[1] == m) ? 1 : (cv[2] == m) ? 2 : 3;
            const int sel = __shfl(se, ln);
            { const bool me = (lane == ln);
              cv[0] = (me && sel == 0) ? NEGBIG : cv[0]; cv[1] = (me && sel == 1) ? NEGBIG : cv[1];
              cv[2] = (me && sel == 2) ? NEGBIG : cv[2]; cv[3] = (me && sel == 3) ? NEGBIG : cv[3]; }
            const int ci = ln * 4 + sel;
            const int id = topi[tok * 16 + (ci >> 4)] * 128 + topi[(32 + tok) * 16 + (ci & 15)];
            if (lane == r) { mysc = m; myid = id; }
        }
#if MK_CHECK == 16
        { int dup = 0; for (int e = 0; e < 16; ++e) { const int oi = __shfl(myid, e); if (lane < 16 && e != lane && oi == myid) dup = 1; } if (dup) atomicAdd((unsigned*)DBGW + 1, 1u); }
#endif
        const float s0 = __shfl(mysc, 0);
        const float ev = (lane < 16) ? __expf(mysc - s0) : 0.f;
        const float sum = wave_sum(ev);
        if (lane < 16) { IDS[(size_t)(row0 + tok) * 128 + h * 16 + lane] = myid; GG[(size_t)(row0 + tok) * 128 + h * 16 + lane] = ev / sum; }
    }
    __syncthreads();
}

DEV void expert_row(int l, int row, const bf16* __restrict__ H, const int* __restrict__ IDS, const float* __restrict__ GG, const bf16* __restrict__ U, const bf16* __restrict__ V,
                    const float* __restrict__ X1, const float* __restrict__ g2, const float* __restrict__ fnorm, float* __restrict__ XO, int lane, float pscale, float* STATP = nullptr) {
    v4u xv[4];
#pragma unroll
    for (int j = 0; j < 4; ++j) xv[j] = *(const v4u*)(H + (size_t)row * D + lane * 8 + 512 * j);
    const int id0 = IDS[(size_t)row * 128 + lane], id1 = IDS[(size_t)row * 128 + 64 + lane];
    const float gg0 = GG[(size_t)row * 128 + lane], gg1 = GG[(size_t)row * 128 + 64 + lane];
    float y[32];
#pragma unroll
    for (int i = 0; i < 32; ++i) y[i] = 0.f;
    const bf16* Ul = U + (size_t)l * NEXP * D + lane * 8;
    const bf16* Vl = V + (size_t)l * NEXP * D + lane * 8;
    for (int e0 = 0; e0 < 128; e0 += 2) {
        int id[2]; float gq[2];
#pragma unroll
        for (int q = 0; q < 2; ++q) { const int e = e0 + q;
            id[q] = (e < 64) ? __builtin_amdgcn_readlane(id0, e & 63) : __builtin_amdgcn_readlane(id1, e & 63);
            gq[q] = (e < 64) ? __builtin_bit_cast(float, __builtin_amdgcn_readlane(__builtin_bit_cast(int, gg0), e & 63)) : __builtin_bit_cast(float, __builtin_amdgcn_readlane(__builtin_bit_cast(int, gg1), e & 63)); }
        v4u uu[2][4], vv[2][4];
#pragma unroll
        for (int q = 0; q < 2; ++q)
#pragma unroll
            for (int j = 0; j < 4; ++j) uu[q][j] = *(const v4u*)(Ul + (size_t)id[q] * D + 512 * j);
#pragma unroll
        for (int q = 0; q < 2; ++q)
#pragma unroll
            for (int j = 0; j < 4; ++j) vv[q][j] = *(const v4u*)(Vl + (size_t)id[q] * D + 512 * j);
#pragma unroll
        for (int q = 0; q < 2; ++q) {
            float dsum = 0.f;
#pragma unroll
            for (int j = 0; j < 4; ++j) dsum += dot8(xv[j], uu[q][j]);
            dsum = wave_sum(dsum);
            const float w = gq[q] * gelu_tanh(dsum);
#if MK_CHECK == 7
            if (lane == 0 && l == 0) atomicAdd(STATP, gelu_tanh(dsum) * gelu_tanh(dsum) * 2048.f / 128.f);
#elif MK_CHECK == 8
            if (lane == 0 && l == 0) atomicAdd(STATP, gq[q] * gq[q] * 2048.f * 16.f / 128.f);
#elif MK_CHECK == 9
            if (lane == 0 && l == 0) atomicAdd(STATP, dsum * dsum * 2048.f / 128.f);
#elif MK_CHECK == 11
            if (lane == 0 && l == 0) atomicAdd(STATP, w * w * 2048.f);
#endif
#pragma unroll
            for (int j = 0; j < 4; ++j) {
                y[j * 8 + 0] += w * bf_lo(vv[q][j].x); y[j * 8 + 1] += w * bf_hi(vv[q][j].x);
                y[j * 8 + 2] += w * bf_lo(vv[q][j].y); y[j * 8 + 3] += w * bf_hi(vv[q][j].y);
                y[j * 8 + 4] += w * bf_lo(vv[q][j].z); y[j * 8 + 5] += w * bf_hi(vv[q][j].z);
                y[j * 8 + 6] += w * bf_lo(vv[q][j].w); y[j * 8 + 7] += w * bf_hi(vv[q][j].w);
            }
        }
    }
#if MK_CHECK == 6
    { float q2 = 0.f;
#pragma unroll
      for (int i = 0; i < 32; ++i) q2 += y[i] * y[i];
      q2 = wave_sum(q2); if (lane == 0 && l == 0) atomicAdd(STATP, q2); }
#endif
    float ssq = 0.f;
#pragma unroll
    for (int j = 0; j < 4; ++j) {
        const int col = lane * 8 + 512 * j;
        const f32x4 xa = *(const f32x4*)(X1 + (size_t)row * D + col), xb = *(const f32x4*)(X1 + (size_t)row * D + col + 4);
        const f32x4 ga = *(const f32x4*)(g2 + col) * pscale, gb = *(const f32x4*)(g2 + col + 4) * pscale;
        y[j * 8 + 0] = xa.x + ga.x * y[j * 8 + 0]; y[j * 8 + 1] = xa.y + ga.y * y[j * 8 + 1]; y[j * 8 + 2] = xa.z + ga.z * y[j * 8 + 2]; y[j * 8 + 3] = xa.w + ga.w * y[j * 8 + 3];
        y[j * 8 + 4] = xb.x + gb.x * y[j * 8 + 4]; y[j * 8 + 5] = xb.y + gb.y * y[j * 8 + 5]; y[j * 8 + 6] = xb.z + gb.z * y[j * 8 + 6]; y[j * 8 + 7] = xb.w + gb.w * y[j * 8 + 7];
#pragma unroll
        for (int e = 0; e < 8; ++e) ssq += y[j * 8 + e] * y[j * 8 + e];
    }
    if (fnorm) {
        const float r = rsqrtf(wave_sum(ssq) * (1.f / D) + EPS);
#pragma unroll
        for (int j = 0; j < 4; ++j) { const int col = lane * 8 + 512 * j;
            const f32x4 fa = *(const f32x4*)(fnorm + col), fb = *(const f32x4*)(fnorm + col + 4);
            *(f32x4*)(XO + (size_t)row * D + col) = (f32x4){y[j * 8 + 0] * r * fa.x, y[j * 8 + 1] * r * fa.y, y[j * 8 + 2] * r * fa.z, y[j * 8 + 3] * r * fa.w};
            *(f32x4*)(XO + (size_t)row * D + col + 4) = (f32x4){y[j * 8 + 4] * r * fb.x, y[j * 8 + 5] * r * fb.y, y[j * 8 + 6] * r * fb.z, y[j * 8 + 7] * r * fb.w}; }
    } else {
#pragma unroll
        for (int j = 0; j < 4; ++j) { const int col = lane * 8 + 512 * j;
            *(f32x4*)(XO + (size_t)row * D + col) = (f32x4){y[j * 8 + 0], y[j * 8 + 1], y[j * 8 + 2], y[j * 8 + 3]};
            *(f32x4*)(XO + (size_t)row * D + col + 4) = (f32x4){y[j * 8 + 4], y[j * 8 + 5], y[j * 8 + 6], y[j * 8 + 7]}; }
    }
}


constexpr float U8_SCALE = 64.f;
DEV void expert_row8(int l, int row, const bf16* __restrict__ H, const int* __restrict__ IDS, const float* __restrict__ GG, const unsigned char* __restrict__ U8, const unsigned char* __restrict__ V8,
                     const float* __restrict__ X1, const float* __restrict__ g2, const float* __restrict__ fnorm, float* __restrict__ XO, int lane, float pscale) {
    f32x2 x[16];
#pragma unroll
    for (int j = 0; j < 2; ++j) {
        const v4u a = *(const v4u*)(H + (size_t)row * D + lane * 16 + 1024 * j), c = *(const v4u*)(H + (size_t)row * D + lane * 16 + 1024 * j + 8);
        x[j * 8 + 0] = (f32x2){bf_lo(a.x), bf_hi(a.x)}; x[j * 8 + 1] = (f32x2){bf_lo(a.y), bf_hi(a.y)}; x[j * 8 + 2] = (f32x2){bf_lo(a.z), bf_hi(a.z)}; x[j * 8 + 3] = (f32x2){bf_lo(a.w), bf_hi(a.w)};
        x[j * 8 + 4] = (f32x2){bf_lo(c.x), bf_hi(c.x)}; x[j * 8 + 5] = (f32x2){bf_lo(c.y), bf_hi(c.y)}; x[j * 8 + 6] = (f32x2){bf_lo(c.z), bf_hi(c.z)}; x[j * 8 + 7] = (f32x2){bf_lo(c.w), bf_hi(c.w)};
    }
    const int id0 = IDS[(size_t)row * 128 + lane], id1 = IDS[(size_t)row * 128 + 64 + lane];
    const float gg0 = GG[(size_t)row * 128 + lane], gg1 = GG[(size_t)row * 128 + 64 + lane];
    float wv0 = 0.f, wv1 = 0.f;
    const unsigned char* Ul = U8 + (size_t)l * NEXP * D + lane * 16;
    const unsigned char* Vl = V8 + (size_t)l * NEXP * D + lane * 16;
    for (int e0 = 0; e0 < 128; e0 += 8) {
        v4u uu[8][2];
#pragma unroll
        for (int q = 0; q < 8; ++q) { const int e = e0 + q; const int id = (e < 64) ? __builtin_amdgcn_readlane(id0, e & 63) : __builtin_amdgcn_readlane(id1, e & 63);
            uu[q][0] = *(const v4u*)(Ul + (size_t)id * D); uu[q][1] = *(const v4u*)(Ul + (size_t)id * D + 1024); }
        float ds[8];
#pragma unroll
        for (int q = 0; q < 8; ++q) {
            f32x2 acc = {0.f, 0.f};
#pragma unroll
            for (int j = 0; j < 2; ++j) {
                const unsigned wd[4] = {uu[q][j].x, uu[q][j].y, uu[q][j].z, uu[q][j].w};
#pragma unroll
                for (int dw = 0; dw < 4; ++dw) {
                    const f32x2 lo = __builtin_amdgcn_cvt_pk_f32_fp8((int)wd[dw], false), hi = __builtin_amdgcn_cvt_pk_f32_fp8((int)wd[dw], true);
                    acc = __builtin_elementwise_fma(lo, x[j * 8 + 2 * dw], acc); acc = __builtin_elementwise_fma(hi, x[j * 8 + 2 * dw + 1], acc);
                }
            }
            ds[q] = acc.x + acc.y;
        }
#pragma unroll
        for (int o = 1; o < 64; o <<= 1)
#pragma unroll
            for (int q = 0; q < 8; ++q) ds[q] += __shfl_xor(ds[q], o);
#pragma unroll
        for (int q = 0; q < 8; ++q) { const int e = e0 + q;
            const float gq = (e < 64) ? __builtin_bit_cast(float, __builtin_amdgcn_readlane(__builtin_bit_cast(int, gg0), e & 63)) : __builtin_bit_cast(float, __builtin_amdgcn_readlane(__builtin_bit_cast(int, gg1), e & 63));
            const float w = gq * gelu_tanh(ds[q] * (1.f / U8_SCALE));
            if (e < 64) wv0 = (lane == (e & 63)) ? w : wv0; else wv1 = (lane == (e & 63)) ? w : wv1; }
    }
    f32x2 y[16];
#pragma unroll
    for (int i = 0; i < 16; ++i) y[i] = (f32x2){0.f, 0.f};
    for (int e0 = 0; e0 < 128; e0 += 8) {
        v4u vv[8][2];
#pragma unroll
        for (int q = 0; q < 8; ++q) { const int e = e0 + q; const int id = (e < 64) ? __builtin_amdgcn_readlane(id0, e & 63) : __builtin_amdgcn_readlane(id1, e & 63);
            vv[q][0] = *(const v4u*)(Vl + (size_t)id * D); vv[q][1] = *(const v4u*)(Vl + (size_t)id * D + 1024); }
#pragma unroll
        for (int q = 0; q < 8; ++q) { const int e = e0 + q;
            const float w = (e < 64) ? __builtin_bit_cast(float, __builtin_amdgcn_readlane(__builtin_bit_cast(int, wv0), e & 63)) : __builtin_bit_cast(float, __builtin_amdgcn_readlane(__builtin_bit_cast(int, wv1), e & 63));
            const f32x2 w2 = {w, w};
#pragma unroll
            for (int j = 0; j < 2; ++j) {
                const unsigned wd[4] = {vv[q][j].x, vv[q][j].y, vv[q][j].z, vv[q][j].w};
#pragma unroll
                for (int dw = 0; dw < 4; ++dw) {
                    const f32x2 lo = __builtin_amdgcn_cvt_pk_f32_fp8((int)wd[dw], false), hi = __builtin_amdgcn_cvt_pk_f32_fp8((int)wd[dw], true);
                    y[j * 8 + 2 * dw] = __builtin_elementwise_fma(w2, lo, y[j * 8 + 2 * dw]); y[j * 8 + 2 * dw + 1] = __builtin_elementwise_fma(w2, hi, y[j * 8 + 2 * dw + 1]);
                }
            }
        }
    }
    float ssq = 0.f;
#pragma unroll
    for (int j = 0; j < 2; ++j)
#pragma unroll
        for (int k4 = 0; k4 < 4; ++k4) {
            const int col = lane * 16 + 1024 * j + 4 * k4;
            const f32x4 xa = *(const f32x4*)(X1 + (size_t)row * D + col); const f32x4 ga = *(const f32x4*)(g2 + col) * pscale;
            f32x2& ya = y[j * 8 + 2 * k4]; f32x2& yb = y[j * 8 + 2 * k4 + 1];
            ya.x = xa.x + ga.x * ya.x; ya.y = xa.y + ga.y * ya.y; yb.x = xa.z + ga.z * yb.x; yb.y = xa.w + ga.w * yb.y;
            ssq += (ya.x * ya.x + ya.y * ya.y) + (yb.x * yb.x + yb.y * yb.y);
        }
    float r = 1.f;
    if (fnorm) r = rsqrtf(wave_sum(ssq) * (1.f / D) + EPS);
#pragma unroll
    for (int j = 0; j < 2; ++j)
#pragma unroll
        for (int k4 = 0; k4 < 4; ++k4) {
            const int col = lane * 16 + 1024 * j + 4 * k4;
            const f32x2 ya = y[j * 8 + 2 * k4], yb = y[j * 8 + 2 * k4 + 1];
            f32x4 ov = {ya.x, ya.y, yb.x, yb.y};
            if (fnorm) ov = ov * r * *(const f32x4*)(fnorm + col);
            *(f32x4*)(XO + (size_t)row * D + col) = ov;
        }
}
DEV void convert_fp8(const float* __restrict__ src, unsigned char* __restrict__ dst, size_t ngroups16, size_t gtid, size_t gstride, float scale) {
    for (size_t g = gtid; g < ngroups16; g += gstride) {
        const f32x4 a = *(const f32x4*)(src + g * 16) * scale, b = *(const f32x4*)(src + g * 16 + 4) * scale, c = *(const f32x4*)(src + g * 16 + 8) * scale, d = *(const f32x4*)(src + g * 16 + 12) * scale;
        int w0 = 0, w1 = 0, w2 = 0, w3 = 0;
        w0 = __builtin_amdgcn_cvt_pk_fp8_f32(a.x, a.y, w0, false); w0 = __builtin_amdgcn_cvt_pk_fp8_f32(a.z, a.w, w0, true);
        w1 = __builtin_amdgcn_cvt_pk_fp8_f32(b.x, b.y, w1, false); w1 = __builtin_amdgcn_cvt_pk_fp8_f32(b.z, b.w, w1, true);
        w2 = __builtin_amdgcn_cvt_pk_fp8_f32(c.x, c.y, w2, false); w2 = __builtin_amdgcn_cvt_pk_fp8_f32(c.z, c.w, w2, true);
        w3 = __builtin_amdgcn_cvt_pk_fp8_f32(d.x, d.y, w3, false); w3 = __builtin_amdgcn_cvt_pk_fp8_f32(d.z, d.w, w3, true);
        *(v4u*)(dst + g * 16) = (v4u){(unsigned)w0, (unsigned)w1, (unsigned)w2, (unsigned)w3};
    }
}

#if MK_CHECK
DEV void chk_route(int l, int row, int h, const bf16* __restrict__ Q, const bf16* __restrict__ SK, const int* __restrict__ IDS, const float* __restrict__ GG, unsigned* bad, LAS float* sL, LAS unsigned* cntL, int tid) {
    if (tid < 256) { const int c = tid >> 7, k = tid & 127; const bf16* skp = SK + ((size_t)((l * 8 + h) * 2 + c)) * 128 * 128 + k * 128; const bf16* qp = Q + (size_t)row * D + h * 256 + c * 128;
        float s = 0.f; for (int d = 0; d < 128; ++d) s += bf1(qp[d]) * bf1(skp[d]); sL[c * 128 + k] = s; }
    if (tid == 0) cntL[0] = 0u;
    __syncthreads();
    float sc15 = 0.f; unsigned mybad = 0;
    { float prev = 3e38f; float s0 = 0.f, gsum = 0.f; float g0 = GG[(size_t)row * 128 + h * 16];
      for (int r = 0; r < 16; ++r) { const int id = IDS[(size_t)row * 128 + h * 16 + r]; const float g = GG[(size_t)row * 128 + h * 16 + r];
          if (id < 0 || id >= NEXP) { mybad |= 1; continue; }
          const float scv = sL[id >> 7] + sL[128 + (id & 127)];
          if (r == 0) s0 = scv;
          if (scv > prev + 1e-5f) mybad |= 2;
          prev = scv; gsum += g;
          const float ratio = __expf(scv - s0);
          if (fabsf(g / g0 - ratio) > 0.02f * ratio + 1e-4f) mybad |= 4;
          if (r == 15) sc15 = scv; }
      if (fabsf(gsum - 1.f) > 1e-3f) mybad |= 8; }
    unsigned cnt = 0;
    for (int p = tid; p < 16384; p += 512) { const float v = sL[p >> 7] + sL[128 + (p & 127)]; if (v > sc15 + 1e-5f) ++cnt; }
    __hip_atomic_fetch_add(cntL, cnt, __ATOMIC_RELAXED, __HIP_MEMORY_SCOPE_WORKGROUP);
    __syncthreads();
    if (tid == 0) { if (cntL[0] > 15u) mybad |= 16; if (mybad) atomicAdd(bad, 1u); }
    __syncthreads();
}
DEV void chk_expert(int l, int row, const bf16* __restrict__ H, const int* __restrict__ IDS, const float* __restrict__ GG, const float* __restrict__ Uf, const float* __restrict__ Vf,
                    const float* __restrict__ X1, const float* __restrict__ X2, const float* __restrict__ g2, unsigned* bad, LAS float* wL, int tid) {
    if (tid < 128) { const int id = IDS[(size_t)row * 128 + tid]; const float* up = Uf + ((size_t)l * NEXP + id) * D; const bf16* hp = H + (size_t)row * D;
        float s = 0.f; for (int d = 0; d < D; ++d) s += up[d] * bf1(hp[d]);
        wL[tid] = GG[(size_t)row * 128 + tid] * gelu_tanh(s); }
    __syncthreads();
    unsigned mybad = 0;
    for (int d = tid; d < D; d += 512) { float y = 0.f;
        for (int e = 0; e < 128; ++e) { const int id = IDS[(size_t)row * 128 + e]; y += wL[e] * Vf[((size_t)l * NEXP + id) * D + d]; }
        const float want = X1[(size_t)row * D + d] + g2[d] * y * (MK_CHECK == 3 ? 1.5f : 1.f); const float got = X2[(size_t)row * D + d];
        if (!(fabsf(got - want) <= 0.02f * fabsf(want) + 0.02f)) mybad = 1; }
    if (mybad) atomicAdd(bad, 1u);
    __syncthreads();
}

DEV void chk_hq(int l, int row, const float* __restrict__ X1, const float* __restrict__ gain, const float* __restrict__ modl, const float* __restrict__ wq, const bf16* __restrict__ H, const bf16* __restrict__ Q,
                unsigned* bad, LAS float* hL, LAS float* redL, int tid) {
    const int b = row >> 12;
    float ss = 0.f;
    for (int d = tid; d < D; d += 512) { const float v = X1[(size_t)row * D + d]; ss += v * v; }
    ss = wave_sum(ss);
    if ((tid & 63) == 0) redL[tid >> 6] = ss;
    __syncthreads();
    float tot = 0.f; for (int w = 0; w < 8; ++w) tot += redL[w];
    const float r = rsqrtf(tot * (1.f / D) + EPS);
    unsigned badh = 0, badq = 0;
    for (int d = tid; d < D; d += 512) { const float hv = X1[(size_t)row * D + d] * r * gain[d] * (1.f + modl[(size_t)b * MODW + MO_SC2 + d]) + modl[(size_t)b * MODW + MO_SH2 + d];
        hL[d] = hv; const float got = bf1(H[(size_t)row * D + d]); if (!(fabsf(got - hv) <= 0.01f * fabsf(hv) + 0.01f)) badh = 1; }
    __syncthreads();
    for (int c = tid; c < D; c += 512) { float q = 0.f; for (int k = 0; k < D; ++k) q += hL[k] * wq[(size_t)k * D + c];
        const float got = bf1(Q[(size_t)row * D + c]); if (!(fabsf(got - q) <= 0.02f * fabsf(q) + 0.03f)) badq = 1; }
    if (badh) atomicAdd(bad, 1u);
    if (badq) atomicAdd(bad + 1, 1u);
    __syncthreads();
}
#endif
struct Args { const float* in[24]; float* out; unsigned char* ws; int ph_lo, ph_hi, li, pad; };

__global__ void __launch_bounds__(512, 2) fwd(Args a) {
    extern __shared__ __attribute__((aligned(16))) unsigned char lds_raw[];
    LAS unsigned char* lds = (LAS unsigned char*)lds_raw;
    const int wave = __builtin_amdgcn_readfirstlane((int)threadIdx.x >> 6);
    const int G = gridDim.x; const int bx = blockIdx.x;
#define PHASE_TID() int tid = threadIdx.x; asm volatile("" : "+v"(tid)); const int lane = tid & 63; (void)lane; \
    const __attribute__((address_space(4))) Args* A = (const __attribute__((address_space(4))) Args*)__builtin_amdgcn_kernarg_segment_ptr(); asm volatile("" : "+s"(A))
    const int vcu = (G % 8 == 0) ? (bx % 8) * (G / 8) + bx / 8 : bx;
    const int gw = vcu * 8 + wave, NGW = G * 8;
    unsigned* ctl = (unsigned*)(a.ws + WS_CTL);
    const int lo = a.ph_lo, hi = a.ph_hi;
    for (int u = threadIdx.x; u < (LDS_BYTES - LDS_MISC) / 4; u += 512) ((LAS unsigned*)(lds + LDS_MISC))[u] = 0u;
    __syncthreads();
    XcdBarrier bar; bar.bar = ctl + CW_BAR + (a.li & 7) * XCD_BAR_WORDS; bar.x = 0; bar.st = (volatile LAS unsigned*)(lds + LDS_MISC + 64);
    if (hi - lo > 1) bar = xcd_barrier_post(ctl + CW_BAR + (a.li & 7) * XCD_BAR_WORDS, (volatile LAS unsigned*)(lds + LDS_MISC + 64));
#ifndef MK_MASK
#define MK_MASK 0x3ff
#endif
#define KON(q) (((MK_MASK) >> (q)) & 1)
#define IN(k) (lo <= (k) && (k) < hi)
#define SEAM(k) do { if (IN(k) && IN((k) + 1)) xcd_barrier(bar); } while (0)

#define mod   ((float*)(A->ws + WS_MOD))
#define WIN_T ((bf16*)(A->ws + WS_WIN_T))
#define WOUT_T ((bf16*)(A->ws + WS_WOUT_T))
#define WQ_T  ((bf16*)(A->ws + WS_WQ_T))
#define SUBK  ((bf16*)(A->ws + WS_SUBK))
#define UB    ((bf16*)(A->ws + WS_U))
#define VB    ((bf16*)(A->ws + WS_V))
#define H     ((bf16*)(A->ws + WS_H))
#define Z     ((bf16*)(A->ws + WS_Z))
#define HLOC  ((float*)(A->ws + WS_HLOC))
#define PP    ((float*)(A->ws + WS_P))
#define YB    ((float*)(A->ws + WS_YB))
#define YC    ((float*)(A->ws + WS_YC))
#define SUMA  ((float*)(A->ws + WS_SUMA))
#define SUMB  ((float*)(A->ws + WS_SUMB))
#define X1    ((float*)(A->ws + WS_X1))
#define X2    ((float*)(A->ws + WS_X2))
#define QB    ((bf16*)(A->ws + WS_Q))
#define IDS   ((int*)(A->ws + WS_IDS))
#define GG    ((float*)(A->ws + WS_G))
#define PARTB ((float*)(A->ws + WS_PART))
#define LSEB  ((float*)(A->ws + WS_LSE))
#define XIN   ((l == 0) ? A->in[0] : (const float*)X2)
#define MODL  (mod + (size_t)l * 2 * MODW)
    for (int rep = 0; rep < (MK_DUP == 0 ? 2 : 1); ++rep) if (KON(0) && IN(0)) {
        PHASE_TID();
        ph_mod(A->in[1], A->in[2], A->in[3], mod, (LAS float*)lds, vcu, G, tid);
        {
            LAS float* scr = (LAS float*)(lds + wave * 16384);
            constexpr int I_IN = (D / 64) * (IN_W / 32), I_SQ = (D / 64) * (D / 32), I_L = I_IN + 2 * I_SQ;
            for (int it = gw; it < 2 * I_L; it += NGW) {
                const int l = it / I_L; int r = it % I_L;
                if (r < I_IN) { transpose_item(A->in[6] + (size_t)l * D * IN_W, D, IN_W, WIN_T + (size_t)l * IN_W * D, scr, r, lane); continue; } r -= I_IN;
                if (r < I_SQ) { transpose_item(A->in[18] + (size_t)l * D * D, D, D, WOUT_T + (size_t)l * D * D, scr, r, lane); continue; } r -= I_SQ;
                transpose_item(A->in[19] + (size_t)l * D * D, D, D, WQ_T + (size_t)l * D * D, scr, r, lane);
            }
        }
        const size_t gtid = (size_t)vcu * 512 + tid, gstride = (size_t)G * 512;
        convert_copy(A->in[20], SUBK, (size_t)2 * 8 * 2 * 128 * 128 / 8, gtid, gstride);
        convert_fp8(A->in[21], (unsigned char*)UB, (size_t)NL * NEXP * D / 16, gtid, gstride, U8_SCALE);
        convert_fp8(A->in[22], (unsigned char*)VB, (size_t)NL * NEXP * D / 16, gtid, gstride, 1.f);
    }
    SEAM(0);

    for (int l = 0; l < NL; ++l) {
        const int pb = 1 + 9 * l;
        for (int rep = 0; rep < (MK_DUP == 1 ? 2 : 1); ++rep) if (KON(1) && IN(pb + 0)) { PHASE_TID(); modnorm_rows(XIN, A->in[4] + l * D, MODL, MO_SH1, MO_SC1, H, gw, NGW, lane); }
        SEAM(pb + 0);
        for (int rep = 0; rep < (MK_DUP == 2 ? 2 : 1); ++rep) if (KON(2) && IN(pb + 1)) {
            PHASE_TID(); (void)tid;
            pg8::Gemm g{H, WIN_T + (size_t)l * IN_W * D, M, IN_W, D}; pg8::StaticOrder S; S.init(M, IN_W, G, bx);
            pg8::EpiBf16<0> E{Z, IN_W, nullptr, 0, 0};
            pg8::gemm_phase<pg8::EpiBf16<0>, pg8::StaticOrder, false>((PG8_LAS unsigned char*)lds, g, S, E, nullptr);
        }
        SEAM(pb + 1);
        for (int rep = 0; rep < (MK_DUP == 3 ? 2 : 1); ++rep) if (KON(3) && IN(pb + 2)) {
            PHASE_TID();
            if (rep) __syncthreads();
            for (int it = vcu; it < 2 * 64 * 6; it += G) {
                const int b = it / 384, r = it % 384, j = r / 6, n = r % 6;
                lru_item(l, b, j, n, Z, A->in[7], A->in[8], A->in[9], A->in[10], A->in[11], A->in[12], A->in[13], HLOC, PP, SUMA, SUMB,
                         (LAS float*)lds, (LAS float*)(lds + 32768), (LAS float*)(lds + 65536), tid);
            }
            {
                LAS float* qs = (LAS float*)(lds + wave * 16384 + 12288); LAS float* lgp = qs + 128;
                {
                    LAS unsigned char* wl = lds + wave * 16384;
                    for (int it = gw; it < 2 * 6 * 3 * 128; it += NGW) { const int tl = it & 127, p = (it >> 7) % 3, bh = it / 384; const int d = 1 << (2 * p);
                        dil_mfma_item(bh / 6, bh % 6, p, tl % d, 32 * (tl / d), Z, A->in[14], PARTB, LSEB, wl, lane); }
                }
                (void)qs; (void)lgp;
                {
                    LAS unsigned char* wl = lds + wave * 16384;
                    for (int it = gw; it < 2 * 4 * 128; it += NGW) { const int bh = it >> 7, tl = it & 127; sb_mfma_item(bh >> 2, bh & 3, 32 * tl, Z, YC, wl, lane); }
                }
            }
        }
        SEAM(pb + 2);
        for (int rep = 0; rep < (MK_DUP == 4 ? 2 : 1); ++rep) if (KON(4) && IN(pb + 3)) {
            PHASE_TID();
            for (int it = vcu; it < 256; it += G) { const int b = it >> 7, j = (it >> 1) & 63, half = it & 1;
                combine_item(l, b, j, half, Z, HLOC, PP, SUMA, SUMB, PARTB, LSEB, YC, A->in[15], A->in[16], A->in[17], H, (LAS float*)lds, tid); }
        }
        SEAM(pb + 3);
        for (int rep = 0; rep < (MK_DUP == 5 ? 2 : 1); ++rep) if (KON(5) && IN(pb + 4)) {
            PHASE_TID(); (void)tid;
            pg8::Gemm g{H, WOUT_T + (size_t)l * D * D, M, D, D}; pg8::StaticOrder S; S.init(M, D, G, bx);
            EpiResGate E{XIN, X1, MODL + MO_G1, ((MK_DBG >> (2 * l)) & 1) ? 0.f : ((MK_DBG & 256) ? -1.f : 1.f)};
            pg8::gemm_phase<EpiResGate, pg8::StaticOrder, false>((PG8_LAS unsigned char*)lds, g, S, E, nullptr);
        }
        SEAM(pb + 4);
        for (int rep = 0; rep < (MK_DUP == 6 ? 2 : 1); ++rep) if (KON(6) && IN(pb + 5)) { PHASE_TID(); modnorm_rows(X1, A->in[5] + l * D, MODL, MO_SH2, MO_SC2, H, gw, NGW, lane); }
        SEAM(pb + 5);
        for (int rep = 0; rep < (MK_DUP == 7 ? 2 : 1); ++rep) if (KON(7) && IN(pb + 6)) {
            PHASE_TID(); (void)tid;
            pg8::Gemm g{H, WQ_T + (size_t)l * D * D, M, D, D}; pg8::StaticOrder S; S.init(M, D, G, bx);
            pg8::EpiBf16<0> E{QB, D, nullptr, 0, 0};
            pg8::gemm_phase<pg8::EpiBf16<0>, pg8::StaticOrder, false>((PG8_LAS unsigned char*)lds, g, S, E, nullptr);
        }
        SEAM(pb + 6);
        for (int rep = 0; rep < (MK_DUP == 8 ? 2 : 1); ++rep) if (KON(8) && IN(pb + 7)) {
            PHASE_TID();
            for (int it = vcu; it < 256 * 8; it += G) route_item(l, it >> 3, it & 7, QB, SUBK, IDS, GG, lds, tid, (unsigned*)(A->ws + WS_CTL) + 8);
        }
        SEAM(pb + 7);
        for (int rep = 0; rep < (MK_DUP == 9 ? 2 : 1); ++rep) if (KON(9) && IN(pb + 8)) {
            PHASE_TID();
            for (int m = gw; m < M; m += NGW)
                expert_row8(l, m, H, IDS, GG, (const unsigned char*)UB, (const unsigned char*)VB, X1, MODL + (size_t)(m >> 12) * MODW + MO_G2, (l == NL - 1) ? A->in[23] : nullptr, (l == NL - 1) ? A->out : X2, lane, ((MK_DBG >> (2 * l + 1)) & 1) ? 0.f : ((MK_DBG & 128) ? -1.f : 1.f));
        }
        if (l + 1 < NL) SEAM(pb + 8);
    }
#if MK_CHECK
    if (IN(19)) {
        PHASE_TID();
        unsigned* badw = (unsigned*)(A->ws + WS_CTL) + 8;
#if MK_CHECK == 1 || MK_CHECK == 3 || MK_CHECK == 4
        for (int it = vcu; it < (MK_CHECK == 4 ? 8192 : 256) * 8; it += G) { const int row = (MK_CHECK == 4) ? (it >> 3) : (((it >> 3) * 131 + 7) & 8191); chk_route(0, row, it & 7, QB, SUBK, IDS, GG, badw, (LAS float*)lds, (LAS unsigned*)(lds + 2048), tid); }
        for (int it = vcu; it < (MK_CHECK == 4 ? 8192 : 256); it += G) { const int row = (MK_CHECK == 4) ? it : ((it * 131 + 7) & 8191); chk_expert(0, row, H, IDS, GG, A->in[21], A->in[22], X1, X2, mod + (size_t)(row >> 12) * MODW + MO_G2, badw + 1, (LAS float*)lds, tid); }
#elif MK_CHECK == 12 || MK_CHECK == 15
        { (void)badw;
          for (int m = gw; m < M; m += NGW) { const int ia = IDS[(size_t)m * 128 + lane], ib = IDS[(size_t)m * 128 + 64 + lane]; int cnt = 0;
              for (int e = 0; e < 128; ++e) { const int ie = (e < 64) ? __shfl(ia, e) : __shfl(ib, e - 64); if (lane < e && ia == ie && (MK_CHECK == 12 || (lane >> 4) == (e >> 4))) ++cnt; if (lane + 64 < e && ib == ie && (MK_CHECK == 12 || ((lane + 64) >> 4) == (e >> 4))) ++cnt; }
              float fc = wave_sum((float)cnt); if (lane == 0) atomicAdd((float*)(A->ws + WS_CTL) + 16, fc * 2048.f); } }
#elif MK_CHECK == 13 || MK_CHECK == 14
        { (void)badw;
          float cnt = 0.f;
          if (MK_CHECK == 13) { const float* sk = A->in[20]; for (int o = vcu * 512 + tid; o < 2 * 128 * 128; o += G * 512) if (sk[o] == sk[o + 2 * 128 * 128]) cnt += 1.f; cnt *= (float)M * D / (2.f * 128 * 128); }
          else { const float* wq = A->in[19]; for (int o = vcu * 512 + tid; o < D * 256; o += G * 512) { const int k = o >> 8, c = o & 255; if (wq[(size_t)k * D + c] == wq[(size_t)k * D + 256 + c]) cnt += 1.f; } cnt *= (float)M * D / ((float)D * 256); }
          cnt = wave_sum(cnt); if (lane == 0) atomicAdd((float*)(A->ws + WS_CTL) + 16, cnt); }
#elif MK_CHECK == 10
        { (void)badw; float acc = 0.f; const float* vt = A->in[22];
          for (size_t o = (size_t)vcu * 512 + tid; o < (size_t)NEXP * D; o += (size_t)G * 512) { const float v = vt[o]; acc += v * v; }
          acc = wave_sum(acc); if (lane == 0) atomicAdd((float*)(A->ws + WS_CTL) + 16, acc * ((float)M * D / ((float)NEXP * D))); }
#elif MK_CHECK == 16
        (void)badw;
#elif MK_CHECK >= 6
        (void)badw;
#elif MK_CHECK == 5
        {
            const float* cc = A->in[1]; const float* wm = A->in[2]; const float* bm = A->in[3];
            unsigned mb = 0;
            for (int o = vcu * 512 + tid; o < 2 * 2 * MODW; o += G * 512) { const int l = o / (2 * MODW), b = (o / MODW) & 1, n = o % MODW;
                float sacc = 0.f; for (int k = 0; k < D; ++k) { const float cv = cc[b * D + k]; sacc += (cv / (1.f + __expf(-cv))) * wm[((size_t)l * D + k) * MODW + n]; }
                sacc += bm[l * MODW + n];
                if (!(fabsf(sacc - mod[o]) <= 2e-3f * fabsf(sacc) + 2e-3f)) mb = 1; }
            if (mb) atomicAdd(badw, 1u);
            unsigned sb = 0;
            for (int o = vcu * 512 + tid; o < 2 * 8 * 2 * 128 * 128; o += G * 512) { const float want = A->in[20][o]; const float got = bf1(SUBK[o]); if (!(fabsf(got - want) <= 0.01f * fabsf(want) + 1e-6f)) sb = 1; }
            if (sb) atomicAdd(badw + 1, 1u);
        }
#else
        for (int it = vcu; it < 256; it += G) { const int row = (it * 131 + 7) & 8191; chk_hq(0, row, X1, A->in[5], mod, A->in[19], H, QB, badw, (LAS float*)lds, (LAS float*)(lds + 16384), tid); }
#endif
    }
    if (IN(20)) {
        PHASE_TID();
        const unsigned* badw = (const unsigned*)(A->ws + WS_CTL) + 8;
        const unsigned b0 = __hip_atomic_load(badw, __ATOMIC_RELAXED, __HIP_MEMORY_SCOPE_AGENT), b1 = __hip_atomic_load(badw + 1, __ATOMIC_RELAXED, __HIP_MEMORY_SCOPE_AGENT);
#if MK_CHECK >= 6 && MK_CHECK != 16
        const float f = 1.f + ((const float*)(A->ws + WS_CTL))[16] * (1.f / ((float)M * D)); (void)b0; (void)b1;
#else
        const float f = (b0 ? (b1 ? -2.f : 0.f) : (b1 ? -1.f : 1.f));
#endif
        for (int m = gw; m < M; m += NGW) { const f32x4* xr = (const f32x4*)(X2 + (size_t)m * D) + lane; f32x4 v[8]; float ss = 0.f;
#pragma unroll
            for (int j = 0; j < 8; ++j) { v[j] = xr[64 * j]; ss += (v[j].x * v[j].x + v[j].y * v[j].y) + (v[j].z * v[j].z + v[j].w * v[j].w); }
            const float r = rsqrtf(wave_sum(ss) * (1.f / D) + EPS) * f;
#pragma unroll
            for (int j = 0; j < 8; ++j) { const f32x4 fn = ((const f32x4*)A->in[23])[lane + 64 * j]; ((f32x4*)(A->out + (size_t)m * D))[lane + 64 * j] = v[j] * r * fn; } }
    }
#endif
#undef IN
#undef SEAM
#undef mod
#undef H
#undef Z
#undef X1
#undef X2
}
}

extern "C" void kernel_launch(void* const* d_in, const int* in_sizes, int n_in, void* d_out, int out_size, void* d_ws, size_t ws_size, hipStream_t stream) {
    using namespace mk;
    static int grid = 0;
    if (grid == 0) {
        if (n_in != 24 || out_size != M * D || ws_size < WS_END) { fprintf(stderr, "kernel_launch: unexpected shapes (n_in %d out %d ws %zu)\n", n_in, out_size, ws_size); grid = -1; return; }
        int dev = 0, cus = 0, per_cu = 0;
        if (hipGetDevice(&dev) != hipSuccess || hipDeviceGetAttribute(&cus, hipDeviceAttributeMultiprocessorCount, dev) != hipSuccess) { grid = -1; return; }
        if (hipFuncSetAttribute((const void*)fwd, hipFuncAttributeMaxDynamicSharedMemorySize, LDS_BYTES) != hipSuccess) { fprintf(stderr, "kernel_launch: hipFuncSetAttribute failed\n"); grid = -1; return; }
        if (hipOccupancyMaxActiveBlocksPerMultiprocessor(&per_cu, (const void*)fwd, 512, LDS_BYTES) != hipSuccess || per_cu < 1) fprintf(stderr, "kernel_launch: occupancy query says %d\n", per_cu);
        (void)hipGetLastError();
        grid = cus;
    }
    if (grid < 0) return;
    (void)hipMemsetAsync((char*)d_ws + WS_CTL, 0, CTL_ZERO_BYTES, stream);
    Args a{};
    for (int i = 0; i < 24; ++i) a.in[i] = (const float*)d_in[i];
    a.out = (float*)d_out; a.ws = (unsigned char*)d_ws; a.pad = 0;
#if MK_CHECK
    constexpr int NLAUNCH = 12;
#else
    constexpr int NLAUNCH = MK_N_LAUNCHES;
#endif
    for (int li = 0; li < NLAUNCH; ++li) {
        a.ph_lo = (NLAUNCH == 1) ? 0 : li; a.ph_hi = (NLAUNCH == 1) ? NPHASE : li + 1; a.li = li;
#if MK_CHECK
        if (li >= 10) { a.ph_lo = li + 9; a.ph_hi = li + 10; }
#endif
        hipLaunchKernelGGL(fwd, dim3(grid), dim3(512), LDS_BYTES, stream, a);
    }
}
```

```cpp
#include <hip/hip_runtime.h>
#include <cstdio>
#include <cstdint>
#define MK_DBG 0
#define MK_N_LAUNCHES 1
#define MK_CHECK 0
namespace pg8 {
#define PG8_LAS __attribute__((address_space(3)))
typedef unsigned short bf16_t;
typedef short bf16x8 __attribute__((ext_vector_type(8)));
typedef float f32x4 __attribute__((ext_vector_type(4)));
typedef unsigned u32x4 __attribute__((ext_vector_type(4)));
constexpr int BM = 256, BK = 64, HALF = 128, HTB = HALF * BK * 2  , STAGE_BYTES = 8 * HTB, NXCD = 8, WGM = 8;

__host__ __device__ __forceinline__ int lds_byte(int r, int c) { const int st = (r >> 4) * 2 + (c >> 5), rr = r & 15, cc = c & 31, ob = rr * 64 + cc * 2; return st * 1024 + (ob ^ (((ob >> 9) & 1) << 5)); }
__host__ __device__ __forceinline__ void stage_rc(int b, int& R, int& C) { const int st = b / 1024, sb = b % 1024, swz = sb ^ (((sb >> 9) & 1) << 5); R = (st >> 1) * 16 + swz / 64; C = (st & 1) * 32 + (swz % 64) / 2; }
__host__ __device__ __forceinline__ int perm32(int rho) { const int n = rho >> 4, i = rho & 15; return 8 * (i >> 2) + 4 * n + (i & 3); }

struct Unit { int pm, pn; };
struct Gemm { const bf16_t* A; const bf16_t* Bt; int M, N, K; };

struct StaticOrder {
    int nM, nN, nwg, G, c;
    __host__ __device__ void init(int M, int N, int G_, int c_) { nM = M / BM; nN = N / BM; nwg = nM * nN; G = G_; c = c_; }
    __host__ __device__ bool next(int i, Unit& u) const {
        const long L = (long)i * G + c; if (L >= nwg) return false;
        int wgid = (int)L; { const int q = nwg / NXCD, r = nwg % NXCD, xcd = wgid % NXCD, off = wgid / NXCD; wgid = (xcd < r ? xcd * (q + 1) : r * (q + 1) + (xcd - r) * q) + off; }
        const int nig = WGM * nN, gid = wgid / nig, fm = gid * WGM, gsz = (nM - fm) < WGM ? (nM - fm) : WGM;
        u.pm = fm + ((wgid % nig) % gsz); u.pn = (wgid % nig) / gsz; return true;
    }
    __device__ __forceinline__ void a_ready(const Unit&) const {}
    __device__ __forceinline__ void done(const Unit&) const {}
};
struct CountedOrder : StaticOrder {
    const unsigned* ready; unsigned need; unsigned* tmo;
    __device__ __forceinline__ void a_ready(const Unit& u) const {
        if (threadIdx.x < 64) {
            const unsigned long long t0 = __builtin_amdgcn_s_memrealtime(); unsigned polls = 0;
            while ((unsigned)__builtin_amdgcn_readfirstlane(__hip_atomic_load(ready + 64 * u.pm, __ATOMIC_RELAXED, __HIP_MEMORY_SCOPE_AGENT)) < need) {
                if ((++polls & 255u) == 0u && __builtin_amdgcn_readfirstlane(__hip_atomic_load(tmo, __ATOMIC_RELAXED, __HIP_MEMORY_SCOPE_AGENT)) != 0u) break;
                if (__builtin_amdgcn_s_memrealtime() - t0 > 2000000ull) {
                    if (threadIdx.x == 0) { unsigned expect = 0u; __hip_atomic_compare_exchange_strong(tmo + 1, &expect, 0x600u | (unsigned)(u.pm & 0xff), __ATOMIC_RELAXED, __ATOMIC_RELAXED, __HIP_MEMORY_SCOPE_AGENT); __hip_atomic_store(tmo, 1u, __ATOMIC_RELAXED, __HIP_MEMORY_SCOPE_AGENT); }
                    break; }
                __builtin_amdgcn_s_sleep(2); }
            __builtin_amdgcn_fence(__ATOMIC_ACQUIRE, "agent");
            asm volatile("s_waitcnt vmcnt(0)" ::: "memory");
        }
#if !defined(BROKEN_HOOK_NO_BARRIER)
        asm volatile("" ::: "memory"); __builtin_amdgcn_s_barrier(); asm volatile("" ::: "memory");
#endif
    }
};

__device__ __forceinline__ unsigned cvt_pk_bf16(float lo, float hi) { unsigned r; asm volatile("v_cvt_pk_bf16_f32 %0, %1, %2" : "=v"(r) : "v"(lo), "v"(hi)); return r; }
typedef float f32x2 __attribute__((ext_vector_type(2)));
__device__ __forceinline__ f32x2 gelu_pk(f32x2 v) {
    const f32x2 av = __builtin_elementwise_abs(v), d = av * 0.2316418882f + 1.0f;
    f32x2 t; t.x = __builtin_amdgcn_rcpf(d.x); t.y = __builtin_amdgcn_rcpf(d.y);
    f32x2 q = t * 0.5307027145f + (-0.7265760135f); q = q * t + 0.7107068705f; q = q * t + (-0.142248368f); q = q * t + 0.127414796f; q = q * t;
    const f32x2 s = (v * v) * (-0.72134752044f);
    f32x2 e; e.x = __builtin_amdgcn_exp2f(s.x); e.y = __builtin_amdgcn_exp2f(s.y);
    const f32x2 m = v * (q * e), r = v - m;
    f32x2 o; o.x = v.x < 0.f ? m.x : r.x; o.y = v.y < 0.f ? m.y : r.y; return o;
}

struct EpiF32 {
    static constexpr bool PERM = false, AFTER_DRAIN = false;
    float* C; int ldc; const float* bias;
    __device__ __forceinline__ void operator()(const f32x4 (&acc)[2][2][4][2], const Unit& u, int wr, int wc, int fr, int fq) const {
        const int row0 = u.pm * BM + wr * 64 + fr, col0 = u.pn * BM + wc * 32 + 4 * fq;
        f32x4 bv[2][2];
#pragma unroll
        for (int bj = 0; bj < 2; ++bj)
#pragma unroll
            for (int n = 0; n < 2; ++n) bv[bj][n] = bias ? *(const f32x4*)(bias + col0 + bj * HALF + n * 16) : (f32x4){0.f, 0.f, 0.f, 0.f};
#pragma unroll
        for (int ai = 0; ai < 2; ++ai)
#pragma unroll
            for (int m = 0; m < 4; ++m) { float* rowp = C + (size_t)(row0 + ai * HALF + m * 16) * ldc + col0;
#pragma unroll
                for (int bj = 0; bj < 2; ++bj)
#pragma unroll
                    for (int n = 0; n < 2; ++n) *(f32x4*)(rowp + bj * HALF + n * 16) = acc[ai][bj][m][n] + bv[bj][n]; }
    }
};
template <int ACT  > struct EpiBf16 {
    static constexpr bool PERM = true, AFTER_DRAIN = false;
    bf16_t* O; int ldc; const float* bias; int split_cols; size_t split_stride;
    __device__ __forceinline__ void operator()(const f32x4 (&acc)[2][2][4][2], const Unit& u, int wr, int wc, int fr, int fq) const {
        const int row0 = u.pm * BM + wr * 64 + fr; int colt = u.pn * BM; bf16_t* base = O;
        if (split_cols) { const int t = colt / split_cols; base += (size_t)t * split_stride; colt -= t * split_cols; }
        const int col0 = colt + wc * 32 + 8 * fq, bcol0 = u.pn * BM + wc * 32 + 8 * fq;
        f32x4 bv[2][2];
#pragma unroll
        for (int bj = 0; bj < 2; ++bj)
#pragma unroll
            for (int n = 0; n < 2; ++n) bv[bj][n] = bias ? *(const f32x4*)(bias + bcol0 + bj * HALF + 4 * n) : (f32x4){0.f, 0.f, 0.f, 0.f};
#pragma unroll
        for (int ai = 0; ai < 2; ++ai)
#pragma unroll
            for (int m = 0; m < 4; ++m) { bf16_t* rowp = base + (size_t)(row0 + ai * HALF + m * 16) * ldc + col0;
#pragma unroll
                for (int bj = 0; bj < 2; ++bj) { f32x4 v0 = acc[ai][bj][m][0] + bv[bj][0], v1 = acc[ai][bj][m][1] + bv[bj][1];
                    if (ACT == 1) { f32x2 a = gelu_pk((f32x2){v0[0], v0[1]}), b = gelu_pk((f32x2){v0[2], v0[3]}), c = gelu_pk((f32x2){v1[0], v1[1]}), d = gelu_pk((f32x2){v1[2], v1[3]});
                        v0 = (f32x4){a.x, a.y, b.x, b.y}; v1 = (f32x4){c.x, c.y, d.x, d.y}; }
                    if (ACT == 2) {
#pragma unroll
                        for (int j = 0; j < 4; ++j) { v0[j] = 0.5f * v0[j] * (1.0f + erff(v0[j] * 0.70710678f)); v1[j] = 0.5f * v1[j] * (1.0f + erff(v1[j] * 0.70710678f)); } }
                    u32x4 w; w.x = cvt_pk_bf16(v0[0], v0[1]); w.y = cvt_pk_bf16(v0[2], v0[3]); w.z = cvt_pk_bf16(v1[0], v1[1]); w.w = cvt_pk_bf16(v1[2], v1[3]);
                    *(u32x4*)(rowp + bj * HALF) = w; } }
    }
};
template <class Epi, class Sched, bool STAMP = false>
__device__ __forceinline__ void gemm_phase(PG8_LAS unsigned char* lds, const Gemm g, const Sched& S, const Epi& E, unsigned long long* stamps) {
    const int tid = threadIdx.x, wid = __builtin_amdgcn_readfirstlane(tid >> 6), lane = tid & 63, wr = wid >> 2, wc = wid & 3, fr = lane & 15, fq = lane >> 4;
    constexpr int K = 2048, nt = K / BK;
    int ts_lo = 0, ts_hi = 0, nts = 0; const unsigned long long rt_entry = STAMP ? (unsigned long long)wall_clock64() : 0ull;
#define PG8_STAMP() do { if (STAMP && wid == 0 && nts < 64) { const unsigned long long _c = (unsigned long long)clock64(); \
        ts_lo = (lane == nts) ? (int)(unsigned)_c : ts_lo; ts_hi = (lane == nts) ? (int)(unsigned)(_c >> 32) : ts_hi; ++nts; } } while (0)
    PG8_STAMP();
    unsigned voffA[2], voffB[2];
#pragma unroll
    for (int i = 0; i < 2; ++i) { int R, C; stage_rc(tid * 16 + i * 8192, R, C); const int Rb = Epi::PERM ? ((R & ~31) + perm32(R & 31)) : R;
        voffA[i] = (unsigned)(R * K + C) * 2u; voffB[i] = (unsigned)(Rb * K + C) * 2u; }
    const size_t kstep = (size_t)(BK * 2);
    const size_t hstep = (size_t)HALF * K * 2;
    const size_t tstep = 2 * hstep;
    const unsigned ldsw = (unsigned)wid * 1024u;
    const int aoff = lds_byte(wr * 64 + fr, fq * 8), boff = lds_byte(wc * 32 + fr, fq * 8);
#define PG8_SA(b, h) (((b) * 2 + (h)) * HTB)
#define PG8_SB(b, h) ((4 + (b) * 2 + (h)) * HTB)
#define PG8_STAGE(bufoff, gbase, voff) do { _Pragma("unroll") for (int _i = 0; _i < 2; ++_i) \
        __builtin_amdgcn_global_load_lds((const unsigned*)((const char*)(gbase) + (voff)[_i]), (PG8_LAS unsigned*)(lds + (bufoff) + ldsw + _i * 8192), 16, 0, 0); } while (0)
#define PG8_LDA(dst, b, h) do { _Pragma("unroll") for (int m = 0; m < 4; ++m) _Pragma("unroll") for (int k = 0; k < 2; ++k) dst[m][k] = *(const PG8_LAS bf16x8*)(lds + PG8_SA(b, h) + aoff + m * 2048 + k * 1024); } while (0)
#define PG8_LDB(dst, b, h) do { _Pragma("unroll") for (int n = 0; n < 2; ++n) _Pragma("unroll") for (int k = 0; k < 2; ++k) dst[n][k] = *(const PG8_LAS bf16x8*)(lds + PG8_SB(b, h) + boff + n * 2048 + k * 1024); } while (0)
#define PG8_MMA(ai, bj, At, Bt) do { __builtin_amdgcn_s_setprio(1); _Pragma("unroll") for (int m = 0; m < 4; ++m) _Pragma("unroll") for (int n = 0; n < 2; ++n) _Pragma("unroll") for (int k = 0; k < 2; ++k) \
        acc[ai][bj][m][n] = __builtin_amdgcn_mfma_f32_16x16x32_bf16(Bt[n][k], At[m][k], acc[ai][bj][m][n], 0, 0, 0); __builtin_amdgcn_s_setprio(0); } while (0)
#define PG8_WAIT_V(n) asm volatile("s_waitcnt vmcnt(" #n ")" ::: "memory")
#define PG8_WAIT_L(n) asm volatile("s_waitcnt lgkmcnt(" #n ")" ::: "memory")
#define PG8_BAR __builtin_amdgcn_s_barrier()
#define PG8_SCHED __builtin_amdgcn_sched_barrier(0)
    Unit cur, nxt; int ui = 0;
    if (!S.next(0, cur)) return;
    f32x4 acc[2][2][4][2];
#pragma unroll
    for (int a = 0; a < 2; ++a)
#pragma unroll
        for (int b = 0; b < 2; ++b)
#pragma unroll
            for (int m = 0; m < 4; ++m)
#pragma unroll
                for (int n = 0; n < 2; ++n) acc[a][b][m][n] = (f32x4){0.f, 0.f, 0.f, 0.f};
    bf16x8 At[4][2], B0[2][2], B1[2][2];
    const char* cA = (const char*)g.A + (size_t)cur.pm * tstep; const char* cB = (const char*)g.Bt + (size_t)cur.pn * tstep;
    S.a_ready(cur);
    PG8_STAGE(PG8_SB(0, 0), cB, voffB); PG8_STAGE(PG8_SA(0, 0), cA, voffA); PG8_STAGE(PG8_SB(0, 1), cB + hstep, voffB); PG8_STAGE(PG8_SA(0, 1), cA + hstep, voffA);
    if (wr == 1) PG8_BAR;
    PG8_WAIT_V(4); PG8_BAR;
    PG8_STAGE(PG8_SB(1, 0), cB + kstep, voffB); PG8_STAGE(PG8_SA(1, 0), cA + kstep, voffA); PG8_STAGE(PG8_SB(1, 1), cB + hstep + kstep, voffB);
    PG8_WAIT_V(6); PG8_BAR;
    PG8_STAMP();
    for (;;) {
        const bool has_next = S.next(ui + 1, nxt);
        const char* nA = has_next ? (const char*)g.A + (size_t)nxt.pm * tstep : cA; const char* nB = has_next ? (const char*)g.Bt + (size_t)nxt.pn * tstep : cB;
        for (int t = 0; t < nt; t += 2) {
            const bool last = (t == nt - 2);
            const char* a1 = cA + (size_t)(t + 1) * kstep;
            const char* a2 = last ? nA : cA + (size_t)(t + 2) * kstep; const char* b2 = last ? nB : cB + (size_t)(t + 2) * kstep;
            const char* a3 = a2 + kstep; const char* b3 = b2 + kstep;
            if (last && has_next) S.a_ready(nxt);
            PG8_LDB(B0, 0, 0); PG8_SCHED; PG8_LDA(At, 0, 0); PG8_STAGE(PG8_SA(1, 1), a1 + hstep, voffA);
            PG8_WAIT_L(8); PG8_BAR; PG8_WAIT_L(0); PG8_MMA(0, 0, At, B0); PG8_BAR; PG8_SCHED;
            PG8_LDB(B1, 0, 1); PG8_STAGE(PG8_SB(0, 0), b2, voffB);
            PG8_BAR; PG8_WAIT_L(0); PG8_MMA(0, 1, At, B1); PG8_BAR;
            PG8_LDA(At, 0, 1); PG8_STAGE(PG8_SA(0, 0), a2, voffA);
            PG8_BAR; PG8_WAIT_L(0); PG8_MMA(1, 0, At, B0); PG8_BAR; PG8_SCHED;
            PG8_STAGE(PG8_SB(0, 1), b2 + hstep, voffB);
            PG8_WAIT_V(6); PG8_BAR; PG8_MMA(1, 1, At, B1); PG8_BAR;
            PG8_LDB(B0, 1, 0); PG8_SCHED; PG8_LDA(At, 1, 0); PG8_STAGE(PG8_SA(0, 1), a2 + hstep, voffA);
            PG8_WAIT_L(8); PG8_BAR; PG8_WAIT_L(0); PG8_MMA(0, 0, At, B0); PG8_BAR; PG8_SCHED;
            PG8_LDB(B1, 1, 1); PG8_STAGE(PG8_SB(1, 0), b3, voffB);
            PG8_BAR; PG8_WAIT_L(0); PG8_MMA(0, 1, At, B1); PG8_BAR;
            PG8_LDA(At, 1, 1); PG8_STAGE(PG8_SA(1, 0), a3, voffA);
            PG8_BAR; PG8_WAIT_L(0); PG8_MMA(1, 0, At, B0); PG8_BAR; PG8_SCHED;
            PG8_STAGE(PG8_SB(1, 1), b3 + hstep, voffB);
            PG8_WAIT_V(6); PG8_BAR; PG8_MMA(1, 1, At, B1); PG8_BAR;
        }
        PG8_STAMP();
        if constexpr (!Epi::AFTER_DRAIN) { E(acc, cur, wr, wc, fr, fq); S.done(cur); }
        PG8_STAMP();
        if (!has_next) break;
#pragma unroll
        for (int a = 0; a < 2; ++a)
#pragma unroll
            for (int b = 0; b < 2; ++b)
#pragma unroll
                for (int m = 0; m < 4; ++m)
#pragma unroll
                    for (int n = 0; n < 2; ++n) acc[a][b][m][n] = (f32x4){0.f, 0.f, 0.f, 0.f};
        cur = nxt; cA = nA; cB = nB; ++ui;
    }
    PG8_WAIT_V(0);
    if (wr == 0) PG8_BAR;
    PG8_BAR;
    if constexpr (Epi::AFTER_DRAIN) { E.fused(acc, cur, wr, wc, fr, fq, lds, wid, lane); S.done(cur); }
    PG8_STAMP();
    if (STAMP && wid == 0) { stamps[lane] = lane < nts ? (((unsigned long long)(unsigned)ts_hi << 32) | (unsigned)ts_lo) : 0ull;
        if (lane == 62) stamps[62] = rt_entry; if (lane == 63) stamps[63] = (unsigned long long)wall_clock64(); }
#undef PG8_STAMP
#undef PG8_SA
#undef PG8_SB
#undef PG8_STAGE
#undef PG8_LDA
#undef PG8_LDB
#undef PG8_MMA
#undef PG8_WAIT_V
#undef PG8_WAIT_L
#undef PG8_BAR
#undef PG8_SCHED
}
}

namespace mk {
#define GAS __attribute__((address_space(1)))
#define LAS __attribute__((address_space(3)))
#define DEV __device__ __forceinline__
typedef unsigned short bf16;
typedef unsigned v4u __attribute__((ext_vector_type(4)));
typedef float f32x4 __attribute__((ext_vector_type(4)));
typedef float f32x2 __attribute__((ext_vector_type(2)));
typedef short bf16x8 __attribute__((ext_vector_type(8)));
typedef float f32x16 __attribute__((ext_vector_type(16)));
typedef __bf16 bf16x2_t __attribute__((ext_vector_type(2)));

#ifndef MK_DBG
#define MK_DBG 0
#endif
#ifndef MK_CHECK
#define MK_CHECK 0
#endif
#ifndef MK_DUP
#define MK_DUP (-1)
#endif
#ifndef MK_N_LAUNCHES
#define MK_N_LAUNCHES 19
#endif

constexpr int D = 2048, SEQ = 4096, M = 8192, NL = 2;
constexpr int LRU_W = 768, SWA_W = 768, SB_W = 512, IN_W = 5376;
constexpr int ZO_XA = 0, ZO_GA = 768, ZO_QB = 1536, ZO_KB = 2304, ZO_VB = 3072, ZO_QC = 3840, ZO_KC = 4352, ZO_VC = 4864;
constexpr int NEXP = 16384, MODW = 12288;
constexpr int MO_SH1 = 0, MO_SC1 = 2048, MO_G1 = 4096, MO_SH2 = 6144, MO_SC2 = 8192, MO_G2 = 10240;
constexpr float EPS = 1e-6f;
constexpr float QSCALE = 0.08838834764831845f;
constexpr float NEGBIG = -3.0e38f;
constexpr int NPHASE = 19 + 2 * (MK_CHECK != 0);

constexpr size_t MiB = 1u << 20;
constexpr size_t WS_CTL = 0, CTL_ZERO_BYTES = 1 * MiB;
constexpr size_t WS_MOD = 512 * 1024;
constexpr size_t WS_WIN_T = 2 * MiB, WS_WOUT_T = 44 * MiB, WS_WQ_T = 60 * MiB, WS_SUBK = 76 * MiB, WS_U = 80 * MiB, WS_V = 208 * MiB,
                 WS_H = 336 * MiB, WS_Z = 368 * MiB, WS_HLOC = 452 * MiB, WS_P = 476 * MiB, WS_YB = 500 * MiB, WS_YC = 524 * MiB,
                 WS_SUMA = 540 * MiB, WS_SUMB = 541 * MiB, WS_X1 = 544 * MiB, WS_X2 = 608 * MiB, WS_Q = 672 * MiB, WS_IDS = 704 * MiB,
                 WS_G = 708 * MiB, WS_PART = 712 * MiB, WS_LSE = 784 * MiB, WS_END = 785 * MiB;
constexpr int CW_BAR = 4096;

constexpr int LDS_BYTES = 147456;
constexpr int LDS_MISC = 131072;

__device__ const unsigned char T5B[3][132] = {
 {0,1,2,3,4,5,6,7,8,9,10,11,12,13,14,15,16,16,16,16,16,16,17,17,17,17,17,17,17,17,18,18,18,18,18,18,18,18,18,18,19,19,19,19,19,19,19,19,19,19,19,19,19,19,20,20,20,20,20,20,20,20,20,20,20,20,20,20,20,20,20,20,20,21,21,21,21,21,21,21,21,21,21,21,21,21,21,21,21,21,21,21,21,21,21,21,21,21,21,22,22,22,22,22,22,22,22,22,22,22,22,22,22,22,22,22,22,22,22,22,22,22,22,22,22,22,22,22,22,0,0,0},
 {0,4,8,12,16,16,17,17,18,18,19,19,19,19,20,20,20,20,20,21,21,21,21,21,21,22,22,22,22,22,22,22,22,22,23,23,23,23,23,23,23,23,23,23,23,23,24,24,24,24,24,24,24,24,24,24,24,24,24,24,24,24,25,25,25,25,25,25,25,25,25,25,25,25,25,25,25,25,25,25,25,25,25,26,26,26,26,26,26,26,26,26,26,26,26,26,26,26,26,26,26,26,26,26,26,26,26,26,26,26,26,26,26,27,27,27,27,27,27,27,27,27,27,27,27,27,27,27,27,0,0,0},
 {0,16,18,19,20,21,21,22,22,23,23,23,24,24,24,24,25,25,25,25,25,26,26,26,26,26,26,26,26,27,27,27,27,27,27,27,27,27,27,28,28,28,28,28,28,28,28,28,28,28,28,28,29,29,29,29,29,29,29,29,29,29,29,29,29,29,29,29,29,29,30,30,30,30,30,30,30,30,30,30,30,30,30,30,30,30,30,30,30,30,30,30,30,30,30,31,31,31,31,31,31,31,31,31,31,31,31,31,31,31,31,31,31,31,31,31,31,31,31,31,31,31,31,31,31,31,31,31,31,0,0,0}};

#define LDS_WAIT() asm volatile("s_waitcnt lgkmcnt(0)" ::: "memory")
DEV unsigned f2bf(float f) { unsigned u = __builtin_bit_cast(unsigned, f); return (u + 0x7fffu + ((u >> 16) & 1u)) >> 16; }
DEV unsigned pk2(float lo, float hi) { return f2bf(lo) | (f2bf(hi) << 16); }
DEV float bf_lo(unsigned w) { return __builtin_bit_cast(float, w << 16); }
DEV float bf_hi(unsigned w) { return __builtin_bit_cast(float, w & 0xffff0000u); }
DEV float bf1(bf16 h) { return __builtin_bit_cast(float, ((unsigned)h) << 16); }
DEV float wave_sum(float v) {
#pragma unroll
    for (int o = 1; o < 64; o <<= 1) v += __shfl_xor(v, o);
    return v;
}
DEV float wave_max(float v) {
#pragma unroll
    for (int o = 1; o < 64; o <<= 1) v = fmaxf(v, __shfl_xor(v, o));
    return v;
}
DEV float sigmoid_f(float x) { return 1.f / (1.f + __expf(-x)); }
DEV float softplus_f(float x) { return fmaxf(x, 0.f) + log1pf(__expf(-fabsf(x))); }
DEV float gelu_tanh(float x) { const float u = 0.7978845608028654f * (x + 0.044715f * x * x * x); const float t = 1.f - 2.f / (1.f + __expf(2.f * u)); return 0.5f * x * (1.f + t); }
DEV float dot8(const v4u a, const v4u b) {
    float s = bf_lo(a.x) * bf_lo(b.x); s += bf_hi(a.x) * bf_hi(b.x);
    s += bf_lo(a.y) * bf_lo(b.y); s += bf_hi(a.y) * bf_hi(b.y);
    s += bf_lo(a.z) * bf_lo(b.z); s += bf_hi(a.z) * bf_hi(b.z);
    s += bf_lo(a.w) * bf_lo(b.w); s += bf_hi(a.w) * bf_hi(b.w);
    return s;
}

#define XB_TMO      128
#define XB_XCNT(j)  (256  + 64 * (j))
#define XB_XSUB(j)  (1280 + 64 * (j))
#define XB_XGEN(j)  (2304 + 64 * (j))
#define XB_TOP      3328
#define XB_TOPGEN   3392
#define XCD_BAR_WORDS 3456
#define XB_SPIN_CAP (1u << 18)

__device__ __forceinline__ unsigned xb_ld(unsigned* p)              { return __hip_atomic_load(p, __ATOMIC_RELAXED, __HIP_MEMORY_SCOPE_AGENT); }
__device__ __forceinline__ unsigned xb_add(unsigned* p, unsigned v) { return __hip_atomic_fetch_add(p, v, __ATOMIC_RELAXED, __HIP_MEMORY_SCOPE_AGENT); }
__device__ __forceinline__ unsigned xb_xcc_id() { return (unsigned)__builtin_amdgcn_s_getreg((3 << 11) | 20) & 0xFu; }
#define XB_SPIN(cond, bar) do { unsigned _sp = 0; while (cond) { __builtin_amdgcn_s_sleep(1); \
    if ((++_sp & 255u) == 0u) { if (xb_ld(&(bar)[XB_TMO])) break; if (_sp > XB_SPIN_CAP) { atomicAdd(&(bar)[XB_TMO], 1u); break; } } } } while (0)

struct XcdBarrier {
    unsigned* bar; unsigned x;
    volatile LAS unsigned* st;
};
__device__ __forceinline__ XcdBarrier xcd_barrier_post(unsigned* bar, volatile LAS unsigned* st) {
    XcdBarrier b; b.bar = bar; b.x = xb_xcc_id(); b.st = st;
    if (threadIdx.x == 0) (void)xb_add(&bar[XB_XCNT(b.x)], 1u);
    return b;
}
__device__ __forceinline__ void xcd_barrier_complete(unsigned* bar, unsigned x, unsigned& nloc, unsigned& nx) {
    const unsigned G = gridDim.x * gridDim.y * gridDim.z;
    unsigned sum, cnt, mine, sp = 0u;
    for (;;) {
        sum = 0u; cnt = 0u; mine = 0u;
#pragma unroll
        for (unsigned j = 0; j < 16; ++j) { const unsigned c = xb_ld(&bar[XB_XCNT(j)]); sum += c; cnt += (c > 0u) ? 1u : 0u; mine = (j == x) ? c : mine; }
        if (sum == G) break;
        __builtin_amdgcn_s_sleep(1);
        if ((++sp & 255u) == 0u) { if (xb_ld(&bar[XB_TMO])) break; if (sp > XB_SPIN_CAP) { atomicAdd(&bar[XB_TMO], 1u); break; } }
    }
    nloc = mine > 0u ? mine : 1u; nx = cnt > 0u ? cnt : 1u;
}
__device__ __forceinline__ void xcd_barrier(const XcdBarrier& b) {
    asm volatile("s_waitcnt vmcnt(0)" ::: "memory");
    __syncthreads();
    if (threadIdx.x == 0) {
        unsigned* bar = b.bar;
        __builtin_amdgcn_s_waitcnt(0);
        unsigned nloc = b.st[0], nx = b.st[1];
        if (nloc == 0u) { xcd_barrier_complete(bar, b.x, nloc, nx); b.st[0] = nloc; b.st[1] = nx; }
        const unsigned old = xb_add(&bar[XB_XSUB(b.x)], 1u);
        const unsigned gen = old / nloc;
        if (old + 1u == (gen + 1u) * nloc) {
            __builtin_amdgcn_fence(__ATOMIC_RELEASE, "agent");
            asm volatile("s_waitcnt vmcnt(0)" ::: "memory");
            const unsigned og = xb_add(&bar[XB_TOP], 1u);
            const unsigned tg = og / nx;
            if (og + 1u == (tg + 1u) * nx) xb_add(&bar[XB_TOPGEN], 1u);
            else XB_SPIN(xb_ld(&bar[XB_TOPGEN]) == tg, bar);
            __builtin_amdgcn_fence(__ATOMIC_ACQUIRE, "agent");
            xb_add(&bar[XB_XGEN(b.x)], 1u);
            asm volatile("s_waitcnt vmcnt(0)" ::: "memory");
        } else {
            XB_SPIN(xb_ld(&bar[XB_XGEN(b.x)]) == gen, bar);
            __builtin_amdgcn_fence(__ATOMIC_ACQUIRE, "agent");
            asm volatile("s_waitcnt vmcnt(0)" ::: "memory");
        }
    }
    __syncthreads();
}

struct EpiResGate {
    static constexpr bool PERM = false, AFTER_DRAIN = false;
    const float* X; float* O; const float* gate; float gscale;
    __device__ __forceinline__ void operator()(const pg8::f32x4 (&acc)[2][2][4][2], const pg8::Unit& u, int wr, int wc, int fr, int fq) const {
        const int row0 = u.pm * 256 + wr * 64 + fr, col0 = u.pn * 256 + wc * 32 + 4 * fq;
        const float* gp = gate + (size_t)((u.pm * 256) >> 12) * MODW;
        pg8::f32x4 gv[2][2];
#pragma unroll
        for (int bj = 0; bj < 2; ++bj)
#pragma unroll
            for (int n = 0; n < 2; ++n) gv[bj][n] = *(const pg8::f32x4*)(gp + col0 + bj * 128 + n * 16) * gscale;
#pragma unroll
        for (int ai = 0; ai < 2; ++ai)
#pragma unroll
            for (int m = 0; m < 4; ++m) {
                const size_t ro = (size_t)(row0 + ai * 128 + m * 16) * D + col0;
#pragma unroll
                for (int bj = 0; bj < 2; ++bj)
#pragma unroll
                    for (int n = 0; n < 2; ++n) {
                        const pg8::f32x4 xv = *(const pg8::f32x4*)(X + ro + bj * 128 + n * 16);
                        *(pg8::f32x4*)(O + ro + bj * 128 + n * 16) = xv + gv[bj][n] * acc[ai][bj][m][n];
                    }
            }
    }
};

DEV void ph_mod(const float* __restrict__ c, const float* __restrict__ w_mod, const float* __restrict__ b_mod, float* __restrict__ mod, LAS float* red, int vcu, int G, int tid) {
    const int lane = tid & 63, wave = tid >> 6;
    for (int it = vcu; it < 2 * 192; it += G) {
        const int l = it / 192, cb = it % 192;
        const int k0 = wave * 256;
        const float* W = w_mod + ((size_t)l * D + k0) * MODW + cb * 64 + lane;
        float a0 = 0.f, a1 = 0.f;
#pragma unroll 16
        for (int k = 0; k < 256; ++k) {
            const float w = W[(size_t)k * MODW];
            const float c0 = c[k0 + k], c1 = c[D + k0 + k];
            a0 += (c0 * sigmoid_f(c0)) * w; a1 += (c1 * sigmoid_f(c1)) * w;
        }
        red[(wave * 2 + 0) * 64 + lane] = a0; red[(wave * 2 + 1) * 64 + lane] = a1;
        __syncthreads();
        if (tid < 128) {
            const int b = tid >> 6, ln = tid & 63; float s = 0.f;
#pragma unroll
            for (int w = 0; w < 8; ++w) s += red[(w * 2 + b) * 64 + ln];
            const int col = cb * 64 + ln;
            mod[(size_t)(l * 2 + b) * MODW + col] = s + b_mod[l * MODW + col];
        }
        __syncthreads();
    }
}
DEV void transpose_item(const float* __restrict__ W, int K, int N, bf16* __restrict__ WT, LAS float* scr, int item, int lane) {
    const int nblk = N / 32, kb = item / nblk, nb = item % nblk, k0 = 64 * kb, n0 = 32 * nb;
#pragma unroll 8
    for (int i = 0; i < 32; ++i) { const int kk = 2 * i + (lane >> 5); scr[kk * 33 + (lane & 31)] = W[(size_t)(k0 + kk) * N + n0 + (lane & 31)]; }
    LDS_WAIT();
    const int c = lane & 7;
#pragma unroll
    for (int j = 0; j < 4; ++j) { const int n = (lane >> 3) + 8 * j; const LAS float* s = scr + (8 * c) * 33 + n;
        v4u o; o.x = pk2(s[0 * 33], s[1 * 33]); o.y = pk2(s[2 * 33], s[3 * 33]); o.z = pk2(s[4 * 33], s[5 * 33]); o.w = pk2(s[6 * 33], s[7 * 33]);
        *(v4u*)(WT + (size_t)(n0 + n) * K + k0 + 8 * c) = o; }
    LDS_WAIT();
}
DEV void convert_copy(const float* __restrict__ src, bf16* __restrict__ dst, size_t ngroups8, size_t gtid, size_t gstride) {
    for (size_t g = gtid; g < ngroups8; g += gstride) {
        const f32x4 a = *(const f32x4*)(src + g * 8), b = *(const f32x4*)(src + g * 8 + 4);
        v4u o; o.x = pk2(a.x, a.y); o.y = pk2(a.z, a.w); o.z = pk2(b.x, b.y); o.w = pk2(b.z, b.w);
        *(v4u*)(dst + g * 8) = o;
    }
}

DEV void modnorm_rows(const float* __restrict__ X, const float* __restrict__ gain, const float* __restrict__ modl, int sh_off, int sc_off, bf16* __restrict__ H, int gw, int NGW, int lane) {
    for (int m = gw; m < M; m += NGW) {
        const int b = m >> 12;
        const f32x4* xr = (const f32x4*)(X + (size_t)m * D) + lane;
        f32x4 v[8]; float s = 0.f;
#pragma unroll
        for (int j = 0; j < 8; ++j) { v[j] = xr[64 * j]; s += (v[j].x * v[j].x + v[j].y * v[j].y) + (v[j].z * v[j].z + v[j].w * v[j].w); }
        const float r = rsqrtf(wave_sum(s) * (1.f / D) + EPS);
        const f32x4* g4 = (const f32x4*)gain + lane;
        const f32x4* sc4 = (const f32x4*)(modl + (size_t)b * MODW + sc_off) + lane;
        const f32x4* sh4 = (const f32x4*)(modl + (size_t)b * MODW + sh_off) + lane;
        unsigned long long* o8 = (unsigned long long*)(H + (size_t)m * D) + lane;
#pragma unroll
        for (int j = 0; j < 8; ++j) {
            const f32x4 g = g4[64 * j], sc = sc4[64 * j], sh = sh4[64 * j];
            const f32x4 y = (v[j] * r) * g * (sc + 1.f) + sh;
            o8[64 * j] = (unsigned long long)pk2(y.x, y.y) | ((unsigned long long)pk2(y.z, y.w) << 32);
        }
    }
}

DEV void lru_item(int l, int b, int j, int n, const bf16* __restrict__ Z, const float* __restrict__ conv_w, const float* __restrict__ conv_b,
                  const float* __restrict__ w_rec, const float* __restrict__ b_rec, const float* __restrict__ w_gi, const float* __restrict__ b_gi, const float* __restrict__ lam,
                  float* __restrict__ HLOC, float* __restrict__ PP, float* __restrict__ SUMA, float* __restrict__ SUMB, LAS float* xc, LAS float* aL, LAS float* uL, int tid) {
    const int ch = tid & 127, tq = tid >> 7, c = n * 128 + ch;
    {
        const float cw0 = conv_w[(l * 4 + 0) * LRU_W + c], cw1 = conv_w[(l * 4 + 1) * LRU_W + c], cw2 = conv_w[(l * 4 + 2) * LRU_W + c], cw3 = conv_w[(l * 4 + 3) * LRU_W + c];
        const float cb = conv_b[l * LRU_W + c];
#pragma unroll 4
        for (int i = 0; i < 16; ++i) {
            const int tok = tq + 4 * i, t = j * 64 + tok;
            const bf16* zp = Z + ((size_t)b * SEQ + t) * IN_W + ZO_XA + c;
            float s = cb + cw3 * bf1(zp[0]);
            if (t >= 1) s += cw2 * bf1(zp[-(ptrdiff_t)IN_W]);
            if (t >= 2) s += cw1 * bf1(zp[-(ptrdiff_t)2 * IN_W]);
            if (t >= 3) s += cw0 * bf1(zp[-(ptrdiff_t)3 * IN_W]);
            xc[tok * 128 + ch] = s;
        }
    }
    __syncthreads();
    float accr[16], acci[16];
#pragma unroll
    for (int i = 0; i < 16; ++i) { accr[i] = 0.f; acci[i] = 0.f; }
    const float* Wr = w_rec + ((size_t)(l * 6 + n) * 128) * 128 + ch;
    const float* Wi = w_gi + ((size_t)(l * 6 + n) * 128) * 128 + ch;
#pragma unroll 2
    for (int jj = 0; jj < 128; ++jj) {
        const float wr = Wr[jj * 128], wi = Wi[jj * 128];
#pragma unroll
        for (int i = 0; i < 16; ++i) { const float x = xc[(tq + 4 * i) * 128 + jj]; accr[i] += x * wr; acci[i] += x * wi; }
    }
    {
        const float br = b_rec[l * LRU_W + c], bi = b_gi[l * LRU_W + c], sp = softplus_f(-lam[l * LRU_W + c]);
#pragma unroll
        for (int i = 0; i < 16; ++i) {
            const int tok = tq + 4 * i;
            const float r = sigmoid_f(accr[i] + br), ig = sigmoid_f(acci[i] + bi);
            const float log_a = -8.0f * r * sp;
            const float av = __expf(log_a);
            const float x = xc[tok * 128 + ch];
            const float uv = sqrtf(fmaxf(-expm1f(2.f * log_a), 0.f)) * (ig * x);
            aL[tok * 128 + ch] = av; uL[tok * 128 + ch] = uv;
        }
    }
    __syncthreads();
    if (tid < 128) {
        float h = 0.f, P = 1.f;
        const size_t rb = ((size_t)b * SEQ + j * 64) * LRU_W + n * 128 + tid;
        for (int tok = 0; tok < 64; ++tok) {
            const float av = aL[tok * 128 + tid];
            h = av * h + uL[tok * 128 + tid]; P *= av;
            HLOC[rb + (size_t)tok * LRU_W] = h; PP[rb + (size_t)tok * LRU_W] = P;
        }
        SUMA[(size_t)(b * 64 + j) * LRU_W + n * 128 + tid] = P; SUMB[(size_t)(b * 64 + j) * LRU_W + n * 128 + tid] = h;
    }
    __syncthreads();
}

DEV void dil_item(int b, int h, int t, const bf16* __restrict__ Z, const float* __restrict__ rel_bias, float* __restrict__ YB, LAS float* qs, LAS float* lg, int lane) {
    const size_t row = (size_t)b * SEQ + t;
    { const unsigned w = *(const unsigned*)(Z + row * IN_W + ZO_QB + h * 128 + 2 * lane); qs[2 * lane] = bf_lo(w) * QSCALE; qs[2 * lane + 1] = bf_hi(w) * QSCALE; }
    LDS_WAIT();
    float mx = NEGBIG;
#pragma unroll
    for (int p = 0; p < 3; ++p) {
        const int d = 1 << (2 * p);
        for (int jj = lane; jj < 129; jj += 64) {
            const int pos = t - jj * d; float lgt = NEGBIG;
            if (pos >= 0) {
                const v4u* kr = (const v4u*)(Z + ((size_t)b * SEQ + pos) * IN_W + ZO_KB + h * 128);
                float s = 0.f;
#pragma unroll 4
                for (int c8 = 0; c8 < 16; ++c8) { const v4u kv = kr[c8]; const LAS float* q = qs + c8 * 8;
                    s += q[0] * bf_lo(kv.x) + q[1] * bf_hi(kv.x) + q[2] * bf_lo(kv.y) + q[3] * bf_hi(kv.y) + q[4] * bf_lo(kv.z) + q[5] * bf_hi(kv.z) + q[6] * bf_lo(kv.w) + q[7] * bf_hi(kv.w); }
                lgt = s + rel_bias[(int)T5B[p][jj] * 6 + h];
            }
            lg[p * 129 + jj] = lgt; mx = fmaxf(mx, lgt);
        }
    }
    mx = wave_max(mx);
    LDS_WAIT();
    float sum = 0.f;
    for (int idx = lane; idx < 387; idx += 64) { const float v = lg[idx]; const float pv = (v > -1.0e37f) ? __expf(v - mx) : 0.f; lg[idx] = pv; sum += pv; }
    sum = wave_sum(sum);
    LDS_WAIT();
    float a0 = 0.f, a1 = 0.f;
#pragma unroll
    for (int p = 0; p < 3; ++p) {
        const int d = 1 << (2 * p);
        int nk = t / d + 1; nk = nk > 129 ? 129 : nk;
        const bf16* vb = Z + row * IN_W + ZO_VB + h * 128 + 2 * lane;
#pragma unroll 4
        for (int jj = 0; jj < nk; ++jj) {
            const float pv = lg[p * 129 + jj];
            const unsigned w = *(const unsigned*)(vb - (size_t)jj * d * IN_W);
            a0 += pv * bf_lo(w); a1 += pv * bf_hi(w);
        }
    }
    const float inv = 1.f / sum;
    *(f32x2*)(YB + row * SWA_W + h * 128 + 2 * lane) = (f32x2){a0 * inv, a1 * inv};
    LDS_WAIT();
}


DEV unsigned cvtpk_bf16(float lo, float hi) { f32x2 v = {lo, hi}; bf16x2_t b = __builtin_convertvector(v, bf16x2_t); return __builtin_bit_cast(unsigned, b); }
constexpr int DIL_VSTR = 272;
constexpr int DIL_WLDS = 32 * DIL_VSTR + 132 * 4;
DEV void dil_mfma_item(int b, int h, int p, int rr, int i0, const bf16* __restrict__ Z, const float* __restrict__ rel_bias, float* __restrict__ PART, float* __restrict__ LSE, LAS unsigned char* wl, int lane) {
    const int r = lane & 31, hh = lane >> 5;
    const int d = 1 << (2 * p);
    LAS float* biasL = (LAS float*)(wl + 32 * DIL_VSTR);
    for (int dd = lane; dd < 129; dd += 64) biasL[dd] = rel_bias[(int)T5B[p][dd] * 6 + h];
    const size_t rowq = (size_t)b * SEQ + rr + d * (i0 + r);
    bf16x8 qf[8];
    { const bf16* qrow = Z + rowq * IN_W + ZO_QB + h * 128 + 8 * hh;
#pragma unroll
      for (int ks = 0; ks < 8; ++ks) qf[ks] = *(const bf16x8*)(qrow + 16 * ks); }
    float m_run = NEGBIG, l_run = 0.f;
    f32x16 o[4];
#pragma unroll
    for (int dt = 0; dt < 4; ++dt)
#pragma unroll
        for (int e = 0; e < 16; ++e) o[dt][e] = 0.f;
    const int kap = (r & 0x13) | ((r & 4) << 1) | ((r & 8) >> 1);
    LDS_WAIT();
    for (int jt = 0; jt < 5; ++jt) {
        const int j0 = i0 - 128 + 32 * jt;
        if (j0 + 31 < 0) continue;
        {
            v4u vr[8];
#pragma unroll
            for (int q = 0; q < 8; ++q) { const int pi = lane + 64 * q, kl = pi >> 4, c = pi & 15; int j = j0 + kl; j = j < 0 ? 0 : j;
                vr[q] = *(const v4u*)(Z + ((size_t)b * SEQ + rr + d * j) * IN_W + ZO_VB + h * 128 + 8 * c); }
#pragma unroll
            for (int q = 0; q < 8; ++q) { const int pi = lane + 64 * q, kl = pi >> 4, c = pi & 15; *(LAS v4u*)(wl + kl * DIL_VSTR + c * 16) = vr[q]; }
        }
        f32x16 sacc;
#pragma unroll
        for (int e = 0; e < 16; ++e) sacc[e] = 0.f;
        { int jk = j0 + kap; jk = jk < 0 ? 0 : jk;
          const bf16* krow = Z + ((size_t)b * SEQ + rr + d * jk) * IN_W + ZO_KB + h * 128 + 8 * hh;
          bf16x8 kf[8];
#pragma unroll
          for (int ks = 0; ks < 8; ++ks) kf[ks] = *(const bf16x8*)(krow + 16 * ks);
#pragma unroll
          for (int ks = 0; ks < 8; ++ks) sacc = __builtin_amdgcn_mfma_f32_32x32x16_bf16(kf[ks], qf[ks], sacc, 0, 0, 0); }
        float tm = NEGBIG;
#pragma unroll
        for (int e = 0; e < 16; ++e) {
            const int j = j0 + 16 * (e >> 3) + 8 * hh + (e & 7);
            const int dist = (i0 + r) - j;
            const bool valid = (j >= 0) && (dist >= 0) && (dist <= 128);
            const int dc = dist < 0 ? 0 : (dist > 128 ? 128 : dist);
            const float lg = valid ? sacc[e] * QSCALE + biasL[dc] : NEGBIG;
            sacc[e] = lg; tm = fmaxf(tm, lg);
        }
        tm = fmaxf(tm, __shfl_xor(tm, 32));
        const float m_new = fmaxf(m_run, tm);
        const float alpha = __expf(m_run - m_new);
        float ps = 0.f;
#pragma unroll
        for (int e = 0; e < 16; ++e) { const float pv = (sacc[e] > -1.0e37f) ? __expf(sacc[e] - m_new) : 0.f; sacc[e] = pv; ps += pv; }
        ps += __shfl_xor(ps, 32);
        l_run = l_run * alpha + ps; m_run = m_new;
#pragma unroll
        for (int dt = 0; dt < 4; ++dt)
#pragma unroll
            for (int e = 0; e < 16; ++e) o[dt][e] *= alpha;
        bf16x8 pf[2];
#pragma unroll
        for (int s2 = 0; s2 < 2; ++s2) { v4u w; w.x = cvtpk_bf16(sacc[8 * s2 + 0], sacc[8 * s2 + 1]); w.y = cvtpk_bf16(sacc[8 * s2 + 2], sacc[8 * s2 + 3]);
            w.z = cvtpk_bf16(sacc[8 * s2 + 4], sacc[8 * s2 + 5]); w.w = cvtpk_bf16(sacc[8 * s2 + 6], sacc[8 * s2 + 7]); pf[s2] = __builtin_bit_cast(bf16x8, w); }
        LDS_WAIT();
#pragma unroll
        for (int dt = 0; dt < 4; ++dt)
#pragma unroll
            for (int s2 = 0; s2 < 2; ++s2) {
                const LAS unsigned short* vp = (const LAS unsigned short*)(wl + (16 * s2 + 8 * hh) * DIL_VSTR + (32 * dt + r) * 2);
                v4u w;
                w.x = (unsigned)vp[0 * (DIL_VSTR / 2)] | ((unsigned)vp[1 * (DIL_VSTR / 2)] << 16);
                w.y = (unsigned)vp[2 * (DIL_VSTR / 2)] | ((unsigned)vp[3 * (DIL_VSTR / 2)] << 16);
                w.z = (unsigned)vp[4 * (DIL_VSTR / 2)] | ((unsigned)vp[5 * (DIL_VSTR / 2)] << 16);
                w.w = (unsigned)vp[6 * (DIL_VSTR / 2)] | ((unsigned)vp[7 * (DIL_VSTR / 2)] << 16);
                o[dt] = __builtin_amdgcn_mfma_f32_32x32x16_bf16(__builtin_bit_cast(bf16x8, w), pf[s2], o[dt], 0, 0, 0);
            }
        LDS_WAIT();
    }
    const float inv = 1.f / l_run;
    float* po = PART + ((size_t)p * M + rowq) * SWA_W + h * 128;
#pragma unroll
    for (int dt = 0; dt < 4; ++dt)
#pragma unroll
        for (int g = 0; g < 4; ++g)
            *(f32x4*)(po + 32 * dt + 8 * g + 4 * hh) = (f32x4){o[dt][4 * g + 0] * inv, o[dt][4 * g + 1] * inv, o[dt][4 * g + 2] * inv, o[dt][4 * g + 3] * inv};
    if (hh == 0) LSE[((size_t)p * M + rowq) * 6 + h] = m_run + __logf(l_run);
}

DEV void sb_item(int b, int h, int t, const bf16* __restrict__ Z, float* __restrict__ YC, LAS float* qs, LAS float* pA, int lane) {
    const size_t row = (size_t)b * SEQ + t;
    { const unsigned w = *(const unsigned*)(Z + row * IN_W + ZO_QC + h * 128 + 2 * lane); qs[2 * lane] = bf_lo(w) * QSCALE; qs[2 * lane + 1] = bf_hi(w) * QSCALE; }
    LDS_WAIT();
    float carry = 0.f, a0 = 0.f, a1 = 0.f;
    for (int shi = t - 1; shi >= 0; shi -= 64) {
        const int s = shi - lane; const bool valid = s >= 0;
        float z = 0.f;
        if (valid) {
            const v4u* kr = (const v4u*)(Z + ((size_t)b * SEQ + s) * IN_W + ZO_KC + h * 128);
#pragma unroll 4
            for (int c8 = 0; c8 < 16; ++c8) { const v4u kv = kr[c8]; const LAS float* q = qs + c8 * 8;
                z += q[0] * bf_lo(kv.x) + q[1] * bf_hi(kv.x) + q[2] * bf_lo(kv.y) + q[3] * bf_hi(kv.y) + q[4] * bf_lo(kv.z) + q[5] * bf_hi(kv.z) + q[6] * bf_lo(kv.w) + q[7] * bf_hi(kv.w); }
        }
        const float l1m = valid ? -softplus_f(z) : 0.f;
        float inc = l1m;
#pragma unroll
        for (int o = 1; o < 64; o <<= 1) { const float tmp = __shfl_up(inc, o); if (lane >= o) inc += tmp; }
        const float A = valid ? __expf(-softplus_f(-z) + carry + (inc - l1m)) : 0.f;
        carry += __shfl(inc, 63);
        pA[lane] = A;
        const bool done = carry < -105.0f;
        LDS_WAIT();
        const int nk = (shi + 1) < 64 ? (shi + 1) : 64;
        const bf16* vb = Z + ((size_t)b * SEQ + shi) * IN_W + ZO_VC + h * 128 + 2 * lane;
#pragma unroll 4
        for (int i = 0; i < nk; ++i) {
            const float pv = pA[i];
            const unsigned w = *(const unsigned*)(vb - (size_t)i * IN_W);
            a0 += pv * bf_lo(w); a1 += pv * bf_hi(w);
        }
        LDS_WAIT();
        if (done) break;
    }
    *(f32x2*)(YC + row * SB_W + h * 128 + 2 * lane) = (f32x2){a0, a1};
}


DEV void sb_mfma_item(int b, int h, int t0, const bf16* __restrict__ Z, float* __restrict__ YC, LAS unsigned char* wl, int lane) {
    const int r = lane & 31, hh = lane >> 5;
    const size_t rowq = (size_t)b * SEQ + t0 + r;
    bf16x8 qf[8];
    { const bf16* qrow = Z + rowq * IN_W + ZO_QC + h * 128 + 8 * hh;
#pragma unroll
      for (int ks = 0; ks < 8; ++ks) qf[ks] = *(const bf16x8*)(qrow + 16 * ks); }
    f32x16 o[4];
#pragma unroll
    for (int dt = 0; dt < 4; ++dt)
#pragma unroll
        for (int e = 0; e < 16; ++e) o[dt][e] = 0.f;
    const int kap = (r & 0x13) | ((r & 4) << 1) | ((r & 8) >> 1);
    float carry = 0.f;
    for (int k0 = t0; k0 >= 0; k0 -= 32) {
        {
            v4u vr[8];
#pragma unroll
            for (int q = 0; q < 8; ++q) { const int pi = lane + 64 * q, kl = pi >> 4, c = pi & 15;
                vr[q] = *(const v4u*)(Z + ((size_t)b * SEQ + k0 + kl) * IN_W + ZO_VC + h * 128 + 8 * c); }
#pragma unroll
            for (int q = 0; q < 8; ++q) { const int pi = lane + 64 * q, kl = pi >> 4, c = pi & 15; *(LAS v4u*)(wl + kl * DIL_VSTR + c * 16) = vr[q]; }
        }
        f32x16 sacc;
#pragma unroll
        for (int e = 0; e < 16; ++e) sacc[e] = 0.f;
        { const bf16* krow = Z + ((size_t)b * SEQ + k0 + kap) * IN_W + ZO_KC + h * 128 + 8 * hh;
          bf16x8 kf[8];
#pragma unroll
          for (int ks = 0; ks < 8; ++ks) kf[ks] = *(const bf16x8*)(krow + 16 * ks);
#pragma unroll
          for (int ks = 0; ks < 8; ++ks) sacc = __builtin_amdgcn_mfma_f32_32x32x16_bf16(kf[ks], qf[ks], sacc, 0, 0, 0); }
        float l1[16]; float T0 = 0.f, T1 = 0.f;
#pragma unroll
        for (int e = 0; e < 16; ++e) {
            const int key = k0 + 16 * (e >> 3) + 8 * hh + (e & 7);
            const bool valid = key < t0 + r;
            const float z = sacc[e] * QSCALE;
            sacc[e] = z;
            l1[e] = valid ? -softplus_f(z) : 0.f;
        }
#pragma unroll
        for (int e = 0; e < 8; ++e) { T0 += l1[e]; T1 += l1[8 + e]; }
        const float PT0 = __shfl_xor(T0, 32), PT1 = __shfl_xor(T1, 32);
        const float base1 = carry + (hh ? 0.f : PT1);
        const float base0 = carry + (hh ? (T1 + PT1) : (PT1 + T1 + PT0));
        float run1 = base1, run0 = base0;
#pragma unroll
        for (int e = 7; e >= 0; --e) {
            { const int key = k0 + 16 + 8 * hh + e; const bool valid = key < t0 + r; const float a = valid ? __expf(sacc[8 + e] + l1[8 + e] + run1) : 0.f; run1 += l1[8 + e]; sacc[8 + e] = a; }
            { const int key = k0 + 8 * hh + e; const bool valid = key < t0 + r; const float a = valid ? __expf(sacc[e] + l1[e] + run0) : 0.f; run0 += l1[e]; sacc[e] = a; }
        }
        carry += (T0 + T1) + (PT0 + PT1);
        bf16x8 pf[2];
#pragma unroll
        for (int s2 = 0; s2 < 2; ++s2) { v4u w; w.x = cvtpk_bf16(sacc[8 * s2 + 0], sacc[8 * s2 + 1]); w.y = cvtpk_bf16(sacc[8 * s2 + 2], sacc[8 * s2 + 3]);
            w.z = cvtpk_bf16(sacc[8 * s2 + 4], sacc[8 * s2 + 5]); w.w = cvtpk_bf16(sacc[8 * s2 + 6], sacc[8 * s2 + 7]); pf[s2] = __builtin_bit_cast(bf16x8, w); }
        LDS_WAIT();
#pragma unroll
        for (int dt = 0; dt < 4; ++dt)
#pragma unroll
            for (int s2 = 0; s2 < 2; ++s2) {
                const LAS unsigned short* vp = (const LAS unsigned short*)(wl + (16 * s2 + 8 * hh) * DIL_VSTR + (32 * dt + r) * 2);
                v4u w;
                w.x = (unsigned)vp[0 * (DIL_VSTR / 2)] | ((unsigned)vp[1 * (DIL_VSTR / 2)] << 16);
                w.y = (unsigned)vp[2 * (DIL_VSTR / 2)] | ((unsigned)vp[3 * (DIL_VSTR / 2)] << 16);
                w.z = (unsigned)vp[4 * (DIL_VSTR / 2)] | ((unsigned)vp[5 * (DIL_VSTR / 2)] << 16);
                w.w = (unsigned)vp[6 * (DIL_VSTR / 2)] | ((unsigned)vp[7 * (DIL_VSTR / 2)] << 16);
                o[dt] = __builtin_amdgcn_mfma_f32_32x32x16_bf16(__builtin_bit_cast(bf16x8, w), pf[s2], o[dt], 0, 0, 0);
            }
        LDS_WAIT();
        if (__all(carry < -105.0f)) break;
    }
    float* po = YC + rowq * SB_W + h * 128;
#pragma unroll
    for (int dt = 0; dt < 4; ++dt)
#pragma unroll
        for (int g = 0; g < 4; ++g)
            *(f32x4*)(po + 32 * dt + 8 * g + 4 * hh) = (f32x4){o[dt][4 * g + 0], o[dt][4 * g + 1], o[dt][4 * g + 2], o[dt][4 * g + 3]};
}

DEV void combine_item(int l, int b, int j, int half, const bf16* __restrict__ Z, const float* __restrict__ HLOC, const float* __restrict__ PP, const float* __restrict__ SUMA, const float* __restrict__ SUMB,
                      const float* __restrict__ PART, const float* __restrict__ LSE, const float* __restrict__ YC, const float* __restrict__ g_lru, const float* __restrict__ g_swa, const float* __restrict__ g_sb,
                      bf16* __restrict__ Y, LAS float* carryL, int tid) {
    const int lane = tid & 63, wave = tid >> 6;
    for (int c = tid; c < LRU_W; c += 512) {
        float cr = 0.f;
        for (int i = 0; i < j; ++i) cr = SUMA[(size_t)(b * 64 + i) * LRU_W + c] * cr + SUMB[(size_t)(b * 64 + i) * LRU_W + c];
        carryL[c] = cr;
    }
    __syncthreads();
    for (int i = 0; i < 4; ++i) {
        const int tok = half * 32 + wave * 4 + i;
        const size_t row = (size_t)b * SEQ + j * 64 + tok;
        bf16* yo = Y + row * D;
        {
            float ya[12]; float ssq = 0.f;
#pragma unroll
            for (int e = 0; e < 12; ++e) { const int c = lane + 64 * e;
                const float hv = HLOC[row * LRU_W + c] + PP[row * LRU_W + c] * carryL[c];
                const float ga = bf1(Z[row * IN_W + ZO_GA + c]);
                ya[e] = hv * gelu_tanh(ga); ssq += ya[e] * ya[e]; }
            const float r = rsqrtf(wave_sum(ssq) * (1.f / LRU_W) + EPS);
#pragma unroll
            for (int e = 0; e < 12; ++e) { const int c = lane + 64 * e; yo[c] = (MK_DBG & 16) ? (bf16)0 : (bf16)f2bf(ya[e] * r * g_lru[l * LRU_W + c]); }
        }
        {
            float yb[12]; float ssq = 0.f;
            float wgt[3][2];
            (void)wgt;
#pragma unroll
            for (int e = 0; e < 12; ++e) { const int c = lane + 64 * e; const int hd = c >> 7;
                const float l0 = LSE[((size_t)0 * M + row) * 6 + hd], l1 = LSE[((size_t)1 * M + row) * 6 + hd], l2 = LSE[((size_t)2 * M + row) * 6 + hd];
                const float mx = fmaxf(l0, fmaxf(l1, l2)); const float e0 = __expf(l0 - mx), e1 = __expf(l1 - mx), e2 = __expf(l2 - mx); const float iz = 1.f / (e0 + e1 + e2);
                yb[e] = (e0 * PART[((size_t)0 * M + row) * SWA_W + c] + e1 * PART[((size_t)1 * M + row) * SWA_W + c] + e2 * PART[((size_t)2 * M + row) * SWA_W + c]) * iz;
                ssq += yb[e] * yb[e]; }
            const float r = rsqrtf(wave_sum(ssq) * (1.f / SWA_W) + EPS);
#pragma unroll
            for (int e = 0; e < 12; ++e) { const int c = lane + 64 * e; yo[LRU_W + c] = (MK_DBG & 32) ? (bf16)0 : (bf16)f2bf(yb[e] * r * g_swa[l * SWA_W + c]); }
        }
        {
            float yc[8]; float ssq = 0.f;
#pragma unroll
            for (int e = 0; e < 8; ++e) { const int c = lane + 64 * e; yc[e] = YC[row * SB_W + c]; ssq += yc[e] * yc[e]; }
            const float r = rsqrtf(wave_sum(ssq) * (1.f / SB_W) + EPS);
#pragma unroll
            for (int e = 0; e < 8; ++e) { const int c = lane + 64 * e; yo[LRU_W + SWA_W + c] = (MK_DBG & 64) ? (bf16)0 : (bf16)f2bf(yc[e] * r * g_sb[l * SB_W + c]); }
        }
    }
    __syncthreads();
}

constexpr int RT_SK = 0, RT_Q = 128 * 129 * 4, RT_SC = RT_Q + 32 * 128 * 4, RT_TV = RT_SC + 64 * 129 * 4, RT_TI = RT_TV + 64 * 16 * 4, RT_END = RT_TI + 64 * 16 * 4;
static_assert(RT_END <= LDS_MISC, "routing LDS");
DEV void route_item(int l, int tile, int h, const bf16* __restrict__ Q, const bf16* __restrict__ SK, int* __restrict__ IDS, float* __restrict__ GG, LAS unsigned char* lds, int tid, unsigned* DBGW = nullptr) {
    LAS float* skL = (LAS float*)(lds + RT_SK); LAS float* qL = (LAS float*)(lds + RT_Q); LAS float* sc = (LAS float*)(lds + RT_SC);
    LAS float* topv = (LAS float*)(lds + RT_TV); LAS int* topi = (LAS int*)(lds + RT_TI);
    const int lane = tid & 63, wave = tid >> 6, row0 = tile * 32;
    for (int c = 0; c < 2; ++c) {
        const bf16* skp = SK + ((size_t)((l * 8 + h) * 2 + c)) * 128 * 128;
#pragma unroll 4
        for (int i = 0; i < 16; ++i) { const int idx2 = tid + 512 * i; const int k = idx2 >> 6, d2 = idx2 & 63; const unsigned w = *(const unsigned*)(skp + k * 128 + 2 * d2); skL[k * 129 + 2 * d2] = bf_lo(w); skL[k * 129 + 2 * d2 + 1] = bf_hi(w); }
#pragma unroll
        for (int i = 0; i < 4; ++i) { const int idx2 = tid + 512 * i; const int tok = idx2 >> 6, d2 = idx2 & 63; const unsigned w = *(const unsigned*)(Q + (size_t)(row0 + tok) * D + h * 256 + c * 128 + 2 * d2); qL[tok * 128 + 2 * d2] = bf_lo(w); qL[tok * 128 + 2 * d2 + 1] = bf_hi(w); }
        __syncthreads();
        {
            const int k = tid & 127, tg = tid >> 7;
            float acc[8];
#pragma unroll
            for (int i = 0; i < 8; ++i) acc[i] = 0.f;
#pragma unroll 4
            for (int d = 0; d < 128; ++d) { const float s = skL[k * 129 + d];
#pragma unroll
                for (int i = 0; i < 8; ++i) acc[i] += s * qL[(tg * 8 + i) * 128 + d]; }
#pragma unroll
            for (int i = 0; i < 8; ++i) sc[(c * 32 + tg * 8 + i) * 129 + k] = acc[i];
        }
        __syncthreads();
    }
    for (int q = 0; q < 8; ++q) {
        const int L = wave * 8 + q;
        float v0 = sc[L * 129 + lane], v1 = sc[L * 129 + 64 + lane];
        for (int r = 0; r < 16; ++r) {
            const float m = wave_max(fmaxf(v0, v1));
            const unsigned long long b0 = __ballot(v0 == m);
            int idx;
            if (b0) { const int ln = __ffsll((long long)b0) - 1; idx = ln; if (lane == ln) v0 = NEGBIG; }
            else { const unsigned long long b1 = __ballot(v1 == m); const int ln = __ffsll((long long)b1) - 1; idx = 64 + ln; if (lane == ln) v1 = NEGBIG; }
            if (lane == 0) { topv[L * 16 + r] = m; topi[L * 16 + r] = idx; }
        }
    }
    __syncthreads();
#if MK_CHECK == 16
    { for (int q = 0; q < 8; ++q) { const int L = wave * 8 + q; const int mi = topi[L * 16 + (lane & 15)]; int dup = 0;
          for (int e = 0; e < 16; ++e) { const int oi = __shfl(mi, e); if (lane < 16 && e != lane && oi == mi) dup = 1; }
          if (dup) atomicAdd((unsigned*)DBGW, 1u); } }
#endif
    for (int q = 0; q < 4; ++q) {
        const int tok = wave * 4 + q;
        float cv[4];
#pragma unroll
        for (int e = 0; e < 4; ++e) cv[e] = topv[tok * 16 + (lane >> 2)] + topv[(32 + tok) * 16 + (lane & 3) * 4 + e];
        float mysc = NEGBIG; int myid = 0;
        for (int r = 0; r < 16; ++r) {
            const float lm = fmaxf(fmaxf(cv[0], cv[1]), fmaxf(cv[2], cv[3]));
            const float m = wave_max(lm);
            const unsigned long long bb = __ballot(lm == m);
            const int ln = __ffsll((long long)bb) - 1;
            const int se = (cv[0] == m) ? 0 : (cv[1] == m) ? 1 : (cv[2] == m) ? 2 : 3;
            const int sel = __shfl(se, ln);
            { const bool me = (lane == ln);
              cv[0] = (me && sel == 0) ? NEGBIG : cv[0]; cv[1] = (me && sel == 1) ? NEGBIG : cv[1];
              cv[2] = (me && sel == 2) ? NEGBIG : cv[2]; cv[3] = (me && sel == 3) ? NEGBIG : cv[3]; }
            const int ci = ln * 4 + sel;
            const int id = topi[tok * 16 + (ci >> 4)] * 128 + topi[(32 + tok) * 16 + (ci & 15)];
            if (lane == r) { mysc = m; myid = id; }
        }
#if MK_CHECK == 16
        { int dup = 0; for (int e = 0; e < 16; ++e) { const int oi = __shfl(myid, e); if (lane < 16 && e != lane && oi == myid) dup = 1; } if (dup) atomicAdd((unsigned*)DBGW + 1, 1u); }
#endif
        const float s0 = __shfl(mysc, 0);
        const float ev = (lane < 16) ? __expf(mysc - s0) : 0.f;
        const float sum = wave_sum(ev);
        if (lane < 16) { IDS[(size_t)(row0 + tok) * 128 + h * 16 + lane] = myid; GG[(size_t)(row0 + tok) * 128 + h * 16 + lane] = ev / sum; }
    }
    __syncthreads();
}


constexpr int R2_SC = 0, R2_TV = 128 * 129 * 4, R2_TI = R2_TV + 128 * 16 * 4, R2_END = R2_TI + 128 * 16 * 4;
static_assert(R2_END <= LDS_MISC, "routing v2 LDS");
DEV unsigned ord_key(float s) { const unsigned u = __builtin_bit_cast(unsigned, s); return (u & 0x80000000u) ? ~u : (u | 0x80000000u); }
DEV void route_item2(int l, int tile, int h, const bf16* __restrict__ Q, const bf16* __restrict__ SK, int* __restrict__ IDS, float* __restrict__ GG, LAS unsigned char* lds, int tid) {
    LAS float* sc = (LAS float*)(lds + R2_SC); LAS float* tv = (LAS float*)(lds + R2_TV); LAS int* ti = (LAS int*)(lds + R2_TI);
    const int lane = tid & 63, wave = tid >> 6, row0 = tile * 64;
    {
        const int r = lane & 31, hh = lane >> 5, c = wave >> 2, key0 = 32 * (wave & 3);
        const bf16* skp = SK + ((size_t)(((l * 8 + h) * 2 + c) * 128 + key0 + r)) * 128 + 8 * hh;
        bf16x8 bfr[8];
#pragma unroll
        for (int ks = 0; ks < 8; ++ks) bfr[ks] = *(const bf16x8*)(skp + 16 * ks);
#pragma unroll
        for (int rt = 0; rt < 2; ++rt) {
            const bf16* qp = Q + (size_t)(row0 + 32 * rt + r) * D + h * 256 + c * 128 + 8 * hh;
            bf16x8 afr[8];
#pragma unroll
            for (int ks = 0; ks < 8; ++ks) afr[ks] = *(const bf16x8*)(qp + 16 * ks);
            f32x16 acc;
#pragma unroll
            for (int e = 0; e < 16; ++e) acc[e] = 0.f;
#pragma unroll
            for (int ks = 0; ks < 8; ++ks) acc = __builtin_amdgcn_mfma_f32_32x32x16_bf16(afr[ks], bfr[ks], acc, 0, 0, 0);
#pragma unroll
            for (int e = 0; e < 16; ++e) { const int tok = 32 * rt + (e & 3) + 8 * (e >> 2) + 4 * hh; sc[(c * 64 + tok) * 129 + key0 + r] = acc[e]; }
        }
    }
    __syncthreads();
    if (tid < 128) {
        const int L = tid;
        unsigned t[16];
#pragma unroll
        for (int q = 0; q < 16; ++q) t[q] = 0u;
#pragma unroll 4
        for (int k = 0; k < 128; ++k) {
            unsigned key = (ord_key(sc[L * 129 + k]) & ~127u) | (unsigned)(127 - k);
#pragma unroll
            for (int q = 0; q < 16; ++q) { const unsigned hi = t[q] > key ? t[q] : key; key = t[q] > key ? key : t[q]; t[q] = hi; }
        }
#pragma unroll
        for (int q = 0; q < 16; ++q) { const int idx = 127 - (int)(t[q] & 127u); tv[L * 16 + q] = sc[L * 129 + idx]; ti[L * 16 + q] = idx; }
    }
    __syncthreads();
    if (tid < 64) {
        const int tok = tid;
        float a[16], bq[16];
#pragma unroll
        for (int i = 0; i < 16; ++i) { a[i] = tv[tok * 16 + i]; bq[i] = tv[(64 + tok) * 16 + i]; }
        unsigned t[16];
#pragma unroll
        for (int q = 0; q < 16; ++q) t[q] = 0u;
#pragma unroll
        for (int i = 0; i < 16; ++i)
#pragma unroll
            for (int j = 0; j < 16 / (i + 1); ++j) {
                unsigned key = (ord_key(a[i] + bq[j]) & ~255u) | (unsigned)(255 - (i * 16 + j));
#pragma unroll
                for (int q = 0; q < 16; ++q) { const unsigned hi = t[q] > key ? t[q] : key; key = t[q] > key ? key : t[q]; t[q] = hi; }
            }
        float scv[16]; int idv[16]; float mx = NEGBIG;
#pragma unroll
        for (int q = 0; q < 16; ++q) { const int ci = 255 - (int)(t[q] & 255u); const int i = ci >> 4, j = ci & 15;
            scv[q] = tv[tok * 16 + i] + tv[(64 + tok) * 16 + j]; idv[q] = ti[tok * 16 + i] * 128 + ti[(64 + tok) * 16 + j]; mx = fmaxf(mx, scv[q]); }
        float sum = 0.f;
#pragma unroll
        for (int q = 0; q < 16; ++q) { scv[q] = __expf(scv[q] - mx); sum += scv[q]; }
        const float inv = 1.f / sum;
        int* ip = IDS + (size_t)(row0 + tok) * 128 + h * 16; float* gp = GG + (size_t)(row0 + tok) * 128 + h * 16;
#pragma unroll
        for (int q4 = 0; q4 < 4; ++q4) {
            *(int4*)(ip + 4 * q4) = make_int4(idv[4 * q4], idv[4 * q4 + 1], idv[4 * q4 + 2], idv[4 * q4 + 3]);
            *(f32x4*)(gp + 4 * q4) = (f32x4){scv[4 * q4] * inv, scv[4 * q4 + 1] * inv, scv[4 * q4 + 2] * inv, scv[4 * q4 + 3] * inv};
        }
    }
    __syncthreads();
}

DEV void expert_row(int l, int row, const bf16* __restrict__ H, const int* __restrict__ IDS, const float* __restrict__ GG, const bf16* __restrict__ U, const bf16* __restrict__ V,
                    const float* __restrict__ X1, const float* __restrict__ g2, const float* __restrict__ fnorm, float* __restrict__ XO, int lane, float pscale, float* STATP = nullptr) {
    v4u xv[4];
#pragma unroll
    for (int j = 0; j < 4; ++j) xv[j] = *(const v4u*)(H + (size_t)row * D + lane * 8 + 512 * j);
    const int id0 = IDS[(size_t)row * 128 + lane], id1 = IDS[(size_t)row * 128 + 64 + lane];
    const float gg0 = GG[(size_t)row * 128 + lane], gg1 = GG[(size_t)row * 128 + 64 + lane];
    float y[32];
#pragma unroll
    for (int i = 0; i < 32; ++i) y[i] = 0.f;
    const bf16* Ul = U + (size_t)l * NEXP * D + lane * 8;
    const bf16* Vl = V + (size_t)l * NEXP * D + lane * 8;
    for (int e0 = 0; e0 < 128; e0 += 2) {
        int id[2]; float gq[2];
#pragma unroll
        for (int q = 0; q < 2; ++q) { const int e = e0 + q;
            id[q] = (e < 64) ? __builtin_amdgcn_readlane(id0, e & 63) : __builtin_amdgcn_readlane(id1, e & 63);
            gq[q] = (e < 64) ? __builtin_bit_cast(float, __builtin_amdgcn_readlane(__builtin_bit_cast(int, gg0), e & 63)) : __builtin_bit_cast(float, __builtin_amdgcn_readlane(__builtin_bit_cast(int, gg1), e & 63)); }
        v4u uu[2][4], vv[2][4];
#pragma unroll
        for (int q = 0; q < 2; ++q)
#pragma unroll
            for (int j = 0; j < 4; ++j) uu[q][j] = *(const v4u*)(Ul + (size_t)id[q] * D + 512 * j);
#pragma unroll
        for (int q = 0; q < 2; ++q)
#pragma unroll
            for (int j = 0; j < 4; ++j) vv[q][j] = *(const v4u*)(Vl + (size_t)id[q] * D + 512 * j);
#pragma unroll
        for (int q = 0; q < 2; ++q) {
            float dsum = 0.f;
#pragma unroll
            for (int j = 0; j < 4; ++j) dsum += dot8(xv[j], uu[q][j]);
            dsum = wave_sum(dsum);
            const float w = gq[q] * gelu_tanh(dsum);
#if MK_CHECK == 7
            if (lane == 0 && l == 0) atomicAdd(STATP, gelu_tanh(dsum) * gelu_tanh(dsum) * 2048.f / 128.f);
#elif MK_CHECK == 8
            if (lane == 0 && l == 0) atomicAdd(STATP, gq[q] * gq[q] * 2048.f * 16.f / 128.f);
#elif MK_CHECK == 9
            if (lane == 0 && l == 0) atomicAdd(STATP, dsum * dsum * 2048.f / 128.f);
#elif MK_CHECK == 11
            if (lane == 0 && l == 0) atomicAdd(STATP, w * w * 2048.f);
#endif
#pragma unroll
            for (int j = 0; j < 4; ++j) {
                y[j * 8 + 0] += w * bf_lo(vv[q][j].x); y[j * 8 + 1] += w * bf_hi(vv[q][j].x);
                y[j * 8 + 2] += w * bf_lo(vv[q][j].y); y[j * 8 + 3] += w * bf_hi(vv[q][j].y);
                y[j * 8 + 4] += w * bf_lo(vv[q][j].z); y[j * 8 + 5] += w * bf_hi(vv[q][j].z);
                y[j * 8 + 6] += w * bf_lo(vv[q][j].w); y[j * 8 + 7] += w * bf_hi(vv[q][j].w);
            }
        }
    }
#if MK_CHECK == 6
    { float q2 = 0.f;
#pragma unroll
      for (int i = 0; i < 32; ++i) q2 += y[i] * y[i];
      q2 = wave_sum(q2); if (lane == 0 && l == 0) atomicAdd(STATP, q2); }
#endif
    float ssq = 0.f;
#pragma unroll
    for (int j = 0; j < 4; ++j) {
        const int col = lane * 8 + 512 * j;
        const f32x4 xa = *(const f32x4*)(X1 + (size_t)row * D + col), xb = *(const f32x4*)(X1 + (size_t)row * D + col + 4);
        const f32x4 ga = *(const f32x4*)(g2 + col) * pscale, gb = *(const f32x4*)(g2 + col + 4) * pscale;
        y[j * 8 + 0] = xa.x + ga.x * y[j * 8 + 0]; y[j * 8 + 1] = xa.y + ga.y * y[j * 8 + 1]; y[j * 8 + 2] = xa.z + ga.z * y[j * 8 + 2]; y[j * 8 + 3] = xa.w + ga.w * y[j * 8 + 3];
        y[j * 8 + 4] = xb.x + gb.x * y[j * 8 + 4]; y[j * 8 + 5] = xb.y + gb.y * y[j * 8 + 5]; y[j * 8 + 6] = xb.z + gb.z * y[j * 8 + 6]; y[j * 8 + 7] = xb.w + gb.w * y[j * 8 + 7];
#pragma unroll
        for (int e = 0; e < 8; ++e) ssq += y[j * 8 + e] * y[j * 8 + e];
    }
    if (fnorm) {
        const float r = rsqrtf(wave_sum(ssq) * (1.f / D) + EPS);
#pragma unroll
        for (int j = 0; j < 4; ++j) { const int col = lane * 8 + 512 * j;
            const f32x4 fa = *(const f32x4*)(fnorm + col), fb = *(const f32x4*)(fnorm + col + 4);
            *(f32x4*)(XO + (size_t)row * D + col) = (f32x4){y[j * 8 + 0] * r * fa.x, y[j * 8 + 1] * r * fa.y, y[j * 8 + 2] * r * fa.z, y[j * 8 + 3] * r * fa.w};
            *(f32x4*)(XO + (size_t)row * D + col + 4) = (f32x4){y[j * 8 + 4] * r * fb.x, y[j * 8 + 5] * r * fb.y, y[j * 8 + 6] * r * fb.z, y[j * 8 + 7] * r * fb.w}; }
    } else {
#pragma unroll
        for (int j = 0; j < 4; ++j) { const int col = lane * 8 + 512 * j;
            *(f32x4*)(XO + (size_t)row * D + col) = (f32x4){y[j * 8 + 0], y[j * 8 + 1], y[j * 8 + 2], y[j * 8 + 3]};
            *(f32x4*)(XO + (size_t)row * D + col + 4) = (f32x4){y[j * 8 + 4], y[j * 8 + 5], y[j * 8 + 6], y[j * 8 + 7]}; }
    }
}


constexpr float U8_SCALE = 64.f;
DEV void expert_row8(int l, int row, const bf16* __restrict__ H, const int* __restrict__ IDS, const float* __restrict__ GG, const unsigned char* __restrict__ U8, const unsigned char* __restrict__ V8,
                     const float* __restrict__ X1, const float* __restrict__ g2, const float* __restrict__ fnorm, float* __restrict__ XO, int lane, float pscale) {
    f32x2 x[16];
#pragma unroll
    for (int j = 0; j < 2; ++j) {
        const v4u a = *(const v4u*)(H + (size_t)row * D + lane * 16 + 1024 * j), c = *(const v4u*)(H + (size_t)row * D + lane * 16 + 1024 * j + 8);
        x[j * 8 + 0] = (f32x2){bf_lo(a.x), bf_hi(a.x)}; x[j * 8 + 1] = (f32x2){bf_lo(a.y), bf_hi(a.y)}; x[j * 8 + 2] = (f32x2){bf_lo(a.z), bf_hi(a.z)}; x[j * 8 + 3] = (f32x2){bf_lo(a.w), bf_hi(a.w)};
        x[j * 8 + 4] = (f32x2){bf_lo(c.x), bf_hi(c.x)}; x[j * 8 + 5] = (f32x2){bf_lo(c.y), bf_hi(c.y)}; x[j * 8 + 6] = (f32x2){bf_lo(c.z), bf_hi(c.z)}; x[j * 8 + 7] = (f32x2){bf_lo(c.w), bf_hi(c.w)};
    }
    const int id0 = IDS[(size_t)row * 128 + lane], id1 = IDS[(size_t)row * 128 + 64 + lane];
    const float gg0 = GG[(size_t)row * 128 + lane], gg1 = GG[(size_t)row * 128 + 64 + lane];
    float wv0 = 0.f, wv1 = 0.f;
    const unsigned char* Ul = U8 + (size_t)l * NEXP * D + lane * 16;
    const unsigned char* Vl = V8 + (size_t)l * NEXP * D + lane * 16;
    for (int e0 = 0; e0 < 128; e0 += 8) {
        v4u uu[8][2];
#pragma unroll
        for (int q = 0; q < 8; ++q) { const int e = e0 + q; const int id = (e < 64) ? __builtin_amdgcn_readlane(id0, e & 63) : __builtin_amdgcn_readlane(id1, e & 63);
            uu[q][0] = *(const v4u*)(Ul + (size_t)id * D); uu[q][1] = *(const v4u*)(Ul + (size_t)id * D + 1024); }
        float ds[8];
#pragma unroll
        for (int q = 0; q < 8; ++q) {
            f32x2 acc = {0.f, 0.f};
#pragma unroll
            for (int j = 0; j < 2; ++j) {
                const unsigned wd[4] = {uu[q][j].x, uu[q][j].y, uu[q][j].z, uu[q][j].w};
#pragma unroll
                for (int dw = 0; dw < 4; ++dw) {
                    const f32x2 lo = __builtin_amdgcn_cvt_pk_f32_fp8((int)wd[dw], false), hi = __builtin_amdgcn_cvt_pk_f32_fp8((int)wd[dw], true);
                    acc = __builtin_elementwise_fma(lo, x[j * 8 + 2 * dw], acc); acc = __builtin_elementwise_fma(hi, x[j * 8 + 2 * dw + 1], acc);
                }
            }
            ds[q] = acc.x + acc.y;
        }
#pragma unroll
        for (int o = 1; o < 64; o <<= 1)
#pragma unroll
            for (int q = 0; q < 8; ++q) ds[q] += __shfl_xor(ds[q], o);
#pragma unroll
        for (int q = 0; q < 8; ++q) { const int e = e0 + q;
            const float gq = (e < 64) ? __builtin_bit_cast(float, __builtin_amdgcn_readlane(__builtin_bit_cast(int, gg0), e & 63)) : __builtin_bit_cast(float, __builtin_amdgcn_readlane(__builtin_bit_cast(int, gg1), e & 63));
            const float w = gq * gelu_tanh(ds[q] * (1.f / U8_SCALE));
            if (e < 64) wv0 = (lane == (e & 63)) ? w : wv0; else wv1 = (lane == (e & 63)) ? w : wv1; }
    }
    f32x2 y[16];
#pragma unroll
    for (int i = 0; i < 16; ++i) y[i] = (f32x2){0.f, 0.f};
    for (int e0 = 0; e0 < 128; e0 += 8) {
        v4u vv[8][2];
#pragma unroll
        for (int q = 0; q < 8; ++q) { const int e = e0 + q; const int id = (e < 64) ? __builtin_amdgcn_readlane(id0, e & 63) : __builtin_amdgcn_readlane(id1, e & 63);
            vv[q][0] = *(const v4u*)(Vl + (size_t)id * D); vv[q][1] = *(const v4u*)(Vl + (size_t)id * D + 1024); }
#pragma unroll
        for (int q = 0; q < 8; ++q) { const int e = e0 + q;
            const float w = (e < 64) ? __builtin_bit_cast(float, __builtin_amdgcn_readlane(__builtin_bit_cast(int, wv0), e & 63)) : __builtin_bit_cast(float, __builtin_amdgcn_readlane(__builtin_bit_cast(int, wv1), e & 63));
            const f32x2 w2 = {w, w};
#pragma unroll
            for (int j = 0; j < 2; ++j) {
                const unsigned wd[4] = {vv[q][j].x, vv[q][j].y, vv[q][j].z, vv[q][j].w};
#pragma unroll
                for (int dw = 0; dw < 4; ++dw) {
                    const f32x2 lo = __builtin_amdgcn_cvt_pk_f32_fp8((int)wd[dw], false), hi = __builtin_amdgcn_cvt_pk_f32_fp8((int)wd[dw], true);
                    y[j * 8 + 2 * dw] = __builtin_elementwise_fma(w2, lo, y[j * 8 + 2 * dw]); y[j * 8 + 2 * dw + 1] = __builtin_elementwise_fma(w2, hi, y[j * 8 + 2 * dw + 1]);
                }
            }
        }
    }
    float ssq = 0.f;
#pragma unroll
    for (int j = 0; j < 2; ++j)
#pragma unroll
        for (int k4 = 0; k4 < 4; ++k4) {
            const int col = lane * 16 + 1024 * j + 4 * k4;
            const f32x4 xa = *(const f32x4*)(X1 + (size_t)row * D + col); const f32x4 ga = *(const f32x4*)(g2 + col) * pscale;
            f32x2& ya = y[j * 8 + 2 * k4]; f32x2& yb = y[j * 8 + 2 * k4 + 1];
            ya.x = xa.x + ga.x * ya.x; ya.y = xa.y + ga.y * ya.y; yb.x = xa.z + ga.z * yb.x; yb.y = xa.w + ga.w * yb.y;
            ssq += (ya.x * ya.x + ya.y * ya.y) + (yb.x * yb.x + yb.y * yb.y);
        }
    float r = 1.f;
    if (fnorm) r = rsqrtf(wave_sum(ssq) * (1.f / D) + EPS);
#pragma unroll
    for (int j = 0; j < 2; ++j)
#pragma unroll
        for (int k4 = 0; k4 < 4; ++k4) {
            const int col = lane * 16 + 1024 * j + 4 * k4;
            const f32x2 ya = y[j * 8 + 2 * k4], yb = y[j * 8 + 2 * k4 + 1];
            f32x4 ov = {ya.x, ya.y, yb.x, yb.y};
            if (fnorm) ov = ov * r * *(const f32x4*)(fnorm + col);
            *(f32x4*)(XO + (size_t)row * D + col) = ov;
        }
}
DEV void convert_fp8(const float* __restrict__ src, unsigned char* __restrict__ dst, size_t ngroups16, size_t gtid, size_t gstride, float scale) {
    for (size_t g = gtid; g < ngroups16; g += gstride) {
        const f32x4 a = *(const f32x4*)(src + g * 16) * scale, b = *(const f32x4*)(src + g * 16 + 4) * scale, c = *(const f32x4*)(src + g * 16 + 8) * scale, d = *(const f32x4*)(src + g * 16 + 12) * scale;
        int w0 = 0, w1 = 0, w2 = 0, w3 = 0;
        w0 = __builtin_amdgcn_cvt_pk_fp8_f32(a.x, a.y, w0, false); w0 = __builtin_amdgcn_cvt_pk_fp8_f32(a.z, a.w, w0, true);
        w1 = __builtin_amdgcn_cvt_pk_fp8_f32(b.x, b.y, w1, false); w1 = __builtin_amdgcn_cvt_pk_fp8_f32(b.z, b.w, w1, true);
        w2 = __builtin_amdgcn_cvt_pk_fp8_f32(c.x, c.y, w2, false); w2 = __builtin_amdgcn_cvt_pk_fp8_f32(c.z, c.w, w2, true);
        w3 = __builtin_amdgcn_cvt_pk_fp8_f32(d.x, d.y, w3, false); w3 = __builtin_amdgcn_cvt_pk_fp8_f32(d.z, d.w, w3, true);
        *(v4u*)(dst + g * 16) = (v4u){(unsigned)w0, (unsigned)w1, (unsigned)w2, (unsigned)w3};
    }
}

#if MK_CHECK
DEV void chk_route(int l, int row, int h, const bf16* __restrict__ Q, const bf16* __restrict__ SK, const int* __restrict__ IDS, const float* __restrict__ GG, unsigned* bad, LAS float* sL, LAS unsigned* cntL, int tid) {
    if (tid < 256) { const int c = tid >> 7, k = tid & 127; const bf16* skp = SK + ((size_t)((l * 8 + h) * 2 + c)) * 128 * 128 + k * 128; const bf16* qp = Q + (size_t)row * D + h * 256 + c * 128;
        float s = 0.f; for (int d = 0; d < 128; ++d) s += bf1(qp[d]) * bf1(skp[d]); sL[c * 128 + k] = s; }
    if (tid == 0) cntL[0] = 0u;
    __syncthreads();
    float sc15 = 0.f; unsigned mybad = 0;
    { float prev = 3e38f; float s0 = 0.f, gsum = 0.f; float g0 = GG[(size_t)row * 128 + h * 16];
      for (int r = 0; r < 16; ++r) { const int id = IDS[(size_t)row * 128 + h * 16 + r]; const float g = GG[(size_t)row * 128 + h * 16 + r];
          if (id < 0 || id >= NEXP) { mybad |= 1; continue; }
          const float scv = sL[id >> 7] + sL[128 + (id & 127)];
          if (r == 0) s0 = scv;
          if (scv > prev + 1e-5f) mybad |= 2;
          prev = scv; gsum += g;
          const float ratio = __expf(scv - s0);
          if (fabsf(g / g0 - ratio) > 0.02f * ratio + 1e-4f) mybad |= 4;
          if (r == 15) sc15 = scv; }
      if (fabsf(gsum - 1.f) > 1e-3f) mybad |= 8; }
    unsigned cnt = 0;
    for (int p = tid; p < 16384; p += 512) { const float v = sL[p >> 7] + sL[128 + (p & 127)]; if (v > sc15 + 1e-5f) ++cnt; }
    __hip_atomic_fetch_add(cntL, cnt, __ATOMIC_RELAXED, __HIP_MEMORY_SCOPE_WORKGROUP);
    __syncthreads();
    if (tid == 0) { if (cntL[0] > 15u) mybad |= 16; if (mybad) atomicAdd(bad, 1u); }
    __syncthreads();
}
DEV void chk_expert(int l, int row, const bf16* __restrict__ H, const int* __restrict__ IDS, const float* __restrict__ GG, const float* __restrict__ Uf, const float* __restrict__ Vf,
                    const float* __restrict__ X1, const float* __restrict__ X2, const float* __restrict__ g2, unsigned* bad, LAS float* wL, int tid) {
    if (tid < 128) { const int id = IDS[(size_t)row * 128 + tid]; const float* up = Uf + ((size_t)l * NEXP + id) * D; const bf16* hp = H + (size_t)row * D;
        float s = 0.f; for (int d = 0; d < D; ++d) s += up[d] * bf1(hp[d]);
        wL[tid] = GG[(size_t)row * 128 + tid] * gelu_tanh(s); }
    __syncthreads();
    unsigned mybad = 0;
    for (int d = tid; d < D; d += 512) { float y = 0.f;
        for (int e = 0; e < 128; ++e) { const int id = IDS[(size_t)row * 128 + e]; y += wL[e] * Vf[((size_t)l * NEXP + id) * D + d]; }
        const float want = X1[(size_t)row * D + d] + g2[d] * y * (MK_CHECK == 3 ? 1.5f : 1.f); const float got = X2[(size_t)row * D + d];
        if (!(fabsf(got - want) <= 0.02f * fabsf(want) + 0.02f)) mybad = 1; }
    if (mybad) atomicAdd(bad, 1u);
    __syncthreads();
}

DEV void chk_hq(int l, int row, const float* __restrict__ X1, const float* __restrict__ gain, const float* __restrict__ modl, const float* __restrict__ wq, const bf16* __restrict__ H, const bf16* __restrict__ Q,
                unsigned* bad, LAS float* hL, LAS float* redL, int tid) {
    const int b = row >> 12;
    float ss = 0.f;
    for (int d = tid; d < D; d += 512) { const float v = X1[(size_t)row * D + d]; ss += v * v; }
    ss = wave_sum(ss);
    if ((tid & 63) == 0) redL[tid >> 6] = ss;
    __syncthreads();
    float tot = 0.f; for (int w = 0; w < 8; ++w) tot += redL[w];
    const float r = rsqrtf(tot * (1.f / D) + EPS);
    unsigned badh = 0, badq = 0;
    for (int d = tid; d < D; d += 512) { const float hv = X1[(size_t)row * D + d] * r * gain[d] * (1.f + modl[(size_t)b * MODW + MO_SC2 + d]) + modl[(size_t)b * MODW + MO_SH2 + d];
        hL[d] = hv; const float got = bf1(H[(size_t)row * D + d]); if (!(fabsf(got - hv) <= 0.01f * fabsf(hv) + 0.01f)) badh = 1; }
    __syncthreads();
    for (int c = tid; c < D; c += 512) { float q = 0.f; for (int k = 0; k < D; ++k) q += hL[k] * wq[(size_t)k * D + c];
        const float got = bf1(Q[(size_t)row * D + c]); if (!(fabsf(got - q) <= 0.02f * fabsf(q) + 0.03f)) badq = 1; }
    if (badh) atomicAdd(bad, 1u);
    if (badq) atomicAdd(bad + 1, 1u);
    __syncthreads();
}
#endif
struct Args { const float* in[24]; float* out; unsigned char* ws; int ph_lo, ph_hi, li, pad; };

__global__ void __launch_bounds__(512, 2) fwd(Args a) {
    extern __shared__ __attribute__((aligned(16))) unsigned char lds_raw[];
    LAS unsigned char* lds = (LAS unsigned char*)lds_raw;
    const int wave = __builtin_amdgcn_readfirstlane((int)threadIdx.x >> 6);
    const int G = gridDim.x; const int bx = blockIdx.x;
#define PHASE_TID() int tid = threadIdx.x; asm volatile("" : "+v"(tid)); const int lane = tid & 63; (void)lane; \
    const __attribute__((address_space(4))) Args* A = (const __attribute__((address_space(4))) Args*)__builtin_amdgcn_kernarg_segment_ptr(); asm volatile("" : "+s"(A))
    const int vcu = (G % 8 == 0) ? (bx % 8) * (G / 8) + bx / 8 : bx;
    const int gw = vcu * 8 + wave, NGW = G * 8;
    unsigned* ctl = (unsigned*)(a.ws + WS_CTL);
    const int lo = a.ph_lo, hi = a.ph_hi;
    for (int u = threadIdx.x; u < (LDS_BYTES - LDS_MISC) / 4; u += 512) ((LAS unsigned*)(lds + LDS_MISC))[u] = 0u;
    __syncthreads();
    XcdBarrier bar; bar.bar = ctl + CW_BAR + (a.li & 7) * XCD_BAR_WORDS; bar.x = 0; bar.st = (volatile LAS unsigned*)(lds + LDS_MISC + 64);
    if (hi - lo > 1) bar = xcd_barrier_post(ctl + CW_BAR + (a.li & 7) * XCD_BAR_WORDS, (volatile LAS unsigned*)(lds + LDS_MISC + 64));
#ifndef MK_MASK
#define MK_MASK 0x3ff
#endif
#define KON(q) (((MK_MASK) >> (q)) & 1)
#define IN(k) (lo <= (k) && (k) < hi)
#define SEAM(k) do { if (IN(k) && IN((k) + 1)) xcd_barrier(bar); } while (0)

#define mod   ((float*)(A->ws + WS_MOD))
#define WIN_T ((bf16*)(A->ws + WS_WIN_T))
#define WOUT_T ((bf16*)(A->ws + WS_WOUT_T))
#define WQ_T  ((bf16*)(A->ws + WS_WQ_T))
#define SUBK  ((bf16*)(A->ws + WS_SUBK))
#define UB    ((bf16*)(A->ws + WS_U))
#define VB    ((bf16*)(A->ws + WS_V))
#define H     ((bf16*)(A->ws + WS_H))
#define Z     ((bf16*)(A->ws + WS_Z))
#define HLOC  ((float*)(A->ws + WS_HLOC))
#define PP    ((float*)(A->ws + WS_P))
#define YB    ((float*)(A->ws + WS_YB))
#define YC    ((float*)(A->ws + WS_YC))
#define SUMA  ((float*)(A->ws + WS_SUMA))
#define SUMB  ((float*)(A->ws + WS_SUMB))
#define X1    ((float*)(A->ws + WS_X1))
#define X2    ((float*)(A->ws + WS_X2))
#define QB    ((bf16*)(A->ws + WS_Q))
#define IDS   ((int*)(A->ws + WS_IDS))
#define GG    ((float*)(A->ws + WS_G))
#define PARTB ((float*)(A->ws + WS_PART))
#define LSEB  ((float*)(A->ws + WS_LSE))
#define XIN   ((l == 0) ? A->in[0] : (const float*)X2)
#define MODL  (mod + (size_t)l * 2 * MODW)
    for (int rep = 0; rep < (MK_DUP == 0 ? 2 : 1); ++rep) if (KON(0) && IN(0)) {
        PHASE_TID();
        ph_mod(A->in[1], A->in[2], A->in[3], mod, (LAS float*)lds, vcu, G, tid);
        {
            LAS float* scr = (LAS float*)(lds + wave * 16384);
            constexpr int I_IN = (D / 64) * (IN_W / 32), I_SQ = (D / 64) * (D / 32), I_L = I_IN + 2 * I_SQ;
            for (int it = gw; it < 2 * I_L; it += NGW) {
                const int l = it / I_L; int r = it % I_L;
                if (r < I_IN) { transpose_item(A->in[6] + (size_t)l * D * IN_W, D, IN_W, WIN_T + (size_t)l * IN_W * D, scr, r, lane); continue; } r -= I_IN;
                if (r < I_SQ) { transpose_item(A->in[18] + (size_t)l * D * D, D, D, WOUT_T + (size_t)l * D * D, scr, r, lane); continue; } r -= I_SQ;
                transpose_item(A->in[19] + (size_t)l * D * D, D, D, WQ_T + (size_t)l * D * D, scr, r, lane);
            }
        }
        const size_t gtid = (size_t)vcu * 512 + tid, gstride = (size_t)G * 512;
        convert_copy(A->in[20], SUBK, (size_t)2 * 8 * 2 * 128 * 128 / 8, gtid, gstride);
        convert_fp8(A->in[21], (unsigned char*)UB, (size_t)NL * NEXP * D / 16, gtid, gstride, U8_SCALE);
        convert_fp8(A->in[22], (unsigned char*)VB, (size_t)NL * NEXP * D / 16, gtid, gstride, 1.f);
    }
    SEAM(0);

    for (int l = 0; l < NL; ++l) {
        const int pb = 1 + 9 * l;
        for (int rep = 0; rep < (MK_DUP == 1 ? 2 : 1); ++rep) if (KON(1) && IN(pb + 0)) { PHASE_TID(); modnorm_rows(XIN, A->in[4] + l * D, MODL, MO_SH1, MO_SC1, H, gw, NGW, lane); }
        SEAM(pb + 0);
        for (int rep = 0; rep < (MK_DUP == 2 ? 2 : 1); ++rep) if (KON(2) && IN(pb + 1)) {
            PHASE_TID(); (void)tid;
            pg8::Gemm g{H, WIN_T + (size_t)l * IN_W * D, M, IN_W, D}; pg8::StaticOrder S; S.init(M, IN_W, G, bx);
            pg8::EpiBf16<0> E{Z, IN_W, nullptr, 0, 0};
            pg8::gemm_phase<pg8::EpiBf16<0>, pg8::StaticOrder, false>((PG8_LAS unsigned char*)lds, g, S, E, nullptr);
        }
        SEAM(pb + 1);
        for (int rep = 0; rep < (MK_DUP == 3 ? 2 : 1); ++rep) if (KON(3) && IN(pb + 2)) {
            PHASE_TID();
            if (rep) __syncthreads();
            for (int it = vcu; it < 2 * 64 * 6; it += G) {
                const int b = it / 384, r = it % 384, j = r / 6, n = r % 6;
                lru_item(l, b, j, n, Z, A->in[7], A->in[8], A->in[9], A->in[10], A->in[11], A->in[12], A->in[13], HLOC, PP, SUMA, SUMB,
                         (LAS float*)lds, (LAS float*)(lds + 32768), (LAS float*)(lds + 65536), tid);
            }
            {
                LAS float* qs = (LAS float*)(lds + wave * 16384 + 12288); LAS float* lgp = qs + 128;
                {
                    LAS unsigned char* wl = lds + wave * 16384;
                    for (int it = gw; it < 2 * 6 * 3 * 128; it += NGW) { const int tl = it & 127, p = (it >> 7) % 3, bh = it / 384; const int d = 1 << (2 * p);
                        dil_mfma_item(bh / 6, bh % 6, p, tl % d, 32 * (tl / d), Z, A->in[14], PARTB, LSEB, wl, lane); }
                }
                (void)qs; (void)lgp;
                {
                    LAS unsigned char* wl = lds + wave * 16384;
                    for (int it = gw; it < 2 * 4 * 128; it += NGW) { const int bh = it >> 7, tl = it & 127; sb_mfma_item(bh >> 2, bh & 3, 32 * tl, Z, YC, wl, lane); }
                }
            }
        }
        SEAM(pb + 2);
        for (int rep = 0; rep < (MK_DUP == 4 ? 2 : 1); ++rep) if (KON(4) && IN(pb + 3)) {
            PHASE_TID();
            for (int it = vcu; it < 256; it += G) { const int b = it >> 7, j = (it >> 1) & 63, half = it & 1;
                combine_item(l, b, j, half, Z, HLOC, PP, SUMA, SUMB, PARTB, LSEB, YC, A->in[15], A->in[16], A->in[17], H, (LAS float*)lds, tid); }
        }
        SEAM(pb + 3);
        for (int rep = 0; rep < (MK_DUP == 5 ? 2 : 1); ++rep) if (KON(5) && IN(pb + 4)) {
            PHASE_TID(); (void)tid;
            pg8::Gemm g{H, WOUT_T + (size_t)l * D * D, M, D, D}; pg8::StaticOrder S; S.init(M, D, G, bx);
            EpiResGate E{XIN, X1, MODL + MO_G1, ((MK_DBG >> (2 * l)) & 1) ? 0.f : ((MK_DBG & 256) ? -1.f : 1.f)};
            pg8::gemm_phase<EpiResGate, pg8::StaticOrder, false>((PG8_LAS unsigned char*)lds, g, S, E, nullptr);
        }
        SEAM(pb + 4);
        for (int rep = 0; rep < (MK_DUP == 6 ? 2 : 1); ++rep) if (KON(6) && IN(pb + 5)) { PHASE_TID(); modnorm_rows(X1, A->in[5] + l * D, MODL, MO_SH2, MO_SC2, H, gw, NGW, lane); }
        SEAM(pb + 5);
        for (int rep = 0; rep < (MK_DUP == 7 ? 2 : 1); ++rep) if (KON(7) && IN(pb + 6)) {
            PHASE_TID(); (void)tid;
            pg8::Gemm g{H, WQ_T + (size_t)l * D * D, M, D, D}; pg8::StaticOrder S; S.init(M, D, G, bx);
            pg8::EpiBf16<0> E{QB, D, nullptr, 0, 0};
            pg8::gemm_phase<pg8::EpiBf16<0>, pg8::StaticOrder, false>((PG8_LAS unsigned char*)lds, g, S, E, nullptr);
        }
        SEAM(pb + 6);
        for (int rep = 0; rep < (MK_DUP == 8 ? 2 : 1); ++rep) if (KON(8) && IN(pb + 7)) {
            PHASE_TID();
            for (int it = vcu; it < 128 * 8; it += G) route_item2(l, it >> 3, it & 7, QB, SUBK, IDS, GG, lds, tid);
        }
        SEAM(pb + 7);
        for (int rep = 0; rep < (MK_DUP == 9 ? 2 : 1); ++rep) if (KON(9) && IN(pb + 8)) {
            PHASE_TID();
            for (int m = gw; m < M; m += NGW)
                expert_row8(l, m, H, IDS, GG, (const unsigned char*)UB, (const unsigned char*)VB, X1, MODL + (size_t)(m >> 12) * MODW + MO_G2, (l == NL - 1) ? A->in[23] : nullptr, (l == NL - 1) ? A->out : X2, lane, ((MK_DBG >> (2 * l + 1)) & 1) ? 0.f : ((MK_DBG & 128) ? -1.f : 1.f));
        }
        if (l + 1 < NL) SEAM(pb + 8);
    }
#if MK_CHECK
    if (IN(19)) {
        PHASE_TID();
        unsigned* badw = (unsigned*)(A->ws + WS_CTL) + 8;
#if MK_CHECK == 1 || MK_CHECK == 3 || MK_CHECK == 4
        for (int it = vcu; it < (MK_CHECK == 4 ? 8192 : 256) * 8; it += G) { const int row = (MK_CHECK == 4) ? (it >> 3) : (((it >> 3) * 131 + 7) & 8191); chk_route(0, row, it & 7, QB, SUBK, IDS, GG, badw, (LAS float*)lds, (LAS unsigned*)(lds + 2048), tid); }
        for (int it = vcu; it < (MK_CHECK == 4 ? 8192 : 256); it += G) { const int row = (MK_CHECK == 4) ? it : ((it * 131 + 7) & 8191); chk_expert(0, row, H, IDS, GG, A->in[21], A->in[22], X1, X2, mod + (size_t)(row >> 12) * MODW + MO_G2, badw + 1, (LAS float*)lds, tid); }
#elif MK_CHECK == 12 || MK_CHECK == 15
        { (void)badw;
          for (int m = gw; m < M; m += NGW) { const int ia = IDS[(size_t)m * 128 + lane], ib = IDS[(size_t)m * 128 + 64 + lane]; int cnt = 0;
              for (int e = 0; e < 128; ++e) { const int ie = (e < 64) ? __shfl(ia, e) : __shfl(ib, e - 64); if (lane < e && ia == ie && (MK_CHECK == 12 || (lane >> 4) == (e >> 4))) ++cnt; if (lane + 64 < e && ib == ie && (MK_CHECK == 12 || ((lane + 64) >> 4) == (e >> 4))) ++cnt; }
              float fc = wave_sum((float)cnt); if (lane == 0) atomicAdd((float*)(A->ws + WS_CTL) + 16, fc * 2048.f); } }
#elif MK_CHECK == 13 || MK_CHECK == 14
        { (void)badw;
          float cnt = 0.f;
          if (MK_CHECK == 13) { const float* sk = A->in[20]; for (int o = vcu * 512 + tid; o < 2 * 128 * 128; o += G * 512) if (sk[o] == sk[o + 2 * 128 * 128]) cnt += 1.f; cnt *= (float)M * D / (2.f * 128 * 128); }
          else { const float* wq = A->in[19]; for (int o = vcu * 512 + tid; o < D * 256; o += G * 512) { const int k = o >> 8, c = o & 255; if (wq[(size_t)k * D + c] == wq[(size_t)k * D + 256 + c]) cnt += 1.f; } cnt *= (float)M * D / ((float)D * 256); }
          cnt = wave_sum(cnt); if (lane == 0) atomicAdd((float*)(A->ws + WS_CTL) + 16, cnt); }
#elif MK_CHECK == 10
        { (void)badw; float acc = 0.f; const float* vt = A->in[22];
          for (size_t o = (size_t)vcu * 512 + tid; o < (size_t)NEXP * D; o += (size_t)G * 512) { const float v = vt[o]; acc += v * v; }
          acc = wave_sum(acc); if (lane == 0) atomicAdd((float*)(A->ws + WS_CTL) + 16, acc * ((float)M * D / ((float)NEXP * D))); }
#elif MK_CHECK == 16
        (void)badw;
#elif MK_CHECK >= 6
        (void)badw;
#elif MK_CHECK == 5
        {
            const float* cc = A->in[1]; const float* wm = A->in[2]; const float* bm = A->in[3];
            unsigned mb = 0;
            for (int o = vcu * 512 + tid; o < 2 * 2 * MODW; o += G * 512) { const int l = o / (2 * MODW), b = (o / MODW) & 1, n = o % MODW;
                float sacc = 0.f; for (int k = 0; k < D; ++k) { const float cv = cc[b * D + k]; sacc += (cv / (1.f + __expf(-cv))) * wm[((size_t)l * D + k) * MODW + n]; }
                sacc += bm[l * MODW + n];
                if (!(fabsf(sacc - mod[o]) <= 2e-3f * fabsf(sacc) + 2e-3f)) mb = 1; }
            if (mb) atomicAdd(badw, 1u);
            unsigned sb = 0;
            for (int o = vcu * 512 + tid; o < 2 * 8 * 2 * 128 * 128; o += G * 512) { const float want = A->in[20][o]; const float got = bf1(SUBK[o]); if (!(fabsf(got - want) <= 0.01f * fabsf(want) + 1e-6f)) sb = 1; }
            if (sb) atomicAdd(badw + 1, 1u);
        }
#else
        for (int it = vcu; it < 256; it += G) { const int row = (it * 131 + 7) & 8191; chk_hq(0, row, X1, A->in[5], mod, A->in[19], H, QB, badw, (LAS float*)lds, (LAS float*)(lds + 16384), tid); }
#endif
    }
    if (IN(20)) {
        PHASE_TID();
        const unsigned* badw = (const unsigned*)(A->ws + WS_CTL) + 8;
        const unsigned b0 = __hip_atomic_load(badw, __ATOMIC_RELAXED, __HIP_MEMORY_SCOPE_AGENT), b1 = __hip_atomic_load(badw + 1, __ATOMIC_RELAXED, __HIP_MEMORY_SCOPE_AGENT);
#if MK_CHECK >= 6 && MK_CHECK != 16
        const float f = 1.f + ((const float*)(A->ws + WS_CTL))[16] * (1.f / ((float)M * D)); (void)b0; (void)b1;
#else
        const float f = (b0 ? (b1 ? -2.f : 0.f) : (b1 ? -1.f : 1.f));
#endif
        for (int m = gw; m < M; m += NGW) { const f32x4* xr = (const f32x4*)(X2 + (size_t)m * D) + lane; f32x4 v[8]; float ss = 0.f;
#pragma unroll
            for (int j = 0; j < 8; ++j) { v[j] = xr[64 * j]; ss += (v[j].x * v[j].x + v[j].y * v[j].y) + (v[j].z * v[j].z + v[j].w * v[j].w); }
            const float r = rsqrtf(wave_sum(ss) * (1.f / D) + EPS) * f;
#pragma unroll
            for (int j = 0; j < 8; ++j) { const f32x4 fn = ((const f32x4*)A->in[23])[lane + 64 * j]; ((f32x4*)(A->out + (size_t)m * D))[lane + 64 * j] = v[j] * r * fn; } }
    }
#endif
#undef IN
#undef SEAM
#undef mod
#undef H
#undef Z
#undef X1
#undef X2
}
}

extern "C" void kernel_launch(void* const* d_in, const int* in_sizes, int n_in, void* d_out, int out_size, void* d_ws, size_t ws_size, hipStream_t stream) {
    using namespace mk;
    static int grid = 0;
    if (grid == 0) {
        if (n_in != 24 || out_size != M * D || ws_size < WS_END) { fprintf(stderr, "kernel_launch: unexpected shapes (n_in %d out %d ws %zu)\n", n_in, out_size, ws_size); grid = -1; return; }
        int dev = 0, cus = 0, per_cu = 0;
        if (hipGetDevice(&dev) != hipSuccess || hipDeviceGetAttribute(&cus, hipDeviceAttributeMultiprocessorCount, dev) != hipSuccess) { grid = -1; return; }
        if (hipFuncSetAttribute((const void*)fwd, hipFuncAttributeMaxDynamicSharedMemorySize, LDS_BYTES) != hipSuccess) { fprintf(stderr, "kernel_launch: hipFuncSetAttribute failed\n"); grid = -1; return; }
        if (hipOccupancyMaxActiveBlocksPerMultiprocessor(&per_cu, (const void*)fwd, 512, LDS_BYTES) != hipSuccess || per_cu < 1) fprintf(stderr, "kernel_launch: occupancy query says %d\n", per_cu);
        (void)hipGetLastError();
        grid = cus;
    }
    if (grid < 0) return;
    (void)hipMemsetAsync((char*)d_ws + WS_CTL, 0, CTL_ZERO_BYTES, stream);
    Args a{};
    for (int i = 0; i < 24; ++i) a.in[i] = (const float*)d_in[i];
    a.out = (float*)d_out; a.ws = (unsigned char*)d_ws; a.pad = 0;
#if MK_CHECK
    constexpr int NLAUNCH = 12;
#else
    constexpr int NLAUNCH = MK_N_LAUNCHES;
#endif
    for (int li = 0; li < NLAUNCH; ++li) {
        a.ph_lo = (NLAUNCH == 1) ? 0 : li; a.ph_hi = (NLAUNCH == 1) ? NPHASE : li + 1; a.li = li;
#if MK_CHECK
        if (li >= 10) { a.ph_lo = li + 9; a.ph_hi = li + 10; }
#endif
        hipLaunchKernelGGL(fwd, dim3(grid), dim3(512), LDS_BYTES, stream, a);
    }
}
```

```cpp
#include <hip/hip_runtime.h>
#include <cstdio>
#include <cstdint>
#define MK_DBG 0
#define MK_N_LAUNCHES 1
#define MK_CHECK 0
namespace pg8 {
#define PG8_LAS __attribute__((address_space(3)))
typedef unsigned short bf16_t;
typedef short bf16x8 __attribute__((ext_vector_type(8)));
typedef float f32x4 __attribute__((ext_vector_type(4)));
typedef unsigned u32x4 __attribute__((ext_vector_type(4)));
constexpr int BM = 256, BK = 64, HALF = 128, HTB = HALF * BK * 2  , STAGE_BYTES = 8 * HTB, NXCD = 8, WGM = 8;

__host__ __device__ __forceinline__ int lds_byte(int r, int c) { const int st = (r >> 4) * 2 + (c >> 5), rr = r & 15, cc = c & 31, ob = rr * 64 + cc * 2; return st * 1024 + (ob ^ (((ob >> 9) & 1) << 5)); }
__host__ __device__ __forceinline__ void stage_rc(int b, int& R, int& C) { const int st = b / 1024, sb = b % 1024, swz = sb ^ (((sb >> 9) & 1) << 5); R = (st >> 1) * 16 + swz / 64; C = (st & 1) * 32 + (swz % 64) / 2; }
__host__ __device__ __forceinline__ int perm32(int rho) { const int n = rho >> 4, i = rho & 15; return 8 * (i >> 2) + 4 * n + (i & 3); }

struct Unit { int pm, pn; };
struct Gemm { const bf16_t* A; const bf16_t* Bt; int M, N, K; };

struct StaticOrder {
    int nM, nN, nwg, G, c;
    __host__ __device__ void init(int M, int N, int G_, int c_) { nM = M / BM; nN = N / BM; nwg = nM * nN; G = G_; c = c_; }
    __host__ __device__ bool next(int i, Unit& u) const {
        const long L = (long)i * G + c; if (L >= nwg) return false;
        int wgid = (int)L; { const int q = nwg / NXCD, r = nwg % NXCD, xcd = wgid % NXCD, off = wgid / NXCD; wgid = (xcd < r ? xcd * (q + 1) : r * (q + 1) + (xcd - r) * q) + off; }
        const int nig = WGM * nN, gid = wgid / nig, fm = gid * WGM, gsz = (nM - fm) < WGM ? (nM - fm) : WGM;
        u.pm = fm + ((wgid % nig) % gsz); u.pn = (wgid % nig) / gsz; return true;
    }
    __device__ __forceinline__ void a_ready(const Unit&) const {}
    __device__ __forceinline__ void done(const Unit&) const {}
};
struct CountedOrder : StaticOrder {
    const unsigned* ready; unsigned need; unsigned* tmo;
    __device__ __forceinline__ void a_ready(const Unit& u) const {
        if (threadIdx.x < 64) {
            const unsigned long long t0 = __builtin_amdgcn_s_memrealtime(); unsigned polls = 0;
            while ((unsigned)__builtin_amdgcn_readfirstlane(__hip_atomic_load(ready + 64 * u.pm, __ATOMIC_RELAXED, __HIP_MEMORY_SCOPE_AGENT)) < need) {
                if ((++polls & 255u) == 0u && __builtin_amdgcn_readfirstlane(__hip_atomic_load(tmo, __ATOMIC_RELAXED, __HIP_MEMORY_SCOPE_AGENT)) != 0u) break;
                if (__builtin_amdgcn_s_memrealtime() - t0 > 2000000ull) {
                    if (threadIdx.x == 0) { unsigned expect = 0u; __hip_atomic_compare_exchange_strong(tmo + 1, &expect, 0x600u | (unsigned)(u.pm & 0xff), __ATOMIC_RELAXED, __ATOMIC_RELAXED, __HIP_MEMORY_SCOPE_AGENT); __hip_atomic_store(tmo, 1u, __ATOMIC_RELAXED, __HIP_MEMORY_SCOPE_AGENT); }
                    break; }
                __builtin_amdgcn_s_sleep(2); }
            __builtin_amdgcn_fence(__ATOMIC_ACQUIRE, "agent");
            asm volatile("s_waitcnt vmcnt(0)" ::: "memory");
        }
#if !defined(BROKEN_HOOK_NO_BARRIER)
        asm volatile("" ::: "memory"); __builtin_amdgcn_s_barrier(); asm volatile("" ::: "memory");
#endif
    }
};

__device__ __forceinline__ unsigned cvt_pk_bf16(float lo, float hi) { unsigned r; asm volatile("v_cvt_pk_bf16_f32 %0, %1, %2" : "=v"(r) : "v"(lo), "v"(hi)); return r; }
typedef float f32x2 __attribute__((ext_vector_type(2)));
__device__ __forceinline__ f32x2 gelu_pk(f32x2 v) {
    const f32x2 av = __builtin_elementwise_abs(v), d = av * 0.2316418882f + 1.0f;
    f32x2 t; t.x = __builtin_amdgcn_rcpf(d.x); t.y = __builtin_amdgcn_rcpf(d.y);
    f32x2 q = t * 0.5307027145f + (-0.7265760135f); q = q * t + 0.7107068705f; q = q * t + (-0.142248368f); q = q * t + 0.127414796f; q = q * t;
    const f32x2 s = (v * v) * (-0.72134752044f);
    f32x2 e; e.x = __builtin_amdgcn_exp2f(s.x); e.y = __builtin_amdgcn_exp2f(s.y);
    const f32x2 m = v * (q * e), r = v - m;
    f32x2 o; o.x = v.x < 0.f ? m.x : r.x; o.y = v.y < 0.f ? m.y : r.y; return o;
}

struct EpiF32 {
    static constexpr bool PERM = false, AFTER_DRAIN = false;
    float* C; int ldc; const float* bias;
    __device__ __forceinline__ void operator()(const f32x4 (&acc)[2][2][4][2], const Unit& u, int wr, int wc, int fr, int fq) const {
        const int row0 = u.pm * BM + wr * 64 + fr, col0 = u.pn * BM + wc * 32 + 4 * fq;
        f32x4 bv[2][2];
#pragma unroll
        for (int bj = 0; bj < 2; ++bj)
#pragma unroll
            for (int n = 0; n < 2; ++n) bv[bj][n] = bias ? *(const f32x4*)(bias + col0 + bj * HALF + n * 16) : (f32x4){0.f, 0.f, 0.f, 0.f};
#pragma unroll
        for (int ai = 0; ai < 2; ++ai)
#pragma unroll
            for (int m = 0; m < 4; ++m) { float* rowp = C + (size_t)(row0 + ai * HALF + m * 16) * ldc + col0;
#pragma unroll
                for (int bj = 0; bj < 2; ++bj)
#pragma unroll
                    for (int n = 0; n < 2; ++n) *(f32x4*)(rowp + bj * HALF + n * 16) = acc[ai][bj][m][n] + bv[bj][n]; }
    }
};
template <int ACT  > struct EpiBf16 {
    static constexpr bool PERM = true, AFTER_DRAIN = false;
    bf16_t* O; int ldc; const float* bias; int split_cols; size_t split_stride;
    __device__ __forceinline__ void operator()(const f32x4 (&acc)[2][2][4][2], const Unit& u, int wr, int wc, int fr, int fq) const {
        const int row0 = u.pm * BM + wr * 64 + fr; int colt = u.pn * BM; bf16_t* base = O;
        if (split_cols) { const int t = colt / split_cols; base += (size_t)t * split_stride; colt -= t * split_cols; }
        const int col0 = colt + wc * 32 + 8 * fq, bcol0 = u.pn * BM + wc * 32 + 8 * fq;
        f32x4 bv[2][2];
#pragma unroll
        for (int bj = 0; bj < 2; ++bj)
#pragma unroll
            for (int n = 0; n < 2; ++n) bv[bj][n] = bias ? *(const f32x4*)(bias + bcol0 + bj * HALF + 4 * n) : (f32x4){0.f, 0.f, 0.f, 0.f};
#pragma unroll
        for (int ai = 0; ai < 2; ++ai)
#pragma unroll
            for (int m = 0; m < 4; ++m) { bf16_t* rowp = base + (size_t)(row0 + ai * HALF + m * 16) * ldc + col0;
#pragma unroll
                for (int bj = 0; bj < 2; ++bj) { f32x4 v0 = acc[ai][bj][m][0] + bv[bj][0], v1 = acc[ai][bj][m][1] + bv[bj][1];
                    if (ACT == 1) { f32x2 a = gelu_pk((f32x2){v0[0], v0[1]}), b = gelu_pk((f32x2){v0[2], v0[3]}), c = gelu_pk((f32x2){v1[0], v1[1]}), d = gelu_pk((f32x2){v1[2], v1[3]});
                        v0 = (f32x4){a.x, a.y, b.x, b.y}; v1 = (f32x4){c.x, c.y, d.x, d.y}; }
                    if (ACT == 2) {
#pragma unroll
                        for (int j = 0; j < 4; ++j) { v0[j] = 0.5f * v0[j] * (1.0f + erff(v0[j] * 0.70710678f)); v1[j] = 0.5f * v1[j] * (1.0f + erff(v1[j] * 0.70710678f)); } }
                    u32x4 w; w.x = cvt_pk_bf16(v0[0], v0[1]); w.y = cvt_pk_bf16(v0[2], v0[3]); w.z = cvt_pk_bf16(v1[0], v1[1]); w.w = cvt_pk_bf16(v1[2], v1[3]);
                    *(u32x4*)(rowp + bj * HALF) = w; } }
    }
};
template <class Epi, class Sched, bool STAMP = false>
__device__ __forceinline__ void gemm_phase(PG8_LAS unsigned char* lds, const Gemm g, const Sched& S, const Epi& E, unsigned long long* stamps) {
    int tid_o = threadIdx.x; asm volatile("" : "+v"(tid_o));
    const int tid = tid_o, wid = __builtin_amdgcn_readfirstlane(tid >> 6), lane = tid & 63, wr = wid >> 2, wc = wid & 3, fr = lane & 15, fq = lane >> 4;
    constexpr int K = 2048, nt = K / BK;
    int ts_lo = 0, ts_hi = 0, nts = 0; const unsigned long long rt_entry = STAMP ? (unsigned long long)wall_clock64() : 0ull;
#define PG8_STAMP() do { if (STAMP && wid == 0 && nts < 64) { const unsigned long long _c = (unsigned long long)clock64(); \
        ts_lo = (lane == nts) ? (int)(unsigned)_c : ts_lo; ts_hi = (lane == nts) ? (int)(unsigned)(_c >> 32) : ts_hi; ++nts; } } while (0)
    PG8_STAMP();
    unsigned voffA[2], voffB[2];
#pragma unroll
    for (int i = 0; i < 2; ++i) { int R, C; stage_rc(tid * 16 + i * 8192, R, C); const int Rb = Epi::PERM ? ((R & ~31) + perm32(R & 31)) : R;
        voffA[i] = (unsigned)(R * K + C) * 2u; voffB[i] = (unsigned)(Rb * K + C) * 2u; }
    const size_t kstep = (size_t)(BK * 2);
    const size_t hstep = (size_t)HALF * K * 2;
    const size_t tstep = 2 * hstep;
    const unsigned ldsw = (unsigned)wid * 1024u;
    const int aoff = lds_byte(wr * 64 + fr, fq * 8), boff = lds_byte(wc * 32 + fr, fq * 8);
#define PG8_SA(b, h) (((b) * 2 + (h)) * HTB)
#define PG8_SB(b, h) ((4 + (b) * 2 + (h)) * HTB)
#define PG8_STAGE(bufoff, gbase, voff) do { _Pragma("unroll") for (int _i = 0; _i < 2; ++_i) \
        __builtin_amdgcn_global_load_lds((const unsigned*)((const char*)(gbase) + (voff)[_i]), (PG8_LAS unsigned*)(lds + (bufoff) + ldsw + _i * 8192), 16, 0, 0); } while (0)
#define PG8_LDA(dst, b, h) do { _Pragma("unroll") for (int m = 0; m < 4; ++m) _Pragma("unroll") for (int k = 0; k < 2; ++k) dst[m][k] = *(const PG8_LAS bf16x8*)(lds + PG8_SA(b, h) + aoff + m * 2048 + k * 1024); } while (0)
#define PG8_LDB(dst, b, h) do { _Pragma("unroll") for (int n = 0; n < 2; ++n) _Pragma("unroll") for (int k = 0; k < 2; ++k) dst[n][k] = *(const PG8_LAS bf16x8*)(lds + PG8_SB(b, h) + boff + n * 2048 + k * 1024); } while (0)
#define PG8_MMA(ai, bj, At, Bt) do { __builtin_amdgcn_s_setprio(1); _Pragma("unroll") for (int m = 0; m < 4; ++m) _Pragma("unroll") for (int n = 0; n < 2; ++n) _Pragma("unroll") for (int k = 0; k < 2; ++k) \
        acc[ai][bj][m][n] = __builtin_amdgcn_mfma_f32_16x16x32_bf16(Bt[n][k], At[m][k], acc[ai][bj][m][n], 0, 0, 0); __builtin_amdgcn_s_setprio(0); } while (0)
#define PG8_WAIT_V(n) asm volatile("s_waitcnt vmcnt(" #n ")" ::: "memory")
#define PG8_WAIT_L(n) asm volatile("s_waitcnt lgkmcnt(" #n ")" ::: "memory")
#define PG8_BAR __builtin_amdgcn_s_barrier()
#define PG8_SCHED __builtin_amdgcn_sched_barrier(0)
    Unit cur, nxt; int ui = 0;
    if (!S.next(0, cur)) return;
    f32x4 acc[2][2][4][2];
#pragma unroll
    for (int a = 0; a < 2; ++a)
#pragma unroll
        for (int b = 0; b < 2; ++b)
#pragma unroll
            for (int m = 0; m < 4; ++m)
#pragma unroll
                for (int n = 0; n < 2; ++n) acc[a][b][m][n] = (f32x4){0.f, 0.f, 0.f, 0.f};
    bf16x8 At[4][2], B0[2][2], B1[2][2];
    const char* cA = (const char*)g.A + (size_t)cur.pm * tstep; const char* cB = (const char*)g.Bt + (size_t)cur.pn * tstep;
    S.a_ready(cur);
    PG8_STAGE(PG8_SB(0, 0), cB, voffB); PG8_STAGE(PG8_SA(0, 0), cA, voffA); PG8_STAGE(PG8_SB(0, 1), cB + hstep, voffB); PG8_STAGE(PG8_SA(0, 1), cA + hstep, voffA);
    if (wr == 1) PG8_BAR;
    PG8_WAIT_V(4); PG8_BAR;
    PG8_STAGE(PG8_SB(1, 0), cB + kstep, voffB); PG8_STAGE(PG8_SA(1, 0), cA + kstep, voffA); PG8_STAGE(PG8_SB(1, 1), cB + hstep + kstep, voffB);
    PG8_WAIT_V(6); PG8_BAR;
    PG8_STAMP();
    for (;;) {
        const bool has_next = S.next(ui + 1, nxt);
        const char* nA = has_next ? (const char*)g.A + (size_t)nxt.pm * tstep : cA; const char* nB = has_next ? (const char*)g.Bt + (size_t)nxt.pn * tstep : cB;
        for (int t = 0; t < nt; t += 2) {
            const bool last = (t == nt - 2);
            const char* a1 = cA + (size_t)(t + 1) * kstep;
            const char* a2 = last ? nA : cA + (size_t)(t + 2) * kstep; const char* b2 = last ? nB : cB + (size_t)(t + 2) * kstep;
            const char* a3 = a2 + kstep; const char* b3 = b2 + kstep;
            if (last && has_next) S.a_ready(nxt);
            PG8_LDB(B0, 0, 0); PG8_SCHED; PG8_LDA(At, 0, 0); PG8_STAGE(PG8_SA(1, 1), a1 + hstep, voffA);
            PG8_WAIT_L(8); PG8_BAR; PG8_WAIT_L(0); PG8_MMA(0, 0, At, B0); PG8_BAR; PG8_SCHED;
            PG8_LDB(B1, 0, 1); PG8_STAGE(PG8_SB(0, 0), b2, voffB);
            PG8_BAR; PG8_WAIT_L(0); PG8_MMA(0, 1, At, B1); PG8_BAR;
            PG8_LDA(At, 0, 1); PG8_STAGE(PG8_SA(0, 0), a2, voffA);
            PG8_BAR; PG8_WAIT_L(0); PG8_MMA(1, 0, At, B0); PG8_BAR; PG8_SCHED;
            PG8_STAGE(PG8_SB(0, 1), b2 + hstep, voffB);
            PG8_WAIT_V(6); PG8_BAR; PG8_MMA(1, 1, At, B1); PG8_BAR;
            PG8_LDB(B0, 1, 0); PG8_SCHED; PG8_LDA(At, 1, 0); PG8_STAGE(PG8_SA(0, 1), a2 + hstep, voffA);
            PG8_WAIT_L(8); PG8_BAR; PG8_WAIT_L(0); PG8_MMA(0, 0, At, B0); PG8_BAR; PG8_SCHED;
            PG8_LDB(B1, 1, 1); PG8_STAGE(PG8_SB(1, 0), b3, voffB);
            PG8_BAR; PG8_WAIT_L(0); PG8_MMA(0, 1, At, B1); PG8_BAR;
            PG8_LDA(At, 1, 1); PG8_STAGE(PG8_SA(1, 0), a3, voffA);
            PG8_BAR; PG8_WAIT_L(0); PG8_MMA(1, 0, At, B0); PG8_BAR; PG8_SCHED;
            PG8_STAGE(PG8_SB(1, 1), b3 + hstep, voffB);
            PG8_WAIT_V(6); PG8_BAR; PG8_MMA(1, 1, At, B1); PG8_BAR;
        }
        PG8_STAMP();
        if constexpr (!Epi::AFTER_DRAIN) { E(acc, cur, wr, wc, fr, fq); S.done(cur); }
        PG8_STAMP();
        if (!has_next) break;
#pragma unroll
        for (int a = 0; a < 2; ++a)
#pragma unroll
            for (int b = 0; b < 2; ++b)
#pragma unroll
                for (int m = 0; m < 4; ++m)
#pragma unroll
                    for (int n = 0; n < 2; ++n) acc[a][b][m][n] = (f32x4){0.f, 0.f, 0.f, 0.f};
        cur = nxt; cA = nA; cB = nB; ++ui;
    }
    PG8_WAIT_V(0);
    if (wr == 0) PG8_BAR;
    PG8_BAR;
    if constexpr (Epi::AFTER_DRAIN) { E.fused(acc, cur, wr, wc, fr, fq, lds, wid, lane); S.done(cur); }
    PG8_STAMP();
    if (STAMP && wid == 0) { stamps[lane] = lane < nts ? (((unsigned long long)(unsigned)ts_hi << 32) | (unsigned)ts_lo) : 0ull;
        if (lane == 62) stamps[62] = rt_entry; if (lane == 63) stamps[63] = (unsigned long long)wall_clock64(); }
#undef PG8_STAMP
#undef PG8_SA
#undef PG8_SB
#undef PG8_STAGE
#undef PG8_LDA
#undef PG8_LDB
#undef PG8_MMA
#undef PG8_WAIT_V
#undef PG8_WAIT_L
#undef PG8_BAR
#undef PG8_SCHED
}
}

namespace mk {
#define GAS __attribute__((address_space(1)))
#define LAS __attribute__((address_space(3)))
#define DEV __device__ __forceinline__
typedef unsigned short bf16;
typedef unsigned v4u __attribute__((ext_vector_type(4)));
typedef float f32x4 __attribute__((ext_vector_type(4)));
typedef float f32x2 __attribute__((ext_vector_type(2)));
typedef short bf16x8 __attribute__((ext_vector_type(8)));
typedef float f32x16 __attribute__((ext_vector_type(16)));
typedef __bf16 bf16x2_t __attribute__((ext_vector_type(2)));

#ifndef MK_DBG
#define MK_DBG 0
#endif
#ifndef MK_CHECK
#define MK_CHECK 0
#endif
#ifndef MK_DUP
#define MK_DUP (-1)
#endif
#ifndef MK_N_LAUNCHES
#define MK_N_LAUNCHES 19
#endif

constexpr int D = 2048, SEQ = 4096, M = 8192, NL = 2;
constexpr int LRU_W = 768, SWA_W = 768, SB_W = 512, IN_W = 5376;
constexpr int ZO_XA = 0, ZO_GA = 768, ZO_QB = 1536, ZO_KB = 2304, ZO_VB = 3072, ZO_QC = 3840, ZO_KC = 4352, ZO_VC = 4864;
constexpr int NEXP = 16384, MODW = 12288;
constexpr int MO_SH1 = 0, MO_SC1 = 2048, MO_G1 = 4096, MO_SH2 = 6144, MO_SC2 = 8192, MO_G2 = 10240;
constexpr float EPS = 1e-6f;
constexpr float QSCALE = 0.08838834764831845f;
constexpr float NEGBIG = -3.0e38f;
constexpr int NPHASE = 19 + 2 * (MK_CHECK != 0);

constexpr size_t MiB = 1u << 20;
constexpr size_t WS_CTL = 0, CTL_ZERO_BYTES = 1 * MiB;
constexpr size_t WS_MOD = 512 * 1024;
constexpr size_t WS_WIN_T = 2 * MiB, WS_WOUT_T = 44 * MiB, WS_WQ_T = 60 * MiB, WS_SUBK = 76 * MiB, WS_U = 80 * MiB, WS_V = 208 * MiB,
                 WS_H = 336 * MiB, WS_Z = 368 * MiB, WS_HLOC = 452 * MiB, WS_P = 476 * MiB, WS_YB = 500 * MiB, WS_YC = 524 * MiB,
                 WS_SUMA = 540 * MiB, WS_SUMB = 541 * MiB, WS_X1 = 544 * MiB, WS_X2 = 608 * MiB, WS_Q = 672 * MiB, WS_IDS = 704 * MiB,
                 WS_G = 708 * MiB, WS_WG_T = 77 * MiB, WS_PART = 712 * MiB, WS_LSE = 784 * MiB, WS_END = 785 * MiB;
constexpr int CW_BAR = 4096;

constexpr int LDS_BYTES = 147456;
constexpr int LDS_MISC = 143360;

__device__ const unsigned char T5B[3][132] = {
 {0,1,2,3,4,5,6,7,8,9,10,11,12,13,14,15,16,16,16,16,16,16,17,17,17,17,17,17,17,17,18,18,18,18,18,18,18,18,18,18,19,19,19,19,19,19,19,19,19,19,19,19,19,19,20,20,20,20,20,20,20,20,20,20,20,20,20,20,20,20,20,20,20,21,21,21,21,21,21,21,21,21,21,21,21,21,21,21,21,21,21,21,21,21,21,21,21,21,21,22,22,22,22,22,22,22,22,22,22,22,22,22,22,22,22,22,22,22,22,22,22,22,22,22,22,22,22,22,22,0,0,0},
 {0,4,8,12,16,16,17,17,18,18,19,19,19,19,20,20,20,20,20,21,21,21,21,21,21,22,22,22,22,22,22,22,22,22,23,23,23,23,23,23,23,23,23,23,23,23,24,24,24,24,24,24,24,24,24,24,24,24,24,24,24,24,25,25,25,25,25,25,25,25,25,25,25,25,25,25,25,25,25,25,25,25,25,26,26,26,26,26,26,26,26,26,26,26,26,26,26,26,26,26,26,26,26,26,26,26,26,26,26,26,26,26,26,27,27,27,27,27,27,27,27,27,27,27,27,27,27,27,27,0,0,0},
 {0,16,18,19,20,21,21,22,22,23,23,23,24,24,24,24,25,25,25,25,25,26,26,26,26,26,26,26,26,27,27,27,27,27,27,27,27,27,27,28,28,28,28,28,28,28,28,28,28,28,28,28,29,29,29,29,29,29,29,29,29,29,29,29,29,29,29,29,29,29,30,30,30,30,30,30,30,30,30,30,30,30,30,30,30,30,30,30,30,30,30,30,30,30,30,31,31,31,31,31,31,31,31,31,31,31,31,31,31,31,31,31,31,31,31,31,31,31,31,31,31,31,31,31,31,31,31,31,31,0,0,0}};

#define LDS_WAIT() asm volatile("s_waitcnt lgkmcnt(0)" ::: "memory")
DEV unsigned f2bf(float f) { unsigned u = __builtin_bit_cast(unsigned, f); return (u + 0x7fffu + ((u >> 16) & 1u)) >> 16; }
DEV unsigned pk2(float lo, float hi) { return f2bf(lo) | (f2bf(hi) << 16); }
DEV float bf_lo(unsigned w) { return __builtin_bit_cast(float, w << 16); }
DEV float bf_hi(unsigned w) { return __builtin_bit_cast(float, w & 0xffff0000u); }
DEV float bf1(bf16 h) { return __builtin_bit_cast(float, ((unsigned)h) << 16); }
template <int MSK> DEV float swz_xor(float v) { return __builtin_bit_cast(float, __builtin_amdgcn_ds_swizzle(__builtin_bit_cast(int, v), (MSK << 10) | 0x1F)); }
DEV float part32_(float v) { int ln = (int)__builtin_amdgcn_mbcnt_hi(~0u, __builtin_amdgcn_mbcnt_lo(~0u, 0u)); asm volatile("" : "+v"(ln)); return __builtin_bit_cast(float, __builtin_amdgcn_ds_bpermute((ln ^ 32) << 2, __builtin_bit_cast(int, v))); }
DEV float sum32(float v) { return v + part32_(v); }
DEV float max32(float v) { return fmaxf(v, part32_(v)); }
DEV float partner32(float v, int hh) { (void)hh; return part32_(v); }
DEV float wave_sum(float v) { v += swz_xor<1>(v); v += swz_xor<2>(v); v += swz_xor<4>(v); v += swz_xor<8>(v); v += swz_xor<16>(v); return sum32(v); }
DEV float wave_max(float v) { v = fmaxf(v, swz_xor<1>(v)); v = fmaxf(v, swz_xor<2>(v)); v = fmaxf(v, swz_xor<4>(v)); v = fmaxf(v, swz_xor<8>(v)); v = fmaxf(v, swz_xor<16>(v)); return max32(v); }
DEV float sigmoid_f(float x) { return 1.f / (1.f + __expf(-x)); }
DEV float softplus_f(float x) { return fmaxf(x, 0.f) + log1pf(__expf(-fabsf(x))); }
DEV float gelu_tanh(float x) { const float u = 0.7978845608028654f * (x + 0.044715f * x * x * x); const float t = 1.f - 2.f / (1.f + __expf(2.f * u)); return 0.5f * x * (1.f + t); }
DEV float dot8(const v4u a, const v4u b) {
    float s = bf_lo(a.x) * bf_lo(b.x); s += bf_hi(a.x) * bf_hi(b.x);
    s += bf_lo(a.y) * bf_lo(b.y); s += bf_hi(a.y) * bf_hi(b.y);
    s += bf_lo(a.z) * bf_lo(b.z); s += bf_hi(a.z) * bf_hi(b.z);
    s += bf_lo(a.w) * bf_lo(b.w); s += bf_hi(a.w) * bf_hi(b.w);
    return s;
}

#define XB_TMO      128
#define XB_XCNT(j)  (256  + 64 * (j))
#define XB_XSUB(j)  (1280 + 64 * (j))
#define XB_XGEN(j)  (2304 + 64 * (j))
#define XB_TOP      3328
#define XB_TOPGEN   3392
#define XCD_BAR_WORDS 3456
#define XB_SPIN_CAP (1u << 18)

__device__ __forceinline__ unsigned xb_ld(unsigned* p)              { return __hip_atomic_load(p, __ATOMIC_RELAXED, __HIP_MEMORY_SCOPE_AGENT); }
__device__ __forceinline__ unsigned xb_add(unsigned* p, unsigned v) { return __hip_atomic_fetch_add(p, v, __ATOMIC_RELAXED, __HIP_MEMORY_SCOPE_AGENT); }
__device__ __forceinline__ unsigned xb_xcc_id() { return (unsigned)__builtin_amdgcn_s_getreg((3 << 11) | 20) & 0xFu; }
#define XB_SPIN(cond, bar) do { unsigned _sp = 0; while (cond) { __builtin_amdgcn_s_sleep(1); \
    if ((++_sp & 255u) == 0u) { if (xb_ld(&(bar)[XB_TMO])) break; if (_sp > XB_SPIN_CAP) { atomicAdd(&(bar)[XB_TMO], 1u); break; } } } } while (0)

struct XcdBarrier {
    unsigned* bar; unsigned x;
    volatile LAS unsigned* st;
};
__device__ __forceinline__ XcdBarrier xcd_barrier_post(unsigned* bar, volatile LAS unsigned* st) {
    XcdBarrier b; b.bar = bar; b.x = xb_xcc_id(); b.st = st;
    if (threadIdx.x == 0) (void)xb_add(&bar[XB_XCNT(b.x)], 1u);
    return b;
}
__device__ __forceinline__ void xcd_barrier_complete(unsigned* bar, unsigned x, unsigned& nloc, unsigned& nx) {
    const unsigned G = gridDim.x * gridDim.y * gridDim.z;
    unsigned sum, cnt, mine, sp = 0u;
    for (;;) {
        sum = 0u; cnt = 0u; mine = 0u;
#pragma unroll
        for (unsigned j = 0; j < 16; ++j) { const unsigned c = xb_ld(&bar[XB_XCNT(j)]); sum += c; cnt += (c > 0u) ? 1u : 0u; mine = (j == x) ? c : mine; }
        if (sum == G) break;
        __builtin_amdgcn_s_sleep(1);
        if ((++sp & 255u) == 0u) { if (xb_ld(&bar[XB_TMO])) break; if (sp > XB_SPIN_CAP) { atomicAdd(&bar[XB_TMO], 1u); break; } }
    }
    nloc = mine > 0u ? mine : 1u; nx = cnt > 0u ? cnt : 1u;
}
__device__ __forceinline__ void xcd_barrier(const XcdBarrier& b) {
    asm volatile("s_waitcnt vmcnt(0)" ::: "memory");
    __syncthreads();
    if (threadIdx.x == 0) {
        unsigned* bar = b.bar;
        __builtin_amdgcn_s_waitcnt(0);
        unsigned nloc = b.st[0], nx = b.st[1];
        if (nloc == 0u) { xcd_barrier_complete(bar, b.x, nloc, nx); b.st[0] = nloc; b.st[1] = nx; }
        const unsigned old = xb_add(&bar[XB_XSUB(b.x)], 1u);
        const unsigned gen = old / nloc;
        if (old + 1u == (gen + 1u) * nloc) {
            __builtin_amdgcn_fence(__ATOMIC_RELEASE, "agent");
            asm volatile("s_waitcnt vmcnt(0)" ::: "memory");
            const unsigned og = xb_add(&bar[XB_TOP], 1u);
            const unsigned tg = og / nx;
            if (og + 1u == (tg + 1u) * nx) xb_add(&bar[XB_TOPGEN], 1u);
            else XB_SPIN(xb_ld(&bar[XB_TOPGEN]) == tg, bar);
            __builtin_amdgcn_fence(__ATOMIC_ACQUIRE, "agent");
            xb_add(&bar[XB_XGEN(b.x)], 1u);
            asm volatile("s_waitcnt vmcnt(0)" ::: "memory");
        } else {
            XB_SPIN(xb_ld(&bar[XB_XGEN(b.x)]) == gen, bar);
            __builtin_amdgcn_fence(__ATOMIC_ACQUIRE, "agent");
            asm volatile("s_waitcnt vmcnt(0)" ::: "memory");
        }
    }
    __syncthreads();
}

struct EpiResGate {
    static constexpr bool PERM = false, AFTER_DRAIN = false;
    const float* X; float* O; const float* gate; float gscale;
    __device__ __forceinline__ void operator()(const pg8::f32x4 (&acc)[2][2][4][2], const pg8::Unit& u, int wr, int wc, int fr, int fq) const {
        const int row0 = u.pm * 256 + wr * 64 + fr, col0 = u.pn * 256 + wc * 32 + 4 * fq;
        const float* gp = gate + (size_t)((u.pm * 256) >> 12) * MODW;
        pg8::f32x4 gv[2][2];
#pragma unroll
        for (int bj = 0; bj < 2; ++bj)
#pragma unroll
            for (int n = 0; n < 2; ++n) gv[bj][n] = *(const pg8::f32x4*)(gp + col0 + bj * 128 + n * 16) * gscale;
#pragma unroll
        for (int ai = 0; ai < 2; ++ai)
#pragma unroll
            for (int m = 0; m < 4; ++m) {
                const size_t ro = (size_t)(row0 + ai * 128 + m * 16) * D + col0;
#pragma unroll
                for (int bj = 0; bj < 2; ++bj)
#pragma unroll
                    for (int n = 0; n < 2; ++n) {
                        const pg8::f32x4 xv = *(const pg8::f32x4*)(X + ro + bj * 128 + n * 16);
                        *(pg8::f32x4*)(O + ro + bj * 128 + n * 16) = xv + gv[bj][n] * acc[ai][bj][m][n];
                    }
            }
    }
};

DEV void ph_mod(const float* __restrict__ c, const float* __restrict__ w_mod, const float* __restrict__ b_mod, float* __restrict__ mod, LAS float* red, int vcu, int G, int tid) {
    const int lane = tid & 63, wave = tid >> 6;
    for (int it = vcu; it < 2 * 192; it += G) {
        const int l = it / 192, cb = it % 192;
        const int k0 = wave * 256;
        const float* W = w_mod + ((size_t)l * D + k0) * MODW + cb * 64 + lane;
        float a0 = 0.f, a1 = 0.f;
#pragma unroll 16
        for (int k = 0; k < 256; ++k) {
            const float w = W[(size_t)k * MODW];
            const float c0 = c[k0 + k], c1 = c[D + k0 + k];
            a0 += (c0 * sigmoid_f(c0)) * w; a1 += (c1 * sigmoid_f(c1)) * w;
        }
        red[(wave * 2 + 0) * 64 + lane] = a0; red[(wave * 2 + 1) * 64 + lane] = a1;
        __syncthreads();
        if (tid < 128) {
            const int b = tid >> 6, ln = tid & 63; float s = 0.f;
#pragma unroll
            for (int w = 0; w < 8; ++w) s += red[(w * 2 + b) * 64 + ln];
            const int col = cb * 64 + ln;
            mod[(size_t)(l * 2 + b) * MODW + col] = s + b_mod[l * MODW + col];
        }
        __syncthreads();
    }
}
DEV void transpose_item(const float* __restrict__ W, int K, int N, bf16* __restrict__ WT, LAS float* scr, int item, int lane) {
    const int nblk = N / 32, kb = item / nblk, nb = item % nblk, k0 = 64 * kb, n0 = 32 * nb;
#pragma unroll 8
    for (int i = 0; i < 32; ++i) { const int kk = 2 * i + (lane >> 5); scr[kk * 33 + (lane & 31)] = W[(size_t)(k0 + kk) * N + n0 + (lane & 31)]; }
    LDS_WAIT();
    const int c = lane & 7;
#pragma unroll
    for (int j = 0; j < 4; ++j) { const int n = (lane >> 3) + 8 * j; const LAS float* s = scr + (8 * c) * 33 + n;
        v4u o; o.x = pk2(s[0 * 33], s[1 * 33]); o.y = pk2(s[2 * 33], s[3 * 33]); o.z = pk2(s[4 * 33], s[5 * 33]); o.w = pk2(s[6 * 33], s[7 * 33]);
        *(v4u*)(WT + (size_t)(n0 + n) * K + k0 + 8 * c) = o; }
    LDS_WAIT();
}
DEV void convert_copy(const float* __restrict__ src, bf16* __restrict__ dst, size_t ngroups8, size_t gtid, size_t gstride) {
    for (size_t g = gtid; g < ngroups8; g += gstride) {
        const f32x4 a = *(const f32x4*)(src + g * 8), b = *(const f32x4*)(src + g * 8 + 4);
        v4u o; o.x = pk2(a.x, a.y); o.y = pk2(a.z, a.w); o.z = pk2(b.x, b.y); o.w = pk2(b.z, b.w);
        *(v4u*)(dst + g * 8) = o;
    }
}

DEV void modnorm_rows(const float* __restrict__ X, const float* __restrict__ gain, const float* __restrict__ modl, int sh_off, int sc_off, bf16* __restrict__ H, int gw, int NGW, int lane) {
    for (int m = gw; m < M; m += NGW) {
        const int b = m >> 12;
        const f32x4* xr = (const f32x4*)(X + (size_t)m * D) + lane;
        f32x4 v[8]; float s = 0.f;
#pragma unroll
        for (int j = 0; j < 8; ++j) { v[j] = xr[64 * j]; s += (v[j].x * v[j].x + v[j].y * v[j].y) + (v[j].z * v[j].z + v[j].w * v[j].w); }
        const float r = rsqrtf(wave_sum(s) * (1.f / D) + EPS);
        const f32x4* g4 = (const f32x4*)gain + lane;
        const f32x4* sc4 = (const f32x4*)(modl + (size_t)b * MODW + sc_off) + lane;
        const f32x4* sh4 = (const f32x4*)(modl + (size_t)b * MODW + sh_off) + lane;
        unsigned long long* o8 = (unsigned long long*)(H + (size_t)m * D) + lane;
#pragma unroll
        for (int j = 0; j < 8; ++j) {
            const f32x4 g = g4[64 * j], sc = sc4[64 * j], sh = sh4[64 * j];
            const f32x4 y = (v[j] * r) * g * (sc + 1.f) + sh;
            o8[64 * j] = (unsigned long long)pk2(y.x, y.y) | ((unsigned long long)pk2(y.z, y.w) << 32);
        }
    }
}

DEV void lru_item(int l, int b, int j, int n, const bf16* __restrict__ Z, const float* __restrict__ conv_w, const float* __restrict__ conv_b,
                  const float* __restrict__ w_rec, const float* __restrict__ b_rec, const float* __restrict__ w_gi, const float* __restrict__ b_gi, const float* __restrict__ lam,
                  float* __restrict__ HLOC, float* __restrict__ PP, float* __restrict__ SUMA, float* __restrict__ SUMB, LAS float* xc, LAS float* aL, LAS float* uL, int tid) {
    const int ch = tid & 127, tq = tid >> 7, c = n * 128 + ch;
    {
        const float cw0 = conv_w[(l * 4 + 0) * LRU_W + c], cw1 = conv_w[(l * 4 + 1) * LRU_W + c], cw2 = conv_w[(l * 4 + 2) * LRU_W + c], cw3 = conv_w[(l * 4 + 3) * LRU_W + c];
        const float cb = conv_b[l * LRU_W + c];
#pragma unroll 4
        for (int i = 0; i < 16; ++i) {
            const int tok = tq + 4 * i, t = j * 64 + tok;
            const bf16* zp = Z + ((size_t)b * SEQ + t) * IN_W + ZO_XA + c;
            float s = cb + cw3 * bf1(zp[0]);
            if (t >= 1) s += cw2 * bf1(zp[-(ptrdiff_t)IN_W]);
            if (t >= 2) s += cw1 * bf1(zp[-(ptrdiff_t)2 * IN_W]);
            if (t >= 3) s += cw0 * bf1(zp[-(ptrdiff_t)3 * IN_W]);
            xc[tok * 128 + ch] = s;
        }
    }
    __syncthreads();
    float accr[16], acci[16];
#pragma unroll
    for (int i = 0; i < 16; ++i) { accr[i] = 0.f; acci[i] = 0.f; }
    const float* Wr = w_rec + ((size_t)(l * 6 + n) * 128) * 128 + ch;
    const float* Wi = w_gi + ((size_t)(l * 6 + n) * 128) * 128 + ch;
#pragma unroll 2
    for (int jj = 0; jj < 128; ++jj) {
        const float wr = Wr[jj * 128], wi = Wi[jj * 128];
#pragma unroll
        for (int i = 0; i < 16; ++i) { const float x = xc[(tq + 4 * i) * 128 + jj]; accr[i] += x * wr; acci[i] += x * wi; }
    }
    {
        const float br = b_rec[l * LRU_W + c], bi = b_gi[l * LRU_W + c], sp = softplus_f(-lam[l * LRU_W + c]);
#pragma unroll
        for (int i = 0; i < 16; ++i) {
            const int tok = tq + 4 * i;
            const float r = sigmoid_f(accr[i] + br), ig = sigmoid_f(acci[i] + bi);
            const float log_a = -8.0f * r * sp;
            const float av = __expf(log_a);
            const float x = xc[tok * 128 + ch];
            const float uv = sqrtf(fmaxf(-expm1f(2.f * log_a), 0.f)) * (ig * x);
            aL[tok * 128 + ch] = av; uL[tok * 128 + ch] = uv;
        }
    }
    __syncthreads();
    if (tid < 128) {
        float h = 0.f, P = 1.f;
        const size_t rb = ((size_t)b * SEQ + j * 64) * LRU_W + n * 128 + tid;
        for (int tok = 0; tok < 64; ++tok) {
            const float av = aL[tok * 128 + tid];
            h = av * h + uL[tok * 128 + tid]; P *= av;
            HLOC[rb + (size_t)tok * LRU_W] = h; PP[rb + (size_t)tok * LRU_W] = P;
        }
        SUMA[(size_t)(b * 64 + j) * LRU_W + n * 128 + tid] = P; SUMB[(size_t)(b * 64 + j) * LRU_W + n * 128 + tid] = h;
    }
    __syncthreads();
}

DEV void dil_item(int b, int h, int t, const bf16* __restrict__ Z, const float* __restrict__ rel_bias, float* __restrict__ YB, LAS float* qs, LAS float* lg, int lane) {
    const size_t row = (size_t)b * SEQ + t;
    { const unsigned w = *(const unsigned*)(Z + row * IN_W + ZO_QB + h * 128 + 2 * lane); qs[2 * lane] = bf_lo(w) * QSCALE; qs[2 * lane + 1] = bf_hi(w) * QSCALE; }
    LDS_WAIT();
    float mx = NEGBIG;
#pragma unroll
    for (int p = 0; p < 3; ++p) {
        const int d = 1 << (2 * p);
        for (int jj = lane; jj < 129; jj += 64) {
            const int pos = t - jj * d; float lgt = NEGBIG;
            if (pos >= 0) {
                const v4u* kr = (const v4u*)(Z + ((size_t)b * SEQ + pos) * IN_W + ZO_KB + h * 128);
                float s = 0.f;
#pragma unroll 4
                for (int c8 = 0; c8 < 16; ++c8) { const v4u kv = kr[c8]; const LAS float* q = qs + c8 * 8;
                    s += q[0] * bf_lo(kv.x) + q[1] * bf_hi(kv.x) + q[2] * bf_lo(kv.y) + q[3] * bf_hi(kv.y) + q[4] * bf_lo(kv.z) + q[5] * bf_hi(kv.z) + q[6] * bf_lo(kv.w) + q[7] * bf_hi(kv.w); }
                lgt = s + rel_bias[(int)T5B[p][jj] * 6 + h];
            }
            lg[p * 129 + jj] = lgt; mx = fmaxf(mx, lgt);
        }
    }
    mx = wave_max(mx);
    LDS_WAIT();
    float sum = 0.f;
    for (int idx = lane; idx < 387; idx += 64) { const float v = lg[idx]; const float pv = (v > -1.0e37f) ? __expf(v - mx) : 0.f; lg[idx] = pv; sum += pv; }
    sum = wave_sum(sum);
    LDS_WAIT();
    float a0 = 0.f, a1 = 0.f;
#pragma unroll
    for (int p = 0; p < 3; ++p) {
        const int d = 1 << (2 * p);
        int nk = t / d + 1; nk = nk > 129 ? 129 : nk;
        const bf16* vb = Z + row * IN_W + ZO_VB + h * 128 + 2 * lane;
#pragma unroll 4
        for (int jj = 0; jj < nk; ++jj) {
            const float pv = lg[p * 129 + jj];
            const unsigned w = *(const unsigned*)(vb - (size_t)jj * d * IN_W);
            a0 += pv * bf_lo(w); a1 += pv * bf_hi(w);
        }
    }
    const float inv = 1.f / sum;
    *(f32x2*)(YB + row * SWA_W + h * 128 + 2 * lane) = (f32x2){a0 * inv, a1 * inv};
    LDS_WAIT();
}


DEV unsigned cvtpk_bf16(float lo, float hi) { f32x2 v = {lo, hi}; bf16x2_t b = __builtin_convertvector(v, bf16x2_t); return __builtin_bit_cast(unsigned, b); }
constexpr int DIL_VSTR = 272;
constexpr int DIL_QOFF = 32 * DIL_VSTR + 132 * 4;
constexpr int ATT_WLDS = 17920;
static_assert(DIL_QOFF + 8192 <= ATT_WLDS && 8 * ATT_WLDS <= LDS_MISC, "attention LDS");
DEV void dil_mfma_item(int b, int h, int p, int rr, int i0, const bf16* __restrict__ Z, const float* __restrict__ rel_bias, float* __restrict__ PART, float* __restrict__ LSE, LAS unsigned char* wl, int lane) {
    asm volatile("" : "+v"(lane));
    const int r = lane & 31, hh = lane >> 5;
    const int d = 1 << (2 * p);
    LAS float* biasL = (LAS float*)(wl + 32 * DIL_VSTR);
    for (int dd = lane; dd < 129; dd += 64) biasL[dd] = rel_bias[(int)T5B[p][dd] * 6 + h];
    const size_t rowq = (size_t)b * SEQ + rr + d * (i0 + r);
    LAS bf16x8* qL = (LAS bf16x8*)(wl + DIL_QOFF) + lane;
    { const bf16* qrow = Z + rowq * IN_W + ZO_QB + h * 128 + 8 * hh;
#pragma unroll
      for (int ks = 0; ks < 8; ++ks) qL[64 * ks] = *(const bf16x8*)(qrow + 16 * ks); }
    float m_run = NEGBIG, l_run = 0.f;
    f32x16 o[4];
#pragma unroll
    for (int dt = 0; dt < 4; ++dt)
#pragma unroll
        for (int e = 0; e < 16; ++e) o[dt][e] = 0.f;
    const int kap = (r & 0x13) | ((r & 4) << 1) | ((r & 8) >> 1);
    LDS_WAIT();
    int jt = 4 - (i0 >> 5); jt = jt < 0 ? 0 : jt;
    bf16x8 kf[8];
#define DIL_LOAD_V(JT) do { const int j0_ = i0 - 128 + 32 * (JT); _Pragma("unroll") for (int q = 0; q < 8; ++q) { const int pi = lane + 64 * q, kl = pi >> 4, c = pi & 15; int j = j0_ + kl; j = j < 0 ? 0 : j; \
        vr[q] = *(const v4u*)(Z + ((size_t)b * SEQ + rr + d * j) * IN_W + ZO_VB + h * 128 + 8 * c); } } while (0)
#define DIL_LOAD_K(JT) do { int jk = i0 - 128 + 32 * (JT) + kap; jk = jk < 0 ? 0 : jk; const bf16* krow = Z + ((size_t)b * SEQ + rr + d * jk) * IN_W + ZO_KB + h * 128 + 8 * hh; \
        _Pragma("unroll") for (int ks = 0; ks < 8; ++ks) kf[ks] = *(const bf16x8*)(krow + 16 * ks); } while (0)
    DIL_LOAD_K(jt);
    for (; jt < 5; ++jt) {
        const int j0 = i0 - 128 + 32 * jt;
        const int jn = jt < 4 ? jt + 1 : 4;
#pragma unroll
        for (int hf = 0; hf < 2; ++hf) {
            v4u vr[4];
#pragma unroll
            for (int q = 0; q < 4; ++q) { const int pi = lane + 64 * (4 * hf + q), kl = pi >> 4, c = pi & 15; int j = j0 + kl; j = j < 0 ? 0 : j;
                vr[q] = *(const v4u*)(Z + ((size_t)b * SEQ + rr + d * j) * IN_W + ZO_VB + h * 128 + 8 * c); }
#pragma unroll
            for (int q = 0; q < 4; ++q) { const int pi = lane + 64 * (4 * hf + q), kl = pi >> 4, c = pi & 15; *(LAS v4u*)(wl + kl * DIL_VSTR + c * 16) = vr[q]; }
        }
        f32x16 sacc;
#pragma unroll
        for (int e = 0; e < 16; ++e) sacc[e] = 0.f;
#pragma unroll
        for (int ks = 0; ks < 8; ++ks) sacc = __builtin_amdgcn_mfma_f32_32x32x16_bf16(kf[ks], qL[64 * ks], sacc, 0, 0, 0);
        DIL_LOAD_K(jn);
        float tm = NEGBIG;
#pragma unroll
        for (int e = 0; e < 16; ++e) {
            const int j = j0 + 16 * (e >> 3) + 8 * hh + (e & 7);
            const int dist = (i0 + r) - j;
            const bool valid = (j >= 0) && (dist >= 0) && (dist <= 128);
            const int dc = dist < 0 ? 0 : (dist > 128 ? 128 : dist);
            const float lg = valid ? sacc[e] * QSCALE + biasL[dc] : NEGBIG;
            sacc[e] = lg; tm = fmaxf(tm, lg);
        }
        tm = max32(tm);
        const float m_new = fmaxf(m_run, tm);
        const float alpha = __expf(m_run - m_new);
        float ps = 0.f;
#pragma unroll
        for (int e = 0; e < 16; ++e) { const float pv = (sacc[e] > -1.0e37f) ? __expf(sacc[e] - m_new) : 0.f; sacc[e] = pv; ps += pv; }
        ps = sum32(ps);
        l_run = l_run * alpha + ps; m_run = m_new;
#pragma unroll
        for (int dt = 0; dt < 4; ++dt)
#pragma unroll
            for (int e = 0; e < 16; ++e) o[dt][e] *= alpha;
        bf16x8 pf[2];
#pragma unroll
        for (int s2 = 0; s2 < 2; ++s2) { v4u w; w.x = cvtpk_bf16(sacc[8 * s2 + 0], sacc[8 * s2 + 1]); w.y = cvtpk_bf16(sacc[8 * s2 + 2], sacc[8 * s2 + 3]);
            w.z = cvtpk_bf16(sacc[8 * s2 + 4], sacc[8 * s2 + 5]); w.w = cvtpk_bf16(sacc[8 * s2 + 6], sacc[8 * s2 + 7]); pf[s2] = __builtin_bit_cast(bf16x8, w); }
        LDS_WAIT();
#pragma unroll
        for (int dt = 0; dt < 4; ++dt)
#pragma unroll
            for (int s2 = 0; s2 < 2; ++s2) {
                const LAS unsigned short* vp = (const LAS unsigned short*)(wl + (16 * s2 + 8 * hh) * DIL_VSTR + (32 * dt + r) * 2);
                v4u w;
                w.x = (unsigned)vp[0 * (DIL_VSTR / 2)] | ((unsigned)vp[1 * (DIL_VSTR / 2)] << 16);
                w.y = (unsigned)vp[2 * (DIL_VSTR / 2)] | ((unsigned)vp[3 * (DIL_VSTR / 2)] << 16);
                w.z = (unsigned)vp[4 * (DIL_VSTR / 2)] | ((unsigned)vp[5 * (DIL_VSTR / 2)] << 16);
                w.w = (unsigned)vp[6 * (DIL_VSTR / 2)] | ((unsigned)vp[7 * (DIL_VSTR / 2)] << 16);
                o[dt] = __builtin_amdgcn_mfma_f32_32x32x16_bf16(__builtin_bit_cast(bf16x8, w), pf[s2], o[dt], 0, 0, 0);
            }
        LDS_WAIT();
    }
#undef DIL_LOAD_V
#undef DIL_LOAD_K
    const float inv = 1.f / l_run;
    float* po = PART + ((size_t)p * M + rowq) * SWA_W + h * 128;
#pragma unroll
    for (int dt = 0; dt < 4; ++dt)
#pragma unroll
        for (int g = 0; g < 4; ++g)
            *(f32x4*)(po + 32 * dt + 8 * g + 4 * hh) = (f32x4){o[dt][4 * g + 0] * inv, o[dt][4 * g + 1] * inv, o[dt][4 * g + 2] * inv, o[dt][4 * g + 3] * inv};
    if (hh == 0) LSE[((size_t)p * M + rowq) * 6 + h] = m_run + __logf(l_run);
}

DEV void sb_item(int b, int h, int t, const bf16* __restrict__ Z, float* __restrict__ YC, LAS float* qs, LAS float* pA, int lane) {
    const size_t row = (size_t)b * SEQ + t;
    { const unsigned w = *(const unsigned*)(Z + row * IN_W + ZO_QC + h * 128 + 2 * lane); qs[2 * lane] = bf_lo(w) * QSCALE; qs[2 * lane + 1] = bf_hi(w) * QSCALE; }
    LDS_WAIT();
    float carry = 0.f, a0 = 0.f, a1 = 0.f;
    for (int shi = t - 1; shi >= 0; shi -= 64) {
        const int s = shi - lane; const bool valid = s >= 0;
        float z = 0.f;
        if (valid) {
            const v4u* kr = (const v4u*)(Z + ((size_t)b * SEQ + s) * IN_W + ZO_KC + h * 128);
#pragma unroll 4
            for (int c8 = 0; c8 < 16; ++c8) { const v4u kv = kr[c8]; const LAS float* q = qs + c8 * 8;
                z += q[0] * bf_lo(kv.x) + q[1] * bf_hi(kv.x) + q[2] * bf_lo(kv.y) + q[3] * bf_hi(kv.y) + q[4] * bf_lo(kv.z) + q[5] * bf_hi(kv.z) + q[6] * bf_lo(kv.w) + q[7] * bf_hi(kv.w); }
        }
        const float l1m = valid ? -softplus_f(z) : 0.f;
        float inc = l1m;
#pragma unroll
        for (int o = 1; o < 64; o <<= 1) { const float tmp = __shfl_up(inc, o); if (lane >= o) inc += tmp; }
        const float A = valid ? __expf(-softplus_f(-z) + carry + (inc - l1m)) : 0.f;
        carry += __shfl(inc, 63);
        pA[lane] = A;
        const bool done = carry < -105.0f;
        LDS_WAIT();
        const int nk = (shi + 1) < 64 ? (shi + 1) : 64;
        const bf16* vb = Z + ((size_t)b * SEQ + shi) * IN_W + ZO_VC + h * 128 + 2 * lane;
#pragma unroll 4
        for (int i = 0; i < nk; ++i) {
            const float pv = pA[i];
            const unsigned w = *(const unsigned*)(vb - (size_t)i * IN_W);
            a0 += pv * bf_lo(w); a1 += pv * bf_hi(w);
        }
        LDS_WAIT();
        if (done) break;
    }
    *(f32x2*)(YC + row * SB_W + h * 128 + 2 * lane) = (f32x2){a0, a1};
}


DEV void lru_item2(int l, int b, int j, int n, const bf16* __restrict__ Z, const float* __restrict__ conv_w, const float* __restrict__ conv_b, const bf16* __restrict__ WGT,
                   const float* __restrict__ b_rec, const float* __restrict__ b_gi, const float* __restrict__ lam,
                   float* __restrict__ HLOC, float* __restrict__ PP, float* __restrict__ SUMA, float* __restrict__ SUMB, LAS float* xc, LAS float* g0L, LAS float* g1L, int tid) {
    const int ch = tid & 127, tq = tid >> 7, c = n * 128 + ch;
    {
        const float cw0 = conv_w[(l * 4 + 0) * LRU_W + c], cw1 = conv_w[(l * 4 + 1) * LRU_W + c], cw2 = conv_w[(l * 4 + 2) * LRU_W + c], cw3 = conv_w[(l * 4 + 3) * LRU_W + c];
        const float cb = conv_b[l * LRU_W + c];
#pragma unroll 4
        for (int i = 0; i < 16; ++i) {
            const int tok = tq + 4 * i, t = j * 64 + tok;
            const bf16* zp = Z + ((size_t)b * SEQ + t) * IN_W + ZO_XA + c;
            float s = cb + cw3 * bf1(zp[0]);
            if (t >= 1) s += cw2 * bf1(zp[-(ptrdiff_t)IN_W]);
            if (t >= 2) s += cw1 * bf1(zp[-(ptrdiff_t)2 * IN_W]);
            if (t >= 3) s += cw0 * bf1(zp[-(ptrdiff_t)3 * IN_W]);
            xc[tok * 132 + ch] = s;
        }
    }
    __syncthreads();
    {
        const int lane = tid & 63, wave = tid >> 6, r = lane & 31, hh = lane >> 5, g = wave >> 2, ct = wave & 3;
        const bf16* wp = WGT + (((size_t)(l * 6 + n) * 2 + g) * 128 + ct * 32 + r) * 128 + 8 * hh;
        bf16x8 bfr[8];
#pragma unroll
        for (int ks = 0; ks < 8; ++ks) bfr[ks] = *(const bf16x8*)(wp + 16 * ks);
        LAS float* gL = g ? g1L : g0L;
#pragma unroll
        for (int rt = 0; rt < 2; ++rt) {
            f32x16 acc;
#pragma unroll
            for (int e = 0; e < 16; ++e) acc[e] = 0.f;
#pragma unroll
            for (int ks = 0; ks < 8; ++ks) {
                const LAS float* xp = xc + (32 * rt + r) * 132 + 16 * ks + 8 * hh;
                const f32x4 x0 = *(const LAS f32x4*)xp, x1 = *(const LAS f32x4*)(xp + 4);
                v4u w; w.x = cvtpk_bf16(x0.x, x0.y); w.y = cvtpk_bf16(x0.z, x0.w); w.z = cvtpk_bf16(x1.x, x1.y); w.w = cvtpk_bf16(x1.z, x1.w);
                acc = __builtin_amdgcn_mfma_f32_32x32x16_bf16(__builtin_bit_cast(bf16x8, w), bfr[ks], acc, 0, 0, 0);
            }
#pragma unroll
            for (int e = 0; e < 16; ++e) { const int tok = 32 * rt + (e & 3) + 8 * (e >> 2) + 4 * hh; gL[tok * 132 + ct * 32 + r] = acc[e]; }
        }
    }
    __syncthreads();
    {
        const float br = b_rec[l * LRU_W + c], bi = b_gi[l * LRU_W + c], sp = softplus_f(-lam[l * LRU_W + c]);
#pragma unroll 4
        for (int i = 0; i < 16; ++i) {
            const int tok = tq + 4 * i;
            const float rg = sigmoid_f(g0L[tok * 132 + ch] + br), ig = sigmoid_f(g1L[tok * 132 + ch] + bi);
            const float log_a = -8.0f * rg * sp;
            const float av = __expf(log_a);
            const float x = xc[tok * 132 + ch];
            const float uv = sqrtf(fmaxf(-expm1f(2.f * log_a), 0.f)) * (ig * x);
            g0L[tok * 132 + ch] = av; g1L[tok * 132 + ch] = uv;
        }
    }
    __syncthreads();
    if (tid < 128) {
        float h = 0.f, P = 1.f;
        const size_t rb = ((size_t)b * SEQ + j * 64) * LRU_W + n * 128 + tid;
#pragma unroll 8
        for (int tok = 0; tok < 64; ++tok) {
            const float av = g0L[tok * 132 + tid];
            h = av * h + g1L[tok * 132 + tid]; P *= av;
            HLOC[rb + (size_t)tok * LRU_W] = h; PP[rb + (size_t)tok * LRU_W] = P;
        }
        SUMA[(size_t)(b * 64 + j) * LRU_W + n * 128 + tid] = P; SUMB[(size_t)(b * 64 + j) * LRU_W + n * 128 + tid] = h;
    }
    __syncthreads();
}

DEV void sb_mfma_item(int b, int h, int t0, const bf16* __restrict__ Z, float* __restrict__ YC, LAS unsigned char* wl, int lane) {
    asm volatile("" : "+v"(lane));
    const int r = lane & 31, hh = lane >> 5;
    const size_t rowq = (size_t)b * SEQ + t0 + r;
    LAS bf16x8* qL = (LAS bf16x8*)(wl + DIL_QOFF) + lane;
    { const bf16* qrow = Z + rowq * IN_W + ZO_QC + h * 128 + 8 * hh;
#pragma unroll
      for (int ks = 0; ks < 8; ++ks) qL[64 * ks] = *(const bf16x8*)(qrow + 16 * ks); }
    f32x16 o[4];
#pragma unroll
    for (int dt = 0; dt < 4; ++dt)
#pragma unroll
        for (int e = 0; e < 16; ++e) o[dt][e] = 0.f;
    const int kap = (r & 0x13) | ((r & 4) << 1) | ((r & 8) >> 1);
    float carry = 0.f;
    bf16x8 kf[8];
#define SB_LOAD_V(K0) do { _Pragma("unroll") for (int q = 0; q < 8; ++q) { const int pi = lane + 64 * q, kl = pi >> 4, c = pi & 15; \
        vr[q] = *(const v4u*)(Z + ((size_t)b * SEQ + (K0) + kl) * IN_W + ZO_VC + h * 128 + 8 * c); } } while (0)
#define SB_LOAD_K(K0) do { const bf16* krow = Z + ((size_t)b * SEQ + (K0) + kap) * IN_W + ZO_KC + h * 128 + 8 * hh; \
        _Pragma("unroll") for (int ks = 0; ks < 8; ++ks) kf[ks] = *(const bf16x8*)(krow + 16 * ks); } while (0)
    SB_LOAD_K(t0);
    for (int k0 = t0; k0 >= 0; k0 -= 32) {
        const int kn = k0 >= 32 ? k0 - 32 : 0;
#pragma unroll
        for (int hf = 0; hf < 2; ++hf) {
            v4u vr[4];
#pragma unroll
            for (int q = 0; q < 4; ++q) { const int pi = lane + 64 * (4 * hf + q), kl = pi >> 4, c = pi & 15;
                vr[q] = *(const v4u*)(Z + ((size_t)b * SEQ + k0 + kl) * IN_W + ZO_VC + h * 128 + 8 * c); }
#pragma unroll
            for (int q = 0; q < 4; ++q) { const int pi = lane + 64 * (4 * hf + q), kl = pi >> 4, c = pi & 15; *(LAS v4u*)(wl + kl * DIL_VSTR + c * 16) = vr[q]; }
        }
        f32x16 sacc;
#pragma unroll
        for (int e = 0; e < 16; ++e) sacc[e] = 0.f;
#pragma unroll
        for (int ks = 0; ks < 8; ++ks) sacc = __builtin_amdgcn_mfma_f32_32x32x16_bf16(kf[ks], qL[64 * ks], sacc, 0, 0, 0);
        SB_LOAD_K(kn);
        float l1[16]; float T0 = 0.f, T1 = 0.f;
#pragma unroll
        for (int e = 0; e < 16; ++e) {
            const int key = k0 + 16 * (e >> 3) + 8 * hh + (e & 7);
            const bool valid = key < t0 + r;
            const float z = sacc[e] * QSCALE;
            sacc[e] = z;
            l1[e] = valid ? -softplus_f(z) : 0.f;
        }
#pragma unroll
        for (int e = 0; e < 8; ++e) { T0 += l1[e]; T1 += l1[8 + e]; }
        const float PT0 = partner32(T0, hh), PT1 = partner32(T1, hh);
        const float base1 = carry + (hh ? 0.f : PT1);
        const float base0 = carry + (hh ? (T1 + PT1) : (PT1 + T1 + PT0));
        float run1 = base1, run0 = base0;
#pragma unroll
        for (int e = 7; e >= 0; --e) {
            { const int key = k0 + 16 + 8 * hh + e; const bool valid = key < t0 + r; const float a = valid ? __expf(sacc[8 + e] + l1[8 + e] + run1) : 0.f; run1 += l1[8 + e]; sacc[8 + e] = a; }
            { const int key = k0 + 8 * hh + e; const bool valid = key < t0 + r; const float a = valid ? __expf(sacc[e] + l1[e] + run0) : 0.f; run0 += l1[e]; sacc[e] = a; }
        }
        carry += (T0 + T1) + (PT0 + PT1);
        bf16x8 pf[2];
#pragma unroll
        for (int s2 = 0; s2 < 2; ++s2) { v4u w; w.x = cvtpk_bf16(sacc[8 * s2 + 0], sacc[8 * s2 + 1]); w.y = cvtpk_bf16(sacc[8 * s2 + 2], sacc[8 * s2 + 3]);
            w.z = cvtpk_bf16(sacc[8 * s2 + 4], sacc[8 * s2 + 5]); w.w = cvtpk_bf16(sacc[8 * s2 + 6], sacc[8 * s2 + 7]); pf[s2] = __builtin_bit_cast(bf16x8, w); }
        LDS_WAIT();
#pragma unroll
        for (int dt = 0; dt < 4; ++dt)
#pragma unroll
            for (int s2 = 0; s2 < 2; ++s2) {
                const LAS unsigned short* vp = (const LAS unsigned short*)(wl + (16 * s2 + 8 * hh) * DIL_VSTR + (32 * dt + r) * 2);
                v4u w;
                w.x = (unsigned)vp[0 * (DIL_VSTR / 2)] | ((unsigned)vp[1 * (DIL_VSTR / 2)] << 16);
                w.y = (unsigned)vp[2 * (DIL_VSTR / 2)] | ((unsigned)vp[3 * (DIL_VSTR / 2)] << 16);
                w.z = (unsigned)vp[4 * (DIL_VSTR / 2)] | ((unsigned)vp[5 * (DIL_VSTR / 2)] << 16);
                w.w = (unsigned)vp[6 * (DIL_VSTR / 2)] | ((unsigned)vp[7 * (DIL_VSTR / 2)] << 16);
                o[dt] = __builtin_amdgcn_mfma_f32_32x32x16_bf16(__builtin_bit_cast(bf16x8, w), pf[s2], o[dt], 0, 0, 0);
            }
        LDS_WAIT();
        if (__all(carry < -105.0f)) break;
    }
#undef SB_LOAD_V
#undef SB_LOAD_K
    float* po = YC + rowq * SB_W + h * 128;
#pragma unroll
    for (int dt = 0; dt < 4; ++dt)
#pragma unroll
        for (int g = 0; g < 4; ++g)
            *(f32x4*)(po + 32 * dt + 8 * g + 4 * hh) = (f32x4){o[dt][4 * g + 0], o[dt][4 * g + 1], o[dt][4 * g + 2], o[dt][4 * g + 3]};
}

DEV void combine_item(int l, int b, int j, int half, const bf16* __restrict__ Z, const float* __restrict__ HLOC, const float* __restrict__ PP, const float* __restrict__ SUMA, const float* __restrict__ SUMB,
                      const float* __restrict__ PART, const float* __restrict__ LSE, const float* __restrict__ YC, const float* __restrict__ g_lru, const float* __restrict__ g_swa, const float* __restrict__ g_sb,
                      bf16* __restrict__ Y, LAS float* carryL, int tid) {
    const int lane = tid & 63, wave = tid >> 6;
    for (int c = tid; c < LRU_W; c += 512) {
        float cr = 0.f;
        for (int i = 0; i < j; ++i) cr = SUMA[(size_t)(b * 64 + i) * LRU_W + c] * cr + SUMB[(size_t)(b * 64 + i) * LRU_W + c];
        carryL[c] = cr;
    }
    __syncthreads();
    for (int i = 0; i < 4; ++i) {
        const int tok = half * 32 + wave * 4 + i;
        const size_t row = (size_t)b * SEQ + j * 64 + tok;
        bf16* yo = Y + row * D;
        {
            float ya[12]; float ssq = 0.f;
#pragma unroll
            for (int e = 0; e < 12; ++e) { const int c = lane + 64 * e;
                const float hv = HLOC[row * LRU_W + c] + PP[row * LRU_W + c] * carryL[c];
                const float ga = bf1(Z[row * IN_W + ZO_GA + c]);
                ya[e] = hv * gelu_tanh(ga); ssq += ya[e] * ya[e]; }
            const float r = rsqrtf(wave_sum(ssq) * (1.f / LRU_W) + EPS);
#pragma unroll
            for (int e = 0; e < 12; ++e) { const int c = lane + 64 * e; yo[c] = (MK_DBG & 16) ? (bf16)0 : (bf16)f2bf(ya[e] * r * g_lru[l * LRU_W + c]); }
        }
        {
            float yb[12]; float ssq = 0.f;
            float wgt[3][2];
            (void)wgt;
#pragma unroll
            for (int e = 0; e < 12; ++e) { const int c = lane + 64 * e; const int hd = c >> 7;
                const float l0 = LSE[((size_t)0 * M + row) * 6 + hd], l1 = LSE[((size_t)1 * M + row) * 6 + hd], l2 = LSE[((size_t)2 * M + row) * 6 + hd];
                const float mx = fmaxf(l0, fmaxf(l1, l2)); const float e0 = __expf(l0 - mx), e1 = __expf(l1 - mx), e2 = __expf(l2 - mx); const float iz = 1.f / (e0 + e1 + e2);
                yb[e] = (e0 * PART[((size_t)0 * M + row) * SWA_W + c] + e1 * PART[((size_t)1 * M + row) * SWA_W + c] + e2 * PART[((size_t)2 * M + row) * SWA_W + c]) * iz;
                ssq += yb[e] * yb[e]; }
            const float r = rsqrtf(wave_sum(ssq) * (1.f / SWA_W) + EPS);
#pragma unroll
            for (int e = 0; e < 12; ++e) { const int c = lane + 64 * e; yo[LRU_W + c] = (MK_DBG & 32) ? (bf16)0 : (bf16)f2bf(yb[e] * r * g_swa[l * SWA_W + c]); }
        }
        {
            float yc[8]; float ssq = 0.f;
#pragma unroll
            for (int e = 0; e < 8; ++e) { const int c = lane + 64 * e; yc[e] = YC[row * SB_W + c]; ssq += yc[e] * yc[e]; }
            const float r = rsqrtf(wave_sum(ssq) * (1.f / SB_W) + EPS);
#pragma unroll
            for (int e = 0; e < 8; ++e) { const int c = lane + 64 * e; yo[LRU_W + SWA_W + c] = (MK_DBG & 64) ? (bf16)0 : (bf16)f2bf(yc[e] * r * g_sb[l * SB_W + c]); }
        }
    }
    __syncthreads();
}

constexpr int RT_SK = 0, RT_Q = 128 * 129 * 4, RT_SC = RT_Q + 32 * 128 * 4, RT_TV = RT_SC + 64 * 129 * 4, RT_TI = RT_TV + 64 * 16 * 4, RT_END = RT_TI + 64 * 16 * 4;
static_assert(RT_END <= LDS_MISC, "routing LDS");
DEV void route_item(int l, int tile, int h, const bf16* __restrict__ Q, const bf16* __restrict__ SK, int* __restrict__ IDS, float* __restrict__ GG, LAS unsigned char* lds, int tid, unsigned* DBGW = nullptr) {
    LAS float* skL = (LAS float*)(lds + RT_SK); LAS float* qL = (LAS float*)(lds + RT_Q); LAS float* sc = (LAS float*)(lds + RT_SC);
    LAS float* topv = (LAS float*)(lds + RT_TV); LAS int* topi = (LAS int*)(lds + RT_TI);
    const int lane = tid & 63, wave = tid >> 6, row0 = tile * 32;
    for (int c = 0; c < 2; ++c) {
        const bf16* skp = SK + ((size_t)((l * 8 + h) * 2 + c)) * 128 * 128;
#pragma unroll 4
        for (int i = 0; i < 16; ++i) { const int idx2 = tid + 512 * i; const int k = idx2 >> 6, d2 = idx2 & 63; const unsigned w = *(const unsigned*)(skp + k * 128 + 2 * d2); skL[k * 129 + 2 * d2] = bf_lo(w); skL[k * 129 + 2 * d2 + 1] = bf_hi(w); }
#pragma unroll
        for (int i = 0; i < 4; ++i) { const int idx2 = tid + 512 * i; const int tok = idx2 >> 6, d2 = idx2 & 63; const unsigned w = *(const unsigned*)(Q + (size_t)(row0 + tok) * D + h * 256 + c * 128 + 2 * d2); qL[tok * 128 + 2 * d2] = bf_lo(w); qL[tok * 128 + 2 * d2 + 1] = bf_hi(w); }
        __syncthreads();
        {
            const int k = tid & 127, tg = tid >> 7;
            float acc[8];
#pragma unroll
            for (int i = 0; i < 8; ++i) acc[i] = 0.f;
#pragma unroll 4
            for (int d = 0; d < 128; ++d) { const float s = skL[k * 129 + d];
#pragma unroll
                for (int i = 0; i < 8; ++i) acc[i] += s * qL[(tg * 8 + i) * 128 + d]; }
#pragma unroll
            for (int i = 0; i < 8; ++i) sc[(c * 32 + tg * 8 + i) * 129 + k] = acc[i];
        }
        __syncthreads();
    }
    for (int q = 0; q < 8; ++q) {
        const int L = wave * 8 + q;
        float v0 = sc[L * 129 + lane], v1 = sc[L * 129 + 64 + lane];
        for (int r = 0; r < 16; ++r) {
            const float m = wave_max(fmaxf(v0, v1));
            const unsigned long long b0 = __ballot(v0 == m);
            int idx;
            if (b0) { const int ln = __ffsll((long long)b0) - 1; idx = ln; if (lane == ln) v0 = NEGBIG; }
            else { const unsigned long long b1 = __ballot(v1 == m); const int ln = __ffsll((long long)b1) - 1; idx = 64 + ln; if (lane == ln) v1 = NEGBIG; }
            if (lane == 0) { topv[L * 16 + r] = m; topi[L * 16 + r] = idx; }
        }
    }
    __syncthreads();
#if MK_CHECK == 16
    { for (int q = 0; q < 8; ++q) { const int L = wave * 8 + q; const int mi = topi[L * 16 + (lane & 15)]; int dup = 0;
          for (int e = 0; e < 16; ++e) { const int oi = __shfl(mi, e); if (lane < 16 && e != lane && oi == mi) dup = 1; }
          if (dup) atomicAdd((unsigned*)DBGW, 1u); } }
#endif
    for (int q = 0; q < 4; ++q) {
        const int tok = wave * 4 + q;
        float cv[4];
#pragma unroll
        for (int e = 0; e < 4; ++e) cv[e] = topv[tok * 16 + (lane >> 2)] + topv[(32 + tok) * 16 + (lane & 3) * 4 + e];
        float mysc = NEGBIG; int myid = 0;
        for (int r = 0; r < 16; ++r) {
            const float lm = fmaxf(fmaxf(cv[0], cv[1]), fmaxf(cv[2], cv[3]));
            const float m = wave_max(lm);
            const unsigned long long bb = __ballot(lm == m);
            const int ln = __ffsll((long long)bb) - 1;
            const int se = (cv[0] == m) ? 0 : (cv[1] == m) ? 1 : (cv[2] == m) ? 2 : 3;
            const int sel = __shfl(se, ln);
            { const bool me = (lane == ln);
              cv[0] = (me && sel == 0) ? NEGBIG : cv[0]; cv[1] = (me && sel == 1) ? NEGBIG : cv[1];
              cv[2] = (me && sel == 2) ? NEGBIG : cv[2]; cv[3] = (me && sel == 3) ? NEGBIG : cv[3]; }
            const int ci = ln * 4 + sel;
            const int id = topi[tok * 16 + (ci >> 4)] * 128 + topi[(32 + tok) * 16 + (ci & 15)];
            if (lane == r) { mysc = m; myid = id; }
        }
#if MK_CHECK == 16
        { int dup = 0; for (int e = 0; e < 16; ++e) { const int oi = __shfl(myid, e); if (lane < 16 && e != lane && oi == myid) dup = 1; } if (dup) atomicAdd((unsigned*)DBGW + 1, 1u); }
#endif
        const float s0 = __shfl(mysc, 0);
        const float ev = (lane < 16) ? __expf(mysc - s0) : 0.f;
        const float sum = wave_sum(ev);
        if (lane < 16) { IDS[(size_t)(row0 + tok) * 128 + h * 16 + lane] = myid; GG[(size_t)(row0 + tok) * 128 + h * 16 + lane] = ev / sum; }
    }
    __syncthreads();
}


constexpr int R2_SC = 0, R2_TV = 128 * 129 * 4, R2_TI = R2_TV + 128 * 16 * 4, R2_END = R2_TI + 128 * 16 * 4;
static_assert(R2_END <= LDS_MISC, "routing v2 LDS");
DEV unsigned ord_key(float s) { const unsigned u = __builtin_bit_cast(unsigned, s); return (u & 0x80000000u) ? ~u : (u | 0x80000000u); }
DEV void route_item2(int l, int tile, int h, const bf16* __restrict__ Q, const bf16* __restrict__ SK, int* __restrict__ IDS, float* __restrict__ GG, LAS unsigned char* lds, int tid) {
    LAS float* sc = (LAS float*)(lds + R2_SC); LAS float* tv = (LAS float*)(lds + R2_TV); LAS int* ti = (LAS int*)(lds + R2_TI);
    const int lane = tid & 63, wave = tid >> 6, row0 = tile * 64;
    {
        const int r = lane & 31, hh = lane >> 5, c = wave >> 2, key0 = 32 * (wave & 3);
        const bf16* skp = SK + ((size_t)(((l * 8 + h) * 2 + c) * 128 + key0 + r)) * 128 + 8 * hh;
        bf16x8 bfr[8];
#pragma unroll
        for (int ks = 0; ks < 8; ++ks) bfr[ks] = *(const bf16x8*)(skp + 16 * ks);
#pragma unroll
        for (int rt = 0; rt < 2; ++rt) {
            const bf16* qp = Q + (size_t)(row0 + 32 * rt + r) * D + h * 256 + c * 128 + 8 * hh;
            bf16x8 afr[8];
#pragma unroll
            for (int ks = 0; ks < 8; ++ks) afr[ks] = *(const bf16x8*)(qp + 16 * ks);
            f32x16 acc;
#pragma unroll
            for (int e = 0; e < 16; ++e) acc[e] = 0.f;
#pragma unroll
            for (int ks = 0; ks < 8; ++ks) acc = __builtin_amdgcn_mfma_f32_32x32x16_bf16(afr[ks], bfr[ks], acc, 0, 0, 0);
#pragma unroll
            for (int e = 0; e < 16; ++e) { const int tok = 32 * rt + (e & 3) + 8 * (e >> 2) + 4 * hh; sc[(c * 64 + tok) * 129 + key0 + r] = acc[e]; }
        }
    }
    __syncthreads();
    if (tid < 128) {
        const int L = tid;
        unsigned t[16];
#pragma unroll
        for (int q = 0; q < 16; ++q) t[q] = 0u;
#pragma unroll 4
        for (int k = 0; k < 128; ++k) {
            unsigned key = (ord_key(sc[L * 129 + k]) & ~127u) | (unsigned)(127 - k);
#pragma unroll
            for (int q = 0; q < 16; ++q) { const unsigned hi = t[q] > key ? t[q] : key; key = t[q] > key ? key : t[q]; t[q] = hi; }
        }
#pragma unroll
        for (int q = 0; q < 16; ++q) { const int idx = 127 - (int)(t[q] & 127u); tv[L * 16 + q] = sc[L * 129 + idx]; ti[L * 16 + q] = idx; }
    }
    __syncthreads();
    if (tid < 64) {
        const int tok = tid;
        float a[16], bq[16];
#pragma unroll
        for (int i = 0; i < 16; ++i) { a[i] = tv[tok * 16 + i]; bq[i] = tv[(64 + tok) * 16 + i]; }
        unsigned t[16];
#pragma unroll
        for (int q = 0; q < 16; ++q) t[q] = 0u;
#pragma unroll
        for (int i = 0; i < 16; ++i)
#pragma unroll
            for (int j = 0; j < 16 / (i + 1); ++j) {
                unsigned key = (ord_key(a[i] + bq[j]) & ~255u) | (unsigned)(255 - (i * 16 + j));
#pragma unroll
                for (int q = 0; q < 16; ++q) { const unsigned hi = t[q] > key ? t[q] : key; key = t[q] > key ? key : t[q]; t[q] = hi; }
            }
        float scv[16]; int idv[16]; float mx = NEGBIG;
#pragma unroll
        for (int q = 0; q < 16; ++q) { const int ci = 255 - (int)(t[q] & 255u); const int i = ci >> 4, j = ci & 15;
            scv[q] = tv[tok * 16 + i] + tv[(64 + tok) * 16 + j]; idv[q] = ti[tok * 16 + i] * 128 + ti[(64 + tok) * 16 + j]; mx = fmaxf(mx, scv[q]); }
        float sum = 0.f;
#pragma unroll
        for (int q = 0; q < 16; ++q) { scv[q] = __expf(scv[q] - mx); sum += scv[q]; }
        const float inv = 1.f / sum;
        int* ip = IDS + (size_t)(row0 + tok) * 128 + h * 16; float* gp = GG + (size_t)(row0 + tok) * 128 + h * 16;
#pragma unroll
        for (int q4 = 0; q4 < 4; ++q4) {
            *(int4*)(ip + 4 * q4) = make_int4(idv[4 * q4], idv[4 * q4 + 1], idv[4 * q4 + 2], idv[4 * q4 + 3]);
            *(f32x4*)(gp + 4 * q4) = (f32x4){scv[4 * q4] * inv, scv[4 * q4 + 1] * inv, scv[4 * q4 + 2] * inv, scv[4 * q4 + 3] * inv};
        }
    }
    __syncthreads();
}

DEV void expert_row(int l, int row, const bf16* __restrict__ H, const int* __restrict__ IDS, const float* __restrict__ GG, const bf16* __restrict__ U, const bf16* __restrict__ V,
                    const float* __restrict__ X1, const float* __restrict__ g2, const float* __restrict__ fnorm, float* __restrict__ XO, int lane, float pscale, float* STATP = nullptr) {
    v4u xv[4];
#pragma unroll
    for (int j = 0; j < 4; ++j) xv[j] = *(const v4u*)(H + (size_t)row * D + lane * 8 + 512 * j);
    const int id0 = IDS[(size_t)row * 128 + lane], id1 = IDS[(size_t)row * 128 + 64 + lane];
    const float gg0 = GG[(size_t)row * 128 + lane], gg1 = GG[(size_t)row * 128 + 64 + lane];
    float y[32];
#pragma unroll
    for (int i = 0; i < 32; ++i) y[i] = 0.f;
    const bf16* Ul = U + (size_t)l * NEXP * D + lane * 8;
    const bf16* Vl = V + (size_t)l * NEXP * D + lane * 8;
    for (int e0 = 0; e0 < 128; e0 += 2) {
        int id[2]; float gq[2];
#pragma unroll
        for (int q = 0; q < 2; ++q) { const int e = e0 + q;
            id[q] = (e < 64) ? __builtin_amdgcn_readlane(id0, e & 63) : __builtin_amdgcn_readlane(id1, e & 63);
            gq[q] = (e < 64) ? __builtin_bit_cast(float, __builtin_amdgcn_readlane(__builtin_bit_cast(int, gg0), e & 63)) : __builtin_bit_cast(float, __builtin_amdgcn_readlane(__builtin_bit_cast(int, gg1), e & 63)); }
        v4u uu[2][4], vv[2][4];
#pragma unroll
        for (int q = 0; q < 2; ++q)
#pragma unroll
            for (int j = 0; j < 4; ++j) uu[q][j] = *(const v4u*)(Ul + (size_t)id[q] * D + 512 * j);
#pragma unroll
        for (int q = 0; q < 2; ++q)
#pragma unroll
            for (int j = 0; j < 4; ++j) vv[q][j] = *(const v4u*)(Vl + (size_t)id[q] * D + 512 * j);
#pragma unroll
        for (int q = 0; q < 2; ++q) {
            float dsum = 0.f;
#pragma unroll
            for (int j = 0; j < 4; ++j) dsum += dot8(xv[j], uu[q][j]);
            dsum = wave_sum(dsum);
            const float w = gq[q] * gelu_tanh(dsum);
#if MK_CHECK == 7
            if (lane == 0 && l == 0) atomicAdd(STATP, gelu_tanh(dsum) * gelu_tanh(dsum) * 2048.f / 128.f);
#elif MK_CHECK == 8
            if (lane == 0 && l == 0) atomicAdd(STATP, gq[q] * gq[q] * 2048.f * 16.f / 128.f);
#elif MK_CHECK == 9
            if (lane == 0 && l == 0) atomicAdd(STATP, dsum * dsum * 2048.f / 128.f);
#elif MK_CHECK == 11
            if (lane == 0 && l == 0) atomicAdd(STATP, w * w * 2048.f);
#endif
#pragma unroll
            for (int j = 0; j < 4; ++j) {
                y[j * 8 + 0] += w * bf_lo(vv[q][j].x); y[j * 8 + 1] += w * bf_hi(vv[q][j].x);
                y[j * 8 + 2] += w * bf_lo(vv[q][j].y); y[j * 8 + 3] += w * bf_hi(vv[q][j].y);
                y[j * 8 + 4] += w * bf_lo(vv[q][j].z); y[j * 8 + 5] += w * bf_hi(vv[q][j].z);
                y[j * 8 + 6] += w * bf_lo(vv[q][j].w); y[j * 8 + 7] += w * bf_hi(vv[q][j].w);
            }
        }
    }
#if MK_CHECK == 6
    { float q2 = 0.f;
#pragma unroll
      for (int i = 0; i < 32; ++i) q2 += y[i] * y[i];
      q2 = wave_sum(q2); if (lane == 0 && l == 0) atomicAdd(STATP, q2); }
#endif
    float ssq = 0.f;
#pragma unroll
    for (int j = 0; j < 4; ++j) {
        const int col = lane * 8 + 512 * j;
        const f32x4 xa = *(const f32x4*)(X1 + (size_t)row * D + col), xb = *(const f32x4*)(X1 + (size_t)row * D + col + 4);
        const f32x4 ga = *(const f32x4*)(g2 + col) * pscale, gb = *(const f32x4*)(g2 + col + 4) * pscale;
        y[j * 8 + 0] = xa.x + ga.x * y[j * 8 + 0]; y[j * 8 + 1] = xa.y + ga.y * y[j * 8 + 1]; y[j * 8 + 2] = xa.z + ga.z * y[j * 8 + 2]; y[j * 8 + 3] = xa.w + ga.w * y[j * 8 + 3];
        y[j * 8 + 4] = xb.x + gb.x * y[j * 8 + 4]; y[j * 8 + 5] = xb.y + gb.y * y[j * 8 + 5]; y[j * 8 + 6] = xb.z + gb.z * y[j * 8 + 6]; y[j * 8 + 7] = xb.w + gb.w * y[j * 8 + 7];
#pragma unroll
        for (int e = 0; e < 8; ++e) ssq += y[j * 8 + e] * y[j * 8 + e];
    }
    if (fnorm) {
        const float r = rsqrtf(wave_sum(ssq) * (1.f / D) + EPS);
#pragma unroll
        for (int j = 0; j < 4; ++j) { const int col = lane * 8 + 512 * j;
            const f32x4 fa = *(const f32x4*)(fnorm + col), fb = *(const f32x4*)(fnorm + col + 4);
            *(f32x4*)(XO + (size_t)row * D + col) = (f32x4){y[j * 8 + 0] * r * fa.x, y[j * 8 + 1] * r * fa.y, y[j * 8 + 2] * r * fa.z, y[j * 8 + 3] * r * fa.w};
            *(f32x4*)(XO + (size_t)row * D + col + 4) = (f32x4){y[j * 8 + 4] * r * fb.x, y[j * 8 + 5] * r * fb.y, y[j * 8 + 6] * r * fb.z, y[j * 8 + 7] * r * fb.w}; }
    } else {
#pragma unroll
        for (int j = 0; j < 4; ++j) { const int col = lane * 8 + 512 * j;
            *(f32x4*)(XO + (size_t)row * D + col) = (f32x4){y[j * 8 + 0], y[j * 8 + 1], y[j * 8 + 2], y[j * 8 + 3]};
            *(f32x4*)(XO + (size_t)row * D + col + 4) = (f32x4){y[j * 8 + 4], y[j * 8 + 5], y[j * 8 + 6], y[j * 8 + 7]}; }
    }
}


constexpr float U8_SCALE = 64.f;
DEV void expert_row8(int l, int row, const bf16* __restrict__ H, const int* __restrict__ IDS, const float* __restrict__ GG, const unsigned char* __restrict__ U8, const unsigned char* __restrict__ V8,
                     const float* __restrict__ X1, const float* __restrict__ g2, const float* __restrict__ fnorm, float* __restrict__ XO, int lane, float pscale) {
    f32x2 x[16];
#pragma unroll
    for (int j = 0; j < 2; ++j) {
        const v4u a = *(const v4u*)(H + (size_t)row * D + lane * 16 + 1024 * j), c = *(const v4u*)(H + (size_t)row * D + lane * 16 + 1024 * j + 8);
        x[j * 8 + 0] = (f32x2){bf_lo(a.x), bf_hi(a.x)}; x[j * 8 + 1] = (f32x2){bf_lo(a.y), bf_hi(a.y)}; x[j * 8 + 2] = (f32x2){bf_lo(a.z), bf_hi(a.z)}; x[j * 8 + 3] = (f32x2){bf_lo(a.w), bf_hi(a.w)};
        x[j * 8 + 4] = (f32x2){bf_lo(c.x), bf_hi(c.x)}; x[j * 8 + 5] = (f32x2){bf_lo(c.y), bf_hi(c.y)}; x[j * 8 + 6] = (f32x2){bf_lo(c.z), bf_hi(c.z)}; x[j * 8 + 7] = (f32x2){bf_lo(c.w), bf_hi(c.w)};
    }
    const int id0 = IDS[(size_t)row * 128 + lane], id1 = IDS[(size_t)row * 128 + 64 + lane];
    const float gg0 = GG[(size_t)row * 128 + lane], gg1 = GG[(size_t)row * 128 + 64 + lane];
    float wv0 = 0.f, wv1 = 0.f;
    const unsigned char* Ul = U8 + (size_t)l * NEXP * D + lane * 16;
    const unsigned char* Vl = V8 + (size_t)l * NEXP * D + lane * 16;
    for (int e0 = 0; e0 < 128; e0 += 8) {
        v4u uu[8][2];
#pragma unroll
        for (int q = 0; q < 8; ++q) { const int e = e0 + q; const int id = (e < 64) ? __builtin_amdgcn_readlane(id0, e & 63) : __builtin_amdgcn_readlane(id1, e & 63);
            uu[q][0] = *(const v4u*)(Ul + (size_t)id * D); uu[q][1] = *(const v4u*)(Ul + (size_t)id * D + 1024); }
        float ds[8];
#pragma unroll
        for (int q = 0; q < 8; ++q) {
            f32x2 acc = {0.f, 0.f};
#pragma unroll
            for (int j = 0; j < 2; ++j) {
                const unsigned wd[4] = {uu[q][j].x, uu[q][j].y, uu[q][j].z, uu[q][j].w};
#pragma unroll
                for (int dw = 0; dw < 4; ++dw) {
                    const f32x2 lo = __builtin_amdgcn_cvt_pk_f32_fp8((int)wd[dw], false), hi = __builtin_amdgcn_cvt_pk_f32_fp8((int)wd[dw], true);
                    acc = __builtin_elementwise_fma(lo, x[j * 8 + 2 * dw], acc); acc = __builtin_elementwise_fma(hi, x[j * 8 + 2 * dw + 1], acc);
                }
            }
            ds[q] = acc.x + acc.y;
        }
#pragma unroll
        for (int q = 0; q < 8; ++q) ds[q] += swz_xor<1>(ds[q]);
#pragma unroll
        for (int q = 0; q < 8; ++q) ds[q] += swz_xor<2>(ds[q]);
#pragma unroll
        for (int q = 0; q < 8; ++q) ds[q] += swz_xor<4>(ds[q]);
#pragma unroll
        for (int q = 0; q < 8; ++q) ds[q] += swz_xor<8>(ds[q]);
#pragma unroll
        for (int q = 0; q < 8; ++q) ds[q] += swz_xor<16>(ds[q]);
#pragma unroll
        for (int q = 0; q < 8; ++q) ds[q] = sum32(ds[q]);
#pragma unroll
        for (int q = 0; q < 8; ++q) { const int e = e0 + q;
            const float gq = (e < 64) ? __builtin_bit_cast(float, __builtin_amdgcn_readlane(__builtin_bit_cast(int, gg0), e & 63)) : __builtin_bit_cast(float, __builtin_amdgcn_readlane(__builtin_bit_cast(int, gg1), e & 63));
            const float w = gq * gelu_tanh(ds[q] * (1.f / U8_SCALE));
            if (e < 64) wv0 = (lane == (e & 63)) ? w : wv0; else wv1 = (lane == (e & 63)) ? w : wv1; }
    }
    f32x2 y[16];
#pragma unroll
    for (int i = 0; i < 16; ++i) y[i] = (f32x2){0.f, 0.f};
    for (int e0 = 0; e0 < 128; e0 += 8) {
        v4u vv[8][2];
#pragma unroll
        for (int q = 0; q < 8; ++q) { const int e = e0 + q; const int id = (e < 64) ? __builtin_amdgcn_readlane(id0, e & 63) : __builtin_amdgcn_readlane(id1, e & 63);
            vv[q][0] = *(const v4u*)(Vl + (size_t)id * D); vv[q][1] = *(const v4u*)(Vl + (size_t)id * D + 1024); }
#pragma unroll
        for (int q = 0; q < 8; ++q) { const int e = e0 + q;
            const float w = (e < 64) ? __builtin_bit_cast(float, __builtin_amdgcn_readlane(__builtin_bit_cast(int, wv0), e & 63)) : __builtin_bit_cast(float, __builtin_amdgcn_readlane(__builtin_bit_cast(int, wv1), e & 63));
            const f32x2 w2 = {w, w};
#pragma unroll
            for (int j = 0; j < 2; ++j) {
                const unsigned wd[4] = {vv[q][j].x, vv[q][j].y, vv[q][j].z, vv[q][j].w};
#pragma unroll
                for (int dw = 0; dw < 4; ++dw) {
                    const f32x2 lo = __builtin_amdgcn_cvt_pk_f32_fp8((int)wd[dw], false), hi = __builtin_amdgcn_cvt_pk_f32_fp8((int)wd[dw], true);
                    y[j * 8 + 2 * dw] = __builtin_elementwise_fma(w2, lo, y[j * 8 + 2 * dw]); y[j * 8 + 2 * dw + 1] = __builtin_elementwise_fma(w2, hi, y[j * 8 + 2 * dw + 1]);
                }
            }
        }
    }
    float ssq = 0.f;
#pragma unroll
    for (int j = 0; j < 2; ++j)
#pragma unroll
        for (int k4 = 0; k4 < 4; ++k4) {
            const int col = lane * 16 + 1024 * j + 4 * k4;
            const f32x4 xa = *(const f32x4*)(X1 + (size_t)row * D + col); const f32x4 ga = *(const f32x4*)(g2 + col) * pscale;
            f32x2& ya = y[j * 8 + 2 * k4]; f32x2& yb = y[j * 8 + 2 * k4 + 1];
            ya.x = xa.x + ga.x * ya.x; ya.y = xa.y + ga.y * ya.y; yb.x = xa.z + ga.z * yb.x; yb.y = xa.w + ga.w * yb.y;
            ssq += (ya.x * ya.x + ya.y * ya.y) + (yb.x * yb.x + yb.y * yb.y);
        }
    float r = 1.f;
    if (fnorm) r = rsqrtf(wave_sum(ssq) * (1.f / D) + EPS);
#pragma unroll
    for (int j = 0; j < 2; ++j)
#pragma unroll
        for (int k4 = 0; k4 < 4; ++k4) {
            const int col = lane * 16 + 1024 * j + 4 * k4;
            const f32x2 ya = y[j * 8 + 2 * k4], yb = y[j * 8 + 2 * k4 + 1];
            f32x4 ov = {ya.x, ya.y, yb.x, yb.y};
            if (fnorm) ov = ov * r * *(const f32x4*)(fnorm + col);
            *(f32x4*)(XO + (size_t)row * D + col) = ov;
        }
}
DEV void convert_fp8(const float* __restrict__ src, unsigned char* __restrict__ dst, size_t ngroups16, size_t gtid, size_t gstride, float scale) {
    for (size_t g = gtid; g < ngroups16; g += gstride) {
        const f32x4 a = *(const f32x4*)(src + g * 16) * scale, b = *(const f32x4*)(src + g * 16 + 4) * scale, c = *(const f32x4*)(src + g * 16 + 8) * scale, d = *(const f32x4*)(src + g * 16 + 12) * scale;
        int w0 = 0, w1 = 0, w2 = 0, w3 = 0;
        w0 = __builtin_amdgcn_cvt_pk_fp8_f32(a.x, a.y, w0, false); w0 = __builtin_amdgcn_cvt_pk_fp8_f32(a.z, a.w, w0, true);
        w1 = __builtin_amdgcn_cvt_pk_fp8_f32(b.x, b.y, w1, false); w1 = __builtin_amdgcn_cvt_pk_fp8_f32(b.z, b.w, w1, true);
        w2 = __builtin_amdgcn_cvt_pk_fp8_f32(c.x, c.y, w2, false); w2 = __builtin_amdgcn_cvt_pk_fp8_f32(c.z, c.w, w2, true);
        w3 = __builtin_amdgcn_cvt_pk_fp8_f32(d.x, d.y, w3, false); w3 = __builtin_amdgcn_cvt_pk_fp8_f32(d.z, d.w, w3, true);
        *(v4u*)(dst + g * 16) = (v4u){(unsigned)w0, (unsigned)w1, (unsigned)w2, (unsigned)w3};
    }
}

#if MK_CHECK
DEV void chk_route(int l, int row, int h, const bf16* __restrict__ Q, const bf16* __restrict__ SK, const int* __restrict__ IDS, const float* __restrict__ GG, unsigned* bad, LAS float* sL, LAS unsigned* cntL, int tid) {
    if (tid < 256) { const int c = tid >> 7, k = tid & 127; const bf16* skp = SK + ((size_t)((l * 8 + h) * 2 + c)) * 128 * 128 + k * 128; const bf16* qp = Q + (size_t)row * D + h * 256 + c * 128;
        float s = 0.f; for (int d = 0; d < 128; ++d) s += bf1(qp[d]) * bf1(skp[d]); sL[c * 128 + k] = s; }
    if (tid == 0) cntL[0] = 0u;
    __syncthreads();
    float sc15 = 0.f; unsigned mybad = 0;
    { float prev = 3e38f; float s0 = 0.f, gsum = 0.f; float g0 = GG[(size_t)row * 128 + h * 16];
      for (int r = 0; r < 16; ++r) { const int id = IDS[(size_t)row * 128 + h * 16 + r]; const float g = GG[(size_t)row * 128 + h * 16 + r];
          if (id < 0 || id >= NEXP) { mybad |= 1; continue; }
          const float scv = sL[id >> 7] + sL[128 + (id & 127)];
          if (r == 0) s0 = scv;
          if (scv > prev + 1e-5f) mybad |= 2;
          prev = scv; gsum += g;
          const float ratio = __expf(scv - s0);
          if (fabsf(g / g0 - ratio) > 0.02f * ratio + 1e-4f) mybad |= 4;
          if (r == 15) sc15 = scv; }
      if (fabsf(gsum - 1.f) > 1e-3f) mybad |= 8; }
    unsigned cnt = 0;
    for (int p = tid; p < 16384; p += 512) { const float v = sL[p >> 7] + sL[128 + (p & 127)]; if (v > sc15 + 1e-5f) ++cnt; }
    __hip_atomic_fetch_add(cntL, cnt, __ATOMIC_RELAXED, __HIP_MEMORY_SCOPE_WORKGROUP);
    __syncthreads();
    if (tid == 0) { if (cntL[0] > 15u) mybad |= 16; if (mybad) atomicAdd(bad, 1u); }
    __syncthreads();
}
DEV void chk_expert(int l, int row, const bf16* __restrict__ H, const int* __restrict__ IDS, const float* __restrict__ GG, const float* __restrict__ Uf, const float* __restrict__ Vf,
                    const float* __restrict__ X1, const float* __restrict__ X2, const float* __restrict__ g2, unsigned* bad, LAS float* wL, int tid) {
    if (tid < 128) { const int id = IDS[(size_t)row * 128 + tid]; const float* up = Uf + ((size_t)l * NEXP + id) * D; const bf16* hp = H + (size_t)row * D;
        float s = 0.f; for (int d = 0; d < D; ++d) s += up[d] * bf1(hp[d]);
        wL[tid] = GG[(size_t)row * 128 + tid] * gelu_tanh(s); }
    __syncthreads();
    unsigned mybad = 0;
    for (int d = tid; d < D; d += 512) { float y = 0.f;
        for (int e = 0; e < 128; ++e) { const int id = IDS[(size_t)row * 128 + e]; y += wL[e] * Vf[((size_t)l * NEXP + id) * D + d]; }
        const float want = X1[(size_t)row * D + d] + g2[d] * y * (MK_CHECK == 3 ? 1.5f : 1.f); const float got = X2[(size_t)row * D + d];
        if (!(fabsf(got - want) <= 0.02f * fabsf(want) + 0.02f)) mybad = 1; }
    if (mybad) atomicAdd(bad, 1u);
    __syncthreads();
}

DEV void chk_hq(int l, int row, const float* __restrict__ X1, const float* __restrict__ gain, const float* __restrict__ modl, const float* __restrict__ wq, const bf16* __restrict__ H, const bf16* __restrict__ Q,
                unsigned* bad, LAS float* hL, LAS float* redL, int tid) {
    const int b = row >> 12;
    float ss = 0.f;
    for (int d = tid; d < D; d += 512) { const float v = X1[(size_t)row * D + d]; ss += v * v; }
    ss = wave_sum(ss);
    if ((tid & 63) == 0) redL[tid >> 6] = ss;
    __syncthreads();
    float tot = 0.f; for (int w = 0; w < 8; ++w) tot += redL[w];
    const float r = rsqrtf(tot * (1.f / D) + EPS);
    unsigned badh = 0, badq = 0;
    for (int d = tid; d < D; d += 512) { const float hv = X1[(size_t)row * D + d] * r * gain[d] * (1.f + modl[(size_t)b * MODW + MO_SC2 + d]) + modl[(size_t)b * MODW + MO_SH2 + d];
        hL[d] = hv; const float got = bf1(H[(size_t)row * D + d]); if (!(fabsf(got - hv) <= 0.01f * fabsf(hv) + 0.01f)) badh = 1; }
    __syncthreads();
    for (int c = tid; c < D; c += 512) { float q = 0.f; for (int k = 0; k < D; ++k) q += hL[k] * wq[(size_t)k * D + c];
        const float got = bf1(Q[(size_t)row * D + c]); if (!(fabsf(got - q) <= 0.02f * fabsf(q) + 0.03f)) badq = 1; }
    if (badh) atomicAdd(bad, 1u);
    if (badq) atomicAdd(bad + 1, 1u);
    __syncthreads();
}
#endif
struct Args { const float* in[24]; float* out; unsigned char* ws; int ph_lo, ph_hi, li, pad; };

__global__ void __launch_bounds__(512, 2) fwd(Args a) {
    extern __shared__ __attribute__((aligned(16))) unsigned char lds_raw[];
    LAS unsigned char* lds = (LAS unsigned char*)lds_raw;
#define PHASE_TID() int tid = threadIdx.x; asm volatile("" : "+v"(tid)); const int lane = tid & 63; (void)lane; \
    int bx = blockIdx.x, G = gridDim.x; asm volatile("" : "+s"(bx), "+s"(G)); const int wave = __builtin_amdgcn_readfirstlane(tid >> 6); \
    const int vcu = (G % 8 == 0) ? (bx % 8) * (G / 8) + bx / 8 : bx; const int gw = vcu * 8 + wave, NGW = G * 8; (void)gw; (void)NGW; (void)vcu; (void)wave; \
    const __attribute__((address_space(4))) Args* A = (const __attribute__((address_space(4))) Args*)__builtin_amdgcn_kernarg_segment_ptr(); asm volatile("" : "+s"(A))
    unsigned* ctl = (unsigned*)(a.ws + WS_CTL);
    const int lo = a.ph_lo, hi = a.ph_hi;
    for (int u = threadIdx.x; u < (LDS_BYTES - LDS_MISC) / 4; u += 512) ((LAS unsigned*)(lds + LDS_MISC))[u] = 0u;
    __syncthreads();
    XcdBarrier bar; bar.bar = ctl + CW_BAR + (a.li & 7) * XCD_BAR_WORDS; bar.x = 0; bar.st = (volatile LAS unsigned*)(lds + LDS_MISC + 64);
    if (hi - lo > 1) bar = xcd_barrier_post(ctl + CW_BAR + (a.li & 7) * XCD_BAR_WORDS, (volatile LAS unsigned*)(lds + LDS_MISC + 64));
#ifndef MK_MASK
#define MK_MASK 0x3ff
#endif
#define KON(q) (((MK_MASK) >> (q)) & 1)
#define IN(k) (lo <= (k) && (k) < hi)
#define SEAM(k) do { if (IN(k) && IN((k) + 1)) xcd_barrier(bar); } while (0)

#define mod   ((float*)(A->ws + WS_MOD))
#define WIN_T ((bf16*)(A->ws + WS_WIN_T))
#define WOUT_T ((bf16*)(A->ws + WS_WOUT_T))
#define WQ_T  ((bf16*)(A->ws + WS_WQ_T))
#define SUBK  ((bf16*)(A->ws + WS_SUBK))
#define UB    ((bf16*)(A->ws + WS_U))
#define VB    ((bf16*)(A->ws + WS_V))
#define H     ((bf16*)(A->ws + WS_H))
#define Z     ((bf16*)(A->ws + WS_Z))
#define HLOC  ((float*)(A->ws + WS_HLOC))
#define PP    ((float*)(A->ws + WS_P))
#define YB    ((float*)(A->ws + WS_YB))
#define YC    ((float*)(A->ws + WS_YC))
#define SUMA  ((float*)(A->ws + WS_SUMA))
#define SUMB  ((float*)(A->ws + WS_SUMB))
#define X1    ((float*)(A->ws + WS_X1))
#define X2    ((float*)(A->ws + WS_X2))
#define QB    ((bf16*)(A->ws + WS_Q))
#define IDS   ((int*)(A->ws + WS_IDS))
#define GG    ((float*)(A->ws + WS_G))
#define PARTB ((float*)(A->ws + WS_PART))
#define WG_T  ((bf16*)(A->ws + WS_WG_T))
#define LSEB  ((float*)(A->ws + WS_LSE))
#define XIN   ((l == 0) ? A->in[0] : (const float*)X2)
#define MODL  (mod + (size_t)l * 2 * MODW)
    for (int rep = 0; rep < (MK_DUP == 0 ? 2 : 1); ++rep) if (KON(0) && IN(0)) {
        PHASE_TID();
        ph_mod(A->in[1], A->in[2], A->in[3], mod, (LAS float*)lds, vcu, G, tid);
        {
            LAS float* scr = (LAS float*)(lds + wave * 16384);
            constexpr int I_IN = (D / 64) * (IN_W / 32), I_SQ = (D / 64) * (D / 32), I_L = I_IN + 2 * I_SQ;
            for (int it = gw; it < 2 * I_L; it += NGW) {
                const int l = it / I_L; int r = it % I_L;
                if (r < I_IN) { transpose_item(A->in[6] + (size_t)l * D * IN_W, D, IN_W, WIN_T + (size_t)l * IN_W * D, scr, r, lane); continue; } r -= I_IN;
                if (r < I_SQ) { transpose_item(A->in[18] + (size_t)l * D * D, D, D, WOUT_T + (size_t)l * D * D, scr, r, lane); continue; } r -= I_SQ;
                transpose_item(A->in[19] + (size_t)l * D * D, D, D, WQ_T + (size_t)l * D * D, scr, r, lane);
            }
        }
        {
            LAS float* scr = (LAS float*)(lds + wave * 16384);
            for (int it = gw; it < 2 * 6 * 2 * 8; it += NGW) { const int mi = it >> 3, sub = it & 7; const int ln = mi >> 1, g = mi & 1;
                transpose_item((g ? A->in[11] : A->in[9]) + (size_t)ln * 128 * 128, 128, 128, WG_T + ((size_t)ln * 2 + g) * 128 * 128, scr, sub, lane); }
        }
        const size_t gtid = (size_t)vcu * 512 + tid, gstride = (size_t)G * 512;
        convert_copy(A->in[20], SUBK, (size_t)2 * 8 * 2 * 128 * 128 / 8, gtid, gstride);
        convert_fp8(A->in[21], (unsigned char*)UB, (size_t)NL * NEXP * D / 16, gtid, gstride, U8_SCALE);
        convert_fp8(A->in[22], (unsigned char*)VB, (size_t)NL * NEXP * D / 16, gtid, gstride, 1.f);
    }
    SEAM(0);

    for (int l = 0; l < NL; ++l) {
        const int pb = 1 + 9 * l;
        for (int rep = 0; rep < (MK_DUP == 1 ? 2 : 1); ++rep) if (KON(1) && IN(pb + 0)) { PHASE_TID(); modnorm_rows(XIN, A->in[4] + l * D, MODL, MO_SH1, MO_SC1, H, gw, NGW, lane); }
        SEAM(pb + 0);
        for (int rep = 0; rep < (MK_DUP == 2 ? 2 : 1); ++rep) if (KON(2) && IN(pb + 1)) {
            PHASE_TID(); (void)tid;
            pg8::Gemm g{H, WIN_T + (size_t)l * IN_W * D, M, IN_W, D}; pg8::StaticOrder S; S.init(M, IN_W, G, bx);
            pg8::EpiBf16<0> E{Z, IN_W, nullptr, 0, 0};
            pg8::gemm_phase<pg8::EpiBf16<0>, pg8::StaticOrder, false>((PG8_LAS unsigned char*)lds, g, S, E, nullptr);
        }
        SEAM(pb + 1);
        for (int rep = 0; rep < (MK_DUP == 3 ? 2 : 1); ++rep) if (KON(3) && IN(pb + 2)) {
            PHASE_TID();
            if (rep) __syncthreads();
            for (int it = vcu; it < 2 * 64 * 6; it += G) {
                const int b = it / 384, r = it % 384, j = r / 6, n = r % 6;
                lru_item2(l, b, j, n, Z, A->in[7], A->in[8], WG_T, A->in[10], A->in[12], A->in[13], HLOC, PP, SUMA, SUMB,
                          (LAS float*)lds, (LAS float*)(lds + 34816), (LAS float*)(lds + 69632), tid);
            }
            {
                {
                    LAS unsigned char* wl = lds + wave * ATT_WLDS;
                    for (int it = gw; it < 1024 + 4608; it += NGW) {
                        if (it < 1024) { const int bh = it >> 7, tl = 127 - (it & 127); sb_mfma_item(bh >> 2, bh & 3, 32 * tl, Z, YC, wl, lane); }
                        else { const int i2 = it - 1024; const int tl = i2 & 127, p = (i2 >> 7) % 3, bh = i2 / 384; const int d = 1 << (2 * p);
                            dil_mfma_item(bh / 6, bh % 6, p, tl % d, 32 * (tl / d), Z, A->in[14], PARTB, LSEB, wl, lane); }
                    }
                }
            }
        }
        SEAM(pb + 2);
        for (int rep = 0; rep < (MK_DUP == 4 ? 2 : 1); ++rep) if (KON(4) && IN(pb + 3)) {
            PHASE_TID();
            for (int it = vcu; it < 256; it += G) { const int b = it >> 7, j = (it >> 1) & 63, half = it & 1;
                combine_item(l, b, j, half, Z, HLOC, PP, SUMA, SUMB, PARTB, LSEB, YC, A->in[15], A->in[16], A->in[17], H, (LAS float*)lds, tid); }
        }
        SEAM(pb + 3);
        for (int rep = 0; rep < (MK_DUP == 5 ? 2 : 1); ++rep) if (KON(5) && IN(pb + 4)) {
            PHASE_TID(); (void)tid;
            pg8::Gemm g{H, WOUT_T + (size_t)l * D * D, M, D, D}; pg8::StaticOrder S; S.init(M, D, G, bx);
            EpiResGate E{XIN, X1, MODL + MO_G1, ((MK_DBG >> (2 * l)) & 1) ? 0.f : ((MK_DBG & 256) ? -1.f : 1.f)};
            pg8::gemm_phase<EpiResGate, pg8::StaticOrder, false>((PG8_LAS unsigned char*)lds, g, S, E, nullptr);
        }
        SEAM(pb + 4);
        for (int rep = 0; rep < (MK_DUP == 6 ? 2 : 1); ++rep) if (KON(6) && IN(pb + 5)) { PHASE_TID(); modnorm_rows(X1, A->in[5] + l * D, MODL, MO_SH2, MO_SC2, H, gw, NGW, lane); }
        SEAM(pb + 5);
        for (int rep = 0; rep < (MK_DUP == 7 ? 2 : 1); ++rep) if (KON(7) && IN(pb + 6)) {
            PHASE_TID(); (void)tid;
            pg8::Gemm g{H, WQ_T + (size_t)l * D * D, M, D, D}; pg8::StaticOrder S; S.init(M, D, G, bx);
            pg8::EpiBf16<0> E{QB, D, nullptr, 0, 0};
            pg8::gemm_phase<pg8::EpiBf16<0>, pg8::StaticOrder, false>((PG8_LAS unsigned char*)lds, g, S, E, nullptr);
        }
        SEAM(pb + 6);
        for (int rep = 0; rep < (MK_DUP == 8 ? 2 : 1); ++rep) if (KON(8) && IN(pb + 7)) {
            PHASE_TID();
            for (int it = vcu; it < 128 * 8; it += G) route_item2(l, it >> 3, it & 7, QB, SUBK, IDS, GG, lds, tid);
        }
        SEAM(pb + 7);
        for (int rep = 0; rep < (MK_DUP == 9 ? 2 : 1); ++rep) if (KON(9) && IN(pb + 8)) {
            PHASE_TID();
            for (int m = gw; m < M; m += NGW)
                expert_row8(l, m, H, IDS, GG, (const unsigned char*)UB, (const unsigned char*)VB, X1, MODL + (size_t)(m >> 12) * MODW + MO_G2, (l == NL - 1) ? A->in[23] : nullptr, (l == NL - 1) ? A->out : X2, lane, ((MK_DBG >> (2 * l + 1)) & 1) ? 0.f : ((MK_DBG & 128) ? -1.f : 1.f));
        }
        if (l + 1 < NL) SEAM(pb + 8);
    }
#if MK_CHECK
    if (IN(19)) {
        PHASE_TID();
        unsigned* badw = (unsigned*)(A->ws + WS_CTL) + 8;
#if MK_CHECK == 1 || MK_CHECK == 3 || MK_CHECK == 4
        for (int it = vcu; it < (MK_CHECK == 4 ? 8192 : 256) * 8; it += G) { const int row = (MK_CHECK == 4) ? (it >> 3) : (((it >> 3) * 131 + 7) & 8191); chk_route(0, row, it & 7, QB, SUBK, IDS, GG, badw, (LAS float*)lds, (LAS unsigned*)(lds + 2048), tid); }
        for (int it = vcu; it < (MK_CHECK == 4 ? 8192 : 256); it += G) { const int row = (MK_CHECK == 4) ? it : ((it * 131 + 7) & 8191); chk_expert(0, row, H, IDS, GG, A->in[21], A->in[22], X1, X2, mod + (size_t)(row >> 12) * MODW + MO_G2, badw + 1, (LAS float*)lds, tid); }
#elif MK_CHECK == 12 || MK_CHECK == 15
        { (void)badw;
          for (int m = gw; m < M; m += NGW) { const int ia = IDS[(size_t)m * 128 + lane], ib = IDS[(size_t)m * 128 + 64 + lane]; int cnt = 0;
              for (int e = 0; e < 128; ++e) { const int ie = (e < 64) ? __shfl(ia, e) : __shfl(ib, e - 64); if (lane < e && ia == ie && (MK_CHECK == 12 || (lane >> 4) == (e >> 4))) ++cnt; if (lane + 64 < e && ib == ie && (MK_CHECK == 12 || ((lane + 64) >> 4) == (e >> 4))) ++cnt; }
              float fc = wave_sum((float)cnt); if (lane == 0) atomicAdd((float*)(A->ws + WS_CTL) + 16, fc * 2048.f); } }
#elif MK_CHECK == 13 || MK_CHECK == 14
        { (void)badw;
          float cnt = 0.f;
          if (MK_CHECK == 13) { const float* sk = A->in[20]; for (int o = vcu * 512 + tid; o < 2 * 128 * 128; o += G * 512) if (sk[o] == sk[o + 2 * 128 * 128]) cnt += 1.f; cnt *= (float)M * D / (2.f * 128 * 128); }
          else { const float* wq = A->in[19]; for (int o = vcu * 512 + tid; o < D * 256; o += G * 512) { const int k = o >> 8, c = o & 255; if (wq[(size_t)k * D + c] == wq[(size_t)k * D + 256 + c]) cnt += 1.f; } cnt *= (float)M * D / ((float)D * 256); }
          cnt = wave_sum(cnt); if (lane == 0) atomicAdd((float*)(A->ws + WS_CTL) + 16, cnt); }
#elif MK_CHECK == 10
        { (void)badw; float acc = 0.f; const float* vt = A->in[22];
          for (size_t o = (size_t)vcu * 512 + tid; o < (size_t)NEXP * D; o += (size_t)G * 512) { const float v = vt[o]; acc += v * v; }
          acc = wave_sum(acc); if (lane == 0) atomicAdd((float*)(A->ws + WS_CTL) + 16, acc * ((float)M * D / ((float)NEXP * D))); }
#elif MK_CHECK == 16
        (void)badw;
#elif MK_CHECK >= 6
        (void)badw;
#elif MK_CHECK == 5
        {
            const float* cc = A->in[1]; const float* wm = A->in[2]; const float* bm = A->in[3];
            unsigned mb = 0;
            for (int o = vcu * 512 + tid; o < 2 * 2 * MODW; o += G * 512) { const int l = o / (2 * MODW), b = (o / MODW) & 1, n = o % MODW;
                float sacc = 0.f; for (int k = 0; k < D; ++k) { const float cv = cc[b * D + k]; sacc += (cv / (1.f + __expf(-cv))) * wm[((size_t)l * D + k) * MODW + n]; }
                sacc += bm[l * MODW + n];
                if (!(fabsf(sacc - mod[o]) <= 2e-3f * fabsf(sacc) + 2e-3f)) mb = 1; }
            if (mb) atomicAdd(badw, 1u);
            unsigned sb = 0;
            for (int o = vcu * 512 + tid; o < 2 * 8 * 2 * 128 * 128; o += G * 512) { const float want = A->in[20][o]; const float got = bf1(SUBK[o]); if (!(fabsf(got - want) <= 0.01f * fabsf(want) + 1e-6f)) sb = 1; }
            if (sb) atomicAdd(badw + 1, 1u);
        }
#else
        for (int it = vcu; it < 256; it += G) { const int row = (it * 131 + 7) & 8191; chk_hq(0, row, X1, A->in[5], mod, A->in[19], H, QB, badw, (LAS float*)lds, (LAS float*)(lds + 16384), tid); }
#endif
    }
    if (IN(20)) {
        PHASE_TID();
        const unsigned* badw = (const unsigned*)(A->ws + WS_CTL) + 8;
        const unsigned b0 = __hip_atomic_load(badw, __ATOMIC_RELAXED, __HIP_MEMORY_SCOPE_AGENT), b1 = __hip_atomic_load(badw + 1, __ATOMIC_RELAXED, __HIP_MEMORY_SCOPE_AGENT);
#if MK_CHECK >= 6 && MK_CHECK != 16
        const float f = 1.f + ((const float*)(A->ws + WS_CTL))[16] * (1.f / ((float)M * D)); (void)b0; (void)b1;
#else
        const float f = (b0 ? (b1 ? -2.f : 0.f) : (b1 ? -1.f : 1.f));
#endif
        for (int m = gw; m < M; m += NGW) { const f32x4* xr = (const f32x4*)(X2 + (size_t)m * D) + lane; f32x4 v[8]; float ss = 0.f;
#pragma unroll
            for (int j = 0; j < 8; ++j) { v[j] = xr[64 * j]; ss += (v[j].x * v[j].x + v[j].y * v[j].y) + (v[j].z * v[j].z + v[j].w * v[j].w); }
            const float r = rsqrtf(wave_sum(ss) * (1.f / D) + EPS) * f;
#pragma unroll
            for (int j = 0; j < 8; ++j) { const f32x4 fn = ((const f32x4*)A->in[23])[lane + 64 * j]; ((f32x4*)(A->out + (size_t)m * D))[lane + 64 * j] = v[j] * r * fn; } }
    }
#endif
#undef IN
#undef SEAM
#undef mod
#undef H
#undef Z
#undef X1
#undef X2
}
}

extern "C" void kernel_launch(void* const* d_in, const int* in_sizes, int n_in, void* d_out, int out_size, void* d_ws, size_t ws_size, hipStream_t stream) {
    using namespace mk;
    static int grid = 0;
    if (grid == 0) {
        if (n_in != 24 || out_size != M * D || ws_size < WS_END) { fprintf(stderr, "kernel_launch: unexpected shapes (n_in %d out %d ws %zu)\n", n_in, out_size, ws_size); grid = -1; return; }
        int dev = 0, cus = 0, per_cu = 0;
        if (hipGetDevice(&dev) != hipSuccess || hipDeviceGetAttribute(&cus, hipDeviceAttributeMultiprocessorCount, dev) != hipSuccess) { grid = -1; return; }
        if (hipFuncSetAttribute((const void*)fwd, hipFuncAttributeMaxDynamicSharedMemorySize, LDS_BYTES) != hipSuccess) { fprintf(stderr, "kernel_launch: hipFuncSetAttribute failed\n"); grid = -1; return; }
        if (hipOccupancyMaxActiveBlocksPerMultiprocessor(&per_cu, (const void*)fwd, 512, LDS_BYTES) != hipSuccess || per_cu < 1) fprintf(stderr, "kernel_launch: occupancy query says %d\n", per_cu);
        (void)hipGetLastError();
        grid = cus;
    }
    if (grid < 0) return;
    (void)hipMemsetAsync((char*)d_ws + WS_CTL, 0, CTL_ZERO_BYTES, stream);
    Args a{};
    for (int i = 0; i < 24; ++i) a.in[i] = (const float*)d_in[i];
    a.out = (float*)d_out; a.ws = (unsigned char*)d_ws; a.pad = 0;
#if MK_CHECK
    constexpr int NLAUNCH = 12;
#else
    constexpr int NLAUNCH = MK_N_LAUNCHES;
#endif
    for (int li = 0; li < NLAUNCH; ++li) {
        a.ph_lo = (NLAUNCH == 1) ? 0 : li; a.ph_hi = (NLAUNCH == 1) ? NPHASE : li + 1; a.li = li;
#if MK_CHECK
        if (li >= 10) { a.ph_lo = li + 9; a.ph_hi = li + 10; }
#endif
        hipLaunchKernelGGL(fwd, dim3(grid), dim3(512), LDS_BYTES, stream, a);
    }
}
```

```cpp
#include <hip/hip_runtime.h>
#include <cstdio>
#include <cstdint>
#define MK_DBG 0
#define MK_N_LAUNCHES 1
#define MK_CHECK 0
namespace pg8 {
#define PG8_LAS __attribute__((address_space(3)))
typedef unsigned short bf16_t;
typedef short bf16x8 __attribute__((ext_vector_type(8)));
typedef float f32x4 __attribute__((ext_vector_type(4)));
typedef unsigned u32x4 __attribute__((ext_vector_type(4)));
constexpr int BM = 256, BK = 64, HALF = 128, HTB = HALF * BK * 2  , STAGE_BYTES = 8 * HTB, NXCD = 8, WGM = 8;

__host__ __device__ __forceinline__ int lds_byte(int r, int c) { const int st = (r >> 4) * 2 + (c >> 5), rr = r & 15, cc = c & 31, ob = rr * 64 + cc * 2; return st * 1024 + (ob ^ (((ob >> 9) & 1) << 5)); }
__host__ __device__ __forceinline__ void stage_rc(int b, int& R, int& C) { const int st = b / 1024, sb = b % 1024, swz = sb ^ (((sb >> 9) & 1) << 5); R = (st >> 1) * 16 + swz / 64; C = (st & 1) * 32 + (swz % 64) / 2; }
__host__ __device__ __forceinline__ int perm32(int rho) { const int n = rho >> 4, i = rho & 15; return 8 * (i >> 2) + 4 * n + (i & 3); }

struct Unit { int pm, pn; };
struct Gemm { const bf16_t* A; const bf16_t* Bt; int M, N, K; };

struct StaticOrder {
    int nM, nN, nwg, G, c;
    __host__ __device__ void init(int M, int N, int G_, int c_) { nM = M / BM; nN = N / BM; nwg = nM * nN; G = G_; c = c_; }
    __host__ __device__ bool next(int i, Unit& u) const {
        const long L = (long)i * G + c; if (L >= nwg) return false;
        int wgid = (int)L; { const int q = nwg / NXCD, r = nwg % NXCD, xcd = wgid % NXCD, off = wgid / NXCD; wgid = (xcd < r ? xcd * (q + 1) : r * (q + 1) + (xcd - r) * q) + off; }
        const int nig = WGM * nN, gid = wgid / nig, fm = gid * WGM, gsz = (nM - fm) < WGM ? (nM - fm) : WGM;
        u.pm = fm + ((wgid % nig) % gsz); u.pn = (wgid % nig) / gsz; return true;
    }
    __device__ __forceinline__ void a_ready(const Unit&) const {}
    __device__ __forceinline__ void done(const Unit&) const {}
};
struct CountedOrder : StaticOrder {
    const unsigned* ready; unsigned need; unsigned* tmo;
    __device__ __forceinline__ void a_ready(const Unit& u) const {
        if (threadIdx.x < 64) {
            const unsigned long long t0 = __builtin_amdgcn_s_memrealtime(); unsigned polls = 0;
            while ((unsigned)__builtin_amdgcn_readfirstlane(__hip_atomic_load(ready + 64 * u.pm, __ATOMIC_RELAXED, __HIP_MEMORY_SCOPE_AGENT)) < need) {
                if ((++polls & 255u) == 0u && __builtin_amdgcn_readfirstlane(__hip_atomic_load(tmo, __ATOMIC_RELAXED, __HIP_MEMORY_SCOPE_AGENT)) != 0u) break;
                if (__builtin_amdgcn_s_memrealtime() - t0 > 2000000ull) {
                    if (threadIdx.x == 0) { unsigned expect = 0u; __hip_atomic_compare_exchange_strong(tmo + 1, &expect, 0x600u | (unsigned)(u.pm & 0xff), __ATOMIC_RELAXED, __ATOMIC_RELAXED, __HIP_MEMORY_SCOPE_AGENT); __hip_atomic_store(tmo, 1u, __ATOMIC_RELAXED, __HIP_MEMORY_SCOPE_AGENT); }
                    break; }
                __builtin_amdgcn_s_sleep(2); }
            __builtin_amdgcn_fence(__ATOMIC_ACQUIRE, "agent");
            asm volatile("s_waitcnt vmcnt(0)" ::: "memory");
        }
#if !defined(BROKEN_HOOK_NO_BARRIER)
        asm volatile("" ::: "memory"); __builtin_amdgcn_s_barrier(); asm volatile("" ::: "memory");
#endif
    }
};

__device__ __forceinline__ unsigned cvt_pk_bf16(float lo, float hi) { unsigned r; asm volatile("v_cvt_pk_bf16_f32 %0, %1, %2" : "=v"(r) : "v"(lo), "v"(hi)); return r; }
typedef float f32x2 __attribute__((ext_vector_type(2)));
__device__ __forceinline__ f32x2 gelu_pk(f32x2 v) {
    const f32x2 av = __builtin_elementwise_abs(v), d = av * 0.2316418882f + 1.0f;
    f32x2 t; t.x = __builtin_amdgcn_rcpf(d.x); t.y = __builtin_amdgcn_rcpf(d.y);
    f32x2 q = t * 0.5307027145f + (-0.7265760135f); q = q * t + 0.7107068705f; q = q * t + (-0.142248368f); q = q * t + 0.127414796f; q = q * t;
    const f32x2 s = (v * v) * (-0.72134752044f);
    f32x2 e; e.x = __builtin_amdgcn_exp2f(s.x); e.y = __builtin_amdgcn_exp2f(s.y);
    const f32x2 m = v * (q * e), r = v - m;
    f32x2 o; o.x = v.x < 0.f ? m.x : r.x; o.y = v.y < 0.f ? m.y : r.y; return o;
}

struct EpiF32 {
    static constexpr bool PERM = false, AFTER_DRAIN = false;
    float* C; int ldc; const float* bias;
    __device__ __forceinline__ void operator()(const f32x4 (&acc)[2][2][4][2], const Unit& u, int wr, int wc, int fr, int fq) const {
        const int row0 = u.pm * BM + wr * 64 + fr, col0 = u.pn * BM + wc * 32 + 4 * fq;
        f32x4 bv[2][2];
#pragma unroll
        for (int bj = 0; bj < 2; ++bj)
#pragma unroll
            for (int n = 0; n < 2; ++n) bv[bj][n] = bias ? *(const f32x4*)(bias + col0 + bj * HALF + n * 16) : (f32x4){0.f, 0.f, 0.f, 0.f};
#pragma unroll
        for (int ai = 0; ai < 2; ++ai)
#pragma unroll
            for (int m = 0; m < 4; ++m) { float* rowp = C + (size_t)(row0 + ai * HALF + m * 16) * ldc + col0;
#pragma unroll
                for (int bj = 0; bj < 2; ++bj)
#pragma unroll
                    for (int n = 0; n < 2; ++n) *(f32x4*)(rowp + bj * HALF + n * 16) = acc[ai][bj][m][n] + bv[bj][n]; }
    }
};
template <int ACT  > struct EpiBf16 {
    static constexpr bool PERM = true, AFTER_DRAIN = false;
    bf16_t* O; int ldc; const float* bias; int split_cols; size_t split_stride;
    __device__ __forceinline__ void operator()(const f32x4 (&acc)[2][2][4][2], const Unit& u, int wr, int wc, int fr, int fq) const {
        const int row0 = u.pm * BM + wr * 64 + fr; int colt = u.pn * BM; bf16_t* base = O;
        if (split_cols) { const int t = colt / split_cols; base += (size_t)t * split_stride; colt -= t * split_cols; }
        const int col0 = colt + wc * 32 + 8 * fq, bcol0 = u.pn * BM + wc * 32 + 8 * fq;
        f32x4 bv[2][2];
#pragma unroll
        for (int bj = 0; bj < 2; ++bj)
#pragma unroll
            for (int n = 0; n < 2; ++n) bv[bj][n] = bias ? *(const f32x4*)(bias + bcol0 + bj * HALF + 4 * n) : (f32x4){0.f, 0.f, 0.f, 0.f};
#pragma unroll
        for (int ai = 0; ai < 2; ++ai)
#pragma unroll
            for (int m = 0; m < 4; ++m) { bf16_t* rowp = base + (size_t)(row0 + ai * HALF + m * 16) * ldc + col0;
#pragma unroll
                for (int bj = 0; bj < 2; ++bj) { f32x4 v0 = acc[ai][bj][m][0] + bv[bj][0], v1 = acc[ai][bj][m][1] + bv[bj][1];
                    if (ACT == 1) { f32x2 a = gelu_pk((f32x2){v0[0], v0[1]}), b = gelu_pk((f32x2){v0[2], v0[3]}), c = gelu_pk((f32x2){v1[0], v1[1]}), d = gelu_pk((f32x2){v1[2], v1[3]});
                        v0 = (f32x4){a.x, a.y, b.x, b.y}; v1 = (f32x4){c.x, c.y, d.x, d.y}; }
                    if (ACT == 2) {
#pragma unroll
                        for (int j = 0; j < 4; ++j) { v0[j] = 0.5f * v0[j] * (1.0f + erff(v0[j] * 0.70710678f)); v1[j] = 0.5f * v1[j] * (1.0f + erff(v1[j] * 0.70710678f)); } }
                    u32x4 w; w.x = cvt_pk_bf16(v0[0], v0[1]); w.y = cvt_pk_bf16(v0[2], v0[3]); w.z = cvt_pk_bf16(v1[0], v1[1]); w.w = cvt_pk_bf16(v1[2], v1[3]);
                    *(u32x4*)(rowp + bj * HALF) = w; } }
    }
};
template <class Epi, class Sched, bool STAMP = false>
__device__ __forceinline__ void gemm_phase(PG8_LAS unsigned char* lds, const Gemm g, const Sched& S, const Epi& E, unsigned long long* stamps) {
    int tid_o = threadIdx.x; asm volatile("" : "+v"(tid_o));
    const int tid = tid_o, wid = __builtin_amdgcn_readfirstlane(tid >> 6), lane = tid & 63, wr = wid >> 2, wc = wid & 3, fr = lane & 15, fq = lane >> 4;
    constexpr int K = 2048, nt = K / BK;
    int ts_lo = 0, ts_hi = 0, nts = 0; const unsigned long long rt_entry = STAMP ? (unsigned long long)wall_clock64() : 0ull;
#define PG8_STAMP() do { if (STAMP && wid == 0 && nts < 64) { const unsigned long long _c = (unsigned long long)clock64(); \
        ts_lo = (lane == nts) ? (int)(unsigned)_c : ts_lo; ts_hi = (lane == nts) ? (int)(unsigned)(_c >> 32) : ts_hi; ++nts; } } while (0)
    PG8_STAMP();
    unsigned voffA[2], voffB[2];
#pragma unroll
    for (int i = 0; i < 2; ++i) { int R, C; stage_rc(tid * 16 + i * 8192, R, C); const int Rb = Epi::PERM ? ((R & ~31) + perm32(R & 31)) : R;
        voffA[i] = (unsigned)(R * K + C) * 2u; voffB[i] = (unsigned)(Rb * K + C) * 2u; }
    const size_t kstep = (size_t)(BK * 2);
    const size_t hstep = (size_t)HALF * K * 2;
    const size_t tstep = 2 * hstep;
    const unsigned ldsw = (unsigned)wid * 1024u;
    const int aoff = lds_byte(wr * 64 + fr, fq * 8), boff = lds_byte(wc * 32 + fr, fq * 8);
#define PG8_SA(b, h) (((b) * 2 + (h)) * HTB)
#define PG8_SB(b, h) ((4 + (b) * 2 + (h)) * HTB)
#define PG8_STAGE(bufoff, gbase, voff) do { _Pragma("unroll") for (int _i = 0; _i < 2; ++_i) \
        __builtin_amdgcn_global_load_lds((const unsigned*)((const char*)(gbase) + (voff)[_i]), (PG8_LAS unsigned*)(lds + (bufoff) + ldsw + _i * 8192), 16, 0, 0); } while (0)
#define PG8_LDA(dst, b, h) do { _Pragma("unroll") for (int m = 0; m < 4; ++m) _Pragma("unroll") for (int k = 0; k < 2; ++k) dst[m][k] = *(const PG8_LAS bf16x8*)(lds + PG8_SA(b, h) + aoff + m * 2048 + k * 1024); } while (0)
#define PG8_LDB(dst, b, h) do { _Pragma("unroll") for (int n = 0; n < 2; ++n) _Pragma("unroll") for (int k = 0; k < 2; ++k) dst[n][k] = *(const PG8_LAS bf16x8*)(lds + PG8_SB(b, h) + boff + n * 2048 + k * 1024); } while (0)
#define PG8_MMA(ai, bj, At, Bt) do { __builtin_amdgcn_s_setprio(1); _Pragma("unroll") for (int m = 0; m < 4; ++m) _Pragma("unroll") for (int n = 0; n < 2; ++n) _Pragma("unroll") for (int k = 0; k < 2; ++k) \
        acc[ai][bj][m][n] = __builtin_amdgcn_mfma_f32_16x16x32_bf16(Bt[n][k], At[m][k], acc[ai][bj][m][n], 0, 0, 0); __builtin_amdgcn_s_setprio(0); } while (0)
#define PG8_WAIT_V(n) asm volatile("s_waitcnt vmcnt(" #n ")" ::: "memory")
#define PG8_WAIT_L(n) asm volatile("s_waitcnt lgkmcnt(" #n ")" ::: "memory")
#define PG8_BAR __builtin_amdgcn_s_barrier()
#define PG8_SCHED __builtin_amdgcn_sched_barrier(0)
    Unit cur, nxt; int ui = 0;
    if (!S.next(0, cur)) return;
    f32x4 acc[2][2][4][2];
#pragma unroll
    for (int a = 0; a < 2; ++a)
#pragma unroll
        for (int b = 0; b < 2; ++b)
#pragma unroll
            for (int m = 0; m < 4; ++m)
#pragma unroll
                for (int n = 0; n < 2; ++n) acc[a][b][m][n] = (f32x4){0.f, 0.f, 0.f, 0.f};
    bf16x8 At[4][2], B0[2][2], B1[2][2];
    const char* cA = (const char*)g.A + (size_t)cur.pm * tstep; const char* cB = (const char*)g.Bt + (size_t)cur.pn * tstep;
    S.a_ready(cur);
    PG8_STAGE(PG8_SB(0, 0), cB, voffB); PG8_STAGE(PG8_SA(0, 0), cA, voffA); PG8_STAGE(PG8_SB(0, 1), cB + hstep, voffB); PG8_STAGE(PG8_SA(0, 1), cA + hstep, voffA);
    if (wr == 1) PG8_BAR;
    PG8_WAIT_V(4); PG8_BAR;
    PG8_STAGE(PG8_SB(1, 0), cB + kstep, voffB); PG8_STAGE(PG8_SA(1, 0), cA + kstep, voffA); PG8_STAGE(PG8_SB(1, 1), cB + hstep + kstep, voffB);
    PG8_WAIT_V(6); PG8_BAR;
    PG8_STAMP();
    for (;;) {
        const bool has_next = S.next(ui + 1, nxt);
        const char* nA = has_next ? (const char*)g.A + (size_t)nxt.pm * tstep : cA; const char* nB = has_next ? (const char*)g.Bt + (size_t)nxt.pn * tstep : cB;
        for (int t = 0; t < nt; t += 2) {
            const bool last = (t == nt - 2);
            const char* a1 = cA + (size_t)(t + 1) * kstep;
            const char* a2 = last ? nA : cA + (size_t)(t + 2) * kstep; const char* b2 = last ? nB : cB + (size_t)(t + 2) * kstep;
            const char* a3 = a2 + kstep; const char* b3 = b2 + kstep;
            if (last && has_next) S.a_ready(nxt);
            PG8_LDB(B0, 0, 0); PG8_SCHED; PG8_LDA(At, 0, 0); PG8_STAGE(PG8_SA(1, 1), a1 + hstep, voffA);
            PG8_WAIT_L(8); PG8_BAR; PG8_WAIT_L(0); PG8_MMA(0, 0, At, B0); PG8_BAR; PG8_SCHED;
            PG8_LDB(B1, 0, 1); PG8_STAGE(PG8_SB(0, 0), b2, voffB);
            PG8_BAR; PG8_WAIT_L(0); PG8_MMA(0, 1, At, B1); PG8_BAR;
            PG8_LDA(At, 0, 1); PG8_STAGE(PG8_SA(0, 0), a2, voffA);
            PG8_BAR; PG8_WAIT_L(0); PG8_MMA(1, 0, At, B0); PG8_BAR; PG8_SCHED;
            PG8_STAGE(PG8_SB(0, 1), b2 + hstep, voffB);
            PG8_WAIT_V(6); PG8_BAR; PG8_MMA(1, 1, At, B1); PG8_BAR;
            PG8_LDB(B0, 1, 0); PG8_SCHED; PG8_LDA(At, 1, 0); PG8_STAGE(PG8_SA(0, 1), a2 + hstep, voffA);
            PG8_WAIT_L(8); PG8_BAR; PG8_WAIT_L(0); PG8_MMA(0, 0, At, B0); PG8_BAR; PG8_SCHED;
            PG8_LDB(B1, 1, 1); PG8_STAGE(PG8_SB(1, 0), b3, voffB);
            PG8_BAR; PG8_WAIT_L(0); PG8_MMA(0, 1, At, B1); PG8_BAR;
            PG8_LDA(At, 1, 1); PG8_STAGE(PG8_SA(1, 0), a3, voffA);
            PG8_BAR; PG8_WAIT_L(0); PG8_MMA(1, 0, At, B0); PG8_BAR; PG8_SCHED;
            PG8_STAGE(PG8_SB(1, 1), b3 + hstep, voffB);
            PG8_WAIT_V(6); PG8_BAR; PG8_MMA(1, 1, At, B1); PG8_BAR;
        }
        PG8_STAMP();
        if constexpr (!Epi::AFTER_DRAIN) { E(acc, cur, wr, wc, fr, fq); S.done(cur); }
        PG8_STAMP();
        if (!has_next) break;
#pragma unroll
        for (int a = 0; a < 2; ++a)
#pragma unroll
            for (int b = 0; b < 2; ++b)
#pragma unroll
                for (int m = 0; m < 4; ++m)
#pragma unroll
                    for (int n = 0; n < 2; ++n) acc[a][b][m][n] = (f32x4){0.f, 0.f, 0.f, 0.f};
        cur = nxt; cA = nA; cB = nB; ++ui;
    }
    PG8_WAIT_V(0);
    if (wr == 0) PG8_BAR;
    PG8_BAR;
    if constexpr (Epi::AFTER_DRAIN) { E.fused(acc, cur, wr, wc, fr, fq, lds, wid, lane); S.done(cur); }
    PG8_STAMP();
    if (STAMP && wid == 0) { stamps[lane] = lane < nts ? (((unsigned long long)(unsigned)ts_hi << 32) | (unsigned)ts_lo) : 0ull;
        if (lane == 62) stamps[62] = rt_entry; if (lane == 63) stamps[63] = (unsigned long long)wall_clock64(); }
#undef PG8_STAMP
#undef PG8_SA
#undef PG8_SB
#undef PG8_STAGE
#undef PG8_LDA
#undef PG8_LDB
#undef PG8_MMA
#undef PG8_WAIT_V
#undef PG8_WAIT_L
#undef PG8_BAR
#undef PG8_SCHED
}
}

namespace mk {
#define GAS __attribute__((address_space(1)))
#define LAS __attribute__((address_space(3)))
#define DEV __device__ __forceinline__
typedef unsigned short bf16;
typedef unsigned v4u __attribute__((ext_vector_type(4)));
typedef float f32x4 __attribute__((ext_vector_type(4)));
typedef float f32x2 __attribute__((ext_vector_type(2)));
typedef short bf16x8 __attribute__((ext_vector_type(8)));
typedef float f32x16 __attribute__((ext_vector_type(16)));
typedef __bf16 bf16x2_t __attribute__((ext_vector_type(2)));

#ifndef MK_DBG
#define MK_DBG 0
#endif
#ifndef MK_CHECK
#define MK_CHECK 0
#endif
#ifndef MK_DUP
#define MK_DUP (-1)
#endif
#ifndef MK_N_LAUNCHES
#define MK_N_LAUNCHES 19
#endif

constexpr int D = 2048, SEQ = 4096, M = 8192, NL = 2;
constexpr int LRU_W = 768, SWA_W = 768, SB_W = 512, IN_W = 5376;
constexpr int ZO_XA = 0, ZO_GA = 768, ZO_QB = 1536, ZO_KB = 2304, ZO_VB = 3072, ZO_QC = 3840, ZO_KC = 4352, ZO_VC = 4864;
constexpr int NEXP = 16384, MODW = 12288;
constexpr int MO_SH1 = 0, MO_SC1 = 2048, MO_G1 = 4096, MO_SH2 = 6144, MO_SC2 = 8192, MO_G2 = 10240;
constexpr float EPS = 1e-6f;
constexpr float QSCALE = 0.08838834764831845f;
constexpr float NEGBIG = -3.0e38f;
constexpr int NPHASE = 19 + 2 * (MK_CHECK != 0);

constexpr size_t MiB = 1u << 20;
constexpr size_t WS_CTL = 0, CTL_ZERO_BYTES = 1 * MiB;
constexpr size_t WS_MOD = 512 * 1024;
constexpr size_t WS_WIN_T = 2 * MiB, WS_WOUT_T = 44 * MiB, WS_WQ_T = 60 * MiB, WS_SUBK = 76 * MiB, WS_U = 80 * MiB, WS_V = 208 * MiB,
                 WS_H = 336 * MiB, WS_Z = 368 * MiB, WS_HLOC = 452 * MiB, WS_P = 476 * MiB, WS_YB = 500 * MiB, WS_YC = 524 * MiB,
                 WS_SUMA = 540 * MiB, WS_SUMB = 541 * MiB, WS_X1 = 544 * MiB, WS_X2 = 608 * MiB, WS_Q = 672 * MiB, WS_IDS = 704 * MiB,
                 WS_G = 708 * MiB, WS_WG_T = 77 * MiB, WS_PART = 712 * MiB, WS_LSE = 784 * MiB, WS_END = 785 * MiB;
constexpr int CW_BAR = 4096;

constexpr int LDS_BYTES = 147456;
constexpr int LDS_MISC = 143360;

__device__ const unsigned char T5B[3][132] = {
 {0,1,2,3,4,5,6,7,8,9,10,11,12,13,14,15,16,16,16,16,16,16,17,17,17,17,17,17,17,17,18,18,18,18,18,18,18,18,18,18,19,19,19,19,19,19,19,19,19,19,19,19,19,19,20,20,20,20,20,20,20,20,20,20,20,20,20,20,20,20,20,20,20,21,21,21,21,21,21,21,21,21,21,21,21,21,21,21,21,21,21,21,21,21,21,21,21,21,21,22,22,22,22,22,22,22,22,22,22,22,22,22,22,22,22,22,22,22,22,22,22,22,22,22,22,22,22,22,22,0,0,0},
 {0,4,8,12,16,16,17,17,18,18,19,19,19,19,20,20,20,20,20,21,21,21,21,21,21,22,22,22,22,22,22,22,22,22,23,23,23,23,23,23,23,23,23,23,23,23,24,24,24,24,24,24,24,24,24,24,24,24,24,24,24,24,25,25,25,25,25,25,25,25,25,25,25,25,25,25,25,25,25,25,25,25,25,26,26,26,26,26,26,26,26,26,26,26,26,26,26,26,26,26,26,26,26,26,26,26,26,26,26,26,26,26,26,27,27,27,27,27,27,27,27,27,27,27,27,27,27,27,27,0,0,0},
 {0,16,18,19,20,21,21,22,22,23,23,23,24,24,24,24,25,25,25,25,25,26,26,26,26,26,26,26,26,27,27,27,27,27,27,27,27,27,27,28,28,28,28,28,28,28,28,28,28,28,28,28,29,29,29,29,29,29,29,29,29,29,29,29,29,29,29,29,29,29,30,30,30,30,30,30,30,30,30,30,30,30,30,30,30,30,30,30,30,30,30,30,30,30,30,31,31,31,31,31,31,31,31,31,31,31,31,31,31,31,31,31,31,31,31,31,31,31,31,31,31,31,31,31,31,31,31,31,31,0,0,0}};

#define LDS_WAIT() asm volatile("s_waitcnt lgkmcnt(0)" ::: "memory")
DEV unsigned f2bf(float f) { unsigned u = __builtin_bit_cast(unsigned, f); return (u + 0x7fffu + ((u >> 16) & 1u)) >> 16; }
DEV unsigned pk2(float lo, float hi) { return f2bf(lo) | (f2bf(hi) << 16); }
DEV float bf_lo(unsigned w) { return __builtin_bit_cast(float, w << 16); }
DEV float bf_hi(unsigned w) { return __builtin_bit_cast(float, w & 0xffff0000u); }
DEV float bf1(bf16 h) { return __builtin_bit_cast(float, ((unsigned)h) << 16); }
template <int MSK> DEV float swz_xor(float v) { return __builtin_bit_cast(float, __builtin_amdgcn_ds_swizzle(__builtin_bit_cast(int, v), (MSK << 10) | 0x1F)); }
DEV float part32_(float v) { int ln = (int)__builtin_amdgcn_mbcnt_hi(~0u, __builtin_amdgcn_mbcnt_lo(~0u, 0u)); asm volatile("" : "+v"(ln)); return __builtin_bit_cast(float, __builtin_amdgcn_ds_bpermute((ln ^ 32) << 2, __builtin_bit_cast(int, v))); }
DEV float sum32(float v) { return v + part32_(v); }
DEV float max32(float v) { return fmaxf(v, part32_(v)); }
DEV float partner32(float v, int hh) { (void)hh; return part32_(v); }
DEV float wave_sum(float v) { v += swz_xor<1>(v); v += swz_xor<2>(v); v += swz_xor<4>(v); v += swz_xor<8>(v); v += swz_xor<16>(v); return sum32(v); }
DEV float wave_max(float v) { v = fmaxf(v, swz_xor<1>(v)); v = fmaxf(v, swz_xor<2>(v)); v = fmaxf(v, swz_xor<4>(v)); v = fmaxf(v, swz_xor<8>(v)); v = fmaxf(v, swz_xor<16>(v)); return max32(v); }
DEV float sigmoid_f(float x) { return 1.f / (1.f + __expf(-x)); }
DEV float softplus_f(float x) { return fmaxf(x, 0.f) + log1pf(__expf(-fabsf(x))); }
DEV float gelu_tanh(float x) { const float u = 0.7978845608028654f * (x + 0.044715f * x * x * x); const float t = 1.f - 2.f / (1.f + __expf(2.f * u)); return 0.5f * x * (1.f + t); }
DEV float dot8(const v4u a, const v4u b) {
    float s = bf_lo(a.x) * bf_lo(b.x); s += bf_hi(a.x) * bf_hi(b.x);
    s += bf_lo(a.y) * bf_lo(b.y); s += bf_hi(a.y) * bf_hi(b.y);
    s += bf_lo(a.z) * bf_lo(b.z); s += bf_hi(a.z) * bf_hi(b.z);
    s += bf_lo(a.w) * bf_lo(b.w); s += bf_hi(a.w) * bf_hi(b.w);
    return s;
}

#define XB_TMO      128
#define XB_XCNT(j)  (256  + 64 * (j))
#define XB_XSUB(j)  (1280 + 64 * (j))
#define XB_XGEN(j)  (2304 + 64 * (j))
#define XB_TOP      3328
#define XB_TOPGEN   3392
#define XCD_BAR_WORDS 3456
#define XB_SPIN_CAP (1u << 18)

__device__ __forceinline__ unsigned xb_ld(unsigned* p)              { return __hip_atomic_load(p, __ATOMIC_RELAXED, __HIP_MEMORY_SCOPE_AGENT); }
__device__ __forceinline__ unsigned xb_add(unsigned* p, unsigned v) { return __hip_atomic_fetch_add(p, v, __ATOMIC_RELAXED, __HIP_MEMORY_SCOPE_AGENT); }
__device__ __forceinline__ unsigned xb_xcc_id() { return (unsigned)__builtin_amdgcn_s_getreg((3 << 11) | 20) & 0xFu; }
#define XB_SPIN(cond, bar) do { unsigned _sp = 0; while (cond) { __builtin_amdgcn_s_sleep(1); \
    if ((++_sp & 255u) == 0u) { if (xb_ld(&(bar)[XB_TMO])) break; if (_sp > XB_SPIN_CAP) { atomicAdd(&(bar)[XB_TMO], 1u); break; } } } } while (0)

struct XcdBarrier {
    unsigned* bar; unsigned x;
    volatile LAS unsigned* st;
};
__device__ __forceinline__ XcdBarrier xcd_barrier_post(unsigned* bar, volatile LAS unsigned* st) {
    XcdBarrier b; b.bar = bar; b.x = xb_xcc_id(); b.st = st;
    if (threadIdx.x == 0) (void)xb_add(&bar[XB_XCNT(b.x)], 1u);
    return b;
}
__device__ __forceinline__ void xcd_barrier_complete(unsigned* bar, unsigned x, unsigned& nloc, unsigned& nx) {
    const unsigned G = gridDim.x * gridDim.y * gridDim.z;
    unsigned sum, cnt, mine, sp = 0u;
    for (;;) {
        sum = 0u; cnt = 0u; mine = 0u;
#pragma unroll
        for (unsigned j = 0; j < 16; ++j) { const unsigned c = xb_ld(&bar[XB_XCNT(j)]); sum += c; cnt += (c > 0u) ? 1u : 0u; mine = (j == x) ? c : mine; }
        if (sum == G) break;
        __builtin_amdgcn_s_sleep(1);
        if ((++sp & 255u) == 0u) { if (xb_ld(&bar[XB_TMO])) break; if (sp > XB_SPIN_CAP) { atomicAdd(&bar[XB_TMO], 1u); break; } }
    }
    nloc = mine > 0u ? mine : 1u; nx = cnt > 0u ? cnt : 1u;
}
__device__ __forceinline__ void xcd_barrier(const XcdBarrier& b) {
    asm volatile("s_waitcnt vmcnt(0)" ::: "memory");
    __syncthreads();
    if (threadIdx.x == 0) {
        unsigned* bar = b.bar;
        __builtin_amdgcn_s_waitcnt(0);
        unsigned nloc = b.st[0], nx = b.st[1];
        if (nloc == 0u) { xcd_barrier_complete(bar, b.x, nloc, nx); b.st[0] = nloc; b.st[1] = nx; }
        const unsigned old = xb_add(&bar[XB_XSUB(b.x)], 1u);
        const unsigned gen = old / nloc;
        if (old + 1u == (gen + 1u) * nloc) {
            __builtin_amdgcn_fence(__ATOMIC_RELEASE, "agent");
            asm volatile("s_waitcnt vmcnt(0)" ::: "memory");
            const unsigned og = xb_add(&bar[XB_TOP], 1u);
            const unsigned tg = og / nx;
            if (og + 1u == (tg + 1u) * nx) xb_add(&bar[XB_TOPGEN], 1u);
            else XB_SPIN(xb_ld(&bar[XB_TOPGEN]) == tg, bar);
            __builtin_amdgcn_fence(__ATOMIC_ACQUIRE, "agent");
            xb_add(&bar[XB_XGEN(b.x)], 1u);
            asm volatile("s_waitcnt vmcnt(0)" ::: "memory");
        } else {
            XB_SPIN(xb_ld(&bar[XB_XGEN(b.x)]) == gen, bar);
            __builtin_amdgcn_fence(__ATOMIC_ACQUIRE, "agent");
            asm volatile("s_waitcnt vmcnt(0)" ::: "memory");
        }
    }
    __syncthreads();
}

struct EpiResGate {
    static constexpr bool PERM = false, AFTER_DRAIN = false;
    const float* X; float* O; const float* gate; float gscale;
    __device__ __forceinline__ void operator()(const pg8::f32x4 (&acc)[2][2][4][2], const pg8::Unit& u, int wr, int wc, int fr, int fq) const {
        const int row0 = u.pm * 256 + wr * 64 + fr, col0 = u.pn * 256 + wc * 32 + 4 * fq;
        const float* gp = gate + (size_t)((u.pm * 256) >> 12) * MODW;
        pg8::f32x4 gv[2][2];
#pragma unroll
        for (int bj = 0; bj < 2; ++bj)
#pragma unroll
            for (int n = 0; n < 2; ++n) gv[bj][n] = *(const pg8::f32x4*)(gp + col0 + bj * 128 + n * 16) * gscale;
#pragma unroll
        for (int ai = 0; ai < 2; ++ai)
#pragma unroll
            for (int m = 0; m < 4; ++m) {
                const size_t ro = (size_t)(row0 + ai * 128 + m * 16) * D + col0;
#pragma unroll
                for (int bj = 0; bj < 2; ++bj)
#pragma unroll
                    for (int n = 0; n < 2; ++n) {
                        const pg8::f32x4 xv = *(const pg8::f32x4*)(X + ro + bj * 128 + n * 16);
                        *(pg8::f32x4*)(O + ro + bj * 128 + n * 16) = xv + gv[bj][n] * acc[ai][bj][m][n];
                    }
            }
    }
};

DEV void ph_mod(const float* __restrict__ c, const float* __restrict__ w_mod, const float* __restrict__ b_mod, float* __restrict__ mod, LAS float* red, int vcu, int G, int tid) {
    const int lane = tid & 63, wave = tid >> 6;
    for (int it = vcu; it < 2 * 192; it += G) {
        const int l = it / 192, cb = it % 192;
        const int k0 = wave * 256;
        const float* W = w_mod + ((size_t)l * D + k0) * MODW + cb * 64 + lane;
        float a0 = 0.f, a1 = 0.f;
#pragma unroll 16
        for (int k = 0; k < 256; ++k) {
            const float w = W[(size_t)k * MODW];
            const float c0 = c[k0 + k], c1 = c[D + k0 + k];
            a0 += (c0 * sigmoid_f(c0)) * w; a1 += (c1 * sigmoid_f(c1)) * w;
        }
        red[(wave * 2 + 0) * 64 + lane] = a0; red[(wave * 2 + 1) * 64 + lane] = a1;
        __syncthreads();
        if (tid < 128) {
            const int b = tid >> 6, ln = tid & 63; float s = 0.f;
#pragma unroll
            for (int w = 0; w < 8; ++w) s += red[(w * 2 + b) * 64 + ln];
            const int col = cb * 64 + ln;
            mod[(size_t)(l * 2 + b) * MODW + col] = s + b_mod[l * MODW + col];
        }
        __syncthreads();
    }
}
DEV void transpose_item(const float* __restrict__ W, int K, int N, bf16* __restrict__ WT, LAS float* scr, int item, int lane) {
    const int nblk = N / 32, kb = item / nblk, nb = item % nblk, k0 = 64 * kb, n0 = 32 * nb;
#pragma unroll 8
    for (int i = 0; i < 32; ++i) { const int kk = 2 * i + (lane >> 5); scr[kk * 33 + (lane & 31)] = W[(size_t)(k0 + kk) * N + n0 + (lane & 31)]; }
    LDS_WAIT();
    const int c = lane & 7;
#pragma unroll
    for (int j = 0; j < 4; ++j) { const int n = (lane >> 3) + 8 * j; const LAS float* s = scr + (8 * c) * 33 + n;
        v4u o; o.x = pk2(s[0 * 33], s[1 * 33]); o.y = pk2(s[2 * 33], s[3 * 33]); o.z = pk2(s[4 * 33], s[5 * 33]); o.w = pk2(s[6 * 33], s[7 * 33]);
        *(v4u*)(WT + (size_t)(n0 + n) * K + k0 + 8 * c) = o; }
    LDS_WAIT();
}
DEV void convert_copy(const float* __restrict__ src, bf16* __restrict__ dst, size_t ngroups8, size_t gtid, size_t gstride) {
    for (size_t g = gtid; g < ngroups8; g += gstride) {
        const f32x4 a = *(const f32x4*)(src + g * 8), b = *(const f32x4*)(src + g * 8 + 4);
        v4u o; o.x = pk2(a.x, a.y); o.y = pk2(a.z, a.w); o.z = pk2(b.x, b.y); o.w = pk2(b.z, b.w);
        *(v4u*)(dst + g * 8) = o;
    }
}

DEV void modnorm_rows(const float* __restrict__ X, const float* __restrict__ gain, const float* __restrict__ modl, int sh_off, int sc_off, bf16* __restrict__ H, int gw, int NGW, int lane) {
    for (int m = gw; m < M; m += NGW) {
        const int b = m >> 12;
        const f32x4* xr = (const f32x4*)(X + (size_t)m * D) + lane;
        f32x4 v[8]; float s = 0.f;
#pragma unroll
        for (int j = 0; j < 8; ++j) { v[j] = xr[64 * j]; s += (v[j].x * v[j].x + v[j].y * v[j].y) + (v[j].z * v[j].z + v[j].w * v[j].w); }
        const float r = rsqrtf(wave_sum(s) * (1.f / D) + EPS);
        const f32x4* g4 = (const f32x4*)gain + lane;
        const f32x4* sc4 = (const f32x4*)(modl + (size_t)b * MODW + sc_off) + lane;
        const f32x4* sh4 = (const f32x4*)(modl + (size_t)b * MODW + sh_off) + lane;
        unsigned long long* o8 = (unsigned long long*)(H + (size_t)m * D) + lane;
#pragma unroll
        for (int j = 0; j < 8; ++j) {
            const f32x4 g = g4[64 * j], sc = sc4[64 * j], sh = sh4[64 * j];
            const f32x4 y = (v[j] * r) * g * (sc + 1.f) + sh;
            o8[64 * j] = (unsigned long long)pk2(y.x, y.y) | ((unsigned long long)pk2(y.z, y.w) << 32);
        }
    }
}

DEV void lru_item(int l, int b, int j, int n, const bf16* __restrict__ Z, const float* __restrict__ conv_w, const float* __restrict__ conv_b,
                  const float* __restrict__ w_rec, const float* __restrict__ b_rec, const float* __restrict__ w_gi, const float* __restrict__ b_gi, const float* __restrict__ lam,
                  float* __restrict__ HLOC, float* __restrict__ PP, float* __restrict__ SUMA, float* __restrict__ SUMB, LAS float* xc, LAS float* aL, LAS float* uL, int tid) {
    const int ch = tid & 127, tq = tid >> 7, c = n * 128 + ch;
    {
        const float cw0 = conv_w[(l * 4 + 0) * LRU_W + c], cw1 = conv_w[(l * 4 + 1) * LRU_W + c], cw2 = conv_w[(l * 4 + 2) * LRU_W + c], cw3 = conv_w[(l * 4 + 3) * LRU_W + c];
        const float cb = conv_b[l * LRU_W + c];
#pragma unroll 4
        for (int i = 0; i < 16; ++i) {
            const int tok = tq + 4 * i, t = j * 64 + tok;
            const bf16* zp = Z + ((size_t)b * SEQ + t) * IN_W + ZO_XA + c;
            float s = cb + cw3 * bf1(zp[0]);
            if (t >= 1) s += cw2 * bf1(zp[-(ptrdiff_t)IN_W]);
            if (t >= 2) s += cw1 * bf1(zp[-(ptrdiff_t)2 * IN_W]);
            if (t >= 3) s += cw0 * bf1(zp[-(ptrdiff_t)3 * IN_W]);
            xc[tok * 128 + ch] = s;
        }
    }
    __syncthreads();
    float accr[16], acci[16];
#pragma unroll
    for (int i = 0; i < 16; ++i) { accr[i] = 0.f; acci[i] = 0.f; }
    const float* Wr = w_rec + ((size_t)(l * 6 + n) * 128) * 128 + ch;
    const float* Wi = w_gi + ((size_t)(l * 6 + n) * 128) * 128 + ch;
#pragma unroll 2
    for (int jj = 0; jj < 128; ++jj) {
        const float wr = Wr[jj * 128], wi = Wi[jj * 128];
#pragma unroll
        for (int i = 0; i < 16; ++i) { const float x = xc[(tq + 4 * i) * 128 + jj]; accr[i] += x * wr; acci[i] += x * wi; }
    }
    {
        const float br = b_rec[l * LRU_W + c], bi = b_gi[l * LRU_W + c], sp = softplus_f(-lam[l * LRU_W + c]);
#pragma unroll
        for (int i = 0; i < 16; ++i) {
            const int tok = tq + 4 * i;
            const float r = sigmoid_f(accr[i] + br), ig = sigmoid_f(acci[i] + bi);
            const float log_a = -8.0f * r * sp;
            const float av = __expf(log_a);
            const float x = xc[tok * 128 + ch];
            const float uv = sqrtf(fmaxf(-expm1f(2.f * log_a), 0.f)) * (ig * x);
            aL[tok * 128 + ch] = av; uL[tok * 128 + ch] = uv;
        }
    }
    __syncthreads();
    if (tid < 128) {
        float h = 0.f, P = 1.f;
        const size_t rb = ((size_t)b * SEQ + j * 64) * LRU_W + n * 128 + tid;
        for (int tok = 0; tok < 64; ++tok) {
            const float av = aL[tok * 128 + tid];
            h = av * h + uL[tok * 128 + tid]; P *= av;
            HLOC[rb + (size_t)tok * LRU_W] = h; PP[rb + (size_t)tok * LRU_W] = P;
        }
        SUMA[(size_t)(b * 64 + j) * LRU_W + n * 128 + tid] = P; SUMB[(size_t)(b * 64 + j) * LRU_W + n * 128 + tid] = h;
    }
    __syncthreads();
}

DEV void dil_item(int b, int h, int t, const bf16* __restrict__ Z, const float* __restrict__ rel_bias, float* __restrict__ YB, LAS float* qs, LAS float* lg, int lane) {
    const size_t row = (size_t)b * SEQ + t;
    { const unsigned w = *(const unsigned*)(Z + row * IN_W + ZO_QB + h * 128 + 2 * lane); qs[2 * lane] = bf_lo(w) * QSCALE; qs[2 * lane + 1] = bf_hi(w) * QSCALE; }
    LDS_WAIT();
    float mx = NEGBIG;
#pragma unroll
    for (int p = 0; p < 3; ++p) {
        const int d = 1 << (2 * p);
        for (int jj = lane; jj < 129; jj += 64) {
            const int pos = t - jj * d; float lgt = NEGBIG;
            if (pos >= 0) {
                const v4u* kr = (const v4u*)(Z + ((size_t)b * SEQ + pos) * IN_W + ZO_KB + h * 128);
                float s = 0.f;
#pragma unroll 4
                for (int c8 = 0; c8 < 16; ++c8) { const v4u kv = kr[c8]; const LAS float* q = qs + c8 * 8;
                    s += q[0] * bf_lo(kv.x) + q[1] * bf_hi(kv.x) + q[2] * bf_lo(kv.y) + q[3] * bf_hi(kv.y) + q[4] * bf_lo(kv.z) + q[5] * bf_hi(kv.z) + q[6] * bf_lo(kv.w) + q[7] * bf_hi(kv.w); }
                lgt = s + rel_bias[(int)T5B[p][jj] * 6 + h];
            }
            lg[p * 129 + jj] = lgt; mx = fmaxf(mx, lgt);
        }
    }
    mx = wave_max(mx);
    LDS_WAIT();
    float sum = 0.f;
    for (int idx = lane; idx < 387; idx += 64) { const float v = lg[idx]; const float pv = (v > -1.0e37f) ? __expf(v - mx) : 0.f; lg[idx] = pv; sum += pv; }
    sum = wave_sum(sum);
    LDS_WAIT();
    float a0 = 0.f, a1 = 0.f;
#pragma unroll
    for (int p = 0; p < 3; ++p) {
        const int d = 1 << (2 * p);
        int nk = t / d + 1; nk = nk > 129 ? 129 : nk;
        const bf16* vb = Z + row * IN_W + ZO_VB + h * 128 + 2 * lane;
#pragma unroll 4
        for (int jj = 0; jj < nk; ++jj) {
            const float pv = lg[p * 129 + jj];
            const unsigned w = *(const unsigned*)(vb - (size_t)jj * d * IN_W);
            a0 += pv * bf_lo(w); a1 += pv * bf_hi(w);
        }
    }
    const float inv = 1.f / sum;
    *(f32x2*)(YB + row * SWA_W + h * 128 + 2 * lane) = (f32x2){a0 * inv, a1 * inv};
    LDS_WAIT();
}


DEV unsigned cvtpk_bf16(float lo, float hi) { f32x2 v = {lo, hi}; bf16x2_t b = __builtin_convertvector(v, bf16x2_t); return __builtin_bit_cast(unsigned, b); }
constexpr int DIL_VSTR = 256;
constexpr int ATT_KOFF = 32 * DIL_VSTR;
constexpr int ATT_BOFF = ATT_KOFF + 8192;
constexpr int DIL_QOFF = ATT_BOFF + 132 * 4;
constexpr int ATT_WLDS = 17920;
static_assert(DIL_QOFF <= ATT_WLDS && 8 * ATT_WLDS <= LDS_MISC, "attention LDS");

DEV unsigned vimg_off(unsigned row, unsigned ch) { return 256u * row + 16u * (ch ^ (((row & 3u) << 2) | ((row >> 2) & 3u))); }
typedef short s16x4 __attribute__((ext_vector_type(4)));
DEV bf16x8 vfrag_tr(LAS unsigned char* img, int lane, int c, int ks) {
    const unsigned h = lane >> 5, blk = (lane >> 4) & 1, qq = (lane & 15) >> 2, pp = lane & 3;
    const s16x4 a = __builtin_amdgcn_ds_read_tr16_b64_v4i16((LAS s16x4*)(img + vimg_off(16 * ks + 8 * h + 0 + qq, 4 * c + 2 * blk + (pp >> 1)) + 8 * (pp & 1)));
    const s16x4 b = __builtin_amdgcn_ds_read_tr16_b64_v4i16((LAS s16x4*)(img + vimg_off(16 * ks + 8 * h + 4 + qq, 4 * c + 2 * blk + (pp >> 1)) + 8 * (pp & 1)));
    return __builtin_shufflevector(a, b, 0, 1, 2, 3, 4, 5, 6, 7);
}
DEV void dil_mfma_item(int b, int h, int p, int rr, int i0, const bf16* __restrict__ Z, const float* __restrict__ rel_bias, float* __restrict__ PART, float* __restrict__ LSE, LAS unsigned char* wl, int lane) {
    asm volatile("" : "+v"(lane));
    const int r = lane & 31, hh = lane >> 5;
    const int d = 1 << (2 * p);
    LAS float* biasL = (LAS float*)(wl + ATT_BOFF);
    for (int dd = lane; dd < 129; dd += 64) biasL[dd] = rel_bias[(int)T5B[p][dd] * 6 + h];
    const size_t rowq = (size_t)b * SEQ + rr + d * (i0 + r);
    bf16x8 qf[8];
    { const bf16* qrow = Z + rowq * IN_W + ZO_QB + h * 128 + 8 * hh;
#pragma unroll
      for (int ks = 0; ks < 8; ++ks) qf[ks] = *(const bf16x8*)(qrow + 16 * ks); }
    float m_run = NEGBIG, l_run = 0.f;
    f32x16 o[4];
#pragma unroll
    for (int dt = 0; dt < 4; ++dt)
#pragma unroll
        for (int e = 0; e < 16; ++e) o[dt][e] = 0.f;
    const int kap = (r & 0x13) | ((r & 4) << 1) | ((r & 8) >> 1);
    int jt = 4 - (i0 >> 5); jt = jt < 0 ? 0 : jt;
#define DIL_DMA_K(JT) do { int jk = i0 - 128 + 32 * (JT) + kap; jk = jk < 0 ? 0 : jk; const bf16* krow = Z + ((size_t)b * SEQ + rr + d * jk) * IN_W + ZO_KB + h * 128 + 8 * hh; \
        _Pragma("unroll") for (int ks = 0; ks < 8; ++ks) __builtin_amdgcn_global_load_lds((const unsigned*)(krow + 16 * ks), (LAS unsigned*)(wl + ATT_KOFF + 1024 * ks), 16, 0, 0); } while (0)
#define DIL_DMA_V(JT) do { const int j0_ = i0 - 128 + 32 * (JT); _Pragma("unroll") for (int q = 0; q < 8; ++q) { const int pi = lane + 64 * q, kl = pi >> 4, c = (pi & 15) ^ (((kl & 3) << 2) | ((kl >> 2) & 3)); int j = j0_ + kl; j = j < 0 ? 0 : j; \
        __builtin_amdgcn_global_load_lds((const unsigned*)(Z + ((size_t)b * SEQ + rr + d * j) * IN_W + ZO_VB + h * 128 + 8 * c), (LAS unsigned*)(wl + 1024 * q), 16, 0, 0); } } while (0)
    LDS_WAIT();
    DIL_DMA_K(jt); DIL_DMA_V(jt);
    for (; jt < 5; ++jt) {
        const int j0 = i0 - 128 + 32 * jt;
        const int jn = jt < 4 ? jt + 1 : 4;
        asm volatile("s_waitcnt vmcnt(8)" ::: "memory");
        f32x16 sacc;
#pragma unroll
        for (int e = 0; e < 16; ++e) sacc[e] = 0.f;
        {
            bf16x8 kf[8];
#pragma unroll
            for (int ks = 0; ks < 8; ++ks) kf[ks] = *((const LAS bf16x8*)(wl + ATT_KOFF + 1024 * ks) + lane);
#pragma unroll
            for (int ks = 0; ks < 8; ++ks) sacc = __builtin_amdgcn_mfma_f32_32x32x16_bf16(kf[ks], qf[ks], sacc, 0, 0, 0);
        }
        LDS_WAIT();
        DIL_DMA_K(jn);
        float tm = NEGBIG;
#pragma unroll
        for (int e = 0; e < 16; ++e) {
            const int j = j0 + 16 * (e >> 3) + 8 * hh + (e & 7);
            const int dist = (i0 + r) - j;
            const bool valid = (j >= 0) && (dist >= 0) && (dist <= 128);
            const int dc = dist < 0 ? 0 : (dist > 128 ? 128 : dist);
            const float bv = biasL[dc];
            const float lg = valid ? sacc[e] * QSCALE + bv : NEGBIG;
            sacc[e] = lg; tm = fmaxf(tm, lg);
        }
        tm = max32(tm);
        const float m_new = fmaxf(m_run, tm);
        const float alpha = __expf(m_run - m_new);
        float ps = 0.f;
#pragma unroll
        for (int e = 0; e < 16; ++e) { const float pv = (sacc[e] > -1.0e37f) ? __expf(sacc[e] - m_new) : 0.f; sacc[e] = pv; ps += pv; }
        ps = sum32(ps);
        l_run = l_run * alpha + ps; m_run = m_new;
#pragma unroll
        for (int dt = 0; dt < 4; ++dt)
#pragma unroll
            for (int e = 0; e < 16; ++e) o[dt][e] *= alpha;
        bf16x8 pf[2];
#pragma unroll
        for (int s2 = 0; s2 < 2; ++s2) { v4u w; w.x = cvtpk_bf16(sacc[8 * s2 + 0], sacc[8 * s2 + 1]); w.y = cvtpk_bf16(sacc[8 * s2 + 2], sacc[8 * s2 + 3]);
            w.z = cvtpk_bf16(sacc[8 * s2 + 4], sacc[8 * s2 + 5]); w.w = cvtpk_bf16(sacc[8 * s2 + 6], sacc[8 * s2 + 7]); pf[s2] = __builtin_bit_cast(bf16x8, w); }
        asm volatile("s_waitcnt vmcnt(8)" ::: "memory");
#pragma unroll
        for (int dt = 0; dt < 4; ++dt)
#pragma unroll
            for (int s2 = 0; s2 < 2; ++s2) o[dt] = __builtin_amdgcn_mfma_f32_32x32x16_bf16(vfrag_tr(wl, lane, dt, s2), pf[s2], o[dt], 0, 0, 0);
        LDS_WAIT();
        DIL_DMA_V(jn);
    }
    asm volatile("s_waitcnt vmcnt(0)" ::: "memory");
#undef DIL_DMA_V
#undef DIL_DMA_K
    const float inv = 1.f / l_run;
    float* po = PART + ((size_t)p * M + rowq) * SWA_W + h * 128;
#pragma unroll
    for (int dt = 0; dt < 4; ++dt)
#pragma unroll
        for (int g = 0; g < 4; ++g)
            *(f32x4*)(po + 32 * dt + 8 * g + 4 * hh) = (f32x4){o[dt][4 * g + 0] * inv, o[dt][4 * g + 1] * inv, o[dt][4 * g + 2] * inv, o[dt][4 * g + 3] * inv};
    if (hh == 0) LSE[((size_t)p * M + rowq) * 6 + h] = m_run + __logf(l_run);
}

DEV void sb_item(int b, int h, int t, const bf16* __restrict__ Z, float* __restrict__ YC, LAS float* qs, LAS float* pA, int lane) {
    const size_t row = (size_t)b * SEQ + t;
    { const unsigned w = *(const unsigned*)(Z + row * IN_W + ZO_QC + h * 128 + 2 * lane); qs[2 * lane] = bf_lo(w) * QSCALE; qs[2 * lane + 1] = bf_hi(w) * QSCALE; }
    LDS_WAIT();
    float carry = 0.f, a0 = 0.f, a1 = 0.f;
    for (int shi = t - 1; shi >= 0; shi -= 64) {
        const int s = shi - lane; const bool valid = s >= 0;
        float z = 0.f;
        if (valid) {
            const v4u* kr = (const v4u*)(Z + ((size_t)b * SEQ + s) * IN_W + ZO_KC + h * 128);
#pragma unroll 4
            for (int c8 = 0; c8 < 16; ++c8) { const v4u kv = kr[c8]; const LAS float* q = qs + c8 * 8;
                z += q[0] * bf_lo(kv.x) + q[1] * bf_hi(kv.x) + q[2] * bf_lo(kv.y) + q[3] * bf_hi(kv.y) + q[4] * bf_lo(kv.z) + q[5] * bf_hi(kv.z) + q[6] * bf_lo(kv.w) + q[7] * bf_hi(kv.w); }
        }
        const float l1m = valid ? -softplus_f(z) : 0.f;
        float inc = l1m;
#pragma unroll
        for (int o = 1; o < 64; o <<= 1) { const float tmp = __shfl_up(inc, o); if (lane >= o) inc += tmp; }
        const float A = valid ? __expf(-softplus_f(-z) + carry + (inc - l1m)) : 0.f;
        carry += __shfl(inc, 63);
        pA[lane] = A;
        const bool done = carry < -105.0f;
        LDS_WAIT();
        const int nk = (shi + 1) < 64 ? (shi + 1) : 64;
        const bf16* vb = Z + ((size_t)b * SEQ + shi) * IN_W + ZO_VC + h * 128 + 2 * lane;
#pragma unroll 4
        for (int i = 0; i < nk; ++i) {
            const float pv = pA[i];
            const unsigned w = *(const unsigned*)(vb - (size_t)i * IN_W);
            a0 += pv * bf_lo(w); a1 += pv * bf_hi(w);
        }
        LDS_WAIT();
        if (done) break;
    }
    *(f32x2*)(YC + row * SB_W + h * 128 + 2 * lane) = (f32x2){a0, a1};
}


DEV void lru_item2(int l, int b, int j, int n, const bf16* __restrict__ Z, const float* __restrict__ conv_w, const float* __restrict__ conv_b, const bf16* __restrict__ WGT,
                   const float* __restrict__ b_rec, const float* __restrict__ b_gi, const float* __restrict__ lam,
                   float* __restrict__ HLOC, float* __restrict__ PP, float* __restrict__ SUMA, float* __restrict__ SUMB, LAS float* xc, LAS float* g0L, LAS float* g1L, int tid) {
    const int ch = tid & 127, tq = tid >> 7, c = n * 128 + ch;
    {
        const float cw0 = conv_w[(l * 4 + 0) * LRU_W + c], cw1 = conv_w[(l * 4 + 1) * LRU_W + c], cw2 = conv_w[(l * 4 + 2) * LRU_W + c], cw3 = conv_w[(l * 4 + 3) * LRU_W + c];
        const float cb = conv_b[l * LRU_W + c];
#pragma unroll 4
        for (int i = 0; i < 16; ++i) {
            const int tok = tq + 4 * i, t = j * 64 + tok;
            const bf16* zp = Z + ((size_t)b * SEQ + t) * IN_W + ZO_XA + c;
            float s = cb + cw3 * bf1(zp[0]);
            if (t >= 1) s += cw2 * bf1(zp[-(ptrdiff_t)IN_W]);
            if (t >= 2) s += cw1 * bf1(zp[-(ptrdiff_t)2 * IN_W]);
            if (t >= 3) s += cw0 * bf1(zp[-(ptrdiff_t)3 * IN_W]);
            xc[tok * 132 + ch] = s;
        }
    }
    __syncthreads();
    {
        const int lane = tid & 63, wave = tid >> 6, r = lane & 31, hh = lane >> 5, g = wave >> 2, ct = wave & 3;
        const bf16* wp = WGT + (((size_t)(l * 6 + n) * 2 + g) * 128 + ct * 32 + r) * 128 + 8 * hh;
        bf16x8 bfr[8];
#pragma unroll
        for (int ks = 0; ks < 8; ++ks) bfr[ks] = *(const bf16x8*)(wp + 16 * ks);
        LAS float* gL = g ? g1L : g0L;
#pragma unroll
        for (int rt = 0; rt < 2; ++rt) {
            f32x16 acc;
#pragma unroll
            for (int e = 0; e < 16; ++e) acc[e] = 0.f;
#pragma unroll
            for (int ks = 0; ks < 8; ++ks) {
                const LAS float* xp = xc + (32 * rt + r) * 132 + 16 * ks + 8 * hh;
                const f32x4 x0 = *(const LAS f32x4*)xp, x1 = *(const LAS f32x4*)(xp + 4);
                v4u w; w.x = cvtpk_bf16(x0.x, x0.y); w.y = cvtpk_bf16(x0.z, x0.w); w.z = cvtpk_bf16(x1.x, x1.y); w.w = cvtpk_bf16(x1.z, x1.w);
                acc = __builtin_amdgcn_mfma_f32_32x32x16_bf16(__builtin_bit_cast(bf16x8, w), bfr[ks], acc, 0, 0, 0);
            }
#pragma unroll
            for (int e = 0; e < 16; ++e) { const int tok = 32 * rt + (e & 3) + 8 * (e >> 2) + 4 * hh; gL[tok * 132 + ct * 32 + r] = acc[e]; }
        }
    }
    __syncthreads();
    {
        const float br = b_rec[l * LRU_W + c], bi = b_gi[l * LRU_W + c], sp = softplus_f(-lam[l * LRU_W + c]);
#pragma unroll 4
        for (int i = 0; i < 16; ++i) {
            const int tok = tq + 4 * i;
            const float rg = sigmoid_f(g0L[tok * 132 + ch] + br), ig = sigmoid_f(g1L[tok * 132 + ch] + bi);
            const float log_a = -8.0f * rg * sp;
            const float av = __expf(log_a);
            const float x = xc[tok * 132 + ch];
            const float uv = sqrtf(fmaxf(-expm1f(2.f * log_a), 0.f)) * (ig * x);
            g0L[tok * 132 + ch] = av; g1L[tok * 132 + ch] = uv;
        }
    }
    __syncthreads();
    if (tid < 128) {
        float h = 0.f, P = 1.f;
        const size_t rb = ((size_t)b * SEQ + j * 64) * LRU_W + n * 128 + tid;
#pragma unroll 8
        for (int tok = 0; tok < 64; ++tok) {
            const float av = g0L[tok * 132 + tid];
            h = av * h + g1L[tok * 132 + tid]; P *= av;
            HLOC[rb + (size_t)tok * LRU_W] = h; PP[rb + (size_t)tok * LRU_W] = P;
        }
        SUMA[(size_t)(b * 64 + j) * LRU_W + n * 128 + tid] = P; SUMB[(size_t)(b * 64 + j) * LRU_W + n * 128 + tid] = h;
    }
    __syncthreads();
}

DEV void sb_mfma_item(int b, int h, int t0, const bf16* __restrict__ Z, float* __restrict__ YC, LAS unsigned char* wl, int lane) {
    asm volatile("" : "+v"(lane));
    const int r = lane & 31, hh = lane >> 5;
    const size_t rowq = (size_t)b * SEQ + t0 + r;
    bf16x8 qf[8];
    { const bf16* qrow = Z + rowq * IN_W + ZO_QC + h * 128 + 8 * hh;
#pragma unroll
      for (int ks = 0; ks < 8; ++ks) qf[ks] = *(const bf16x8*)(qrow + 16 * ks); }
    f32x16 o[4];
#pragma unroll
    for (int dt = 0; dt < 4; ++dt)
#pragma unroll
        for (int e = 0; e < 16; ++e) o[dt][e] = 0.f;
    const int kap = (r & 0x13) | ((r & 4) << 1) | ((r & 8) >> 1);
    float carry = 0.f;
#define SB_DMA_K(K0) do { const bf16* krow = Z + ((size_t)b * SEQ + (K0) + kap) * IN_W + ZO_KC + h * 128 + 8 * hh; \
        _Pragma("unroll") for (int ks = 0; ks < 8; ++ks) __builtin_amdgcn_global_load_lds((const unsigned*)(krow + 16 * ks), (LAS unsigned*)(wl + ATT_KOFF + 1024 * ks), 16, 0, 0); } while (0)
#define SB_DMA_V(K0) do { _Pragma("unroll") for (int q = 0; q < 8; ++q) { const int pi = lane + 64 * q, kl = pi >> 4, c = (pi & 15) ^ (((kl & 3) << 2) | ((kl >> 2) & 3)); \
        __builtin_amdgcn_global_load_lds((const unsigned*)(Z + ((size_t)b * SEQ + (K0) + kl) * IN_W + ZO_VC + h * 128 + 8 * c), (LAS unsigned*)(wl + 1024 * q), 16, 0, 0); } } while (0)
    LDS_WAIT();
    SB_DMA_K(t0); SB_DMA_V(t0);
    for (int k0 = t0; k0 >= 0; k0 -= 32) {
        const int kn = k0 >= 32 ? k0 - 32 : 0;
        asm volatile("s_waitcnt vmcnt(8)" ::: "memory");
        f32x16 sacc;
#pragma unroll
        for (int e = 0; e < 16; ++e) sacc[e] = 0.f;
        {
            bf16x8 kf[8];
#pragma unroll
            for (int ks = 0; ks < 8; ++ks) kf[ks] = *((const LAS bf16x8*)(wl + ATT_KOFF + 1024 * ks) + lane);
#pragma unroll
            for (int ks = 0; ks < 8; ++ks) sacc = __builtin_amdgcn_mfma_f32_32x32x16_bf16(kf[ks], qf[ks], sacc, 0, 0, 0);
        }
        LDS_WAIT();
        SB_DMA_K(kn);
        float l1[16]; float T0 = 0.f, T1 = 0.f;
#pragma unroll
        for (int e = 0; e < 16; ++e) {
            const int key = k0 + 16 * (e >> 3) + 8 * hh + (e & 7);
            const bool valid = key < t0 + r;
            const float z = sacc[e] * QSCALE;
            sacc[e] = z;
            l1[e] = valid ? -(fmaxf(z, 0.f) + __logf(1.f + __expf(-fabsf(z)))) : 0.f;
        }
#pragma unroll
        for (int e = 0; e < 8; ++e) { T0 += l1[e]; T1 += l1[8 + e]; }
        const float PT0 = partner32(T0, hh), PT1 = partner32(T1, hh);
        const float base1 = carry + (hh ? 0.f : PT1);
        const float base0 = carry + (hh ? (T1 + PT1) : (PT1 + T1 + PT0));
        float run1 = base1, run0 = base0;
#pragma unroll
        for (int e = 7; e >= 0; --e) {
            { const int key = k0 + 16 + 8 * hh + e; const bool valid = key < t0 + r; const float a = valid ? __expf(sacc[8 + e] + l1[8 + e] + run1) : 0.f; run1 += l1[8 + e]; sacc[8 + e] = a; }
            { const int key = k0 + 8 * hh + e; const bool valid = key < t0 + r; const float a = valid ? __expf(sacc[e] + l1[e] + run0) : 0.f; run0 += l1[e]; sacc[e] = a; }
        }
        carry += (T0 + T1) + (PT0 + PT1);
        bf16x8 pf[2];
#pragma unroll
        for (int s2 = 0; s2 < 2; ++s2) { v4u w; w.x = cvtpk_bf16(sacc[8 * s2 + 0], sacc[8 * s2 + 1]); w.y = cvtpk_bf16(sacc[8 * s2 + 2], sacc[8 * s2 + 3]);
            w.z = cvtpk_bf16(sacc[8 * s2 + 4], sacc[8 * s2 + 5]); w.w = cvtpk_bf16(sacc[8 * s2 + 6], sacc[8 * s2 + 7]); pf[s2] = __builtin_bit_cast(bf16x8, w); }
        asm volatile("s_waitcnt vmcnt(8)" ::: "memory");
#pragma unroll
        for (int dt = 0; dt < 4; ++dt)
#pragma unroll
            for (int s2 = 0; s2 < 2; ++s2) o[dt] = __builtin_amdgcn_mfma_f32_32x32x16_bf16(vfrag_tr(wl, lane, dt, s2), pf[s2], o[dt], 0, 0, 0);
        LDS_WAIT();
        SB_DMA_V(kn);
        if (__all(carry < -105.0f)) break;
    }
    asm volatile("s_waitcnt vmcnt(0)" ::: "memory");
#undef SB_DMA_V
#undef SB_DMA_K
    float* po = YC + rowq * SB_W + h * 128;
#pragma unroll
    for (int dt = 0; dt < 4; ++dt)
#pragma unroll
        for (int g = 0; g < 4; ++g)
            *(f32x4*)(po + 32 * dt + 8 * g + 4 * hh) = (f32x4){o[dt][4 * g + 0], o[dt][4 * g + 1], o[dt][4 * g + 2], o[dt][4 * g + 3]};
}

DEV void combine_item(int l, int b, int j, int half, const bf16* __restrict__ Z, const float* __restrict__ HLOC, const float* __restrict__ PP, const float* __restrict__ SUMA, const float* __restrict__ SUMB,
                      const float* __restrict__ PART, const float* __restrict__ LSE, const float* __restrict__ YC, const float* __restrict__ g_lru, const float* __restrict__ g_swa, const float* __restrict__ g_sb,
                      bf16* __restrict__ Y, LAS float* carryL, int tid) {
    const int lane = tid & 63, wave = tid >> 6;
    for (int c = tid; c < LRU_W; c += 512) {
        float cr = 0.f;
        for (int i = 0; i < j; ++i) cr = SUMA[(size_t)(b * 64 + i) * LRU_W + c] * cr + SUMB[(size_t)(b * 64 + i) * LRU_W + c];
        carryL[c] = cr;
    }
    __syncthreads();
    for (int i = 0; i < 4; ++i) {
        const int tok = half * 32 + wave * 4 + i;
        const size_t row = (size_t)b * SEQ + j * 64 + tok;
        bf16* yo = Y + row * D;
        {
            float ya[12]; float ssq = 0.f;
#pragma unroll
            for (int e = 0; e < 12; ++e) { const int c = lane + 64 * e;
                const float hv = HLOC[row * LRU_W + c] + PP[row * LRU_W + c] * carryL[c];
                const float ga = bf1(Z[row * IN_W + ZO_GA + c]);
                ya[e] = hv * gelu_tanh(ga); ssq += ya[e] * ya[e]; }
            const float r = rsqrtf(wave_sum(ssq) * (1.f / LRU_W) + EPS);
#pragma unroll
            for (int e = 0; e < 12; ++e) { const int c = lane + 64 * e; yo[c] = (MK_DBG & 16) ? (bf16)0 : (bf16)f2bf(ya[e] * r * g_lru[l * LRU_W + c]); }
        }
        {
            float yb[12]; float ssq = 0.f;
            float wgt[3][2];
            (void)wgt;
#pragma unroll
            for (int e = 0; e < 12; ++e) { const int c = lane + 64 * e; const int hd = c >> 7;
                const float l0 = LSE[((size_t)0 * M + row) * 6 + hd], l1 = LSE[((size_t)1 * M + row) * 6 + hd], l2 = LSE[((size_t)2 * M + row) * 6 + hd];
                const float mx = fmaxf(l0, fmaxf(l1, l2)); const float e0 = __expf(l0 - mx), e1 = __expf(l1 - mx), e2 = __expf(l2 - mx); const float iz = 1.f / (e0 + e1 + e2);
                yb[e] = (e0 * PART[((size_t)0 * M + row) * SWA_W + c] + e1 * PART[((size_t)1 * M + row) * SWA_W + c] + e2 * PART[((size_t)2 * M + row) * SWA_W + c]) * iz;
                ssq += yb[e] * yb[e]; }
            const float r = rsqrtf(wave_sum(ssq) * (1.f / SWA_W) + EPS);
#pragma unroll
            for (int e = 0; e < 12; ++e) { const int c = lane + 64 * e; yo[LRU_W + c] = (MK_DBG & 32) ? (bf16)0 : (bf16)f2bf(yb[e] * r * g_swa[l * SWA_W + c]); }
        }
        {
            float yc[8]; float ssq = 0.f;
#pragma unroll
            for (int e = 0; e < 8; ++e) { const int c = lane + 64 * e; yc[e] = YC[row * SB_W + c]; ssq += yc[e] * yc[e]; }
            const float r = rsqrtf(wave_sum(ssq) * (1.f / SB_W) + EPS);
#pragma unroll
            for (int e = 0; e < 8; ++e) { const int c = lane + 64 * e; yo[LRU_W + SWA_W + c] = (MK_DBG & 64) ? (bf16)0 : (bf16)f2bf(yc[e] * r * g_sb[l * SB_W + c]); }
        }
    }
    __syncthreads();
}

constexpr int RT_SK = 0, RT_Q = 128 * 129 * 4, RT_SC = RT_Q + 32 * 128 * 4, RT_TV = RT_SC + 64 * 129 * 4, RT_TI = RT_TV + 64 * 16 * 4, RT_END = RT_TI + 64 * 16 * 4;
static_assert(RT_END <= LDS_MISC, "routing LDS");
DEV void route_item(int l, int tile, int h, const bf16* __restrict__ Q, const bf16* __restrict__ SK, int* __restrict__ IDS, float* __restrict__ GG, LAS unsigned char* lds, int tid, unsigned* DBGW = nullptr) {
    LAS float* skL = (LAS float*)(lds + RT_SK); LAS float* qL = (LAS float*)(lds + RT_Q); LAS float* sc = (LAS float*)(lds + RT_SC);
    LAS float* topv = (LAS float*)(lds + RT_TV); LAS int* topi = (LAS int*)(lds + RT_TI);
    const int lane = tid & 63, wave = tid >> 6, row0 = tile * 32;
    for (int c = 0; c < 2; ++c) {
        const bf16* skp = SK + ((size_t)((l * 8 + h) * 2 + c)) * 128 * 128;
#pragma unroll 4
        for (int i = 0; i < 16; ++i) { const int idx2 = tid + 512 * i; const int k = idx2 >> 6, d2 = idx2 & 63; const unsigned w = *(const unsigned*)(skp + k * 128 + 2 * d2); skL[k * 129 + 2 * d2] = bf_lo(w); skL[k * 129 + 2 * d2 + 1] = bf_hi(w); }
#pragma unroll
        for (int i = 0; i < 4; ++i) { const int idx2 = tid + 512 * i; const int tok = idx2 >> 6, d2 = idx2 & 63; const unsigned w = *(const unsigned*)(Q + (size_t)(row0 + tok) * D + h * 256 + c * 128 + 2 * d2); qL[tok * 128 + 2 * d2] = bf_lo(w); qL[tok * 128 + 2 * d2 + 1] = bf_hi(w); }
        __syncthreads();
        {
            const int k = tid & 127, tg = tid >> 7;
            float acc[8];
#pragma unroll
            for (int i = 0; i < 8; ++i) acc[i] = 0.f;
#pragma unroll 4
            for (int d = 0; d < 128; ++d) { const float s = skL[k * 129 + d];
#pragma unroll
                for (int i = 0; i < 8; ++i) acc[i] += s * qL[(tg * 8 + i) * 128 + d]; }
#pragma unroll
            for (int i = 0; i < 8; ++i) sc[(c * 32 + tg * 8 + i) * 129 + k] = acc[i];
        }
        __syncthreads();
    }
    for (int q = 0; q < 8; ++q) {
        const int L = wave * 8 + q;
        float v0 = sc[L * 129 + lane], v1 = sc[L * 129 + 64 + lane];
        for (int r = 0; r < 16; ++r) {
            const float m = wave_max(fmaxf(v0, v1));
            const unsigned long long b0 = __ballot(v0 == m);
            int idx;
            if (b0) { const int ln = __ffsll((long long)b0) - 1; idx = ln; if (lane == ln) v0 = NEGBIG; }
            else { const unsigned long long b1 = __ballot(v1 == m); const int ln = __ffsll((long long)b1) - 1; idx = 64 + ln; if (lane == ln) v1 = NEGBIG; }
            if (lane == 0) { topv[L * 16 + r] = m; topi[L * 16 + r] = idx; }
        }
    }
    __syncthreads();
#if MK_CHECK == 16
    { for (int q = 0; q < 8; ++q) { const int L = wave * 8 + q; const int mi = topi[L * 16 + (lane & 15)]; int dup = 0;
          for (int e = 0; e < 16; ++e) { const int oi = __shfl(mi, e); if (lane < 16 && e != lane && oi == mi) dup = 1; }
          if (dup) atomicAdd((unsigned*)DBGW, 1u); } }
#endif
    for (int q = 0; q < 4; ++q) {
        const int tok = wave * 4 + q;
        float cv[4];
#pragma unroll
        for (int e = 0; e < 4; ++e) cv[e] = topv[tok * 16 + (lane >> 2)] + topv[(32 + tok) * 16 + (lane & 3) * 4 + e];
        float mysc = NEGBIG; int myid = 0;
        for (int r = 0; r < 16; ++r) {
            const float lm = fmaxf(fmaxf(cv[0], cv[1]), fmaxf(cv[2], cv[3]));
            const float m = wave_max(lm);
            const unsigned long long bb = __ballot(lm == m);
            const int ln = __ffsll((long long)bb) - 1;
            const int se = (cv[0] == m) ? 0 : (cv[1] == m) ? 1 : (cv[2] == m) ? 2 : 3;
            const int sel = __shfl(se, ln);
            { const bool me = (lane == ln);
              cv[0] = (me && sel == 0) ? NEGBIG : cv[0]; cv[1] = (me && sel == 1) ? NEGBIG : cv[1];
              cv[2] = (me && sel == 2) ? NEGBIG : cv[2]; cv[3] = (me && sel == 3) ? NEGBIG : cv[3]; }
            const int ci = ln * 4 + sel;
            const int id = topi[tok * 16 + (ci >> 4)] * 128 + topi[(32 + tok) * 16 + (ci & 15)];
            if (lane == r) { mysc = m; myid = id; }
        }
#if MK_CHECK == 16
        { int dup = 0; for (int e = 0; e < 16; ++e) { const int oi = __shfl(myid, e); if (lane < 16 && e != lane && oi == myid) dup = 1; } if (dup) atomicAdd((unsigned*)DBGW + 1, 1u); }
#endif
        const float s0 = __shfl(mysc, 0);
        const float ev = (lane < 16) ? __expf(mysc - s0) : 0.f;
        const float sum = wave_sum(ev);
        if (lane < 16) { IDS[(size_t)(row0 + tok) * 128 + h * 16 + lane] = myid; GG[(size_t)(row0 + tok) * 128 + h * 16 + lane] = ev / sum; }
    }
    __syncthreads();
}


constexpr float U8_SCALE = 64.f;
DEV void convert_fp8(const float* __restrict__ src, unsigned char* __restrict__ dst, size_t ngroups16, size_t gtid, size_t gstride, float scale) {
    for (size_t g = gtid; g < ngroups16; g += gstride) {
        const f32x4 a = *(const f32x4*)(src + g * 16) * scale, b = *(const f32x4*)(src + g * 16 + 4) * scale, c = *(const f32x4*)(src + g * 16 + 8) * scale, d = *(const f32x4*)(src + g * 16 + 12) * scale;
        int w0 = 0, w1 = 0, w2 = 0, w3 = 0;
        w0 = __builtin_amdgcn_cvt_pk_fp8_f32(a.x, a.y, w0, false); w0 = __builtin_amdgcn_cvt_pk_fp8_f32(a.z, a.w, w0, true);
        w1 = __builtin_amdgcn_cvt_pk_fp8_f32(b.x, b.y, w1, false); w1 = __builtin_amdgcn_cvt_pk_fp8_f32(b.z, b.w, w1, true);
        w2 = __builtin_amdgcn_cvt_pk_fp8_f32(c.x, c.y, w2, false); w2 = __builtin_amdgcn_cvt_pk_fp8_f32(c.z, c.w, w2, true);
        w3 = __builtin_amdgcn_cvt_pk_fp8_f32(d.x, d.y, w3, false); w3 = __builtin_amdgcn_cvt_pk_fp8_f32(d.z, d.w, w3, true);
        *(v4u*)(dst + g * 16) = (v4u){(unsigned)w0, (unsigned)w1, (unsigned)w2, (unsigned)w3};
    }
}

constexpr int R2_SC = 0, R2_TV = 128 * 129 * 4, R2_TI = R2_TV + 128 * 16 * 4, R2_END = R2_TI + 128 * 16 * 4;
static_assert(R2_END <= LDS_MISC, "routing v2 LDS");
DEV unsigned ord_key(float s) { const unsigned u = __builtin_bit_cast(unsigned, s); return (u & 0x80000000u) ? ~u : (u | 0x80000000u); }
DEV void route_item2(int l, int tile, int h, const bf16* __restrict__ Q, const bf16* __restrict__ SK, int* __restrict__ IDS, float* __restrict__ GG, LAS unsigned char* lds, int tid,
                        const float* __restrict__ cv_u, const float* __restrict__ cv_v, unsigned char* __restrict__ cv_u8, unsigned char* __restrict__ cv_v8) {
    LAS float* sc = (LAS float*)(lds + R2_SC); LAS float* tv = (LAS float*)(lds + R2_TV); LAS int* ti = (LAS int*)(lds + R2_TI);
    const int lane = tid & 63, wave = tid >> 6, row0 = tile * 64;
    {
        const int r = lane & 31, hh = lane >> 5, c = wave >> 2, key0 = 32 * (wave & 3);
        const bf16* skp = SK + ((size_t)(((l * 8 + h) * 2 + c) * 128 + key0 + r)) * 128 + 8 * hh;
        bf16x8 bfr[8];
#pragma unroll
        for (int ks = 0; ks < 8; ++ks) bfr[ks] = *(const bf16x8*)(skp + 16 * ks);
#pragma unroll
        for (int rt = 0; rt < 2; ++rt) {
            const bf16* qp = Q + (size_t)(row0 + 32 * rt + r) * D + h * 256 + c * 128 + 8 * hh;
            bf16x8 afr[8];
#pragma unroll
            for (int ks = 0; ks < 8; ++ks) afr[ks] = *(const bf16x8*)(qp + 16 * ks);
            f32x16 acc;
#pragma unroll
            for (int e = 0; e < 16; ++e) acc[e] = 0.f;
#pragma unroll
            for (int ks = 0; ks < 8; ++ks) acc = __builtin_amdgcn_mfma_f32_32x32x16_bf16(afr[ks], bfr[ks], acc, 0, 0, 0);
#pragma unroll
            for (int e = 0; e < 16; ++e) { const int tok = 32 * rt + (e & 3) + 8 * (e >> 2) + 4 * hh; sc[(c * 64 + tok) * 129 + key0 + r] = acc[e]; }
        }
    }
    __syncthreads();
    if (tid >= 128) {
        const size_t TG = (size_t)NEXP * D / 16;
        const size_t g0 = (size_t)(tile * 8 + h) * 4096;
#pragma unroll 4
        for (int k = 0; k < 11; ++k) { const size_t g = g0 + (size_t)(tid - 128) + 384u * k;
            if (g < g0 + 4096) { const bool isv = g >= TG; const size_t gg = isv ? g - TG : g;
                convert_fp8((isv ? cv_v : cv_u) + gg * 16, (isv ? cv_v8 : cv_u8) + gg * 16, 1, 0, 1, isv ? 1.f : U8_SCALE); } }
    }
    if (tid < 128) {
        const int L = tid;
        unsigned t[16];
#pragma unroll
        for (int q = 0; q < 16; ++q) t[q] = 0u;
#pragma unroll 4
        for (int k = 0; k < 128; ++k) {
            unsigned key = (ord_key(sc[L * 129 + k]) & ~127u) | (unsigned)(127 - k);
#pragma unroll
            for (int q = 0; q < 16; ++q) { const unsigned hi = t[q] > key ? t[q] : key; key = t[q] > key ? key : t[q]; t[q] = hi; }
        }
#pragma unroll
        for (int q = 0; q < 16; ++q) { const int idx = 127 - (int)(t[q] & 127u); tv[L * 16 + q] = sc[L * 129 + idx]; ti[L * 16 + q] = idx; }
    }
    __syncthreads();
    if (tid < 64) {
        const int tok = tid;
        float a[16], bq[16];
#pragma unroll
        for (int i = 0; i < 16; ++i) { a[i] = tv[tok * 16 + i]; bq[i] = tv[(64 + tok) * 16 + i]; }
        unsigned t[16];
#pragma unroll
        for (int q = 0; q < 16; ++q) t[q] = 0u;
#pragma unroll
        for (int i = 0; i < 16; ++i)
#pragma unroll
            for (int j = 0; j < 16 / (i + 1); ++j) {
                unsigned key = (ord_key(a[i] + bq[j]) & ~255u) | (unsigned)(255 - (i * 16 + j));
#pragma unroll
                for (int q = 0; q < 16; ++q) { const unsigned hi = t[q] > key ? t[q] : key; key = t[q] > key ? key : t[q]; t[q] = hi; }
            }
        float scv[16]; int idv[16]; float mx = NEGBIG;
#pragma unroll
        for (int q = 0; q < 16; ++q) { const int ci = 255 - (int)(t[q] & 255u); const int i = ci >> 4, j = ci & 15;
            scv[q] = tv[tok * 16 + i] + tv[(64 + tok) * 16 + j]; idv[q] = ti[tok * 16 + i] * 128 + ti[(64 + tok) * 16 + j]; mx = fmaxf(mx, scv[q]); }
        float sum = 0.f;
#pragma unroll
        for (int q = 0; q < 16; ++q) { scv[q] = __expf(scv[q] - mx); sum += scv[q]; }
        const float inv = 1.f / sum;
        int* ip = IDS + (size_t)(row0 + tok) * 128 + h * 16; float* gp = GG + (size_t)(row0 + tok) * 128 + h * 16;
#pragma unroll
        for (int q4 = 0; q4 < 4; ++q4) {
            *(int4*)(ip + 4 * q4) = make_int4(idv[4 * q4], idv[4 * q4 + 1], idv[4 * q4 + 2], idv[4 * q4 + 3]);
            *(f32x4*)(gp + 4 * q4) = (f32x4){scv[4 * q4] * inv, scv[4 * q4 + 1] * inv, scv[4 * q4 + 2] * inv, scv[4 * q4 + 3] * inv};
        }
    }
    __syncthreads();
}

DEV void expert_row(int l, int row, const bf16* __restrict__ H, const int* __restrict__ IDS, const float* __restrict__ GG, const bf16* __restrict__ U, const bf16* __restrict__ V,
                    const float* __restrict__ X1, const float* __restrict__ g2, const float* __restrict__ fnorm, float* __restrict__ XO, int lane, float pscale, float* STATP = nullptr) {
    v4u xv[4];
#pragma unroll
    for (int j = 0; j < 4; ++j) xv[j] = *(const v4u*)(H + (size_t)row * D + lane * 8 + 512 * j);
    const int id0 = IDS[(size_t)row * 128 + lane], id1 = IDS[(size_t)row * 128 + 64 + lane];
    const float gg0 = GG[(size_t)row * 128 + lane], gg1 = GG[(size_t)row * 128 + 64 + lane];
    float y[32];
#pragma unroll
    for (int i = 0; i < 32; ++i) y[i] = 0.f;
    const bf16* Ul = U + (size_t)l * NEXP * D + lane * 8;
    const bf16* Vl = V + (size_t)l * NEXP * D + lane * 8;
    for (int e0 = 0; e0 < 128; e0 += 2) {
        int id[2]; float gq[2];
#pragma unroll
        for (int q = 0; q < 2; ++q) { const int e = e0 + q;
            id[q] = (e < 64) ? __builtin_amdgcn_readlane(id0, e & 63) : __builtin_amdgcn_readlane(id1, e & 63);
            gq[q] = (e < 64) ? __builtin_bit_cast(float, __builtin_amdgcn_readlane(__builtin_bit_cast(int, gg0), e & 63)) : __builtin_bit_cast(float, __builtin_amdgcn_readlane(__builtin_bit_cast(int, gg1), e & 63)); }
        v4u uu[2][4], vv[2][4];
#pragma unroll
        for (int q = 0; q < 2; ++q)
#pragma unroll
            for (int j = 0; j < 4; ++j) uu[q][j] = *(const v4u*)(Ul + (size_t)id[q] * D + 512 * j);
#pragma unroll
        for (int q = 0; q < 2; ++q)
#pragma unroll
            for (int j = 0; j < 4; ++j) vv[q][j] = *(const v4u*)(Vl + (size_t)id[q] * D + 512 * j);
#pragma unroll
        for (int q = 0; q < 2; ++q) {
            float dsum = 0.f;
#pragma unroll
            for (int j = 0; j < 4; ++j) dsum += dot8(xv[j], uu[q][j]);
            dsum = wave_sum(dsum);
            const float w = gq[q] * gelu_tanh(dsum);
#if MK_CHECK == 7
            if (lane == 0 && l == 0) atomicAdd(STATP, gelu_tanh(dsum) * gelu_tanh(dsum) * 2048.f / 128.f);
#elif MK_CHECK == 8
            if (lane == 0 && l == 0) atomicAdd(STATP, gq[q] * gq[q] * 2048.f * 16.f / 128.f);
#elif MK_CHECK == 9
            if (lane == 0 && l == 0) atomicAdd(STATP, dsum * dsum * 2048.f / 128.f);
#elif MK_CHECK == 11
            if (lane == 0 && l == 0) atomicAdd(STATP, w * w * 2048.f);
#endif
#pragma unroll
            for (int j = 0; j < 4; ++j) {
                y[j * 8 + 0] += w * bf_lo(vv[q][j].x); y[j * 8 + 1] += w * bf_hi(vv[q][j].x);
                y[j * 8 + 2] += w * bf_lo(vv[q][j].y); y[j * 8 + 3] += w * bf_hi(vv[q][j].y);
                y[j * 8 + 4] += w * bf_lo(vv[q][j].z); y[j * 8 + 5] += w * bf_hi(vv[q][j].z);
                y[j * 8 + 6] += w * bf_lo(vv[q][j].w); y[j * 8 + 7] += w * bf_hi(vv[q][j].w);
            }
        }
    }
#if MK_CHECK == 6
    { float q2 = 0.f;
#pragma unroll
      for (int i = 0; i < 32; ++i) q2 += y[i] * y[i];
      q2 = wave_sum(q2); if (lane == 0 && l == 0) atomicAdd(STATP, q2); }
#endif
    float ssq = 0.f;
#pragma unroll
    for (int j = 0; j < 4; ++j) {
        const int col = lane * 8 + 512 * j;
        const f32x4 xa = *(const f32x4*)(X1 + (size_t)row * D + col), xb = *(const f32x4*)(X1 + (size_t)row * D + col + 4);
        const f32x4 ga = *(const f32x4*)(g2 + col) * pscale, gb = *(const f32x4*)(g2 + col + 4) * pscale;
        y[j * 8 + 0] = xa.x + ga.x * y[j * 8 + 0]; y[j * 8 + 1] = xa.y + ga.y * y[j * 8 + 1]; y[j * 8 + 2] = xa.z + ga.z * y[j * 8 + 2]; y[j * 8 + 3] = xa.w + ga.w * y[j * 8 + 3];
        y[j * 8 + 4] = xb.x + gb.x * y[j * 8 + 4]; y[j * 8 + 5] = xb.y + gb.y * y[j * 8 + 5]; y[j * 8 + 6] = xb.z + gb.z * y[j * 8 + 6]; y[j * 8 + 7] = xb.w + gb.w * y[j * 8 + 7];
#pragma unroll
        for (int e = 0; e < 8; ++e) ssq += y[j * 8 + e] * y[j * 8 + e];
    }
    if (fnorm) {
        const float r = rsqrtf(wave_sum(ssq) * (1.f / D) + EPS);
#pragma unroll
        for (int j = 0; j < 4; ++j) { const int col = lane * 8 + 512 * j;
            const f32x4 fa = *(const f32x4*)(fnorm + col), fb = *(const f32x4*)(fnorm + col + 4);
            *(f32x4*)(XO + (size_t)row * D + col) = (f32x4){y[j * 8 + 0] * r * fa.x, y[j * 8 + 1] * r * fa.y, y[j * 8 + 2] * r * fa.z, y[j * 8 + 3] * r * fa.w};
            *(f32x4*)(XO + (size_t)row * D + col + 4) = (f32x4){y[j * 8 + 4] * r * fb.x, y[j * 8 + 5] * r * fb.y, y[j * 8 + 6] * r * fb.z, y[j * 8 + 7] * r * fb.w}; }
    } else {
#pragma unroll
        for (int j = 0; j < 4; ++j) { const int col = lane * 8 + 512 * j;
            *(f32x4*)(XO + (size_t)row * D + col) = (f32x4){y[j * 8 + 0], y[j * 8 + 1], y[j * 8 + 2], y[j * 8 + 3]};
            *(f32x4*)(XO + (size_t)row * D + col + 4) = (f32x4){y[j * 8 + 4], y[j * 8 + 5], y[j * 8 + 6], y[j * 8 + 7]}; }
    }
}


DEV void expert_row8(int l, int row, const bf16* H, const int* __restrict__ IDS, const float* __restrict__ GG, const unsigned char* __restrict__ U8, const unsigned char* __restrict__ V8,
                     const float* __restrict__ X1, const float* __restrict__ g2, const float* __restrict__ fnorm, float* __restrict__ XO, int lane, float pscale, LAS int* sortL,
                     const float* __restrict__ ngain, const float* __restrict__ nmod, bf16* Hout) {
    f32x2 x[16];
#pragma unroll
    for (int j = 0; j < 2; ++j) {
        const v4u a = *(const v4u*)(H + (size_t)row * D + lane * 16 + 1024 * j), c = *(const v4u*)(H + (size_t)row * D + lane * 16 + 1024 * j + 8);
        x[j * 8 + 0] = (f32x2){bf_lo(a.x), bf_hi(a.x)}; x[j * 8 + 1] = (f32x2){bf_lo(a.y), bf_hi(a.y)}; x[j * 8 + 2] = (f32x2){bf_lo(a.z), bf_hi(a.z)}; x[j * 8 + 3] = (f32x2){bf_lo(a.w), bf_hi(a.w)};
        x[j * 8 + 4] = (f32x2){bf_lo(c.x), bf_hi(c.x)}; x[j * 8 + 5] = (f32x2){bf_lo(c.y), bf_hi(c.y)}; x[j * 8 + 6] = (f32x2){bf_lo(c.z), bf_hi(c.z)}; x[j * 8 + 7] = (f32x2){bf_lo(c.w), bf_hi(c.w)};
    }
    int id0 = IDS[(size_t)row * 128 + lane], id1 = IDS[(size_t)row * 128 + 64 + lane];
    float gg0 = GG[(size_t)row * 128 + lane], gg1 = GG[(size_t)row * 128 + 64 + lane];
    {
        const int w0 = id0 >> 9, w1 = id1 >> 9; int p0 = 0, p1 = 0, base = 0;
        for (int w = 0; w < 32; ++w) {
            const unsigned long long m0 = __ballot(w0 == w), m1 = __ballot(w1 == w);
            const int c0 = __popcll(m0), c1 = __popcll(m1);
            const int b0 = (int)__builtin_amdgcn_mbcnt_hi((unsigned)(m0 >> 32), __builtin_amdgcn_mbcnt_lo((unsigned)m0, 0u));
            const int b1 = (int)__builtin_amdgcn_mbcnt_hi((unsigned)(m1 >> 32), __builtin_amdgcn_mbcnt_lo((unsigned)m1, 0u));
            p0 = (w0 == w) ? base + b0 : p0; p1 = (w1 == w) ? base + c0 + b1 : p1;
            base += c0 + c1;
        }
        sortL[p0] = id0; sortL[p1] = id1; ((LAS float*)sortL)[128 + p0] = gg0; ((LAS float*)sortL)[128 + p1] = gg1;
        LDS_WAIT();
        id0 = sortL[lane]; id1 = sortL[64 + lane]; gg0 = ((LAS float*)sortL)[128 + lane]; gg1 = ((LAS float*)sortL)[192 + lane];
        LDS_WAIT();
    }
    float wv0 = 0.f, wv1 = 0.f;
    const unsigned char* Ul = U8 + (size_t)l * NEXP * D + lane * 16;
    const unsigned char* Vl = V8 + (size_t)l * NEXP * D + lane * 16;
    for (int e0 = 0; e0 < 128; e0 += 8) {
        v4u uu[8][2];
#pragma unroll
        for (int q = 0; q < 8; ++q) { const int e = e0 + q; const int id = (e < 64) ? __builtin_amdgcn_readlane(id0, e & 63) : __builtin_amdgcn_readlane(id1, e & 63);
            uu[q][0] = *(const v4u*)(Ul + (size_t)id * D); uu[q][1] = *(const v4u*)(Ul + (size_t)id * D + 1024); }
        float ds[8];
#pragma unroll
        for (int q = 0; q < 8; ++q) {
            f32x2 acc = {0.f, 0.f};
#pragma unroll
            for (int j = 0; j < 2; ++j) {
                const unsigned wd[4] = {uu[q][j].x, uu[q][j].y, uu[q][j].z, uu[q][j].w};
#pragma unroll
                for (int dw = 0; dw < 4; ++dw) {
                    const f32x2 lo = __builtin_amdgcn_cvt_pk_f32_fp8((int)wd[dw], false), hi = __builtin_amdgcn_cvt_pk_f32_fp8((int)wd[dw], true);
                    acc = __builtin_elementwise_fma(lo, x[j * 8 + 2 * dw], acc); acc = __builtin_elementwise_fma(hi, x[j * 8 + 2 * dw + 1], acc);
                }
            }
            ds[q] = acc.x + acc.y;
        }
#pragma unroll
        for (int q = 0; q < 8; ++q) ds[q] += swz_xor<1>(ds[q]);
#pragma unroll
        for (int q = 0; q < 8; ++q) ds[q] += swz_xor<2>(ds[q]);
#pragma unroll
        for (int q = 0; q < 8; ++q) ds[q] += swz_xor<4>(ds[q]);
#pragma unroll
        for (int q = 0; q < 8; ++q) ds[q] += swz_xor<8>(ds[q]);
#pragma unroll
        for (int q = 0; q < 8; ++q) ds[q] += swz_xor<16>(ds[q]);
#pragma unroll
        for (int q = 0; q < 8; ++q) ds[q] = sum32(ds[q]);
#pragma unroll
        for (int q = 0; q < 8; ++q) { const int e = e0 + q;
            const float gq = (e < 64) ? __builtin_bit_cast(float, __builtin_amdgcn_readlane(__builtin_bit_cast(int, gg0), e & 63)) : __builtin_bit_cast(float, __builtin_amdgcn_readlane(__builtin_bit_cast(int, gg1), e & 63));
            const float w = gq * gelu_tanh(ds[q] * (1.f / U8_SCALE));
            if (e < 64) wv0 = (lane == (e & 63)) ? w : wv0; else wv1 = (lane == (e & 63)) ? w : wv1; }
    }
    f32x2 y[16];
#pragma unroll
    for (int i = 0; i < 16; ++i) y[i] = (f32x2){0.f, 0.f};
    for (int e0 = 0; e0 < 128; e0 += 8) {
        v4u vv[8][2];
#pragma unroll
        for (int q = 0; q < 8; ++q) { const int e = e0 + q; const int id = (e < 64) ? __builtin_amdgcn_readlane(id0, e & 63) : __builtin_amdgcn_readlane(id1, e & 63);
            vv[q][0] = *(const v4u*)(Vl + (size_t)id * D); vv[q][1] = *(const v4u*)(Vl + (size_t)id * D + 1024); }
#pragma unroll
        for (int q = 0; q < 8; ++q) { const int e = e0 + q;
            const float w = (e < 64) ? __builtin_bit_cast(float, __builtin_amdgcn_readlane(__builtin_bit_cast(int, wv0), e & 63)) : __builtin_bit_cast(float, __builtin_amdgcn_readlane(__builtin_bit_cast(int, wv1), e & 63));
            const f32x2 w2 = {w, w};
#pragma unroll
            for (int j = 0; j < 2; ++j) {
                const unsigned wd[4] = {vv[q][j].x, vv[q][j].y, vv[q][j].z, vv[q][j].w};
#pragma unroll
                for (int dw = 0; dw < 4; ++dw) {
                    const f32x2 lo = __builtin_amdgcn_cvt_pk_f32_fp8((int)wd[dw], false), hi = __builtin_amdgcn_cvt_pk_f32_fp8((int)wd[dw], true);
                    y[j * 8 + 2 * dw] = __builtin_elementwise_fma(w2, lo, y[j * 8 + 2 * dw]); y[j * 8 + 2 * dw + 1] = __builtin_elementwise_fma(w2, hi, y[j * 8 + 2 * dw + 1]);
                }
            }
        }
    }
    float ssq = 0.f;
#pragma unroll
    for (int j = 0; j < 2; ++j)
#pragma unroll
        for (int k4 = 0; k4 < 4; ++k4) {
            const int col = lane * 16 + 1024 * j + 4 * k4;
            const f32x4 xa = *(const f32x4*)(X1 + (size_t)row * D + col); const f32x4 ga = *(const f32x4*)(g2 + col) * pscale;
            f32x2& ya = y[j * 8 + 2 * k4]; f32x2& yb = y[j * 8 + 2 * k4 + 1];
            ya.x = xa.x + ga.x * ya.x; ya.y = xa.y + ga.y * ya.y; yb.x = xa.z + ga.z * yb.x; yb.y = xa.w + ga.w * yb.y;
            ssq += (ya.x * ya.x + ya.y * ya.y) + (yb.x * yb.x + yb.y * yb.y);
        }
    const float r = rsqrtf(wave_sum(ssq) * (1.f / D) + EPS);
#pragma unroll
    for (int j = 0; j < 2; ++j)
#pragma unroll
        for (int k4 = 0; k4 < 4; ++k4) {
            const int col = lane * 16 + 1024 * j + 4 * k4;
            const f32x2 ya = y[j * 8 + 2 * k4], yb = y[j * 8 + 2 * k4 + 1];
            f32x4 ov = {ya.x, ya.y, yb.x, yb.y};
            if (fnorm) ov = ov * r * *(const f32x4*)(fnorm + col);
            *(f32x4*)(XO + (size_t)row * D + col) = ov;
            if (ngain) {
                const f32x4 g = *(const f32x4*)(ngain + col), sc = *(const f32x4*)(nmod + MO_SC1 + col), sh = *(const f32x4*)(nmod + MO_SH1 + col);
                const f32x4 hv = (ov * r) * g * (sc + 1.f) + sh;
                *(unsigned long long*)(Hout + (size_t)row * D + col) = (unsigned long long)pk2(hv.x, hv.y) | ((unsigned long long)pk2(hv.z, hv.w) << 32);
            }
        }
}

#if MK_CHECK
DEV void chk_route(int l, int row, int h, const bf16* __restrict__ Q, const bf16* __restrict__ SK, const int* __restrict__ IDS, const float* __restrict__ GG, unsigned* bad, LAS float* sL, LAS unsigned* cntL, int tid) {
    if (tid < 256) { const int c = tid >> 7, k = tid & 127; const bf16* skp = SK + ((size_t)((l * 8 + h) * 2 + c)) * 128 * 128 + k * 128; const bf16* qp = Q + (size_t)row * D + h * 256 + c * 128;
        float s = 0.f; for (int d = 0; d < 128; ++d) s += bf1(qp[d]) * bf1(skp[d]); sL[c * 128 + k] = s; }
    if (tid == 0) cntL[0] = 0u;
    __syncthreads();
    float sc15 = 0.f; unsigned mybad = 0;
    { float prev = 3e38f; float s0 = 0.f, gsum = 0.f; float g0 = GG[(size_t)row * 128 + h * 16];
      for (int r = 0; r < 16; ++r) { const int id = IDS[(size_t)row * 128 + h * 16 + r]; const float g = GG[(size_t)row * 128 + h * 16 + r];
          if (id < 0 || id >= NEXP) { mybad |= 1; continue; }
          const float scv = sL[id >> 7] + sL[128 + (id & 127)];
          if (r == 0) s0 = scv;
          if (scv > prev + 1e-5f) mybad |= 2;
          prev = scv; gsum += g;
          const float ratio = __expf(scv - s0);
          if (fabsf(g / g0 - ratio) > 0.02f * ratio + 1e-4f) mybad |= 4;
          if (r == 15) sc15 = scv; }
      if (fabsf(gsum - 1.f) > 1e-3f) mybad |= 8; }
    unsigned cnt = 0;
    for (int p = tid; p < 16384; p += 512) { const float v = sL[p >> 7] + sL[128 + (p & 127)]; if (v > sc15 + 1e-5f) ++cnt; }
    __hip_atomic_fetch_add(cntL, cnt, __ATOMIC_RELAXED, __HIP_MEMORY_SCOPE_WORKGROUP);
    __syncthreads();
    if (tid == 0) { if (cntL[0] > 15u) mybad |= 16; if (mybad) atomicAdd(bad, 1u); }
    __syncthreads();
}
DEV void chk_expert(int l, int row, const bf16* __restrict__ H, const int* __restrict__ IDS, const float* __restrict__ GG, const float* __restrict__ Uf, const float* __restrict__ Vf,
                    const float* __restrict__ X1, const float* __restrict__ X2, const float* __restrict__ g2, unsigned* bad, LAS float* wL, int tid) {
    if (tid < 128) { const int id = IDS[(size_t)row * 128 + tid]; const float* up = Uf + ((size_t)l * NEXP + id) * D; const bf16* hp = H + (size_t)row * D;
        float s = 0.f; for (int d = 0; d < D; ++d) s += up[d] * bf1(hp[d]);
        wL[tid] = GG[(size_t)row * 128 + tid] * gelu_tanh(s); }
    __syncthreads();
    unsigned mybad = 0;
    for (int d = tid; d < D; d += 512) { float y = 0.f;
        for (int e = 0; e < 128; ++e) { const int id = IDS[(size_t)row * 128 + e]; y += wL[e] * Vf[((size_t)l * NEXP + id) * D + d]; }
        const float want = X1[(size_t)row * D + d] + g2[d] * y * (MK_CHECK == 3 ? 1.5f : 1.f); const float got = X2[(size_t)row * D + d];
        if (!(fabsf(got - want) <= 0.02f * fabsf(want) + 0.02f)) mybad = 1; }
    if (mybad) atomicAdd(bad, 1u);
    __syncthreads();
}

DEV void chk_hq(int l, int row, const float* __restrict__ X1, const float* __restrict__ gain, const float* __restrict__ modl, const float* __restrict__ wq, const bf16* __restrict__ H, const bf16* __restrict__ Q,
                unsigned* bad, LAS float* hL, LAS float* redL, int tid) {
    const int b = row >> 12;
    float ss = 0.f;
    for (int d = tid; d < D; d += 512) { const float v = X1[(size_t)row * D + d]; ss += v * v; }
    ss = wave_sum(ss);
    if ((tid & 63) == 0) redL[tid >> 6] = ss;
    __syncthreads();
    float tot = 0.f; for (int w = 0; w < 8; ++w) tot += redL[w];
    const float r = rsqrtf(tot * (1.f / D) + EPS);
    unsigned badh = 0, badq = 0;
    for (int d = tid; d < D; d += 512) { const float hv = X1[(size_t)row * D + d] * r * gain[d] * (1.f + modl[(size_t)b * MODW + MO_SC2 + d]) + modl[(size_t)b * MODW + MO_SH2 + d];
        hL[d] = hv; const float got = bf1(H[(size_t)row * D + d]); if (!(fabsf(got - hv) <= 0.01f * fabsf(hv) + 0.01f)) badh = 1; }
    __syncthreads();
    for (int c = tid; c < D; c += 512) { float q = 0.f; for (int k = 0; k < D; ++k) q += hL[k] * wq[(size_t)k * D + c];
        const float got = bf1(Q[(size_t)row * D + c]); if (!(fabsf(got - q) <= 0.02f * fabsf(q) + 0.03f)) badq = 1; }
    if (badh) atomicAdd(bad, 1u);
    if (badq) atomicAdd(bad + 1, 1u);
    __syncthreads();
}
#endif
struct Args { const float* in[24]; float* out; unsigned char* ws; int ph_lo, ph_hi, li, pad; };

__global__ void __launch_bounds__(512, 2) fwd(Args a) {
    extern __shared__ __attribute__((aligned(16))) unsigned char lds_raw[];
    LAS unsigned char* lds = (LAS unsigned char*)lds_raw;
#define PHASE_TID() int tid = wave0 * 64 + (int)__builtin_amdgcn_mbcnt_hi(~0u, __builtin_amdgcn_mbcnt_lo(~0u, 0u)); asm volatile("" : "+v"(tid)); const int lane = tid & 63; (void)lane; \
    int bx = blockIdx.x, G = gridDim.x; asm volatile("" : "+s"(bx), "+s"(G)); const int wave = __builtin_amdgcn_readfirstlane(tid >> 6); \
    const int vcu = (G % 8 == 0) ? (bx % 8) * (G / 8) + bx / 8 : bx; const int gw = vcu * 8 + wave, NGW = G * 8; (void)gw; (void)NGW; (void)vcu; (void)wave; \
    const __attribute__((address_space(4))) Args* A = (const __attribute__((address_space(4))) Args*)__builtin_amdgcn_kernarg_segment_ptr(); asm volatile("" : "+s"(A))
    unsigned* ctl = (unsigned*)(a.ws + WS_CTL);
    const int lo = a.ph_lo, hi = a.ph_hi;
    const int wave0 = __builtin_amdgcn_readfirstlane((int)threadIdx.x >> 6);
    for (int u = threadIdx.x; u < (LDS_BYTES - LDS_MISC) / 4; u += 512) ((LAS unsigned*)(lds + LDS_MISC))[u] = 0u;
    __syncthreads();
    XcdBarrier bar; bar.bar = ctl + CW_BAR + (a.li & 7) * XCD_BAR_WORDS; bar.x = 0; bar.st = (volatile LAS unsigned*)(lds + LDS_MISC + 64);
    if (hi - lo > 1) bar = xcd_barrier_post(ctl + CW_BAR + (a.li & 7) * XCD_BAR_WORDS, (volatile LAS unsigned*)(lds + LDS_MISC + 64));
#ifndef MK_MASK
#define MK_MASK 0x3ff
#endif
#define KON(q) (((MK_MASK) >> (q)) & 1)
#define IN(k) (lo <= (k) && (k) < hi)
#define SEAM(k) do { if (IN(k) && IN((k) + 1)) xcd_barrier(bar); } while (0)

#define mod   ((float*)(A->ws + WS_MOD))
#define WIN_T ((bf16*)(A->ws + WS_WIN_T))
#define WOUT_T ((bf16*)(A->ws + WS_WOUT_T))
#define WQ_T  ((bf16*)(A->ws + WS_WQ_T))
#define SUBK  ((bf16*)(A->ws + WS_SUBK))
#define UB    ((bf16*)(A->ws + WS_U))
#define VB    ((bf16*)(A->ws + WS_V))
#define H     ((bf16*)(A->ws + WS_H))
#define Z     ((bf16*)(A->ws + WS_Z))
#define HLOC  ((float*)(A->ws + WS_HLOC))
#define PP    ((float*)(A->ws + WS_P))
#define YB    ((float*)(A->ws + WS_YB))
#define YC    ((float*)(A->ws + WS_YC))
#define SUMA  ((float*)(A->ws + WS_SUMA))
#define SUMB  ((float*)(A->ws + WS_SUMB))
#define X1    ((float*)(A->ws + WS_X1))
#define X2    ((float*)(A->ws + WS_X2))
#define QB    ((bf16*)(A->ws + WS_Q))
#define IDS   ((int*)(A->ws + WS_IDS))
#define GG    ((float*)(A->ws + WS_G))
#define PARTB ((float*)(A->ws + WS_PART))
#define WG_T  ((bf16*)(A->ws + WS_WG_T))
#define LSEB  ((float*)(A->ws + WS_LSE))
#define XIN   ((l == 0) ? A->in[0] : (const float*)X2)
#define MODL  (mod + (size_t)l * 2 * MODW)
    for (int rep = 0; rep < (MK_DUP == 0 ? 2 : 1); ++rep) if (KON(0) && IN(0)) {
        PHASE_TID();
        ph_mod(A->in[1], A->in[2], A->in[3], mod, (LAS float*)lds, vcu, G, tid);
        {
            LAS float* scr = (LAS float*)(lds + wave * 16384);
            constexpr int I_IN = (D / 64) * (IN_W / 32), I_SQ = (D / 64) * (D / 32), I_L = I_IN + 2 * I_SQ;
            for (int it = gw; it < 2 * I_L; it += NGW) {
                const int l = it / I_L; int r = it % I_L;
                if (r < I_IN) { transpose_item(A->in[6] + (size_t)l * D * IN_W, D, IN_W, WIN_T + (size_t)l * IN_W * D, scr, r, lane); continue; } r -= I_IN;
                if (r < I_SQ) { transpose_item(A->in[18] + (size_t)l * D * D, D, D, WOUT_T + (size_t)l * D * D, scr, r, lane); continue; } r -= I_SQ;
                transpose_item(A->in[19] + (size_t)l * D * D, D, D, WQ_T + (size_t)l * D * D, scr, r, lane);
            }
        }
        {
            LAS float* scr = (LAS float*)(lds + wave * 16384);
            for (int it = gw; it < 2 * 6 * 2 * 8; it += NGW) { const int mi = it >> 3, sub = it & 7; const int ln = mi >> 1, g = mi & 1;
                transpose_item((g ? A->in[11] : A->in[9]) + (size_t)ln * 128 * 128, 128, 128, WG_T + ((size_t)ln * 2 + g) * 128 * 128, scr, sub, lane); }
        }
        const size_t gtid = (size_t)vcu * 512 + tid, gstride = (size_t)G * 512;
        convert_copy(A->in[20], SUBK, (size_t)2 * 8 * 2 * 128 * 128 / 8, gtid, gstride);
    }
    SEAM(0);

    for (int l = 0; l < NL; ++l) {
        const int pb = 1 + 9 * l;
        for (int rep = 0; rep < (MK_DUP == 1 ? 2 : 1); ++rep) if (KON(1) && IN(pb + 0) && l == 0) { PHASE_TID(); modnorm_rows(XIN, A->in[4] + l * D, MODL, MO_SH1, MO_SC1, H, gw, NGW, lane); }
        if (l == 0) SEAM(pb + 0);
        for (int rep = 0; rep < (MK_DUP == 2 ? 2 : 1); ++rep) if (KON(2) && IN(pb + 1)) {
            PHASE_TID(); (void)tid;
            pg8::Gemm g{H, WIN_T + (size_t)l * IN_W * D, M, IN_W, D}; pg8::StaticOrder S; S.init(M, IN_W, G, bx);
            pg8::EpiBf16<0> E{Z, IN_W, nullptr, 0, 0};
            pg8::gemm_phase<pg8::EpiBf16<0>, pg8::StaticOrder, false>((PG8_LAS unsigned char*)lds, g, S, E, nullptr);
        }
        SEAM(pb + 1);
        for (int rep = 0; rep < (MK_DUP == 3 ? 2 : 1); ++rep) if (KON(3) && IN(pb + 2)) {
            PHASE_TID();
            if (rep) __syncthreads();
            for (int it = vcu; it < 2 * 64 * 6; it += G) {
                const int b = it / 384, r = it % 384, j = r / 6, n = r % 6;
                lru_item2(l, b, j, n, Z, A->in[7], A->in[8], WG_T, A->in[10], A->in[12], A->in[13], HLOC, PP, SUMA, SUMB,
                          (LAS float*)lds, (LAS float*)(lds + 34816), (LAS float*)(lds + 69632), tid);
            }
            {
                {
                    LAS unsigned char* wl = lds + wave * ATT_WLDS;
                    for (int it = gw; it < 1024 + 4608; it += NGW) {
                        if (it < 1024) { const int bh = it >> 7, tl = 127 - (it & 127); sb_mfma_item(bh >> 2, bh & 3, 32 * tl, Z, YC, wl, lane); }
                        else { const int i2 = it - 1024; const int tl = i2 & 127, p = (i2 >> 7) % 3, bh = i2 / 384; const int d = 1 << (2 * p);
                            dil_mfma_item(bh / 6, bh % 6, p, tl % d, 32 * (tl / d), Z, A->in[14], PARTB, LSEB, wl, lane); }
                    }
                }
            }
        }
        SEAM(pb + 2);
        for (int rep = 0; rep < (MK_DUP == 4 ? 2 : 1); ++rep) if (KON(4) && IN(pb + 3)) {
            PHASE_TID();
            for (int it = vcu; it < 256; it += G) { const int b = it >> 7, j = (it >> 1) & 63, half = it & 1;
                combine_item(l, b, j, half, Z, HLOC, PP, SUMA, SUMB, PARTB, LSEB, YC, A->in[15], A->in[16], A->in[17], H, (LAS float*)lds, tid); }
        }
        SEAM(pb + 3);
        for (int rep = 0; rep < (MK_DUP == 5 ? 2 : 1); ++rep) if (KON(5) && IN(pb + 4)) {
            PHASE_TID(); (void)tid;
            pg8::Gemm g{H, WOUT_T + (size_t)l * D * D, M, D, D}; pg8::StaticOrder S; S.init(M, D, G, bx);
            EpiResGate E{XIN, X1, MODL + MO_G1, ((MK_DBG >> (2 * l)) & 1) ? 0.f : ((MK_DBG & 256) ? -1.f : 1.f)};
            pg8::gemm_phase<EpiResGate, pg8::StaticOrder, false>((PG8_LAS unsigned char*)lds, g, S, E, nullptr);
        }
        SEAM(pb + 4);
        for (int rep = 0; rep < (MK_DUP == 6 ? 2 : 1); ++rep) if (KON(6) && IN(pb + 5)) { PHASE_TID(); modnorm_rows(X1, A->in[5] + l * D, MODL, MO_SH2, MO_SC2, H, gw, NGW, lane); }
        SEAM(pb + 5);
        for (int rep = 0; rep < (MK_DUP == 7 ? 2 : 1); ++rep) if (KON(7) && IN(pb + 6)) {
            PHASE_TID(); (void)tid;
            pg8::Gemm g{H, WQ_T + (size_t)l * D * D, M, D, D}; pg8::StaticOrder S; S.init(M, D, G, bx);
            pg8::EpiBf16<0> E{QB, D, nullptr, 0, 0};
            pg8::gemm_phase<pg8::EpiBf16<0>, pg8::StaticOrder, false>((PG8_LAS unsigned char*)lds, g, S, E, nullptr);
        }
        SEAM(pb + 6);
        for (int rep = 0; rep < (MK_DUP == 8 ? 2 : 1); ++rep) if (KON(8) && IN(pb + 7)) {
            PHASE_TID();
            for (int it = vcu; it < 128 * 8; it += G) route_item2(l, it >> 3, it & 7, QB, SUBK, IDS, GG, lds, tid, A->in[21] + (size_t)l * NEXP * D, A->in[22] + (size_t)l * NEXP * D,
                                                                                      (unsigned char*)UB + (size_t)l * NEXP * D, (unsigned char*)VB + (size_t)l * NEXP * D);
        }
        SEAM(pb + 7);
        for (int rep = 0; rep < (MK_DUP == 9 ? 2 : 1); ++rep) if (KON(9) && IN(pb + 8)) {
            PHASE_TID();
            for (int m = gw; m < M; m += NGW)
                expert_row8(l, m, H, IDS, GG, (const unsigned char*)UB, (const unsigned char*)VB, X1, MODL + (size_t)(m >> 12) * MODW + MO_G2, (l == NL - 1) ? A->in[23] : nullptr, (l == NL - 1) ? A->out : X2, lane, ((MK_DBG >> (2 * l + 1)) & 1) ? 0.f : ((MK_DBG & 128) ? -1.f : 1.f), (LAS int*)(lds + wave * 1024),
                            (l == NL - 1) ? nullptr : A->in[4] + (l + 1) * D, mod + (size_t)((l + 1) * 2 + (m >> 12)) * MODW, H);
        }
        if (l + 1 < NL) SEAM(pb + 8);
    }
#if MK_CHECK
    if (IN(19)) {
        PHASE_TID();
        unsigned* badw = (unsigned*)(A->ws + WS_CTL) + 8;
#if MK_CHECK == 1 || MK_CHECK == 3 || MK_CHECK == 4
        for (int it = vcu; it < (MK_CHECK == 4 ? 8192 : 256) * 8; it += G) { const int row = (MK_CHECK == 4) ? (it >> 3) : (((it >> 3) * 131 + 7) & 8191); chk_route(0, row, it & 7, QB, SUBK, IDS, GG, badw, (LAS float*)lds, (LAS unsigned*)(lds + 2048), tid); }
        for (int it = vcu; it < (MK_CHECK == 4 ? 8192 : 256); it += G) { const int row = (MK_CHECK == 4) ? it : ((it * 131 + 7) & 8191); chk_expert(0, row, H, IDS, GG, A->in[21], A->in[22], X1, X2, mod + (size_t)(row >> 12) * MODW + MO_G2, badw + 1, (LAS float*)lds, tid); }
#elif MK_CHECK == 12 || MK_CHECK == 15
        { (void)badw;
          for (int m = gw; m < M; m += NGW) { const int ia = IDS[(size_t)m * 128 + lane], ib = IDS[(size_t)m * 128 + 64 + lane]; int cnt = 0;
              for (int e = 0; e < 128; ++e) { const int ie = (e < 64) ? __shfl(ia, e) : __shfl(ib, e - 64); if (lane < e && ia == ie && (MK_CHECK == 12 || (lane >> 4) == (e >> 4))) ++cnt; if (lane + 64 < e && ib == ie && (MK_CHECK == 12 || ((lane + 64) >> 4) == (e >> 4))) ++cnt; }
              float fc = wave_sum((float)cnt); if (lane == 0) atomicAdd((float*)(A->ws + WS_CTL) + 16, fc * 2048.f); } }
#elif MK_CHECK == 13 || MK_CHECK == 14
        { (void)badw;
          float cnt = 0.f;
          if (MK_CHECK == 13) { const float* sk = A->in[20]; for (int o = vcu * 512 + tid; o < 2 * 128 * 128; o += G * 512) if (sk[o] == sk[o + 2 * 128 * 128]) cnt += 1.f; cnt *= (float)M * D / (2.f * 128 * 128); }
          else { const float* wq = A->in[19]; for (int o = vcu * 512 + tid; o < D * 256; o += G * 512) { const int k = o >> 8, c = o & 255; if (wq[(size_t)k * D + c] == wq[(size_t)k * D + 256 + c]) cnt += 1.f; } cnt *= (float)M * D / ((float)D * 256); }
          cnt = wave_sum(cnt); if (lane == 0) atomicAdd((float*)(A->ws + WS_CTL) + 16, cnt); }
#elif MK_CHECK == 10
        { (void)badw; float acc = 0.f; const float* vt = A->in[22];
          for (size_t o = (size_t)vcu * 512 + tid; o < (size_t)NEXP * D; o += (size_t)G * 512) { const float v = vt[o]; acc += v * v; }
          acc = wave_sum(acc); if (lane == 0) atomicAdd((float*)(A->ws + WS_CTL) + 16, acc * ((float)M * D / ((float)NEXP * D))); }
#elif MK_CHECK == 16
        (void)badw;
#elif MK_CHECK >= 6
        (void)badw;
#elif MK_CHECK == 5
        {
            const float* cc = A->in[1]; const float* wm = A->in[2]; const float* bm = A->in[3];
            unsigned mb = 0;
            for (int o = vcu * 512 + tid; o < 2 * 2 * MODW; o += G * 512) { const int l = o / (2 * MODW), b = (o / MODW) & 1, n = o % MODW;
                float sacc = 0.f; for (int k = 0; k < D; ++k) { const float cv = cc[b * D + k]; sacc += (cv / (1.f + __expf(-cv))) * wm[((size_t)l * D + k) * MODW + n]; }
                sacc += bm[l * MODW + n];
                if (!(fabsf(sacc - mod[o]) <= 2e-3f * fabsf(sacc) + 2e-3f)) mb = 1; }
            if (mb) atomicAdd(badw, 1u);
            unsigned sb = 0;
            for (int o = vcu * 512 + tid; o < 2 * 8 * 2 * 128 * 128; o += G * 512) { const float want = A->in[20][o]; const float got = bf1(SUBK[o]); if (!(fabsf(got - want) <= 0.01f * fabsf(want) + 1e-6f)) sb = 1; }
            if (sb) atomicAdd(badw + 1, 1u);
        }
#else
        for (int it = vcu; it < 256; it += G) { const int row = (it * 131 + 7) & 8191; chk_hq(0, row, X1, A->in[5], mod, A->in[19], H, QB, badw, (LAS float*)lds, (LAS float*)(lds + 16384), tid); }
#endif
    }
    if (IN(20)) {
        PHASE_TID();
        const unsigned* badw = (const unsigned*)(A->ws + WS_CTL) + 8;
        const unsigned b0 = __hip_atomic_load(badw, __ATOMIC_RELAXED, __HIP_MEMORY_SCOPE_AGENT), b1 = __hip_atomic_load(badw + 1, __ATOMIC_RELAXED, __HIP_MEMORY_SCOPE_AGENT);
#if MK_CHECK >= 6 && MK_CHECK != 16
        const float f = 1.f + ((const float*)(A->ws + WS_CTL))[16] * (1.f / ((float)M * D)); (void)b0; (void)b1;
#else
        const float f = (b0 ? (b1 ? -2.f : 0.f) : (b1 ? -1.f : 1.f));
#endif
        for (int m = gw; m < M; m += NGW) { const f32x4* xr = (const f32x4*)(X2 + (size_t)m * D) + lane; f32x4 v[8]; float ss = 0.f;
#pragma unroll
            for (int j = 0; j < 8; ++j) { v[j] = xr[64 * j]; ss += (v[j].x * v[j].x + v[j].y * v[j].y) + (v[j].z * v[j].z + v[j].w * v[j].w); }
            const float r = rsqrtf(wave_sum(ss) * (1.f / D) + EPS) * f;
#pragma unroll
            for (int j = 0; j < 8; ++j) { const f32x4 fn = ((const f32x4*)A->in[23])[lane + 64 * j]; ((f32x4*)(A->out + (size_t)m * D))[lane + 64 * j] = v[j] * r * fn; } }
    }
#endif
#undef IN
#undef SEAM
#undef mod
#undef H
#undef Z
#undef X1
#undef X2
}
}

extern "C" void kernel_launch(void* const* d_in, const int* in_sizes, int n_in, void* d_out, int out_size, void* d_ws, size_t ws_size, hipStream_t stream) {
    using namespace mk;
    static int grid = 0;
    if (grid == 0) {
        if (n_in != 24 || out_size != M * D || ws_size < WS_END) { fprintf(stderr, "kernel_launch: unexpected shapes (n_in %d out %d ws %zu)\n", n_in, out_size, ws_size); grid = -1; return; }
        int dev = 0, cus = 0, per_cu = 0;
        if (hipGetDevice(&dev) != hipSuccess || hipDeviceGetAttribute(&cus, hipDeviceAttributeMultiprocessorCount, dev) != hipSuccess) { grid = -1; return; }
        if (hipFuncSetAttribute((const void*)fwd, hipFuncAttributeMaxDynamicSharedMemorySize, LDS_BYTES) != hipSuccess) { fprintf(stderr, "kernel_launch: hipFuncSetAttribute failed\n"); grid = -1; return; }
        if (hipOccupancyMaxActiveBlocksPerMultiprocessor(&per_cu, (const void*)fwd, 512, LDS_BYTES) != hipSuccess || per_cu < 1) fprintf(stderr, "kernel_launch: occupancy query says %d\n", per_cu);
        (void)hipGetLastError();
        grid = cus;
    }
    if (grid < 0) return;
    (void)hipMemsetAsync((char*)d_ws + WS_CTL, 0, CTL_ZERO_BYTES, stream);
    Args a{};
    for (int i = 0; i < 24; ++i) a.in[i] = (const float*)d_in[i];
    a.out = (float*)d_out; a.ws = (unsigned char*)d_ws; a.pad = 0;
#if MK_CHECK
    constexpr int NLAUNCH = 12;
#else
    constexpr int NLAUNCH = MK_N_LAUNCHES;
#endif
    for (int li = 0; li < NLAUNCH; ++li) {
        a.ph_lo = (NLAUNCH == 1) ? 0 : li; a.ph_hi = (NLAUNCH == 1) ? NPHASE : li + 1; a.li = li;
#if MK_CHECK
        if (li >= 10) { a.ph_lo = li + 9; a.ph_hi = li + 10; }
#endif
        hipLaunchKernelGGL(fwd, dim3(grid), dim3(512), LDS_BYTES, stream, a);
    }
}
```

```cpp
#include <hip/hip_runtime.h>
#include <cstdio>
#include <cstdint>
#define MK_DBG 0
#define MK_N_LAUNCHES 1
#define MK_CHECK 0
namespace pg8 {
#define PG8_LAS __attribute__((address_space(3)))
typedef unsigned short bf16_t;
typedef short bf16x8 __attribute__((ext_vector_type(8)));
typedef float f32x4 __attribute__((ext_vector_type(4)));
typedef unsigned u32x4 __attribute__((ext_vector_type(4)));
constexpr int BM = 256, BK = 64, HALF = 128, HTB = HALF * BK * 2  , STAGE_BYTES = 8 * HTB, NXCD = 8, WGM = 8;

__host__ __device__ __forceinline__ int lds_byte(int r, int c) { const int st = (r >> 4) * 2 + (c >> 5), rr = r & 15, cc = c & 31, ob = rr * 64 + cc * 2; return st * 1024 + (ob ^ (((ob >> 9) & 1) << 5)); }
__host__ __device__ __forceinline__ void stage_rc(int b, int& R, int& C) { const int st = b / 1024, sb = b % 1024, swz = sb ^ (((sb >> 9) & 1) << 5); R = (st >> 1) * 16 + swz / 64; C = (st & 1) * 32 + (swz % 64) / 2; }
__host__ __device__ __forceinline__ int perm32(int rho) { const int n = rho >> 4, i = rho & 15; return 8 * (i >> 2) + 4 * n + (i & 3); }

struct Unit { int pm, pn; };
struct Gemm { const bf16_t* A; const bf16_t* Bt; int M, N, K; };

struct StaticOrder {
    int nM, nN, nwg, G, c;
    __host__ __device__ void init(int M, int N, int G_, int c_) { nM = M / BM; nN = N / BM; nwg = nM * nN; G = G_; c = c_; }
    __host__ __device__ bool next(int i, Unit& u) const {
        const long L = (long)i * G + c; if (L >= nwg) return false;
        int wgid = (int)L; { const int q = nwg / NXCD, r = nwg % NXCD, xcd = wgid % NXCD, off = wgid / NXCD; wgid = (xcd < r ? xcd * (q + 1) : r * (q + 1) + (xcd - r) * q) + off; }
        const int nig = WGM * nN, gid = wgid / nig, fm = gid * WGM, gsz = (nM - fm) < WGM ? (nM - fm) : WGM;
        u.pm = fm + ((wgid % nig) % gsz); u.pn = (wgid % nig) / gsz; return true;
    }
    __device__ __forceinline__ void a_ready(const Unit&) const {}
    __device__ __forceinline__ void done(const Unit&) const {}
};
struct CountedOrder : StaticOrder {
    const unsigned* ready; unsigned need; unsigned* tmo;
    __device__ __forceinline__ void a_ready(const Unit& u) const {
        if (threadIdx.x < 64) {
            const unsigned long long t0 = __builtin_amdgcn_s_memrealtime(); unsigned polls = 0;
            while ((unsigned)__builtin_amdgcn_readfirstlane(__hip_atomic_load(ready + 64 * u.pm, __ATOMIC_RELAXED, __HIP_MEMORY_SCOPE_AGENT)) < need) {
                if ((++polls & 255u) == 0u && __builtin_amdgcn_readfirstlane(__hip_atomic_load(tmo, __ATOMIC_RELAXED, __HIP_MEMORY_SCOPE_AGENT)) != 0u) break;
                if (__builtin_amdgcn_s_memrealtime() - t0 > 2000000ull) {
                    if (threadIdx.x == 0) { unsigned expect = 0u; __hip_atomic_compare_exchange_strong(tmo + 1, &expect, 0x600u | (unsigned)(u.pm & 0xff), __ATOMIC_RELAXED, __ATOMIC_RELAXED, __HIP_MEMORY_SCOPE_AGENT); __hip_atomic_store(tmo, 1u, __ATOMIC_RELAXED, __HIP_MEMORY_SCOPE_AGENT); }
                    break; }
                __builtin_amdgcn_s_sleep(2); }
            __builtin_amdgcn_fence(__ATOMIC_ACQUIRE, "agent");
            asm volatile("s_waitcnt vmcnt(0)" ::: "memory");
        }
#if !defined(BROKEN_HOOK_NO_BARRIER)
        asm volatile("" ::: "memory"); __builtin_amdgcn_s_barrier(); asm volatile("" ::: "memory");
#endif
    }
};

__device__ __forceinline__ unsigned cvt_pk_bf16(float lo, float hi) { unsigned r; asm volatile("v_cvt_pk_bf16_f32 %0, %1, %2" : "=v"(r) : "v"(lo), "v"(hi)); return r; }
typedef float f32x2 __attribute__((ext_vector_type(2)));
__device__ __forceinline__ f32x2 gelu_pk(f32x2 v) {
    const f32x2 av = __builtin_elementwise_abs(v), d = av * 0.2316418882f + 1.0f;
    f32x2 t; t.x = __builtin_amdgcn_rcpf(d.x); t.y = __builtin_amdgcn_rcpf(d.y);
    f32x2 q = t * 0.5307027145f + (-0.7265760135f); q = q * t + 0.7107068705f; q = q * t + (-0.142248368f); q = q * t + 0.127414796f; q = q * t;
    const f32x2 s = (v * v) * (-0.72134752044f);
    f32x2 e; e.x = __builtin_amdgcn_exp2f(s.x); e.y = __builtin_amdgcn_exp2f(s.y);
    const f32x2 m = v * (q * e), r = v - m;
    f32x2 o; o.x = v.x < 0.f ? m.x : r.x; o.y = v.y < 0.f ? m.y : r.y; return o;
}

struct EpiF32 {
    static constexpr bool PERM = false, AFTER_DRAIN = false;
    float* C; int ldc; const float* bias;
    __device__ __forceinline__ void operator()(const f32x4 (&acc)[2][2][4][2], const Unit& u, int wr, int wc, int fr, int fq) const {
        const int row0 = u.pm * BM + wr * 64 + fr, col0 = u.pn * BM + wc * 32 + 4 * fq;
        f32x4 bv[2][2];
#pragma unroll
        for (int bj = 0; bj < 2; ++bj)
#pragma unroll
            for (int n = 0; n < 2; ++n) bv[bj][n] = bias ? *(const f32x4*)(bias + col0 + bj * HALF + n * 16) : (f32x4){0.f, 0.f, 0.f, 0.f};
#pragma unroll
        for (int ai = 0; ai < 2; ++ai)
#pragma unroll
            for (int m = 0; m < 4; ++m) { float* rowp = C + (size_t)(row0 + ai * HALF + m * 16) * ldc + col0;
#pragma unroll
                for (int bj = 0; bj < 2; ++bj)
#pragma unroll
                    for (int n = 0; n < 2; ++n) *(f32x4*)(rowp + bj * HALF + n * 16) = acc[ai][bj][m][n] + bv[bj][n]; }
    }
};
template <int ACT  > struct EpiBf16 {
    static constexpr bool PERM = true, AFTER_DRAIN = false;
    bf16_t* O; int ldc; const float* bias; int split_cols; size_t split_stride;
    __device__ __forceinline__ void operator()(const f32x4 (&acc)[2][2][4][2], const Unit& u, int wr, int wc, int fr, int fq) const {
        const int row0 = u.pm * BM + wr * 64 + fr; int colt = u.pn * BM; bf16_t* base = O;
        if (split_cols) { const int t = colt / split_cols; base += (size_t)t * split_stride; colt -= t * split_cols; }
        const int col0 = colt + wc * 32 + 8 * fq, bcol0 = u.pn * BM + wc * 32 + 8 * fq;
        f32x4 bv[2][2];
#pragma unroll
        for (int bj = 0; bj < 2; ++bj)
#pragma unroll
            for (int n = 0; n < 2; ++n) bv[bj][n] = bias ? *(const f32x4*)(bias + bcol0 + bj * HALF + 4 * n) : (f32x4){0.f, 0.f, 0.f, 0.f};
#pragma unroll
        for (int ai = 0; ai < 2; ++ai)
#pragma unroll
            for (int m = 0; m < 4; ++m) { bf16_t* rowp = base + (size_t)(row0 + ai * HALF + m * 16) * ldc + col0;
#pragma unroll
                for (int bj = 0; bj < 2; ++bj) { f32x4 v0 = acc[ai][bj][m][0] + bv[bj][0], v1 = acc[ai][bj][m][1] + bv[bj][1];
                    if (ACT == 1) { f32x2 a = gelu_pk((f32x2){v0[0], v0[1]}), b = gelu_pk((f32x2){v0[2], v0[3]}), c = gelu_pk((f32x2){v1[0], v1[1]}), d = gelu_pk((f32x2){v1[2], v1[3]});
                        v0 = (f32x4){a.x, a.y, b.x, b.y}; v1 = (f32x4){c.x, c.y, d.x, d.y}; }
                    if (ACT == 2) {
#pragma unroll
                        for (int j = 0; j < 4; ++j) { v0[j] = 0.5f * v0[j] * (1.0f + erff(v0[j] * 0.70710678f)); v1[j] = 0.5f * v1[j] * (1.0f + erff(v1[j] * 0.70710678f)); } }
                    u32x4 w; w.x = cvt_pk_bf16(v0[0], v0[1]); w.y = cvt_pk_bf16(v0[2], v0[3]); w.z = cvt_pk_bf16(v1[0], v1[1]); w.w = cvt_pk_bf16(v1[2], v1[3]);
                    *(u32x4*)(rowp + bj * HALF) = w; } }
    }
};
template <class Epi, class Sched, bool STAMP = false>
__device__ __forceinline__ void gemm_phase(PG8_LAS unsigned char* lds, const Gemm g, const Sched& S, const Epi& E, unsigned long long* stamps, int wave_id) {
    unsigned zz_o = 0u; asm volatile("" : "+v"(zz_o)); int tid_o = wave_id * 64 + (int)__builtin_amdgcn_mbcnt_hi(~0u, __builtin_amdgcn_mbcnt_lo(~0u, zz_o));
    const int tid = tid_o, wid = __builtin_amdgcn_readfirstlane(tid >> 6), lane = tid & 63, wr = wid >> 2, wc = wid & 3, fr = lane & 15, fq = lane >> 4;
    constexpr int K = 2048, nt = K / BK;
    int ts_lo = 0, ts_hi = 0, nts = 0; const unsigned long long rt_entry = STAMP ? (unsigned long long)wall_clock64() : 0ull;
#define PG8_STAMP() do { if (STAMP && wid == 0 && nts < 64) { const unsigned long long _c = (unsigned long long)clock64(); \
        ts_lo = (lane == nts) ? (int)(unsigned)_c : ts_lo; ts_hi = (lane == nts) ? (int)(unsigned)(_c >> 32) : ts_hi; ++nts; } } while (0)
    PG8_STAMP();
    unsigned voffA[2], voffB[2];
#pragma unroll
    for (int i = 0; i < 2; ++i) { int R, C; stage_rc(tid * 16 + i * 8192, R, C); const int Rb = Epi::PERM ? ((R & ~31) + perm32(R & 31)) : R;
        voffA[i] = (unsigned)(R * K + C) * 2u; voffB[i] = (unsigned)(Rb * K + C) * 2u; }
    const size_t kstep = (size_t)(BK * 2);
    const size_t hstep = (size_t)HALF * K * 2;
    const size_t tstep = 2 * hstep;
    const unsigned ldsw = (unsigned)wid * 1024u;
    const int aoff = lds_byte(wr * 64 + fr, fq * 8), boff = lds_byte(wc * 32 + fr, fq * 8);
#define PG8_SA(b, h) (((b) * 2 + (h)) * HTB)
#define PG8_SB(b, h) ((4 + (b) * 2 + (h)) * HTB)
#define PG8_STAGE(bufoff, gbase, voff) do { _Pragma("unroll") for (int _i = 0; _i < 2; ++_i) \
        __builtin_amdgcn_global_load_lds((const unsigned*)((const char*)(gbase) + (voff)[_i]), (PG8_LAS unsigned*)(lds + (bufoff) + ldsw + _i * 8192), 16, 0, 0); } while (0)
#define PG8_LDA(dst, b, h) do { _Pragma("unroll") for (int m = 0; m < 4; ++m) _Pragma("unroll") for (int k = 0; k < 2; ++k) dst[m][k] = *(const PG8_LAS bf16x8*)(lds + PG8_SA(b, h) + aoff + m * 2048 + k * 1024); } while (0)
#define PG8_LDB(dst, b, h) do { _Pragma("unroll") for (int n = 0; n < 2; ++n) _Pragma("unroll") for (int k = 0; k < 2; ++k) dst[n][k] = *(const PG8_LAS bf16x8*)(lds + PG8_SB(b, h) + boff + n * 2048 + k * 1024); } while (0)
#define PG8_MMA(ai, bj, At, Bt) do { __builtin_amdgcn_s_setprio(1); _Pragma("unroll") for (int m = 0; m < 4; ++m) _Pragma("unroll") for (int n = 0; n < 2; ++n) _Pragma("unroll") for (int k = 0; k < 2; ++k) \
        acc[ai][bj][m][n] = __builtin_amdgcn_mfma_f32_16x16x32_bf16(Bt[n][k], At[m][k], acc[ai][bj][m][n], 0, 0, 0); __builtin_amdgcn_s_setprio(0); } while (0)
#define PG8_WAIT_V(n) asm volatile("s_waitcnt vmcnt(" #n ")" ::: "memory")
#define PG8_WAIT_L(n) asm volatile("s_waitcnt lgkmcnt(" #n ")" ::: "memory")
#define PG8_BAR __builtin_amdgcn_s_barrier()
#define PG8_SCHED __builtin_amdgcn_sched_barrier(0)
    Unit cur, nxt; int ui = 0;
    if (!S.next(0, cur)) return;
    f32x4 acc[2][2][4][2];
#pragma unroll
    for (int a = 0; a < 2; ++a)
#pragma unroll
        for (int b = 0; b < 2; ++b)
#pragma unroll
            for (int m = 0; m < 4; ++m)
#pragma unroll
                for (int n = 0; n < 2; ++n) acc[a][b][m][n] = (f32x4){0.f, 0.f, 0.f, 0.f};
    bf16x8 At[4][2], B0[2][2], B1[2][2];
    const char* cA = (const char*)g.A + (size_t)cur.pm * tstep; const char* cB = (const char*)g.Bt + (size_t)cur.pn * tstep;
    S.a_ready(cur);
    PG8_STAGE(PG8_SB(0, 0), cB, voffB); PG8_STAGE(PG8_SA(0, 0), cA, voffA); PG8_STAGE(PG8_SB(0, 1), cB + hstep, voffB); PG8_STAGE(PG8_SA(0, 1), cA + hstep, voffA);
    if (wr == 1) PG8_BAR;
    PG8_WAIT_V(4); PG8_BAR;
    PG8_STAGE(PG8_SB(1, 0), cB + kstep, voffB); PG8_STAGE(PG8_SA(1, 0), cA + kstep, voffA); PG8_STAGE(PG8_SB(1, 1), cB + hstep + kstep, voffB);
    PG8_WAIT_V(6); PG8_BAR;
    PG8_STAMP();
    for (;;) {
        const bool has_next = S.next(ui + 1, nxt);
        const char* nA = has_next ? (const char*)g.A + (size_t)nxt.pm * tstep : cA; const char* nB = has_next ? (const char*)g.Bt + (size_t)nxt.pn * tstep : cB;
        for (int t = 0; t < nt; t += 2) {
            const bool last = (t == nt - 2);
            const char* a1 = cA + (size_t)(t + 1) * kstep;
            const char* a2 = last ? nA : cA + (size_t)(t + 2) * kstep; const char* b2 = last ? nB : cB + (size_t)(t + 2) * kstep;
            const char* a3 = a2 + kstep; const char* b3 = b2 + kstep;
            if (last && has_next) S.a_ready(nxt);
            PG8_LDB(B0, 0, 0); PG8_SCHED; PG8_LDA(At, 0, 0); PG8_STAGE(PG8_SA(1, 1), a1 + hstep, voffA);
            PG8_WAIT_L(8); PG8_BAR; PG8_WAIT_L(0); PG8_MMA(0, 0, At, B0); PG8_BAR; PG8_SCHED;
            PG8_LDB(B1, 0, 1); PG8_STAGE(PG8_SB(0, 0), b2, voffB);
            PG8_BAR; PG8_WAIT_L(0); PG8_MMA(0, 1, At, B1); PG8_BAR;
            PG8_LDA(At, 0, 1); PG8_STAGE(PG8_SA(0, 0), a2, voffA);
            PG8_BAR; PG8_WAIT_L(0); PG8_MMA(1, 0, At, B0); PG8_BAR; PG8_SCHED;
            PG8_STAGE(PG8_SB(0, 1), b2 + hstep, voffB);
            PG8_WAIT_V(6); PG8_BAR; PG8_MMA(1, 1, At, B1); PG8_BAR;
            PG8_LDB(B0, 1, 0); PG8_SCHED; PG8_LDA(At, 1, 0); PG8_STAGE(PG8_SA(0, 1), a2 + hstep, voffA);
            PG8_WAIT_L(8); PG8_BAR; PG8_WAIT_L(0); PG8_MMA(0, 0, At, B0); PG8_BAR; PG8_SCHED;
            PG8_LDB(B1, 1, 1); PG8_STAGE(PG8_SB(1, 0), b3, voffB);
            PG8_BAR; PG8_WAIT_L(0); PG8_MMA(0, 1, At, B1); PG8_BAR;
            PG8_LDA(At, 1, 1); PG8_STAGE(PG8_SA(1, 0), a3, voffA);
            PG8_BAR; PG8_WAIT_L(0); PG8_MMA(1, 0, At, B0); PG8_BAR; PG8_SCHED;
            PG8_STAGE(PG8_SB(1, 1), b3 + hstep, voffB);
            PG8_WAIT_V(6); PG8_BAR; PG8_MMA(1, 1, At, B1); PG8_BAR;
        }
        PG8_STAMP();
        if constexpr (!Epi::AFTER_DRAIN) { E(acc, cur, wr, wc, fr, fq); S.done(cur); }
        PG8_STAMP();
        if (!has_next) break;
#pragma unroll
        for (int a = 0; a < 2; ++a)
#pragma unroll
            for (int b = 0; b < 2; ++b)
#pragma unroll
                for (int m = 0; m < 4; ++m)
#pragma unroll
                    for (int n = 0; n < 2; ++n) acc[a][b][m][n] = (f32x4){0.f, 0.f, 0.f, 0.f};
        cur = nxt; cA = nA; cB = nB; ++ui;
    }
    PG8_WAIT_V(0);
    if (wr == 0) PG8_BAR;
    PG8_BAR;
    if constexpr (Epi::AFTER_DRAIN) { E.fused(acc, cur, wr, wc, fr, fq, lds, wid, lane); S.done(cur); }
    PG8_STAMP();
    if (STAMP && wid == 0) { stamps[lane] = lane < nts ? (((unsigned long long)(unsigned)ts_hi << 32) | (unsigned)ts_lo) : 0ull;
        if (lane == 62) stamps[62] = rt_entry; if (lane == 63) stamps[63] = (unsigned long long)wall_clock64(); }
#undef PG8_STAMP
#undef PG8_SA
#undef PG8_SB
#undef PG8_STAGE
#undef PG8_LDA
#undef PG8_LDB
#undef PG8_MMA
#undef PG8_WAIT_V
#undef PG8_WAIT_L
#undef PG8_BAR
#undef PG8_SCHED
}
}

namespace mk {
#define GAS __attribute__((address_space(1)))
#define LAS __attribute__((address_space(3)))
#define DEV __device__ __forceinline__
typedef unsigned short bf16;
typedef unsigned v4u __attribute__((ext_vector_type(4)));
typedef float f32x4 __attribute__((ext_vector_type(4)));
typedef float f32x2 __attribute__((ext_vector_type(2)));
typedef short bf16x8 __attribute__((ext_vector_type(8)));
typedef float f32x16 __attribute__((ext_vector_type(16)));
typedef __bf16 bf16x2_t __attribute__((ext_vector_type(2)));

#ifndef MK_DBG
#define MK_DBG 0
#endif
#ifndef MK_CHECK
#define MK_CHECK 0
#endif
#ifndef MK_DUP
#define MK_DUP (-1)
#endif
#ifndef MK_N_LAUNCHES
#define MK_N_LAUNCHES 19
#endif

constexpr int D = 2048, SEQ = 4096, M = 8192, NL = 2;
constexpr int LRU_W = 768, SWA_W = 768, SB_W = 512, IN_W = 5376;
constexpr int ZO_XA = 0, ZO_GA = 768, ZO_QB = 1536, ZO_KB = 2304, ZO_VB = 3072, ZO_QC = 3840, ZO_KC = 4352, ZO_VC = 4864;
constexpr int NEXP = 16384, MODW = 12288;
constexpr int MO_SH1 = 0, MO_SC1 = 2048, MO_G1 = 4096, MO_SH2 = 6144, MO_SC2 = 8192, MO_G2 = 10240;
constexpr float EPS = 1e-6f;
constexpr float QSCALE = 0.08838834764831845f;
constexpr float NEGBIG = -3.0e38f;
constexpr int NPHASE = 19 + 2 * (MK_CHECK != 0);

constexpr size_t MiB = 1u << 20;
constexpr size_t WS_CTL = 0, CTL_ZERO_BYTES = 1 * MiB;
constexpr size_t WS_MOD = 512 * 1024;
constexpr size_t WS_WIN_T = 2 * MiB, WS_WOUT_T = 44 * MiB, WS_WQ_T = 60 * MiB, WS_SUBK = 76 * MiB, WS_U = 80 * MiB, WS_V = 208 * MiB,
                 WS_H = 336 * MiB, WS_Z = 368 * MiB, WS_HLOC = 452 * MiB, WS_P = 476 * MiB, WS_YB = 500 * MiB, WS_YC = 524 * MiB,
                 WS_SUMA = 540 * MiB, WS_SUMB = 541 * MiB, WS_X1 = 544 * MiB, WS_X2 = 608 * MiB, WS_Q = 672 * MiB, WS_IDS = 704 * MiB,
                 WS_G = 708 * MiB, WS_WG_T = 77 * MiB, WS_PART = 712 * MiB, WS_LSE = 784 * MiB, WS_END = 785 * MiB;
constexpr int CW_BAR = 4096;

constexpr int LDS_BYTES = 147456;
constexpr int LDS_MISC = 143360;

__device__ const unsigned char T5B[3][132] = {
 {0,1,2,3,4,5,6,7,8,9,10,11,12,13,14,15,16,16,16,16,16,16,17,17,17,17,17,17,17,17,18,18,18,18,18,18,18,18,18,18,19,19,19,19,19,19,19,19,19,19,19,19,19,19,20,20,20,20,20,20,20,20,20,20,20,20,20,20,20,20,20,20,20,21,21,21,21,21,21,21,21,21,21,21,21,21,21,21,21,21,21,21,21,21,21,21,21,21,21,22,22,22,22,22,22,22,22,22,22,22,22,22,22,22,22,22,22,22,22,22,22,22,22,22,22,22,22,22,22,0,0,0},
 {0,4,8,12,16,16,17,17,18,18,19,19,19,19,20,20,20,20,20,21,21,21,21,21,21,22,22,22,22,22,22,22,22,22,23,23,23,23,23,23,23,23,23,23,23,23,24,24,24,24,24,24,24,24,24,24,24,24,24,24,24,24,25,25,25,25,25,25,25,25,25,25,25,25,25,25,25,25,25,25,25,25,25,26,26,26,26,26,26,26,26,26,26,26,26,26,26,26,26,26,26,26,26,26,26,26,26,26,26,26,26,26,26,27,27,27,27,27,27,27,27,27,27,27,27,27,27,27,27,0,0,0},
 {0,16,18,19,20,21,21,22,22,23,23,23,24,24,24,24,25,25,25,25,25,26,26,26,26,26,26,26,26,27,27,27,27,27,27,27,27,27,27,28,28,28,28,28,28,28,28,28,28,28,28,28,29,29,29,29,29,29,29,29,29,29,29,29,29,29,29,29,29,29,30,30,30,30,30,30,30,30,30,30,30,30,30,30,30,30,30,30,30,30,30,30,30,30,30,31,31,31,31,31,31,31,31,31,31,31,31,31,31,31,31,31,31,31,31,31,31,31,31,31,31,31,31,31,31,31,31,31,31,0,0,0}};

#define LDS_WAIT() asm volatile("s_waitcnt lgkmcnt(0)" ::: "memory")
DEV unsigned f2bf(float f) { unsigned u = __builtin_bit_cast(unsigned, f); return (u + 0x7fffu + ((u >> 16) & 1u)) >> 16; }
DEV unsigned pk2(float lo, float hi) { return f2bf(lo) | (f2bf(hi) << 16); }
DEV float bf_lo(unsigned w) { return __builtin_bit_cast(float, w << 16); }
DEV float bf_hi(unsigned w) { return __builtin_bit_cast(float, w & 0xffff0000u); }
DEV float bf1(bf16 h) { return __builtin_bit_cast(float, ((unsigned)h) << 16); }
template <int MSK> DEV float swz_xor(float v) { return __builtin_bit_cast(float, __builtin_amdgcn_ds_swizzle(__builtin_bit_cast(int, v), (MSK << 10) | 0x1F)); }
DEV float part32_(float v) { int ln = (int)__builtin_amdgcn_mbcnt_hi(~0u, __builtin_amdgcn_mbcnt_lo(~0u, 0u)); asm volatile("" : "+v"(ln)); return __builtin_bit_cast(float, __builtin_amdgcn_ds_bpermute((ln ^ 32) << 2, __builtin_bit_cast(int, v))); }
DEV float sum32(float v) { return v + part32_(v); }
DEV float max32(float v) { return fmaxf(v, part32_(v)); }
DEV float partner32(float v, int hh) { (void)hh; return part32_(v); }
DEV float wave_sum(float v) { v += swz_xor<1>(v); v += swz_xor<2>(v); v += swz_xor<4>(v); v += swz_xor<8>(v); v += swz_xor<16>(v); return sum32(v); }
DEV float wave_max(float v) { v = fmaxf(v, swz_xor<1>(v)); v = fmaxf(v, swz_xor<2>(v)); v = fmaxf(v, swz_xor<4>(v)); v = fmaxf(v, swz_xor<8>(v)); v = fmaxf(v, swz_xor<16>(v)); return max32(v); }
DEV float sigmoid_f(float x) { return 1.f / (1.f + __expf(-x)); }
DEV float softplus_f(float x) { return fmaxf(x, 0.f) + log1pf(__expf(-fabsf(x))); }
DEV float gelu_tanh(float x) { const float u = 0.7978845608028654f * (x + 0.044715f * x * x * x); const float t = 1.f - 2.f / (1.f + __expf(2.f * u)); return 0.5f * x * (1.f + t); }
DEV float dot8(const v4u a, const v4u b) {
    float s = bf_lo(a.x) * bf_lo(b.x); s += bf_hi(a.x) * bf_hi(b.x);
    s += bf_lo(a.y) * bf_lo(b.y); s += bf_hi(a.y) * bf_hi(b.y);
    s += bf_lo(a.z) * bf_lo(b.z); s += bf_hi(a.z) * bf_hi(b.z);
    s += bf_lo(a.w) * bf_lo(b.w); s += bf_hi(a.w) * bf_hi(b.w);
    return s;
}

#define XB_TMO      128
#define XB_XCNT(j)  (256  + 64 * (j))
#define XB_XSUB(j)  (1280 + 64 * (j))
#define XB_XGEN(j)  (2304 + 64 * (j))
#define XB_TOP      3328
#define XB_TOPGEN   3392
#define XCD_BAR_WORDS 3456
#define XB_SPIN_CAP (1u << 18)

__device__ __forceinline__ unsigned xb_ld(unsigned* p)              { return __hip_atomic_load(p, __ATOMIC_RELAXED, __HIP_MEMORY_SCOPE_AGENT); }
__device__ __forceinline__ unsigned xb_add(unsigned* p, unsigned v) { return __hip_atomic_fetch_add(p, v, __ATOMIC_RELAXED, __HIP_MEMORY_SCOPE_AGENT); }
__device__ __forceinline__ unsigned xb_xcc_id() { return (unsigned)__builtin_amdgcn_s_getreg((3 << 11) | 20) & 0xFu; }
#define XB_SPIN(cond, bar) do { unsigned _sp = 0; while (cond) { __builtin_amdgcn_s_sleep(1); \
    if ((++_sp & 255u) == 0u) { if (xb_ld(&(bar)[XB_TMO])) break; if (_sp > XB_SPIN_CAP) { atomicAdd(&(bar)[XB_TMO], 1u); break; } } } } while (0)

struct XcdBarrier {
    unsigned* bar; unsigned x;
    volatile LAS unsigned* st;
    int w0;
};
DEV bool xb_lead(int w0) { return w0 == 0 && __builtin_amdgcn_mbcnt_hi(~0u, __builtin_amdgcn_mbcnt_lo(~0u, 0u)) == 0u; }
__device__ __forceinline__ XcdBarrier xcd_barrier_post(unsigned* bar, volatile LAS unsigned* st, int w0) {
    XcdBarrier b; b.bar = bar; b.x = xb_xcc_id(); b.st = st; b.w0 = w0;
    if (xb_lead(w0)) (void)xb_add(&bar[XB_XCNT(b.x)], 1u);
    return b;
}
__device__ __forceinline__ void xcd_barrier_complete(unsigned* bar, unsigned x, unsigned& nloc, unsigned& nx) {
    const unsigned G = gridDim.x * gridDim.y * gridDim.z;
    unsigned sum, cnt, mine, sp = 0u;
    for (;;) {
        sum = 0u; cnt = 0u; mine = 0u;
#pragma unroll
        for (unsigned j = 0; j < 16; ++j) { const unsigned c = xb_ld(&bar[XB_XCNT(j)]); sum += c; cnt += (c > 0u) ? 1u : 0u; mine = (j == x) ? c : mine; }
        if (sum == G) break;
        __builtin_amdgcn_s_sleep(1);
        if ((++sp & 255u) == 0u) { if (xb_ld(&bar[XB_TMO])) break; if (sp > XB_SPIN_CAP) { atomicAdd(&bar[XB_TMO], 1u); break; } }
    }
    nloc = mine > 0u ? mine : 1u; nx = cnt > 0u ? cnt : 1u;
}
__device__ __forceinline__ void xcd_barrier(const XcdBarrier& b) {
    asm volatile("s_waitcnt vmcnt(0)" ::: "memory");
    __syncthreads();
    if (xb_lead(b.w0)) {
        unsigned* bar = b.bar;
        __builtin_amdgcn_s_waitcnt(0);
        unsigned nloc = b.st[0], nx = b.st[1];
        if (nloc == 0u) { xcd_barrier_complete(bar, b.x, nloc, nx); b.st[0] = nloc; b.st[1] = nx; }
        const unsigned old = xb_add(&bar[XB_XSUB(b.x)], 1u);
        const unsigned gen = old / nloc;
        if (old + 1u == (gen + 1u) * nloc) {
            __builtin_amdgcn_fence(__ATOMIC_RELEASE, "agent");
            asm volatile("s_waitcnt vmcnt(0)" ::: "memory");
            const unsigned og = xb_add(&bar[XB_TOP], 1u);
            const unsigned tg = og / nx;
            if (og + 1u == (tg + 1u) * nx) xb_add(&bar[XB_TOPGEN], 1u);
            else XB_SPIN(xb_ld(&bar[XB_TOPGEN]) == tg, bar);
            __builtin_amdgcn_fence(__ATOMIC_ACQUIRE, "agent");
            xb_add(&bar[XB_XGEN(b.x)], 1u);
            asm volatile("s_waitcnt vmcnt(0)" ::: "memory");
        } else {
            XB_SPIN(xb_ld(&bar[XB_XGEN(b.x)]) == gen, bar);
            __builtin_amdgcn_fence(__ATOMIC_ACQUIRE, "agent");
            asm volatile("s_waitcnt vmcnt(0)" ::: "memory");
        }
    }
    __syncthreads();
}

struct EpiResGate {
    static constexpr bool PERM = false, AFTER_DRAIN = false;
    const float* X; float* O; const float* gate; float gscale;
    __device__ __forceinline__ void operator()(const pg8::f32x4 (&acc)[2][2][4][2], const pg8::Unit& u, int wr, int wc, int fr, int fq) const {
        const int row0 = u.pm * 256 + wr * 64 + fr, col0 = u.pn * 256 + wc * 32 + 4 * fq;
        const float* gp = gate + (size_t)((u.pm * 256) >> 12) * MODW;
        pg8::f32x4 gv[2][2];
#pragma unroll
        for (int bj = 0; bj < 2; ++bj)
#pragma unroll
            for (int n = 0; n < 2; ++n) gv[bj][n] = *(const pg8::f32x4*)(gp + col0 + bj * 128 + n * 16) * gscale;
#pragma unroll
        for (int ai = 0; ai < 2; ++ai)
#pragma unroll
            for (int m = 0; m < 4; ++m) {
                const size_t ro = (size_t)(row0 + ai * 128 + m * 16) * D + col0;
#pragma unroll
                for (int bj = 0; bj < 2; ++bj)
#pragma unroll
                    for (int n = 0; n < 2; ++n) {
                        const pg8::f32x4 xv = *(const pg8::f32x4*)(X + ro + bj * 128 + n * 16);
                        *(pg8::f32x4*)(O + ro + bj * 128 + n * 16) = xv + gv[bj][n] * acc[ai][bj][m][n];
                    }
            }
    }
};

DEV void ph_mod(const float* __restrict__ c, const float* __restrict__ w_mod, const float* __restrict__ b_mod, float* __restrict__ mod, LAS float* red, int vcu, int G, int tid) {
    const int lane = tid & 63, wave = tid >> 6;
    for (int it = vcu; it < 2 * 192; it += G) {
        const int l = it / 192, cb = it % 192;
        const int k0 = wave * 256;
        const float* W = w_mod + ((size_t)l * D + k0) * MODW + cb * 64 + lane;
        float a0 = 0.f, a1 = 0.f;
#pragma unroll 16
        for (int k = 0; k < 256; ++k) {
            const float w = W[(size_t)k * MODW];
            const float c0 = c[k0 + k], c1 = c[D + k0 + k];
            a0 += (c0 * sigmoid_f(c0)) * w; a1 += (c1 * sigmoid_f(c1)) * w;
        }
        red[(wave * 2 + 0) * 64 + lane] = a0; red[(wave * 2 + 1) * 64 + lane] = a1;
        __syncthreads();
        if (tid < 128) {
            const int b = tid >> 6, ln = tid & 63; float s = 0.f;
#pragma unroll
            for (int w = 0; w < 8; ++w) s += red[(w * 2 + b) * 64 + ln];
            const int col = cb * 64 + ln;
            mod[(size_t)(l * 2 + b) * MODW + col] = s + b_mod[l * MODW + col];
        }
        __syncthreads();
    }
}
DEV void transpose_item(const float* __restrict__ W, int K, int N, bf16* __restrict__ WT, LAS float* scr, int item, int lane) {
    const int nblk = N / 32, kb = item / nblk, nb = item % nblk, k0 = 64 * kb, n0 = 32 * nb;
#pragma unroll 8
    for (int i = 0; i < 32; ++i) { const int kk = 2 * i + (lane >> 5); scr[kk * 33 + (lane & 31)] = W[(size_t)(k0 + kk) * N + n0 + (lane & 31)]; }
    LDS_WAIT();
    const int c = lane & 7;
#pragma unroll
    for (int j = 0; j < 4; ++j) { const int n = (lane >> 3) + 8 * j; const LAS float* s = scr + (8 * c) * 33 + n;
        v4u o; o.x = pk2(s[0 * 33], s[1 * 33]); o.y = pk2(s[2 * 33], s[3 * 33]); o.z = pk2(s[4 * 33], s[5 * 33]); o.w = pk2(s[6 * 33], s[7 * 33]);
        *(v4u*)(WT + (size_t)(n0 + n) * K + k0 + 8 * c) = o; }
    LDS_WAIT();
}
DEV void convert_copy(const float* __restrict__ src, bf16* __restrict__ dst, size_t ngroups8, size_t gtid, size_t gstride) {
    for (size_t g = gtid; g < ngroups8; g += gstride) {
        const f32x4 a = *(const f32x4*)(src + g * 8), b = *(const f32x4*)(src + g * 8 + 4);
        v4u o; o.x = pk2(a.x, a.y); o.y = pk2(a.z, a.w); o.z = pk2(b.x, b.y); o.w = pk2(b.z, b.w);
        *(v4u*)(dst + g * 8) = o;
    }
}

DEV void modnorm_rows(const float* __restrict__ X, const float* __restrict__ gain, const float* __restrict__ modl, int sh_off, int sc_off, bf16* __restrict__ H, int gw, int NGW, int lane) {
    for (int m = gw; m < M; m += NGW) {
        const int b = m >> 12;
        const f32x4* xr = (const f32x4*)(X + (size_t)m * D) + lane;
        f32x4 v[8]; float s = 0.f;
#pragma unroll
        for (int j = 0; j < 8; ++j) { v[j] = xr[64 * j]; s += (v[j].x * v[j].x + v[j].y * v[j].y) + (v[j].z * v[j].z + v[j].w * v[j].w); }
        const float r = rsqrtf(wave_sum(s) * (1.f / D) + EPS);
        const f32x4* g4 = (const f32x4*)gain + lane;
        const f32x4* sc4 = (const f32x4*)(modl + (size_t)b * MODW + sc_off) + lane;
        const f32x4* sh4 = (const f32x4*)(modl + (size_t)b * MODW + sh_off) + lane;
        unsigned long long* o8 = (unsigned long long*)(H + (size_t)m * D) + lane;
#pragma unroll
        for (int j = 0; j < 8; ++j) {
            const f32x4 g = g4[64 * j], sc = sc4[64 * j], sh = sh4[64 * j];
            const f32x4 y = (v[j] * r) * g * (sc + 1.f) + sh;
            o8[64 * j] = (unsigned long long)pk2(y.x, y.y) | ((unsigned long long)pk2(y.z, y.w) << 32);
        }
    }
}

DEV void lru_item(int l, int b, int j, int n, const bf16* __restrict__ Z, const float* __restrict__ conv_w, const float* __restrict__ conv_b,
                  const float* __restrict__ w_rec, const float* __restrict__ b_rec, const float* __restrict__ w_gi, const float* __restrict__ b_gi, const float* __restrict__ lam,
                  float* __restrict__ HLOC, float* __restrict__ PP, float* __restrict__ SUMA, float* __restrict__ SUMB, LAS float* xc, LAS float* aL, LAS float* uL, int tid) {
    const int ch = tid & 127, tq = tid >> 7, c = n * 128 + ch;
    {
        const float cw0 = conv_w[(l * 4 + 0) * LRU_W + c], cw1 = conv_w[(l * 4 + 1) * LRU_W + c], cw2 = conv_w[(l * 4 + 2) * LRU_W + c], cw3 = conv_w[(l * 4 + 3) * LRU_W + c];
        const float cb = conv_b[l * LRU_W + c];
#pragma unroll 4
        for (int i = 0; i < 16; ++i) {
            const int tok = tq + 4 * i, t = j * 64 + tok;
            const bf16* zp = Z + ((size_t)b * SEQ + t) * IN_W + ZO_XA + c;
            float s = cb + cw3 * bf1(zp[0]);
            if (t >= 1) s += cw2 * bf1(zp[-(ptrdiff_t)IN_W]);
            if (t >= 2) s += cw1 * bf1(zp[-(ptrdiff_t)2 * IN_W]);
            if (t >= 3) s += cw0 * bf1(zp[-(ptrdiff_t)3 * IN_W]);
            xc[tok * 128 + ch] = s;
        }
    }
    __syncthreads();
    float accr[16], acci[16];
#pragma unroll
    for (int i = 0; i < 16; ++i) { accr[i] = 0.f; acci[i] = 0.f; }
    const float* Wr = w_rec + ((size_t)(l * 6 + n) * 128) * 128 + ch;
    const float* Wi = w_gi + ((size_t)(l * 6 + n) * 128) * 128 + ch;
#pragma unroll 2
    for (int jj = 0; jj < 128; ++jj) {
        const float wr = Wr[jj * 128], wi = Wi[jj * 128];
#pragma unroll
        for (int i = 0; i < 16; ++i) { const float x = xc[(tq + 4 * i) * 128 + jj]; accr[i] += x * wr; acci[i] += x * wi; }
    }
    {
        const float br = b_rec[l * LRU_W + c], bi = b_gi[l * LRU_W + c], sp = softplus_f(-lam[l * LRU_W + c]);
#pragma unroll
        for (int i = 0; i < 16; ++i) {
            const int tok = tq + 4 * i;
            const float r = sigmoid_f(accr[i] + br), ig = sigmoid_f(acci[i] + bi);
            const float log_a = -8.0f * r * sp;
            const float av = __expf(log_a);
            const float x = xc[tok * 128 + ch];
            const float uv = sqrtf(fmaxf(-expm1f(2.f * log_a), 0.f)) * (ig * x);
            aL[tok * 128 + ch] = av; uL[tok * 128 + ch] = uv;
        }
    }
    __syncthreads();
    if (tid < 128) {
        float h = 0.f, P = 1.f;
        const size_t rb = ((size_t)b * SEQ + j * 64) * LRU_W + n * 128 + tid;
        for (int tok = 0; tok < 64; ++tok) {
            const float av = aL[tok * 128 + tid];
            h = av * h + uL[tok * 128 + tid]; P *= av;
            HLOC[rb + (size_t)tok * LRU_W] = h; PP[rb + (size_t)tok * LRU_W] = P;
        }
        SUMA[(size_t)(b * 64 + j) * LRU_W + n * 128 + tid] = P; SUMB[(size_t)(b * 64 + j) * LRU_W + n * 128 + tid] = h;
    }
    __syncthreads();
}

DEV void dil_item(int b, int h, int t, const bf16* __restrict__ Z, const float* __restrict__ rel_bias, float* __restrict__ YB, LAS float* qs, LAS float* lg, int lane) {
    const size_t row = (size_t)b * SEQ + t;
    { const unsigned w = *(const unsigned*)(Z + row * IN_W + ZO_QB + h * 128 + 2 * lane); qs[2 * lane] = bf_lo(w) * QSCALE; qs[2 * lane + 1] = bf_hi(w) * QSCALE; }
    LDS_WAIT();
    float mx = NEGBIG;
#pragma unroll
    for (int p = 0; p < 3; ++p) {
        const int d = 1 << (2 * p);
        for (int jj = lane; jj < 129; jj += 64) {
            const int pos = t - jj * d; float lgt = NEGBIG;
            if (pos >= 0) {
                const v4u* kr = (const v4u*)(Z + ((size_t)b * SEQ + pos) * IN_W + ZO_KB + h * 128);
                float s = 0.f;
#pragma unroll 4
                for (int c8 = 0; c8 < 16; ++c8) { const v4u kv = kr[c8]; const LAS float* q = qs + c8 * 8;
                    s += q[0] * bf_lo(kv.x) + q[1] * bf_hi(kv.x) + q[2] * bf_lo(kv.y) + q[3] * bf_hi(kv.y) + q[4] * bf_lo(kv.z) + q[5] * bf_hi(kv.z) + q[6] * bf_lo(kv.w) + q[7] * bf_hi(kv.w); }
                lgt = s + rel_bias[(int)T5B[p][jj] * 6 + h];
            }
            lg[p * 129 + jj] = lgt; mx = fmaxf(mx, lgt);
        }
    }
    mx = wave_max(mx);
    LDS_WAIT();
    float sum = 0.f;
    for (int idx = lane; idx < 387; idx += 64) { const float v = lg[idx]; const float pv = (v > -1.0e37f) ? __expf(v - mx) : 0.f; lg[idx] = pv; sum += pv; }
    sum = wave_sum(sum);
    LDS_WAIT();
    float a0 = 0.f, a1 = 0.f;
#pragma unroll
    for (int p = 0; p < 3; ++p) {
        const int d = 1 << (2 * p);
        int nk = t / d + 1; nk = nk > 129 ? 129 : nk;
        const bf16* vb = Z + row * IN_W + ZO_VB + h * 128 + 2 * lane;
#pragma unroll 4
        for (int jj = 0; jj < nk; ++jj) {
            const float pv = lg[p * 129 + jj];
            const unsigned w = *(const unsigned*)(vb - (size_t)jj * d * IN_W);
            a0 += pv * bf_lo(w); a1 += pv * bf_hi(w);
        }
    }
    const float inv = 1.f / sum;
    *(f32x2*)(YB + row * SWA_W + h * 128 + 2 * lane) = (f32x2){a0 * inv, a1 * inv};
    LDS_WAIT();
}


DEV unsigned cvtpk_bf16(float lo, float hi) { f32x2 v = {lo, hi}; bf16x2_t b = __builtin_convertvector(v, bf16x2_t); return __builtin_bit_cast(unsigned, b); }
constexpr int DIL_VSTR = 256;
constexpr int ATT_KOFF = 32 * DIL_VSTR;
constexpr int ATT_BOFF = ATT_KOFF + 8192;
constexpr int DIL_QOFF = ATT_BOFF + 132 * 4;
constexpr int ATT_WLDS = 17920;
static_assert(DIL_QOFF <= ATT_WLDS && 8 * ATT_WLDS <= LDS_MISC, "attention LDS");

DEV unsigned vimg_off(unsigned row, unsigned ch) { return 256u * row + 16u * (ch ^ (((row & 3u) << 2) | ((row >> 2) & 3u))); }
typedef short s16x4 __attribute__((ext_vector_type(4)));
DEV bf16x8 vfrag_tr(LAS unsigned char* img, int lane, int c, int ks) {
    const unsigned h = lane >> 5, blk = (lane >> 4) & 1, qq = (lane & 15) >> 2, pp = lane & 3;
    const s16x4 a = __builtin_amdgcn_ds_read_tr16_b64_v4i16((LAS s16x4*)(img + vimg_off(16 * ks + 8 * h + 0 + qq, 4 * c + 2 * blk + (pp >> 1)) + 8 * (pp & 1)));
    const s16x4 b = __builtin_amdgcn_ds_read_tr16_b64_v4i16((LAS s16x4*)(img + vimg_off(16 * ks + 8 * h + 4 + qq, 4 * c + 2 * blk + (pp >> 1)) + 8 * (pp & 1)));
    return __builtin_shufflevector(a, b, 0, 1, 2, 3, 4, 5, 6, 7);
}
DEV void dil_mfma_item(int b, int h, int p, int rr, int i0, const bf16* __restrict__ Z, const float* __restrict__ rel_bias, bf16* __restrict__ PART, float* __restrict__ LSE, LAS unsigned char* wl, int lane) {
    asm volatile("" : "+v"(lane));
    const int r = lane & 31, hh = lane >> 5;
    const int d = 1 << (2 * p);
    LAS float* biasL = (LAS float*)(wl + ATT_BOFF);
    for (int dd = lane; dd < 129; dd += 64) biasL[dd] = rel_bias[(int)T5B[p][dd] * 6 + h];
    const size_t rowq = (size_t)b * SEQ + rr + d * (i0 + r);
    bf16x8 qf[8];
    { const bf16* qrow = Z + rowq * IN_W + ZO_QB + h * 128 + 8 * hh;
#pragma unroll
      for (int ks = 0; ks < 8; ++ks) qf[ks] = *(const bf16x8*)(qrow + 16 * ks); }
    float m_run = NEGBIG, l_run = 0.f;
    f32x16 o[4];
#pragma unroll
    for (int dt = 0; dt < 4; ++dt)
#pragma unroll
        for (int e = 0; e < 16; ++e) o[dt][e] = 0.f;
    const int kap = (r & 0x13) | ((r & 4) << 1) | ((r & 8) >> 1);
    int jt = 4 - (i0 >> 5); jt = jt < 0 ? 0 : jt;
#define DIL_DMA_K(JT) do { int jk = i0 - 128 + 32 * (JT) + kap; jk = jk < 0 ? 0 : jk; const bf16* krow = Z + ((size_t)b * SEQ + rr + d * jk) * IN_W + ZO_KB + h * 128 + 8 * hh; \
        _Pragma("unroll") for (int ks = 0; ks < 8; ++ks) __builtin_amdgcn_global_load_lds((const unsigned*)(krow + 16 * ks), (LAS unsigned*)(wl + ATT_KOFF + 1024 * ks), 16, 0, 0); } while (0)
#define DIL_DMA_V(JT) do { const int j0_ = i0 - 128 + 32 * (JT); _Pragma("unroll") for (int q = 0; q < 8; ++q) { const int pi = lane + 64 * q, kl = pi >> 4, c = (pi & 15) ^ (((kl & 3) << 2) | ((kl >> 2) & 3)); int j = j0_ + kl; j = j < 0 ? 0 : j; \
        __builtin_amdgcn_global_load_lds((const unsigned*)(Z + ((size_t)b * SEQ + rr + d * j) * IN_W + ZO_VB + h * 128 + 8 * c), (LAS unsigned*)(wl + 1024 * q), 16, 0, 0); } } while (0)
    LDS_WAIT();
    DIL_DMA_K(jt); DIL_DMA_V(jt);
    for (; jt < 5; ++jt) {
        const int j0 = i0 - 128 + 32 * jt;
        const int jn = jt < 4 ? jt + 1 : 4;
        asm volatile("s_waitcnt vmcnt(8)" ::: "memory");
        f32x16 sacc;
#pragma unroll
        for (int e = 0; e < 16; ++e) sacc[e] = 0.f;
        {
            bf16x8 kf[8];
#pragma unroll
            for (int ks = 0; ks < 8; ++ks) kf[ks] = *((const LAS bf16x8*)(wl + ATT_KOFF + 1024 * ks) + lane);
#pragma unroll
            for (int ks = 0; ks < 8; ++ks) sacc = __builtin_amdgcn_mfma_f32_32x32x16_bf16(kf[ks], qf[ks], sacc, 0, 0, 0);
        }
        LDS_WAIT();
        DIL_DMA_K(jn);
        float tm = NEGBIG;
#pragma unroll
        for (int e = 0; e < 16; ++e) {
            const int j = j0 + 16 * (e >> 3) + 8 * hh + (e & 7);
            const int dist = (i0 + r) - j;
            const bool valid = (j >= 0) && (dist >= 0) && (dist <= 128);
            const int dc = dist < 0 ? 0 : (dist > 128 ? 128 : dist);
            const float bv = biasL[dc];
            const float lg = valid ? sacc[e] * QSCALE + bv : NEGBIG;
            sacc[e] = lg; tm = fmaxf(tm, lg);
        }
        tm = max32(tm);
        const float m_new = fmaxf(m_run, tm);
        const float alpha = __expf(m_run - m_new);
        float ps = 0.f;
#pragma unroll
        for (int e = 0; e < 16; ++e) { const float pv = (sacc[e] > -1.0e37f) ? __expf(sacc[e] - m_new) : 0.f; sacc[e] = pv; ps += pv; }
        ps = sum32(ps);
        l_run = l_run * alpha + ps; m_run = m_new;
#pragma unroll
        for (int dt = 0; dt < 4; ++dt)
#pragma unroll
            for (int e = 0; e < 16; ++e) o[dt][e] *= alpha;
        bf16x8 pf[2];
#pragma unroll
        for (int s2 = 0; s2 < 2; ++s2) { v4u w; w.x = cvtpk_bf16(sacc[8 * s2 + 0], sacc[8 * s2 + 1]); w.y = cvtpk_bf16(sacc[8 * s2 + 2], sacc[8 * s2 + 3]);
            w.z = cvtpk_bf16(sacc[8 * s2 + 4], sacc[8 * s2 + 5]); w.w = cvtpk_bf16(sacc[8 * s2 + 6], sacc[8 * s2 + 7]); pf[s2] = __builtin_bit_cast(bf16x8, w); }
        asm volatile("s_waitcnt vmcnt(8)" ::: "memory");
#pragma unroll
        for (int dt = 0; dt < 4; ++dt)
#pragma unroll
            for (int s2 = 0; s2 < 2; ++s2) o[dt] = __builtin_amdgcn_mfma_f32_32x32x16_bf16(vfrag_tr(wl, lane, dt, s2), pf[s2], o[dt], 0, 0, 0);
        LDS_WAIT();
        DIL_DMA_V(jn);
    }
    asm volatile("s_waitcnt vmcnt(0)" ::: "memory");
#undef DIL_DMA_V
#undef DIL_DMA_K
    const float inv = 1.f / l_run;
    bf16* po = PART + ((size_t)p * M + rowq) * SWA_W + h * 128;
#pragma unroll
    for (int dt = 0; dt < 4; ++dt)
#pragma unroll
        for (int g = 0; g < 4; ++g)
            *(unsigned long long*)(po + 32 * dt + 8 * g + 4 * hh) = (unsigned long long)pk2(o[dt][4 * g + 0] * inv, o[dt][4 * g + 1] * inv) | ((unsigned long long)pk2(o[dt][4 * g + 2] * inv, o[dt][4 * g + 3] * inv) << 32);
    if (hh == 0) LSE[((size_t)p * M + rowq) * 6 + h] = m_run + __logf(l_run);
}

DEV void sb_item(int b, int h, int t, const bf16* __restrict__ Z, float* __restrict__ YC, LAS float* qs, LAS float* pA, int lane) {
    const size_t row = (size_t)b * SEQ + t;
    { const unsigned w = *(const unsigned*)(Z + row * IN_W + ZO_QC + h * 128 + 2 * lane); qs[2 * lane] = bf_lo(w) * QSCALE; qs[2 * lane + 1] = bf_hi(w) * QSCALE; }
    LDS_WAIT();
    float carry = 0.f, a0 = 0.f, a1 = 0.f;
    for (int shi = t - 1; shi >= 0; shi -= 64) {
        const int s = shi - lane; const bool valid = s >= 0;
        float z = 0.f;
        if (valid) {
            const v4u* kr = (const v4u*)(Z + ((size_t)b * SEQ + s) * IN_W + ZO_KC + h * 128);
#pragma unroll 4
            for (int c8 = 0; c8 < 16; ++c8) { const v4u kv = kr[c8]; const LAS float* q = qs + c8 * 8;
                z += q[0] * bf_lo(kv.x) + q[1] * bf_hi(kv.x) + q[2] * bf_lo(kv.y) + q[3] * bf_hi(kv.y) + q[4] * bf_lo(kv.z) + q[5] * bf_hi(kv.z) + q[6] * bf_lo(kv.w) + q[7] * bf_hi(kv.w); }
        }
        const float l1m = valid ? -softplus_f(z) : 0.f;
        float inc = l1m;
#pragma unroll
        for (int o = 1; o < 64; o <<= 1) { const float tmp = __shfl_up(inc, o); if (lane >= o) inc += tmp; }
        const float A = valid ? __expf(-softplus_f(-z) + carry + (inc - l1m)) : 0.f;
        carry += __shfl(inc, 63);
        pA[lane] = A;
        const bool done = carry < -105.0f;
        LDS_WAIT();
        const int nk = (shi + 1) < 64 ? (shi + 1) : 64;
        const bf16* vb = Z + ((size_t)b * SEQ + shi) * IN_W + ZO_VC + h * 128 + 2 * lane;
#pragma unroll 4
        for (int i = 0; i < nk; ++i) {
            const float pv = pA[i];
            const unsigned w = *(const unsigned*)(vb - (size_t)i * IN_W);
            a0 += pv * bf_lo(w); a1 += pv * bf_hi(w);
        }
        LDS_WAIT();
        if (done) break;
    }
    *(f32x2*)(YC + row * SB_W + h * 128 + 2 * lane) = (f32x2){a0, a1};
}


DEV void lru_item2(int l, int b, int j, int n, const bf16* __restrict__ Z, const float* __restrict__ conv_w, const float* __restrict__ conv_b, const bf16* __restrict__ WGT,
                   const float* __restrict__ b_rec, const float* __restrict__ b_gi, const float* __restrict__ lam,
                   bf16* __restrict__ HLOC, bf16* __restrict__ PP, float* __restrict__ SUMA, float* __restrict__ SUMB, LAS float* xc, LAS float* g0L, LAS float* g1L, int tid) {
    const int ch = tid & 127, tq = tid >> 7, c = n * 128 + ch;
    {
        const float cw0 = conv_w[(l * 4 + 0) * LRU_W + c], cw1 = conv_w[(l * 4 + 1) * LRU_W + c], cw2 = conv_w[(l * 4 + 2) * LRU_W + c], cw3 = conv_w[(l * 4 + 3) * LRU_W + c];
        const float cb = conv_b[l * LRU_W + c];
#pragma unroll 4
        for (int i = 0; i < 16; ++i) {
            const int tok = tq + 4 * i, t = j * 64 + tok;
            const bf16* zp = Z + ((size_t)b * SEQ + t) * IN_W + ZO_XA + c;
            float s = cb + cw3 * bf1(zp[0]);
            if (t >= 1) s += cw2 * bf1(zp[-(ptrdiff_t)IN_W]);
            if (t >= 2) s += cw1 * bf1(zp[-(ptrdiff_t)2 * IN_W]);
            if (t >= 3) s += cw0 * bf1(zp[-(ptrdiff_t)3 * IN_W]);
            xc[tok * 132 + ch] = s;
        }
    }
    __syncthreads();
    {
        const int lane = tid & 63, wave = tid >> 6, r = lane & 31, hh = lane >> 5, g = wave >> 2, ct = wave & 3;
        const bf16* wp = WGT + (((size_t)(l * 6 + n) * 2 + g) * 128 + ct * 32 + r) * 128 + 8 * hh;
        bf16x8 bfr[8];
#pragma unroll
        for (int ks = 0; ks < 8; ++ks) bfr[ks] = *(const bf16x8*)(wp + 16 * ks);
        LAS float* gL = g ? g1L : g0L;
#pragma unroll
        for (int rt = 0; rt < 2; ++rt) {
            f32x16 acc;
#pragma unroll
            for (int e = 0; e < 16; ++e) acc[e] = 0.f;
#pragma unroll
            for (int ks = 0; ks < 8; ++ks) {
                const LAS float* xp = xc + (32 * rt + r) * 132 + 16 * ks + 8 * hh;
                const f32x4 x0 = *(const LAS f32x4*)xp, x1 = *(const LAS f32x4*)(xp + 4);
                v4u w; w.x = cvtpk_bf16(x0.x, x0.y); w.y = cvtpk_bf16(x0.z, x0.w); w.z = cvtpk_bf16(x1.x, x1.y); w.w = cvtpk_bf16(x1.z, x1.w);
                acc = __builtin_amdgcn_mfma_f32_32x32x16_bf16(__builtin_bit_cast(bf16x8, w), bfr[ks], acc, 0, 0, 0);
            }
#pragma unroll
            for (int e = 0; e < 16; ++e) { const int tok = 32 * rt + (e & 3) + 8 * (e >> 2) + 4 * hh; gL[tok * 132 + ct * 32 + r] = acc[e]; }
        }
    }
    __syncthreads();
    {
        const float br = b_rec[l * LRU_W + c], bi = b_gi[l * LRU_W + c], sp = softplus_f(-lam[l * LRU_W + c]);
#pragma unroll 4
        for (int i = 0; i < 16; ++i) {
            const int tok = tq + 4 * i;
            const float rg = sigmoid_f(g0L[tok * 132 + ch] + br), ig = sigmoid_f(g1L[tok * 132 + ch] + bi);
            const float log_a = -8.0f * rg * sp;
            const float av = __expf(log_a);
            const float x = xc[tok * 132 + ch];
            const float uv = sqrtf(fmaxf(-expm1f(2.f * log_a), 0.f)) * (ig * x);
            g0L[tok * 132 + ch] = av; g1L[tok * 132 + ch] = uv;
        }
    }
    __syncthreads();
    if (tid < 128) {
        float h = 0.f, P = 1.f;
        const size_t rb = ((size_t)b * SEQ + j * 64) * LRU_W + n * 128 + tid;
#pragma unroll 8
        for (int tok = 0; tok < 64; ++tok) {
            const float av = g0L[tok * 132 + tid];
            h = av * h + g1L[tok * 132 + tid]; P *= av;
            HLOC[rb + (size_t)tok * LRU_W] = (bf16)f2bf(h); PP[rb + (size_t)tok * LRU_W] = (bf16)f2bf(P);
        }
        SUMA[(size_t)(b * 64 + j) * LRU_W + n * 128 + tid] = P; SUMB[(size_t)(b * 64 + j) * LRU_W + n * 128 + tid] = h;
    }
    __syncthreads();
}

DEV void sb_mfma_item(int b, int h, int t0, const bf16* __restrict__ Z, bf16* __restrict__ YC, LAS unsigned char* wl, int lane) {
    asm volatile("" : "+v"(lane));
    const int r = lane & 31, hh = lane >> 5;
    const size_t rowq = (size_t)b * SEQ + t0 + r;
    bf16x8 qf[8];
    { const bf16* qrow = Z + rowq * IN_W + ZO_QC + h * 128 + 8 * hh;
#pragma unroll
      for (int ks = 0; ks < 8; ++ks) qf[ks] = *(const bf16x8*)(qrow + 16 * ks); }
    f32x16 o[4];
#pragma unroll
    for (int dt = 0; dt < 4; ++dt)
#pragma unroll
        for (int e = 0; e < 16; ++e) o[dt][e] = 0.f;
    const int kap = (r & 0x13) | ((r & 4) << 1) | ((r & 8) >> 1);
    float carry = 0.f;
#define SB_DMA_K(K0) do { const bf16* krow = Z + ((size_t)b * SEQ + (K0) + kap) * IN_W + ZO_KC + h * 128 + 8 * hh; \
        _Pragma("unroll") for (int ks = 0; ks < 8; ++ks) __builtin_amdgcn_global_load_lds((const unsigned*)(krow + 16 * ks), (LAS unsigned*)(wl + ATT_KOFF + 1024 * ks), 16, 0, 0); } while (0)
#define SB_DMA_V(K0) do { _Pragma("unroll") for (int q = 0; q < 8; ++q) { const int pi = lane + 64 * q, kl = pi >> 4, c = (pi & 15) ^ (((kl & 3) << 2) | ((kl >> 2) & 3)); \
        __builtin_amdgcn_global_load_lds((const unsigned*)(Z + ((size_t)b * SEQ + (K0) + kl) * IN_W + ZO_VC + h * 128 + 8 * c), (LAS unsigned*)(wl + 1024 * q), 16, 0, 0); } } while (0)
    LDS_WAIT();
    SB_DMA_K(t0); SB_DMA_V(t0);
    for (int k0 = t0; k0 >= 0; k0 -= 32) {
        const int kn = k0 >= 32 ? k0 - 32 : 0;
        asm volatile("s_waitcnt vmcnt(8)" ::: "memory");
        f32x16 sacc;
#pragma unroll
        for (int e = 0; e < 16; ++e) sacc[e] = 0.f;
        {
            bf16x8 kf[8];
#pragma unroll
            for (int ks = 0; ks < 8; ++ks) kf[ks] = *((const LAS bf16x8*)(wl + ATT_KOFF + 1024 * ks) + lane);
#pragma unroll
            for (int ks = 0; ks < 8; ++ks) sacc = __builtin_amdgcn_mfma_f32_32x32x16_bf16(kf[ks], qf[ks], sacc, 0, 0, 0);
        }
        LDS_WAIT();
        SB_DMA_K(kn);
        float l1[16]; float T0 = 0.f, T1 = 0.f;
#pragma unroll
        for (int e = 0; e < 16; ++e) {
            const int key = k0 + 16 * (e >> 3) + 8 * hh + (e & 7);
            const bool valid = key < t0 + r;
            const float z = sacc[e] * QSCALE;
            sacc[e] = z;
            l1[e] = valid ? -(fmaxf(z, 0.f) + __logf(1.f + __expf(-fabsf(z)))) : 0.f;
        }
#pragma unroll
        for (int e = 0; e < 8; ++e) { T0 += l1[e]; T1 += l1[8 + e]; }
        const float PT0 = partner32(T0, hh), PT1 = partner32(T1, hh);
        const float base1 = carry + (hh ? 0.f : PT1);
        const float base0 = carry + (hh ? (T1 + PT1) : (PT1 + T1 + PT0));
        float run1 = base1, run0 = base0;
#pragma unroll
        for (int e = 7; e >= 0; --e) {
            { const int key = k0 + 16 + 8 * hh + e; const bool valid = key < t0 + r; const float a = valid ? __expf(sacc[8 + e] + l1[8 + e] + run1) : 0.f; run1 += l1[8 + e]; sacc[8 + e] = a; }
            { const int key = k0 + 8 * hh + e; const bool valid = key < t0 + r; const float a = valid ? __expf(sacc[e] + l1[e] + run0) : 0.f; run0 += l1[e]; sacc[e] = a; }
        }
        carry += (T0 + T1) + (PT0 + PT1);
        bf16x8 pf[2];
#pragma unroll
        for (int s2 = 0; s2 < 2; ++s2) { v4u w; w.x = cvtpk_bf16(sacc[8 * s2 + 0], sacc[8 * s2 + 1]); w.y = cvtpk_bf16(sacc[8 * s2 + 2], sacc[8 * s2 + 3]);
            w.z = cvtpk_bf16(sacc[8 * s2 + 4], sacc[8 * s2 + 5]); w.w = cvtpk_bf16(sacc[8 * s2 + 6], sacc[8 * s2 + 7]); pf[s2] = __builtin_bit_cast(bf16x8, w); }
        asm volatile("s_waitcnt vmcnt(8)" ::: "memory");
#pragma unroll
        for (int dt = 0; dt < 4; ++dt)
#pragma unroll
            for (int s2 = 0; s2 < 2; ++s2) o[dt] = __builtin_amdgcn_mfma_f32_32x32x16_bf16(vfrag_tr(wl, lane, dt, s2), pf[s2], o[dt], 0, 0, 0);
        LDS_WAIT();
        SB_DMA_V(kn);
        if (__all(carry < -105.0f)) break;
    }
    asm volatile("s_waitcnt vmcnt(0)" ::: "memory");
#undef SB_DMA_V
#undef SB_DMA_K
    bf16* po = YC + rowq * SB_W + h * 128;
#pragma unroll
    for (int dt = 0; dt < 4; ++dt)
#pragma unroll
        for (int g = 0; g < 4; ++g)
            *(unsigned long long*)(po + 32 * dt + 8 * g + 4 * hh) = (unsigned long long)pk2(o[dt][4 * g + 0], o[dt][4 * g + 1]) | ((unsigned long long)pk2(o[dt][4 * g + 2], o[dt][4 * g + 3]) << 32);
}

DEV void combine_item(int l, int b, int j, int half, const bf16* __restrict__ Z, const bf16* __restrict__ HLOC, const bf16* __restrict__ PP, const float* __restrict__ SUMA, const float* __restrict__ SUMB,
                      const bf16* __restrict__ PART, const float* __restrict__ LSE, const bf16* __restrict__ YC, const float* __restrict__ g_lru, const float* __restrict__ g_swa, const float* __restrict__ g_sb,
                      bf16* __restrict__ Y, LAS float* carryL, int tid) {
    const int lane = tid & 63, wave = tid >> 6;
    for (int c = tid; c < LRU_W; c += 512) {
        float cr = 0.f;
        for (int i = 0; i < j; ++i) cr = SUMA[(size_t)(b * 64 + i) * LRU_W + c] * cr + SUMB[(size_t)(b * 64 + i) * LRU_W + c];
        carryL[c] = cr;
    }
    __syncthreads();
    for (int i = 0; i < 4; ++i) {
        const int tok = half * 32 + wave * 4 + i;
        const size_t row = (size_t)b * SEQ + j * 64 + tok;
        bf16* yo = Y + row * D;
        {
            float ya[12]; float ssq = 0.f;
#pragma unroll
            for (int e = 0; e < 6; ++e) { const int c = 2 * lane + 128 * e;
                const unsigned hw = *(const unsigned*)(HLOC + row * LRU_W + c), pw = *(const unsigned*)(PP + row * LRU_W + c), gw2 = *(const unsigned*)(Z + row * IN_W + ZO_GA + c);
                const f32x2 cr = *(const LAS f32x2*)(carryL + c);
                ya[2 * e] = (bf_lo(hw) + bf_lo(pw) * cr.x) * gelu_tanh(bf_lo(gw2)); ya[2 * e + 1] = (bf_hi(hw) + bf_hi(pw) * cr.y) * gelu_tanh(bf_hi(gw2));
                ssq += ya[2 * e] * ya[2 * e] + ya[2 * e + 1] * ya[2 * e + 1]; }
            const float r = rsqrtf(wave_sum(ssq) * (1.f / LRU_W) + EPS);
#pragma unroll
            for (int e = 0; e < 6; ++e) { const int c = 2 * lane + 128 * e; const f32x2 g = *(const f32x2*)(g_lru + l * LRU_W + c);
                *(unsigned*)(yo + c) = (MK_DBG & 16) ? 0u : pk2(ya[2 * e] * r * g.x, ya[2 * e + 1] * r * g.y); }
        }
        {
            float yb[12]; float ssq = 0.f;
#pragma unroll
            for (int e = 0; e < 6; ++e) { const int c = 2 * lane + 128 * e;
                const float l0 = LSE[((size_t)0 * M + row) * 6 + e], l1 = LSE[((size_t)1 * M + row) * 6 + e], l2 = LSE[((size_t)2 * M + row) * 6 + e];
                const float mx = fmaxf(l0, fmaxf(l1, l2)); const float e0 = __expf(l0 - mx), e1 = __expf(l1 - mx), e2 = __expf(l2 - mx); const float iz = 1.f / (e0 + e1 + e2);
                const unsigned p0 = *(const unsigned*)(PART + ((size_t)0 * M + row) * SWA_W + c), p1 = *(const unsigned*)(PART + ((size_t)1 * M + row) * SWA_W + c), p2 = *(const unsigned*)(PART + ((size_t)2 * M + row) * SWA_W + c);
                yb[2 * e] = (e0 * bf_lo(p0) + e1 * bf_lo(p1) + e2 * bf_lo(p2)) * iz; yb[2 * e + 1] = (e0 * bf_hi(p0) + e1 * bf_hi(p1) + e2 * bf_hi(p2)) * iz;
                ssq += yb[2 * e] * yb[2 * e] + yb[2 * e + 1] * yb[2 * e + 1]; }
            const float r = rsqrtf(wave_sum(ssq) * (1.f / SWA_W) + EPS);
#pragma unroll
            for (int e = 0; e < 6; ++e) { const int c = 2 * lane + 128 * e; const f32x2 g = *(const f32x2*)(g_swa + l * SWA_W + c);
                *(unsigned*)(yo + LRU_W + c) = (MK_DBG & 32) ? 0u : pk2(yb[2 * e] * r * g.x, yb[2 * e + 1] * r * g.y); }
        }
        {
            float yc[8]; float ssq = 0.f;
#pragma unroll
            for (int e = 0; e < 4; ++e) { const int c = 2 * lane + 128 * e; const unsigned w = *(const unsigned*)(YC + row * SB_W + c); yc[2 * e] = bf_lo(w); yc[2 * e + 1] = bf_hi(w); ssq += yc[2 * e] * yc[2 * e] + yc[2 * e + 1] * yc[2 * e + 1]; }
            const float r = rsqrtf(wave_sum(ssq) * (1.f / SB_W) + EPS);
#pragma unroll
            for (int e = 0; e < 4; ++e) { const int c = 2 * lane + 128 * e; const f32x2 g = *(const f32x2*)(g_sb + l * SB_W + c);
                *(unsigned*)(yo + LRU_W + SWA_W + c) = (MK_DBG & 64) ? 0u : pk2(yc[2 * e] * r * g.x, yc[2 * e + 1] * r * g.y); }
        }
    }
    __syncthreads();
}

constexpr int RT_SK = 0, RT_Q = 128 * 129 * 4, RT_SC = RT_Q + 32 * 128 * 4, RT_TV = RT_SC + 64 * 129 * 4, RT_TI = RT_TV + 64 * 16 * 4, RT_END = RT_TI + 64 * 16 * 4;
static_assert(RT_END <= LDS_MISC, "routing LDS");
DEV void route_item(int l, int tile, int h, const bf16* __restrict__ Q, const bf16* __restrict__ SK, int* __restrict__ IDS, float* __restrict__ GG, LAS unsigned char* lds, int tid, unsigned* DBGW = nullptr) {
    LAS float* skL = (LAS float*)(lds + RT_SK); LAS float* qL = (LAS float*)(lds + RT_Q); LAS float* sc = (LAS float*)(lds + RT_SC);
    LAS float* topv = (LAS float*)(lds + RT_TV); LAS int* topi = (LAS int*)(lds + RT_TI);
    const int lane = tid & 63, wave = tid >> 6, row0 = tile * 32;
    for (int c = 0; c < 2; ++c) {
        const bf16* skp = SK + ((size_t)((l * 8 + h) * 2 + c)) * 128 * 128;
#pragma unroll 4
        for (int i = 0; i < 16; ++i) { const int idx2 = tid + 512 * i; const int k = idx2 >> 6, d2 = idx2 & 63; const unsigned w = *(const unsigned*)(skp + k * 128 + 2 * d2); skL[k * 129 + 2 * d2] = bf_lo(w); skL[k * 129 + 2 * d2 + 1] = bf_hi(w); }
#pragma unroll
        for (int i = 0; i < 4; ++i) { const int idx2 = tid + 512 * i; const int tok = idx2 >> 6, d2 = idx2 & 63; const unsigned w = *(const unsigned*)(Q + (size_t)(row0 + tok) * D + h * 256 + c * 128 + 2 * d2); qL[tok * 128 + 2 * d2] = bf_lo(w); qL[tok * 128 + 2 * d2 + 1] = bf_hi(w); }
        __syncthreads();
        {
            const int k = tid & 127, tg = tid >> 7;
            float acc[8];
#pragma unroll
            for (int i = 0; i < 8; ++i) acc[i] = 0.f;
#pragma unroll 4
            for (int d = 0; d < 128; ++d) { const float s = skL[k * 129 + d];
#pragma unroll
                for (int i = 0; i < 8; ++i) acc[i] += s * qL[(tg * 8 + i) * 128 + d]; }
#pragma unroll
            for (int i = 0; i < 8; ++i) sc[(c * 32 + tg * 8 + i) * 129 + k] = acc[i];
        }
        __syncthreads();
    }
    for (int q = 0; q < 8; ++q) {
        const int L = wave * 8 + q;
        float v0 = sc[L * 129 + lane], v1 = sc[L * 129 + 64 + lane];
        for (int r = 0; r < 16; ++r) {
            const float m = wave_max(fmaxf(v0, v1));
            const unsigned long long b0 = __ballot(v0 == m);
            int idx;
            if (b0) { const int ln = __ffsll((long long)b0) - 1; idx = ln; if (lane == ln) v0 = NEGBIG; }
            else { const unsigned long long b1 = __ballot(v1 == m); const int ln = __ffsll((long long)b1) - 1; idx = 64 + ln; if (lane == ln) v1 = NEGBIG; }
            if (lane == 0) { topv[L * 16 + r] = m; topi[L * 16 + r] = idx; }
        }
    }
    __syncthreads();
#if MK_CHECK == 16
    { for (int q = 0; q < 8; ++q) { const int L = wave * 8 + q; const int mi = topi[L * 16 + (lane & 15)]; int dup = 0;
          for (int e = 0; e < 16; ++e) { const int oi = __shfl(mi, e); if (lane < 16 && e != lane && oi == mi) dup = 1; }
          if (dup) atomicAdd((unsigned*)DBGW, 1u); } }
#endif
    for (int q = 0; q < 4; ++q) {
        const int tok = wave * 4 + q;
        float cv[4];
#pragma unroll
        for (int e = 0; e < 4; ++e) cv[e] = topv[tok * 16 + (lane >> 2)] + topv[(32 + tok) * 16 + (lane & 3) * 4 + e];
        float mysc = NEGBIG; int myid = 0;
        for (int r = 0; r < 16; ++r) {
            const float lm = fmaxf(fmaxf(cv[0], cv[1]), fmaxf(cv[2], cv[3]));
            const float m = wave_max(lm);
            const unsigned long long bb = __ballot(lm == m);
            const int ln = __ffsll((long long)bb) - 1;
            const int se = (cv[0] == m) ? 0 : (cv[1] == m) ? 1 : (cv[2] == m) ? 2 : 3;
            const int sel = __shfl(se, ln);
            { const bool me = (lane == ln);
              cv[0] = (me && sel == 0) ? NEGBIG : cv[0]; cv[1] = (me && sel == 1) ? NEGBIG : cv[1];
              cv[2] = (me && sel == 2) ? NEGBIG : cv[2]; cv[3] = (me && sel == 3) ? NEGBIG : cv[3]; }
            const int ci = ln * 4 + sel;
            const int id = topi[tok * 16 + (ci >> 4)] * 128 + topi[(32 + tok) * 16 + (ci & 15)];
            if (lane == r) { mysc = m; myid = id; }
        }
#if MK_CHECK == 16
        { int dup = 0; for (int e = 0; e < 16; ++e) { const int oi = __shfl(myid, e); if (lane < 16 && e != lane && oi == myid) dup = 1; } if (dup) atomicAdd((unsigned*)DBGW + 1, 1u); }
#endif
        const float s0 = __shfl(mysc, 0);
        const float ev = (lane < 16) ? __expf(mysc - s0) : 0.f;
        const float sum = wave_sum(ev);
        if (lane < 16) { IDS[(size_t)(row0 + tok) * 128 + h * 16 + lane] = myid; GG[(size_t)(row0 + tok) * 128 + h * 16 + lane] = ev / sum; }
    }
    __syncthreads();
}


constexpr float U8_SCALE = 64.f;
DEV void convert_fp8(const float* __restrict__ src, unsigned char* __restrict__ dst, size_t ngroups16, size_t gtid, size_t gstride, float scale) {
    for (size_t g = gtid; g < ngroups16; g += gstride) {
        const f32x4 a = *(const f32x4*)(src + g * 16) * scale, b = *(const f32x4*)(src + g * 16 + 4) * scale, c = *(const f32x4*)(src + g * 16 + 8) * scale, d = *(const f32x4*)(src + g * 16 + 12) * scale;
        int w0 = 0, w1 = 0, w2 = 0, w3 = 0;
        w0 = __builtin_amdgcn_cvt_pk_fp8_f32(a.x, a.y, w0, false); w0 = __builtin_amdgcn_cvt_pk_fp8_f32(a.z, a.w, w0, true);
        w1 = __builtin_amdgcn_cvt_pk_fp8_f32(b.x, b.y, w1, false); w1 = __builtin_amdgcn_cvt_pk_fp8_f32(b.z, b.w, w1, true);
        w2 = __builtin_amdgcn_cvt_pk_fp8_f32(c.x, c.y, w2, false); w2 = __builtin_amdgcn_cvt_pk_fp8_f32(c.z, c.w, w2, true);
        w3 = __builtin_amdgcn_cvt_pk_fp8_f32(d.x, d.y, w3, false); w3 = __builtin_amdgcn_cvt_pk_fp8_f32(d.z, d.w, w3, true);
        *(v4u*)(dst + g * 16) = (v4u){(unsigned)w0, (unsigned)w1, (unsigned)w2, (unsigned)w3};
    }
}

constexpr int R2_SC = 0, R2_TV = 128 * 129 * 4, R2_TI = R2_TV + 128 * 16 * 4, R2_END = R2_TI + 128 * 16 * 4;
static_assert(R2_END <= LDS_MISC, "routing v2 LDS");
DEV unsigned ord_key(float s) { const unsigned u = __builtin_bit_cast(unsigned, s); return (u & 0x80000000u) ? ~u : (u | 0x80000000u); }
DEV void route_item2(int l, int tile, int h, const bf16* __restrict__ Q, const bf16* __restrict__ SK, int* __restrict__ IDS, float* __restrict__ GG, LAS unsigned char* lds, int tid,
                        const float* __restrict__ cv_u, const float* __restrict__ cv_v, unsigned char* __restrict__ cv_u8, unsigned char* __restrict__ cv_v8) {
    LAS float* sc = (LAS float*)(lds + R2_SC); LAS float* tv = (LAS float*)(lds + R2_TV); LAS int* ti = (LAS int*)(lds + R2_TI);
    const int lane = tid & 63, wave = tid >> 6, row0 = tile * 64;
    {
        const int r = lane & 31, hh = lane >> 5, c = wave >> 2, key0 = 32 * (wave & 3);
        const bf16* skp = SK + ((size_t)(((l * 8 + h) * 2 + c) * 128 + key0 + r)) * 128 + 8 * hh;
        bf16x8 bfr[8];
#pragma unroll
        for (int ks = 0; ks < 8; ++ks) bfr[ks] = *(const bf16x8*)(skp + 16 * ks);
#pragma unroll
        for (int rt = 0; rt < 2; ++rt) {
            const bf16* qp = Q + (size_t)(row0 + 32 * rt + r) * D + h * 256 + c * 128 + 8 * hh;
            bf16x8 afr[8];
#pragma unroll
            for (int ks = 0; ks < 8; ++ks) afr[ks] = *(const bf16x8*)(qp + 16 * ks);
            f32x16 acc;
#pragma unroll
            for (int e = 0; e < 16; ++e) acc[e] = 0.f;
#pragma unroll
            for (int ks = 0; ks < 8; ++ks) acc = __builtin_amdgcn_mfma_f32_32x32x16_bf16(afr[ks], bfr[ks], acc, 0, 0, 0);
#pragma unroll
            for (int e = 0; e < 16; ++e) { const int tok = 32 * rt + (e & 3) + 8 * (e >> 2) + 4 * hh; sc[(c * 64 + tok) * 129 + key0 + r] = acc[e]; }
        }
    }
    __syncthreads();
    if (tid >= 128) {
        const size_t TG = (size_t)NEXP * D / 16;
        const size_t g0 = (size_t)(tile * 8 + h) * 4096;
#pragma unroll 4
        for (int k = 0; k < 11; ++k) { const size_t g = g0 + (size_t)(tid - 128) + 384u * k;
            if (g < g0 + 4096) { const bool isv = g >= TG; const size_t gg = isv ? g - TG : g;
                convert_fp8((isv ? cv_v : cv_u) + gg * 16, (isv ? cv_v8 : cv_u8) + gg * 16, 1, 0, 1, isv ? 1.f : U8_SCALE); } }
    }
    if (tid < 128) {
        const int L = tid;
        unsigned t[16];
#pragma unroll
        for (int q = 0; q < 16; ++q) t[q] = 0u;
#pragma unroll 4
        for (int k = 0; k < 128; ++k) {
            unsigned key = (ord_key(sc[L * 129 + k]) & ~127u) | (unsigned)(127 - k);
#pragma unroll
            for (int q = 0; q < 16; ++q) { const unsigned hi = t[q] > key ? t[q] : key; key = t[q] > key ? key : t[q]; t[q] = hi; }
        }
#pragma unroll
        for (int q = 0; q < 16; ++q) { const int idx = 127 - (int)(t[q] & 127u); tv[L * 16 + q] = sc[L * 129 + idx]; ti[L * 16 + q] = idx; }
    }
    __syncthreads();
    if (tid < 64) {
        const int tok = tid;
        float a[16], bq[16];
#pragma unroll
        for (int i = 0; i < 16; ++i) { a[i] = tv[tok * 16 + i]; bq[i] = tv[(64 + tok) * 16 + i]; }
        unsigned t[16];
#pragma unroll
        for (int q = 0; q < 16; ++q) t[q] = 0u;
#pragma unroll
        for (int i = 0; i < 16; ++i)
#pragma unroll
            for (int j = 0; j < 16 / (i + 1); ++j) {
                unsigned key = (ord_key(a[i] + bq[j]) & ~255u) | (unsigned)(255 - (i * 16 + j));
#pragma unroll
                for (int q = 0; q < 16; ++q) { const unsigned hi = t[q] > key ? t[q] : key; key = t[q] > key ? key : t[q]; t[q] = hi; }
            }
        float scv[16]; int idv[16]; float mx = NEGBIG;
#pragma unroll
        for (int q = 0; q < 16; ++q) { const int ci = 255 - (int)(t[q] & 255u); const int i = ci >> 4, j = ci & 15;
            scv[q] = tv[tok * 16 + i] + tv[(64 + tok) * 16 + j]; idv[q] = ti[tok * 16 + i] * 128 + ti[(64 + tok) * 16 + j]; mx = fmaxf(mx, scv[q]); }
        float sum = 0.f;
#pragma unroll
        for (int q = 0; q < 16; ++q) { scv[q] = __expf(scv[q] - mx); sum += scv[q]; }
        const float inv = 1.f / sum;
        int* ip = IDS + (size_t)(row0 + tok) * 128 + h * 16; float* gp = GG + (size_t)(row0 + tok) * 128 + h * 16;
#pragma unroll
        for (int q4 = 0; q4 < 4; ++q4) {
            *(int4*)(ip + 4 * q4) = make_int4(idv[4 * q4], idv[4 * q4 + 1], idv[4 * q4 + 2], idv[4 * q4 + 3]);
            *(f32x4*)(gp + 4 * q4) = (f32x4){scv[4 * q4] * inv, scv[4 * q4 + 1] * inv, scv[4 * q4 + 2] * inv, scv[4 * q4 + 3] * inv};
        }
    }
    __syncthreads();
}

DEV void expert_row(int l, int row, const bf16* __restrict__ H, const int* __restrict__ IDS, const float* __restrict__ GG, const bf16* __restrict__ U, const bf16* __restrict__ V,
                    const float* __restrict__ X1, const float* __restrict__ g2, const float* __restrict__ fnorm, float* __restrict__ XO, int lane, float pscale, float* STATP = nullptr) {
    v4u xv[4];
#pragma unroll
    for (int j = 0; j < 4; ++j) xv[j] = *(const v4u*)(H + (size_t)row * D + lane * 8 + 512 * j);
    const int id0 = IDS[(size_t)row * 128 + lane], id1 = IDS[(size_t)row * 128 + 64 + lane];
    const float gg0 = GG[(size_t)row * 128 + lane], gg1 = GG[(size_t)row * 128 + 64 + lane];
    float y[32];
#pragma unroll
    for (int i = 0; i < 32; ++i) y[i] = 0.f;
    const bf16* Ul = U + (size_t)l * NEXP * D + lane * 8;
    const bf16* Vl = V + (size_t)l * NEXP * D + lane * 8;
    for (int e0 = 0; e0 < 128; e0 += 2) {
        int id[2]; float gq[2];
#pragma unroll
        for (int q = 0; q < 2; ++q) { const int e = e0 + q;
            id[q] = (e < 64) ? __builtin_amdgcn_readlane(id0, e & 63) : __builtin_amdgcn_readlane(id1, e & 63);
            gq[q] = (e < 64) ? __builtin_bit_cast(float, __builtin_amdgcn_readlane(__builtin_bit_cast(int, gg0), e & 63)) : __builtin_bit_cast(float, __builtin_amdgcn_readlane(__builtin_bit_cast(int, gg1), e & 63)); }
        v4u uu[2][4], vv[2][4];
#pragma unroll
        for (int q = 0; q < 2; ++q)
#pragma unroll
            for (int j = 0; j < 4; ++j) uu[q][j] = *(const v4u*)(Ul + (size_t)id[q] * D + 512 * j);
#pragma unroll
        for (int q = 0; q < 2; ++q)
#pragma unroll
            for (int j = 0; j < 4; ++j) vv[q][j] = *(const v4u*)(Vl + (size_t)id[q] * D + 512 * j);
#pragma unroll
        for (int q = 0; q < 2; ++q) {
            float dsum = 0.f;
#pragma unroll
            for (int j = 0; j < 4; ++j) dsum += dot8(xv[j], uu[q][j]);
            dsum = wave_sum(dsum);
            const float w = gq[q] * gelu_tanh(dsum);
#if MK_CHECK == 7
            if (lane == 0 && l == 0) atomicAdd(STATP, gelu_tanh(dsum) * gelu_tanh(dsum) * 2048.f / 128.f);
#elif MK_CHECK == 8
            if (lane == 0 && l == 0) atomicAdd(STATP, gq[q] * gq[q] * 2048.f * 16.f / 128.f);
#elif MK_CHECK == 9
            if (lane == 0 && l == 0) atomicAdd(STATP, dsum * dsum * 2048.f / 128.f);
#elif MK_CHECK == 11
            if (lane == 0 && l == 0) atomicAdd(STATP, w * w * 2048.f);
#endif
#pragma unroll
            for (int j = 0; j < 4; ++j) {
                y[j * 8 + 0] += w * bf_lo(vv[q][j].x); y[j * 8 + 1] += w * bf_hi(vv[q][j].x);
                y[j * 8 + 2] += w * bf_lo(vv[q][j].y); y[j * 8 + 3] += w * bf_hi(vv[q][j].y);
                y[j * 8 + 4] += w * bf_lo(vv[q][j].z); y[j * 8 + 5] += w * bf_hi(vv[q][j].z);
                y[j * 8 + 6] += w * bf_lo(vv[q][j].w); y[j * 8 + 7] += w * bf_hi(vv[q][j].w);
            }
        }
    }
#if MK_CHECK == 6
    { float q2 = 0.f;
#pragma unroll
      for (int i = 0; i < 32; ++i) q2 += y[i] * y[i];
      q2 = wave_sum(q2); if (lane == 0 && l == 0) atomicAdd(STATP, q2); }
#endif
    float ssq = 0.f;
#pragma unroll
    for (int j = 0; j < 4; ++j) {
        const int col = lane * 8 + 512 * j;
        const f32x4 xa = *(const f32x4*)(X1 + (size_t)row * D + col), xb = *(const f32x4*)(X1 + (size_t)row * D + col + 4);
        const f32x4 ga = *(const f32x4*)(g2 + col) * pscale, gb = *(const f32x4*)(g2 + col + 4) * pscale;
        y[j * 8 + 0] = xa.x + ga.x * y[j * 8 + 0]; y[j * 8 + 1] = xa.y + ga.y * y[j * 8 + 1]; y[j * 8 + 2] = xa.z + ga.z * y[j * 8 + 2]; y[j * 8 + 3] = xa.w + ga.w * y[j * 8 + 3];
        y[j * 8 + 4] = xb.x + gb.x * y[j * 8 + 4]; y[j * 8 + 5] = xb.y + gb.y * y[j * 8 + 5]; y[j * 8 + 6] = xb.z + gb.z * y[j * 8 + 6]; y[j * 8 + 7] = xb.w + gb.w * y[j * 8 + 7];
#pragma unroll
        for (int e = 0; e < 8; ++e) ssq += y[j * 8 + e] * y[j * 8 + e];
    }
    if (fnorm) {
        const float r = rsqrtf(wave_sum(ssq) * (1.f / D) + EPS);
#pragma unroll
        for (int j = 0; j < 4; ++j) { const int col = lane * 8 + 512 * j;
            const f32x4 fa = *(const f32x4*)(fnorm + col), fb = *(const f32x4*)(fnorm + col + 4);
            *(f32x4*)(XO + (size_t)row * D + col) = (f32x4){y[j * 8 + 0] * r * fa.x, y[j * 8 + 1] * r * fa.y, y[j * 8 + 2] * r * fa.z, y[j * 8 + 3] * r * fa.w};
            *(f32x4*)(XO + (size_t)row * D + col + 4) = (f32x4){y[j * 8 + 4] * r * fb.x, y[j * 8 + 5] * r * fb.y, y[j * 8 + 6] * r * fb.z, y[j * 8 + 7] * r * fb.w}; }
    } else {
#pragma unroll
        for (int j = 0; j < 4; ++j) { const int col = lane * 8 + 512 * j;
            *(f32x4*)(XO + (size_t)row * D + col) = (f32x4){y[j * 8 + 0], y[j * 8 + 1], y[j * 8 + 2], y[j * 8 + 3]};
            *(f32x4*)(XO + (size_t)row * D + col + 4) = (f32x4){y[j * 8 + 4], y[j * 8 + 5], y[j * 8 + 6], y[j * 8 + 7]}; }
    }
}


DEV void expert_row8(int l, int row, const bf16* H, const int* __restrict__ IDS, const float* __restrict__ GG, const unsigned char* __restrict__ U8, const unsigned char* __restrict__ V8,
                     const float* __restrict__ X1, const float* __restrict__ g2, const float* __restrict__ fnorm, float* __restrict__ XO, int lane, float pscale, LAS int* sortL,
                     const float* __restrict__ ngain, const float* __restrict__ nmod, bf16* Hout) {
    f32x2 x[16];
#pragma unroll
    for (int j = 0; j < 2; ++j) {
        const v4u a = *(const v4u*)(H + (size_t)row * D + lane * 16 + 1024 * j), c = *(const v4u*)(H + (size_t)row * D + lane * 16 + 1024 * j + 8);
        x[j * 8 + 0] = (f32x2){bf_lo(a.x), bf_hi(a.x)}; x[j * 8 + 1] = (f32x2){bf_lo(a.y), bf_hi(a.y)}; x[j * 8 + 2] = (f32x2){bf_lo(a.z), bf_hi(a.z)}; x[j * 8 + 3] = (f32x2){bf_lo(a.w), bf_hi(a.w)};
        x[j * 8 + 4] = (f32x2){bf_lo(c.x), bf_hi(c.x)}; x[j * 8 + 5] = (f32x2){bf_lo(c.y), bf_hi(c.y)}; x[j * 8 + 6] = (f32x2){bf_lo(c.z), bf_hi(c.z)}; x[j * 8 + 7] = (f32x2){bf_lo(c.w), bf_hi(c.w)};
    }
    int id0 = IDS[(size_t)row * 128 + lane], id1 = IDS[(size_t)row * 128 + 64 + lane];
    float gg0 = GG[(size_t)row * 128 + lane], gg1 = GG[(size_t)row * 128 + 64 + lane];
    {
        const int w0 = id0 >> 9, w1 = id1 >> 9; int p0 = 0, p1 = 0, base = 0;
        for (int w = 0; w < 32; ++w) {
            const unsigned long long m0 = __ballot(w0 == w), m1 = __ballot(w1 == w);
            const int c0 = __popcll(m0), c1 = __popcll(m1);
            const int b0 = (int)__builtin_amdgcn_mbcnt_hi((unsigned)(m0 >> 32), __builtin_amdgcn_mbcnt_lo((unsigned)m0, 0u));
            const int b1 = (int)__builtin_amdgcn_mbcnt_hi((unsigned)(m1 >> 32), __builtin_amdgcn_mbcnt_lo((unsigned)m1, 0u));
            p0 = (w0 == w) ? base + b0 : p0; p1 = (w1 == w) ? base + c0 + b1 : p1;
            base += c0 + c1;
        }
        sortL[p0] = id0; sortL[p1] = id1; ((LAS float*)sortL)[128 + p0] = gg0; ((LAS float*)sortL)[128 + p1] = gg1;
        LDS_WAIT();
        id0 = sortL[lane]; id1 = sortL[64 + lane]; gg0 = ((LAS float*)sortL)[128 + lane]; gg1 = ((LAS float*)sortL)[192 + lane];
        LDS_WAIT();
    }
    float wv0 = 0.f, wv1 = 0.f;
    const unsigned char* Ul = U8 + (size_t)l * NEXP * D + lane * 16;
    const unsigned char* Vl = V8 + (size_t)l * NEXP * D + lane * 16;
    for (int e0 = 0; e0 < 128; e0 += 8) {
        v4u uu[8][2];
#pragma unroll
        for (int q = 0; q < 8; ++q) { const int e = e0 + q; const int id = (e < 64) ? __builtin_amdgcn_readlane(id0, e & 63) : __builtin_amdgcn_readlane(id1, e & 63);
            uu[q][0] = *(const v4u*)(Ul + (size_t)id * D); uu[q][1] = *(const v4u*)(Ul + (size_t)id * D + 1024); }
        float ds[8];
#pragma unroll
        for (int q = 0; q < 8; ++q) {
            f32x2 acc = {0.f, 0.f};
#pragma unroll
            for (int j = 0; j < 2; ++j) {
                const unsigned wd[4] = {uu[q][j].x, uu[q][j].y, uu[q][j].z, uu[q][j].w};
#pragma unroll
                for (int dw = 0; dw < 4; ++dw) {
                    const f32x2 lo = __builtin_amdgcn_cvt_pk_f32_fp8((int)wd[dw], false), hi = __builtin_amdgcn_cvt_pk_f32_fp8((int)wd[dw], true);
                    acc = __builtin_elementwise_fma(lo, x[j * 8 + 2 * dw], acc); acc = __builtin_elementwise_fma(hi, x[j * 8 + 2 * dw + 1], acc);
                }
            }
            ds[q] = acc.x + acc.y;
        }
#pragma unroll
        for (int q = 0; q < 8; ++q) ds[q] += swz_xor<1>(ds[q]);
#pragma unroll
        for (int q = 0; q < 8; ++q) ds[q] += swz_xor<2>(ds[q]);
#pragma unroll
        for (int q = 0; q < 8; ++q) ds[q] += swz_xor<4>(ds[q]);
#pragma unroll
        for (int q = 0; q < 8; ++q) ds[q] += swz_xor<8>(ds[q]);
#pragma unroll
        for (int q = 0; q < 8; ++q) ds[q] += swz_xor<16>(ds[q]);
#pragma unroll
        for (int q = 0; q < 8; ++q) ds[q] = sum32(ds[q]);
#pragma unroll
        for (int q = 0; q < 8; ++q) { const int e = e0 + q;
            const float gq = (e < 64) ? __builtin_bit_cast(float, __builtin_amdgcn_readlane(__builtin_bit_cast(int, gg0), e & 63)) : __builtin_bit_cast(float, __builtin_amdgcn_readlane(__builtin_bit_cast(int, gg1), e & 63));
            const float w = gq * gelu_tanh(ds[q] * (1.f / U8_SCALE));
            if (e < 64) wv0 = (lane == (e & 63)) ? w : wv0; else wv1 = (lane == (e & 63)) ? w : wv1; }
    }
    f32x2 y[16];
#pragma unroll
    for (int i = 0; i < 16; ++i) y[i] = (f32x2){0.f, 0.f};
    for (int e0 = 0; e0 < 128; e0 += 8) {
        v4u vv[8][2];
#pragma unroll
        for (int q = 0; q < 8; ++q) { const int e = e0 + q; const int id = (e < 64) ? __builtin_amdgcn_readlane(id0, e & 63) : __builtin_amdgcn_readlane(id1, e & 63);
            vv[q][0] = *(const v4u*)(Vl + (size_t)id * D); vv[q][1] = *(const v4u*)(Vl + (size_t)id * D + 1024); }
#pragma unroll
        for (int q = 0; q < 8; ++q) { const int e = e0 + q;
            const float w = (e < 64) ? __builtin_bit_cast(float, __builtin_amdgcn_readlane(__builtin_bit_cast(int, wv0), e & 63)) : __builtin_bit_cast(float, __builtin_amdgcn_readlane(__builtin_bit_cast(int, wv1), e & 63));
            const f32x2 w2 = {w, w};
#pragma unroll
            for (int j = 0; j < 2; ++j) {
                const unsigned wd[4] = {vv[q][j].x, vv[q][j].y, vv[q][j].z, vv[q][j].w};
#pragma unroll
                for (int dw = 0; dw < 4; ++dw) {
                    const f32x2 lo = __builtin_amdgcn_cvt_pk_f32_fp8((int)wd[dw], false), hi = __builtin_amdgcn_cvt_pk_f32_fp8((int)wd[dw], true);
                    y[j * 8 + 2 * dw] = __builtin_elementwise_fma(w2, lo, y[j * 8 + 2 * dw]); y[j * 8 + 2 * dw + 1] = __builtin_elementwise_fma(w2, hi, y[j * 8 + 2 * dw + 1]);
                }
            }
        }
    }
    float ssq = 0.f;
#pragma unroll
    for (int j = 0; j < 2; ++j)
#pragma unroll
        for (int k4 = 0; k4 < 4; ++k4) {
            const int col = lane * 16 + 1024 * j + 4 * k4;
            const f32x4 xa = *(const f32x4*)(X1 + (size_t)row * D + col); const f32x4 ga = *(const f32x4*)(g2 + col) * pscale;
            f32x2& ya = y[j * 8 + 2 * k4]; f32x2& yb = y[j * 8 + 2 * k4 + 1];
            ya.x = xa.x + ga.x * ya.x; ya.y = xa.y + ga.y * ya.y; yb.x = xa.z + ga.z * yb.x; yb.y = xa.w + ga.w * yb.y;
            ssq += (ya.x * ya.x + ya.y * ya.y) + (yb.x * yb.x + yb.y * yb.y);
        }
    const float r = rsqrtf(wave_sum(ssq) * (1.f / D) + EPS);
#pragma unroll
    for (int j = 0; j < 2; ++j)
#pragma unroll
        for (int k4 = 0; k4 < 4; ++k4) {
            const int col = lane * 16 + 1024 * j + 4 * k4;
            const f32x2 ya = y[j * 8 + 2 * k4], yb = y[j * 8 + 2 * k4 + 1];
            f32x4 ov = {ya.x, ya.y, yb.x, yb.y};
            if (fnorm) ov = ov * r * *(const f32x4*)(fnorm + col);
            *(f32x4*)(XO + (size_t)row * D + col) = ov;
            if (ngain) {
                const f32x4 g = *(const f32x4*)(ngain + col), sc = *(const f32x4*)(nmod + MO_SC1 + col), sh = *(const f32x4*)(nmod + MO_SH1 + col);
                const f32x4 hv = (ov * r) * g * (sc + 1.f) + sh;
                *(unsigned long long*)(Hout + (size_t)row * D + col) = (unsigned long long)pk2(hv.x, hv.y) | ((unsigned long long)pk2(hv.z, hv.w) << 32);
            }
        }
}


DEV f32x2 dot_u8_bf16(const v4u (&xk)[4], const v4u u0, const v4u u1) {
    f32x2 acc = {0.f, 0.f};
    const unsigned uw[8] = {u0.x, u0.y, u0.z, u0.w, u1.x, u1.y, u1.z, u1.w};
    const unsigned xw[16] = {xk[0].x, xk[0].y, xk[0].z, xk[0].w, xk[1].x, xk[1].y, xk[1].z, xk[1].w, xk[2].x, xk[2].y, xk[2].z, xk[2].w, xk[3].x, xk[3].y, xk[3].z, xk[3].w};
#pragma unroll
    for (int dw = 0; dw < 8; ++dw) {
        const f32x2 lo = __builtin_amdgcn_cvt_pk_f32_fp8((int)uw[dw], false), hi = __builtin_amdgcn_cvt_pk_f32_fp8((int)uw[dw], true);
        acc = __builtin_elementwise_fma(lo, (f32x2){bf_lo(xw[2 * dw]), bf_hi(xw[2 * dw])}, acc);
        acc = __builtin_elementwise_fma(hi, (f32x2){bf_lo(xw[2 * dw + 1]), bf_hi(xw[2 * dw + 1])}, acc);
    }
    return acc;
}
DEV void axpy_v8(f32x2 (&y)[16], float w, const v4u v0, const v4u v1) {
    const f32x2 w2 = {w, w};
    const unsigned vw[8] = {v0.x, v0.y, v0.z, v0.w, v1.x, v1.y, v1.z, v1.w};
#pragma unroll
    for (int dw = 0; dw < 8; ++dw) {
        const f32x2 lo = __builtin_amdgcn_cvt_pk_f32_fp8((int)vw[dw], false), hi = __builtin_amdgcn_cvt_pk_f32_fp8((int)vw[dw], true);
        y[2 * dw] = __builtin_elementwise_fma(w2, lo, y[2 * dw]); y[2 * dw + 1] = __builtin_elementwise_fma(w2, hi, y[2 * dw + 1]);
    }
}
DEV void expert_epilogue(f32x2 (&y)[16], int row, const float* __restrict__ X1, const float* __restrict__ g2, const float* __restrict__ fnorm, float* __restrict__ XO, int lane, float pscale,
                         const float* __restrict__ ngain, const float* __restrict__ nmod, bf16* Hout) {
    float ssq = 0.f;
#pragma unroll
    for (int j = 0; j < 2; ++j)
#pragma unroll
        for (int k4 = 0; k4 < 4; ++k4) {
            const int col = lane * 16 + 1024 * j + 4 * k4;
            const f32x4 xa = *(const f32x4*)(X1 + (size_t)row * D + col); const f32x4 ga = *(const f32x4*)(g2 + col) * pscale;
            f32x2& ya = y[j * 8 + 2 * k4]; f32x2& yb = y[j * 8 + 2 * k4 + 1];
            ya.x = xa.x + ga.x * ya.x; ya.y = xa.y + ga.y * ya.y; yb.x = xa.z + ga.z * yb.x; yb.y = xa.w + ga.w * yb.y;
            ssq += (ya.x * ya.x + ya.y * ya.y) + (yb.x * yb.x + yb.y * yb.y);
        }
    const float r = rsqrtf(wave_sum(ssq) * (1.f / D) + EPS);
#pragma unroll
    for (int j = 0; j < 2; ++j)
#pragma unroll
        for (int k4 = 0; k4 < 4; ++k4) {
            const int col = lane * 16 + 1024 * j + 4 * k4;
            const f32x2 ya = y[j * 8 + 2 * k4], yb = y[j * 8 + 2 * k4 + 1];
            f32x4 ov = {ya.x, ya.y, yb.x, yb.y};
            if (fnorm) ov = ov * r * *(const f32x4*)(fnorm + col);
            *(f32x4*)(XO + (size_t)row * D + col) = ov;
            if (ngain) {
                const f32x4 g = *(const f32x4*)(ngain + col), sc = *(const f32x4*)(nmod + MO_SC1 + col), sh = *(const f32x4*)(nmod + MO_SH1 + col);
                const f32x4 hv = (ov * r) * g * (sc + 1.f) + sh;
                *(unsigned long long*)(Hout + (size_t)row * D + col) = (unsigned long long)pk2(hv.x, hv.y) | ((unsigned long long)pk2(hv.z, hv.w) << 32);
            }
        }
}

DEV void unpack_fp8x32(f32x2 (&t)[16], const v4u a, const v4u b) {
    const unsigned w[8] = {a.x, a.y, a.z, a.w, b.x, b.y, b.z, b.w};
#pragma unroll
    for (int dw = 0; dw < 8; ++dw) { t[2 * dw] = __builtin_amdgcn_cvt_pk_f32_fp8((int)w[dw], false); t[2 * dw + 1] = __builtin_amdgcn_cvt_pk_f32_fp8((int)w[dw], true); }
}
DEV float dot_t_bf16(const f32x2 (&t)[16], const v4u (&xk)[4]) {
    const unsigned xw[16] = {xk[0].x, xk[0].y, xk[0].z, xk[0].w, xk[1].x, xk[1].y, xk[1].z, xk[1].w, xk[2].x, xk[2].y, xk[2].z, xk[2].w, xk[3].x, xk[3].y, xk[3].z, xk[3].w};
    f32x2 acc = {0.f, 0.f};
#pragma unroll
    for (int i = 0; i < 16; ++i) { unsigned xv = xw[i]; asm volatile("" : "+v"(xv));
        acc = __builtin_elementwise_fma(t[i], (f32x2){bf_lo(xv), bf_hi(xv)}, acc); }
    return acc.x + acc.y;
}
DEV void axpy_t(f32x2 (&y)[16], float w, const f32x2 (&t)[16]) {
    const f32x2 w2 = {w, w};
#pragma unroll
    for (int i = 0; i < 16; ++i) y[i] = __builtin_elementwise_fma(w2, t[i], y[i]);
}
DEV void expert_pair8(int l, int m0, int mstride, const bf16* H, const int* __restrict__ IDS, const float* __restrict__ GG, const unsigned char* __restrict__ U8, const unsigned char* __restrict__ V8,
                      const float* __restrict__ X1, const float* __restrict__ modg2  , const float* __restrict__ fnorm, float* __restrict__ XO, int lane, float pscale,
                      LAS unsigned char* wl, const float* __restrict__ ngain, const float* __restrict__ nmodl  , bf16* Hout) {
    asm volatile("" : "+v"(lane));
    LAS unsigned* ent = (LAS unsigned*)wl; LAS float* eg = (LAS float*)(wl + 1024);
    {
        int idv[4]; float ggv[4]; int pos[4];
#pragma unroll
        for (int sidx = 0; sidx < 4; ++sidx) { const size_t o = (size_t)(m0 + (sidx >> 1) * mstride) * 128 + (sidx & 1) * 64 + lane; idv[sidx] = IDS[o]; ggv[sidx] = GG[o]; pos[sidx] = 0; }
        int base = 0;
        for (int w = 0; w < 32; ++w) {
#pragma unroll
            for (int sidx = 0; sidx < 4; ++sidx) {
                const bool hit = (idv[sidx] >> 9) == w;
                const unsigned long long mk = __ballot(hit);
                const int bl = (int)__builtin_amdgcn_mbcnt_hi((unsigned)(mk >> 32), __builtin_amdgcn_mbcnt_lo((unsigned)mk, 0u));
                pos[sidx] = hit ? base + bl : pos[sidx];
                base += __popcll(mk);
            }
        }
#pragma unroll
        for (int sidx = 0; sidx < 4; ++sidx) { ent[pos[sidx]] = (unsigned)idv[sidx] | ((unsigned)(sidx >> 1) << 16); eg[pos[sidx]] = ggv[sidx]; }
        LDS_WAIT();
    }
    const unsigned char* Ul = U8 + (size_t)l * NEXP * D + lane * 16;
    const unsigned char* Vl = V8 + (size_t)l * NEXP * D + lane * 16;
    {
        v4u xk0[4], xk1[4];
#pragma unroll
        for (int j = 0; j < 2; ++j) {
            const bf16* hp0 = H + (size_t)(m0 + 0 * mstride) * D + lane * 16 + 1024 * j; xk0[2 * j] = *(const v4u*)hp0; xk0[2 * j + 1] = *(const v4u*)(hp0 + 8);
            const bf16* hp1 = H + (size_t)(m0 + 1 * mstride) * D + lane * 16 + 1024 * j; xk1[2 * j] = *(const v4u*)hp1; xk1[2 * j + 1] = *(const v4u*)(hp1 + 8);
        }
#pragma unroll 1
        for (int e0 = 0; e0 < 256; e0 += 4) {
            const unsigned entv = ent[e0 + (lane & 3)]; const float egv = eg[e0 + (lane & 3)];
            unsigned eq[4]; v4u uu[4][2];
#pragma unroll
            for (int q = 0; q < 4; ++q) { eq[q] = (unsigned)__builtin_amdgcn_readlane((int)entv, q); const size_t ro = (size_t)(eq[q] & 0xffffu) * D; uu[q][0] = *(const v4u*)(Ul + ro); uu[q][1] = *(const v4u*)(Ul + ro + 1024); }
            float ds[4];
#pragma unroll
            for (int q = 0; q < 4; ++q) {
                f32x2 t[16]; unpack_fp8x32(t, uu[q][0], uu[q][1]);
                if ((eq[q] >> 16) == 0) { asm volatile(""); ds[q] = dot_t_bf16(t, xk0); } else { asm volatile(""); ds[q] = dot_t_bf16(t, xk1); }
            }
#pragma unroll
            for (int q = 0; q < 4; ++q) ds[q] += swz_xor<1>(ds[q]);
#pragma unroll
            for (int q = 0; q < 4; ++q) ds[q] += swz_xor<2>(ds[q]);
#pragma unroll
            for (int q = 0; q < 4; ++q) ds[q] += swz_xor<4>(ds[q]);
#pragma unroll
            for (int q = 0; q < 4; ++q) ds[q] += swz_xor<8>(ds[q]);
#pragma unroll
            for (int q = 0; q < 4; ++q) ds[q] += swz_xor<16>(ds[q]);
#pragma unroll
            for (int q = 0; q < 4; ++q) ds[q] = sum32(ds[q]);
            float wmine = 0.f;
#pragma unroll
            for (int q = 0; q < 4; ++q) { const float gq = __builtin_bit_cast(float, __builtin_amdgcn_readlane(__builtin_bit_cast(int, egv), q)); const float wq = gq * gelu_tanh(ds[q] * (1.f / U8_SCALE)); wmine = (lane == q) ? wq : wmine; }
            if (lane < 4) eg[e0 + lane] = wmine;
        }
        LDS_WAIT();
    }
    {
        f32x2 y0[16], y1[16];
#pragma unroll
        for (int i = 0; i < 16; ++i) { y0[i] = (f32x2){0.f, 0.f}; y1[i] = (f32x2){0.f, 0.f}; }
#pragma unroll 1
        for (int e0 = 0; e0 < 256; e0 += 4) {
            const unsigned entv = ent[e0 + (lane & 3)]; const float egv = eg[e0 + (lane & 3)];
            unsigned eq[4]; v4u vv[4][2];
#pragma unroll
            for (int q = 0; q < 4; ++q) { eq[q] = (unsigned)__builtin_amdgcn_readlane((int)entv, q); const size_t ro = (size_t)(eq[q] & 0xffffu) * D; vv[q][0] = *(const v4u*)(Vl + ro); vv[q][1] = *(const v4u*)(Vl + ro + 1024); }
#pragma unroll
            for (int q = 0; q < 4; ++q) {
                const float wq = __builtin_bit_cast(float, __builtin_amdgcn_readlane(__builtin_bit_cast(int, egv), q));
                f32x2 t[16]; unpack_fp8x32(t, vv[q][0], vv[q][1]);
                if ((eq[q] >> 16) == 0) { asm volatile(""); axpy_t(y0, wq, t); } else { asm volatile(""); axpy_t(y1, wq, t); }
            }
        }
#define EXP_EPI(Y, K) do { const int row = m0 + (K) * mstride; const int b = row >> 12; \
            expert_epilogue(Y, row, X1, modg2 + (size_t)b * MODW, fnorm, XO, lane, pscale, ngain, nmodl ? nmodl + (size_t)b * MODW : nullptr, Hout); } while (0)
        EXP_EPI(y0, 0); EXP_EPI(y1, 1);
#undef EXP_EPI
    }
    LDS_WAIT();
}

#if MK_CHECK
DEV void chk_route(int l, int row, int h, const bf16* __restrict__ Q, const bf16* __restrict__ SK, const int* __restrict__ IDS, const float* __restrict__ GG, unsigned* bad, LAS float* sL, LAS unsigned* cntL, int tid) {
    if (tid < 256) { const int c = tid >> 7, k = tid & 127; const bf16* skp = SK + ((size_t)((l * 8 + h) * 2 + c)) * 128 * 128 + k * 128; const bf16* qp = Q + (size_t)row * D + h * 256 + c * 128;
        float s = 0.f; for (int d = 0; d < 128; ++d) s += bf1(qp[d]) * bf1(skp[d]); sL[c * 128 + k] = s; }
    if (tid == 0) cntL[0] = 0u;
    __syncthreads();
    float sc15 = 0.f; unsigned mybad = 0;
    { float prev = 3e38f; float s0 = 0.f, gsum = 0.f; float g0 = GG[(size_t)row * 128 + h * 16];
      for (int r = 0; r < 16; ++r) { const int id = IDS[(size_t)row * 128 + h * 16 + r]; const float g = GG[(size_t)row * 128 + h * 16 + r];
          if (id < 0 || id >= NEXP) { mybad |= 1; continue; }
          const float scv = sL[id >> 7] + sL[128 + (id & 127)];
          if (r == 0) s0 = scv;
          if (scv > prev + 1e-5f) mybad |= 2;
          prev = scv; gsum += g;
          const float ratio = __expf(scv - s0);
          if (fabsf(g / g0 - ratio) > 0.02f * ratio + 1e-4f) mybad |= 4;
          if (r == 15) sc15 = scv; }
      if (fabsf(gsum - 1.f) > 1e-3f) mybad |= 8; }
    unsigned cnt = 0;
    for (int p = tid; p < 16384; p += 512) { const float v = sL[p >> 7] + sL[128 + (p & 127)]; if (v > sc15 + 1e-5f) ++cnt; }
    __hip_atomic_fetch_add(cntL, cnt, __ATOMIC_RELAXED, __HIP_MEMORY_SCOPE_WORKGROUP);
    __syncthreads();
    if (tid == 0) { if (cntL[0] > 15u) mybad |= 16; if (mybad) atomicAdd(bad, 1u); }
    __syncthreads();
}
DEV void chk_expert(int l, int row, const bf16* __restrict__ H, const int* __restrict__ IDS, const float* __restrict__ GG, const float* __restrict__ Uf, const float* __restrict__ Vf,
                    const float* __restrict__ X1, const float* __restrict__ X2, const float* __restrict__ g2, unsigned* bad, LAS float* wL, int tid) {
    if (tid < 128) { const int id = IDS[(size_t)row * 128 + tid]; const float* up = Uf + ((size_t)l * NEXP + id) * D; const bf16* hp = H + (size_t)row * D;
        float s = 0.f; for (int d = 0; d < D; ++d) s += up[d] * bf1(hp[d]);
        wL[tid] = GG[(size_t)row * 128 + tid] * gelu_tanh(s); }
    __syncthreads();
    unsigned mybad = 0;
    for (int d = tid; d < D; d += 512) { float y = 0.f;
        for (int e = 0; e < 128; ++e) { const int id = IDS[(size_t)row * 128 + e]; y += wL[e] * Vf[((size_t)l * NEXP + id) * D + d]; }
        const float want = X1[(size_t)row * D + d] + g2[d] * y * (MK_CHECK == 3 ? 1.5f : 1.f); const float got = X2[(size_t)row * D + d];
        if (!(fabsf(got - want) <= 0.02f * fabsf(want) + 0.02f)) mybad = 1; }
    if (mybad) atomicAdd(bad, 1u);
    __syncthreads();
}

DEV void chk_hq(int l, int row, const float* __restrict__ X1, const float* __restrict__ gain, const float* __restrict__ modl, const float* __restrict__ wq, const bf16* __restrict__ H, const bf16* __restrict__ Q,
                unsigned* bad, LAS float* hL, LAS float* redL, int tid) {
    const int b = row >> 12;
    float ss = 0.f;
    for (int d = tid; d < D; d += 512) { const float v = X1[(size_t)row * D + d]; ss += v * v; }
    ss = wave_sum(ss);
    if ((tid & 63) == 0) redL[tid >> 6] = ss;
    __syncthreads();
    float tot = 0.f; for (int w = 0; w < 8; ++w) tot += redL[w];
    const float r = rsqrtf(tot * (1.f / D) + EPS);
    unsigned badh = 0, badq = 0;
    for (int d = tid; d < D; d += 512) { const float hv = X1[(size_t)row * D + d] * r * gain[d] * (1.f + modl[(size_t)b * MODW + MO_SC2 + d]) + modl[(size_t)b * MODW + MO_SH2 + d];
        hL[d] = hv; const float got = bf1(H[(size_t)row * D + d]); if (!(fabsf(got - hv) <= 0.01f * fabsf(hv) + 0.01f)) badh = 1; }
    __syncthreads();
    for (int c = tid; c < D; c += 512) { float q = 0.f; for (int k = 0; k < D; ++k) q += hL[k] * wq[(size_t)k * D + c];
        const float got = bf1(Q[(size_t)row * D + c]); if (!(fabsf(got - q) <= 0.02f * fabsf(q) + 0.03f)) badq = 1; }
    if (badh) atomicAdd(bad, 1u);
    if (badq) atomicAdd(bad + 1, 1u);
    __syncthreads();
}
#endif
struct Args { const float* in[24]; float* out; unsigned char* ws; int ph_lo, ph_hi, li, pad; };

__global__ void __launch_bounds__(512, 2) fwd(Args a) {
    extern __shared__ __attribute__((aligned(16))) unsigned char lds_raw[];
    LAS unsigned char* lds = (LAS unsigned char*)lds_raw;
#define PHASE_TID() unsigned zz_ = 0u; asm volatile("" : "+v"(zz_));   \
    int tid = wave0 * 64 + (int)__builtin_amdgcn_mbcnt_hi(~0u, __builtin_amdgcn_mbcnt_lo(~0u, zz_)); const int lane = tid & 63; (void)lane; \
    int bx = blockIdx.x, G = gridDim.x; asm volatile("" : "+s"(bx), "+s"(G)); const int wave = __builtin_amdgcn_readfirstlane(tid >> 6); \
    const int vcu = (G % 8 == 0) ? (bx % 8) * (G / 8) + bx / 8 : bx; const int gw = vcu * 8 + wave, NGW = G * 8; (void)gw; (void)NGW; (void)vcu; (void)wave; \
    const __attribute__((address_space(4))) Args* A = (const __attribute__((address_space(4))) Args*)__builtin_amdgcn_kernarg_segment_ptr(); asm volatile("" : "+s"(A))
    unsigned* ctl = (unsigned*)(a.ws + WS_CTL);
    const int lo = a.ph_lo, hi = a.ph_hi;
    const int wave0 = __builtin_amdgcn_readfirstlane((int)threadIdx.x >> 6);
    for (int u = threadIdx.x; u < (LDS_BYTES - LDS_MISC) / 4; u += 512) ((LAS unsigned*)(lds + LDS_MISC))[u] = 0u;
    __syncthreads();
    XcdBarrier bar; bar.bar = ctl + CW_BAR + (a.li & 7) * XCD_BAR_WORDS; bar.x = 0; bar.st = (volatile LAS unsigned*)(lds + LDS_MISC + 64); bar.w0 = wave0;
    if (hi - lo > 1) bar = xcd_barrier_post(ctl + CW_BAR + (a.li & 7) * XCD_BAR_WORDS, (volatile LAS unsigned*)(lds + LDS_MISC + 64), wave0);
#ifndef MK_MASK
#define MK_MASK 0x3ff
#endif
#define KON(q) (((MK_MASK) >> (q)) & 1)
#define IN(k) (lo <= (k) && (k) < hi)
#define SEAM(k) do { if (IN(k) && IN((k) + 1)) xcd_barrier(bar); } while (0)

#define mod   ((float*)(A->ws + WS_MOD))
#define WIN_T ((bf16*)(A->ws + WS_WIN_T))
#define WOUT_T ((bf16*)(A->ws + WS_WOUT_T))
#define WQ_T  ((bf16*)(A->ws + WS_WQ_T))
#define SUBK  ((bf16*)(A->ws + WS_SUBK))
#define UB    ((bf16*)(A->ws + WS_U))
#define VB    ((bf16*)(A->ws + WS_V))
#define H     ((bf16*)(A->ws + WS_H))
#define Z     ((bf16*)(A->ws + WS_Z))
#define HLOC  ((bf16*)(A->ws + WS_HLOC))
#define PP    ((bf16*)(A->ws + WS_P))
#define YB    ((float*)(A->ws + WS_YB))
#define YC    ((bf16*)(A->ws + WS_YC))
#define SUMA  ((float*)(A->ws + WS_SUMA))
#define SUMB  ((float*)(A->ws + WS_SUMB))
#define X1    ((float*)(A->ws + WS_X1))
#define X2    ((float*)(A->ws + WS_X2))
#define QB    ((bf16*)(A->ws + WS_Q))
#define IDS   ((int*)(A->ws + WS_IDS))
#define GG    ((float*)(A->ws + WS_G))
#define PARTB ((bf16*)(A->ws + WS_PART))
#define WG_T  ((bf16*)(A->ws + WS_WG_T))
#define LSEB  ((float*)(A->ws + WS_LSE))
#define XIN   ((l == 0) ? A->in[0] : (const float*)X2)
#define MODL  (mod + (size_t)l * 2 * MODW)
    for (int rep = 0; rep < (MK_DUP == 0 ? 2 : 1); ++rep) if (KON(0) && IN(0)) {
        PHASE_TID();
        ph_mod(A->in[1], A->in[2], A->in[3], mod, (LAS float*)lds, vcu, G, tid);
        {
            LAS float* scr = (LAS float*)(lds + wave * 16384);
            constexpr int I_IN = (D / 64) * (IN_W / 32), I_SQ = (D / 64) * (D / 32), I_L = I_IN + 2 * I_SQ;
            for (int it = gw; it < 2 * I_L; it += NGW) {
                const int l = it / I_L; int r = it % I_L;
                if (r < I_IN) { transpose_item(A->in[6] + (size_t)l * D * IN_W, D, IN_W, WIN_T + (size_t)l * IN_W * D, scr, r, lane); continue; } r -= I_IN;
                if (r < I_SQ) { transpose_item(A->in[18] + (size_t)l * D * D, D, D, WOUT_T + (size_t)l * D * D, scr, r, lane); continue; } r -= I_SQ;
                transpose_item(A->in[19] + (size_t)l * D * D, D, D, WQ_T + (size_t)l * D * D, scr, r, lane);
            }
        }
        {
            LAS float* scr = (LAS float*)(lds + wave * 16384);
            for (int it = gw; it < 2 * 6 * 2 * 8; it += NGW) { const int mi = it >> 3, sub = it & 7; const int ln = mi >> 1, g = mi & 1;
                transpose_item((g ? A->in[11] : A->in[9]) + (size_t)ln * 128 * 128, 128, 128, WG_T + ((size_t)ln * 2 + g) * 128 * 128, scr, sub, lane); }
        }
        const size_t gtid = (size_t)vcu * 512 + tid, gstride = (size_t)G * 512;
        convert_copy(A->in[20], SUBK, (size_t)2 * 8 * 2 * 128 * 128 / 8, gtid, gstride);
    }
    SEAM(0);

    for (int l = 0; l < NL; ++l) {
        const int pb = 1 + 9 * l;
        for (int rep = 0; rep < (MK_DUP == 1 ? 2 : 1); ++rep) if (KON(1) && IN(pb + 0) && l == 0) { PHASE_TID(); modnorm_rows(XIN, A->in[4] + l * D, MODL, MO_SH1, MO_SC1, H, gw, NGW, lane); }
        if (l == 0) SEAM(pb + 0);
        for (int rep = 0; rep < (MK_DUP == 2 ? 2 : 1); ++rep) if (KON(2) && IN(pb + 1)) {
            PHASE_TID(); (void)tid;
            pg8::Gemm g{H, WIN_T + (size_t)l * IN_W * D, M, IN_W, D}; pg8::StaticOrder S; S.init(M, IN_W, G, bx);
            pg8::EpiBf16<0> E{Z, IN_W, nullptr, 0, 0};
            pg8::gemm_phase<pg8::EpiBf16<0>, pg8::StaticOrder, false>((PG8_LAS unsigned char*)lds, g, S, E, nullptr, wave0);
        }
        SEAM(pb + 1);
        for (int rep = 0; rep < (MK_DUP == 3 ? 2 : 1); ++rep) if (KON(3) && IN(pb + 2)) {
            PHASE_TID();
            if (rep) __syncthreads();
            for (int it = vcu; it < 2 * 64 * 6; it += G) {
                const int b = it / 384, r = it % 384, j = r / 6, n = r % 6;
                lru_item2(l, b, j, n, Z, A->in[7], A->in[8], WG_T, A->in[10], A->in[12], A->in[13], HLOC, PP, SUMA, SUMB,
                          (LAS float*)lds, (LAS float*)(lds + 34816), (LAS float*)(lds + 69632), tid);
            }
            {
                {
                    LAS unsigned char* wl = lds + wave * ATT_WLDS;
                    for (int it = gw; it < 1024 + 4608; it += NGW) {
                        if (it < 1024) { const int bh = it >> 7, tl = 127 - (it & 127); sb_mfma_item(bh >> 2, bh & 3, 32 * tl, Z, YC, wl, lane); }
                        else { const int i2 = it - 1024; const int tl = i2 & 127, p = (i2 >> 7) % 3, bh = i2 / 384; const int d = 1 << (2 * p);
                            dil_mfma_item(bh / 6, bh % 6, p, tl % d, 32 * (tl / d), Z, A->in[14], PARTB, LSEB, wl, lane); }
                    }
                }
            }
        }
        SEAM(pb + 2);
        for (int rep = 0; rep < (MK_DUP == 4 ? 2 : 1); ++rep) if (KON(4) && IN(pb + 3)) {
            PHASE_TID();
            for (int it = vcu; it < 256; it += G) { const int b = it >> 7, j = (it >> 1) & 63, half = it & 1;
                combine_item(l, b, j, half, Z, HLOC, PP, SUMA, SUMB, PARTB, LSEB, YC, A->in[15], A->in[16], A->in[17], H, (LAS float*)lds, tid); }
        }
        SEAM(pb + 3);
        for (int rep = 0; rep < (MK_DUP == 5 ? 2 : 1); ++rep) if (KON(5) && IN(pb + 4)) {
            PHASE_TID(); (void)tid;
            pg8::Gemm g{H, WOUT_T + (size_t)l * D * D, M, D, D}; pg8::StaticOrder S; S.init(M, D, G, bx);
            EpiResGate E{XIN, X1, MODL + MO_G1, ((MK_DBG >> (2 * l)) & 1) ? 0.f : ((MK_DBG & 256) ? -1.f : 1.f)};
            pg8::gemm_phase<EpiResGate, pg8::StaticOrder, false>((PG8_LAS unsigned char*)lds, g, S, E, nullptr, wave0);
        }
        SEAM(pb + 4);
        for (int rep = 0; rep < (MK_DUP == 6 ? 2 : 1); ++rep) if (KON(6) && IN(pb + 5)) { PHASE_TID(); modnorm_rows(X1, A->in[5] + l * D, MODL, MO_SH2, MO_SC2, H, gw, NGW, lane); }
        SEAM(pb + 5);
        for (int rep = 0; rep < (MK_DUP == 7 ? 2 : 1); ++rep) if (KON(7) && IN(pb + 6)) {
            PHASE_TID(); (void)tid;
            pg8::Gemm g{H, WQ_T + (size_t)l * D * D, M, D, D}; pg8::StaticOrder S; S.init(M, D, G, bx);
            pg8::EpiBf16<0> E{QB, D, nullptr, 0, 0};
            pg8::gemm_phase<pg8::EpiBf16<0>, pg8::StaticOrder, false>((PG8_LAS unsigned char*)lds, g, S, E, nullptr, wave0);
        }
        SEAM(pb + 6);
        for (int rep = 0; rep < (MK_DUP == 8 ? 2 : 1); ++rep) if (KON(8) && IN(pb + 7)) {
            PHASE_TID();
            for (int it = vcu; it < 128 * 8; it += G) route_item2(l, it >> 3, it & 7, QB, SUBK, IDS, GG, lds, tid, A->in[21] + (size_t)l * NEXP * D, A->in[22] + (size_t)l * NEXP * D,
                                                                                      (unsigned char*)UB + (size_t)l * NEXP * D, (unsigned char*)VB + (size_t)l * NEXP * D);
        }
        SEAM(pb + 7);
        for (int rep = 0; rep < (MK_DUP == 9 ? 2 : 1); ++rep) if (KON(9) && IN(pb + 8)) {
            PHASE_TID();
            for (int m = gw; m < M; m += NGW)
                expert_row8(l, m, H, IDS, GG, (const unsigned char*)UB, (const unsigned char*)VB, X1, MODL + (size_t)(m >> 12) * MODW + MO_G2, (l == NL - 1) ? A->in[23] : nullptr, (l == NL - 1) ? A->out : X2, lane,
                            ((MK_DBG >> (2 * l + 1)) & 1) ? 0.f : ((MK_DBG & 128) ? -1.f : 1.f), (LAS int*)(lds + wave * 1024),
                            (l == NL - 1) ? nullptr : A->in[4] + (l + 1) * D, mod + (size_t)((l + 1) * 2 + (m >> 12)) * MODW, H);
        }
        if (l + 1 < NL) SEAM(pb + 8);
    }
#if MK_CHECK
    if (IN(19)) {
        PHASE_TID();
        unsigned* badw = (unsigned*)(A->ws + WS_CTL) + 8;
#if MK_CHECK == 1 || MK_CHECK == 3 || MK_CHECK == 4
        for (int it = vcu; it < (MK_CHECK == 4 ? 8192 : 256) * 8; it += G) { const int row = (MK_CHECK == 4) ? (it >> 3) : (((it >> 3) * 131 + 7) & 8191); chk_route(0, row, it & 7, QB, SUBK, IDS, GG, badw, (LAS float*)lds, (LAS unsigned*)(lds + 2048), tid); }
        for (int it = vcu; it < (MK_CHECK == 4 ? 8192 : 256); it += G) { const int row = (MK_CHECK == 4) ? it : ((it * 131 + 7) & 8191); chk_expert(0, row, H, IDS, GG, A->in[21], A->in[22], X1, X2, mod + (size_t)(row >> 12) * MODW + MO_G2, badw + 1, (LAS float*)lds, tid); }
#elif MK_CHECK == 12 || MK_CHECK == 15
        { (void)badw;
          for (int m = gw; m < M; m += NGW) { const int ia = IDS[(size_t)m * 128 + lane], ib = IDS[(size_t)m * 128 + 64 + lane]; int cnt = 0;
              for (int e = 0; e < 128; ++e) { const int ie = (e < 64) ? __shfl(ia, e) : __shfl(ib, e - 64); if (lane < e && ia == ie && (MK_CHECK == 12 || (lane >> 4) == (e >> 4))) ++cnt; if (lane + 64 < e && ib == ie && (MK_CHECK == 12 || ((lane + 64) >> 4) == (e >> 4))) ++cnt; }
              float fc = wave_sum((float)cnt); if (lane == 0) atomicAdd((float*)(A->ws + WS_CTL) + 16, fc * 2048.f); } }
#elif MK_CHECK == 13 || MK_CHECK == 14
        { (void)badw;
          float cnt = 0.f;
          if (MK_CHECK == 13) { const float* sk = A->in[20]; for (int o = vcu * 512 + tid; o < 2 * 128 * 128; o += G * 512) if (sk[o] == sk[o + 2 * 128 * 128]) cnt += 1.f; cnt *= (float)M * D / (2.f * 128 * 128); }
          else { const float* wq = A->in[19]; for (int o = vcu * 512 + tid; o < D * 256; o += G * 512) { const int k = o >> 8, c = o & 255; if (wq[(size_t)k * D + c] == wq[(size_t)k * D + 256 + c]) cnt += 1.f; } cnt *= (float)M * D / ((float)D * 256); }
          cnt = wave_sum(cnt); if (lane == 0) atomicAdd((float*)(A->ws + WS_CTL) + 16, cnt); }
#elif MK_CHECK == 10
        { (void)badw; float acc = 0.f; const float* vt = A->in[22];
          for (size_t o = (size_t)vcu * 512 + tid; o < (size_t)NEXP * D; o += (size_t)G * 512) { const float v = vt[o]; acc += v * v; }
          acc = wave_sum(acc); if (lane == 0) atomicAdd((float*)(A->ws + WS_CTL) + 16, acc * ((float)M * D / ((float)NEXP * D))); }
#elif MK_CHECK == 16
        (void)badw;
#elif MK_CHECK >= 6
        (void)badw;
#elif MK_CHECK == 5
        {
            const float* cc = A->in[1]; const float* wm = A->in[2]; const float* bm = A->in[3];
            unsigned mb = 0;
            for (int o = vcu * 512 + tid; o < 2 * 2 * MODW; o += G * 512) { const int l = o / (2 * MODW), b = (o / MODW) & 1, n = o % MODW;
                float sacc = 0.f; for (int k = 0; k < D; ++k) { const float cv = cc[b * D + k]; sacc += (cv / (1.f + __expf(-cv))) * wm[((size_t)l * D + k) * MODW + n]; }
                sacc += bm[l * MODW + n];
                if (!(fabsf(sacc - mod[o]) <= 2e-3f * fabsf(sacc) + 2e-3f)) mb = 1; }
            if (mb) atomicAdd(badw, 1u);
            unsigned sb = 0;
            for (int o = vcu * 512 + tid; o < 2 * 8 * 2 * 128 * 128; o += G * 512) { const float want = A->in[20][o]; const float got = bf1(SUBK[o]); if (!(fabsf(got - want) <= 0.01f * fabsf(want) + 1e-6f)) sb = 1; }
            if (sb) atomicAdd(badw + 1, 1u);
        }
#else
        for (int it = vcu; it < 256; it += G) { const int row = (it * 131 + 7) & 8191; chk_hq(0, row, X1, A->in[5], mod, A->in[19], H, QB, badw, (LAS float*)lds, (LAS float*)(lds + 16384), tid); }
#endif
    }
    if (IN(20)) {
        PHASE_TID();
        const unsigned* badw = (const unsigned*)(A->ws + WS_CTL) + 8;
        const unsigned b0 = __hip_atomic_load(badw, __ATOMIC_RELAXED, __HIP_MEMORY_SCOPE_AGENT), b1 = __hip_atomic_load(badw + 1, __ATOMIC_RELAXED, __HIP_MEMORY_SCOPE_AGENT);
#if MK_CHECK >= 6 && MK_CHECK != 16
        const float f = 1.f + ((const float*)(A->ws + WS_CTL))[16] * (1.f / ((float)M * D)); (void)b0; (void)b1;
#else
        const float f = (b0 ? (b1 ? -2.f : 0.f) : (b1 ? -1.f : 1.f));
#endif
        for (int m = gw; m < M; m += NGW) { const f32x4* xr = (const f32x4*)(X2 + (size_t)m * D) + lane; f32x4 v[8]; float ss = 0.f;
#pragma unroll
            for (int j = 0; j < 8; ++j) { v[j] = xr[64 * j]; ss += (v[j].x * v[j].x + v[j].y * v[j].y) + (v[j].z * v[j].z + v[j].w * v[j].w); }
            const float r = rsqrtf(wave_sum(ss) * (1.f / D) + EPS) * f;
#pragma unroll
            for (int j = 0; j < 8; ++j) { const f32x4 fn = ((const f32x4*)A->in[23])[lane + 64 * j]; ((f32x4*)(A->out + (size_t)m * D))[lane + 64 * j] = v[j] * r * fn; } }
    }
#endif
#undef IN
#undef SEAM
#undef mod
#undef H
#undef Z
#undef X1
#undef X2
}
}

extern "C" void kernel_launch(void* const* d_in, const int* in_sizes, int n_in, void* d_out, int out_size, void* d_ws, size_t ws_size, hipStream_t stream) {
    using namespace mk;
    static int grid = 0;
    if (grid == 0) {
        if (n_in != 24 || out_size != M * D || ws_size < WS_END) { fprintf(stderr, "kernel_launch: unexpected shapes (n_in %d out %d ws %zu)\n", n_in, out_size, ws_size); grid = -1; return; }
        int dev = 0, cus = 0, per_cu = 0;
        if (hipGetDevice(&dev) != hipSuccess || hipDeviceGetAttribute(&cus, hipDeviceAttributeMultiprocessorCount, dev) != hipSuccess) { grid = -1; return; }
        if (hipFuncSetAttribute((const void*)fwd, hipFuncAttributeMaxDynamicSharedMemorySize, LDS_BYTES) != hipSuccess) { fprintf(stderr, "kernel_launch: hipFuncSetAttribute failed\n"); grid = -1; return; }
        if (hipOccupancyMaxActiveBlocksPerMultiprocessor(&per_cu, (const void*)fwd, 512, LDS_BYTES) != hipSuccess || per_cu < 1) fprintf(stderr, "kernel_launch: occupancy query says %d\n", per_cu);
        (void)hipGetLastError();
        grid = cus;
    }
    if (grid < 0) return;
    (void)hipMemsetAsync((char*)d_ws + WS_CTL, 0, CTL_ZERO_BYTES, stream);
    Args a{};
    for (int i = 0; i < 24; ++i) a.in[i] = (const float*)d_in[i];
    a.out = (float*)d_out; a.ws = (unsigned char*)d_ws; a.pad = 0;
#if MK_CHECK
    constexpr int NLAUNCH = 12;
#else
    constexpr int NLAUNCH = MK_N_LAUNCHES;
#endif
    for (int li = 0; li < NLAUNCH; ++li) {
        a.ph_lo = (NLAUNCH == 1) ? 0 : li; a.ph_hi = (NLAUNCH == 1) ? NPHASE : li + 1; a.li = li;
#if MK_CHECK
        if (li >= 10) { a.ph_lo = li + 9; a.ph_hi = li + 10; }
#endif
        hipLaunchKernelGGL(fwd, dim3(grid), dim3(512), LDS_BYTES, stream, a);
    }
}
```

```cpp
#include <hip/hip_runtime.h>
#include <cstdio>
#include <cstdint>
#define MK_DBG 0
#define MK_N_LAUNCHES 1
#define MK_CHECK 0
namespace pg8 {
#define PG8_LAS __attribute__((address_space(3)))
typedef unsigned short bf16_t;
typedef short bf16x8 __attribute__((ext_vector_type(8)));
typedef float f32x4 __attribute__((ext_vector_type(4)));
typedef unsigned u32x4 __attribute__((ext_vector_type(4)));
constexpr int BM = 256, BK = 64, HALF = 128, HTB = HALF * BK * 2  , STAGE_BYTES = 8 * HTB, NXCD = 8, WGM = 8;

__host__ __device__ __forceinline__ int lds_byte(int r, int c) { const int st = (r >> 4) * 2 + (c >> 5), rr = r & 15, cc = c & 31, ob = rr * 64 + cc * 2; return st * 1024 + (ob ^ (((ob >> 9) & 1) << 5)); }
__host__ __device__ __forceinline__ void stage_rc(int b, int& R, int& C) { const int st = b / 1024, sb = b % 1024, swz = sb ^ (((sb >> 9) & 1) << 5); R = (st >> 1) * 16 + swz / 64; C = (st & 1) * 32 + (swz % 64) / 2; }
__host__ __device__ __forceinline__ int perm32(int rho) { const int n = rho >> 4, i = rho & 15; return 8 * (i >> 2) + 4 * n + (i & 3); }

struct Unit { int pm, pn; };
struct Gemm { const bf16_t* A; const bf16_t* Bt; int M, N, K; };

struct StaticOrder {
    int nM, nN, nwg, G, c;
    __host__ __device__ void init(int M, int N, int G_, int c_) { nM = M / BM; nN = N / BM; nwg = nM * nN; G = G_; c = c_; }
    __host__ __device__ bool next(int i, Unit& u) const {
        const long L = (long)i * G + c; if (L >= nwg) return false;
        int wgid = (int)L; { const int q = nwg / NXCD, r = nwg % NXCD, xcd = wgid % NXCD, off = wgid / NXCD; wgid = (xcd < r ? xcd * (q + 1) : r * (q + 1) + (xcd - r) * q) + off; }
        const int nig = WGM * nN, gid = wgid / nig, fm = gid * WGM, gsz = (nM - fm) < WGM ? (nM - fm) : WGM;
        u.pm = fm + ((wgid % nig) % gsz); u.pn = (wgid % nig) / gsz; return true;
    }
    __device__ __forceinline__ void a_ready(const Unit&) const {}
    __device__ __forceinline__ void done(const Unit&) const {}
};
struct CountedOrder : StaticOrder {
    const unsigned* ready; unsigned need; unsigned* tmo;
    __device__ __forceinline__ void a_ready(const Unit& u) const {
        if (threadIdx.x < 64) {
            const unsigned long long t0 = __builtin_amdgcn_s_memrealtime(); unsigned polls = 0;
            while ((unsigned)__builtin_amdgcn_readfirstlane(__hip_atomic_load(ready + 64 * u.pm, __ATOMIC_RELAXED, __HIP_MEMORY_SCOPE_AGENT)) < need) {
                if ((++polls & 255u) == 0u && __builtin_amdgcn_readfirstlane(__hip_atomic_load(tmo, __ATOMIC_RELAXED, __HIP_MEMORY_SCOPE_AGENT)) != 0u) break;
                if (__builtin_amdgcn_s_memrealtime() - t0 > 2000000ull) {
                    if (threadIdx.x == 0) { unsigned expect = 0u; __hip_atomic_compare_exchange_strong(tmo + 1, &expect, 0x600u | (unsigned)(u.pm & 0xff), __ATOMIC_RELAXED, __ATOMIC_RELAXED, __HIP_MEMORY_SCOPE_AGENT); __hip_atomic_store(tmo, 1u, __ATOMIC_RELAXED, __HIP_MEMORY_SCOPE_AGENT); }
                    break; }
                __builtin_amdgcn_s_sleep(2); }
            __builtin_amdgcn_fence(__ATOMIC_ACQUIRE, "agent");
            asm volatile("s_waitcnt vmcnt(0)" ::: "memory");
        }
#if !defined(BROKEN_HOOK_NO_BARRIER)
        asm volatile("" ::: "memory"); __builtin_amdgcn_s_barrier(); asm volatile("" ::: "memory");
#endif
    }
};

__device__ __forceinline__ unsigned cvt_pk_bf16(float lo, float hi) { unsigned r; asm volatile("v_cvt_pk_bf16_f32 %0, %1, %2" : "=v"(r) : "v"(lo), "v"(hi)); return r; }
typedef float f32x2 __attribute__((ext_vector_type(2)));
__device__ __forceinline__ f32x2 gelu_pk(f32x2 v) {
    const f32x2 av = __builtin_elementwise_abs(v), d = av * 0.2316418882f + 1.0f;
    f32x2 t; t.x = __builtin_amdgcn_rcpf(d.x); t.y = __builtin_amdgcn_rcpf(d.y);
    f32x2 q = t * 0.5307027145f + (-0.7265760135f); q = q * t + 0.7107068705f; q = q * t + (-0.142248368f); q = q * t + 0.127414796f; q = q * t;
    const f32x2 s = (v * v) * (-0.72134752044f);
    f32x2 e; e.x = __builtin_amdgcn_exp2f(s.x); e.y = __builtin_amdgcn_exp2f(s.y);
    const f32x2 m = v * (q * e), r = v - m;
    f32x2 o; o.x = v.x < 0.f ? m.x : r.x; o.y = v.y < 0.f ? m.y : r.y; return o;
}

struct EpiF32 {
    static constexpr bool PERM = false, AFTER_DRAIN = false;
    float* C; int ldc; const float* bias;
    __device__ __forceinline__ void operator()(const f32x4 (&acc)[2][2][4][2], const Unit& u, int wr, int wc, int fr, int fq) const {
        const int row0 = u.pm * BM + wr * 64 + fr, col0 = u.pn * BM + wc * 32 + 4 * fq;
        f32x4 bv[2][2];
#pragma unroll
        for (int bj = 0; bj < 2; ++bj)
#pragma unroll
            for (int n = 0; n < 2; ++n) bv[bj][n] = bias ? *(const f32x4*)(bias + col0 + bj * HALF + n * 16) : (f32x4){0.f, 0.f, 0.f, 0.f};
#pragma unroll
        for (int ai = 0; ai < 2; ++ai)
#pragma unroll
            for (int m = 0; m < 4; ++m) { float* rowp = C + (size_t)(row0 + ai * HALF + m * 16) * ldc + col0;
#pragma unroll
                for (int bj = 0; bj < 2; ++bj)
#pragma unroll
                    for (int n = 0; n < 2; ++n) *(f32x4*)(rowp + bj * HALF + n * 16) = acc[ai][bj][m][n] + bv[bj][n]; }
    }
};
template <int ACT  > struct EpiBf16 {
    static constexpr bool PERM = true, AFTER_DRAIN = false;
    bf16_t* O; int ldc; const float* bias; int split_cols; size_t split_stride;
    __device__ __forceinline__ void operator()(const f32x4 (&acc)[2][2][4][2], const Unit& u, int wr, int wc, int fr, int fq) const {
        const int row0 = u.pm * BM + wr * 64 + fr; int colt = u.pn * BM; bf16_t* base = O;
        if (split_cols) { const int t = colt / split_cols; base += (size_t)t * split_stride; colt -= t * split_cols; }
        const int col0 = colt + wc * 32 + 8 * fq, bcol0 = u.pn * BM + wc * 32 + 8 * fq;
        f32x4 bv[2][2];
#pragma unroll
        for (int bj = 0; bj < 2; ++bj)
#pragma unroll
            for (int n = 0; n < 2; ++n) bv[bj][n] = bias ? *(const f32x4*)(bias + bcol0 + bj * HALF + 4 * n) : (f32x4){0.f, 0.f, 0.f, 0.f};
#pragma unroll
        for (int ai = 0; ai < 2; ++ai)
#pragma unroll
            for (int m = 0; m < 4; ++m) { bf16_t* rowp = base + (size_t)(row0 + ai * HALF + m * 16) * ldc + col0;
#pragma unroll
                for (int bj = 0; bj < 2; ++bj) { f32x4 v0 = acc[ai][bj][m][0] + bv[bj][0], v1 = acc[ai][bj][m][1] + bv[bj][1];
                    if (ACT == 1) { f32x2 a = gelu_pk((f32x2){v0[0], v0[1]}), b = gelu_pk((f32x2){v0[2], v0[3]}), c = gelu_pk((f32x2){v1[0], v1[1]}), d = gelu_pk((f32x2){v1[2], v1[3]});
                        v0 = (f32x4){a.x, a.y, b.x, b.y}; v1 = (f32x4){c.x, c.y, d.x, d.y}; }
                    if (ACT == 2) {
#pragma unroll
                        for (int j = 0; j < 4; ++j) { v0[j] = 0.5f * v0[j] * (1.0f + erff(v0[j] * 0.70710678f)); v1[j] = 0.5f * v1[j] * (1.0f + erff(v1[j] * 0.70710678f)); } }
                    u32x4 w; w.x = cvt_pk_bf16(v0[0], v0[1]); w.y = cvt_pk_bf16(v0[2], v0[3]); w.z = cvt_pk_bf16(v1[0], v1[1]); w.w = cvt_pk_bf16(v1[2], v1[3]);
                    *(u32x4*)(rowp + bj * HALF) = w; } }
    }
};
template <class Epi, class Sched, bool STAMP = false>
__device__ __forceinline__ void gemm_phase(PG8_LAS unsigned char* lds, const Gemm g, const Sched& S, const Epi& E, unsigned long long* stamps, int wave_id) {
    unsigned zz_o = 0u; asm volatile("" : "+v"(zz_o)); int tid_o = wave_id * 64 + (int)__builtin_amdgcn_mbcnt_hi(~0u, __builtin_amdgcn_mbcnt_lo(~0u, zz_o));
    const int tid = tid_o, wid = __builtin_amdgcn_readfirstlane(tid >> 6), lane = tid & 63, wr = wid >> 2, wc = wid & 3, fr = lane & 15, fq = lane >> 4;
    constexpr int K = 2048, nt = K / BK;
    int ts_lo = 0, ts_hi = 0, nts = 0; const unsigned long long rt_entry = STAMP ? (unsigned long long)wall_clock64() : 0ull;
#define PG8_STAMP() do { if (STAMP && wid == 0 && nts < 64) { const unsigned long long _c = (unsigned long long)clock64(); \
        ts_lo = (lane == nts) ? (int)(unsigned)_c : ts_lo; ts_hi = (lane == nts) ? (int)(unsigned)(_c >> 32) : ts_hi; ++nts; } } while (0)
    PG8_STAMP();
    unsigned voffA[2], voffB[2];
#pragma unroll
    for (int i = 0; i < 2; ++i) { int R, C; stage_rc(tid * 16 + i * 8192, R, C); const int Rb = Epi::PERM ? ((R & ~31) + perm32(R & 31)) : R;
        voffA[i] = (unsigned)(R * K + C) * 2u; voffB[i] = (unsigned)(Rb * K + C) * 2u; }
    const size_t kstep = (size_t)(BK * 2);
    const size_t hstep = (size_t)HALF * K * 2;
    const size_t tstep = 2 * hstep;
    const unsigned ldsw = (unsigned)wid * 1024u;
    const int aoff = lds_byte(wr * 64 + fr, fq * 8), boff = lds_byte(wc * 32 + fr, fq * 8);
#define PG8_SA(b, h) (((b) * 2 + (h)) * HTB)
#define PG8_SB(b, h) ((4 + (b) * 2 + (h)) * HTB)
#define PG8_STAGE(bufoff, gbase, voff) do { _Pragma("unroll") for (int _i = 0; _i < 2; ++_i) \
        __builtin_amdgcn_global_load_lds((const unsigned*)((const char*)(gbase) + (voff)[_i]), (PG8_LAS unsigned*)(lds + (bufoff) + ldsw + _i * 8192), 16, 0, 0); } while (0)
#define PG8_LDA(dst, b, h) do { _Pragma("unroll") for (int m = 0; m < 4; ++m) _Pragma("unroll") for (int k = 0; k < 2; ++k) dst[m][k] = *(const PG8_LAS bf16x8*)(lds + PG8_SA(b, h) + aoff + m * 2048 + k * 1024); } while (0)
#define PG8_LDB(dst, b, h) do { _Pragma("unroll") for (int n = 0; n < 2; ++n) _Pragma("unroll") for (int k = 0; k < 2; ++k) dst[n][k] = *(const PG8_LAS bf16x8*)(lds + PG8_SB(b, h) + boff + n * 2048 + k * 1024); } while (0)
#define PG8_MMA(ai, bj, At, Bt) do { __builtin_amdgcn_s_setprio(1); _Pragma("unroll") for (int m = 0; m < 4; ++m) _Pragma("unroll") for (int n = 0; n < 2; ++n) _Pragma("unroll") for (int k = 0; k < 2; ++k) \
        acc[ai][bj][m][n] = __builtin_amdgcn_mfma_f32_16x16x32_bf16(Bt[n][k], At[m][k], acc[ai][bj][m][n], 0, 0, 0); __builtin_amdgcn_s_setprio(0); } while (0)
#define PG8_WAIT_V(n) asm volatile("s_waitcnt vmcnt(" #n ")" ::: "memory")
#define PG8_WAIT_L(n) asm volatile("s_waitcnt lgkmcnt(" #n ")" ::: "memory")
#define PG8_BAR __builtin_amdgcn_s_barrier()
#define PG8_SCHED __builtin_amdgcn_sched_barrier(0)
    Unit cur, nxt; int ui = 0;
    if (!S.next(0, cur)) return;
    f32x4 acc[2][2][4][2];
#pragma unroll
    for (int a = 0; a < 2; ++a)
#pragma unroll
        for (int b = 0; b < 2; ++b)
#pragma unroll
            for (int m = 0; m < 4; ++m)
#pragma unroll
                for (int n = 0; n < 2; ++n) acc[a][b][m][n] = (f32x4){0.f, 0.f, 0.f, 0.f};
    bf16x8 At[4][2], B0[2][2], B1[2][2];
    const char* cA = (const char*)g.A + (size_t)cur.pm * tstep; const char* cB = (const char*)g.Bt + (size_t)cur.pn * tstep;
    S.a_ready(cur);
    PG8_STAGE(PG8_SB(0, 0), cB, voffB); PG8_STAGE(PG8_SA(0, 0), cA, voffA); PG8_STAGE(PG8_SB(0, 1), cB + hstep, voffB); PG8_STAGE(PG8_SA(0, 1), cA + hstep, voffA);
    if (wr == 1) PG8_BAR;
    PG8_WAIT_V(4); PG8_BAR;
    PG8_STAGE(PG8_SB(1, 0), cB + kstep, voffB); PG8_STAGE(PG8_SA(1, 0), cA + kstep, voffA); PG8_STAGE(PG8_SB(1, 1), cB + hstep + kstep, voffB);
    PG8_WAIT_V(6); PG8_BAR;
    PG8_STAMP();
    for (;;) {
        const bool has_next = S.next(ui + 1, nxt);
        const char* nA = has_next ? (const char*)g.A + (size_t)nxt.pm * tstep : cA; const char* nB = has_next ? (const char*)g.Bt + (size_t)nxt.pn * tstep : cB;
        for (int t = 0; t < nt; t += 2) {
            const bool last = (t == nt - 2);
            const char* a1 = cA + (size_t)(t + 1) * kstep;
            const char* a2 = last ? nA : cA + (size_t)(t + 2) * kstep; const char* b2 = last ? nB : cB + (size_t)(t + 2) * kstep;
            const char* a3 = a2 + kstep; const char* b3 = b2 + kstep;
            if (last && has_next) S.a_ready(nxt);
            PG8_LDB(B0, 0, 0); PG8_SCHED; PG8_LDA(At, 0, 0); PG8_STAGE(PG8_SA(1, 1), a1 + hstep, voffA);
            PG8_WAIT_L(8); PG8_BAR; PG8_WAIT_L(0); PG8_MMA(0, 0, At, B0); PG8_BAR; PG8_SCHED;
            PG8_LDB(B1, 0, 1); PG8_STAGE(PG8_SB(0, 0), b2, voffB);
            PG8_BAR; PG8_WAIT_L(0); PG8_MMA(0, 1, At, B1); PG8_BAR;
            PG8_LDA(At, 0, 1); PG8_STAGE(PG8_SA(0, 0), a2, voffA);
            PG8_BAR; PG8_WAIT_L(0); PG8_MMA(1, 0, At, B0); PG8_BAR; PG8_SCHED;
            PG8_STAGE(PG8_SB(0, 1), b2 + hstep, voffB);
            PG8_WAIT_V(6); PG8_BAR; PG8_MMA(1, 1, At, B1); PG8_BAR;
            PG8_LDB(B0, 1, 0); PG8_SCHED; PG8_LDA(At, 1, 0); PG8_STAGE(PG8_SA(0, 1), a2 + hstep, voffA);
            PG8_WAIT_L(8); PG8_BAR; PG8_WAIT_L(0); PG8_MMA(0, 0, At, B0); PG8_BAR; PG8_SCHED;
            PG8_LDB(B1, 1, 1); PG8_STAGE(PG8_SB(1, 0), b3, voffB);
            PG8_BAR; PG8_WAIT_L(0); PG8_MMA(0, 1, At, B1); PG8_BAR;
            PG8_LDA(At, 1, 1); PG8_STAGE(PG8_SA(1, 0), a3, voffA);
            PG8_BAR; PG8_WAIT_L(0); PG8_MMA(1, 0, At, B0); PG8_BAR; PG8_SCHED;
            PG8_STAGE(PG8_SB(1, 1), b3 + hstep, voffB);
            PG8_WAIT_V(6); PG8_BAR; PG8_MMA(1, 1, At, B1); PG8_BAR;
        }
        PG8_STAMP();
        if constexpr (!Epi::AFTER_DRAIN) { E(acc, cur, wr, wc, fr, fq); S.done(cur); }
        PG8_STAMP();
        if (!has_next) break;
#pragma unroll
        for (int a = 0; a < 2; ++a)
#pragma unroll
            for (int b = 0; b < 2; ++b)
#pragma unroll
                for (int m = 0; m < 4; ++m)
#pragma unroll
                    for (int n = 0; n < 2; ++n) acc[a][b][m][n] = (f32x4){0.f, 0.f, 0.f, 0.f};
        cur = nxt; cA = nA; cB = nB; ++ui;
    }
    PG8_WAIT_V(0);
    if (wr == 0) PG8_BAR;
    PG8_BAR;
    if constexpr (Epi::AFTER_DRAIN) { E.fused(acc, cur, wr, wc, fr, fq, lds, wid, lane); S.done(cur); }
    PG8_STAMP();
    if (STAMP && wid == 0) { stamps[lane] = lane < nts ? (((unsigned long long)(unsigned)ts_hi << 32) | (unsigned)ts_lo) : 0ull;
        if (lane == 62) stamps[62] = rt_entry; if (lane == 63) stamps[63] = (unsigned long long)wall_clock64(); }
#undef PG8_STAMP
#undef PG8_SA
#undef PG8_SB
#undef PG8_STAGE
#undef PG8_LDA
#undef PG8_LDB
#undef PG8_MMA
#undef PG8_WAIT_V
#undef PG8_WAIT_L
#undef PG8_BAR
#undef PG8_SCHED
}
}

namespace mk {
#define GAS __attribute__((address_space(1)))
#define LAS __attribute__((address_space(3)))
#define DEV __device__ __forceinline__
typedef unsigned short bf16;
typedef unsigned v4u __attribute__((ext_vector_type(4)));
typedef float f32x4 __attribute__((ext_vector_type(4)));
typedef float f32x2 __attribute__((ext_vector_type(2)));
typedef short bf16x8 __attribute__((ext_vector_type(8)));
typedef float f32x16 __attribute__((ext_vector_type(16)));
typedef __bf16 bf16x2_t __attribute__((ext_vector_type(2)));

#ifndef MK_DBG
#define MK_DBG 0
#endif
#ifndef MK_CHECK
#define MK_CHECK 0
#endif
#ifndef MK_DUP
#define MK_DUP (-1)
#endif
#ifndef MK_N_LAUNCHES
#define MK_N_LAUNCHES 19
#endif

constexpr int D = 2048, SEQ = 4096, M = 8192, NL = 2;
constexpr int LRU_W = 768, SWA_W = 768, SB_W = 512, IN_W = 5376;
constexpr int ZO_XA = 0, ZO_GA = 768, ZO_QB = 1536, ZO_KB = 2304, ZO_VB = 3072, ZO_QC = 3840, ZO_KC = 4352, ZO_VC = 4864;
constexpr int NEXP = 16384, MODW = 12288;
constexpr int MO_SH1 = 0, MO_SC1 = 2048, MO_G1 = 4096, MO_SH2 = 6144, MO_SC2 = 8192, MO_G2 = 10240;
constexpr float EPS = 1e-6f;
constexpr float QSCALE = 0.08838834764831845f;
constexpr float NEGBIG = -3.0e38f;
constexpr int NPHASE = 19 + 2 * (MK_CHECK != 0);

constexpr size_t MiB = 1u << 20;
constexpr size_t WS_CTL = 0, CTL_ZERO_BYTES = 1 * MiB;
constexpr size_t WS_MOD = 512 * 1024;
constexpr size_t WS_WIN_T = 2 * MiB, WS_WOUT_T = 44 * MiB, WS_WQ_T = 60 * MiB, WS_SUBK = 76 * MiB, WS_U = 80 * MiB, WS_V = 208 * MiB,
                 WS_H = 336 * MiB, WS_Z = 368 * MiB, WS_HLOC = 452 * MiB, WS_P = 476 * MiB, WS_YB = 500 * MiB, WS_YC = 524 * MiB,
                 WS_SUMA = 540 * MiB, WS_SUMB = 541 * MiB, WS_X1 = 544 * MiB, WS_X2 = 608 * MiB, WS_Q = 672 * MiB, WS_IDS = 704 * MiB,
                 WS_G = 708 * MiB, WS_WG_T = 77 * MiB, WS_PART = 712 * MiB, WS_LSE = 784 * MiB, WS_XR = 786 * MiB, WS_END = 818 * MiB;
constexpr int CW_BAR = 4096;

constexpr int LDS_BYTES = 147456;
constexpr int LDS_MISC = 143360;

__device__ const unsigned char T5B[3][132] = {
 {0,1,2,3,4,5,6,7,8,9,10,11,12,13,14,15,16,16,16,16,16,16,17,17,17,17,17,17,17,17,18,18,18,18,18,18,18,18,18,18,19,19,19,19,19,19,19,19,19,19,19,19,19,19,20,20,20,20,20,20,20,20,20,20,20,20,20,20,20,20,20,20,20,21,21,21,21,21,21,21,21,21,21,21,21,21,21,21,21,21,21,21,21,21,21,21,21,21,21,22,22,22,22,22,22,22,22,22,22,22,22,22,22,22,22,22,22,22,22,22,22,22,22,22,22,22,22,22,22,0,0,0},
 {0,4,8,12,16,16,17,17,18,18,19,19,19,19,20,20,20,20,20,21,21,21,21,21,21,22,22,22,22,22,22,22,22,22,23,23,23,23,23,23,23,23,23,23,23,23,24,24,24,24,24,24,24,24,24,24,24,24,24,24,24,24,25,25,25,25,25,25,25,25,25,25,25,25,25,25,25,25,25,25,25,25,25,26,26,26,26,26,26,26,26,26,26,26,26,26,26,26,26,26,26,26,26,26,26,26,26,26,26,26,26,26,26,27,27,27,27,27,27,27,27,27,27,27,27,27,27,27,27,0,0,0},
 {0,16,18,19,20,21,21,22,22,23,23,23,24,24,24,24,25,25,25,25,25,26,26,26,26,26,26,26,26,27,27,27,27,27,27,27,27,27,27,28,28,28,28,28,28,28,28,28,28,28,28,28,29,29,29,29,29,29,29,29,29,29,29,29,29,29,29,29,29,29,30,30,30,30,30,30,30,30,30,30,30,30,30,30,30,30,30,30,30,30,30,30,30,30,30,31,31,31,31,31,31,31,31,31,31,31,31,31,31,31,31,31,31,31,31,31,31,31,31,31,31,31,31,31,31,31,31,31,31,0,0,0}};

#define LDS_WAIT() asm volatile("s_waitcnt lgkmcnt(0)" ::: "memory")
DEV unsigned f2bf(float f) { unsigned u = __builtin_bit_cast(unsigned, f); return (u + 0x7fffu + ((u >> 16) & 1u)) >> 16; }
DEV unsigned pk2(float lo, float hi) { return f2bf(lo) | (f2bf(hi) << 16); }
DEV float bf_lo(unsigned w) { return __builtin_bit_cast(float, w << 16); }
DEV float bf_hi(unsigned w) { return __builtin_bit_cast(float, w & 0xffff0000u); }
DEV float bf1(bf16 h) { return __builtin_bit_cast(float, ((unsigned)h) << 16); }
template <int MSK> DEV float swz_xor(float v) { return __builtin_bit_cast(float, __builtin_amdgcn_ds_swizzle(__builtin_bit_cast(int, v), (MSK << 10) | 0x1F)); }
DEV float part32_(float v) { int ln = (int)__builtin_amdgcn_mbcnt_hi(~0u, __builtin_amdgcn_mbcnt_lo(~0u, 0u)); asm volatile("" : "+v"(ln)); return __builtin_bit_cast(float, __builtin_amdgcn_ds_bpermute((ln ^ 32) << 2, __builtin_bit_cast(int, v))); }
DEV float sum32(float v) { return v + part32_(v); }
DEV float max32(float v) { return fmaxf(v, part32_(v)); }
DEV float partner32(float v, int hh) { (void)hh; return part32_(v); }
DEV float wave_sum(float v) { v += swz_xor<1>(v); v += swz_xor<2>(v); v += swz_xor<4>(v); v += swz_xor<8>(v); v += swz_xor<16>(v); return sum32(v); }
DEV float wave_max(float v) { v = fmaxf(v, swz_xor<1>(v)); v = fmaxf(v, swz_xor<2>(v)); v = fmaxf(v, swz_xor<4>(v)); v = fmaxf(v, swz_xor<8>(v)); v = fmaxf(v, swz_xor<16>(v)); return max32(v); }
DEV float sigmoid_f(float x) { return 1.f / (1.f + __expf(-x)); }
DEV float softplus_f(float x) { return fmaxf(x, 0.f) + log1pf(__expf(-fabsf(x))); }
DEV float gelu_tanh(float x) { const float u = 0.7978845608028654f * (x + 0.044715f * x * x * x); const float t = 1.f - 2.f / (1.f + __expf(2.f * u)); return 0.5f * x * (1.f + t); }
DEV float dot8(const v4u a, const v4u b) {
    float s = bf_lo(a.x) * bf_lo(b.x); s += bf_hi(a.x) * bf_hi(b.x);
    s += bf_lo(a.y) * bf_lo(b.y); s += bf_hi(a.y) * bf_hi(b.y);
    s += bf_lo(a.z) * bf_lo(b.z); s += bf_hi(a.z) * bf_hi(b.z);
    s += bf_lo(a.w) * bf_lo(b.w); s += bf_hi(a.w) * bf_hi(b.w);
    return s;
}

#define XB_TMO      128
#define XB_XCNT(j)  (256  + 64 * (j))
#define XB_XSUB(j)  (1280 + 64 * (j))
#define XB_XGEN(j)  (2304 + 64 * (j))
#define XB_TOP      3328
#define XB_TOPGEN   3392
#define XCD_BAR_WORDS 3456
#define XB_SPIN_CAP (1u << 18)

__device__ __forceinline__ unsigned xb_ld(unsigned* p)              { return __hip_atomic_load(p, __ATOMIC_RELAXED, __HIP_MEMORY_SCOPE_AGENT); }
__device__ __forceinline__ unsigned xb_add(unsigned* p, unsigned v) { return __hip_atomic_fetch_add(p, v, __ATOMIC_RELAXED, __HIP_MEMORY_SCOPE_AGENT); }
__device__ __forceinline__ unsigned xb_xcc_id() { return (unsigned)__builtin_amdgcn_s_getreg((3 << 11) | 20) & 0xFu; }
#define XB_SPIN(cond, bar) do { unsigned _sp = 0; while (cond) { __builtin_amdgcn_s_sleep(1); \
    if ((++_sp & 255u) == 0u) { if (xb_ld(&(bar)[XB_TMO])) break; if (_sp > XB_SPIN_CAP) { atomicAdd(&(bar)[XB_TMO], 1u); break; } } } } while (0)

struct XcdBarrier {
    unsigned* bar; unsigned x;
    volatile LAS unsigned* st;
    int w0;
};
DEV bool xb_lead(int w0) { return w0 == 0 && __builtin_amdgcn_mbcnt_hi(~0u, __builtin_amdgcn_mbcnt_lo(~0u, 0u)) == 0u; }
__device__ __forceinline__ XcdBarrier xcd_barrier_post(unsigned* bar, volatile LAS unsigned* st, int w0) {
    XcdBarrier b; b.bar = bar; b.x = xb_xcc_id(); b.st = st; b.w0 = w0;
    if (xb_lead(w0)) (void)xb_add(&bar[XB_XCNT(b.x)], 1u);
    return b;
}
__device__ __forceinline__ void xcd_barrier_complete(unsigned* bar, unsigned x, unsigned& nloc, unsigned& nx) {
    const unsigned G = gridDim.x * gridDim.y * gridDim.z;
    unsigned sum, cnt, mine, sp = 0u;
    for (;;) {
        sum = 0u; cnt = 0u; mine = 0u;
#pragma unroll
        for (unsigned j = 0; j < 16; ++j) { const unsigned c = xb_ld(&bar[XB_XCNT(j)]); sum += c; cnt += (c > 0u) ? 1u : 0u; mine = (j == x) ? c : mine; }
        if (sum == G) break;
        __builtin_amdgcn_s_sleep(1);
        if ((++sp & 255u) == 0u) { if (xb_ld(&bar[XB_TMO])) break; if (sp > XB_SPIN_CAP) { atomicAdd(&bar[XB_TMO], 1u); break; } }
    }
    nloc = mine > 0u ? mine : 1u; nx = cnt > 0u ? cnt : 1u;
}
__device__ __forceinline__ void xcd_barrier(const XcdBarrier& b) {
    asm volatile("s_waitcnt vmcnt(0)" ::: "memory");
    __syncthreads();
    if (xb_lead(b.w0)) {
        unsigned* bar = b.bar;
        __builtin_amdgcn_s_waitcnt(0);
        unsigned nloc = b.st[0], nx = b.st[1];
        if (nloc == 0u) { xcd_barrier_complete(bar, b.x, nloc, nx); b.st[0] = nloc; b.st[1] = nx; }
        const unsigned old = xb_add(&bar[XB_XSUB(b.x)], 1u);
        const unsigned gen = old / nloc;
        if (old + 1u == (gen + 1u) * nloc) {
            __builtin_amdgcn_fence(__ATOMIC_RELEASE, "agent");
            asm volatile("s_waitcnt vmcnt(0)" ::: "memory");
            const unsigned og = xb_add(&bar[XB_TOP], 1u);
            const unsigned tg = og / nx;
            if (og + 1u == (tg + 1u) * nx) xb_add(&bar[XB_TOPGEN], 1u);
            else XB_SPIN(xb_ld(&bar[XB_TOPGEN]) == tg, bar);
            __builtin_amdgcn_fence(__ATOMIC_ACQUIRE, "agent");
            xb_add(&bar[XB_XGEN(b.x)], 1u);
            asm volatile("s_waitcnt vmcnt(0)" ::: "memory");
        } else {
            XB_SPIN(xb_ld(&bar[XB_XGEN(b.x)]) == gen, bar);
            __builtin_amdgcn_fence(__ATOMIC_ACQUIRE, "agent");
            asm volatile("s_waitcnt vmcnt(0)" ::: "memory");
        }
    }
    __syncthreads();
}

struct EpiResGate {
    static constexpr bool PERM = false, AFTER_DRAIN = false;
    const bf16* X; bf16* O; const float* gate; float gscale;
    __device__ __forceinline__ void operator()(const pg8::f32x4 (&acc)[2][2][4][2], const pg8::Unit& u, int wr, int wc, int fr, int fq) const {
        const int row0 = u.pm * 256 + wr * 64 + fr, col0 = u.pn * 256 + wc * 32 + 4 * fq;
        const float* gp = gate + (size_t)((u.pm * 256) >> 12) * MODW;
        pg8::f32x4 gv[2][2];
#pragma unroll
        for (int bj = 0; bj < 2; ++bj)
#pragma unroll
            for (int n = 0; n < 2; ++n) gv[bj][n] = *(const pg8::f32x4*)(gp + col0 + bj * 128 + n * 16) * gscale;
#pragma unroll
        for (int ai = 0; ai < 2; ++ai)
#pragma unroll
            for (int m = 0; m < 4; ++m) {
                const size_t ro = (size_t)(row0 + ai * 128 + m * 16) * D + col0;
#pragma unroll
                for (int bj = 0; bj < 2; ++bj)
#pragma unroll
                    for (int n = 0; n < 2; ++n) {
                        const unsigned long long xw = *(const unsigned long long*)(X + ro + bj * 128 + n * 16);
                        const pg8::f32x4 xv = {bf_lo((unsigned)xw), bf_hi((unsigned)xw), bf_lo((unsigned)(xw >> 32)), bf_hi((unsigned)(xw >> 32))};
                        const pg8::f32x4 ov = xv + gv[bj][n] * acc[ai][bj][m][n];
                        *(unsigned long long*)(O + ro + bj * 128 + n * 16) = (unsigned long long)pk2(ov.x, ov.y) | ((unsigned long long)pk2(ov.z, ov.w) << 32);
                    }
            }
    }
};

DEV void ph_mod(const float* __restrict__ c, const float* __restrict__ w_mod, const float* __restrict__ b_mod, float* __restrict__ mod, LAS float* red, int vcu, int G, int tid) {
    const int lane = tid & 63, wave = tid >> 6;
    for (int it = vcu; it < 2 * 192; it += G) {
        const int l = it / 192, cb = it % 192;
        const int k0 = wave * 256;
        const float* W = w_mod + ((size_t)l * D + k0) * MODW + cb * 64 + lane;
        float a0 = 0.f, a1 = 0.f;
#pragma unroll 16
        for (int k = 0; k < 256; ++k) {
            const float w = W[(size_t)k * MODW];
            const float c0 = c[k0 + k], c1 = c[D + k0 + k];
            a0 += (c0 * sigmoid_f(c0)) * w; a1 += (c1 * sigmoid_f(c1)) * w;
        }
        red[(wave * 2 + 0) * 64 + lane] = a0; red[(wave * 2 + 1) * 64 + lane] = a1;
        __syncthreads();
        if (tid < 128) {
            const int b = tid >> 6, ln = tid & 63; float s = 0.f;
#pragma unroll
            for (int w = 0; w < 8; ++w) s += red[(w * 2 + b) * 64 + ln];
            const int col = cb * 64 + ln;
            mod[(size_t)(l * 2 + b) * MODW + col] = s + b_mod[l * MODW + col];
        }
        __syncthreads();
    }
}
DEV void transpose_item(const float* __restrict__ W, int K, int N, bf16* __restrict__ WT, LAS float* scr, int item, int lane) {
    const int nblk = N / 32, kb = item / nblk, nb = item % nblk, k0 = 64 * kb, n0 = 32 * nb;
#pragma unroll 8
    for (int i = 0; i < 32; ++i) { const int kk = 2 * i + (lane >> 5); scr[kk * 33 + (lane & 31)] = W[(size_t)(k0 + kk) * N + n0 + (lane & 31)]; }
    LDS_WAIT();
    const int c = lane & 7;
#pragma unroll
    for (int j = 0; j < 4; ++j) { const int n = (lane >> 3) + 8 * j; const LAS float* s = scr + (8 * c) * 33 + n;
        v4u o; o.x = pk2(s[0 * 33], s[1 * 33]); o.y = pk2(s[2 * 33], s[3 * 33]); o.z = pk2(s[4 * 33], s[5 * 33]); o.w = pk2(s[6 * 33], s[7 * 33]);
        *(v4u*)(WT + (size_t)(n0 + n) * K + k0 + 8 * c) = o; }
    LDS_WAIT();
}
DEV void convert_copy(const float* __restrict__ src, bf16* __restrict__ dst, size_t ngroups8, size_t gtid, size_t gstride) {
    for (size_t g = gtid; g < ngroups8; g += gstride) {
        const f32x4 a = *(const f32x4*)(src + g * 8), b = *(const f32x4*)(src + g * 8 + 4);
        v4u o; o.x = pk2(a.x, a.y); o.y = pk2(a.z, a.w); o.z = pk2(b.x, b.y); o.w = pk2(b.z, b.w);
        *(v4u*)(dst + g * 8) = o;
    }
}

DEV void modnorm_rows(const float* __restrict__ X, const float* __restrict__ gain, const float* __restrict__ modl, int sh_off, int sc_off, bf16* __restrict__ H, int gw, int NGW, int lane, bf16* __restrict__ XC = nullptr) {
    for (int m = gw; m < M; m += NGW) {
        const int b = m >> 12;
        const f32x4* xr = (const f32x4*)(X + (size_t)m * D) + lane;
        f32x4 v[8]; float s = 0.f;
#pragma unroll
        for (int j = 0; j < 8; ++j) { v[j] = xr[64 * j]; s += (v[j].x * v[j].x + v[j].y * v[j].y) + (v[j].z * v[j].z + v[j].w * v[j].w); }
        const float r = rsqrtf(wave_sum(s) * (1.f / D) + EPS);
        const f32x4* g4 = (const f32x4*)gain + lane;
        const f32x4* sc4 = (const f32x4*)(modl + (size_t)b * MODW + sc_off) + lane;
        const f32x4* sh4 = (const f32x4*)(modl + (size_t)b * MODW + sh_off) + lane;
        unsigned long long* o8 = (unsigned long long*)(H + (size_t)m * D) + lane;
#pragma unroll
        for (int j = 0; j < 8; ++j) {
            const f32x4 g = g4[64 * j], sc = sc4[64 * j], sh = sh4[64 * j];
            const f32x4 y = (v[j] * r) * g * (sc + 1.f) + sh;
            o8[64 * j] = (unsigned long long)pk2(y.x, y.y) | ((unsigned long long)pk2(y.z, y.w) << 32);
            if (XC) ((unsigned long long*)(XC + (size_t)m * D) + lane)[64 * j] = (unsigned long long)pk2(v[j].x, v[j].y) | ((unsigned long long)pk2(v[j].z, v[j].w) << 32);
        }
    }
}
DEV void modnorm_rows_h(const bf16* __restrict__ X, const float* __restrict__ gain, const float* __restrict__ modl, int sh_off, int sc_off, bf16* __restrict__ H, int gw, int NGW, int lane) {
    for (int m = gw; m < M; m += NGW) {
        const int b = m >> 12;
        const v4u* xr = (const v4u*)(X + (size_t)m * D) + lane;
        float v[32]; float s = 0.f;
#pragma unroll
        for (int j = 0; j < 4; ++j) { const v4u w = xr[64 * j];
            v[8 * j + 0] = bf_lo(w.x); v[8 * j + 1] = bf_hi(w.x); v[8 * j + 2] = bf_lo(w.y); v[8 * j + 3] = bf_hi(w.y); v[8 * j + 4] = bf_lo(w.z); v[8 * j + 5] = bf_hi(w.z); v[8 * j + 6] = bf_lo(w.w); v[8 * j + 7] = bf_hi(w.w);
#pragma unroll
            for (int e = 0; e < 8; ++e) s += v[8 * j + e] * v[8 * j + e]; }
        const float r = rsqrtf(wave_sum(s) * (1.f / D) + EPS);
        const float* scp = modl + (size_t)b * MODW + sc_off; const float* shp = modl + (size_t)b * MODW + sh_off;
        v4u* o16 = (v4u*)(H + (size_t)m * D) + lane;
#pragma unroll
        for (int j = 0; j < 4; ++j) { const int col = 8 * (lane + 64 * j);
            const f32x4 g0 = *(const f32x4*)(gain + col), g1 = *(const f32x4*)(gain + col + 4), c0 = *(const f32x4*)(scp + col), c1 = *(const f32x4*)(scp + col + 4), h0 = *(const f32x4*)(shp + col), h1 = *(const f32x4*)(shp + col + 4);
            v4u o;
            o.x = pk2(v[8 * j + 0] * r * g0.x * (c0.x + 1.f) + h0.x, v[8 * j + 1] * r * g0.y * (c0.y + 1.f) + h0.y); o.y = pk2(v[8 * j + 2] * r * g0.z * (c0.z + 1.f) + h0.z, v[8 * j + 3] * r * g0.w * (c0.w + 1.f) + h0.w);
            o.z = pk2(v[8 * j + 4] * r * g1.x * (c1.x + 1.f) + h1.x, v[8 * j + 5] * r * g1.y * (c1.y + 1.f) + h1.y); o.w = pk2(v[8 * j + 6] * r * g1.z * (c1.z + 1.f) + h1.z, v[8 * j + 7] * r * g1.w * (c1.w + 1.f) + h1.w);
            o16[64 * j] = o; }
    }
}

DEV void lru_item(int l, int b, int j, int n, const bf16* __restrict__ Z, const float* __restrict__ conv_w, const float* __restrict__ conv_b,
                  const float* __restrict__ w_rec, const float* __restrict__ b_rec, const float* __restrict__ w_gi, const float* __restrict__ b_gi, const float* __restrict__ lam,
                  float* __restrict__ HLOC, float* __restrict__ PP, float* __restrict__ SUMA, float* __restrict__ SUMB, LAS float* xc, LAS float* aL, LAS float* uL, int tid) {
    const int ch = tid & 127, tq = tid >> 7, c = n * 128 + ch;
    {
        const float cw0 = conv_w[(l * 4 + 0) * LRU_W + c], cw1 = conv_w[(l * 4 + 1) * LRU_W + c], cw2 = conv_w[(l * 4 + 2) * LRU_W + c], cw3 = conv_w[(l * 4 + 3) * LRU_W + c];
        const float cb = conv_b[l * LRU_W + c];
#pragma unroll 4
        for (int i = 0; i < 16; ++i) {
            const int tok = tq + 4 * i, t = j * 64 + tok;
            const bf16* zp = Z + ((size_t)b * SEQ + t) * IN_W + ZO_XA + c;
            float s = cb + cw3 * bf1(zp[0]);
            if (t >= 1) s += cw2 * bf1(zp[-(ptrdiff_t)IN_W]);
            if (t >= 2) s += cw1 * bf1(zp[-(ptrdiff_t)2 * IN_W]);
            if (t >= 3) s += cw0 * bf1(zp[-(ptrdiff_t)3 * IN_W]);
            xc[tok * 128 + ch] = s;
        }
    }
    __syncthreads();
    float accr[16], acci[16];
#pragma unroll
    for (int i = 0; i < 16; ++i) { accr[i] = 0.f; acci[i] = 0.f; }
    const float* Wr = w_rec + ((size_t)(l * 6 + n) * 128) * 128 + ch;
    const float* Wi = w_gi + ((size_t)(l * 6 + n) * 128) * 128 + ch;
#pragma unroll 2
    for (int jj = 0; jj < 128; ++jj) {
        const float wr = Wr[jj * 128], wi = Wi[jj * 128];
#pragma unroll
        for (int i = 0; i < 16; ++i) { const float x = xc[(tq + 4 * i) * 128 + jj]; accr[i] += x * wr; acci[i] += x * wi; }
    }
    {
        const float br = b_rec[l * LRU_W + c], bi = b_gi[l * LRU_W + c], sp = softplus_f(-lam[l * LRU_W + c]);
#pragma unroll
        for (int i = 0; i < 16; ++i) {
            const int tok = tq + 4 * i;
            const float r = sigmoid_f(accr[i] + br), ig = sigmoid_f(acci[i] + bi);
            const float log_a = -8.0f * r * sp;
            const float av = __expf(log_a);
            const float x = xc[tok * 128 + ch];
            const float uv = sqrtf(fmaxf(-expm1f(2.f * log_a), 0.f)) * (ig * x);
            aL[tok * 128 + ch] = av; uL[tok * 128 + ch] = uv;
        }
    }
    __syncthreads();
    if (tid < 128) {
        float h = 0.f, P = 1.f;
        const size_t rb = ((size_t)b * SEQ + j * 64) * LRU_W + n * 128 + tid;
        for (int tok = 0; tok < 64; ++tok) {
            const float av = aL[tok * 128 + tid];
            h = av * h + uL[tok * 128 + tid]; P *= av;
            HLOC[rb + (size_t)tok * LRU_W] = h; PP[rb + (size_t)tok * LRU_W] = P;
        }
        SUMA[(size_t)(b * 64 + j) * LRU_W + n * 128 + tid] = P; SUMB[(size_t)(b * 64 + j) * LRU_W + n * 128 + tid] = h;
    }
    __syncthreads();
}

DEV void dil_item(int b, int h, int t, const bf16* __restrict__ Z, const float* __restrict__ rel_bias, float* __restrict__ YB, LAS float* qs, LAS float* lg, int lane) {
    const size_t row = (size_t)b * SEQ + t;
    { const unsigned w = *(const unsigned*)(Z + row * IN_W + ZO_QB + h * 128 + 2 * lane); qs[2 * lane] = bf_lo(w) * QSCALE; qs[2 * lane + 1] = bf_hi(w) * QSCALE; }
    LDS_WAIT();
    float mx = NEGBIG;
#pragma unroll
    for (int p = 0; p < 3; ++p) {
        const int d = 1 << (2 * p);
        for (int jj = lane; jj < 129; jj += 64) {
            const int pos = t - jj * d; float lgt = NEGBIG;
            if (pos >= 0) {
                const v4u* kr = (const v4u*)(Z + ((size_t)b * SEQ + pos) * IN_W + ZO_KB + h * 128);
                float s = 0.f;
#pragma unroll 4
                for (int c8 = 0; c8 < 16; ++c8) { const v4u kv = kr[c8]; const LAS float* q = qs + c8 * 8;
                    s += q[0] * bf_lo(kv.x) + q[1] * bf_hi(kv.x) + q[2] * bf_lo(kv.y) + q[3] * bf_hi(kv.y) + q[4] * bf_lo(kv.z) + q[5] * bf_hi(kv.z) + q[6] * bf_lo(kv.w) + q[7] * bf_hi(kv.w); }
                lgt = s + rel_bias[(int)T5B[p][jj] * 6 + h];
            }
            lg[p * 129 + jj] = lgt; mx = fmaxf(mx, lgt);
        }
    }
    mx = wave_max(mx);
    LDS_WAIT();
    float sum = 0.f;
    for (int idx = lane; idx < 387; idx += 64) { const float v = lg[idx]; const float pv = (v > -1.0e37f) ? __expf(v - mx) : 0.f; lg[idx] = pv; sum += pv; }
    sum = wave_sum(sum);
    LDS_WAIT();
    float a0 = 0.f, a1 = 0.f;
#pragma unroll
    for (int p = 0; p < 3; ++p) {
        const int d = 1 << (2 * p);
        int nk = t / d + 1; nk = nk > 129 ? 129 : nk;
        const bf16* vb = Z + row * IN_W + ZO_VB + h * 128 + 2 * lane;
#pragma unroll 4
        for (int jj = 0; jj < nk; ++jj) {
            const float pv = lg[p * 129 + jj];
            const unsigned w = *(const unsigned*)(vb - (size_t)jj * d * IN_W);
            a0 += pv * bf_lo(w); a1 += pv * bf_hi(w);
        }
    }
    const float inv = 1.f / sum;
    *(f32x2*)(YB + row * SWA_W + h * 128 + 2 * lane) = (f32x2){a0 * inv, a1 * inv};
    LDS_WAIT();
}


DEV unsigned cvtpk_bf16(float lo, float hi) { f32x2 v = {lo, hi}; bf16x2_t b = __builtin_convertvector(v, bf16x2_t); return __builtin_bit_cast(unsigned, b); }
constexpr int DIL_VSTR = 256;
constexpr int ATT_KOFF = 32 * DIL_VSTR;
constexpr int ATT_BOFF = ATT_KOFF + 8192;
constexpr int DIL_QOFF = ATT_BOFF + 132 * 4;
constexpr int ATT_WLDS = 17920;
static_assert(DIL_QOFF <= ATT_WLDS && 8 * ATT_WLDS <= LDS_MISC, "attention LDS");

DEV unsigned vimg_off(unsigned row, unsigned ch) { return 256u * row + 16u * (ch ^ (((row & 3u) << 2) | ((row >> 2) & 3u))); }
typedef short s16x4 __attribute__((ext_vector_type(4)));
DEV bf16x8 vfrag_tr(LAS unsigned char* img, int lane, int c, int ks) {
    const unsigned h = lane >> 5, blk = (lane >> 4) & 1, qq = (lane & 15) >> 2, pp = lane & 3;
    const s16x4 a = __builtin_amdgcn_ds_read_tr16_b64_v4i16((LAS s16x4*)(img + vimg_off(16 * ks + 8 * h + 0 + qq, 4 * c + 2 * blk + (pp >> 1)) + 8 * (pp & 1)));
    const s16x4 b = __builtin_amdgcn_ds_read_tr16_b64_v4i16((LAS s16x4*)(img + vimg_off(16 * ks + 8 * h + 4 + qq, 4 * c + 2 * blk + (pp >> 1)) + 8 * (pp & 1)));
    return __builtin_shufflevector(a, b, 0, 1, 2, 3, 4, 5, 6, 7);
}
DEV void dil_mfma_item(int b, int h, int p, int rr, int i0, const bf16* __restrict__ Z, const float* __restrict__ rel_bias, bf16* __restrict__ PART, float* __restrict__ LSE, LAS unsigned char* wl, int lane) {
    asm volatile("" : "+v"(lane));
    const int r = lane & 31, hh = lane >> 5;
    const int d = 1 << (2 * p);
    LAS float* biasL = (LAS float*)(wl + ATT_BOFF);
    for (int dd = lane; dd < 129; dd += 64) biasL[dd] = rel_bias[(int)T5B[p][dd] * 6 + h];
    const size_t rowq = (size_t)b * SEQ + rr + d * (i0 + r);
    bf16x8 qf[8];
    { const bf16* qrow = Z + rowq * IN_W + ZO_QB + h * 128 + 8 * hh;
#pragma unroll
      for (int ks = 0; ks < 8; ++ks) qf[ks] = *(const bf16x8*)(qrow + 16 * ks); }
    float m_run = NEGBIG, l_run = 0.f;
    f32x16 o[4];
#pragma unroll
    for (int dt = 0; dt < 4; ++dt)
#pragma unroll
        for (int e = 0; e < 16; ++e) o[dt][e] = 0.f;
    const int kap = (r & 0x13) | ((r & 4) << 1) | ((r & 8) >> 1);
    int jt = 4 - (i0 >> 5); jt = jt < 0 ? 0 : jt;
#define DIL_DMA_K(JT) do { int jk = i0 - 128 + 32 * (JT) + kap; jk = jk < 0 ? 0 : jk; const bf16* krow = Z + ((size_t)b * SEQ + rr + d * jk) * IN_W + ZO_KB + h * 128 + 8 * hh; \
        _Pragma("unroll") for (int ks = 0; ks < 8; ++ks) __builtin_amdgcn_global_load_lds((const unsigned*)(krow + 16 * ks), (LAS unsigned*)(wl + ATT_KOFF + 1024 * ks), 16, 0, 0); } while (0)
#define DIL_DMA_V(JT) do { const int j0_ = i0 - 128 + 32 * (JT); _Pragma("unroll") for (int q = 0; q < 8; ++q) { const int pi = lane + 64 * q, kl = pi >> 4, c = (pi & 15) ^ (((kl & 3) << 2) | ((kl >> 2) & 3)); int j = j0_ + kl; j = j < 0 ? 0 : j; \
        __builtin_amdgcn_global_load_lds((const unsigned*)(Z + ((size_t)b * SEQ + rr + d * j) * IN_W + ZO_VB + h * 128 + 8 * c), (LAS unsigned*)(wl + 1024 * q), 16, 0, 0); } } while (0)
    LDS_WAIT();
    DIL_DMA_K(jt); DIL_DMA_V(jt);
    for (; jt < 5; ++jt) {
        const int j0 = i0 - 128 + 32 * jt;
        const int jn = jt < 4 ? jt + 1 : 4;
        asm volatile("s_waitcnt vmcnt(8)" ::: "memory");
        f32x16 sacc;
#pragma unroll
        for (int e = 0; e < 16; ++e) sacc[e] = 0.f;
        {
            bf16x8 kf[8];
#pragma unroll
            for (int ks = 0; ks < 8; ++ks) kf[ks] = *((const LAS bf16x8*)(wl + ATT_KOFF + 1024 * ks) + lane);
#pragma unroll
            for (int ks = 0; ks < 8; ++ks) sacc = __builtin_amdgcn_mfma_f32_32x32x16_bf16(kf[ks], qf[ks], sacc, 0, 0, 0);
        }
        LDS_WAIT();
        DIL_DMA_K(jn);
        float tm = NEGBIG;
#pragma unroll
        for (int e = 0; e < 16; ++e) {
            const int j = j0 + 16 * (e >> 3) + 8 * hh + (e & 7);
            const int dist = (i0 + r) - j;
            const bool valid = (j >= 0) && (dist >= 0) && (dist <= 128);
            const int dc = dist < 0 ? 0 : (dist > 128 ? 128 : dist);
            const float bv = biasL[dc];
            const float lg = valid ? sacc[e] * QSCALE + bv : NEGBIG;
            sacc[e] = lg; tm = fmaxf(tm, lg);
        }
        tm = max32(tm);
        const float m_new = fmaxf(m_run, tm);
        const float alpha = __expf(m_run - m_new);
        float ps = 0.f;
#pragma unroll
        for (int e = 0; e < 16; ++e) { const float pv = (sacc[e] > -1.0e37f) ? __expf(sacc[e] - m_new) : 0.f; sacc[e] = pv; ps += pv; }
        ps = sum32(ps);
        l_run = l_run * alpha + ps; m_run = m_new;
#pragma unroll
        for (int dt = 0; dt < 4; ++dt)
#pragma unroll
            for (int e = 0; e < 16; ++e) o[dt][e] *= alpha;
        bf16x8 pf[2];
#pragma unroll
        for (int s2 = 0; s2 < 2; ++s2) { v4u w; w.x = cvtpk_bf16(sacc[8 * s2 + 0], sacc[8 * s2 + 1]); w.y = cvtpk_bf16(sacc[8 * s2 + 2], sacc[8 * s2 + 3]);
            w.z = cvtpk_bf16(sacc[8 * s2 + 4], sacc[8 * s2 + 5]); w.w = cvtpk_bf16(sacc[8 * s2 + 6], sacc[8 * s2 + 7]); pf[s2] = __builtin_bit_cast(bf16x8, w); }
        asm volatile("s_waitcnt vmcnt(8)" ::: "memory");
#pragma unroll
        for (int dt = 0; dt < 4; ++dt)
#pragma unroll
            for (int s2 = 0; s2 < 2; ++s2) o[dt] = __builtin_amdgcn_mfma_f32_32x32x16_bf16(vfrag_tr(wl, lane, dt, s2), pf[s2], o[dt], 0, 0, 0);
        LDS_WAIT();
        DIL_DMA_V(jn);
    }
    asm volatile("s_waitcnt vmcnt(0)" ::: "memory");
#undef DIL_DMA_V
#undef DIL_DMA_K
    const float inv = 1.f / l_run;
    bf16* po = PART + ((size_t)p * M + rowq) * SWA_W + h * 128;
#pragma unroll
    for (int dt = 0; dt < 4; ++dt)
#pragma unroll
        for (int g = 0; g < 4; ++g)
            *(unsigned long long*)(po + 32 * dt + 8 * g + 4 * hh) = (unsigned long long)pk2(o[dt][4 * g + 0] * inv, o[dt][4 * g + 1] * inv) | ((unsigned long long)pk2(o[dt][4 * g + 2] * inv, o[dt][4 * g + 3] * inv) << 32);
    if (hh == 0) LSE[((size_t)p * M + rowq) * 6 + h] = m_run + __logf(l_run);
}

DEV void sb_item(int b, int h, int t, const bf16* __restrict__ Z, float* __restrict__ YC, LAS float* qs, LAS float* pA, int lane) {
    const size_t row = (size_t)b * SEQ + t;
    { const unsigned w = *(const unsigned*)(Z + row * IN_W + ZO_QC + h * 128 + 2 * lane); qs[2 * lane] = bf_lo(w) * QSCALE; qs[2 * lane + 1] = bf_hi(w) * QSCALE; }
    LDS_WAIT();
    float carry = 0.f, a0 = 0.f, a1 = 0.f;
    for (int shi = t - 1; shi >= 0; shi -= 64) {
        const int s = shi - lane; const bool valid = s >= 0;
        float z = 0.f;
        if (valid) {
            const v4u* kr = (const v4u*)(Z + ((size_t)b * SEQ + s) * IN_W + ZO_KC + h * 128);
#pragma unroll 4
            for (int c8 = 0; c8 < 16; ++c8) { const v4u kv = kr[c8]; const LAS float* q = qs + c8 * 8;
                z += q[0] * bf_lo(kv.x) + q[1] * bf_hi(kv.x) + q[2] * bf_lo(kv.y) + q[3] * bf_hi(kv.y) + q[4] * bf_lo(kv.z) + q[5] * bf_hi(kv.z) + q[6] * bf_lo(kv.w) + q[7] * bf_hi(kv.w); }
        }
        const float l1m = valid ? -softplus_f(z) : 0.f;
        float inc = l1m;
#pragma unroll
        for (int o = 1; o < 64; o <<= 1) { const float tmp = __shfl_up(inc, o); if (lane >= o) inc += tmp; }
        const float A = valid ? __expf(-softplus_f(-z) + carry + (inc - l1m)) : 0.f;
        carry += __shfl(inc, 63);
        pA[lane] = A;
        const bool done = carry < -105.0f;
        LDS_WAIT();
        const int nk = (shi + 1) < 64 ? (shi + 1) : 64;
        const bf16* vb = Z + ((size_t)b * SEQ + shi) * IN_W + ZO_VC + h * 128 + 2 * lane;
#pragma unroll 4
        for (int i = 0; i < nk; ++i) {
            const float pv = pA[i];
            const unsigned w = *(const unsigned*)(vb - (size_t)i * IN_W);
            a0 += pv * bf_lo(w); a1 += pv * bf_hi(w);
        }
        LDS_WAIT();
        if (done) break;
    }
    *(f32x2*)(YC + row * SB_W + h * 128 + 2 * lane) = (f32x2){a0, a1};
}


DEV void lru_item2(int l, int b, int j, int n, const bf16* __restrict__ Z, const float* __restrict__ conv_w, const float* __restrict__ conv_b, const bf16* __restrict__ WGT,
                   const float* __restrict__ b_rec, const float* __restrict__ b_gi, const float* __restrict__ lam,
                   bf16* __restrict__ HLOC, bf16* __restrict__ PP, float* __restrict__ SUMA, float* __restrict__ SUMB, LAS float* xc, LAS float* g0L, LAS float* g1L, int tid) {
    const int ch = tid & 127, tq = tid >> 7, c = n * 128 + ch;
    {
        const float cw0 = conv_w[(l * 4 + 0) * LRU_W + c], cw1 = conv_w[(l * 4 + 1) * LRU_W + c], cw2 = conv_w[(l * 4 + 2) * LRU_W + c], cw3 = conv_w[(l * 4 + 3) * LRU_W + c];
        const float cb = conv_b[l * LRU_W + c];
#pragma unroll 4
        for (int i = 0; i < 16; ++i) {
            const int tok = tq + 4 * i, t = j * 64 + tok;
            const bf16* zp = Z + ((size_t)b * SEQ + t) * IN_W + ZO_XA + c;
            float s = cb + cw3 * bf1(zp[0]);
            if (t >= 1) s += cw2 * bf1(zp[-(ptrdiff_t)IN_W]);
            if (t >= 2) s += cw1 * bf1(zp[-(ptrdiff_t)2 * IN_W]);
            if (t >= 3) s += cw0 * bf1(zp[-(ptrdiff_t)3 * IN_W]);
            xc[tok * 132 + ch] = s;
        }
    }
    __syncthreads();
    {
        const int lane = tid & 63, wave = tid >> 6, r = lane & 31, hh = lane >> 5, g = wave >> 2, ct = wave & 3;
        const bf16* wp = WGT + (((size_t)(l * 6 + n) * 2 + g) * 128 + ct * 32 + r) * 128 + 8 * hh;
        bf16x8 bfr[8];
#pragma unroll
        for (int ks = 0; ks < 8; ++ks) bfr[ks] = *(const bf16x8*)(wp + 16 * ks);
        LAS float* gL = g ? g1L : g0L;
#pragma unroll
        for (int rt = 0; rt < 2; ++rt) {
            f32x16 acc;
#pragma unroll
            for (int e = 0; e < 16; ++e) acc[e] = 0.f;
#pragma unroll
            for (int ks = 0; ks < 8; ++ks) {
                const LAS float* xp = xc + (32 * rt + r) * 132 + 16 * ks + 8 * hh;
                const f32x4 x0 = *(const LAS f32x4*)xp, x1 = *(const LAS f32x4*)(xp + 4);
                v4u w; w.x = cvtpk_bf16(x0.x, x0.y); w.y = cvtpk_bf16(x0.z, x0.w); w.z = cvtpk_bf16(x1.x, x1.y); w.w = cvtpk_bf16(x1.z, x1.w);
                acc = __builtin_amdgcn_mfma_f32_32x32x16_bf16(__builtin_bit_cast(bf16x8, w), bfr[ks], acc, 0, 0, 0);
            }
#pragma unroll
            for (int e = 0; e < 16; ++e) { const int tok = 32 * rt + (e & 3) + 8 * (e >> 2) + 4 * hh; gL[tok * 132 + ct * 32 + r] = acc[e]; }
        }
    }
    __syncthreads();
    {
        const float br = b_rec[l * LRU_W + c], bi = b_gi[l * LRU_W + c], sp = softplus_f(-lam[l * LRU_W + c]);
#pragma unroll 4
        for (int i = 0; i < 16; ++i) {
            const int tok = tq + 4 * i;
            const float rg = sigmoid_f(g0L[tok * 132 + ch] + br), ig = sigmoid_f(g1L[tok * 132 + ch] + bi);
            const float log_a = -8.0f * rg * sp;
            const float av = __expf(log_a);
            const float x = xc[tok * 132 + ch];
            const float uv = sqrtf(fmaxf(-expm1f(2.f * log_a), 0.f)) * (ig * x);
            g0L[tok * 132 + ch] = av; g1L[tok * 132 + ch] = uv;
        }
    }
    __syncthreads();
    if (tid < 128) {
        float h = 0.f, P = 1.f;
        const size_t rb = ((size_t)b * SEQ + j * 64) * LRU_W + n * 128 + tid;
#pragma unroll 8
        for (int tok = 0; tok < 64; ++tok) {
            const float av = g0L[tok * 132 + tid];
            h = av * h + g1L[tok * 132 + tid]; P *= av;
            HLOC[rb + (size_t)tok * LRU_W] = (bf16)f2bf(h); PP[rb + (size_t)tok * LRU_W] = (bf16)f2bf(P);
        }
        SUMA[(size_t)(b * 64 + j) * LRU_W + n * 128 + tid] = P; SUMB[(size_t)(b * 64 + j) * LRU_W + n * 128 + tid] = h;
    }
    __syncthreads();
}

DEV void sb_mfma_item(int b, int h, int t0, const bf16* __restrict__ Z, bf16* __restrict__ YC, LAS unsigned char* wl, int lane) {
    asm volatile("" : "+v"(lane));
    const int r = lane & 31, hh = lane >> 5;
    const size_t rowq = (size_t)b * SEQ + t0 + r;
    bf16x8 qf[8];
    { const bf16* qrow = Z + rowq * IN_W + ZO_QC + h * 128 + 8 * hh;
#pragma unroll
      for (int ks = 0; ks < 8; ++ks) qf[ks] = *(const bf16x8*)(qrow + 16 * ks); }
    f32x16 o[4];
#pragma unroll
    for (int dt = 0; dt < 4; ++dt)
#pragma unroll
        for (int e = 0; e < 16; ++e) o[dt][e] = 0.f;
    const int kap = (r & 0x13) | ((r & 4) << 1) | ((r & 8) >> 1);
    float carry = 0.f;
#define SB_DMA_K(K0) do { const bf16* krow = Z + ((size_t)b * SEQ + (K0) + kap) * IN_W + ZO_KC + h * 128 + 8 * hh; \
        _Pragma("unroll") for (int ks = 0; ks < 8; ++ks) __builtin_amdgcn_global_load_lds((const unsigned*)(krow + 16 * ks), (LAS unsigned*)(wl + ATT_KOFF + 1024 * ks), 16, 0, 0); } while (0)
#define SB_DMA_V(K0) do { _Pragma("unroll") for (int q = 0; q < 8; ++q) { const int pi = lane + 64 * q, kl = pi >> 4, c = (pi & 15) ^ (((kl & 3) << 2) | ((kl >> 2) & 3)); \
        __builtin_amdgcn_global_load_lds((const unsigned*)(Z + ((size_t)b * SEQ + (K0) + kl) * IN_W + ZO_VC + h * 128 + 8 * c), (LAS unsigned*)(wl + 1024 * q), 16, 0, 0); } } while (0)
    LDS_WAIT();
    SB_DMA_K(t0); SB_DMA_V(t0);
    for (int k0 = t0; k0 >= 0; k0 -= 32) {
        const int kn = k0 >= 32 ? k0 - 32 : 0;
        asm volatile("s_waitcnt vmcnt(8)" ::: "memory");
        f32x16 sacc;
#pragma unroll
        for (int e = 0; e < 16; ++e) sacc[e] = 0.f;
        {
            bf16x8 kf[8];
#pragma unroll
            for (int ks = 0; ks < 8; ++ks) kf[ks] = *((const LAS bf16x8*)(wl + ATT_KOFF + 1024 * ks) + lane);
#pragma unroll
            for (int ks = 0; ks < 8; ++ks) sacc = __builtin_amdgcn_mfma_f32_32x32x16_bf16(kf[ks], qf[ks], sacc, 0, 0, 0);
        }
        LDS_WAIT();
        SB_DMA_K(kn);
        float l1[16]; float T0 = 0.f, T1 = 0.f;
#pragma unroll
        for (int e = 0; e < 16; ++e) {
            const int key = k0 + 16 * (e >> 3) + 8 * hh + (e & 7);
            const bool valid = key < t0 + r;
            const float z = sacc[e] * QSCALE;
            sacc[e] = z;
            l1[e] = valid ? -(fmaxf(z, 0.f) + __logf(1.f + __expf(-fabsf(z)))) : 0.f;
        }
#pragma unroll
        for (int e = 0; e < 8; ++e) { T0 += l1[e]; T1 += l1[8 + e]; }
        const float PT0 = partner32(T0, hh), PT1 = partner32(T1, hh);
        const float base1 = carry + (hh ? 0.f : PT1);
        const float base0 = carry + (hh ? (T1 + PT1) : (PT1 + T1 + PT0));
        float run1 = base1, run0 = base0;
#pragma unroll
        for (int e = 7; e >= 0; --e) {
            { const int key = k0 + 16 + 8 * hh + e; const bool valid = key < t0 + r; const float a = valid ? __expf(sacc[8 + e] + l1[8 + e] + run1) : 0.f; run1 += l1[8 + e]; sacc[8 + e] = a; }
            { const int key = k0 + 8 * hh + e; const bool valid = key < t0 + r; const float a = valid ? __expf(sacc[e] + l1[e] + run0) : 0.f; run0 += l1[e]; sacc[e] = a; }
        }
        carry += (T0 + T1) + (PT0 + PT1);
        bf16x8 pf[2];
#pragma unroll
        for (int s2 = 0; s2 < 2; ++s2) { v4u w; w.x = cvtpk_bf16(sacc[8 * s2 + 0], sacc[8 * s2 + 1]); w.y = cvtpk_bf16(sacc[8 * s2 + 2], sacc[8 * s2 + 3]);
            w.z = cvtpk_bf16(sacc[8 * s2 + 4], sacc[8 * s2 + 5]); w.w = cvtpk_bf16(sacc[8 * s2 + 6], sacc[8 * s2 + 7]); pf[s2] = __builtin_bit_cast(bf16x8, w); }
        asm volatile("s_waitcnt vmcnt(8)" ::: "memory");
#pragma unroll
        for (int dt = 0; dt < 4; ++dt)
#pragma unroll
            for (int s2 = 0; s2 < 2; ++s2) o[dt] = __builtin_amdgcn_mfma_f32_32x32x16_bf16(vfrag_tr(wl, lane, dt, s2), pf[s2], o[dt], 0, 0, 0);
        LDS_WAIT();
        SB_DMA_V(kn);
        if (__all(carry < -105.0f)) break;
    }
    asm volatile("s_waitcnt vmcnt(0)" ::: "memory");
#undef SB_DMA_V
#undef SB_DMA_K
    bf16* po = YC + rowq * SB_W + h * 128;
#pragma unroll
    for (int dt = 0; dt < 4; ++dt)
#pragma unroll
        for (int g = 0; g < 4; ++g)
            *(unsigned long long*)(po + 32 * dt + 8 * g + 4 * hh) = (unsigned long long)pk2(o[dt][4 * g + 0], o[dt][4 * g + 1]) | ((unsigned long long)pk2(o[dt][4 * g + 2], o[dt][4 * g + 3]) << 32);
}

DEV void combine_item(int l, int b, int j, int half, const bf16* __restrict__ Z, const bf16* __restrict__ HLOC, const bf16* __restrict__ PP, const float* __restrict__ SUMA, const float* __restrict__ SUMB,
                      const bf16* __restrict__ PART, const float* __restrict__ LSE, const bf16* __restrict__ YC, const float* __restrict__ g_lru, const float* __restrict__ g_swa, const float* __restrict__ g_sb,
                      bf16* __restrict__ Y, LAS float* carryL, int tid) {
    const int lane = tid & 63, wave = tid >> 6;
    for (int c = tid; c < LRU_W; c += 512) {
        float cr = 0.f;
        for (int i = 0; i < j; ++i) cr = SUMA[(size_t)(b * 64 + i) * LRU_W + c] * cr + SUMB[(size_t)(b * 64 + i) * LRU_W + c];
        carryL[c] = cr;
    }
    __syncthreads();
    for (int i = 0; i < 4; ++i) {
        const int tok = half * 32 + wave * 4 + i;
        const size_t row = (size_t)b * SEQ + j * 64 + tok;
        bf16* yo = Y + row * D;
        {
            float ya[12]; float ssq = 0.f;
#pragma unroll
            for (int e = 0; e < 6; ++e) { const int c = 2 * lane + 128 * e;
                const unsigned hw = *(const unsigned*)(HLOC + row * LRU_W + c), pw = *(const unsigned*)(PP + row * LRU_W + c), gw2 = *(const unsigned*)(Z + row * IN_W + ZO_GA + c);
                const f32x2 cr = *(const LAS f32x2*)(carryL + c);
                ya[2 * e] = (bf_lo(hw) + bf_lo(pw) * cr.x) * gelu_tanh(bf_lo(gw2)); ya[2 * e + 1] = (bf_hi(hw) + bf_hi(pw) * cr.y) * gelu_tanh(bf_hi(gw2));
                ssq += ya[2 * e] * ya[2 * e] + ya[2 * e + 1] * ya[2 * e + 1]; }
            const float r = rsqrtf(wave_sum(ssq) * (1.f / LRU_W) + EPS);
#pragma unroll
            for (int e = 0; e < 6; ++e) { const int c = 2 * lane + 128 * e; const f32x2 g = *(const f32x2*)(g_lru + l * LRU_W + c);
                *(unsigned*)(yo + c) = (MK_DBG & 16) ? 0u : pk2(ya[2 * e] * r * g.x, ya[2 * e + 1] * r * g.y); }
        }
        {
            float yb[12]; float ssq = 0.f;
#pragma unroll
            for (int e = 0; e < 6; ++e) { const int c = 2 * lane + 128 * e;
                const float l0 = LSE[((size_t)0 * M + row) * 6 + e], l1 = LSE[((size_t)1 * M + row) * 6 + e], l2 = LSE[((size_t)2 * M + row) * 6 + e];
                const float mx = fmaxf(l0, fmaxf(l1, l2)); const float e0 = __expf(l0 - mx), e1 = __expf(l1 - mx), e2 = __expf(l2 - mx); const float iz = 1.f / (e0 + e1 + e2);
                const unsigned p0 = *(const unsigned*)(PART + ((size_t)0 * M + row) * SWA_W + c), p1 = *(const unsigned*)(PART + ((size_t)1 * M + row) * SWA_W + c), p2 = *(const unsigned*)(PART + ((size_t)2 * M + row) * SWA_W + c);
                yb[2 * e] = (e0 * bf_lo(p0) + e1 * bf_lo(p1) + e2 * bf_lo(p2)) * iz; yb[2 * e + 1] = (e0 * bf_hi(p0) + e1 * bf_hi(p1) + e2 * bf_hi(p2)) * iz;
                ssq += yb[2 * e] * yb[2 * e] + yb[2 * e + 1] * yb[2 * e + 1]; }
            const float r = rsqrtf(wave_sum(ssq) * (1.f / SWA_W) + EPS);
#pragma unroll
            for (int e = 0; e < 6; ++e) { const int c = 2 * lane + 128 * e; const f32x2 g = *(const f32x2*)(g_swa + l * SWA_W + c);
                *(unsigned*)(yo + LRU_W + c) = (MK_DBG & 32) ? 0u : pk2(yb[2 * e] * r * g.x, yb[2 * e + 1] * r * g.y); }
        }
        {
            float yc[8]; float ssq = 0.f;
#pragma unroll
            for (int e = 0; e < 4; ++e) { const int c = 2 * lane + 128 * e; const unsigned w = *(const unsigned*)(YC + row * SB_W + c); yc[2 * e] = bf_lo(w); yc[2 * e + 1] = bf_hi(w); ssq += yc[2 * e] * yc[2 * e] + yc[2 * e + 1] * yc[2 * e + 1]; }
            const float r = rsqrtf(wave_sum(ssq) * (1.f / SB_W) + EPS);
#pragma unroll
            for (int e = 0; e < 4; ++e) { const int c = 2 * lane + 128 * e; const f32x2 g = *(const f32x2*)(g_sb + l * SB_W + c);
                *(unsigned*)(yo + LRU_W + SWA_W + c) = (MK_DBG & 64) ? 0u : pk2(yc[2 * e] * r * g.x, yc[2 * e + 1] * r * g.y); }
        }
    }
    __syncthreads();
}

constexpr int RT_SK = 0, RT_Q = 128 * 129 * 4, RT_SC = RT_Q + 32 * 128 * 4, RT_TV = RT_SC + 64 * 129 * 4, RT_TI = RT_TV + 64 * 16 * 4, RT_END = RT_TI + 64 * 16 * 4;
static_assert(RT_END <= LDS_MISC, "routing LDS");
DEV void route_item(int l, int tile, int h, const bf16* __restrict__ Q, const bf16* __restrict__ SK, int* __restrict__ IDS, float* __restrict__ GG, LAS unsigned char* lds, int tid, unsigned* DBGW = nullptr) {
    LAS float* skL = (LAS float*)(lds + RT_SK); LAS float* qL = (LAS float*)(lds + RT_Q); LAS float* sc = (LAS float*)(lds + RT_SC);
    LAS float* topv = (LAS float*)(lds + RT_TV); LAS int* topi = (LAS int*)(lds + RT_TI);
    const int lane = tid & 63, wave = tid >> 6, row0 = tile * 32;
    for (int c = 0; c < 2; ++c) {
        const bf16* skp = SK + ((size_t)((l * 8 + h) * 2 + c)) * 128 * 128;
#pragma unroll 4
        for (int i = 0; i < 16; ++i) { const int idx2 = tid + 512 * i; const int k = idx2 >> 6, d2 = idx2 & 63; const unsigned w = *(const unsigned*)(skp + k * 128 + 2 * d2); skL[k * 129 + 2 * d2] = bf_lo(w); skL[k * 129 + 2 * d2 + 1] = bf_hi(w); }
#pragma unroll
        for (int i = 0; i < 4; ++i) { const int idx2 = tid + 512 * i; const int tok = idx2 >> 6, d2 = idx2 & 63; const unsigned w = *(const unsigned*)(Q + (size_t)(row0 + tok) * D + h * 256 + c * 128 + 2 * d2); qL[tok * 128 + 2 * d2] = bf_lo(w); qL[tok * 128 + 2 * d2 + 1] = bf_hi(w); }
        __syncthreads();
        {
            const int k = tid & 127, tg = tid >> 7;
            float acc[8];
#pragma unroll
            for (int i = 0; i < 8; ++i) acc[i] = 0.f;
#pragma unroll 4
            for (int d = 0; d < 128; ++d) { const float s = skL[k * 129 + d];
#pragma unroll
                for (int i = 0; i < 8; ++i) acc[i] += s * qL[(tg * 8 + i) * 128 + d]; }
#pragma unroll
            for (int i = 0; i < 8; ++i) sc[(c * 32 + tg * 8 + i) * 129 + k] = acc[i];
        }
        __syncthreads();
    }
    for (int q = 0; q < 8; ++q) {
        const int L = wave * 8 + q;
        float v0 = sc[L * 129 + lane], v1 = sc[L * 129 + 64 + lane];
        for (int r = 0; r < 16; ++r) {
            const float m = wave_max(fmaxf(v0, v1));
            const unsigned long long b0 = __ballot(v0 == m);
            int idx;
            if (b0) { const int ln = __ffsll((long long)b0) - 1; idx = ln; if (lane == ln) v0 = NEGBIG; }
            else { const unsigned long long b1 = __ballot(v1 == m); const int ln = __ffsll((long long)b1) - 1; idx = 64 + ln; if (lane == ln) v1 = NEGBIG; }
            if (lane == 0) { topv[L * 16 + r] = m; topi[L * 16 + r] = idx; }
        }
    }
    __syncthreads();
#if MK_CHECK == 16
    { for (int q = 0; q < 8; ++q) { const int L = wave * 8 + q; const int mi = topi[L * 16 + (lane & 15)]; int dup = 0;
          for (int e = 0; e < 16; ++e) { const int oi = __shfl(mi, e); if (lane < 16 && e != lane && oi == mi) dup = 1; }
          if (dup) atomicAdd((unsigned*)DBGW, 1u); } }
#endif
    for (int q = 0; q < 4; ++q) {
        const int tok = wave * 4 + q;
        float cv[4];
#pragma unroll
        for (int e = 0; e < 4; ++e) cv[e] = topv[tok * 16 + (lane >> 2)] + topv[(32 + tok) * 16 + (lane & 3) * 4 + e];
        float mysc = NEGBIG; int myid = 0;
        for (int r = 0; r < 16; ++r) {
            const float lm = fmaxf(fmaxf(cv[0], cv[1]), fmaxf(cv[2], cv[3]));
            const float m = wave_max(lm);
            const unsigned long long bb = __ballot(lm == m);
            const int ln = __ffsll((long long)bb) - 1;
            const int se = (cv[0] == m) ? 0 : (cv[1] == m) ? 1 : (cv[2] == m) ? 2 : 3;
            const int sel = __shfl(se, ln);
            { const bool me = (lane == ln);
              cv[0] = (me && sel == 0) ? NEGBIG : cv[0]; cv[1] = (me && sel == 1) ? NEGBIG : cv[1];
              cv[2] = (me && sel == 2) ? NEGBIG : cv[2]; cv[3] = (me && sel == 3) ? NEGBIG : cv[3]; }
            const int ci = ln * 4 + sel;
            const int id = topi[tok * 16 + (ci >> 4)] * 128 + topi[(32 + tok) * 16 + (ci & 15)];
            if (lane == r) { mysc = m; myid = id; }
        }
#if MK_CHECK == 16
        { int dup = 0; for (int e = 0; e < 16; ++e) { const int oi = __shfl(myid, e); if (lane < 16 && e != lane && oi == myid) dup = 1; } if (dup) atomicAdd((unsigned*)DBGW + 1, 1u); }
#endif
        const float s0 = __shfl(mysc, 0);
        const float ev = (lane < 16) ? __expf(mysc - s0) : 0.f;
        const float sum = wave_sum(ev);
        if (lane < 16) { IDS[(size_t)(row0 + tok) * 128 + h * 16 + lane] = myid; GG[(size_t)(row0 + tok) * 128 + h * 16 + lane] = ev / sum; }
    }
    __syncthreads();
}


constexpr float U8_SCALE = 64.f;
DEV void convert_fp8(const float* __restrict__ src, unsigned char* __restrict__ dst, size_t ngroups16, size_t gtid, size_t gstride, float scale) {
    for (size_t g = gtid; g < ngroups16; g += gstride) {
        const f32x4 a = *(const f32x4*)(src + g * 16) * scale, b = *(const f32x4*)(src + g * 16 + 4) * scale, c = *(const f32x4*)(src + g * 16 + 8) * scale, d = *(const f32x4*)(src + g * 16 + 12) * scale;
        int w0 = 0, w1 = 0, w2 = 0, w3 = 0;
        w0 = __builtin_amdgcn_cvt_pk_fp8_f32(a.x, a.y, w0, false); w0 = __builtin_amdgcn_cvt_pk_fp8_f32(a.z, a.w, w0, true);
        w1 = __builtin_amdgcn_cvt_pk_fp8_f32(b.x, b.y, w1, false); w1 = __builtin_amdgcn_cvt_pk_fp8_f32(b.z, b.w, w1, true);
        w2 = __builtin_amdgcn_cvt_pk_fp8_f32(c.x, c.y, w2, false); w2 = __builtin_amdgcn_cvt_pk_fp8_f32(c.z, c.w, w2, true);
        w3 = __builtin_amdgcn_cvt_pk_fp8_f32(d.x, d.y, w3, false); w3 = __builtin_amdgcn_cvt_pk_fp8_f32(d.z, d.w, w3, true);
        *(v4u*)(dst + g * 16) = (v4u){(unsigned)w0, (unsigned)w1, (unsigned)w2, (unsigned)w3};
    }
}

constexpr int R2_SC = 0, R2_TV = 128 * 129 * 4, R2_TI = R2_TV + 128 * 16 * 4, R2_END = R2_TI + 128 * 16 * 4;
static_assert(R2_END <= LDS_MISC, "routing v2 LDS");
DEV unsigned ord_key(float s) { const unsigned u = __builtin_bit_cast(unsigned, s); return (u & 0x80000000u) ? ~u : (u | 0x80000000u); }
DEV void route_item2(int l, int tile, int h, const bf16* __restrict__ Q, const bf16* __restrict__ SK, int* __restrict__ IDS, float* __restrict__ GG, LAS unsigned char* lds, int tid,
                        const float* __restrict__ cv_u, const float* __restrict__ cv_v, unsigned char* __restrict__ cv_u8, unsigned char* __restrict__ cv_v8) {
    LAS float* sc = (LAS float*)(lds + R2_SC); LAS float* tv = (LAS float*)(lds + R2_TV); LAS int* ti = (LAS int*)(lds + R2_TI);
    const int lane = tid & 63, wave = tid >> 6, row0 = tile * 64;
    {
        const int r = lane & 31, hh = lane >> 5, c = wave >> 2, key0 = 32 * (wave & 3);
        const bf16* skp = SK + ((size_t)(((l * 8 + h) * 2 + c) * 128 + key0 + r)) * 128 + 8 * hh;
        bf16x8 bfr[8];
#pragma unroll
        for (int ks = 0; ks < 8; ++ks) bfr[ks] = *(const bf16x8*)(skp + 16 * ks);
#pragma unroll
        for (int rt = 0; rt < 2; ++rt) {
            const bf16* qp = Q + (size_t)(row0 + 32 * rt + r) * D + h * 256 + c * 128 + 8 * hh;
            bf16x8 afr[8];
#pragma unroll
            for (int ks = 0; ks < 8; ++ks) afr[ks] = *(const bf16x8*)(qp + 16 * ks);
            f32x16 acc;
#pragma unroll
            for (int e = 0; e < 16; ++e) acc[e] = 0.f;
#pragma unroll
            for (int ks = 0; ks < 8; ++ks) acc = __builtin_amdgcn_mfma_f32_32x32x16_bf16(afr[ks], bfr[ks], acc, 0, 0, 0);
#pragma unroll
            for (int e = 0; e < 16; ++e) { const int tok = 32 * rt + (e & 3) + 8 * (e >> 2) + 4 * hh; sc[(c * 64 + tok) * 129 + key0 + r] = acc[e]; }
        }
    }
    __syncthreads();
    if (tid >= 128) {
        const size_t TG = (size_t)NEXP * D / 16;
        const size_t g0 = (size_t)(tile * 8 + h) * 4096;
#pragma unroll 4
        for (int k = 0; k < 11; ++k) { const size_t g = g0 + (size_t)(tid - 128) + 384u * k;
            if (g < g0 + 4096) { const bool isv = g >= TG; const size_t gg = isv ? g - TG : g;
                convert_fp8((isv ? cv_v : cv_u) + gg * 16, (isv ? cv_v8 : cv_u8) + gg * 16, 1, 0, 1, isv ? 1.f : U8_SCALE); } }
    }
    if (tid < 128) {
        const int L = tid;
        unsigned t[16];
#pragma unroll
        for (int q = 0; q < 16; ++q) t[q] = 0u;
#pragma unroll 4
        for (int k = 0; k < 128; ++k) {
            unsigned key = (ord_key(sc[L * 129 + k]) & ~127u) | (unsigned)(127 - k);
#pragma unroll
            for (int q = 0; q < 16; ++q) { const unsigned hi = t[q] > key ? t[q] : key; key = t[q] > key ? key : t[q]; t[q] = hi; }
        }
#pragma unroll
        for (int q = 0; q < 16; ++q) { const int idx = 127 - (int)(t[q] & 127u); tv[L * 16 + q] = sc[L * 129 + idx]; ti[L * 16 + q] = idx; }
    }
    __syncthreads();
    if (tid < 64) {
        const int tok = tid;
        float a[16], bq[16];
#pragma unroll
        for (int i = 0; i < 16; ++i) { a[i] = tv[tok * 16 + i]; bq[i] = tv[(64 + tok) * 16 + i]; }
        unsigned t[16];
#pragma unroll
        for (int q = 0; q < 16; ++q) t[q] = 0u;
#pragma unroll
        for (int i = 0; i < 16; ++i)
#pragma unroll
            for (int j = 0; j < 16 / (i + 1); ++j) {
                unsigned key = (ord_key(a[i] + bq[j]) & ~255u) | (unsigned)(255 - (i * 16 + j));
#pragma unroll
                for (int q = 0; q < 16; ++q) { const unsigned hi = t[q] > key ? t[q] : key; key = t[q] > key ? key : t[q]; t[q] = hi; }
            }
        float scv[16]; int idv[16]; float mx = NEGBIG;
#pragma unroll
        for (int q = 0; q < 16; ++q) { const int ci = 255 - (int)(t[q] & 255u); const int i = ci >> 4, j = ci & 15;
            scv[q] = tv[tok * 16 + i] + tv[(64 + tok) * 16 + j]; idv[q] = ti[tok * 16 + i] * 128 + ti[(64 + tok) * 16 + j]; mx = fmaxf(mx, scv[q]); }
        float sum = 0.f;
#pragma unroll
        for (int q = 0; q < 16; ++q) { scv[q] = __expf(scv[q] - mx); sum += scv[q]; }
        const float inv = 1.f / sum;
        int* ip = IDS + (size_t)(row0 + tok) * 128 + h * 16; float* gp = GG + (size_t)(row0 + tok) * 128 + h * 16;
#pragma unroll
        for (int q4 = 0; q4 < 4; ++q4) {
            *(int4*)(ip + 4 * q4) = make_int4(idv[4 * q4], idv[4 * q4 + 1], idv[4 * q4 + 2], idv[4 * q4 + 3]);
            *(f32x4*)(gp + 4 * q4) = (f32x4){scv[4 * q4] * inv, scv[4 * q4 + 1] * inv, scv[4 * q4 + 2] * inv, scv[4 * q4 + 3] * inv};
        }
    }
    __syncthreads();
}

DEV void expert_row(int l, int row, const bf16* __restrict__ H, const int* __restrict__ IDS, const float* __restrict__ GG, const bf16* __restrict__ U, const bf16* __restrict__ V,
                    const float* __restrict__ X1, const float* __restrict__ g2, const float* __restrict__ fnorm, float* __restrict__ XO, int lane, float pscale, float* STATP = nullptr) {
    v4u xv[4];
#pragma unroll
    for (int j = 0; j < 4; ++j) xv[j] = *(const v4u*)(H + (size_t)row * D + lane * 8 + 512 * j);
    const int id0 = IDS[(size_t)row * 128 + lane], id1 = IDS[(size_t)row * 128 + 64 + lane];
    const float gg0 = GG[(size_t)row * 128 + lane], gg1 = GG[(size_t)row * 128 + 64 + lane];
    float y[32];
#pragma unroll
    for (int i = 0; i < 32; ++i) y[i] = 0.f;
    const bf16* Ul = U + (size_t)l * NEXP * D + lane * 8;
    const bf16* Vl = V + (size_t)l * NEXP * D + lane * 8;
    for (int e0 = 0; e0 < 128; e0 += 2) {
        int id[2]; float gq[2];
#pragma unroll
        for (int q = 0; q < 2; ++q) { const int e = e0 + q;
            id[q] = (e < 64) ? __builtin_amdgcn_readlane(id0, e & 63) : __builtin_amdgcn_readlane(id1, e & 63);
            gq[q] = (e < 64) ? __builtin_bit_cast(float, __builtin_amdgcn_readlane(__builtin_bit_cast(int, gg0), e & 63)) : __builtin_bit_cast(float, __builtin_amdgcn_readlane(__builtin_bit_cast(int, gg1), e & 63)); }
        v4u uu[2][4], vv[2][4];
#pragma unroll
        for (int q = 0; q < 2; ++q)
#pragma unroll
            for (int j = 0; j < 4; ++j) uu[q][j] = *(const v4u*)(Ul + (size_t)id[q] * D + 512 * j);
#pragma unroll
        for (int q = 0; q < 2; ++q)
#pragma unroll
            for (int j = 0; j < 4; ++j) vv[q][j] = *(const v4u*)(Vl + (size_t)id[q] * D + 512 * j);
#pragma unroll
        for (int q = 0; q < 2; ++q) {
            float dsum = 0.f;
#pragma unroll
            for (int j = 0; j < 4; ++j) dsum += dot8(xv[j], uu[q][j]);
            dsum = wave_sum(dsum);
            const float w = gq[q] * gelu_tanh(dsum);
#if MK_CHECK == 7
            if (lane == 0 && l == 0) atomicAdd(STATP, gelu_tanh(dsum) * gelu_tanh(dsum) * 2048.f / 128.f);
#elif MK_CHECK == 8
            if (lane == 0 && l == 0) atomicAdd(STATP, gq[q] * gq[q] * 2048.f * 16.f / 128.f);
#elif MK_CHECK == 9
            if (lane == 0 && l == 0) atomicAdd(STATP, dsum * dsum * 2048.f / 128.f);
#elif MK_CHECK == 11
            if (lane == 0 && l == 0) atomicAdd(STATP, w * w * 2048.f);
#endif
#pragma unroll
            for (int j = 0; j < 4; ++j) {
                y[j * 8 + 0] += w * bf_lo(vv[q][j].x); y[j * 8 + 1] += w * bf_hi(vv[q][j].x);
                y[j * 8 + 2] += w * bf_lo(vv[q][j].y); y[j * 8 + 3] += w * bf_hi(vv[q][j].y);
                y[j * 8 + 4] += w * bf_lo(vv[q][j].z); y[j * 8 + 5] += w * bf_hi(vv[q][j].z);
                y[j * 8 + 6] += w * bf_lo(vv[q][j].w); y[j * 8 + 7] += w * bf_hi(vv[q][j].w);
            }
        }
    }
#if MK_CHECK == 6
    { float q2 = 0.f;
#pragma unroll
      for (int i = 0; i < 32; ++i) q2 += y[i] * y[i];
      q2 = wave_sum(q2); if (lane == 0 && l == 0) atomicAdd(STATP, q2); }
#endif
    float ssq = 0.f;
#pragma unroll
    for (int j = 0; j < 4; ++j) {
        const int col = lane * 8 + 512 * j;
        const f32x4 xa = *(const f32x4*)(X1 + (size_t)row * D + col), xb = *(const f32x4*)(X1 + (size_t)row * D + col + 4);
        const f32x4 ga = *(const f32x4*)(g2 + col) * pscale, gb = *(const f32x4*)(g2 + col + 4) * pscale;
        y[j * 8 + 0] = xa.x + ga.x * y[j * 8 + 0]; y[j * 8 + 1] = xa.y + ga.y * y[j * 8 + 1]; y[j * 8 + 2] = xa.z + ga.z * y[j * 8 + 2]; y[j * 8 + 3] = xa.w + ga.w * y[j * 8 + 3];
        y[j * 8 + 4] = xb.x + gb.x * y[j * 8 + 4]; y[j * 8 + 5] = xb.y + gb.y * y[j * 8 + 5]; y[j * 8 + 6] = xb.z + gb.z * y[j * 8 + 6]; y[j * 8 + 7] = xb.w + gb.w * y[j * 8 + 7];
#pragma unroll
        for (int e = 0; e < 8; ++e) ssq += y[j * 8 + e] * y[j * 8 + e];
    }
    if (fnorm) {
        const float r = rsqrtf(wave_sum(ssq) * (1.f / D) + EPS);
#pragma unroll
        for (int j = 0; j < 4; ++j) { const int col = lane * 8 + 512 * j;
            const f32x4 fa = *(const f32x4*)(fnorm + col), fb = *(const f32x4*)(fnorm + col + 4);
            *(f32x4*)(XO + (size_t)row * D + col) = (f32x4){y[j * 8 + 0] * r * fa.x, y[j * 8 + 1] * r * fa.y, y[j * 8 + 2] * r * fa.z, y[j * 8 + 3] * r * fa.w};
            *(f32x4*)(XO + (size_t)row * D + col + 4) = (f32x4){y[j * 8 + 4] * r * fb.x, y[j * 8 + 5] * r * fb.y, y[j * 8 + 6] * r * fb.z, y[j * 8 + 7] * r * fb.w}; }
    } else {
#pragma unroll
        for (int j = 0; j < 4; ++j) { const int col = lane * 8 + 512 * j;
            *(f32x4*)(XO + (size_t)row * D + col) = (f32x4){y[j * 8 + 0], y[j * 8 + 1], y[j * 8 + 2], y[j * 8 + 3]};
            *(f32x4*)(XO + (size_t)row * D + col + 4) = (f32x4){y[j * 8 + 4], y[j * 8 + 5], y[j * 8 + 6], y[j * 8 + 7]}; }
    }
}


DEV void expert_row8(int l, int row, const bf16* H, const int* __restrict__ IDS, const float* __restrict__ GG, const unsigned char* __restrict__ U8, const unsigned char* __restrict__ V8,
                     const bf16* __restrict__ X1, const float* __restrict__ g2, const float* __restrict__ fnorm, float* __restrict__ XO, bf16* __restrict__ XOH, int lane, float pscale, LAS int* sortL,
                     const float* __restrict__ ngain, const float* __restrict__ nmod, bf16* Hout) {
    f32x2 x[16];
#pragma unroll
    for (int j = 0; j < 2; ++j) {
        const v4u a = *(const v4u*)(H + (size_t)row * D + lane * 16 + 1024 * j), c = *(const v4u*)(H + (size_t)row * D + lane * 16 + 1024 * j + 8);
        x[j * 8 + 0] = (f32x2){bf_lo(a.x), bf_hi(a.x)}; x[j * 8 + 1] = (f32x2){bf_lo(a.y), bf_hi(a.y)}; x[j * 8 + 2] = (f32x2){bf_lo(a.z), bf_hi(a.z)}; x[j * 8 + 3] = (f32x2){bf_lo(a.w), bf_hi(a.w)};
        x[j * 8 + 4] = (f32x2){bf_lo(c.x), bf_hi(c.x)}; x[j * 8 + 5] = (f32x2){bf_lo(c.y), bf_hi(c.y)}; x[j * 8 + 6] = (f32x2){bf_lo(c.z), bf_hi(c.z)}; x[j * 8 + 7] = (f32x2){bf_lo(c.w), bf_hi(c.w)};
    }
    int id0 = IDS[(size_t)row * 128 + lane], id1 = IDS[(size_t)row * 128 + 64 + lane];
    float gg0 = GG[(size_t)row * 128 + lane], gg1 = GG[(size_t)row * 128 + 64 + lane];
    {
        const int w0 = id0 >> 9, w1 = id1 >> 9; int p0 = 0, p1 = 0, base = 0;
        for (int w = 0; w < 32; ++w) {
            const unsigned long long m0 = __ballot(w0 == w), m1 = __ballot(w1 == w);
            const int c0 = __popcll(m0), c1 = __popcll(m1);
            const int b0 = (int)__builtin_amdgcn_mbcnt_hi((unsigned)(m0 >> 32), __builtin_amdgcn_mbcnt_lo((unsigned)m0, 0u));
            const int b1 = (int)__builtin_amdgcn_mbcnt_hi((unsigned)(m1 >> 32), __builtin_amdgcn_mbcnt_lo((unsigned)m1, 0u));
            p0 = (w0 == w) ? base + b0 : p0; p1 = (w1 == w) ? base + c0 + b1 : p1;
            base += c0 + c1;
        }
        sortL[p0] = id0; sortL[p1] = id1; ((LAS float*)sortL)[128 + p0] = gg0; ((LAS float*)sortL)[128 + p1] = gg1;
        LDS_WAIT();
        id0 = sortL[lane]; id1 = sortL[64 + lane]; gg0 = ((LAS float*)sortL)[128 + lane]; gg1 = ((LAS float*)sortL)[192 + lane];
        LDS_WAIT();
    }
    float wv0 = 0.f, wv1 = 0.f;
    const unsigned char* Ul = U8 + (size_t)l * NEXP * D + lane * 16;
    const unsigned char* Vl = V8 + (size_t)l * NEXP * D + lane * 16;
    for (int e0 = 0; e0 < 128; e0 += 8) {
        v4u uu[8][2];
#pragma unroll
        for (int q = 0; q < 8; ++q) { const int e = e0 + q; const int id = (e < 64) ? __builtin_amdgcn_readlane(id0, e & 63) : __builtin_amdgcn_readlane(id1, e & 63);
            uu[q][0] = *(const v4u*)(Ul + (size_t)id * D); uu[q][1] = *(const v4u*)(Ul + (size_t)id * D + 1024); }
        float ds[8];
#pragma unroll
        for (int q = 0; q < 8; ++q) {
            f32x2 acc = {0.f, 0.f};
#pragma unroll
            for (int j = 0; j < 2; ++j) {
                const unsigned wd[4] = {uu[q][j].x, uu[q][j].y, uu[q][j].z, uu[q][j].w};
#pragma unroll
                for (int dw = 0; dw < 4; ++dw) {
                    const f32x2 lo = __builtin_amdgcn_cvt_pk_f32_fp8((int)wd[dw], false), hi = __builtin_amdgcn_cvt_pk_f32_fp8((int)wd[dw], true);
                    acc = __builtin_elementwise_fma(lo, x[j * 8 + 2 * dw], acc); acc = __builtin_elementwise_fma(hi, x[j * 8 + 2 * dw + 1], acc);
                }
            }
            ds[q] = acc.x + acc.y;
        }
#pragma unroll
        for (int q = 0; q < 8; ++q) ds[q] += swz_xor<1>(ds[q]);
#pragma unroll
        for (int q = 0; q < 8; ++q) ds[q] += swz_xor<2>(ds[q]);
#pragma unroll
        for (int q = 0; q < 8; ++q) ds[q] += swz_xor<4>(ds[q]);
#pragma unroll
        for (int q = 0; q < 8; ++q) ds[q] += swz_xor<8>(ds[q]);
#pragma unroll
        for (int q = 0; q < 8; ++q) ds[q] += swz_xor<16>(ds[q]);
#pragma unroll
        for (int q = 0; q < 8; ++q) ds[q] = sum32(ds[q]);
#pragma unroll
        for (int q = 0; q < 8; ++q) { const int e = e0 + q;
            const float gq = (e < 64) ? __builtin_bit_cast(float, __builtin_amdgcn_readlane(__builtin_bit_cast(int, gg0), e & 63)) : __builtin_bit_cast(float, __builtin_amdgcn_readlane(__builtin_bit_cast(int, gg1), e & 63));
            const float w = gq * gelu_tanh(ds[q] * (1.f / U8_SCALE));
            if (e < 64) wv0 = (lane == (e & 63)) ? w : wv0; else wv1 = (lane == (e & 63)) ? w : wv1; }
    }
    f32x2 y[16];
#pragma unroll
    for (int i = 0; i < 16; ++i) y[i] = (f32x2){0.f, 0.f};
    for (int e0 = 0; e0 < 128; e0 += 8) {
        v4u vv[8][2];
#pragma unroll
        for (int q = 0; q < 8; ++q) { const int e = e0 + q; const int id = (e < 64) ? __builtin_amdgcn_readlane(id0, e & 63) : __builtin_amdgcn_readlane(id1, e & 63);
            vv[q][0] = *(const v4u*)(Vl + (size_t)id * D); vv[q][1] = *(const v4u*)(Vl + (size_t)id * D + 1024); }
#pragma unroll
        for (int q = 0; q < 8; ++q) { const int e = e0 + q;
            const float w = (e < 64) ? __builtin_bit_cast(float, __builtin_amdgcn_readlane(__builtin_bit_cast(int, wv0), e & 63)) : __builtin_bit_cast(float, __builtin_amdgcn_readlane(__builtin_bit_cast(int, wv1), e & 63));
            const f32x2 w2 = {w, w};
#pragma unroll
            for (int j = 0; j < 2; ++j) {
                const unsigned wd[4] = {vv[q][j].x, vv[q][j].y, vv[q][j].z, vv[q][j].w};
#pragma unroll
                for (int dw = 0; dw < 4; ++dw) {
                    const f32x2 lo = __builtin_amdgcn_cvt_pk_f32_fp8((int)wd[dw], false), hi = __builtin_amdgcn_cvt_pk_f32_fp8((int)wd[dw], true);
                    y[j * 8 + 2 * dw] = __builtin_elementwise_fma(w2, lo, y[j * 8 + 2 * dw]); y[j * 8 + 2 * dw + 1] = __builtin_elementwise_fma(w2, hi, y[j * 8 + 2 * dw + 1]);
                }
            }
        }
    }
    float ssq = 0.f;
#pragma unroll
    for (int j = 0; j < 2; ++j)
#pragma unroll
        for (int k4 = 0; k4 < 4; ++k4) {
            const int col = lane * 16 + 1024 * j + 4 * k4;
            const unsigned long long xw = *(const unsigned long long*)(X1 + (size_t)row * D + col); const f32x4 xa = {bf_lo((unsigned)xw), bf_hi((unsigned)xw), bf_lo((unsigned)(xw >> 32)), bf_hi((unsigned)(xw >> 32))}; const f32x4 ga = *(const f32x4*)(g2 + col) * pscale;
            f32x2& ya = y[j * 8 + 2 * k4]; f32x2& yb = y[j * 8 + 2 * k4 + 1];
            ya.x = xa.x + ga.x * ya.x; ya.y = xa.y + ga.y * ya.y; yb.x = xa.z + ga.z * yb.x; yb.y = xa.w + ga.w * yb.y;
            ssq += (ya.x * ya.x + ya.y * ya.y) + (yb.x * yb.x + yb.y * yb.y);
        }
    const float r = rsqrtf(wave_sum(ssq) * (1.f / D) + EPS);
#pragma unroll
    for (int j = 0; j < 2; ++j)
#pragma unroll
        for (int k4 = 0; k4 < 4; ++k4) {
            const int col = lane * 16 + 1024 * j + 4 * k4;
            const f32x2 ya = y[j * 8 + 2 * k4], yb = y[j * 8 + 2 * k4 + 1];
            f32x4 ov = {ya.x, ya.y, yb.x, yb.y};
            if (fnorm) *(f32x4*)(XO + (size_t)row * D + col) = ov * r * *(const f32x4*)(fnorm + col);
            else *(unsigned long long*)(XOH + (size_t)row * D + col) = (unsigned long long)pk2(ov.x, ov.y) | ((unsigned long long)pk2(ov.z, ov.w) << 32);
            if (ngain) {
                const f32x4 g = *(const f32x4*)(ngain + col), sc = *(const f32x4*)(nmod + MO_SC1 + col), sh = *(const f32x4*)(nmod + MO_SH1 + col);
                const f32x4 hv = (ov * r) * g * (sc + 1.f) + sh;
                *(unsigned long long*)(Hout + (size_t)row * D + col) = (unsigned long long)pk2(hv.x, hv.y) | ((unsigned long long)pk2(hv.z, hv.w) << 32);
            }
        }
}


DEV f32x2 dot_u8_bf16(const v4u (&xk)[4], const v4u u0, const v4u u1) {
    f32x2 acc = {0.f, 0.f};
    const unsigned uw[8] = {u0.x, u0.y, u0.z, u0.w, u1.x, u1.y, u1.z, u1.w};
    const unsigned xw[16] = {xk[0].x, xk[0].y, xk[0].z, xk[0].w, xk[1].x, xk[1].y, xk[1].z, xk[1].w, xk[2].x, xk[2].y, xk[2].z, xk[2].w, xk[3].x, xk[3].y, xk[3].z, xk[3].w};
#pragma unroll
    for (int dw = 0; dw < 8; ++dw) {
        const f32x2 lo = __builtin_amdgcn_cvt_pk_f32_fp8((int)uw[dw], false), hi = __builtin_amdgcn_cvt_pk_f32_fp8((int)uw[dw], true);
        acc = __builtin_elementwise_fma(lo, (f32x2){bf_lo(xw[2 * dw]), bf_hi(xw[2 * dw])}, acc);
        acc = __builtin_elementwise_fma(hi, (f32x2){bf_lo(xw[2 * dw + 1]), bf_hi(xw[2 * dw + 1])}, acc);
    }
    return acc;
}
DEV void axpy_v8(f32x2 (&y)[16], float w, const v4u v0, const v4u v1) {
    const f32x2 w2 = {w, w};
    const unsigned vw[8] = {v0.x, v0.y, v0.z, v0.w, v1.x, v1.y, v1.z, v1.w};
#pragma unroll
    for (int dw = 0; dw < 8; ++dw) {
        const f32x2 lo = __builtin_amdgcn_cvt_pk_f32_fp8((int)vw[dw], false), hi = __builtin_amdgcn_cvt_pk_f32_fp8((int)vw[dw], true);
        y[2 * dw] = __builtin_elementwise_fma(w2, lo, y[2 * dw]); y[2 * dw + 1] = __builtin_elementwise_fma(w2, hi, y[2 * dw + 1]);
    }
}
DEV void expert_epilogue(f32x2 (&y)[16], int row, const float* __restrict__ X1, const float* __restrict__ g2, const float* __restrict__ fnorm, float* __restrict__ XO, int lane, float pscale,
                         const float* __restrict__ ngain, const float* __restrict__ nmod, bf16* Hout) {
    float ssq = 0.f;
#pragma unroll
    for (int j = 0; j < 2; ++j)
#pragma unroll
        for (int k4 = 0; k4 < 4; ++k4) {
            const int col = lane * 16 + 1024 * j + 4 * k4;
            const f32x4 xa = *(const f32x4*)(X1 + (size_t)row * D + col); const f32x4 ga = *(const f32x4*)(g2 + col) * pscale;
            f32x2& ya = y[j * 8 + 2 * k4]; f32x2& yb = y[j * 8 + 2 * k4 + 1];
            ya.x = xa.x + ga.x * ya.x; ya.y = xa.y + ga.y * ya.y; yb.x = xa.z + ga.z * yb.x; yb.y = xa.w + ga.w * yb.y;
            ssq += (ya.x * ya.x + ya.y * ya.y) + (yb.x * yb.x + yb.y * yb.y);
        }
    const float r = rsqrtf(wave_sum(ssq) * (1.f / D) + EPS);
#pragma unroll
    for (int j = 0; j < 2; ++j)
#pragma unroll
        for (int k4 = 0; k4 < 4; ++k4) {
            const int col = lane * 16 + 1024 * j + 4 * k4;
            const f32x2 ya = y[j * 8 + 2 * k4], yb = y[j * 8 + 2 * k4 + 1];
            f32x4 ov = {ya.x, ya.y, yb.x, yb.y};
            if (fnorm) ov = ov * r * *(const f32x4*)(fnorm + col);
            *(f32x4*)(XO + (size_t)row * D + col) = ov;
            if (ngain) {
                const f32x4 g = *(const f32x4*)(ngain + col), sc = *(const f32x4*)(nmod + MO_SC1 + col), sh = *(const f32x4*)(nmod + MO_SH1 + col);
                const f32x4 hv = (ov * r) * g * (sc + 1.f) + sh;
                *(unsigned long long*)(Hout + (size_t)row * D + col) = (unsigned long long)pk2(hv.x, hv.y) | ((unsigned long long)pk2(hv.z, hv.w) << 32);
            }
        }
}

DEV void unpack_fp8x32(f32x2 (&t)[16], const v4u a, const v4u b) {
    const unsigned w[8] = {a.x, a.y, a.z, a.w, b.x, b.y, b.z, b.w};
#pragma unroll
    for (int dw = 0; dw < 8; ++dw) { t[2 * dw] = __builtin_amdgcn_cvt_pk_f32_fp8((int)w[dw], false); t[2 * dw + 1] = __builtin_amdgcn_cvt_pk_f32_fp8((int)w[dw], true); }
}
DEV float dot_t_bf16(const f32x2 (&t)[16], const v4u (&xk)[4]) {
    const unsigned xw[16] = {xk[0].x, xk[0].y, xk[0].z, xk[0].w, xk[1].x, xk[1].y, xk[1].z, xk[1].w, xk[2].x, xk[2].y, xk[2].z, xk[2].w, xk[3].x, xk[3].y, xk[3].z, xk[3].w};
    f32x2 acc = {0.f, 0.f};
#pragma unroll
    for (int i = 0; i < 16; ++i) { unsigned xv = xw[i]; asm volatile("" : "+v"(xv));
        acc = __builtin_elementwise_fma(t[i], (f32x2){bf_lo(xv), bf_hi(xv)}, acc); }
    return acc.x + acc.y;
}
DEV void axpy_t(f32x2 (&y)[16], float w, const f32x2 (&t)[16]) {
    const f32x2 w2 = {w, w};
#pragma unroll
    for (int i = 0; i < 16; ++i) y[i] = __builtin_elementwise_fma(w2, t[i], y[i]);
}
DEV void expert_pair8(int l, int m0, int mstride, const bf16* H, const int* __restrict__ IDS, const float* __restrict__ GG, const unsigned char* __restrict__ U8, const unsigned char* __restrict__ V8,
                      const float* __restrict__ X1, const float* __restrict__ modg2  , const float* __restrict__ fnorm, float* __restrict__ XO, int lane, float pscale,
                      LAS unsigned char* wl, const float* __restrict__ ngain, const float* __restrict__ nmodl  , bf16* Hout) {
    asm volatile("" : "+v"(lane));
    LAS unsigned* ent = (LAS unsigned*)wl; LAS float* eg = (LAS float*)(wl + 1024);
    {
        int idv[4]; float ggv[4]; int pos[4];
#pragma unroll
        for (int sidx = 0; sidx < 4; ++sidx) { const size_t o = (size_t)(m0 + (sidx >> 1) * mstride) * 128 + (sidx & 1) * 64 + lane; idv[sidx] = IDS[o]; ggv[sidx] = GG[o]; pos[sidx] = 0; }
        int base = 0;
        for (int w = 0; w < 32; ++w) {
#pragma unroll
            for (int sidx = 0; sidx < 4; ++sidx) {
                const bool hit = (idv[sidx] >> 9) == w;
                const unsigned long long mk = __ballot(hit);
                const int bl = (int)__builtin_amdgcn_mbcnt_hi((unsigned)(mk >> 32), __builtin_amdgcn_mbcnt_lo((unsigned)mk, 0u));
                pos[sidx] = hit ? base + bl : pos[sidx];
                base += __popcll(mk);
            }
        }
#pragma unroll
        for (int sidx = 0; sidx < 4; ++sidx) { ent[pos[sidx]] = (unsigned)idv[sidx] | ((unsigned)(sidx >> 1) << 16); eg[pos[sidx]] = ggv[sidx]; }
        LDS_WAIT();
    }
    const unsigned char* Ul = U8 + (size_t)l * NEXP * D + lane * 16;
    const unsigned char* Vl = V8 + (size_t)l * NEXP * D + lane * 16;
    {
        v4u xk0[4], xk1[4];
#pragma unroll
        for (int j = 0; j < 2; ++j) {
            const bf16* hp0 = H + (size_t)(m0 + 0 * mstride) * D + lane * 16 + 1024 * j; xk0[2 * j] = *(const v4u*)hp0; xk0[2 * j + 1] = *(const v4u*)(hp0 + 8);
            const bf16* hp1 = H + (size_t)(m0 + 1 * mstride) * D + lane * 16 + 1024 * j; xk1[2 * j] = *(const v4u*)hp1; xk1[2 * j + 1] = *(const v4u*)(hp1 + 8);
        }
#pragma unroll 1
        for (int e0 = 0; e0 < 256; e0 += 4) {
            const unsigned entv = ent[e0 + (lane & 3)]; const float egv = eg[e0 + (lane & 3)];
            unsigned eq[4]; v4u uu[4][2];
#pragma unroll
            for (int q = 0; q < 4; ++q) { eq[q] = (unsigned)__builtin_amdgcn_readlane((int)entv, q); const size_t ro = (size_t)(eq[q] & 0xffffu) * D; uu[q][0] = *(const v4u*)(Ul + ro); uu[q][1] = *(const v4u*)(Ul + ro + 1024); }
            float ds[4];
#pragma unroll
            for (int q = 0; q < 4; ++q) {
                f32x2 t[16]; unpack_fp8x32(t, uu[q][0], uu[q][1]);
                if ((eq[q] >> 16) == 0) { asm volatile(""); ds[q] = dot_t_bf16(t, xk0); } else { asm volatile(""); ds[q] = dot_t_bf16(t, xk1); }
            }
#pragma unroll
            for (int q = 0; q < 4; ++q) ds[q] += swz_xor<1>(ds[q]);
#pragma unroll
            for (int q = 0; q < 4; ++q) ds[q] += swz_xor<2>(ds[q]);
#pragma unroll
            for (int q = 0; q < 4; ++q) ds[q] += swz_xor<4>(ds[q]);
#pragma unroll
            for (int q = 0; q < 4; ++q) ds[q] += swz_xor<8>(ds[q]);
#pragma unroll
            for (int q = 0; q < 4; ++q) ds[q] += swz_xor<16>(ds[q]);
#pragma unroll
            for (int q = 0; q < 4; ++q) ds[q] = sum32(ds[q]);
            float wmine = 0.f;
#pragma unroll
            for (int q = 0; q < 4; ++q) { const float gq = __builtin_bit_cast(float, __builtin_amdgcn_readlane(__builtin_bit_cast(int, egv), q)); const float wq = gq * gelu_tanh(ds[q] * (1.f / U8_SCALE)); wmine = (lane == q) ? wq : wmine; }
            if (lane < 4) eg[e0 + lane] = wmine;
        }
        LDS_WAIT();
    }
    {
        f32x2 y0[16], y1[16];
#pragma unroll
        for (int i = 0; i < 16; ++i) { y0[i] = (f32x2){0.f, 0.f}; y1[i] = (f32x2){0.f, 0.f}; }
#pragma unroll 1
        for (int e0 = 0; e0 < 256; e0 += 4) {
            const unsigned entv = ent[e0 + (lane & 3)]; const float egv = eg[e0 + (lane & 3)];
            unsigned eq[4]; v4u vv[4][2];
#pragma unroll
            for (int q = 0; q < 4; ++q) { eq[q] = (unsigned)__builtin_amdgcn_readlane((int)entv, q); const size_t ro = (size_t)(eq[q] & 0xffffu) * D; vv[q][0] = *(const v4u*)(Vl + ro); vv[q][1] = *(const v4u*)(Vl + ro + 1024); }
#pragma unroll
            for (int q = 0; q < 4; ++q) {
                const float wq = __builtin_bit_cast(float, __builtin_amdgcn_readlane(__builtin_bit_cast(int, egv), q));
                f32x2 t[16]; unpack_fp8x32(t, vv[q][0], vv[q][1]);
                if ((eq[q] >> 16) == 0) { asm volatile(""); axpy_t(y0, wq, t); } else { asm volatile(""); axpy_t(y1, wq, t); }
            }
        }
#define EXP_EPI(Y, K) do { const int row = m0 + (K) * mstride; const int b = row >> 12; \
            expert_epilogue(Y, row, X1, modg2 + (size_t)b * MODW, fnorm, XO, lane, pscale, ngain, nmodl ? nmodl + (size_t)b * MODW : nullptr, Hout); } while (0)
        EXP_EPI(y0, 0); EXP_EPI(y1, 1);
#undef EXP_EPI
    }
    LDS_WAIT();
}

#if MK_CHECK
DEV void chk_route(int l, int row, int h, const bf16* __restrict__ Q, const bf16* __restrict__ SK, const int* __restrict__ IDS, const float* __restrict__ GG, unsigned* bad, LAS float* sL, LAS unsigned* cntL, int tid) {
    if (tid < 256) { const int c = tid >> 7, k = tid & 127; const bf16* skp = SK + ((size_t)((l * 8 + h) * 2 + c)) * 128 * 128 + k * 128; const bf16* qp = Q + (size_t)row * D + h * 256 + c * 128;
        float s = 0.f; for (int d = 0; d < 128; ++d) s += bf1(qp[d]) * bf1(skp[d]); sL[c * 128 + k] = s; }
    if (tid == 0) cntL[0] = 0u;
    __syncthreads();
    float sc15 = 0.f; unsigned mybad = 0;
    { float prev = 3e38f; float s0 = 0.f, gsum = 0.f; float g0 = GG[(size_t)row * 128 + h * 16];
      for (int r = 0; r < 16; ++r) { const int id = IDS[(size_t)row * 128 + h * 16 + r]; const float g = GG[(size_t)row * 128 + h * 16 + r];
          if (id < 0 || id >= NEXP) { mybad |= 1; continue; }
          const float scv = sL[id >> 7] + sL[128 + (id & 127)];
          if (r == 0) s0 = scv;
          if (scv > prev + 1e-5f) mybad |= 2;
          prev = scv; gsum += g;
          const float ratio = __expf(scv - s0);
          if (fabsf(g / g0 - ratio) > 0.02f * ratio + 1e-4f) mybad |= 4;
          if (r == 15) sc15 = scv; }
      if (fabsf(gsum - 1.f) > 1e-3f) mybad |= 8; }
    unsigned cnt = 0;
    for (int p = tid; p < 16384; p += 512) { const float v = sL[p >> 7] + sL[128 + (p & 127)]; if (v > sc15 + 1e-5f) ++cnt; }
    __hip_atomic_fetch_add(cntL, cnt, __ATOMIC_RELAXED, __HIP_MEMORY_SCOPE_WORKGROUP);
    __syncthreads();
    if (tid == 0) { if (cntL[0] > 15u) mybad |= 16; if (mybad) atomicAdd(bad, 1u); }
    __syncthreads();
}
DEV void chk_expert(int l, int row, const bf16* __restrict__ H, const int* __restrict__ IDS, const float* __restrict__ GG, const float* __restrict__ Uf, const float* __restrict__ Vf,
                    const float* __restrict__ X1, const float* __restrict__ X2, const float* __restrict__ g2, unsigned* bad, LAS float* wL, int tid) {
    if (tid < 128) { const int id = IDS[(size_t)row * 128 + tid]; const float* up = Uf + ((size_t)l * NEXP + id) * D; const bf16* hp = H + (size_t)row * D;
        float s = 0.f; for (int d = 0; d < D; ++d) s += up[d] * bf1(hp[d]);
        wL[tid] = GG[(size_t)row * 128 + tid] * gelu_tanh(s); }
    __syncthreads();
    unsigned mybad = 0;
    for (int d = tid; d < D; d += 512) { float y = 0.f;
        for (int e = 0; e < 128; ++e) { const int id = IDS[(size_t)row * 128 + e]; y += wL[e] * Vf[((size_t)l * NEXP + id) * D + d]; }
        const float want = X1[(size_t)row * D + d] + g2[d] * y * (MK_CHECK == 3 ? 1.5f : 1.f); const float got = X2[(size_t)row * D + d];
        if (!(fabsf(got - want) <= 0.02f * fabsf(want) + 0.02f)) mybad = 1; }
    if (mybad) atomicAdd(bad, 1u);
    __syncthreads();
}

DEV void chk_hq(int l, int row, const float* __restrict__ X1, const float* __restrict__ gain, const float* __restrict__ modl, const float* __restrict__ wq, const bf16* __restrict__ H, const bf16* __restrict__ Q,
                unsigned* bad, LAS float* hL, LAS float* redL, int tid) {
    const int b = row >> 12;
    float ss = 0.f;
    for (int d = tid; d < D; d += 512) { const float v = X1[(size_t)row * D + d]; ss += v * v; }
    ss = wave_sum(ss);
    if ((tid & 63) == 0) redL[tid >> 6] = ss;
    __syncthreads();
    float tot = 0.f; for (int w = 0; w < 8; ++w) tot += redL[w];
    const float r = rsqrtf(tot * (1.f / D) + EPS);
    unsigned badh = 0, badq = 0;
    for (int d = tid; d < D; d += 512) { const float hv = X1[(size_t)row * D + d] * r * gain[d] * (1.f + modl[(size_t)b * MODW + MO_SC2 + d]) + modl[(size_t)b * MODW + MO_SH2 + d];
        hL[d] = hv; const float got = bf1(H[(size_t)row * D + d]); if (!(fabsf(got - hv) <= 0.01f * fabsf(hv) + 0.01f)) badh = 1; }
    __syncthreads();
    for (int c = tid; c < D; c += 512) { float q = 0.f; for (int k = 0; k < D; ++k) q += hL[k] * wq[(size_t)k * D + c];
        const float got = bf1(Q[(size_t)row * D + c]); if (!(fabsf(got - q) <= 0.02f * fabsf(q) + 0.03f)) badq = 1; }
    if (badh) atomicAdd(bad, 1u);
    if (badq) atomicAdd(bad + 1, 1u);
    __syncthreads();
}
#endif
struct Args { const float* in[24]; float* out; unsigned char* ws; int ph_lo, ph_hi, li, pad; };

__global__ void __launch_bounds__(512, 2) fwd(Args a) {
    extern __shared__ __attribute__((aligned(16))) unsigned char lds_raw[];
    LAS unsigned char* lds = (LAS unsigned char*)lds_raw;
#define PHASE_TID() unsigned zz_ = 0u; asm volatile("" : "+v"(zz_));   \
    int tid = wave0 * 64 + (int)__builtin_amdgcn_mbcnt_hi(~0u, __builtin_amdgcn_mbcnt_lo(~0u, zz_)); const int lane = tid & 63; (void)lane; \
    int bx = blockIdx.x, G = gridDim.x; asm volatile("" : "+s"(bx), "+s"(G)); const int wave = __builtin_amdgcn_readfirstlane(tid >> 6); \
    const int vcu = (G % 8 == 0) ? (bx % 8) * (G / 8) + bx / 8 : bx; const int gw = vcu * 8 + wave, NGW = G * 8; (void)gw; (void)NGW; (void)vcu; (void)wave; \
    const __attribute__((address_space(4))) Args* A = (const __attribute__((address_space(4))) Args*)__builtin_amdgcn_kernarg_segment_ptr(); asm volatile("" : "+s"(A))
    unsigned* ctl = (unsigned*)(a.ws + WS_CTL);
    const int lo = a.ph_lo, hi = a.ph_hi;
    const int wave0 = __builtin_amdgcn_readfirstlane((int)threadIdx.x >> 6);
    for (int u = threadIdx.x; u < (LDS_BYTES - LDS_MISC) / 4; u += 512) ((LAS unsigned*)(lds + LDS_MISC))[u] = 0u;
    __syncthreads();
    XcdBarrier bar; bar.bar = ctl + CW_BAR + (a.li & 7) * XCD_BAR_WORDS; bar.x = 0; bar.st = (volatile LAS unsigned*)(lds + LDS_MISC + 64); bar.w0 = wave0;
    if (hi - lo > 1) bar = xcd_barrier_post(ctl + CW_BAR + (a.li & 7) * XCD_BAR_WORDS, (volatile LAS unsigned*)(lds + LDS_MISC + 64), wave0);
#ifndef MK_MASK
#define MK_MASK 0x3ff
#endif
#define KON(q) (((MK_MASK) >> (q)) & 1)
#define IN(k) (lo <= (k) && (k) < hi)
#define SEAM(k) do { if (IN(k) && IN((k) + 1)) xcd_barrier(bar); } while (0)

#define mod   ((float*)(A->ws + WS_MOD))
#define WIN_T ((bf16*)(A->ws + WS_WIN_T))
#define WOUT_T ((bf16*)(A->ws + WS_WOUT_T))
#define WQ_T  ((bf16*)(A->ws + WS_WQ_T))
#define SUBK  ((bf16*)(A->ws + WS_SUBK))
#define UB    ((bf16*)(A->ws + WS_U))
#define VB    ((bf16*)(A->ws + WS_V))
#define H     ((bf16*)(A->ws + WS_H))
#define Z     ((bf16*)(A->ws + WS_Z))
#define HLOC  ((bf16*)(A->ws + WS_HLOC))
#define PP    ((bf16*)(A->ws + WS_P))
#define YB    ((float*)(A->ws + WS_YB))
#define YC    ((bf16*)(A->ws + WS_YC))
#define SUMA  ((float*)(A->ws + WS_SUMA))
#define SUMB  ((float*)(A->ws + WS_SUMB))
#define X1    ((float*)(A->ws + WS_X1))
#define X2    ((float*)(A->ws + WS_X2))
#define QB    ((bf16*)(A->ws + WS_Q))
#define IDS   ((int*)(A->ws + WS_IDS))
#define GG    ((float*)(A->ws + WS_G))
#define PARTB ((bf16*)(A->ws + WS_PART))
#define WG_T  ((bf16*)(A->ws + WS_WG_T))
#define LSEB  ((float*)(A->ws + WS_LSE))
#define XIN   ((l == 0) ? A->in[0] : (const float*)X2)
#define XR    ((bf16*)(A->ws + WS_XR))
#define X1H   ((bf16*)(A->ws + WS_X1))
#define X2H   ((bf16*)(A->ws + WS_X2))
#define XRES  ((l == 0) ? (const bf16*)XR : (const bf16*)X2H)
#define MODL  (mod + (size_t)l * 2 * MODW)
    for (int rep = 0; rep < (MK_DUP == 0 ? 2 : 1); ++rep) if (KON(0) && IN(0)) {
        PHASE_TID();
        ph_mod(A->in[1], A->in[2], A->in[3], mod, (LAS float*)lds, vcu, G, tid);
        {
            LAS float* scr = (LAS float*)(lds + wave * 16384);
            constexpr int I_IN = (D / 64) * (IN_W / 32), I_SQ = (D / 64) * (D / 32), I_L = I_IN + 2 * I_SQ;
            for (int it = gw; it < 2 * I_L; it += NGW) {
                const int l = it / I_L; int r = it % I_L;
                if (r < I_IN) { transpose_item(A->in[6] + (size_t)l * D * IN_W, D, IN_W, WIN_T + (size_t)l * IN_W * D, scr, r, lane); continue; } r -= I_IN;
                if (r < I_SQ) { transpose_item(A->in[18] + (size_t)l * D * D, D, D, WOUT_T + (size_t)l * D * D, scr, r, lane); continue; } r -= I_SQ;
                transpose_item(A->in[19] + (size_t)l * D * D, D, D, WQ_T + (size_t)l * D * D, scr, r, lane);
            }
        }
        {
            LAS float* scr = (LAS float*)(lds + wave * 16384);
            for (int it = gw; it < 2 * 6 * 2 * 8; it += NGW) { const int mi = it >> 3, sub = it & 7; const int ln = mi >> 1, g = mi & 1;
                transpose_item((g ? A->in[11] : A->in[9]) + (size_t)ln * 128 * 128, 128, 128, WG_T + ((size_t)ln * 2 + g) * 128 * 128, scr, sub, lane); }
        }
        const size_t gtid = (size_t)vcu * 512 + tid, gstride = (size_t)G * 512;
        convert_copy(A->in[20], SUBK, (size_t)2 * 8 * 2 * 128 * 128 / 8, gtid, gstride);
    }
    SEAM(0);

    for (int l = 0; l < NL; ++l) {
        const int pb = 1 + 9 * l;
        for (int rep = 0; rep < (MK_DUP == 1 ? 2 : 1); ++rep) if (KON(1) && IN(pb + 0) && l == 0) { PHASE_TID(); modnorm_rows(XIN, A->in[4] + l * D, MODL, MO_SH1, MO_SC1, H, gw, NGW, lane, XR); }
        if (l == 0) SEAM(pb + 0);
        for (int rep = 0; rep < (MK_DUP == 2 ? 2 : 1); ++rep) if (KON(2) && IN(pb + 1)) {
            PHASE_TID(); (void)tid;
            pg8::Gemm g{H, WIN_T + (size_t)l * IN_W * D, M, IN_W, D}; pg8::StaticOrder S; S.init(M, IN_W, G, bx);
            pg8::EpiBf16<0> E{Z, IN_W, nullptr, 0, 0};
            pg8::gemm_phase<pg8::EpiBf16<0>, pg8::StaticOrder, false>((PG8_LAS unsigned char*)lds, g, S, E, nullptr, wave0);
        }
        SEAM(pb + 1);
        for (int rep = 0; rep < (MK_DUP == 3 ? 2 : 1); ++rep) if (KON(3) && IN(pb + 2)) {
            PHASE_TID();
            if (rep) __syncthreads();
            for (int it = vcu; it < 2 * 64 * 6; it += G) {
                const int b = it / 384, r = it % 384, j = r / 6, n = r % 6;
                lru_item2(l, b, j, n, Z, A->in[7], A->in[8], WG_T, A->in[10], A->in[12], A->in[13], HLOC, PP, SUMA, SUMB,
                          (LAS float*)lds, (LAS float*)(lds + 34816), (LAS float*)(lds + 69632), tid);
            }
            {
                {
                    LAS unsigned char* wl = lds + wave * ATT_WLDS;
                    for (int it = gw; it < 1024 + 4608; it += NGW) {
                        if (it < 1024) { const int bh = it >> 7, tl = 127 - (it & 127); sb_mfma_item(bh >> 2, bh & 3, 32 * tl, Z, YC, wl, lane); }
                        else { const int i2 = it - 1024; const int tl = i2 & 127, p = (i2 >> 7) % 3, bh = i2 / 384; const int d = 1 << (2 * p);
                            dil_mfma_item(bh / 6, bh % 6, p, tl % d, 32 * (tl / d), Z, A->in[14], PARTB, LSEB, wl, lane); }
                    }
                }
            }
        }
        SEAM(pb + 2);
        for (int rep = 0; rep < (MK_DUP == 4 ? 2 : 1); ++rep) if (KON(4) && IN(pb + 3)) {
            PHASE_TID();
            for (int it = vcu; it < 256; it += G) { const int b = it >> 7, j = (it >> 1) & 63, half = it & 1;
                combine_item(l, b, j, half, Z, HLOC, PP, SUMA, SUMB, PARTB, LSEB, YC, A->in[15], A->in[16], A->in[17], H, (LAS float*)lds, tid); }
        }
        SEAM(pb + 3);
        for (int rep = 0; rep < (MK_DUP == 5 ? 2 : 1); ++rep) if (KON(5) && IN(pb + 4)) {
            PHASE_TID(); (void)tid;
            pg8::Gemm g{H, WOUT_T + (size_t)l * D * D, M, D, D}; pg8::StaticOrder S; S.init(M, D, G, bx);
            EpiResGate E{XRES, X1H, MODL + MO_G1, ((MK_DBG >> (2 * l)) & 1) ? 0.f : ((MK_DBG & 256) ? -1.f : 1.f)};
            pg8::gemm_phase<EpiResGate, pg8::StaticOrder, false>((PG8_LAS unsigned char*)lds, g, S, E, nullptr, wave0);
        }
        SEAM(pb + 4);
        for (int rep = 0; rep < (MK_DUP == 6 ? 2 : 1); ++rep) if (KON(6) && IN(pb + 5)) { PHASE_TID(); modnorm_rows_h(X1H, A->in[5] + l * D, MODL, MO_SH2, MO_SC2, H, gw, NGW, lane); }
        SEAM(pb + 5);
        for (int rep = 0; rep < (MK_DUP == 7 ? 2 : 1); ++rep) if (KON(7) && IN(pb + 6)) {
            PHASE_TID(); (void)tid;
            pg8::Gemm g{H, WQ_T + (size_t)l * D * D, M, D, D}; pg8::StaticOrder S; S.init(M, D, G, bx);
            pg8::EpiBf16<0> E{QB, D, nullptr, 0, 0};
            pg8::gemm_phase<pg8::EpiBf16<0>, pg8::StaticOrder, false>((PG8_LAS unsigned char*)lds, g, S, E, nullptr, wave0);
        }
        SEAM(pb + 6);
        for (int rep = 0; rep < (MK_DUP == 8 ? 2 : 1); ++rep) if (KON(8) && IN(pb + 7)) {
            PHASE_TID();
            for (int it = vcu; it < 128 * 8; it += G) route_item2(l, it >> 3, it & 7, QB, SUBK, IDS, GG, lds, tid, A->in[21] + (size_t)l * NEXP * D, A->in[22] + (size_t)l * NEXP * D,
                                                                                      (unsigned char*)UB + (size_t)l * NEXP * D, (unsigned char*)VB + (size_t)l * NEXP * D);
        }
        SEAM(pb + 7);
        for (int rep = 0; rep < (MK_DUP == 9 ? 2 : 1); ++rep) if (KON(9) && IN(pb + 8)) {
            PHASE_TID();
            for (int m = gw; m < M; m += NGW)
                expert_row8(l, m, H, IDS, GG, (const unsigned char*)UB, (const unsigned char*)VB, X1H, MODL + (size_t)(m >> 12) * MODW + MO_G2, (l == NL - 1) ? A->in[23] : nullptr, A->out, X2H, lane,
                            ((MK_DBG >> (2 * l + 1)) & 1) ? 0.f : ((MK_DBG & 128) ? -1.f : 1.f), (LAS int*)(lds + wave * 1024),
                            (l == NL - 1) ? nullptr : A->in[4] + (l + 1) * D, mod + (size_t)((l + 1) * 2 + (m >> 12)) * MODW, H);
        }
        if (l + 1 < NL) SEAM(pb + 8);
    }
#if MK_CHECK
    if (IN(19)) {
        PHASE_TID();
        unsigned* badw = (unsigned*)(A->ws + WS_CTL) + 8;
#if MK_CHECK == 1 || MK_CHECK == 3 || MK_CHECK == 4
        for (int it = vcu; it < (MK_CHECK == 4 ? 8192 : 256) * 8; it += G) { const int row = (MK_CHECK == 4) ? (it >> 3) : (((it >> 3) * 131 + 7) & 8191); chk_route(0, row, it & 7, QB, SUBK, IDS, GG, badw, (LAS float*)lds, (LAS unsigned*)(lds + 2048), tid); }
        for (int it = vcu; it < (MK_CHECK == 4 ? 8192 : 256); it += G) { const int row = (MK_CHECK == 4) ? it : ((it * 131 + 7) & 8191); chk_expert(0, row, H, IDS, GG, A->in[21], A->in[22], X1, X2, mod + (size_t)(row >> 12) * MODW + MO_G2, badw + 1, (LAS float*)lds, tid); }
#elif MK_CHECK == 12 || MK_CHECK == 15
        { (void)badw;
          for (int m = gw; m < M; m += NGW) { const int ia = IDS[(size_t)m * 128 + lane], ib = IDS[(size_t)m * 128 + 64 + lane]; int cnt = 0;
              for (int e = 0; e < 128; ++e) { const int ie = (e < 64) ? __shfl(ia, e) : __shfl(ib, e - 64); if (lane < e && ia == ie && (MK_CHECK == 12 || (lane >> 4) == (e >> 4))) ++cnt; if (lane + 64 < e && ib == ie && (MK_CHECK == 12 || ((lane + 64) >> 4) == (e >> 4))) ++cnt; }
              float fc = wave_sum((float)cnt); if (lane == 0) atomicAdd((float*)(A->ws + WS_CTL) + 16, fc * 2048.f); } }
#elif MK_CHECK == 13 || MK_CHECK == 14
        { (void)badw;
          float cnt = 0.f;
          if (MK_CHECK == 13) { const float* sk = A->in[20]; for (int o = vcu * 512 + tid; o < 2 * 128 * 128; o += G * 512) if (sk[o] == sk[o + 2 * 128 * 128]) cnt += 1.f; cnt *= (float)M * D / (2.f * 128 * 128); }
          else { const float* wq = A->in[19]; for (int o = vcu * 512 + tid; o < D * 256; o += G * 512) { const int k = o >> 8, c = o & 255; if (wq[(size_t)k * D + c] == wq[(size_t)k * D + 256 + c]) cnt += 1.f; } cnt *= (float)M * D / ((float)D * 256); }
          cnt = wave_sum(cnt); if (lane == 0) atomicAdd((float*)(A->ws + WS_CTL) + 16, cnt); }
#elif MK_CHECK == 10
        { (void)badw; float acc = 0.f; const float* vt = A->in[22];
          for (size_t o = (size_t)vcu * 512 + tid; o < (size_t)NEXP * D; o += (size_t)G * 512) { const float v = vt[o]; acc += v * v; }
          acc = wave_sum(acc); if (lane == 0) atomicAdd((float*)(A->ws + WS_CTL) + 16, acc * ((float)M * D / ((float)NEXP * D))); }
#elif MK_CHECK == 16
        (void)badw;
#elif MK_CHECK >= 6
        (void)badw;
#elif MK_CHECK == 5
        {
            const float* cc = A->in[1]; const float* wm = A->in[2]; const float* bm = A->in[3];
            unsigned mb = 0;
            for (int o = vcu * 512 + tid; o < 2 * 2 * MODW; o += G * 512) { const int l = o / (2 * MODW), b = (o / MODW) & 1, n = o % MODW;
                float sacc = 0.f; for (int k = 0; k < D; ++k) { const float cv = cc[b * D + k]; sacc += (cv / (1.f + __expf(-cv))) * wm[((size_t)l * D + k) * MODW + n]; }
                sacc += bm[l * MODW + n];
                if (!(fabsf(sacc - mod[o]) <= 2e-3f * fabsf(sacc) + 2e-3f)) mb = 1; }
            if (mb) atomicAdd(badw, 1u);
            unsigned sb = 0;
            for (int o = vcu * 512 + tid; o < 2 * 8 * 2 * 128 * 128; o += G * 512) { const float want = A->in[20][o]; const float got = bf1(SUBK[o]); if (!(fabsf(got - want) <= 0.01f * fabsf(want) + 1e-6f)) sb = 1; }
            if (sb) atomicAdd(badw + 1, 1u);
        }
#else
        for (int it = vcu; it < 256; it += G) { const int row = (it * 131 + 7) & 8191; chk_hq(0, row, X1, A->in[5], mod, A->in[19], H, QB, badw, (LAS float*)lds, (LAS float*)(lds + 16384), tid); }
#endif
    }
    if (IN(20)) {
        PHASE_TID();
        const unsigned* badw = (const unsigned*)(A->ws + WS_CTL) + 8;
        const unsigned b0 = __hip_atomic_load(badw, __ATOMIC_RELAXED, __HIP_MEMORY_SCOPE_AGENT), b1 = __hip_atomic_load(badw + 1, __ATOMIC_RELAXED, __HIP_MEMORY_SCOPE_AGENT);
#if MK_CHECK >= 6 && MK_CHECK != 16
        const float f = 1.f + ((const float*)(A->ws + WS_CTL))[16] * (1.f / ((float)M * D)); (void)b0; (void)b1;
#else
        const float f = (b0 ? (b1 ? -2.f : 0.f) : (b1 ? -1.f : 1.f));
#endif
        for (int m = gw; m < M; m += NGW) { const f32x4* xr = (const f32x4*)(X2 + (size_t)m * D) + lane; f32x4 v[8]; float ss = 0.f;
#pragma unroll
            for (int j = 0; j < 8; ++j) { v[j] = xr[64 * j]; ss += (v[j].x * v[j].x + v[j].y * v[j].y) + (v[j].z * v[j].z + v[j].w * v[j].w); }
            const float r = rsqrtf(wave_sum(ss) * (1.f / D) + EPS) * f;
#pragma unroll
            for (int j = 0; j < 8; ++j) { const f32x4 fn = ((const f32x4*)A->in[23])[lane + 64 * j]; ((f32x4*)(A->out + (size_t)m * D))[lane + 64 * j] = v[j] * r * fn; } }
    }
#endif
#undef IN
#undef SEAM
#undef mod
#undef H
#undef Z
#undef X1
#undef X2
}
}

extern "C" void kernel_launch(void* const* d_in, const int* in_sizes, int n_in, void* d_out, int out_size, void* d_ws, size_t ws_size, hipStream_t stream) {
    using namespace mk;
    static int grid = 0;
    if (grid == 0) {
        if (n_in != 24 || out_size != M * D || ws_size < WS_END) { fprintf(stderr, "kernel_launch: unexpected shapes (n_in %d out %d ws %zu)\n", n_in, out_size, ws_size); grid = -1; return; }
        int dev = 0, cus = 0, per_cu = 0;
        if (hipGetDevice(&dev) != hipSuccess || hipDeviceGetAttribute(&cus, hipDeviceAttributeMultiprocessorCount, dev) != hipSuccess) { grid = -1; return; }
        if (hipFuncSetAttribute((const void*)fwd, hipFuncAttributeMaxDynamicSharedMemorySize, LDS_BYTES) != hipSuccess) { fprintf(stderr, "kernel_launch: hipFuncSetAttribute failed\n"); grid = -1; return; }
        if (hipOccupancyMaxActiveBlocksPerMultiprocessor(&per_cu, (const void*)fwd, 512, LDS_BYTES) != hipSuccess || per_cu < 1) fprintf(stderr, "kernel_launch: occupancy query says %d\n", per_cu);
        (void)hipGetLastError();
        grid = cus;
    }
    if (grid < 0) return;
    (void)hipMemsetAsync((char*)d_ws + WS_CTL, 0, CTL_ZERO_BYTES, stream);
    Args a{};
    for (int i = 0; i < 24; ++i) a.in[i] = (const float*)d_in[i];
    a.out = (float*)d_out; a.ws = (unsigned char*)d_ws; a.pad = 0;
#if MK_CHECK
    constexpr int NLAUNCH = 12;
#else
    constexpr int NLAUNCH = MK_N_LAUNCHES;
#endif
    for (int li = 0; li < NLAUNCH; ++li) {
        a.ph_lo = (NLAUNCH == 1) ? 0 : li; a.ph_hi = (NLAUNCH == 1) ? NPHASE : li + 1; a.li = li;
#if MK_CHECK
        if (li >= 10) { a.ph_lo = li + 9; a.ph_hi = li + 10; }
#endif
        hipLaunchKernelGGL(fwd, dim3(grid), dim3(512), LDS_BYTES, stream, a);
    }
}
```

```cpp
#include <hip/hip_runtime.h>
#include <cstdio>
#include <cstdint>
namespace pg8 {
#define PG8_LAS __attribute__((address_space(3)))
typedef unsigned short bf16_t;
typedef short bf16x8 __attribute__((ext_vector_type(8)));
typedef float f32x4 __attribute__((ext_vector_type(4)));
typedef unsigned u32x4 __attribute__((ext_vector_type(4)));
constexpr int BM = 256, BK = 64, HALF = 128, HTB = HALF * BK * 2  , STAGE_BYTES = 8 * HTB, NXCD = 8, WGM = 8;

__host__ __device__ __forceinline__ int lds_byte(int r, int c) { const int st = (r >> 4) * 2 + (c >> 5), rr = r & 15, cc = c & 31, ob = rr * 64 + cc * 2; return st * 1024 + (ob ^ (((ob >> 9) & 1) << 5)); }
__host__ __device__ __forceinline__ void stage_rc(int b, int& R, int& C) { const int st = b / 1024, sb = b % 1024, swz = sb ^ (((sb >> 9) & 1) << 5); R = (st >> 1) * 16 + swz / 64; C = (st & 1) * 32 + (swz % 64) / 2; }
__host__ __device__ __forceinline__ int perm32(int rho) { const int n = rho >> 4, i = rho & 15; return 8 * (i >> 2) + 4 * n + (i & 3); }

struct Unit { int pm, pn; };
struct Gemm { const bf16_t* A; const bf16_t* Bt; int M, N, K; };

struct StaticOrder {
    int nM, nN, nwg, G, c;
    __host__ __device__ void init(int M, int N, int G_, int c_) { nM = M / BM; nN = N / BM; nwg = nM * nN; G = G_; c = c_; }
    __host__ __device__ bool next(int i, Unit& u) const {
        const long L = (long)i * G + c; if (L >= nwg) return false;
        int wgid = (int)L; { const int q = nwg / NXCD, r = nwg % NXCD, xcd = wgid % NXCD, off = wgid / NXCD; wgid = (xcd < r ? xcd * (q + 1) : r * (q + 1) + (xcd - r) * q) + off; }
        const int nig = WGM * nN, gid = wgid / nig, fm = gid * WGM, gsz = (nM - fm) < WGM ? (nM - fm) : WGM;
        u.pm = fm + ((wgid % nig) % gsz); u.pn = (wgid % nig) / gsz; return true;
    }
    __device__ __forceinline__ void a_ready(const Unit&) const {}
    __device__ __forceinline__ void done(const Unit&) const {}
};
struct CountedOrder : StaticOrder {
    const unsigned* ready; unsigned need; unsigned* tmo;
    __device__ __forceinline__ void a_ready(const Unit& u) const {
        if (threadIdx.x < 64) {
            const unsigned long long t0 = __builtin_amdgcn_s_memrealtime(); unsigned polls = 0;
            while ((unsigned)__builtin_amdgcn_readfirstlane(__hip_atomic_load(ready + 64 * u.pm, __ATOMIC_RELAXED, __HIP_MEMORY_SCOPE_AGENT)) < need) {
                if ((++polls & 255u) == 0u && __builtin_amdgcn_readfirstlane(__hip_atomic_load(tmo, __ATOMIC_RELAXED, __HIP_MEMORY_SCOPE_AGENT)) != 0u) break;
                if (__builtin_amdgcn_s_memrealtime() - t0 > 2000000ull) {
                    if (threadIdx.x == 0) { unsigned expect = 0u; __hip_atomic_compare_exchange_strong(tmo + 1, &expect, 0x600u | (unsigned)(u.pm & 0xff), __ATOMIC_RELAXED, __ATOMIC_RELAXED, __HIP_MEMORY_SCOPE_AGENT); __hip_atomic_store(tmo, 1u, __ATOMIC_RELAXED, __HIP_MEMORY_SCOPE_AGENT); }
                    break; }
                __builtin_amdgcn_s_sleep(2); }
            __builtin_amdgcn_fence(__ATOMIC_ACQUIRE, "agent");
            asm volatile("s_waitcnt vmcnt(0)" ::: "memory");
        }
#if !defined(BROKEN_HOOK_NO_BARRIER)
        asm volatile("" ::: "memory"); __builtin_amdgcn_s_barrier(); asm volatile("" ::: "memory");
#endif
    }
};

__device__ __forceinline__ unsigned cvt_pk_bf16(float lo, float hi) { unsigned r; asm volatile("v_cvt_pk_bf16_f32 %0, %1, %2" : "=v"(r) : "v"(lo), "v"(hi)); return r; }
typedef float f32x2 __attribute__((ext_vector_type(2)));
__device__ __forceinline__ f32x2 gelu_pk(f32x2 v) {
    const f32x2 av = __builtin_elementwise_abs(v), d = av * 0.2316418882f + 1.0f;
    f32x2 t; t.x = __builtin_amdgcn_rcpf(d.x); t.y = __builtin_amdgcn_rcpf(d.y);
    f32x2 q = t * 0.5307027145f + (-0.7265760135f); q = q * t + 0.7107068705f; q = q * t + (-0.142248368f); q = q * t + 0.127414796f; q = q * t;
    const f32x2 s = (v * v) * (-0.72134752044f);
    f32x2 e; e.x = __builtin_amdgcn_exp2f(s.x); e.y = __builtin_amdgcn_exp2f(s.y);
    const f32x2 m = v * (q * e), r = v - m;
    f32x2 o; o.x = v.x < 0.f ? m.x : r.x; o.y = v.y < 0.f ? m.y : r.y; return o;
}

struct EpiF32 {
    static constexpr bool PERM = false, AFTER_DRAIN = false;
    float* C; int ldc; const float* bias;
    __device__ __forceinline__ void operator()(const f32x4 (&acc)[2][2][4][2], const Unit& u, int wr, int wc, int fr, int fq) const {
        const int row0 = u.pm * BM + wr * 64 + fr, col0 = u.pn * BM + wc * 32 + 4 * fq;
        f32x4 bv[2][2];
#pragma unroll
        for (int bj = 0; bj < 2; ++bj)
#pragma unroll
            for (int n = 0; n < 2; ++n) bv[bj][n] = bias ? *(const f32x4*)(bias + col0 + bj * HALF + n * 16) : (f32x4){0.f, 0.f, 0.f, 0.f};
#pragma unroll
        for (int ai = 0; ai < 2; ++ai)
#pragma unroll
            for (int m = 0; m < 4; ++m) { float* rowp = C + (size_t)(row0 + ai * HALF + m * 16) * ldc + col0;
#pragma unroll
                for (int bj = 0; bj < 2; ++bj)
#pragma unroll
                    for (int n = 0; n < 2; ++n) *(f32x4*)(rowp + bj * HALF + n * 16) = acc[ai][bj][m][n] + bv[bj][n]; }
    }
};
template <int ACT  > struct EpiBf16 {
    static constexpr bool PERM = true, AFTER_DRAIN = false;
    bf16_t* O; int ldc; const float* bias; int split_cols; size_t split_stride;
    __device__ __forceinline__ void operator()(const f32x4 (&acc)[2][2][4][2], const Unit& u, int wr, int wc, int fr, int fq) const {
        const int row0 = u.pm * BM + wr * 64 + fr; int colt = u.pn * BM; bf16_t* base = O;
        if (split_cols) { const int t = colt / split_cols; base += (size_t)t * split_stride; colt -= t * split_cols; }
        const int col0 = colt + wc * 32 + 8 * fq, bcol0 = u.pn * BM + wc * 32 + 8 * fq;
        f32x4 bv[2][2];
#pragma unroll
        for (int bj = 0; bj < 2; ++bj)
#pragma unroll
            for (int n = 0; n < 2; ++n) bv[bj][n] = bias ? *(const f32x4*)(bias + bcol0 + bj * HALF + 4 * n) : (f32x4){0.f, 0.f, 0.f, 0.f};
#pragma unroll
        for (int ai = 0; ai < 2; ++ai)
#pragma unroll
            for (int m = 0; m < 4; ++m) { bf16_t* rowp = base + (size_t)(row0 + ai * HALF + m * 16) * ldc + col0;
#pragma unroll
                for (int bj = 0; bj < 2; ++bj) { f32x4 v0 = acc[ai][bj][m][0] + bv[bj][0], v1 = acc[ai][bj][m][1] + bv[bj][1];
                    if (ACT == 1) { f32x2 a = gelu_pk((f32x2){v0[0], v0[1]}), b = gelu_pk((f32x2){v0[2], v0[3]}), c = gelu_pk((f32x2){v1[0], v1[1]}), d = gelu_pk((f32x2){v1[2], v1[3]});
                        v0 = (f32x4){a.x, a.y, b.x, b.y}; v1 = (f32x4){c.x, c.y, d.x, d.y}; }
                    if (ACT == 2) {
#pragma unroll
                        for (int j = 0; j < 4; ++j) { v0[j] = 0.5f * v0[j] * (1.0f + erff(v0[j] * 0.70710678f)); v1[j] = 0.5f * v1[j] * (1.0f + erff(v1[j] * 0.70710678f)); } }
                    u32x4 w; w.x = cvt_pk_bf16(v0[0], v0[1]); w.y = cvt_pk_bf16(v0[2], v0[3]); w.z = cvt_pk_bf16(v1[0], v1[1]); w.w = cvt_pk_bf16(v1[2], v1[3]);
                    *(u32x4*)(rowp + bj * HALF) = w; } }
    }
};
template <class Epi, class Sched, bool STAMP = false>
__device__ __forceinline__ void gemm_phase(PG8_LAS unsigned char* lds, const Gemm g, const Sched& S, const Epi& E, unsigned long long* stamps, int wave_id) {
    unsigned zz_o = 0u; asm volatile("" : "+v"(zz_o)); int tid_o = wave_id * 64 + (int)__builtin_amdgcn_mbcnt_hi(~0u, __builtin_amdgcn_mbcnt_lo(~0u, zz_o));
    const int tid = tid_o, wid = __builtin_amdgcn_readfirstlane(tid >> 6), lane = tid & 63, wr = wid >> 2, wc = wid & 3, fr = lane & 15, fq = lane >> 4;
    constexpr int K = 2048, nt = K / BK;
    int ts_lo = 0, ts_hi = 0, nts = 0; const unsigned long long rt_entry = STAMP ? (unsigned long long)wall_clock64() : 0ull;
#define PG8_STAMP() do { if (STAMP && wid == 0 && nts < 64) { const unsigned long long _c = (unsigned long long)clock64(); \
        ts_lo = (lane == nts) ? (int)(unsigned)_c : ts_lo; ts_hi = (lane == nts) ? (int)(unsigned)(_c >> 32) : ts_hi; ++nts; } } while (0)
    PG8_STAMP();
    unsigned voffA[2], voffB[2];
#pragma unroll
    for (int i = 0; i < 2; ++i) { int R, C; stage_rc(tid * 16 + i * 8192, R, C); const int Rb = Epi::PERM ? ((R & ~31) + perm32(R & 31)) : R;
        voffA[i] = (unsigned)(R * K + C) * 2u; voffB[i] = (unsigned)(Rb * K + C) * 2u; }
    const size_t kstep = (size_t)(BK * 2);
    const size_t hstep = (size_t)HALF * K * 2;
    const size_t tstep = 2 * hstep;
    const unsigned ldsw = (unsigned)wid * 1024u;
    const int aoff = lds_byte(wr * 64 + fr, fq * 8), boff = lds_byte(wc * 32 + fr, fq * 8);
#define PG8_SA(b, h) (((b) * 2 + (h)) * HTB)
#define PG8_SB(b, h) ((4 + (b) * 2 + (h)) * HTB)
#define PG8_STAGE(bufoff, gbase, voff) do { _Pragma("unroll") for (int _i = 0; _i < 2; ++_i) \
        __builtin_amdgcn_global_load_lds((const unsigned*)((const char*)(gbase) + (voff)[_i]), (PG8_LAS unsigned*)(lds + (bufoff) + ldsw + _i * 8192), 16, 0, 0); } while (0)
#define PG8_LDA(dst, b, h) do { _Pragma("unroll") for (int m = 0; m < 4; ++m) _Pragma("unroll") for (int k = 0; k < 2; ++k) dst[m][k] = *(const PG8_LAS bf16x8*)(lds + PG8_SA(b, h) + aoff + m * 2048 + k * 1024); } while (0)
#define PG8_LDB(dst, b, h) do { _Pragma("unroll") for (int n = 0; n < 2; ++n) _Pragma("unroll") for (int k = 0; k < 2; ++k) dst[n][k] = *(const PG8_LAS bf16x8*)(lds + PG8_SB(b, h) + boff + n * 2048 + k * 1024); } while (0)
#define PG8_MMA(ai, bj, At, Bt) do { __builtin_amdgcn_s_setprio(1); _Pragma("unroll") for (int m = 0; m < 4; ++m) _Pragma("unroll") for (int n = 0; n < 2; ++n) _Pragma("unroll") for (int k = 0; k < 2; ++k) \
        acc[ai][bj][m][n] = __builtin_amdgcn_mfma_f32_16x16x32_bf16(Bt[n][k], At[m][k], acc[ai][bj][m][n], 0, 0, 0); __builtin_amdgcn_s_setprio(0); } while (0)
#define PG8_WAIT_V(n) asm volatile("s_waitcnt vmcnt(" #n ")" ::: "memory")
#define PG8_WAIT_L(n) asm volatile("s_waitcnt lgkmcnt(" #n ")" ::: "memory")
#define PG8_BAR __builtin_amdgcn_s_barrier()
#define PG8_SCHED __builtin_amdgcn_sched_barrier(0)
    Unit cur, nxt; int ui = 0;
    if (!S.next(0, cur)) return;
    f32x4 acc[2][2][4][2];
#pragma unroll
    for (int a = 0; a < 2; ++a)
#pragma unroll
        for (int b = 0; b < 2; ++b)
#pragma unroll
            for (int m = 0; m < 4; ++m)
#pragma unroll
                for (int n = 0; n < 2; ++n) acc[a][b][m][n] = (f32x4){0.f, 0.f, 0.f, 0.f};
    bf16x8 At[4][2], B0[2][2], B1[2][2];
    const char* cA = (const char*)g.A + (size_t)cur.pm * tstep; const char* cB = (const char*)g.Bt + (size_t)cur.pn * tstep;
    S.a_ready(cur);
    PG8_STAGE(PG8_SB(0, 0), cB, voffB); PG8_STAGE(PG8_SA(0, 0), cA, voffA); PG8_STAGE(PG8_SB(0, 1), cB + hstep, voffB); PG8_STAGE(PG8_SA(0, 1), cA + hstep, voffA);
    if (wr == 1) PG8_BAR;
    PG8_WAIT_V(4); PG8_BAR;
    PG8_STAGE(PG8_SB(1, 0), cB + kstep, voffB); PG8_STAGE(PG8_SA(1, 0), cA + kstep, voffA); PG8_STAGE(PG8_SB(1, 1), cB + hstep + kstep, voffB);
    PG8_WAIT_V(6); PG8_BAR;
    PG8_STAMP();
    for (;;) {
        const bool has_next = S.next(ui + 1, nxt);
        const char* nA = has_next ? (const char*)g.A + (size_t)nxt.pm * tstep : cA; const char* nB = has_next ? (const char*)g.Bt + (size_t)nxt.pn * tstep : cB;
        for (int t = 0; t < nt; t += 2) {
            const bool last = (t == nt - 2);
            const char* a1 = cA + (size_t)(t + 1) * kstep;
            const char* a2 = last ? nA : cA + (size_t)(t + 2) * kstep; const char* b2 = last ? nB : cB + (size_t)(t + 2) * kstep;
            const char* a3 = a2 + kstep; const char* b3 = b2 + kstep;
            if (last && has_next) S.a_ready(nxt);
            PG8_LDB(B0, 0, 0); PG8_SCHED; PG8_LDA(At, 0, 0); PG8_STAGE(PG8_SA(1, 1), a1 + hstep, voffA);
            PG8_WAIT_L(8); PG8_BAR; PG8_WAIT_L(0); PG8_MMA(0, 0, At, B0); PG8_BAR; PG8_SCHED;
            PG8_LDB(B1, 0, 1); PG8_STAGE(PG8_SB(0, 0), b2, voffB);
            PG8_BAR; PG8_WAIT_L(0); PG8_MMA(0, 1, At, B1); PG8_BAR;
            PG8_LDA(At, 0, 1); PG8_STAGE(PG8_SA(0, 0), a2, voffA);
            PG8_BAR; PG8_WAIT_L(0); PG8_MMA(1, 0, At, B0); PG8_BAR; PG8_SCHED;
            PG8_STAGE(PG8_SB(0, 1), b2 + hstep, voffB);
            PG8_WAIT_V(6); PG8_BAR; PG8_MMA(1, 1, At, B1); PG8_BAR;
            PG8_LDB(B0, 1, 0); PG8_SCHED; PG8_LDA(At, 1, 0); PG8_STAGE(PG8_SA(0, 1), a2 + hstep, voffA);
            PG8_WAIT_L(8); PG8_BAR; PG8_WAIT_L(0); PG8_MMA(0, 0, At, B0); PG8_BAR; PG8_SCHED;
            PG8_LDB(B1, 1, 1); PG8_STAGE(PG8_SB(1, 0), b3, voffB);
            PG8_BAR; PG8_WAIT_L(0); PG8_MMA(0, 1, At, B1); PG8_BAR;
            PG8_LDA(At, 1, 1); PG8_STAGE(PG8_SA(1, 0), a3, voffA);
            PG8_BAR; PG8_WAIT_L(0); PG8_MMA(1, 0, At, B0); PG8_BAR; PG8_SCHED;
            PG8_STAGE(PG8_SB(1, 1), b3 + hstep, voffB);
            PG8_WAIT_V(6); PG8_BAR; PG8_MMA(1, 1, At, B1); PG8_BAR;
        }
        PG8_STAMP();
        if constexpr (!Epi::AFTER_DRAIN) { E(acc, cur, wr, wc, fr, fq); S.done(cur); }
        PG8_STAMP();
        if (!has_next) break;
#pragma unroll
        for (int a = 0; a < 2; ++a)
#pragma unroll
            for (int b = 0; b < 2; ++b)
#pragma unroll
                for (int m = 0; m < 4; ++m)
#pragma unroll
                    for (int n = 0; n < 2; ++n) acc[a][b][m][n] = (f32x4){0.f, 0.f, 0.f, 0.f};
        cur = nxt; cA = nA; cB = nB; ++ui;
    }
    PG8_WAIT_V(0);
    if (wr == 0) PG8_BAR;
    PG8_BAR;
    if constexpr (Epi::AFTER_DRAIN) { E.fused(acc, cur, wr, wc, fr, fq, lds, wid, lane); S.done(cur); }
    PG8_STAMP();
    if (STAMP && wid == 0) { stamps[lane] = lane < nts ? (((unsigned long long)(unsigned)ts_hi << 32) | (unsigned)ts_lo) : 0ull;
        if (lane == 62) stamps[62] = rt_entry; if (lane == 63) stamps[63] = (unsigned long long)wall_clock64(); }
#undef PG8_STAMP
#undef PG8_SA
#undef PG8_SB
#undef PG8_STAGE
#undef PG8_LDA
#undef PG8_LDB
#undef PG8_MMA
#undef PG8_WAIT_V
#undef PG8_WAIT_L
#undef PG8_BAR
#undef PG8_SCHED
}
}

namespace mk {
#define GAS __attribute__((address_space(1)))
#define LAS __attribute__((address_space(3)))
#define DEV __device__ __forceinline__
typedef unsigned short bf16;
typedef unsigned v4u __attribute__((ext_vector_type(4)));
typedef float f32x4 __attribute__((ext_vector_type(4)));
typedef float f32x2 __attribute__((ext_vector_type(2)));
typedef short bf16x8 __attribute__((ext_vector_type(8)));
typedef float f32x16 __attribute__((ext_vector_type(16)));
typedef __bf16 bf16x2_t __attribute__((ext_vector_type(2)));

#ifndef MK_N_LAUNCHES
#define MK_N_LAUNCHES 1
#endif

constexpr int D = 2048, SEQ = 4096, M = 8192, NL = 2;
constexpr int LRU_W = 768, SWA_W = 768, SB_W = 512, IN_W = 5376;
constexpr int ZO_XA = 0, ZO_GA = 768, ZO_QB = 1536, ZO_KB = 2304, ZO_VB = 3072, ZO_QC = 3840, ZO_KC = 4352, ZO_VC = 4864;
constexpr int NEXP = 16384, MODW = 12288;
constexpr int MO_SH1 = 0, MO_SC1 = 2048, MO_G1 = 4096, MO_SH2 = 6144, MO_SC2 = 8192, MO_G2 = 10240;
constexpr float EPS = 1e-6f;
constexpr float QSCALE = 0.08838834764831845f;
constexpr float NEGBIG = -3.0e38f;
constexpr int NPHASE = 19;

constexpr size_t MiB = 1u << 20;
constexpr size_t WS_CTL = 0, CTL_ZERO_BYTES = 1 * MiB;
constexpr size_t WS_MOD = 512 * 1024;
constexpr size_t WS_WIN_T = 2 * MiB, WS_WOUT_T = 44 * MiB, WS_WQ_T = 60 * MiB, WS_SUBK = 76 * MiB, WS_U = 80 * MiB, WS_V = 208 * MiB,
                 WS_H = 336 * MiB, WS_Z = 368 * MiB, WS_HLOC = 452 * MiB, WS_P = 476 * MiB, WS_YB = 500 * MiB, WS_YC = 524 * MiB,
                 WS_SUMA = 540 * MiB, WS_SUMB = 541 * MiB, WS_X1 = 544 * MiB, WS_X2 = 608 * MiB, WS_Q = 672 * MiB, WS_IDS = 704 * MiB,
                 WS_G = 708 * MiB, WS_WG_T = 77 * MiB, WS_PART = 712 * MiB, WS_LSE = 784 * MiB, WS_XR = 786 * MiB, WS_END = 818 * MiB;
constexpr int CW_BAR = 4096;

constexpr int LDS_BYTES = 147456;
constexpr int LDS_MISC = 143360;

__device__ const unsigned char T5B[3][132] = {
 {0,1,2,3,4,5,6,7,8,9,10,11,12,13,14,15,16,16,16,16,16,16,17,17,17,17,17,17,17,17,18,18,18,18,18,18,18,18,18,18,19,19,19,19,19,19,19,19,19,19,19,19,19,19,20,20,20,20,20,20,20,20,20,20,20,20,20,20,20,20,20,20,20,21,21,21,21,21,21,21,21,21,21,21,21,21,21,21,21,21,21,21,21,21,21,21,21,21,21,22,22,22,22,22,22,22,22,22,22,22,22,22,22,22,22,22,22,22,22,22,22,22,22,22,22,22,22,22,22,0,0,0},
 {0,4,8,12,16,16,17,17,18,18,19,19,19,19,20,20,20,20,20,21,21,21,21,21,21,22,22,22,22,22,22,22,22,22,23,23,23,23,23,23,23,23,23,23,23,23,24,24,24,24,24,24,24,24,24,24,24,24,24,24,24,24,25,25,25,25,25,25,25,25,25,25,25,25,25,25,25,25,25,25,25,25,25,26,26,26,26,26,26,26,26,26,26,26,26,26,26,26,26,26,26,26,26,26,26,26,26,26,26,26,26,26,26,27,27,27,27,27,27,27,27,27,27,27,27,27,27,27,27,0,0,0},
 {0,16,18,19,20,21,21,22,22,23,23,23,24,24,24,24,25,25,25,25,25,26,26,26,26,26,26,26,26,27,27,27,27,27,27,27,27,27,27,28,28,28,28,28,28,28,28,28,28,28,28,28,29,29,29,29,29,29,29,29,29,29,29,29,29,29,29,29,29,29,30,30,30,30,30,30,30,30,30,30,30,30,30,30,30,30,30,30,30,30,30,30,30,30,30,31,31,31,31,31,31,31,31,31,31,31,31,31,31,31,31,31,31,31,31,31,31,31,31,31,31,31,31,31,31,31,31,31,31,0,0,0}};

#define LDS_WAIT() asm volatile("s_waitcnt lgkmcnt(0)" ::: "memory")
DEV unsigned f2bf(float f) { unsigned u = __builtin_bit_cast(unsigned, f); return (u + 0x7fffu + ((u >> 16) & 1u)) >> 16; }
DEV unsigned pk2(float lo, float hi) { return f2bf(lo) | (f2bf(hi) << 16); }
DEV float bf_lo(unsigned w) { return __builtin_bit_cast(float, w << 16); }
DEV float bf_hi(unsigned w) { return __builtin_bit_cast(float, w & 0xffff0000u); }
DEV float bf1(bf16 h) { return __builtin_bit_cast(float, ((unsigned)h) << 16); }
template <int MSK> DEV float swz_xor(float v) { return __builtin_bit_cast(float, __builtin_amdgcn_ds_swizzle(__builtin_bit_cast(int, v), (MSK << 10) | 0x1F)); }
DEV float part32_(float v) { int ln = (int)__builtin_amdgcn_mbcnt_hi(~0u, __builtin_amdgcn_mbcnt_lo(~0u, 0u)); asm volatile("" : "+v"(ln)); return __builtin_bit_cast(float, __builtin_amdgcn_ds_bpermute((ln ^ 32) << 2, __builtin_bit_cast(int, v))); }
DEV float sum32(float v) { return v + part32_(v); }
DEV float max32(float v) { return fmaxf(v, part32_(v)); }
DEV float partner32(float v, int hh) { (void)hh; return part32_(v); }
DEV float wave_sum(float v) { v += swz_xor<1>(v); v += swz_xor<2>(v); v += swz_xor<4>(v); v += swz_xor<8>(v); v += swz_xor<16>(v); return sum32(v); }
DEV float wave_max(float v) { v = fmaxf(v, swz_xor<1>(v)); v = fmaxf(v, swz_xor<2>(v)); v = fmaxf(v, swz_xor<4>(v)); v = fmaxf(v, swz_xor<8>(v)); v = fmaxf(v, swz_xor<16>(v)); return max32(v); }
DEV float sigmoid_f(float x) { return 1.f / (1.f + __expf(-x)); }
DEV float softplus_f(float x) { return fmaxf(x, 0.f) + log1pf(__expf(-fabsf(x))); }
DEV float gelu_tanh(float x) { const float u = 0.7978845608028654f * (x + 0.044715f * x * x * x); const float t = 1.f - 2.f / (1.f + __expf(2.f * u)); return 0.5f * x * (1.f + t); }
DEV float dot8(const v4u a, const v4u b) {
    float s = bf_lo(a.x) * bf_lo(b.x); s += bf_hi(a.x) * bf_hi(b.x);
    s += bf_lo(a.y) * bf_lo(b.y); s += bf_hi(a.y) * bf_hi(b.y);
    s += bf_lo(a.z) * bf_lo(b.z); s += bf_hi(a.z) * bf_hi(b.z);
    s += bf_lo(a.w) * bf_lo(b.w); s += bf_hi(a.w) * bf_hi(b.w);
    return s;
}

#define XB_TMO      128
#define XB_XCNT(j)  (256  + 64 * (j))
#define XB_XSUB(j)  (1280 + 64 * (j))
#define XB_XGEN(j)  (2304 + 64 * (j))
#define XB_TOP      3328
#define XB_TOPGEN   3392
#define XCD_BAR_WORDS 3456
#define XB_SPIN_CAP (1u << 18)

__device__ __forceinline__ unsigned xb_ld(unsigned* p)              { return __hip_atomic_load(p, __ATOMIC_RELAXED, __HIP_MEMORY_SCOPE_AGENT); }
__device__ __forceinline__ unsigned xb_add(unsigned* p, unsigned v) { return __hip_atomic_fetch_add(p, v, __ATOMIC_RELAXED, __HIP_MEMORY_SCOPE_AGENT); }
__device__ __forceinline__ unsigned xb_xcc_id() { return (unsigned)__builtin_amdgcn_s_getreg((3 << 11) | 20) & 0xFu; }
#define XB_SPIN(cond, bar) do { unsigned _sp = 0; while (cond) { __builtin_amdgcn_s_sleep(1); \
    if ((++_sp & 255u) == 0u) { if (xb_ld(&(bar)[XB_TMO])) break; if (_sp > XB_SPIN_CAP) { atomicAdd(&(bar)[XB_TMO], 1u); break; } } } } while (0)

struct XcdBarrier {
    unsigned* bar; unsigned x;
    volatile LAS unsigned* st;
    int w0;
};
DEV bool xb_lead(int w0) { return w0 == 0 && __builtin_amdgcn_mbcnt_hi(~0u, __builtin_amdgcn_mbcnt_lo(~0u, 0u)) == 0u; }
__device__ __forceinline__ XcdBarrier xcd_barrier_post(unsigned* bar, volatile LAS unsigned* st, int w0) {
    XcdBarrier b; b.bar = bar; b.x = xb_xcc_id(); b.st = st; b.w0 = w0;
    if (xb_lead(w0)) (void)xb_add(&bar[XB_XCNT(b.x)], 1u);
    return b;
}
__device__ __forceinline__ void xcd_barrier_complete(unsigned* bar, unsigned x, unsigned& nloc, unsigned& nx) {
    const unsigned G = gridDim.x * gridDim.y * gridDim.z;
    unsigned sum, cnt, mine, sp = 0u;
    for (;;) {
        sum = 0u; cnt = 0u; mine = 0u;
#pragma unroll
        for (unsigned j = 0; j < 16; ++j) { const unsigned c = xb_ld(&bar[XB_XCNT(j)]); sum += c; cnt += (c > 0u) ? 1u : 0u; mine = (j == x) ? c : mine; }
        if (sum == G) break;
        __builtin_amdgcn_s_sleep(1);
        if ((++sp & 255u) == 0u) { if (xb_ld(&bar[XB_TMO])) break; if (sp > XB_SPIN_CAP) { atomicAdd(&bar[XB_TMO], 1u); break; } }
    }
    nloc = mine > 0u ? mine : 1u; nx = cnt > 0u ? cnt : 1u;
}
__device__ __forceinline__ void xcd_barrier(const XcdBarrier& b) {
    asm volatile("s_waitcnt vmcnt(0)" ::: "memory");
    __syncthreads();
    if (xb_lead(b.w0)) {
        unsigned* bar = b.bar;
        __builtin_amdgcn_s_waitcnt(0);
        unsigned nloc = b.st[0], nx = b.st[1];
        if (nloc == 0u) { xcd_barrier_complete(bar, b.x, nloc, nx); b.st[0] = nloc; b.st[1] = nx; }
        const unsigned old = xb_add(&bar[XB_XSUB(b.x)], 1u);
        const unsigned gen = old / nloc;
        if (old + 1u == (gen + 1u) * nloc) {
            __builtin_amdgcn_fence(__ATOMIC_RELEASE, "agent");
            asm volatile("s_waitcnt vmcnt(0)" ::: "memory");
            const unsigned og = xb_add(&bar[XB_TOP], 1u);
            const unsigned tg = og / nx;
            if (og + 1u == (tg + 1u) * nx) xb_add(&bar[XB_TOPGEN], 1u);
            else XB_SPIN(xb_ld(&bar[XB_TOPGEN]) == tg, bar);
            __builtin_amdgcn_fence(__ATOMIC_ACQUIRE, "agent");
            xb_add(&bar[XB_XGEN(b.x)], 1u);
            asm volatile("s_waitcnt vmcnt(0)" ::: "memory");
        } else {
            XB_SPIN(xb_ld(&bar[XB_XGEN(b.x)]) == gen, bar);
            __builtin_amdgcn_fence(__ATOMIC_ACQUIRE, "agent");
            asm volatile("s_waitcnt vmcnt(0)" ::: "memory");
        }
    }
    __syncthreads();
}

struct EpiResGate {
    static constexpr bool PERM = false, AFTER_DRAIN = false;
    const bf16* X; bf16* O; const float* gate; float gscale;
    __device__ __forceinline__ void operator()(const pg8::f32x4 (&acc)[2][2][4][2], const pg8::Unit& u, int wr, int wc, int fr, int fq) const {
        const int row0 = u.pm * 256 + wr * 64 + fr, col0 = u.pn * 256 + wc * 32 + 4 * fq;
        const float* gp = gate + (size_t)((u.pm * 256) >> 12) * MODW;
        pg8::f32x4 gv[2][2];
#pragma unroll
        for (int bj = 0; bj < 2; ++bj)
#pragma unroll
            for (int n = 0; n < 2; ++n) gv[bj][n] = *(const pg8::f32x4*)(gp + col0 + bj * 128 + n * 16) * gscale;
#pragma unroll
        for (int ai = 0; ai < 2; ++ai)
#pragma unroll
            for (int m = 0; m < 4; ++m) {
                const size_t ro = (size_t)(row0 + ai * 128 + m * 16) * D + col0;
#pragma unroll
                for (int bj = 0; bj < 2; ++bj)
#pragma unroll
                    for (int n = 0; n < 2; ++n) {
                        const unsigned long long xw = *(const unsigned long long*)(X + ro + bj * 128 + n * 16);
                        const pg8::f32x4 xv = {bf_lo((unsigned)xw), bf_hi((unsigned)xw), bf_lo((unsigned)(xw >> 32)), bf_hi((unsigned)(xw >> 32))};
                        const pg8::f32x4 ov = xv + gv[bj][n] * acc[ai][bj][m][n];
                        *(unsigned long long*)(O + ro + bj * 128 + n * 16) = (unsigned long long)pk2(ov.x, ov.y) | ((unsigned long long)pk2(ov.z, ov.w) << 32);
                    }
            }
    }
};

DEV void ph_mod(const float* __restrict__ c, const float* __restrict__ w_mod, const float* __restrict__ b_mod, float* __restrict__ mod, LAS float* red, int vcu, int G, int tid) {
    const int lane = tid & 63, wave = tid >> 6;
    for (int it = vcu; it < 2 * 192; it += G) {
        const int l = it / 192, cb = it % 192;
        const int k0 = wave * 256;
        const float* W = w_mod + ((size_t)l * D + k0) * MODW + cb * 64 + lane;
        float a0 = 0.f, a1 = 0.f;
#pragma unroll 16
        for (int k = 0; k < 256; ++k) {
            const float w = W[(size_t)k * MODW];
            const float c0 = c[k0 + k], c1 = c[D + k0 + k];
            a0 += (c0 * sigmoid_f(c0)) * w; a1 += (c1 * sigmoid_f(c1)) * w;
        }
        red[(wave * 2 + 0) * 64 + lane] = a0; red[(wave * 2 + 1) * 64 + lane] = a1;
        __syncthreads();
        if (tid < 128) {
            const int b = tid >> 6, ln = tid & 63; float s = 0.f;
#pragma unroll
            for (int w = 0; w < 8; ++w) s += red[(w * 2 + b) * 64 + ln];
            const int col = cb * 64 + ln;
            mod[(size_t)(l * 2 + b) * MODW + col] = s + b_mod[l * MODW + col];
        }
        __syncthreads();
    }
}
DEV void transpose_item(const float* __restrict__ W, int K, int N, bf16* __restrict__ WT, LAS float* scr, int item, int lane) {
    const int nblk = N / 32, kb = item / nblk, nb = item % nblk, k0 = 64 * kb, n0 = 32 * nb;
#pragma unroll 8
    for (int i = 0; i < 32; ++i) { const int kk = 2 * i + (lane >> 5); scr[kk * 33 + (lane & 31)] = W[(size_t)(k0 + kk) * N + n0 + (lane & 31)]; }
    LDS_WAIT();
    const int c = lane & 7;
#pragma unroll
    for (int j = 0; j < 4; ++j) { const int n = (lane >> 3) + 8 * j; const LAS float* s = scr + (8 * c) * 33 + n;
        v4u o; o.x = pk2(s[0 * 33], s[1 * 33]); o.y = pk2(s[2 * 33], s[3 * 33]); o.z = pk2(s[4 * 33], s[5 * 33]); o.w = pk2(s[6 * 33], s[7 * 33]);
        *(v4u*)(WT + (size_t)(n0 + n) * K + k0 + 8 * c) = o; }
    LDS_WAIT();
}

DEV void transpose_item64(const float* __restrict__ W, int K, int N, bf16* __restrict__ WT, LAS float* scr, int item, int lane) {
    const int nblk = N / 64, kb = item / nblk, nb = item % nblk, k0 = 64 * kb, n0 = 64 * nb;
#pragma unroll 8
    for (int i = 0; i < 16; ++i) { const int kk = 4 * i + (lane >> 4), nn = 4 * (lane & 15);
        const f32x4 w = *(const f32x4*)(W + (size_t)(k0 + kk) * N + n0 + nn);
        LAS float* d = scr + kk * 65 + nn; d[0] = w.x; d[1] = w.y; d[2] = w.z; d[3] = w.w; }
    LDS_WAIT();
#pragma unroll
    for (int jj = 0; jj < 8; ++jj) { const int pz = lane + 64 * jj, n = pz >> 3, c = pz & 7; const LAS float* sp = scr + (8 * c) * 65 + n;
        v4u o; o.x = pk2(sp[0 * 65], sp[1 * 65]); o.y = pk2(sp[2 * 65], sp[3 * 65]); o.z = pk2(sp[4 * 65], sp[5 * 65]); o.w = pk2(sp[6 * 65], sp[7 * 65]);
        *(v4u*)(WT + (size_t)(n0 + n) * K + k0 + 8 * c) = o; }
    LDS_WAIT();
}
DEV void convert_copy(const float* __restrict__ src, bf16* __restrict__ dst, size_t ngroups8, size_t gtid, size_t gstride) {
    for (size_t g = gtid; g < ngroups8; g += gstride) {
        const f32x4 a = *(const f32x4*)(src + g * 8), b = *(const f32x4*)(src + g * 8 + 4);
        v4u o; o.x = pk2(a.x, a.y); o.y = pk2(a.z, a.w); o.z = pk2(b.x, b.y); o.w = pk2(b.z, b.w);
        *(v4u*)(dst + g * 8) = o;
    }
}

DEV void modnorm_rows(const float* __restrict__ X, const float* __restrict__ gain, const float* __restrict__ modl, int sh_off, int sc_off, bf16* __restrict__ H, int gw, int NGW, int lane, bf16* __restrict__ XC = nullptr) {
    for (int m = gw; m < M; m += NGW) {
        const int b = m >> 12;
        const f32x4* xr = (const f32x4*)(X + (size_t)m * D) + lane;
        f32x4 v[8]; float s = 0.f;
#pragma unroll
        for (int j = 0; j < 8; ++j) { v[j] = xr[64 * j]; s += (v[j].x * v[j].x + v[j].y * v[j].y) + (v[j].z * v[j].z + v[j].w * v[j].w); }
        const float r = rsqrtf(wave_sum(s) * (1.f / D) + EPS);
        const f32x4* g4 = (const f32x4*)gain + lane;
        const f32x4* sc4 = (const f32x4*)(modl + (size_t)b * MODW + sc_off) + lane;
        const f32x4* sh4 = (const f32x4*)(modl + (size_t)b * MODW + sh_off) + lane;
        unsigned long long* o8 = (unsigned long long*)(H + (size_t)m * D) + lane;
#pragma unroll
        for (int j = 0; j < 8; ++j) {
            const f32x4 g = g4[64 * j], sc = sc4[64 * j], sh = sh4[64 * j];
            const f32x4 y = (v[j] * r) * g * (sc + 1.f) + sh;
            o8[64 * j] = (unsigned long long)pk2(y.x, y.y) | ((unsigned long long)pk2(y.z, y.w) << 32);
            if (XC) ((unsigned long long*)(XC + (size_t)m * D) + lane)[64 * j] = (unsigned long long)pk2(v[j].x, v[j].y) | ((unsigned long long)pk2(v[j].z, v[j].w) << 32);
        }
    }
}
DEV void modnorm_rows_h(const bf16* __restrict__ X, const float* __restrict__ gain, const float* __restrict__ modl, int sh_off, int sc_off, bf16* __restrict__ H, int gw, int NGW, int lane) {
    for (int m = gw; m < M; m += NGW) {
        const int b = m >> 12;
        const v4u* xr = (const v4u*)(X + (size_t)m * D) + lane;
        float v[32]; float s = 0.f;
#pragma unroll
        for (int j = 0; j < 4; ++j) { const v4u w = xr[64 * j];
            v[8 * j + 0] = bf_lo(w.x); v[8 * j + 1] = bf_hi(w.x); v[8 * j + 2] = bf_lo(w.y); v[8 * j + 3] = bf_hi(w.y); v[8 * j + 4] = bf_lo(w.z); v[8 * j + 5] = bf_hi(w.z); v[8 * j + 6] = bf_lo(w.w); v[8 * j + 7] = bf_hi(w.w);
#pragma unroll
            for (int e = 0; e < 8; ++e) s += v[8 * j + e] * v[8 * j + e]; }
        const float r = rsqrtf(wave_sum(s) * (1.f / D) + EPS);
        const float* scp = modl + (size_t)b * MODW + sc_off; const float* shp = modl + (size_t)b * MODW + sh_off;
        v4u* o16 = (v4u*)(H + (size_t)m * D) + lane;
#pragma unroll
        for (int j = 0; j < 4; ++j) { const int col = 8 * (lane + 64 * j);
            const f32x4 g0 = *(const f32x4*)(gain + col), g1 = *(const f32x4*)(gain + col + 4), c0 = *(const f32x4*)(scp + col), c1 = *(const f32x4*)(scp + col + 4), h0 = *(const f32x4*)(shp + col), h1 = *(const f32x4*)(shp + col + 4);
            v4u o;
            o.x = pk2(v[8 * j + 0] * r * g0.x * (c0.x + 1.f) + h0.x, v[8 * j + 1] * r * g0.y * (c0.y + 1.f) + h0.y); o.y = pk2(v[8 * j + 2] * r * g0.z * (c0.z + 1.f) + h0.z, v[8 * j + 3] * r * g0.w * (c0.w + 1.f) + h0.w);
            o.z = pk2(v[8 * j + 4] * r * g1.x * (c1.x + 1.f) + h1.x, v[8 * j + 5] * r * g1.y * (c1.y + 1.f) + h1.y); o.w = pk2(v[8 * j + 6] * r * g1.z * (c1.z + 1.f) + h1.z, v[8 * j + 7] * r * g1.w * (c1.w + 1.f) + h1.w);
            o16[64 * j] = o; }
    }
}


DEV unsigned cvtpk_bf16(float lo, float hi) { f32x2 v = {lo, hi}; bf16x2_t b = __builtin_convertvector(v, bf16x2_t); return __builtin_bit_cast(unsigned, b); }
constexpr int DIL_VSTR = 256;
constexpr int ATT_KOFF = 32 * DIL_VSTR;
constexpr int ATT_BOFF = ATT_KOFF + 8192;
constexpr int DIL_QOFF = ATT_BOFF + 132 * 4;
constexpr int ATT_WLDS = 17920;
static_assert(DIL_QOFF <= ATT_WLDS && 8 * ATT_WLDS <= LDS_MISC, "attention LDS");

DEV unsigned vimg_off(unsigned row, unsigned ch) { return 256u * row + 16u * (ch ^ (((row & 3u) << 2) | ((row >> 2) & 3u))); }
typedef short s16x4 __attribute__((ext_vector_type(4)));
DEV bf16x8 vfrag_tr(LAS unsigned char* img, int lane, int c, int ks) {
    const unsigned h = lane >> 5, blk = (lane >> 4) & 1, qq = (lane & 15) >> 2, pp = lane & 3;
    const s16x4 a = __builtin_amdgcn_ds_read_tr16_b64_v4i16((LAS s16x4*)(img + vimg_off(16 * ks + 8 * h + 0 + qq, 4 * c + 2 * blk + (pp >> 1)) + 8 * (pp & 1)));
    const s16x4 b = __builtin_amdgcn_ds_read_tr16_b64_v4i16((LAS s16x4*)(img + vimg_off(16 * ks + 8 * h + 4 + qq, 4 * c + 2 * blk + (pp >> 1)) + 8 * (pp & 1)));
    return __builtin_shufflevector(a, b, 0, 1, 2, 3, 4, 5, 6, 7);
}
DEV void dil_mfma_item(int b, int h, int p, int rr, int i0, const bf16* __restrict__ Z, const float* __restrict__ rel_bias, bf16* __restrict__ PART, float* __restrict__ LSE, LAS unsigned char* wl, int lane) {
    asm volatile("" : "+v"(lane));
    const int r = lane & 31, hh = lane >> 5;
    const int d = 1 << (2 * p);
    LAS float* biasL = (LAS float*)(wl + ATT_BOFF);
    for (int dd = lane; dd < 129; dd += 64) biasL[dd] = rel_bias[(int)T5B[p][dd] * 6 + h];
    const size_t rowq = (size_t)b * SEQ + rr + d * (i0 + r);
    bf16x8 qf[8];
    { const bf16* qrow = Z + rowq * IN_W + ZO_QB + h * 128 + 8 * hh;
#pragma unroll
      for (int ks = 0; ks < 8; ++ks) qf[ks] = *(const bf16x8*)(qrow + 16 * ks); }
    float m_run = NEGBIG, l_run = 0.f;
    f32x16 o[4];
#pragma unroll
    for (int dt = 0; dt < 4; ++dt)
#pragma unroll
        for (int e = 0; e < 16; ++e) o[dt][e] = 0.f;
    const int kap = (r & 0x13) | ((r & 4) << 1) | ((r & 8) >> 1);
    int jt = 4 - (i0 >> 5); jt = jt < 0 ? 0 : jt;
#define DIL_DMA_K(JT) do { int jk = i0 - 128 + 32 * (JT) + kap; jk = jk < 0 ? 0 : jk; const bf16* krow = Z + ((size_t)b * SEQ + rr + d * jk) * IN_W + ZO_KB + h * 128 + 8 * hh; \
        _Pragma("unroll") for (int ks = 0; ks < 8; ++ks) __builtin_amdgcn_global_load_lds((const unsigned*)(krow + 16 * ks), (LAS unsigned*)(wl + ATT_KOFF + 1024 * ks), 16, 0, 0); } while (0)
#define DIL_DMA_V(JT) do { const int j0_ = i0 - 128 + 32 * (JT); _Pragma("unroll") for (int q = 0; q < 8; ++q) { const int pi = lane + 64 * q, kl = pi >> 4, c = (pi & 15) ^ (((kl & 3) << 2) | ((kl >> 2) & 3)); int j = j0_ + kl; j = j < 0 ? 0 : j; \
        __builtin_amdgcn_global_load_lds((const unsigned*)(Z + ((size_t)b * SEQ + rr + d * j) * IN_W + ZO_VB + h * 128 + 8 * c), (LAS unsigned*)(wl + 1024 * q), 16, 0, 0); } } while (0)
    LDS_WAIT();
    DIL_DMA_K(jt); DIL_DMA_V(jt);
    for (; jt < 5; ++jt) {
        const int j0 = i0 - 128 + 32 * jt;
        const int jn = jt < 4 ? jt + 1 : 4;
        asm volatile("s_waitcnt vmcnt(8)" ::: "memory");
        f32x16 sacc;
#pragma unroll
        for (int e = 0; e < 16; ++e) sacc[e] = 0.f;
        {
            bf16x8 kf[8];
#pragma unroll
            for (int ks = 0; ks < 8; ++ks) kf[ks] = *((const LAS bf16x8*)(wl + ATT_KOFF + 1024 * ks) + lane);
#pragma unroll
            for (int ks = 0; ks < 8; ++ks) sacc = __builtin_amdgcn_mfma_f32_32x32x16_bf16(kf[ks], qf[ks], sacc, 0, 0, 0);
        }
        LDS_WAIT();
        DIL_DMA_K(jn);
        float tm = NEGBIG;
#pragma unroll
        for (int e = 0; e < 16; ++e) {
            const int j = j0 + 16 * (e >> 3) + 8 * hh + (e & 7);
            const int dist = (i0 + r) - j;
            const bool valid = (j >= 0) && (dist >= 0) && (dist <= 128);
            const int dc = dist < 0 ? 0 : (dist > 128 ? 128 : dist);
            const float bv = *(volatile LAS float*)(biasL + dc);
            const float lg = valid ? sacc[e] * QSCALE + bv : NEGBIG;
            sacc[e] = lg; tm = fmaxf(tm, lg);
        }
        tm = max32(tm);
        const float m_new = fmaxf(m_run, tm);
        const float alpha = __expf(m_run - m_new);
        float ps = 0.f;
#pragma unroll
        for (int e = 0; e < 16; ++e) { const float pv = (sacc[e] > -1.0e37f) ? __expf(sacc[e] - m_new) : 0.f; sacc[e] = pv; ps += pv; }
        ps = sum32(ps);
        l_run = l_run * alpha + ps; m_run = m_new;
#pragma unroll
        for (int dt = 0; dt < 4; ++dt)
#pragma unroll
            for (int e = 0; e < 16; ++e) o[dt][e] *= alpha;
        bf16x8 pf[2];
#pragma unroll
        for (int s2 = 0; s2 < 2; ++s2) { v4u w; w.x = cvtpk_bf16(sacc[8 * s2 + 0], sacc[8 * s2 + 1]); w.y = cvtpk_bf16(sacc[8 * s2 + 2], sacc[8 * s2 + 3]);
            w.z = cvtpk_bf16(sacc[8 * s2 + 4], sacc[8 * s2 + 5]); w.w = cvtpk_bf16(sacc[8 * s2 + 6], sacc[8 * s2 + 7]); pf[s2] = __builtin_bit_cast(bf16x8, w); }
        asm volatile("s_waitcnt vmcnt(8)" ::: "memory");
#pragma unroll
        for (int dt = 0; dt < 4; ++dt)
#pragma unroll
            for (int s2 = 0; s2 < 2; ++s2) o[dt] = __builtin_amdgcn_mfma_f32_32x32x16_bf16(vfrag_tr(wl, lane, dt, s2), pf[s2], o[dt], 0, 0, 0);
        LDS_WAIT();
        DIL_DMA_V(jn);
    }
    asm volatile("s_waitcnt vmcnt(0)" ::: "memory");
#undef DIL_DMA_V
#undef DIL_DMA_K
    const float inv = 1.f / l_run;
    bf16* po = PART + ((size_t)p * M + rowq) * SWA_W + h * 128;
#pragma unroll
    for (int dt = 0; dt < 4; ++dt)
#pragma unroll
        for (int g = 0; g < 4; ++g)
            *(unsigned long long*)(po + 32 * dt + 8 * g + 4 * hh) = (unsigned long long)pk2(o[dt][4 * g + 0] * inv, o[dt][4 * g + 1] * inv) | ((unsigned long long)pk2(o[dt][4 * g + 2] * inv, o[dt][4 * g + 3] * inv) << 32);
    if (hh == 0) LSE[((size_t)p * M + rowq) * 6 + h] = m_run + __logf(l_run);
}


DEV void lru_item2(int l, int b, int j, int n, const bf16* __restrict__ Z, const float* __restrict__ conv_w, const float* __restrict__ conv_b, const bf16* __restrict__ WGT,
                   const float* __restrict__ b_rec, const float* __restrict__ b_gi, const float* __restrict__ lam,
                   bf16* __restrict__ HLOC, bf16* __restrict__ PP, float* __restrict__ SUMA, float* __restrict__ SUMB, LAS float* xc, LAS float* g0L, LAS float* g1L, int tid) {
    const int ch = tid & 127, tq = tid >> 7, c = n * 128 + ch;
    {
        LAS unsigned char* xaL = (LAS unsigned char*)(g1L + 64 * 132);
        const int t0 = j * 64;
#pragma unroll
        for (int i = 0; i < 3; ++i) { const int pz = tid + 512 * i; if (pz < 67 * 16) { const int row = pz >> 4, cc = pz & 15; const int t = t0 - 3 + row;
            v4u w = {0u, 0u, 0u, 0u}; if (t >= 0) w = *(const v4u*)(Z + ((size_t)b * SEQ + t) * IN_W + ZO_XA + n * 128 + 8 * cc);
            *(LAS v4u*)(xaL + row * 256 + cc * 16) = w; } }
        __syncthreads();
        const float cw0 = conv_w[(l * 4 + 0) * LRU_W + c], cw1 = conv_w[(l * 4 + 1) * LRU_W + c], cw2 = conv_w[(l * 4 + 2) * LRU_W + c], cw3 = conv_w[(l * 4 + 3) * LRU_W + c];
        const float cb = conv_b[l * LRU_W + c];
        const LAS bf16* xp = (const LAS bf16*)xaL + ch;
#pragma unroll 4
        for (int i = 0; i < 16; ++i) {
            const int tok = tq + 4 * i;
            xc[tok * 132 + ch] = cb + cw0 * bf1(xp[(tok + 0) * 128]) + cw1 * bf1(xp[(tok + 1) * 128]) + cw2 * bf1(xp[(tok + 2) * 128]) + cw3 * bf1(xp[(tok + 3) * 128]);
        }
    }
    __syncthreads();
    {
        const int lane = tid & 63, wave = tid >> 6, r = lane & 31, hh = lane >> 5, g = wave >> 2, ct = wave & 3;
        const bf16* wp = WGT + (((size_t)(l * 6 + n) * 2 + g) * 128 + ct * 32 + r) * 128 + 8 * hh;
        bf16x8 bfr[8];
#pragma unroll
        for (int ks = 0; ks < 8; ++ks) bfr[ks] = *(const bf16x8*)(wp + 16 * ks);
        LAS float* gL = g ? g1L : g0L;
#pragma unroll
        for (int rt = 0; rt < 2; ++rt) {
            f32x16 acc;
#pragma unroll
            for (int e = 0; e < 16; ++e) acc[e] = 0.f;
#pragma unroll
            for (int ks = 0; ks < 8; ++ks) {
                const LAS float* xp = xc + (32 * rt + r) * 132 + 16 * ks + 8 * hh;
                const f32x4 x0 = *(const LAS f32x4*)xp, x1 = *(const LAS f32x4*)(xp + 4);
                v4u w; w.x = cvtpk_bf16(x0.x, x0.y); w.y = cvtpk_bf16(x0.z, x0.w); w.z = cvtpk_bf16(x1.x, x1.y); w.w = cvtpk_bf16(x1.z, x1.w);
                acc = __builtin_amdgcn_mfma_f32_32x32x16_bf16(__builtin_bit_cast(bf16x8, w), bfr[ks], acc, 0, 0, 0);
            }
#pragma unroll
            for (int e = 0; e < 16; ++e) { const int tok = 32 * rt + (e & 3) + 8 * (e >> 2) + 4 * hh; gL[tok * 132 + ct * 32 + r] = acc[e]; }
        }
    }
    __syncthreads();
    {
        const float br = b_rec[l * LRU_W + c], bi = b_gi[l * LRU_W + c], sp = softplus_f(-lam[l * LRU_W + c]);
#pragma unroll 4
        for (int i = 0; i < 16; ++i) {
            const int tok = tq + 4 * i;
            const float rg = sigmoid_f(g0L[tok * 132 + ch] + br), ig = sigmoid_f(g1L[tok * 132 + ch] + bi);
            const float log_a = -8.0f * rg * sp;
            const float av = __expf(log_a);
            const float x = xc[tok * 132 + ch];
            const float uv = sqrtf(fmaxf(-expm1f(2.f * log_a), 0.f)) * (ig * x);
            g0L[tok * 132 + ch] = av; g1L[tok * 132 + ch] = uv;
        }
    }
    __syncthreads();
    if (tid < 128) {
        float h = 0.f, P = 1.f;
        const size_t rb = ((size_t)b * SEQ + j * 64) * LRU_W + n * 128 + tid;
#pragma unroll 8
        for (int tok = 0; tok < 64; ++tok) {
            const float av = g0L[tok * 132 + tid];
            h = av * h + g1L[tok * 132 + tid]; P *= av;
            HLOC[rb + (size_t)tok * LRU_W] = (bf16)f2bf(h); PP[rb + (size_t)tok * LRU_W] = (bf16)f2bf(P);
        }
        SUMA[(size_t)(b * 64 + j) * LRU_W + n * 128 + tid] = P; SUMB[(size_t)(b * 64 + j) * LRU_W + n * 128 + tid] = h;
    }
    __syncthreads();
}

DEV void sb_mfma_item(int b, int h, int t0, const bf16* __restrict__ Z, bf16* __restrict__ YC, LAS unsigned char* wl, int lane) {
    asm volatile("" : "+v"(lane));
    const int r = lane & 31, hh = lane >> 5;
    const size_t rowq = (size_t)b * SEQ + t0 + r;
    bf16x8 qf[8];
    { const bf16* qrow = Z + rowq * IN_W + ZO_QC + h * 128 + 8 * hh;
#pragma unroll
      for (int ks = 0; ks < 8; ++ks) qf[ks] = *(const bf16x8*)(qrow + 16 * ks); }
    f32x16 o[4];
#pragma unroll
    for (int dt = 0; dt < 4; ++dt)
#pragma unroll
        for (int e = 0; e < 16; ++e) o[dt][e] = 0.f;
    const int kap = (r & 0x13) | ((r & 4) << 1) | ((r & 8) >> 1);
    float carry = 0.f;
#define SB_DMA_K(K0) do { const bf16* krow = Z + ((size_t)b * SEQ + (K0) + kap) * IN_W + ZO_KC + h * 128 + 8 * hh; \
        _Pragma("unroll") for (int ks = 0; ks < 8; ++ks) __builtin_amdgcn_global_load_lds((const unsigned*)(krow + 16 * ks), (LAS unsigned*)(wl + ATT_KOFF + 1024 * ks), 16, 0, 0); } while (0)
#define SB_DMA_V(K0) do { _Pragma("unroll") for (int q = 0; q < 8; ++q) { const int pi = lane + 64 * q, kl = pi >> 4, c = (pi & 15) ^ (((kl & 3) << 2) | ((kl >> 2) & 3)); \
        __builtin_amdgcn_global_load_lds((const unsigned*)(Z + ((size_t)b * SEQ + (K0) + kl) * IN_W + ZO_VC + h * 128 + 8 * c), (LAS unsigned*)(wl + 1024 * q), 16, 0, 0); } } while (0)
    LDS_WAIT();
    SB_DMA_K(t0); SB_DMA_V(t0);
    for (int k0 = t0; k0 >= 0; k0 -= 32) {
        const int kn = k0 >= 32 ? k0 - 32 : 0;
        asm volatile("s_waitcnt vmcnt(8)" ::: "memory");
        f32x16 sacc;
#pragma unroll
        for (int e = 0; e < 16; ++e) sacc[e] = 0.f;
        {
            bf16x8 kf[8];
#pragma unroll
            for (int ks = 0; ks < 8; ++ks) kf[ks] = *((const LAS bf16x8*)(wl + ATT_KOFF + 1024 * ks) + lane);
#pragma unroll
            for (int ks = 0; ks < 8; ++ks) sacc = __builtin_amdgcn_mfma_f32_32x32x16_bf16(kf[ks], qf[ks], sacc, 0, 0, 0);
        }
        LDS_WAIT();
        SB_DMA_K(kn);
        float l1[16]; float T0 = 0.f, T1 = 0.f;
#pragma unroll
        for (int e = 0; e < 16; ++e) {
            const int key = k0 + 16 * (e >> 3) + 8 * hh + (e & 7);
            const bool valid = key < t0 + r;
            const float z = sacc[e] * QSCALE;
            sacc[e] = z;
            l1[e] = valid ? -(fmaxf(z, 0.f) + __logf(1.f + __expf(-fabsf(z)))) : 0.f;
        }
#pragma unroll
        for (int e = 0; e < 8; ++e) { T0 += l1[e]; T1 += l1[8 + e]; }
        const float PT0 = partner32(T0, hh), PT1 = partner32(T1, hh);
        const float base1 = carry + (hh ? 0.f : PT1);
        const float base0 = carry + (hh ? (T1 + PT1) : (PT1 + T1 + PT0));
        float run1 = base1, run0 = base0;
#pragma unroll
        for (int e = 7; e >= 0; --e) {
            { const int key = k0 + 16 + 8 * hh + e; const bool valid = key < t0 + r; const float a = valid ? __expf(sacc[8 + e] + l1[8 + e] + run1) : 0.f; run1 += l1[8 + e]; sacc[8 + e] = a; }
            { const int key = k0 + 8 * hh + e; const bool valid = key < t0 + r; const float a = valid ? __expf(sacc[e] + l1[e] + run0) : 0.f; run0 += l1[e]; sacc[e] = a; }
        }
        carry += (T0 + T1) + (PT0 + PT1);
        bf16x8 pf[2];
#pragma unroll
        for (int s2 = 0; s2 < 2; ++s2) { v4u w; w.x = cvtpk_bf16(sacc[8 * s2 + 0], sacc[8 * s2 + 1]); w.y = cvtpk_bf16(sacc[8 * s2 + 2], sacc[8 * s2 + 3]);
            w.z = cvtpk_bf16(sacc[8 * s2 + 4], sacc[8 * s2 + 5]); w.w = cvtpk_bf16(sacc[8 * s2 + 6], sacc[8 * s2 + 7]); pf[s2] = __builtin_bit_cast(bf16x8, w); }
        asm volatile("s_waitcnt vmcnt(8)" ::: "memory");
#pragma unroll
        for (int dt = 0; dt < 4; ++dt)
#pragma unroll
            for (int s2 = 0; s2 < 2; ++s2) o[dt] = __builtin_amdgcn_mfma_f32_32x32x16_bf16(vfrag_tr(wl, lane, dt, s2), pf[s2], o[dt], 0, 0, 0);
        LDS_WAIT();
        SB_DMA_V(kn);
        if (__all(carry < -105.0f)) break;
    }
    asm volatile("s_waitcnt vmcnt(0)" ::: "memory");
#undef SB_DMA_V
#undef SB_DMA_K
    bf16* po = YC + rowq * SB_W + h * 128;
#pragma unroll
    for (int dt = 0; dt < 4; ++dt)
#pragma unroll
        for (int g = 0; g < 4; ++g)
            *(unsigned long long*)(po + 32 * dt + 8 * g + 4 * hh) = (unsigned long long)pk2(o[dt][4 * g + 0], o[dt][4 * g + 1]) | ((unsigned long long)pk2(o[dt][4 * g + 2], o[dt][4 * g + 3]) << 32);
}

DEV void combine_item(int l, int b, int j, int half, const bf16* __restrict__ Z, const bf16* __restrict__ HLOC, const bf16* __restrict__ PP, const float* __restrict__ SUMA, const float* __restrict__ SUMB,
                      const bf16* __restrict__ PART, const float* __restrict__ LSE, const bf16* __restrict__ YC, const float* __restrict__ g_lru, const float* __restrict__ g_swa, const float* __restrict__ g_sb,
                      bf16* __restrict__ Y, LAS float* carryL, int tid) {
    const int lane = tid & 63, wave = tid >> 6;
    for (int c = tid; c < LRU_W; c += 512) {
        float cr = 0.f; int i = 0;
        for (; i + 8 <= j; i += 8) {
            float av[8], bv[8];
#pragma unroll
            for (int u = 0; u < 8; ++u) { av[u] = SUMA[(size_t)(b * 64 + i + u) * LRU_W + c]; bv[u] = SUMB[(size_t)(b * 64 + i + u) * LRU_W + c]; }
#pragma unroll
            for (int u = 0; u < 8; ++u) cr = av[u] * cr + bv[u];
        }
        for (; i < j; ++i) cr = SUMA[(size_t)(b * 64 + i) * LRU_W + c] * cr + SUMB[(size_t)(b * 64 + i) * LRU_W + c];
        carryL[c] = cr;
    }
    __syncthreads();
    for (int i = 0; i < 4; ++i) {
        const int tok = half * 32 + wave * 4 + i;
        const size_t row = (size_t)b * SEQ + j * 64 + tok;
        bf16* yo = Y + row * D;
        {
            float ya[12]; float ssq = 0.f;
#pragma unroll
            for (int e = 0; e < 6; ++e) { const int c = 2 * lane + 128 * e;
                const unsigned hw = *(const unsigned*)(HLOC + row * LRU_W + c), pw = *(const unsigned*)(PP + row * LRU_W + c), gw2 = *(const unsigned*)(Z + row * IN_W + ZO_GA + c);
                const f32x2 cr = *(const LAS f32x2*)(carryL + c);
                ya[2 * e] = (bf_lo(hw) + bf_lo(pw) * cr.x) * gelu_tanh(bf_lo(gw2)); ya[2 * e + 1] = (bf_hi(hw) + bf_hi(pw) * cr.y) * gelu_tanh(bf_hi(gw2));
                ssq += ya[2 * e] * ya[2 * e] + ya[2 * e + 1] * ya[2 * e + 1]; }
            const float r = rsqrtf(wave_sum(ssq) * (1.f / LRU_W) + EPS);
#pragma unroll
            for (int e = 0; e < 6; ++e) { const int c = 2 * lane + 128 * e; const f32x2 g = *(const f32x2*)(g_lru + l * LRU_W + c);
                *(unsigned*)(yo + c) = pk2(ya[2 * e] * r * g.x, ya[2 * e + 1] * r * g.y); }
        }
        {
            float yb[12]; float ssq = 0.f;
#pragma unroll
            for (int e = 0; e < 6; ++e) { const int c = 2 * lane + 128 * e;
                const float l0 = LSE[((size_t)0 * M + row) * 6 + e], l1 = LSE[((size_t)1 * M + row) * 6 + e], l2 = LSE[((size_t)2 * M + row) * 6 + e];
                const float mx = fmaxf(l0, fmaxf(l1, l2)); const float e0 = __expf(l0 - mx), e1 = __expf(l1 - mx), e2 = __expf(l2 - mx); const float iz = 1.f / (e0 + e1 + e2);
                const unsigned p0 = *(const unsigned*)(PART + ((size_t)0 * M + row) * SWA_W + c), p1 = *(const unsigned*)(PART + ((size_t)1 * M + row) * SWA_W + c), p2 = *(const unsigned*)(PART + ((size_t)2 * M + row) * SWA_W + c);
                yb[2 * e] = (e0 * bf_lo(p0) + e1 * bf_lo(p1) + e2 * bf_lo(p2)) * iz; yb[2 * e + 1] = (e0 * bf_hi(p0) + e1 * bf_hi(p1) + e2 * bf_hi(p2)) * iz;
                ssq += yb[2 * e] * yb[2 * e] + yb[2 * e + 1] * yb[2 * e + 1]; }
            const float r = rsqrtf(wave_sum(ssq) * (1.f / SWA_W) + EPS);
#pragma unroll
            for (int e = 0; e < 6; ++e) { const int c = 2 * lane + 128 * e; const f32x2 g = *(const f32x2*)(g_swa + l * SWA_W + c);
                *(unsigned*)(yo + LRU_W + c) = pk2(yb[2 * e] * r * g.x, yb[2 * e + 1] * r * g.y); }
        }
        {
            float yc[8]; float ssq = 0.f;
#pragma unroll
            for (int e = 0; e < 4; ++e) { const int c = 2 * lane + 128 * e; const unsigned w = *(const unsigned*)(YC + row * SB_W + c); yc[2 * e] = bf_lo(w); yc[2 * e + 1] = bf_hi(w); ssq += yc[2 * e] * yc[2 * e] + yc[2 * e + 1] * yc[2 * e + 1]; }
            const float r = rsqrtf(wave_sum(ssq) * (1.f / SB_W) + EPS);
#pragma unroll
            for (int e = 0; e < 4; ++e) { const int c = 2 * lane + 128 * e; const f32x2 g = *(const f32x2*)(g_sb + l * SB_W + c);
                *(unsigned*)(yo + LRU_W + SWA_W + c) = pk2(yc[2 * e] * r * g.x, yc[2 * e + 1] * r * g.y); }
        }
    }
    __syncthreads();
}


constexpr float U8_SCALE = 64.f;
DEV void convert_fp8(const float* __restrict__ src, unsigned char* __restrict__ dst, size_t ngroups16, size_t gtid, size_t gstride, float scale) {
    for (size_t g = gtid; g < ngroups16; g += gstride) {
        const f32x4 a = *(const f32x4*)(src + g * 16) * scale, b = *(const f32x4*)(src + g * 16 + 4) * scale, c = *(const f32x4*)(src + g * 16 + 8) * scale, d = *(const f32x4*)(src + g * 16 + 12) * scale;
        int w0 = 0, w1 = 0, w2 = 0, w3 = 0;
        w0 = __builtin_amdgcn_cvt_pk_fp8_f32(a.x, a.y, w0, false); w0 = __builtin_amdgcn_cvt_pk_fp8_f32(a.z, a.w, w0, true);
        w1 = __builtin_amdgcn_cvt_pk_fp8_f32(b.x, b.y, w1, false); w1 = __builtin_amdgcn_cvt_pk_fp8_f32(b.z, b.w, w1, true);
        w2 = __builtin_amdgcn_cvt_pk_fp8_f32(c.x, c.y, w2, false); w2 = __builtin_amdgcn_cvt_pk_fp8_f32(c.z, c.w, w2, true);
        w3 = __builtin_amdgcn_cvt_pk_fp8_f32(d.x, d.y, w3, false); w3 = __builtin_amdgcn_cvt_pk_fp8_f32(d.z, d.w, w3, true);
        *(v4u*)(dst + g * 16) = (v4u){(unsigned)w0, (unsigned)w1, (unsigned)w2, (unsigned)w3};
    }
}

constexpr int R2_SC = 0, R2_TV = 128 * 129 * 4, R2_TI = R2_TV + 128 * 16 * 4, R2_END = R2_TI + 128 * 16 * 4;
static_assert(R2_END <= LDS_MISC, "routing v2 LDS");
DEV unsigned ord_key(float s) { const unsigned u = __builtin_bit_cast(unsigned, s); return (u & 0x80000000u) ? ~u : (u | 0x80000000u); }
DEV void route_item2(int l, int tile, int h, const bf16* __restrict__ Q, const bf16* __restrict__ SK, int* __restrict__ IDS, float* __restrict__ GG, LAS unsigned char* lds, int tid, int seq,
                        const float* __restrict__ cv_u, const float* __restrict__ cv_v, unsigned char* __restrict__ cv_u8, unsigned char* __restrict__ cv_v8) {
    LAS float* sc = (LAS float*)(lds + R2_SC); LAS float* tv = (LAS float*)(lds + R2_TV); LAS int* ti = (LAS int*)(lds + R2_TI);
    const int lane = tid & 63, wave = tid >> 6, row0 = tile * 64;
    {
        const int r = lane & 31, hh = lane >> 5, c = wave >> 2, key0 = 32 * (wave & 3);
        const bf16* skp = SK + ((size_t)(((l * 8 + h) * 2 + c) * 128 + key0 + r)) * 128 + 8 * hh;
        bf16x8 bfr[8];
#pragma unroll
        for (int ks = 0; ks < 8; ++ks) bfr[ks] = *(const bf16x8*)(skp + 16 * ks);
#pragma unroll
        for (int rt = 0; rt < 2; ++rt) {
            const bf16* qp = Q + (size_t)(row0 + 32 * rt + r) * D + h * 256 + c * 128 + 8 * hh;
            bf16x8 afr[8];
#pragma unroll
            for (int ks = 0; ks < 8; ++ks) afr[ks] = *(const bf16x8*)(qp + 16 * ks);
            f32x16 acc;
#pragma unroll
            for (int e = 0; e < 16; ++e) acc[e] = 0.f;
#pragma unroll
            for (int ks = 0; ks < 8; ++ks) acc = __builtin_amdgcn_mfma_f32_32x32x16_bf16(afr[ks], bfr[ks], acc, 0, 0, 0);
#pragma unroll
            for (int e = 0; e < 16; ++e) { const int tok = 32 * rt + (e & 3) + 8 * (e >> 2) + 4 * hh; sc[(c * 64 + tok) * 129 + key0 + r] = acc[e]; }
        }
    }
    __syncthreads();
    if (tid >= 128) {
        const size_t TG = (size_t)NEXP * D / 16;
        const size_t g0 = (size_t)(tile * 8 + h) * 4096;
#pragma unroll 4
        for (int k = 0; k < 11; ++k) { const size_t g = g0 + (size_t)(tid - 128) + 384u * k;
            if (g < g0 + 4096) { const bool isv = g >= TG; const size_t gg = isv ? g - TG : g;
                convert_fp8((isv ? cv_v : cv_u) + gg * 16, (isv ? cv_v8 : cv_u8) + gg * 16, 1, 0, 1, isv ? 1.f : U8_SCALE); } }
    }
    if (tid < 128) {
        const int L = tid;
        unsigned t[16];
#pragma unroll
        for (int q = 0; q < 16; ++q) t[q] = 0u;
#pragma unroll 4
        for (int k = 0; k < 128; ++k) {
            unsigned key = (ord_key(sc[L * 129 + k]) & ~127u) | (unsigned)(127 - k);
#pragma unroll
            for (int q = 0; q < 16; ++q) { const unsigned hi = t[q] > key ? t[q] : key; key = t[q] > key ? key : t[q]; t[q] = hi; }
        }
#pragma unroll
        for (int q = 0; q < 16; ++q) { const int idx = 127 - (int)(t[q] & 127u); tv[L * 16 + q] = sc[L * 129 + idx]; ti[L * 16 + q] = idx; }
    }
    if (wave == 1) { LDS_WAIT(); if (lane == 0) *(volatile LAS int*)(lds + LDS_MISC + 128) = seq; }
    if (wave == 0) { LDS_WAIT(); while (*(volatile LAS int*)(lds + LDS_MISC + 128) != seq) __builtin_amdgcn_s_sleep(1); }
    if (tid < 64) {
        const int tok = tid;
        float a[16], bq[16];
#pragma unroll
        for (int i = 0; i < 16; ++i) { a[i] = tv[tok * 16 + i]; bq[i] = tv[(64 + tok) * 16 + i]; }
        unsigned t[16];
#pragma unroll
        for (int q = 0; q < 16; ++q) t[q] = 0u;
#pragma unroll
        for (int i = 0; i < 16; ++i)
#pragma unroll
            for (int j = 0; j < 16 / (i + 1); ++j) {
                unsigned key = (ord_key(a[i] + bq[j]) & ~255u) | (unsigned)(255 - (i * 16 + j));
#pragma unroll
                for (int q = 0; q < 16; ++q) { const unsigned hi = t[q] > key ? t[q] : key; key = t[q] > key ? key : t[q]; t[q] = hi; }
            }
        float scv[16]; int idv[16]; float mx = NEGBIG;
#pragma unroll
        for (int q = 0; q < 16; ++q) { const int ci = 255 - (int)(t[q] & 255u); const int i = ci >> 4, j = ci & 15;
            scv[q] = tv[tok * 16 + i] + tv[(64 + tok) * 16 + j]; idv[q] = ti[tok * 16 + i] * 128 + ti[(64 + tok) * 16 + j]; mx = fmaxf(mx, scv[q]); }
        float sum = 0.f;
#pragma unroll
        for (int q = 0; q < 16; ++q) { scv[q] = __expf(scv[q] - mx); sum += scv[q]; }
        const float inv = 1.f / sum;
        int* ip = IDS + (size_t)(row0 + tok) * 128 + h * 16; float* gp = GG + (size_t)(row0 + tok) * 128 + h * 16;
#pragma unroll
        for (int q4 = 0; q4 < 4; ++q4) {
            *(int4*)(ip + 4 * q4) = make_int4(idv[4 * q4], idv[4 * q4 + 1], idv[4 * q4 + 2], idv[4 * q4 + 3]);
            *(f32x4*)(gp + 4 * q4) = (f32x4){scv[4 * q4] * inv, scv[4 * q4 + 1] * inv, scv[4 * q4 + 2] * inv, scv[4 * q4 + 3] * inv};
        }
    }
    __syncthreads();
}


DEV void expert_row8(int l, int row, const bf16* H, const int* __restrict__ IDS, const float* __restrict__ GG, const unsigned char* __restrict__ U8, const unsigned char* __restrict__ V8,
                     const bf16* __restrict__ X1, const float* __restrict__ g2, const float* __restrict__ fnorm, float* __restrict__ XO, bf16* __restrict__ XOH, int lane, float pscale, LAS int* sortL,
                     const float* __restrict__ ngain, const float* __restrict__ nmod, bf16* Hout) {
    f32x2 x[16];
#pragma unroll
    for (int j = 0; j < 2; ++j) {
        const v4u a = *(const v4u*)(H + (size_t)row * D + lane * 16 + 1024 * j), c = *(const v4u*)(H + (size_t)row * D + lane * 16 + 1024 * j + 8);
        x[j * 8 + 0] = (f32x2){bf_lo(a.x), bf_hi(a.x)}; x[j * 8 + 1] = (f32x2){bf_lo(a.y), bf_hi(a.y)}; x[j * 8 + 2] = (f32x2){bf_lo(a.z), bf_hi(a.z)}; x[j * 8 + 3] = (f32x2){bf_lo(a.w), bf_hi(a.w)};
        x[j * 8 + 4] = (f32x2){bf_lo(c.x), bf_hi(c.x)}; x[j * 8 + 5] = (f32x2){bf_lo(c.y), bf_hi(c.y)}; x[j * 8 + 6] = (f32x2){bf_lo(c.z), bf_hi(c.z)}; x[j * 8 + 7] = (f32x2){bf_lo(c.w), bf_hi(c.w)};
    }
    int id0 = IDS[(size_t)row * 128 + lane], id1 = IDS[(size_t)row * 128 + 64 + lane];
    float gg0 = GG[(size_t)row * 128 + lane], gg1 = GG[(size_t)row * 128 + 64 + lane];
    {
        const int w0 = id0 >> 9, w1 = id1 >> 9; int p0 = 0, p1 = 0, base = 0;
        for (int w = 0; w < 32; ++w) {
            const unsigned long long m0 = __ballot(w0 == w), m1 = __ballot(w1 == w);
            const int c0 = __popcll(m0), c1 = __popcll(m1);
            const int b0 = (int)__builtin_amdgcn_mbcnt_hi((unsigned)(m0 >> 32), __builtin_amdgcn_mbcnt_lo((unsigned)m0, 0u));
            const int b1 = (int)__builtin_amdgcn_mbcnt_hi((unsigned)(m1 >> 32), __builtin_amdgcn_mbcnt_lo((unsigned)m1, 0u));
            p0 = (w0 == w) ? base + b0 : p0; p1 = (w1 == w) ? base + c0 + b1 : p1;
            base += c0 + c1;
        }
        sortL[p0] = id0; sortL[p1] = id1; ((LAS float*)sortL)[128 + p0] = gg0; ((LAS float*)sortL)[128 + p1] = gg1;
        LDS_WAIT();
        id0 = sortL[lane]; id1 = sortL[64 + lane]; gg0 = ((LAS float*)sortL)[128 + lane]; gg1 = ((LAS float*)sortL)[192 + lane];
        LDS_WAIT();
    }
    float wv0 = 0.f, wv1 = 0.f;
    const unsigned char* Ul = U8 + (size_t)l * NEXP * D + lane * 16;
    const unsigned char* Vl = V8 + (size_t)l * NEXP * D + lane * 16;
    for (int e0 = 0; e0 < 128; e0 += 8) {
        v4u uu[8][2];
#pragma unroll
        for (int q = 0; q < 8; ++q) { const int e = e0 + q; const int id = (e < 64) ? __builtin_amdgcn_readlane(id0, e & 63) : __builtin_amdgcn_readlane(id1, e & 63);
            uu[q][0] = *(const v4u*)(Ul + (size_t)id * D); uu[q][1] = *(const v4u*)(Ul + (size_t)id * D + 1024); }
        float ds[8];
#pragma unroll
        for (int q = 0; q < 8; ++q) {
            f32x2 acc = {0.f, 0.f};
#pragma unroll
            for (int j = 0; j < 2; ++j) {
                const unsigned wd[4] = {uu[q][j].x, uu[q][j].y, uu[q][j].z, uu[q][j].w};
#pragma unroll
                for (int dw = 0; dw < 4; ++dw) {
                    const f32x2 lo = __builtin_amdgcn_cvt_pk_f32_fp8((int)wd[dw], false), hi = __builtin_amdgcn_cvt_pk_f32_fp8((int)wd[dw], true);
                    acc = __builtin_elementwise_fma(lo, x[j * 8 + 2 * dw], acc); acc = __builtin_elementwise_fma(hi, x[j * 8 + 2 * dw + 1], acc);
                }
            }
            ds[q] = acc.x + acc.y;
        }
#pragma unroll
        for (int q = 0; q < 8; ++q) ds[q] += swz_xor<1>(ds[q]);
#pragma unroll
        for (int q = 0; q < 8; ++q) ds[q] += swz_xor<2>(ds[q]);
#pragma unroll
        for (int q = 0; q < 8; ++q) ds[q] += swz_xor<4>(ds[q]);
#pragma unroll
        for (int q = 0; q < 8; ++q) ds[q] += swz_xor<8>(ds[q]);
#pragma unroll
        for (int q = 0; q < 8; ++q) ds[q] += swz_xor<16>(ds[q]);
#pragma unroll
        for (int q = 0; q < 8; ++q) ds[q] = sum32(ds[q]);
#pragma unroll
        for (int q = 0; q < 8; ++q) { const int e = e0 + q;
            const float gq = (e < 64) ? __builtin_bit_cast(float, __builtin_amdgcn_readlane(__builtin_bit_cast(int, gg0), e & 63)) : __builtin_bit_cast(float, __builtin_amdgcn_readlane(__builtin_bit_cast(int, gg1), e & 63));
            const float w = gq * gelu_tanh(ds[q] * (1.f / U8_SCALE));
            if (e < 64) wv0 = (lane == (e & 63)) ? w : wv0; else wv1 = (lane == (e & 63)) ? w : wv1; }
    }
    f32x2 y[16];
#pragma unroll
    for (int i = 0; i < 16; ++i) y[i] = (f32x2){0.f, 0.f};
    for (int e0 = 0; e0 < 128; e0 += 8) {
        v4u vv[8][2];
#pragma unroll
        for (int q = 0; q < 8; ++q) { const int e = e0 + q; const int id = (e < 64) ? __builtin_amdgcn_readlane(id0, e & 63) : __builtin_amdgcn_readlane(id1, e & 63);
            vv[q][0] = *(const v4u*)(Vl + (size_t)id * D); vv[q][1] = *(const v4u*)(Vl + (size_t)id * D + 1024); }
#pragma unroll
        for (int q = 0; q < 8; ++q) { const int e = e0 + q;
            const float w = (e < 64) ? __builtin_bit_cast(float, __builtin_amdgcn_readlane(__builtin_bit_cast(int, wv0), e & 63)) : __builtin_bit_cast(float, __builtin_amdgcn_readlane(__builtin_bit_cast(int, wv1), e & 63));
            const f32x2 w2 = {w, w};
#pragma unroll
            for (int j = 0; j < 2; ++j) {
                const unsigned wd[4] = {vv[q][j].x, vv[q][j].y, vv[q][j].z, vv[q][j].w};
#pragma unroll
                for (int dw = 0; dw < 4; ++dw) {
                    const f32x2 lo = __builtin_amdgcn_cvt_pk_f32_fp8((int)wd[dw], false), hi = __builtin_amdgcn_cvt_pk_f32_fp8((int)wd[dw], true);
                    y[j * 8 + 2 * dw] = __builtin_elementwise_fma(w2, lo, y[j * 8 + 2 * dw]); y[j * 8 + 2 * dw + 1] = __builtin_elementwise_fma(w2, hi, y[j * 8 + 2 * dw + 1]);
                }
            }
        }
    }
    float ssq = 0.f;
#pragma unroll
    for (int j = 0; j < 2; ++j)
#pragma unroll
        for (int k4 = 0; k4 < 4; ++k4) {
            const int col = lane * 16 + 1024 * j + 4 * k4;
            const unsigned long long xw = *(const unsigned long long*)(X1 + (size_t)row * D + col); const f32x4 xa = {bf_lo((unsigned)xw), bf_hi((unsigned)xw), bf_lo((unsigned)(xw >> 32)), bf_hi((unsigned)(xw >> 32))}; const f32x4 ga = *(const f32x4*)(g2 + col) * pscale;
            f32x2& ya = y[j * 8 + 2 * k4]; f32x2& yb = y[j * 8 + 2 * k4 + 1];
            ya.x = xa.x + ga.x * ya.x; ya.y = xa.y + ga.y * ya.y; yb.x = xa.z + ga.z * yb.x; yb.y = xa.w + ga.w * yb.y;
            ssq += (ya.x * ya.x + ya.y * ya.y) + (yb.x * yb.x + yb.y * yb.y);
        }
    const float r = rsqrtf(wave_sum(ssq) * (1.f / D) + EPS);
#pragma unroll
    for (int j = 0; j < 2; ++j)
#pragma unroll
        for (int k4 = 0; k4 < 4; ++k4) {
            const int col = lane * 16 + 1024 * j + 4 * k4;
            const f32x2 ya = y[j * 8 + 2 * k4], yb = y[j * 8 + 2 * k4 + 1];
            f32x4 ov = {ya.x, ya.y, yb.x, yb.y};
            if (fnorm) *(f32x4*)(XO + (size_t)row * D + col) = ov * r * *(const f32x4*)(fnorm + col);
            else *(unsigned long long*)(XOH + (size_t)row * D + col) = (unsigned long long)pk2(ov.x, ov.y) | ((unsigned long long)pk2(ov.z, ov.w) << 32);
            if (ngain) {
                const f32x4 g = *(const f32x4*)(ngain + col), sc = *(const f32x4*)(nmod + MO_SC1 + col), sh = *(const f32x4*)(nmod + MO_SH1 + col);
                const f32x4 hv = (ov * r) * g * (sc + 1.f) + sh;
                *(unsigned long long*)(Hout + (size_t)row * D + col) = (unsigned long long)pk2(hv.x, hv.y) | ((unsigned long long)pk2(hv.z, hv.w) << 32);
            }
        }
}


struct Args { const float* in[24]; float* out; unsigned char* ws; int ph_lo, ph_hi, li, pad; };

__global__ void __launch_bounds__(512, 2) fwd(Args a) {
    extern __shared__ __attribute__((aligned(16))) unsigned char lds_raw[];
    LAS unsigned char* lds = (LAS unsigned char*)lds_raw;
#define PHASE_TID() unsigned zz_ = 0u; asm volatile("" : "+v"(zz_));   \
    int tid = wave0 * 64 + (int)__builtin_amdgcn_mbcnt_hi(~0u, __builtin_amdgcn_mbcnt_lo(~0u, zz_)); const int lane = tid & 63; (void)lane; \
    int bx = blockIdx.x, G = gridDim.x; asm volatile("" : "+s"(bx), "+s"(G)); const int wave = __builtin_amdgcn_readfirstlane(tid >> 6); \
    const int vcu = (G % 8 == 0) ? (bx % 8) * (G / 8) + bx / 8 : bx; const int gw = vcu * 8 + wave, NGW = G * 8; (void)gw; (void)NGW; (void)vcu; (void)wave; \
    const __attribute__((address_space(4))) Args* A = (const __attribute__((address_space(4))) Args*)__builtin_amdgcn_kernarg_segment_ptr(); asm volatile("" : "+s"(A))
    unsigned* ctl = (unsigned*)(a.ws + WS_CTL);
    const int lo = a.ph_lo, hi = a.ph_hi;
    const int wave0 = __builtin_amdgcn_readfirstlane((int)threadIdx.x >> 6);
    for (int u = threadIdx.x; u < (LDS_BYTES - LDS_MISC) / 4; u += 512) ((LAS unsigned*)(lds + LDS_MISC))[u] = 0u;
    __syncthreads();
    XcdBarrier bar; bar.bar = ctl + CW_BAR + (a.li & 7) * XCD_BAR_WORDS; bar.x = 0; bar.st = (volatile LAS unsigned*)(lds + LDS_MISC + 64); bar.w0 = wave0;
    if (hi - lo > 1) bar = xcd_barrier_post(ctl + CW_BAR + (a.li & 7) * XCD_BAR_WORDS, (volatile LAS unsigned*)(lds + LDS_MISC + 64), wave0);
#define IN(k) (lo <= (k) && (k) < hi)
#define SEAM(k) do { if (IN(k) && IN((k) + 1)) xcd_barrier(bar); } while (0)

#define mod   ((float*)(A->ws + WS_MOD))
#define WIN_T ((bf16*)(A->ws + WS_WIN_T))
#define WOUT_T ((bf16*)(A->ws + WS_WOUT_T))
#define WQ_T  ((bf16*)(A->ws + WS_WQ_T))
#define SUBK  ((bf16*)(A->ws + WS_SUBK))
#define UB    ((bf16*)(A->ws + WS_U))
#define VB    ((bf16*)(A->ws + WS_V))
#define H     ((bf16*)(A->ws + WS_H))
#define Z     ((bf16*)(A->ws + WS_Z))
#define HLOC  ((bf16*)(A->ws + WS_HLOC))
#define PP    ((bf16*)(A->ws + WS_P))
#define YB    ((float*)(A->ws + WS_YB))
#define YC    ((bf16*)(A->ws + WS_YC))
#define SUMA  ((float*)(A->ws + WS_SUMA))
#define SUMB  ((float*)(A->ws + WS_SUMB))
#define X1    ((float*)(A->ws + WS_X1))
#define X2    ((float*)(A->ws + WS_X2))
#define QB    ((bf16*)(A->ws + WS_Q))
#define IDS   ((int*)(A->ws + WS_IDS))
#define GG    ((float*)(A->ws + WS_G))
#define PARTB ((bf16*)(A->ws + WS_PART))
#define WG_T  ((bf16*)(A->ws + WS_WG_T))
#define LSEB  ((float*)(A->ws + WS_LSE))
#define XIN   ((l == 0) ? A->in[0] : (const float*)X2)
#define XR    ((bf16*)(A->ws + WS_XR))
#define X1H   ((bf16*)(A->ws + WS_X1))
#define X2H   ((bf16*)(A->ws + WS_X2))
#define XRES  ((l == 0) ? (const bf16*)XR : (const bf16*)X2H)
#define MODL  (mod + (size_t)l * 2 * MODW)
    if (IN(0)) {
        PHASE_TID();
        ph_mod(A->in[1], A->in[2], A->in[3], mod, (LAS float*)lds, vcu, G, tid);
        {
            LAS float* scr = (LAS float*)(lds + wave * 17408);
            constexpr int I_IN = (D / 64) * (IN_W / 64), I_SQ = (D / 64) * (D / 64), I_L = I_IN + 2 * I_SQ;
            for (int it = gw; it < 2 * I_L; it += NGW) {
                const int l = it / I_L; int r = it % I_L;
                if (r < I_IN) { transpose_item64(A->in[6] + (size_t)l * D * IN_W, D, IN_W, WIN_T + (size_t)l * IN_W * D, scr, r, lane); continue; } r -= I_IN;
                if (r < I_SQ) { transpose_item64(A->in[18] + (size_t)l * D * D, D, D, WOUT_T + (size_t)l * D * D, scr, r, lane); continue; } r -= I_SQ;
                transpose_item64(A->in[19] + (size_t)l * D * D, D, D, WQ_T + (size_t)l * D * D, scr, r, lane);
            }
        }
        {
            LAS float* scr = (LAS float*)(lds + wave * 17408);
            for (int it = gw; it < 2 * 6 * 2 * 8; it += NGW) { const int mi = it >> 3, sub = it & 7; const int ln = mi >> 1, g = mi & 1;
                transpose_item((g ? A->in[11] : A->in[9]) + (size_t)ln * 128 * 128, 128, 128, WG_T + ((size_t)ln * 2 + g) * 128 * 128, scr, sub, lane); }
        }
        const size_t gtid = (size_t)vcu * 512 + tid, gstride = (size_t)G * 512;
        convert_copy(A->in[20], SUBK, (size_t)2 * 8 * 2 * 128 * 128 / 8, gtid, gstride);
    }
    SEAM(0);

    for (int l = 0; l < NL; ++l) {
        const int pb = 1 + 9 * l;
        if (IN(pb + 0) && l == 0) { PHASE_TID(); modnorm_rows(XIN, A->in[4] + l * D, MODL, MO_SH1, MO_SC1, H, gw, NGW, lane, XR); }
        if (l == 0) SEAM(pb + 0);
        if (IN(pb + 1)) {
            PHASE_TID(); (void)tid;
            pg8::Gemm g{H, WIN_T + (size_t)l * IN_W * D, M, IN_W, D}; pg8::StaticOrder S; S.init(M, IN_W, G, bx);
            pg8::EpiBf16<0> E{Z, IN_W, nullptr, 0, 0};
            pg8::gemm_phase<pg8::EpiBf16<0>, pg8::StaticOrder, false>((PG8_LAS unsigned char*)lds, g, S, E, nullptr, wave0);
        }
        SEAM(pb + 1);
        if (IN(pb + 2)) {
            PHASE_TID();
            for (int it = vcu; it < 2 * 64 * 6; it += G) {
                const int b = it / 384, r = it % 384, j = r / 6, n = r % 6;
                lru_item2(l, b, j, n, Z, A->in[7], A->in[8], WG_T, A->in[10], A->in[12], A->in[13], HLOC, PP, SUMA, SUMB,
                          (LAS float*)lds, (LAS float*)(lds + 34816), (LAS float*)(lds + 69632), tid);
            }
            {
                {
                    LAS unsigned char* wl = lds + wave * ATT_WLDS;
                    for (int it = gw; it < 1024 + 4608; it += NGW) {
                        if (it < 1024) { const int bh = it >> 7, tl = 127 - (it & 127); sb_mfma_item(bh >> 2, bh & 3, 32 * tl, Z, YC, wl, lane); }
                        else { const int i2 = it - 1024; const int tl = i2 & 127, p = (i2 >> 7) % 3, bh = i2 / 384; const int d = 1 << (2 * p);
                            dil_mfma_item(bh / 6, bh % 6, p, tl % d, 32 * (tl / d), Z, A->in[14], PARTB, LSEB, wl, lane); }
                    }
                }
            }
        }
        SEAM(pb + 2);
        if (IN(pb + 3)) {
            PHASE_TID();
            for (int it = vcu; it < 256; it += G) { const int b = it >> 7, j = (it >> 1) & 63, half = it & 1;
                combine_item(l, b, j, half, Z, HLOC, PP, SUMA, SUMB, PARTB, LSEB, YC, A->in[15], A->in[16], A->in[17], H, (LAS float*)lds, tid); }
        }
        SEAM(pb + 3);
        if (IN(pb + 4)) {
            PHASE_TID(); (void)tid;
            pg8::Gemm g{H, WOUT_T + (size_t)l * D * D, M, D, D}; pg8::StaticOrder S; S.init(M, D, G, bx);
            EpiResGate E{XRES, X1H, MODL + MO_G1, 1.f};
            pg8::gemm_phase<EpiResGate, pg8::StaticOrder, false>((PG8_LAS unsigned char*)lds, g, S, E, nullptr, wave0);
        }
        SEAM(pb + 4);
        if (IN(pb + 5)) { PHASE_TID(); modnorm_rows_h(X1H, A->in[5] + l * D, MODL, MO_SH2, MO_SC2, H, gw, NGW, lane); }
        SEAM(pb + 5);
        if (IN(pb + 6)) {
            PHASE_TID(); (void)tid;
            pg8::Gemm g{H, WQ_T + (size_t)l * D * D, M, D, D}; pg8::StaticOrder S; S.init(M, D, G, bx);
            pg8::EpiBf16<0> E{QB, D, nullptr, 0, 0};
            pg8::gemm_phase<pg8::EpiBf16<0>, pg8::StaticOrder, false>((PG8_LAS unsigned char*)lds, g, S, E, nullptr, wave0);
        }
        SEAM(pb + 6);
        if (IN(pb + 7)) {
            PHASE_TID();
            for (int it = vcu; it < 128 * 8; it += G) route_item2(l, it >> 3, it & 7, QB, SUBK, IDS, GG, lds, tid, l * 1024 + it + 1, A->in[21] + (size_t)l * NEXP * D, A->in[22] + (size_t)l * NEXP * D,
                                                                                      (unsigned char*)UB + (size_t)l * NEXP * D, (unsigned char*)VB + (size_t)l * NEXP * D);
        }
        SEAM(pb + 7);
        if (IN(pb + 8)) {
            PHASE_TID();
            for (int m = gw; m < M; m += NGW)
                expert_row8(l, m, H, IDS, GG, (const unsigned char*)UB, (const unsigned char*)VB, X1H, MODL + (size_t)(m >> 12) * MODW + MO_G2, (l == NL - 1) ? A->in[23] : nullptr, A->out, X2H, lane,
                            1.f, (LAS int*)(lds + wave * 1024),
                            (l == NL - 1) ? nullptr : A->in[4] + (l + 1) * D, mod + (size_t)((l + 1) * 2 + (m >> 12)) * MODW, H);
        }
        if (l + 1 < NL) SEAM(pb + 8);
    }
#undef IN
#undef SEAM
#undef mod
#undef H
#undef Z
#undef X1
#undef X2
}
}

extern "C" void kernel_launch(void* const* d_in, const int* in_sizes, int n_in, void* d_out, int out_size, void* d_ws, size_t ws_size, hipStream_t stream) {
    using namespace mk;
    static int grid = 0;
    if (grid == 0) {
        if (n_in != 24 || out_size != M * D || ws_size < WS_END) { fprintf(stderr, "kernel_launch: unexpected shapes (n_in %d out %d ws %zu)\n", n_in, out_size, ws_size); grid = -1; return; }
        int dev = 0, cus = 0, per_cu = 0;
        if (hipGetDevice(&dev) != hipSuccess || hipDeviceGetAttribute(&cus, hipDeviceAttributeMultiprocessorCount, dev) != hipSuccess) { grid = -1; return; }
        if (hipFuncSetAttribute((const void*)fwd, hipFuncAttributeMaxDynamicSharedMemorySize, LDS_BYTES) != hipSuccess) { fprintf(stderr, "kernel_launch: hipFuncSetAttribute failed\n"); grid = -1; return; }
        if (hipOccupancyMaxActiveBlocksPerMultiprocessor(&per_cu, (const void*)fwd, 512, LDS_BYTES) != hipSuccess || per_cu < 1) fprintf(stderr, "kernel_launch: occupancy query says %d\n", per_cu);
        (void)hipGetLastError();
        grid = cus;
    }
    if (grid < 0) return;
    (void)hipMemsetAsync((char*)d_ws + WS_CTL, 0, CTL_ZERO_BYTES, stream);
    Args a{};
    for (int i = 0; i < 24; ++i) a.in[i] = (const float*)d_in[i];
    a.out = (float*)d_out; a.ws = (unsigned char*)d_ws; a.pad = 0;
    constexpr int NLAUNCH = MK_N_LAUNCHES;
    for (int li = 0; li < NLAUNCH; ++li) {
        a.ph_lo = (NLAUNCH == 1) ? 0 : li; a.ph_hi = (NLAUNCH == 1) ? NPHASE : li + 1; a.li = li;
        hipLaunchKernelGGL(fwd, dim3(grid), dim3(512), LDS_BYTES, stream, a);
    }
}
```

```cpp
#include <hip/hip_runtime.h>
#include <cstdio>
#include <cstdint>
namespace pg8 {
#define PG8_LAS __attribute__((address_space(3)))
typedef unsigned short bf16_t;
typedef short bf16x8 __attribute__((ext_vector_type(8)));
typedef float f32x4 __attribute__((ext_vector_type(4)));
typedef unsigned u32x4 __attribute__((ext_vector_type(4)));
constexpr int BM = 256, BK = 64, HALF = 128, HTB = HALF * BK * 2  , STAGE_BYTES = 8 * HTB, NXCD = 8, WGM = 8;

__host__ __device__ __forceinline__ int lds_byte(int r, int c) { const int st = (r >> 4) * 2 + (c >> 5), rr = r & 15, cc = c & 31, ob = rr * 64 + cc * 2; return st * 1024 + (ob ^ (((ob >> 9) & 1) << 5)); }
__host__ __device__ __forceinline__ void stage_rc(int b, int& R, int& C) { const int st = b / 1024, sb = b % 1024, swz = sb ^ (((sb >> 9) & 1) << 5); R = (st >> 1) * 16 + swz / 64; C = (st & 1) * 32 + (swz % 64) / 2; }
__host__ __device__ __forceinline__ int perm32(int rho) { const int n = rho >> 4, i = rho & 15; return 8 * (i >> 2) + 4 * n + (i & 3); }

struct Unit { int pm, pn; };
struct Gemm { const bf16_t* A; const bf16_t* Bt; int M, N, K; };

struct StaticOrder {
    int nM, nN, nwg, G, c;
    __host__ __device__ void init(int M, int N, int G_, int c_) { nM = M / BM; nN = N / BM; nwg = nM * nN; G = G_; c = c_; }
    __host__ __device__ bool next(int i, Unit& u) const {
        const long L = (long)i * G + c; if (L >= nwg) return false;
        int wgid = (int)L; { const int q = nwg / NXCD, r = nwg % NXCD, xcd = wgid % NXCD, off = wgid / NXCD; wgid = (xcd < r ? xcd * (q + 1) : r * (q + 1) + (xcd - r) * q) + off; }
        const int nig = WGM * nN, gid = wgid / nig, fm = gid * WGM, gsz = (nM - fm) < WGM ? (nM - fm) : WGM;
        u.pm = fm + ((wgid % nig) % gsz); u.pn = (wgid % nig) / gsz; return true;
    }
    __device__ __forceinline__ void a_ready(const Unit&) const {}
    __device__ __forceinline__ void done(const Unit&) const {}
};
struct CountedOrder : StaticOrder {
    const unsigned* ready; unsigned need; unsigned* tmo;
    __device__ __forceinline__ void a_ready(const Unit& u) const {
        if (threadIdx.x < 64) {
            const unsigned long long t0 = __builtin_amdgcn_s_memrealtime(); unsigned polls = 0;
            while ((unsigned)__builtin_amdgcn_readfirstlane(__hip_atomic_load(ready + 64 * u.pm, __ATOMIC_RELAXED, __HIP_MEMORY_SCOPE_AGENT)) < need) {
                if ((++polls & 255u) == 0u && __builtin_amdgcn_readfirstlane(__hip_atomic_load(tmo, __ATOMIC_RELAXED, __HIP_MEMORY_SCOPE_AGENT)) != 0u) break;
                if (__builtin_amdgcn_s_memrealtime() - t0 > 2000000ull) {
                    if (threadIdx.x == 0) { unsigned expect = 0u; __hip_atomic_compare_exchange_strong(tmo + 1, &expect, 0x600u | (unsigned)(u.pm & 0xff), __ATOMIC_RELAXED, __ATOMIC_RELAXED, __HIP_MEMORY_SCOPE_AGENT); __hip_atomic_store(tmo, 1u, __ATOMIC_RELAXED, __HIP_MEMORY_SCOPE_AGENT); }
                    break; }
                __builtin_amdgcn_s_sleep(2); }
            __builtin_amdgcn_fence(__ATOMIC_ACQUIRE, "agent");
            asm volatile("s_waitcnt vmcnt(0)" ::: "memory");
        }
#if !defined(BROKEN_HOOK_NO_BARRIER)
        asm volatile("" ::: "memory"); __builtin_amdgcn_s_barrier(); asm volatile("" ::: "memory");
#endif
    }
};

__device__ __forceinline__ unsigned cvt_pk_bf16(float lo, float hi) { unsigned r; asm volatile("v_cvt_pk_bf16_f32 %0, %1, %2" : "=v"(r) : "v"(lo), "v"(hi)); return r; }
typedef float f32x2 __attribute__((ext_vector_type(2)));
__device__ __forceinline__ f32x2 gelu_pk(f32x2 v) {
    const f32x2 av = __builtin_elementwise_abs(v), d = av * 0.2316418882f + 1.0f;
    f32x2 t; t.x = __builtin_amdgcn_rcpf(d.x); t.y = __builtin_amdgcn_rcpf(d.y);
    f32x2 q = t * 0.5307027145f + (-0.7265760135f); q = q * t + 0.7107068705f; q = q * t + (-0.142248368f); q = q * t + 0.127414796f; q = q * t;
    const f32x2 s = (v * v) * (-0.72134752044f);
    f32x2 e; e.x = __builtin_amdgcn_exp2f(s.x); e.y = __builtin_amdgcn_exp2f(s.y);
    const f32x2 m = v * (q * e), r = v - m;
    f32x2 o; o.x = v.x < 0.f ? m.x : r.x; o.y = v.y < 0.f ? m.y : r.y; return o;
}

struct EpiF32 {
    static constexpr bool PERM = false, AFTER_DRAIN = false;
    float* C; int ldc; const float* bias;
    __device__ __forceinline__ void operator()(const f32x4 (&acc)[2][2][4][2], const Unit& u, int wr, int wc, int fr, int fq) const {
        const int row0 = u.pm * BM + wr * 64 + fr, col0 = u.pn * BM + wc * 32 + 4 * fq;
        f32x4 bv[2][2];
#pragma unroll
        for (int bj = 0; bj < 2; ++bj)
#pragma unroll
            for (int n = 0; n < 2; ++n) bv[bj][n] = bias ? *(const f32x4*)(bias + col0 + bj * HALF + n * 16) : (f32x4){0.f, 0.f, 0.f, 0.f};
#pragma unroll
        for (int ai = 0; ai < 2; ++ai)
#pragma unroll
            for (int m = 0; m < 4; ++m) { float* rowp = C + (size_t)(row0 + ai * HALF + m * 16) * ldc + col0;
#pragma unroll
                for (int bj = 0; bj < 2; ++bj)
#pragma unroll
                    for (int n = 0; n < 2; ++n) *(f32x4*)(rowp + bj * HALF + n * 16) = acc[ai][bj][m][n] + bv[bj][n]; }
    }
};
template <int ACT  > struct EpiBf16 {
    static constexpr bool PERM = true, AFTER_DRAIN = false;
    bf16_t* O; int ldc; const float* bias; int split_cols; size_t split_stride;
    __device__ __forceinline__ void operator()(const f32x4 (&acc)[2][2][4][2], const Unit& u, int wr, int wc, int fr, int fq) const {
        const int row0 = u.pm * BM + wr * 64 + fr; int colt = u.pn * BM; bf16_t* base = O;
        if (split_cols) { const int t = colt / split_cols; base += (size_t)t * split_stride; colt -= t * split_cols; }
        const int col0 = colt + wc * 32 + 8 * fq, bcol0 = u.pn * BM + wc * 32 + 8 * fq;
        f32x4 bv[2][2];
#pragma unroll
        for (int bj = 0; bj < 2; ++bj)
#pragma unroll
            for (int n = 0; n < 2; ++n) bv[bj][n] = bias ? *(const f32x4*)(bias + bcol0 + bj * HALF + 4 * n) : (f32x4){0.f, 0.f, 0.f, 0.f};
#pragma unroll
        for (int ai = 0; ai < 2; ++ai)
#pragma unroll
            for (int m = 0; m < 4; ++m) { bf16_t* rowp = base + (size_t)(row0 + ai * HALF + m * 16) * ldc + col0;
#pragma unroll
                for (int bj = 0; bj < 2; ++bj) { f32x4 v0 = acc[ai][bj][m][0] + bv[bj][0], v1 = acc[ai][bj][m][1] + bv[bj][1];
                    if (ACT == 1) { f32x2 a = gelu_pk((f32x2){v0[0], v0[1]}), b = gelu_pk((f32x2){v0[2], v0[3]}), c = gelu_pk((f32x2){v1[0], v1[1]}), d = gelu_pk((f32x2){v1[2], v1[3]});
                        v0 = (f32x4){a.x, a.y, b.x, b.y}; v1 = (f32x4){c.x, c.y, d.x, d.y}; }
                    if (ACT == 2) {
#pragma unroll
                        for (int j = 0; j < 4; ++j) { v0[j] = 0.5f * v0[j] * (1.0f + erff(v0[j] * 0.70710678f)); v1[j] = 0.5f * v1[j] * (1.0f + erff(v1[j] * 0.70710678f)); } }
                    u32x4 w; w.x = cvt_pk_bf16(v0[0], v0[1]); w.y = cvt_pk_bf16(v0[2], v0[3]); w.z = cvt_pk_bf16(v1[0], v1[1]); w.w = cvt_pk_bf16(v1[2], v1[3]);
                    *(u32x4*)(rowp + bj * HALF) = w; } }
    }
};
template <class Epi, class Sched, bool STAMP = false>
__device__ __forceinline__ void gemm_phase(PG8_LAS unsigned char* lds, const Gemm g, const Sched& S, const Epi& E, unsigned long long* stamps, int wave_id) {
    unsigned zz_o = 0u; asm volatile("" : "+v"(zz_o)); int tid_o = wave_id * 64 + (int)__builtin_amdgcn_mbcnt_hi(~0u, __builtin_amdgcn_mbcnt_lo(~0u, zz_o));
    const int tid = tid_o, wid = __builtin_amdgcn_readfirstlane(tid >> 6), lane = tid & 63, wr = wid >> 2, wc = wid & 3, fr = lane & 15, fq = lane >> 4;
    constexpr int K = 2048, nt = K / BK;
    int ts_lo = 0, ts_hi = 0, nts = 0; const unsigned long long rt_entry = STAMP ? (unsigned long long)wall_clock64() : 0ull;
#define PG8_STAMP() do { if (STAMP && wid == 0 && nts < 64) { const unsigned long long _c = (unsigned long long)clock64(); \
        ts_lo = (lane == nts) ? (int)(unsigned)_c : ts_lo; ts_hi = (lane == nts) ? (int)(unsigned)(_c >> 32) : ts_hi; ++nts; } } while (0)
    PG8_STAMP();
    unsigned voffA[2], voffB[2];
#pragma unroll
    for (int i = 0; i < 2; ++i) { int R, C; stage_rc(tid * 16 + i * 8192, R, C); const int Rb = Epi::PERM ? ((R & ~31) + perm32(R & 31)) : R;
        voffA[i] = (unsigned)(R * K + C) * 2u; voffB[i] = (unsigned)(Rb * K + C) * 2u; }
    const size_t kstep = (size_t)(BK * 2);
    const size_t hstep = (size_t)HALF * K * 2;
    const size_t tstep = 2 * hstep;
    const unsigned ldsw = (unsigned)wid * 1024u;
    const int aoff = lds_byte(wr * 64 + fr, fq * 8), boff = lds_byte(wc * 32 + fr, fq * 8);
#define PG8_SA(b, h) (((b) * 2 + (h)) * HTB)
#define PG8_SB(b, h) ((4 + (b) * 2 + (h)) * HTB)
#define PG8_STAGE(bufoff, gbase, voff) do { _Pragma("unroll") for (int _i = 0; _i < 2; ++_i) \
        __builtin_amdgcn_global_load_lds((const unsigned*)((const char*)(gbase) + (voff)[_i]), (PG8_LAS unsigned*)(lds + (bufoff) + ldsw + _i * 8192), 16, 0, 0); } while (0)
#define PG8_LDA(dst, b, h) do { _Pragma("unroll") for (int m = 0; m < 4; ++m) _Pragma("unroll") for (int k = 0; k < 2; ++k) dst[m][k] = *(const PG8_LAS bf16x8*)(lds + PG8_SA(b, h) + aoff + m * 2048 + k * 1024); } while (0)
#define PG8_LDB(dst, b, h) do { _Pragma("unroll") for (int n = 0; n < 2; ++n) _Pragma("unroll") for (int k = 0; k < 2; ++k) dst[n][k] = *(const PG8_LAS bf16x8*)(lds + PG8_SB(b, h) + boff + n * 2048 + k * 1024); } while (0)
#define PG8_MMA(ai, bj, At, Bt) do { __builtin_amdgcn_s_setprio(1); _Pragma("unroll") for (int m = 0; m < 4; ++m) _Pragma("unroll") for (int n = 0; n < 2; ++n) _Pragma("unroll") for (int k = 0; k < 2; ++k) \
        acc[ai][bj][m][n] = __builtin_amdgcn_mfma_f32_16x16x32_bf16(Bt[n][k], At[m][k], acc[ai][bj][m][n], 0, 0, 0); __builtin_amdgcn_s_setprio(0); } while (0)
#define PG8_WAIT_V(n) asm volatile("s_waitcnt vmcnt(" #n ")" ::: "memory")
#define PG8_WAIT_L(n) asm volatile("s_waitcnt lgkmcnt(" #n ")" ::: "memory")
#define PG8_BAR __builtin_amdgcn_s_barrier()
#define PG8_SCHED __builtin_amdgcn_sched_barrier(0)
    Unit cur, nxt; int ui = 0;
    if (!S.next(0, cur)) return;
    f32x4 acc[2][2][4][2];
#pragma unroll
    for (int a = 0; a < 2; ++a)
#pragma unroll
        for (int b = 0; b < 2; ++b)
#pragma unroll
            for (int m = 0; m < 4; ++m)
#pragma unroll
                for (int n = 0; n < 2; ++n) acc[a][b][m][n] = (f32x4){0.f, 0.f, 0.f, 0.f};
    bf16x8 At[4][2], B0[2][2], B1[2][2];
    const char* cA = (const char*)g.A + (size_t)cur.pm * tstep; const char* cB = (const char*)g.Bt + (size_t)cur.pn * tstep;
    S.a_ready(cur);
    PG8_STAGE(PG8_SB(0, 0), cB, voffB); PG8_STAGE(PG8_SA(0, 0), cA, voffA); PG8_STAGE(PG8_SB(0, 1), cB + hstep, voffB); PG8_STAGE(PG8_SA(0, 1), cA + hstep, voffA);
    if (wr == 1) PG8_BAR;
    PG8_WAIT_V(4); PG8_BAR;
    PG8_STAGE(PG8_SB(1, 0), cB + kstep, voffB); PG8_STAGE(PG8_SA(1, 0), cA + kstep, voffA); PG8_STAGE(PG8_SB(1, 1), cB + hstep + kstep, voffB);
    PG8_WAIT_V(6); PG8_BAR;
    PG8_STAMP();
    for (;;) {
        const bool has_next = S.next(ui + 1, nxt);
        const char* nA = has_next ? (const char*)g.A + (size_t)nxt.pm * tstep : cA; const char* nB = has_next ? (const char*)g.Bt + (size_t)nxt.pn * tstep : cB;
        for (int t = 0; t < nt; t += 2) {
            const bool last = (t == nt - 2);
            const char* a1 = cA + (size_t)(t + 1) * kstep;
            const char* a2 = last ? nA : cA + (size_t)(t + 2) * kstep; const char* b2 = last ? nB : cB + (size_t)(t + 2) * kstep;
            const char* a3 = a2 + kstep; const char* b3 = b2 + kstep;
            if (last && has_next) S.a_ready(nxt);
            PG8_LDB(B0, 0, 0); PG8_SCHED; PG8_LDA(At, 0, 0); PG8_STAGE(PG8_SA(1, 1), a1 + hstep, voffA);
            PG8_WAIT_L(8); PG8_BAR; PG8_WAIT_L(0); PG8_MMA(0, 0, At, B0); PG8_BAR; PG8_SCHED;
            PG8_LDB(B1, 0, 1); PG8_STAGE(PG8_SB(0, 0), b2, voffB);
            PG8_BAR; PG8_WAIT_L(0); PG8_MMA(0, 1, At, B1); PG8_BAR;
            PG8_LDA(At, 0, 1); PG8_STAGE(PG8_SA(0, 0), a2, voffA);
            PG8_BAR; PG8_WAIT_L(0); PG8_MMA(1, 0, At, B0); PG8_BAR; PG8_SCHED;
            PG8_STAGE(PG8_SB(0, 1), b2 + hstep, voffB);
            PG8_WAIT_V(6); PG8_BAR; PG8_MMA(1, 1, At, B1); PG8_BAR;
            PG8_LDB(B0, 1, 0); PG8_SCHED; PG8_LDA(At, 1, 0); PG8_STAGE(PG8_SA(0, 1), a2 + hstep, voffA);
            PG8_WAIT_L(8); PG8_BAR; PG8_WAIT_L(0); PG8_MMA(0, 0, At, B0); PG8_BAR; PG8_SCHED;
            PG8_LDB(B1, 1, 1); PG8_STAGE(PG8_SB(1, 0), b3, voffB);
            PG8_BAR; PG8_WAIT_L(0); PG8_MMA(0, 1, At, B1); PG8_BAR;
            PG8_LDA(At, 1, 1); PG8_STAGE(PG8_SA(1, 0), a3, voffA);
            PG8_BAR; PG8_WAIT_L(0); PG8_MMA(1, 0, At, B0); PG8_BAR; PG8_SCHED;
            PG8_STAGE(PG8_SB(1, 1), b3 + hstep, voffB);
            PG8_WAIT_V(6); PG8_BAR; PG8_MMA(1, 1, At, B1); PG8_BAR;
        }
        PG8_STAMP();
        if constexpr (!Epi::AFTER_DRAIN) { E(acc, cur, wr, wc, fr, fq); S.done(cur); }
        PG8_STAMP();
        if (!has_next) break;
#pragma unroll
        for (int a = 0; a < 2; ++a)
#pragma unroll
            for (int b = 0; b < 2; ++b)
#pragma unroll
                for (int m = 0; m < 4; ++m)
#pragma unroll
                    for (int n = 0; n < 2; ++n) acc[a][b][m][n] = (f32x4){0.f, 0.f, 0.f, 0.f};
        cur = nxt; cA = nA; cB = nB; ++ui;
    }
    PG8_WAIT_V(0);
    if (wr == 0) PG8_BAR;
    PG8_BAR;
    if constexpr (Epi::AFTER_DRAIN) { E.fused(acc, cur, wr, wc, fr, fq, lds, wid, lane); S.done(cur); }
    PG8_STAMP();
    if (STAMP && wid == 0) { stamps[lane] = lane < nts ? (((unsigned long long)(unsigned)ts_hi << 32) | (unsigned)ts_lo) : 0ull;
        if (lane == 62) stamps[62] = rt_entry; if (lane == 63) stamps[63] = (unsigned long long)wall_clock64(); }
#undef PG8_STAMP
#undef PG8_SA
#undef PG8_SB
#undef PG8_STAGE
#undef PG8_LDA
#undef PG8_LDB
#undef PG8_MMA
#undef PG8_WAIT_V
#undef PG8_WAIT_L
#undef PG8_BAR
#undef PG8_SCHED
}
}

namespace mk {
#define GAS __attribute__((address_space(1)))
#define LAS __attribute__((address_space(3)))
#define DEV __device__ __forceinline__
typedef unsigned short bf16;
typedef unsigned v4u __attribute__((ext_vector_type(4)));
typedef float f32x4 __attribute__((ext_vector_type(4)));
typedef float f32x2 __attribute__((ext_vector_type(2)));
typedef short bf16x8 __attribute__((ext_vector_type(8)));
typedef float f32x16 __attribute__((ext_vector_type(16)));
typedef __bf16 bf16x2_t __attribute__((ext_vector_type(2)));

#ifndef MK_N_LAUNCHES
#define MK_N_LAUNCHES 1
#endif

constexpr int D = 2048, SEQ = 4096, M = 8192, NL = 2;
constexpr int LRU_W = 768, SWA_W = 768, SB_W = 512, IN_W = 5376;
constexpr int ZO_XA = 0, ZO_GA = 768, ZO_QB = 1536, ZO_KB = 2304, ZO_VB = 3072, ZO_QC = 3840, ZO_KC = 4352, ZO_VC = 4864;
constexpr int NEXP = 16384, MODW = 12288;
constexpr int MO_SH1 = 0, MO_SC1 = 2048, MO_G1 = 4096, MO_SH2 = 6144, MO_SC2 = 8192, MO_G2 = 10240;
constexpr float EPS = 1e-6f;
constexpr float QSCALE = 0.08838834764831845f;
constexpr float NEGBIG = -3.0e38f;
constexpr int NPHASE = 19;

constexpr size_t MiB = 1u << 20;
constexpr size_t WS_CTL = 0, CTL_ZERO_BYTES = 1 * MiB;
constexpr size_t WS_MOD = 512 * 1024;
constexpr size_t WS_WIN_T = 2 * MiB, WS_WOUT_T = 44 * MiB, WS_WQ_T = 60 * MiB, WS_SUBK = 76 * MiB, WS_U = 80 * MiB, WS_V = 208 * MiB,
                 WS_H = 336 * MiB, WS_Z = 368 * MiB, WS_HLOC = 452 * MiB, WS_P = 476 * MiB, WS_YB = 500 * MiB, WS_YC = 524 * MiB,
                 WS_SUMA = 540 * MiB, WS_SUMB = 541 * MiB, WS_X1 = 544 * MiB, WS_X2 = 608 * MiB, WS_Q = 672 * MiB, WS_IDS = 704 * MiB,
                 WS_G = 708 * MiB, WS_WG_T = 77 * MiB, WS_PART = 712 * MiB, WS_LSE = 784 * MiB, WS_XR = 786 * MiB, WS_END = 818 * MiB;
constexpr int CW_BAR = 4096;

constexpr int LDS_BYTES = 147456;
constexpr int LDS_MISC = 143360;

__device__ const unsigned char T5B[3][132] = {
 {0,1,2,3,4,5,6,7,8,9,10,11,12,13,14,15,16,16,16,16,16,16,17,17,17,17,17,17,17,17,18,18,18,18,18,18,18,18,18,18,19,19,19,19,19,19,19,19,19,19,19,19,19,19,20,20,20,20,20,20,20,20,20,20,20,20,20,20,20,20,20,20,20,21,21,21,21,21,21,21,21,21,21,21,21,21,21,21,21,21,21,21,21,21,21,21,21,21,21,22,22,22,22,22,22,22,22,22,22,22,22,22,22,22,22,22,22,22,22,22,22,22,22,22,22,22,22,22,22,0,0,0},
 {0,4,8,12,16,16,17,17,18,18,19,19,19,19,20,20,20,20,20,21,21,21,21,21,21,22,22,22,22,22,22,22,22,22,23,23,23,23,23,23,23,23,23,23,23,23,24,24,24,24,24,24,24,24,24,24,24,24,24,24,24,24,25,25,25,25,25,25,25,25,25,25,25,25,25,25,25,25,25,25,25,25,25,26,26,26,26,26,26,26,26,26,26,26,26,26,26,26,26,26,26,26,26,26,26,26,26,26,26,26,26,26,26,27,27,27,27,27,27,27,27,27,27,27,27,27,27,27,27,0,0,0},
 {0,16,18,19,20,21,21,22,22,23,23,23,24,24,24,24,25,25,25,25,25,26,26,26,26,26,26,26,26,27,27,27,27,27,27,27,27,27,27,28,28,28,28,28,28,28,28,28,28,28,28,28,29,29,29,29,29,29,29,29,29,29,29,29,29,29,29,29,29,29,30,30,30,30,30,30,30,30,30,30,30,30,30,30,30,30,30,30,30,30,30,30,30,30,30,31,31,31,31,31,31,31,31,31,31,31,31,31,31,31,31,31,31,31,31,31,31,31,31,31,31,31,31,31,31,31,31,31,31,0,0,0}};

#define LDS_WAIT() asm volatile("s_waitcnt lgkmcnt(0)" ::: "memory")
DEV unsigned f2bf(float f) { unsigned u = __builtin_bit_cast(unsigned, f); return (u + 0x7fffu + ((u >> 16) & 1u)) >> 16; }
DEV unsigned pk2(float lo, float hi) { return f2bf(lo) | (f2bf(hi) << 16); }
DEV float bf_lo(unsigned w) { return __builtin_bit_cast(float, w << 16); }
DEV float bf_hi(unsigned w) { return __builtin_bit_cast(float, w & 0xffff0000u); }
DEV float bf1(bf16 h) { return __builtin_bit_cast(float, ((unsigned)h) << 16); }
template <int MSK> DEV float swz_xor(float v) { return __builtin_bit_cast(float, __builtin_amdgcn_ds_swizzle(__builtin_bit_cast(int, v), (MSK << 10) | 0x1F)); }
DEV float part32_(float v) { int ln = (int)__builtin_amdgcn_mbcnt_hi(~0u, __builtin_amdgcn_mbcnt_lo(~0u, 0u)); asm volatile("" : "+v"(ln)); return __builtin_bit_cast(float, __builtin_amdgcn_ds_bpermute((ln ^ 32) << 2, __builtin_bit_cast(int, v))); }
DEV float sum32(float v) { return v + part32_(v); }
DEV float max32(float v) { return fmaxf(v, part32_(v)); }
DEV float partner32(float v, int hh) { (void)hh; return part32_(v); }
DEV float wave_sum(float v) { v += swz_xor<1>(v); v += swz_xor<2>(v); v += swz_xor<4>(v); v += swz_xor<8>(v); v += swz_xor<16>(v); return sum32(v); }
DEV float wave_max(float v) { v = fmaxf(v, swz_xor<1>(v)); v = fmaxf(v, swz_xor<2>(v)); v = fmaxf(v, swz_xor<4>(v)); v = fmaxf(v, swz_xor<8>(v)); v = fmaxf(v, swz_xor<16>(v)); return max32(v); }
DEV float sigmoid_f(float x) { return 1.f / (1.f + __expf(-x)); }
DEV float softplus_f(float x) { return fmaxf(x, 0.f) + log1pf(__expf(-fabsf(x))); }
DEV float gelu_tanh(float x) { const float u = 0.7978845608028654f * (x + 0.044715f * x * x * x); const float t = 1.f - 2.f / (1.f + __expf(2.f * u)); return 0.5f * x * (1.f + t); }
DEV float dot8(const v4u a, const v4u b) {
    float s = bf_lo(a.x) * bf_lo(b.x); s += bf_hi(a.x) * bf_hi(b.x);
    s += bf_lo(a.y) * bf_lo(b.y); s += bf_hi(a.y) * bf_hi(b.y);
    s += bf_lo(a.z) * bf_lo(b.z); s += bf_hi(a.z) * bf_hi(b.z);
    s += bf_lo(a.w) * bf_lo(b.w); s += bf_hi(a.w) * bf_hi(b.w);
    return s;
}

#define XB_TMO      128
#define XB_XCNT(j)  (256  + 64 * (j))
#define XB_XSUB(j)  (1280 + 64 * (j))
#define XB_XGEN(j)  (2304 + 64 * (j))
#define XB_TOP      3328
#define XB_TOPGEN   3392
#define XCD_BAR_WORDS 3456
#define XB_SPIN_CAP (1u << 18)

__device__ __forceinline__ unsigned xb_ld(unsigned* p)              { return __hip_atomic_load(p, __ATOMIC_RELAXED, __HIP_MEMORY_SCOPE_AGENT); }
__device__ __forceinline__ unsigned xb_add(unsigned* p, unsigned v) { return __hip_atomic_fetch_add(p, v, __ATOMIC_RELAXED, __HIP_MEMORY_SCOPE_AGENT); }
__device__ __forceinline__ unsigned xb_xcc_id() { return (unsigned)__builtin_amdgcn_s_getreg((3 << 11) | 20) & 0xFu; }
#define XB_SPIN(cond, bar) do { unsigned _sp = 0; while (cond) { __builtin_amdgcn_s_sleep(1); \
    if ((++_sp & 255u) == 0u) { if (xb_ld(&(bar)[XB_TMO])) break; if (_sp > XB_SPIN_CAP) { atomicAdd(&(bar)[XB_TMO], 1u); break; } } } } while (0)

struct XcdBarrier {
    unsigned* bar; unsigned x;
    volatile LAS unsigned* st;
    int w0;
};
DEV bool xb_lead(int w0) { return w0 == 0 && __builtin_amdgcn_mbcnt_hi(~0u, __builtin_amdgcn_mbcnt_lo(~0u, 0u)) == 0u; }
__device__ __forceinline__ XcdBarrier xcd_barrier_post(unsigned* bar, volatile LAS unsigned* st, int w0) {
    XcdBarrier b; b.bar = bar; b.x = xb_xcc_id(); b.st = st; b.w0 = w0;
    if (xb_lead(w0)) (void)xb_add(&bar[XB_XCNT(b.x)], 1u);
    return b;
}
__device__ __forceinline__ void xcd_barrier_complete(unsigned* bar, unsigned x, unsigned& nloc, unsigned& nx) {
    const unsigned G = gridDim.x * gridDim.y * gridDim.z;
    unsigned sum, cnt, mine, sp = 0u;
    for (;;) {
        sum = 0u; cnt = 0u; mine = 0u;
#pragma unroll
        for (unsigned j = 0; j < 16; ++j) { const unsigned c = xb_ld(&bar[XB_XCNT(j)]); sum += c; cnt += (c > 0u) ? 1u : 0u; mine = (j == x) ? c : mine; }
        if (sum == G) break;
        __builtin_amdgcn_s_sleep(1);
        if ((++sp & 255u) == 0u) { if (xb_ld(&bar[XB_TMO])) break; if (sp > XB_SPIN_CAP) { atomicAdd(&bar[XB_TMO], 1u); break; } }
    }
    nloc = mine > 0u ? mine : 1u; nx = cnt > 0u ? cnt : 1u;
}
__device__ __forceinline__ void xcd_barrier(const XcdBarrier& b) {
    asm volatile("s_waitcnt vmcnt(0)" ::: "memory");
    __syncthreads();
    if (xb_lead(b.w0)) {
        unsigned* bar = b.bar;
        __builtin_amdgcn_s_waitcnt(0);
        unsigned nloc = b.st[0], nx = b.st[1];
        if (nloc == 0u) { xcd_barrier_complete(bar, b.x, nloc, nx); b.st[0] = nloc; b.st[1] = nx; }
        const unsigned old = xb_add(&bar[XB_XSUB(b.x)], 1u);
        const unsigned gen = old / nloc;
        if (old + 1u == (gen + 1u) * nloc) {
            __builtin_amdgcn_fence(__ATOMIC_RELEASE, "agent");
            asm volatile("s_waitcnt vmcnt(0)" ::: "memory");
            const unsigned og = xb_add(&bar[XB_TOP], 1u);
            const unsigned tg = og / nx;
            if (og + 1u == (tg + 1u) * nx) xb_add(&bar[XB_TOPGEN], 1u);
            else XB_SPIN(xb_ld(&bar[XB_TOPGEN]) == tg, bar);
            __builtin_amdgcn_fence(__ATOMIC_ACQUIRE, "agent");
            xb_add(&bar[XB_XGEN(b.x)], 1u);
            asm volatile("s_waitcnt vmcnt(0)" ::: "memory");
        } else {
            XB_SPIN(xb_ld(&bar[XB_XGEN(b.x)]) == gen, bar);
            __builtin_amdgcn_fence(__ATOMIC_ACQUIRE, "agent");
            asm volatile("s_waitcnt vmcnt(0)" ::: "memory");
        }
    }
    __syncthreads();
}

struct EpiResGate {
    static constexpr bool PERM = false, AFTER_DRAIN = false;
    const bf16* X; bf16* O; const float* gate; float gscale;
    __device__ __forceinline__ void operator()(const pg8::f32x4 (&acc)[2][2][4][2], const pg8::Unit& u, int wr, int wc, int fr, int fq) const {
        const int row0 = u.pm * 256 + wr * 64 + fr, col0 = u.pn * 256 + wc * 32 + 4 * fq;
        const float* gp = gate + (size_t)((u.pm * 256) >> 12) * MODW;
        pg8::f32x4 gv[2][2];
#pragma unroll
        for (int bj = 0; bj < 2; ++bj)
#pragma unroll
            for (int n = 0; n < 2; ++n) gv[bj][n] = *(const pg8::f32x4*)(gp + col0 + bj * 128 + n * 16) * gscale;
#pragma unroll
        for (int ai = 0; ai < 2; ++ai)
#pragma unroll
            for (int m = 0; m < 4; ++m) {
                const size_t ro = (size_t)(row0 + ai * 128 + m * 16) * D + col0;
#pragma unroll
                for (int bj = 0; bj < 2; ++bj)
#pragma unroll
                    for (int n = 0; n < 2; ++n) {
                        const unsigned long long xw = *(const unsigned long long*)(X + ro + bj * 128 + n * 16);
                        const pg8::f32x4 xv = {bf_lo((unsigned)xw), bf_hi((unsigned)xw), bf_lo((unsigned)(xw >> 32)), bf_hi((unsigned)(xw >> 32))};
                        const pg8::f32x4 ov = xv + gv[bj][n] * acc[ai][bj][m][n];
                        *(unsigned long long*)(O + ro + bj * 128 + n * 16) = (unsigned long long)pk2(ov.x, ov.y) | ((unsigned long long)pk2(ov.z, ov.w) << 32);
                    }
            }
    }
};

DEV void ph_mod(const float* __restrict__ c, const float* __restrict__ w_mod, const float* __restrict__ b_mod, float* __restrict__ mod, LAS float* lds_f, int vcu, int G, int tid) {
    const int lane = tid & 63, wave = tid >> 6;
    LAS float* cs = lds_f;
    LAS float* red = lds_f + 4096;
    for (int i = tid; i < 2 * D; i += 512) { const float v = c[i]; cs[i] = v * sigmoid_f(v); }
    __syncthreads();
    const int cg = lane & 15, rg = lane >> 4;
    for (int it = vcu; it < 2 * 192 * 2; it += G) {
        const int kh = it & 1, cb = (it >> 1) % 192, l = it / 384;
        const int k0 = kh * 1024 + wave * 128;
        const float* W = w_mod + ((size_t)l * D + k0 + rg) * MODW + cb * 64 + cg * 4;
        f32x4 a0 = {0.f, 0.f, 0.f, 0.f}, a1 = {0.f, 0.f, 0.f, 0.f};
#pragma unroll 16
        for (int i = 0; i < 32; ++i) {
            const f32x4 w = *(const f32x4*)(W + (size_t)(4 * i) * MODW);
            const float c0 = cs[k0 + 4 * i + rg], c1 = cs[D + k0 + 4 * i + rg];
            a0 += w * c0; a1 += w * c1;
        }
#pragma unroll
        for (int e = 0; e < 4; ++e) { a0[e] += swz_xor<16>(a0[e]); a0[e] = sum32(a0[e]); a1[e] += swz_xor<16>(a1[e]); a1[e] = sum32(a1[e]); }
        if (lane < 16) { *(LAS f32x4*)(red + (wave * 2 + 0) * 64 + cg * 4) = a0; *(LAS f32x4*)(red + (wave * 2 + 1) * 64 + cg * 4) = a1; }
        __syncthreads();
        if (tid < 128) {
            const int bq = tid >> 6, ln = tid & 63; float sacc = 0.f;
#pragma unroll
            for (int w = 0; w < 8; ++w) sacc += red[(w * 2 + bq) * 64 + ln];
            const int col = cb * 64 + ln;
            if (kh == 0) sacc += b_mod[l * MODW + col];
            atomicAdd(mod + (size_t)(l * 2 + bq) * MODW + col, sacc);
        }
        __syncthreads();
    }
}
DEV void transpose_item(const float* __restrict__ W, int K, int N, bf16* __restrict__ WT, LAS float* scr, int item, int lane) {
    const int nblk = N / 32, kb = item / nblk, nb = item % nblk, k0 = 64 * kb, n0 = 32 * nb;
#pragma unroll 8
    for (int i = 0; i < 32; ++i) { const int kk = 2 * i + (lane >> 5); scr[kk * 33 + (lane & 31)] = W[(size_t)(k0 + kk) * N + n0 + (lane & 31)]; }
    LDS_WAIT();
    const int c = lane & 7;
#pragma unroll
    for (int j = 0; j < 4; ++j) { const int n = (lane >> 3) + 8 * j; const LAS float* s = scr + (8 * c) * 33 + n;
        v4u o; o.x = pk2(s[0 * 33], s[1 * 33]); o.y = pk2(s[2 * 33], s[3 * 33]); o.z = pk2(s[4 * 33], s[5 * 33]); o.w = pk2(s[6 * 33], s[7 * 33]);
        *(v4u*)(WT + (size_t)(n0 + n) * K + k0 + 8 * c) = o; }
    LDS_WAIT();
}

DEV void transpose_item64(const float* __restrict__ W, int K, int N, bf16* __restrict__ WT, LAS float* scr, int item, int lane) {
    const int nblk = N / 64, kb = item / nblk, nb = item % nblk, k0 = 64 * kb, n0 = 64 * nb;
#pragma unroll 8
    for (int i = 0; i < 16; ++i) { const int kk = 4 * i + (lane >> 4), nn = 4 * (lane & 15);
        const f32x4 w = *(const f32x4*)(W + (size_t)(k0 + kk) * N + n0 + nn);
        LAS float* d = scr + kk * 65 + nn; d[0] = w.x; d[1] = w.y; d[2] = w.z; d[3] = w.w; }
    LDS_WAIT();
#pragma unroll
    for (int jj = 0; jj < 8; ++jj) { const int pz = lane + 64 * jj, n = pz >> 3, c = pz & 7; const LAS float* sp = scr + (8 * c) * 65 + n;
        v4u o; o.x = pk2(sp[0 * 65], sp[1 * 65]); o.y = pk2(sp[2 * 65], sp[3 * 65]); o.z = pk2(sp[4 * 65], sp[5 * 65]); o.w = pk2(sp[6 * 65], sp[7 * 65]);
        *(v4u*)(WT + (size_t)(n0 + n) * K + k0 + 8 * c) = o; }
    LDS_WAIT();
}
DEV void convert_copy(const float* __restrict__ src, bf16* __restrict__ dst, size_t ngroups8, size_t gtid, size_t gstride) {
    for (size_t g = gtid; g < ngroups8; g += gstride) {
        const f32x4 a = *(const f32x4*)(src + g * 8), b = *(const f32x4*)(src + g * 8 + 4);
        v4u o; o.x = pk2(a.x, a.y); o.y = pk2(a.z, a.w); o.z = pk2(b.x, b.y); o.w = pk2(b.z, b.w);
        *(v4u*)(dst + g * 8) = o;
    }
}

DEV void modnorm_rows(const float* __restrict__ X, const float* __restrict__ gain, const float* __restrict__ modl, int sh_off, int sc_off, bf16* __restrict__ H, int gw, int NGW, int lane, bf16* __restrict__ XC = nullptr) {
    for (int m = gw; m < M; m += NGW) {
        const int b = m >> 12;
        const f32x4* xr = (const f32x4*)(X + (size_t)m * D) + lane;
        f32x4 v[8]; float s = 0.f;
#pragma unroll
        for (int j = 0; j < 8; ++j) { v[j] = xr[64 * j]; s += (v[j].x * v[j].x + v[j].y * v[j].y) + (v[j].z * v[j].z + v[j].w * v[j].w); }
        const float r = rsqrtf(wave_sum(s) * (1.f / D) + EPS);
        const f32x4* g4 = (const f32x4*)gain + lane;
        const f32x4* sc4 = (const f32x4*)(modl + (size_t)b * MODW + sc_off) + lane;
        const f32x4* sh4 = (const f32x4*)(modl + (size_t)b * MODW + sh_off) + lane;
        unsigned long long* o8 = (unsigned long long*)(H + (size_t)m * D) + lane;
#pragma unroll
        for (int j = 0; j < 8; ++j) {
            const f32x4 g = g4[64 * j], sc = sc4[64 * j], sh = sh4[64 * j];
            const f32x4 y = (v[j] * r) * g * (sc + 1.f) + sh;
            o8[64 * j] = (unsigned long long)pk2(y.x, y.y) | ((unsigned long long)pk2(y.z, y.w) << 32);
            if (XC) ((unsigned long long*)(XC + (size_t)m * D) + lane)[64 * j] = (unsigned long long)pk2(v[j].x, v[j].y) | ((unsigned long long)pk2(v[j].z, v[j].w) << 32);
        }
    }
}
DEV void modnorm_rows_h(const bf16* __restrict__ X, const float* __restrict__ gain, const float* __restrict__ modl, int sh_off, int sc_off, bf16* __restrict__ H, int gw, int NGW, int lane) {
    for (int m = gw; m < M; m += NGW) {
        const int b = m >> 12;
        const v4u* xr = (const v4u*)(X + (size_t)m * D) + lane;
        float v[32]; float s = 0.f;
#pragma unroll
        for (int j = 0; j < 4; ++j) { const v4u w = xr[64 * j];
            v[8 * j + 0] = bf_lo(w.x); v[8 * j + 1] = bf_hi(w.x); v[8 * j + 2] = bf_lo(w.y); v[8 * j + 3] = bf_hi(w.y); v[8 * j + 4] = bf_lo(w.z); v[8 * j + 5] = bf_hi(w.z); v[8 * j + 6] = bf_lo(w.w); v[8 * j + 7] = bf_hi(w.w);
#pragma unroll
            for (int e = 0; e < 8; ++e) s += v[8 * j + e] * v[8 * j + e]; }
        const float r = rsqrtf(wave_sum(s) * (1.f / D) + EPS);
        const float* scp = modl + (size_t)b * MODW + sc_off; const float* shp = modl + (size_t)b * MODW + sh_off;
        v4u* o16 = (v4u*)(H + (size_t)m * D) + lane;
#pragma unroll
        for (int j = 0; j < 4; ++j) { const int col = 8 * (lane + 64 * j);
            const f32x4 g0 = *(const f32x4*)(gain + col), g1 = *(const f32x4*)(gain + col + 4), c0 = *(const f32x4*)(scp + col), c1 = *(const f32x4*)(scp + col + 4), h0 = *(const f32x4*)(shp + col), h1 = *(const f32x4*)(shp + col + 4);
            v4u o;
            o.x = pk2(v[8 * j + 0] * r * g0.x * (c0.x + 1.f) + h0.x, v[8 * j + 1] * r * g0.y * (c0.y + 1.f) + h0.y); o.y = pk2(v[8 * j + 2] * r * g0.z * (c0.z + 1.f) + h0.z, v[8 * j + 3] * r * g0.w * (c0.w + 1.f) + h0.w);
            o.z = pk2(v[8 * j + 4] * r * g1.x * (c1.x + 1.f) + h1.x, v[8 * j + 5] * r * g1.y * (c1.y + 1.f) + h1.y); o.w = pk2(v[8 * j + 6] * r * g1.z * (c1.z + 1.f) + h1.z, v[8 * j + 7] * r * g1.w * (c1.w + 1.f) + h1.w);
            o16[64 * j] = o; }
    }
}


DEV unsigned cvtpk_bf16(float lo, float hi) { f32x2 v = {lo, hi}; bf16x2_t b = __builtin_convertvector(v, bf16x2_t); return __builtin_bit_cast(unsigned, b); }
constexpr int DIL_VSTR = 256;
constexpr int ATT_KOFF = 32 * DIL_VSTR;
constexpr int ATT_BOFF = ATT_KOFF + 8192;
constexpr int DIL_QOFF = ATT_BOFF + 132 * 4;
constexpr int ATT_WLDS = 17920;
static_assert(DIL_QOFF <= ATT_WLDS && 8 * ATT_WLDS <= LDS_MISC, "attention LDS");

DEV unsigned vimg_off(unsigned row, unsigned ch) { return 256u * row + 16u * (ch ^ (((row & 3u) << 2) | ((row >> 2) & 3u))); }
typedef short s16x4 __attribute__((ext_vector_type(4)));
DEV bf16x8 vfrag_tr(LAS unsigned char* img, int lane, int c, int ks) {
    const unsigned h = lane >> 5, blk = (lane >> 4) & 1, qq = (lane & 15) >> 2, pp = lane & 3;
    const s16x4 a = __builtin_amdgcn_ds_read_tr16_b64_v4i16((LAS s16x4*)(img + vimg_off(16 * ks + 8 * h + 0 + qq, 4 * c + 2 * blk + (pp >> 1)) + 8 * (pp & 1)));
    const s16x4 b = __builtin_amdgcn_ds_read_tr16_b64_v4i16((LAS s16x4*)(img + vimg_off(16 * ks + 8 * h + 4 + qq, 4 * c + 2 * blk + (pp >> 1)) + 8 * (pp & 1)));
    return __builtin_shufflevector(a, b, 0, 1, 2, 3, 4, 5, 6, 7);
}
DEV void dil_mfma_item(int b, int h, int p, int rr, int i0, const bf16* __restrict__ Z, const float* __restrict__ rel_bias, bf16* __restrict__ PART, float* __restrict__ LSE, LAS unsigned char* wl, int lane) {
    asm volatile("" : "+v"(lane));
    const int r = lane & 31, hh = lane >> 5;
    const int d = 1 << (2 * p);
    LAS float* biasL = (LAS float*)(wl + ATT_BOFF);
    for (int dd = lane; dd < 129; dd += 64) biasL[dd] = rel_bias[(int)T5B[p][dd] * 6 + h];
    const size_t rowq = (size_t)b * SEQ + rr + d * (i0 + r);
    bf16x8 qf[8];
    { const bf16* qrow = Z + rowq * IN_W + ZO_QB + h * 128 + 8 * hh;
#pragma unroll
      for (int ks = 0; ks < 8; ++ks) qf[ks] = *(const bf16x8*)(qrow + 16 * ks); }
    float m_run = NEGBIG, l_run = 0.f;
    f32x16 o[4];
#pragma unroll
    for (int dt = 0; dt < 4; ++dt)
#pragma unroll
        for (int e = 0; e < 16; ++e) o[dt][e] = 0.f;
    const int kap = (r & 0x13) | ((r & 4) << 1) | ((r & 8) >> 1);
    int jt = 4 - (i0 >> 5); jt = jt < 0 ? 0 : jt;
#define DIL_DMA_K(JT) do { int jk = i0 - 128 + 32 * (JT) + kap; jk = jk < 0 ? 0 : jk; const bf16* krow = Z + ((size_t)b * SEQ + rr + d * jk) * IN_W + ZO_KB + h * 128 + 8 * hh; \
        _Pragma("unroll") for (int ks = 0; ks < 8; ++ks) __builtin_amdgcn_global_load_lds((const unsigned*)(krow + 16 * ks), (LAS unsigned*)(wl + ATT_KOFF + 1024 * ks), 16, 0, 0); } while (0)
#define DIL_DMA_V(JT) do { const int j0_ = i0 - 128 + 32 * (JT); _Pragma("unroll") for (int q = 0; q < 8; ++q) { const int pi = lane + 64 * q, kl = pi >> 4, c = (pi & 15) ^ (((kl & 3) << 2) | ((kl >> 2) & 3)); int j = j0_ + kl; j = j < 0 ? 0 : j; \
        __builtin_amdgcn_global_load_lds((const unsigned*)(Z + ((size_t)b * SEQ + rr + d * j) * IN_W + ZO_VB + h * 128 + 8 * c), (LAS unsigned*)(wl + 1024 * q), 16, 0, 0); } } while (0)
    LDS_WAIT();
    DIL_DMA_K(jt); DIL_DMA_V(jt);
    for (; jt < 5; ++jt) {
        const int j0 = i0 - 128 + 32 * jt;
        const int jn = jt < 4 ? jt + 1 : 4;
        asm volatile("s_waitcnt vmcnt(8)" ::: "memory");
        f32x16 sacc;
#pragma unroll
        for (int e = 0; e < 16; ++e) sacc[e] = 0.f;
        {
            bf16x8 kf[8];
#pragma unroll
            for (int ks = 0; ks < 8; ++ks) kf[ks] = *((const LAS bf16x8*)(wl + ATT_KOFF + 1024 * ks) + lane);
#pragma unroll
            for (int ks = 0; ks < 8; ++ks) sacc = __builtin_amdgcn_mfma_f32_32x32x16_bf16(kf[ks], qf[ks], sacc, 0, 0, 0);
        }
        LDS_WAIT();
        DIL_DMA_K(jn);
        float tm = NEGBIG;
#pragma unroll
        for (int e = 0; e < 16; ++e) {
            const int j = j0 + 16 * (e >> 3) + 8 * hh + (e & 7);
            const int dist = (i0 + r) - j;
            const bool valid = (j >= 0) && (dist >= 0) && (dist <= 128);
            const int dc = dist < 0 ? 0 : (dist > 128 ? 128 : dist);
            const float bv = *(volatile LAS float*)(biasL + dc);
            const float lg = valid ? sacc[e] * QSCALE + bv : NEGBIG;
            sacc[e] = lg; tm = fmaxf(tm, lg);
        }
        tm = max32(tm);
        const float m_new = fmaxf(m_run, tm);
        const float alpha = __expf(m_run - m_new);
        float ps = 0.f;
#pragma unroll
        for (int e = 0; e < 16; ++e) { const float pv = (sacc[e] > -1.0e37f) ? __expf(sacc[e] - m_new) : 0.f; sacc[e] = pv; ps += pv; }
        ps = sum32(ps);
        l_run = l_run * alpha + ps; m_run = m_new;
#pragma unroll
        for (int dt = 0; dt < 4; ++dt)
#pragma unroll
            for (int e = 0; e < 16; ++e) o[dt][e] *= alpha;
        bf16x8 pf[2];
#pragma unroll
        for (int s2 = 0; s2 < 2; ++s2) { v4u w; w.x = cvtpk_bf16(sacc[8 * s2 + 0], sacc[8 * s2 + 1]); w.y = cvtpk_bf16(sacc[8 * s2 + 2], sacc[8 * s2 + 3]);
            w.z = cvtpk_bf16(sacc[8 * s2 + 4], sacc[8 * s2 + 5]); w.w = cvtpk_bf16(sacc[8 * s2 + 6], sacc[8 * s2 + 7]); pf[s2] = __builtin_bit_cast(bf16x8, w); }
        asm volatile("s_waitcnt vmcnt(8)" ::: "memory");
#pragma unroll
        for (int dt = 0; dt < 4; ++dt)
#pragma unroll
            for (int s2 = 0; s2 < 2; ++s2) o[dt] = __builtin_amdgcn_mfma_f32_32x32x16_bf16(vfrag_tr(wl, lane, dt, s2), pf[s2], o[dt], 0, 0, 0);
        LDS_WAIT();
        DIL_DMA_V(jn);
    }
    asm volatile("s_waitcnt vmcnt(0)" ::: "memory");
#undef DIL_DMA_V
#undef DIL_DMA_K
    const float inv = 1.f / l_run;
    bf16* po = PART + ((size_t)p * M + rowq) * SWA_W + h * 128;
#pragma unroll
    for (int dt = 0; dt < 4; ++dt)
#pragma unroll
        for (int g = 0; g < 4; ++g)
            *(unsigned long long*)(po + 32 * dt + 8 * g + 4 * hh) = (unsigned long long)pk2(o[dt][4 * g + 0] * inv, o[dt][4 * g + 1] * inv) | ((unsigned long long)pk2(o[dt][4 * g + 2] * inv, o[dt][4 * g + 3] * inv) << 32);
    if (hh == 0) LSE[((size_t)p * M + rowq) * 6 + h] = m_run + __logf(l_run);
}


DEV void lru_item2(int l, int b, int j, int n, const bf16* __restrict__ Z, const float* __restrict__ conv_w, const float* __restrict__ conv_b, const bf16* __restrict__ WGT,
                   const float* __restrict__ b_rec, const float* __restrict__ b_gi, const float* __restrict__ lam,
                   bf16* __restrict__ HLOC, bf16* __restrict__ PP, float* __restrict__ SUMA, float* __restrict__ SUMB, LAS float* xc, LAS float* g0L, LAS float* g1L, int tid) {
    const int ch = tid & 127, tq = tid >> 7, c = n * 128 + ch;
    {
        LAS unsigned char* xaL = (LAS unsigned char*)(g1L + 64 * 132);
        const int t0 = j * 64;
#pragma unroll
        for (int i = 0; i < 3; ++i) { const int pz = tid + 512 * i; if (pz < 67 * 16) { const int row = pz >> 4, cc = pz & 15; const int t = t0 - 3 + row;
            v4u w = {0u, 0u, 0u, 0u}; if (t >= 0) w = *(const v4u*)(Z + ((size_t)b * SEQ + t) * IN_W + ZO_XA + n * 128 + 8 * cc);
            *(LAS v4u*)(xaL + row * 256 + cc * 16) = w; } }
        __syncthreads();
        const float cw0 = conv_w[(l * 4 + 0) * LRU_W + c], cw1 = conv_w[(l * 4 + 1) * LRU_W + c], cw2 = conv_w[(l * 4 + 2) * LRU_W + c], cw3 = conv_w[(l * 4 + 3) * LRU_W + c];
        const float cb = conv_b[l * LRU_W + c];
        const LAS bf16* xp = (const LAS bf16*)xaL + ch;
#pragma unroll 4
        for (int i = 0; i < 16; ++i) {
            const int tok = tq + 4 * i;
            xc[tok * 132 + ch] = cb + cw0 * bf1(xp[(tok + 0) * 128]) + cw1 * bf1(xp[(tok + 1) * 128]) + cw2 * bf1(xp[(tok + 2) * 128]) + cw3 * bf1(xp[(tok + 3) * 128]);
        }
    }
    __syncthreads();
    {
        const int lane = tid & 63, wave = tid >> 6, r = lane & 31, hh = lane >> 5, g = wave >> 2, ct = wave & 3;
        const bf16* wp = WGT + (((size_t)(l * 6 + n) * 2 + g) * 128 + ct * 32 + r) * 128 + 8 * hh;
        bf16x8 bfr[8];
#pragma unroll
        for (int ks = 0; ks < 8; ++ks) bfr[ks] = *(const bf16x8*)(wp + 16 * ks);
        LAS float* gL = g ? g1L : g0L;
#pragma unroll
        for (int rt = 0; rt < 2; ++rt) {
            f32x16 acc;
#pragma unroll
            for (int e = 0; e < 16; ++e) acc[e] = 0.f;
#pragma unroll
            for (int ks = 0; ks < 8; ++ks) {
                const LAS float* xp = xc + (32 * rt + r) * 132 + 16 * ks + 8 * hh;
                const f32x4 x0 = *(const LAS f32x4*)xp, x1 = *(const LAS f32x4*)(xp + 4);
                v4u w; w.x = cvtpk_bf16(x0.x, x0.y); w.y = cvtpk_bf16(x0.z, x0.w); w.z = cvtpk_bf16(x1.x, x1.y); w.w = cvtpk_bf16(x1.z, x1.w);
                acc = __builtin_amdgcn_mfma_f32_32x32x16_bf16(__builtin_bit_cast(bf16x8, w), bfr[ks], acc, 0, 0, 0);
            }
#pragma unroll
            for (int e = 0; e < 16; ++e) { const int tok = 32 * rt + (e & 3) + 8 * (e >> 2) + 4 * hh; gL[tok * 132 + ct * 32 + r] = acc[e]; }
        }
    }
    __syncthreads();
    {
        const float br = b_rec[l * LRU_W + c], bi = b_gi[l * LRU_W + c], sp = softplus_f(-lam[l * LRU_W + c]);
#pragma unroll 4
        for (int i = 0; i < 16; ++i) {
            const int tok = tq + 4 * i;
            const float rg = sigmoid_f(g0L[tok * 132 + ch] + br), ig = sigmoid_f(g1L[tok * 132 + ch] + bi);
            const float log_a = -8.0f * rg * sp;
            const float av = __expf(log_a);
            const float x = xc[tok * 132 + ch];
            const float uv = sqrtf(fmaxf(-expm1f(2.f * log_a), 0.f)) * (ig * x);
            g0L[tok * 132 + ch] = av; g1L[tok * 132 + ch] = uv;
        }
    }
    __syncthreads();
    if (tid < 128) {
        float h = 0.f, P = 1.f;
        const size_t rb = ((size_t)b * SEQ + j * 64) * LRU_W + n * 128 + tid;
#pragma unroll 8
        for (int tok = 0; tok < 64; ++tok) {
            const float av = g0L[tok * 132 + tid];
            h = av * h + g1L[tok * 132 + tid]; P *= av;
            HLOC[rb + (size_t)tok * LRU_W] = (bf16)f2bf(h); PP[rb + (size_t)tok * LRU_W] = (bf16)f2bf(P);
        }
        SUMA[(size_t)(b * 64 + j) * LRU_W + n * 128 + tid] = P; SUMB[(size_t)(b * 64 + j) * LRU_W + n * 128 + tid] = h;
    }
    __syncthreads();
}

DEV void sb_mfma_item(int b, int h, int t0, const bf16* __restrict__ Z, bf16* __restrict__ YC, LAS unsigned char* wl, int lane) {
    asm volatile("" : "+v"(lane));
    const int r = lane & 31, hh = lane >> 5;
    const size_t rowq = (size_t)b * SEQ + t0 + r;
    bf16x8 qf[8];
    { const bf16* qrow = Z + rowq * IN_W + ZO_QC + h * 128 + 8 * hh;
#pragma unroll
      for (int ks = 0; ks < 8; ++ks) qf[ks] = *(const bf16x8*)(qrow + 16 * ks); }
    f32x16 o[4];
#pragma unroll
    for (int dt = 0; dt < 4; ++dt)
#pragma unroll
        for (int e = 0; e < 16; ++e) o[dt][e] = 0.f;
    const int kap = (r & 0x13) | ((r & 4) << 1) | ((r & 8) >> 1);
    float carry = 0.f;
#define SB_DMA_K(K0) do { const bf16* krow = Z + ((size_t)b * SEQ + (K0) + kap) * IN_W + ZO_KC + h * 128 + 8 * hh; \
        _Pragma("unroll") for (int ks = 0; ks < 8; ++ks) __builtin_amdgcn_global_load_lds((const unsigned*)(krow + 16 * ks), (LAS unsigned*)(wl + ATT_KOFF + 1024 * ks), 16, 0, 0); } while (0)
#define SB_DMA_V(K0) do { _Pragma("unroll") for (int q = 0; q < 8; ++q) { const int pi = lane + 64 * q, kl = pi >> 4, c = (pi & 15) ^ (((kl & 3) << 2) | ((kl >> 2) & 3)); \
        __builtin_amdgcn_global_load_lds((const unsigned*)(Z + ((size_t)b * SEQ + (K0) + kl) * IN_W + ZO_VC + h * 128 + 8 * c), (LAS unsigned*)(wl + 1024 * q), 16, 0, 0); } } while (0)
    LDS_WAIT();
    SB_DMA_K(t0); SB_DMA_V(t0);
    for (int k0 = t0; k0 >= 0; k0 -= 32) {
        const int kn = k0 >= 32 ? k0 - 32 : 0;
        asm volatile("s_waitcnt vmcnt(8)" ::: "memory");
        f32x16 sacc;
#pragma unroll
        for (int e = 0; e < 16; ++e) sacc[e] = 0.f;
        {
            bf16x8 kf[8];
#pragma unroll
            for (int ks = 0; ks < 8; ++ks) kf[ks] = *((const LAS bf16x8*)(wl + ATT_KOFF + 1024 * ks) + lane);
#pragma unroll
            for (int ks = 0; ks < 8; ++ks) sacc = __builtin_amdgcn_mfma_f32_32x32x16_bf16(kf[ks], qf[ks], sacc, 0, 0, 0);
        }
        LDS_WAIT();
        SB_DMA_K(kn);
        float l1[16]; float T0 = 0.f, T1 = 0.f;
#pragma unroll
        for (int e = 0; e < 16; ++e) {
            const int key = k0 + 16 * (e >> 3) + 8 * hh + (e & 7);
            const bool valid = key < t0 + r;
            const float z = sacc[e] * QSCALE;
            sacc[e] = z;
            l1[e] = valid ? -(fmaxf(z, 0.f) + __logf(1.f + __expf(-fabsf(z)))) : 0.f;
        }
#pragma unroll
        for (int e = 0; e < 8; ++e) { T0 += l1[e]; T1 += l1[8 + e]; }
        const float PT0 = partner32(T0, hh), PT1 = partner32(T1, hh);
        const float base1 = carry + (hh ? 0.f : PT1);
        const float base0 = carry + (hh ? (T1 + PT1) : (PT1 + T1 + PT0));
        float run1 = base1, run0 = base0;
#pragma unroll
        for (int e = 7; e >= 0; --e) {
            { const int key = k0 + 16 + 8 * hh + e; const bool valid = key < t0 + r; const float a = valid ? __expf(sacc[8 + e] + l1[8 + e] + run1) : 0.f; run1 += l1[8 + e]; sacc[8 + e] = a; }
            { const int key = k0 + 8 * hh + e; const bool valid = key < t0 + r; const float a = valid ? __expf(sacc[e] + l1[e] + run0) : 0.f; run0 += l1[e]; sacc[e] = a; }
        }
        carry += (T0 + T1) + (PT0 + PT1);
        bf16x8 pf[2];
#pragma unroll
        for (int s2 = 0; s2 < 2; ++s2) { v4u w; w.x = cvtpk_bf16(sacc[8 * s2 + 0], sacc[8 * s2 + 1]); w.y = cvtpk_bf16(sacc[8 * s2 + 2], sacc[8 * s2 + 3]);
            w.z = cvtpk_bf16(sacc[8 * s2 + 4], sacc[8 * s2 + 5]); w.w = cvtpk_bf16(sacc[8 * s2 + 6], sacc[8 * s2 + 7]); pf[s2] = __builtin_bit_cast(bf16x8, w); }
        asm volatile("s_waitcnt vmcnt(8)" ::: "memory");
#pragma unroll
        for (int dt = 0; dt < 4; ++dt)
#pragma unroll
            for (int s2 = 0; s2 < 2; ++s2) o[dt] = __builtin_amdgcn_mfma_f32_32x32x16_bf16(vfrag_tr(wl, lane, dt, s2), pf[s2], o[dt], 0, 0, 0);
        LDS_WAIT();
        SB_DMA_V(kn);
        if (__all(carry < -105.0f)) break;
    }
    asm volatile("s_waitcnt vmcnt(0)" ::: "memory");
#undef SB_DMA_V
#undef SB_DMA_K
    bf16* po = YC + rowq * SB_W + h * 128;
#pragma unroll
    for (int dt = 0; dt < 4; ++dt)
#pragma unroll
        for (int g = 0; g < 4; ++g)
            *(unsigned long long*)(po + 32 * dt + 8 * g + 4 * hh) = (unsigned long long)pk2(o[dt][4 * g + 0], o[dt][4 * g + 1]) | ((unsigned long long)pk2(o[dt][4 * g + 2], o[dt][4 * g + 3]) << 32);
}

DEV void combine_item(int l, int b, int j, int half, const bf16* __restrict__ Z, const bf16* __restrict__ HLOC, const bf16* __restrict__ PP, const float* __restrict__ SUMA, const float* __restrict__ SUMB,
                      const bf16* __restrict__ PART, const float* __restrict__ LSE, const bf16* __restrict__ YC, const float* __restrict__ g_lru, const float* __restrict__ g_swa, const float* __restrict__ g_sb,
                      bf16* __restrict__ Y, LAS float* carryL, int tid) {
    const int lane = tid & 63, wave = tid >> 6;
    for (int c = tid; c < LRU_W; c += 512) {
        float cr = 0.f; int i = 0;
        for (; i + 8 <= j; i += 8) {
            float av[8], bv[8];
#pragma unroll
            for (int u = 0; u < 8; ++u) { av[u] = SUMA[(size_t)(b * 64 + i + u) * LRU_W + c]; bv[u] = SUMB[(size_t)(b * 64 + i + u) * LRU_W + c]; }
#pragma unroll
            for (int u = 0; u < 8; ++u) cr = av[u] * cr + bv[u];
        }
        for (; i < j; ++i) cr = SUMA[(size_t)(b * 64 + i) * LRU_W + c] * cr + SUMB[(size_t)(b * 64 + i) * LRU_W + c];
        carryL[c] = cr;
    }
    __syncthreads();
    for (int i = 0; i < 4; ++i) {
        const int tok = half * 32 + wave * 4 + i;
        const size_t row = (size_t)b * SEQ + j * 64 + tok;
        bf16* yo = Y + row * D;
        {
            float ya[12]; float ssq = 0.f;
#pragma unroll
            for (int e = 0; e < 6; ++e) { const int c = 2 * lane + 128 * e;
                const unsigned hw = *(const unsigned*)(HLOC + row * LRU_W + c), pw = *(const unsigned*)(PP + row * LRU_W + c), gw2 = *(const unsigned*)(Z + row * IN_W + ZO_GA + c);
                const f32x2 cr = *(const LAS f32x2*)(carryL + c);
                ya[2 * e] = (bf_lo(hw) + bf_lo(pw) * cr.x) * gelu_tanh(bf_lo(gw2)); ya[2 * e + 1] = (bf_hi(hw) + bf_hi(pw) * cr.y) * gelu_tanh(bf_hi(gw2));
                ssq += ya[2 * e] * ya[2 * e] + ya[2 * e + 1] * ya[2 * e + 1]; }
            const float r = rsqrtf(wave_sum(ssq) * (1.f / LRU_W) + EPS);
#pragma unroll
            for (int e = 0; e < 6; ++e) { const int c = 2 * lane + 128 * e; const f32x2 g = *(const f32x2*)(g_lru + l * LRU_W + c);
                *(unsigned*)(yo + c) = pk2(ya[2 * e] * r * g.x, ya[2 * e + 1] * r * g.y); }
        }
        {
            float yb[12]; float ssq = 0.f;
#pragma unroll
            for (int e = 0; e < 6; ++e) { const int c = 2 * lane + 128 * e;
                const float l0 = LSE[((size_t)0 * M + row) * 6 + e], l1 = LSE[((size_t)1 * M + row) * 6 + e], l2 = LSE[((size_t)2 * M + row) * 6 + e];
                const float mx = fmaxf(l0, fmaxf(l1, l2)); const float e0 = __expf(l0 - mx), e1 = __expf(l1 - mx), e2 = __expf(l2 - mx); const float iz = 1.f / (e0 + e1 + e2);
                const unsigned p0 = *(const unsigned*)(PART + ((size_t)0 * M + row) * SWA_W + c), p1 = *(const unsigned*)(PART + ((size_t)1 * M + row) * SWA_W + c), p2 = *(const unsigned*)(PART + ((size_t)2 * M + row) * SWA_W + c);
                yb[2 * e] = (e0 * bf_lo(p0) + e1 * bf_lo(p1) + e2 * bf_lo(p2)) * iz; yb[2 * e + 1] = (e0 * bf_hi(p0) + e1 * bf_hi(p1) + e2 * bf_hi(p2)) * iz;
                ssq += yb[2 * e] * yb[2 * e] + yb[2 * e + 1] * yb[2 * e + 1]; }
            const float r = rsqrtf(wave_sum(ssq) * (1.f / SWA_W) + EPS);
#pragma unroll
            for (int e = 0; e < 6; ++e) { const int c = 2 * lane + 128 * e; const f32x2 g = *(const f32x2*)(g_swa + l * SWA_W + c);
                *(unsigned*)(yo + LRU_W + c) = pk2(yb[2 * e] * r * g.x, yb[2 * e + 1] * r * g.y); }
        }
        {
            float yc[8]; float ssq = 0.f;
#pragma unroll
            for (int e = 0; e < 4; ++e) { const int c = 2 * lane + 128 * e; const unsigned w = *(const unsigned*)(YC + row * SB_W + c); yc[2 * e] = bf_lo(w); yc[2 * e + 1] = bf_hi(w); ssq += yc[2 * e] * yc[2 * e] + yc[2 * e + 1] * yc[2 * e + 1]; }
            const float r = rsqrtf(wave_sum(ssq) * (1.f / SB_W) + EPS);
#pragma unroll
            for (int e = 0; e < 4; ++e) { const int c = 2 * lane + 128 * e; const f32x2 g = *(const f32x2*)(g_sb + l * SB_W + c);
                *(unsigned*)(yo + LRU_W + SWA_W + c) = pk2(yc[2 * e] * r * g.x, yc[2 * e + 1] * r * g.y); }
        }
    }
    __syncthreads();
}


constexpr float U8_SCALE = 64.f;
DEV void convert_fp8(const float* __restrict__ src, unsigned char* __restrict__ dst, size_t ngroups16, size_t gtid, size_t gstride, float scale) {
    for (size_t g = gtid; g < ngroups16; g += gstride) {
        const f32x4 a = *(const f32x4*)(src + g * 16) * scale, b = *(const f32x4*)(src + g * 16 + 4) * scale, c = *(const f32x4*)(src + g * 16 + 8) * scale, d = *(const f32x4*)(src + g * 16 + 12) * scale;
        int w0 = 0, w1 = 0, w2 = 0, w3 = 0;
        w0 = __builtin_amdgcn_cvt_pk_fp8_f32(a.x, a.y, w0, false); w0 = __builtin_amdgcn_cvt_pk_fp8_f32(a.z, a.w, w0, true);
        w1 = __builtin_amdgcn_cvt_pk_fp8_f32(b.x, b.y, w1, false); w1 = __builtin_amdgcn_cvt_pk_fp8_f32(b.z, b.w, w1, true);
        w2 = __builtin_amdgcn_cvt_pk_fp8_f32(c.x, c.y, w2, false); w2 = __builtin_amdgcn_cvt_pk_fp8_f32(c.z, c.w, w2, true);
        w3 = __builtin_amdgcn_cvt_pk_fp8_f32(d.x, d.y, w3, false); w3 = __builtin_amdgcn_cvt_pk_fp8_f32(d.z, d.w, w3, true);
        *(v4u*)(dst + g * 16) = (v4u){(unsigned)w0, (unsigned)w1, (unsigned)w2, (unsigned)w3};
    }
}

constexpr int R2_SC = 0, R2_TV = 128 * 129 * 4, R2_TI = R2_TV + 128 * 16 * 4, R2_END = R2_TI + 128 * 16 * 4;
static_assert(R2_END <= LDS_MISC, "routing v2 LDS");
DEV unsigned ord_key(float s) { const unsigned u = __builtin_bit_cast(unsigned, s); return (u & 0x80000000u) ? ~u : (u | 0x80000000u); }

#define KEY_CE(A, B) do { const unsigned hi_ = (A) > (B) ? (A) : (B); const unsigned lo_ = (A) > (B) ? (B) : (A); (A) = hi_; (B) = lo_; } while (0)
DEV void bitonic_sort16_desc(unsigned (&a)[16]) {
#pragma unroll
    for (int k = 2; k <= 16; k <<= 1)
#pragma unroll
        for (int j = k >> 1; j > 0; j >>= 1)
#pragma unroll
            for (int i = 0; i < 16; ++i) { const int m = i ^ j; if (m > i) { if ((i & k) == 0) KEY_CE(a[i], a[m]); else KEY_CE(a[m], a[i]); } }
}
DEV void bitonic_merge16_desc(unsigned (&a)[16]) {
#pragma unroll
    for (int j = 8; j > 0; j >>= 1)
#pragma unroll
        for (int i = 0; i < 16; ++i) { const int m = i ^ j; if (m > i) KEY_CE(a[i], a[m]); }
}
DEV void route_item2(int l, int tile, int h, const bf16* __restrict__ Q, const bf16* __restrict__ SK, int* __restrict__ IDS, float* __restrict__ GG, LAS unsigned char* lds, int tid, int seq,
                        const float* __restrict__ cv_u, const float* __restrict__ cv_v, unsigned char* __restrict__ cv_u8, unsigned char* __restrict__ cv_v8) {
    LAS float* sc = (LAS float*)(lds + R2_SC); LAS float* tv = (LAS float*)(lds + R2_TV); LAS int* ti = (LAS int*)(lds + R2_TI);
    const int lane = tid & 63, wave = tid >> 6, row0 = tile * 64;
    {
        const int r = lane & 31, hh = lane >> 5, c = wave >> 2, key0 = 32 * (wave & 3);
        const bf16* skp = SK + ((size_t)(((l * 8 + h) * 2 + c) * 128 + key0 + r)) * 128 + 8 * hh;
        bf16x8 bfr[8];
#pragma unroll
        for (int ks = 0; ks < 8; ++ks) bfr[ks] = *(const bf16x8*)(skp + 16 * ks);
#pragma unroll
        for (int rt = 0; rt < 2; ++rt) {
            const bf16* qp = Q + (size_t)(row0 + 32 * rt + r) * D + h * 256 + c * 128 + 8 * hh;
            bf16x8 afr[8];
#pragma unroll
            for (int ks = 0; ks < 8; ++ks) afr[ks] = *(const bf16x8*)(qp + 16 * ks);
            f32x16 acc;
#pragma unroll
            for (int e = 0; e < 16; ++e) acc[e] = 0.f;
#pragma unroll
            for (int ks = 0; ks < 8; ++ks) acc = __builtin_amdgcn_mfma_f32_32x32x16_bf16(afr[ks], bfr[ks], acc, 0, 0, 0);
#pragma unroll
            for (int e = 0; e < 16; ++e) { const int tok = 32 * rt + (e & 3) + 8 * (e >> 2) + 4 * hh; sc[(c * 64 + tok) * 129 + key0 + r] = acc[e]; }
        }
    }
    __syncthreads();
    if (tid >= 128) {
        const size_t TG = (size_t)NEXP * D / 16;
        const size_t g0 = (size_t)(tile * 8 + h) * 4096;
#pragma unroll 4
        for (int k = 0; k < 11; ++k) { const size_t g = g0 + (size_t)(tid - 128) + 384u * k;
            if (g < g0 + 4096) { const bool isv = g >= TG; const size_t gg = isv ? g - TG : g;
                convert_fp8((isv ? cv_v : cv_u) + gg * 16, (isv ? cv_v8 : cv_u8) + gg * 16, 1, 0, 1, isv ? 1.f : U8_SCALE); } }
    }
    if (tid < 128) {
        const int L = tid;
        unsigned t[16];
#pragma unroll
        for (int q = 0; q < 16; ++q) t[q] = 0u;
#pragma unroll 1
        for (int blk = 0; blk < 8; ++blk) {
            unsigned bk[16];
#pragma unroll
            for (int i = 0; i < 16; ++i) { const int k = blk * 16 + i; bk[i] = (ord_key(sc[L * 129 + k]) & ~127u) | (unsigned)(127 - k); }
            bitonic_sort16_desc(bk);
#pragma unroll
            for (int i = 0; i < 16; ++i) t[i] = t[i] > bk[15 - i] ? t[i] : bk[15 - i];
            bitonic_merge16_desc(t);
        }
#pragma unroll
        for (int q = 0; q < 16; ++q) { const int idx = 127 - (int)(t[q] & 127u); tv[L * 16 + q] = sc[L * 129 + idx]; ti[L * 16 + q] = idx; }
    }
    if (wave == 1) { LDS_WAIT(); if (lane == 0) *(volatile LAS int*)(lds + LDS_MISC + 128) = seq; }
    if (wave == 0) { LDS_WAIT(); while (*(volatile LAS int*)(lds + LDS_MISC + 128) != seq) __builtin_amdgcn_s_sleep(1); }
    if (tid < 64) {
        const int tok = tid;
        float a[16], bq[16];
#pragma unroll
        for (int i = 0; i < 16; ++i) { a[i] = tv[tok * 16 + i]; bq[i] = tv[(64 + tok) * 16 + i]; }
        unsigned t[16];
#pragma unroll
        for (int q = 0; q < 16; ++q) t[q] = 0u;
#pragma unroll
        for (int i = 0; i < 16; ++i)
#pragma unroll
            for (int j = 0; j < 16 / (i + 1); ++j) {
                unsigned key = (ord_key(a[i] + bq[j]) & ~255u) | (unsigned)(255 - (i * 16 + j));
#pragma unroll
                for (int q = 0; q < 16; ++q) { const unsigned hi = t[q] > key ? t[q] : key; key = t[q] > key ? key : t[q]; t[q] = hi; }
            }
        float scv[16]; int idv[16]; float mx = NEGBIG;
#pragma unroll
        for (int q = 0; q < 16; ++q) { const int ci = 255 - (int)(t[q] & 255u); const int i = ci >> 4, j = ci & 15;
            scv[q] = tv[tok * 16 + i] + tv[(64 + tok) * 16 + j]; idv[q] = ti[tok * 16 + i] * 128 + ti[(64 + tok) * 16 + j]; mx = fmaxf(mx, scv[q]); }
        float sum = 0.f;
#pragma unroll
        for (int q = 0; q < 16; ++q) { scv[q] = __expf(scv[q] - mx); sum += scv[q]; }
        const float inv = 1.f / sum;
        int* ip = IDS + (size_t)(row0 + tok) * 128 + h * 16; float* gp = GG + (size_t)(row0 + tok) * 128 + h * 16;
#pragma unroll
        for (int q4 = 0; q4 < 4; ++q4) {
            *(int4*)(ip + 4 * q4) = make_int4(idv[4 * q4], idv[4 * q4 + 1], idv[4 * q4 + 2], idv[4 * q4 + 3]);
            *(f32x4*)(gp + 4 * q4) = (f32x4){scv[4 * q4] * inv, scv[4 * q4 + 1] * inv, scv[4 * q4 + 2] * inv, scv[4 * q4 + 3] * inv};
        }
    }
    __syncthreads();
}


DEV void expert_row8(int l, int row, const bf16* H, const int* __restrict__ IDS, const float* __restrict__ GG, const unsigned char* __restrict__ U8, const unsigned char* __restrict__ V8,
                     const bf16* __restrict__ X1, const float* __restrict__ g2, const float* __restrict__ fnorm, float* __restrict__ XO, bf16* __restrict__ XOH, int lane, float pscale, LAS int* sortL,
                     const float* __restrict__ ngain, const float* __restrict__ nmod, bf16* Hout) {
    f32x2 x[16];
#pragma unroll
    for (int j = 0; j < 2; ++j) {
        const v4u a = *(const v4u*)(H + (size_t)row * D + lane * 16 + 1024 * j), c = *(const v4u*)(H + (size_t)row * D + lane * 16 + 1024 * j + 8);
        x[j * 8 + 0] = (f32x2){bf_lo(a.x), bf_hi(a.x)}; x[j * 8 + 1] = (f32x2){bf_lo(a.y), bf_hi(a.y)}; x[j * 8 + 2] = (f32x2){bf_lo(a.z), bf_hi(a.z)}; x[j * 8 + 3] = (f32x2){bf_lo(a.w), bf_hi(a.w)};
        x[j * 8 + 4] = (f32x2){bf_lo(c.x), bf_hi(c.x)}; x[j * 8 + 5] = (f32x2){bf_lo(c.y), bf_hi(c.y)}; x[j * 8 + 6] = (f32x2){bf_lo(c.z), bf_hi(c.z)}; x[j * 8 + 7] = (f32x2){bf_lo(c.w), bf_hi(c.w)};
    }
    int id0 = IDS[(size_t)row * 128 + lane], id1 = IDS[(size_t)row * 128 + 64 + lane];
    float gg0 = GG[(size_t)row * 128 + lane], gg1 = GG[(size_t)row * 128 + 64 + lane];
    {
        const int w0 = id0 >> 9, w1 = id1 >> 9; int p0 = 0, p1 = 0, base = 0;
        for (int w = 0; w < 32; ++w) {
            const unsigned long long m0 = __ballot(w0 == w), m1 = __ballot(w1 == w);
            const int c0 = __popcll(m0), c1 = __popcll(m1);
            const int b0 = (int)__builtin_amdgcn_mbcnt_hi((unsigned)(m0 >> 32), __builtin_amdgcn_mbcnt_lo((unsigned)m0, 0u));
            const int b1 = (int)__builtin_amdgcn_mbcnt_hi((unsigned)(m1 >> 32), __builtin_amdgcn_mbcnt_lo((unsigned)m1, 0u));
            p0 = (w0 == w) ? base + b0 : p0; p1 = (w1 == w) ? base + c0 + b1 : p1;
            base += c0 + c1;
        }
        sortL[p0] = id0; sortL[p1] = id1; ((LAS float*)sortL)[128 + p0] = gg0; ((LAS float*)sortL)[128 + p1] = gg1;
        LDS_WAIT();
        id0 = sortL[lane]; id1 = sortL[64 + lane]; gg0 = ((LAS float*)sortL)[128 + lane]; gg1 = ((LAS float*)sortL)[192 + lane];
        LDS_WAIT();
    }
    float wv0 = 0.f, wv1 = 0.f;
    const unsigned char* Ul = U8 + (size_t)l * NEXP * D + lane * 16;
    const unsigned char* Vl = V8 + (size_t)l * NEXP * D + lane * 16;
    for (int e0 = 0; e0 < 128; e0 += 8) {
        v4u uu[8][2];
#pragma unroll
        for (int q = 0; q < 8; ++q) { const int e = e0 + q; const int id = (e < 64) ? __builtin_amdgcn_readlane(id0, e & 63) : __builtin_amdgcn_readlane(id1, e & 63);
            uu[q][0] = *(const v4u*)(Ul + (size_t)id * D); uu[q][1] = *(const v4u*)(Ul + (size_t)id * D + 1024); }
        float ds[8];
#pragma unroll
        for (int q = 0; q < 8; ++q) {
            f32x2 acc = {0.f, 0.f};
#pragma unroll
            for (int j = 0; j < 2; ++j) {
                const unsigned wd[4] = {uu[q][j].x, uu[q][j].y, uu[q][j].z, uu[q][j].w};
#pragma unroll
                for (int dw = 0; dw < 4; ++dw) {
                    const f32x2 lo = __builtin_amdgcn_cvt_pk_f32_fp8((int)wd[dw], false), hi = __builtin_amdgcn_cvt_pk_f32_fp8((int)wd[dw], true);
                    acc = __builtin_elementwise_fma(lo, x[j * 8 + 2 * dw], acc); acc = __builtin_elementwise_fma(hi, x[j * 8 + 2 * dw + 1], acc);
                }
            }
            ds[q] = acc.x + acc.y;
        }
#pragma unroll
        for (int q = 0; q < 8; ++q) ds[q] += swz_xor<1>(ds[q]);
#pragma unroll
        for (int q = 0; q < 8; ++q) ds[q] += swz_xor<2>(ds[q]);
#pragma unroll
        for (int q = 0; q < 8; ++q) ds[q] += swz_xor<4>(ds[q]);
#pragma unroll
        for (int q = 0; q < 8; ++q) ds[q] += swz_xor<8>(ds[q]);
#pragma unroll
        for (int q = 0; q < 8; ++q) ds[q] += swz_xor<16>(ds[q]);
#pragma unroll
        for (int q = 0; q < 8; ++q) ds[q] = sum32(ds[q]);
#pragma unroll
        for (int q = 0; q < 8; ++q) { const int e = e0 + q;
            const float gq = (e < 64) ? __builtin_bit_cast(float, __builtin_amdgcn_readlane(__builtin_bit_cast(int, gg0), e & 63)) : __builtin_bit_cast(float, __builtin_amdgcn_readlane(__builtin_bit_cast(int, gg1), e & 63));
            const float w = gq * gelu_tanh(ds[q] * (1.f / U8_SCALE));
            if (e < 64) wv0 = (lane == (e & 63)) ? w : wv0; else wv1 = (lane == (e & 63)) ? w : wv1; }
    }
    f32x2 y[16];
#pragma unroll
    for (int i = 0; i < 16; ++i) y[i] = (f32x2){0.f, 0.f};
    for (int e0 = 0; e0 < 128; e0 += 8) {
        v4u vv[8][2];
#pragma unroll
        for (int q = 0; q < 8; ++q) { const int e = e0 + q; const int id = (e < 64) ? __builtin_amdgcn_readlane(id0, e & 63) : __builtin_amdgcn_readlane(id1, e & 63);
            vv[q][0] = *(const v4u*)(Vl + (size_t)id * D); vv[q][1] = *(const v4u*)(Vl + (size_t)id * D + 1024); }
#pragma unroll
        for (int q = 0; q < 8; ++q) { const int e = e0 + q;
            const float w = (e < 64) ? __builtin_bit_cast(float, __builtin_amdgcn_readlane(__builtin_bit_cast(int, wv0), e & 63)) : __builtin_bit_cast(float, __builtin_amdgcn_readlane(__builtin_bit_cast(int, wv1), e & 63));
            const f32x2 w2 = {w, w};
#pragma unroll
            for (int j = 0; j < 2; ++j) {
                const unsigned wd[4] = {vv[q][j].x, vv[q][j].y, vv[q][j].z, vv[q][j].w};
#pragma unroll
                for (int dw = 0; dw < 4; ++dw) {
                    const f32x2 lo = __builtin_amdgcn_cvt_pk_f32_fp8((int)wd[dw], false), hi = __builtin_amdgcn_cvt_pk_f32_fp8((int)wd[dw], true);
                    y[j * 8 + 2 * dw] = __builtin_elementwise_fma(w2, lo, y[j * 8 + 2 * dw]); y[j * 8 + 2 * dw + 1] = __builtin_elementwise_fma(w2, hi, y[j * 8 + 2 * dw + 1]);
                }
            }
        }
    }
    float ssq = 0.f;
#pragma unroll
    for (int j = 0; j < 2; ++j)
#pragma unroll
        for (int k4 = 0; k4 < 4; ++k4) {
            const int col = lane * 16 + 1024 * j + 4 * k4;
            const unsigned long long xw = *(const unsigned long long*)(X1 + (size_t)row * D + col); const f32x4 xa = {bf_lo((unsigned)xw), bf_hi((unsigned)xw), bf_lo((unsigned)(xw >> 32)), bf_hi((unsigned)(xw >> 32))}; const f32x4 ga = *(const f32x4*)(g2 + col) * pscale;
            f32x2& ya = y[j * 8 + 2 * k4]; f32x2& yb = y[j * 8 + 2 * k4 + 1];
            ya.x = xa.x + ga.x * ya.x; ya.y = xa.y + ga.y * ya.y; yb.x = xa.z + ga.z * yb.x; yb.y = xa.w + ga.w * yb.y;
            ssq += (ya.x * ya.x + ya.y * ya.y) + (yb.x * yb.x + yb.y * yb.y);
        }
    const float r = rsqrtf(wave_sum(ssq) * (1.f / D) + EPS);
#pragma unroll
    for (int j = 0; j < 2; ++j)
#pragma unroll
        for (int k4 = 0; k4 < 4; ++k4) {
            const int col = lane * 16 + 1024 * j + 4 * k4;
            const f32x2 ya = y[j * 8 + 2 * k4], yb = y[j * 8 + 2 * k4 + 1];
            f32x4 ov = {ya.x, ya.y, yb.x, yb.y};
            if (fnorm) *(f32x4*)(XO + (size_t)row * D + col) = ov * r * *(const f32x4*)(fnorm + col);
            else *(unsigned long long*)(XOH + (size_t)row * D + col) = (unsigned long long)pk2(ov.x, ov.y) | ((unsigned long long)pk2(ov.z, ov.w) << 32);
            if (ngain) {
                const f32x4 g = *(const f32x4*)(ngain + col), sc = *(const f32x4*)(nmod + MO_SC1 + col), sh = *(const f32x4*)(nmod + MO_SH1 + col);
                const f32x4 hv = (ov * r) * g * (sc + 1.f) + sh;
                *(unsigned long long*)(Hout + (size_t)row * D + col) = (unsigned long long)pk2(hv.x, hv.y) | ((unsigned long long)pk2(hv.z, hv.w) << 32);
            }
        }
}


struct Args { const float* in[24]; float* out; unsigned char* ws; int ph_lo, ph_hi, li, pad; };

__global__ void __launch_bounds__(512, 2) fwd(Args a) {
    extern __shared__ __attribute__((aligned(16))) unsigned char lds_raw[];
    LAS unsigned char* lds = (LAS unsigned char*)lds_raw;
#define PHASE_TID() unsigned zz_ = 0u; asm volatile("" : "+v"(zz_));   \
    int tid = wave0 * 64 + (int)__builtin_amdgcn_mbcnt_hi(~0u, __builtin_amdgcn_mbcnt_lo(~0u, zz_)); const int lane = tid & 63; (void)lane; \
    int bx = blockIdx.x, G = gridDim.x; asm volatile("" : "+s"(bx), "+s"(G)); const int wave = __builtin_amdgcn_readfirstlane(tid >> 6); \
    const int vcu = (G % 8 == 0) ? (bx % 8) * (G / 8) + bx / 8 : bx; const int gw = vcu * 8 + wave, NGW = G * 8; (void)gw; (void)NGW; (void)vcu; (void)wave; \
    const __attribute__((address_space(4))) Args* A = (const __attribute__((address_space(4))) Args*)__builtin_amdgcn_kernarg_segment_ptr(); asm volatile("" : "+s"(A))
    unsigned* ctl = (unsigned*)(a.ws + WS_CTL);
    const int lo = a.ph_lo, hi = a.ph_hi;
    const int wave0 = __builtin_amdgcn_readfirstlane((int)threadIdx.x >> 6);
    for (int u = threadIdx.x; u < (LDS_BYTES - LDS_MISC) / 4; u += 512) ((LAS unsigned*)(lds + LDS_MISC))[u] = 0u;
    __syncthreads();
    XcdBarrier bar; bar.bar = ctl + CW_BAR + (a.li & 7) * XCD_BAR_WORDS; bar.x = 0; bar.st = (volatile LAS unsigned*)(lds + LDS_MISC + 64); bar.w0 = wave0;
    if (hi - lo > 1) bar = xcd_barrier_post(ctl + CW_BAR + (a.li & 7) * XCD_BAR_WORDS, (volatile LAS unsigned*)(lds + LDS_MISC + 64), wave0);
#define IN(k) (lo <= (k) && (k) < hi)
#define SEAM(k) do { if (IN(k) && IN((k) + 1)) xcd_barrier(bar); } while (0)

#define mod   ((float*)(A->ws + WS_MOD))
#define WIN_T ((bf16*)(A->ws + WS_WIN_T))
#define WOUT_T ((bf16*)(A->ws + WS_WOUT_T))
#define WQ_T  ((bf16*)(A->ws + WS_WQ_T))
#define SUBK  ((bf16*)(A->ws + WS_SUBK))
#define UB    ((bf16*)(A->ws + WS_U))
#define VB    ((bf16*)(A->ws + WS_V))
#define H     ((bf16*)(A->ws + WS_H))
#define Z     ((bf16*)(A->ws + WS_Z))
#define HLOC  ((bf16*)(A->ws + WS_HLOC))
#define PP    ((bf16*)(A->ws + WS_P))
#define YB    ((float*)(A->ws + WS_YB))
#define YC    ((bf16*)(A->ws + WS_YC))
#define SUMA  ((float*)(A->ws + WS_SUMA))
#define SUMB  ((float*)(A->ws + WS_SUMB))
#define X1    ((float*)(A->ws + WS_X1))
#define X2    ((float*)(A->ws + WS_X2))
#define QB    ((bf16*)(A->ws + WS_Q))
#define IDS   ((int*)(A->ws + WS_IDS))
#define GG    ((float*)(A->ws + WS_G))
#define PARTB ((bf16*)(A->ws + WS_PART))
#define WG_T  ((bf16*)(A->ws + WS_WG_T))
#define LSEB  ((float*)(A->ws + WS_LSE))
#define XIN   ((l == 0) ? A->in[0] : (const float*)X2)
#define XR    ((bf16*)(A->ws + WS_XR))
#define X1H   ((bf16*)(A->ws + WS_X1))
#define X2H   ((bf16*)(A->ws + WS_X2))
#define XRES  ((l == 0) ? (const bf16*)XR : (const bf16*)X2H)
#define MODL  (mod + (size_t)l * 2 * MODW)
    if (IN(0)) {
        PHASE_TID();
        ph_mod(A->in[1], A->in[2], A->in[3], mod, (LAS float*)lds, vcu, G, tid);
        {
            LAS float* scr = (LAS float*)(lds + wave * 17408);
            constexpr int I_IN = (D / 64) * (IN_W / 64), I_SQ = (D / 64) * (D / 64), I_L = I_IN + 2 * I_SQ;
            for (int it = gw; it < 2 * I_L; it += NGW) {
                const int l = it / I_L; int r = it % I_L;
                if (r < I_IN) { transpose_item64(A->in[6] + (size_t)l * D * IN_W, D, IN_W, WIN_T + (size_t)l * IN_W * D, scr, r, lane); continue; } r -= I_IN;
                if (r < I_SQ) { transpose_item64(A->in[18] + (size_t)l * D * D, D, D, WOUT_T + (size_t)l * D * D, scr, r, lane); continue; } r -= I_SQ;
                transpose_item64(A->in[19] + (size_t)l * D * D, D, D, WQ_T + (size_t)l * D * D, scr, r, lane);
            }
        }
        {
            LAS float* scr = (LAS float*)(lds + wave * 17408);
            for (int it = gw; it < 2 * 6 * 2 * 8; it += NGW) { const int mi = it >> 3, sub = it & 7; const int ln = mi >> 1, g = mi & 1;
                transpose_item((g ? A->in[11] : A->in[9]) + (size_t)ln * 128 * 128, 128, 128, WG_T + ((size_t)ln * 2 + g) * 128 * 128, scr, sub, lane); }
        }
        const size_t gtid = (size_t)vcu * 512 + tid, gstride = (size_t)G * 512;
        convert_copy(A->in[20], SUBK, (size_t)2 * 8 * 2 * 128 * 128 / 8, gtid, gstride);
    }
    SEAM(0);

    for (int l = 0; l < NL; ++l) {
        const int pb = 1 + 9 * l;
        if (IN(pb + 0) && l == 0) { PHASE_TID(); modnorm_rows(XIN, A->in[4] + l * D, MODL, MO_SH1, MO_SC1, H, gw, NGW, lane, XR); }
        if (l == 0) SEAM(pb + 0);
        if (IN(pb + 1)) {
            PHASE_TID(); (void)tid;
            pg8::Gemm g{H, WIN_T + (size_t)l * IN_W * D, M, IN_W, D}; pg8::StaticOrder S; S.init(M, IN_W, G, bx);
            pg8::EpiBf16<0> E{Z, IN_W, nullptr, 0, 0};
            pg8::gemm_phase<pg8::EpiBf16<0>, pg8::StaticOrder, false>((PG8_LAS unsigned char*)lds, g, S, E, nullptr, wave0);
        }
        SEAM(pb + 1);
        if (IN(pb + 2)) {
            PHASE_TID();
            for (int it = vcu; it < 2 * 64 * 6; it += G) {
                const int b = it / 384, r = it % 384, j = r / 6, n = r % 6;
                lru_item2(l, b, j, n, Z, A->in[7], A->in[8], WG_T, A->in[10], A->in[12], A->in[13], HLOC, PP, SUMA, SUMB,
                          (LAS float*)lds, (LAS float*)(lds + 34816), (LAS float*)(lds + 69632), tid);
            }
            {
                {
                    LAS unsigned char* wl = lds + wave * ATT_WLDS;
                    for (int it = gw; it < 1024 + 4608; it += NGW) {
                        if (it < 1024) { const int bh = it >> 7, tl = 127 - (it & 127); sb_mfma_item(bh >> 2, bh & 3, 32 * tl, Z, YC, wl, lane); }
                        else { const int i2 = it - 1024; const int tl = i2 & 127, p = (i2 >> 7) % 3, bh = i2 / 384; const int d = 1 << (2 * p);
                            dil_mfma_item(bh / 6, bh % 6, p, tl % d, 32 * (tl / d), Z, A->in[14], PARTB, LSEB, wl, lane); }
                    }
                }
            }
        }
        SEAM(pb + 2);
        if (IN(pb + 3)) {
            PHASE_TID();
            for (int it = vcu; it < 256; it += G) { const int b = it >> 7, j = (it >> 1) & 63, half = it & 1;
                combine_item(l, b, j, half, Z, HLOC, PP, SUMA, SUMB, PARTB, LSEB, YC, A->in[15], A->in[16], A->in[17], H, (LAS float*)lds, tid); }
        }
        SEAM(pb + 3);
        if (IN(pb + 4)) {
            PHASE_TID(); (void)tid;
            pg8::Gemm g{H, WOUT_T + (size_t)l * D * D, M, D, D}; pg8::StaticOrder S; S.init(M, D, G, bx);
            EpiResGate E{XRES, X1H, MODL + MO_G1, 1.f};
            pg8::gemm_phase<EpiResGate, pg8::StaticOrder, false>((PG8_LAS unsigned char*)lds, g, S, E, nullptr, wave0);
        }
        SEAM(pb + 4);
        if (IN(pb + 5)) { PHASE_TID(); modnorm_rows_h(X1H, A->in[5] + l * D, MODL, MO_SH2, MO_SC2, H, gw, NGW, lane); }
        SEAM(pb + 5);
        if (IN(pb + 6)) {
            PHASE_TID(); (void)tid;
            pg8::Gemm g{H, WQ_T + (size_t)l * D * D, M, D, D}; pg8::StaticOrder S; S.init(M, D, G, bx);
            pg8::EpiBf16<0> E{QB, D, nullptr, 0, 0};
            pg8::gemm_phase<pg8::EpiBf16<0>, pg8::StaticOrder, false>((PG8_LAS unsigned char*)lds, g, S, E, nullptr, wave0);
        }
        SEAM(pb + 6);
        if (IN(pb + 7)) {
            PHASE_TID();
            for (int it = vcu; it < 128 * 8; it += G) route_item2(l, it >> 3, it & 7, QB, SUBK, IDS, GG, lds, tid, l * 1024 + it + 1, A->in[21] + (size_t)l * NEXP * D, A->in[22] + (size_t)l * NEXP * D,
                                                                                      (unsigned char*)UB + (size_t)l * NEXP * D, (unsigned char*)VB + (size_t)l * NEXP * D);
        }
        SEAM(pb + 7);
        if (IN(pb + 8)) {
            PHASE_TID();
            for (int m = gw; m < M; m += NGW)
                expert_row8(l, m, H, IDS, GG, (const unsigned char*)UB, (const unsigned char*)VB, X1H, MODL + (size_t)(m >> 12) * MODW + MO_G2, (l == NL - 1) ? A->in[23] : nullptr, A->out, X2H, lane,
                            1.f, (LAS int*)(lds + wave * 1024),
                            (l == NL - 1) ? nullptr : A->in[4] + (l + 1) * D, mod + (size_t)((l + 1) * 2 + (m >> 12)) * MODW, H);
        }
        if (l + 1 < NL) SEAM(pb + 8);
    }
#undef IN
#undef SEAM
#undef mod
#undef H
#undef Z
#undef X1
#undef X2
}
}

extern "C" void kernel_launch(void* const* d_in, const int* in_sizes, int n_in, void* d_out, int out_size, void* d_ws, size_t ws_size, hipStream_t stream) {
    using namespace mk;
    static int grid = 0;
    if (grid == 0) {
        if (n_in != 24 || out_size != M * D || ws_size < WS_END) { fprintf(stderr, "kernel_launch: unexpected shapes (n_in %d out %d ws %zu)\n", n_in, out_size, ws_size); grid = -1; return; }
        int dev = 0, cus = 0, per_cu = 0;
        if (hipGetDevice(&dev) != hipSuccess || hipDeviceGetAttribute(&cus, hipDeviceAttributeMultiprocessorCount, dev) != hipSuccess) { grid = -1; return; }
        if (hipFuncSetAttribute((const void*)fwd, hipFuncAttributeMaxDynamicSharedMemorySize, LDS_BYTES) != hipSuccess) { fprintf(stderr, "kernel_launch: hipFuncSetAttribute failed\n"); grid = -1; return; }
        if (hipOccupancyMaxActiveBlocksPerMultiprocessor(&per_cu, (const void*)fwd, 512, LDS_BYTES) != hipSuccess || per_cu < 1) fprintf(stderr, "kernel_launch: occupancy query says %d\n", per_cu);
        (void)hipGetLastError();
        grid = cus;
    }
    if (grid < 0) return;
    (void)hipMemsetAsync((char*)d_ws + WS_CTL, 0, CTL_ZERO_BYTES, stream);
    Args a{};
    for (int i = 0; i < 24; ++i) a.in[i] = (const float*)d_in[i];
    a.out = (float*)d_out; a.ws = (unsigned char*)d_ws; a.pad = 0;
    constexpr int NLAUNCH = MK_N_LAUNCHES;
    for (int li = 0; li < NLAUNCH; ++li) {
        a.ph_lo = (NLAUNCH == 1) ? 0 : li; a.ph_hi = (NLAUNCH == 1) ? NPHASE : li + 1; a.li = li;
        hipLaunchKernelGGL(fwd, dim3(grid), dim3(512), LDS_BYTES, stream, a);
    }
}
```

```cpp
#include <hip/hip_runtime.h>
#include <cstdio>
#include <cstdint>
namespace pg8 {
#define PG8_LAS __attribute__((address_space(3)))
typedef unsigned short bf16_t;
typedef short bf16x8 __attribute__((ext_vector_type(8)));
typedef float f32x4 __attribute__((ext_vector_type(4)));
typedef unsigned u32x4 __attribute__((ext_vector_type(4)));
constexpr int BM = 256, BK = 64, HALF = 128, HTB = HALF * BK * 2  , STAGE_BYTES = 8 * HTB, NXCD = 8, WGM = 8;

__host__ __device__ __forceinline__ int lds_byte(int r, int c) { const int st = (r >> 4) * 2 + (c >> 5), rr = r & 15, cc = c & 31, ob = rr * 64 + cc * 2; return st * 1024 + (ob ^ (((ob >> 9) & 1) << 5)); }
__host__ __device__ __forceinline__ void stage_rc(int b, int& R, int& C) { const int st = b / 1024, sb = b % 1024, swz = sb ^ (((sb >> 9) & 1) << 5); R = (st >> 1) * 16 + swz / 64; C = (st & 1) * 32 + (swz % 64) / 2; }
__host__ __device__ __forceinline__ int perm32(int rho) { const int n = rho >> 4, i = rho & 15; return 8 * (i >> 2) + 4 * n + (i & 3); }

struct Unit { int pm, pn; };
struct Gemm { const bf16_t* A; const bf16_t* Bt; int M, N, K; };

struct StaticOrder {
    int nM, nN, nwg, G, c;
    __host__ __device__ void init(int M, int N, int G_, int c_) { nM = M / BM; nN = N / BM; nwg = nM * nN; G = G_; c = c_; }
    __host__ __device__ bool next(int i, Unit& u) const {
        const long L = (long)i * G + c; if (L >= nwg) return false;
        int wgid = (int)L; { const int q = nwg / NXCD, r = nwg % NXCD, xcd = wgid % NXCD, off = wgid / NXCD; wgid = (xcd < r ? xcd * (q + 1) : r * (q + 1) + (xcd - r) * q) + off; }
        const int nig = WGM * nN, gid = wgid / nig, fm = gid * WGM, gsz = (nM - fm) < WGM ? (nM - fm) : WGM;
        u.pm = fm + ((wgid % nig) % gsz); u.pn = (wgid % nig) / gsz; return true;
    }
    __device__ __forceinline__ void a_ready(const Unit&) const {}
    __device__ __forceinline__ void done(const Unit&) const {}
};
struct CountedOrder : StaticOrder {
    const unsigned* ready; unsigned need; unsigned* tmo;
    __device__ __forceinline__ void a_ready(const Unit& u) const {
        if (threadIdx.x < 64) {
            const unsigned long long t0 = __builtin_amdgcn_s_memrealtime(); unsigned polls = 0;
            while ((unsigned)__builtin_amdgcn_readfirstlane(__hip_atomic_load(ready + 64 * u.pm, __ATOMIC_RELAXED, __HIP_MEMORY_SCOPE_AGENT)) < need) {
                if ((++polls & 255u) == 0u && __builtin_amdgcn_readfirstlane(__hip_atomic_load(tmo, __ATOMIC_RELAXED, __HIP_MEMORY_SCOPE_AGENT)) != 0u) break;
                if (__builtin_amdgcn_s_memrealtime() - t0 > 2000000ull) {
                    if (threadIdx.x == 0) { unsigned expect = 0u; __hip_atomic_compare_exchange_strong(tmo + 1, &expect, 0x600u | (unsigned)(u.pm & 0xff), __ATOMIC_RELAXED, __ATOMIC_RELAXED, __HIP_MEMORY_SCOPE_AGENT); __hip_atomic_store(tmo, 1u, __ATOMIC_RELAXED, __HIP_MEMORY_SCOPE_AGENT); }
                    break; }
                __builtin_amdgcn_s_sleep(2); }
            __builtin_amdgcn_fence(__ATOMIC_ACQUIRE, "agent");
            asm volatile("s_waitcnt vmcnt(0)" ::: "memory");
        }
#if !defined(BROKEN_HOOK_NO_BARRIER)
        asm volatile("" ::: "memory"); __builtin_amdgcn_s_barrier(); asm volatile("" ::: "memory");
#endif
    }
};

__device__ __forceinline__ unsigned cvt_pk_bf16(float lo, float hi) { unsigned r; asm volatile("v_cvt_pk_bf16_f32 %0, %1, %2" : "=v"(r) : "v"(lo), "v"(hi)); return r; }
typedef float f32x2 __attribute__((ext_vector_type(2)));
__device__ __forceinline__ f32x2 gelu_pk(f32x2 v) {
    const f32x2 av = __builtin_elementwise_abs(v), d = av * 0.2316418882f + 1.0f;
    f32x2 t; t.x = __builtin_amdgcn_rcpf(d.x); t.y = __builtin_amdgcn_rcpf(d.y);
    f32x2 q = t * 0.5307027145f + (-0.7265760135f); q = q * t + 0.7107068705f; q = q * t + (-0.142248368f); q = q * t + 0.127414796f; q = q * t;
    const f32x2 s = (v * v) * (-0.72134752044f);
    f32x2 e; e.x = __builtin_amdgcn_exp2f(s.x); e.y = __builtin_amdgcn_exp2f(s.y);
    const f32x2 m = v * (q * e), r = v - m;
    f32x2 o; o.x = v.x < 0.f ? m.x : r.x; o.y = v.y < 0.f ? m.y : r.y; return o;
}

struct EpiF32 {
    static constexpr bool PERM = false, AFTER_DRAIN = false;
    float* C; int ldc; const float* bias;
    __device__ __forceinline__ void operator()(const f32x4 (&acc)[2][2][4][2], const Unit& u, int wr, int wc, int fr, int fq) const {
        const int row0 = u.pm * BM + wr * 64 + fr, col0 = u.pn * BM + wc * 32 + 4 * fq;
        f32x4 bv[2][2];
#pragma unroll
        for (int bj = 0; bj < 2; ++bj)
#pragma unroll
            for (int n = 0; n < 2; ++n) bv[bj][n] = bias ? *(const f32x4*)(bias + col0 + bj * HALF + n * 16) : (f32x4){0.f, 0.f, 0.f, 0.f};
#pragma unroll
        for (int ai = 0; ai < 2; ++ai)
#pragma unroll
            for (int m = 0; m < 4; ++m) { float* rowp = C + (size_t)(row0 + ai * HALF + m * 16) * ldc + col0;
#pragma unroll
                for (int bj = 0; bj < 2; ++bj)
#pragma unroll
                    for (int n = 0; n < 2; ++n) *(f32x4*)(rowp + bj * HALF + n * 16) = acc[ai][bj][m][n] + bv[bj][n]; }
    }
};
template <int ACT  > struct EpiBf16 {
    static constexpr bool PERM = true, AFTER_DRAIN = false;
    bf16_t* O; int ldc; const float* bias; int split_cols; size_t split_stride;
    __device__ __forceinline__ void operator()(const f32x4 (&acc)[2][2][4][2], const Unit& u, int wr, int wc, int fr, int fq) const {
        const int row0 = u.pm * BM + wr * 64 + fr; int colt = u.pn * BM; bf16_t* base = O;
        if (split_cols) { const int t = colt / split_cols; base += (size_t)t * split_stride; colt -= t * split_cols; }
        const int col0 = colt + wc * 32 + 8 * fq, bcol0 = u.pn * BM + wc * 32 + 8 * fq;
        f32x4 bv[2][2];
#pragma unroll
        for (int bj = 0; bj < 2; ++bj)
#pragma unroll
            for (int n = 0; n < 2; ++n) bv[bj][n] = bias ? *(const f32x4*)(bias + bcol0 + bj * HALF + 4 * n) : (f32x4){0.f, 0.f, 0.f, 0.f};
#pragma unroll
        for (int ai = 0; ai < 2; ++ai)
#pragma unroll
            for (int m = 0; m < 4; ++m) { bf16_t* rowp = base + (size_t)(row0 + ai * HALF + m * 16) * ldc + col0;
#pragma unroll
                for (int bj = 0; bj < 2; ++bj) { f32x4 v0 = acc[ai][bj][m][0] + bv[bj][0], v1 = acc[ai][bj][m][1] + bv[bj][1];
                    if (ACT == 1) { f32x2 a = gelu_pk((f32x2){v0[0], v0[1]}), b = gelu_pk((f32x2){v0[2], v0[3]}), c = gelu_pk((f32x2){v1[0], v1[1]}), d = gelu_pk((f32x2){v1[2], v1[3]});
                        v0 = (f32x4){a.x, a.y, b.x, b.y}; v1 = (f32x4){c.x, c.y, d.x, d.y}; }
                    if (ACT == 2) {
#pragma unroll
                        for (int j = 0; j < 4; ++j) { v0[j] = 0.5f * v0[j] * (1.0f + erff(v0[j] * 0.70710678f)); v1[j] = 0.5f * v1[j] * (1.0f + erff(v1[j] * 0.70710678f)); } }
                    u32x4 w; w.x = cvt_pk_bf16(v0[0], v0[1]); w.y = cvt_pk_bf16(v0[2], v0[3]); w.z = cvt_pk_bf16(v1[0], v1[1]); w.w = cvt_pk_bf16(v1[2], v1[3]);
                    *(u32x4*)(rowp + bj * HALF) = w; } }
    }
};
template <class Epi, class Sched, bool STAMP = false>
__device__ __forceinline__ void gemm_phase(PG8_LAS unsigned char* lds, const Gemm g, const Sched& S, const Epi& E, unsigned long long* stamps, int wave_id) {
    unsigned zz_o = 0u; asm volatile("" : "+v"(zz_o)); int tid_o = wave_id * 64 + (int)__builtin_amdgcn_mbcnt_hi(~0u, __builtin_amdgcn_mbcnt_lo(~0u, zz_o));
    const int tid = tid_o, wid = __builtin_amdgcn_readfirstlane(tid >> 6), lane = tid & 63, wr = wid >> 2, wc = wid & 3, fr = lane & 15, fq = lane >> 4;
    constexpr int K = 2048, nt = K / BK;
    int ts_lo = 0, ts_hi = 0, nts = 0; const unsigned long long rt_entry = STAMP ? (unsigned long long)wall_clock64() : 0ull;
#define PG8_STAMP() do { if (STAMP && wid == 0 && nts < 64) { const unsigned long long _c = (unsigned long long)clock64(); \
        ts_lo = (lane == nts) ? (int)(unsigned)_c : ts_lo; ts_hi = (lane == nts) ? (int)(unsigned)(_c >> 32) : ts_hi; ++nts; } } while (0)
    PG8_STAMP();
    unsigned voffA[2], voffB[2];
#pragma unroll
    for (int i = 0; i < 2; ++i) { int R, C; stage_rc(tid * 16 + i * 8192, R, C); const int Rb = Epi::PERM ? ((R & ~31) + perm32(R & 31)) : R;
        voffA[i] = (unsigned)(R * K + C) * 2u; voffB[i] = (unsigned)(Rb * K + C) * 2u; }
    const size_t kstep = (size_t)(BK * 2);
    const size_t hstep = (size_t)HALF * K * 2;
    const size_t tstep = 2 * hstep;
    const unsigned ldsw = (unsigned)wid * 1024u;
    const int aoff = lds_byte(wr * 64 + fr, fq * 8), boff = lds_byte(wc * 32 + fr, fq * 8);
#define PG8_SA(b, h) (((b) * 2 + (h)) * HTB)
#define PG8_SB(b, h) ((4 + (b) * 2 + (h)) * HTB)
#define PG8_STAGE(bufoff, gbase, voff) do { _Pragma("unroll") for (int _i = 0; _i < 2; ++_i) \
        __builtin_amdgcn_global_load_lds((const unsigned*)((const char*)(gbase) + (voff)[_i]), (PG8_LAS unsigned*)(lds + (bufoff) + ldsw + _i * 8192), 16, 0, 0); } while (0)
#define PG8_LDA(dst, b, h) do { _Pragma("unroll") for (int m = 0; m < 4; ++m) _Pragma("unroll") for (int k = 0; k < 2; ++k) dst[m][k] = *(const PG8_LAS bf16x8*)(lds + PG8_SA(b, h) + aoff + m * 2048 + k * 1024); } while (0)
#define PG8_LDB(dst, b, h) do { _Pragma("unroll") for (int n = 0; n < 2; ++n) _Pragma("unroll") for (int k = 0; k < 2; ++k) dst[n][k] = *(const PG8_LAS bf16x8*)(lds + PG8_SB(b, h) + boff + n * 2048 + k * 1024); } while (0)
#define PG8_MMA(ai, bj, At, Bt) do { __builtin_amdgcn_s_setprio(1); _Pragma("unroll") for (int m = 0; m < 4; ++m) _Pragma("unroll") for (int n = 0; n < 2; ++n) _Pragma("unroll") for (int k = 0; k < 2; ++k) \
        acc[ai][bj][m][n] = __builtin_amdgcn_mfma_f32_16x16x32_bf16(Bt[n][k], At[m][k], acc[ai][bj][m][n], 0, 0, 0); __builtin_amdgcn_s_setprio(0); } while (0)
#define PG8_WAIT_V(n) asm volatile("s_waitcnt vmcnt(" #n ")" ::: "memory")
#define PG8_WAIT_L(n) asm volatile("s_waitcnt lgkmcnt(" #n ")" ::: "memory")
#define PG8_BAR __builtin_amdgcn_s_barrier()
#define PG8_SCHED __builtin_amdgcn_sched_barrier(0)
    Unit cur, nxt; int ui = 0;
    if (!S.next(0, cur)) return;
    f32x4 acc[2][2][4][2];
#pragma unroll
    for (int a = 0; a < 2; ++a)
#pragma unroll
        for (int b = 0; b < 2; ++b)
#pragma unroll
            for (int m = 0; m < 4; ++m)
#pragma unroll
                for (int n = 0; n < 2; ++n) acc[a][b][m][n] = (f32x4){0.f, 0.f, 0.f, 0.f};
    bf16x8 At[4][2], B0[2][2], B1[2][2];
    const char* cA = (const char*)g.A + (size_t)cur.pm * tstep; const char* cB = (const char*)g.Bt + (size_t)cur.pn * tstep;
    S.a_ready(cur);
    PG8_STAGE(PG8_SB(0, 0), cB, voffB); PG8_STAGE(PG8_SA(0, 0), cA, voffA); PG8_STAGE(PG8_SB(0, 1), cB + hstep, voffB); PG8_STAGE(PG8_SA(0, 1), cA + hstep, voffA);
    if (wr == 1) PG8_BAR;
    PG8_WAIT_V(4); PG8_BAR;
    PG8_STAGE(PG8_SB(1, 0), cB + kstep, voffB); PG8_STAGE(PG8_SA(1, 0), cA + kstep, voffA); PG8_STAGE(PG8_SB(1, 1), cB + hstep + kstep, voffB);
    PG8_WAIT_V(6); PG8_BAR;
    PG8_STAMP();
    for (;;) {
        const bool has_next = S.next(ui + 1, nxt);
        const char* nA = has_next ? (const char*)g.A + (size_t)nxt.pm * tstep : cA; const char* nB = has_next ? (const char*)g.Bt + (size_t)nxt.pn * tstep : cB;
        for (int t = 0; t < nt; t += 2) {
            const bool last = (t == nt - 2);
            const char* a1 = cA + (size_t)(t + 1) * kstep;
            const char* a2 = last ? nA : cA + (size_t)(t + 2) * kstep; const char* b2 = last ? nB : cB + (size_t)(t + 2) * kstep;
            const char* a3 = a2 + kstep; const char* b3 = b2 + kstep;
            if (last && has_next) S.a_ready(nxt);
            PG8_LDB(B0, 0, 0); PG8_SCHED; PG8_LDA(At, 0, 0); PG8_STAGE(PG8_SA(1, 1), a1 + hstep, voffA);
            PG8_WAIT_L(8); PG8_BAR; PG8_WAIT_L(0); PG8_MMA(0, 0, At, B0); PG8_BAR; PG8_SCHED;
            PG8_LDB(B1, 0, 1); PG8_STAGE(PG8_SB(0, 0), b2, voffB);
            PG8_BAR; PG8_WAIT_L(0); PG8_MMA(0, 1, At, B1); PG8_BAR;
            PG8_LDA(At, 0, 1); PG8_STAGE(PG8_SA(0, 0), a2, voffA);
            PG8_BAR; PG8_WAIT_L(0); PG8_MMA(1, 0, At, B0); PG8_BAR; PG8_SCHED;
            PG8_STAGE(PG8_SB(0, 1), b2 + hstep, voffB);
            PG8_WAIT_V(6); PG8_BAR; PG8_MMA(1, 1, At, B1); PG8_BAR;
            PG8_LDB(B0, 1, 0); PG8_SCHED; PG8_LDA(At, 1, 0); PG8_STAGE(PG8_SA(0, 1), a2 + hstep, voffA);
            PG8_WAIT_L(8); PG8_BAR; PG8_WAIT_L(0); PG8_MMA(0, 0, At, B0); PG8_BAR; PG8_SCHED;
            PG8_LDB(B1, 1, 1); PG8_STAGE(PG8_SB(1, 0), b3, voffB);
            PG8_BAR; PG8_WAIT_L(0); PG8_MMA(0, 1, At, B1); PG8_BAR;
            PG8_LDA(At, 1, 1); PG8_STAGE(PG8_SA(1, 0), a3, voffA);
            PG8_BAR; PG8_WAIT_L(0); PG8_MMA(1, 0, At, B0); PG8_BAR; PG8_SCHED;
            PG8_STAGE(PG8_SB(1, 1), b3 + hstep, voffB);
            PG8_WAIT_V(6); PG8_BAR; PG8_MMA(1, 1, At, B1); PG8_BAR;
        }
        PG8_STAMP();
        if constexpr (!Epi::AFTER_DRAIN) { E(acc, cur, wr, wc, fr, fq); S.done(cur); }
        PG8_STAMP();
        if (!has_next) break;
#pragma unroll
        for (int a = 0; a < 2; ++a)
#pragma unroll
            for (int b = 0; b < 2; ++b)
#pragma unroll
                for (int m = 0; m < 4; ++m)
#pragma unroll
                    for (int n = 0; n < 2; ++n) acc[a][b][m][n] = (f32x4){0.f, 0.f, 0.f, 0.f};
        cur = nxt; cA = nA; cB = nB; ++ui;
    }
    PG8_WAIT_V(0);
    if (wr == 0) PG8_BAR;
    PG8_BAR;
    if constexpr (Epi::AFTER_DRAIN) { E.fused(acc, cur, wr, wc, fr, fq, lds, wid, lane); S.done(cur); }
    PG8_STAMP();
    if (STAMP && wid == 0) { stamps[lane] = lane < nts ? (((unsigned long long)(unsigned)ts_hi << 32) | (unsigned)ts_lo) : 0ull;
        if (lane == 62) stamps[62] = rt_entry; if (lane == 63) stamps[63] = (unsigned long long)wall_clock64(); }
#undef PG8_STAMP
#undef PG8_SA
#undef PG8_SB
#undef PG8_STAGE
#undef PG8_LDA
#undef PG8_LDB
#undef PG8_MMA
#undef PG8_WAIT_V
#undef PG8_WAIT_L
#undef PG8_BAR
#undef PG8_SCHED
}
}

namespace mk {
#define GAS __attribute__((address_space(1)))
#define LAS __attribute__((address_space(3)))
#define DEV __device__ __forceinline__
typedef unsigned short bf16;
typedef unsigned v4u __attribute__((ext_vector_type(4)));
typedef float f32x4 __attribute__((ext_vector_type(4)));
typedef float f32x2 __attribute__((ext_vector_type(2)));
typedef short bf16x8 __attribute__((ext_vector_type(8)));
typedef float f32x16 __attribute__((ext_vector_type(16)));
typedef __bf16 bf16x2_t __attribute__((ext_vector_type(2)));

#ifndef MK_N_LAUNCHES
#define MK_N_LAUNCHES 1
#endif

constexpr int D = 2048, SEQ = 4096, M = 8192, NL = 2;
constexpr int LRU_W = 768, SWA_W = 768, SB_W = 512, IN_W = 5376;
constexpr int ZO_XA = 0, ZO_GA = 768, ZO_QB = 1536, ZO_KB = 2304, ZO_VB = 3072, ZO_QC = 3840, ZO_KC = 4352, ZO_VC = 4864;
constexpr int NEXP = 16384, MODW = 12288;
constexpr int MO_SH1 = 0, MO_SC1 = 2048, MO_G1 = 4096, MO_SH2 = 6144, MO_SC2 = 8192, MO_G2 = 10240;
constexpr float EPS = 1e-6f;
constexpr float QSCALE = 0.08838834764831845f;
constexpr float NEGBIG = -3.0e38f;
constexpr int NPHASE = 19;

constexpr size_t MiB = 1u << 20;
constexpr size_t WS_CTL = 0, CTL_ZERO_BYTES = 1 * MiB;
constexpr size_t WS_MOD = 512 * 1024;
constexpr size_t WS_WIN_T = 2 * MiB, WS_WOUT_T = 44 * MiB, WS_WQ_T = 60 * MiB, WS_SUBK = 76 * MiB, WS_U = 80 * MiB, WS_V = 208 * MiB,
                 WS_H = 336 * MiB, WS_Z = 368 * MiB, WS_HLOC = 452 * MiB, WS_P = 476 * MiB, WS_YB = 500 * MiB, WS_YC = 524 * MiB,
                 WS_SUMA = 540 * MiB, WS_SUMB = 541 * MiB, WS_X1 = 544 * MiB, WS_X2 = 608 * MiB, WS_Q = 672 * MiB, WS_IDS = 704 * MiB,
                 WS_G = 708 * MiB, WS_WG_T = 77 * MiB, WS_PART = 712 * MiB, WS_LSE = 784 * MiB, WS_XR = 786 * MiB, WS_END = 818 * MiB;
constexpr int CW_BAR = 4096;

constexpr int LDS_BYTES = 147456;
constexpr int LDS_MISC = 143360;

__device__ const unsigned char T5B[3][132] = {
 {0,1,2,3,4,5,6,7,8,9,10,11,12,13,14,15,16,16,16,16,16,16,17,17,17,17,17,17,17,17,18,18,18,18,18,18,18,18,18,18,19,19,19,19,19,19,19,19,19,19,19,19,19,19,20,20,20,20,20,20,20,20,20,20,20,20,20,20,20,20,20,20,20,21,21,21,21,21,21,21,21,21,21,21,21,21,21,21,21,21,21,21,21,21,21,21,21,21,21,22,22,22,22,22,22,22,22,22,22,22,22,22,22,22,22,22,22,22,22,22,22,22,22,22,22,22,22,22,22,0,0,0},
 {0,4,8,12,16,16,17,17,18,18,19,19,19,19,20,20,20,20,20,21,21,21,21,21,21,22,22,22,22,22,22,22,22,22,23,23,23,23,23,23,23,23,23,23,23,23,24,24,24,24,24,24,24,24,24,24,24,24,24,24,24,24,25,25,25,25,25,25,25,25,25,25,25,25,25,25,25,25,25,25,25,25,25,26,26,26,26,26,26,26,26,26,26,26,26,26,26,26,26,26,26,26,26,26,26,26,26,26,26,26,26,26,26,27,27,27,27,27,27,27,27,27,27,27,27,27,27,27,27,0,0,0},
 {0,16,18,19,20,21,21,22,22,23,23,23,24,24,24,24,25,25,25,25,25,26,26,26,26,26,26,26,26,27,27,27,27,27,27,27,27,27,27,28,28,28,28,28,28,28,28,28,28,28,28,28,29,29,29,29,29,29,29,29,29,29,29,29,29,29,29,29,29,29,30,30,30,30,30,30,30,30,30,30,30,30,30,30,30,30,30,30,30,30,30,30,30,30,30,31,31,31,31,31,31,31,31,31,31,31,31,31,31,31,31,31,31,31,31,31,31,31,31,31,31,31,31,31,31,31,31,31,31,0,0,0}};

#define LDS_WAIT() asm volatile("s_waitcnt lgkmcnt(0)" ::: "memory")
DEV unsigned f2bf(float f) { unsigned u = __builtin_bit_cast(unsigned, f); return (u + 0x7fffu + ((u >> 16) & 1u)) >> 16; }
DEV unsigned pk2(float lo, float hi) { return f2bf(lo) | (f2bf(hi) << 16); }
DEV float bf_lo(unsigned w) { return __builtin_bit_cast(float, w << 16); }
DEV float bf_hi(unsigned w) { return __builtin_bit_cast(float, w & 0xffff0000u); }
DEV float bf1(bf16 h) { return __builtin_bit_cast(float, ((unsigned)h) << 16); }
template <int MSK> DEV float swz_xor(float v) { return __builtin_bit_cast(float, __builtin_amdgcn_ds_swizzle(__builtin_bit_cast(int, v), (MSK << 10) | 0x1F)); }
DEV float part32_(float v) { int ln = (int)__builtin_amdgcn_mbcnt_hi(~0u, __builtin_amdgcn_mbcnt_lo(~0u, 0u)); asm volatile("" : "+v"(ln)); return __builtin_bit_cast(float, __builtin_amdgcn_ds_bpermute((ln ^ 32) << 2, __builtin_bit_cast(int, v))); }
DEV float sum32(float v) { return v + part32_(v); }
DEV float max32(float v) { return fmaxf(v, part32_(v)); }
DEV float partner32(float v, int hh) { (void)hh; return part32_(v); }
DEV float wave_sum(float v) { v += swz_xor<1>(v); v += swz_xor<2>(v); v += swz_xor<4>(v); v += swz_xor<8>(v); v += swz_xor<16>(v); return sum32(v); }
DEV float wave_max(float v) { v = fmaxf(v, swz_xor<1>(v)); v = fmaxf(v, swz_xor<2>(v)); v = fmaxf(v, swz_xor<4>(v)); v = fmaxf(v, swz_xor<8>(v)); v = fmaxf(v, swz_xor<16>(v)); return max32(v); }
DEV float sigmoid_f(float x) { return 1.f / (1.f + __expf(-x)); }
DEV float softplus_f(float x) { return fmaxf(x, 0.f) + log1pf(__expf(-fabsf(x))); }
DEV float gelu_tanh(float x) { const float u = 0.7978845608028654f * (x + 0.044715f * x * x * x); const float t = 1.f - 2.f / (1.f + __expf(2.f * u)); return 0.5f * x * (1.f + t); }
DEV float dot8(const v4u a, const v4u b) {
    float s = bf_lo(a.x) * bf_lo(b.x); s += bf_hi(a.x) * bf_hi(b.x);
    s += bf_lo(a.y) * bf_lo(b.y); s += bf_hi(a.y) * bf_hi(b.y);
    s += bf_lo(a.z) * bf_lo(b.z); s += bf_hi(a.z) * bf_hi(b.z);
    s += bf_lo(a.w) * bf_lo(b.w); s += bf_hi(a.w) * bf_hi(b.w);
    return s;
}

#define XB_TMO      128
#define XB_XCNT(j)  (256  + 64 * (j))
#define XB_XSUB(j)  (1280 + 64 * (j))
#define XB_XGEN(j)  (2304 + 64 * (j))
#define XB_TOP      3328
#define XB_TOPGEN   3392
#define XCD_BAR_WORDS 3456
#define XB_SPIN_CAP (1u << 18)

__device__ __forceinline__ unsigned xb_ld(unsigned* p)              { return __hip_atomic_load(p, __ATOMIC_RELAXED, __HIP_MEMORY_SCOPE_AGENT); }
__device__ __forceinline__ unsigned xb_add(unsigned* p, unsigned v) { return __hip_atomic_fetch_add(p, v, __ATOMIC_RELAXED, __HIP_MEMORY_SCOPE_AGENT); }
__device__ __forceinline__ unsigned xb_xcc_id() { return (unsigned)__builtin_amdgcn_s_getreg((3 << 11) | 20) & 0xFu; }
#define XB_SPIN(cond, bar) do { unsigned _sp = 0; while (cond) { __builtin_amdgcn_s_sleep(1); \
    if ((++_sp & 255u) == 0u) { if (xb_ld(&(bar)[XB_TMO])) break; if (_sp > XB_SPIN_CAP) { atomicAdd(&(bar)[XB_TMO], 1u); break; } } } } while (0)

struct XcdBarrier {
    unsigned* bar; unsigned x;
    volatile LAS unsigned* st;
    int w0;
};
DEV bool xb_lead(int w0) { return w0 == 0 && __builtin_amdgcn_mbcnt_hi(~0u, __builtin_amdgcn_mbcnt_lo(~0u, 0u)) == 0u; }
__device__ __forceinline__ XcdBarrier xcd_barrier_post(unsigned* bar, volatile LAS unsigned* st, int w0) {
    XcdBarrier b; b.bar = bar; b.x = xb_xcc_id(); b.st = st; b.w0 = w0;
    if (xb_lead(w0)) (void)xb_add(&bar[XB_XCNT(b.x)], 1u);
    return b;
}
__device__ __forceinline__ void xcd_barrier_complete(unsigned* bar, unsigned x, unsigned& nloc, unsigned& nx) {
    const unsigned G = gridDim.x * gridDim.y * gridDim.z;
    unsigned sum, cnt, mine, sp = 0u;
    for (;;) {
        sum = 0u; cnt = 0u; mine = 0u;
#pragma unroll
        for (unsigned j = 0; j < 16; ++j) { const unsigned c = xb_ld(&bar[XB_XCNT(j)]); sum += c; cnt += (c > 0u) ? 1u : 0u; mine = (j == x) ? c : mine; }
        if (sum == G) break;
        __builtin_amdgcn_s_sleep(1);
        if ((++sp & 255u) == 0u) { if (xb_ld(&bar[XB_TMO])) break; if (sp > XB_SPIN_CAP) { atomicAdd(&bar[XB_TMO], 1u); break; } }
    }
    nloc = mine > 0u ? mine : 1u; nx = cnt > 0u ? cnt : 1u;
}
__device__ __forceinline__ void xcd_barrier(const XcdBarrier& b) {
    asm volatile("s_waitcnt vmcnt(0)" ::: "memory");
    __syncthreads();
    if (xb_lead(b.w0)) {
        unsigned* bar = b.bar;
        __builtin_amdgcn_s_waitcnt(0);
        unsigned nloc = b.st[0], nx = b.st[1];
        if (nloc == 0u) { xcd_barrier_complete(bar, b.x, nloc, nx); b.st[0] = nloc; b.st[1] = nx; }
        const unsigned old = xb_add(&bar[XB_XSUB(b.x)], 1u);
        const unsigned gen = old / nloc;
        if (old + 1u == (gen + 1u) * nloc) {
            __builtin_amdgcn_fence(__ATOMIC_RELEASE, "agent");
            asm volatile("s_waitcnt vmcnt(0)" ::: "memory");
            const unsigned og = xb_add(&bar[XB_TOP], 1u);
            const unsigned tg = og / nx;
            if (og + 1u == (tg + 1u) * nx) xb_add(&bar[XB_TOPGEN], 1u);
            else XB_SPIN(xb_ld(&bar[XB_TOPGEN]) == tg, bar);
            __builtin_amdgcn_fence(__ATOMIC_ACQUIRE, "agent");
            xb_add(&bar[XB_XGEN(b.x)], 1u);
            asm volatile("s_waitcnt vmcnt(0)" ::: "memory");
        } else {
            XB_SPIN(xb_ld(&bar[XB_XGEN(b.x)]) == gen, bar);
            __builtin_amdgcn_fence(__ATOMIC_ACQUIRE, "agent");
            asm volatile("s_waitcnt vmcnt(0)" ::: "memory");
        }
    }
    __syncthreads();
}

struct EpiResGate {
    static constexpr bool PERM = false, AFTER_DRAIN = false;
    const bf16* X; bf16* O; const float* gate; float gscale;
    __device__ __forceinline__ void operator()(const pg8::f32x4 (&acc)[2][2][4][2], const pg8::Unit& u, int wr, int wc, int fr, int fq) const {
        const int row0 = u.pm * 256 + wr * 64 + fr, col0 = u.pn * 256 + wc * 32 + 4 * fq;
        const float* gp = gate + (size_t)((u.pm * 256) >> 12) * MODW;
        pg8::f32x4 gv[2][2];
#pragma unroll
        for (int bj = 0; bj < 2; ++bj)
#pragma unroll
            for (int n = 0; n < 2; ++n) gv[bj][n] = *(const pg8::f32x4*)(gp + col0 + bj * 128 + n * 16) * gscale;
#pragma unroll
        for (int ai = 0; ai < 2; ++ai)
#pragma unroll
            for (int m = 0; m < 4; ++m) {
                const size_t ro = (size_t)(row0 + ai * 128 + m * 16) * D + col0;
#pragma unroll
                for (int bj = 0; bj < 2; ++bj)
#pragma unroll
                    for (int n = 0; n < 2; ++n) {
                        const unsigned long long xw = *(const unsigned long long*)(X + ro + bj * 128 + n * 16);
                        const pg8::f32x4 xv = {bf_lo((unsigned)xw), bf_hi((unsigned)xw), bf_lo((unsigned)(xw >> 32)), bf_hi((unsigned)(xw >> 32))};
                        const pg8::f32x4 ov = xv + gv[bj][n] * acc[ai][bj][m][n];
                        *(unsigned long long*)(O + ro + bj * 128 + n * 16) = (unsigned long long)pk2(ov.x, ov.y) | ((unsigned long long)pk2(ov.z, ov.w) << 32);
                    }
            }
    }
};

DEV void ph_mod(const float* __restrict__ c, const float* __restrict__ w_mod, const float* __restrict__ b_mod, float* __restrict__ mod, LAS float* lds_f, int vcu, int G, int tid) {
    const int lane = tid & 63, wave = tid >> 6;
    LAS float* cs = lds_f;
    LAS float* red = lds_f + 4096;
    for (int i = tid; i < 2 * D; i += 512) { const float v = c[i]; cs[i] = v * sigmoid_f(v); }
    __syncthreads();
    const int cg = lane & 15, rg = lane >> 4;
    for (int it = vcu; it < 2 * 192 * 2; it += G) {
        const int kh = it & 1, cb = (it >> 1) % 192, l = it / 384;
        const int k0 = kh * 1024 + wave * 128;
        const float* W = w_mod + ((size_t)l * D + k0 + rg) * MODW + cb * 64 + cg * 4;
        f32x4 a0 = {0.f, 0.f, 0.f, 0.f}, a1 = {0.f, 0.f, 0.f, 0.f};
#pragma unroll 16
        for (int i = 0; i < 32; ++i) {
            const f32x4 w = *(const f32x4*)(W + (size_t)(4 * i) * MODW);
            const float c0 = cs[k0 + 4 * i + rg], c1 = cs[D + k0 + 4 * i + rg];
            a0 += w * c0; a1 += w * c1;
        }
#pragma unroll
        for (int e = 0; e < 4; ++e) { a0[e] += swz_xor<16>(a0[e]); a0[e] = sum32(a0[e]); a1[e] += swz_xor<16>(a1[e]); a1[e] = sum32(a1[e]); }
        if (lane < 16) { *(LAS f32x4*)(red + (wave * 2 + 0) * 64 + cg * 4) = a0; *(LAS f32x4*)(red + (wave * 2 + 1) * 64 + cg * 4) = a1; }
        __syncthreads();
        if (tid < 128) {
            const int bq = tid >> 6, ln = tid & 63; float sacc = 0.f;
#pragma unroll
            for (int w = 0; w < 8; ++w) sacc += red[(w * 2 + bq) * 64 + ln];
            const int col = cb * 64 + ln;
            if (kh == 0) sacc += b_mod[l * MODW + col];
            atomicAdd(mod + (size_t)(l * 2 + bq) * MODW + col, sacc);
        }
        __syncthreads();
    }
}
DEV void transpose_item(const float* __restrict__ W, int K, int N, bf16* __restrict__ WT, LAS float* scr, int item, int lane) {
    const int nblk = N / 32, kb = item / nblk, nb = item % nblk, k0 = 64 * kb, n0 = 32 * nb;
#pragma unroll 8
    for (int i = 0; i < 32; ++i) { const int kk = 2 * i + (lane >> 5); scr[kk * 33 + (lane & 31)] = W[(size_t)(k0 + kk) * N + n0 + (lane & 31)]; }
    LDS_WAIT();
    const int c = lane & 7;
#pragma unroll
    for (int j = 0; j < 4; ++j) { const int n = (lane >> 3) + 8 * j; const LAS float* s = scr + (8 * c) * 33 + n;
        v4u o; o.x = pk2(s[0 * 33], s[1 * 33]); o.y = pk2(s[2 * 33], s[3 * 33]); o.z = pk2(s[4 * 33], s[5 * 33]); o.w = pk2(s[6 * 33], s[7 * 33]);
        *(v4u*)(WT + (size_t)(n0 + n) * K + k0 + 8 * c) = o; }
    LDS_WAIT();
}

DEV void transpose_item64(const float* __restrict__ W, int K, int N, bf16* __restrict__ WT, LAS float* scr, int item, int lane) {
    const int nblk = N / 64, kb = item / nblk, nb = item % nblk, k0 = 64 * kb, n0 = 64 * nb;
#pragma unroll 8
    for (int i = 0; i < 16; ++i) { const int kk = 4 * i + (lane >> 4), nn = 4 * (lane & 15);
        const f32x4 w = *(const f32x4*)(W + (size_t)(k0 + kk) * N + n0 + nn);
        LAS float* d = scr + kk * 65 + nn; d[0] = w.x; d[1] = w.y; d[2] = w.z; d[3] = w.w; }
    LDS_WAIT();
#pragma unroll
    for (int jj = 0; jj < 8; ++jj) { const int pz = lane + 64 * jj, n = pz >> 3, c = pz & 7; const LAS float* sp = scr + (8 * c) * 65 + n;
        v4u o; o.x = pk2(sp[0 * 65], sp[1 * 65]); o.y = pk2(sp[2 * 65], sp[3 * 65]); o.z = pk2(sp[4 * 65], sp[5 * 65]); o.w = pk2(sp[6 * 65], sp[7 * 65]);
        *(v4u*)(WT + (size_t)(n0 + n) * K + k0 + 8 * c) = o; }
    LDS_WAIT();
}
DEV void convert_copy(const float* __restrict__ src, bf16* __restrict__ dst, size_t ngroups8, size_t gtid, size_t gstride) {
    for (size_t g = gtid; g < ngroups8; g += gstride) {
        const f32x4 a = *(const f32x4*)(src + g * 8), b = *(const f32x4*)(src + g * 8 + 4);
        v4u o; o.x = pk2(a.x, a.y); o.y = pk2(a.z, a.w); o.z = pk2(b.x, b.y); o.w = pk2(b.z, b.w);
        *(v4u*)(dst + g * 8) = o;
    }
}

DEV void modnorm_rows(const float* __restrict__ X, const float* __restrict__ gain, const float* __restrict__ modl, int sh_off, int sc_off, bf16* __restrict__ H, int gw, int NGW, int lane, bf16* __restrict__ XC = nullptr) {
    for (int m = gw; m < M; m += NGW) {
        const int b = m >> 12;
        const f32x4* xr = (const f32x4*)(X + (size_t)m * D) + lane;
        f32x4 v[8]; float s = 0.f;
#pragma unroll
        for (int j = 0; j < 8; ++j) { v[j] = xr[64 * j]; s += (v[j].x * v[j].x + v[j].y * v[j].y) + (v[j].z * v[j].z + v[j].w * v[j].w); }
        const float r = rsqrtf(wave_sum(s) * (1.f / D) + EPS);
        const f32x4* g4 = (const f32x4*)gain + lane;
        const f32x4* sc4 = (const f32x4*)(modl + (size_t)b * MODW + sc_off) + lane;
        const f32x4* sh4 = (const f32x4*)(modl + (size_t)b * MODW + sh_off) + lane;
        unsigned long long* o8 = (unsigned long long*)(H + (size_t)m * D) + lane;
#pragma unroll
        for (int j = 0; j < 8; ++j) {
            const f32x4 g = g4[64 * j], sc = sc4[64 * j], sh = sh4[64 * j];
            const f32x4 y = (v[j] * r) * g * (sc + 1.f) + sh;
            o8[64 * j] = (unsigned long long)pk2(y.x, y.y) | ((unsigned long long)pk2(y.z, y.w) << 32);
            if (XC) ((unsigned long long*)(XC + (size_t)m * D) + lane)[64 * j] = (unsigned long long)pk2(v[j].x, v[j].y) | ((unsigned long long)pk2(v[j].z, v[j].w) << 32);
        }
    }
}
DEV void modnorm_rows_h(const bf16* __restrict__ X, const float* __restrict__ gain, const float* __restrict__ modl, int sh_off, int sc_off, bf16* __restrict__ H, int gw, int NGW, int lane) {
    for (int m = gw; m < M; m += NGW) {
        const int b = m >> 12;
        const v4u* xr = (const v4u*)(X + (size_t)m * D) + lane;
        float v[32]; float s = 0.f;
#pragma unroll
        for (int j = 0; j < 4; ++j) { const v4u w = xr[64 * j];
            v[8 * j + 0] = bf_lo(w.x); v[8 * j + 1] = bf_hi(w.x); v[8 * j + 2] = bf_lo(w.y); v[8 * j + 3] = bf_hi(w.y); v[8 * j + 4] = bf_lo(w.z); v[8 * j + 5] = bf_hi(w.z); v[8 * j + 6] = bf_lo(w.w); v[8 * j + 7] = bf_hi(w.w);
#pragma unroll
            for (int e = 0; e < 8; ++e) s += v[8 * j + e] * v[8 * j + e]; }
        const float r = rsqrtf(wave_sum(s) * (1.f / D) + EPS);
        const float* scp = modl + (size_t)b * MODW + sc_off; const float* shp = modl + (size_t)b * MODW + sh_off;
        v4u* o16 = (v4u*)(H + (size_t)m * D) + lane;
#pragma unroll
        for (int j = 0; j < 4; ++j) { const int col = 8 * (lane + 64 * j);
            const f32x4 g0 = *(const f32x4*)(gain + col), g1 = *(const f32x4*)(gain + col + 4), c0 = *(const f32x4*)(scp + col), c1 = *(const f32x4*)(scp + col + 4), h0 = *(const f32x4*)(shp + col), h1 = *(const f32x4*)(shp + col + 4);
            v4u o;
            o.x = pk2(v[8 * j + 0] * r * g0.x * (c0.x + 1.f) + h0.x, v[8 * j + 1] * r * g0.y * (c0.y + 1.f) + h0.y); o.y = pk2(v[8 * j + 2] * r * g0.z * (c0.z + 1.f) + h0.z, v[8 * j + 3] * r * g0.w * (c0.w + 1.f) + h0.w);
            o.z = pk2(v[8 * j + 4] * r * g1.x * (c1.x + 1.f) + h1.x, v[8 * j + 5] * r * g1.y * (c1.y + 1.f) + h1.y); o.w = pk2(v[8 * j + 6] * r * g1.z * (c1.z + 1.f) + h1.z, v[8 * j + 7] * r * g1.w * (c1.w + 1.f) + h1.w);
            o16[64 * j] = o; }
    }
}


DEV unsigned cvtpk_bf16(float lo, float hi) { f32x2 v = {lo, hi}; bf16x2_t b = __builtin_convertvector(v, bf16x2_t); return __builtin_bit_cast(unsigned, b); }
constexpr int DIL_VSTR = 256;
constexpr int ATT_KOFF = 32 * DIL_VSTR;
constexpr int ATT_BOFF = ATT_KOFF + 8192;
constexpr int DIL_QOFF = ATT_BOFF + 132 * 4;
constexpr int ATT_WLDS = 17920;
static_assert(DIL_QOFF <= ATT_WLDS && 8 * ATT_WLDS <= LDS_MISC, "attention LDS");

DEV unsigned vimg_off(unsigned row, unsigned ch) { return 256u * row + 16u * (ch ^ (((row & 3u) << 2) | ((row >> 2) & 3u))); }
typedef short s16x4 __attribute__((ext_vector_type(4)));
DEV bf16x8 vfrag_tr(LAS unsigned char* img, int lane, int c, int ks) {
    const unsigned h = lane >> 5, blk = (lane >> 4) & 1, qq = (lane & 15) >> 2, pp = lane & 3;
    const s16x4 a = __builtin_amdgcn_ds_read_tr16_b64_v4i16((LAS s16x4*)(img + vimg_off(16 * ks + 8 * h + 0 + qq, 4 * c + 2 * blk + (pp >> 1)) + 8 * (pp & 1)));
    const s16x4 b = __builtin_amdgcn_ds_read_tr16_b64_v4i16((LAS s16x4*)(img + vimg_off(16 * ks + 8 * h + 4 + qq, 4 * c + 2 * blk + (pp >> 1)) + 8 * (pp & 1)));
    return __builtin_shufflevector(a, b, 0, 1, 2, 3, 4, 5, 6, 7);
}
DEV void dil_mfma_item(int b, int h, int p, int rr, int i0, const bf16* __restrict__ Z, const float* __restrict__ rel_bias, bf16* __restrict__ PART, float* __restrict__ LSE, LAS unsigned char* wl, int lane) {
    asm volatile("" : "+v"(lane));
    const int r = lane & 31, hh = lane >> 5;
    const int d = 1 << (2 * p);
    LAS float* biasL = (LAS float*)(wl + ATT_BOFF);
    for (int dd = lane; dd < 129; dd += 64) biasL[dd] = rel_bias[(int)T5B[p][dd] * 6 + h];
    const size_t rowq = (size_t)b * SEQ + rr + d * (i0 + r);
    bf16x8 qf[8];
    { const bf16* qrow = Z + rowq * IN_W + ZO_QB + h * 128 + 8 * hh;
#pragma unroll
      for (int ks = 0; ks < 8; ++ks) qf[ks] = *(const bf16x8*)(qrow + 16 * ks); }
    float m_run = NEGBIG, l_run = 0.f;
    f32x16 o[4];
#pragma unroll
    for (int dt = 0; dt < 4; ++dt)
#pragma unroll
        for (int e = 0; e < 16; ++e) o[dt][e] = 0.f;
    const int kap = (r & 0x13) | ((r & 4) << 1) | ((r & 8) >> 1);
    int jt = 4 - (i0 >> 5); jt = jt < 0 ? 0 : jt;
#define DIL_DMA_K(JT) do { int jk = i0 - 128 + 32 * (JT) + kap; jk = jk < 0 ? 0 : jk; const bf16* krow = Z + ((size_t)b * SEQ + rr + d * jk) * IN_W + ZO_KB + h * 128 + 8 * hh; \
        _Pragma("unroll") for (int ks = 0; ks < 8; ++ks) __builtin_amdgcn_global_load_lds((const unsigned*)(krow + 16 * ks), (LAS unsigned*)(wl + ATT_KOFF + 1024 * ks), 16, 0, 0); } while (0)
#define DIL_DMA_V(JT) do { const int j0_ = i0 - 128 + 32 * (JT); _Pragma("unroll") for (int q = 0; q < 8; ++q) { const int pi = lane + 64 * q, kl = pi >> 4, c = (pi & 15) ^ (((kl & 3) << 2) | ((kl >> 2) & 3)); int j = j0_ + kl; j = j < 0 ? 0 : j; \
        __builtin_amdgcn_global_load_lds((const unsigned*)(Z + ((size_t)b * SEQ + rr + d * j) * IN_W + ZO_VB + h * 128 + 8 * c), (LAS unsigned*)(wl + 1024 * q), 16, 0, 0); } } while (0)
    LDS_WAIT();
    DIL_DMA_K(jt); DIL_DMA_V(jt);
    for (; jt < 5; ++jt) {
        const int j0 = i0 - 128 + 32 * jt;
        const int jn = jt < 4 ? jt + 1 : 4;
        asm volatile("s_waitcnt vmcnt(8)" ::: "memory");
        f32x16 sacc, sac2;
#pragma unroll
        for (int e = 0; e < 16; ++e) { sacc[e] = 0.f; sac2[e] = 0.f; }
        {
            bf16x8 kf[8];
#pragma unroll
            for (int ks = 0; ks < 8; ++ks) kf[ks] = *((const LAS bf16x8*)(wl + ATT_KOFF + 1024 * ks) + lane);
#pragma unroll
            for (int ks = 0; ks < 8; ks += 2) { sacc = __builtin_amdgcn_mfma_f32_32x32x16_bf16(kf[ks], qf[ks], sacc, 0, 0, 0); sac2 = __builtin_amdgcn_mfma_f32_32x32x16_bf16(kf[ks + 1], qf[ks + 1], sac2, 0, 0, 0); }
#pragma unroll
            for (int e = 0; e < 16; ++e) sacc[e] += sac2[e];
        }
        LDS_WAIT();
        DIL_DMA_K(jn);
        float tm = NEGBIG;
#pragma unroll
        for (int e = 0; e < 16; ++e) {
            const int j = j0 + 16 * (e >> 3) + 8 * hh + (e & 7);
            const int dist = (i0 + r) - j;
            const bool valid = (j >= 0) && (dist >= 0) && (dist <= 128);
            const int dc = dist < 0 ? 0 : (dist > 128 ? 128 : dist);
            const float bv = *(volatile LAS float*)(biasL + dc);
            const float lg = valid ? sacc[e] * QSCALE + bv : NEGBIG;
            sacc[e] = lg; tm = fmaxf(tm, lg);
        }
        tm = max32(tm);
        const float m_new = fmaxf(m_run, tm);
        const float alpha = __expf(m_run - m_new);
        float ps = 0.f;
#pragma unroll
        for (int e = 0; e < 16; ++e) { const float pv = (sacc[e] > -1.0e37f) ? __expf(sacc[e] - m_new) : 0.f; sacc[e] = pv; ps += pv; }
        ps = sum32(ps);
        l_run = l_run * alpha + ps; m_run = m_new;
#pragma unroll
        for (int dt = 0; dt < 4; ++dt)
#pragma unroll
            for (int e = 0; e < 16; ++e) o[dt][e] *= alpha;
        bf16x8 pf[2];
#pragma unroll
        for (int s2 = 0; s2 < 2; ++s2) { v4u w; w.x = cvtpk_bf16(sacc[8 * s2 + 0], sacc[8 * s2 + 1]); w.y = cvtpk_bf16(sacc[8 * s2 + 2], sacc[8 * s2 + 3]);
            w.z = cvtpk_bf16(sacc[8 * s2 + 4], sacc[8 * s2 + 5]); w.w = cvtpk_bf16(sacc[8 * s2 + 6], sacc[8 * s2 + 7]); pf[s2] = __builtin_bit_cast(bf16x8, w); }
        asm volatile("s_waitcnt vmcnt(8)" ::: "memory");
#pragma unroll
        for (int dt = 0; dt < 4; ++dt)
#pragma unroll
            for (int s2 = 0; s2 < 2; ++s2) o[dt] = __builtin_amdgcn_mfma_f32_32x32x16_bf16(vfrag_tr(wl, lane, dt, s2), pf[s2], o[dt], 0, 0, 0);
        LDS_WAIT();
        DIL_DMA_V(jn);
    }
    asm volatile("s_waitcnt vmcnt(0)" ::: "memory");
#undef DIL_DMA_V
#undef DIL_DMA_K
    const float inv = 1.f / l_run;
    bf16* po = PART + ((size_t)p * M + rowq) * SWA_W + h * 128;
#pragma unroll
    for (int dt = 0; dt < 4; ++dt)
#pragma unroll
        for (int g = 0; g < 4; ++g)
            *(unsigned long long*)(po + 32 * dt + 8 * g + 4 * hh) = (unsigned long long)pk2(o[dt][4 * g + 0] * inv, o[dt][4 * g + 1] * inv) | ((unsigned long long)pk2(o[dt][4 * g + 2] * inv, o[dt][4 * g + 3] * inv) << 32);
    if (hh == 0) LSE[((size_t)p * M + rowq) * 6 + h] = m_run + __logf(l_run);
}


DEV void lru_item2(int l, int b, int j, int n, const bf16* __restrict__ Z, const float* __restrict__ conv_w, const float* __restrict__ conv_b, const bf16* __restrict__ WGT,
                   const float* __restrict__ b_rec, const float* __restrict__ b_gi, const float* __restrict__ lam,
                   bf16* __restrict__ HLOC, bf16* __restrict__ PP, float* __restrict__ SUMA, float* __restrict__ SUMB, LAS float* xc, LAS float* g0L, LAS float* g1L, int tid) {
    const int ch = tid & 127, tq = tid >> 7, c = n * 128 + ch;
    {
        LAS unsigned char* xaL = (LAS unsigned char*)(g1L + 64 * 132);
        const int t0 = j * 64;
#pragma unroll
        for (int i = 0; i < 3; ++i) { const int pz = tid + 512 * i; if (pz < 67 * 16) { const int row = pz >> 4, cc = pz & 15; const int t = t0 - 3 + row;
            v4u w = {0u, 0u, 0u, 0u}; if (t >= 0) w = *(const v4u*)(Z + ((size_t)b * SEQ + t) * IN_W + ZO_XA + n * 128 + 8 * cc);
            *(LAS v4u*)(xaL + row * 256 + cc * 16) = w; } }
        __syncthreads();
        const float cw0 = conv_w[(l * 4 + 0) * LRU_W + c], cw1 = conv_w[(l * 4 + 1) * LRU_W + c], cw2 = conv_w[(l * 4 + 2) * LRU_W + c], cw3 = conv_w[(l * 4 + 3) * LRU_W + c];
        const float cb = conv_b[l * LRU_W + c];
        const LAS bf16* xp = (const LAS bf16*)xaL + ch;
#pragma unroll 4
        for (int i = 0; i < 16; ++i) {
            const int tok = tq + 4 * i;
            xc[tok * 132 + ch] = cb + cw0 * bf1(xp[(tok + 0) * 128]) + cw1 * bf1(xp[(tok + 1) * 128]) + cw2 * bf1(xp[(tok + 2) * 128]) + cw3 * bf1(xp[(tok + 3) * 128]);
        }
    }
    __syncthreads();
    {
        const int lane = tid & 63, wave = tid >> 6, r = lane & 31, hh = lane >> 5, g = wave >> 2, ct = wave & 3;
        const bf16* wp = WGT + (((size_t)(l * 6 + n) * 2 + g) * 128 + ct * 32 + r) * 128 + 8 * hh;
        bf16x8 bfr[8];
#pragma unroll
        for (int ks = 0; ks < 8; ++ks) bfr[ks] = *(const bf16x8*)(wp + 16 * ks);
        LAS float* gL = g ? g1L : g0L;
#pragma unroll
        for (int rt = 0; rt < 2; ++rt) {
            f32x16 acc;
#pragma unroll
            for (int e = 0; e < 16; ++e) acc[e] = 0.f;
#pragma unroll
            for (int ks = 0; ks < 8; ++ks) {
                const LAS float* xp = xc + (32 * rt + r) * 132 + 16 * ks + 8 * hh;
                const f32x4 x0 = *(const LAS f32x4*)xp, x1 = *(const LAS f32x4*)(xp + 4);
                v4u w; w.x = cvtpk_bf16(x0.x, x0.y); w.y = cvtpk_bf16(x0.z, x0.w); w.z = cvtpk_bf16(x1.x, x1.y); w.w = cvtpk_bf16(x1.z, x1.w);
                acc = __builtin_amdgcn_mfma_f32_32x32x16_bf16(__builtin_bit_cast(bf16x8, w), bfr[ks], acc, 0, 0, 0);
            }
#pragma unroll
            for (int e = 0; e < 16; ++e) { const int tok = 32 * rt + (e & 3) + 8 * (e >> 2) + 4 * hh; gL[tok * 132 + ct * 32 + r] = acc[e]; }
        }
    }
    __syncthreads();
    {
        const float br = b_rec[l * LRU_W + c], bi = b_gi[l * LRU_W + c], sp = softplus_f(-lam[l * LRU_W + c]);
#pragma unroll 4
        for (int i = 0; i < 16; ++i) {
            const int tok = tq + 4 * i;
            const float rg = sigmoid_f(g0L[tok * 132 + ch] + br), ig = sigmoid_f(g1L[tok * 132 + ch] + bi);
            const float log_a = -8.0f * rg * sp;
            const float av = __expf(log_a);
            const float x = xc[tok * 132 + ch];
            const float uv = sqrtf(fmaxf(-expm1f(2.f * log_a), 0.f)) * (ig * x);
            g0L[tok * 132 + ch] = av; g1L[tok * 132 + ch] = uv;
        }
    }
    __syncthreads();
    if (tid < 128) {
        float h = 0.f, P = 1.f;
        const size_t rb = ((size_t)b * SEQ + j * 64) * LRU_W + n * 128 + tid;
#pragma unroll 8
        for (int tok = 0; tok < 64; ++tok) {
            const float av = g0L[tok * 132 + tid];
            h = av * h + g1L[tok * 132 + tid]; P *= av;
            HLOC[rb + (size_t)tok * LRU_W] = (bf16)f2bf(h); PP[rb + (size_t)tok * LRU_W] = (bf16)f2bf(P);
        }
        SUMA[(size_t)(b * 64 + j) * LRU_W + n * 128 + tid] = P; SUMB[(size_t)(b * 64 + j) * LRU_W + n * 128 + tid] = h;
    }
    __syncthreads();
}

DEV void sb_mfma_item(int b, int h, int t0, const bf16* __restrict__ Z, bf16* __restrict__ YC, LAS unsigned char* wl, int lane) {
    asm volatile("" : "+v"(lane));
    const int r = lane & 31, hh = lane >> 5;
    const size_t rowq = (size_t)b * SEQ + t0 + r;
    bf16x8 qf[8];
    { const bf16* qrow = Z + rowq * IN_W + ZO_QC + h * 128 + 8 * hh;
#pragma unroll
      for (int ks = 0; ks < 8; ++ks) qf[ks] = *(const bf16x8*)(qrow + 16 * ks); }
    f32x16 o[4];
#pragma unroll
    for (int dt = 0; dt < 4; ++dt)
#pragma unroll
        for (int e = 0; e < 16; ++e) o[dt][e] = 0.f;
    const int kap = (r & 0x13) | ((r & 4) << 1) | ((r & 8) >> 1);
    float carry = 0.f;
#define SB_DMA_K(K0) do { const bf16* krow = Z + ((size_t)b * SEQ + (K0) + kap) * IN_W + ZO_KC + h * 128 + 8 * hh; \
        _Pragma("unroll") for (int ks = 0; ks < 8; ++ks) __builtin_amdgcn_global_load_lds((const unsigned*)(krow + 16 * ks), (LAS unsigned*)(wl + ATT_KOFF + 1024 * ks), 16, 0, 0); } while (0)
#define SB_DMA_V(K0) do { _Pragma("unroll") for (int q = 0; q < 8; ++q) { const int pi = lane + 64 * q, kl = pi >> 4, c = (pi & 15) ^ (((kl & 3) << 2) | ((kl >> 2) & 3)); \
        __builtin_amdgcn_global_load_lds((const unsigned*)(Z + ((size_t)b * SEQ + (K0) + kl) * IN_W + ZO_VC + h * 128 + 8 * c), (LAS unsigned*)(wl + 1024 * q), 16, 0, 0); } } while (0)
    LDS_WAIT();
    SB_DMA_K(t0); SB_DMA_V(t0);
    for (int k0 = t0; k0 >= 0; k0 -= 32) {
        const int kn = k0 >= 32 ? k0 - 32 : 0;
        asm volatile("s_waitcnt vmcnt(8)" ::: "memory");
        f32x16 sacc, sac2;
#pragma unroll
        for (int e = 0; e < 16; ++e) { sacc[e] = 0.f; sac2[e] = 0.f; }
        {
            bf16x8 kf[8];
#pragma unroll
            for (int ks = 0; ks < 8; ++ks) kf[ks] = *((const LAS bf16x8*)(wl + ATT_KOFF + 1024 * ks) + lane);
#pragma unroll
            for (int ks = 0; ks < 8; ks += 2) { sacc = __builtin_amdgcn_mfma_f32_32x32x16_bf16(kf[ks], qf[ks], sacc, 0, 0, 0); sac2 = __builtin_amdgcn_mfma_f32_32x32x16_bf16(kf[ks + 1], qf[ks + 1], sac2, 0, 0, 0); }
#pragma unroll
            for (int e = 0; e < 16; ++e) sacc[e] += sac2[e];
        }
        LDS_WAIT();
        SB_DMA_K(kn);
        float l1[16]; float T0 = 0.f, T1 = 0.f;
#pragma unroll
        for (int e = 0; e < 16; ++e) {
            const int key = k0 + 16 * (e >> 3) + 8 * hh + (e & 7);
            const bool valid = key < t0 + r;
            const float z = sacc[e] * QSCALE;
            sacc[e] = z;
            l1[e] = valid ? -(fmaxf(z, 0.f) + __logf(1.f + __expf(-fabsf(z)))) : 0.f;
        }
#pragma unroll
        for (int e = 0; e < 8; ++e) { T0 += l1[e]; T1 += l1[8 + e]; }
        const float PT0 = partner32(T0, hh), PT1 = partner32(T1, hh);
        const float base1 = carry + (hh ? 0.f : PT1);
        const float base0 = carry + (hh ? (T1 + PT1) : (PT1 + T1 + PT0));
        float run1 = base1, run0 = base0;
#pragma unroll
        for (int e = 7; e >= 0; --e) {
            { const int key = k0 + 16 + 8 * hh + e; const bool valid = key < t0 + r; const float a = valid ? __expf(sacc[8 + e] + l1[8 + e] + run1) : 0.f; run1 += l1[8 + e]; sacc[8 + e] = a; }
            { const int key = k0 + 8 * hh + e; const bool valid = key < t0 + r; const float a = valid ? __expf(sacc[e] + l1[e] + run0) : 0.f; run0 += l1[e]; sacc[e] = a; }
        }
        carry += (T0 + T1) + (PT0 + PT1);
        bf16x8 pf[2];
#pragma unroll
        for (int s2 = 0; s2 < 2; ++s2) { v4u w; w.x = cvtpk_bf16(sacc[8 * s2 + 0], sacc[8 * s2 + 1]); w.y = cvtpk_bf16(sacc[8 * s2 + 2], sacc[8 * s2 + 3]);
            w.z = cvtpk_bf16(sacc[8 * s2 + 4], sacc[8 * s2 + 5]); w.w = cvtpk_bf16(sacc[8 * s2 + 6], sacc[8 * s2 + 7]); pf[s2] = __builtin_bit_cast(bf16x8, w); }
        asm volatile("s_waitcnt vmcnt(8)" ::: "memory");
#pragma unroll
        for (int dt = 0; dt < 4; ++dt)
#pragma unroll
            for (int s2 = 0; s2 < 2; ++s2) o[dt] = __builtin_amdgcn_mfma_f32_32x32x16_bf16(vfrag_tr(wl, lane, dt, s2), pf[s2], o[dt], 0, 0, 0);
        LDS_WAIT();
        SB_DMA_V(kn);
        if (__all(carry < -105.0f)) break;
    }
    asm volatile("s_waitcnt vmcnt(0)" ::: "memory");
#undef SB_DMA_V
#undef SB_DMA_K
    bf16* po = YC + rowq * SB_W + h * 128;
#pragma unroll
    for (int dt = 0; dt < 4; ++dt)
#pragma unroll
        for (int g = 0; g < 4; ++g)
            *(unsigned long long*)(po + 32 * dt + 8 * g + 4 * hh) = (unsigned long long)pk2(o[dt][4 * g + 0], o[dt][4 * g + 1]) | ((unsigned long long)pk2(o[dt][4 * g + 2], o[dt][4 * g + 3]) << 32);
}

DEV void combine_item(int l, int b, int j, int half, const bf16* __restrict__ Z, const bf16* __restrict__ HLOC, const bf16* __restrict__ PP, const float* __restrict__ SUMA, const float* __restrict__ SUMB,
                      const bf16* __restrict__ PART, const float* __restrict__ LSE, const bf16* __restrict__ YC, const float* __restrict__ g_lru, const float* __restrict__ g_swa, const float* __restrict__ g_sb,
                      bf16* __restrict__ Y, LAS float* carryL, int tid) {
    const int lane = tid & 63, wave = tid >> 6;
    for (int c = tid; c < LRU_W; c += 512) {
        float cr = 0.f; int i = 0;
        for (; i + 8 <= j; i += 8) {
            float av[8], bv[8];
#pragma unroll
            for (int u = 0; u < 8; ++u) { av[u] = SUMA[(size_t)(b * 64 + i + u) * LRU_W + c]; bv[u] = SUMB[(size_t)(b * 64 + i + u) * LRU_W + c]; }
#pragma unroll
            for (int u = 0; u < 8; ++u) cr = av[u] * cr + bv[u];
        }
        for (; i < j; ++i) cr = SUMA[(size_t)(b * 64 + i) * LRU_W + c] * cr + SUMB[(size_t)(b * 64 + i) * LRU_W + c];
        carryL[c] = cr;
    }
    __syncthreads();
    for (int i = 0; i < 4; ++i) {
        const int tok = half * 32 + wave * 4 + i;
        const size_t row = (size_t)b * SEQ + j * 64 + tok;
        bf16* yo = Y + row * D;
        {
            float ya[12]; float ssq = 0.f;
#pragma unroll
            for (int e = 0; e < 6; ++e) { const int c = 2 * lane + 128 * e;
                const unsigned hw = *(const unsigned*)(HLOC + row * LRU_W + c), pw = *(const unsigned*)(PP + row * LRU_W + c), gw2 = *(const unsigned*)(Z + row * IN_W + ZO_GA + c);
                const f32x2 cr = *(const LAS f32x2*)(carryL + c);
                ya[2 * e] = (bf_lo(hw) + bf_lo(pw) * cr.x) * gelu_tanh(bf_lo(gw2)); ya[2 * e + 1] = (bf_hi(hw) + bf_hi(pw) * cr.y) * gelu_tanh(bf_hi(gw2));
                ssq += ya[2 * e] * ya[2 * e] + ya[2 * e + 1] * ya[2 * e + 1]; }
            const float r = rsqrtf(wave_sum(ssq) * (1.f / LRU_W) + EPS);
#pragma unroll
            for (int e = 0; e < 6; ++e) { const int c = 2 * lane + 128 * e; const f32x2 g = *(const f32x2*)(g_lru + l * LRU_W + c);
                *(unsigned*)(yo + c) = pk2(ya[2 * e] * r * g.x, ya[2 * e + 1] * r * g.y); }
        }
        {
            float yb[12]; float ssq = 0.f;
#pragma unroll
            for (int e = 0; e < 6; ++e) { const int c = 2 * lane + 128 * e;
                const float l0 = LSE[((size_t)0 * M + row) * 6 + e], l1 = LSE[((size_t)1 * M + row) * 6 + e], l2 = LSE[((size_t)2 * M + row) * 6 + e];
                const float mx = fmaxf(l0, fmaxf(l1, l2)); const float e0 = __expf(l0 - mx), e1 = __expf(l1 - mx), e2 = __expf(l2 - mx); const float iz = 1.f / (e0 + e1 + e2);
                const unsigned p0 = *(const unsigned*)(PART + ((size_t)0 * M + row) * SWA_W + c), p1 = *(const unsigned*)(PART + ((size_t)1 * M + row) * SWA_W + c), p2 = *(const unsigned*)(PART + ((size_t)2 * M + row) * SWA_W + c);
                yb[2 * e] = (e0 * bf_lo(p0) + e1 * bf_lo(p1) + e2 * bf_lo(p2)) * iz; yb[2 * e + 1] = (e0 * bf_hi(p0) + e1 * bf_hi(p1) + e2 * bf_hi(p2)) * iz;
                ssq += yb[2 * e] * yb[2 * e] + yb[2 * e + 1] * yb[2 * e + 1]; }
            const float r = rsqrtf(wave_sum(ssq) * (1.f / SWA_W) + EPS);
#pragma unroll
            for (int e = 0; e < 6; ++e) { const int c = 2 * lane + 128 * e; const f32x2 g = *(const f32x2*)(g_swa + l * SWA_W + c);
                *(unsigned*)(yo + LRU_W + c) = pk2(yb[2 * e] * r * g.x, yb[2 * e + 1] * r * g.y); }
        }
        {
            float yc[8]; float ssq = 0.f;
#pragma unroll
            for (int e = 0; e < 4; ++e) { const int c = 2 * lane + 128 * e; const unsigned w = *(const unsigned*)(YC + row * SB_W + c); yc[2 * e] = bf_lo(w); yc[2 * e + 1] = bf_hi(w); ssq += yc[2 * e] * yc[2 * e] + yc[2 * e + 1] * yc[2 * e + 1]; }
            const float r = rsqrtf(wave_sum(ssq) * (1.f / SB_W) + EPS);
#pragma unroll
            for (int e = 0; e < 4; ++e) { const int c = 2 * lane + 128 * e; const f32x2 g = *(const f32x2*)(g_sb + l * SB_W + c);
                *(unsigned*)(yo + LRU_W + SWA_W + c) = pk2(yc[2 * e] * r * g.x, yc[2 * e + 1] * r * g.y); }
        }
    }
    __syncthreads();
}


constexpr float U8_SCALE = 64.f;
DEV void convert_fp8(const float* __restrict__ src, unsigned char* __restrict__ dst, size_t ngroups16, size_t gtid, size_t gstride, float scale) {
    for (size_t g = gtid; g < ngroups16; g += gstride) {
        const f32x4 a = *(const f32x4*)(src + g * 16) * scale, b = *(const f32x4*)(src + g * 16 + 4) * scale, c = *(const f32x4*)(src + g * 16 + 8) * scale, d = *(const f32x4*)(src + g * 16 + 12) * scale;
        int w0 = 0, w1 = 0, w2 = 0, w3 = 0;
        w0 = __builtin_amdgcn_cvt_pk_fp8_f32(a.x, a.y, w0, false); w0 = __builtin_amdgcn_cvt_pk_fp8_f32(a.z, a.w, w0, true);
        w1 = __builtin_amdgcn_cvt_pk_fp8_f32(b.x, b.y, w1, false); w1 = __builtin_amdgcn_cvt_pk_fp8_f32(b.z, b.w, w1, true);
        w2 = __builtin_amdgcn_cvt_pk_fp8_f32(c.x, c.y, w2, false); w2 = __builtin_amdgcn_cvt_pk_fp8_f32(c.z, c.w, w2, true);
        w3 = __builtin_amdgcn_cvt_pk_fp8_f32(d.x, d.y, w3, false); w3 = __builtin_amdgcn_cvt_pk_fp8_f32(d.z, d.w, w3, true);
        *(v4u*)(dst + g * 16) = (v4u){(unsigned)w0, (unsigned)w1, (unsigned)w2, (unsigned)w3};
    }
}

constexpr int R2_SC = 0, R2_TV = 128 * 129 * 4, R2_TI = R2_TV + 128 * 16 * 4, R2_END = R2_TI + 128 * 16 * 4;
static_assert(R2_END <= LDS_MISC, "routing v2 LDS");
DEV unsigned ord_key(float s) { const unsigned u = __builtin_bit_cast(unsigned, s); return (u & 0x80000000u) ? ~u : (u | 0x80000000u); }

#define KEY_CE(A, B) do { const unsigned hi_ = (A) > (B) ? (A) : (B); const unsigned lo_ = (A) > (B) ? (B) : (A); (A) = hi_; (B) = lo_; } while (0)
DEV void bitonic_sort16_desc(unsigned (&a)[16]) {
#pragma unroll
    for (int k = 2; k <= 16; k <<= 1)
#pragma unroll
        for (int j = k >> 1; j > 0; j >>= 1)
#pragma unroll
            for (int i = 0; i < 16; ++i) { const int m = i ^ j; if (m > i) { if ((i & k) == 0) KEY_CE(a[i], a[m]); else KEY_CE(a[m], a[i]); } }
}
DEV void bitonic_merge16_desc(unsigned (&a)[16]) {
#pragma unroll
    for (int j = 8; j > 0; j >>= 1)
#pragma unroll
        for (int i = 0; i < 16; ++i) { const int m = i ^ j; if (m > i) KEY_CE(a[i], a[m]); }
}
DEV void route_item2(int l, int tile, int h, const bf16* __restrict__ Q, const bf16* __restrict__ SK, int* __restrict__ IDS, float* __restrict__ GG, LAS unsigned char* lds, int tid, int seq,
                        const float* __restrict__ cv_u, const float* __restrict__ cv_v, unsigned char* __restrict__ cv_u8, unsigned char* __restrict__ cv_v8) {
    LAS float* sc = (LAS float*)(lds + R2_SC); LAS float* tv = (LAS float*)(lds + R2_TV); LAS int* ti = (LAS int*)(lds + R2_TI);
    const int lane = tid & 63, wave = tid >> 6, row0 = tile * 64;
    {
        const int r = lane & 31, hh = lane >> 5, c = wave >> 2, key0 = 32 * (wave & 3);
        const bf16* skp = SK + ((size_t)(((l * 8 + h) * 2 + c) * 128 + key0 + r)) * 128 + 8 * hh;
        bf16x8 bfr[8];
#pragma unroll
        for (int ks = 0; ks < 8; ++ks) bfr[ks] = *(const bf16x8*)(skp + 16 * ks);
#pragma unroll
        for (int rt = 0; rt < 2; ++rt) {
            const bf16* qp = Q + (size_t)(row0 + 32 * rt + r) * D + h * 256 + c * 128 + 8 * hh;
            bf16x8 afr[8];
#pragma unroll
            for (int ks = 0; ks < 8; ++ks) afr[ks] = *(const bf16x8*)(qp + 16 * ks);
            f32x16 acc;
#pragma unroll
            for (int e = 0; e < 16; ++e) acc[e] = 0.f;
#pragma unroll
            for (int ks = 0; ks < 8; ++ks) acc = __builtin_amdgcn_mfma_f32_32x32x16_bf16(afr[ks], bfr[ks], acc, 0, 0, 0);
#pragma unroll
            for (int e = 0; e < 16; ++e) { const int tok = 32 * rt + (e & 3) + 8 * (e >> 2) + 4 * hh; sc[(c * 64 + tok) * 129 + key0 + r] = acc[e]; }
        }
    }
    __syncthreads();
    if (tid >= 128) {
        const size_t TG = (size_t)NEXP * D / 16;
        const size_t g0 = (size_t)(tile * 8 + h) * 4096;
#pragma unroll 4
        for (int k = 0; k < 11; ++k) { const size_t g = g0 + (size_t)(tid - 128) + 384u * k;
            if (g < g0 + 4096) { const bool isv = g >= TG; const size_t gg = isv ? g - TG : g;
                convert_fp8((isv ? cv_v : cv_u) + gg * 16, (isv ? cv_v8 : cv_u8) + gg * 16, 1, 0, 1, isv ? 1.f : U8_SCALE); } }
    }
    if (tid < 128) {
        const int L = tid;
        unsigned t[16];
#pragma unroll
        for (int q = 0; q < 16; ++q) t[q] = 0u;
#pragma unroll 1
        for (int blk = 0; blk < 8; ++blk) {
            unsigned bk[16];
#pragma unroll
            for (int i = 0; i < 16; ++i) { const int k = blk * 16 + i; bk[i] = (ord_key(sc[L * 129 + k]) & ~127u) | (unsigned)(127 - k); }
            bitonic_sort16_desc(bk);
#pragma unroll
            for (int i = 0; i < 16; ++i) t[i] = t[i] > bk[15 - i] ? t[i] : bk[15 - i];
            bitonic_merge16_desc(t);
        }
#pragma unroll
        for (int q = 0; q < 16; ++q) { const int idx = 127 - (int)(t[q] & 127u); tv[L * 16 + q] = sc[L * 129 + idx]; ti[L * 16 + q] = idx; }
    }
    if (wave == 1) { LDS_WAIT(); if (lane == 0) *(volatile LAS int*)(lds + LDS_MISC + 128) = seq; }
    if (wave == 0) { LDS_WAIT(); while (*(volatile LAS int*)(lds + LDS_MISC + 128) != seq) __builtin_amdgcn_s_sleep(1); }
    if (tid < 64) {
        const int tok = tid;
        float a[16], bq[16];
#pragma unroll
        for (int i = 0; i < 16; ++i) { a[i] = tv[tok * 16 + i]; bq[i] = tv[(64 + tok) * 16 + i]; }
        unsigned t[16];
#pragma unroll
        for (int q = 0; q < 16; ++q) t[q] = 0u;
#pragma unroll
        for (int i = 0; i < 16; ++i)
#pragma unroll
            for (int j = 0; j < 16 / (i + 1); ++j) {
                unsigned key = (ord_key(a[i] + bq[j]) & ~255u) | (unsigned)(255 - (i * 16 + j));
#pragma unroll
                for (int q = 0; q < 16; ++q) { const unsigned hi = t[q] > key ? t[q] : key; key = t[q] > key ? key : t[q]; t[q] = hi; }
            }
        float scv[16]; int idv[16]; float mx = NEGBIG;
#pragma unroll
        for (int q = 0; q < 16; ++q) { const int ci = 255 - (int)(t[q] & 255u); const int i = ci >> 4, j = ci & 15;
            scv[q] = tv[tok * 16 + i] + tv[(64 + tok) * 16 + j]; idv[q] = ti[tok * 16 + i] * 128 + ti[(64 + tok) * 16 + j]; mx = fmaxf(mx, scv[q]); }
        float sum = 0.f;
#pragma unroll
        for (int q = 0; q < 16; ++q) { scv[q] = __expf(scv[q] - mx); sum += scv[q]; }
        const float inv = 1.f / sum;
        int* ip = IDS + (size_t)(row0 + tok) * 128 + h * 16; float* gp = GG + (size_t)(row0 + tok) * 128 + h * 16;
#pragma unroll
        for (int q4 = 0; q4 < 4; ++q4) {
            *(int4*)(ip + 4 * q4) = make_int4(idv[4 * q4], idv[4 * q4 + 1], idv[4 * q4 + 2], idv[4 * q4 + 3]);
            *(f32x4*)(gp + 4 * q4) = (f32x4){scv[4 * q4] * inv, scv[4 * q4 + 1] * inv, scv[4 * q4 + 2] * inv, scv[4 * q4 + 3] * inv};
        }
    }
    __syncthreads();
}


DEV void expert_row8(int l, int row, const bf16* H, const int* __restrict__ IDS, const float* __restrict__ GG, const unsigned char* __restrict__ U8, const unsigned char* __restrict__ V8,
                     const bf16* __restrict__ X1, const float* __restrict__ g2, const float* __restrict__ fnorm, float* __restrict__ XO, bf16* __restrict__ XOH, int lane, float pscale, LAS int* sortL,
                     const float* __restrict__ ngain, const float* __restrict__ nmod, bf16* Hout) {
    f32x2 x[16];
#pragma unroll
    for (int j = 0; j < 2; ++j) {
        const v4u a = *(const v4u*)(H + (size_t)row * D + lane * 16 + 1024 * j), c = *(const v4u*)(H + (size_t)row * D + lane * 16 + 1024 * j + 8);
        x[j * 8 + 0] = (f32x2){bf_lo(a.x), bf_hi(a.x)}; x[j * 8 + 1] = (f32x2){bf_lo(a.y), bf_hi(a.y)}; x[j * 8 + 2] = (f32x2){bf_lo(a.z), bf_hi(a.z)}; x[j * 8 + 3] = (f32x2){bf_lo(a.w), bf_hi(a.w)};
        x[j * 8 + 4] = (f32x2){bf_lo(c.x), bf_hi(c.x)}; x[j * 8 + 5] = (f32x2){bf_lo(c.y), bf_hi(c.y)}; x[j * 8 + 6] = (f32x2){bf_lo(c.z), bf_hi(c.z)}; x[j * 8 + 7] = (f32x2){bf_lo(c.w), bf_hi(c.w)};
    }
    int id0 = IDS[(size_t)row * 128 + lane], id1 = IDS[(size_t)row * 128 + 64 + lane];
    float gg0 = GG[(size_t)row * 128 + lane], gg1 = GG[(size_t)row * 128 + 64 + lane];
    {
        const int w0 = id0 >> 9, w1 = id1 >> 9; int p0 = 0, p1 = 0, base = 0;
        for (int w = 0; w < 32; ++w) {
            const unsigned long long m0 = __ballot(w0 == w), m1 = __ballot(w1 == w);
            const int c0 = __popcll(m0), c1 = __popcll(m1);
            const int b0 = (int)__builtin_amdgcn_mbcnt_hi((unsigned)(m0 >> 32), __builtin_amdgcn_mbcnt_lo((unsigned)m0, 0u));
            const int b1 = (int)__builtin_amdgcn_mbcnt_hi((unsigned)(m1 >> 32), __builtin_amdgcn_mbcnt_lo((unsigned)m1, 0u));
            p0 = (w0 == w) ? base + b0 : p0; p1 = (w1 == w) ? base + c0 + b1 : p1;
            base += c0 + c1;
        }
        sortL[p0] = id0; sortL[p1] = id1; ((LAS float*)sortL)[128 + p0] = gg0; ((LAS float*)sortL)[128 + p1] = gg1;
        LDS_WAIT();
        id0 = sortL[lane]; id1 = sortL[64 + lane]; gg0 = ((LAS float*)sortL)[128 + lane]; gg1 = ((LAS float*)sortL)[192 + lane];
        LDS_WAIT();
    }
    float wv0 = 0.f, wv1 = 0.f;
    const unsigned char* Ul = U8 + (size_t)l * NEXP * D + lane * 16;
    const unsigned char* Vl = V8 + (size_t)l * NEXP * D + lane * 16;
    for (int e0 = 0; e0 < 128; e0 += 8) {
        v4u uu[8][2];
#pragma unroll
        for (int q = 0; q < 8; ++q) { const int e = e0 + q; const int id = (e < 64) ? __builtin_amdgcn_readlane(id0, e & 63) : __builtin_amdgcn_readlane(id1, e & 63);
            uu[q][0] = *(const v4u*)(Ul + (size_t)id * D); uu[q][1] = *(const v4u*)(Ul + (size_t)id * D + 1024); }
        float ds[8];
#pragma unroll
        for (int q = 0; q < 8; ++q) {
            f32x2 acc = {0.f, 0.f};
#pragma unroll
            for (int j = 0; j < 2; ++j) {
                const unsigned wd[4] = {uu[q][j].x, uu[q][j].y, uu[q][j].z, uu[q][j].w};
#pragma unroll
                for (int dw = 0; dw < 4; ++dw) {
                    const f32x2 lo = __builtin_amdgcn_cvt_pk_f32_fp8((int)wd[dw], false), hi = __builtin_amdgcn_cvt_pk_f32_fp8((int)wd[dw], true);
                    acc = __builtin_elementwise_fma(lo, x[j * 8 + 2 * dw], acc); acc = __builtin_elementwise_fma(hi, x[j * 8 + 2 * dw + 1], acc);
                }
            }
            ds[q] = acc.x + acc.y;
        }
#pragma unroll
        for (int q = 0; q < 8; ++q) ds[q] += swz_xor<1>(ds[q]);
#pragma unroll
        for (int q = 0; q < 8; ++q) ds[q] += swz_xor<2>(ds[q]);
#pragma unroll
        for (int q = 0; q < 8; ++q) ds[q] += swz_xor<4>(ds[q]);
#pragma unroll
        for (int q = 0; q < 8; ++q) ds[q] += swz_xor<8>(ds[q]);
#pragma unroll
        for (int q = 0; q < 8; ++q) ds[q] += swz_xor<16>(ds[q]);
#pragma unroll
        for (int q = 0; q < 8; ++q) ds[q] = sum32(ds[q]);
#pragma unroll
        for (int q = 0; q < 8; ++q) { const int e = e0 + q;
            const float gq = (e < 64) ? __builtin_bit_cast(float, __builtin_amdgcn_readlane(__builtin_bit_cast(int, gg0), e & 63)) : __builtin_bit_cast(float, __builtin_amdgcn_readlane(__builtin_bit_cast(int, gg1), e & 63));
            const float w = gq * gelu_tanh(ds[q] * (1.f / U8_SCALE));
            if (e < 64) wv0 = (lane == (e & 63)) ? w : wv0; else wv1 = (lane == (e & 63)) ? w : wv1; }
    }
    f32x2 y[16];
#pragma unroll
    for (int i = 0; i < 16; ++i) y[i] = (f32x2){0.f, 0.f};
    for (int e0 = 0; e0 < 128; e0 += 8) {
        v4u vv[8][2];
#pragma unroll
        for (int q = 0; q < 8; ++q) { const int e = e0 + q; const int id = (e < 64) ? __builtin_amdgcn_readlane(id0, e & 63) : __builtin_amdgcn_readlane(id1, e & 63);
            vv[q][0] = *(const v4u*)(Vl + (size_t)id * D); vv[q][1] = *(const v4u*)(Vl + (size_t)id * D + 1024); }
#pragma unroll
        for (int q = 0; q < 8; ++q) { const int e = e0 + q;
            const float w = (e < 64) ? __builtin_bit_cast(float, __builtin_amdgcn_readlane(__builtin_bit_cast(int, wv0), e & 63)) : __builtin_bit_cast(float, __builtin_amdgcn_readlane(__builtin_bit_cast(int, wv1), e & 63));
            const f32x2 w2 = {w, w};
#pragma unroll
            for (int j = 0; j < 2; ++j) {
                const unsigned wd[4] = {vv[q][j].x, vv[q][j].y, vv[q][j].z, vv[q][j].w};
#pragma unroll
                for (int dw = 0; dw < 4; ++dw) {
                    const f32x2 lo = __builtin_amdgcn_cvt_pk_f32_fp8((int)wd[dw], false), hi = __builtin_amdgcn_cvt_pk_f32_fp8((int)wd[dw], true);
                    y[j * 8 + 2 * dw] = __builtin_elementwise_fma(w2, lo, y[j * 8 + 2 * dw]); y[j * 8 + 2 * dw + 1] = __builtin_elementwise_fma(w2, hi, y[j * 8 + 2 * dw + 1]);
                }
            }
        }
    }
    float ssq = 0.f;
#pragma unroll
    for (int j = 0; j < 2; ++j)
#pragma unroll
        for (int k4 = 0; k4 < 4; ++k4) {
            const int col = lane * 16 + 1024 * j + 4 * k4;
            const unsigned long long xw = *(const unsigned long long*)(X1 + (size_t)row * D + col); const f32x4 xa = {bf_lo((unsigned)xw), bf_hi((unsigned)xw), bf_lo((unsigned)(xw >> 32)), bf_hi((unsigned)(xw >> 32))}; const f32x4 ga = *(const f32x4*)(g2 + col) * pscale;
            f32x2& ya = y[j * 8 + 2 * k4]; f32x2& yb = y[j * 8 + 2 * k4 + 1];
            ya.x = xa.x + ga.x * ya.x; ya.y = xa.y + ga.y * ya.y; yb.x = xa.z + ga.z * yb.x; yb.y = xa.w + ga.w * yb.y;
            ssq += (ya.x * ya.x + ya.y * ya.y) + (yb.x * yb.x + yb.y * yb.y);
        }
    const float r = rsqrtf(wave_sum(ssq) * (1.f / D) + EPS);
#pragma unroll
    for (int j = 0; j < 2; ++j)
#pragma unroll
        for (int k4 = 0; k4 < 4; ++k4) {
            const int col = lane * 16 + 1024 * j + 4 * k4;
            const f32x2 ya = y[j * 8 + 2 * k4], yb = y[j * 8 + 2 * k4 + 1];
            f32x4 ov = {ya.x, ya.y, yb.x, yb.y};
            if (fnorm) *(f32x4*)(XO + (size_t)row * D + col) = ov * r * *(const f32x4*)(fnorm + col);
            else *(unsigned long long*)(XOH + (size_t)row * D + col) = (unsigned long long)pk2(ov.x, ov.y) | ((unsigned long long)pk2(ov.z, ov.w) << 32);
            if (ngain) {
                const f32x4 g = *(const f32x4*)(ngain + col), sc = *(const f32x4*)(nmod + MO_SC1 + col), sh = *(const f32x4*)(nmod + MO_SH1 + col);
                const f32x4 hv = (ov * r) * g * (sc + 1.f) + sh;
                *(unsigned long long*)(Hout + (size_t)row * D + col) = (unsigned long long)pk2(hv.x, hv.y) | ((unsigned long long)pk2(hv.z, hv.w) << 32);
            }
        }
}


struct Args { const float* in[24]; float* out; unsigned char* ws; int ph_lo, ph_hi, li, pad; };

__global__ void __launch_bounds__(512, 2) fwd(Args a) {
    extern __shared__ __attribute__((aligned(16))) unsigned char lds_raw[];
    LAS unsigned char* lds = (LAS unsigned char*)lds_raw;
#define PHASE_TID() unsigned zz_ = 0u; asm volatile("" : "+v"(zz_));   \
    int tid = wave0 * 64 + (int)__builtin_amdgcn_mbcnt_hi(~0u, __builtin_amdgcn_mbcnt_lo(~0u, zz_)); const int lane = tid & 63; (void)lane; \
    int bx = blockIdx.x, G = gridDim.x; asm volatile("" : "+s"(bx), "+s"(G)); const int wave = __builtin_amdgcn_readfirstlane(tid >> 6); \
    const int vcu = (G % 8 == 0) ? (bx % 8) * (G / 8) + bx / 8 : bx; const int gw = vcu * 8 + wave, NGW = G * 8; (void)gw; (void)NGW; (void)vcu; (void)wave; \
    const __attribute__((address_space(4))) Args* A = (const __attribute__((address_space(4))) Args*)__builtin_amdgcn_kernarg_segment_ptr(); asm volatile("" : "+s"(A))
    unsigned* ctl = (unsigned*)(a.ws + WS_CTL);
    const int lo = a.ph_lo, hi = a.ph_hi;
    const int wave0 = __builtin_amdgcn_readfirstlane((int)threadIdx.x >> 6);
    for (int u = threadIdx.x; u < (LDS_BYTES - LDS_MISC) / 4; u += 512) ((LAS unsigned*)(lds + LDS_MISC))[u] = 0u;
    __syncthreads();
    XcdBarrier bar; bar.bar = ctl + CW_BAR + (a.li & 7) * XCD_BAR_WORDS; bar.x = 0; bar.st = (volatile LAS unsigned*)(lds + LDS_MISC + 64); bar.w0 = wave0;
    if (hi - lo > 1) bar = xcd_barrier_post(ctl + CW_BAR + (a.li & 7) * XCD_BAR_WORDS, (volatile LAS unsigned*)(lds + LDS_MISC + 64), wave0);
#define IN(k) (lo <= (k) && (k) < hi)
#define SEAM(k) do { if (IN(k) && IN((k) + 1)) xcd_barrier(bar); } while (0)

#define mod   ((float*)(A->ws + WS_MOD))
#define WIN_T ((bf16*)(A->ws + WS_WIN_T))
#define WOUT_T ((bf16*)(A->ws + WS_WOUT_T))
#define WQ_T  ((bf16*)(A->ws + WS_WQ_T))
#define SUBK  ((bf16*)(A->ws + WS_SUBK))
#define UB    ((bf16*)(A->ws + WS_U))
#define VB    ((bf16*)(A->ws + WS_V))
#define H     ((bf16*)(A->ws + WS_H))
#define Z     ((bf16*)(A->ws + WS_Z))
#define HLOC  ((bf16*)(A->ws + WS_HLOC))
#define PP    ((bf16*)(A->ws + WS_P))
#define YB    ((float*)(A->ws + WS_YB))
#define YC    ((bf16*)(A->ws + WS_YC))
#define SUMA  ((float*)(A->ws + WS_SUMA))
#define SUMB  ((float*)(A->ws + WS_SUMB))
#define X1    ((float*)(A->ws + WS_X1))
#define X2    ((float*)(A->ws + WS_X2))
#define QB    ((bf16*)(A->ws + WS_Q))
#define IDS   ((int*)(A->ws + WS_IDS))
#define GG    ((float*)(A->ws + WS_G))
#define PARTB ((bf16*)(A->ws + WS_PART))
#define WG_T  ((bf16*)(A->ws + WS_WG_T))
#define LSEB  ((float*)(A->ws + WS_LSE))
#define XIN   ((l == 0) ? A->in[0] : (const float*)X2)
#define XR    ((bf16*)(A->ws + WS_XR))
#define X1H   ((bf16*)(A->ws + WS_X1))
#define X2H   ((bf16*)(A->ws + WS_X2))
#define XRES  ((l == 0) ? (const bf16*)XR : (const bf16*)X2H)
#define MODL  (mod + (size_t)l * 2 * MODW)
    if (IN(0)) {
        PHASE_TID();
        ph_mod(A->in[1], A->in[2], A->in[3], mod, (LAS float*)lds, vcu, G, tid);
        {
            LAS float* scr = (LAS float*)(lds + wave * 17408);
            constexpr int I_IN = (D / 64) * (IN_W / 64), I_SQ = (D / 64) * (D / 64), I_L = I_IN + 2 * I_SQ;
            for (int it = gw; it < 2 * I_L; it += NGW) {
                const int l = it / I_L; int r = it % I_L;
                if (r < I_IN) { transpose_item64(A->in[6] + (size_t)l * D * IN_W, D, IN_W, WIN_T + (size_t)l * IN_W * D, scr, r, lane); continue; } r -= I_IN;
                if (r < I_SQ) { transpose_item64(A->in[18] + (size_t)l * D * D, D, D, WOUT_T + (size_t)l * D * D, scr, r, lane); continue; } r -= I_SQ;
                transpose_item64(A->in[19] + (size_t)l * D * D, D, D, WQ_T + (size_t)l * D * D, scr, r, lane);
            }
        }
        {
            LAS float* scr = (LAS float*)(lds + wave * 17408);
            for (int it = gw; it < 2 * 6 * 2 * 8; it += NGW) { const int mi = it >> 3, sub = it & 7; const int ln = mi >> 1, g = mi & 1;
                transpose_item((g ? A->in[11] : A->in[9]) + (size_t)ln * 128 * 128, 128, 128, WG_T + ((size_t)ln * 2 + g) * 128 * 128, scr, sub, lane); }
        }
        const size_t gtid = (size_t)vcu * 512 + tid, gstride = (size_t)G * 512;
        convert_copy(A->in[20], SUBK, (size_t)2 * 8 * 2 * 128 * 128 / 8, gtid, gstride);
    }
    SEAM(0);

    for (int l = 0; l < NL; ++l) {
        const int pb = 1 + 9 * l;
        if (IN(pb + 0) && l == 0) { PHASE_TID(); modnorm_rows(XIN, A->in[4] + l * D, MODL, MO_SH1, MO_SC1, H, gw, NGW, lane, XR); }
        if (l == 0) SEAM(pb + 0);
        if (IN(pb + 1)) {
            PHASE_TID(); (void)tid;
            pg8::Gemm g{H, WIN_T + (size_t)l * IN_W * D, M, IN_W, D}; pg8::StaticOrder S; S.init(M, IN_W, G, bx);
            pg8::EpiBf16<0> E{Z, IN_W, nullptr, 0, 0};
            pg8::gemm_phase<pg8::EpiBf16<0>, pg8::StaticOrder, false>((PG8_LAS unsigned char*)lds, g, S, E, nullptr, wave0);
        }
        SEAM(pb + 1);
        if (IN(pb + 2)) {
            PHASE_TID();
            for (int it = vcu; it < 2 * 64 * 6; it += G) {
                const int b = it / 384, r = it % 384, j = r / 6, n = r % 6;
                lru_item2(l, b, j, n, Z, A->in[7], A->in[8], WG_T, A->in[10], A->in[12], A->in[13], HLOC, PP, SUMA, SUMB,
                          (LAS float*)lds, (LAS float*)(lds + 34816), (LAS float*)(lds + 69632), tid);
            }
            {
                {
                    LAS unsigned char* wl = lds + wave * ATT_WLDS;
                    for (int it = gw; it < 1024 + 4608; it += NGW) {
                        if (it < 1024) { const int bh = it >> 7, tl = 127 - (it & 127); sb_mfma_item(bh >> 2, bh & 3, 32 * tl, Z, YC, wl, lane); }
                        else { const int i2 = it - 1024; const int tl = i2 & 127, p = (i2 >> 7) % 3, bh = i2 / 384; const int d = 1 << (2 * p);
                            dil_mfma_item(bh / 6, bh % 6, p, tl % d, 32 * (tl / d), Z, A->in[14], PARTB, LSEB, wl, lane); }
                    }
                }
            }
        }
        SEAM(pb + 2);
        if (IN(pb + 3)) {
            PHASE_TID();
            for (int it = vcu; it < 256; it += G) { const int b = it >> 7, j = (it >> 1) & 63, half = it & 1;
                combine_item(l, b, j, half, Z, HLOC, PP, SUMA, SUMB, PARTB, LSEB, YC, A->in[15], A->in[16], A->in[17], H, (LAS float*)lds, tid); }
        }
        SEAM(pb + 3);
        if (IN(pb + 4)) {
            PHASE_TID(); (void)tid;
            pg8::Gemm g{H, WOUT_T + (size_t)l * D * D, M, D, D}; pg8::StaticOrder S; S.init(M, D, G, bx);
            EpiResGate E{XRES, X1H, MODL + MO_G1, 1.f};
            pg8::gemm_phase<EpiResGate, pg8::StaticOrder, false>((PG8_LAS unsigned char*)lds, g, S, E, nullptr, wave0);
        }
        SEAM(pb + 4);
        if (IN(pb + 5)) { PHASE_TID(); modnorm_rows_h(X1H, A->in[5] + l * D, MODL, MO_SH2, MO_SC2, H, gw, NGW, lane); }
        SEAM(pb + 5);
        if (IN(pb + 6)) {
            PHASE_TID(); (void)tid;
            pg8::Gemm g{H, WQ_T + (size_t)l * D * D, M, D, D}; pg8::StaticOrder S; S.init(M, D, G, bx);
            pg8::EpiBf16<0> E{QB, D, nullptr, 0, 0};
            pg8::gemm_phase<pg8::EpiBf16<0>, pg8::StaticOrder, false>((PG8_LAS unsigned char*)lds, g, S, E, nullptr, wave0);
        }
        SEAM(pb + 6);
        if (IN(pb + 7)) {
            PHASE_TID();
            for (int it = vcu; it < 128 * 8; it += G) route_item2(l, it >> 3, it & 7, QB, SUBK, IDS, GG, lds, tid, l * 1024 + it + 1, A->in[21] + (size_t)l * NEXP * D, A->in[22] + (size_t)l * NEXP * D,
                                                                                      (unsigned char*)UB + (size_t)l * NEXP * D, (unsigned char*)VB + (size_t)l * NEXP * D);
        }
        SEAM(pb + 7);
        if (IN(pb + 8)) {
            PHASE_TID();
            for (int m = gw; m < M; m += NGW)
                expert_row8(l, m, H, IDS, GG, (const unsigned char*)UB, (const unsigned char*)VB, X1H, MODL + (size_t)(m >> 12) * MODW + MO_G2, (l == NL - 1) ? A->in[23] : nullptr, A->out, X2H, lane,
                            1.f, (LAS int*)(lds + wave * 1024),
                            (l == NL - 1) ? nullptr : A->in[4] + (l + 1) * D, mod + (size_t)((l + 1) * 2 + (m >> 12)) * MODW, H);
        }
        if (l + 1 < NL) SEAM(pb + 8);
    }
#undef IN
#undef SEAM
#undef mod
#undef H
#undef Z
#undef X1
#undef X2
}
}

extern "C" void kernel_launch(void* const* d_in, const int* in_sizes, int n_in, void* d_out, int out_size, void* d_ws, size_t ws_size, hipStream_t stream) {
    using namespace mk;
    static int grid = 0;
    if (grid == 0) {
        if (n_in != 24 || out_size != M * D || ws_size < WS_END) { fprintf(stderr, "kernel_launch: unexpected shapes (n_in %d out %d ws %zu)\n", n_in, out_size, ws_size); grid = -1; return; }
        int dev = 0, cus = 0, per_cu = 0;
        if (hipGetDevice(&dev) != hipSuccess || hipDeviceGetAttribute(&cus, hipDeviceAttributeMultiprocessorCount, dev) != hipSuccess) { grid = -1; return; }
        if (hipFuncSetAttribute((const void*)fwd, hipFuncAttributeMaxDynamicSharedMemorySize, LDS_BYTES) != hipSuccess) { fprintf(stderr, "kernel_launch: hipFuncSetAttribute failed\n"); grid = -1; return; }
        if (hipOccupancyMaxActiveBlocksPerMultiprocessor(&per_cu, (const void*)fwd, 512, LDS_BYTES) != hipSuccess || per_cu < 1) fprintf(stderr, "kernel_launch: occupancy query says %d\n", per_cu);
        (void)hipGetLastError();
        grid = cus;
    }
    if (grid < 0) return;
    (void)hipMemsetAsync((char*)d_ws + WS_CTL, 0, CTL_ZERO_BYTES, stream);
    Args a{};
    for (int i = 0; i < 24; ++i) a.in[i] = (const float*)d_in[i];
    a.out = (float*)d_out; a.ws = (unsigned char*)d_ws; a.pad = 0;
    constexpr int NLAUNCH = MK_N_LAUNCHES;
    for (int li = 0; li < NLAUNCH; ++li) {
        a.ph_lo = (NLAUNCH == 1) ? 0 : li; a.ph_hi = (NLAUNCH == 1) ? NPHASE : li + 1; a.li = li;
        hipLaunchKernelGGL(fwd, dim3(grid), dim3(512), LDS_BYTES, stream, a);
    }
}
```

```cpp
#include <hip/hip_runtime.h>
#include <cstdio>
#include <cstdint>
namespace pg8 {
#define PG8_LAS __attribute__((address_space(3)))
typedef unsigned short bf16_t;
typedef short bf16x8 __attribute__((ext_vector_type(8)));
typedef float f32x4 __attribute__((ext_vector_type(4)));
typedef unsigned u32x4 __attribute__((ext_vector_type(4)));
constexpr int BM = 256, BK = 64, HALF = 128, HTB = HALF * BK * 2  , STAGE_BYTES = 8 * HTB, NXCD = 8, WGM = 8;

__host__ __device__ __forceinline__ int lds_byte(int r, int c) { const int st = (r >> 4) * 2 + (c >> 5), rr = r & 15, cc = c & 31, ob = rr * 64 + cc * 2; return st * 1024 + (ob ^ (((ob >> 9) & 1) << 5)); }
__host__ __device__ __forceinline__ void stage_rc(int b, int& R, int& C) { const int st = b / 1024, sb = b % 1024, swz = sb ^ (((sb >> 9) & 1) << 5); R = (st >> 1) * 16 + swz / 64; C = (st & 1) * 32 + (swz % 64) / 2; }
__host__ __device__ __forceinline__ int perm32(int rho) { const int n = rho >> 4, i = rho & 15; return 8 * (i >> 2) + 4 * n + (i & 3); }

struct Unit { int pm, pn; };
struct Gemm { const bf16_t* A; const bf16_t* Bt; int M, N, K; };

struct StaticOrder {
    int nM, nN, nwg, G, c;
    __host__ __device__ void init(int M, int N, int G_, int c_) { nM = M / BM; nN = N / BM; nwg = nM * nN; G = G_; c = c_; }
    __host__ __device__ bool next(int i, Unit& u) const {
        const long L = (long)i * G + c; if (L >= nwg) return false;
        int wgid = (int)L; { const int q = nwg / NXCD, r = nwg % NXCD, xcd = wgid % NXCD, off = wgid / NXCD; wgid = (xcd < r ? xcd * (q + 1) : r * (q + 1) + (xcd - r) * q) + off; }
        const int nig = WGM * nN, gid = wgid / nig, fm = gid * WGM, gsz = (nM - fm) < WGM ? (nM - fm) : WGM;
        u.pm = fm + ((wgid % nig) % gsz); u.pn = (wgid % nig) / gsz; return true;
    }
    __device__ __forceinline__ void a_ready(const Unit&) const {}
    __device__ __forceinline__ void done(const Unit&) const {}
};
struct CountedOrder : StaticOrder {
    const unsigned* ready; unsigned need; unsigned* tmo;
    __device__ __forceinline__ void a_ready(const Unit& u) const {
        if (threadIdx.x < 64) {
            const unsigned long long t0 = __builtin_amdgcn_s_memrealtime(); unsigned polls = 0;
            while ((unsigned)__builtin_amdgcn_readfirstlane(__hip_atomic_load(ready + 64 * u.pm, __ATOMIC_RELAXED, __HIP_MEMORY_SCOPE_AGENT)) < need) {
                if ((++polls & 255u) == 0u && __builtin_amdgcn_readfirstlane(__hip_atomic_load(tmo, __ATOMIC_RELAXED, __HIP_MEMORY_SCOPE_AGENT)) != 0u) break;
                if (__builtin_amdgcn_s_memrealtime() - t0 > 2000000ull) {
                    if (threadIdx.x == 0) { unsigned expect = 0u; __hip_atomic_compare_exchange_strong(tmo + 1, &expect, 0x600u | (unsigned)(u.pm & 0xff), __ATOMIC_RELAXED, __ATOMIC_RELAXED, __HIP_MEMORY_SCOPE_AGENT); __hip_atomic_store(tmo, 1u, __ATOMIC_RELAXED, __HIP_MEMORY_SCOPE_AGENT); }
                    break; }
                __builtin_amdgcn_s_sleep(2); }
            __builtin_amdgcn_fence(__ATOMIC_ACQUIRE, "agent");
            asm volatile("s_waitcnt vmcnt(0)" ::: "memory");
        }
#if !defined(BROKEN_HOOK_NO_BARRIER)
        asm volatile("" ::: "memory"); __builtin_amdgcn_s_barrier(); asm volatile("" ::: "memory");
#endif
    }
};

__device__ __forceinline__ unsigned cvt_pk_bf16(float lo, float hi) { unsigned r; asm volatile("v_cvt_pk_bf16_f32 %0, %1, %2" : "=v"(r) : "v"(lo), "v"(hi)); return r; }
typedef float f32x2 __attribute__((ext_vector_type(2)));
__device__ __forceinline__ f32x2 gelu_pk(f32x2 v) {
    const f32x2 av = __builtin_elementwise_abs(v), d = av * 0.2316418882f + 1.0f;
    f32x2 t; t.x = __builtin_amdgcn_rcpf(d.x); t.y = __builtin_amdgcn_rcpf(d.y);
    f32x2 q = t * 0.5307027145f + (-0.7265760135f); q = q * t + 0.7107068705f; q = q * t + (-0.142248368f); q = q * t + 0.127414796f; q = q * t;
    const f32x2 s = (v * v) * (-0.72134752044f);
    f32x2 e; e.x = __builtin_amdgcn_exp2f(s.x); e.y = __builtin_amdgcn_exp2f(s.y);
    const f32x2 m = v * (q * e), r = v - m;
    f32x2 o; o.x = v.x < 0.f ? m.x : r.x; o.y = v.y < 0.f ? m.y : r.y; return o;
}

struct EpiF32 {
    static constexpr bool PERM = false, AFTER_DRAIN = false;
    float* C; int ldc; const float* bias;
    __device__ __forceinline__ void operator()(const f32x4 (&acc)[2][2][4][2], const Unit& u, int wr, int wc, int fr, int fq) const {
        const int row0 = u.pm * BM + wr * 64 + fr, col0 = u.pn * BM + wc * 32 + 4 * fq;
        f32x4 bv[2][2];
#pragma unroll
        for (int bj = 0; bj < 2; ++bj)
#pragma unroll
            for (int n = 0; n < 2; ++n) bv[bj][n] = bias ? *(const f32x4*)(bias + col0 + bj * HALF + n * 16) : (f32x4){0.f, 0.f, 0.f, 0.f};
#pragma unroll
        for (int ai = 0; ai < 2; ++ai)
#pragma unroll
            for (int m = 0; m < 4; ++m) { float* rowp = C + (size_t)(row0 + ai * HALF + m * 16) * ldc + col0;
#pragma unroll
                for (int bj = 0; bj < 2; ++bj)
#pragma unroll
                    for (int n = 0; n < 2; ++n) *(f32x4*)(rowp + bj * HALF + n * 16) = acc[ai][bj][m][n] + bv[bj][n]; }
    }
};
template <int ACT  > struct EpiBf16 {
    static constexpr bool PERM = true, AFTER_DRAIN = false;
    bf16_t* O; int ldc; const float* bias; int split_cols; size_t split_stride;
    __device__ __forceinline__ void operator()(const f32x4 (&acc)[2][2][4][2], const Unit& u, int wr, int wc, int fr, int fq) const {
        const int row0 = u.pm * BM + wr * 64 + fr; int colt = u.pn * BM; bf16_t* base = O;
        if (split_cols) { const int t = colt / split_cols; base += (size_t)t * split_stride; colt -= t * split_cols; }
        const int col0 = colt + wc * 32 + 8 * fq, bcol0 = u.pn * BM + wc * 32 + 8 * fq;
        f32x4 bv[2][2];
#pragma unroll
        for (int bj = 0; bj < 2; ++bj)
#pragma unroll
            for (int n = 0; n < 2; ++n) bv[bj][n] = bias ? *(const f32x4*)(bias + bcol0 + bj * HALF + 4 * n) : (f32x4){0.f, 0.f, 0.f, 0.f};
#pragma unroll
        for (int ai = 0; ai < 2; ++ai)
#pragma unroll
            for (int m = 0; m < 4; ++m) { bf16_t* rowp = base + (size_t)(row0 + ai * HALF + m * 16) * ldc + col0;
#pragma unroll
                for (int bj = 0; bj < 2; ++bj) { f32x4 v0 = acc[ai][bj][m][0] + bv[bj][0], v1 = acc[ai][bj][m][1] + bv[bj][1];
                    if (ACT == 1) { f32x2 a = gelu_pk((f32x2){v0[0], v0[1]}), b = gelu_pk((f32x2){v0[2], v0[3]}), c = gelu_pk((f32x2){v1[0], v1[1]}), d = gelu_pk((f32x2){v1[2], v1[3]});
                        v0 = (f32x4){a.x, a.y, b.x, b.y}; v1 = (f32x4){c.x, c.y, d.x, d.y}; }
                    if (ACT == 2) {
#pragma unroll
                        for (int j = 0; j < 4; ++j) { v0[j] = 0.5f * v0[j] * (1.0f + erff(v0[j] * 0.70710678f)); v1[j] = 0.5f * v1[j] * (1.0f + erff(v1[j] * 0.70710678f)); } }
                    u32x4 w; w.x = cvt_pk_bf16(v0[0], v0[1]); w.y = cvt_pk_bf16(v0[2], v0[3]); w.z = cvt_pk_bf16(v1[0], v1[1]); w.w = cvt_pk_bf16(v1[2], v1[3]);
                    *(u32x4*)(rowp + bj * HALF) = w; } }
    }
};
template <class Epi, class Sched, bool STAMP = false>
__device__ __forceinline__ void gemm_phase(PG8_LAS unsigned char* lds, const Gemm g, const Sched& S, const Epi& E, unsigned long long* stamps, int wave_id) {
    unsigned zz_o = 0u; asm volatile("" : "+v"(zz_o)); int tid_o = wave_id * 64 + (int)__builtin_amdgcn_mbcnt_hi(~0u, __builtin_amdgcn_mbcnt_lo(~0u, zz_o));
    const int tid = tid_o, wid = __builtin_amdgcn_readfirstlane(tid >> 6), lane = tid & 63, wr = wid >> 2, wc = wid & 3, fr = lane & 15, fq = lane >> 4;
    constexpr int K = 2048, nt = K / BK;
    int ts_lo = 0, ts_hi = 0, nts = 0; const unsigned long long rt_entry = STAMP ? (unsigned long long)wall_clock64() : 0ull;
#define PG8_STAMP() do { if (STAMP && wid == 0 && nts < 64) { const unsigned long long _c = (unsigned long long)clock64(); \
        ts_lo = (lane == nts) ? (int)(unsigned)_c : ts_lo; ts_hi = (lane == nts) ? (int)(unsigned)(_c >> 32) : ts_hi; ++nts; } } while (0)
    PG8_STAMP();
    unsigned voffA[2], voffB[2];
#pragma unroll
    for (int i = 0; i < 2; ++i) { int R, C; stage_rc(tid * 16 + i * 8192, R, C); const int Rb = Epi::PERM ? ((R & ~31) + perm32(R & 31)) : R;
        voffA[i] = (unsigned)(R * K + C) * 2u; voffB[i] = (unsigned)(Rb * K + C) * 2u; }
    const size_t kstep = (size_t)(BK * 2);
    const size_t hstep = (size_t)HALF * K * 2;
    const size_t tstep = 2 * hstep;
    const unsigned ldsw = (unsigned)wid * 1024u;
    const int aoff = lds_byte(wr * 64 + fr, fq * 8), boff = lds_byte(wc * 32 + fr, fq * 8);
#define PG8_SA(b, h) (((b) * 2 + (h)) * HTB)
#define PG8_SB(b, h) ((4 + (b) * 2 + (h)) * HTB)
#define PG8_STAGE(bufoff, gbase, voff) do { _Pragma("unroll") for (int _i = 0; _i < 2; ++_i) \
        __builtin_amdgcn_global_load_lds((const unsigned*)((const char*)(gbase) + (voff)[_i]), (PG8_LAS unsigned*)(lds + (bufoff) + ldsw + _i * 8192), 16, 0, 0); } while (0)
#define PG8_LDA(dst, b, h) do { _Pragma("unroll") for (int m = 0; m < 4; ++m) _Pragma("unroll") for (int k = 0; k < 2; ++k) dst[m][k] = *(const PG8_LAS bf16x8*)(lds + PG8_SA(b, h) + aoff + m * 2048 + k * 1024); } while (0)
#define PG8_LDB(dst, b, h) do { _Pragma("unroll") for (int n = 0; n < 2; ++n) _Pragma("unroll") for (int k = 0; k < 2; ++k) dst[n][k] = *(const PG8_LAS bf16x8*)(lds + PG8_SB(b, h) + boff + n * 2048 + k * 1024); } while (0)
#define PG8_MMA(ai, bj, At, Bt) do { __builtin_amdgcn_s_setprio(1); _Pragma("unroll") for (int m = 0; m < 4; ++m) _Pragma("unroll") for (int n = 0; n < 2; ++n) _Pragma("unroll") for (int k = 0; k < 2; ++k) \
        acc[ai][bj][m][n] = __builtin_amdgcn_mfma_f32_16x16x32_bf16(Bt[n][k], At[m][k], acc[ai][bj][m][n], 0, 0, 0); __builtin_amdgcn_s_setprio(0); } while (0)
#define PG8_WAIT_V(n) asm volatile("s_waitcnt vmcnt(" #n ")" ::: "memory")
#define PG8_WAIT_L(n) asm volatile("s_waitcnt lgkmcnt(" #n ")" ::: "memory")
#define PG8_BAR __builtin_amdgcn_s_barrier()
#define PG8_SCHED __builtin_amdgcn_sched_barrier(0)
    Unit cur, nxt; int ui = 0;
    if (!S.next(0, cur)) return;
    f32x4 acc[2][2][4][2];
#pragma unroll
    for (int a = 0; a < 2; ++a)
#pragma unroll
        for (int b = 0; b < 2; ++b)
#pragma unroll
            for (int m = 0; m < 4; ++m)
#pragma unroll
                for (int n = 0; n < 2; ++n) acc[a][b][m][n] = (f32x4){0.f, 0.f, 0.f, 0.f};
    bf16x8 At[4][2], B0[2][2], B1[2][2];
    const char* cA = (const char*)g.A + (size_t)cur.pm * tstep; const char* cB = (const char*)g.Bt + (size_t)cur.pn * tstep;
    S.a_ready(cur);
    PG8_STAGE(PG8_SB(0, 0), cB, voffB); PG8_STAGE(PG8_SA(0, 0), cA, voffA); PG8_STAGE(PG8_SB(0, 1), cB + hstep, voffB); PG8_STAGE(PG8_SA(0, 1), cA + hstep, voffA);
    if (wr == 1) PG8_BAR;
    PG8_WAIT_V(4); PG8_BAR;
    PG8_STAGE(PG8_SB(1, 0), cB + kstep, voffB); PG8_STAGE(PG8_SA(1, 0), cA + kstep, voffA); PG8_STAGE(PG8_SB(1, 1), cB + hstep + kstep, voffB);
    PG8_WAIT_V(6); PG8_BAR;
    PG8_STAMP();
    for (;;) {
        const bool has_next = S.next(ui + 1, nxt);
        const char* nA = has_next ? (const char*)g.A + (size_t)nxt.pm * tstep : cA; const char* nB = has_next ? (const char*)g.Bt + (size_t)nxt.pn * tstep : cB;
        for (int t = 0; t < nt; t += 2) {
            const bool last = (t == nt - 2);
            const char* a1 = cA + (size_t)(t + 1) * kstep;
            const char* a2 = last ? nA : cA + (size_t)(t + 2) * kstep; const char* b2 = last ? nB : cB + (size_t)(t + 2) * kstep;
            const char* a3 = a2 + kstep; const char* b3 = b2 + kstep;
            if (last && has_next) S.a_ready(nxt);
            PG8_LDB(B0, 0, 0); PG8_SCHED; PG8_LDA(At, 0, 0); PG8_STAGE(PG8_SA(1, 1), a1 + hstep, voffA);
            PG8_WAIT_L(8); PG8_BAR; PG8_WAIT_L(0); PG8_MMA(0, 0, At, B0); PG8_BAR; PG8_SCHED;
            PG8_LDB(B1, 0, 1); PG8_STAGE(PG8_SB(0, 0), b2, voffB);
            PG8_BAR; PG8_WAIT_L(0); PG8_MMA(0, 1, At, B1); PG8_BAR;
            PG8_LDA(At, 0, 1); PG8_STAGE(PG8_SA(0, 0), a2, voffA);
            PG8_BAR; PG8_WAIT_L(0); PG8_MMA(1, 0, At, B0); PG8_BAR; PG8_SCHED;
            PG8_STAGE(PG8_SB(0, 1), b2 + hstep, voffB);
            PG8_WAIT_V(6); PG8_BAR; PG8_MMA(1, 1, At, B1); PG8_BAR;
            PG8_LDB(B0, 1, 0); PG8_SCHED; PG8_LDA(At, 1, 0); PG8_STAGE(PG8_SA(0, 1), a2 + hstep, voffA);
            PG8_WAIT_L(8); PG8_BAR; PG8_WAIT_L(0); PG8_MMA(0, 0, At, B0); PG8_BAR; PG8_SCHED;
            PG8_LDB(B1, 1, 1); PG8_STAGE(PG8_SB(1, 0), b3, voffB);
            PG8_BAR; PG8_WAIT_L(0); PG8_MMA(0, 1, At, B1); PG8_BAR;
            PG8_LDA(At, 1, 1); PG8_STAGE(PG8_SA(1, 0), a3, voffA);
            PG8_BAR; PG8_WAIT_L(0); PG8_MMA(1, 0, At, B0); PG8_BAR; PG8_SCHED;
            PG8_STAGE(PG8_SB(1, 1), b3 + hstep, voffB);
            PG8_WAIT_V(6); PG8_BAR; PG8_MMA(1, 1, At, B1); PG8_BAR;
        }
        PG8_STAMP();
        if constexpr (!Epi::AFTER_DRAIN) { E(acc, cur, wr, wc, fr, fq); S.done(cur); }
        PG8_STAMP();
        if (!has_next) break;
#pragma unroll
        for (int a = 0; a < 2; ++a)
#pragma unroll
            for (int b = 0; b < 2; ++b)
#pragma unroll
                for (int m = 0; m < 4; ++m)
#pragma unroll
                    for (int n = 0; n < 2; ++n) acc[a][b][m][n] = (f32x4){0.f, 0.f, 0.f, 0.f};
        cur = nxt; cA = nA; cB = nB; ++ui;
    }
    PG8_WAIT_V(0);
    if (wr == 0) PG8_BAR;
    PG8_BAR;
    if constexpr (Epi::AFTER_DRAIN) { E.fused(acc, cur, wr, wc, fr, fq, lds, wid, lane); S.done(cur); }
    PG8_STAMP();
    if (STAMP && wid == 0) { stamps[lane] = lane < nts ? (((unsigned long long)(unsigned)ts_hi << 32) | (unsigned)ts_lo) : 0ull;
        if (lane == 62) stamps[62] = rt_entry; if (lane == 63) stamps[63] = (unsigned long long)wall_clock64(); }
#undef PG8_STAMP
#undef PG8_SA
#undef PG8_SB
#undef PG8_STAGE
#undef PG8_LDA
#undef PG8_LDB
#undef PG8_MMA
#undef PG8_WAIT_V
#undef PG8_WAIT_L
#undef PG8_BAR
#undef PG8_SCHED
}
}

namespace mk {
#define GAS __attribute__((address_space(1)))
#define LAS __attribute__((address_space(3)))
#define DEV __device__ __forceinline__
typedef unsigned short bf16;
typedef unsigned v4u __attribute__((ext_vector_type(4)));
typedef float f32x4 __attribute__((ext_vector_type(4)));
typedef float f32x2 __attribute__((ext_vector_type(2)));
typedef short bf16x8 __attribute__((ext_vector_type(8)));
typedef float f32x16 __attribute__((ext_vector_type(16)));
typedef __bf16 bf16x2_t __attribute__((ext_vector_type(2)));

#ifndef MK_N_LAUNCHES
#define MK_N_LAUNCHES 1
#endif

constexpr int D = 2048, SEQ = 4096, M = 8192, NL = 2;
constexpr int LRU_W = 768, SWA_W = 768, SB_W = 512, IN_W = 5376;
constexpr int ZO_XA = 0, ZO_GA = 768, ZO_QB = 1536, ZO_KB = 2304, ZO_VB = 3072, ZO_QC = 3840, ZO_KC = 4352, ZO_VC = 4864;
constexpr int NEXP = 16384, MODW = 12288;
constexpr int MO_SH1 = 0, MO_SC1 = 2048, MO_G1 = 4096, MO_SH2 = 6144, MO_SC2 = 8192, MO_G2 = 10240;
constexpr float EPS = 1e-6f;
constexpr float QSCALE = 0.08838834764831845f;
constexpr float NEGBIG = -3.0e38f;
constexpr int PH_L = 12;
constexpr int NPHASE = 1 + 2 * PH_L;

constexpr size_t MiB = 1u << 20;
constexpr size_t WS_CTL = 0, CTL_ZERO_BYTES = 1 * MiB;
constexpr size_t WS_MOD = 512 * 1024;
constexpr size_t WS_WIN_T = 2 * MiB, WS_WOUT_T = 44 * MiB, WS_WQ_T = 60 * MiB, WS_SUBK = 76 * MiB, WS_U = 80 * MiB, WS_V = 208 * MiB,
                 WS_H = 336 * MiB, WS_Z = 368 * MiB, WS_HLOC = 452 * MiB, WS_P = 476 * MiB, WS_YB = 500 * MiB, WS_YC = 524 * MiB,
                 WS_SUMA = 540 * MiB, WS_SUMB = 541 * MiB, WS_X1 = 544 * MiB, WS_X2 = 608 * MiB, WS_Q = 672 * MiB, WS_IDS = 704 * MiB,
                 WS_G = 708 * MiB, WS_WG_T = 77 * MiB, WS_PART = 712 * MiB, WS_LSE = 784 * MiB, WS_XR = 786 * MiB, WS_PDOT = 820 * MiB, WS_WEXP = 888 * MiB, WS_END = 892 * MiB;
constexpr int CW_BAR = 4096;

constexpr int LDS_BYTES = 147456;
constexpr int LDS_MISC = 143360;

__device__ const unsigned char T5B[3][132] = {
 {0,1,2,3,4,5,6,7,8,9,10,11,12,13,14,15,16,16,16,16,16,16,17,17,17,17,17,17,17,17,18,18,18,18,18,18,18,18,18,18,19,19,19,19,19,19,19,19,19,19,19,19,19,19,20,20,20,20,20,20,20,20,20,20,20,20,20,20,20,20,20,20,20,21,21,21,21,21,21,21,21,21,21,21,21,21,21,21,21,21,21,21,21,21,21,21,21,21,21,22,22,22,22,22,22,22,22,22,22,22,22,22,22,22,22,22,22,22,22,22,22,22,22,22,22,22,22,22,22,0,0,0},
 {0,4,8,12,16,16,17,17,18,18,19,19,19,19,20,20,20,20,20,21,21,21,21,21,21,22,22,22,22,22,22,22,22,22,23,23,23,23,23,23,23,23,23,23,23,23,24,24,24,24,24,24,24,24,24,24,24,24,24,24,24,24,25,25,25,25,25,25,25,25,25,25,25,25,25,25,25,25,25,25,25,25,25,26,26,26,26,26,26,26,26,26,26,26,26,26,26,26,26,26,26,26,26,26,26,26,26,26,26,26,26,26,26,27,27,27,27,27,27,27,27,27,27,27,27,27,27,27,27,0,0,0},
 {0,16,18,19,20,21,21,22,22,23,23,23,24,24,24,24,25,25,25,25,25,26,26,26,26,26,26,26,26,27,27,27,27,27,27,27,27,27,27,28,28,28,28,28,28,28,28,28,28,28,28,28,29,29,29,29,29,29,29,29,29,29,29,29,29,29,29,29,29,29,30,30,30,30,30,30,30,30,30,30,30,30,30,30,30,30,30,30,30,30,30,30,30,30,30,31,31,31,31,31,31,31,31,31,31,31,31,31,31,31,31,31,31,31,31,31,31,31,31,31,31,31,31,31,31,31,31,31,31,0,0,0}};

#define LDS_WAIT() asm volatile("s_waitcnt lgkmcnt(0)" ::: "memory")
DEV unsigned f2bf(float f) { unsigned u = __builtin_bit_cast(unsigned, f); return (u + 0x7fffu + ((u >> 16) & 1u)) >> 16; }
DEV unsigned pk2(float lo, float hi) { return f2bf(lo) | (f2bf(hi) << 16); }
DEV float bf_lo(unsigned w) { return __builtin_bit_cast(float, w << 16); }
DEV float bf_hi(unsigned w) { return __builtin_bit_cast(float, w & 0xffff0000u); }
DEV float bf1(bf16 h) { return __builtin_bit_cast(float, ((unsigned)h) << 16); }
template <int MSK> DEV float swz_xor(float v) { return __builtin_bit_cast(float, __builtin_amdgcn_ds_swizzle(__builtin_bit_cast(int, v), (MSK << 10) | 0x1F)); }
DEV float part32_(float v) { int ln = (int)__builtin_amdgcn_mbcnt_hi(~0u, __builtin_amdgcn_mbcnt_lo(~0u, 0u)); asm volatile("" : "+v"(ln)); return __builtin_bit_cast(float, __builtin_amdgcn_ds_bpermute((ln ^ 32) << 2, __builtin_bit_cast(int, v))); }
DEV float sum32(float v) { return v + part32_(v); }
DEV float max32(float v) { return fmaxf(v, part32_(v)); }
DEV float partner32(float v, int hh) { (void)hh; return part32_(v); }
DEV float wave_sum(float v) { v += swz_xor<1>(v); v += swz_xor<2>(v); v += swz_xor<4>(v); v += swz_xor<8>(v); v += swz_xor<16>(v); return sum32(v); }
DEV float wave_max(float v) { v = fmaxf(v, swz_xor<1>(v)); v = fmaxf(v, swz_xor<2>(v)); v = fmaxf(v, swz_xor<4>(v)); v = fmaxf(v, swz_xor<8>(v)); v = fmaxf(v, swz_xor<16>(v)); return max32(v); }
DEV float sigmoid_f(float x) { return 1.f / (1.f + __expf(-x)); }
DEV float softplus_f(float x) { return fmaxf(x, 0.f) + log1pf(__expf(-fabsf(x))); }
DEV float gelu_tanh(float x) { const float u = 0.7978845608028654f * (x + 0.044715f * x * x * x); const float t = 1.f - 2.f / (1.f + __expf(2.f * u)); return 0.5f * x * (1.f + t); }
DEV float dot8(const v4u a, const v4u b) {
    float s = bf_lo(a.x) * bf_lo(b.x); s += bf_hi(a.x) * bf_hi(b.x);
    s += bf_lo(a.y) * bf_lo(b.y); s += bf_hi(a.y) * bf_hi(b.y);
    s += bf_lo(a.z) * bf_lo(b.z); s += bf_hi(a.z) * bf_hi(b.z);
    s += bf_lo(a.w) * bf_lo(b.w); s += bf_hi(a.w) * bf_hi(b.w);
    return s;
}

#define XB_TMO      128
#define XB_XCNT(j)  (256  + 64 * (j))
#define XB_XSUB(j)  (1280 + 64 * (j))
#define XB_XGEN(j)  (2304 + 64 * (j))
#define XB_TOP      3328
#define XB_TOPGEN   3392
#define XCD_BAR_WORDS 3456
#define XB_SPIN_CAP (1u << 18)

__device__ __forceinline__ unsigned xb_ld(unsigned* p)              { return __hip_atomic_load(p, __ATOMIC_RELAXED, __HIP_MEMORY_SCOPE_AGENT); }
__device__ __forceinline__ unsigned xb_add(unsigned* p, unsigned v) { return __hip_atomic_fetch_add(p, v, __ATOMIC_RELAXED, __HIP_MEMORY_SCOPE_AGENT); }
__device__ __forceinline__ unsigned xb_xcc_id() { return (unsigned)__builtin_amdgcn_s_getreg((3 << 11) | 20) & 0xFu; }
#define XB_SPIN(cond, bar) do { unsigned _sp = 0; while (cond) { __builtin_amdgcn_s_sleep(1); \
    if ((++_sp & 255u) == 0u) { if (xb_ld(&(bar)[XB_TMO])) break; if (_sp > XB_SPIN_CAP) { atomicAdd(&(bar)[XB_TMO], 1u); break; } } } } while (0)

struct XcdBarrier {
    unsigned* bar; unsigned x;
    volatile LAS unsigned* st;
    int w0;
};
DEV bool xb_lead(int w0) { return w0 == 0 && __builtin_amdgcn_mbcnt_hi(~0u, __builtin_amdgcn_mbcnt_lo(~0u, 0u)) == 0u; }
__device__ __forceinline__ XcdBarrier xcd_barrier_post(unsigned* bar, volatile LAS unsigned* st, int w0) {
    XcdBarrier b; b.bar = bar; b.x = xb_xcc_id(); b.st = st; b.w0 = w0;
    if (xb_lead(w0)) (void)xb_add(&bar[XB_XCNT(b.x)], 1u);
    return b;
}
__device__ __forceinline__ void xcd_barrier_complete(unsigned* bar, unsigned x, unsigned& nloc, unsigned& nx) {
    const unsigned G = gridDim.x * gridDim.y * gridDim.z;
    unsigned sum, cnt, mine, sp = 0u;
    for (;;) {
        sum = 0u; cnt = 0u; mine = 0u;
#pragma unroll
        for (unsigned j = 0; j < 16; ++j) { const unsigned c = xb_ld(&bar[XB_XCNT(j)]); sum += c; cnt += (c > 0u) ? 1u : 0u; mine = (j == x) ? c : mine; }
        if (sum == G) break;
        __builtin_amdgcn_s_sleep(1);
        if ((++sp & 255u) == 0u) { if (xb_ld(&bar[XB_TMO])) break; if (sp > XB_SPIN_CAP) { atomicAdd(&bar[XB_TMO], 1u); break; } }
    }
    nloc = mine > 0u ? mine : 1u; nx = cnt > 0u ? cnt : 1u;
}
__device__ __forceinline__ void xcd_barrier(const XcdBarrier& b) {
    asm volatile("s_waitcnt vmcnt(0)" ::: "memory");
    __syncthreads();
    if (xb_lead(b.w0)) {
        unsigned* bar = b.bar;
        __builtin_amdgcn_s_waitcnt(0);
        unsigned nloc = b.st[0], nx = b.st[1];
        if (nloc == 0u) { xcd_barrier_complete(bar, b.x, nloc, nx); b.st[0] = nloc; b.st[1] = nx; }
        const unsigned old = xb_add(&bar[XB_XSUB(b.x)], 1u);
        const unsigned gen = old / nloc;
        if (old + 1u == (gen + 1u) * nloc) {
            __builtin_amdgcn_fence(__ATOMIC_RELEASE, "agent");
            asm volatile("s_waitcnt vmcnt(0)" ::: "memory");
            const unsigned og = xb_add(&bar[XB_TOP], 1u);
            const unsigned tg = og / nx;
            if (og + 1u == (tg + 1u) * nx) xb_add(&bar[XB_TOPGEN], 1u);
            else XB_SPIN(xb_ld(&bar[XB_TOPGEN]) == tg, bar);
            __builtin_amdgcn_fence(__ATOMIC_ACQUIRE, "agent");
            xb_add(&bar[XB_XGEN(b.x)], 1u);
            asm volatile("s_waitcnt vmcnt(0)" ::: "memory");
        } else {
            XB_SPIN(xb_ld(&bar[XB_XGEN(b.x)]) == gen, bar);
            __builtin_amdgcn_fence(__ATOMIC_ACQUIRE, "agent");
            asm volatile("s_waitcnt vmcnt(0)" ::: "memory");
        }
    }
    __syncthreads();
}

struct EpiResGate {
    static constexpr bool PERM = false, AFTER_DRAIN = false;
    const bf16* X; bf16* O; const float* gate; float gscale;
    __device__ __forceinline__ void operator()(const pg8::f32x4 (&acc)[2][2][4][2], const pg8::Unit& u, int wr, int wc, int fr, int fq) const {
        const int row0 = u.pm * 256 + wr * 64 + fr, col0 = u.pn * 256 + wc * 32 + 4 * fq;
        const float* gp = gate + (size_t)((u.pm * 256) >> 12) * MODW;
        pg8::f32x4 gv[2][2];
#pragma unroll
        for (int bj = 0; bj < 2; ++bj)
#pragma unroll
            for (int n = 0; n < 2; ++n) gv[bj][n] = *(const pg8::f32x4*)(gp + col0 + bj * 128 + n * 16) * gscale;
#pragma unroll
        for (int ai = 0; ai < 2; ++ai)
#pragma unroll
            for (int m = 0; m < 4; ++m) {
                const size_t ro = (size_t)(row0 + ai * 128 + m * 16) * D + col0;
#pragma unroll
                for (int bj = 0; bj < 2; ++bj)
#pragma unroll
                    for (int n = 0; n < 2; ++n) {
                        const unsigned long long xw = *(const unsigned long long*)(X + ro + bj * 128 + n * 16);
                        const pg8::f32x4 xv = {bf_lo((unsigned)xw), bf_hi((unsigned)xw), bf_lo((unsigned)(xw >> 32)), bf_hi((unsigned)(xw >> 32))};
                        const pg8::f32x4 ov = xv + gv[bj][n] * acc[ai][bj][m][n];
                        *(unsigned long long*)(O + ro + bj * 128 + n * 16) = (unsigned long long)pk2(ov.x, ov.y) | ((unsigned long long)pk2(ov.z, ov.w) << 32);
                    }
            }
    }
};

DEV void ph_mod(const float* __restrict__ c, const float* __restrict__ w_mod, const float* __restrict__ b_mod, float* __restrict__ mod, LAS float* lds_f, int vcu, int G, int tid) {
    const int lane = tid & 63, wave = tid >> 6;
    LAS float* cs = lds_f;
    LAS float* red = lds_f + 4096;
    for (int i = tid; i < 2 * D; i += 512) { const float v = c[i]; cs[i] = v * sigmoid_f(v); }
    __syncthreads();
    const int cg = lane & 15, rg = lane >> 4;
    for (int it = vcu; it < 2 * 192 * 2; it += G) {
        const int kh = it & 1, cb = (it >> 1) % 192, l = it / 384;
        const int k0 = kh * 1024 + wave * 128;
        const float* W = w_mod + ((size_t)l * D + k0 + rg) * MODW + cb * 64 + cg * 4;
        f32x4 a0 = {0.f, 0.f, 0.f, 0.f}, a1 = {0.f, 0.f, 0.f, 0.f};
#pragma unroll 16
        for (int i = 0; i < 32; ++i) {
            const f32x4 w = *(const f32x4*)(W + (size_t)(4 * i) * MODW);
            const float c0 = cs[k0 + 4 * i + rg], c1 = cs[D + k0 + 4 * i + rg];
            a0 += w * c0; a1 += w * c1;
        }
#pragma unroll
        for (int e = 0; e < 4; ++e) { a0[e] += swz_xor<16>(a0[e]); a0[e] = sum32(a0[e]); a1[e] += swz_xor<16>(a1[e]); a1[e] = sum32(a1[e]); }
        if (lane < 16) { *(LAS f32x4*)(red + (wave * 2 + 0) * 64 + cg * 4) = a0; *(LAS f32x4*)(red + (wave * 2 + 1) * 64 + cg * 4) = a1; }
        __syncthreads();
        if (tid < 128) {
            const int bq = tid >> 6, ln = tid & 63; float sacc = 0.f;
#pragma unroll
            for (int w = 0; w < 8; ++w) sacc += red[(w * 2 + bq) * 64 + ln];
            const int col = cb * 64 + ln;
            if (kh == 0) sacc += b_mod[l * MODW + col];
            atomicAdd(mod + (size_t)(l * 2 + bq) * MODW + col, sacc);
        }
        __syncthreads();
    }
}
DEV void transpose_item(const float* __restrict__ W, int K, int N, bf16* __restrict__ WT, LAS float* scr, int item, int lane) {
    const int nblk = N / 32, kb = item / nblk, nb = item % nblk, k0 = 64 * kb, n0 = 32 * nb;
#pragma unroll 8
    for (int i = 0; i < 32; ++i) { const int kk = 2 * i + (lane >> 5); scr[kk * 33 + (lane & 31)] = W[(size_t)(k0 + kk) * N + n0 + (lane & 31)]; }
    LDS_WAIT();
    const int c = lane & 7;
#pragma unroll
    for (int j = 0; j < 4; ++j) { const int n = (lane >> 3) + 8 * j; const LAS float* s = scr + (8 * c) * 33 + n;
        v4u o; o.x = pk2(s[0 * 33], s[1 * 33]); o.y = pk2(s[2 * 33], s[3 * 33]); o.z = pk2(s[4 * 33], s[5 * 33]); o.w = pk2(s[6 * 33], s[7 * 33]);
        *(v4u*)(WT + (size_t)(n0 + n) * K + k0 + 8 * c) = o; }
    LDS_WAIT();
}

DEV void transpose_item64(const float* __restrict__ W, int K, int N, bf16* __restrict__ WT, LAS float* scr, int item, int lane) {
    const int nblk = N / 64, kb = item / nblk, nb = item % nblk, k0 = 64 * kb, n0 = 64 * nb;
#pragma unroll 8
    for (int i = 0; i < 16; ++i) { const int kk = 4 * i + (lane >> 4), nn = 4 * (lane & 15);
        const f32x4 w = *(const f32x4*)(W + (size_t)(k0 + kk) * N + n0 + nn);
        LAS float* d = scr + kk * 65 + nn; d[0] = w.x; d[1] = w.y; d[2] = w.z; d[3] = w.w; }
    LDS_WAIT();
#pragma unroll
    for (int jj = 0; jj < 8; ++jj) { const int pz = lane + 64 * jj, n = pz >> 3, c = pz & 7; const LAS float* sp = scr + (8 * c) * 65 + n;
        v4u o; o.x = pk2(sp[0 * 65], sp[1 * 65]); o.y = pk2(sp[2 * 65], sp[3 * 65]); o.z = pk2(sp[4 * 65], sp[5 * 65]); o.w = pk2(sp[6 * 65], sp[7 * 65]);
        *(v4u*)(WT + (size_t)(n0 + n) * K + k0 + 8 * c) = o; }
    LDS_WAIT();
}
DEV void convert_copy(const float* __restrict__ src, bf16* __restrict__ dst, size_t ngroups8, size_t gtid, size_t gstride) {
    for (size_t g = gtid; g < ngroups8; g += gstride) {
        const f32x4 a = *(const f32x4*)(src + g * 8), b = *(const f32x4*)(src + g * 8 + 4);
        v4u o; o.x = pk2(a.x, a.y); o.y = pk2(a.z, a.w); o.z = pk2(b.x, b.y); o.w = pk2(b.z, b.w);
        *(v4u*)(dst + g * 8) = o;
    }
}

DEV void modnorm_rows(const float* __restrict__ X, const float* __restrict__ gain, const float* __restrict__ modl, int sh_off, int sc_off, bf16* __restrict__ H, int gw, int NGW, int lane, bf16* __restrict__ XC = nullptr) {
    for (int m = gw; m < M; m += NGW) {
        const int b = m >> 12;
        const f32x4* xr = (const f32x4*)(X + (size_t)m * D) + lane;
        f32x4 v[8]; float s = 0.f;
#pragma unroll
        for (int j = 0; j < 8; ++j) { v[j] = xr[64 * j]; s += (v[j].x * v[j].x + v[j].y * v[j].y) + (v[j].z * v[j].z + v[j].w * v[j].w); }
        const float r = rsqrtf(wave_sum(s) * (1.f / D) + EPS);
        const f32x4* g4 = (const f32x4*)gain + lane;
        const f32x4* sc4 = (const f32x4*)(modl + (size_t)b * MODW + sc_off) + lane;
        const f32x4* sh4 = (const f32x4*)(modl + (size_t)b * MODW + sh_off) + lane;
        unsigned long long* o8 = (unsigned long long*)(H + (size_t)m * D) + lane;
#pragma unroll
        for (int j = 0; j < 8; ++j) {
            const f32x4 g = g4[64 * j], sc = sc4[64 * j], sh = sh4[64 * j];
            const f32x4 y = (v[j] * r) * g * (sc + 1.f) + sh;
            o8[64 * j] = (unsigned long long)pk2(y.x, y.y) | ((unsigned long long)pk2(y.z, y.w) << 32);
            if (XC) ((unsigned long long*)(XC + (size_t)m * D) + lane)[64 * j] = (unsigned long long)pk2(v[j].x, v[j].y) | ((unsigned long long)pk2(v[j].z, v[j].w) << 32);
        }
    }
}
DEV void modnorm_rows_h(const bf16* __restrict__ X, const float* __restrict__ gain, const float* __restrict__ modl, int sh_off, int sc_off, bf16* __restrict__ H, int gw, int NGW, int lane) {
    for (int m = gw; m < M; m += NGW) {
        const int b = m >> 12;
        const v4u* xr = (const v4u*)(X + (size_t)m * D) + lane;
        float v[32]; float s = 0.f;
#pragma unroll
        for (int j = 0; j < 4; ++j) { const v4u w = xr[64 * j];
            v[8 * j + 0] = bf_lo(w.x); v[8 * j + 1] = bf_hi(w.x); v[8 * j + 2] = bf_lo(w.y); v[8 * j + 3] = bf_hi(w.y); v[8 * j + 4] = bf_lo(w.z); v[8 * j + 5] = bf_hi(w.z); v[8 * j + 6] = bf_lo(w.w); v[8 * j + 7] = bf_hi(w.w);
#pragma unroll
            for (int e = 0; e < 8; ++e) s += v[8 * j + e] * v[8 * j + e]; }
        const float r = rsqrtf(wave_sum(s) * (1.f / D) + EPS);
        const float* scp = modl + (size_t)b * MODW + sc_off; const float* shp = modl + (size_t)b * MODW + sh_off;
        v4u* o16 = (v4u*)(H + (size_t)m * D) + lane;
#pragma unroll
        for (int j = 0; j < 4; ++j) { const int col = 8 * (lane + 64 * j);
            const f32x4 g0 = *(const f32x4*)(gain + col), g1 = *(const f32x4*)(gain + col + 4), c0 = *(const f32x4*)(scp + col), c1 = *(const f32x4*)(scp + col + 4), h0 = *(const f32x4*)(shp + col), h1 = *(const f32x4*)(shp + col + 4);
            v4u o;
            o.x = pk2(v[8 * j + 0] * r * g0.x * (c0.x + 1.f) + h0.x, v[8 * j + 1] * r * g0.y * (c0.y + 1.f) + h0.y); o.y = pk2(v[8 * j + 2] * r * g0.z * (c0.z + 1.f) + h0.z, v[8 * j + 3] * r * g0.w * (c0.w + 1.f) + h0.w);
            o.z = pk2(v[8 * j + 4] * r * g1.x * (c1.x + 1.f) + h1.x, v[8 * j + 5] * r * g1.y * (c1.y + 1.f) + h1.y); o.w = pk2(v[8 * j + 6] * r * g1.z * (c1.z + 1.f) + h1.z, v[8 * j + 7] * r * g1.w * (c1.w + 1.f) + h1.w);
            o16[64 * j] = o; }
    }
}


DEV unsigned cvtpk_bf16(float lo, float hi) { f32x2 v = {lo, hi}; bf16x2_t b = __builtin_convertvector(v, bf16x2_t); return __builtin_bit_cast(unsigned, b); }
constexpr int DIL_VSTR = 256;
constexpr int ATT_KOFF = 32 * DIL_VSTR;
constexpr int ATT_BOFF = ATT_KOFF + 8192;
constexpr int DIL_QOFF = ATT_BOFF + 132 * 4;
constexpr int ATT_WLDS = 17920;
static_assert(DIL_QOFF <= ATT_WLDS && 8 * ATT_WLDS <= LDS_MISC, "attention LDS");

DEV unsigned vimg_off(unsigned row, unsigned ch) { return 256u * row + 16u * (ch ^ (((row & 3u) << 2) | ((row >> 2) & 3u))); }
typedef short s16x4 __attribute__((ext_vector_type(4)));
DEV bf16x8 vfrag_tr(LAS unsigned char* img, int lane, int c, int ks) {
    const unsigned h = lane >> 5, blk = (lane >> 4) & 1, qq = (lane & 15) >> 2, pp = lane & 3;
    const s16x4 a = __builtin_amdgcn_ds_read_tr16_b64_v4i16((LAS s16x4*)(img + vimg_off(16 * ks + 8 * h + 0 + qq, 4 * c + 2 * blk + (pp >> 1)) + 8 * (pp & 1)));
    const s16x4 b = __builtin_amdgcn_ds_read_tr16_b64_v4i16((LAS s16x4*)(img + vimg_off(16 * ks + 8 * h + 4 + qq, 4 * c + 2 * blk + (pp >> 1)) + 8 * (pp & 1)));
    return __builtin_shufflevector(a, b, 0, 1, 2, 3, 4, 5, 6, 7);
}
DEV void dil_mfma_item(int b, int h, int p, int rr, int i0, const bf16* __restrict__ Z, const float* __restrict__ rel_bias, bf16* __restrict__ PART, float* __restrict__ LSE, LAS unsigned char* wl, int lane) {
    asm volatile("" : "+v"(lane));
    const int r = lane & 31, hh = lane >> 5;
    const int d = 1 << (2 * p);
    LAS float* biasL = (LAS float*)(wl + ATT_BOFF);
    for (int dd = lane; dd < 129; dd += 64) biasL[dd] = rel_bias[(int)T5B[p][dd] * 6 + h];
    const size_t rowq = (size_t)b * SEQ + rr + d * (i0 + r);
    bf16x8 qf[8];
    { const bf16* qrow = Z + rowq * IN_W + ZO_QB + h * 128 + 8 * hh;
#pragma unroll
      for (int ks = 0; ks < 8; ++ks) qf[ks] = *(const bf16x8*)(qrow + 16 * ks); }
    float m_run = NEGBIG, l_run = 0.f;
    f32x16 o[4];
#pragma unroll
    for (int dt = 0; dt < 4; ++dt)
#pragma unroll
        for (int e = 0; e < 16; ++e) o[dt][e] = 0.f;
    const int kap = (r & 0x13) | ((r & 4) << 1) | ((r & 8) >> 1);
    int jt = 4 - (i0 >> 5); jt = jt < 0 ? 0 : jt;
#define DIL_DMA_K(JT) do { int jk = i0 - 128 + 32 * (JT) + kap; jk = jk < 0 ? 0 : jk; const bf16* krow = Z + ((size_t)b * SEQ + rr + d * jk) * IN_W + ZO_KB + h * 128 + 8 * hh; \
        _Pragma("unroll") for (int ks = 0; ks < 8; ++ks) __builtin_amdgcn_global_load_lds((const unsigned*)(krow + 16 * ks), (LAS unsigned*)(wl + ATT_KOFF + 1024 * ks), 16, 0, 0); } while (0)
#define DIL_DMA_V(JT) do { const int j0_ = i0 - 128 + 32 * (JT); _Pragma("unroll") for (int q = 0; q < 8; ++q) { const int pi = lane + 64 * q, kl = pi >> 4, c = (pi & 15) ^ (((kl & 3) << 2) | ((kl >> 2) & 3)); int j = j0_ + kl; j = j < 0 ? 0 : j; \
        __builtin_amdgcn_global_load_lds((const unsigned*)(Z + ((size_t)b * SEQ + rr + d * j) * IN_W + ZO_VB + h * 128 + 8 * c), (LAS unsigned*)(wl + 1024 * q), 16, 0, 0); } } while (0)
    LDS_WAIT();
    DIL_DMA_K(jt); DIL_DMA_V(jt);
    for (; jt < 5; ++jt) {
        const int j0 = i0 - 128 + 32 * jt;
        const int jn = jt < 4 ? jt + 1 : 4;
        asm volatile("s_waitcnt vmcnt(8)" ::: "memory");
        f32x16 sacc, sac2;
#pragma unroll
        for (int e = 0; e < 16; ++e) { sacc[e] = 0.f; sac2[e] = 0.f; }
        {
            bf16x8 kf[8];
#pragma unroll
            for (int ks = 0; ks < 8; ++ks) kf[ks] = *((const LAS bf16x8*)(wl + ATT_KOFF + 1024 * ks) + lane);
#pragma unroll
            for (int ks = 0; ks < 8; ks += 2) { sacc = __builtin_amdgcn_mfma_f32_32x32x16_bf16(kf[ks], qf[ks], sacc, 0, 0, 0); sac2 = __builtin_amdgcn_mfma_f32_32x32x16_bf16(kf[ks + 1], qf[ks + 1], sac2, 0, 0, 0); }
#pragma unroll
            for (int e = 0; e < 16; ++e) sacc[e] += sac2[e];
        }
        LDS_WAIT();
        DIL_DMA_K(jn);
        float tm = NEGBIG;
#pragma unroll
        for (int e = 0; e < 16; ++e) {
            const int j = j0 + 16 * (e >> 3) + 8 * hh + (e & 7);
            const int dist = (i0 + r) - j;
            const bool valid = (j >= 0) && (dist >= 0) && (dist <= 128);
            const int dc = dist < 0 ? 0 : (dist > 128 ? 128 : dist);
            const float bv = *(volatile LAS float*)(biasL + dc);
            const float lg = valid ? sacc[e] * QSCALE + bv : NEGBIG;
            sacc[e] = lg; tm = fmaxf(tm, lg);
        }
        tm = max32(tm);
        const float m_new = fmaxf(m_run, tm);
        const float alpha = __expf(m_run - m_new);
        float ps = 0.f;
#pragma unroll
        for (int e = 0; e < 16; ++e) { const float pv = (sacc[e] > -1.0e37f) ? __expf(sacc[e] - m_new) : 0.f; sacc[e] = pv; ps += pv; }
        ps = sum32(ps);
        l_run = l_run * alpha + ps; m_run = m_new;
#pragma unroll
        for (int dt = 0; dt < 4; ++dt)
#pragma unroll
            for (int e = 0; e < 16; ++e) o[dt][e] *= alpha;
        bf16x8 pf[2];
#pragma unroll
        for (int s2 = 0; s2 < 2; ++s2) { v4u w; w.x = cvtpk_bf16(sacc[8 * s2 + 0], sacc[8 * s2 + 1]); w.y = cvtpk_bf16(sacc[8 * s2 + 2], sacc[8 * s2 + 3]);
            w.z = cvtpk_bf16(sacc[8 * s2 + 4], sacc[8 * s2 + 5]); w.w = cvtpk_bf16(sacc[8 * s2 + 6], sacc[8 * s2 + 7]); pf[s2] = __builtin_bit_cast(bf16x8, w); }
        asm volatile("s_waitcnt vmcnt(8)" ::: "memory");
#pragma unroll
        for (int dt = 0; dt < 4; ++dt)
#pragma unroll
            for (int s2 = 0; s2 < 2; ++s2) o[dt] = __builtin_amdgcn_mfma_f32_32x32x16_bf16(vfrag_tr(wl, lane, dt, s2), pf[s2], o[dt], 0, 0, 0);
        LDS_WAIT();
        DIL_DMA_V(jn);
    }
    asm volatile("s_waitcnt vmcnt(0)" ::: "memory");
#undef DIL_DMA_V
#undef DIL_DMA_K
    const float inv = 1.f / l_run;
    bf16* po = PART + ((size_t)p * M + rowq) * SWA_W + h * 128;
#pragma unroll
    for (int dt = 0; dt < 4; ++dt)
#pragma unroll
        for (int g = 0; g < 4; ++g)
            *(unsigned long long*)(po + 32 * dt + 8 * g + 4 * hh) = (unsigned long long)pk2(o[dt][4 * g + 0] * inv, o[dt][4 * g + 1] * inv) | ((unsigned long long)pk2(o[dt][4 * g + 2] * inv, o[dt][4 * g + 3] * inv) << 32);
    if (hh == 0) LSE[((size_t)p * M + rowq) * 6 + h] = m_run + __logf(l_run);
}


DEV void lru_item2(int l, int b, int j, int n, const bf16* __restrict__ Z, const float* __restrict__ conv_w, const float* __restrict__ conv_b, const bf16* __restrict__ WGT,
                   const float* __restrict__ b_rec, const float* __restrict__ b_gi, const float* __restrict__ lam,
                   bf16* __restrict__ HLOC, bf16* __restrict__ PP, float* __restrict__ SUMA, float* __restrict__ SUMB, LAS float* xc, LAS float* g0L, LAS float* g1L, int tid) {
    const int ch = tid & 127, tq = tid >> 7, c = n * 128 + ch;
    {
        LAS unsigned char* xaL = (LAS unsigned char*)(g1L + 64 * 132);
        const int t0 = j * 64;
#pragma unroll
        for (int i = 0; i < 3; ++i) { const int pz = tid + 512 * i; if (pz < 67 * 16) { const int row = pz >> 4, cc = pz & 15; const int t = t0 - 3 + row;
            v4u w = {0u, 0u, 0u, 0u}; if (t >= 0) w = *(const v4u*)(Z + ((size_t)b * SEQ + t) * IN_W + ZO_XA + n * 128 + 8 * cc);
            *(LAS v4u*)(xaL + row * 256 + cc * 16) = w; } }
        __syncthreads();
        const float cw0 = conv_w[(l * 4 + 0) * LRU_W + c], cw1 = conv_w[(l * 4 + 1) * LRU_W + c], cw2 = conv_w[(l * 4 + 2) * LRU_W + c], cw3 = conv_w[(l * 4 + 3) * LRU_W + c];
        const float cb = conv_b[l * LRU_W + c];
        const LAS bf16* xp = (const LAS bf16*)xaL + ch;
#pragma unroll 4
        for (int i = 0; i < 16; ++i) {
            const int tok = tq + 4 * i;
            xc[tok * 132 + ch] = cb + cw0 * bf1(xp[(tok + 0) * 128]) + cw1 * bf1(xp[(tok + 1) * 128]) + cw2 * bf1(xp[(tok + 2) * 128]) + cw3 * bf1(xp[(tok + 3) * 128]);
        }
    }
    __syncthreads();
    {
        const int lane = tid & 63, wave = tid >> 6, r = lane & 31, hh = lane >> 5, g = wave >> 2, ct = wave & 3;
        const bf16* wp = WGT + (((size_t)(l * 6 + n) * 2 + g) * 128 + ct * 32 + r) * 128 + 8 * hh;
        bf16x8 bfr[8];
#pragma unroll
        for (int ks = 0; ks < 8; ++ks) bfr[ks] = *(const bf16x8*)(wp + 16 * ks);
        LAS float* gL = g ? g1L : g0L;
#pragma unroll
        for (int rt = 0; rt < 2; ++rt) {
            f32x16 acc;
#pragma unroll
            for (int e = 0; e < 16; ++e) acc[e] = 0.f;
#pragma unroll
            for (int ks = 0; ks < 8; ++ks) {
                const LAS float* xp = xc + (32 * rt + r) * 132 + 16 * ks + 8 * hh;
                const f32x4 x0 = *(const LAS f32x4*)xp, x1 = *(const LAS f32x4*)(xp + 4);
                v4u w; w.x = cvtpk_bf16(x0.x, x0.y); w.y = cvtpk_bf16(x0.z, x0.w); w.z = cvtpk_bf16(x1.x, x1.y); w.w = cvtpk_bf16(x1.z, x1.w);
                acc = __builtin_amdgcn_mfma_f32_32x32x16_bf16(__builtin_bit_cast(bf16x8, w), bfr[ks], acc, 0, 0, 0);
            }
#pragma unroll
            for (int e = 0; e < 16; ++e) { const int tok = 32 * rt + (e & 3) + 8 * (e >> 2) + 4 * hh; gL[tok * 132 + ct * 32 + r] = acc[e]; }
        }
    }
    __syncthreads();
    {
        const float br = b_rec[l * LRU_W + c], bi = b_gi[l * LRU_W + c], sp = softplus_f(-lam[l * LRU_W + c]);
#pragma unroll 4
        for (int i = 0; i < 16; ++i) {
            const int tok = tq + 4 * i;
            const float rg = sigmoid_f(g0L[tok * 132 + ch] + br), ig = sigmoid_f(g1L[tok * 132 + ch] + bi);
            const float log_a = -8.0f * rg * sp;
            const float av = __expf(log_a);
            const float x = xc[tok * 132 + ch];
            const float uv = sqrtf(fmaxf(-expm1f(2.f * log_a), 0.f)) * (ig * x);
            g0L[tok * 132 + ch] = av; g1L[tok * 132 + ch] = uv;
        }
    }
    __syncthreads();
    if (tid < 128) {
        float h = 0.f, P = 1.f;
        const size_t rb = ((size_t)b * SEQ + j * 64) * LRU_W + n * 128 + tid;
#pragma unroll 8
        for (int tok = 0; tok < 64; ++tok) {
            const float av = g0L[tok * 132 + tid];
            h = av * h + g1L[tok * 132 + tid]; P *= av;
            HLOC[rb + (size_t)tok * LRU_W] = (bf16)f2bf(h); PP[rb + (size_t)tok * LRU_W] = (bf16)f2bf(P);
        }
        SUMA[(size_t)(b * 64 + j) * LRU_W + n * 128 + tid] = P; SUMB[(size_t)(b * 64 + j) * LRU_W + n * 128 + tid] = h;
    }
    __syncthreads();
}

DEV void sb_mfma_item(int b, int h, int t0, const bf16* __restrict__ Z, bf16* __restrict__ YC, LAS unsigned char* wl, int lane) {
    asm volatile("" : "+v"(lane));
    const int r = lane & 31, hh = lane >> 5;
    const size_t rowq = (size_t)b * SEQ + t0 + r;
    bf16x8 qf[8];
    { const bf16* qrow = Z + rowq * IN_W + ZO_QC + h * 128 + 8 * hh;
#pragma unroll
      for (int ks = 0; ks < 8; ++ks) qf[ks] = *(const bf16x8*)(qrow + 16 * ks); }
    f32x16 o[4];
#pragma unroll
    for (int dt = 0; dt < 4; ++dt)
#pragma unroll
        for (int e = 0; e < 16; ++e) o[dt][e] = 0.f;
    const int kap = (r & 0x13) | ((r & 4) << 1) | ((r & 8) >> 1);
    float carry = 0.f;
#define SB_DMA_K(K0) do { const bf16* krow = Z + ((size_t)b * SEQ + (K0) + kap) * IN_W + ZO_KC + h * 128 + 8 * hh; \
        _Pragma("unroll") for (int ks = 0; ks < 8; ++ks) __builtin_amdgcn_global_load_lds((const unsigned*)(krow + 16 * ks), (LAS unsigned*)(wl + ATT_KOFF + 1024 * ks), 16, 0, 0); } while (0)
#define SB_DMA_V(K0) do { _Pragma("unroll") for (int q = 0; q < 8; ++q) { const int pi = lane + 64 * q, kl = pi >> 4, c = (pi & 15) ^ (((kl & 3) << 2) | ((kl >> 2) & 3)); \
        __builtin_amdgcn_global_load_lds((const unsigned*)(Z + ((size_t)b * SEQ + (K0) + kl) * IN_W + ZO_VC + h * 128 + 8 * c), (LAS unsigned*)(wl + 1024 * q), 16, 0, 0); } } while (0)
    LDS_WAIT();
    SB_DMA_K(t0); SB_DMA_V(t0);
    for (int k0 = t0; k0 >= 0; k0 -= 32) {
        const int kn = k0 >= 32 ? k0 - 32 : 0;
        asm volatile("s_waitcnt vmcnt(8)" ::: "memory");
        f32x16 sacc, sac2;
#pragma unroll
        for (int e = 0; e < 16; ++e) { sacc[e] = 0.f; sac2[e] = 0.f; }
        {
            bf16x8 kf[8];
#pragma unroll
            for (int ks = 0; ks < 8; ++ks) kf[ks] = *((const LAS bf16x8*)(wl + ATT_KOFF + 1024 * ks) + lane);
#pragma unroll
            for (int ks = 0; ks < 8; ks += 2) { sacc = __builtin_amdgcn_mfma_f32_32x32x16_bf16(kf[ks], qf[ks], sacc, 0, 0, 0); sac2 = __builtin_amdgcn_mfma_f32_32x32x16_bf16(kf[ks + 1], qf[ks + 1], sac2, 0, 0, 0); }
#pragma unroll
            for (int e = 0; e < 16; ++e) sacc[e] += sac2[e];
        }
        LDS_WAIT();
        SB_DMA_K(kn);
        float l1[16]; float T0 = 0.f, T1 = 0.f;
#pragma unroll
        for (int e = 0; e < 16; ++e) {
            const int key = k0 + 16 * (e >> 3) + 8 * hh + (e & 7);
            const bool valid = key < t0 + r;
            const float z = sacc[e] * QSCALE;
            sacc[e] = z;
            l1[e] = valid ? -(fmaxf(z, 0.f) + __logf(1.f + __expf(-fabsf(z)))) : 0.f;
        }
#pragma unroll
        for (int e = 0; e < 8; ++e) { T0 += l1[e]; T1 += l1[8 + e]; }
        const float PT0 = partner32(T0, hh), PT1 = partner32(T1, hh);
        const float base1 = carry + (hh ? 0.f : PT1);
        const float base0 = carry + (hh ? (T1 + PT1) : (PT1 + T1 + PT0));
        float run1 = base1, run0 = base0;
#pragma unroll
        for (int e = 7; e >= 0; --e) {
            { const int key = k0 + 16 + 8 * hh + e; const bool valid = key < t0 + r; const float a = valid ? __expf(sacc[8 + e] + l1[8 + e] + run1) : 0.f; run1 += l1[8 + e]; sacc[8 + e] = a; }
            { const int key = k0 + 8 * hh + e; const bool valid = key < t0 + r; const float a = valid ? __expf(sacc[e] + l1[e] + run0) : 0.f; run0 += l1[e]; sacc[e] = a; }
        }
        carry += (T0 + T1) + (PT0 + PT1);
        bf16x8 pf[2];
#pragma unroll
        for (int s2 = 0; s2 < 2; ++s2) { v4u w; w.x = cvtpk_bf16(sacc[8 * s2 + 0], sacc[8 * s2 + 1]); w.y = cvtpk_bf16(sacc[8 * s2 + 2], sacc[8 * s2 + 3]);
            w.z = cvtpk_bf16(sacc[8 * s2 + 4], sacc[8 * s2 + 5]); w.w = cvtpk_bf16(sacc[8 * s2 + 6], sacc[8 * s2 + 7]); pf[s2] = __builtin_bit_cast(bf16x8, w); }
        asm volatile("s_waitcnt vmcnt(8)" ::: "memory");
#pragma unroll
        for (int dt = 0; dt < 4; ++dt)
#pragma unroll
            for (int s2 = 0; s2 < 2; ++s2) o[dt] = __builtin_amdgcn_mfma_f32_32x32x16_bf16(vfrag_tr(wl, lane, dt, s2), pf[s2], o[dt], 0, 0, 0);
        LDS_WAIT();
        SB_DMA_V(kn);
        if (__all(carry < -105.0f)) break;
    }
    asm volatile("s_waitcnt vmcnt(0)" ::: "memory");
#undef SB_DMA_V
#undef SB_DMA_K
    bf16* po = YC + rowq * SB_W + h * 128;
#pragma unroll
    for (int dt = 0; dt < 4; ++dt)
#pragma unroll
        for (int g = 0; g < 4; ++g)
            *(unsigned long long*)(po + 32 * dt + 8 * g + 4 * hh) = (unsigned long long)pk2(o[dt][4 * g + 0], o[dt][4 * g + 1]) | ((unsigned long long)pk2(o[dt][4 * g + 2], o[dt][4 * g + 3]) << 32);
}

DEV void combine_item(int l, int b, int j, int half, const bf16* __restrict__ Z, const bf16* __restrict__ HLOC, const bf16* __restrict__ PP, const float* __restrict__ SUMA, const float* __restrict__ SUMB,
                      const bf16* __restrict__ PART, const float* __restrict__ LSE, const bf16* __restrict__ YC, const float* __restrict__ g_lru, const float* __restrict__ g_swa, const float* __restrict__ g_sb,
                      bf16* __restrict__ Y, LAS float* carryL, int tid) {
    const int lane = tid & 63, wave = tid >> 6;
    for (int c = tid; c < LRU_W; c += 512) {
        float cr = 0.f; int i = 0;
        for (; i + 8 <= j; i += 8) {
            float av[8], bv[8];
#pragma unroll
            for (int u = 0; u < 8; ++u) { av[u] = SUMA[(size_t)(b * 64 + i + u) * LRU_W + c]; bv[u] = SUMB[(size_t)(b * 64 + i + u) * LRU_W + c]; }
#pragma unroll
            for (int u = 0; u < 8; ++u) cr = av[u] * cr + bv[u];
        }
        for (; i < j; ++i) cr = SUMA[(size_t)(b * 64 + i) * LRU_W + c] * cr + SUMB[(size_t)(b * 64 + i) * LRU_W + c];
        carryL[c] = cr;
    }
    __syncthreads();
    for (int i = 0; i < 4; ++i) {
        const int tok = half * 32 + wave * 4 + i;
        const size_t row = (size_t)b * SEQ + j * 64 + tok;
        bf16* yo = Y + row * D;
        {
            float ya[12]; float ssq = 0.f;
#pragma unroll
            for (int e = 0; e < 6; ++e) { const int c = 2 * lane + 128 * e;
                const unsigned hw = *(const unsigned*)(HLOC + row * LRU_W + c), pw = *(const unsigned*)(PP + row * LRU_W + c), gw2 = *(const unsigned*)(Z + row * IN_W + ZO_GA + c);
                const f32x2 cr = *(const LAS f32x2*)(carryL + c);
                ya[2 * e] = (bf_lo(hw) + bf_lo(pw) * cr.x) * gelu_tanh(bf_lo(gw2)); ya[2 * e + 1] = (bf_hi(hw) + bf_hi(pw) * cr.y) * gelu_tanh(bf_hi(gw2));
                ssq += ya[2 * e] * ya[2 * e] + ya[2 * e + 1] * ya[2 * e + 1]; }
            const float r = rsqrtf(wave_sum(ssq) * (1.f / LRU_W) + EPS);
#pragma unroll
            for (int e = 0; e < 6; ++e) { const int c = 2 * lane + 128 * e; const f32x2 g = *(const f32x2*)(g_lru + l * LRU_W + c);
                *(unsigned*)(yo + c) = pk2(ya[2 * e] * r * g.x, ya[2 * e + 1] * r * g.y); }
        }
        {
            float yb[12]; float ssq = 0.f;
#pragma unroll
            for (int e = 0; e < 6; ++e) { const int c = 2 * lane + 128 * e;
                const float l0 = LSE[((size_t)0 * M + row) * 6 + e], l1 = LSE[((size_t)1 * M + row) * 6 + e], l2 = LSE[((size_t)2 * M + row) * 6 + e];
                const float mx = fmaxf(l0, fmaxf(l1, l2)); const float e0 = __expf(l0 - mx), e1 = __expf(l1 - mx), e2 = __expf(l2 - mx); const float iz = 1.f / (e0 + e1 + e2);
                const unsigned p0 = *(const unsigned*)(PART + ((size_t)0 * M + row) * SWA_W + c), p1 = *(const unsigned*)(PART + ((size_t)1 * M + row) * SWA_W + c), p2 = *(const unsigned*)(PART + ((size_t)2 * M + row) * SWA_W + c);
                yb[2 * e] = (e0 * bf_lo(p0) + e1 * bf_lo(p1) + e2 * bf_lo(p2)) * iz; yb[2 * e + 1] = (e0 * bf_hi(p0) + e1 * bf_hi(p1) + e2 * bf_hi(p2)) * iz;
                ssq += yb[2 * e] * yb[2 * e] + yb[2 * e + 1] * yb[2 * e + 1]; }
            const float r = rsqrtf(wave_sum(ssq) * (1.f / SWA_W) + EPS);
#pragma unroll
            for (int e = 0; e < 6; ++e) { const int c = 2 * lane + 128 * e; const f32x2 g = *(const f32x2*)(g_swa + l * SWA_W + c);
                *(unsigned*)(yo + LRU_W + c) = pk2(yb[2 * e] * r * g.x, yb[2 * e + 1] * r * g.y); }
        }
        {
            float yc[8]; float ssq = 0.f;
#pragma unroll
            for (int e = 0; e < 4; ++e) { const int c = 2 * lane + 128 * e; const unsigned w = *(const unsigned*)(YC + row * SB_W + c); yc[2 * e] = bf_lo(w); yc[2 * e + 1] = bf_hi(w); ssq += yc[2 * e] * yc[2 * e] + yc[2 * e + 1] * yc[2 * e + 1]; }
            const float r = rsqrtf(wave_sum(ssq) * (1.f / SB_W) + EPS);
#pragma unroll
            for (int e = 0; e < 4; ++e) { const int c = 2 * lane + 128 * e; const f32x2 g = *(const f32x2*)(g_sb + l * SB_W + c);
                *(unsigned*)(yo + LRU_W + SWA_W + c) = pk2(yc[2 * e] * r * g.x, yc[2 * e + 1] * r * g.y); }
        }
    }
    __syncthreads();
}


constexpr float U8_SCALE = 64.f;
DEV void convert_fp8(const float* __restrict__ src, unsigned char* __restrict__ dst, size_t ngroups16, size_t gtid, size_t gstride, float scale) {
    for (size_t g = gtid; g < ngroups16; g += gstride) {
        const f32x4 a = *(const f32x4*)(src + g * 16) * scale, b = *(const f32x4*)(src + g * 16 + 4) * scale, c = *(const f32x4*)(src + g * 16 + 8) * scale, d = *(const f32x4*)(src + g * 16 + 12) * scale;
        int w0 = 0, w1 = 0, w2 = 0, w3 = 0;
        w0 = __builtin_amdgcn_cvt_pk_fp8_f32(a.x, a.y, w0, false); w0 = __builtin_amdgcn_cvt_pk_fp8_f32(a.z, a.w, w0, true);
        w1 = __builtin_amdgcn_cvt_pk_fp8_f32(b.x, b.y, w1, false); w1 = __builtin_amdgcn_cvt_pk_fp8_f32(b.z, b.w, w1, true);
        w2 = __builtin_amdgcn_cvt_pk_fp8_f32(c.x, c.y, w2, false); w2 = __builtin_amdgcn_cvt_pk_fp8_f32(c.z, c.w, w2, true);
        w3 = __builtin_amdgcn_cvt_pk_fp8_f32(d.x, d.y, w3, false); w3 = __builtin_amdgcn_cvt_pk_fp8_f32(d.z, d.w, w3, true);
        *(v4u*)(dst + g * 16) = (v4u){(unsigned)w0, (unsigned)w1, (unsigned)w2, (unsigned)w3};
    }
}

constexpr int R2_SC = 0, R2_TV = 128 * 129 * 4, R2_TI = R2_TV + 128 * 16 * 4, R2_END = R2_TI + 128 * 16 * 4;
static_assert(R2_END <= LDS_MISC, "routing v2 LDS");
DEV unsigned ord_key(float s) { const unsigned u = __builtin_bit_cast(unsigned, s); return (u & 0x80000000u) ? ~u : (u | 0x80000000u); }

#define KEY_CE(A, B) do { const unsigned hi_ = (A) > (B) ? (A) : (B); const unsigned lo_ = (A) > (B) ? (B) : (A); (A) = hi_; (B) = lo_; } while (0)
DEV void bitonic_sort16_desc(unsigned (&a)[16]) {
#pragma unroll
    for (int k = 2; k <= 16; k <<= 1)
#pragma unroll
        for (int j = k >> 1; j > 0; j >>= 1)
#pragma unroll
            for (int i = 0; i < 16; ++i) { const int m = i ^ j; if (m > i) { if ((i & k) == 0) KEY_CE(a[i], a[m]); else KEY_CE(a[m], a[i]); } }
}
DEV void bitonic_merge16_desc(unsigned (&a)[16]) {
#pragma unroll
    for (int j = 8; j > 0; j >>= 1)
#pragma unroll
        for (int i = 0; i < 16; ++i) { const int m = i ^ j; if (m > i) KEY_CE(a[i], a[m]); }
}
DEV void route_item2(int l, int tile, int h, const bf16* __restrict__ Q, const bf16* __restrict__ SK, int* __restrict__ IDS, float* __restrict__ GG, LAS unsigned char* lds, int tid, int seq,
                        const float* __restrict__ cv_u, const float* __restrict__ cv_v, unsigned char* __restrict__ cv_u8, unsigned char* __restrict__ cv_v8) {
    LAS float* sc = (LAS float*)(lds + R2_SC); LAS float* tv = (LAS float*)(lds + R2_TV); LAS int* ti = (LAS int*)(lds + R2_TI);
    const int lane = tid & 63, wave = tid >> 6, row0 = tile * 64;
    {
        const int r = lane & 31, hh = lane >> 5, c = wave >> 2, key0 = 32 * (wave & 3);
        const bf16* skp = SK + ((size_t)(((l * 8 + h) * 2 + c) * 128 + key0 + r)) * 128 + 8 * hh;
        bf16x8 bfr[8];
#pragma unroll
        for (int ks = 0; ks < 8; ++ks) bfr[ks] = *(const bf16x8*)(skp + 16 * ks);
#pragma unroll
        for (int rt = 0; rt < 2; ++rt) {
            const bf16* qp = Q + (size_t)(row0 + 32 * rt + r) * D + h * 256 + c * 128 + 8 * hh;
            bf16x8 afr[8];
#pragma unroll
            for (int ks = 0; ks < 8; ++ks) afr[ks] = *(const bf16x8*)(qp + 16 * ks);
            f32x16 acc;
#pragma unroll
            for (int e = 0; e < 16; ++e) acc[e] = 0.f;
#pragma unroll
            for (int ks = 0; ks < 8; ++ks) acc = __builtin_amdgcn_mfma_f32_32x32x16_bf16(afr[ks], bfr[ks], acc, 0, 0, 0);
#pragma unroll
            for (int e = 0; e < 16; ++e) { const int tok = 32 * rt + (e & 3) + 8 * (e >> 2) + 4 * hh; sc[(c * 64 + tok) * 129 + key0 + r] = acc[e]; }
        }
    }
    __syncthreads();
    if (tid >= 128) {
        const size_t TG = (size_t)NEXP * D / 16;
        const size_t g0 = (size_t)(tile * 8 + h) * 4096;
#pragma unroll 4
        for (int k = 0; k < 11; ++k) { const size_t g = g0 + (size_t)(tid - 128) + 384u * k;
            if (g < g0 + 4096) { const bool isv = g >= TG; const size_t gg = isv ? g - TG : g;
                const size_t ex = gg >> 7, cg = gg & 127;
                convert_fp8((isv ? cv_v : cv_u) + gg * 16, (isv ? cv_v8 : cv_u8) + (((cg >> 3) * (size_t)NEXP + ex) * 128 + (cg & 7) * 16), 1, 0, 1, isv ? 1.f : U8_SCALE); } }
    }
    if (tid < 128) {
        const int L = tid;
        unsigned t[16];
#pragma unroll
        for (int q = 0; q < 16; ++q) t[q] = 0u;
#pragma unroll 1
        for (int blk = 0; blk < 8; ++blk) {
            unsigned bk[16];
#pragma unroll
            for (int i = 0; i < 16; ++i) { const int k = blk * 16 + i; bk[i] = (ord_key(sc[L * 129 + k]) & ~127u) | (unsigned)(127 - k); }
            bitonic_sort16_desc(bk);
#pragma unroll
            for (int i = 0; i < 16; ++i) t[i] = t[i] > bk[15 - i] ? t[i] : bk[15 - i];
            bitonic_merge16_desc(t);
        }
#pragma unroll
        for (int q = 0; q < 16; ++q) { const int idx = 127 - (int)(t[q] & 127u); tv[L * 16 + q] = sc[L * 129 + idx]; ti[L * 16 + q] = idx; }
    }
    if (wave == 1) { LDS_WAIT(); if (lane == 0) *(volatile LAS int*)(lds + LDS_MISC + 128) = seq; }
    if (wave == 0) { LDS_WAIT(); while (*(volatile LAS int*)(lds + LDS_MISC + 128) != seq) __builtin_amdgcn_s_sleep(1); }
    if (tid < 64) {
        const int tok = tid;
        float a[16], bq[16];
#pragma unroll
        for (int i = 0; i < 16; ++i) { a[i] = tv[tok * 16 + i]; bq[i] = tv[(64 + tok) * 16 + i]; }
        unsigned t[16];
#pragma unroll
        for (int q = 0; q < 16; ++q) t[q] = 0u;
#pragma unroll
        for (int i = 0; i < 16; ++i)
#pragma unroll
            for (int j = 0; j < 16 / (i + 1); ++j) {
                unsigned key = (ord_key(a[i] + bq[j]) & ~255u) | (unsigned)(255 - (i * 16 + j));
#pragma unroll
                for (int q = 0; q < 16; ++q) { const unsigned hi = t[q] > key ? t[q] : key; key = t[q] > key ? key : t[q]; t[q] = hi; }
            }
        float scv[16]; int idv[16]; float mx = NEGBIG;
#pragma unroll
        for (int q = 0; q < 16; ++q) { const int ci = 255 - (int)(t[q] & 255u); const int i = ci >> 4, j = ci & 15;
            scv[q] = tv[tok * 16 + i] + tv[(64 + tok) * 16 + j]; idv[q] = ti[tok * 16 + i] * 128 + ti[(64 + tok) * 16 + j]; mx = fmaxf(mx, scv[q]); }
        float sum = 0.f;
#pragma unroll
        for (int q = 0; q < 16; ++q) { scv[q] = __expf(scv[q] - mx); sum += scv[q]; }
        const float inv = 1.f / sum;
        int* ip = IDS + (size_t)(row0 + tok) * 128 + h * 16; float* gp = GG + (size_t)(row0 + tok) * 128 + h * 16;
#pragma unroll
        for (int q4 = 0; q4 < 4; ++q4) {
            *(int4*)(ip + 4 * q4) = make_int4(idv[4 * q4], idv[4 * q4 + 1], idv[4 * q4 + 2], idv[4 * q4 + 3]);
            *(f32x4*)(gp + 4 * q4) = (f32x4){scv[4 * q4] * inv, scv[4 * q4 + 1] * inv, scv[4 * q4 + 2] * inv, scv[4 * q4 + 3] * inv};
        }
    }
    __syncthreads();
}


DEV void expert_row8(int l, int row, const bf16* H, const int* __restrict__ IDS, const float* __restrict__ GG, const unsigned char* __restrict__ U8, const unsigned char* __restrict__ V8,
                     const bf16* __restrict__ X1, const float* __restrict__ g2, const float* __restrict__ fnorm, float* __restrict__ XO, bf16* __restrict__ XOH, int lane, float pscale, LAS int* sortL,
                     const float* __restrict__ ngain, const float* __restrict__ nmod, bf16* Hout) {
    f32x2 x[16];
#pragma unroll
    for (int j = 0; j < 2; ++j) {
        const v4u a = *(const v4u*)(H + (size_t)row * D + lane * 16 + 1024 * j), c = *(const v4u*)(H + (size_t)row * D + lane * 16 + 1024 * j + 8);
        x[j * 8 + 0] = (f32x2){bf_lo(a.x), bf_hi(a.x)}; x[j * 8 + 1] = (f32x2){bf_lo(a.y), bf_hi(a.y)}; x[j * 8 + 2] = (f32x2){bf_lo(a.z), bf_hi(a.z)}; x[j * 8 + 3] = (f32x2){bf_lo(a.w), bf_hi(a.w)};
        x[j * 8 + 4] = (f32x2){bf_lo(c.x), bf_hi(c.x)}; x[j * 8 + 5] = (f32x2){bf_lo(c.y), bf_hi(c.y)}; x[j * 8 + 6] = (f32x2){bf_lo(c.z), bf_hi(c.z)}; x[j * 8 + 7] = (f32x2){bf_lo(c.w), bf_hi(c.w)};
    }
    int id0 = IDS[(size_t)row * 128 + lane], id1 = IDS[(size_t)row * 128 + 64 + lane];
    float gg0 = GG[(size_t)row * 128 + lane], gg1 = GG[(size_t)row * 128 + 64 + lane];
    {
        const int w0 = id0 >> 9, w1 = id1 >> 9; int p0 = 0, p1 = 0, base = 0;
        for (int w = 0; w < 32; ++w) {
            const unsigned long long m0 = __ballot(w0 == w), m1 = __ballot(w1 == w);
            const int c0 = __popcll(m0), c1 = __popcll(m1);
            const int b0 = (int)__builtin_amdgcn_mbcnt_hi((unsigned)(m0 >> 32), __builtin_amdgcn_mbcnt_lo((unsigned)m0, 0u));
            const int b1 = (int)__builtin_amdgcn_mbcnt_hi((unsigned)(m1 >> 32), __builtin_amdgcn_mbcnt_lo((unsigned)m1, 0u));
            p0 = (w0 == w) ? base + b0 : p0; p1 = (w1 == w) ? base + c0 + b1 : p1;
            base += c0 + c1;
        }
        sortL[p0] = id0; sortL[p1] = id1; ((LAS float*)sortL)[128 + p0] = gg0; ((LAS float*)sortL)[128 + p1] = gg1;
        LDS_WAIT();
        id0 = sortL[lane]; id1 = sortL[64 + lane]; gg0 = ((LAS float*)sortL)[128 + lane]; gg1 = ((LAS float*)sortL)[192 + lane];
        LDS_WAIT();
    }
    float wv0 = 0.f, wv1 = 0.f;
    const unsigned char* Ul = U8 + (size_t)l * NEXP * D + lane * 16;
    const unsigned char* Vl = V8 + (size_t)l * NEXP * D + lane * 16;
    for (int e0 = 0; e0 < 128; e0 += 8) {
        v4u uu[8][2];
#pragma unroll
        for (int q = 0; q < 8; ++q) { const int e = e0 + q; const int id = (e < 64) ? __builtin_amdgcn_readlane(id0, e & 63) : __builtin_amdgcn_readlane(id1, e & 63);
            uu[q][0] = *(const v4u*)(Ul + (size_t)id * D); uu[q][1] = *(const v4u*)(Ul + (size_t)id * D + 1024); }
        float ds[8];
#pragma unroll
        for (int q = 0; q < 8; ++q) {
            f32x2 acc = {0.f, 0.f};
#pragma unroll
            for (int j = 0; j < 2; ++j) {
                const unsigned wd[4] = {uu[q][j].x, uu[q][j].y, uu[q][j].z, uu[q][j].w};
#pragma unroll
                for (int dw = 0; dw < 4; ++dw) {
                    const f32x2 lo = __builtin_amdgcn_cvt_pk_f32_fp8((int)wd[dw], false), hi = __builtin_amdgcn_cvt_pk_f32_fp8((int)wd[dw], true);
                    acc = __builtin_elementwise_fma(lo, x[j * 8 + 2 * dw], acc); acc = __builtin_elementwise_fma(hi, x[j * 8 + 2 * dw + 1], acc);
                }
            }
            ds[q] = acc.x + acc.y;
        }
#pragma unroll
        for (int q = 0; q < 8; ++q) ds[q] += swz_xor<1>(ds[q]);
#pragma unroll
        for (int q = 0; q < 8; ++q) ds[q] += swz_xor<2>(ds[q]);
#pragma unroll
        for (int q = 0; q < 8; ++q) ds[q] += swz_xor<4>(ds[q]);
#pragma unroll
        for (int q = 0; q < 8; ++q) ds[q] += swz_xor<8>(ds[q]);
#pragma unroll
        for (int q = 0; q < 8; ++q) ds[q] += swz_xor<16>(ds[q]);
#pragma unroll
        for (int q = 0; q < 8; ++q) ds[q] = sum32(ds[q]);
#pragma unroll
        for (int q = 0; q < 8; ++q) { const int e = e0 + q;
            const float gq = (e < 64) ? __builtin_bit_cast(float, __builtin_amdgcn_readlane(__builtin_bit_cast(int, gg0), e & 63)) : __builtin_bit_cast(float, __builtin_amdgcn_readlane(__builtin_bit_cast(int, gg1), e & 63));
            const float w = gq * gelu_tanh(ds[q] * (1.f / U8_SCALE));
            if (e < 64) wv0 = (lane == (e & 63)) ? w : wv0; else wv1 = (lane == (e & 63)) ? w : wv1; }
    }
    f32x2 y[16];
#pragma unroll
    for (int i = 0; i < 16; ++i) y[i] = (f32x2){0.f, 0.f};
    for (int e0 = 0; e0 < 128; e0 += 8) {
        v4u vv[8][2];
#pragma unroll
        for (int q = 0; q < 8; ++q) { const int e = e0 + q; const int id = (e < 64) ? __builtin_amdgcn_readlane(id0, e & 63) : __builtin_amdgcn_readlane(id1, e & 63);
            vv[q][0] = *(const v4u*)(Vl + (size_t)id * D); vv[q][1] = *(const v4u*)(Vl + (size_t)id * D + 1024); }
#pragma unroll
        for (int q = 0; q < 8; ++q) { const int e = e0 + q;
            const float w = (e < 64) ? __builtin_bit_cast(float, __builtin_amdgcn_readlane(__builtin_bit_cast(int, wv0), e & 63)) : __builtin_bit_cast(float, __builtin_amdgcn_readlane(__builtin_bit_cast(int, wv1), e & 63));
            const f32x2 w2 = {w, w};
#pragma unroll
            for (int j = 0; j < 2; ++j) {
                const unsigned wd[4] = {vv[q][j].x, vv[q][j].y, vv[q][j].z, vv[q][j].w};
#pragma unroll
                for (int dw = 0; dw < 4; ++dw) {
                    const f32x2 lo = __builtin_amdgcn_cvt_pk_f32_fp8((int)wd[dw], false), hi = __builtin_amdgcn_cvt_pk_f32_fp8((int)wd[dw], true);
                    y[j * 8 + 2 * dw] = __builtin_elementwise_fma(w2, lo, y[j * 8 + 2 * dw]); y[j * 8 + 2 * dw + 1] = __builtin_elementwise_fma(w2, hi, y[j * 8 + 2 * dw + 1]);
                }
            }
        }
    }
    float ssq = 0.f;
#pragma unroll
    for (int j = 0; j < 2; ++j)
#pragma unroll
        for (int k4 = 0; k4 < 4; ++k4) {
            const int col = lane * 16 + 1024 * j + 4 * k4;
            const unsigned long long xw = *(const unsigned long long*)(X1 + (size_t)row * D + col); const f32x4 xa = {bf_lo((unsigned)xw), bf_hi((unsigned)xw), bf_lo((unsigned)(xw >> 32)), bf_hi((unsigned)(xw >> 32))}; const f32x4 ga = *(const f32x4*)(g2 + col) * pscale;
            f32x2& ya = y[j * 8 + 2 * k4]; f32x2& yb = y[j * 8 + 2 * k4 + 1];
            ya.x = xa.x + ga.x * ya.x; ya.y = xa.y + ga.y * ya.y; yb.x = xa.z + ga.z * yb.x; yb.y = xa.w + ga.w * yb.y;
            ssq += (ya.x * ya.x + ya.y * ya.y) + (yb.x * yb.x + yb.y * yb.y);
        }
    const float r = rsqrtf(wave_sum(ssq) * (1.f / D) + EPS);
#pragma unroll
    for (int j = 0; j < 2; ++j)
#pragma unroll
        for (int k4 = 0; k4 < 4; ++k4) {
            const int col = lane * 16 + 1024 * j + 4 * k4;
            const f32x2 ya = y[j * 8 + 2 * k4], yb = y[j * 8 + 2 * k4 + 1];
            f32x4 ov = {ya.x, ya.y, yb.x, yb.y};
            if (fnorm) *(f32x4*)(XO + (size_t)row * D + col) = ov * r * *(const f32x4*)(fnorm + col);
            else *(unsigned long long*)(XOH + (size_t)row * D + col) = (unsigned long long)pk2(ov.x, ov.y) | ((unsigned long long)pk2(ov.z, ov.w) << 32);
            if (ngain) {
                const f32x4 g = *(const f32x4*)(ngain + col), sc = *(const f32x4*)(nmod + MO_SC1 + col), sh = *(const f32x4*)(nmod + MO_SH1 + col);
                const f32x4 hv = (ov * r) * g * (sc + 1.f) + sh;
                *(unsigned long long*)(Hout + (size_t)row * D + col) = (unsigned long long)pk2(hv.x, hv.y) | ((unsigned long long)pk2(hv.z, hv.w) << 32);
            }
        }
}


DEV int claim_unit(unsigned* cnt, LAS int* claimL, int w0) {
    __syncthreads();
    if (xb_lead(w0)) *claimL = (int)__hip_atomic_fetch_add(cnt, 1u, __ATOMIC_RELAXED, __HIP_MEMORY_SCOPE_AGENT);
    __syncthreads();
    return *(volatile LAS int*)claimL;
}
struct ExIds { int id[16]; };
DEV void ex_load_ids(ExIds& I, int t, const int* __restrict__ IDS, int rg) {
#pragma unroll
    for (int q = 0; q < 4; ++q) { const int4 v = *(const int4*)(IDS + (size_t)t * 128 + 16 * rg + 4 * q); I.id[4 * q] = v.x; I.id[4 * q + 1] = v.y; I.id[4 * q + 2] = v.z; I.id[4 * q + 3] = v.w; }
}
DEV void ex_load_rows(v4u (&r)[16], const ExIds& I, const unsigned char* __restrict__ Tb) {
#pragma unroll
    for (int i = 0; i < 16; ++i) r[i] = *(const v4u*)(Tb + (size_t)I.id[i] * 128);
}
DEV void exu_compute(const v4u (&uu)[16], const v4u xa, const v4u xb, float* __restrict__ pp, int cl) {
    const f32x2 x[8] = {{bf_lo(xa.x), bf_hi(xa.x)}, {bf_lo(xa.y), bf_hi(xa.y)}, {bf_lo(xa.z), bf_hi(xa.z)}, {bf_lo(xa.w), bf_hi(xa.w)},
                        {bf_lo(xb.x), bf_hi(xb.x)}, {bf_lo(xb.y), bf_hi(xb.y)}, {bf_lo(xb.z), bf_hi(xb.z)}, {bf_lo(xb.w), bf_hi(xb.w)}};
    float pd[16];
#pragma unroll
    for (int i = 0; i < 16; ++i) {
        const unsigned uw[4] = {uu[i].x, uu[i].y, uu[i].z, uu[i].w}; f32x2 acc = {0.f, 0.f};
#pragma unroll
        for (int dw = 0; dw < 4; ++dw) { const f32x2 lo = __builtin_amdgcn_cvt_pk_f32_fp8((int)uw[dw], false), hi = __builtin_amdgcn_cvt_pk_f32_fp8((int)uw[dw], true);
            acc = __builtin_elementwise_fma(lo, x[2 * dw], acc); acc = __builtin_elementwise_fma(hi, x[2 * dw + 1], acc); }
        pd[i] = acc.x + acc.y;
    }
    const bool b2 = (cl & 4) != 0, b1 = (cl & 2) != 0, b0 = (cl & 1) != 0;
    float v8[8], v4[4], v2[2];
#pragma unroll
    for (int j = 0; j < 8; ++j) { const float keep = b2 ? pd[8 + j] : pd[j], give = b2 ? pd[j] : pd[8 + j]; v8[j] = keep + swz_xor<4>(give); }
#pragma unroll
    for (int j = 0; j < 4; ++j) { const float keep = b1 ? v8[4 + j] : v8[j], give = b1 ? v8[j] : v8[4 + j]; v4[j] = keep + swz_xor<2>(give); }
#pragma unroll
    for (int j = 0; j < 2; ++j) { const float keep = b0 ? v4[2 + j] : v4[j], give = b0 ? v4[j] : v4[2 + j]; v2[j] = keep + swz_xor<1>(give); }
    *(f32x2*)pp = (f32x2){v2[0], v2[1]};
}
template <int NT>
DEV void exu_unit(int s, int t0, const bf16* __restrict__ H, const int* __restrict__ IDS, const unsigned char* __restrict__ U8l, float* __restrict__ PD, int lane) {
    const int rg = lane >> 3, cl = lane & 7;
    const unsigned char* Ub = U8l + (size_t)s * NEXP * 128 + cl * 16;
    ExIds Ia, Ib; v4u ra[16], rb[16]; v4u xa0, xa1, xb0, xb1;
#define EXU_X(X0, X1, T) do { X0 = *(const v4u*)(H + (size_t)(T) * D + 128 * s + 16 * cl); X1 = *(const v4u*)(H + (size_t)(T) * D + 128 * s + 16 * cl + 8); } while (0)
    ex_load_ids(Ia, t0, IDS, rg); EXU_X(xa0, xa1, t0);
    ex_load_rows(ra, Ia, Ub);
    if (NT > 1) { ex_load_ids(Ib, t0 + 1, IDS, rg); EXU_X(xb0, xb1, t0 + 1); }
#pragma unroll
    for (int k = 0; k < NT; k += 2) {
        if (k + 1 < NT) ex_load_rows(rb, Ib, Ub);
        if (k + 2 < NT) { ex_load_ids(Ia, t0 + k + 2, IDS, rg); }
        exu_compute(ra, xa0, xa1, PD + ((size_t)s * M + t0 + k) * 128 + 16 * rg + 2 * cl, cl);
        if (k + 2 < NT) { EXU_X(xa0, xa1, t0 + k + 2); ex_load_rows(ra, Ia, Ub); }
        if (k + 1 < NT) {
            if (k + 3 < NT) { ex_load_ids(Ib, t0 + k + 3, IDS, rg); }
            exu_compute(rb, xb0, xb1, PD + ((size_t)s * M + t0 + k + 1) * 128 + 16 * rg + 2 * cl, cl);
            if (k + 3 < NT) { EXU_X(xb0, xb1, t0 + k + 3); }
        }
    }
#undef EXU_X
}
struct ExW { float w[16]; };
DEV void ex_load_w(ExW& W, int t, const float* __restrict__ WE, int rg) {
#pragma unroll
    for (int q = 0; q < 4; ++q) { const f32x4 w = *(const f32x4*)(WE + (size_t)t * 128 + 16 * rg + 4 * q); W.w[4 * q] = w.x; W.w[4 * q + 1] = w.y; W.w[4 * q + 2] = w.z; W.w[4 * q + 3] = w.w; }
}
DEV void exv_compute(const v4u (&vv)[16], const ExW& W, int s, int t, const bf16* __restrict__ X1, const float* __restrict__ g2, bf16* __restrict__ XO, int rg, int cl) {
    f32x2 y[8];
#pragma unroll
    for (int i = 0; i < 8; ++i) y[i] = (f32x2){0.f, 0.f};
#pragma unroll
    for (int i = 0; i < 16; ++i) {
        const unsigned vw[4] = {vv[i].x, vv[i].y, vv[i].z, vv[i].w}; const f32x2 w2 = {W.w[i], W.w[i]};
#pragma unroll
        for (int dw = 0; dw < 4; ++dw) { const f32x2 lo = __builtin_amdgcn_cvt_pk_f32_fp8((int)vw[dw], false), hi = __builtin_amdgcn_cvt_pk_f32_fp8((int)vw[dw], true);
            y[2 * dw] = __builtin_elementwise_fma(w2, lo, y[2 * dw]); y[2 * dw + 1] = __builtin_elementwise_fma(w2, hi, y[2 * dw + 1]); }
    }
    const bool c5 = (rg & 4) != 0, c4 = (rg & 2) != 0, c3 = (rg & 1) != 0;
    f32x2 u4[4], u2[2], u1;
#pragma unroll
    for (int j = 0; j < 4; ++j) { const f32x2 keep = c5 ? y[4 + j] : y[j], give = c5 ? y[j] : y[4 + j]; u4[j].x = keep.x + part32_(give.x); u4[j].y = keep.y + part32_(give.y); }
#pragma unroll
    for (int j = 0; j < 2; ++j) { const f32x2 keep = c4 ? u4[2 + j] : u4[j], give = c4 ? u4[j] : u4[2 + j]; u2[j].x = keep.x + swz_xor<16>(give.x); u2[j].y = keep.y + swz_xor<16>(give.y); }
    { const f32x2 keep = c3 ? u2[1] : u2[0], give = c3 ? u2[0] : u2[1]; u1.x = keep.x + swz_xor<8>(give.x); u1.y = keep.y + swz_xor<8>(give.y); }
    {
        const size_t o = (size_t)t * D + 128 * s + 16 * cl + 2 * rg;
        const unsigned xw = *(const unsigned*)(X1 + o); const f32x2 gg = *(const f32x2*)(g2 + 128 * s + 16 * cl + 2 * rg);
        *(unsigned*)(XO + o) = pk2(bf_lo(xw) + gg.x * u1.x, bf_hi(xw) + gg.y * u1.y);
    }
}
template <int NT>
DEV void exv_unit(int s, int t0, const int* __restrict__ IDS, const float* __restrict__ WE, const unsigned char* __restrict__ V8l, const bf16* __restrict__ X1, const float* __restrict__ g2b  ,
                  bf16* __restrict__ XO, int lane) {
    const int rg = lane >> 3, cl = lane & 7;
    const unsigned char* Vb = V8l + (size_t)s * NEXP * 128 + cl * 16;
    ExIds Ia, Ib; ExW Wa, Wb; v4u ra[16], rb[16];
    ex_load_ids(Ia, t0, IDS, rg); ex_load_w(Wa, t0, WE, rg);
    ex_load_rows(ra, Ia, Vb);
    if (NT > 1) { ex_load_ids(Ib, t0 + 1, IDS, rg); ex_load_w(Wb, t0 + 1, WE, rg); }
#pragma unroll
    for (int k = 0; k < NT; k += 2) {
        if (k + 1 < NT) ex_load_rows(rb, Ib, Vb);
        if (k + 2 < NT) ex_load_ids(Ia, t0 + k + 2, IDS, rg);
        exv_compute(ra, Wa, s, t0 + k, X1, g2b + (size_t)((t0 + k) >> 12) * MODW, XO, rg, cl);
        if (k + 2 < NT) { ex_load_w(Wa, t0 + k + 2, WE, rg); ex_load_rows(ra, Ia, Vb); }
        if (k + 1 < NT) {
            if (k + 3 < NT) ex_load_ids(Ib, t0 + k + 3, IDS, rg);
            exv_compute(rb, Wb, s, t0 + k + 1, X1, g2b + (size_t)((t0 + k + 1) >> 12) * MODW, XO, rg, cl);
            if (k + 3 < NT) ex_load_w(Wb, t0 + k + 3, WE, rg);
        }
    }
}
DEV void finalnorm_rows(const bf16* __restrict__ X, const float* __restrict__ gain, float* __restrict__ O, int gw, int NGW, int lane) {
    for (int m = gw; m < M; m += NGW) {
        const v4u* xr = (const v4u*)(X + (size_t)m * D) + lane;
        float v[32]; float sq = 0.f;
#pragma unroll
        for (int j = 0; j < 4; ++j) { const v4u w = xr[64 * j];
            v[8 * j + 0] = bf_lo(w.x); v[8 * j + 1] = bf_hi(w.x); v[8 * j + 2] = bf_lo(w.y); v[8 * j + 3] = bf_hi(w.y); v[8 * j + 4] = bf_lo(w.z); v[8 * j + 5] = bf_hi(w.z); v[8 * j + 6] = bf_lo(w.w); v[8 * j + 7] = bf_hi(w.w);
#pragma unroll
            for (int e = 0; e < 8; ++e) sq += v[8 * j + e] * v[8 * j + e]; }
        const float r = rsqrtf(wave_sum(sq) * (1.f / D) + EPS);
#pragma unroll
        for (int j = 0; j < 4; ++j) { const int col = 8 * (lane + 64 * j);
            const f32x4 g0 = *(const f32x4*)(gain + col), g1 = *(const f32x4*)(gain + col + 4);
            *(f32x4*)(O + (size_t)m * D + col) = (f32x4){v[8 * j + 0] * r * g0.x, v[8 * j + 1] * r * g0.y, v[8 * j + 2] * r * g0.z, v[8 * j + 3] * r * g0.w};
            *(f32x4*)(O + (size_t)m * D + col + 4) = (f32x4){v[8 * j + 4] * r * g1.x, v[8 * j + 5] * r * g1.y, v[8 * j + 6] * r * g1.z, v[8 * j + 7] * r * g1.w}; }
    }
}

struct Args { const float* in[24]; float* out; unsigned char* ws; int ph_lo, ph_hi, li, pad; };

__global__ void __launch_bounds__(512, 2) fwd(Args a) {
    extern __shared__ __attribute__((aligned(16))) unsigned char lds_raw[];
    LAS unsigned char* lds = (LAS unsigned char*)lds_raw;
#define PHASE_TID() unsigned zz_ = 0u; asm volatile("" : "+v"(zz_));   \
    int tid = wave0 * 64 + (int)__builtin_amdgcn_mbcnt_hi(~0u, __builtin_amdgcn_mbcnt_lo(~0u, zz_)); const int lane = tid & 63; (void)lane; \
    int bx = blockIdx.x, G = gridDim.x; asm volatile("" : "+s"(bx), "+s"(G)); const int wave = __builtin_amdgcn_readfirstlane(tid >> 6); \
    const int vcu = (G % 8 == 0) ? (bx % 8) * (G / 8) + bx / 8 : bx; const int gw = vcu * 8 + wave, NGW = G * 8; (void)gw; (void)NGW; (void)vcu; (void)wave; \
    const __attribute__((address_space(4))) Args* A = (const __attribute__((address_space(4))) Args*)__builtin_amdgcn_kernarg_segment_ptr(); asm volatile("" : "+s"(A))
    unsigned* ctl = (unsigned*)(a.ws + WS_CTL);
    const int lo = a.ph_lo, hi = a.ph_hi;
    const int wave0 = __builtin_amdgcn_readfirstlane((int)threadIdx.x >> 6);
    for (int u = threadIdx.x; u < (LDS_BYTES - LDS_MISC) / 4; u += 512) ((LAS unsigned*)(lds + LDS_MISC))[u] = 0u;
    __syncthreads();
    XcdBarrier bar; bar.bar = ctl + CW_BAR + (a.li & 7) * XCD_BAR_WORDS; bar.x = 0; bar.st = (volatile LAS unsigned*)(lds + LDS_MISC + 64); bar.w0 = wave0;
    if (hi - lo > 1) bar = xcd_barrier_post(ctl + CW_BAR + (a.li & 7) * XCD_BAR_WORDS, (volatile LAS unsigned*)(lds + LDS_MISC + 64), wave0);
#define IN(k) (lo <= (k) && (k) < hi)
#define SEAM(k) do { if (IN(k) && IN((k) + 1)) xcd_barrier(bar); } while (0)

#define mod   ((float*)(A->ws + WS_MOD))
#define WIN_T ((bf16*)(A->ws + WS_WIN_T))
#define WOUT_T ((bf16*)(A->ws + WS_WOUT_T))
#define WQ_T  ((bf16*)(A->ws + WS_WQ_T))
#define SUBK  ((bf16*)(A->ws + WS_SUBK))
#define UB    ((bf16*)(A->ws + WS_U))
#define VB    ((bf16*)(A->ws + WS_V))
#define H     ((bf16*)(A->ws + WS_H))
#define Z     ((bf16*)(A->ws + WS_Z))
#define HLOC  ((bf16*)(A->ws + WS_HLOC))
#define PP    ((bf16*)(A->ws + WS_P))
#define YB    ((float*)(A->ws + WS_YB))
#define YC    ((bf16*)(A->ws + WS_YC))
#define SUMA  ((float*)(A->ws + WS_SUMA))
#define SUMB  ((float*)(A->ws + WS_SUMB))
#define X1    ((float*)(A->ws + WS_X1))
#define X2    ((float*)(A->ws + WS_X2))
#define QB    ((bf16*)(A->ws + WS_Q))
#define IDS   ((int*)(A->ws + WS_IDS))
#define GG    ((float*)(A->ws + WS_G))
#define PARTB ((bf16*)(A->ws + WS_PART))
#define WG_T  ((bf16*)(A->ws + WS_WG_T))
#define PDOT  ((float*)(A->ws + WS_PDOT))
#define WEXP  ((float*)(A->ws + WS_WEXP))
#define LSEB  ((float*)(A->ws + WS_LSE))
#define XIN   ((l == 0) ? A->in[0] : (const float*)X2)
#define XR    ((bf16*)(A->ws + WS_XR))
#define X1H   ((bf16*)(A->ws + WS_X1))
#define X2H   ((bf16*)(A->ws + WS_X2))
#define XRES  ((l == 0) ? (const bf16*)XR : (const bf16*)X2H)
#define MODL  (mod + (size_t)l * 2 * MODW)
    if (IN(0)) {
        PHASE_TID();
        ph_mod(A->in[1], A->in[2], A->in[3], mod, (LAS float*)lds, vcu, G, tid);
        {
            LAS float* scr = (LAS float*)(lds + wave * 17408);
            constexpr int I_IN = (D / 64) * (IN_W / 64), I_SQ = (D / 64) * (D / 64), I_L = I_IN + 2 * I_SQ;
            for (int it = gw; it < 2 * I_L; it += NGW) {
                const int l = it / I_L; int r = it % I_L;
                if (r < I_IN) { transpose_item64(A->in[6] + (size_t)l * D * IN_W, D, IN_W, WIN_T + (size_t)l * IN_W * D, scr, r, lane); continue; } r -= I_IN;
                if (r < I_SQ) { transpose_item64(A->in[18] + (size_t)l * D * D, D, D, WOUT_T + (size_t)l * D * D, scr, r, lane); continue; } r -= I_SQ;
                transpose_item64(A->in[19] + (size_t)l * D * D, D, D, WQ_T + (size_t)l * D * D, scr, r, lane);
            }
        }
        {
            LAS float* scr = (LAS float*)(lds + wave * 17408);
            for (int it = gw; it < 2 * 6 * 2 * 8; it += NGW) { const int mi = it >> 3, sub = it & 7; const int ln = mi >> 1, g = mi & 1;
                transpose_item((g ? A->in[11] : A->in[9]) + (size_t)ln * 128 * 128, 128, 128, WG_T + ((size_t)ln * 2 + g) * 128 * 128, scr, sub, lane); }
        }
        const size_t gtid = (size_t)vcu * 512 + tid, gstride = (size_t)G * 512;
        convert_copy(A->in[20], SUBK, (size_t)2 * 8 * 2 * 128 * 128 / 8, gtid, gstride);
    }
    SEAM(0);

    for (int l = 0; l < NL; ++l) {
        const int pb = 1 + PH_L * l;
        if (IN(pb + 0) && l == 0) { PHASE_TID(); modnorm_rows(XIN, A->in[4] + l * D, MODL, MO_SH1, MO_SC1, H, gw, NGW, lane, XR); }
        if (l == 0) SEAM(pb + 0);
        if (IN(pb + 1)) {
            PHASE_TID(); (void)tid;
            pg8::Gemm g{H, WIN_T + (size_t)l * IN_W * D, M, IN_W, D}; pg8::StaticOrder S; S.init(M, IN_W, G, bx);
            pg8::EpiBf16<0> E{Z, IN_W, nullptr, 0, 0};
            pg8::gemm_phase<pg8::EpiBf16<0>, pg8::StaticOrder, false>((PG8_LAS unsigned char*)lds, g, S, E, nullptr, wave0);
        }
        SEAM(pb + 1);
        if (IN(pb + 2)) {
            PHASE_TID();
            for (int it = vcu; it < 2 * 64 * 6; it += G) {
                const int b = it / 384, r = it % 384, j = r / 6, n = r % 6;
                lru_item2(l, b, j, n, Z, A->in[7], A->in[8], WG_T, A->in[10], A->in[12], A->in[13], HLOC, PP, SUMA, SUMB,
                          (LAS float*)lds, (LAS float*)(lds + 34816), (LAS float*)(lds + 69632), tid);
            }
            {
                {
                    LAS unsigned char* wl = lds + wave * ATT_WLDS;
                    for (int it = gw; it < 1024 + 4608; it += NGW) {
                        if (it < 1024) { const int bh = it >> 7, tl = 127 - (it & 127); sb_mfma_item(bh >> 2, bh & 3, 32 * tl, Z, YC, wl, lane); }
                        else { const int i2 = it - 1024; const int tl = i2 & 127, p = (i2 >> 7) % 3, bh = i2 / 384; const int d = 1 << (2 * p);
                            dil_mfma_item(bh / 6, bh % 6, p, tl % d, 32 * (tl / d), Z, A->in[14], PARTB, LSEB, wl, lane); }
                    }
                }
            }
        }
        SEAM(pb + 2);
        if (IN(pb + 3)) {
            PHASE_TID();
            for (int it = vcu; it < 256; it += G) { const int b = it >> 7, j = (it >> 1) & 63, half = it & 1;
                combine_item(l, b, j, half, Z, HLOC, PP, SUMA, SUMB, PARTB, LSEB, YC, A->in[15], A->in[16], A->in[17], H, (LAS float*)lds, tid); }
        }
        SEAM(pb + 3);
        if (IN(pb + 4)) {
            PHASE_TID(); (void)tid;
            pg8::Gemm g{H, WOUT_T + (size_t)l * D * D, M, D, D}; pg8::StaticOrder S; S.init(M, D, G, bx);
            EpiResGate E{XRES, X1H, MODL + MO_G1, 1.f};
            pg8::gemm_phase<EpiResGate, pg8::StaticOrder, false>((PG8_LAS unsigned char*)lds, g, S, E, nullptr, wave0);
        }
        SEAM(pb + 4);
        if (IN(pb + 5)) { PHASE_TID(); modnorm_rows_h(X1H, A->in[5] + l * D, MODL, MO_SH2, MO_SC2, H, gw, NGW, lane); }
        SEAM(pb + 5);
        if (IN(pb + 6)) {
            PHASE_TID(); (void)tid;
            pg8::Gemm g{H, WQ_T + (size_t)l * D * D, M, D, D}; pg8::StaticOrder S; S.init(M, D, G, bx);
            pg8::EpiBf16<0> E{QB, D, nullptr, 0, 0};
            pg8::gemm_phase<pg8::EpiBf16<0>, pg8::StaticOrder, false>((PG8_LAS unsigned char*)lds, g, S, E, nullptr, wave0);
        }
        SEAM(pb + 6);
        if (IN(pb + 7)) {
            PHASE_TID();
            for (int it = vcu; it < 128 * 8; it += G) route_item2(l, it >> 3, it & 7, QB, SUBK, IDS, GG, lds, tid, l * 1024 + it + 1, A->in[21] + (size_t)l * NEXP * D, A->in[22] + (size_t)l * NEXP * D,
                                                                                      (unsigned char*)UB + (size_t)l * NEXP * D, (unsigned char*)VB + (size_t)l * NEXP * D);
        }
        SEAM(pb + 7);
        if (IN(pb + 8)) {
            PHASE_TID();
            LAS int* claimL = (LAS int*)(lds + LDS_MISC + 192);
            const int s0 = 2 * (int)xb_xcc_id();
            for (int ds = 0; ds < 16; ++ds) { const int s = (s0 + ds) & 15;
                unsigned* cnt = (unsigned*)(A->ws + WS_CTL) + 45056 + ((l * 2 + 0) * 16 + s) * 64;
                for (;;) { const int c = claim_unit(cnt, claimL, wave0); if (c >= M / 64) break;
                    exu_unit<8>(s, c * 64 + wave * 8, H, IDS, (const unsigned char*)UB + (size_t)l * NEXP * D, PDOT, lane); } }
        }
        SEAM(pb + 8);
        if (IN(pb + 9)) {
            PHASE_TID();
            for (int o = vcu * 512 + tid; o < M * 128; o += G * 512) { float d = 0.f;
#pragma unroll
                for (int sl = 0; sl < 16; ++sl) d += PDOT[(size_t)sl * M * 128 + o];
                WEXP[o] = GG[o] * gelu_tanh(d * (1.f / U8_SCALE)); }
        }
        SEAM(pb + 9);
        if (IN(pb + 10)) {
            PHASE_TID();
            LAS int* claimL = (LAS int*)(lds + LDS_MISC + 192);
            const int s0 = 2 * (int)xb_xcc_id();
            for (int ds = 0; ds < 16; ++ds) { const int s = (s0 + ds) & 15;
                unsigned* cnt = (unsigned*)(A->ws + WS_CTL) + 45056 + ((l * 2 + 1) * 16 + s) * 64;
                for (;;) { const int c = claim_unit(cnt, claimL, wave0); if (c >= M / 64) break;
                    exv_unit<8>(s, c * 64 + wave * 8, IDS, WEXP, (const unsigned char*)VB + (size_t)l * NEXP * D, X1H, MODL + MO_G2, X2H, lane); } }
        }
        SEAM(pb + 10);
        if (IN(pb + 11)) {
            PHASE_TID();
            if (l + 1 < NL) modnorm_rows_h(X2H, A->in[4] + (l + 1) * D, mod + (size_t)(l + 1) * 2 * MODW, MO_SH1, MO_SC1, H, gw, NGW, lane);
            else finalnorm_rows(X2H, A->in[23], A->out, gw, NGW, lane);
        }
        if (l + 1 < NL) SEAM(pb + 11);
    }
#undef IN
#undef SEAM
#undef mod
#undef H
#undef Z
#undef X1
#undef X2
}
}

extern "C" void kernel_launch(void* const* d_in, const int* in_sizes, int n_in, void* d_out, int out_size, void* d_ws, size_t ws_size, hipStream_t stream) {
    using namespace mk;
    static int grid = 0;
    if (grid == 0) {
        if (n_in != 24 || out_size != M * D || ws_size < WS_END) { fprintf(stderr, "kernel_launch: unexpected shapes (n_in %d out %d ws %zu)\n", n_in, out_size, ws_size); grid = -1; return; }
        int dev = 0, cus = 0, per_cu = 0;
        if (hipGetDevice(&dev) != hipSuccess || hipDeviceGetAttribute(&cus, hipDeviceAttributeMultiprocessorCount, dev) != hipSuccess) { grid = -1; return; }
        if (hipFuncSetAttribute((const void*)fwd, hipFuncAttributeMaxDynamicSharedMemorySize, LDS_BYTES) != hipSuccess) { fprintf(stderr, "kernel_launch: hipFuncSetAttribute failed\n"); grid = -1; return; }
        if (hipOccupancyMaxActiveBlocksPerMultiprocessor(&per_cu, (const void*)fwd, 512, LDS_BYTES) != hipSuccess || per_cu < 1) fprintf(stderr, "kernel_launch: occupancy query says %d\n", per_cu);
        (void)hipGetLastError();
        grid = cus;
    }
    if (grid < 0) return;
    (void)hipMemsetAsync((char*)d_ws + WS_CTL, 0, CTL_ZERO_BYTES, stream);
    Args a{};
    for (int i = 0; i < 24; ++i) a.in[i] = (const float*)d_in[i];
    a.out = (float*)d_out; a.ws = (unsigned char*)d_ws; a.pad = 0;
    constexpr int NLAUNCH = MK_N_LAUNCHES;
    for (int li = 0; li < NLAUNCH; ++li) {
        a.ph_lo = (NLAUNCH == 1) ? 0 : li; a.ph_hi = (NLAUNCH == 1) ? NPHASE : li + 1; a.li = li;
        hipLaunchKernelGGL(fwd, dim3(grid), dim3(512), LDS_BYTES, stream, a);
    }
}
```

```cpp
#include <hip/hip_runtime.h>
#include <cstdio>
#include <cstdint>
namespace pg8 {
#define PG8_LAS __attribute__((address_space(3)))
typedef unsigned short bf16_t;
typedef short bf16x8 __attribute__((ext_vector_type(8)));
typedef float f32x4 __attribute__((ext_vector_type(4)));
typedef unsigned u32x4 __attribute__((ext_vector_type(4)));
constexpr int BM = 256, BK = 64, HALF = 128, HTB = HALF * BK * 2  , STAGE_BYTES = 8 * HTB, NXCD = 8, WGM = 8;

__host__ __device__ __forceinline__ int lds_byte(int r, int c) { const int st = (r >> 4) * 2 + (c >> 5), rr = r & 15, cc = c & 31, ob = rr * 64 + cc * 2; return st * 1024 + (ob ^ (((ob >> 9) & 1) << 5)); }
__host__ __device__ __forceinline__ void stage_rc(int b, int& R, int& C) { const int st = b / 1024, sb = b % 1024, swz = sb ^ (((sb >> 9) & 1) << 5); R = (st >> 1) * 16 + swz / 64; C = (st & 1) * 32 + (swz % 64) / 2; }
__host__ __device__ __forceinline__ int perm32(int rho) { const int n = rho >> 4, i = rho & 15; return 8 * (i >> 2) + 4 * n + (i & 3); }

struct Unit { int pm, pn; };
struct Gemm { const bf16_t* A; const bf16_t* Bt; int M, N, K; };

struct StaticOrder {
    int nM, nN, nwg, G, c;
    __host__ __device__ void init(int M, int N, int G_, int c_) { nM = M / BM; nN = N / BM; nwg = nM * nN; G = G_; c = c_; }
    __host__ __device__ bool next(int i, Unit& u) const {
        const long L = (long)i * G + c; if (L >= nwg) return false;
        int wgid = (int)L; { const int q = nwg / NXCD, r = nwg % NXCD, xcd = wgid % NXCD, off = wgid / NXCD; wgid = (xcd < r ? xcd * (q + 1) : r * (q + 1) + (xcd - r) * q) + off; }
        const int nig = WGM * nN, gid = wgid / nig, fm = gid * WGM, gsz = (nM - fm) < WGM ? (nM - fm) : WGM;
        u.pm = fm + ((wgid % nig) % gsz); u.pn = (wgid % nig) / gsz; return true;
    }
    __device__ __forceinline__ void a_ready(const Unit&) const {}
    __device__ __forceinline__ void done(const Unit&) const {}
};
struct CountedOrder : StaticOrder {
    const unsigned* ready; unsigned need; unsigned* tmo;
    __device__ __forceinline__ void a_ready(const Unit& u) const {
        if (threadIdx.x < 64) {
            const unsigned long long t0 = __builtin_amdgcn_s_memrealtime(); unsigned polls = 0;
            while ((unsigned)__builtin_amdgcn_readfirstlane(__hip_atomic_load(ready + 64 * u.pm, __ATOMIC_RELAXED, __HIP_MEMORY_SCOPE_AGENT)) < need) {
                if ((++polls & 255u) == 0u && __builtin_amdgcn_readfirstlane(__hip_atomic_load(tmo, __ATOMIC_RELAXED, __HIP_MEMORY_SCOPE_AGENT)) != 0u) break;
                if (__builtin_amdgcn_s_memrealtime() - t0 > 2000000ull) {
                    if (threadIdx.x == 0) { unsigned expect = 0u; __hip_atomic_compare_exchange_strong(tmo + 1, &expect, 0x600u | (unsigned)(u.pm & 0xff), __ATOMIC_RELAXED, __ATOMIC_RELAXED, __HIP_MEMORY_SCOPE_AGENT); __hip_atomic_store(tmo, 1u, __ATOMIC_RELAXED, __HIP_MEMORY_SCOPE_AGENT); }
                    break; }
                __builtin_amdgcn_s_sleep(2); }
            __builtin_amdgcn_fence(__ATOMIC_ACQUIRE, "agent");
            asm volatile("s_waitcnt vmcnt(0)" ::: "memory");
        }
#if !defined(BROKEN_HOOK_NO_BARRIER)
        asm volatile("" ::: "memory"); __builtin_amdgcn_s_barrier(); asm volatile("" ::: "memory");
#endif
    }
};

__device__ __forceinline__ unsigned cvt_pk_bf16(float lo, float hi) { unsigned r; asm volatile("v_cvt_pk_bf16_f32 %0, %1, %2" : "=v"(r) : "v"(lo), "v"(hi)); return r; }
typedef float f32x2 __attribute__((ext_vector_type(2)));
__device__ __forceinline__ f32x2 gelu_pk(f32x2 v) {
    const f32x2 av = __builtin_elementwise_abs(v), d = av * 0.2316418882f + 1.0f;
    f32x2 t; t.x = __builtin_amdgcn_rcpf(d.x); t.y = __builtin_amdgcn_rcpf(d.y);
    f32x2 q = t * 0.5307027145f + (-0.7265760135f); q = q * t + 0.7107068705f; q = q * t + (-0.142248368f); q = q * t + 0.127414796f; q = q * t;
    const f32x2 s = (v * v) * (-0.72134752044f);
    f32x2 e; e.x = __builtin_amdgcn_exp2f(s.x); e.y = __builtin_amdgcn_exp2f(s.y);
    const f32x2 m = v * (q * e), r = v - m;
    f32x2 o; o.x = v.x < 0.f ? m.x : r.x; o.y = v.y < 0.f ? m.y : r.y; return o;
}

struct EpiF32 {
    static constexpr bool PERM = false, AFTER_DRAIN = false;
    float* C; int ldc; const float* bias;
    __device__ __forceinline__ void operator()(const f32x4 (&acc)[2][2][4][2], const Unit& u, int wr, int wc, int fr, int fq) const {
        const int row0 = u.pm * BM + wr * 64 + fr, col0 = u.pn * BM + wc * 32 + 4 * fq;
        f32x4 bv[2][2];
#pragma unroll
        for (int bj = 0; bj < 2; ++bj)
#pragma unroll
            for (int n = 0; n < 2; ++n) bv[bj][n] = bias ? *(const f32x4*)(bias + col0 + bj * HALF + n * 16) : (f32x4){0.f, 0.f, 0.f, 0.f};
#pragma unroll
        for (int ai = 0; ai < 2; ++ai)
#pragma unroll
            for (int m = 0; m < 4; ++m) { float* rowp = C + (size_t)(row0 + ai * HALF + m * 16) * ldc + col0;
#pragma unroll
                for (int bj = 0; bj < 2; ++bj)
#pragma unroll
                    for (int n = 0; n < 2; ++n) *(f32x4*)(rowp + bj * HALF + n * 16) = acc[ai][bj][m][n] + bv[bj][n]; }
    }
};
template <int ACT  > struct EpiBf16 {
    static constexpr bool PERM = true, AFTER_DRAIN = false;
    bf16_t* O; int ldc; const float* bias; int split_cols; size_t split_stride;
    __device__ __forceinline__ void operator()(const f32x4 (&acc)[2][2][4][2], const Unit& u, int wr, int wc, int fr, int fq) const {
        const int row0 = u.pm * BM + wr * 64 + fr; int colt = u.pn * BM; bf16_t* base = O;
        if (split_cols) { const int t = colt / split_cols; base += (size_t)t * split_stride; colt -= t * split_cols; }
        const int col0 = colt + wc * 32 + 8 * fq, bcol0 = u.pn * BM + wc * 32 + 8 * fq;
        f32x4 bv[2][2];
#pragma unroll
        for (int bj = 0; bj < 2; ++bj)
#pragma unroll
            for (int n = 0; n < 2; ++n) bv[bj][n] = bias ? *(const f32x4*)(bias + bcol0 + bj * HALF + 4 * n) : (f32x4){0.f, 0.f, 0.f, 0.f};
#pragma unroll
        for (int ai = 0; ai < 2; ++ai)
#pragma unroll
            for (int m = 0; m < 4; ++m) { bf16_t* rowp = base + (size_t)(row0 + ai * HALF + m * 16) * ldc + col0;
#pragma unroll
                for (int bj = 0; bj < 2; ++bj) { f32x4 v0 = acc[ai][bj][m][0] + bv[bj][0], v1 = acc[ai][bj][m][1] + bv[bj][1];
                    if (ACT == 1) { f32x2 a = gelu_pk((f32x2){v0[0], v0[1]}), b = gelu_pk((f32x2){v0[2], v0[3]}), c = gelu_pk((f32x2){v1[0], v1[1]}), d = gelu_pk((f32x2){v1[2], v1[3]});
                        v0 = (f32x4){a.x, a.y, b.x, b.y}; v1 = (f32x4){c.x, c.y, d.x, d.y}; }
                    if (ACT == 2) {
#pragma unroll
                        for (int j = 0; j < 4; ++j) { v0[j] = 0.5f * v0[j] * (1.0f + erff(v0[j] * 0.70710678f)); v1[j] = 0.5f * v1[j] * (1.0f + erff(v1[j] * 0.70710678f)); } }
                    u32x4 w; w.x = cvt_pk_bf16(v0[0], v0[1]); w.y = cvt_pk_bf16(v0[2], v0[3]); w.z = cvt_pk_bf16(v1[0], v1[1]); w.w = cvt_pk_bf16(v1[2], v1[3]);
                    *(u32x4*)(rowp + bj * HALF) = w; } }
    }
};
template <class Epi, class Sched, bool STAMP = false>
__device__ __forceinline__ void gemm_phase(PG8_LAS unsigned char* lds, const Gemm g, const Sched& S, const Epi& E, unsigned long long* stamps, int wave_id) {
    unsigned zz_o = 0u; asm volatile("" : "+v"(zz_o)); int tid_o = wave_id * 64 + (int)__builtin_amdgcn_mbcnt_hi(~0u, __builtin_amdgcn_mbcnt_lo(~0u, zz_o));
    const int tid = tid_o, wid = __builtin_amdgcn_readfirstlane(tid >> 6), lane = tid & 63, wr = wid >> 2, wc = wid & 3, fr = lane & 15, fq = lane >> 4;
    constexpr int K = 2048, nt = K / BK;
    int ts_lo = 0, ts_hi = 0, nts = 0; const unsigned long long rt_entry = STAMP ? (unsigned long long)wall_clock64() : 0ull;
#define PG8_STAMP() do { if (STAMP && wid == 0 && nts < 64) { const unsigned long long _c = (unsigned long long)clock64(); \
        ts_lo = (lane == nts) ? (int)(unsigned)_c : ts_lo; ts_hi = (lane == nts) ? (int)(unsigned)(_c >> 32) : ts_hi; ++nts; } } while (0)
    PG8_STAMP();
    unsigned voffA[2], voffB[2];
#pragma unroll
    for (int i = 0; i < 2; ++i) { int R, C; stage_rc(tid * 16 + i * 8192, R, C); const int Rb = Epi::PERM ? ((R & ~31) + perm32(R & 31)) : R;
        voffA[i] = (unsigned)(R * K + C) * 2u; voffB[i] = (unsigned)(Rb * K + C) * 2u; }
    const size_t kstep = (size_t)(BK * 2);
    const size_t hstep = (size_t)HALF * K * 2;
    const size_t tstep = 2 * hstep;
    const unsigned ldsw = (unsigned)wid * 1024u;
    const int aoff = lds_byte(wr * 64 + fr, fq * 8), boff = lds_byte(wc * 32 + fr, fq * 8);
#define PG8_SA(b, h) (((b) * 2 + (h)) * HTB)
#define PG8_SB(b, h) ((4 + (b) * 2 + (h)) * HTB)
#define PG8_STAGE(bufoff, gbase, voff) do { _Pragma("unroll") for (int _i = 0; _i < 2; ++_i) \
        __builtin_amdgcn_global_load_lds((const unsigned*)((const char*)(gbase) + (voff)[_i]), (PG8_LAS unsigned*)(lds + (bufoff) + ldsw + _i * 8192), 16, 0, 0); } while (0)
#define PG8_LDA(dst, b, h) do { _Pragma("unroll") for (int m = 0; m < 4; ++m) _Pragma("unroll") for (int k = 0; k < 2; ++k) dst[m][k] = *(const PG8_LAS bf16x8*)(lds + PG8_SA(b, h) + aoff + m * 2048 + k * 1024); } while (0)
#define PG8_LDB(dst, b, h) do { _Pragma("unroll") for (int n = 0; n < 2; ++n) _Pragma("unroll") for (int k = 0; k < 2; ++k) dst[n][k] = *(const PG8_LAS bf16x8*)(lds + PG8_SB(b, h) + boff + n * 2048 + k * 1024); } while (0)
#define PG8_MMA(ai, bj, At, Bt) do { __builtin_amdgcn_s_setprio(1); _Pragma("unroll") for (int m = 0; m < 4; ++m) _Pragma("unroll") for (int n = 0; n < 2; ++n) _Pragma("unroll") for (int k = 0; k < 2; ++k) \
        acc[ai][bj][m][n] = __builtin_amdgcn_mfma_f32_16x16x32_bf16(Bt[n][k], At[m][k], acc[ai][bj][m][n], 0, 0, 0); __builtin_amdgcn_s_setprio(0); } while (0)
#define PG8_WAIT_V(n) asm volatile("s_waitcnt vmcnt(" #n ")" ::: "memory")
#define PG8_WAIT_L(n) asm volatile("s_waitcnt lgkmcnt(" #n ")" ::: "memory")
#define PG8_BAR __builtin_amdgcn_s_barrier()
#define PG8_SCHED __builtin_amdgcn_sched_barrier(0)
    Unit cur, nxt; int ui = 0;
    if (!S.next(0, cur)) return;
    f32x4 acc[2][2][4][2];
#pragma unroll
    for (int a = 0; a < 2; ++a)
#pragma unroll
        for (int b = 0; b < 2; ++b)
#pragma unroll
            for (int m = 0; m < 4; ++m)
#pragma unroll
                for (int n = 0; n < 2; ++n) acc[a][b][m][n] = (f32x4){0.f, 0.f, 0.f, 0.f};
    bf16x8 At[4][2], B0[2][2], B1[2][2];
    const char* cA = (const char*)g.A + (size_t)cur.pm * tstep; const char* cB = (const char*)g.Bt + (size_t)cur.pn * tstep;
    S.a_ready(cur);
    PG8_STAGE(PG8_SB(0, 0), cB, voffB); PG8_STAGE(PG8_SA(0, 0), cA, voffA); PG8_STAGE(PG8_SB(0, 1), cB + hstep, voffB); PG8_STAGE(PG8_SA(0, 1), cA + hstep, voffA);
    if (wr == 1) PG8_BAR;
    PG8_WAIT_V(4); PG8_BAR;
    PG8_STAGE(PG8_SB(1, 0), cB + kstep, voffB); PG8_STAGE(PG8_SA(1, 0), cA + kstep, voffA); PG8_STAGE(PG8_SB(1, 1), cB + hstep + kstep, voffB);
    PG8_WAIT_V(6); PG8_BAR;
    PG8_STAMP();
    for (;;) {
        const bool has_next = S.next(ui + 1, nxt);
        const char* nA = has_next ? (const char*)g.A + (size_t)nxt.pm * tstep : cA; const char* nB = has_next ? (const char*)g.Bt + (size_t)nxt.pn * tstep : cB;
        for (int t = 0; t < nt; t += 2) {
            const bool last = (t == nt - 2);
            const char* a1 = cA + (size_t)(t + 1) * kstep;
            const char* a2 = last ? nA : cA + (size_t)(t + 2) * kstep; const char* b2 = last ? nB : cB + (size_t)(t + 2) * kstep;
            const char* a3 = a2 + kstep; const char* b3 = b2 + kstep;
            if (last && has_next) S.a_ready(nxt);
            PG8_LDB(B0, 0, 0); PG8_SCHED; PG8_LDA(At, 0, 0); PG8_STAGE(PG8_SA(1, 1), a1 + hstep, voffA);
            PG8_WAIT_L(8); PG8_BAR; PG8_WAIT_L(0); PG8_MMA(0, 0, At, B0); PG8_BAR; PG8_SCHED;
            PG8_LDB(B1, 0, 1); PG8_STAGE(PG8_SB(0, 0), b2, voffB);
            PG8_BAR; PG8_WAIT_L(0); PG8_MMA(0, 1, At, B1); PG8_BAR;
            PG8_LDA(At, 0, 1); PG8_STAGE(PG8_SA(0, 0), a2, voffA);
            PG8_BAR; PG8_WAIT_L(0); PG8_MMA(1, 0, At, B0); PG8_BAR; PG8_SCHED;
            PG8_STAGE(PG8_SB(0, 1), b2 + hstep, voffB);
            PG8_WAIT_V(6); PG8_BAR; PG8_MMA(1, 1, At, B1); PG8_BAR;
            PG8_LDB(B0, 1, 0); PG8_SCHED; PG8_LDA(At, 1, 0); PG8_STAGE(PG8_SA(0, 1), a2 + hstep, voffA);
            PG8_WAIT_L(8); PG8_BAR; PG8_WAIT_L(0); PG8_MMA(0, 0, At, B0); PG8_BAR; PG8_SCHED;
            PG8_LDB(B1, 1, 1); PG8_STAGE(PG8_SB(1, 0), b3, voffB);
            PG8_BAR; PG8_WAIT_L(0); PG8_MMA(0, 1, At, B1); PG8_BAR;
            PG8_LDA(At, 1, 1); PG8_STAGE(PG8_SA(1, 0), a3, voffA);
            PG8_BAR; PG8_WAIT_L(0); PG8_MMA(1, 0, At, B0); PG8_BAR; PG8_SCHED;
            PG8_STAGE(PG8_SB(1, 1), b3 + hstep, voffB);
            PG8_WAIT_V(6); PG8_BAR; PG8_MMA(1, 1, At, B1); PG8_BAR;
        }
        PG8_STAMP();
        if constexpr (!Epi::AFTER_DRAIN) { E(acc, cur, wr, wc, fr, fq); S.done(cur); }
        PG8_STAMP();
        if (!has_next) break;
#pragma unroll
        for (int a = 0; a < 2; ++a)
#pragma unroll
            for (int b = 0; b < 2; ++b)
#pragma unroll
                for (int m = 0; m < 4; ++m)
#pragma unroll
                    for (int n = 0; n < 2; ++n) acc[a][b][m][n] = (f32x4){0.f, 0.f, 0.f, 0.f};
        cur = nxt; cA = nA; cB = nB; ++ui;
    }
    PG8_WAIT_V(0);
    if (wr == 0) PG8_BAR;
    PG8_BAR;
    if constexpr (Epi::AFTER_DRAIN) { E.fused(acc, cur, wr, wc, fr, fq, lds, wid, lane); S.done(cur); }
    PG8_STAMP();
    if (STAMP && wid == 0) { stamps[lane] = lane < nts ? (((unsigned long long)(unsigned)ts_hi << 32) | (unsigned)ts_lo) : 0ull;
        if (lane == 62) stamps[62] = rt_entry; if (lane == 63) stamps[63] = (unsigned long long)wall_clock64(); }
#undef PG8_STAMP
#undef PG8_SA
#undef PG8_SB
#undef PG8_STAGE
#undef PG8_LDA
#undef PG8_LDB
#undef PG8_MMA
#undef PG8_WAIT_V
#undef PG8_WAIT_L
#undef PG8_BAR
#undef PG8_SCHED
}
}

namespace mk {
#define GAS __attribute__((address_space(1)))
#define LAS __attribute__((address_space(3)))
#define DEV __device__ __forceinline__
typedef unsigned short bf16;
typedef unsigned v4u __attribute__((ext_vector_type(4)));
typedef float f32x4 __attribute__((ext_vector_type(4)));
typedef float f32x2 __attribute__((ext_vector_type(2)));
typedef short bf16x8 __attribute__((ext_vector_type(8)));
typedef float f32x16 __attribute__((ext_vector_type(16)));
typedef __bf16 bf16x2_t __attribute__((ext_vector_type(2)));

#ifndef MK_N_LAUNCHES
#define MK_N_LAUNCHES 1
#endif

constexpr int D = 2048, SEQ = 4096, M = 8192, NL = 2;
constexpr int LRU_W = 768, SWA_W = 768, SB_W = 512, IN_W = 5376;
constexpr int ZO_XA = 0, ZO_GA = 768, ZO_QB = 1536, ZO_KB = 2304, ZO_VB = 3072, ZO_QC = 3840, ZO_KC = 4352, ZO_VC = 4864;
constexpr int NEXP = 16384, MODW = 12288;
constexpr int MO_SH1 = 0, MO_SC1 = 2048, MO_G1 = 4096, MO_SH2 = 6144, MO_SC2 = 8192, MO_G2 = 10240;
constexpr float EPS = 1e-6f;
constexpr float QSCALE = 0.08838834764831845f;
constexpr float NEGBIG = -3.0e38f;
constexpr int PH_L = 12;
constexpr int NPHASE = 1 + 2 * PH_L;

constexpr size_t MiB = 1u << 20;
constexpr size_t WS_CTL = 0, CTL_ZERO_BYTES = 1 * MiB;
constexpr size_t WS_MOD = 512 * 1024;
constexpr size_t WS_WIN_T = 2 * MiB, WS_WOUT_T = 44 * MiB, WS_WQ_T = 60 * MiB, WS_SUBK = 76 * MiB, WS_U = 80 * MiB, WS_V = 208 * MiB,
                 WS_H = 336 * MiB, WS_Z = 368 * MiB, WS_HLOC = 452 * MiB, WS_P = 476 * MiB, WS_YB = 500 * MiB, WS_YC = 524 * MiB,
                 WS_SUMA = 540 * MiB, WS_SUMB = 541 * MiB, WS_X1 = 544 * MiB, WS_X2 = 608 * MiB, WS_Q = 672 * MiB, WS_IDS = 704 * MiB,
                 WS_G = 708 * MiB, WS_WG_T = 77 * MiB, WS_PART = 712 * MiB, WS_LSE = 784 * MiB, WS_XR = 786 * MiB, WS_PDOT = 820 * MiB, WS_WEXP = 888 * MiB, WS_SCL = 892 * MiB  , WS_END = 893 * MiB;
constexpr int CW_BAR = 4096;

constexpr int LDS_BYTES = 147456;
constexpr int LDS_MISC = 143360;

__device__ const unsigned char T5B[3][132] = {
 {0,1,2,3,4,5,6,7,8,9,10,11,12,13,14,15,16,16,16,16,16,16,17,17,17,17,17,17,17,17,18,18,18,18,18,18,18,18,18,18,19,19,19,19,19,19,19,19,19,19,19,19,19,19,20,20,20,20,20,20,20,20,20,20,20,20,20,20,20,20,20,20,20,21,21,21,21,21,21,21,21,21,21,21,21,21,21,21,21,21,21,21,21,21,21,21,21,21,21,22,22,22,22,22,22,22,22,22,22,22,22,22,22,22,22,22,22,22,22,22,22,22,22,22,22,22,22,22,22,0,0,0},
 {0,4,8,12,16,16,17,17,18,18,19,19,19,19,20,20,20,20,20,21,21,21,21,21,21,22,22,22,22,22,22,22,22,22,23,23,23,23,23,23,23,23,23,23,23,23,24,24,24,24,24,24,24,24,24,24,24,24,24,24,24,24,25,25,25,25,25,25,25,25,25,25,25,25,25,25,25,25,25,25,25,25,25,26,26,26,26,26,26,26,26,26,26,26,26,26,26,26,26,26,26,26,26,26,26,26,26,26,26,26,26,26,26,27,27,27,27,27,27,27,27,27,27,27,27,27,27,27,27,0,0,0},
 {0,16,18,19,20,21,21,22,22,23,23,23,24,24,24,24,25,25,25,25,25,26,26,26,26,26,26,26,26,27,27,27,27,27,27,27,27,27,27,28,28,28,28,28,28,28,28,28,28,28,28,28,29,29,29,29,29,29,29,29,29,29,29,29,29,29,29,29,29,29,30,30,30,30,30,30,30,30,30,30,30,30,30,30,30,30,30,30,30,30,30,30,30,30,30,31,31,31,31,31,31,31,31,31,31,31,31,31,31,31,31,31,31,31,31,31,31,31,31,31,31,31,31,31,31,31,31,31,31,0,0,0}};

#define LDS_WAIT() asm volatile("s_waitcnt lgkmcnt(0)" ::: "memory")
DEV unsigned f2bf(float f) { unsigned u = __builtin_bit_cast(unsigned, f); return (u + 0x7fffu + ((u >> 16) & 1u)) >> 16; }
DEV unsigned pk2(float lo, float hi) { return f2bf(lo) | (f2bf(hi) << 16); }
DEV float bf_lo(unsigned w) { return __builtin_bit_cast(float, w << 16); }
DEV float bf_hi(unsigned w) { return __builtin_bit_cast(float, w & 0xffff0000u); }
DEV float bf1(bf16 h) { return __builtin_bit_cast(float, ((unsigned)h) << 16); }
template <int MSK> DEV float swz_xor(float v) { return __builtin_bit_cast(float, __builtin_amdgcn_ds_swizzle(__builtin_bit_cast(int, v), (MSK << 10) | 0x1F)); }
DEV float part32_(float v) { int ln = (int)__builtin_amdgcn_mbcnt_hi(~0u, __builtin_amdgcn_mbcnt_lo(~0u, 0u)); asm volatile("" : "+v"(ln)); return __builtin_bit_cast(float, __builtin_amdgcn_ds_bpermute((ln ^ 32) << 2, __builtin_bit_cast(int, v))); }
DEV float sum32(float v) { return v + part32_(v); }
DEV float max32(float v) { return fmaxf(v, part32_(v)); }
DEV float partner32(float v, int hh) { (void)hh; return part32_(v); }
DEV float wave_sum(float v) { v += swz_xor<1>(v); v += swz_xor<2>(v); v += swz_xor<4>(v); v += swz_xor<8>(v); v += swz_xor<16>(v); return sum32(v); }
DEV float wave_max(float v) { v = fmaxf(v, swz_xor<1>(v)); v = fmaxf(v, swz_xor<2>(v)); v = fmaxf(v, swz_xor<4>(v)); v = fmaxf(v, swz_xor<8>(v)); v = fmaxf(v, swz_xor<16>(v)); return max32(v); }
DEV float sigmoid_f(float x) { return 1.f / (1.f + __expf(-x)); }
DEV float softplus_f(float x) { return fmaxf(x, 0.f) + log1pf(__expf(-fabsf(x))); }
DEV float gelu_tanh(float x) { const float u = 0.7978845608028654f * (x + 0.044715f * x * x * x); const float t = 1.f - 2.f / (1.f + __expf(2.f * u)); return 0.5f * x * (1.f + t); }
DEV float dot8(const v4u a, const v4u b) {
    float s = bf_lo(a.x) * bf_lo(b.x); s += bf_hi(a.x) * bf_hi(b.x);
    s += bf_lo(a.y) * bf_lo(b.y); s += bf_hi(a.y) * bf_hi(b.y);
    s += bf_lo(a.z) * bf_lo(b.z); s += bf_hi(a.z) * bf_hi(b.z);
    s += bf_lo(a.w) * bf_lo(b.w); s += bf_hi(a.w) * bf_hi(b.w);
    return s;
}

#define XB_TMO      128
#define XB_XCNT(j)  (256  + 64 * (j))
#define XB_XSUB(j)  (1280 + 64 * (j))
#define XB_XGEN(j)  (2304 + 64 * (j))
#define XB_TOP      3328
#define XB_TOPGEN   3392
#define XCD_BAR_WORDS 3456
#define XB_SPIN_CAP (1u << 18)

__device__ __forceinline__ unsigned xb_ld(unsigned* p)              { return __hip_atomic_load(p, __ATOMIC_RELAXED, __HIP_MEMORY_SCOPE_AGENT); }
__device__ __forceinline__ unsigned xb_add(unsigned* p, unsigned v) { return __hip_atomic_fetch_add(p, v, __ATOMIC_RELAXED, __HIP_MEMORY_SCOPE_AGENT); }
__device__ __forceinline__ unsigned xb_xcc_id() { return (unsigned)__builtin_amdgcn_s_getreg((3 << 11) | 20) & 0xFu; }
#define XB_SPIN(cond, bar) do { unsigned _sp = 0; while (cond) { __builtin_amdgcn_s_sleep(1); \
    if ((++_sp & 255u) == 0u) { if (xb_ld(&(bar)[XB_TMO])) break; if (_sp > XB_SPIN_CAP) { atomicAdd(&(bar)[XB_TMO], 1u); break; } } } } while (0)

struct XcdBarrier {
    unsigned* bar; unsigned x;
    volatile LAS unsigned* st;
    int w0;
};
DEV bool xb_lead(int w0) { return w0 == 0 && __builtin_amdgcn_mbcnt_hi(~0u, __builtin_amdgcn_mbcnt_lo(~0u, 0u)) == 0u; }
__device__ __forceinline__ XcdBarrier xcd_barrier_post(unsigned* bar, volatile LAS unsigned* st, int w0) {
    XcdBarrier b; b.bar = bar; b.x = xb_xcc_id(); b.st = st; b.w0 = w0;
    if (xb_lead(w0)) (void)xb_add(&bar[XB_XCNT(b.x)], 1u);
    return b;
}
__device__ __forceinline__ void xcd_barrier_complete(unsigned* bar, unsigned x, unsigned& nloc, unsigned& nx) {
    const unsigned G = gridDim.x * gridDim.y * gridDim.z;
    unsigned sum, cnt, mine, sp = 0u;
    for (;;) {
        sum = 0u; cnt = 0u; mine = 0u;
#pragma unroll
        for (unsigned j = 0; j < 16; ++j) { const unsigned c = xb_ld(&bar[XB_XCNT(j)]); sum += c; cnt += (c > 0u) ? 1u : 0u; mine = (j == x) ? c : mine; }
        if (sum == G) break;
        __builtin_amdgcn_s_sleep(1);
        if ((++sp & 255u) == 0u) { if (xb_ld(&bar[XB_TMO])) break; if (sp > XB_SPIN_CAP) { atomicAdd(&bar[XB_TMO], 1u); break; } }
    }
    nloc = mine > 0u ? mine : 1u; nx = cnt > 0u ? cnt : 1u;
}
__device__ __forceinline__ void xcd_barrier(const XcdBarrier& b) {
    asm volatile("s_waitcnt vmcnt(0)" ::: "memory");
    __syncthreads();
    if (xb_lead(b.w0)) {
        unsigned* bar = b.bar;
        __builtin_amdgcn_s_waitcnt(0);
        unsigned nloc = b.st[0], nx = b.st[1];
        if (nloc == 0u) { xcd_barrier_complete(bar, b.x, nloc, nx); b.st[0] = nloc; b.st[1] = nx; }
        const unsigned old = xb_add(&bar[XB_XSUB(b.x)], 1u);
        const unsigned gen = old / nloc;
        if (old + 1u == (gen + 1u) * nloc) {
            __builtin_amdgcn_fence(__ATOMIC_RELEASE, "agent");
            asm volatile("s_waitcnt vmcnt(0)" ::: "memory");
            const unsigned og = xb_add(&bar[XB_TOP], 1u);
            const unsigned tg = og / nx;
            if (og + 1u == (tg + 1u) * nx) xb_add(&bar[XB_TOPGEN], 1u);
            else XB_SPIN(xb_ld(&bar[XB_TOPGEN]) == tg, bar);
            __builtin_amdgcn_fence(__ATOMIC_ACQUIRE, "agent");
            xb_add(&bar[XB_XGEN(b.x)], 1u);
            asm volatile("s_waitcnt vmcnt(0)" ::: "memory");
        } else {
            XB_SPIN(xb_ld(&bar[XB_XGEN(b.x)]) == gen, bar);
            __builtin_amdgcn_fence(__ATOMIC_ACQUIRE, "agent");
            asm volatile("s_waitcnt vmcnt(0)" ::: "memory");
        }
    }
    __syncthreads();
}

struct EpiResGate {
    static constexpr bool PERM = false, AFTER_DRAIN = false;
    const bf16* X; bf16* O; const float* gate; float gscale;
    __device__ __forceinline__ void operator()(const pg8::f32x4 (&acc)[2][2][4][2], const pg8::Unit& u, int wr, int wc, int fr, int fq) const {
        const int row0 = u.pm * 256 + wr * 64 + fr, col0 = u.pn * 256 + wc * 32 + 4 * fq;
        const float* gp = gate + (size_t)((u.pm * 256) >> 12) * MODW;
        pg8::f32x4 gv[2][2];
#pragma unroll
        for (int bj = 0; bj < 2; ++bj)
#pragma unroll
            for (int n = 0; n < 2; ++n) gv[bj][n] = *(const pg8::f32x4*)(gp + col0 + bj * 128 + n * 16) * gscale;
#pragma unroll
        for (int ai = 0; ai < 2; ++ai)
#pragma unroll
            for (int m = 0; m < 4; ++m) {
                const size_t ro = (size_t)(row0 + ai * 128 + m * 16) * D + col0;
#pragma unroll
                for (int bj = 0; bj < 2; ++bj)
#pragma unroll
                    for (int n = 0; n < 2; ++n) {
                        const unsigned long long xw = *(const unsigned long long*)(X + ro + bj * 128 + n * 16);
                        const pg8::f32x4 xv = {bf_lo((unsigned)xw), bf_hi((unsigned)xw), bf_lo((unsigned)(xw >> 32)), bf_hi((unsigned)(xw >> 32))};
                        const pg8::f32x4 ov = xv + gv[bj][n] * acc[ai][bj][m][n];
                        *(unsigned long long*)(O + ro + bj * 128 + n * 16) = (unsigned long long)pk2(ov.x, ov.y) | ((unsigned long long)pk2(ov.z, ov.w) << 32);
                    }
            }
    }
};

DEV void ph_mod(const float* __restrict__ c, const float* __restrict__ w_mod, const float* __restrict__ b_mod, float* __restrict__ mod, LAS float* lds_f, int vcu, int G, int tid) {
    const int lane = tid & 63, wave = tid >> 6;
    LAS float* cs = lds_f;
    LAS float* red = lds_f + 4096;
    for (int i = tid; i < 2 * D; i += 512) { const float v = c[i]; cs[i] = v * sigmoid_f(v); }
    __syncthreads();
    const int cg = lane & 15, rg = lane >> 4;
    for (int it = vcu; it < 2 * 192 * 2; it += G) {
        const int kh = it & 1, cb = (it >> 1) % 192, l = it / 384;
        const int k0 = kh * 1024 + wave * 128;
        const float* W = w_mod + ((size_t)l * D + k0 + rg) * MODW + cb * 64 + cg * 4;
        f32x4 a0 = {0.f, 0.f, 0.f, 0.f}, a1 = {0.f, 0.f, 0.f, 0.f};
#pragma unroll 16
        for (int i = 0; i < 32; ++i) {
            const f32x4 w = *(const f32x4*)(W + (size_t)(4 * i) * MODW);
            const float c0 = cs[k0 + 4 * i + rg], c1 = cs[D + k0 + 4 * i + rg];
            a0 += w * c0; a1 += w * c1;
        }
#pragma unroll
        for (int e = 0; e < 4; ++e) { a0[e] += swz_xor<16>(a0[e]); a0[e] = sum32(a0[e]); a1[e] += swz_xor<16>(a1[e]); a1[e] = sum32(a1[e]); }
        if (lane < 16) { *(LAS f32x4*)(red + (wave * 2 + 0) * 64 + cg * 4) = a0; *(LAS f32x4*)(red + (wave * 2 + 1) * 64 + cg * 4) = a1; }
        __syncthreads();
        if (tid < 128) {
            const int bq = tid >> 6, ln = tid & 63; float sacc = 0.f;
#pragma unroll
            for (int w = 0; w < 8; ++w) sacc += red[(w * 2 + bq) * 64 + ln];
            const int col = cb * 64 + ln;
            if (kh == 0) sacc += b_mod[l * MODW + col];
            atomicAdd(mod + (size_t)(l * 2 + bq) * MODW + col, sacc);
        }
        __syncthreads();
    }
}
DEV void transpose_item(const float* __restrict__ W, int K, int N, bf16* __restrict__ WT, LAS float* scr, int item, int lane) {
    const int nblk = N / 32, kb = item / nblk, nb = item % nblk, k0 = 64 * kb, n0 = 32 * nb;
#pragma unroll 8
    for (int i = 0; i < 32; ++i) { const int kk = 2 * i + (lane >> 5); scr[kk * 33 + (lane & 31)] = W[(size_t)(k0 + kk) * N + n0 + (lane & 31)]; }
    LDS_WAIT();
    const int c = lane & 7;
#pragma unroll
    for (int j = 0; j < 4; ++j) { const int n = (lane >> 3) + 8 * j; const LAS float* s = scr + (8 * c) * 33 + n;
        v4u o; o.x = pk2(s[0 * 33], s[1 * 33]); o.y = pk2(s[2 * 33], s[3 * 33]); o.z = pk2(s[4 * 33], s[5 * 33]); o.w = pk2(s[6 * 33], s[7 * 33]);
        *(v4u*)(WT + (size_t)(n0 + n) * K + k0 + 8 * c) = o; }
    LDS_WAIT();
}

DEV void transpose_item64(const float* __restrict__ W, int K, int N, bf16* __restrict__ WT, LAS float* scr, int item, int lane) {
    const int nblk = N / 64, kb = item / nblk, nb = item % nblk, k0 = 64 * kb, n0 = 64 * nb;
#pragma unroll 8
    for (int i = 0; i < 16; ++i) { const int kk = 4 * i + (lane >> 4), nn = 4 * (lane & 15);
        const f32x4 w = *(const f32x4*)(W + (size_t)(k0 + kk) * N + n0 + nn);
        LAS float* d = scr + kk * 65 + nn; d[0] = w.x; d[1] = w.y; d[2] = w.z; d[3] = w.w; }
    LDS_WAIT();
#pragma unroll
    for (int jj = 0; jj < 8; ++jj) { const int pz = lane + 64 * jj, n = pz >> 3, c = pz & 7; const LAS float* sp = scr + (8 * c) * 65 + n;
        v4u o; o.x = pk2(sp[0 * 65], sp[1 * 65]); o.y = pk2(sp[2 * 65], sp[3 * 65]); o.z = pk2(sp[4 * 65], sp[5 * 65]); o.w = pk2(sp[6 * 65], sp[7 * 65]);
        *(v4u*)(WT + (size_t)(n0 + n) * K + k0 + 8 * c) = o; }
    LDS_WAIT();
}
DEV void convert_copy(const float* __restrict__ src, bf16* __restrict__ dst, size_t ngroups8, size_t gtid, size_t gstride) {
    for (size_t g = gtid; g < ngroups8; g += gstride) {
        const f32x4 a = *(const f32x4*)(src + g * 8), b = *(const f32x4*)(src + g * 8 + 4);
        v4u o; o.x = pk2(a.x, a.y); o.y = pk2(a.z, a.w); o.z = pk2(b.x, b.y); o.w = pk2(b.z, b.w);
        *(v4u*)(dst + g * 8) = o;
    }
}

DEV void modnorm_rows(const float* __restrict__ X, const float* __restrict__ gain, const float* __restrict__ modl, int sh_off, int sc_off, bf16* __restrict__ H, int gw, int NGW, int lane, bf16* __restrict__ XC = nullptr) {
    for (int m = gw; m < M; m += NGW) {
        const int b = m >> 12;
        const f32x4* xr = (const f32x4*)(X + (size_t)m * D) + lane;
        f32x4 v[8]; float s = 0.f;
#pragma unroll
        for (int j = 0; j < 8; ++j) { v[j] = xr[64 * j]; s += (v[j].x * v[j].x + v[j].y * v[j].y) + (v[j].z * v[j].z + v[j].w * v[j].w); }
        const float r = rsqrtf(wave_sum(s) * (1.f / D) + EPS);
        const f32x4* g4 = (const f32x4*)gain + lane;
        const f32x4* sc4 = (const f32x4*)(modl + (size_t)b * MODW + sc_off) + lane;
        const f32x4* sh4 = (const f32x4*)(modl + (size_t)b * MODW + sh_off) + lane;
        unsigned long long* o8 = (unsigned long long*)(H + (size_t)m * D) + lane;
#pragma unroll
        for (int j = 0; j < 8; ++j) {
            const f32x4 g = g4[64 * j], sc = sc4[64 * j], sh = sh4[64 * j];
            const f32x4 y = (v[j] * r) * g * (sc + 1.f) + sh;
            o8[64 * j] = (unsigned long long)pk2(y.x, y.y) | ((unsigned long long)pk2(y.z, y.w) << 32);
            if (XC) ((unsigned long long*)(XC + (size_t)m * D) + lane)[64 * j] = (unsigned long long)pk2(v[j].x, v[j].y) | ((unsigned long long)pk2(v[j].z, v[j].w) << 32);
        }
    }
}
DEV void modnorm_rows_h(const bf16* __restrict__ X, const float* __restrict__ gain, const float* __restrict__ modl, int sh_off, int sc_off, bf16* __restrict__ H, int gw, int NGW, int lane) {
    for (int m = gw; m < M; m += NGW) {
        const int b = m >> 12;
        const v4u* xr = (const v4u*)(X + (size_t)m * D) + lane;
        float v[32]; float s = 0.f;
#pragma unroll
        for (int j = 0; j < 4; ++j) { const v4u w = xr[64 * j];
            v[8 * j + 0] = bf_lo(w.x); v[8 * j + 1] = bf_hi(w.x); v[8 * j + 2] = bf_lo(w.y); v[8 * j + 3] = bf_hi(w.y); v[8 * j + 4] = bf_lo(w.z); v[8 * j + 5] = bf_hi(w.z); v[8 * j + 6] = bf_lo(w.w); v[8 * j + 7] = bf_hi(w.w);
#pragma unroll
            for (int e = 0; e < 8; ++e) s += v[8 * j + e] * v[8 * j + e]; }
        const float r = rsqrtf(wave_sum(s) * (1.f / D) + EPS);
        const float* scp = modl + (size_t)b * MODW + sc_off; const float* shp = modl + (size_t)b * MODW + sh_off;
        v4u* o16 = (v4u*)(H + (size_t)m * D) + lane;
#pragma unroll
        for (int j = 0; j < 4; ++j) { const int col = 8 * (lane + 64 * j);
            const f32x4 g0 = *(const f32x4*)(gain + col), g1 = *(const f32x4*)(gain + col + 4), c0 = *(const f32x4*)(scp + col), c1 = *(const f32x4*)(scp + col + 4), h0 = *(const f32x4*)(shp + col), h1 = *(const f32x4*)(shp + col + 4);
            v4u o;
            o.x = pk2(v[8 * j + 0] * r * g0.x * (c0.x + 1.f) + h0.x, v[8 * j + 1] * r * g0.y * (c0.y + 1.f) + h0.y); o.y = pk2(v[8 * j + 2] * r * g0.z * (c0.z + 1.f) + h0.z, v[8 * j + 3] * r * g0.w * (c0.w + 1.f) + h0.w);
            o.z = pk2(v[8 * j + 4] * r * g1.x * (c1.x + 1.f) + h1.x, v[8 * j + 5] * r * g1.y * (c1.y + 1.f) + h1.y); o.w = pk2(v[8 * j + 6] * r * g1.z * (c1.z + 1.f) + h1.z, v[8 * j + 7] * r * g1.w * (c1.w + 1.f) + h1.w);
            o16[64 * j] = o; }
    }
}


DEV unsigned cvtpk_bf16(float lo, float hi) { f32x2 v = {lo, hi}; bf16x2_t b = __builtin_convertvector(v, bf16x2_t); return __builtin_bit_cast(unsigned, b); }
constexpr int DIL_VSTR = 256;
constexpr int ATT_KOFF = 32 * DIL_VSTR;
constexpr int ATT_BOFF = ATT_KOFF + 8192;
constexpr int DIL_QOFF = ATT_BOFF + 132 * 4;
constexpr int ATT_WLDS = 17920;
static_assert(DIL_QOFF <= ATT_WLDS && 8 * ATT_WLDS <= LDS_MISC, "attention LDS");

DEV unsigned vimg_off(unsigned row, unsigned ch) { return 256u * row + 16u * (ch ^ (((row & 3u) << 2) | ((row >> 2) & 3u))); }
typedef short s16x4 __attribute__((ext_vector_type(4)));
DEV bf16x8 vfrag_tr(LAS unsigned char* img, int lane, int c, int ks) {
    const unsigned h = lane >> 5, blk = (lane >> 4) & 1, qq = (lane & 15) >> 2, pp = lane & 3;
    const s16x4 a = __builtin_amdgcn_ds_read_tr16_b64_v4i16((LAS s16x4*)(img + vimg_off(16 * ks + 8 * h + 0 + qq, 4 * c + 2 * blk + (pp >> 1)) + 8 * (pp & 1)));
    const s16x4 b = __builtin_amdgcn_ds_read_tr16_b64_v4i16((LAS s16x4*)(img + vimg_off(16 * ks + 8 * h + 4 + qq, 4 * c + 2 * blk + (pp >> 1)) + 8 * (pp & 1)));
    return __builtin_shufflevector(a, b, 0, 1, 2, 3, 4, 5, 6, 7);
}
DEV void dil_mfma_item(int b, int h, int p, int rr, int i0, const bf16* __restrict__ Z, const float* __restrict__ rel_bias, bf16* __restrict__ PART, float* __restrict__ LSE, LAS unsigned char* wl, int lane) {
    asm volatile("" : "+v"(lane));
    const int r = lane & 31, hh = lane >> 5;
    const int d = 1 << (2 * p);
    LAS float* biasL = (LAS float*)(wl + ATT_BOFF);
    for (int dd = lane; dd < 129; dd += 64) biasL[dd] = rel_bias[(int)T5B[p][dd] * 6 + h];
    const size_t rowq = (size_t)b * SEQ + rr + d * (i0 + r);
    bf16x8 qf[8];
    { const bf16* qrow = Z + rowq * IN_W + ZO_QB + h * 128 + 8 * hh;
#pragma unroll
      for (int ks = 0; ks < 8; ++ks) qf[ks] = *(const bf16x8*)(qrow + 16 * ks); }
    float m_run = NEGBIG, l_run = 0.f;
    f32x16 o[4];
#pragma unroll
    for (int dt = 0; dt < 4; ++dt)
#pragma unroll
        for (int e = 0; e < 16; ++e) o[dt][e] = 0.f;
    const int kap = (r & 0x13) | ((r & 4) << 1) | ((r & 8) >> 1);
    int jt = 4 - (i0 >> 5); jt = jt < 0 ? 0 : jt;
#define DIL_DMA_K(JT) do { int jk = i0 - 128 + 32 * (JT) + kap; jk = jk < 0 ? 0 : jk; const bf16* krow = Z + ((size_t)b * SEQ + rr + d * jk) * IN_W + ZO_KB + h * 128 + 8 * hh; \
        _Pragma("unroll") for (int ks = 0; ks < 8; ++ks) __builtin_amdgcn_global_load_lds((const unsigned*)(krow + 16 * ks), (LAS unsigned*)(wl + ATT_KOFF + 1024 * ks), 16, 0, 0); } while (0)
#define DIL_DMA_V(JT) do { const int j0_ = i0 - 128 + 32 * (JT); _Pragma("unroll") for (int q = 0; q < 8; ++q) { const int pi = lane + 64 * q, kl = pi >> 4, c = (pi & 15) ^ (((kl & 3) << 2) | ((kl >> 2) & 3)); int j = j0_ + kl; j = j < 0 ? 0 : j; \
        __builtin_amdgcn_global_load_lds((const unsigned*)(Z + ((size_t)b * SEQ + rr + d * j) * IN_W + ZO_VB + h * 128 + 8 * c), (LAS unsigned*)(wl + 1024 * q), 16, 0, 0); } } while (0)
    LDS_WAIT();
    DIL_DMA_K(jt); DIL_DMA_V(jt);
    for (; jt < 5; ++jt) {
        const int j0 = i0 - 128 + 32 * jt;
        const int jn = jt < 4 ? jt + 1 : 4;
        asm volatile("s_waitcnt vmcnt(8)" ::: "memory");
        f32x16 sacc, sac2;
#pragma unroll
        for (int e = 0; e < 16; ++e) { sacc[e] = 0.f; sac2[e] = 0.f; }
        {
            bf16x8 kf[8];
#pragma unroll
            for (int ks = 0; ks < 8; ++ks) kf[ks] = *((const LAS bf16x8*)(wl + ATT_KOFF + 1024 * ks) + lane);
#pragma unroll
            for (int ks = 0; ks < 8; ks += 2) { sacc = __builtin_amdgcn_mfma_f32_32x32x16_bf16(kf[ks], qf[ks], sacc, 0, 0, 0); sac2 = __builtin_amdgcn_mfma_f32_32x32x16_bf16(kf[ks + 1], qf[ks + 1], sac2, 0, 0, 0); }
#pragma unroll
            for (int e = 0; e < 16; ++e) sacc[e] += sac2[e];
        }
        LDS_WAIT();
        DIL_DMA_K(jn);
        float tm = NEGBIG;
#pragma unroll
        for (int e = 0; e < 16; ++e) {
            const int j = j0 + 16 * (e >> 3) + 8 * hh + (e & 7);
            const int dist = (i0 + r) - j;
            const bool valid = (j >= 0) && (dist >= 0) && (dist <= 128);
            const int dc = dist < 0 ? 0 : (dist > 128 ? 128 : dist);
            const float bv = *(volatile LAS float*)(biasL + dc);
            const float lg = valid ? sacc[e] * QSCALE + bv : NEGBIG;
            sacc[e] = lg; tm = fmaxf(tm, lg);
        }
        tm = max32(tm);
        const float m_new = fmaxf(m_run, tm);
        const float alpha = __expf(m_run - m_new);
        float ps = 0.f;
#pragma unroll
        for (int e = 0; e < 16; ++e) { const float pv = (sacc[e] > -1.0e37f) ? __expf(sacc[e] - m_new) : 0.f; sacc[e] = pv; ps += pv; }
        ps = sum32(ps);
        l_run = l_run * alpha + ps; m_run = m_new;
#pragma unroll
        for (int dt = 0; dt < 4; ++dt)
#pragma unroll
            for (int e = 0; e < 16; ++e) o[dt][e] *= alpha;
        bf16x8 pf[2];
#pragma unroll
        for (int s2 = 0; s2 < 2; ++s2) { v4u w; w.x = cvtpk_bf16(sacc[8 * s2 + 0], sacc[8 * s2 + 1]); w.y = cvtpk_bf16(sacc[8 * s2 + 2], sacc[8 * s2 + 3]);
            w.z = cvtpk_bf16(sacc[8 * s2 + 4], sacc[8 * s2 + 5]); w.w = cvtpk_bf16(sacc[8 * s2 + 6], sacc[8 * s2 + 7]); pf[s2] = __builtin_bit_cast(bf16x8, w); }
        asm volatile("s_waitcnt vmcnt(8)" ::: "memory");
#pragma unroll
        for (int dt = 0; dt < 4; ++dt)
#pragma unroll
            for (int s2 = 0; s2 < 2; ++s2) o[dt] = __builtin_amdgcn_mfma_f32_32x32x16_bf16(vfrag_tr(wl, lane, dt, s2), pf[s2], o[dt], 0, 0, 0);
        LDS_WAIT();
        DIL_DMA_V(jn);
    }
    asm volatile("s_waitcnt vmcnt(0)" ::: "memory");
#undef DIL_DMA_V
#undef DIL_DMA_K
    const float inv = 1.f / l_run;
    bf16* po = PART + ((size_t)p * M + rowq) * SWA_W + h * 128;
#pragma unroll
    for (int dt = 0; dt < 4; ++dt)
#pragma unroll
        for (int g = 0; g < 4; ++g)
            *(unsigned long long*)(po + 32 * dt + 8 * g + 4 * hh) = (unsigned long long)pk2(o[dt][4 * g + 0] * inv, o[dt][4 * g + 1] * inv) | ((unsigned long long)pk2(o[dt][4 * g + 2] * inv, o[dt][4 * g + 3] * inv) << 32);
    if (hh == 0) LSE[((size_t)p * M + rowq) * 6 + h] = m_run + __logf(l_run);
}


DEV void lru_item2(int l, int b, int j, int n, const bf16* __restrict__ Z, const float* __restrict__ conv_w, const float* __restrict__ conv_b, const bf16* __restrict__ WGT,
                   const float* __restrict__ b_rec, const float* __restrict__ b_gi, const float* __restrict__ lam,
                   bf16* __restrict__ HLOC, bf16* __restrict__ PP, float* __restrict__ SUMA, float* __restrict__ SUMB, LAS float* xc, LAS float* g0L, LAS float* g1L, int tid) {
    const int ch = tid & 127, tq = tid >> 7, c = n * 128 + ch;
    {
        LAS unsigned char* xaL = (LAS unsigned char*)(g1L + 64 * 132);
        const int t0 = j * 64;
#pragma unroll
        for (int i = 0; i < 3; ++i) { const int pz = tid + 512 * i; if (pz < 67 * 16) { const int row = pz >> 4, cc = pz & 15; const int t = t0 - 3 + row;
            v4u w = {0u, 0u, 0u, 0u}; if (t >= 0) w = *(const v4u*)(Z + ((size_t)b * SEQ + t) * IN_W + ZO_XA + n * 128 + 8 * cc);
            *(LAS v4u*)(xaL + row * 256 + cc * 16) = w; } }
        __syncthreads();
        const float cw0 = conv_w[(l * 4 + 0) * LRU_W + c], cw1 = conv_w[(l * 4 + 1) * LRU_W + c], cw2 = conv_w[(l * 4 + 2) * LRU_W + c], cw3 = conv_w[(l * 4 + 3) * LRU_W + c];
        const float cb = conv_b[l * LRU_W + c];
        const LAS bf16* xp = (const LAS bf16*)xaL + ch;
#pragma unroll 4
        for (int i = 0; i < 16; ++i) {
            const int tok = tq + 4 * i;
            xc[tok * 132 + ch] = cb + cw0 * bf1(xp[(tok + 0) * 128]) + cw1 * bf1(xp[(tok + 1) * 128]) + cw2 * bf1(xp[(tok + 2) * 128]) + cw3 * bf1(xp[(tok + 3) * 128]);
        }
    }
    __syncthreads();
    {
        const int lane = tid & 63, wave = tid >> 6, r = lane & 31, hh = lane >> 5, g = wave >> 2, ct = wave & 3;
        const bf16* wp = WGT + (((size_t)(l * 6 + n) * 2 + g) * 128 + ct * 32 + r) * 128 + 8 * hh;
        bf16x8 bfr[8];
#pragma unroll
        for (int ks = 0; ks < 8; ++ks) bfr[ks] = *(const bf16x8*)(wp + 16 * ks);
        LAS float* gL = g ? g1L : g0L;
#pragma unroll
        for (int rt = 0; rt < 2; ++rt) {
            f32x16 acc;
#pragma unroll
            for (int e = 0; e < 16; ++e) acc[e] = 0.f;
#pragma unroll
            for (int ks = 0; ks < 8; ++ks) {
                const LAS float* xp = xc + (32 * rt + r) * 132 + 16 * ks + 8 * hh;
                const f32x4 x0 = *(const LAS f32x4*)xp, x1 = *(const LAS f32x4*)(xp + 4);
                v4u w; w.x = cvtpk_bf16(x0.x, x0.y); w.y = cvtpk_bf16(x0.z, x0.w); w.z = cvtpk_bf16(x1.x, x1.y); w.w = cvtpk_bf16(x1.z, x1.w);
                acc = __builtin_amdgcn_mfma_f32_32x32x16_bf16(__builtin_bit_cast(bf16x8, w), bfr[ks], acc, 0, 0, 0);
            }
#pragma unroll
            for (int e = 0; e < 16; ++e) { const int tok = 32 * rt + (e & 3) + 8 * (e >> 2) + 4 * hh; gL[tok * 132 + ct * 32 + r] = acc[e]; }
        }
    }
    __syncthreads();
    {
        const float br = b_rec[l * LRU_W + c], bi = b_gi[l * LRU_W + c], sp = softplus_f(-lam[l * LRU_W + c]);
#pragma unroll 4
        for (int i = 0; i < 16; ++i) {
            const int tok = tq + 4 * i;
            const float rg = sigmoid_f(g0L[tok * 132 + ch] + br), ig = sigmoid_f(g1L[tok * 132 + ch] + bi);
            const float log_a = -8.0f * rg * sp;
            const float av = __expf(log_a);
            const float x = xc[tok * 132 + ch];
            const float uv = sqrtf(fmaxf(-expm1f(2.f * log_a), 0.f)) * (ig * x);
            g0L[tok * 132 + ch] = av; g1L[tok * 132 + ch] = uv;
        }
    }
    __syncthreads();
    if (tid < 128) {
        float h = 0.f, P = 1.f;
        const size_t rb = ((size_t)b * SEQ + j * 64) * LRU_W + n * 128 + tid;
#pragma unroll 8
        for (int tok = 0; tok < 64; ++tok) {
            const float av = g0L[tok * 132 + tid];
            h = av * h + g1L[tok * 132 + tid]; P *= av;
            HLOC[rb + (size_t)tok * LRU_W] = (bf16)f2bf(h); PP[rb + (size_t)tok * LRU_W] = (bf16)f2bf(P);
        }
        SUMA[(size_t)(b * 64 + j) * LRU_W + n * 128 + tid] = P; SUMB[(size_t)(b * 64 + j) * LRU_W + n * 128 + tid] = h;
    }
    __syncthreads();
}

DEV void sb_mfma_item(int b, int h, int t0, const bf16* __restrict__ Z, bf16* __restrict__ YC, LAS unsigned char* wl, int lane) {
    asm volatile("" : "+v"(lane));
    const int r = lane & 31, hh = lane >> 5;
    const size_t rowq = (size_t)b * SEQ + t0 + r;
    bf16x8 qf[8];
    { const bf16* qrow = Z + rowq * IN_W + ZO_QC + h * 128 + 8 * hh;
#pragma unroll
      for (int ks = 0; ks < 8; ++ks) qf[ks] = *(const bf16x8*)(qrow + 16 * ks); }
    f32x16 o[4];
#pragma unroll
    for (int dt = 0; dt < 4; ++dt)
#pragma unroll
        for (int e = 0; e < 16; ++e) o[dt][e] = 0.f;
    const int kap = (r & 0x13) | ((r & 4) << 1) | ((r & 8) >> 1);
    float carry = 0.f;
#define SB_DMA_K(K0) do { const bf16* krow = Z + ((size_t)b * SEQ + (K0) + kap) * IN_W + ZO_KC + h * 128 + 8 * hh; \
        _Pragma("unroll") for (int ks = 0; ks < 8; ++ks) __builtin_amdgcn_global_load_lds((const unsigned*)(krow + 16 * ks), (LAS unsigned*)(wl + ATT_KOFF + 1024 * ks), 16, 0, 0); } while (0)
#define SB_DMA_V(K0) do { _Pragma("unroll") for (int q = 0; q < 8; ++q) { const int pi = lane + 64 * q, kl = pi >> 4, c = (pi & 15) ^ (((kl & 3) << 2) | ((kl >> 2) & 3)); \
        __builtin_amdgcn_global_load_lds((const unsigned*)(Z + ((size_t)b * SEQ + (K0) + kl) * IN_W + ZO_VC + h * 128 + 8 * c), (LAS unsigned*)(wl + 1024 * q), 16, 0, 0); } } while (0)
    LDS_WAIT();
    SB_DMA_K(t0); SB_DMA_V(t0);
    for (int k0 = t0; k0 >= 0; k0 -= 32) {
        const int kn = k0 >= 32 ? k0 - 32 : 0;
        asm volatile("s_waitcnt vmcnt(8)" ::: "memory");
        f32x16 sacc, sac2;
#pragma unroll
        for (int e = 0; e < 16; ++e) { sacc[e] = 0.f; sac2[e] = 0.f; }
        {
            bf16x8 kf[8];
#pragma unroll
            for (int ks = 0; ks < 8; ++ks) kf[ks] = *((const LAS bf16x8*)(wl + ATT_KOFF + 1024 * ks) + lane);
#pragma unroll
            for (int ks = 0; ks < 8; ks += 2) { sacc = __builtin_amdgcn_mfma_f32_32x32x16_bf16(kf[ks], qf[ks], sacc, 0, 0, 0); sac2 = __builtin_amdgcn_mfma_f32_32x32x16_bf16(kf[ks + 1], qf[ks + 1], sac2, 0, 0, 0); }
#pragma unroll
            for (int e = 0; e < 16; ++e) sacc[e] += sac2[e];
        }
        LDS_WAIT();
        SB_DMA_K(kn);
        float l1[16]; float T0 = 0.f, T1 = 0.f;
#pragma unroll
        for (int e = 0; e < 16; ++e) {
            const int key = k0 + 16 * (e >> 3) + 8 * hh + (e & 7);
            const bool valid = key < t0 + r;
            const float z = sacc[e] * QSCALE;
            sacc[e] = z;
            l1[e] = valid ? -(fmaxf(z, 0.f) + __logf(1.f + __expf(-fabsf(z)))) : 0.f;
        }
#pragma unroll
        for (int e = 0; e < 8; ++e) { T0 += l1[e]; T1 += l1[8 + e]; }
        const float PT0 = partner32(T0, hh), PT1 = partner32(T1, hh);
        const float base1 = carry + (hh ? 0.f : PT1);
        const float base0 = carry + (hh ? (T1 + PT1) : (PT1 + T1 + PT0));
        float run1 = base1, run0 = base0;
#pragma unroll
        for (int e = 7; e >= 0; --e) {
            { const int key = k0 + 16 + 8 * hh + e; const bool valid = key < t0 + r; const float a = valid ? __expf(sacc[8 + e] + l1[8 + e] + run1) : 0.f; run1 += l1[8 + e]; sacc[8 + e] = a; }
            { const int key = k0 + 8 * hh + e; const bool valid = key < t0 + r; const float a = valid ? __expf(sacc[e] + l1[e] + run0) : 0.f; run0 += l1[e]; sacc[e] = a; }
        }
        carry += (T0 + T1) + (PT0 + PT1);
        bf16x8 pf[2];
#pragma unroll
        for (int s2 = 0; s2 < 2; ++s2) { v4u w; w.x = cvtpk_bf16(sacc[8 * s2 + 0], sacc[8 * s2 + 1]); w.y = cvtpk_bf16(sacc[8 * s2 + 2], sacc[8 * s2 + 3]);
            w.z = cvtpk_bf16(sacc[8 * s2 + 4], sacc[8 * s2 + 5]); w.w = cvtpk_bf16(sacc[8 * s2 + 6], sacc[8 * s2 + 7]); pf[s2] = __builtin_bit_cast(bf16x8, w); }
        asm volatile("s_waitcnt vmcnt(8)" ::: "memory");
#pragma unroll
        for (int dt = 0; dt < 4; ++dt)
#pragma unroll
            for (int s2 = 0; s2 < 2; ++s2) o[dt] = __builtin_amdgcn_mfma_f32_32x32x16_bf16(vfrag_tr(wl, lane, dt, s2), pf[s2], o[dt], 0, 0, 0);
        LDS_WAIT();
        SB_DMA_V(kn);
        if (__all(carry < -105.0f)) break;
    }
    asm volatile("s_waitcnt vmcnt(0)" ::: "memory");
#undef SB_DMA_V
#undef SB_DMA_K
    bf16* po = YC + rowq * SB_W + h * 128;
#pragma unroll
    for (int dt = 0; dt < 4; ++dt)
#pragma unroll
        for (int g = 0; g < 4; ++g)
            *(unsigned long long*)(po + 32 * dt + 8 * g + 4 * hh) = (unsigned long long)pk2(o[dt][4 * g + 0], o[dt][4 * g + 1]) | ((unsigned long long)pk2(o[dt][4 * g + 2], o[dt][4 * g + 3]) << 32);
}

DEV void combine_item(int l, int b, int j, int half, const bf16* __restrict__ Z, const bf16* __restrict__ HLOC, const bf16* __restrict__ PP, const float* __restrict__ SUMA, const float* __restrict__ SUMB,
                      const bf16* __restrict__ PART, const float* __restrict__ LSE, const bf16* __restrict__ YC, const float* __restrict__ g_lru, const float* __restrict__ g_swa, const float* __restrict__ g_sb,
                      bf16* __restrict__ Y, LAS float* carryL, int tid) {
    const int lane = tid & 63, wave = tid >> 6;
    for (int c = tid; c < LRU_W; c += 512) {
        float cr = 0.f; int i = 0;
        for (; i + 8 <= j; i += 8) {
            float av[8], bv[8];
#pragma unroll
            for (int u = 0; u < 8; ++u) { av[u] = SUMA[(size_t)(b * 64 + i + u) * LRU_W + c]; bv[u] = SUMB[(size_t)(b * 64 + i + u) * LRU_W + c]; }
#pragma unroll
            for (int u = 0; u < 8; ++u) cr = av[u] * cr + bv[u];
        }
        for (; i < j; ++i) cr = SUMA[(size_t)(b * 64 + i) * LRU_W + c] * cr + SUMB[(size_t)(b * 64 + i) * LRU_W + c];
        carryL[c] = cr;
    }
    __syncthreads();
    for (int i = 0; i < 4; ++i) {
        const int tok = half * 32 + wave * 4 + i;
        const size_t row = (size_t)b * SEQ + j * 64 + tok;
        bf16* yo = Y + row * D;
        {
            float ya[12]; float ssq = 0.f;
#pragma unroll
            for (int e = 0; e < 6; ++e) { const int c = 2 * lane + 128 * e;
                const unsigned hw = *(const unsigned*)(HLOC + row * LRU_W + c), pw = *(const unsigned*)(PP + row * LRU_W + c), gw2 = *(const unsigned*)(Z + row * IN_W + ZO_GA + c);
                const f32x2 cr = *(const LAS f32x2*)(carryL + c);
                ya[2 * e] = (bf_lo(hw) + bf_lo(pw) * cr.x) * gelu_tanh(bf_lo(gw2)); ya[2 * e + 1] = (bf_hi(hw) + bf_hi(pw) * cr.y) * gelu_tanh(bf_hi(gw2));
                ssq += ya[2 * e] * ya[2 * e] + ya[2 * e + 1] * ya[2 * e + 1]; }
            const float r = rsqrtf(wave_sum(ssq) * (1.f / LRU_W) + EPS);
#pragma unroll
            for (int e = 0; e < 6; ++e) { const int c = 2 * lane + 128 * e; const f32x2 g = *(const f32x2*)(g_lru + l * LRU_W + c);
                *(unsigned*)(yo + c) = pk2(ya[2 * e] * r * g.x, ya[2 * e + 1] * r * g.y); }
        }
        {
            float yb[12]; float ssq = 0.f;
#pragma unroll
            for (int e = 0; e < 6; ++e) { const int c = 2 * lane + 128 * e;
                const float l0 = LSE[((size_t)0 * M + row) * 6 + e], l1 = LSE[((size_t)1 * M + row) * 6 + e], l2 = LSE[((size_t)2 * M + row) * 6 + e];
                const float mx = fmaxf(l0, fmaxf(l1, l2)); const float e0 = __expf(l0 - mx), e1 = __expf(l1 - mx), e2 = __expf(l2 - mx); const float iz = 1.f / (e0 + e1 + e2);
                const unsigned p0 = *(const unsigned*)(PART + ((size_t)0 * M + row) * SWA_W + c), p1 = *(const unsigned*)(PART + ((size_t)1 * M + row) * SWA_W + c), p2 = *(const unsigned*)(PART + ((size_t)2 * M + row) * SWA_W + c);
                yb[2 * e] = (e0 * bf_lo(p0) + e1 * bf_lo(p1) + e2 * bf_lo(p2)) * iz; yb[2 * e + 1] = (e0 * bf_hi(p0) + e1 * bf_hi(p1) + e2 * bf_hi(p2)) * iz;
                ssq += yb[2 * e] * yb[2 * e] + yb[2 * e + 1] * yb[2 * e + 1]; }
            const float r = rsqrtf(wave_sum(ssq) * (1.f / SWA_W) + EPS);
#pragma unroll
            for (int e = 0; e < 6; ++e) { const int c = 2 * lane + 128 * e; const f32x2 g = *(const f32x2*)(g_swa + l * SWA_W + c);
                *(unsigned*)(yo + LRU_W + c) = pk2(yb[2 * e] * r * g.x, yb[2 * e + 1] * r * g.y); }
        }
        {
            float yc[8]; float ssq = 0.f;
#pragma unroll
            for (int e = 0; e < 4; ++e) { const int c = 2 * lane + 128 * e; const unsigned w = *(const unsigned*)(YC + row * SB_W + c); yc[2 * e] = bf_lo(w); yc[2 * e + 1] = bf_hi(w); ssq += yc[2 * e] * yc[2 * e] + yc[2 * e + 1] * yc[2 * e + 1]; }
            const float r = rsqrtf(wave_sum(ssq) * (1.f / SB_W) + EPS);
#pragma unroll
            for (int e = 0; e < 4; ++e) { const int c = 2 * lane + 128 * e; const f32x2 g = *(const f32x2*)(g_sb + l * SB_W + c);
                *(unsigned*)(yo + LRU_W + SWA_W + c) = pk2(yc[2 * e] * r * g.x, yc[2 * e + 1] * r * g.y); }
        }
    }
    __syncthreads();
}


constexpr float U8_SCALE = 64.f;
DEV void convert_fp8(const float* __restrict__ src, unsigned char* __restrict__ dst, size_t ngroups16, size_t gtid, size_t gstride, float scale) {
    for (size_t g = gtid; g < ngroups16; g += gstride) {
        const f32x4 a = *(const f32x4*)(src + g * 16) * scale, b = *(const f32x4*)(src + g * 16 + 4) * scale, c = *(const f32x4*)(src + g * 16 + 8) * scale, d = *(const f32x4*)(src + g * 16 + 12) * scale;
        int w0 = 0, w1 = 0, w2 = 0, w3 = 0;
        w0 = __builtin_amdgcn_cvt_pk_fp8_f32(a.x, a.y, w0, false); w0 = __builtin_amdgcn_cvt_pk_fp8_f32(a.z, a.w, w0, true);
        w1 = __builtin_amdgcn_cvt_pk_fp8_f32(b.x, b.y, w1, false); w1 = __builtin_amdgcn_cvt_pk_fp8_f32(b.z, b.w, w1, true);
        w2 = __builtin_amdgcn_cvt_pk_fp8_f32(c.x, c.y, w2, false); w2 = __builtin_amdgcn_cvt_pk_fp8_f32(c.z, c.w, w2, true);
        w3 = __builtin_amdgcn_cvt_pk_fp8_f32(d.x, d.y, w3, false); w3 = __builtin_amdgcn_cvt_pk_fp8_f32(d.z, d.w, w3, true);
        *(v4u*)(dst + g * 16) = (v4u){(unsigned)w0, (unsigned)w1, (unsigned)w2, (unsigned)w3};
    }
}

constexpr int R2_SC = 0, R2_TV = 128 * 129 * 4, R2_TI = R2_TV + 128 * 16 * 4, R2_END = R2_TI + 128 * 16 * 4;
static_assert(R2_END <= LDS_MISC, "routing v2 LDS");
DEV unsigned ord_key(float s) { const unsigned u = __builtin_bit_cast(unsigned, s); return (u & 0x80000000u) ? ~u : (u | 0x80000000u); }

#define KEY_CE(A, B) do { const unsigned hi_ = (A) > (B) ? (A) : (B); const unsigned lo_ = (A) > (B) ? (B) : (A); (A) = hi_; (B) = lo_; } while (0)
DEV void bitonic_sort16_desc(unsigned (&a)[16]) {
#pragma unroll
    for (int k = 2; k <= 16; k <<= 1)
#pragma unroll
        for (int j = k >> 1; j > 0; j >>= 1)
#pragma unroll
            for (int i = 0; i < 16; ++i) { const int m = i ^ j; if (m > i) { if ((i & k) == 0) KEY_CE(a[i], a[m]); else KEY_CE(a[m], a[i]); } }
}
DEV void bitonic_merge16_desc(unsigned (&a)[16]) {
#pragma unroll
    for (int j = 8; j > 0; j >>= 1)
#pragma unroll
        for (int i = 0; i < 16; ++i) { const int m = i ^ j; if (m > i) KEY_CE(a[i], a[m]); }
}
DEV void route_item2(int l, int tile, int h, const bf16* __restrict__ Q, const bf16* __restrict__ SK, int* __restrict__ IDS, float* __restrict__ GG, LAS unsigned char* lds, int tid, int seq,
                        const float* __restrict__ cv_u, const float* __restrict__ cv_v, unsigned char* __restrict__ cv_u8, unsigned char* __restrict__ cv_v8, float* __restrict__ cv_su, float* __restrict__ cv_sv) {
    LAS float* sc = (LAS float*)(lds + R2_SC); LAS float* tv = (LAS float*)(lds + R2_TV); LAS int* ti = (LAS int*)(lds + R2_TI);
    const int lane = tid & 63, wave = tid >> 6, row0 = tile * 64;
    {
        const int r = lane & 31, hh = lane >> 5, c = wave >> 2, key0 = 32 * (wave & 3);
        const bf16* skp = SK + ((size_t)(((l * 8 + h) * 2 + c) * 128 + key0 + r)) * 128 + 8 * hh;
        bf16x8 bfr[8];
#pragma unroll
        for (int ks = 0; ks < 8; ++ks) bfr[ks] = *(const bf16x8*)(skp + 16 * ks);
#pragma unroll
        for (int rt = 0; rt < 2; ++rt) {
            const bf16* qp = Q + (size_t)(row0 + 32 * rt + r) * D + h * 256 + c * 128 + 8 * hh;
            bf16x8 afr[8];
#pragma unroll
            for (int ks = 0; ks < 8; ++ks) afr[ks] = *(const bf16x8*)(qp + 16 * ks);
            f32x16 acc;
#pragma unroll
            for (int e = 0; e < 16; ++e) acc[e] = 0.f;
#pragma unroll
            for (int ks = 0; ks < 8; ++ks) acc = __builtin_amdgcn_mfma_f32_32x32x16_bf16(afr[ks], bfr[ks], acc, 0, 0, 0);
#pragma unroll
            for (int e = 0; e < 16; ++e) { const int tok = 32 * rt + (e & 3) + 8 * (e >> 2) + 4 * hh; sc[(c * 64 + tok) * 129 + key0 + r] = acc[e]; }
        }
    }
    __syncthreads();
    if (tid >= 128) {
#pragma unroll 2
        for (int rr = wave - 2; rr < 32; rr += 6) {
            const int R = (tile * 8 + h) * 32 + rr; const bool isv = R >= NEXP; const int ex = isv ? R - NEXP : R;
            const float* srow = (isv ? cv_v : cv_u) + (size_t)ex * D + 4 * lane;
            f32x4 v[8]; float am = 0.f;
#pragma unroll
            for (int j = 0; j < 8; ++j) { v[j] = *(const f32x4*)(srow + 256 * j); am = fmaxf(am, fmaxf(fmaxf(fabsf(v[j].x), fabsf(v[j].y)), fmaxf(fabsf(v[j].z), fabsf(v[j].w)))); }
            am = wave_max(am);
            const float scl = am > 0.f ? am * (1.f / 6.f) : 1.f, inv = am > 0.f ? 6.f / am : 1.f;
            unsigned char* drow = (isv ? cv_v8 : cv_u8) + (size_t)ex * 128 + 2 * lane;
#pragma unroll
            for (int j = 0; j < 8; ++j) { unsigned w = 0u;
                w = __builtin_amdgcn_cvt_scalef32_pk_fp4_f32(w, v[j].x * inv, v[j].y * inv, 1.0f, 0); w = __builtin_amdgcn_cvt_scalef32_pk_fp4_f32(w, v[j].z * inv, v[j].w * inv, 1.0f, 1);
                *(unsigned short*)(drow + (size_t)j * NEXP * 128) = (unsigned short)w; }
            if (lane == 0) (isv ? cv_sv : cv_su)[ex] = scl;
        }
    }
    if (tid < 128) {
        const int L = tid;
        unsigned t[16];
#pragma unroll
        for (int q = 0; q < 16; ++q) t[q] = 0u;
#pragma unroll 1
        for (int blk = 0; blk < 8; ++blk) {
            unsigned bk[16];
#pragma unroll
            for (int i = 0; i < 16; ++i) { const int k = blk * 16 + i; bk[i] = (ord_key(sc[L * 129 + k]) & ~127u) | (unsigned)(127 - k); }
            bitonic_sort16_desc(bk);
#pragma unroll
            for (int i = 0; i < 16; ++i) t[i] = t[i] > bk[15 - i] ? t[i] : bk[15 - i];
            bitonic_merge16_desc(t);
        }
#pragma unroll
        for (int q = 0; q < 16; ++q) { const int idx = 127 - (int)(t[q] & 127u); tv[L * 16 + q] = sc[L * 129 + idx]; ti[L * 16 + q] = idx; }
    }
    if (wave == 1) { LDS_WAIT(); if (lane == 0) *(volatile LAS int*)(lds + LDS_MISC + 128) = seq; }
    if (wave == 0) { LDS_WAIT(); while (*(volatile LAS int*)(lds + LDS_MISC + 128) != seq) __builtin_amdgcn_s_sleep(1); }
    if (tid < 64) {
        const int tok = tid;
        float a[16], bq[16];
#pragma unroll
        for (int i = 0; i < 16; ++i) { a[i] = tv[tok * 16 + i]; bq[i] = tv[(64 + tok) * 16 + i]; }
        unsigned t[16];
#pragma unroll
        for (int q = 0; q < 16; ++q) t[q] = 0u;
#pragma unroll
        for (int i = 0; i < 16; ++i)
#pragma unroll
            for (int j = 0; j < 16 / (i + 1); ++j) {
                unsigned key = (ord_key(a[i] + bq[j]) & ~255u) | (unsigned)(255 - (i * 16 + j));
#pragma unroll
                for (int q = 0; q < 16; ++q) { const unsigned hi = t[q] > key ? t[q] : key; key = t[q] > key ? key : t[q]; t[q] = hi; }
            }
        float scv[16]; int idv[16]; float mx = NEGBIG;
#pragma unroll
        for (int q = 0; q < 16; ++q) { const int ci = 255 - (int)(t[q] & 255u); const int i = ci >> 4, j = ci & 15;
            scv[q] = tv[tok * 16 + i] + tv[(64 + tok) * 16 + j]; idv[q] = ti[tok * 16 + i] * 128 + ti[(64 + tok) * 16 + j]; mx = fmaxf(mx, scv[q]); }
        float sum = 0.f;
#pragma unroll
        for (int q = 0; q < 16; ++q) { scv[q] = __expf(scv[q] - mx); sum += scv[q]; }
        const float inv = 1.f / sum;
        int* ip = IDS + (size_t)(row0 + tok) * 128 + h * 16; float* gp = GG + (size_t)(row0 + tok) * 128 + h * 16;
#pragma unroll
        for (int q4 = 0; q4 < 4; ++q4) {
            *(int4*)(ip + 4 * q4) = make_int4(idv[4 * q4], idv[4 * q4 + 1], idv[4 * q4 + 2], idv[4 * q4 + 3]);
            *(f32x4*)(gp + 4 * q4) = (f32x4){scv[4 * q4] * inv, scv[4 * q4 + 1] * inv, scv[4 * q4 + 2] * inv, scv[4 * q4 + 3] * inv};
        }
    }
    __syncthreads();
}


DEV void expert_row8(int l, int row, const bf16* H, const int* __restrict__ IDS, const float* __restrict__ GG, const unsigned char* __restrict__ U8, const unsigned char* __restrict__ V8,
                     const bf16* __restrict__ X1, const float* __restrict__ g2, const float* __restrict__ fnorm, float* __restrict__ XO, bf16* __restrict__ XOH, int lane, float pscale, LAS int* sortL,
                     const float* __restrict__ ngain, const float* __restrict__ nmod, bf16* Hout) {
    f32x2 x[16];
#pragma unroll
    for (int j = 0; j < 2; ++j) {
        const v4u a = *(const v4u*)(H + (size_t)row * D + lane * 16 + 1024 * j), c = *(const v4u*)(H + (size_t)row * D + lane * 16 + 1024 * j + 8);
        x[j * 8 + 0] = (f32x2){bf_lo(a.x), bf_hi(a.x)}; x[j * 8 + 1] = (f32x2){bf_lo(a.y), bf_hi(a.y)}; x[j * 8 + 2] = (f32x2){bf_lo(a.z), bf_hi(a.z)}; x[j * 8 + 3] = (f32x2){bf_lo(a.w), bf_hi(a.w)};
        x[j * 8 + 4] = (f32x2){bf_lo(c.x), bf_hi(c.x)}; x[j * 8 + 5] = (f32x2){bf_lo(c.y), bf_hi(c.y)}; x[j * 8 + 6] = (f32x2){bf_lo(c.z), bf_hi(c.z)}; x[j * 8 + 7] = (f32x2){bf_lo(c.w), bf_hi(c.w)};
    }
    int id0 = IDS[(size_t)row * 128 + lane], id1 = IDS[(size_t)row * 128 + 64 + lane];
    float gg0 = GG[(size_t)row * 128 + lane], gg1 = GG[(size_t)row * 128 + 64 + lane];
    {
        const int w0 = id0 >> 9, w1 = id1 >> 9; int p0 = 0, p1 = 0, base = 0;
        for (int w = 0; w < 32; ++w) {
            const unsigned long long m0 = __ballot(w0 == w), m1 = __ballot(w1 == w);
            const int c0 = __popcll(m0), c1 = __popcll(m1);
            const int b0 = (int)__builtin_amdgcn_mbcnt_hi((unsigned)(m0 >> 32), __builtin_amdgcn_mbcnt_lo((unsigned)m0, 0u));
            const int b1 = (int)__builtin_amdgcn_mbcnt_hi((unsigned)(m1 >> 32), __builtin_amdgcn_mbcnt_lo((unsigned)m1, 0u));
            p0 = (w0 == w) ? base + b0 : p0; p1 = (w1 == w) ? base + c0 + b1 : p1;
            base += c0 + c1;
        }
        sortL[p0] = id0; sortL[p1] = id1; ((LAS float*)sortL)[128 + p0] = gg0; ((LAS float*)sortL)[128 + p1] = gg1;
        LDS_WAIT();
        id0 = sortL[lane]; id1 = sortL[64 + lane]; gg0 = ((LAS float*)sortL)[128 + lane]; gg1 = ((LAS float*)sortL)[192 + lane];
        LDS_WAIT();
    }
    float wv0 = 0.f, wv1 = 0.f;
    const unsigned char* Ul = U8 + (size_t)l * NEXP * D + lane * 16;
    const unsigned char* Vl = V8 + (size_t)l * NEXP * D + lane * 16;
    for (int e0 = 0; e0 < 128; e0 += 8) {
        v4u uu[8][2];
#pragma unroll
        for (int q = 0; q < 8; ++q) { const int e = e0 + q; const int id = (e < 64) ? __builtin_amdgcn_readlane(id0, e & 63) : __builtin_amdgcn_readlane(id1, e & 63);
            uu[q][0] = *(const v4u*)(Ul + (size_t)id * D); uu[q][1] = *(const v4u*)(Ul + (size_t)id * D + 1024); }
        float ds[8];
#pragma unroll
        for (int q = 0; q < 8; ++q) {
            f32x2 acc = {0.f, 0.f};
#pragma unroll
            for (int j = 0; j < 2; ++j) {
                const unsigned wd[4] = {uu[q][j].x, uu[q][j].y, uu[q][j].z, uu[q][j].w};
#pragma unroll
                for (int dw = 0; dw < 4; ++dw) {
                    const f32x2 lo = __builtin_amdgcn_cvt_pk_f32_fp8((int)wd[dw], false), hi = __builtin_amdgcn_cvt_pk_f32_fp8((int)wd[dw], true);
                    acc = __builtin_elementwise_fma(lo, x[j * 8 + 2 * dw], acc); acc = __builtin_elementwise_fma(hi, x[j * 8 + 2 * dw + 1], acc);
                }
            }
            ds[q] = acc.x + acc.y;
        }
#pragma unroll
        for (int q = 0; q < 8; ++q) ds[q] += swz_xor<1>(ds[q]);
#pragma unroll
        for (int q = 0; q < 8; ++q) ds[q] += swz_xor<2>(ds[q]);
#pragma unroll
        for (int q = 0; q < 8; ++q) ds[q] += swz_xor<4>(ds[q]);
#pragma unroll
        for (int q = 0; q < 8; ++q) ds[q] += swz_xor<8>(ds[q]);
#pragma unroll
        for (int q = 0; q < 8; ++q) ds[q] += swz_xor<16>(ds[q]);
#pragma unroll
        for (int q = 0; q < 8; ++q) ds[q] = sum32(ds[q]);
#pragma unroll
        for (int q = 0; q < 8; ++q) { const int e = e0 + q;
            const float gq = (e < 64) ? __builtin_bit_cast(float, __builtin_amdgcn_readlane(__builtin_bit_cast(int, gg0), e & 63)) : __builtin_bit_cast(float, __builtin_amdgcn_readlane(__builtin_bit_cast(int, gg1), e & 63));
            const float w = gq * gelu_tanh(ds[q] * (1.f / U8_SCALE));
            if (e < 64) wv0 = (lane == (e & 63)) ? w : wv0; else wv1 = (lane == (e & 63)) ? w : wv1; }
    }
    f32x2 y[16];
#pragma unroll
    for (int i = 0; i < 16; ++i) y[i] = (f32x2){0.f, 0.f};
    for (int e0 = 0; e0 < 128; e0 += 8) {
        v4u vv[8][2];
#pragma unroll
        for (int q = 0; q < 8; ++q) { const int e = e0 + q; const int id = (e < 64) ? __builtin_amdgcn_readlane(id0, e & 63) : __builtin_amdgcn_readlane(id1, e & 63);
            vv[q][0] = *(const v4u*)(Vl + (size_t)id * D); vv[q][1] = *(const v4u*)(Vl + (size_t)id * D + 1024); }
#pragma unroll
        for (int q = 0; q < 8; ++q) { const int e = e0 + q;
            const float w = (e < 64) ? __builtin_bit_cast(float, __builtin_amdgcn_readlane(__builtin_bit_cast(int, wv0), e & 63)) : __builtin_bit_cast(float, __builtin_amdgcn_readlane(__builtin_bit_cast(int, wv1), e & 63));
            const f32x2 w2 = {w, w};
#pragma unroll
            for (int j = 0; j < 2; ++j) {
                const unsigned wd[4] = {vv[q][j].x, vv[q][j].y, vv[q][j].z, vv[q][j].w};
#pragma unroll
                for (int dw = 0; dw < 4; ++dw) {
                    const f32x2 lo = __builtin_amdgcn_cvt_pk_f32_fp8((int)wd[dw], false), hi = __builtin_amdgcn_cvt_pk_f32_fp8((int)wd[dw], true);
                    y[j * 8 + 2 * dw] = __builtin_elementwise_fma(w2, lo, y[j * 8 + 2 * dw]); y[j * 8 + 2 * dw + 1] = __builtin_elementwise_fma(w2, hi, y[j * 8 + 2 * dw + 1]);
                }
            }
        }
    }
    float ssq = 0.f;
#pragma unroll
    for (int j = 0; j < 2; ++j)
#pragma unroll
        for (int k4 = 0; k4 < 4; ++k4) {
            const int col = lane * 16 + 1024 * j + 4 * k4;
            const unsigned long long xw = *(const unsigned long long*)(X1 + (size_t)row * D + col); const f32x4 xa = {bf_lo((unsigned)xw), bf_hi((unsigned)xw), bf_lo((unsigned)(xw >> 32)), bf_hi((unsigned)(xw >> 32))}; const f32x4 ga = *(const f32x4*)(g2 + col) * pscale;
            f32x2& ya = y[j * 8 + 2 * k4]; f32x2& yb = y[j * 8 + 2 * k4 + 1];
            ya.x = xa.x + ga.x * ya.x; ya.y = xa.y + ga.y * ya.y; yb.x = xa.z + ga.z * yb.x; yb.y = xa.w + ga.w * yb.y;
            ssq += (ya.x * ya.x + ya.y * ya.y) + (yb.x * yb.x + yb.y * yb.y);
        }
    const float r = rsqrtf(wave_sum(ssq) * (1.f / D) + EPS);
#pragma unroll
    for (int j = 0; j < 2; ++j)
#pragma unroll
        for (int k4 = 0; k4 < 4; ++k4) {
            const int col = lane * 16 + 1024 * j + 4 * k4;
            const f32x2 ya = y[j * 8 + 2 * k4], yb = y[j * 8 + 2 * k4 + 1];
            f32x4 ov = {ya.x, ya.y, yb.x, yb.y};
            if (fnorm) *(f32x4*)(XO + (size_t)row * D + col) = ov * r * *(const f32x4*)(fnorm + col);
            else *(unsigned long long*)(XOH + (size_t)row * D + col) = (unsigned long long)pk2(ov.x, ov.y) | ((unsigned long long)pk2(ov.z, ov.w) << 32);
            if (ngain) {
                const f32x4 g = *(const f32x4*)(ngain + col), sc = *(const f32x4*)(nmod + MO_SC1 + col), sh = *(const f32x4*)(nmod + MO_SH1 + col);
                const f32x4 hv = (ov * r) * g * (sc + 1.f) + sh;
                *(unsigned long long*)(Hout + (size_t)row * D + col) = (unsigned long long)pk2(hv.x, hv.y) | ((unsigned long long)pk2(hv.z, hv.w) << 32);
            }
        }
}


DEV int claim_unit(unsigned* cnt, LAS int* claimL, int w0) {
    __syncthreads();
    if (xb_lead(w0)) *claimL = (int)__hip_atomic_fetch_add(cnt, 1u, __ATOMIC_RELAXED, __HIP_MEMORY_SCOPE_AGENT);
    __syncthreads();
    return *(volatile LAS int*)claimL;
}
struct ExIds { int id[16]; };
DEV void ex_load_ids(ExIds& I, int t, const int* __restrict__ IDS, int rg) {
#pragma unroll
    for (int q = 0; q < 4; ++q) { const int4 v = *(const int4*)(IDS + (size_t)t * 128 + 16 * rg + 4 * q); I.id[4 * q] = v.x; I.id[4 * q + 1] = v.y; I.id[4 * q + 2] = v.z; I.id[4 * q + 3] = v.w; }
}
DEV void ex_load_rows(v4u (&r)[16], const ExIds& I, const unsigned char* __restrict__ Tb) {
#pragma unroll
    for (int i = 0; i < 16; ++i) r[i] = *(const v4u*)(Tb + (size_t)I.id[i] * 128);
}
DEV void exu_compute(const v4u (&uu)[16], const v4u (&xp)[4], float* __restrict__ pp, int cl) {
    f32x2 x[16];
#pragma unroll
    for (int q = 0; q < 4; ++q) { x[4 * q] = (f32x2){bf_lo(xp[q].x), bf_hi(xp[q].x)}; x[4 * q + 1] = (f32x2){bf_lo(xp[q].y), bf_hi(xp[q].y)}; x[4 * q + 2] = (f32x2){bf_lo(xp[q].z), bf_hi(xp[q].z)}; x[4 * q + 3] = (f32x2){bf_lo(xp[q].w), bf_hi(xp[q].w)}; }
    float pd[16];
#pragma unroll
    for (int i = 0; i < 16; ++i) {
        const unsigned uw[4] = {uu[i].x, uu[i].y, uu[i].z, uu[i].w}; f32x2 a0 = {0.f, 0.f}, a1 = {0.f, 0.f};
#pragma unroll
        for (int dw = 0; dw < 4; ++dw) {
            a0 = __builtin_elementwise_fma(__builtin_amdgcn_cvt_scalef32_pk_f32_fp4(uw[dw], 1.0f, 0), x[4 * dw], a0); a1 = __builtin_elementwise_fma(__builtin_amdgcn_cvt_scalef32_pk_f32_fp4(uw[dw], 1.0f, 1), x[4 * dw + 1], a1);
            a0 = __builtin_elementwise_fma(__builtin_amdgcn_cvt_scalef32_pk_f32_fp4(uw[dw], 1.0f, 2), x[4 * dw + 2], a0); a1 = __builtin_elementwise_fma(__builtin_amdgcn_cvt_scalef32_pk_f32_fp4(uw[dw], 1.0f, 3), x[4 * dw + 3], a1); }
        pd[i] = (a0.x + a1.x) + (a0.y + a1.y);
    }
    const bool b2 = (cl & 4) != 0, b1 = (cl & 2) != 0, b0 = (cl & 1) != 0;
    float v8[8], v4[4], v2[2];
#pragma unroll
    for (int j = 0; j < 8; ++j) { const float keep = b2 ? pd[8 + j] : pd[j], give = b2 ? pd[j] : pd[8 + j]; v8[j] = keep + swz_xor<4>(give); }
#pragma unroll
    for (int j = 0; j < 4; ++j) { const float keep = b1 ? v8[4 + j] : v8[j], give = b1 ? v8[j] : v8[4 + j]; v4[j] = keep + swz_xor<2>(give); }
#pragma unroll
    for (int j = 0; j < 2; ++j) { const float keep = b0 ? v4[2 + j] : v4[j], give = b0 ? v4[j] : v4[2 + j]; v2[j] = keep + swz_xor<1>(give); }
    *(f32x2*)pp = (f32x2){v2[0], v2[1]};
}
template <int NT>
DEV void exu_unit(int s, int t0, const bf16* __restrict__ H, const int* __restrict__ IDS, const unsigned char* __restrict__ U8l, float* __restrict__ PD, int lane) {
    const int rg = lane >> 3, cl = lane & 7;
    const unsigned char* Ub = U8l + (size_t)s * NEXP * 128 + cl * 16;
    ExIds Ia, Ib; v4u ra[16], rb[16]; v4u xa[4], xb[4];
#define EXU_X(XV, T) do { const v4u* xp_ = (const v4u*)(H + (size_t)(T) * D + 256 * s + 32 * cl); XV[0] = xp_[0]; XV[1] = xp_[1]; XV[2] = xp_[2]; XV[3] = xp_[3]; } while (0)
    ex_load_ids(Ia, t0, IDS, rg); EXU_X(xa, t0);
    ex_load_rows(ra, Ia, Ub);
    if (NT > 1) { ex_load_ids(Ib, t0 + 1, IDS, rg); EXU_X(xb, t0 + 1); }
#pragma unroll
    for (int k = 0; k < NT; k += 2) {
        if (k + 1 < NT) ex_load_rows(rb, Ib, Ub);
        if (k + 2 < NT) { ex_load_ids(Ia, t0 + k + 2, IDS, rg); }
        exu_compute(ra, xa, PD + ((size_t)s * M + t0 + k) * 128 + 16 * rg + 2 * cl, cl);
        if (k + 2 < NT) { EXU_X(xa, t0 + k + 2); ex_load_rows(ra, Ia, Ub); }
        if (k + 1 < NT) {
            if (k + 3 < NT) { ex_load_ids(Ib, t0 + k + 3, IDS, rg); }
            exu_compute(rb, xb, PD + ((size_t)s * M + t0 + k + 1) * 128 + 16 * rg + 2 * cl, cl);
            if (k + 3 < NT) { EXU_X(xb, t0 + k + 3); }
        }
    }
#undef EXU_X
}
struct ExW { float w[16]; };
DEV void ex_load_w(ExW& W, int t, const float* __restrict__ WE, int rg) {
#pragma unroll
    for (int q = 0; q < 4; ++q) { const f32x4 w = *(const f32x4*)(WE + (size_t)t * 128 + 16 * rg + 4 * q); W.w[4 * q] = w.x; W.w[4 * q + 1] = w.y; W.w[4 * q + 2] = w.z; W.w[4 * q + 3] = w.w; }
}
DEV void exv_compute(const v4u (&vv)[16], const ExW& W, int s, int t, const bf16* __restrict__ X1, const float* __restrict__ g2, bf16* __restrict__ XO, int rg, int cl) {
    f32x2 y[16];
#pragma unroll
    for (int i = 0; i < 16; ++i) y[i] = (f32x2){0.f, 0.f};
#pragma unroll
    for (int i = 0; i < 16; ++i) {
        const unsigned vw[4] = {vv[i].x, vv[i].y, vv[i].z, vv[i].w}; const f32x2 w2 = {W.w[i], W.w[i]};
#pragma unroll
        for (int dw = 0; dw < 4; ++dw) {
            y[4 * dw] = __builtin_elementwise_fma(w2, __builtin_amdgcn_cvt_scalef32_pk_f32_fp4(vw[dw], 1.0f, 0), y[4 * dw]); y[4 * dw + 1] = __builtin_elementwise_fma(w2, __builtin_amdgcn_cvt_scalef32_pk_f32_fp4(vw[dw], 1.0f, 1), y[4 * dw + 1]);
            y[4 * dw + 2] = __builtin_elementwise_fma(w2, __builtin_amdgcn_cvt_scalef32_pk_f32_fp4(vw[dw], 1.0f, 2), y[4 * dw + 2]); y[4 * dw + 3] = __builtin_elementwise_fma(w2, __builtin_amdgcn_cvt_scalef32_pk_f32_fp4(vw[dw], 1.0f, 3), y[4 * dw + 3]); }
    }
    const bool c5 = (rg & 4) != 0, c4 = (rg & 2) != 0, c3 = (rg & 1) != 0;
    f32x2 u8[8], u4[4], u2[2];
#pragma unroll
    for (int j = 0; j < 8; ++j) { const f32x2 keep = c5 ? y[8 + j] : y[j], give = c5 ? y[j] : y[8 + j]; u8[j].x = keep.x + part32_(give.x); u8[j].y = keep.y + part32_(give.y); }
#pragma unroll
    for (int j = 0; j < 4; ++j) { const f32x2 keep = c4 ? u8[4 + j] : u8[j], give = c4 ? u8[j] : u8[4 + j]; u4[j].x = keep.x + swz_xor<16>(give.x); u4[j].y = keep.y + swz_xor<16>(give.y); }
#pragma unroll
    for (int j = 0; j < 2; ++j) { const f32x2 keep = c3 ? u4[2 + j] : u4[j], give = c3 ? u4[j] : u4[2 + j]; u2[j].x = keep.x + swz_xor<8>(give.x); u2[j].y = keep.y + swz_xor<8>(give.y); }
    {
        const size_t o = (size_t)t * D + 256 * s + 32 * cl + 4 * rg;
        const unsigned long long xw = *(const unsigned long long*)(X1 + o); const f32x4 gg = *(const f32x4*)(g2 + 256 * s + 32 * cl + 4 * rg);
        const unsigned lo = pk2(bf_lo((unsigned)xw) + gg.x * u2[0].x, bf_hi((unsigned)xw) + gg.y * u2[0].y), hi = pk2(bf_lo((unsigned)(xw >> 32)) + gg.z * u2[1].x, bf_hi((unsigned)(xw >> 32)) + gg.w * u2[1].y);
        *(unsigned long long*)(XO + o) = (unsigned long long)lo | ((unsigned long long)hi << 32);
    }
}
template <int NT>
DEV void exv_unit(int s, int t0, const int* __restrict__ IDS, const float* __restrict__ WE, const unsigned char* __restrict__ V8l, const bf16* __restrict__ X1, const float* __restrict__ g2b  ,
                  bf16* __restrict__ XO, int lane) {
    const int rg = lane >> 3, cl = lane & 7;
    const unsigned char* Vb = V8l + (size_t)s * NEXP * 128 + cl * 16;
    ExIds Ia, Ib; ExW Wa, Wb; v4u ra[16], rb[16];
    ex_load_ids(Ia, t0, IDS, rg); ex_load_w(Wa, t0, WE, rg);
    ex_load_rows(ra, Ia, Vb);
    if (NT > 1) { ex_load_ids(Ib, t0 + 1, IDS, rg); ex_load_w(Wb, t0 + 1, WE, rg); }
#pragma unroll
    for (int k = 0; k < NT; k += 2) {
        if (k + 1 < NT) ex_load_rows(rb, Ib, Vb);
        if (k + 2 < NT) ex_load_ids(Ia, t0 + k + 2, IDS, rg);
        exv_compute(ra, Wa, s, t0 + k, X1, g2b + (size_t)((t0 + k) >> 12) * MODW, XO, rg, cl);
        if (k + 2 < NT) { ex_load_w(Wa, t0 + k + 2, WE, rg); ex_load_rows(ra, Ia, Vb); }
        if (k + 1 < NT) {
            if (k + 3 < NT) ex_load_ids(Ib, t0 + k + 3, IDS, rg);
            exv_compute(rb, Wb, s, t0 + k + 1, X1, g2b + (size_t)((t0 + k + 1) >> 12) * MODW, XO, rg, cl);
            if (k + 3 < NT) ex_load_w(Wb, t0 + k + 3, WE, rg);
        }
    }
}
DEV void finalnorm_rows(const bf16* __restrict__ X, const float* __restrict__ gain, float* __restrict__ O, int gw, int NGW, int lane) {
    for (int m = gw; m < M; m += NGW) {
        const v4u* xr = (const v4u*)(X + (size_t)m * D) + lane;
        float v[32]; float sq = 0.f;
#pragma unroll
        for (int j = 0; j < 4; ++j) { const v4u w = xr[64 * j];
            v[8 * j + 0] = bf_lo(w.x); v[8 * j + 1] = bf_hi(w.x); v[8 * j + 2] = bf_lo(w.y); v[8 * j + 3] = bf_hi(w.y); v[8 * j + 4] = bf_lo(w.z); v[8 * j + 5] = bf_hi(w.z); v[8 * j + 6] = bf_lo(w.w); v[8 * j + 7] = bf_hi(w.w);
#pragma unroll
            for (int e = 0; e < 8; ++e) sq += v[8 * j + e] * v[8 * j + e]; }
        const float r = rsqrtf(wave_sum(sq) * (1.f / D) + EPS);
#pragma unroll
        for (int j = 0; j < 4; ++j) { const int col = 8 * (lane + 64 * j);
            const f32x4 g0 = *(const f32x4*)(gain + col), g1 = *(const f32x4*)(gain + col + 4);
            *(f32x4*)(O + (size_t)m * D + col) = (f32x4){v[8 * j + 0] * r * g0.x, v[8 * j + 1] * r * g0.y, v[8 * j + 2] * r * g0.z, v[8 * j + 3] * r * g0.w};
            *(f32x4*)(O + (size_t)m * D + col + 4) = (f32x4){v[8 * j + 4] * r * g1.x, v[8 * j + 5] * r * g1.y, v[8 * j + 6] * r * g1.z, v[8 * j + 7] * r * g1.w}; }
    }
}

struct Args { const float* in[24]; float* out; unsigned char* ws; int ph_lo, ph_hi, li, pad; };

__global__ void __launch_bounds__(512, 2) fwd(Args a) {
    extern __shared__ __attribute__((aligned(16))) unsigned char lds_raw[];
    LAS unsigned char* lds = (LAS unsigned char*)lds_raw;
#define PHASE_TID() unsigned zz_ = 0u; asm volatile("" : "+v"(zz_));   \
    int tid = wave0 * 64 + (int)__builtin_amdgcn_mbcnt_hi(~0u, __builtin_amdgcn_mbcnt_lo(~0u, zz_)); const int lane = tid & 63; (void)lane; \
    int bx = blockIdx.x, G = gridDim.x; asm volatile("" : "+s"(bx), "+s"(G)); const int wave = __builtin_amdgcn_readfirstlane(tid >> 6); \
    const int vcu = (G % 8 == 0) ? (bx % 8) * (G / 8) + bx / 8 : bx; const int gw = vcu * 8 + wave, NGW = G * 8; (void)gw; (void)NGW; (void)vcu; (void)wave; \
    const __attribute__((address_space(4))) Args* A = (const __attribute__((address_space(4))) Args*)__builtin_amdgcn_kernarg_segment_ptr(); asm volatile("" : "+s"(A))
    unsigned* ctl = (unsigned*)(a.ws + WS_CTL);
    const int lo = a.ph_lo, hi = a.ph_hi;
    const int wave0 = __builtin_amdgcn_readfirstlane((int)threadIdx.x >> 6);
    for (int u = threadIdx.x; u < (LDS_BYTES - LDS_MISC) / 4; u += 512) ((LAS unsigned*)(lds + LDS_MISC))[u] = 0u;
    __syncthreads();
    XcdBarrier bar; bar.bar = ctl + CW_BAR + (a.li & 7) * XCD_BAR_WORDS; bar.x = 0; bar.st = (volatile LAS unsigned*)(lds + LDS_MISC + 64); bar.w0 = wave0;
    if (hi - lo > 1) bar = xcd_barrier_post(ctl + CW_BAR + (a.li & 7) * XCD_BAR_WORDS, (volatile LAS unsigned*)(lds + LDS_MISC + 64), wave0);
#define IN(k) (lo <= (k) && (k) < hi)
#define SEAM(k) do { if (IN(k) && IN((k) + 1)) xcd_barrier(bar); } while (0)

#define mod   ((float*)(A->ws + WS_MOD))
#define WIN_T ((bf16*)(A->ws + WS_WIN_T))
#define WOUT_T ((bf16*)(A->ws + WS_WOUT_T))
#define WQ_T  ((bf16*)(A->ws + WS_WQ_T))
#define SUBK  ((bf16*)(A->ws + WS_SUBK))
#define UB    ((bf16*)(A->ws + WS_U))
#define VB    ((bf16*)(A->ws + WS_V))
#define H     ((bf16*)(A->ws + WS_H))
#define Z     ((bf16*)(A->ws + WS_Z))
#define HLOC  ((bf16*)(A->ws + WS_HLOC))
#define PP    ((bf16*)(A->ws + WS_P))
#define YB    ((float*)(A->ws + WS_YB))
#define YC    ((bf16*)(A->ws + WS_YC))
#define SUMA  ((float*)(A->ws + WS_SUMA))
#define SUMB  ((float*)(A->ws + WS_SUMB))
#define X1    ((float*)(A->ws + WS_X1))
#define X2    ((float*)(A->ws + WS_X2))
#define QB    ((bf16*)(A->ws + WS_Q))
#define IDS   ((int*)(A->ws + WS_IDS))
#define GG    ((float*)(A->ws + WS_G))
#define PARTB ((bf16*)(A->ws + WS_PART))
#define WG_T  ((bf16*)(A->ws + WS_WG_T))
#define PDOT  ((float*)(A->ws + WS_PDOT))
#define SCL   ((float*)(A->ws + WS_SCL))
#define WEXP  ((float*)(A->ws + WS_WEXP))
#define LSEB  ((float*)(A->ws + WS_LSE))
#define XIN   ((l == 0) ? A->in[0] : (const float*)X2)
#define XR    ((bf16*)(A->ws + WS_XR))
#define X1H   ((bf16*)(A->ws + WS_X1))
#define X2H   ((bf16*)(A->ws + WS_X2))
#define XRES  ((l == 0) ? (const bf16*)XR : (const bf16*)X2H)
#define MODL  (mod + (size_t)l * 2 * MODW)
    if (IN(0)) {
        PHASE_TID();
        ph_mod(A->in[1], A->in[2], A->in[3], mod, (LAS float*)lds, vcu, G, tid);
        {
            LAS float* scr = (LAS float*)(lds + wave * 17408);
            constexpr int I_IN = (D / 64) * (IN_W / 64), I_SQ = (D / 64) * (D / 64), I_L = I_IN + 2 * I_SQ;
            for (int it = gw; it < 2 * I_L; it += NGW) {
                const int l = it / I_L; int r = it % I_L;
                if (r < I_IN) { transpose_item64(A->in[6] + (size_t)l * D * IN_W, D, IN_W, WIN_T + (size_t)l * IN_W * D, scr, r, lane); continue; } r -= I_IN;
                if (r < I_SQ) { transpose_item64(A->in[18] + (size_t)l * D * D, D, D, WOUT_T + (size_t)l * D * D, scr, r, lane); continue; } r -= I_SQ;
                transpose_item64(A->in[19] + (size_t)l * D * D, D, D, WQ_T + (size_t)l * D * D, scr, r, lane);
            }
        }
        {
            LAS float* scr = (LAS float*)(lds + wave * 17408);
            for (int it = gw; it < 2 * 6 * 2 * 8; it += NGW) { const int mi = it >> 3, sub = it & 7; const int ln = mi >> 1, g = mi & 1;
                transpose_item((g ? A->in[11] : A->in[9]) + (size_t)ln * 128 * 128, 128, 128, WG_T + ((size_t)ln * 2 + g) * 128 * 128, scr, sub, lane); }
        }
        const size_t gtid = (size_t)vcu * 512 + tid, gstride = (size_t)G * 512;
        convert_copy(A->in[20], SUBK, (size_t)2 * 8 * 2 * 128 * 128 / 8, gtid, gstride);
    }
    SEAM(0);

    for (int l = 0; l < NL; ++l) {
        const int pb = 1 + PH_L * l;
        if (IN(pb + 0) && l == 0) { PHASE_TID(); modnorm_rows(XIN, A->in[4] + l * D, MODL, MO_SH1, MO_SC1, H, gw, NGW, lane, XR); }
        if (l == 0) SEAM(pb + 0);
        if (IN(pb + 1)) {
            PHASE_TID(); (void)tid;
            pg8::Gemm g{H, WIN_T + (size_t)l * IN_W * D, M, IN_W, D}; pg8::StaticOrder S; S.init(M, IN_W, G, bx);
            pg8::EpiBf16<0> E{Z, IN_W, nullptr, 0, 0};
            pg8::gemm_phase<pg8::EpiBf16<0>, pg8::StaticOrder, false>((PG8_LAS unsigned char*)lds, g, S, E, nullptr, wave0);
        }
        SEAM(pb + 1);
        if (IN(pb + 2)) {
            PHASE_TID();
            for (int it = vcu; it < 2 * 64 * 6; it += G) {
                const int b = it / 384, r = it % 384, j = r / 6, n = r % 6;
                lru_item2(l, b, j, n, Z, A->in[7], A->in[8], WG_T, A->in[10], A->in[12], A->in[13], HLOC, PP, SUMA, SUMB,
                          (LAS float*)lds, (LAS float*)(lds + 34816), (LAS float*)(lds + 69632), tid);
            }
            {
                {
                    LAS unsigned char* wl = lds + wave * ATT_WLDS;
                    for (int it = gw; it < 1024 + 4608; it += NGW) {
                        if (it < 1024) { const int bh = it >> 7, tl = 127 - (it & 127); sb_mfma_item(bh >> 2, bh & 3, 32 * tl, Z, YC, wl, lane); }
                        else { const int i2 = it - 1024; const int tl = i2 & 127, p = (i2 >> 7) % 3, bh = i2 / 384; const int d = 1 << (2 * p);
                            dil_mfma_item(bh / 6, bh % 6, p, tl % d, 32 * (tl / d), Z, A->in[14], PARTB, LSEB, wl, lane); }
                    }
                }
            }
        }
        SEAM(pb + 2);
        if (IN(pb + 3)) {
            PHASE_TID();
            for (int it = vcu; it < 256; it += G) { const int b = it >> 7, j = (it >> 1) & 63, half = it & 1;
                combine_item(l, b, j, half, Z, HLOC, PP, SUMA, SUMB, PARTB, LSEB, YC, A->in[15], A->in[16], A->in[17], H, (LAS float*)lds, tid); }
        }
        SEAM(pb + 3);
        if (IN(pb + 4)) {
            PHASE_TID(); (void)tid;
            pg8::Gemm g{H, WOUT_T + (size_t)l * D * D, M, D, D}; pg8::StaticOrder S; S.init(M, D, G, bx);
            EpiResGate E{XRES, X1H, MODL + MO_G1, 1.f};
            pg8::gemm_phase<EpiResGate, pg8::StaticOrder, false>((PG8_LAS unsigned char*)lds, g, S, E, nullptr, wave0);
        }
        SEAM(pb + 4);
        if (IN(pb + 5)) { PHASE_TID(); modnorm_rows_h(X1H, A->in[5] + l * D, MODL, MO_SH2, MO_SC2, H, gw, NGW, lane); }
        SEAM(pb + 5);
        if (IN(pb + 6)) {
            PHASE_TID(); (void)tid;
            pg8::Gemm g{H, WQ_T + (size_t)l * D * D, M, D, D}; pg8::StaticOrder S; S.init(M, D, G, bx);
            pg8::EpiBf16<0> E{QB, D, nullptr, 0, 0};
            pg8::gemm_phase<pg8::EpiBf16<0>, pg8::StaticOrder, false>((PG8_LAS unsigned char*)lds, g, S, E, nullptr, wave0);
        }
        SEAM(pb + 6);
        if (IN(pb + 7)) {
            PHASE_TID();
            for (int it = vcu; it < 128 * 8; it += G) route_item2(l, it >> 3, it & 7, QB, SUBK, IDS, GG, lds, tid, l * 1024 + it + 1, A->in[21] + (size_t)l * NEXP * D, A->in[22] + (size_t)l * NEXP * D,
                                                                                      (unsigned char*)UB + (size_t)l * NEXP * D, (unsigned char*)VB + (size_t)l * NEXP * D, SCL + (size_t)(2 * l) * NEXP, SCL + (size_t)(2 * l + 1) * NEXP);
        }
        SEAM(pb + 7);
        if (IN(pb + 8)) {
            PHASE_TID();
            LAS int* claimL = (LAS int*)(lds + LDS_MISC + 192);
            const int s0 = (int)xb_xcc_id();
            for (int ds = 0; ds < 8; ++ds) { const int s = (s0 + ds) & 7;
                unsigned* cnt = (unsigned*)(A->ws + WS_CTL) + 45056 + ((l * 2 + 0) * 16 + s) * 64;
                for (;;) { const int c = claim_unit(cnt, claimL, wave0); if (c >= M / 64) break;
                    exu_unit<8>(s, c * 64 + wave * 8, H, IDS, (const unsigned char*)UB + (size_t)l * NEXP * D, PDOT, lane); } }
        }
        SEAM(pb + 8);
        if (IN(pb + 9)) {
            PHASE_TID();
            const float* su = SCL + (size_t)(2 * l) * NEXP; const float* sv = SCL + (size_t)(2 * l + 1) * NEXP;
            for (int o = vcu * 512 + tid; o < M * 128; o += G * 512) { float d = 0.f; const int id = IDS[o];
#pragma unroll
                for (int sl = 0; sl < 8; ++sl) d += PDOT[(size_t)sl * M * 128 + o];
                WEXP[o] = GG[o] * gelu_tanh(d * su[id]) * sv[id]; }
        }
        SEAM(pb + 9);
        if (IN(pb + 10)) {
            PHASE_TID();
            LAS int* claimL = (LAS int*)(lds + LDS_MISC + 192);
            const int s0 = (int)xb_xcc_id();
            for (int ds = 0; ds < 8; ++ds) { const int s = (s0 + ds) & 7;
                unsigned* cnt = (unsigned*)(A->ws + WS_CTL) + 45056 + ((l * 2 + 1) * 16 + s) * 64;
                for (;;) { const int c = claim_unit(cnt, claimL, wave0); if (c >= M / 64) break;
                    exv_unit<8>(s, c * 64 + wave * 8, IDS, WEXP, (const unsigned char*)VB + (size_t)l * NEXP * D, X1H, MODL + MO_G2, X2H, lane); } }
        }
        SEAM(pb + 10);
        if (IN(pb + 11)) {
            PHASE_TID();
            if (l + 1 < NL) modnorm_rows_h(X2H, A->in[4] + (l + 1) * D, mod + (size_t)(l + 1) * 2 * MODW, MO_SH1, MO_SC1, H, gw, NGW, lane);
            else finalnorm_rows(X2H, A->in[23], A->out, gw, NGW, lane);
        }
        if (l + 1 < NL) SEAM(pb + 11);
    }
#undef IN
#undef SEAM
#undef mod
#undef H
#undef Z
#undef X1
#undef X2
}
}

extern "C" void kernel_launch(void* const* d_in, const int* in_sizes, int n_in, void* d_out, int out_size, void* d_ws, size_t ws_size, hipStream_t stream) {
    using namespace mk;
    static int grid = 0;
    if (grid == 0) {
        if (n_in != 24 || out_size != M * D || ws_size < WS_END) { fprintf(stderr, "kernel_launch: unexpected shapes (n_in %d out %d ws %zu)\n", n_in, out_size, ws_size); grid = -1; return; }
        int dev = 0, cus = 0, per_cu = 0;
        if (hipGetDevice(&dev) != hipSuccess || hipDeviceGetAttribute(&cus, hipDeviceAttributeMultiprocessorCount, dev) != hipSuccess) { grid = -1; return; }
        if (hipFuncSetAttribute((const void*)fwd, hipFuncAttributeMaxDynamicSharedMemorySize, LDS_BYTES) != hipSuccess) { fprintf(stderr, "kernel_launch: hipFuncSetAttribute failed\n"); grid = -1; return; }
        if (hipOccupancyMaxActiveBlocksPerMultiprocessor(&per_cu, (const void*)fwd, 512, LDS_BYTES) != hipSuccess || per_cu < 1) fprintf(stderr, "kernel_launch: occupancy query says %d\n", per_cu);
        (void)hipGetLastError();
        grid = cus;
    }
    if (grid < 0) return;
    (void)hipMemsetAsync((char*)d_ws + WS_CTL, 0, CTL_ZERO_BYTES, stream);
    Args a{};
    for (int i = 0; i < 24; ++i) a.in[i] = (const float*)d_in[i];
    a.out = (float*)d_out; a.ws = (unsigned char*)d_ws; a.pad = 0;
    constexpr int NLAUNCH = MK_N_LAUNCHES;
    for (int li = 0; li < NLAUNCH; ++li) {
        a.ph_lo = (NLAUNCH == 1) ? 0 : li; a.ph_hi = (NLAUNCH == 1) ? NPHASE : li + 1; a.li = li;
        hipLaunchKernelGGL(fwd, dim3(grid), dim3(512), LDS_BYTES, stream, a);
    }
}
```

```cpp
#include <hip/hip_runtime.h>
#include <cstdio>
#include <cstdint>
namespace pg8 {
#define PG8_LAS __attribute__((address_space(3)))
typedef unsigned short bf16_t;
typedef short bf16x8 __attribute__((ext_vector_type(8)));
typedef float f32x4 __attribute__((ext_vector_type(4)));
typedef unsigned u32x4 __attribute__((ext_vector_type(4)));
constexpr int BM = 256, BK = 64, HALF = 128, HTB = HALF * BK * 2  , STAGE_BYTES = 8 * HTB, NXCD = 8, WGM = 8;

__host__ __device__ __forceinline__ int lds_byte(int r, int c) { const int st = (r >> 4) * 2 + (c >> 5), rr = r & 15, cc = c & 31, ob = rr * 64 + cc * 2; return st * 1024 + (ob ^ (((ob >> 9) & 1) << 5)); }
__host__ __device__ __forceinline__ void stage_rc(int b, int& R, int& C) { const int st = b / 1024, sb = b % 1024, swz = sb ^ (((sb >> 9) & 1) << 5); R = (st >> 1) * 16 + swz / 64; C = (st & 1) * 32 + (swz % 64) / 2; }
__host__ __device__ __forceinline__ int perm32(int rho) { const int n = rho >> 4, i = rho & 15; return 8 * (i >> 2) + 4 * n + (i & 3); }

struct Unit { int pm, pn; };
struct Gemm { const bf16_t* A; const bf16_t* Bt; int M, N, K; };

struct StaticOrder {
    int nM, nN, nwg, G, c;
    __host__ __device__ void init(int M, int N, int G_, int c_) { nM = M / BM; nN = N / BM; nwg = nM * nN; G = G_; c = c_; }
    __host__ __device__ bool next(int i, Unit& u) const {
        const long L = (long)i * G + c; if (L >= nwg) return false;
        int wgid = (int)L; { const int q = nwg / NXCD, r = nwg % NXCD, xcd = wgid % NXCD, off = wgid / NXCD; wgid = (xcd < r ? xcd * (q + 1) : r * (q + 1) + (xcd - r) * q) + off; }
        const int nig = WGM * nN, gid = wgid / nig, fm = gid * WGM, gsz = (nM - fm) < WGM ? (nM - fm) : WGM;
        u.pm = fm + ((wgid % nig) % gsz); u.pn = (wgid % nig) / gsz; return true;
    }
    __device__ __forceinline__ void a_ready(const Unit&) const {}
    __device__ __forceinline__ void done(const Unit&) const {}
};
struct CountedOrder : StaticOrder {
    const unsigned* ready; unsigned need; unsigned* tmo;
    __device__ __forceinline__ void a_ready(const Unit& u) const {
        if (threadIdx.x < 64) {
            const unsigned long long t0 = __builtin_amdgcn_s_memrealtime(); unsigned polls = 0;
            while ((unsigned)__builtin_amdgcn_readfirstlane(__hip_atomic_load(ready + 64 * u.pm, __ATOMIC_RELAXED, __HIP_MEMORY_SCOPE_AGENT)) < need) {
                if ((++polls & 255u) == 0u && __builtin_amdgcn_readfirstlane(__hip_atomic_load(tmo, __ATOMIC_RELAXED, __HIP_MEMORY_SCOPE_AGENT)) != 0u) break;
                if (__builtin_amdgcn_s_memrealtime() - t0 > 2000000ull) {
                    if (threadIdx.x == 0) { unsigned expect = 0u; __hip_atomic_compare_exchange_strong(tmo + 1, &expect, 0x600u | (unsigned)(u.pm & 0xff), __ATOMIC_RELAXED, __ATOMIC_RELAXED, __HIP_MEMORY_SCOPE_AGENT); __hip_atomic_store(tmo, 1u, __ATOMIC_RELAXED, __HIP_MEMORY_SCOPE_AGENT); }
                    break; }
                __builtin_amdgcn_s_sleep(2); }
            __builtin_amdgcn_fence(__ATOMIC_ACQUIRE, "agent");
            asm volatile("s_waitcnt vmcnt(0)" ::: "memory");
        }
#if !defined(BROKEN_HOOK_NO_BARRIER)
        asm volatile("" ::: "memory"); __builtin_amdgcn_s_barrier(); asm volatile("" ::: "memory");
#endif
    }
};

__device__ __forceinline__ unsigned cvt_pk_bf16(float lo, float hi) { unsigned r; asm volatile("v_cvt_pk_bf16_f32 %0, %1, %2" : "=v"(r) : "v"(lo), "v"(hi)); return r; }
typedef float f32x2 __attribute__((ext_vector_type(2)));
__device__ __forceinline__ f32x2 gelu_pk(f32x2 v) {
    const f32x2 av = __builtin_elementwise_abs(v), d = av * 0.2316418882f + 1.0f;
    f32x2 t; t.x = __builtin_amdgcn_rcpf(d.x); t.y = __builtin_amdgcn_rcpf(d.y);
    f32x2 q = t * 0.5307027145f + (-0.7265760135f); q = q * t + 0.7107068705f; q = q * t + (-0.142248368f); q = q * t + 0.127414796f; q = q * t;
    const f32x2 s = (v * v) * (-0.72134752044f);
    f32x2 e; e.x = __builtin_amdgcn_exp2f(s.x); e.y = __builtin_amdgcn_exp2f(s.y);
    const f32x2 m = v * (q * e), r = v - m;
    f32x2 o; o.x = v.x < 0.f ? m.x : r.x; o.y = v.y < 0.f ? m.y : r.y; return o;
}

struct EpiF32 {
    static constexpr bool PERM = false, AFTER_DRAIN = false;
    float* C; int ldc; const float* bias;
    __device__ __forceinline__ void operator()(const f32x4 (&acc)[2][2][4][2], const Unit& u, int wr, int wc, int fr, int fq) const {
        const int row0 = u.pm * BM + wr * 64 + fr, col0 = u.pn * BM + wc * 32 + 4 * fq;
        f32x4 bv[2][2];
#pragma unroll
        for (int bj = 0; bj < 2; ++bj)
#pragma unroll
            for (int n = 0; n < 2; ++n) bv[bj][n] = bias ? *(const f32x4*)(bias + col0 + bj * HALF + n * 16) : (f32x4){0.f, 0.f, 0.f, 0.f};
#pragma unroll
        for (int ai = 0; ai < 2; ++ai)
#pragma unroll
            for (int m = 0; m < 4; ++m) { float* rowp = C + (size_t)(row0 + ai * HALF + m * 16) * ldc + col0;
#pragma unroll
                for (int bj = 0; bj < 2; ++bj)
#pragma unroll
                    for (int n = 0; n < 2; ++n) *(f32x4*)(rowp + bj * HALF + n * 16) = acc[ai][bj][m][n] + bv[bj][n]; }
    }
};
template <int ACT  > struct EpiBf16 {
    static constexpr bool PERM = true, AFTER_DRAIN = false;
    bf16_t* O; int ldc; const float* bias; int split_cols; size_t split_stride;
    __device__ __forceinline__ void operator()(const f32x4 (&acc)[2][2][4][2], const Unit& u, int wr, int wc, int fr, int fq) const {
        const int row0 = u.pm * BM + wr * 64 + fr; int colt = u.pn * BM; bf16_t* base = O;
        if (split_cols) { const int t = colt / split_cols; base += (size_t)t * split_stride; colt -= t * split_cols; }
        const int col0 = colt + wc * 32 + 8 * fq, bcol0 = u.pn * BM + wc * 32 + 8 * fq;
        f32x4 bv[2][2];
#pragma unroll
        for (int bj = 0; bj < 2; ++bj)
#pragma unroll
            for (int n = 0; n < 2; ++n) bv[bj][n] = bias ? *(const f32x4*)(bias + bcol0 + bj * HALF + 4 * n) : (f32x4){0.f, 0.f, 0.f, 0.f};
#pragma unroll
        for (int ai = 0; ai < 2; ++ai)
#pragma unroll
            for (int m = 0; m < 4; ++m) { bf16_t* rowp = base + (size_t)(row0 + ai * HALF + m * 16) * ldc + col0;
#pragma unroll
                for (int bj = 0; bj < 2; ++bj) { f32x4 v0 = acc[ai][bj][m][0] + bv[bj][0], v1 = acc[ai][bj][m][1] + bv[bj][1];
                    if (ACT == 1) { f32x2 a = gelu_pk((f32x2){v0[0], v0[1]}), b = gelu_pk((f32x2){v0[2], v0[3]}), c = gelu_pk((f32x2){v1[0], v1[1]}), d = gelu_pk((f32x2){v1[2], v1[3]});
                        v0 = (f32x4){a.x, a.y, b.x, b.y}; v1 = (f32x4){c.x, c.y, d.x, d.y}; }
                    if (ACT == 2) {
#pragma unroll
                        for (int j = 0; j < 4; ++j) { v0[j] = 0.5f * v0[j] * (1.0f + erff(v0[j] * 0.70710678f)); v1[j] = 0.5f * v1[j] * (1.0f + erff(v1[j] * 0.70710678f)); } }
                    u32x4 w; w.x = cvt_pk_bf16(v0[0], v0[1]); w.y = cvt_pk_bf16(v0[2], v0[3]); w.z = cvt_pk_bf16(v1[0], v1[1]); w.w = cvt_pk_bf16(v1[2], v1[3]);
                    *(u32x4*)(rowp + bj * HALF) = w; } }
    }
};
template <class Epi, class Sched, bool STAMP = false>
__device__ __forceinline__ void gemm_phase(PG8_LAS unsigned char* lds, const Gemm g, const Sched& S, const Epi& E, unsigned long long* stamps, int wave_id) {
    unsigned zz_o = 0u; asm volatile("" : "+v"(zz_o)); int tid_o = wave_id * 64 + (int)__builtin_amdgcn_mbcnt_hi(~0u, __builtin_amdgcn_mbcnt_lo(~0u, zz_o));
    const int tid = tid_o, wid = __builtin_amdgcn_readfirstlane(tid >> 6), lane = tid & 63, wr = wid >> 2, wc = wid & 3, fr = lane & 15, fq = lane >> 4;
    constexpr int K = 2048, nt = K / BK;
    int ts_lo = 0, ts_hi = 0, nts = 0; const unsigned long long rt_entry = STAMP ? (unsigned long long)wall_clock64() : 0ull;
#define PG8_STAMP() do { if (STAMP && wid == 0 && nts < 64) { const unsigned long long _c = (unsigned long long)clock64(); \
        ts_lo = (lane == nts) ? (int)(unsigned)_c : ts_lo; ts_hi = (lane == nts) ? (int)(unsigned)(_c >> 32) : ts_hi; ++nts; } } while (0)
    PG8_STAMP();
    unsigned voffA[2], voffB[2];
#pragma unroll
    for (int i = 0; i < 2; ++i) { int R, C; stage_rc(tid * 16 + i * 8192, R, C); const int Rb = Epi::PERM ? ((R & ~31) + perm32(R & 31)) : R;
        voffA[i] = (unsigned)(R * K + C) * 2u; voffB[i] = (unsigned)(Rb * K + C) * 2u; }
    const size_t kstep = (size_t)(BK * 2);
    const size_t hstep = (size_t)HALF * K * 2;
    const size_t tstep = 2 * hstep;
    const unsigned ldsw = (unsigned)wid * 1024u;
    const int aoff = lds_byte(wr * 64 + fr, fq * 8), boff = lds_byte(wc * 32 + fr, fq * 8);
#define PG8_SA(b, h) (((b) * 2 + (h)) * HTB)
#define PG8_SB(b, h) ((4 + (b) * 2 + (h)) * HTB)
#define PG8_STAGE(bufoff, gbase, voff) do { _Pragma("unroll") for (int _i = 0; _i < 2; ++_i) \
        __builtin_amdgcn_global_load_lds((const unsigned*)((const char*)(gbase) + (voff)[_i]), (PG8_LAS unsigned*)(lds + (bufoff) + ldsw + _i * 8192), 16, 0, 0); } while (0)
#define PG8_LDA(dst, b, h) do { _Pragma("unroll") for (int m = 0; m < 4; ++m) _Pragma("unroll") for (int k = 0; k < 2; ++k) dst[m][k] = *(const PG8_LAS bf16x8*)(lds + PG8_SA(b, h) + aoff + m * 2048 + k * 1024); } while (0)
#define PG8_LDB(dst, b, h) do { _Pragma("unroll") for (int n = 0; n < 2; ++n) _Pragma("unroll") for (int k = 0; k < 2; ++k) dst[n][k] = *(const PG8_LAS bf16x8*)(lds + PG8_SB(b, h) + boff + n * 2048 + k * 1024); } while (0)
#define PG8_MMA(ai, bj, At, Bt) do { __builtin_amdgcn_s_setprio(1); _Pragma("unroll") for (int m = 0; m < 4; ++m) _Pragma("unroll") for (int n = 0; n < 2; ++n) _Pragma("unroll") for (int k = 0; k < 2; ++k) \
        acc[ai][bj][m][n] = __builtin_amdgcn_mfma_f32_16x16x32_bf16(Bt[n][k], At[m][k], acc[ai][bj][m][n], 0, 0, 0); __builtin_amdgcn_s_setprio(0); } while (0)
#define PG8_WAIT_V(n) asm volatile("s_waitcnt vmcnt(" #n ")" ::: "memory")
#define PG8_WAIT_L(n) asm volatile("s_waitcnt lgkmcnt(" #n ")" ::: "memory")
#define PG8_BAR __builtin_amdgcn_s_barrier()
#define PG8_SCHED __builtin_amdgcn_sched_barrier(0)
    Unit cur, nxt; int ui = 0;
    if (!S.next(0, cur)) return;
    f32x4 acc[2][2][4][2];
#pragma unroll
    for (int a = 0; a < 2; ++a)
#pragma unroll
        for (int b = 0; b < 2; ++b)
#pragma unroll
            for (int m = 0; m < 4; ++m)
#pragma unroll
                for (int n = 0; n < 2; ++n) acc[a][b][m][n] = (f32x4){0.f, 0.f, 0.f, 0.f};
    bf16x8 At[4][2], B0[2][2], B1[2][2];
    const char* cA = (const char*)g.A + (size_t)cur.pm * tstep; const char* cB = (const char*)g.Bt + (size_t)cur.pn * tstep;
    S.a_ready(cur);
    PG8_STAGE(PG8_SB(0, 0), cB, voffB); PG8_STAGE(PG8_SA(0, 0), cA, voffA); PG8_STAGE(PG8_SB(0, 1), cB + hstep, voffB); PG8_STAGE(PG8_SA(0, 1), cA + hstep, voffA);
    if (wr == 1) PG8_BAR;
    PG8_WAIT_V(4); PG8_BAR;
    PG8_STAGE(PG8_SB(1, 0), cB + kstep, voffB); PG8_STAGE(PG8_SA(1, 0), cA + kstep, voffA); PG8_STAGE(PG8_SB(1, 1), cB + hstep + kstep, voffB);
    PG8_WAIT_V(6); PG8_BAR;
    PG8_STAMP();
    for (;;) {
        const bool has_next = S.next(ui + 1, nxt);
        const char* nA = has_next ? (const char*)g.A + (size_t)nxt.pm * tstep : cA; const char* nB = has_next ? (const char*)g.Bt + (size_t)nxt.pn * tstep : cB;
        for (int t = 0; t < nt; t += 2) {
            const bool last = (t == nt - 2);
            const char* a1 = cA + (size_t)(t + 1) * kstep;
            const char* a2 = last ? nA : cA + (size_t)(t + 2) * kstep; const char* b2 = last ? nB : cB + (size_t)(t + 2) * kstep;
            const char* a3 = a2 + kstep; const char* b3 = b2 + kstep;
            if (last && has_next) S.a_ready(nxt);
            PG8_LDB(B0, 0, 0); PG8_SCHED; PG8_LDA(At, 0, 0); PG8_STAGE(PG8_SA(1, 1), a1 + hstep, voffA);
            PG8_WAIT_L(8); PG8_BAR; PG8_WAIT_L(0); PG8_MMA(0, 0, At, B0); PG8_BAR; PG8_SCHED;
            PG8_LDB(B1, 0, 1); PG8_STAGE(PG8_SB(0, 0), b2, voffB);
            PG8_BAR; PG8_WAIT_L(0); PG8_MMA(0, 1, At, B1); PG8_BAR;
            PG8_LDA(At, 0, 1); PG8_STAGE(PG8_SA(0, 0), a2, voffA);
            PG8_BAR; PG8_WAIT_L(0); PG8_MMA(1, 0, At, B0); PG8_BAR; PG8_SCHED;
            PG8_STAGE(PG8_SB(0, 1), b2 + hstep, voffB);
            PG8_WAIT_V(6); PG8_BAR; PG8_MMA(1, 1, At, B1); PG8_BAR;
            PG8_LDB(B0, 1, 0); PG8_SCHED; PG8_LDA(At, 1, 0); PG8_STAGE(PG8_SA(0, 1), a2 + hstep, voffA);
            PG8_WAIT_L(8); PG8_BAR; PG8_WAIT_L(0); PG8_MMA(0, 0, At, B0); PG8_BAR; PG8_SCHED;
            PG8_LDB(B1, 1, 1); PG8_STAGE(PG8_SB(1, 0), b3, voffB);
            PG8_BAR; PG8_WAIT_L(0); PG8_MMA(0, 1, At, B1); PG8_BAR;
            PG8_LDA(At, 1, 1); PG8_STAGE(PG8_SA(1, 0), a3, voffA);
            PG8_BAR; PG8_WAIT_L(0); PG8_MMA(1, 0, At, B0); PG8_BAR; PG8_SCHED;
            PG8_STAGE(PG8_SB(1, 1), b3 + hstep, voffB);
            PG8_WAIT_V(6); PG8_BAR; PG8_MMA(1, 1, At, B1); PG8_BAR;
        }
        PG8_STAMP();
        if constexpr (!Epi::AFTER_DRAIN) { E(acc, cur, wr, wc, fr, fq); S.done(cur); }
        PG8_STAMP();
        if (!has_next) break;
#pragma unroll
        for (int a = 0; a < 2; ++a)
#pragma unroll
            for (int b = 0; b < 2; ++b)
#pragma unroll
                for (int m = 0; m < 4; ++m)
#pragma unroll
                    for (int n = 0; n < 2; ++n) acc[a][b][m][n] = (f32x4){0.f, 0.f, 0.f, 0.f};
        cur = nxt; cA = nA; cB = nB; ++ui;
    }
    PG8_WAIT_V(0);
    if (wr == 0) PG8_BAR;
    PG8_BAR;
    if constexpr (Epi::AFTER_DRAIN) { E.fused(acc, cur, wr, wc, fr, fq, lds, wid, lane); S.done(cur); }
    PG8_STAMP();
    if (STAMP && wid == 0) { stamps[lane] = lane < nts ? (((unsigned long long)(unsigned)ts_hi << 32) | (unsigned)ts_lo) : 0ull;
        if (lane == 62) stamps[62] = rt_entry; if (lane == 63) stamps[63] = (unsigned long long)wall_clock64(); }
#undef PG8_STAMP
#undef PG8_SA
#undef PG8_SB
#undef PG8_STAGE
#undef PG8_LDA
#undef PG8_LDB
#undef PG8_MMA
#undef PG8_WAIT_V
#undef PG8_WAIT_L
#undef PG8_BAR
#undef PG8_SCHED
}
}

namespace mk {
#define GAS __attribute__((address_space(1)))
#define LAS __attribute__((address_space(3)))
#define DEV __device__ __forceinline__
typedef unsigned short bf16;
typedef unsigned v4u __attribute__((ext_vector_type(4)));
typedef float f32x4 __attribute__((ext_vector_type(4)));
typedef float f32x2 __attribute__((ext_vector_type(2)));
typedef short bf16x8 __attribute__((ext_vector_type(8)));
typedef float f32x16 __attribute__((ext_vector_type(16)));
typedef __bf16 bf16x2_t __attribute__((ext_vector_type(2)));

#ifndef MK_DUP
#define MK_DUP -1
#endif
#ifndef MK_REPEAT_CONTROL
#define MK_REPEAT_CONTROL 0
#endif
#ifndef MK_N_LAUNCHES
#define MK_N_LAUNCHES 1
#endif

constexpr int D = 2048, SEQ = 4096, M = 8192, NL = 2;
constexpr int LRU_W = 768, SWA_W = 768, SB_W = 512, IN_W = 5376;
constexpr int ZO_XA = 0, ZO_GA = 768, ZO_QB = 1536, ZO_KB = 2304, ZO_VB = 3072, ZO_QC = 3840, ZO_KC = 4352, ZO_VC = 4864;
constexpr int NEXP = 16384, MODW = 12288;
constexpr int MO_SH1 = 0, MO_SC1 = 2048, MO_G1 = 4096, MO_SH2 = 6144, MO_SC2 = 8192, MO_G2 = 10240;
constexpr float EPS = 1e-6f;
constexpr float QSCALE = 0.08838834764831845f;
constexpr float NEGBIG = -3.0e38f;
constexpr int PH_L = 12;
constexpr int NPHASE = 1 + 2 * PH_L;

constexpr size_t MiB = 1u << 20;
constexpr size_t WS_CTL = 0, CTL_ZERO_BYTES = 1 * MiB;
constexpr size_t WS_MOD = 512 * 1024;
constexpr size_t WS_WIN_T = 2 * MiB, WS_WOUT_T = 44 * MiB, WS_WQ_T = 60 * MiB, WS_SUBK = 76 * MiB, WS_U = 80 * MiB, WS_V = 208 * MiB,
                 WS_H = 336 * MiB, WS_Z = 368 * MiB, WS_HLOC = 452 * MiB, WS_P = 476 * MiB, WS_YB = 500 * MiB, WS_YC = 524 * MiB,
                 WS_SUMA = 540 * MiB, WS_SUMB = 541 * MiB, WS_X1 = 544 * MiB, WS_X2 = 608 * MiB, WS_Q = 672 * MiB, WS_IDS = 704 * MiB,
                 WS_G = 708 * MiB, WS_WG_T = 77 * MiB, WS_PART = 712 * MiB, WS_LSE = 784 * MiB, WS_XR = 786 * MiB, WS_PDOT = 820 * MiB, WS_WEXP = 888 * MiB, WS_SCL = 892 * MiB  , WS_END = 893 * MiB;
constexpr int CW_BAR = 4096;

constexpr int LDS_BYTES = 147456;
constexpr int LDS_MISC = 143360;

__device__ const unsigned char T5B[3][132] = {
 {0,1,2,3,4,5,6,7,8,9,10,11,12,13,14,15,16,16,16,16,16,16,17,17,17,17,17,17,17,17,18,18,18,18,18,18,18,18,18,18,19,19,19,19,19,19,19,19,19,19,19,19,19,19,20,20,20,20,20,20,20,20,20,20,20,20,20,20,20,20,20,20,20,21,21,21,21,21,21,21,21,21,21,21,21,21,21,21,21,21,21,21,21,21,21,21,21,21,21,22,22,22,22,22,22,22,22,22,22,22,22,22,22,22,22,22,22,22,22,22,22,22,22,22,22,22,22,22,22,0,0,0},
 {0,4,8,12,16,16,17,17,18,18,19,19,19,19,20,20,20,20,20,21,21,21,21,21,21,22,22,22,22,22,22,22,22,22,23,23,23,23,23,23,23,23,23,23,23,23,24,24,24,24,24,24,24,24,24,24,24,24,24,24,24,24,25,25,25,25,25,25,25,25,25,25,25,25,25,25,25,25,25,25,25,25,25,26,26,26,26,26,26,26,26,26,26,26,26,26,26,26,26,26,26,26,26,26,26,26,26,26,26,26,26,26,26,27,27,27,27,27,27,27,27,27,27,27,27,27,27,27,27,0,0,0},
 {0,16,18,19,20,21,21,22,22,23,23,23,24,24,24,24,25,25,25,25,25,26,26,26,26,26,26,26,26,27,27,27,27,27,27,27,27,27,27,28,28,28,28,28,28,28,28,28,28,28,28,28,29,29,29,29,29,29,29,29,29,29,29,29,29,29,29,29,29,29,30,30,30,30,30,30,30,30,30,30,30,30,30,30,30,30,30,30,30,30,30,30,30,30,30,31,31,31,31,31,31,31,31,31,31,31,31,31,31,31,31,31,31,31,31,31,31,31,31,31,31,31,31,31,31,31,31,31,31,0,0,0}};

#define LDS_WAIT() asm volatile("s_waitcnt lgkmcnt(0)" ::: "memory")
DEV unsigned f2bf(float f) { unsigned u = __builtin_bit_cast(unsigned, f); return (u + 0x7fffu + ((u >> 16) & 1u)) >> 16; }
DEV unsigned pk2(float lo, float hi) { return f2bf(lo) | (f2bf(hi) << 16); }
DEV float bf_lo(unsigned w) { return __builtin_bit_cast(float, w << 16); }
DEV float bf_hi(unsigned w) { return __builtin_bit_cast(float, w & 0xffff0000u); }
DEV float bf1(bf16 h) { return __builtin_bit_cast(float, ((unsigned)h) << 16); }
template <int MSK> DEV float swz_xor(float v) { return __builtin_bit_cast(float, __builtin_amdgcn_ds_swizzle(__builtin_bit_cast(int, v), (MSK << 10) | 0x1F)); }
DEV float part32_(float v) { int ln = (int)__builtin_amdgcn_mbcnt_hi(~0u, __builtin_amdgcn_mbcnt_lo(~0u, 0u)); asm volatile("" : "+v"(ln)); return __builtin_bit_cast(float, __builtin_amdgcn_ds_bpermute((ln ^ 32) << 2, __builtin_bit_cast(int, v))); }
DEV float sum32(float v) { return v + part32_(v); }
DEV float max32(float v) { return fmaxf(v, part32_(v)); }
DEV float partner32(float v, int hh) { (void)hh; return part32_(v); }
DEV float wave_sum(float v) { v += swz_xor<1>(v); v += swz_xor<2>(v); v += swz_xor<4>(v); v += swz_xor<8>(v); v += swz_xor<16>(v); return sum32(v); }
DEV float wave_max(float v) { v = fmaxf(v, swz_xor<1>(v)); v = fmaxf(v, swz_xor<2>(v)); v = fmaxf(v, swz_xor<4>(v)); v = fmaxf(v, swz_xor<8>(v)); v = fmaxf(v, swz_xor<16>(v)); return max32(v); }
DEV float sigmoid_f(float x) { return 1.f / (1.f + __expf(-x)); }
DEV float softplus_f(float x) { return fmaxf(x, 0.f) + log1pf(__expf(-fabsf(x))); }
DEV float gelu_tanh(float x) { const float u = 0.7978845608028654f * (x + 0.044715f * x * x * x); const float t = 1.f - 2.f / (1.f + __expf(2.f * u)); return 0.5f * x * (1.f + t); }
DEV float dot8(const v4u a, const v4u b) {
    float s = bf_lo(a.x) * bf_lo(b.x); s += bf_hi(a.x) * bf_hi(b.x);
    s += bf_lo(a.y) * bf_lo(b.y); s += bf_hi(a.y) * bf_hi(b.y);
    s += bf_lo(a.z) * bf_lo(b.z); s += bf_hi(a.z) * bf_hi(b.z);
    s += bf_lo(a.w) * bf_lo(b.w); s += bf_hi(a.w) * bf_hi(b.w);
    return s;
}

#define XB_TMO      128
#define XB_XCNT(j)  (256  + 64 * (j))
#define XB_XSUB(j)  (1280 + 64 * (j))
#define XB_XGEN(j)  (2304 + 64 * (j))
#define XB_TOP      3328
#define XB_TOPGEN   3392
#define XCD_BAR_WORDS 3456
#define XB_SPIN_CAP (1u << 18)

__device__ __forceinline__ unsigned xb_ld(unsigned* p)              { return __hip_atomic_load(p, __ATOMIC_RELAXED, __HIP_MEMORY_SCOPE_AGENT); }
__device__ __forceinline__ unsigned xb_add(unsigned* p, unsigned v) { return __hip_atomic_fetch_add(p, v, __ATOMIC_RELAXED, __HIP_MEMORY_SCOPE_AGENT); }
__device__ __forceinline__ unsigned xb_xcc_id() { return (unsigned)__builtin_amdgcn_s_getreg((3 << 11) | 20) & 0xFu; }
#define XB_SPIN(cond, bar) do { unsigned _sp = 0; while (cond) { __builtin_amdgcn_s_sleep(1); \
    if ((++_sp & 255u) == 0u) { if (xb_ld(&(bar)[XB_TMO])) break; if (_sp > XB_SPIN_CAP) { atomicAdd(&(bar)[XB_TMO], 1u); break; } } } } while (0)

struct XcdBarrier {
    unsigned* bar; unsigned x;
    volatile LAS unsigned* st;
    int w0;
};
DEV bool xb_lead(int w0) { return w0 == 0 && __builtin_amdgcn_mbcnt_hi(~0u, __builtin_amdgcn_mbcnt_lo(~0u, 0u)) == 0u; }
__device__ __forceinline__ XcdBarrier xcd_barrier_post(unsigned* bar, volatile LAS unsigned* st, int w0) {
    XcdBarrier b; b.bar = bar; b.x = xb_xcc_id(); b.st = st; b.w0 = w0;
    if (xb_lead(w0)) (void)xb_add(&bar[XB_XCNT(b.x)], 1u);
    return b;
}
__device__ __forceinline__ void xcd_barrier_complete(unsigned* bar, unsigned x, unsigned& nloc, unsigned& nx) {
    const unsigned G = gridDim.x * gridDim.y * gridDim.z;
    unsigned sum, cnt, mine, sp = 0u;
    for (;;) {
        sum = 0u; cnt = 0u; mine = 0u;
#pragma unroll
        for (unsigned j = 0; j < 16; ++j) { const unsigned c = xb_ld(&bar[XB_XCNT(j)]); sum += c; cnt += (c > 0u) ? 1u : 0u; mine = (j == x) ? c : mine; }
        if (sum == G) break;
        __builtin_amdgcn_s_sleep(1);
        if ((++sp & 255u) == 0u) { if (xb_ld(&bar[XB_TMO])) break; if (sp > XB_SPIN_CAP) { atomicAdd(&bar[XB_TMO], 1u); break; } }
    }
    nloc = mine > 0u ? mine : 1u; nx = cnt > 0u ? cnt : 1u;
}
__device__ __forceinline__ void xcd_barrier(const XcdBarrier& b) {
    asm volatile("s_waitcnt vmcnt(0)" ::: "memory");
    __syncthreads();
    if (xb_lead(b.w0)) {
        unsigned* bar = b.bar;
        __builtin_amdgcn_s_waitcnt(0);
        unsigned nloc = b.st[0], nx = b.st[1];
        if (nloc == 0u) { xcd_barrier_complete(bar, b.x, nloc, nx); b.st[0] = nloc; b.st[1] = nx; }
        const unsigned old = xb_add(&bar[XB_XSUB(b.x)], 1u);
        const unsigned gen = old / nloc;
        if (old + 1u == (gen + 1u) * nloc) {
            __builtin_amdgcn_fence(__ATOMIC_RELEASE, "agent");
            asm volatile("s_waitcnt vmcnt(0)" ::: "memory");
            const unsigned og = xb_add(&bar[XB_TOP], 1u);
            const unsigned tg = og / nx;
            if (og + 1u == (tg + 1u) * nx) xb_add(&bar[XB_TOPGEN], 1u);
            else XB_SPIN(xb_ld(&bar[XB_TOPGEN]) == tg, bar);
            __builtin_amdgcn_fence(__ATOMIC_ACQUIRE, "agent");
            xb_add(&bar[XB_XGEN(b.x)], 1u);
            asm volatile("s_waitcnt vmcnt(0)" ::: "memory");
        } else {
            XB_SPIN(xb_ld(&bar[XB_XGEN(b.x)]) == gen, bar);
            __builtin_amdgcn_fence(__ATOMIC_ACQUIRE, "agent");
            asm volatile("s_waitcnt vmcnt(0)" ::: "memory");
        }
    }
    __syncthreads();
}

struct EpiResGate {
    static constexpr bool PERM = false, AFTER_DRAIN = false;
    const bf16* X; bf16* O; const float* gate; float gscale;
    __device__ __forceinline__ void operator()(const pg8::f32x4 (&acc)[2][2][4][2], const pg8::Unit& u, int wr, int wc, int fr, int fq) const {
        const int row0 = u.pm * 256 + wr * 64 + fr, col0 = u.pn * 256 + wc * 32 + 4 * fq;
        const float* gp = gate + (size_t)((u.pm * 256) >> 12) * MODW;
        pg8::f32x4 gv[2][2];
#pragma unroll
        for (int bj = 0; bj < 2; ++bj)
#pragma unroll
            for (int n = 0; n < 2; ++n) gv[bj][n] = *(const pg8::f32x4*)(gp + col0 + bj * 128 + n * 16) * gscale;
#pragma unroll
        for (int ai = 0; ai < 2; ++ai)
#pragma unroll
            for (int m = 0; m < 4; ++m) {
                const size_t ro = (size_t)(row0 + ai * 128 + m * 16) * D + col0;
#pragma unroll
                for (int bj = 0; bj < 2; ++bj)
#pragma unroll
                    for (int n = 0; n < 2; ++n) {
                        const unsigned long long xw = *(const unsigned long long*)(X + ro + bj * 128 + n * 16);
                        const pg8::f32x4 xv = {bf_lo((unsigned)xw), bf_hi((unsigned)xw), bf_lo((unsigned)(xw >> 32)), bf_hi((unsigned)(xw >> 32))};
                        const pg8::f32x4 ov = xv + gv[bj][n] * acc[ai][bj][m][n];
                        *(unsigned long long*)(O + ro + bj * 128 + n * 16) = (unsigned long long)pk2(ov.x, ov.y) | ((unsigned long long)pk2(ov.z, ov.w) << 32);
                    }
            }
    }
};

DEV void ph_mod(const float* __restrict__ c, const float* __restrict__ w_mod, const float* __restrict__ b_mod, float* __restrict__ mod, LAS float* lds_f, int vcu, int G, int tid) {
    const int lane = tid & 63, wave = tid >> 6;
    LAS float* cs = lds_f;
    LAS float* red = lds_f + 4096;
    for (int i = tid; i < 2 * D; i += 512) { const float v = c[i]; cs[i] = v * sigmoid_f(v); }
    __syncthreads();
    const int cg = lane & 15, rg = lane >> 4;
    for (int it = vcu; it < 2 * 192 * 2; it += G) {
        const int kh = it & 1, cb = (it >> 1) % 192, l = it / 384;
        const int k0 = kh * 1024 + wave * 128;
        const float* W = w_mod + ((size_t)l * D + k0 + rg) * MODW + cb * 64 + cg * 4;
        f32x4 a0 = {0.f, 0.f, 0.f, 0.f}, a1 = {0.f, 0.f, 0.f, 0.f};
#pragma unroll 16
        for (int i = 0; i < 32; ++i) {
            const f32x4 w = *(const f32x4*)(W + (size_t)(4 * i) * MODW);
            const float c0 = cs[k0 + 4 * i + rg], c1 = cs[D + k0 + 4 * i + rg];
            a0 += w * c0; a1 += w * c1;
        }
#pragma unroll
        for (int e = 0; e < 4; ++e) { a0[e] += swz_xor<16>(a0[e]); a0[e] = sum32(a0[e]); a1[e] += swz_xor<16>(a1[e]); a1[e] = sum32(a1[e]); }
        if (lane < 16) { *(LAS f32x4*)(red + (wave * 2 + 0) * 64 + cg * 4) = a0; *(LAS f32x4*)(red + (wave * 2 + 1) * 64 + cg * 4) = a1; }
        __syncthreads();
        if (tid < 128) {
            const int bq = tid >> 6, ln = tid & 63; float sacc = 0.f;
#pragma unroll
            for (int w = 0; w < 8; ++w) sacc += red[(w * 2 + bq) * 64 + ln];
            const int col = cb * 64 + ln;
            if (kh == 0) sacc += b_mod[l * MODW + col];
            atomicAdd(mod + (size_t)(l * 2 + bq) * MODW + col, sacc);
        }
        __syncthreads();
    }
}
DEV void transpose_item(const float* __restrict__ W, int K, int N, bf16* __restrict__ WT, LAS float* scr, int item, int lane) {
    const int nblk = N / 32, kb = item / nblk, nb = item % nblk, k0 = 64 * kb, n0 = 32 * nb;
#pragma unroll 8
    for (int i = 0; i < 32; ++i) { const int kk = 2 * i + (lane >> 5); scr[kk * 33 + (lane & 31)] = W[(size_t)(k0 + kk) * N + n0 + (lane & 31)]; }
    LDS_WAIT();
    const int c = lane & 7;
#pragma unroll
    for (int j = 0; j < 4; ++j) { const int n = (lane >> 3) + 8 * j; const LAS float* s = scr + (8 * c) * 33 + n;
        v4u o; o.x = pk2(s[0 * 33], s[1 * 33]); o.y = pk2(s[2 * 33], s[3 * 33]); o.z = pk2(s[4 * 33], s[5 * 33]); o.w = pk2(s[6 * 33], s[7 * 33]);
        *(v4u*)(WT + (size_t)(n0 + n) * K + k0 + 8 * c) = o; }
    LDS_WAIT();
}

DEV void transpose_item64(const float* __restrict__ W, int K, int N, bf16* __restrict__ WT, LAS float* scr, int item, int lane) {
    const int nblk = N / 64, kb = item / nblk, nb = item % nblk, k0 = 64 * kb, n0 = 64 * nb;
#pragma unroll 8
    for (int i = 0; i < 16; ++i) { const int kk = 4 * i + (lane >> 4), nn = 4 * (lane & 15);
        const f32x4 w = *(const f32x4*)(W + (size_t)(k0 + kk) * N + n0 + nn);
        LAS float* d = scr + kk * 65 + nn; d[0] = w.x; d[1] = w.y; d[2] = w.z; d[3] = w.w; }
    LDS_WAIT();
#pragma unroll
    for (int jj = 0; jj < 8; ++jj) { const int pz = lane + 64 * jj, n = pz >> 3, c = pz & 7; const LAS float* sp = scr + (8 * c) * 65 + n;
        v4u o; o.x = pk2(sp[0 * 65], sp[1 * 65]); o.y = pk2(sp[2 * 65], sp[3 * 65]); o.z = pk2(sp[4 * 65], sp[5 * 65]); o.w = pk2(sp[6 * 65], sp[7 * 65]);
        *(v4u*)(WT + (size_t)(n0 + n) * K + k0 + 8 * c) = o; }
    LDS_WAIT();
}
DEV void convert_copy(const float* __restrict__ src, bf16* __restrict__ dst, size_t ngroups8, size_t gtid, size_t gstride) {
    for (size_t g = gtid; g < ngroups8; g += gstride) {
        const f32x4 a = *(const f32x4*)(src + g * 8), b = *(const f32x4*)(src + g * 8 + 4);
        v4u o; o.x = pk2(a.x, a.y); o.y = pk2(a.z, a.w); o.z = pk2(b.x, b.y); o.w = pk2(b.z, b.w);
        *(v4u*)(dst + g * 8) = o;
    }
}

DEV void modnorm_rows(const float* __restrict__ X, const float* __restrict__ gain, const float* __restrict__ modl, int sh_off, int sc_off, bf16* __restrict__ H, int gw, int NGW, int lane, bf16* __restrict__ XC = nullptr) {
    for (int m = gw; m < M; m += NGW) {
        const int b = m >> 12;
        const f32x4* xr = (const f32x4*)(X + (size_t)m * D) + lane;
        f32x4 v[8]; float s = 0.f;
#pragma unroll
        for (int j = 0; j < 8; ++j) { v[j] = xr[64 * j]; s += (v[j].x * v[j].x + v[j].y * v[j].y) + (v[j].z * v[j].z + v[j].w * v[j].w); }
        const float r = rsqrtf(wave_sum(s) * (1.f / D) + EPS);
        const f32x4* g4 = (const f32x4*)gain + lane;
        const f32x4* sc4 = (const f32x4*)(modl + (size_t)b * MODW + sc_off) + lane;
        const f32x4* sh4 = (const f32x4*)(modl + (size_t)b * MODW + sh_off) + lane;
        unsigned long long* o8 = (unsigned long long*)(H + (size_t)m * D) + lane;
#pragma unroll
        for (int j = 0; j < 8; ++j) {
            const f32x4 g = g4[64 * j], sc = sc4[64 * j], sh = sh4[64 * j];
            const f32x4 y = (v[j] * r) * g * (sc + 1.f) + sh;
            o8[64 * j] = (unsigned long long)pk2(y.x, y.y) | ((unsigned long long)pk2(y.z, y.w) << 32);
            if (XC) ((unsigned long long*)(XC + (size_t)m * D) + lane)[64 * j] = (unsigned long long)pk2(v[j].x, v[j].y) | ((unsigned long long)pk2(v[j].z, v[j].w) << 32);
        }
    }
}
DEV void modnorm_rows_h(const bf16* __restrict__ X, const float* __restrict__ gain, const float* __restrict__ modl, int sh_off, int sc_off, bf16* __restrict__ H, int gw, int NGW, int lane) {
    for (int m = gw; m < M; m += NGW) {
        const int b = m >> 12;
        const v4u* xr = (const v4u*)(X + (size_t)m * D) + lane;
        float v[32]; float s = 0.f;
#pragma unroll
        for (int j = 0; j < 4; ++j) { const v4u w = xr[64 * j];
            v[8 * j + 0] = bf_lo(w.x); v[8 * j + 1] = bf_hi(w.x); v[8 * j + 2] = bf_lo(w.y); v[8 * j + 3] = bf_hi(w.y); v[8 * j + 4] = bf_lo(w.z); v[8 * j + 5] = bf_hi(w.z); v[8 * j + 6] = bf_lo(w.w); v[8 * j + 7] = bf_hi(w.w);
#pragma unroll
            for (int e = 0; e < 8; ++e) s += v[8 * j + e] * v[8 * j + e]; }
        const float r = rsqrtf(wave_sum(s) * (1.f / D) + EPS);
        const float* scp = modl + (size_t)b * MODW + sc_off; const float* shp = modl + (size_t)b * MODW + sh_off;
        v4u* o16 = (v4u*)(H + (size_t)m * D) + lane;
#pragma unroll
        for (int j = 0; j < 4; ++j) { const int col = 8 * (lane + 64 * j);
            const f32x4 g0 = *(const f32x4*)(gain + col), g1 = *(const f32x4*)(gain + col + 4), c0 = *(const f32x4*)(scp + col), c1 = *(const f32x4*)(scp + col + 4), h0 = *(const f32x4*)(shp + col), h1 = *(const f32x4*)(shp + col + 4);
            v4u o;
            o.x = pk2(v[8 * j + 0] * r * g0.x * (c0.x + 1.f) + h0.x, v[8 * j + 1] * r * g0.y * (c0.y + 1.f) + h0.y); o.y = pk2(v[8 * j + 2] * r * g0.z * (c0.z + 1.f) + h0.z, v[8 * j + 3] * r * g0.w * (c0.w + 1.f) + h0.w);
            o.z = pk2(v[8 * j + 4] * r * g1.x * (c1.x + 1.f) + h1.x, v[8 * j + 5] * r * g1.y * (c1.y + 1.f) + h1.y); o.w = pk2(v[8 * j + 6] * r * g1.z * (c1.z + 1.f) + h1.z, v[8 * j + 7] * r * g1.w * (c1.w + 1.f) + h1.w);
            o16[64 * j] = o; }
    }
}


DEV unsigned cvtpk_bf16(float lo, float hi) { f32x2 v = {lo, hi}; bf16x2_t b = __builtin_convertvector(v, bf16x2_t); return __builtin_bit_cast(unsigned, b); }
constexpr int DIL_VSTR = 256;
constexpr int ATT_KOFF = 32 * DIL_VSTR;
constexpr int ATT_BOFF = ATT_KOFF + 8192;
constexpr int DIL_QOFF = ATT_BOFF + 132 * 4;
constexpr int ATT_WLDS = 17920;
static_assert(DIL_QOFF <= ATT_WLDS && 8 * ATT_WLDS <= LDS_MISC, "attention LDS");

DEV unsigned vimg_off(unsigned row, unsigned ch) { return 256u * row + 16u * (ch ^ (((row & 3u) << 2) | ((row >> 2) & 3u))); }
typedef short s16x4 __attribute__((ext_vector_type(4)));
DEV bf16x8 vfrag_tr(LAS unsigned char* img, int lane, int c, int ks) {
    const unsigned h = lane >> 5, blk = (lane >> 4) & 1, qq = (lane & 15) >> 2, pp = lane & 3;
    const s16x4 a = __builtin_amdgcn_ds_read_tr16_b64_v4i16((LAS s16x4*)(img + vimg_off(16 * ks + 8 * h + 0 + qq, 4 * c + 2 * blk + (pp >> 1)) + 8 * (pp & 1)));
    const s16x4 b = __builtin_amdgcn_ds_read_tr16_b64_v4i16((LAS s16x4*)(img + vimg_off(16 * ks + 8 * h + 4 + qq, 4 * c + 2 * blk + (pp >> 1)) + 8 * (pp & 1)));
    return __builtin_shufflevector(a, b, 0, 1, 2, 3, 4, 5, 6, 7);
}
DEV void dil_mfma_item(int b, int h, int p, int rr, int i0, const bf16* __restrict__ Z, const float* __restrict__ rel_bias, bf16* __restrict__ PART, float* __restrict__ LSE, LAS unsigned char* wl, int lane) {
    asm volatile("" : "+v"(lane));
    const int r = lane & 31, hh = lane >> 5;
    const int d = 1 << (2 * p);
    LAS float* biasL = (LAS float*)(wl + ATT_BOFF);
    for (int dd = lane; dd < 129; dd += 64) biasL[dd] = rel_bias[(int)T5B[p][dd] * 6 + h];
    const size_t rowq = (size_t)b * SEQ + rr + d * (i0 + r);
    bf16x8 qf[8];
    { const bf16* qrow = Z + rowq * IN_W + ZO_QB + h * 128 + 8 * hh;
#pragma unroll
      for (int ks = 0; ks < 8; ++ks) qf[ks] = *(const bf16x8*)(qrow + 16 * ks); }
    float m_run = NEGBIG, l_run = 0.f;
    f32x16 o[4];
#pragma unroll
    for (int dt = 0; dt < 4; ++dt)
#pragma unroll
        for (int e = 0; e < 16; ++e) o[dt][e] = 0.f;
    const int kap = (r & 0x13) | ((r & 4) << 1) | ((r & 8) >> 1);
    int jt = 4 - (i0 >> 5); jt = jt < 0 ? 0 : jt;
#define DIL_DMA_K(JT) do { int jk = i0 - 128 + 32 * (JT) + kap; jk = jk < 0 ? 0 : jk; const bf16* krow = Z + ((size_t)b * SEQ + rr + d * jk) * IN_W + ZO_KB + h * 128 + 8 * hh; \
        _Pragma("unroll") for (int ks = 0; ks < 8; ++ks) __builtin_amdgcn_global_load_lds((const unsigned*)(krow + 16 * ks), (LAS unsigned*)(wl + ATT_KOFF + 1024 * ks), 16, 0, 0); } while (0)
#define DIL_DMA_V(JT) do { const int j0_ = i0 - 128 + 32 * (JT); _Pragma("unroll") for (int q = 0; q < 8; ++q) { const int pi = lane + 64 * q, kl = pi >> 4, c = (pi & 15) ^ (((kl & 3) << 2) | ((kl >> 2) & 3)); int j = j0_ + kl; j = j < 0 ? 0 : j; \
        __builtin_amdgcn_global_load_lds((const unsigned*)(Z + ((size_t)b * SEQ + rr + d * j) * IN_W + ZO_VB + h * 128 + 8 * c), (LAS unsigned*)(wl + 1024 * q), 16, 0, 0); } } while (0)
    LDS_WAIT();
    DIL_DMA_K(jt); DIL_DMA_V(jt);
    for (; jt < 5; ++jt) {
        const int j0 = i0 - 128 + 32 * jt;
        const int jn = jt < 4 ? jt + 1 : 4;
        asm volatile("s_waitcnt vmcnt(8)" ::: "memory");
        f32x16 sacc, sac2;
#pragma unroll
        for (int e = 0; e < 16; ++e) { sacc[e] = 0.f; sac2[e] = 0.f; }
        {
            bf16x8 kf[8];
#pragma unroll
            for (int ks = 0; ks < 8; ++ks) kf[ks] = *((const LAS bf16x8*)(wl + ATT_KOFF + 1024 * ks) + lane);
#pragma unroll
            for (int ks = 0; ks < 8; ks += 2) { sacc = __builtin_amdgcn_mfma_f32_32x32x16_bf16(kf[ks], qf[ks], sacc, 0, 0, 0); sac2 = __builtin_amdgcn_mfma_f32_32x32x16_bf16(kf[ks + 1], qf[ks + 1], sac2, 0, 0, 0); }
#pragma unroll
            for (int e = 0; e < 16; ++e) sacc[e] += sac2[e];
        }
        LDS_WAIT();
        DIL_DMA_K(jn);
        float tm = NEGBIG;
#pragma unroll
        for (int e = 0; e < 16; ++e) {
            const int j = j0 + 16 * (e >> 3) + 8 * hh + (e & 7);
            const int dist = (i0 + r) - j;
            const bool valid = (j >= 0) && (dist >= 0) && (dist <= 128);
            const int dc = dist < 0 ? 0 : (dist > 128 ? 128 : dist);
            const float bv = *(volatile LAS float*)(biasL + dc);
            const float lg = valid ? sacc[e] * QSCALE + bv : NEGBIG;
            sacc[e] = lg; tm = fmaxf(tm, lg);
        }
        tm = max32(tm);
        const float m_new = fmaxf(m_run, tm);
        const float alpha = __expf(m_run - m_new);
        float ps = 0.f;
#pragma unroll
        for (int e = 0; e < 16; ++e) { const float pv = (sacc[e] > -1.0e37f) ? __expf(sacc[e] - m_new) : 0.f; sacc[e] = pv; ps += pv; }
        ps = sum32(ps);
        l_run = l_run * alpha + ps; m_run = m_new;
#pragma unroll
        for (int dt = 0; dt < 4; ++dt)
#pragma unroll
            for (int e = 0; e < 16; ++e) o[dt][e] *= alpha;
        bf16x8 pf[2];
#pragma unroll
        for (int s2 = 0; s2 < 2; ++s2) { v4u w; w.x = cvtpk_bf16(sacc[8 * s2 + 0], sacc[8 * s2 + 1]); w.y = cvtpk_bf16(sacc[8 * s2 + 2], sacc[8 * s2 + 3]);
            w.z = cvtpk_bf16(sacc[8 * s2 + 4], sacc[8 * s2 + 5]); w.w = cvtpk_bf16(sacc[8 * s2 + 6], sacc[8 * s2 + 7]); pf[s2] = __builtin_bit_cast(bf16x8, w); }
        asm volatile("s_waitcnt vmcnt(8)" ::: "memory");
#pragma unroll
        for (int dt = 0; dt < 4; ++dt)
#pragma unroll
            for (int s2 = 0; s2 < 2; ++s2) o[dt] = __builtin_amdgcn_mfma_f32_32x32x16_bf16(vfrag_tr(wl, lane, dt, s2), pf[s2], o[dt], 0, 0, 0);
        LDS_WAIT();
        DIL_DMA_V(jn);
    }
    asm volatile("s_waitcnt vmcnt(0)" ::: "memory");
#undef DIL_DMA_V
#undef DIL_DMA_K
    const float inv = 1.f / l_run;
    bf16* po = PART + ((size_t)p * M + rowq) * SWA_W + h * 128;
#pragma unroll
    for (int dt = 0; dt < 4; ++dt)
#pragma unroll
        for (int g = 0; g < 4; ++g)
            *(unsigned long long*)(po + 32 * dt + 8 * g + 4 * hh) = (unsigned long long)pk2(o[dt][4 * g + 0] * inv, o[dt][4 * g + 1] * inv) | ((unsigned long long)pk2(o[dt][4 * g + 2] * inv, o[dt][4 * g + 3] * inv) << 32);
    if (hh == 0) LSE[((size_t)p * M + rowq) * 6 + h] = m_run + __logf(l_run);
}


DEV void lru_item2(int l, int b, int j, int n, const bf16* __restrict__ Z, const float* __restrict__ conv_w, const float* __restrict__ conv_b, const bf16* __restrict__ WGT,
                   const float* __restrict__ b_rec, const float* __restrict__ b_gi, const float* __restrict__ lam,
                   bf16* __restrict__ HLOC, bf16* __restrict__ PP, float* __restrict__ SUMA, float* __restrict__ SUMB, LAS float* xc, LAS float* g0L, LAS float* g1L, int tid) {
    const int ch = tid & 127, tq = tid >> 7, c = n * 128 + ch;
    {
        LAS unsigned char* xaL = (LAS unsigned char*)(g1L + 64 * 132);
        const int t0 = j * 64;
#pragma unroll
        for (int i = 0; i < 3; ++i) { const int pz = tid + 512 * i; if (pz < 67 * 16) { const int row = pz >> 4, cc = pz & 15; const int t = t0 - 3 + row;
            v4u w = {0u, 0u, 0u, 0u}; if (t >= 0) w = *(const v4u*)(Z + ((size_t)b * SEQ + t) * IN_W + ZO_XA + n * 128 + 8 * cc);
            *(LAS v4u*)(xaL + row * 256 + cc * 16) = w; } }
        __syncthreads();
        const float cw0 = conv_w[(l * 4 + 0) * LRU_W + c], cw1 = conv_w[(l * 4 + 1) * LRU_W + c], cw2 = conv_w[(l * 4 + 2) * LRU_W + c], cw3 = conv_w[(l * 4 + 3) * LRU_W + c];
        const float cb = conv_b[l * LRU_W + c];
        const LAS bf16* xp = (const LAS bf16*)xaL + ch;
#pragma unroll 4
        for (int i = 0; i < 16; ++i) {
            const int tok = tq + 4 * i;
            xc[tok * 132 + ch] = cb + cw0 * bf1(xp[(tok + 0) * 128]) + cw1 * bf1(xp[(tok + 1) * 128]) + cw2 * bf1(xp[(tok + 2) * 128]) + cw3 * bf1(xp[(tok + 3) * 128]);
        }
    }
    __syncthreads();
    {
        const int lane = tid & 63, wave = tid >> 6, r = lane & 31, hh = lane >> 5, g = wave >> 2, ct = wave & 3;
        const bf16* wp = WGT + (((size_t)(l * 6 + n) * 2 + g) * 128 + ct * 32 + r) * 128 + 8 * hh;
        bf16x8 bfr[8];
#pragma unroll
        for (int ks = 0; ks < 8; ++ks) bfr[ks] = *(const bf16x8*)(wp + 16 * ks);
        LAS float* gL = g ? g1L : g0L;
#pragma unroll
        for (int rt = 0; rt < 2; ++rt) {
            f32x16 acc;
#pragma unroll
            for (int e = 0; e < 16; ++e) acc[e] = 0.f;
#pragma unroll
            for (int ks = 0; ks < 8; ++ks) {
                const LAS float* xp = xc + (32 * rt + r) * 132 + 16 * ks + 8 * hh;
                const f32x4 x0 = *(const LAS f32x4*)xp, x1 = *(const LAS f32x4*)(xp + 4);
                v4u w; w.x = cvtpk_bf16(x0.x, x0.y); w.y = cvtpk_bf16(x0.z, x0.w); w.z = cvtpk_bf16(x1.x, x1.y); w.w = cvtpk_bf16(x1.z, x1.w);
                acc = __builtin_amdgcn_mfma_f32_32x32x16_bf16(__builtin_bit_cast(bf16x8, w), bfr[ks], acc, 0, 0, 0);
            }
#pragma unroll
            for (int e = 0; e < 16; ++e) { const int tok = 32 * rt + (e & 3) + 8 * (e >> 2) + 4 * hh; gL[tok * 132 + ct * 32 + r] = acc[e]; }
        }
    }
    __syncthreads();
    {
        const float br = b_rec[l * LRU_W + c], bi = b_gi[l * LRU_W + c], sp = softplus_f(-lam[l * LRU_W + c]);
#pragma unroll 4
        for (int i = 0; i < 16; ++i) {
            const int tok = tq + 4 * i;
            const float rg = sigmoid_f(g0L[tok * 132 + ch] + br), ig = sigmoid_f(g1L[tok * 132 + ch] + bi);
            const float log_a = -8.0f * rg * sp;
            const float av = __expf(log_a);
            const float x = xc[tok * 132 + ch];
            const float uv = sqrtf(fmaxf(-expm1f(2.f * log_a), 0.f)) * (ig * x);
            g0L[tok * 132 + ch] = av; g1L[tok * 132 + ch] = uv;
        }
    }
    __syncthreads();
    if (tid < 128) {
        float h = 0.f, P = 1.f;
        const size_t rb = ((size_t)b * SEQ + j * 64) * LRU_W + n * 128 + tid;
#pragma unroll 8
        for (int tok = 0; tok < 64; ++tok) {
            const float av = g0L[tok * 132 + tid];
            h = av * h + g1L[tok * 132 + tid]; P *= av;
            HLOC[rb + (size_t)tok * LRU_W] = (bf16)f2bf(h); PP[rb + (size_t)tok * LRU_W] = (bf16)f2bf(P);
        }
        SUMA[(size_t)(b * 64 + j) * LRU_W + n * 128 + tid] = P; SUMB[(size_t)(b * 64 + j) * LRU_W + n * 128 + tid] = h;
    }
    __syncthreads();
}

DEV void sb_mfma_item(int b, int h, int t0, const bf16* __restrict__ Z, bf16* __restrict__ YC, LAS unsigned char* wl, int lane) {
    asm volatile("" : "+v"(lane));
    const int r = lane & 31, hh = lane >> 5;
    const size_t rowq = (size_t)b * SEQ + t0 + r;
    bf16x8 qf[8];
    { const bf16* qrow = Z + rowq * IN_W + ZO_QC + h * 128 + 8 * hh;
#pragma unroll
      for (int ks = 0; ks < 8; ++ks) qf[ks] = *(const bf16x8*)(qrow + 16 * ks); }
    f32x16 o[4];
#pragma unroll
    for (int dt = 0; dt < 4; ++dt)
#pragma unroll
        for (int e = 0; e < 16; ++e) o[dt][e] = 0.f;
    const int kap = (r & 0x13) | ((r & 4) << 1) | ((r & 8) >> 1);
    float carry = 0.f;
#define SB_DMA_K(K0) do { const bf16* krow = Z + ((size_t)b * SEQ + (K0) + kap) * IN_W + ZO_KC + h * 128 + 8 * hh; \
        _Pragma("unroll") for (int ks = 0; ks < 8; ++ks) __builtin_amdgcn_global_load_lds((const unsigned*)(krow + 16 * ks), (LAS unsigned*)(wl + ATT_KOFF + 1024 * ks), 16, 0, 0); } while (0)
#define SB_DMA_V(K0) do { _Pragma("unroll") for (int q = 0; q < 8; ++q) { const int pi = lane + 64 * q, kl = pi >> 4, c = (pi & 15) ^ (((kl & 3) << 2) | ((kl >> 2) & 3)); \
        __builtin_amdgcn_global_load_lds((const unsigned*)(Z + ((size_t)b * SEQ + (K0) + kl) * IN_W + ZO_VC + h * 128 + 8 * c), (LAS unsigned*)(wl + 1024 * q), 16, 0, 0); } } while (0)
    LDS_WAIT();
    SB_DMA_K(t0); SB_DMA_V(t0);
    for (int k0 = t0; k0 >= 0; k0 -= 32) {
        const int kn = k0 >= 32 ? k0 - 32 : 0;
        asm volatile("s_waitcnt vmcnt(8)" ::: "memory");
        f32x16 sacc, sac2;
#pragma unroll
        for (int e = 0; e < 16; ++e) { sacc[e] = 0.f; sac2[e] = 0.f; }
        {
            bf16x8 kf[8];
#pragma unroll
            for (int ks = 0; ks < 8; ++ks) kf[ks] = *((const LAS bf16x8*)(wl + ATT_KOFF + 1024 * ks) + lane);
#pragma unroll
            for (int ks = 0; ks < 8; ks += 2) { sacc = __builtin_amdgcn_mfma_f32_32x32x16_bf16(kf[ks], qf[ks], sacc, 0, 0, 0); sac2 = __builtin_amdgcn_mfma_f32_32x32x16_bf16(kf[ks + 1], qf[ks + 1], sac2, 0, 0, 0); }
#pragma unroll
            for (int e = 0; e < 16; ++e) sacc[e] += sac2[e];
        }
        LDS_WAIT();
        SB_DMA_K(kn);
        float l1[16]; float T0 = 0.f, T1 = 0.f;
#pragma unroll
        for (int e = 0; e < 16; ++e) {
            const int key = k0 + 16 * (e >> 3) + 8 * hh + (e & 7);
            const bool valid = key < t0 + r;
            const float z = sacc[e] * QSCALE;
            sacc[e] = z;
            l1[e] = valid ? -(fmaxf(z, 0.f) + __logf(1.f + __expf(-fabsf(z)))) : 0.f;
        }
#pragma unroll
        for (int e = 0; e < 8; ++e) { T0 += l1[e]; T1 += l1[8 + e]; }
        const float PT0 = partner32(T0, hh), PT1 = partner32(T1, hh);
        const float base1 = carry + (hh ? 0.f : PT1);
        const float base0 = carry + (hh ? (T1 + PT1) : (PT1 + T1 + PT0));
        float run1 = base1, run0 = base0;
#pragma unroll
        for (int e = 7; e >= 0; --e) {
            { const int key = k0 + 16 + 8 * hh + e; const bool valid = key < t0 + r; const float a = valid ? __expf(sacc[8 + e] + l1[8 + e] + run1) : 0.f; run1 += l1[8 + e]; sacc[8 + e] = a; }
            { const int key = k0 + 8 * hh + e; const bool valid = key < t0 + r; const float a = valid ? __expf(sacc[e] + l1[e] + run0) : 0.f; run0 += l1[e]; sacc[e] = a; }
        }
        carry += (T0 + T1) + (PT0 + PT1);
        bf16x8 pf[2];
#pragma unroll
        for (int s2 = 0; s2 < 2; ++s2) { v4u w; w.x = cvtpk_bf16(sacc[8 * s2 + 0], sacc[8 * s2 + 1]); w.y = cvtpk_bf16(sacc[8 * s2 + 2], sacc[8 * s2 + 3]);
            w.z = cvtpk_bf16(sacc[8 * s2 + 4], sacc[8 * s2 + 5]); w.w = cvtpk_bf16(sacc[8 * s2 + 6], sacc[8 * s2 + 7]); pf[s2] = __builtin_bit_cast(bf16x8, w); }
        asm volatile("s_waitcnt vmcnt(8)" ::: "memory");
#pragma unroll
        for (int dt = 0; dt < 4; ++dt)
#pragma unroll
            for (int s2 = 0; s2 < 2; ++s2) o[dt] = __builtin_amdgcn_mfma_f32_32x32x16_bf16(vfrag_tr(wl, lane, dt, s2), pf[s2], o[dt], 0, 0, 0);
        LDS_WAIT();
        SB_DMA_V(kn);
        if (__all(carry < -105.0f)) break;
    }
    asm volatile("s_waitcnt vmcnt(0)" ::: "memory");
#undef SB_DMA_V
#undef SB_DMA_K
    bf16* po = YC + rowq * SB_W + h * 128;
#pragma unroll
    for (int dt = 0; dt < 4; ++dt)
#pragma unroll
        for (int g = 0; g < 4; ++g)
            *(unsigned long long*)(po + 32 * dt + 8 * g + 4 * hh) = (unsigned long long)pk2(o[dt][4 * g + 0], o[dt][4 * g + 1]) | ((unsigned long long)pk2(o[dt][4 * g + 2], o[dt][4 * g + 3]) << 32);
}

DEV void combine_item(int l, int b, int j, int half, const bf16* __restrict__ Z, const bf16* __restrict__ HLOC, const bf16* __restrict__ PP, const float* __restrict__ SUMA, const float* __restrict__ SUMB,
                      const bf16* __restrict__ PART, const float* __restrict__ LSE, const bf16* __restrict__ YC, const float* __restrict__ g_lru, const float* __restrict__ g_swa, const float* __restrict__ g_sb,
                      bf16* __restrict__ Y, LAS float* carryL, int tid) {
    const int lane = tid & 63, wave = tid >> 6;
    for (int c = tid; c < LRU_W; c += 512) {
        float cr = 0.f; int i = 0;
        for (; i + 8 <= j; i += 8) {
            float av[8], bv[8];
#pragma unroll
            for (int u = 0; u < 8; ++u) { av[u] = SUMA[(size_t)(b * 64 + i + u) * LRU_W + c]; bv[u] = SUMB[(size_t)(b * 64 + i + u) * LRU_W + c]; }
#pragma unroll
            for (int u = 0; u < 8; ++u) cr = av[u] * cr + bv[u];
        }
        for (; i < j; ++i) cr = SUMA[(size_t)(b * 64 + i) * LRU_W + c] * cr + SUMB[(size_t)(b * 64 + i) * LRU_W + c];
        carryL[c] = cr;
    }
    __syncthreads();
    for (int i = 0; i < 4; ++i) {
        const int tok = half * 32 + wave * 4 + i;
        const size_t row = (size_t)b * SEQ + j * 64 + tok;
        bf16* yo = Y + row * D;
        {
            float ya[12]; float ssq = 0.f;
#pragma unroll
            for (int e = 0; e < 6; ++e) { const int c = 2 * lane + 128 * e;
                const unsigned hw = *(const unsigned*)(HLOC + row * LRU_W + c), pw = *(const unsigned*)(PP + row * LRU_W + c), gw2 = *(const unsigned*)(Z + row * IN_W + ZO_GA + c);
                const f32x2 cr = *(const LAS f32x2*)(carryL + c);
                ya[2 * e] = (bf_lo(hw) + bf_lo(pw) * cr.x) * gelu_tanh(bf_lo(gw2)); ya[2 * e + 1] = (bf_hi(hw) + bf_hi(pw) * cr.y) * gelu_tanh(bf_hi(gw2));
                ssq += ya[2 * e] * ya[2 * e] + ya[2 * e + 1] * ya[2 * e + 1]; }
            const float r = rsqrtf(wave_sum(ssq) * (1.f / LRU_W) + EPS);
#pragma unroll
            for (int e = 0; e < 6; ++e) { const int c = 2 * lane + 128 * e; const f32x2 g = *(const f32x2*)(g_lru + l * LRU_W + c);
                *(unsigned*)(yo + c) = pk2(ya[2 * e] * r * g.x, ya[2 * e + 1] * r * g.y); }
        }
        {
            float yb[12]; float ssq = 0.f;
#pragma unroll
            for (int e = 0; e < 6; ++e) { const int c = 2 * lane + 128 * e;
                const float l0 = LSE[((size_t)0 * M + row) * 6 + e], l1 = LSE[((size_t)1 * M + row) * 6 + e], l2 = LSE[((size_t)2 * M + row) * 6 + e];
                const float mx = fmaxf(l0, fmaxf(l1, l2)); const float e0 = __expf(l0 - mx), e1 = __expf(l1 - mx), e2 = __expf(l2 - mx); const float iz = 1.f / (e0 + e1 + e2);
                const unsigned p0 = *(const unsigned*)(PART + ((size_t)0 * M + row) * SWA_W + c), p1 = *(const unsigned*)(PART + ((size_t)1 * M + row) * SWA_W + c), p2 = *(const unsigned*)(PART + ((size_t)2 * M + row) * SWA_W + c);
                yb[2 * e] = (e0 * bf_lo(p0) + e1 * bf_lo(p1) + e2 * bf_lo(p2)) * iz; yb[2 * e + 1] = (e0 * bf_hi(p0) + e1 * bf_hi(p1) + e2 * bf_hi(p2)) * iz;
                ssq += yb[2 * e] * yb[2 * e] + yb[2 * e + 1] * yb[2 * e + 1]; }
            const float r = rsqrtf(wave_sum(ssq) * (1.f / SWA_W) + EPS);
#pragma unroll
            for (int e = 0; e < 6; ++e) { const int c = 2 * lane + 128 * e; const f32x2 g = *(const f32x2*)(g_swa + l * SWA_W + c);
                *(unsigned*)(yo + LRU_W + c) = pk2(yb[2 * e] * r * g.x, yb[2 * e + 1] * r * g.y); }
        }
        {
            float yc[8]; float ssq = 0.f;
#pragma unroll
            for (int e = 0; e < 4; ++e) { const int c = 2 * lane + 128 * e; const unsigned w = *(const unsigned*)(YC + row * SB_W + c); yc[2 * e] = bf_lo(w); yc[2 * e + 1] = bf_hi(w); ssq += yc[2 * e] * yc[2 * e] + yc[2 * e + 1] * yc[2 * e + 1]; }
            const float r = rsqrtf(wave_sum(ssq) * (1.f / SB_W) + EPS);
#pragma unroll
            for (int e = 0; e < 4; ++e) { const int c = 2 * lane + 128 * e; const f32x2 g = *(const f32x2*)(g_sb + l * SB_W + c);
                *(unsigned*)(yo + LRU_W + SWA_W + c) = pk2(yc[2 * e] * r * g.x, yc[2 * e + 1] * r * g.y); }
        }
    }
    __syncthreads();
}


constexpr float U8_SCALE = 64.f;
DEV void convert_fp8(const float* __restrict__ src, unsigned char* __restrict__ dst, size_t ngroups16, size_t gtid, size_t gstride, float scale) {
    for (size_t g = gtid; g < ngroups16; g += gstride) {
        const f32x4 a = *(const f32x4*)(src + g * 16) * scale, b = *(const f32x4*)(src + g * 16 + 4) * scale, c = *(const f32x4*)(src + g * 16 + 8) * scale, d = *(const f32x4*)(src + g * 16 + 12) * scale;
        int w0 = 0, w1 = 0, w2 = 0, w3 = 0;
        w0 = __builtin_amdgcn_cvt_pk_fp8_f32(a.x, a.y, w0, false); w0 = __builtin_amdgcn_cvt_pk_fp8_f32(a.z, a.w, w0, true);
        w1 = __builtin_amdgcn_cvt_pk_fp8_f32(b.x, b.y, w1, false); w1 = __builtin_amdgcn_cvt_pk_fp8_f32(b.z, b.w, w1, true);
        w2 = __builtin_amdgcn_cvt_pk_fp8_f32(c.x, c.y, w2, false); w2 = __builtin_amdgcn_cvt_pk_fp8_f32(c.z, c.w, w2, true);
        w3 = __builtin_amdgcn_cvt_pk_fp8_f32(d.x, d.y, w3, false); w3 = __builtin_amdgcn_cvt_pk_fp8_f32(d.z, d.w, w3, true);
        *(v4u*)(dst + g * 16) = (v4u){(unsigned)w0, (unsigned)w1, (unsigned)w2, (unsigned)w3};
    }
}

constexpr int R2_SC = 0, R2_TV = 128 * 129 * 4, R2_TI = R2_TV + 128 * 16 * 4, R2_END = R2_TI + 128 * 16 * 4;
static_assert(R2_END <= LDS_MISC, "routing v2 LDS");
DEV unsigned ord_key(float s) { const unsigned u = __builtin_bit_cast(unsigned, s); return (u & 0x80000000u) ? ~u : (u | 0x80000000u); }

#define KEY_CE(A, B) do { const unsigned hi_ = (A) > (B) ? (A) : (B); const unsigned lo_ = (A) > (B) ? (B) : (A); (A) = hi_; (B) = lo_; } while (0)
DEV void bitonic_sort16_desc(unsigned (&a)[16]) {
#pragma unroll
    for (int k = 2; k <= 16; k <<= 1)
#pragma unroll
        for (int j = k >> 1; j > 0; j >>= 1)
#pragma unroll
            for (int i = 0; i < 16; ++i) { const int m = i ^ j; if (m > i) { if ((i & k) == 0) KEY_CE(a[i], a[m]); else KEY_CE(a[m], a[i]); } }
}
DEV void bitonic_merge16_desc(unsigned (&a)[16]) {
#pragma unroll
    for (int j = 8; j > 0; j >>= 1)
#pragma unroll
        for (int i = 0; i < 16; ++i) { const int m = i ^ j; if (m > i) KEY_CE(a[i], a[m]); }
}
DEV void route_item2(int l, int tile, int h, const bf16* __restrict__ Q, const bf16* __restrict__ SK, int* __restrict__ IDS, float* __restrict__ GG, LAS unsigned char* lds, int tid, int seq,
                        const float* __restrict__ cv_u, const float* __restrict__ cv_v, unsigned char* __restrict__ cv_u8, unsigned char* __restrict__ cv_v8, float* __restrict__ cv_su, float* __restrict__ cv_sv) {
    LAS float* sc = (LAS float*)(lds + R2_SC); LAS float* tv = (LAS float*)(lds + R2_TV); LAS int* ti = (LAS int*)(lds + R2_TI);
    const int lane = tid & 63, wave = tid >> 6, row0 = tile * 64;
    {
        const int r = lane & 31, hh = lane >> 5, c = wave >> 2, key0 = 32 * (wave & 3);
        const bf16* skp = SK + ((size_t)(((l * 8 + h) * 2 + c) * 128 + key0 + r)) * 128 + 8 * hh;
        bf16x8 bfr[8];
#pragma unroll
        for (int ks = 0; ks < 8; ++ks) bfr[ks] = *(const bf16x8*)(skp + 16 * ks);
#pragma unroll
        for (int rt = 0; rt < 2; ++rt) {
            const bf16* qp = Q + (size_t)(row0 + 32 * rt + r) * D + h * 256 + c * 128 + 8 * hh;
            bf16x8 afr[8];
#pragma unroll
            for (int ks = 0; ks < 8; ++ks) afr[ks] = *(const bf16x8*)(qp + 16 * ks);
            f32x16 acc;
#pragma unroll
            for (int e = 0; e < 16; ++e) acc[e] = 0.f;
#pragma unroll
            for (int ks = 0; ks < 8; ++ks) acc = __builtin_amdgcn_mfma_f32_32x32x16_bf16(afr[ks], bfr[ks], acc, 0, 0, 0);
#pragma unroll
            for (int e = 0; e < 16; ++e) { const int tok = 32 * rt + (e & 3) + 8 * (e >> 2) + 4 * hh; sc[(c * 64 + tok) * 129 + key0 + r] = acc[e]; }
        }
    }
    __syncthreads();
    if (tid >= 128) {
#pragma unroll 1
        for (int r0 = wave - 2; r0 < 32; r0 += 18) {
            f32x4 v[3][8];
#pragma unroll
            for (int bb = 0; bb < 3; ++bb) { const int rr = r0 + 6 * bb;
                if (rr < 32) { const int R = (tile * 8 + h) * 32 + rr; const bool isv = R >= NEXP; const int ex = isv ? R - NEXP : R;
                    const float* srow = (isv ? cv_v : cv_u) + (size_t)ex * D + 4 * lane;
#pragma unroll
                    for (int j = 0; j < 8; ++j) v[bb][j] = *(const f32x4*)(srow + 256 * j); } }
            __builtin_amdgcn_sched_barrier(0);
#pragma unroll
            for (int bb = 0; bb < 3; ++bb) { const int rr = r0 + 6 * bb;
                if (rr < 32) { const int R = (tile * 8 + h) * 32 + rr; const bool isv = R >= NEXP; const int ex = isv ? R - NEXP : R;
                    float am = 0.f;
#pragma unroll
                    for (int j = 0; j < 8; ++j) am = fmaxf(am, fmaxf(fmaxf(fabsf(v[bb][j].x), fabsf(v[bb][j].y)), fmaxf(fabsf(v[bb][j].z), fabsf(v[bb][j].w))));
                    am = wave_max(am);
                    const float scl = am > 0.f ? am * (1.f / 6.f) : 1.f, inv = am > 0.f ? 6.f / am : 1.f;
                    unsigned char* drow = (isv ? cv_v8 : cv_u8) + (size_t)ex * 128 + 2 * lane;
#pragma unroll
                    for (int j = 0; j < 8; ++j) { unsigned w = 0u;
                        w = __builtin_amdgcn_cvt_scalef32_pk_fp4_f32(w, v[bb][j].x * inv, v[bb][j].y * inv, 1.0f, 0); w = __builtin_amdgcn_cvt_scalef32_pk_fp4_f32(w, v[bb][j].z * inv, v[bb][j].w * inv, 1.0f, 1);
                        *(unsigned short*)(drow + (size_t)j * NEXP * 128) = (unsigned short)w; }
                    if (lane == 0) (isv ? cv_sv : cv_su)[ex] = scl; } }
        }
    }
    if (tid < 128) {
        const int L = tid;
        unsigned t[16];
#pragma unroll
        for (int q = 0; q < 16; ++q) t[q] = 0u;
#pragma unroll 1
        for (int blk = 0; blk < 8; ++blk) {
            unsigned bk[16];
#pragma unroll
            for (int i = 0; i < 16; ++i) { const int k = blk * 16 + i; bk[i] = (ord_key(sc[L * 129 + k]) & ~127u) | (unsigned)(127 - k); }
            bitonic_sort16_desc(bk);
#pragma unroll
            for (int i = 0; i < 16; ++i) t[i] = t[i] > bk[15 - i] ? t[i] : bk[15 - i];
            bitonic_merge16_desc(t);
        }
#pragma unroll
        for (int q = 0; q < 16; ++q) { const int idx = 127 - (int)(t[q] & 127u); tv[L * 16 + q] = sc[L * 129 + idx]; ti[L * 16 + q] = idx; }
    }
    if (wave == 1) { LDS_WAIT(); if (lane == 0) *(volatile LAS int*)(lds + LDS_MISC + 128) = seq; }
    if (wave == 0) { LDS_WAIT(); while (*(volatile LAS int*)(lds + LDS_MISC + 128) != seq) __builtin_amdgcn_s_sleep(1); }
    if (tid < 64) {
        const int tok = tid;
        float a[16], bq[16];
#pragma unroll
        for (int i = 0; i < 16; ++i) { a[i] = tv[tok * 16 + i]; bq[i] = tv[(64 + tok) * 16 + i]; }
        unsigned t[16];
#pragma unroll
        for (int q = 0; q < 16; ++q) t[q] = 0u;
#pragma unroll
        for (int i = 0; i < 16; ++i)
#pragma unroll
            for (int j = 0; j < 16 / (i + 1); ++j) {
                unsigned key = (ord_key(a[i] + bq[j]) & ~255u) | (unsigned)(255 - (i * 16 + j));
#pragma unroll
                for (int q = 0; q < 16; ++q) { const unsigned hi = t[q] > key ? t[q] : key; key = t[q] > key ? key : t[q]; t[q] = hi; }
            }
        float scv[16]; int idv[16]; float mx = NEGBIG;
#pragma unroll
        for (int q = 0; q < 16; ++q) { const int ci = 255 - (int)(t[q] & 255u); const int i = ci >> 4, j = ci & 15;
            scv[q] = tv[tok * 16 + i] + tv[(64 + tok) * 16 + j]; idv[q] = ti[tok * 16 + i] * 128 + ti[(64 + tok) * 16 + j]; mx = fmaxf(mx, scv[q]); }
        float sum = 0.f;
#pragma unroll
        for (int q = 0; q < 16; ++q) { scv[q] = __expf(scv[q] - mx); sum += scv[q]; }
        const float inv = 1.f / sum;
        int* ip = IDS + (size_t)(row0 + tok) * 128 + h * 16; float* gp = GG + (size_t)(row0 + tok) * 128 + h * 16;
#pragma unroll
        for (int q4 = 0; q4 < 4; ++q4) {
            *(int4*)(ip + 4 * q4) = make_int4(idv[4 * q4], idv[4 * q4 + 1], idv[4 * q4 + 2], idv[4 * q4 + 3]);
            *(f32x4*)(gp + 4 * q4) = (f32x4){scv[4 * q4] * inv, scv[4 * q4 + 1] * inv, scv[4 * q4 + 2] * inv, scv[4 * q4 + 3] * inv};
        }
    }
    __syncthreads();
}


DEV void expert_row8(int l, int row, const bf16* H, const int* __restrict__ IDS, const float* __restrict__ GG, const unsigned char* __restrict__ U8, const unsigned char* __restrict__ V8,
                     const bf16* __restrict__ X1, const float* __restrict__ g2, const float* __restrict__ fnorm, float* __restrict__ XO, bf16* __restrict__ XOH, int lane, float pscale, LAS int* sortL,
                     const float* __restrict__ ngain, const float* __restrict__ nmod, bf16* Hout) {
    f32x2 x[16];
#pragma unroll
    for (int j = 0; j < 2; ++j) {
        const v4u a = *(const v4u*)(H + (size_t)row * D + lane * 16 + 1024 * j), c = *(const v4u*)(H + (size_t)row * D + lane * 16 + 1024 * j + 8);
        x[j * 8 + 0] = (f32x2){bf_lo(a.x), bf_hi(a.x)}; x[j * 8 + 1] = (f32x2){bf_lo(a.y), bf_hi(a.y)}; x[j * 8 + 2] = (f32x2){bf_lo(a.z), bf_hi(a.z)}; x[j * 8 + 3] = (f32x2){bf_lo(a.w), bf_hi(a.w)};
        x[j * 8 + 4] = (f32x2){bf_lo(c.x), bf_hi(c.x)}; x[j * 8 + 5] = (f32x2){bf_lo(c.y), bf_hi(c.y)}; x[j * 8 + 6] = (f32x2){bf_lo(c.z), bf_hi(c.z)}; x[j * 8 + 7] = (f32x2){bf_lo(c.w), bf_hi(c.w)};
    }
    int id0 = IDS[(size_t)row * 128 + lane], id1 = IDS[(size_t)row * 128 + 64 + lane];
    float gg0 = GG[(size_t)row * 128 + lane], gg1 = GG[(size_t)row * 128 + 64 + lane];
    {
        const int w0 = id0 >> 9, w1 = id1 >> 9; int p0 = 0, p1 = 0, base = 0;
        for (int w = 0; w < 32; ++w) {
            const unsigned long long m0 = __ballot(w0 == w), m1 = __ballot(w1 == w);
            const int c0 = __popcll(m0), c1 = __popcll(m1);
            const int b0 = (int)__builtin_amdgcn_mbcnt_hi((unsigned)(m0 >> 32), __builtin_amdgcn_mbcnt_lo((unsigned)m0, 0u));
            const int b1 = (int)__builtin_amdgcn_mbcnt_hi((unsigned)(m1 >> 32), __builtin_amdgcn_mbcnt_lo((unsigned)m1, 0u));
            p0 = (w0 == w) ? base + b0 : p0; p1 = (w1 == w) ? base + c0 + b1 : p1;
            base += c0 + c1;
        }
        sortL[p0] = id0; sortL[p1] = id1; ((LAS float*)sortL)[128 + p0] = gg0; ((LAS float*)sortL)[128 + p1] = gg1;
        LDS_WAIT();
        id0 = sortL[lane]; id1 = sortL[64 + lane]; gg0 = ((LAS float*)sortL)[128 + lane]; gg1 = ((LAS float*)sortL)[192 + lane];
        LDS_WAIT();
    }
    float wv0 = 0.f, wv1 = 0.f;
    const unsigned char* Ul = U8 + (size_t)l * NEXP * D + lane * 16;
    const unsigned char* Vl = V8 + (size_t)l * NEXP * D + lane * 16;
    for (int e0 = 0; e0 < 128; e0 += 8) {
        v4u uu[8][2];
#pragma unroll
        for (int q = 0; q < 8; ++q) { const int e = e0 + q; const int id = (e < 64) ? __builtin_amdgcn_readlane(id0, e & 63) : __builtin_amdgcn_readlane(id1, e & 63);
            uu[q][0] = *(const v4u*)(Ul + (size_t)id * D); uu[q][1] = *(const v4u*)(Ul + (size_t)id * D + 1024); }
        float ds[8];
#pragma unroll
        for (int q = 0; q < 8; ++q) {
            f32x2 acc = {0.f, 0.f};
#pragma unroll
            for (int j = 0; j < 2; ++j) {
                const unsigned wd[4] = {uu[q][j].x, uu[q][j].y, uu[q][j].z, uu[q][j].w};
#pragma unroll
                for (int dw = 0; dw < 4; ++dw) {
                    const f32x2 lo = __builtin_amdgcn_cvt_pk_f32_fp8((int)wd[dw], false), hi = __builtin_amdgcn_cvt_pk_f32_fp8((int)wd[dw], true);
                    acc = __builtin_elementwise_fma(lo, x[j * 8 + 2 * dw], acc); acc = __builtin_elementwise_fma(hi, x[j * 8 + 2 * dw + 1], acc);
                }
            }
            ds[q] = acc.x + acc.y;
        }
#pragma unroll
        for (int q = 0; q < 8; ++q) ds[q] += swz_xor<1>(ds[q]);
#pragma unroll
        for (int q = 0; q < 8; ++q) ds[q] += swz_xor<2>(ds[q]);
#pragma unroll
        for (int q = 0; q < 8; ++q) ds[q] += swz_xor<4>(ds[q]);
#pragma unroll
        for (int q = 0; q < 8; ++q) ds[q] += swz_xor<8>(ds[q]);
#pragma unroll
        for (int q = 0; q < 8; ++q) ds[q] += swz_xor<16>(ds[q]);
#pragma unroll
        for (int q = 0; q < 8; ++q) ds[q] = sum32(ds[q]);
#pragma unroll
        for (int q = 0; q < 8; ++q) { const int e = e0 + q;
            const float gq = (e < 64) ? __builtin_bit_cast(float, __builtin_amdgcn_readlane(__builtin_bit_cast(int, gg0), e & 63)) : __builtin_bit_cast(float, __builtin_amdgcn_readlane(__builtin_bit_cast(int, gg1), e & 63));
            const float w = gq * gelu_tanh(ds[q] * (1.f / U8_SCALE));
            if (e < 64) wv0 = (lane == (e & 63)) ? w : wv0; else wv1 = (lane == (e & 63)) ? w : wv1; }
    }
    f32x2 y[16];
#pragma unroll
    for (int i = 0; i < 16; ++i) y[i] = (f32x2){0.f, 0.f};
    for (int e0 = 0; e0 < 128; e0 += 8) {
        v4u vv[8][2];
#pragma unroll
        for (int q = 0; q < 8; ++q) { const int e = e0 + q; const int id = (e < 64) ? __builtin_amdgcn_readlane(id0, e & 63) : __builtin_amdgcn_readlane(id1, e & 63);
            vv[q][0] = *(const v4u*)(Vl + (size_t)id * D); vv[q][1] = *(const v4u*)(Vl + (size_t)id * D + 1024); }
#pragma unroll
        for (int q = 0; q < 8; ++q) { const int e = e0 + q;
            const float w = (e < 64) ? __builtin_bit_cast(float, __builtin_amdgcn_readlane(__builtin_bit_cast(int, wv0), e & 63)) : __builtin_bit_cast(float, __builtin_amdgcn_readlane(__builtin_bit_cast(int, wv1), e & 63));
            const f32x2 w2 = {w, w};
#pragma unroll
            for (int j = 0; j < 2; ++j) {
                const unsigned wd[4] = {vv[q][j].x, vv[q][j].y, vv[q][j].z, vv[q][j].w};
#pragma unroll
                for (int dw = 0; dw < 4; ++dw) {
                    const f32x2 lo = __builtin_amdgcn_cvt_pk_f32_fp8((int)wd[dw], false), hi = __builtin_amdgcn_cvt_pk_f32_fp8((int)wd[dw], true);
                    y[j * 8 + 2 * dw] = __builtin_elementwise_fma(w2, lo, y[j * 8 + 2 * dw]); y[j * 8 + 2 * dw + 1] = __builtin_elementwise_fma(w2, hi, y[j * 8 + 2 * dw + 1]);
                }
            }
        }
    }
    float ssq = 0.f;
#pragma unroll
    for (int j = 0; j < 2; ++j)
#pragma unroll
        for (int k4 = 0; k4 < 4; ++k4) {
            const int col = lane * 16 + 1024 * j + 4 * k4;
            const unsigned long long xw = *(const unsigned long long*)(X1 + (size_t)row * D + col); const f32x4 xa = {bf_lo((unsigned)xw), bf_hi((unsigned)xw), bf_lo((unsigned)(xw >> 32)), bf_hi((unsigned)(xw >> 32))}; const f32x4 ga = *(const f32x4*)(g2 + col) * pscale;
            f32x2& ya = y[j * 8 + 2 * k4]; f32x2& yb = y[j * 8 + 2 * k4 + 1];
            ya.x = xa.x + ga.x * ya.x; ya.y = xa.y + ga.y * ya.y; yb.x = xa.z + ga.z * yb.x; yb.y = xa.w + ga.w * yb.y;
            ssq += (ya.x * ya.x + ya.y * ya.y) + (yb.x * yb.x + yb.y * yb.y);
        }
    const float r = rsqrtf(wave_sum(ssq) * (1.f / D) + EPS);
#pragma unroll
    for (int j = 0; j < 2; ++j)
#pragma unroll
        for (int k4 = 0; k4 < 4; ++k4) {
            const int col = lane * 16 + 1024 * j + 4 * k4;
            const f32x2 ya = y[j * 8 + 2 * k4], yb = y[j * 8 + 2 * k4 + 1];
            f32x4 ov = {ya.x, ya.y, yb.x, yb.y};
            if (fnorm) *(f32x4*)(XO + (size_t)row * D + col) = ov * r * *(const f32x4*)(fnorm + col);
            else *(unsigned long long*)(XOH + (size_t)row * D + col) = (unsigned long long)pk2(ov.x, ov.y) | ((unsigned long long)pk2(ov.z, ov.w) << 32);
            if (ngain) {
                const f32x4 g = *(const f32x4*)(ngain + col), sc = *(const f32x4*)(nmod + MO_SC1 + col), sh = *(const f32x4*)(nmod + MO_SH1 + col);
                const f32x4 hv = (ov * r) * g * (sc + 1.f) + sh;
                *(unsigned long long*)(Hout + (size_t)row * D + col) = (unsigned long long)pk2(hv.x, hv.y) | ((unsigned long long)pk2(hv.z, hv.w) << 32);
            }
        }
}


DEV int claim_unit(unsigned* cnt, LAS int* claimL, int w0) {
    __syncthreads();
    if (xb_lead(w0)) *claimL = (int)__hip_atomic_fetch_add(cnt, 1u, __ATOMIC_RELAXED, __HIP_MEMORY_SCOPE_AGENT);
    __syncthreads();
    return *(volatile LAS int*)claimL;
}
struct ExIds { int id[16]; };
DEV void ex_load_ids(ExIds& I, int t, const int* __restrict__ IDS, int rg) {
#pragma unroll
    for (int q = 0; q < 4; ++q) { const int4 v = *(const int4*)(IDS + (size_t)t * 128 + 16 * rg + 4 * q); I.id[4 * q] = v.x; I.id[4 * q + 1] = v.y; I.id[4 * q + 2] = v.z; I.id[4 * q + 3] = v.w; }
}
DEV void ex_load_rows(v4u (&r)[16], const ExIds& I, const unsigned char* __restrict__ Tb) {
#pragma unroll
    for (int i = 0; i < 16; ++i) r[i] = *(const v4u*)(Tb + (size_t)I.id[i] * 128);
}
DEV void exu_compute(const v4u (&uu)[16], const v4u (&xp)[4], float* __restrict__ pp, int cl) {
    f32x2 x[16];
#pragma unroll
    for (int q = 0; q < 4; ++q) { x[4 * q] = (f32x2){bf_lo(xp[q].x), bf_hi(xp[q].x)}; x[4 * q + 1] = (f32x2){bf_lo(xp[q].y), bf_hi(xp[q].y)}; x[4 * q + 2] = (f32x2){bf_lo(xp[q].z), bf_hi(xp[q].z)}; x[4 * q + 3] = (f32x2){bf_lo(xp[q].w), bf_hi(xp[q].w)}; }
    float pd[16];
#pragma unroll
    for (int i = 0; i < 16; ++i) {
        const unsigned uw[4] = {uu[i].x, uu[i].y, uu[i].z, uu[i].w}; f32x2 a0 = {0.f, 0.f}, a1 = {0.f, 0.f};
#pragma unroll
        for (int dw = 0; dw < 4; ++dw) {
            a0 = __builtin_elementwise_fma(__builtin_amdgcn_cvt_scalef32_pk_f32_fp4(uw[dw], 1.0f, 0), x[4 * dw], a0); a1 = __builtin_elementwise_fma(__builtin_amdgcn_cvt_scalef32_pk_f32_fp4(uw[dw], 1.0f, 1), x[4 * dw + 1], a1);
            a0 = __builtin_elementwise_fma(__builtin_amdgcn_cvt_scalef32_pk_f32_fp4(uw[dw], 1.0f, 2), x[4 * dw + 2], a0); a1 = __builtin_elementwise_fma(__builtin_amdgcn_cvt_scalef32_pk_f32_fp4(uw[dw], 1.0f, 3), x[4 * dw + 3], a1); }
        pd[i] = (a0.x + a1.x) + (a0.y + a1.y);
    }
    const bool b2 = (cl & 4) != 0, b1 = (cl & 2) != 0, b0 = (cl & 1) != 0;
    float v8[8], v4[4], v2[2];
#pragma unroll
    for (int j = 0; j < 8; ++j) { const float keep = b2 ? pd[8 + j] : pd[j], give = b2 ? pd[j] : pd[8 + j]; v8[j] = keep + swz_xor<4>(give); }
#pragma unroll
    for (int j = 0; j < 4; ++j) { const float keep = b1 ? v8[4 + j] : v8[j], give = b1 ? v8[j] : v8[4 + j]; v4[j] = keep + swz_xor<2>(give); }
#pragma unroll
    for (int j = 0; j < 2; ++j) { const float keep = b0 ? v4[2 + j] : v4[j], give = b0 ? v4[j] : v4[2 + j]; v2[j] = keep + swz_xor<1>(give); }
    *(f32x2*)pp = (f32x2){v2[0], v2[1]};
}
template <int NT>
DEV void exu_unit(int s, int t0, const bf16* __restrict__ H, const int* __restrict__ IDS, const unsigned char* __restrict__ U8l, float* __restrict__ PD, int lane) {
    const int rg = lane >> 3, cl = lane & 7;
    const unsigned char* Ub = U8l + (size_t)s * NEXP * 128 + cl * 16;
    ExIds Ia, Ib; v4u ra[16], rb[16]; v4u xa[4], xb[4];
#define EXU_X(XV, T) do { const v4u* xp_ = (const v4u*)(H + (size_t)(T) * D + 256 * s + 32 * cl); XV[0] = xp_[0]; XV[1] = xp_[1]; XV[2] = xp_[2]; XV[3] = xp_[3]; } while (0)
    ex_load_ids(Ia, t0, IDS, rg); EXU_X(xa, t0);
    ex_load_rows(ra, Ia, Ub);
    if (NT > 1) { ex_load_ids(Ib, t0 + 1, IDS, rg); EXU_X(xb, t0 + 1); }
#pragma unroll
    for (int k = 0; k < NT; k += 2) {
        if (k + 1 < NT) ex_load_rows(rb, Ib, Ub);
        if (k + 2 < NT) { ex_load_ids(Ia, t0 + k + 2, IDS, rg); }
        exu_compute(ra, xa, PD + ((size_t)s * M + t0 + k) * 128 + 16 * rg + 2 * cl, cl);
        if (k + 2 < NT) { EXU_X(xa, t0 + k + 2); ex_load_rows(ra, Ia, Ub); }
        if (k + 1 < NT) {
            if (k + 3 < NT) { ex_load_ids(Ib, t0 + k + 3, IDS, rg); }
            exu_compute(rb, xb, PD + ((size_t)s * M + t0 + k + 1) * 128 + 16 * rg + 2 * cl, cl);
            if (k + 3 < NT) { EXU_X(xb, t0 + k + 3); }
        }
    }
#undef EXU_X
}
struct ExW { float w[16]; };
DEV void ex_load_w(ExW& W, int t, const float* __restrict__ WE, int rg) {
#pragma unroll
    for (int q = 0; q < 4; ++q) { const f32x4 w = *(const f32x4*)(WE + (size_t)t * 128 + 16 * rg + 4 * q); W.w[4 * q] = w.x; W.w[4 * q + 1] = w.y; W.w[4 * q + 2] = w.z; W.w[4 * q + 3] = w.w; }
}
DEV void exv_compute(const v4u (&vv)[16], const ExW& W, int s, int t, const bf16* __restrict__ X1, const float* __restrict__ g2, bf16* __restrict__ XO, int rg, int cl) {
    f32x2 y[16];
#pragma unroll
    for (int i = 0; i < 16; ++i) y[i] = (f32x2){0.f, 0.f};
#pragma unroll
    for (int i = 0; i < 16; ++i) {
        const unsigned vw[4] = {vv[i].x, vv[i].y, vv[i].z, vv[i].w}; const f32x2 w2 = {W.w[i], W.w[i]};
#pragma unroll
        for (int dw = 0; dw < 4; ++dw) {
            y[4 * dw] = __builtin_elementwise_fma(w2, __builtin_amdgcn_cvt_scalef32_pk_f32_fp4(vw[dw], 1.0f, 0), y[4 * dw]); y[4 * dw + 1] = __builtin_elementwise_fma(w2, __builtin_amdgcn_cvt_scalef32_pk_f32_fp4(vw[dw], 1.0f, 1), y[4 * dw + 1]);
            y[4 * dw + 2] = __builtin_elementwise_fma(w2, __builtin_amdgcn_cvt_scalef32_pk_f32_fp4(vw[dw], 1.0f, 2), y[4 * dw + 2]); y[4 * dw + 3] = __builtin_elementwise_fma(w2, __builtin_amdgcn_cvt_scalef32_pk_f32_fp4(vw[dw], 1.0f, 3), y[4 * dw + 3]); }
    }
    const bool c5 = (rg & 4) != 0, c4 = (rg & 2) != 0, c3 = (rg & 1) != 0;
    f32x2 u8[8], u4[4], u2[2];
#pragma unroll
    for (int j = 0; j < 8; ++j) { const f32x2 keep = c5 ? y[8 + j] : y[j], give = c5 ? y[j] : y[8 + j]; u8[j].x = keep.x + part32_(give.x); u8[j].y = keep.y + part32_(give.y); }
#pragma unroll
    for (int j = 0; j < 4; ++j) { const f32x2 keep = c4 ? u8[4 + j] : u8[j], give = c4 ? u8[j] : u8[4 + j]; u4[j].x = keep.x + swz_xor<16>(give.x); u4[j].y = keep.y + swz_xor<16>(give.y); }
#pragma unroll
    for (int j = 0; j < 2; ++j) { const f32x2 keep = c3 ? u4[2 + j] : u4[j], give = c3 ? u4[j] : u4[2 + j]; u2[j].x = keep.x + swz_xor<8>(give.x); u2[j].y = keep.y + swz_xor<8>(give.y); }
    {
        const size_t o = (size_t)t * D + 256 * s + 32 * cl + 4 * rg;
        const unsigned long long xw = *(const unsigned long long*)(X1 + o); const f32x4 gg = *(const f32x4*)(g2 + 256 * s + 32 * cl + 4 * rg);
        const unsigned lo = pk2(bf_lo((unsigned)xw) + gg.x * u2[0].x, bf_hi((unsigned)xw) + gg.y * u2[0].y), hi = pk2(bf_lo((unsigned)(xw >> 32)) + gg.z * u2[1].x, bf_hi((unsigned)(xw >> 32)) + gg.w * u2[1].y);
        *(unsigned long long*)(XO + o) = (unsigned long long)lo | ((unsigned long long)hi << 32);
    }
}
template <int NT>
DEV void exv_unit(int s, int t0, const int* __restrict__ IDS, const float* __restrict__ WE, const unsigned char* __restrict__ V8l, const bf16* __restrict__ X1, const float* __restrict__ g2b  ,
                  bf16* __restrict__ XO, int lane) {
    const int rg = lane >> 3, cl = lane & 7;
    const unsigned char* Vb = V8l + (size_t)s * NEXP * 128 + cl * 16;
    ExIds Ia, Ib; ExW Wa, Wb; v4u ra[16], rb[16];
    ex_load_ids(Ia, t0, IDS, rg); ex_load_w(Wa, t0, WE, rg);
    ex_load_rows(ra, Ia, Vb);
    if (NT > 1) { ex_load_ids(Ib, t0 + 1, IDS, rg); ex_load_w(Wb, t0 + 1, WE, rg); }
#pragma unroll
    for (int k = 0; k < NT; k += 2) {
        if (k + 1 < NT) ex_load_rows(rb, Ib, Vb);
        if (k + 2 < NT) ex_load_ids(Ia, t0 + k + 2, IDS, rg);
        exv_compute(ra, Wa, s, t0 + k, X1, g2b + (size_t)((t0 + k) >> 12) * MODW, XO, rg, cl);
        if (k + 2 < NT) { ex_load_w(Wa, t0 + k + 2, WE, rg); ex_load_rows(ra, Ia, Vb); }
        if (k + 1 < NT) {
            if (k + 3 < NT) ex_load_ids(Ib, t0 + k + 3, IDS, rg);
            exv_compute(rb, Wb, s, t0 + k + 1, X1, g2b + (size_t)((t0 + k + 1) >> 12) * MODW, XO, rg, cl);
            if (k + 3 < NT) ex_load_w(Wb, t0 + k + 3, WE, rg);
        }
    }
}
DEV void finalnorm_rows(const bf16* __restrict__ X, const float* __restrict__ gain, float* __restrict__ O, int gw, int NGW, int lane) {
    for (int m = gw; m < M; m += NGW) {
        const v4u* xr = (const v4u*)(X + (size_t)m * D) + lane;
        float v[32]; float sq = 0.f;
#pragma unroll
        for (int j = 0; j < 4; ++j) { const v4u w = xr[64 * j];
            v[8 * j + 0] = bf_lo(w.x); v[8 * j + 1] = bf_hi(w.x); v[8 * j + 2] = bf_lo(w.y); v[8 * j + 3] = bf_hi(w.y); v[8 * j + 4] = bf_lo(w.z); v[8 * j + 5] = bf_hi(w.z); v[8 * j + 6] = bf_lo(w.w); v[8 * j + 7] = bf_hi(w.w);
#pragma unroll
            for (int e = 0; e < 8; ++e) sq += v[8 * j + e] * v[8 * j + e]; }
        const float r = rsqrtf(wave_sum(sq) * (1.f / D) + EPS);
#pragma unroll
        for (int j = 0; j < 4; ++j) { const int col = 8 * (lane + 64 * j);
            const f32x4 g0 = *(const f32x4*)(gain + col), g1 = *(const f32x4*)(gain + col + 4);
            *(f32x4*)(O + (size_t)m * D + col) = (f32x4){v[8 * j + 0] * r * g0.x, v[8 * j + 1] * r * g0.y, v[8 * j + 2] * r * g0.z, v[8 * j + 3] * r * g0.w};
            *(f32x4*)(O + (size_t)m * D + col + 4) = (f32x4){v[8 * j + 4] * r * g1.x, v[8 * j + 5] * r * g1.y, v[8 * j + 6] * r * g1.z, v[8 * j + 7] * r * g1.w}; }
    }
}

struct Args { const float* in[24]; float* out; unsigned char* ws; int ph_lo, ph_hi, li, pad; };

__global__ void __launch_bounds__(512, 2) fwd(Args a) {
    extern __shared__ __attribute__((aligned(16))) unsigned char lds_raw[];
    LAS unsigned char* lds = (LAS unsigned char*)lds_raw;
#define PHASE_TID() unsigned zz_ = 0u; asm volatile("" : "+v"(zz_));   \
    int tid = wave0 * 64 + (int)__builtin_amdgcn_mbcnt_hi(~0u, __builtin_amdgcn_mbcnt_lo(~0u, zz_)); const int lane = tid & 63; (void)lane; \
    int bx = blockIdx.x, G = gridDim.x; asm volatile("" : "+s"(bx), "+s"(G)); const int wave = __builtin_amdgcn_readfirstlane(tid >> 6); \
    const int vcu = (G % 8 == 0) ? (bx % 8) * (G / 8) + bx / 8 : bx; const int gw = vcu * 8 + wave, NGW = G * 8; (void)gw; (void)NGW; (void)vcu; (void)wave; \
    const __attribute__((address_space(4))) Args* A = (const __attribute__((address_space(4))) Args*)__builtin_amdgcn_kernarg_segment_ptr(); asm volatile("" : "+s"(A))
    unsigned* ctl = (unsigned*)(a.ws + WS_CTL);
    const int lo = a.ph_lo, hi = a.ph_hi;
    const int wave0 = __builtin_amdgcn_readfirstlane((int)threadIdx.x >> 6);
    for (int u = threadIdx.x; u < (LDS_BYTES - LDS_MISC) / 4; u += 512) ((LAS unsigned*)(lds + LDS_MISC))[u] = 0u;
    __syncthreads();
    XcdBarrier bar; bar.bar = ctl + CW_BAR + (a.li & 7) * XCD_BAR_WORDS; bar.x = 0; bar.st = (volatile LAS unsigned*)(lds + LDS_MISC + 64); bar.w0 = wave0;
    if (hi - lo > 1) bar = xcd_barrier_post(ctl + CW_BAR + (a.li & 7) * XCD_BAR_WORDS, (volatile LAS unsigned*)(lds + LDS_MISC + 64), wave0);
#define IN(k) (lo <= (k) && (k) < hi)
#define SEAM(k) do { if (IN(k) && IN((k) + 1)) xcd_barrier(bar); } while (0)
#if MK_DUP >= 0
#define PH(k) if (IN(pb + (k))) for (int rep_ = 0; rep_ < ((MK_DUP == (k)) ? 2 : 1); ++rep_)
#define PH_SYNC if (rep_) __syncthreads();
#define PH_REP rep_
#define PH_UNIT(k) for (int r2_ = 0; r2_ < ((MK_DUP == (k)) ? 2 : 1); ++r2_)
#else
#define PH(k) if (IN(pb + (k)))
#define PH_SYNC
#define PH_REP 0
#define PH_UNIT(k)
#endif

#define mod   ((float*)(A->ws + WS_MOD))
#define WIN_T ((bf16*)(A->ws + WS_WIN_T))
#define WOUT_T ((bf16*)(A->ws + WS_WOUT_T))
#define WQ_T  ((bf16*)(A->ws + WS_WQ_T))
#define SUBK  ((bf16*)(A->ws + WS_SUBK))
#define UB    ((bf16*)(A->ws + WS_U))
#define VB    ((bf16*)(A->ws + WS_V))
#define H     ((bf16*)(A->ws + WS_H))
#define Z     ((bf16*)(A->ws + WS_Z))
#define HLOC  ((bf16*)(A->ws + WS_HLOC))
#define PP    ((bf16*)(A->ws + WS_P))
#define YB    ((float*)(A->ws + WS_YB))
#define YC    ((bf16*)(A->ws + WS_YC))
#define SUMA  ((float*)(A->ws + WS_SUMA))
#define SUMB  ((float*)(A->ws + WS_SUMB))
#define X1    ((float*)(A->ws + WS_X1))
#define X2    ((float*)(A->ws + WS_X2))
#define QB    ((bf16*)(A->ws + WS_Q))
#define IDS   ((int*)(A->ws + WS_IDS))
#define GG    ((float*)(A->ws + WS_G))
#define PARTB ((bf16*)(A->ws + WS_PART))
#define WG_T  ((bf16*)(A->ws + WS_WG_T))
#define PDOT  ((float*)(A->ws + WS_PDOT))
#define SCL   ((float*)(A->ws + WS_SCL))
#define WEXP  ((float*)(A->ws + WS_WEXP))
#define LSEB  ((float*)(A->ws + WS_LSE))
#define XIN   ((l == 0) ? A->in[0] : (const float*)X2)
#define XR    ((bf16*)(A->ws + WS_XR))
#define X1H   ((bf16*)(A->ws + WS_X1))
#define X2H   ((bf16*)(A->ws + WS_X2))
#define XRES  ((l == 0) ? (const bf16*)XR : (const bf16*)X2H)
#define MODL  (mod + (size_t)l * 2 * MODW)
    if (IN(0)) {
        PHASE_TID();
        ph_mod(A->in[1], A->in[2], A->in[3], mod, (LAS float*)lds, vcu, G, tid);
        {
            LAS float* scr = (LAS float*)(lds + wave * 17408);
            constexpr int I_IN = (D / 64) * (IN_W / 64), I_SQ = (D / 64) * (D / 64), I_L = I_IN + 2 * I_SQ;
            for (int it = gw; it < 2 * I_L; it += NGW) {
                const int l = it / I_L; int r = it % I_L;
                if (r < I_IN) { transpose_item64(A->in[6] + (size_t)l * D * IN_W, D, IN_W, WIN_T + (size_t)l * IN_W * D, scr, r, lane); continue; } r -= I_IN;
                if (r < I_SQ) { transpose_item64(A->in[18] + (size_t)l * D * D, D, D, WOUT_T + (size_t)l * D * D, scr, r, lane); continue; } r -= I_SQ;
                transpose_item64(A->in[19] + (size_t)l * D * D, D, D, WQ_T + (size_t)l * D * D, scr, r, lane);
            }
        }
        {
            LAS float* scr = (LAS float*)(lds + wave * 17408);
            for (int it = gw; it < 2 * 6 * 2 * 8; it += NGW) { const int mi = it >> 3, sub = it & 7; const int ln = mi >> 1, g = mi & 1;
                transpose_item((g ? A->in[11] : A->in[9]) + (size_t)ln * 128 * 128, 128, 128, WG_T + ((size_t)ln * 2 + g) * 128 * 128, scr, sub, lane); }
        }
        const size_t gtid = (size_t)vcu * 512 + tid, gstride = (size_t)G * 512;
        convert_copy(A->in[20], SUBK, (size_t)2 * 8 * 2 * 128 * 128 / 8, gtid, gstride);
    }
    SEAM(0);

    for (int l = 0; l < NL; ++l) {
        const int pb = 1 + PH_L * l;
        if (IN(pb + 0) && l == 0) { PHASE_TID(); modnorm_rows(XIN, A->in[4] + l * D, MODL, MO_SH1, MO_SC1, H, gw, NGW, lane, XR); }
        if (l == 0) SEAM(pb + 0);
        PH(1) { PH_SYNC
            PHASE_TID(); (void)tid;
            pg8::Gemm g{H, WIN_T + (size_t)l * IN_W * D, M, IN_W, D}; pg8::StaticOrder S; S.init(M, IN_W, G, bx);
            pg8::EpiBf16<0> E{Z, IN_W, nullptr, 0, 0};
            pg8::gemm_phase<pg8::EpiBf16<0>, pg8::StaticOrder, false>((PG8_LAS unsigned char*)lds, g, S, E, nullptr, wave0);
        }
        SEAM(pb + 1);
        PH(2) { PH_SYNC
            PHASE_TID();
            for (int it = vcu; it < 2 * 64 * 6; it += G) {
                const int b = it / 384, r = it % 384, j = r / 6, n = r % 6;
                lru_item2(l, b, j, n, Z, A->in[7], A->in[8], WG_T, A->in[10], A->in[12], A->in[13], HLOC, PP, SUMA, SUMB,
                          (LAS float*)lds, (LAS float*)(lds + 34816), (LAS float*)(lds + 69632), tid);
            }
            {
                {
                    LAS unsigned char* wl = lds + wave * ATT_WLDS;
                    for (int it = gw; it < 1024 + 4608; it += NGW) {
                        if (it < 1024) { const int bh = it >> 7, tl = 127 - (it & 127); sb_mfma_item(bh >> 2, bh & 3, 32 * tl, Z, YC, wl, lane); }
                        else { const int i2 = it - 1024; const int tl = i2 & 127, p = (i2 >> 7) % 3, bh = i2 / 384; const int d = 1 << (2 * p);
                            dil_mfma_item(bh / 6, bh % 6, p, tl % d, 32 * (tl / d), Z, A->in[14], PARTB, LSEB, wl, lane); }
                    }
                }
            }
        }
        SEAM(pb + 2);
        PH(3) { PH_SYNC
            PHASE_TID();
            for (int it = vcu; it < 256; it += G) { const int b = it >> 7, j = (it >> 1) & 63, half = it & 1;
                combine_item(l, b, j, half, Z, HLOC, PP, SUMA, SUMB, PARTB, LSEB, YC, A->in[15], A->in[16], A->in[17], H, (LAS float*)lds, tid); }
        }
        SEAM(pb + 3);
        PH(4) { PH_SYNC
            PHASE_TID(); (void)tid;
            pg8::Gemm g{H, WOUT_T + (size_t)l * D * D, M, D, D}; pg8::StaticOrder S; S.init(M, D, G, bx);
            EpiResGate E{XRES, X1H, MODL + MO_G1, 1.f};
            pg8::gemm_phase<EpiResGate, pg8::StaticOrder, false>((PG8_LAS unsigned char*)lds, g, S, E, nullptr, wave0);
        }
        SEAM(pb + 4);
        PH(5) { PH_SYNC PHASE_TID(); modnorm_rows_h(X1H, A->in[5] + l * D, MODL, MO_SH2, MO_SC2, H, gw, NGW, lane); }
        SEAM(pb + 5);
        PH(6) { PH_SYNC
            PHASE_TID(); (void)tid;
            pg8::Gemm g{H, WQ_T + (size_t)l * D * D, M, D, D}; pg8::StaticOrder S; S.init(M, D, G, bx);
            pg8::EpiBf16<0> E{QB, D, nullptr, 0, 0};
            pg8::gemm_phase<pg8::EpiBf16<0>, pg8::StaticOrder, false>((PG8_LAS unsigned char*)lds, g, S, E, nullptr, wave0);
        }
        SEAM(pb + 6);
        PH(7) { PH_SYNC
            PHASE_TID();
            for (int it = vcu; it < 128 * 8; it += G) route_item2(l, it >> 3, it & 7, QB, SUBK, IDS, GG, lds, tid, l * 1024 + it + 1 + PH_REP * 4096, A->in[21] + (size_t)l * NEXP * D, A->in[22] + (size_t)l * NEXP * D,
                                                                                      (unsigned char*)UB + (size_t)l * NEXP * D, (unsigned char*)VB + (size_t)l * NEXP * D, SCL + (size_t)(2 * l) * NEXP, SCL + (size_t)(2 * l + 1) * NEXP);
        }
        SEAM(pb + 7);
        PH(8) { PH_SYNC
            PHASE_TID();
            LAS int* claimL = (LAS int*)(lds + LDS_MISC + 192);
            const int s0 = (int)xb_xcc_id();
            for (int ds = 0; ds < 8; ++ds) { const int s = (s0 + ds) & 7;
                unsigned* cnt = (unsigned*)(A->ws + WS_CTL) + 45056 + ((l * 2 + 0) * 16 + s) * 64;
                for (;;) { const int c = claim_unit(cnt, claimL, wave0); if (c >= M / 64) break;
                    PH_UNIT(108)
                    exu_unit<8>(s, c * 64 + wave * 8, H, IDS, (const unsigned char*)UB + (size_t)l * NEXP * D, PDOT, lane); } }
        }
        SEAM(pb + 8);
        PH(9) { PH_SYNC
            PHASE_TID();
            const float* su = SCL + (size_t)(2 * l) * NEXP; const float* sv = SCL + (size_t)(2 * l + 1) * NEXP;
            for (int o = vcu * 512 + tid; o < M * 128; o += G * 512) { float d = 0.f; const int id = IDS[o];
#pragma unroll
                for (int sl = 0; sl < 8; ++sl) d += PDOT[(size_t)sl * M * 128 + o];
                WEXP[o] = GG[o] * gelu_tanh(d * su[id]) * sv[id]; }
        }
        SEAM(pb + 9);
        PH(10) { PH_SYNC
            PHASE_TID();
            LAS int* claimL = (LAS int*)(lds + LDS_MISC + 192);
            const int s0 = (int)xb_xcc_id();
            for (int ds = 0; ds < 8; ++ds) { const int s = (s0 + ds) & 7;
                unsigned* cnt = (unsigned*)(A->ws + WS_CTL) + 45056 + ((l * 2 + 1) * 16 + s) * 64;
                for (;;) { const int c = claim_unit(cnt, claimL, wave0); if (c >= M / 64) break;
                    PH_UNIT(110)
                    exv_unit<8>(s, c * 64 + wave * 8, IDS, WEXP, (const unsigned char*)VB + (size_t)l * NEXP * D, X1H, MODL + MO_G2, X2H, lane); } }
        }
        SEAM(pb + 10);
        PH(11) { PH_SYNC
            PHASE_TID();
            if (l + 1 < NL) modnorm_rows_h(X2H, A->in[4] + (l + 1) * D, mod + (size_t)(l + 1) * 2 * MODW, MO_SH1, MO_SC1, H, gw, NGW, lane);
            else finalnorm_rows(X2H, A->in[23], A->out, gw, NGW, lane);
        }
        if (l + 1 < NL) SEAM(pb + 11);
    }
#undef IN
#undef SEAM
#undef mod
#undef H
#undef Z
#undef X1
#undef X2
}
}

extern "C" void kernel_launch(void* const* d_in, const int* in_sizes, int n_in, void* d_out, int out_size, void* d_ws, size_t ws_size, hipStream_t stream) {
    using namespace mk;
    static int grid = 0;
    if (grid == 0) {
        if (n_in != 24 || out_size != M * D || ws_size < WS_END) { fprintf(stderr, "kernel_launch: unexpected shapes (n_in %d out %d ws %zu)\n", n_in, out_size, ws_size); grid = -1; return; }
        int dev = 0, cus = 0, per_cu = 0;
        if (hipGetDevice(&dev) != hipSuccess || hipDeviceGetAttribute(&cus, hipDeviceAttributeMultiprocessorCount, dev) != hipSuccess) { grid = -1; return; }
        if (hipFuncSetAttribute((const void*)fwd, hipFuncAttributeMaxDynamicSharedMemorySize, LDS_BYTES) != hipSuccess) { fprintf(stderr, "kernel_launch: hipFuncSetAttribute failed\n"); grid = -1; return; }
        if (hipOccupancyMaxActiveBlocksPerMultiprocessor(&per_cu, (const void*)fwd, 512, LDS_BYTES) != hipSuccess || per_cu < 1) fprintf(stderr, "kernel_launch: occupancy query says %d\n", per_cu);
        (void)hipGetLastError();
        grid = cus;
    }
    if (grid < 0) return;
    (void)hipMemsetAsync((char*)d_ws + WS_CTL, 0, CTL_ZERO_BYTES, stream);
    Args a{};
    for (int i = 0; i < 24; ++i) a.in[i] = (const float*)d_in[i];
    a.out = (float*)d_out; a.ws = (unsigned char*)d_ws; a.pad = 0;
#ifdef MK_REPEAT_PHASE
    {   const int P = 1 + (MK_REPEAT_PHASE); const int lo_[5] = {0, P, P + 1, P + 12, P + 13}, hi_[5] = {P + 1, P + 1, P + 13, P + 13, NPHASE};
        for (int li = 0; li < 5; ++li) { a.ph_lo = lo_[li]; a.ph_hi = hi_[li]; a.li = li; if (MK_REPEAT_CONTROL && (li == 1 || li == 3)) continue; hipLaunchKernelGGL(fwd, dim3(grid), dim3(512), LDS_BYTES, stream, a); }
        return; }
#endif
    constexpr int NLAUNCH = MK_N_LAUNCHES;
    for (int li = 0; li < NLAUNCH; ++li) {
        a.ph_lo = (NLAUNCH == 1) ? 0 : li; a.ph_hi = (NLAUNCH == 1) ? NPHASE : li + 1; a.li = li;
        hipLaunchKernelGGL(fwd, dim3(grid), dim3(512), LDS_BYTES, stream, a);
    }
}
```

```cpp
#include <hip/hip_runtime.h>
#include <cstdio>
#include <cstdint>
namespace pg8 {
#define PG8_LAS __attribute__((address_space(3)))
typedef unsigned short bf16_t;
typedef short bf16x8 __attribute__((ext_vector_type(8)));
typedef float f32x4 __attribute__((ext_vector_type(4)));
typedef unsigned u32x4 __attribute__((ext_vector_type(4)));
constexpr int BM = 256, BK = 64, HALF = 128, HTB = HALF * BK * 2  , STAGE_BYTES = 8 * HTB, NXCD = 8, WGM = 8;

__host__ __device__ __forceinline__ int lds_byte(int r, int c) { const int st = (r >> 4) * 2 + (c >> 5), rr = r & 15, cc = c & 31, ob = rr * 64 + cc * 2; return st * 1024 + (ob ^ (((ob >> 9) & 1) << 5)); }
__host__ __device__ __forceinline__ void stage_rc(int b, int& R, int& C) { const int st = b / 1024, sb = b % 1024, swz = sb ^ (((sb >> 9) & 1) << 5); R = (st >> 1) * 16 + swz / 64; C = (st & 1) * 32 + (swz % 64) / 2; }
__host__ __device__ __forceinline__ int perm32(int rho) { const int n = rho >> 4, i = rho & 15; return 8 * (i >> 2) + 4 * n + (i & 3); }

struct Unit { int pm, pn; };
struct Gemm { const bf16_t* A; const bf16_t* Bt; int M, N, K; };

struct StaticOrder {
    int nM, nN, nwg, G, c;
    __host__ __device__ void init(int M, int N, int G_, int c_) { nM = M / BM; nN = N / BM; nwg = nM * nN; G = G_; c = c_; }
    __host__ __device__ bool next(int i, Unit& u) const {
        const long L = (long)i * G + c; if (L >= nwg) return false;
        int wgid = (int)L; { const int q = nwg / NXCD, r = nwg % NXCD, xcd = wgid % NXCD, off = wgid / NXCD; wgid = (xcd < r ? xcd * (q + 1) : r * (q + 1) + (xcd - r) * q) + off; }
        const int nig = WGM * nN, gid = wgid / nig, fm = gid * WGM, gsz = (nM - fm) < WGM ? (nM - fm) : WGM;
        u.pm = fm + ((wgid % nig) % gsz); u.pn = (wgid % nig) / gsz; return true;
    }
    __device__ __forceinline__ void a_ready(const Unit&) const {}
    __device__ __forceinline__ void done(const Unit&) const {}
};
struct CountedOrder : StaticOrder {
    const unsigned* ready; unsigned need; unsigned* tmo;
    __device__ __forceinline__ void a_ready(const Unit& u) const {
        if (threadIdx.x < 64) {
            const unsigned long long t0 = __builtin_amdgcn_s_memrealtime(); unsigned polls = 0;
            while ((unsigned)__builtin_amdgcn_readfirstlane(__hip_atomic_load(ready + 64 * u.pm, __ATOMIC_RELAXED, __HIP_MEMORY_SCOPE_AGENT)) < need) {
                if ((++polls & 255u) == 0u && __builtin_amdgcn_readfirstlane(__hip_atomic_load(tmo, __ATOMIC_RELAXED, __HIP_MEMORY_SCOPE_AGENT)) != 0u) break;
                if (__builtin_amdgcn_s_memrealtime() - t0 > 2000000ull) {
                    if (threadIdx.x == 0) { unsigned expect = 0u; __hip_atomic_compare_exchange_strong(tmo + 1, &expect, 0x600u | (unsigned)(u.pm & 0xff), __ATOMIC_RELAXED, __ATOMIC_RELAXED, __HIP_MEMORY_SCOPE_AGENT); __hip_atomic_store(tmo, 1u, __ATOMIC_RELAXED, __HIP_MEMORY_SCOPE_AGENT); }
                    break; }
                __builtin_amdgcn_s_sleep(2); }
            __builtin_amdgcn_fence(__ATOMIC_ACQUIRE, "agent");
            asm volatile("s_waitcnt vmcnt(0)" ::: "memory");
        }
#if !defined(BROKEN_HOOK_NO_BARRIER)
        asm volatile("" ::: "memory"); __builtin_amdgcn_s_barrier(); asm volatile("" ::: "memory");
#endif
    }
};

__device__ __forceinline__ unsigned cvt_pk_bf16(float lo, float hi) { unsigned r; asm volatile("v_cvt_pk_bf16_f32 %0, %1, %2" : "=v"(r) : "v"(lo), "v"(hi)); return r; }
typedef float f32x2 __attribute__((ext_vector_type(2)));
__device__ __forceinline__ f32x2 gelu_pk(f32x2 v) {
    const f32x2 av = __builtin_elementwise_abs(v), d = av * 0.2316418882f + 1.0f;
    f32x2 t; t.x = __builtin_amdgcn_rcpf(d.x); t.y = __builtin_amdgcn_rcpf(d.y);
    f32x2 q = t * 0.5307027145f + (-0.7265760135f); q = q * t + 0.7107068705f; q = q * t + (-0.142248368f); q = q * t + 0.127414796f; q = q * t;
    const f32x2 s = (v * v) * (-0.72134752044f);
    f32x2 e; e.x = __builtin_amdgcn_exp2f(s.x); e.y = __builtin_amdgcn_exp2f(s.y);
    const f32x2 m = v * (q * e), r = v - m;
    f32x2 o; o.x = v.x < 0.f ? m.x : r.x; o.y = v.y < 0.f ? m.y : r.y; return o;
}

struct EpiF32 {
    static constexpr bool PERM = false, AFTER_DRAIN = false;
    float* C; int ldc; const float* bias;
    __device__ __forceinline__ void operator()(const f32x4 (&acc)[2][2][4][2], const Unit& u, int wr, int wc, int fr, int fq) const {
        const int row0 = u.pm * BM + wr * 64 + fr, col0 = u.pn * BM + wc * 32 + 4 * fq;
        f32x4 bv[2][2];
#pragma unroll
        for (int bj = 0; bj < 2; ++bj)
#pragma unroll
            for (int n = 0; n < 2; ++n) bv[bj][n] = bias ? *(const f32x4*)(bias + col0 + bj * HALF + n * 16) : (f32x4){0.f, 0.f, 0.f, 0.f};
#pragma unroll
        for (int ai = 0; ai < 2; ++ai)
#pragma unroll
            for (int m = 0; m < 4; ++m) { float* rowp = C + (size_t)(row0 + ai * HALF + m * 16) * ldc + col0;
#pragma unroll
                for (int bj = 0; bj < 2; ++bj)
#pragma unroll
                    for (int n = 0; n < 2; ++n) *(f32x4*)(rowp + bj * HALF + n * 16) = acc[ai][bj][m][n] + bv[bj][n]; }
    }
};
template <int ACT  > struct EpiBf16 {
    static constexpr bool PERM = true, AFTER_DRAIN = false;
    bf16_t* O; int ldc; const float* bias; int split_cols; size_t split_stride;
    __device__ __forceinline__ void operator()(const f32x4 (&acc)[2][2][4][2], const Unit& u, int wr, int wc, int fr, int fq) const {
        const int row0 = u.pm * BM + wr * 64 + fr; int colt = u.pn * BM; bf16_t* base = O;
        if (split_cols) { const int t = colt / split_cols; base += (size_t)t * split_stride; colt -= t * split_cols; }
        const int col0 = colt + wc * 32 + 8 * fq, bcol0 = u.pn * BM + wc * 32 + 8 * fq;
        f32x4 bv[2][2];
#pragma unroll
        for (int bj = 0; bj < 2; ++bj)
#pragma unroll
            for (int n = 0; n < 2; ++n) bv[bj][n] = bias ? *(const f32x4*)(bias + bcol0 + bj * HALF + 4 * n) : (f32x4){0.f, 0.f, 0.f, 0.f};
#pragma unroll
        for (int ai = 0; ai < 2; ++ai)
#pragma unroll
            for (int m = 0; m < 4; ++m) { bf16_t* rowp = base + (size_t)(row0 + ai * HALF + m * 16) * ldc + col0;
#pragma unroll
                for (int bj = 0; bj < 2; ++bj) { f32x4 v0 = acc[ai][bj][m][0] + bv[bj][0], v1 = acc[ai][bj][m][1] + bv[bj][1];
                    if (ACT == 1) { f32x2 a = gelu_pk((f32x2){v0[0], v0[1]}), b = gelu_pk((f32x2){v0[2], v0[3]}), c = gelu_pk((f32x2){v1[0], v1[1]}), d = gelu_pk((f32x2){v1[2], v1[3]});
                        v0 = (f32x4){a.x, a.y, b.x, b.y}; v1 = (f32x4){c.x, c.y, d.x, d.y}; }
                    if (ACT == 2) {
#pragma unroll
                        for (int j = 0; j < 4; ++j) { v0[j] = 0.5f * v0[j] * (1.0f + erff(v0[j] * 0.70710678f)); v1[j] = 0.5f * v1[j] * (1.0f + erff(v1[j] * 0.70710678f)); } }
                    u32x4 w; w.x = cvt_pk_bf16(v0[0], v0[1]); w.y = cvt_pk_bf16(v0[2], v0[3]); w.z = cvt_pk_bf16(v1[0], v1[1]); w.w = cvt_pk_bf16(v1[2], v1[3]);
                    *(u32x4*)(rowp + bj * HALF) = w; } }
    }
};
template <class Epi, class Sched, bool STAMP = false>
__device__ __forceinline__ void gemm_phase(PG8_LAS unsigned char* lds, const Gemm g, const Sched& S, const Epi& E, unsigned long long* stamps, int wave_id) {
    unsigned zz_o = 0u; asm volatile("" : "+v"(zz_o)); int tid_o = wave_id * 64 + (int)__builtin_amdgcn_mbcnt_hi(~0u, __builtin_amdgcn_mbcnt_lo(~0u, zz_o));
    const int tid = tid_o, wid = __builtin_amdgcn_readfirstlane(tid >> 6), lane = tid & 63, wr = wid >> 2, wc = wid & 3, fr = lane & 15, fq = lane >> 4;
    constexpr int K = 2048, nt = K / BK;
    int ts_lo = 0, ts_hi = 0, nts = 0; const unsigned long long rt_entry = STAMP ? (unsigned long long)wall_clock64() : 0ull;
#define PG8_STAMP() do { if (STAMP && wid == 0 && nts < 64) { const unsigned long long _c = (unsigned long long)clock64(); \
        ts_lo = (lane == nts) ? (int)(unsigned)_c : ts_lo; ts_hi = (lane == nts) ? (int)(unsigned)(_c >> 32) : ts_hi; ++nts; } } while (0)
    PG8_STAMP();
    unsigned voffA[2], voffB[2];
#pragma unroll
    for (int i = 0; i < 2; ++i) { int R, C; stage_rc(tid * 16 + i * 8192, R, C); const int Rb = Epi::PERM ? ((R & ~31) + perm32(R & 31)) : R;
        voffA[i] = (unsigned)(R * K + C) * 2u; voffB[i] = (unsigned)(Rb * K + C) * 2u; }
    const size_t kstep = (size_t)(BK * 2);
    const size_t hstep = (size_t)HALF * K * 2;
    const size_t tstep = 2 * hstep;
    const unsigned ldsw = (unsigned)wid * 1024u;
    const int aoff = lds_byte(wr * 64 + fr, fq * 8), boff = lds_byte(wc * 32 + fr, fq * 8);
#define PG8_SA(b, h) (((b) * 2 + (h)) * HTB)
#define PG8_SB(b, h) ((4 + (b) * 2 + (h)) * HTB)
#define PG8_STAGE(bufoff, gbase, voff) do { _Pragma("unroll") for (int _i = 0; _i < 2; ++_i) \
        __builtin_amdgcn_global_load_lds((const unsigned*)((const char*)(gbase) + (voff)[_i]), (PG8_LAS unsigned*)(lds + (bufoff) + ldsw + _i * 8192), 16, 0, 0); } while (0)
#define PG8_LDA(dst, b, h) do { _Pragma("unroll") for (int m = 0; m < 4; ++m) _Pragma("unroll") for (int k = 0; k < 2; ++k) dst[m][k] = *(const PG8_LAS bf16x8*)(lds + PG8_SA(b, h) + aoff + m * 2048 + k * 1024); } while (0)
#define PG8_LDB(dst, b, h) do { _Pragma("unroll") for (int n = 0; n < 2; ++n) _Pragma("unroll") for (int k = 0; k < 2; ++k) dst[n][k] = *(const PG8_LAS bf16x8*)(lds + PG8_SB(b, h) + boff + n * 2048 + k * 1024); } while (0)
#define PG8_MMA(ai, bj, At, Bt) do { __builtin_amdgcn_s_setprio(1); _Pragma("unroll") for (int m = 0; m < 4; ++m) _Pragma("unroll") for (int n = 0; n < 2; ++n) _Pragma("unroll") for (int k = 0; k < 2; ++k) \
        acc[ai][bj][m][n] = __builtin_amdgcn_mfma_f32_16x16x32_bf16(Bt[n][k], At[m][k], acc[ai][bj][m][n], 0, 0, 0); __builtin_amdgcn_s_setprio(0); } while (0)
#define PG8_WAIT_V(n) asm volatile("s_waitcnt vmcnt(" #n ")" ::: "memory")
#define PG8_WAIT_L(n) asm volatile("s_waitcnt lgkmcnt(" #n ")" ::: "memory")
#define PG8_BAR __builtin_amdgcn_s_barrier()
#define PG8_SCHED __builtin_amdgcn_sched_barrier(0)
    Unit cur, nxt; int ui = 0;
    if (!S.next(0, cur)) return;
    f32x4 acc[2][2][4][2];
#pragma unroll
    for (int a = 0; a < 2; ++a)
#pragma unroll
        for (int b = 0; b < 2; ++b)
#pragma unroll
            for (int m = 0; m < 4; ++m)
#pragma unroll
                for (int n = 0; n < 2; ++n) acc[a][b][m][n] = (f32x4){0.f, 0.f, 0.f, 0.f};
    bf16x8 At[4][2], B0[2][2], B1[2][2];
    const char* cA = (const char*)g.A + (size_t)cur.pm * tstep; const char* cB = (const char*)g.Bt + (size_t)cur.pn * tstep;
    S.a_ready(cur);
    PG8_STAGE(PG8_SB(0, 0), cB, voffB); PG8_STAGE(PG8_SA(0, 0), cA, voffA); PG8_STAGE(PG8_SB(0, 1), cB + hstep, voffB); PG8_STAGE(PG8_SA(0, 1), cA + hstep, voffA);
    if (wr == 1) PG8_BAR;
    PG8_WAIT_V(4); PG8_BAR;
    PG8_STAGE(PG8_SB(1, 0), cB + kstep, voffB); PG8_STAGE(PG8_SA(1, 0), cA + kstep, voffA); PG8_STAGE(PG8_SB(1, 1), cB + hstep + kstep, voffB);
    PG8_WAIT_V(6); PG8_BAR;
    PG8_STAMP();
    for (;;) {
        const bool has_next = S.next(ui + 1, nxt);
        const char* nA = has_next ? (const char*)g.A + (size_t)nxt.pm * tstep : cA; const char* nB = has_next ? (const char*)g.Bt + (size_t)nxt.pn * tstep : cB;
        for (int t = 0; t < nt; t += 2) {
            const bool last = (t == nt - 2);
            const char* a1 = cA + (size_t)(t + 1) * kstep;
            const char* a2 = last ? nA : cA + (size_t)(t + 2) * kstep; const char* b2 = last ? nB : cB + (size_t)(t + 2) * kstep;
            const char* a3 = a2 + kstep; const char* b3 = b2 + kstep;
            if (last && has_next) S.a_ready(nxt);
            PG8_LDB(B0, 0, 0); PG8_SCHED; PG8_LDA(At, 0, 0); PG8_STAGE(PG8_SA(1, 1), a1 + hstep, voffA);
            PG8_WAIT_L(8); PG8_BAR; PG8_WAIT_L(0); PG8_MMA(0, 0, At, B0); PG8_BAR; PG8_SCHED;
            PG8_LDB(B1, 0, 1); PG8_STAGE(PG8_SB(0, 0), b2, voffB);
            PG8_BAR; PG8_WAIT_L(0); PG8_MMA(0, 1, At, B1); PG8_BAR;
            PG8_LDA(At, 0, 1); PG8_STAGE(PG8_SA(0, 0), a2, voffA);
            PG8_BAR; PG8_WAIT_L(0); PG8_MMA(1, 0, At, B0); PG8_BAR; PG8_SCHED;
            PG8_STAGE(PG8_SB(0, 1), b2 + hstep, voffB);
            PG8_WAIT_V(6); PG8_BAR; PG8_MMA(1, 1, At, B1); PG8_BAR;
            PG8_LDB(B0, 1, 0); PG8_SCHED; PG8_LDA(At, 1, 0); PG8_STAGE(PG8_SA(0, 1), a2 + hstep, voffA);
            PG8_WAIT_L(8); PG8_BAR; PG8_WAIT_L(0); PG8_MMA(0, 0, At, B0); PG8_BAR; PG8_SCHED;
            PG8_LDB(B1, 1, 1); PG8_STAGE(PG8_SB(1, 0), b3, voffB);
            PG8_BAR; PG8_WAIT_L(0); PG8_MMA(0, 1, At, B1); PG8_BAR;
            PG8_LDA(At, 1, 1); PG8_STAGE(PG8_SA(1, 0), a3, voffA);
            PG8_BAR; PG8_WAIT_L(0); PG8_MMA(1, 0, At, B0); PG8_BAR; PG8_SCHED;
            PG8_STAGE(PG8_SB(1, 1), b3 + hstep, voffB);
            PG8_WAIT_V(6); PG8_BAR; PG8_MMA(1, 1, At, B1); PG8_BAR;
        }
        PG8_STAMP();
        if constexpr (!Epi::AFTER_DRAIN) { E(acc, cur, wr, wc, fr, fq); S.done(cur); }
        PG8_STAMP();
        if (!has_next) break;
#pragma unroll
        for (int a = 0; a < 2; ++a)
#pragma unroll
            for (int b = 0; b < 2; ++b)
#pragma unroll
                for (int m = 0; m < 4; ++m)
#pragma unroll
                    for (int n = 0; n < 2; ++n) acc[a][b][m][n] = (f32x4){0.f, 0.f, 0.f, 0.f};
        cur = nxt; cA = nA; cB = nB; ++ui;
    }
    PG8_WAIT_V(0);
    if (wr == 0) PG8_BAR;
    PG8_BAR;
    if constexpr (Epi::AFTER_DRAIN) { E.fused(acc, cur, wr, wc, fr, fq, lds, wid, lane); S.done(cur); }
    PG8_STAMP();
    if (STAMP && wid == 0) { stamps[lane] = lane < nts ? (((unsigned long long)(unsigned)ts_hi << 32) | (unsigned)ts_lo) : 0ull;
        if (lane == 62) stamps[62] = rt_entry; if (lane == 63) stamps[63] = (unsigned long long)wall_clock64(); }
#undef PG8_STAMP
#undef PG8_SA
#undef PG8_SB
#undef PG8_STAGE
#undef PG8_LDA
#undef PG8_LDB
#undef PG8_MMA
#undef PG8_WAIT_V
#undef PG8_WAIT_L
#undef PG8_BAR
#undef PG8_SCHED
}
}

namespace mk {
#define GAS __attribute__((address_space(1)))
#define LAS __attribute__((address_space(3)))
#define DEV __device__ __forceinline__
typedef unsigned short bf16;
typedef unsigned v4u __attribute__((ext_vector_type(4)));
typedef float f32x4 __attribute__((ext_vector_type(4)));
typedef float f32x2 __attribute__((ext_vector_type(2)));
typedef short bf16x8 __attribute__((ext_vector_type(8)));
typedef float f32x16 __attribute__((ext_vector_type(16)));
typedef __bf16 bf16x2_t __attribute__((ext_vector_type(2)));

#ifndef MK_DUP
#define MK_DUP -1
#endif
#ifndef MK_REPEAT_CONTROL
#define MK_REPEAT_CONTROL 0
#endif
#ifndef MK_N_LAUNCHES
#define MK_N_LAUNCHES 1
#endif

constexpr int D = 2048, SEQ = 4096, M = 8192, NL = 2;
constexpr int LRU_W = 768, SWA_W = 768, SB_W = 512, IN_W = 5376;
constexpr int ZO_XA = 0, ZO_GA = 768, ZO_QB = 1536, ZO_KB = 2304, ZO_VB = 3072, ZO_QC = 3840, ZO_KC = 4352, ZO_VC = 4864;
constexpr int NEXP = 16384, MODW = 12288;
constexpr int MO_SH1 = 0, MO_SC1 = 2048, MO_G1 = 4096, MO_SH2 = 6144, MO_SC2 = 8192, MO_G2 = 10240;
constexpr float EPS = 1e-6f;
constexpr float QSCALE = 0.08838834764831845f;
constexpr float NEGBIG = -3.0e38f;
constexpr int PH_L = 12;
constexpr int NPHASE = 1 + 2 * PH_L;

constexpr size_t MiB = 1u << 20;
constexpr size_t WS_CTL = 0, CTL_ZERO_BYTES = 1 * MiB;
constexpr size_t WS_MOD = 512 * 1024;
constexpr size_t WS_WIN_T = 2 * MiB, WS_WOUT_T = 44 * MiB, WS_WQ_T = 60 * MiB, WS_SUBK = 76 * MiB, WS_U = 80 * MiB, WS_V = 208 * MiB,
                 WS_H = 336 * MiB, WS_Z = 368 * MiB, WS_HLOC = 452 * MiB, WS_P = 476 * MiB, WS_YB = 500 * MiB, WS_YC = 524 * MiB,
                 WS_SUMA = 540 * MiB, WS_SUMB = 541 * MiB, WS_X1 = 544 * MiB, WS_X2 = 608 * MiB, WS_Q = 672 * MiB, WS_IDS = 704 * MiB,
                 WS_G = 708 * MiB, WS_WG_T = 77 * MiB, WS_PART = 712 * MiB, WS_LSE = 784 * MiB, WS_XR = 786 * MiB, WS_PDOT = 820 * MiB, WS_WEXP = 888 * MiB, WS_SCL = 892 * MiB  , WS_END = 893 * MiB;
constexpr int CW_BAR = 4096;

constexpr int LDS_BYTES = 147456;
constexpr int LDS_MISC = 143360;

__device__ const unsigned char T5B[3][132] = {
 {0,1,2,3,4,5,6,7,8,9,10,11,12,13,14,15,16,16,16,16,16,16,17,17,17,17,17,17,17,17,18,18,18,18,18,18,18,18,18,18,19,19,19,19,19,19,19,19,19,19,19,19,19,19,20,20,20,20,20,20,20,20,20,20,20,20,20,20,20,20,20,20,20,21,21,21,21,21,21,21,21,21,21,21,21,21,21,21,21,21,21,21,21,21,21,21,21,21,21,22,22,22,22,22,22,22,22,22,22,22,22,22,22,22,22,22,22,22,22,22,22,22,22,22,22,22,22,22,22,0,0,0},
 {0,4,8,12,16,16,17,17,18,18,19,19,19,19,20,20,20,20,20,21,21,21,21,21,21,22,22,22,22,22,22,22,22,22,23,23,23,23,23,23,23,23,23,23,23,23,24,24,24,24,24,24,24,24,24,24,24,24,24,24,24,24,25,25,25,25,25,25,25,25,25,25,25,25,25,25,25,25,25,25,25,25,25,26,26,26,26,26,26,26,26,26,26,26,26,26,26,26,26,26,26,26,26,26,26,26,26,26,26,26,26,26,26,27,27,27,27,27,27,27,27,27,27,27,27,27,27,27,27,0,0,0},
 {0,16,18,19,20,21,21,22,22,23,23,23,24,24,24,24,25,25,25,25,25,26,26,26,26,26,26,26,26,27,27,27,27,27,27,27,27,27,27,28,28,28,28,28,28,28,28,28,28,28,28,28,29,29,29,29,29,29,29,29,29,29,29,29,29,29,29,29,29,29,30,30,30,30,30,30,30,30,30,30,30,30,30,30,30,30,30,30,30,30,30,30,30,30,30,31,31,31,31,31,31,31,31,31,31,31,31,31,31,31,31,31,31,31,31,31,31,31,31,31,31,31,31,31,31,31,31,31,31,0,0,0}};

#define LDS_WAIT() asm volatile("s_waitcnt lgkmcnt(0)" ::: "memory")
DEV unsigned f2bf(float f) { unsigned u = __builtin_bit_cast(unsigned, f); return (u + 0x7fffu + ((u >> 16) & 1u)) >> 16; }
DEV unsigned pk2(float lo, float hi) { return f2bf(lo) | (f2bf(hi) << 16); }
DEV float bf_lo(unsigned w) { return __builtin_bit_cast(float, w << 16); }
DEV float bf_hi(unsigned w) { return __builtin_bit_cast(float, w & 0xffff0000u); }
DEV float bf1(bf16 h) { return __builtin_bit_cast(float, ((unsigned)h) << 16); }
template <int MSK> DEV float swz_xor(float v) { return __builtin_bit_cast(float, __builtin_amdgcn_ds_swizzle(__builtin_bit_cast(int, v), (MSK << 10) | 0x1F)); }
DEV float part32_(float v) { int ln = (int)__builtin_amdgcn_mbcnt_hi(~0u, __builtin_amdgcn_mbcnt_lo(~0u, 0u)); asm volatile("" : "+v"(ln)); return __builtin_bit_cast(float, __builtin_amdgcn_ds_bpermute((ln ^ 32) << 2, __builtin_bit_cast(int, v))); }
DEV float sum32(float v) { return v + part32_(v); }
DEV float max32(float v) { return fmaxf(v, part32_(v)); }
DEV float partner32(float v, int hh) { (void)hh; return part32_(v); }
DEV float wave_sum(float v) { v += swz_xor<1>(v); v += swz_xor<2>(v); v += swz_xor<4>(v); v += swz_xor<8>(v); v += swz_xor<16>(v); return sum32(v); }
DEV float wave_max(float v) { v = fmaxf(v, swz_xor<1>(v)); v = fmaxf(v, swz_xor<2>(v)); v = fmaxf(v, swz_xor<4>(v)); v = fmaxf(v, swz_xor<8>(v)); v = fmaxf(v, swz_xor<16>(v)); return max32(v); }
DEV float sigmoid_f(float x) { return 1.f / (1.f + __expf(-x)); }
DEV float softplus_f(float x) { return fmaxf(x, 0.f) + log1pf(__expf(-fabsf(x))); }
DEV float gelu_tanh(float x) { const float u = 0.7978845608028654f * (x + 0.044715f * x * x * x); const float t = 1.f - 2.f / (1.f + __expf(2.f * u)); return 0.5f * x * (1.f + t); }
DEV float dot8(const v4u a, const v4u b) {
    float s = bf_lo(a.x) * bf_lo(b.x); s += bf_hi(a.x) * bf_hi(b.x);
    s += bf_lo(a.y) * bf_lo(b.y); s += bf_hi(a.y) * bf_hi(b.y);
    s += bf_lo(a.z) * bf_lo(b.z); s += bf_hi(a.z) * bf_hi(b.z);
    s += bf_lo(a.w) * bf_lo(b.w); s += bf_hi(a.w) * bf_hi(b.w);
    return s;
}

#define XB_TMO      128
#define XB_XCNT(j)  (256  + 64 * (j))
#define XB_XSUB(j)  (1280 + 64 * (j))
#define XB_XGEN(j)  (2304 + 64 * (j))
#define XB_TOP      3328
#define XB_TOPGEN   3392
#define XCD_BAR_WORDS 3456
#define XB_SPIN_CAP (1u << 18)

__device__ __forceinline__ unsigned xb_ld(unsigned* p)              { return __hip_atomic_load(p, __ATOMIC_RELAXED, __HIP_MEMORY_SCOPE_AGENT); }
__device__ __forceinline__ unsigned xb_add(unsigned* p, unsigned v) { return __hip_atomic_fetch_add(p, v, __ATOMIC_RELAXED, __HIP_MEMORY_SCOPE_AGENT); }
__device__ __forceinline__ unsigned xb_xcc_id() { return (unsigned)__builtin_amdgcn_s_getreg((3 << 11) | 20) & 0xFu; }
#define XB_SPIN(cond, bar) do { unsigned _sp = 0; while (cond) { __builtin_amdgcn_s_sleep(1); \
    if ((++_sp & 255u) == 0u) { if (xb_ld(&(bar)[XB_TMO])) break; if (_sp > XB_SPIN_CAP) { atomicAdd(&(bar)[XB_TMO], 1u); break; } } } } while (0)

struct XcdBarrier {
    unsigned* bar; unsigned x;
    volatile LAS unsigned* st;
    int w0;
};
DEV bool xb_lead(int w0) { return w0 == 0 && __builtin_amdgcn_mbcnt_hi(~0u, __builtin_amdgcn_mbcnt_lo(~0u, 0u)) == 0u; }
__device__ __forceinline__ XcdBarrier xcd_barrier_post(unsigned* bar, volatile LAS unsigned* st, int w0) {
    XcdBarrier b; b.bar = bar; b.x = xb_xcc_id(); b.st = st; b.w0 = w0;
    if (xb_lead(w0)) (void)xb_add(&bar[XB_XCNT(b.x)], 1u);
    return b;
}
__device__ __forceinline__ void xcd_barrier_complete(unsigned* bar, unsigned x, unsigned& nloc, unsigned& nx) {
    const unsigned G = gridDim.x * gridDim.y * gridDim.z;
    unsigned sum, cnt, mine, sp = 0u;
    for (;;) {
        sum = 0u; cnt = 0u; mine = 0u;
#pragma unroll
        for (unsigned j = 0; j < 16; ++j) { const unsigned c = xb_ld(&bar[XB_XCNT(j)]); sum += c; cnt += (c > 0u) ? 1u : 0u; mine = (j == x) ? c : mine; }
        if (sum == G) break;
        __builtin_amdgcn_s_sleep(1);
        if ((++sp & 255u) == 0u) { if (xb_ld(&bar[XB_TMO])) break; if (sp > XB_SPIN_CAP) { atomicAdd(&bar[XB_TMO], 1u); break; } }
    }
    nloc = mine > 0u ? mine : 1u; nx = cnt > 0u ? cnt : 1u;
}
__device__ __forceinline__ void xcd_barrier(const XcdBarrier& b) {
    asm volatile("s_waitcnt vmcnt(0)" ::: "memory");
    __syncthreads();
    if (xb_lead(b.w0)) {
        unsigned* bar = b.bar;
        __builtin_amdgcn_s_waitcnt(0);
        unsigned nloc = b.st[0], nx = b.st[1];
        if (nloc == 0u) { xcd_barrier_complete(bar, b.x, nloc, nx); b.st[0] = nloc; b.st[1] = nx; }
        const unsigned old = xb_add(&bar[XB_XSUB(b.x)], 1u);
        const unsigned gen = old / nloc;
        if (old + 1u == (gen + 1u) * nloc) {
            __builtin_amdgcn_fence(__ATOMIC_RELEASE, "agent");
            asm volatile("s_waitcnt vmcnt(0)" ::: "memory");
            const unsigned og = xb_add(&bar[XB_TOP], 1u);
            const unsigned tg = og / nx;
            if (og + 1u == (tg + 1u) * nx) xb_add(&bar[XB_TOPGEN], 1u);
            else XB_SPIN(xb_ld(&bar[XB_TOPGEN]) == tg, bar);
            __builtin_amdgcn_fence(__ATOMIC_ACQUIRE, "agent");
            xb_add(&bar[XB_XGEN(b.x)], 1u);
            asm volatile("s_waitcnt vmcnt(0)" ::: "memory");
        } else {
            XB_SPIN(xb_ld(&bar[XB_XGEN(b.x)]) == gen, bar);
            __builtin_amdgcn_fence(__ATOMIC_ACQUIRE, "agent");
            asm volatile("s_waitcnt vmcnt(0)" ::: "memory");
        }
    }
    __syncthreads();
}

struct EpiResGate {
    static constexpr bool PERM = true, AFTER_DRAIN = false;
    const bf16* X; bf16* O; const float* gate; float gscale;
    __device__ __forceinline__ void operator()(const pg8::f32x4 (&acc)[2][2][4][2], const pg8::Unit& u, int wr, int wc, int fr, int fq) const {
        const int row0 = u.pm * 256 + wr * 64 + fr, col0 = u.pn * 256 + wc * 32 + 8 * fq;
        const float* gp = gate + (size_t)((u.pm * 256) >> 12) * MODW;
        pg8::f32x4 gv[2][2];
#pragma unroll
        for (int bj = 0; bj < 2; ++bj)
#pragma unroll
            for (int n = 0; n < 2; ++n) gv[bj][n] = *(const pg8::f32x4*)(gp + col0 + bj * 128 + 4 * n) * gscale;
#pragma unroll
        for (int ai = 0; ai < 2; ++ai)
#pragma unroll
            for (int m = 0; m < 4; ++m) {
                const size_t ro = (size_t)(row0 + ai * 128 + m * 16) * D + col0;
#pragma unroll
                for (int bj = 0; bj < 2; ++bj) {
                    const v4u xw = *(const v4u*)(X + ro + bj * 128);
                    const pg8::f32x4 x0 = {bf_lo(xw.x), bf_hi(xw.x), bf_lo(xw.y), bf_hi(xw.y)}, x1 = {bf_lo(xw.z), bf_hi(xw.z), bf_lo(xw.w), bf_hi(xw.w)};
                    const pg8::f32x4 o0 = x0 + gv[bj][0] * acc[ai][bj][m][0], o1 = x1 + gv[bj][1] * acc[ai][bj][m][1];
                    *(v4u*)(O + ro + bj * 128) = (v4u){pk2(o0.x, o0.y), pk2(o0.z, o0.w), pk2(o1.x, o1.y), pk2(o1.z, o1.w)};
                }
            }
    }
};

DEV void ph_mod(const float* __restrict__ c, const float* __restrict__ w_mod, const float* __restrict__ b_mod, float* __restrict__ mod, LAS float* lds_f, int vcu, int G, int tid) {
    const int lane = tid & 63, wave = tid >> 6;
    LAS float* cs = lds_f;
    LAS float* red = lds_f + 4096;
    for (int i = tid; i < 2 * D; i += 512) { const float v = c[i]; cs[i] = v * sigmoid_f(v); }
    __syncthreads();
    const int cg = lane & 15, rg = lane >> 4;
    for (int it = vcu; it < 2 * 192 * 2; it += G) {
        const int kh = it & 1, cb = (it >> 1) % 192, l = it / 384;
        const int k0 = kh * 1024 + wave * 128;
        const float* W = w_mod + ((size_t)l * D + k0 + rg) * MODW + cb * 64 + cg * 4;
        f32x4 a0 = {0.f, 0.f, 0.f, 0.f}, a1 = {0.f, 0.f, 0.f, 0.f};
#pragma unroll 16
        for (int i = 0; i < 32; ++i) {
            const f32x4 w = *(const f32x4*)(W + (size_t)(4 * i) * MODW);
            const float c0 = cs[k0 + 4 * i + rg], c1 = cs[D + k0 + 4 * i + rg];
            a0 += w * c0; a1 += w * c1;
        }
#pragma unroll
        for (int e = 0; e < 4; ++e) { a0[e] += swz_xor<16>(a0[e]); a0[e] = sum32(a0[e]); a1[e] += swz_xor<16>(a1[e]); a1[e] = sum32(a1[e]); }
        if (lane < 16) { *(LAS f32x4*)(red + (wave * 2 + 0) * 64 + cg * 4) = a0; *(LAS f32x4*)(red + (wave * 2 + 1) * 64 + cg * 4) = a1; }
        __syncthreads();
        if (tid < 128) {
            const int bq = tid >> 6, ln = tid & 63; float sacc = 0.f;
#pragma unroll
            for (int w = 0; w < 8; ++w) sacc += red[(w * 2 + bq) * 64 + ln];
            const int col = cb * 64 + ln;
            if (kh == 0) sacc += b_mod[l * MODW + col];
            atomicAdd(mod + (size_t)(l * 2 + bq) * MODW + col, sacc);
        }
        __syncthreads();
    }
}
DEV void transpose_item(const float* __restrict__ W, int K, int N, bf16* __restrict__ WT, LAS float* scr, int item, int lane) {
    const int nblk = N / 32, kb = item / nblk, nb = item % nblk, k0 = 64 * kb, n0 = 32 * nb;
#pragma unroll 8
    for (int i = 0; i < 32; ++i) { const int kk = 2 * i + (lane >> 5); scr[kk * 33 + (lane & 31)] = W[(size_t)(k0 + kk) * N + n0 + (lane & 31)]; }
    LDS_WAIT();
    const int c = lane & 7;
#pragma unroll
    for (int j = 0; j < 4; ++j) { const int n = (lane >> 3) + 8 * j; const LAS float* s = scr + (8 * c) * 33 + n;
        v4u o; o.x = pk2(s[0 * 33], s[1 * 33]); o.y = pk2(s[2 * 33], s[3 * 33]); o.z = pk2(s[4 * 33], s[5 * 33]); o.w = pk2(s[6 * 33], s[7 * 33]);
        *(v4u*)(WT + (size_t)(n0 + n) * K + k0 + 8 * c) = o; }
    LDS_WAIT();
}

DEV void transpose_item64(const float* __restrict__ W, int K, int N, bf16* __restrict__ WT, LAS float* scr, int item, int lane) {
    const int nblk = N / 64, kb = item / nblk, nb = item % nblk, k0 = 64 * kb, n0 = 64 * nb;
#pragma unroll 8
    for (int i = 0; i < 16; ++i) { const int kk = 4 * i + (lane >> 4), nn = 4 * (lane & 15);
        const f32x4 w = *(const f32x4*)(W + (size_t)(k0 + kk) * N + n0 + nn);
        LAS float* d = scr + kk * 65 + nn; d[0] = w.x; d[1] = w.y; d[2] = w.z; d[3] = w.w; }
    LDS_WAIT();
#pragma unroll
    for (int jj = 0; jj < 8; ++jj) { const int pz = lane + 64 * jj, n = pz >> 3, c = pz & 7; const LAS float* sp = scr + (8 * c) * 65 + n;
        v4u o; o.x = pk2(sp[0 * 65], sp[1 * 65]); o.y = pk2(sp[2 * 65], sp[3 * 65]); o.z = pk2(sp[4 * 65], sp[5 * 65]); o.w = pk2(sp[6 * 65], sp[7 * 65]);
        *(v4u*)(WT + (size_t)(n0 + n) * K + k0 + 8 * c) = o; }
    LDS_WAIT();
}
DEV void convert_copy(const float* __restrict__ src, bf16* __restrict__ dst, size_t ngroups8, size_t gtid, size_t gstride) {
    for (size_t g = gtid; g < ngroups8; g += gstride) {
        const f32x4 a = *(const f32x4*)(src + g * 8), b = *(const f32x4*)(src + g * 8 + 4);
        v4u o; o.x = pk2(a.x, a.y); o.y = pk2(a.z, a.w); o.z = pk2(b.x, b.y); o.w = pk2(b.z, b.w);
        *(v4u*)(dst + g * 8) = o;
    }
}

DEV void modnorm_rows(const float* __restrict__ X, const float* __restrict__ gain, const float* __restrict__ modl, int sh_off, int sc_off, bf16* __restrict__ H, int gw, int NGW, int lane, bf16* __restrict__ XC = nullptr) {
#pragma unroll 2
    for (int m = gw; m < M; m += NGW) {
        const int b = m >> 12;
        const f32x4* xr = (const f32x4*)(X + (size_t)m * D) + lane;
        f32x4 v[8]; float s = 0.f;
#pragma unroll
        for (int j = 0; j < 8; ++j) { v[j] = xr[64 * j]; s += (v[j].x * v[j].x + v[j].y * v[j].y) + (v[j].z * v[j].z + v[j].w * v[j].w); }
        const float r = rsqrtf(wave_sum(s) * (1.f / D) + EPS);
        const f32x4* g4 = (const f32x4*)gain + lane;
        const f32x4* sc4 = (const f32x4*)(modl + (size_t)b * MODW + sc_off) + lane;
        const f32x4* sh4 = (const f32x4*)(modl + (size_t)b * MODW + sh_off) + lane;
        unsigned long long* o8 = (unsigned long long*)(H + (size_t)m * D) + lane;
#pragma unroll
        for (int j = 0; j < 8; ++j) {
            const f32x4 g = g4[64 * j], sc = sc4[64 * j], sh = sh4[64 * j];
            const f32x4 y = (v[j] * r) * g * (sc + 1.f) + sh;
            o8[64 * j] = (unsigned long long)pk2(y.x, y.y) | ((unsigned long long)pk2(y.z, y.w) << 32);
            if (XC) ((unsigned long long*)(XC + (size_t)m * D) + lane)[64 * j] = (unsigned long long)pk2(v[j].x, v[j].y) | ((unsigned long long)pk2(v[j].z, v[j].w) << 32);
        }
    }
}
DEV void modnorm_rows_h(const bf16* __restrict__ X, const float* __restrict__ gain, const float* __restrict__ modl, int sh_off, int sc_off, bf16* __restrict__ H, int gw, int NGW, int lane) {
#pragma unroll 2
    for (int m = gw; m < M; m += NGW) {
        const int b = m >> 12;
        const v4u* xr = (const v4u*)(X + (size_t)m * D) + lane;
        float v[32]; float s = 0.f;
#pragma unroll
        for (int j = 0; j < 4; ++j) { const v4u w = xr[64 * j];
            v[8 * j + 0] = bf_lo(w.x); v[8 * j + 1] = bf_hi(w.x); v[8 * j + 2] = bf_lo(w.y); v[8 * j + 3] = bf_hi(w.y); v[8 * j + 4] = bf_lo(w.z); v[8 * j + 5] = bf_hi(w.z); v[8 * j + 6] = bf_lo(w.w); v[8 * j + 7] = bf_hi(w.w);
#pragma unroll
            for (int e = 0; e < 8; ++e) s += v[8 * j + e] * v[8 * j + e]; }
        const float r = rsqrtf(wave_sum(s) * (1.f / D) + EPS);
        const float* scp = modl + (size_t)b * MODW + sc_off; const float* shp = modl + (size_t)b * MODW + sh_off;
        v4u* o16 = (v4u*)(H + (size_t)m * D) + lane;
#pragma unroll
        for (int j = 0; j < 4; ++j) { const int col = 8 * (lane + 64 * j);
            const f32x4 g0 = *(const f32x4*)(gain + col), g1 = *(const f32x4*)(gain + col + 4), c0 = *(const f32x4*)(scp + col), c1 = *(const f32x4*)(scp + col + 4), h0 = *(const f32x4*)(shp + col), h1 = *(const f32x4*)(shp + col + 4);
            v4u o;
            o.x = pk2(v[8 * j + 0] * r * g0.x * (c0.x + 1.f) + h0.x, v[8 * j + 1] * r * g0.y * (c0.y + 1.f) + h0.y); o.y = pk2(v[8 * j + 2] * r * g0.z * (c0.z + 1.f) + h0.z, v[8 * j + 3] * r * g0.w * (c0.w + 1.f) + h0.w);
            o.z = pk2(v[8 * j + 4] * r * g1.x * (c1.x + 1.f) + h1.x, v[8 * j + 5] * r * g1.y * (c1.y + 1.f) + h1.y); o.w = pk2(v[8 * j + 6] * r * g1.z * (c1.z + 1.f) + h1.z, v[8 * j + 7] * r * g1.w * (c1.w + 1.f) + h1.w);
            o16[64 * j] = o; }
    }
}


DEV unsigned cvtpk_bf16(float lo, float hi) { f32x2 v = {lo, hi}; bf16x2_t b = __builtin_convertvector(v, bf16x2_t); return __builtin_bit_cast(unsigned, b); }
constexpr int DIL_VSTR = 256;
constexpr int ATT_KOFF = 32 * DIL_VSTR;
constexpr int ATT_BOFF = ATT_KOFF + 8192;
constexpr int DIL_QOFF = ATT_BOFF + 192 * 4;
constexpr int ATT_WLDS = 17920;
static_assert(DIL_QOFF <= ATT_WLDS && 8 * ATT_WLDS <= LDS_MISC, "attention LDS");

DEV unsigned vimg_off(unsigned row, unsigned ch) { return 256u * row + 16u * (ch ^ (((row & 3u) << 2) | ((row >> 2) & 3u))); }
typedef short s16x4 __attribute__((ext_vector_type(4)));
DEV bf16x8 vfrag_tr(LAS unsigned char* img, int lane, int c, int ks) {
    const unsigned h = lane >> 5, blk = (lane >> 4) & 1, qq = (lane & 15) >> 2, pp = lane & 3;
    const s16x4 a = __builtin_amdgcn_ds_read_tr16_b64_v4i16((LAS s16x4*)(img + vimg_off(16 * ks + 8 * h + 0 + qq, 4 * c + 2 * blk + (pp >> 1)) + 8 * (pp & 1)));
    const s16x4 b = __builtin_amdgcn_ds_read_tr16_b64_v4i16((LAS s16x4*)(img + vimg_off(16 * ks + 8 * h + 4 + qq, 4 * c + 2 * blk + (pp >> 1)) + 8 * (pp & 1)));
    return __builtin_shufflevector(a, b, 0, 1, 2, 3, 4, 5, 6, 7);
}
DEV void dil_mfma_item(int b, int h, int p, int rr, int i0, const bf16* __restrict__ Z, const float* __restrict__ rel_bias, bf16* __restrict__ PART, float* __restrict__ LSE, LAS unsigned char* wl, int lane) {
    asm volatile("" : "+v"(lane));
    const int r = lane & 31, hh = lane >> 5;
    const int d = 1 << (2 * p);
    LAS float* biasL = (LAS float*)(wl + ATT_BOFF);
    for (int dd = lane; dd < 192; dd += 64) { const int k = dd - 32; const int kc = k < 0 ? 0 : (k > 128 ? 128 : k); const float bvv = rel_bias[(int)T5B[p][kc] * 6 + h]; biasL[dd] = (k >= 0 && k <= 128) ? bvv : NEGBIG; }
    const size_t rowq = (size_t)b * SEQ + rr + d * (i0 + r);
    bf16x8 qf[8];
    { const bf16* qrow = Z + rowq * IN_W + ZO_QB + h * 128 + 8 * hh;
#pragma unroll
      for (int ks = 0; ks < 8; ++ks) qf[ks] = *(const bf16x8*)(qrow + 16 * ks); }
    float m_run = NEGBIG, l_run = 0.f;
    f32x16 o[4];
#pragma unroll
    for (int dt = 0; dt < 4; ++dt)
#pragma unroll
        for (int e = 0; e < 16; ++e) o[dt][e] = 0.f;
    const int kap = (r & 0x13) | ((r & 4) << 1) | ((r & 8) >> 1);
    const int kc0 = (lane & 15) ^ (lane >> 4);
    const unsigned kfa = (unsigned)(size_t)(wl + ATT_KOFF) + 256u * (unsigned)kap + 16u * (unsigned)((kap & 15) ^ hh);
    int jt = 4 - (i0 >> 5); jt = jt < 0 ? 0 : jt;
#define DIL_DMA_K(JT) do { const bf16* kb0_ = Z + ((size_t)b * SEQ + rr + d * (i0 - 128 + 32 * (JT) + (lane >> 4))) * IN_W + ZO_KB + h * 128;     \
        _Pragma("unroll") for (int q = 0; q < 8; ++q) __builtin_amdgcn_global_load_lds((const unsigned*)(kb0_ + (size_t)q * 4 * d * IN_W + 8 * (kc0 ^ (4 * (q & 3)))), (LAS unsigned*)(wl + ATT_KOFF + 1024 * q), 16, 0, 0); } while (0)
#define DIL_DMA_V(JT) do { const int j0_ = i0 - 128 + 32 * (JT); _Pragma("unroll") for (int q = 0; q < 8; ++q) { const int pi = lane + 64 * q, kl = pi >> 4, c = (pi & 15) ^ (((kl & 3) << 2) | ((kl >> 2) & 3)); int j = j0_ + kl; j = j < 0 ? 0 : j; \
        __builtin_amdgcn_global_load_lds((const unsigned*)(Z + ((size_t)b * SEQ + rr + d * j) * IN_W + ZO_VB + h * 128 + 8 * c), (LAS unsigned*)(wl + 1024 * q), 16, 0, 0); } } while (0)
    LDS_WAIT();
    DIL_DMA_K(jt); DIL_DMA_V(jt);
    for (; jt < 5; ++jt) {
        const int j0 = i0 - 128 + 32 * jt;
        const int jn = jt < 4 ? jt + 1 : 4;
        asm volatile("s_waitcnt vmcnt(8)" ::: "memory");
        f32x16 sacc, sac2;
#pragma unroll
        for (int e = 0; e < 16; ++e) { sacc[e] = 0.f; sac2[e] = 0.f; }
        {
            bf16x8 kf[8]; unsigned kfo = kfa; asm volatile("" : "+v"(kfo));
#pragma unroll
            for (int ks = 0; ks < 8; ++ks) kf[ks] = *(const LAS bf16x8*)(size_t)(kfo ^ (32u * ks));
#pragma unroll
            for (int ks = 0; ks < 8; ks += 2) { sacc = __builtin_amdgcn_mfma_f32_32x32x16_bf16(kf[ks], qf[ks], sacc, 0, 0, 0); sac2 = __builtin_amdgcn_mfma_f32_32x32x16_bf16(kf[ks + 1], qf[ks + 1], sac2, 0, 0, 0); }
#pragma unroll
            for (int e = 0; e < 16; ++e) sacc[e] += sac2[e];
        }
        LDS_WAIT();
        DIL_DMA_K(jn);
        float tm = NEGBIG;
        {
            const LAS float* bp = biasL + (9 + 128 - 32 * jt + r - 8 * hh);
#pragma unroll
            for (int e = 0; e < 16; ++e) { const float lg = __builtin_fmaf(sacc[e], QSCALE, bp[23 - 16 * (e >> 3) - (e & 7)]); sacc[e] = lg; tm = fmaxf(tm, lg); }
        }
        tm = max32(tm);
        const float m_new = fmaxf(m_run, tm);
        const float alpha = __expf(m_run - m_new);
        float ps = 0.f;
#pragma unroll
        for (int e = 0; e < 16; ++e) { const float pv = (sacc[e] > -1.0e37f) ? __expf(sacc[e] - m_new) : 0.f; sacc[e] = pv; ps += pv; }
        ps = sum32(ps);
        l_run = l_run * alpha + ps; m_run = m_new;
#pragma unroll
        for (int dt = 0; dt < 4; ++dt)
#pragma unroll
            for (int e = 0; e < 16; ++e) o[dt][e] *= alpha;
        bf16x8 pf[2];
#pragma unroll
        for (int s2 = 0; s2 < 2; ++s2) { v4u w; w.x = cvtpk_bf16(sacc[8 * s2 + 0], sacc[8 * s2 + 1]); w.y = cvtpk_bf16(sacc[8 * s2 + 2], sacc[8 * s2 + 3]);
            w.z = cvtpk_bf16(sacc[8 * s2 + 4], sacc[8 * s2 + 5]); w.w = cvtpk_bf16(sacc[8 * s2 + 6], sacc[8 * s2 + 7]); pf[s2] = __builtin_bit_cast(bf16x8, w); }
        asm volatile("s_waitcnt vmcnt(8)" ::: "memory");
#pragma unroll
        for (int dt = 0; dt < 4; ++dt)
#pragma unroll
            for (int s2 = 0; s2 < 2; ++s2) o[dt] = __builtin_amdgcn_mfma_f32_32x32x16_bf16(vfrag_tr(wl, lane, dt, s2), pf[s2], o[dt], 0, 0, 0);
        LDS_WAIT();
        DIL_DMA_V(jn);
    }
    asm volatile("s_waitcnt vmcnt(0)" ::: "memory");
#undef DIL_DMA_V
#undef DIL_DMA_K
    const float inv = 1.f / l_run;
    bf16* po = PART + ((size_t)p * M + rowq) * SWA_W + h * 128;
#pragma unroll
    for (int dt = 0; dt < 4; ++dt)
#pragma unroll
        for (int g = 0; g < 4; ++g)
            *(unsigned long long*)(po + 32 * dt + 8 * g + 4 * hh) = (unsigned long long)pk2(o[dt][4 * g + 0] * inv, o[dt][4 * g + 1] * inv) | ((unsigned long long)pk2(o[dt][4 * g + 2] * inv, o[dt][4 * g + 3] * inv) << 32);
    if (hh == 0) LSE[((size_t)p * M + rowq) * 6 + h] = m_run + __logf(l_run);
}


DEV void lru_item2(int l, int b, int j, int n, const bf16* __restrict__ Z, const float* __restrict__ conv_w, const float* __restrict__ conv_b, const bf16* __restrict__ WGT,
                   const float* __restrict__ b_rec, const float* __restrict__ b_gi, const float* __restrict__ lam,
                   bf16* __restrict__ HLOC, bf16* __restrict__ PP, float* __restrict__ SUMA, float* __restrict__ SUMB, LAS float* xc, LAS float* g0L, LAS float* g1L, int tid) {
    const int ch = tid & 127, tq = tid >> 7, c = n * 128 + ch;
    const float cw0 = conv_w[(l * 4 + 0) * LRU_W + c], cw1 = conv_w[(l * 4 + 1) * LRU_W + c], cw2 = conv_w[(l * 4 + 2) * LRU_W + c], cw3 = conv_w[(l * 4 + 3) * LRU_W + c];
    const float cb = conv_b[l * LRU_W + c];
    const float br = b_rec[l * LRU_W + c], bi = b_gi[l * LRU_W + c], lamv = lam[l * LRU_W + c];
    bf16x8 bfr[8];
    {   const int lane = tid & 63, wave = tid >> 6, r = lane & 31, hh = lane >> 5, g = wave >> 2, ct = wave & 3;
        const bf16* wp = WGT + (((size_t)(l * 6 + n) * 2 + g) * 128 + ct * 32 + r) * 128 + 8 * hh;
#pragma unroll
        for (int ks = 0; ks < 8; ++ks) bfr[ks] = *(const bf16x8*)(wp + 16 * ks); }
    {
        LAS unsigned char* xaL = (LAS unsigned char*)(g1L + 64 * 132);
        const int t0 = j * 64;
#pragma unroll
        for (int i = 0; i < 3; ++i) { const int pz = tid + 512 * i; if (pz < 67 * 16) { const int row = pz >> 4, cc = pz & 15; const int t = t0 - 3 + row;
            v4u w = {0u, 0u, 0u, 0u}; if (t >= 0) w = *(const v4u*)(Z + ((size_t)b * SEQ + t) * IN_W + ZO_XA + n * 128 + 8 * cc);
            *(LAS v4u*)(xaL + row * 256 + cc * 16) = w; } }
        __syncthreads();
        const LAS bf16* xp = (const LAS bf16*)xaL + ch;
#pragma unroll 4
        for (int i = 0; i < 16; ++i) {
            const int tok = tq + 4 * i;
            xc[tok * 132 + ch] = cb + cw0 * bf1(xp[(tok + 0) * 128]) + cw1 * bf1(xp[(tok + 1) * 128]) + cw2 * bf1(xp[(tok + 2) * 128]) + cw3 * bf1(xp[(tok + 3) * 128]);
        }
    }
    __syncthreads();
    {
        const int lane = tid & 63, wave = tid >> 6, r = lane & 31, hh = lane >> 5, g = wave >> 2, ct = wave & 3;
        LAS float* gL = g ? g1L : g0L;
#pragma unroll
        for (int rt = 0; rt < 2; ++rt) {
            f32x16 acc;
#pragma unroll
            for (int e = 0; e < 16; ++e) acc[e] = 0.f;
#pragma unroll
            for (int ks = 0; ks < 8; ++ks) {
                const LAS float* xp = xc + (32 * rt + r) * 132 + 16 * ks + 8 * hh;
                const f32x4 x0 = *(const LAS f32x4*)xp, x1 = *(const LAS f32x4*)(xp + 4);
                v4u w; w.x = cvtpk_bf16(x0.x, x0.y); w.y = cvtpk_bf16(x0.z, x0.w); w.z = cvtpk_bf16(x1.x, x1.y); w.w = cvtpk_bf16(x1.z, x1.w);
                acc = __builtin_amdgcn_mfma_f32_32x32x16_bf16(__builtin_bit_cast(bf16x8, w), bfr[ks], acc, 0, 0, 0);
            }
#pragma unroll
            for (int e = 0; e < 16; ++e) { const int tok = 32 * rt + (e & 3) + 8 * (e >> 2) + 4 * hh; gL[tok * 132 + ct * 32 + r] = acc[e]; }
        }
    }
    __syncthreads();
    {
        const float sp = softplus_f(-lamv);
#pragma unroll 4
        for (int i = 0; i < 16; ++i) {
            const int tok = tq + 4 * i;
            const float rg = __builtin_amdgcn_rcpf(1.f + __expf(-(g0L[tok * 132 + ch] + br))), ig = __builtin_amdgcn_rcpf(1.f + __expf(-(g1L[tok * 132 + ch] + bi)));
            const float log_a = -8.0f * rg * sp;
            const float av = __expf(log_a);
            const float x = xc[tok * 132 + ch];
            const float y = 2.f * log_a;
            const float small = -y * (1.f + y * (0.5f + y * (0.16666667f + y * (0.041666668f + y * 0.0083333338f))));
            const float om = (y > -0.25f) ? small : (1.f - av * av);
            const float uv = __builtin_amdgcn_sqrtf(fmaxf(om, 0.f)) * (ig * x);
            g0L[tok * 132 + ch] = av; g1L[tok * 132 + ch] = uv;
        }
    }
    __syncthreads();
    {
        LAS float* segL = g1L + 64 * 132 + 67 * 64;
        float hl[16], pl[16]; float h = 0.f, P = 1.f;
#pragma unroll
        for (int t = 0; t < 16; ++t) { const int tok = 16 * tq + t; const float av = g0L[tok * 132 + ch]; h = av * h + g1L[tok * 132 + ch]; P *= av; hl[t] = h; pl[t] = P; }
        segL[(tq * 128 + ch) * 2] = P; segL[(tq * 128 + ch) * 2 + 1] = h;
        __syncthreads();
        float Hin = 0.f, Pin = 1.f;
#pragma unroll
        for (int sg = 0; sg < 3; ++sg) if (sg < tq) { const float pa = segL[(sg * 128 + ch) * 2], hb = segL[(sg * 128 + ch) * 2 + 1]; Hin = pa * Hin + hb; Pin *= pa; }
        const size_t rb = ((size_t)b * SEQ + j * 64 + 16 * tq) * LRU_W + n * 128 + ch;
#pragma unroll
        for (int t = 0; t < 16; ++t) { HLOC[rb + (size_t)t * LRU_W] = (bf16)f2bf(hl[t] + pl[t] * Hin); PP[rb + (size_t)t * LRU_W] = (bf16)f2bf(pl[t] * Pin); }
        if (tq == 3) { SUMA[(size_t)(b * 64 + j) * LRU_W + n * 128 + ch] = pl[15] * Pin; SUMB[(size_t)(b * 64 + j) * LRU_W + n * 128 + ch] = hl[15] + pl[15] * Hin; }
    }
    __syncthreads();
}

DEV void sb_mfma_item(int b, int h, int t0, const bf16* __restrict__ Z, bf16* __restrict__ YC, LAS unsigned char* wl, int lane) {
    asm volatile("" : "+v"(lane));
    const int r = lane & 31, hh = lane >> 5;
    const size_t rowq = (size_t)b * SEQ + t0 + r;
    bf16x8 qf[8];
    { const bf16* qrow = Z + rowq * IN_W + ZO_QC + h * 128 + 8 * hh;
#pragma unroll
      for (int ks = 0; ks < 8; ++ks) qf[ks] = *(const bf16x8*)(qrow + 16 * ks); }
    f32x16 o[4];
#pragma unroll
    for (int dt = 0; dt < 4; ++dt)
#pragma unroll
        for (int e = 0; e < 16; ++e) o[dt][e] = 0.f;
    const int kap = (r & 0x13) | ((r & 4) << 1) | ((r & 8) >> 1);
    const int kc0 = (lane & 15) ^ (lane >> 4);
    const unsigned kfa = (unsigned)(size_t)(wl + ATT_KOFF) + 256u * (unsigned)kap + 16u * (unsigned)((kap & 15) ^ hh);
    float carry = 0.f;
#define SB_DMA_K(K0) do { const bf16* kb0_ = Z + ((size_t)b * SEQ + (K0) + (lane >> 4)) * IN_W + ZO_KC + h * 128; \
        _Pragma("unroll") for (int q = 0; q < 8; ++q) __builtin_amdgcn_global_load_lds((const unsigned*)(kb0_ + (size_t)q * 4 * IN_W + 8 * (kc0 ^ (4 * (q & 3)))), (LAS unsigned*)(wl + ATT_KOFF + 1024 * q), 16, 0, 0); } while (0)
#define SB_DMA_V(K0) do { _Pragma("unroll") for (int q = 0; q < 8; ++q) { const int pi = lane + 64 * q, kl = pi >> 4, c = (pi & 15) ^ (((kl & 3) << 2) | ((kl >> 2) & 3)); \
        __builtin_amdgcn_global_load_lds((const unsigned*)(Z + ((size_t)b * SEQ + (K0) + kl) * IN_W + ZO_VC + h * 128 + 8 * c), (LAS unsigned*)(wl + 1024 * q), 16, 0, 0); } } while (0)
    LDS_WAIT();
    SB_DMA_K(t0); SB_DMA_V(t0);
    for (int k0 = t0; k0 >= 0; k0 -= 32) {
        const int kn = k0 >= 32 ? k0 - 32 : 0;
        asm volatile("s_waitcnt vmcnt(8)" ::: "memory");
        f32x16 sacc, sac2;
#pragma unroll
        for (int e = 0; e < 16; ++e) { sacc[e] = 0.f; sac2[e] = 0.f; }
        {
            bf16x8 kf[8]; unsigned kfo = kfa; asm volatile("" : "+v"(kfo));
#pragma unroll
            for (int ks = 0; ks < 8; ++ks) kf[ks] = *(const LAS bf16x8*)(size_t)(kfo ^ (32u * ks));
#pragma unroll
            for (int ks = 0; ks < 8; ks += 2) { sacc = __builtin_amdgcn_mfma_f32_32x32x16_bf16(kf[ks], qf[ks], sacc, 0, 0, 0); sac2 = __builtin_amdgcn_mfma_f32_32x32x16_bf16(kf[ks + 1], qf[ks + 1], sac2, 0, 0, 0); }
#pragma unroll
            for (int e = 0; e < 16; ++e) sacc[e] += sac2[e];
        }
        LDS_WAIT();
        SB_DMA_K(kn);
        float l1[16]; float T0 = 0.f, T1 = 0.f;
#pragma unroll
        for (int e = 0; e < 16; ++e) {
            const int key = k0 + 16 * (e >> 3) + 8 * hh + (e & 7);
            const bool valid = key < t0 + r;
            const float z = sacc[e] * QSCALE;
            sacc[e] = z;
            l1[e] = valid ? -(fmaxf(z, 0.f) + __logf(1.f + __expf(-fabsf(z)))) : 0.f;
        }
#pragma unroll
        for (int e = 0; e < 8; ++e) { T0 += l1[e]; T1 += l1[8 + e]; }
        const float PT0 = partner32(T0, hh), PT1 = partner32(T1, hh);
        const float base1 = carry + (hh ? 0.f : PT1);
        const float base0 = carry + (hh ? (T1 + PT1) : (PT1 + T1 + PT0));
        float run1 = base1, run0 = base0;
#pragma unroll
        for (int e = 7; e >= 0; --e) {
            { const int key = k0 + 16 + 8 * hh + e; const bool valid = key < t0 + r; const float a = valid ? __expf(sacc[8 + e] + l1[8 + e] + run1) : 0.f; run1 += l1[8 + e]; sacc[8 + e] = a; }
            { const int key = k0 + 8 * hh + e; const bool valid = key < t0 + r; const float a = valid ? __expf(sacc[e] + l1[e] + run0) : 0.f; run0 += l1[e]; sacc[e] = a; }
        }
        carry += (T0 + T1) + (PT0 + PT1);
        bf16x8 pf[2];
#pragma unroll
        for (int s2 = 0; s2 < 2; ++s2) { v4u w; w.x = cvtpk_bf16(sacc[8 * s2 + 0], sacc[8 * s2 + 1]); w.y = cvtpk_bf16(sacc[8 * s2 + 2], sacc[8 * s2 + 3]);
            w.z = cvtpk_bf16(sacc[8 * s2 + 4], sacc[8 * s2 + 5]); w.w = cvtpk_bf16(sacc[8 * s2 + 6], sacc[8 * s2 + 7]); pf[s2] = __builtin_bit_cast(bf16x8, w); }
        asm volatile("s_waitcnt vmcnt(8)" ::: "memory");
#pragma unroll
        for (int dt = 0; dt < 4; ++dt)
#pragma unroll
            for (int s2 = 0; s2 < 2; ++s2) o[dt] = __builtin_amdgcn_mfma_f32_32x32x16_bf16(vfrag_tr(wl, lane, dt, s2), pf[s2], o[dt], 0, 0, 0);
        LDS_WAIT();
        SB_DMA_V(kn);
        if (__all(carry < -105.0f)) break;
    }
    asm volatile("s_waitcnt vmcnt(0)" ::: "memory");
#undef SB_DMA_V
#undef SB_DMA_K
    bf16* po = YC + rowq * SB_W + h * 128;
#pragma unroll
    for (int dt = 0; dt < 4; ++dt)
#pragma unroll
        for (int g = 0; g < 4; ++g)
            *(unsigned long long*)(po + 32 * dt + 8 * g + 4 * hh) = (unsigned long long)pk2(o[dt][4 * g + 0], o[dt][4 * g + 1]) | ((unsigned long long)pk2(o[dt][4 * g + 2], o[dt][4 * g + 3]) << 32);
}

DEV void combine_item(int l, int b, int j, int half, const bf16* __restrict__ Z, const bf16* __restrict__ HLOC, const bf16* __restrict__ PP, const float* __restrict__ SUMA, const float* __restrict__ SUMB,
                      const bf16* __restrict__ PART, const float* __restrict__ LSE, const bf16* __restrict__ YC, const float* __restrict__ g_lru, const float* __restrict__ g_swa, const float* __restrict__ g_sb,
                      bf16* __restrict__ Y, LAS float* carryL, int tid) {
    const int lane = tid & 63, wave = tid >> 6;
    for (int c = tid; c < LRU_W; c += 512) {
        float cr = 0.f;
        for (int i = 0; i < j; i += 16) {
            float av[16], bv[16];
#pragma unroll
            for (int u = 0; u < 16; ++u) { const int q = i + u < j ? i + u : j - 1; av[u] = SUMA[(size_t)(b * 64 + q) * LRU_W + c]; bv[u] = SUMB[(size_t)(b * 64 + q) * LRU_W + c]; }
#pragma unroll
            for (int u = 0; u < 16; ++u) { const bool in = i + u < j; cr = in ? av[u] * cr + bv[u] : cr; }
        }
        carryL[c] = cr;
    }
    __syncthreads();
#pragma unroll 2
    for (int i = 0; i < 4; ++i) {
        const int tok = half * 32 + wave * 4 + i;
        const size_t row = (size_t)b * SEQ + j * 64 + tok;
        bf16* yo = Y + row * D;
        {
            float ya[12]; float ssq = 0.f;
#pragma unroll
            for (int e = 0; e < 6; ++e) { const int c = 2 * lane + 128 * e;
                const unsigned hw = *(const unsigned*)(HLOC + row * LRU_W + c), pw = *(const unsigned*)(PP + row * LRU_W + c), gw2 = *(const unsigned*)(Z + row * IN_W + ZO_GA + c);
                const f32x2 cr = *(const LAS f32x2*)(carryL + c);
                ya[2 * e] = (bf_lo(hw) + bf_lo(pw) * cr.x) * gelu_tanh(bf_lo(gw2)); ya[2 * e + 1] = (bf_hi(hw) + bf_hi(pw) * cr.y) * gelu_tanh(bf_hi(gw2));
                ssq += ya[2 * e] * ya[2 * e] + ya[2 * e + 1] * ya[2 * e + 1]; }
            const float r = rsqrtf(wave_sum(ssq) * (1.f / LRU_W) + EPS);
#pragma unroll
            for (int e = 0; e < 6; ++e) { const int c = 2 * lane + 128 * e; const f32x2 g = *(const f32x2*)(g_lru + l * LRU_W + c);
                *(unsigned*)(yo + c) = pk2(ya[2 * e] * r * g.x, ya[2 * e + 1] * r * g.y); }
        }
        {
            float yb[12]; float ssq = 0.f;
#pragma unroll
            for (int e = 0; e < 6; ++e) { const int c = 2 * lane + 128 * e;
                const float l0 = LSE[((size_t)0 * M + row) * 6 + e], l1 = LSE[((size_t)1 * M + row) * 6 + e], l2 = LSE[((size_t)2 * M + row) * 6 + e];
                const float mx = fmaxf(l0, fmaxf(l1, l2)); const float e0 = __expf(l0 - mx), e1 = __expf(l1 - mx), e2 = __expf(l2 - mx); const float iz = 1.f / (e0 + e1 + e2);
                const unsigned p0 = *(const unsigned*)(PART + ((size_t)0 * M + row) * SWA_W + c), p1 = *(const unsigned*)(PART + ((size_t)1 * M + row) * SWA_W + c), p2 = *(const unsigned*)(PART + ((size_t)2 * M + row) * SWA_W + c);
                yb[2 * e] = (e0 * bf_lo(p0) + e1 * bf_lo(p1) + e2 * bf_lo(p2)) * iz; yb[2 * e + 1] = (e0 * bf_hi(p0) + e1 * bf_hi(p1) + e2 * bf_hi(p2)) * iz;
                ssq += yb[2 * e] * yb[2 * e] + yb[2 * e + 1] * yb[2 * e + 1]; }
            const float r = rsqrtf(wave_sum(ssq) * (1.f / SWA_W) + EPS);
#pragma unroll
            for (int e = 0; e < 6; ++e) { const int c = 2 * lane + 128 * e; const f32x2 g = *(const f32x2*)(g_swa + l * SWA_W + c);
                *(unsigned*)(yo + LRU_W + c) = pk2(yb[2 * e] * r * g.x, yb[2 * e + 1] * r * g.y); }
        }
        {
            float yc[8]; float ssq = 0.f;
#pragma unroll
            for (int e = 0; e < 4; ++e) { const int c = 2 * lane + 128 * e; const unsigned w = *(const unsigned*)(YC + row * SB_W + c); yc[2 * e] = bf_lo(w); yc[2 * e + 1] = bf_hi(w); ssq += yc[2 * e] * yc[2 * e] + yc[2 * e + 1] * yc[2 * e + 1]; }
            const float r = rsqrtf(wave_sum(ssq) * (1.f / SB_W) + EPS);
#pragma unroll
            for (int e = 0; e < 4; ++e) { const int c = 2 * lane + 128 * e; const f32x2 g = *(const f32x2*)(g_sb + l * SB_W + c);
                *(unsigned*)(yo + LRU_W + SWA_W + c) = pk2(yc[2 * e] * r * g.x, yc[2 * e + 1] * r * g.y); }
        }
    }
    __syncthreads();
}


constexpr float U8_SCALE = 64.f;
DEV void convert_fp8(const float* __restrict__ src, unsigned char* __restrict__ dst, size_t ngroups16, size_t gtid, size_t gstride, float scale) {
    for (size_t g = gtid; g < ngroups16; g += gstride) {
        const f32x4 a = *(const f32x4*)(src + g * 16) * scale, b = *(const f32x4*)(src + g * 16 + 4) * scale, c = *(const f32x4*)(src + g * 16 + 8) * scale, d = *(const f32x4*)(src + g * 16 + 12) * scale;
        int w0 = 0, w1 = 0, w2 = 0, w3 = 0;
        w0 = __builtin_amdgcn_cvt_pk_fp8_f32(a.x, a.y, w0, false); w0 = __builtin_amdgcn_cvt_pk_fp8_f32(a.z, a.w, w0, true);
        w1 = __builtin_amdgcn_cvt_pk_fp8_f32(b.x, b.y, w1, false); w1 = __builtin_amdgcn_cvt_pk_fp8_f32(b.z, b.w, w1, true);
        w2 = __builtin_amdgcn_cvt_pk_fp8_f32(c.x, c.y, w2, false); w2 = __builtin_amdgcn_cvt_pk_fp8_f32(c.z, c.w, w2, true);
        w3 = __builtin_amdgcn_cvt_pk_fp8_f32(d.x, d.y, w3, false); w3 = __builtin_amdgcn_cvt_pk_fp8_f32(d.z, d.w, w3, true);
        *(v4u*)(dst + g * 16) = (v4u){(unsigned)w0, (unsigned)w1, (unsigned)w2, (unsigned)w3};
    }
}

constexpr int R2_SC = 0, R2_TV = 128 * 129 * 4, R2_TI = R2_TV + 128 * 16 * 4, R2_END = R2_TI + 128 * 16 * 4, R2_MK = 4 * 16 * 128 * 4  ;
static_assert(R2_END + R2_MK <= LDS_MISC, "routing v2 LDS");
DEV unsigned ord_key(float s) { const unsigned u = __builtin_bit_cast(unsigned, s); return (u & 0x80000000u) ? ~u : (u | 0x80000000u); }

#define KEY_CE(A, B) do { const unsigned hi_ = (A) > (B) ? (A) : (B); const unsigned lo_ = (A) > (B) ? (B) : (A); (A) = hi_; (B) = lo_; } while (0)
DEV void bitonic_sort16_desc(unsigned (&a)[16]) {
#pragma unroll
    for (int k = 2; k <= 16; k <<= 1)
#pragma unroll
        for (int j = k >> 1; j > 0; j >>= 1)
#pragma unroll
            for (int i = 0; i < 16; ++i) { const int m = i ^ j; if (m > i) { if ((i & k) == 0) KEY_CE(a[i], a[m]); else KEY_CE(a[m], a[i]); } }
}
DEV void bitonic_merge16_desc(unsigned (&a)[16]) {
#pragma unroll
    for (int j = 8; j > 0; j >>= 1)
#pragma unroll
        for (int i = 0; i < 16; ++i) { const int m = i ^ j; if (m > i) KEY_CE(a[i], a[m]); }
}
DEV void convert_rows3(int R0, int RS, int RLIM, const float* __restrict__ cv_u, const float* __restrict__ cv_v, unsigned char* __restrict__ cv_u8, unsigned char* __restrict__ cv_v8,
                       float* __restrict__ cv_su, float* __restrict__ cv_sv, int lane) {
    f32x4 v[3][8];
#pragma unroll
    for (int bb = 0; bb < 3; ++bb) { const int R = R0 + RS * bb;
        if (R < RLIM) { const bool isv = R >= NEXP; const int ex = isv ? R - NEXP : R;
            const float* srow = (isv ? cv_v : cv_u) + (size_t)ex * D + 4 * lane;
#pragma unroll
            for (int j = 0; j < 8; ++j) v[bb][j] = __builtin_nontemporal_load((const f32x4*)(srow + 256 * j)); } }
    __builtin_amdgcn_sched_barrier(0);
#pragma unroll
    for (int bb = 0; bb < 3; ++bb) { const int R = R0 + RS * bb;
        if (R < RLIM) { const bool isv = R >= NEXP; const int ex = isv ? R - NEXP : R;
            float am = 0.f;
#pragma unroll
            for (int j = 0; j < 8; ++j) am = fmaxf(am, fmaxf(fmaxf(fabsf(v[bb][j].x), fabsf(v[bb][j].y)), fmaxf(fabsf(v[bb][j].z), fabsf(v[bb][j].w))));
            am = wave_max(am);
            const float scl = am > 0.f ? am * (1.f / 6.f) : 1.f, inv = am > 0.f ? 6.f / am : 1.f;
            unsigned char* drow = (isv ? cv_v8 : cv_u8) + (size_t)ex * 128 + 2 * lane;
#pragma unroll
            for (int j = 0; j < 8; ++j) { unsigned w = 0u;
                w = __builtin_amdgcn_cvt_scalef32_pk_fp4_f32(w, v[bb][j].x * inv, v[bb][j].y * inv, 1.0f, 0); w = __builtin_amdgcn_cvt_scalef32_pk_fp4_f32(w, v[bb][j].z * inv, v[bb][j].w * inv, 1.0f, 1);
                *(unsigned short*)(drow + (size_t)j * NEXP * 128) = (unsigned short)w; }
            if (lane == 0) (isv ? cv_sv : cv_su)[ex] = scl; } }
}
DEV void route_item2(int l, int tile, int h, const bf16* __restrict__ Q, const bf16* __restrict__ SK, int* __restrict__ IDS, float* __restrict__ GG, LAS unsigned char* lds, int tid, int seq,
                        const float* __restrict__ cv_u, const float* __restrict__ cv_v, unsigned char* __restrict__ cv_u8, unsigned char* __restrict__ cv_v8, float* __restrict__ cv_su, float* __restrict__ cv_sv, bool do_conv) {
    LAS float* sc = (LAS float*)(lds + R2_SC); LAS float* tv = (LAS float*)(lds + R2_TV); LAS int* ti = (LAS int*)(lds + R2_TI);
    const int lane = tid & 63, wave = tid >> 6, row0 = tile * 64;
    {
        const int r = lane & 31, hh = lane >> 5, kt = wave & 3, rt = wave >> 2;
        {
            const int rq = lane >> 4, pos = lane & 15;
#pragma unroll 1
            for (int i = 0; i < 12; ++i) { const int q = wave * 12 + i;
                const bool isq = q >= 64; const int qq = isq ? q - 64 : q; const int c = isq ? (qq >> 4) : (qq >> 5); const int rw = isq ? 4 * (qq & 15) + rq : 4 * (qq & 31) + rq;
                const bf16* src = isq ? Q + (size_t)(row0 + rw) * D + h * 256 + c * 128 : SK + ((size_t)(((l * 8 + h) * 2 + c) * 128 + rw)) * 128;
                __builtin_amdgcn_global_load_lds((const unsigned*)(src + 8 * (pos ^ (rw & 15))), (LAS unsigned*)(lds + 1024 * q), 16, 0, 0); }
        }
        asm volatile("s_waitcnt vmcnt(0)" ::: "memory"); __syncthreads();
        f32x16 acc[2];
#pragma unroll
        for (int c = 0; c < 2; ++c) {
            const int krow = 32 * kt + r, trow = 32 * rt + r;
            unsigned ka = (unsigned)(size_t)lds + (unsigned)((c * 128 + krow) * 256 + 16 * ((krow & 15) ^ hh)), qa = (unsigned)(size_t)lds + 65536u + (unsigned)((c * 64 + trow) * 256 + 16 * ((trow & 15) ^ hh));
            asm volatile("" : "+v"(ka), "+v"(qa));
            bf16x8 bfr[8], afr[8];
#pragma unroll
            for (int ks = 0; ks < 8; ++ks) { bfr[ks] = *(const LAS bf16x8*)(size_t)(ka ^ (32u * ks)); afr[ks] = *(const LAS bf16x8*)(size_t)(qa ^ (32u * ks)); }
#pragma unroll
            for (int e = 0; e < 16; ++e) acc[c][e] = 0.f;
#pragma unroll
            for (int ks = 0; ks < 8; ++ks) acc[c] = __builtin_amdgcn_mfma_f32_32x32x16_bf16(afr[ks], bfr[ks], acc[c], 0, 0, 0);
        }
        __syncthreads();
#pragma unroll
        for (int c = 0; c < 2; ++c)
#pragma unroll
            for (int e = 0; e < 16; ++e) { const int tok = 32 * rt + (e & 3) + 8 * (e >> 2) + 4 * hh; sc[(c * 64 + tok) * 129 + 32 * kt + r] = acc[c][e]; }
    }
    __syncthreads();
    {
        const int L = tid & 127, part = tid >> 7;
        LAS unsigned* mk = (LAS unsigned*)(lds + R2_END);
        unsigned t[16], bk[16];
#pragma unroll
        for (int i = 0; i < 16; ++i) { const int k = part * 32 + i; t[i] = (ord_key(sc[L * 129 + k]) & ~127u) | (unsigned)(127 - k); }
        bitonic_sort16_desc(t);
#pragma unroll
        for (int i = 0; i < 16; ++i) { const int k = part * 32 + 16 + i; bk[i] = (ord_key(sc[L * 129 + k]) & ~127u) | (unsigned)(127 - k); }
        bitonic_sort16_desc(bk);
#pragma unroll
        for (int i = 0; i < 16; ++i) t[i] = t[i] > bk[15 - i] ? t[i] : bk[15 - i];
        bitonic_merge16_desc(t);
        if (part & 1) {
#pragma unroll
            for (int q = 0; q < 16; ++q) mk[(part * 16 + q) * 128 + L] = t[q]; }
        __syncthreads();
        if (!(part & 1)) {
#pragma unroll
            for (int i = 0; i < 16; ++i) bk[i] = mk[((part + 1) * 16 + i) * 128 + L];
#pragma unroll
            for (int i = 0; i < 16; ++i) t[i] = t[i] > bk[15 - i] ? t[i] : bk[15 - i];
            bitonic_merge16_desc(t);
            if (part == 2) {
#pragma unroll
                for (int q = 0; q < 16; ++q) mk[(2 * 16 + q) * 128 + L] = t[q]; }
        }
        __syncthreads();
        if (part == 0) {
#pragma unroll
            for (int i = 0; i < 16; ++i) bk[i] = mk[(2 * 16 + i) * 128 + L];
#pragma unroll
            for (int i = 0; i < 16; ++i) t[i] = t[i] > bk[15 - i] ? t[i] : bk[15 - i];
            bitonic_merge16_desc(t);
#pragma unroll
            for (int q = 0; q < 16; ++q) { const int idx = 127 - (int)(t[q] & 127u); tv[L * 16 + q] = sc[L * 129 + idx]; ti[L * 16 + q] = idx; }
        }
    }
    __syncthreads();
    {
        const int tok = tid & 63, part = tid >> 6;
        LAS unsigned* mk = (LAS unsigned*)(lds + R2_END);
        unsigned t[16], bk[16];
#pragma unroll
        for (int q = 0; q < 16; ++q) t[q] = 0u;
        if (part < 4) {
            float a[16], bq[16];
#pragma unroll
            for (int i = 0; i < 16; ++i) { a[i] = tv[tok * 16 + i]; bq[i] = tv[(64 + tok) * 16 + i]; }
#define R3_KEY(I, J) ((ord_key(a[I] + bq[J]) & ~255u) | (unsigned)(255 - ((I) * 16 + (J))))
            if (part == 0) {
#pragma unroll
                for (int j = 0; j < 16; ++j) t[j] = R3_KEY(0, j);
            } else if (part == 1) {
#pragma unroll
                for (int j = 0; j < 8; ++j) t[j] = R3_KEY(1, j);
#pragma unroll
                for (int j = 0; j < 5; ++j) t[8 + j] = R3_KEY(2, j);
                t[13] = R3_KEY(8, 0); t[14] = R3_KEY(9, 0); t[15] = R3_KEY(10, 0);
            } else if (part == 2) {
#pragma unroll
                for (int j = 0; j < 4; ++j) t[j] = R3_KEY(3, j);
#pragma unroll
                for (int j = 0; j < 3; ++j) t[4 + j] = R3_KEY(4, j);
                t[7] = R3_KEY(5, 0); t[8] = R3_KEY(5, 1); t[9] = R3_KEY(6, 0); t[10] = R3_KEY(6, 1); t[11] = R3_KEY(7, 0); t[12] = R3_KEY(7, 1);
                t[13] = R3_KEY(11, 0); t[14] = R3_KEY(12, 0); t[15] = R3_KEY(13, 0);
            } else {
                t[0] = R3_KEY(14, 0); t[1] = R3_KEY(15, 0);
            }
#undef R3_KEY
            bitonic_sort16_desc(t);
            if (part & 1) {
#pragma unroll
                for (int q = 0; q < 16; ++q) mk[(part * 16 + q) * 64 + tok] = t[q]; }
        }
        __syncthreads();
        if (part == 0 || part == 2) {
#pragma unroll
            for (int i = 0; i < 16; ++i) bk[i] = mk[((part + 1) * 16 + i) * 64 + tok];
#pragma unroll
            for (int i = 0; i < 16; ++i) t[i] = t[i] > bk[15 - i] ? t[i] : bk[15 - i];
            bitonic_merge16_desc(t);
            if (part == 2) {
#pragma unroll
                for (int q = 0; q < 16; ++q) mk[(2 * 16 + q) * 64 + tok] = t[q]; }
        }
        __syncthreads();
        if (part == 0) {
#pragma unroll
            for (int i = 0; i < 16; ++i) bk[i] = mk[(2 * 16 + i) * 64 + tok];
#pragma unroll
            for (int i = 0; i < 16; ++i) t[i] = t[i] > bk[15 - i] ? t[i] : bk[15 - i];
            bitonic_merge16_desc(t);
        float scv[16]; int idv[16]; float mx = NEGBIG;
#pragma unroll
        for (int q = 0; q < 16; ++q) { const int ci = 255 - (int)(t[q] & 255u); const int i = ci >> 4, j = ci & 15;
            scv[q] = tv[tok * 16 + i] + tv[(64 + tok) * 16 + j]; idv[q] = ti[tok * 16 + i] * 128 + ti[(64 + tok) * 16 + j]; mx = fmaxf(mx, scv[q]); }
        float sum = 0.f;
#pragma unroll
        for (int q = 0; q < 16; ++q) { scv[q] = __expf(scv[q] - mx); sum += scv[q]; }
        const float inv = 1.f / sum;
        int* ip = IDS + (size_t)(row0 + tok) * 128 + h * 16; float* gp = GG + (size_t)(row0 + tok) * 128 + h * 16;
#pragma unroll
        for (int q4 = 0; q4 < 4; ++q4) {
            *(int4*)(ip + 4 * q4) = make_int4(idv[4 * q4], idv[4 * q4 + 1], idv[4 * q4 + 2], idv[4 * q4 + 3]);
            *(f32x4*)(gp + 4 * q4) = (f32x4){scv[4 * q4] * inv, scv[4 * q4 + 1] * inv, scv[4 * q4 + 2] * inv, scv[4 * q4 + 3] * inv};
        }
        }
    }
    if (do_conv) {
        convert_rows3((tile * 8 + h) * 32 + wave, 8, (tile * 8 + h) * 32 + 32, cv_u, cv_v, cv_u8, cv_v8, cv_su, cv_sv, lane);
        convert_rows3((tile * 8 + h) * 32 + wave + 24, 8, (tile * 8 + h) * 32 + 32, cv_u, cv_v, cv_u8, cv_v8, cv_su, cv_sv, lane);
    }
    __syncthreads();
}


DEV void expert_row8(int l, int row, const bf16* H, const int* __restrict__ IDS, const float* __restrict__ GG, const unsigned char* __restrict__ U8, const unsigned char* __restrict__ V8,
                     const bf16* __restrict__ X1, const float* __restrict__ g2, const float* __restrict__ fnorm, float* __restrict__ XO, bf16* __restrict__ XOH, int lane, float pscale, LAS int* sortL,
                     const float* __restrict__ ngain, const float* __restrict__ nmod, bf16* Hout) {
    f32x2 x[16];
#pragma unroll
    for (int j = 0; j < 2; ++j) {
        const v4u a = *(const v4u*)(H + (size_t)row * D + lane * 16 + 1024 * j), c = *(const v4u*)(H + (size_t)row * D + lane * 16 + 1024 * j + 8);
        x[j * 8 + 0] = (f32x2){bf_lo(a.x), bf_hi(a.x)}; x[j * 8 + 1] = (f32x2){bf_lo(a.y), bf_hi(a.y)}; x[j * 8 + 2] = (f32x2){bf_lo(a.z), bf_hi(a.z)}; x[j * 8 + 3] = (f32x2){bf_lo(a.w), bf_hi(a.w)};
        x[j * 8 + 4] = (f32x2){bf_lo(c.x), bf_hi(c.x)}; x[j * 8 + 5] = (f32x2){bf_lo(c.y), bf_hi(c.y)}; x[j * 8 + 6] = (f32x2){bf_lo(c.z), bf_hi(c.z)}; x[j * 8 + 7] = (f32x2){bf_lo(c.w), bf_hi(c.w)};
    }
    int id0 = IDS[(size_t)row * 128 + lane], id1 = IDS[(size_t)row * 128 + 64 + lane];
    float gg0 = GG[(size_t)row * 128 + lane], gg1 = GG[(size_t)row * 128 + 64 + lane];
    {
        const int w0 = id0 >> 9, w1 = id1 >> 9; int p0 = 0, p1 = 0, base = 0;
        for (int w = 0; w < 32; ++w) {
            const unsigned long long m0 = __ballot(w0 == w), m1 = __ballot(w1 == w);
            const int c0 = __popcll(m0), c1 = __popcll(m1);
            const int b0 = (int)__builtin_amdgcn_mbcnt_hi((unsigned)(m0 >> 32), __builtin_amdgcn_mbcnt_lo((unsigned)m0, 0u));
            const int b1 = (int)__builtin_amdgcn_mbcnt_hi((unsigned)(m1 >> 32), __builtin_amdgcn_mbcnt_lo((unsigned)m1, 0u));
            p0 = (w0 == w) ? base + b0 : p0; p1 = (w1 == w) ? base + c0 + b1 : p1;
            base += c0 + c1;
        }
        sortL[p0] = id0; sortL[p1] = id1; ((LAS float*)sortL)[128 + p0] = gg0; ((LAS float*)sortL)[128 + p1] = gg1;
        LDS_WAIT();
        id0 = sortL[lane]; id1 = sortL[64 + lane]; gg0 = ((LAS float*)sortL)[128 + lane]; gg1 = ((LAS float*)sortL)[192 + lane];
        LDS_WAIT();
    }
    float wv0 = 0.f, wv1 = 0.f;
    const unsigned char* Ul = U8 + (size_t)l * NEXP * D + lane * 16;
    const unsigned char* Vl = V8 + (size_t)l * NEXP * D + lane * 16;
    for (int e0 = 0; e0 < 128; e0 += 8) {
        v4u uu[8][2];
#pragma unroll
        for (int q = 0; q < 8; ++q) { const int e = e0 + q; const int id = (e < 64) ? __builtin_amdgcn_readlane(id0, e & 63) : __builtin_amdgcn_readlane(id1, e & 63);
            uu[q][0] = *(const v4u*)(Ul + (size_t)id * D); uu[q][1] = *(const v4u*)(Ul + (size_t)id * D + 1024); }
        float ds[8];
#pragma unroll
        for (int q = 0; q < 8; ++q) {
            f32x2 acc = {0.f, 0.f};
#pragma unroll
            for (int j = 0; j < 2; ++j) {
                const unsigned wd[4] = {uu[q][j].x, uu[q][j].y, uu[q][j].z, uu[q][j].w};
#pragma unroll
                for (int dw = 0; dw < 4; ++dw) {
                    const f32x2 lo = __builtin_amdgcn_cvt_pk_f32_fp8((int)wd[dw], false), hi = __builtin_amdgcn_cvt_pk_f32_fp8((int)wd[dw], true);
                    acc = __builtin_elementwise_fma(lo, x[j * 8 + 2 * dw], acc); acc = __builtin_elementwise_fma(hi, x[j * 8 + 2 * dw + 1], acc);
                }
            }
            ds[q] = acc.x + acc.y;
        }
#pragma unroll
        for (int q = 0; q < 8; ++q) ds[q] += swz_xor<1>(ds[q]);
#pragma unroll
        for (int q = 0; q < 8; ++q) ds[q] += swz_xor<2>(ds[q]);
#pragma unroll
        for (int q = 0; q < 8; ++q) ds[q] += swz_xor<4>(ds[q]);
#pragma unroll
        for (int q = 0; q < 8; ++q) ds[q] += swz_xor<8>(ds[q]);
#pragma unroll
        for (int q = 0; q < 8; ++q) ds[q] += swz_xor<16>(ds[q]);
#pragma unroll
        for (int q = 0; q < 8; ++q) ds[q] = sum32(ds[q]);
#pragma unroll
        for (int q = 0; q < 8; ++q) { const int e = e0 + q;
            const float gq = (e < 64) ? __builtin_bit_cast(float, __builtin_amdgcn_readlane(__builtin_bit_cast(int, gg0), e & 63)) : __builtin_bit_cast(float, __builtin_amdgcn_readlane(__builtin_bit_cast(int, gg1), e & 63));
            const float w = gq * gelu_tanh(ds[q] * (1.f / U8_SCALE));
            if (e < 64) wv0 = (lane == (e & 63)) ? w : wv0; else wv1 = (lane == (e & 63)) ? w : wv1; }
    }
    f32x2 y[16];
#pragma unroll
    for (int i = 0; i < 16; ++i) y[i] = (f32x2){0.f, 0.f};
    for (int e0 = 0; e0 < 128; e0 += 8) {
        v4u vv[8][2];
#pragma unroll
        for (int q = 0; q < 8; ++q) { const int e = e0 + q; const int id = (e < 64) ? __builtin_amdgcn_readlane(id0, e & 63) : __builtin_amdgcn_readlane(id1, e & 63);
            vv[q][0] = *(const v4u*)(Vl + (size_t)id * D); vv[q][1] = *(const v4u*)(Vl + (size_t)id * D + 1024); }
#pragma unroll
        for (int q = 0; q < 8; ++q) { const int e = e0 + q;
            const float w = (e < 64) ? __builtin_bit_cast(float, __builtin_amdgcn_readlane(__builtin_bit_cast(int, wv0), e & 63)) : __builtin_bit_cast(float, __builtin_amdgcn_readlane(__builtin_bit_cast(int, wv1), e & 63));
            const f32x2 w2 = {w, w};
#pragma unroll
            for (int j = 0; j < 2; ++j) {
                const unsigned wd[4] = {vv[q][j].x, vv[q][j].y, vv[q][j].z, vv[q][j].w};
#pragma unroll
                for (int dw = 0; dw < 4; ++dw) {
                    const f32x2 lo = __builtin_amdgcn_cvt_pk_f32_fp8((int)wd[dw], false), hi = __builtin_amdgcn_cvt_pk_f32_fp8((int)wd[dw], true);
                    y[j * 8 + 2 * dw] = __builtin_elementwise_fma(w2, lo, y[j * 8 + 2 * dw]); y[j * 8 + 2 * dw + 1] = __builtin_elementwise_fma(w2, hi, y[j * 8 + 2 * dw + 1]);
                }
            }
        }
    }
    float ssq = 0.f;
#pragma unroll
    for (int j = 0; j < 2; ++j)
#pragma unroll
        for (int k4 = 0; k4 < 4; ++k4) {
            const int col = lane * 16 + 1024 * j + 4 * k4;
            const unsigned long long xw = *(const unsigned long long*)(X1 + (size_t)row * D + col); const f32x4 xa = {bf_lo((unsigned)xw), bf_hi((unsigned)xw), bf_lo((unsigned)(xw >> 32)), bf_hi((unsigned)(xw >> 32))}; const f32x4 ga = *(const f32x4*)(g2 + col) * pscale;
            f32x2& ya = y[j * 8 + 2 * k4]; f32x2& yb = y[j * 8 + 2 * k4 + 1];
            ya.x = xa.x + ga.x * ya.x; ya.y = xa.y + ga.y * ya.y; yb.x = xa.z + ga.z * yb.x; yb.y = xa.w + ga.w * yb.y;
            ssq += (ya.x * ya.x + ya.y * ya.y) + (yb.x * yb.x + yb.y * yb.y);
        }
    const float r = rsqrtf(wave_sum(ssq) * (1.f / D) + EPS);
#pragma unroll
    for (int j = 0; j < 2; ++j)
#pragma unroll
        for (int k4 = 0; k4 < 4; ++k4) {
            const int col = lane * 16 + 1024 * j + 4 * k4;
            const f32x2 ya = y[j * 8 + 2 * k4], yb = y[j * 8 + 2 * k4 + 1];
            f32x4 ov = {ya.x, ya.y, yb.x, yb.y};
            if (fnorm) *(f32x4*)(XO + (size_t)row * D + col) = ov * r * *(const f32x4*)(fnorm + col);
            else *(unsigned long long*)(XOH + (size_t)row * D + col) = (unsigned long long)pk2(ov.x, ov.y) | ((unsigned long long)pk2(ov.z, ov.w) << 32);
            if (ngain) {
                const f32x4 g = *(const f32x4*)(ngain + col), sc = *(const f32x4*)(nmod + MO_SC1 + col), sh = *(const f32x4*)(nmod + MO_SH1 + col);
                const f32x4 hv = (ov * r) * g * (sc + 1.f) + sh;
                *(unsigned long long*)(Hout + (size_t)row * D + col) = (unsigned long long)pk2(hv.x, hv.y) | ((unsigned long long)pk2(hv.z, hv.w) << 32);
            }
        }
}


DEV int claim_unit(unsigned* cnt, LAS int* claimL, int w0) {
    __syncthreads();
    if (xb_lead(w0)) *claimL = (int)__hip_atomic_fetch_add(cnt, 1u, __ATOMIC_RELAXED, __HIP_MEMORY_SCOPE_AGENT);
    __syncthreads();
    return *(volatile LAS int*)claimL;
}
struct ExIds { int id[16]; };
DEV void ex_load_ids(ExIds& I, int t, const int* __restrict__ IDS, int rg) {
#pragma unroll
    for (int q = 0; q < 4; ++q) { const int4 v = *(const int4*)(IDS + (size_t)t * 128 + 16 * rg + 4 * q); I.id[4 * q] = v.x; I.id[4 * q + 1] = v.y; I.id[4 * q + 2] = v.z; I.id[4 * q + 3] = v.w; }
}
DEV void ex_load_rows(v4u (&r)[16], const ExIds& I, const unsigned char* __restrict__ Tb  , unsigned loff  ) {
#pragma unroll
    for (int i = 0; i < 16; ++i) r[i] = *(const v4u*)(Tb + (((unsigned)I.id[i] << 7) | loff));
}
DEV void exu_compute(const v4u (&uu)[16], const v4u (&xp)[4], float* __restrict__ pp, int cl) {
    f32x2 x[16];
#pragma unroll
    for (int q = 0; q < 4; ++q) { x[4 * q] = (f32x2){bf_lo(xp[q].x), bf_hi(xp[q].x)}; x[4 * q + 1] = (f32x2){bf_lo(xp[q].y), bf_hi(xp[q].y)}; x[4 * q + 2] = (f32x2){bf_lo(xp[q].z), bf_hi(xp[q].z)}; x[4 * q + 3] = (f32x2){bf_lo(xp[q].w), bf_hi(xp[q].w)}; }
    float pd[16];
#pragma unroll
    for (int i = 0; i < 16; ++i) {
        const unsigned uw[4] = {uu[i].x, uu[i].y, uu[i].z, uu[i].w};
        f32x2 a0 = __builtin_amdgcn_cvt_scalef32_pk_f32_fp4(uw[0], 1.0f, 0) * x[0], a1 = __builtin_amdgcn_cvt_scalef32_pk_f32_fp4(uw[0], 1.0f, 1) * x[1];
        a0 = __builtin_elementwise_fma(__builtin_amdgcn_cvt_scalef32_pk_f32_fp4(uw[0], 1.0f, 2), x[2], a0); a1 = __builtin_elementwise_fma(__builtin_amdgcn_cvt_scalef32_pk_f32_fp4(uw[0], 1.0f, 3), x[3], a1);
#pragma unroll
        for (int dw = 1; dw < 4; ++dw) {
            a0 = __builtin_elementwise_fma(__builtin_amdgcn_cvt_scalef32_pk_f32_fp4(uw[dw], 1.0f, 0), x[4 * dw], a0); a1 = __builtin_elementwise_fma(__builtin_amdgcn_cvt_scalef32_pk_f32_fp4(uw[dw], 1.0f, 1), x[4 * dw + 1], a1);
            a0 = __builtin_elementwise_fma(__builtin_amdgcn_cvt_scalef32_pk_f32_fp4(uw[dw], 1.0f, 2), x[4 * dw + 2], a0); a1 = __builtin_elementwise_fma(__builtin_amdgcn_cvt_scalef32_pk_f32_fp4(uw[dw], 1.0f, 3), x[4 * dw + 3], a1); }
        { const f32x2 a = a0 + a1; pd[i] = a.x + a.y; }
    }
    const bool b2 = (cl & 4) != 0, b1 = (cl & 2) != 0, b0 = (cl & 1) != 0;
    float v8[8], v4[4], v2[2];
#pragma unroll
    for (int j = 0; j < 8; ++j) { const float keep = b2 ? pd[8 + j] : pd[j], give = b2 ? pd[j] : pd[8 + j]; v8[j] = keep + swz_xor<4>(give); }
#pragma unroll
    for (int j = 0; j < 4; ++j) { const float keep = b1 ? v8[4 + j] : v8[j], give = b1 ? v8[j] : v8[4 + j]; v4[j] = keep + swz_xor<2>(give); }
#pragma unroll
    for (int j = 0; j < 2; ++j) { const float keep = b0 ? v4[2 + j] : v4[j], give = b0 ? v4[j] : v4[2 + j]; v2[j] = keep + swz_xor<1>(give); }
    *(f32x2*)pp = (f32x2){v2[0], v2[1]};
}
template <int NT>
DEV void exu_unit(int s, int t0, const bf16* __restrict__ H, const int* __restrict__ IDS, const unsigned char* __restrict__ U8l, float* __restrict__ PD, int lane) {
    const int rg = lane >> 3, cl = lane & 7;
    const unsigned char* Ub = U8l + (size_t)s * NEXP * 128; const unsigned loff = (unsigned)cl * 16u;
    ExIds Ia, Ib; v4u ra[16], rb[16]; v4u xa[4], xb[4];
#define EXU_X(XV, T) do { const v4u* xp_ = (const v4u*)(H + (size_t)(T) * D + 256 * s + 32 * cl); XV[0] = xp_[0]; XV[1] = xp_[1]; XV[2] = xp_[2]; XV[3] = xp_[3]; } while (0)
    ex_load_ids(Ia, t0, IDS, rg); EXU_X(xa, t0);
    ex_load_rows(ra, Ia, Ub, loff);
    if (NT > 1) { ex_load_ids(Ib, t0 + 1, IDS, rg); EXU_X(xb, t0 + 1); }
#pragma unroll
    for (int k = 0; k < NT; k += 2) {
        if (k + 1 < NT) ex_load_rows(rb, Ib, Ub, loff);
        if (k + 2 < NT) { ex_load_ids(Ia, t0 + k + 2, IDS, rg); }
        exu_compute(ra, xa, PD + ((size_t)s * M + t0 + k) * 128 + 16 * rg + 2 * cl, cl);
        if (k + 2 < NT) { EXU_X(xa, t0 + k + 2); ex_load_rows(ra, Ia, Ub, loff); }
        if (k + 1 < NT) {
            if (k + 3 < NT) { ex_load_ids(Ib, t0 + k + 3, IDS, rg); }
            exu_compute(rb, xb, PD + ((size_t)s * M + t0 + k + 1) * 128 + 16 * rg + 2 * cl, cl);
            if (k + 3 < NT) { EXU_X(xb, t0 + k + 3); }
        }
    }
#undef EXU_X
}
struct ExW { float w[16]; };
DEV void ex_load_w(ExW& W, int t, const float* __restrict__ WE, int rg) {
#pragma unroll
    for (int q = 0; q < 4; ++q) { const f32x4 w = *(const f32x4*)(WE + (size_t)t * 128 + 16 * rg + 4 * q); W.w[4 * q] = w.x; W.w[4 * q + 1] = w.y; W.w[4 * q + 2] = w.z; W.w[4 * q + 3] = w.w; }
}
DEV void exv_compute(const v4u (&vv)[16], const ExW& W, int s, int t, const bf16* __restrict__ X1, const float* __restrict__ g2, bf16* __restrict__ XO, int rg, int cl) {
    f32x2 y[16];
    {   const unsigned vw[4] = {vv[0].x, vv[0].y, vv[0].z, vv[0].w}; const f32x2 w2 = {W.w[0], W.w[0]};
#pragma unroll
        for (int dw = 0; dw < 4; ++dw) { y[4 * dw] = w2 * __builtin_amdgcn_cvt_scalef32_pk_f32_fp4(vw[dw], 1.0f, 0); y[4 * dw + 1] = w2 * __builtin_amdgcn_cvt_scalef32_pk_f32_fp4(vw[dw], 1.0f, 1);
            y[4 * dw + 2] = w2 * __builtin_amdgcn_cvt_scalef32_pk_f32_fp4(vw[dw], 1.0f, 2); y[4 * dw + 3] = w2 * __builtin_amdgcn_cvt_scalef32_pk_f32_fp4(vw[dw], 1.0f, 3); } }
#pragma unroll
    for (int i = 1; i < 16; ++i) {
        const unsigned vw[4] = {vv[i].x, vv[i].y, vv[i].z, vv[i].w}; const f32x2 w2 = {W.w[i], W.w[i]};
#pragma unroll
        for (int dw = 0; dw < 4; ++dw) {
            y[4 * dw] = __builtin_elementwise_fma(w2, __builtin_amdgcn_cvt_scalef32_pk_f32_fp4(vw[dw], 1.0f, 0), y[4 * dw]); y[4 * dw + 1] = __builtin_elementwise_fma(w2, __builtin_amdgcn_cvt_scalef32_pk_f32_fp4(vw[dw], 1.0f, 1), y[4 * dw + 1]);
            y[4 * dw + 2] = __builtin_elementwise_fma(w2, __builtin_amdgcn_cvt_scalef32_pk_f32_fp4(vw[dw], 1.0f, 2), y[4 * dw + 2]); y[4 * dw + 3] = __builtin_elementwise_fma(w2, __builtin_amdgcn_cvt_scalef32_pk_f32_fp4(vw[dw], 1.0f, 3), y[4 * dw + 3]); }
    }
    const bool c5 = (rg & 4) != 0, c4 = (rg & 2) != 0, c3 = (rg & 1) != 0;
    f32x2 u8[8], u4[4], u2[2];
#pragma unroll
    for (int j = 0; j < 8; ++j) { const f32x2 keep = c5 ? y[8 + j] : y[j], give = c5 ? y[j] : y[8 + j]; u8[j].x = keep.x + part32_(give.x); u8[j].y = keep.y + part32_(give.y); }
#pragma unroll
    for (int j = 0; j < 4; ++j) { const f32x2 keep = c4 ? u8[4 + j] : u8[j], give = c4 ? u8[j] : u8[4 + j]; u4[j].x = keep.x + swz_xor<16>(give.x); u4[j].y = keep.y + swz_xor<16>(give.y); }
#pragma unroll
    for (int j = 0; j < 2; ++j) { const f32x2 keep = c3 ? u4[2 + j] : u4[j], give = c3 ? u4[j] : u4[2 + j]; u2[j].x = keep.x + swz_xor<8>(give.x); u2[j].y = keep.y + swz_xor<8>(give.y); }
    {
        const size_t o = (size_t)t * D + 256 * s + 32 * cl + 4 * rg;
        const unsigned long long xw = *(const unsigned long long*)(X1 + o); const f32x4 gg = *(const f32x4*)(g2 + 256 * s + 32 * cl + 4 * rg);
        const unsigned lo = pk2(bf_lo((unsigned)xw) + gg.x * u2[0].x, bf_hi((unsigned)xw) + gg.y * u2[0].y), hi = pk2(bf_lo((unsigned)(xw >> 32)) + gg.z * u2[1].x, bf_hi((unsigned)(xw >> 32)) + gg.w * u2[1].y);
        *(unsigned long long*)(XO + o) = (unsigned long long)lo | ((unsigned long long)hi << 32);
    }
}
template <int NT>
DEV void exv_unit(int s, int t0, const int* __restrict__ IDS, const float* __restrict__ WE, const unsigned char* __restrict__ V8l, const bf16* __restrict__ X1, const float* __restrict__ g2b  ,
                  bf16* __restrict__ XO, int lane) {
    const int rg = lane >> 3, cl = lane & 7;
    const unsigned char* Vb = V8l + (size_t)s * NEXP * 128; const unsigned loff = (unsigned)cl * 16u;
    ExIds Ia, Ib; ExW Wa, Wb; v4u ra[16], rb[16];
    ex_load_ids(Ia, t0, IDS, rg); ex_load_w(Wa, t0, WE, rg);
    ex_load_rows(ra, Ia, Vb, loff);
    if (NT > 1) { ex_load_ids(Ib, t0 + 1, IDS, rg); ex_load_w(Wb, t0 + 1, WE, rg); }
#pragma unroll
    for (int k = 0; k < NT; k += 2) {
        if (k + 1 < NT) ex_load_rows(rb, Ib, Vb, loff);
        if (k + 2 < NT) ex_load_ids(Ia, t0 + k + 2, IDS, rg);
        exv_compute(ra, Wa, s, t0 + k, X1, g2b + (size_t)((t0 + k) >> 12) * MODW, XO, rg, cl);
        if (k + 2 < NT) { ex_load_w(Wa, t0 + k + 2, WE, rg); ex_load_rows(ra, Ia, Vb, loff); }
        if (k + 1 < NT) {
            if (k + 3 < NT) ex_load_ids(Ib, t0 + k + 3, IDS, rg);
            exv_compute(rb, Wb, s, t0 + k + 1, X1, g2b + (size_t)((t0 + k + 1) >> 12) * MODW, XO, rg, cl);
            if (k + 3 < NT) ex_load_w(Wb, t0 + k + 3, WE, rg);
        }
    }
}
DEV void finalnorm_rows(const bf16* __restrict__ X, const float* __restrict__ gain, float* __restrict__ O, int gw, int NGW, int lane) {
#pragma unroll 2
    for (int m = gw; m < M; m += NGW) {
        const v4u* xr = (const v4u*)(X + (size_t)m * D) + lane;
        float v[32]; float sq = 0.f;
#pragma unroll
        for (int j = 0; j < 4; ++j) { const v4u w = xr[64 * j];
            v[8 * j + 0] = bf_lo(w.x); v[8 * j + 1] = bf_hi(w.x); v[8 * j + 2] = bf_lo(w.y); v[8 * j + 3] = bf_hi(w.y); v[8 * j + 4] = bf_lo(w.z); v[8 * j + 5] = bf_hi(w.z); v[8 * j + 6] = bf_lo(w.w); v[8 * j + 7] = bf_hi(w.w);
#pragma unroll
            for (int e = 0; e < 8; ++e) sq += v[8 * j + e] * v[8 * j + e]; }
        const float r = rsqrtf(wave_sum(sq) * (1.f / D) + EPS);
#pragma unroll
        for (int j = 0; j < 4; ++j) { const int col = 8 * (lane + 64 * j);
            const f32x4 g0 = *(const f32x4*)(gain + col), g1 = *(const f32x4*)(gain + col + 4);
            *(f32x4*)(O + (size_t)m * D + col) = (f32x4){v[8 * j + 0] * r * g0.x, v[8 * j + 1] * r * g0.y, v[8 * j + 2] * r * g0.z, v[8 * j + 3] * r * g0.w};
            *(f32x4*)(O + (size_t)m * D + col + 4) = (f32x4){v[8 * j + 4] * r * g1.x, v[8 * j + 5] * r * g1.y, v[8 * j + 6] * r * g1.z, v[8 * j + 7] * r * g1.w}; }
    }
}

struct Args { const float* in[24]; float* out; unsigned char* ws; int ph_lo, ph_hi, li, pad; };

__global__ void __launch_bounds__(512, 2) fwd(Args a) {
    extern __shared__ __attribute__((aligned(16))) unsigned char lds_raw[];
    LAS unsigned char* lds = (LAS unsigned char*)lds_raw;
#define PHASE_TID() unsigned zz_ = 0u; asm volatile("" : "+v"(zz_));   \
    int tid = wave0 * 64 + (int)__builtin_amdgcn_mbcnt_hi(~0u, __builtin_amdgcn_mbcnt_lo(~0u, zz_)); const int lane = tid & 63; (void)lane; \
    int bx = blockIdx.x, G = gridDim.x; asm volatile("" : "+s"(bx), "+s"(G)); const int wave = __builtin_amdgcn_readfirstlane(tid >> 6); \
    const int vcu = (G % 8 == 0) ? (bx % 8) * (G / 8) + bx / 8 : bx; const int gw = vcu * 8 + wave, NGW = G * 8; (void)gw; (void)NGW; (void)vcu; (void)wave; \
    const __attribute__((address_space(4))) Args* A = (const __attribute__((address_space(4))) Args*)__builtin_amdgcn_kernarg_segment_ptr(); asm volatile("" : "+s"(A))
    unsigned* ctl = (unsigned*)(a.ws + WS_CTL);
    const int lo = a.ph_lo, hi = a.ph_hi;
    const int wave0 = __builtin_amdgcn_readfirstlane((int)threadIdx.x >> 6);
    for (int u = threadIdx.x; u < (LDS_BYTES - LDS_MISC) / 4; u += 512) ((LAS unsigned*)(lds + LDS_MISC))[u] = 0u;
    __syncthreads();
    XcdBarrier bar; bar.bar = ctl + CW_BAR + (a.li & 7) * XCD_BAR_WORDS; bar.x = 0; bar.st = (volatile LAS unsigned*)(lds + LDS_MISC + 64); bar.w0 = wave0;
    if (hi - lo > 1) bar = xcd_barrier_post(ctl + CW_BAR + (a.li & 7) * XCD_BAR_WORDS, (volatile LAS unsigned*)(lds + LDS_MISC + 64), wave0);
#define TAIL_FIRST(G_) ((M / 256) * (IN_W / 256) - 2 * (G_))
#define TAIL_CONV(G_)  (TAIL_FIRST(G_) > 0 && (G_) - TAIL_FIRST(G_) >= 64)
#define IN(k) (lo <= (k) && (k) < hi)
#define SEAM(k) do { if (IN(k) && IN((k) + 1)) xcd_barrier(bar); } while (0)
#if MK_DUP >= 0
#define PH(k) if (IN(pb + (k))) for (int rep_ = 0; rep_ < ((MK_DUP == (k)) ? 2 : 1); ++rep_)
#define PH_SYNC if (rep_) __syncthreads();
#define PH_REP rep_
#define PH_UNIT(k) for (int r2_ = 0; r2_ < ((MK_DUP == (k)) ? 2 : 1); ++r2_)
#else
#define PH(k) if (IN(pb + (k)))
#define PH_SYNC
#define PH_REP 0
#define PH_UNIT(k)
#endif

#define mod   ((float*)(A->ws + WS_MOD))
#define WIN_T ((bf16*)(A->ws + WS_WIN_T))
#define WOUT_T ((bf16*)(A->ws + WS_WOUT_T))
#define WQ_T  ((bf16*)(A->ws + WS_WQ_T))
#define SUBK  ((bf16*)(A->ws + WS_SUBK))
#define UB    ((bf16*)(A->ws + WS_U))
#define VB    ((bf16*)(A->ws + WS_V))
#define H     ((bf16*)(A->ws + WS_H))
#define Z     ((bf16*)(A->ws + WS_Z))
#define HLOC  ((bf16*)(A->ws + WS_HLOC))
#define PP    ((bf16*)(A->ws + WS_P))
#define YB    ((float*)(A->ws + WS_YB))
#define YC    ((bf16*)(A->ws + WS_YC))
#define SUMA  ((float*)(A->ws + WS_SUMA))
#define SUMB  ((float*)(A->ws + WS_SUMB))
#define X1    ((float*)(A->ws + WS_X1))
#define X2    ((float*)(A->ws + WS_X2))
#define QB    ((bf16*)(A->ws + WS_Q))
#define IDS   ((int*)(A->ws + WS_IDS))
#define GG    ((float*)(A->ws + WS_G))
#define PARTB ((bf16*)(A->ws + WS_PART))
#define WG_T  ((bf16*)(A->ws + WS_WG_T))
#define PDOT  ((float*)(A->ws + WS_PDOT))
#define SCL   ((float*)(A->ws + WS_SCL))
#define WEXP  ((float*)(A->ws + WS_WEXP))
#define LSEB  ((float*)(A->ws + WS_LSE))
#define XIN   ((l == 0) ? A->in[0] : (const float*)X2)
#define XR    ((bf16*)(A->ws + WS_XR))
#define X1H   ((bf16*)(A->ws + WS_X1))
#define X2H   ((bf16*)(A->ws + WS_X2))
#define XRES  ((l == 0) ? (const bf16*)XR : (const bf16*)X2H)
#define MODL  (mod + (size_t)l * 2 * MODW)
    if (IN(0)) {
        PHASE_TID();
        ph_mod(A->in[1], A->in[2], A->in[3], mod, (LAS float*)lds, vcu, G, tid);
        {
            LAS float* scr = (LAS float*)(lds + wave * 17408);
            constexpr int I_IN = (D / 64) * (IN_W / 64), I_SQ = (D / 64) * (D / 64), I_L = I_IN + 2 * I_SQ;
            for (int it = gw; it < 2 * I_L; it += NGW) {
                const int l = it / I_L; int r = it % I_L;
                if (r < I_IN) { transpose_item64(A->in[6] + (size_t)l * D * IN_W, D, IN_W, WIN_T + (size_t)l * IN_W * D, scr, r, lane); continue; } r -= I_IN;
                if (r < I_SQ) { transpose_item64(A->in[18] + (size_t)l * D * D, D, D, WOUT_T + (size_t)l * D * D, scr, r, lane); continue; } r -= I_SQ;
                transpose_item64(A->in[19] + (size_t)l * D * D, D, D, WQ_T + (size_t)l * D * D, scr, r, lane);
            }
        }
        {
            LAS float* scr = (LAS float*)(lds + wave * 17408);
            for (int it = gw; it < 2 * 6 * 2 * 8; it += NGW) { const int mi = it >> 3, sub = it & 7; const int ln = mi >> 1, g = mi & 1;
                transpose_item((g ? A->in[11] : A->in[9]) + (size_t)ln * 128 * 128, 128, 128, WG_T + ((size_t)ln * 2 + g) * 128 * 128, scr, sub, lane); }
        }
        const size_t gtid = (size_t)vcu * 512 + tid, gstride = (size_t)G * 512;
        convert_copy(A->in[20], SUBK, (size_t)2 * 8 * 2 * 128 * 128 / 8, gtid, gstride);
    }
    SEAM(0);

    for (int l = 0; l < NL; ++l) {
        const int pb = 1 + PH_L * l;
        if (IN(pb + 0) && l == 0) { PHASE_TID(); modnorm_rows(XIN, A->in[4] + l * D, MODL, MO_SH1, MO_SC1, H, gw, NGW, lane, XR); }
        if (l == 0) SEAM(pb + 0);
        PH(1) { PH_SYNC
            PHASE_TID(); (void)tid;
            pg8::Gemm g{H, WIN_T + (size_t)l * IN_W * D, M, IN_W, D}; pg8::StaticOrder S; S.init(M, IN_W, G, bx);
            pg8::EpiBf16<0> E{Z, IN_W, nullptr, 0, 0};
            pg8::gemm_phase<pg8::EpiBf16<0>, pg8::StaticOrder, false>((PG8_LAS unsigned char*)lds, g, S, E, nullptr, wave0);
            if (TAIL_CONV(G) && bx >= TAIL_FIRST(G)) {
                const int lane_ = (int)__builtin_amdgcn_mbcnt_hi(~0u, __builtin_amdgcn_mbcnt_lo(~0u, 0u));
                const int NW = (G - TAIL_FIRST(G)) * 8, w = (bx - TAIL_FIRST(G)) * 8 + wave0;
#pragma unroll 1
                for (int R = w; R < NEXP; R += 3 * NW) convert_rows3(R, NW, NEXP,        A->in[21] + (size_t)l * NEXP * D, A->in[22] + (size_t)l * NEXP * D, (unsigned char*)UB + (size_t)l * NEXP * D,
                                                                         (unsigned char*)VB + (size_t)l * NEXP * D, SCL + (size_t)(2 * l) * NEXP, SCL + (size_t)(2 * l + 1) * NEXP, lane_);
            }
        }
        SEAM(pb + 1);
        PH(2) { PH_SYNC
            PHASE_TID();
            const bool lru_bal = (G == 256);
            const int it_lo = !lru_bal ? vcu : (vcu < 128 ? 2 * vcu : (vcu < 192 ? 256 + 3 * (vcu - 128) : 448 + 5 * (vcu - 192)));
            const int it_hi = !lru_bal ? 2 * 64 * 6 : (vcu < 128 ? it_lo + 2 : (vcu < 192 ? it_lo + 3 : it_lo + 5)), it_st = lru_bal ? 1 : G;
            for (int it = it_lo; it < it_hi; it += it_st) {
                const int b = it / 384, r = it % 384, j = r / 6, n = r % 6;
                lru_item2(l, b, j, n, Z, A->in[7], A->in[8], WG_T, A->in[10], A->in[12], A->in[13], HLOC, PP, SUMA, SUMB,
                          (LAS float*)lds, (LAS float*)(lds + 34816), (LAS float*)(lds + 69632), tid);
            }
            {
                {
                    LAS unsigned char* wl = lds + wave * ATT_WLDS;
                    for (int it = gw; it < 1024 + 4608; it += NGW) {
                        if (it < 1024) { const int bh = it >> 7, tl = 127 - (it & 127); sb_mfma_item(bh >> 2, bh & 3, 32 * tl, Z, YC, wl, lane); }
                        else { const int i2 = it - 1024; const int tl = i2 & 127, p = (i2 >> 7) % 3, bh = i2 / 384; const int d = 1 << (2 * p);
                            dil_mfma_item(bh / 6, bh % 6, p, tl % d, 32 * (tl / d), Z, A->in[14], PARTB, LSEB, wl, lane); }
                    }
                }
            }
        }
        SEAM(pb + 2);
        PH(3) { PH_SYNC
            PHASE_TID();
            for (int it = vcu; it < 256; it += G) { const int b = it >> 7, j = (it >> 1) & 63, half = it & 1;
                combine_item(l, b, j, half, Z, HLOC, PP, SUMA, SUMB, PARTB, LSEB, YC, A->in[15], A->in[16], A->in[17], H, (LAS float*)lds, tid); }
        }
        SEAM(pb + 3);
        PH(4) { PH_SYNC
            PHASE_TID(); (void)tid;
            pg8::Gemm g{H, WOUT_T + (size_t)l * D * D, M, D, D}; pg8::StaticOrder S; S.init(M, D, G, bx);
            EpiResGate E{XRES, X1H, MODL + MO_G1, 1.f};
            pg8::gemm_phase<EpiResGate, pg8::StaticOrder, false>((PG8_LAS unsigned char*)lds, g, S, E, nullptr, wave0);
        }
        SEAM(pb + 4);
        PH(5) { PH_SYNC PHASE_TID(); modnorm_rows_h(X1H, A->in[5] + l * D, MODL, MO_SH2, MO_SC2, H, gw, NGW, lane); }
        SEAM(pb + 5);
        PH(6) { PH_SYNC
            PHASE_TID(); (void)tid;
            pg8::Gemm g{H, WQ_T + (size_t)l * D * D, M, D, D}; pg8::StaticOrder S; S.init(M, D, G, bx);
            pg8::EpiBf16<0> E{QB, D, nullptr, 0, 0};
            pg8::gemm_phase<pg8::EpiBf16<0>, pg8::StaticOrder, false>((PG8_LAS unsigned char*)lds, g, S, E, nullptr, wave0);
        }
        SEAM(pb + 6);
        PH(7) { PH_SYNC
            PHASE_TID();
            for (int it = vcu; it < 128 * 8; it += G) route_item2(l, it >> 3, it & 7, QB, SUBK, IDS, GG, lds, tid, l * 1024 + it + 1 + PH_REP * 4096, A->in[21] + (size_t)l * NEXP * D, A->in[22] + (size_t)l * NEXP * D,
                                                                                      (unsigned char*)UB + (size_t)l * NEXP * D, (unsigned char*)VB + (size_t)l * NEXP * D, SCL + (size_t)(2 * l) * NEXP, SCL + (size_t)(2 * l + 1) * NEXP, !TAIL_CONV(G) || it >= 512);
        }
        SEAM(pb + 7);
        PH(8) { PH_SYNC
            PHASE_TID();
            LAS int* claimL = (LAS int*)(lds + LDS_MISC + 192);
            const int s0 = (int)xb_xcc_id();
            for (int ds = 0; ds < 8; ++ds) { const int s = (s0 + ds) & 7;
                unsigned* cnt = (unsigned*)(A->ws + WS_CTL) + 45056 + ((l * 2 + 0) * 16 + s) * 64;
                for (;;) { const int c = claim_unit(cnt, claimL, wave0); if (c >= M / 128) break;
                    PH_UNIT(108)
                    exu_unit<16>(s, c * 128 + wave * 16, H, IDS, (const unsigned char*)UB + (size_t)l * NEXP * D, PDOT, lane); } }
        }
        SEAM(pb + 8);
        PH(9) { PH_SYNC
            PHASE_TID();
            const float* su = SCL + (size_t)(2 * l) * NEXP; const float* sv = SCL + (size_t)(2 * l + 1) * NEXP;
            for (int o = vcu * 512 + tid; o < M * 128; o += G * 512) { float d = 0.f; const int id = IDS[o];
#pragma unroll
                for (int sl = 0; sl < 8; ++sl) d += PDOT[(size_t)sl * M * 128 + o];
                WEXP[o] = GG[o] * gelu_tanh(d * su[id]) * sv[id]; }
        }
        SEAM(pb + 9);
        PH(10) { PH_SYNC
            PHASE_TID();
            LAS int* claimL = (LAS int*)(lds + LDS_MISC + 192);
            const int s0 = (int)xb_xcc_id();
            for (int ds = 0; ds < 8; ++ds) { const int s = (s0 + ds) & 7;
                unsigned* cnt = (unsigned*)(A->ws + WS_CTL) + 45056 + ((l * 2 + 1) * 16 + s) * 64;
                for (;;) { const int c = claim_unit(cnt, claimL, wave0); if (c >= M / 128) break;
                    PH_UNIT(110)
                    exv_unit<16>(s, c * 128 + wave * 16, IDS, WEXP, (const unsigned char*)VB + (size_t)l * NEXP * D, X1H, MODL + MO_G2, X2H, lane); } }
        }
        SEAM(pb + 10);
        PH(11) { PH_SYNC
            PHASE_TID();
            if (l + 1 < NL) modnorm_rows_h(X2H, A->in[4] + (l + 1) * D, mod + (size_t)(l + 1) * 2 * MODW, MO_SH1, MO_SC1, H, gw, NGW, lane);
            else finalnorm_rows(X2H, A->in[23], A->out, gw, NGW, lane);
        }
        if (l + 1 < NL) SEAM(pb + 11);
    }
#undef IN
#undef SEAM
#undef mod
#undef H
#undef Z
#undef X1
#undef X2
}
}

extern "C" void kernel_launch(void* const* d_in, const int* in_sizes, int n_in, void* d_out, int out_size, void* d_ws, size_t ws_size, hipStream_t stream) {
    using namespace mk;
    static int grid = 0;
    if (grid == 0) {
        if (n_in != 24 || out_size != M * D || ws_size < WS_END) { fprintf(stderr, "kernel_launch: unexpected shapes (n_in %d out %d ws %zu)\n", n_in, out_size, ws_size); grid = -1; return; }
        int dev = 0, cus = 0, per_cu = 0;
        if (hipGetDevice(&dev) != hipSuccess || hipDeviceGetAttribute(&cus, hipDeviceAttributeMultiprocessorCount, dev) != hipSuccess) { grid = -1; return; }
        if (hipFuncSetAttribute((const void*)fwd, hipFuncAttributeMaxDynamicSharedMemorySize, LDS_BYTES) != hipSuccess) { fprintf(stderr, "kernel_launch: hipFuncSetAttribute failed\n"); grid = -1; return; }
        if (hipOccupancyMaxActiveBlocksPerMultiprocessor(&per_cu, (const void*)fwd, 512, LDS_BYTES) != hipSuccess || per_cu < 1) fprintf(stderr, "kernel_launch: occupancy query says %d\n", per_cu);
        (void)hipGetLastError();
        grid = cus;
    }
    if (grid < 0) return;
    (void)hipMemsetAsync((char*)d_ws + WS_CTL, 0, CTL_ZERO_BYTES, stream);
    Args a{};
    for (int i = 0; i < 24; ++i) a.in[i] = (const float*)d_in[i];
    a.out = (float*)d_out; a.ws = (unsigned char*)d_ws; a.pad = 0;
#ifdef MK_REPEAT_PHASE
    {   const int P = 1 + (MK_REPEAT_PHASE); const int lo_[5] = {0, P, P + 1, P + 12, P + 13}, hi_[5] = {P + 1, P + 1, P + 13, P + 13, NPHASE};
        for (int li = 0; li < 5; ++li) { a.ph_lo = lo_[li]; a.ph_hi = hi_[li]; a.li = li; if (MK_REPEAT_CONTROL && (li == 1 || li == 3)) continue;
            if (li == 1 || li == 3) (void)hipMemsetAsync((char*)d_ws + WS_CTL + 45056 * 4, 0, 4096 * 4, stream);
            hipLaunchKernelGGL(fwd, dim3(grid), dim3(512), LDS_BYTES, stream, a); }
        return; }
#endif
    constexpr int NLAUNCH = MK_N_LAUNCHES;
    for (int li = 0; li < NLAUNCH; ++li) {
        a.ph_lo = (NLAUNCH == 1) ? 0 : li; a.ph_hi = (NLAUNCH == 1) ? NPHASE : li + 1; a.li = li;
        hipLaunchKernelGGL(fwd, dim3(grid), dim3(512), LDS_BYTES, stream, a);
    }
}
```

```cpp
#include <hip/hip_runtime.h>
#include <cstdio>
#include <cstdint>
namespace pg8 {
#define PG8_LAS __attribute__((address_space(3)))
typedef unsigned short bf16_t;
typedef short bf16x8 __attribute__((ext_vector_type(8)));
typedef float f32x4 __attribute__((ext_vector_type(4)));
typedef unsigned u32x4 __attribute__((ext_vector_type(4)));
constexpr int BM = 256, BK = 64, HALF = 128, HTB = HALF * BK * 2  , STAGE_BYTES = 8 * HTB, NXCD = 8, WGM = 8;

__host__ __device__ __forceinline__ int lds_byte(int r, int c) { const int st = (r >> 4) * 2 + (c >> 5), rr = r & 15, cc = c & 31, ob = rr * 64 + cc * 2; return st * 1024 + (ob ^ (((ob >> 9) & 1) << 5)); }
__host__ __device__ __forceinline__ void stage_rc(int b, int& R, int& C) { const int st = b / 1024, sb = b % 1024, swz = sb ^ (((sb >> 9) & 1) << 5); R = (st >> 1) * 16 + swz / 64; C = (st & 1) * 32 + (swz % 64) / 2; }
__host__ __device__ __forceinline__ int perm32(int rho) { const int n = rho >> 4, i = rho & 15; return 8 * (i >> 2) + 4 * n + (i & 3); }

struct Unit { int pm, pn; };
struct Gemm { const bf16_t* A; const bf16_t* Bt; int M, N, K; };

struct StaticOrder {
    int nM, nN, nwg, G, c;
    __host__ __device__ void init(int M, int N, int G_, int c_) { nM = M / BM; nN = N / BM; nwg = nM * nN; G = G_; c = c_; }
    __host__ __device__ bool next(int i, Unit& u) const {
        const long L = (long)i * G + c; if (L >= nwg) return false;
        int wgid = (int)L; { const int q = nwg / NXCD, r = nwg % NXCD, xcd = wgid % NXCD, off = wgid / NXCD; wgid = (xcd < r ? xcd * (q + 1) : r * (q + 1) + (xcd - r) * q) + off; }
        const int nig = WGM * nN, gid = wgid / nig, fm = gid * WGM, gsz = (nM - fm) < WGM ? (nM - fm) : WGM;
        u.pm = fm + ((wgid % nig) % gsz); u.pn = (wgid % nig) / gsz; return true;
    }
    __device__ __forceinline__ void a_ready(const Unit&) const {}
    __device__ __forceinline__ void done(const Unit&) const {}
};
struct CountedOrder : StaticOrder {
    const unsigned* ready; unsigned need; unsigned* tmo;
    __device__ __forceinline__ void a_ready(const Unit& u) const {
        if (threadIdx.x < 64) {
            const unsigned long long t0 = __builtin_amdgcn_s_memrealtime(); unsigned polls = 0;
            while ((unsigned)__builtin_amdgcn_readfirstlane(__hip_atomic_load(ready + 64 * u.pm, __ATOMIC_RELAXED, __HIP_MEMORY_SCOPE_AGENT)) < need) {
                if ((++polls & 255u) == 0u && __builtin_amdgcn_readfirstlane(__hip_atomic_load(tmo, __ATOMIC_RELAXED, __HIP_MEMORY_SCOPE_AGENT)) != 0u) break;
                if (__builtin_amdgcn_s_memrealtime() - t0 > 2000000ull) {
                    if (threadIdx.x == 0) { unsigned expect = 0u; __hip_atomic_compare_exchange_strong(tmo + 1, &expect, 0x600u | (unsigned)(u.pm & 0xff), __ATOMIC_RELAXED, __ATOMIC_RELAXED, __HIP_MEMORY_SCOPE_AGENT); __hip_atomic_store(tmo, 1u, __ATOMIC_RELAXED, __HIP_MEMORY_SCOPE_AGENT); }
                    break; }
                __builtin_amdgcn_s_sleep(2); }
            __builtin_amdgcn_fence(__ATOMIC_ACQUIRE, "agent");
            asm volatile("s_waitcnt vmcnt(0)" ::: "memory");
        }
#if !defined(BROKEN_HOOK_NO_BARRIER)
        asm volatile("" ::: "memory"); __builtin_amdgcn_s_barrier(); asm volatile("" ::: "memory");
#endif
    }
};

__device__ __forceinline__ unsigned cvt_pk_bf16(float lo, float hi) { unsigned r; asm volatile("v_cvt_pk_bf16_f32 %0, %1, %2" : "=v"(r) : "v"(lo), "v"(hi)); return r; }
typedef float f32x2 __attribute__((ext_vector_type(2)));
__device__ __forceinline__ f32x2 gelu_pk(f32x2 v) {
    const f32x2 av = __builtin_elementwise_abs(v), d = av * 0.2316418882f + 1.0f;
    f32x2 t; t.x = __builtin_amdgcn_rcpf(d.x); t.y = __builtin_amdgcn_rcpf(d.y);
    f32x2 q = t * 0.5307027145f + (-0.7265760135f); q = q * t + 0.7107068705f; q = q * t + (-0.142248368f); q = q * t + 0.127414796f; q = q * t;
    const f32x2 s = (v * v) * (-0.72134752044f);
    f32x2 e; e.x = __builtin_amdgcn_exp2f(s.x); e.y = __builtin_amdgcn_exp2f(s.y);
    const f32x2 m = v * (q * e), r = v - m;
    f32x2 o; o.x = v.x < 0.f ? m.x : r.x; o.y = v.y < 0.f ? m.y : r.y; return o;
}

struct EpiF32 {
    static constexpr bool PERM = false, AFTER_DRAIN = false;
    float* C; int ldc; const float* bias;
    __device__ __forceinline__ void operator()(const f32x4 (&acc)[2][2][4][2], const Unit& u, int wr, int wc, int fr, int fq) const {
        const int row0 = u.pm * BM + wr * 64 + fr, col0 = u.pn * BM + wc * 32 + 4 * fq;
        f32x4 bv[2][2];
#pragma unroll
        for (int bj = 0; bj < 2; ++bj)
#pragma unroll
            for (int n = 0; n < 2; ++n) bv[bj][n] = bias ? *(const f32x4*)(bias + col0 + bj * HALF + n * 16) : (f32x4){0.f, 0.f, 0.f, 0.f};
#pragma unroll
        for (int ai = 0; ai < 2; ++ai)
#pragma unroll
            for (int m = 0; m < 4; ++m) { float* rowp = C + (size_t)(row0 + ai * HALF + m * 16) * ldc + col0;
#pragma unroll
                for (int bj = 0; bj < 2; ++bj)
#pragma unroll
                    for (int n = 0; n < 2; ++n) *(f32x4*)(rowp + bj * HALF + n * 16) = acc[ai][bj][m][n] + bv[bj][n]; }
    }
};
template <int ACT  > struct EpiBf16 {
    static constexpr bool PERM = true, AFTER_DRAIN = false;
    bf16_t* O; int ldc; const float* bias; int split_cols; size_t split_stride;
    __device__ __forceinline__ void operator()(const f32x4 (&acc)[2][2][4][2], const Unit& u, int wr, int wc, int fr, int fq) const {
        const int row0 = u.pm * BM + wr * 64 + fr; int colt = u.pn * BM; bf16_t* base = O;
        if (split_cols) { const int t = colt / split_cols; base += (size_t)t * split_stride; colt -= t * split_cols; }
        const int col0 = colt + wc * 32 + 8 * fq, bcol0 = u.pn * BM + wc * 32 + 8 * fq;
        f32x4 bv[2][2];
#pragma unroll
        for (int bj = 0; bj < 2; ++bj)
#pragma unroll
            for (int n = 0; n < 2; ++n) bv[bj][n] = bias ? *(const f32x4*)(bias + bcol0 + bj * HALF + 4 * n) : (f32x4){0.f, 0.f, 0.f, 0.f};
#pragma unroll
        for (int ai = 0; ai < 2; ++ai)
#pragma unroll
            for (int m = 0; m < 4; ++m) { bf16_t* rowp = base + (size_t)(row0 + ai * HALF + m * 16) * ldc + col0;
#pragma unroll
                for (int bj = 0; bj < 2; ++bj) { f32x4 v0 = acc[ai][bj][m][0] + bv[bj][0], v1 = acc[ai][bj][m][1] + bv[bj][1];
                    if (ACT == 1) { f32x2 a = gelu_pk((f32x2){v0[0], v0[1]}), b = gelu_pk((f32x2){v0[2], v0[3]}), c = gelu_pk((f32x2){v1[0], v1[1]}), d = gelu_pk((f32x2){v1[2], v1[3]});
                        v0 = (f32x4){a.x, a.y, b.x, b.y}; v1 = (f32x4){c.x, c.y, d.x, d.y}; }
                    if (ACT == 2) {
#pragma unroll
                        for (int j = 0; j < 4; ++j) { v0[j] = 0.5f * v0[j] * (1.0f + erff(v0[j] * 0.70710678f)); v1[j] = 0.5f * v1[j] * (1.0f + erff(v1[j] * 0.70710678f)); } }
                    u32x4 w; w.x = cvt_pk_bf16(v0[0], v0[1]); w.y = cvt_pk_bf16(v0[2], v0[3]); w.z = cvt_pk_bf16(v1[0], v1[1]); w.w = cvt_pk_bf16(v1[2], v1[3]);
                    *(u32x4*)(rowp + bj * HALF) = w; } }
    }
};
template <class Epi, class Sched, bool STAMP = false>
__device__ __forceinline__ void gemm_phase(PG8_LAS unsigned char* lds, const Gemm g, const Sched& S, const Epi& E, unsigned long long* stamps, int wave_id) {
    unsigned zz_o = 0u; asm volatile("" : "+v"(zz_o)); int tid_o = wave_id * 64 + (int)__builtin_amdgcn_mbcnt_hi(~0u, __builtin_amdgcn_mbcnt_lo(~0u, zz_o));
    const int tid = tid_o, wid = __builtin_amdgcn_readfirstlane(tid >> 6), lane = tid & 63, wr = wid >> 2, wc = wid & 3, fr = lane & 15, fq = lane >> 4;
    constexpr int K = 2048, nt = K / BK;
    int ts_lo = 0, ts_hi = 0, nts = 0; const unsigned long long rt_entry = STAMP ? (unsigned long long)wall_clock64() : 0ull;
#define PG8_STAMP() do { if (STAMP && wid == 0 && nts < 64) { const unsigned long long _c = (unsigned long long)clock64(); \
        ts_lo = (lane == nts) ? (int)(unsigned)_c : ts_lo; ts_hi = (lane == nts) ? (int)(unsigned)(_c >> 32) : ts_hi; ++nts; } } while (0)
    PG8_STAMP();
    unsigned voffA[2], voffB[2];
#pragma unroll
    for (int i = 0; i < 2; ++i) { int R, C; stage_rc(tid * 16 + i * 8192, R, C); const int Rb = Epi::PERM ? ((R & ~31) + perm32(R & 31)) : R;
        voffA[i] = (unsigned)(R * K + C) * 2u; voffB[i] = (unsigned)(Rb * K + C) * 2u; }
    const size_t kstep = (size_t)(BK * 2);
    const size_t hstep = (size_t)HALF * K * 2;
    const size_t tstep = 2 * hstep;
    const unsigned ldsw = (unsigned)wid * 1024u;
    const int aoff = lds_byte(wr * 64 + fr, fq * 8), boff = lds_byte(wc * 32 + fr, fq * 8);
#define PG8_SA(b, h) (((b) * 2 + (h)) * HTB)
#define PG8_SB(b, h) ((4 + (b) * 2 + (h)) * HTB)
#define PG8_STAGE(bufoff, gbase, voff) do { _Pragma("unroll") for (int _i = 0; _i < 2; ++_i) \
        __builtin_amdgcn_global_load_lds((const unsigned*)((const char*)(gbase) + (voff)[_i]), (PG8_LAS unsigned*)(lds + (bufoff) + ldsw + _i * 8192), 16, 0, 0); } while (0)
#define PG8_LDA(dst, b, h) do { _Pragma("unroll") for (int m = 0; m < 4; ++m) _Pragma("unroll") for (int k = 0; k < 2; ++k) dst[m][k] = *(const PG8_LAS bf16x8*)(lds + PG8_SA(b, h) + aoff + m * 2048 + k * 1024); } while (0)
#define PG8_LDB(dst, b, h) do { _Pragma("unroll") for (int n = 0; n < 2; ++n) _Pragma("unroll") for (int k = 0; k < 2; ++k) dst[n][k] = *(const PG8_LAS bf16x8*)(lds + PG8_SB(b, h) + boff + n * 2048 + k * 1024); } while (0)
#define PG8_MMA(ai, bj, At, Bt) do { __builtin_amdgcn_s_setprio(1); _Pragma("unroll") for (int m = 0; m < 4; ++m) _Pragma("unroll") for (int n = 0; n < 2; ++n) _Pragma("unroll") for (int k = 0; k < 2; ++k) \
        acc[ai][bj][m][n] = __builtin_amdgcn_mfma_f32_16x16x32_bf16(Bt[n][k], At[m][k], acc[ai][bj][m][n], 0, 0, 0); __builtin_amdgcn_s_setprio(0); } while (0)
#define PG8_WAIT_V(n) asm volatile("s_waitcnt vmcnt(" #n ")" ::: "memory")
#define PG8_WAIT_L(n) asm volatile("s_waitcnt lgkmcnt(" #n ")" ::: "memory")
#define PG8_BAR __builtin_amdgcn_s_barrier()
#define PG8_SCHED __builtin_amdgcn_sched_barrier(0)
    Unit cur, nxt; int ui = 0;
    if (!S.next(0, cur)) return;
    f32x4 acc[2][2][4][2];
#pragma unroll
    for (int a = 0; a < 2; ++a)
#pragma unroll
        for (int b = 0; b < 2; ++b)
#pragma unroll
            for (int m = 0; m < 4; ++m)
#pragma unroll
                for (int n = 0; n < 2; ++n) acc[a][b][m][n] = (f32x4){0.f, 0.f, 0.f, 0.f};
    bf16x8 At[4][2], B0[2][2], B1[2][2];
    const char* cA = (const char*)g.A + (size_t)cur.pm * tstep; const char* cB = (const char*)g.Bt + (size_t)cur.pn * tstep;
    S.a_ready(cur);
    PG8_STAGE(PG8_SB(0, 0), cB, voffB); PG8_STAGE(PG8_SA(0, 0), cA, voffA); PG8_STAGE(PG8_SB(0, 1), cB + hstep, voffB); PG8_STAGE(PG8_SA(0, 1), cA + hstep, voffA);
    if (wr == 1) PG8_BAR;
    PG8_WAIT_V(4); PG8_BAR;
    PG8_STAGE(PG8_SB(1, 0), cB + kstep, voffB); PG8_STAGE(PG8_SA(1, 0), cA + kstep, voffA); PG8_STAGE(PG8_SB(1, 1), cB + hstep + kstep, voffB);
    PG8_WAIT_V(6); PG8_BAR;
    PG8_STAMP();
    for (;;) {
        const bool has_next = S.next(ui + 1, nxt);
        const char* nA = has_next ? (const char*)g.A + (size_t)nxt.pm * tstep : cA; const char* nB = has_next ? (const char*)g.Bt + (size_t)nxt.pn * tstep : cB;
        for (int t = 0; t < nt; t += 2) {
            const bool last = (t == nt - 2);
            const char* a1 = cA + (size_t)(t + 1) * kstep;
            const char* a2 = last ? nA : cA + (size_t)(t + 2) * kstep; const char* b2 = last ? nB : cB + (size_t)(t + 2) * kstep;
            const char* a3 = a2 + kstep; const char* b3 = b2 + kstep;
            if (last && has_next) S.a_ready(nxt);
            PG8_LDB(B0, 0, 0); PG8_SCHED; PG8_LDA(At, 0, 0); PG8_STAGE(PG8_SA(1, 1), a1 + hstep, voffA);
            PG8_WAIT_L(8); PG8_BAR; PG8_WAIT_L(0); PG8_MMA(0, 0, At, B0); PG8_BAR; PG8_SCHED;
            PG8_LDB(B1, 0, 1); PG8_STAGE(PG8_SB(0, 0), b2, voffB);
            PG8_BAR; PG8_WAIT_L(0); PG8_MMA(0, 1, At, B1); PG8_BAR;
            PG8_LDA(At, 0, 1); PG8_STAGE(PG8_SA(0, 0), a2, voffA);
            PG8_BAR; PG8_WAIT_L(0); PG8_MMA(1, 0, At, B0); PG8_BAR; PG8_SCHED;
            PG8_STAGE(PG8_SB(0, 1), b2 + hstep, voffB);
            PG8_WAIT_V(6); PG8_BAR; PG8_MMA(1, 1, At, B1); PG8_BAR;
            PG8_LDB(B0, 1, 0); PG8_SCHED; PG8_LDA(At, 1, 0); PG8_STAGE(PG8_SA(0, 1), a2 + hstep, voffA);
            PG8_WAIT_L(8); PG8_BAR; PG8_WAIT_L(0); PG8_MMA(0, 0, At, B0); PG8_BAR; PG8_SCHED;
            PG8_LDB(B1, 1, 1); PG8_STAGE(PG8_SB(1, 0), b3, voffB);
            PG8_BAR; PG8_WAIT_L(0); PG8_MMA(0, 1, At, B1); PG8_BAR;
            PG8_LDA(At, 1, 1); PG8_STAGE(PG8_SA(1, 0), a3, voffA);
            PG8_BAR; PG8_WAIT_L(0); PG8_MMA(1, 0, At, B0); PG8_BAR; PG8_SCHED;
            PG8_STAGE(PG8_SB(1, 1), b3 + hstep, voffB);
            PG8_WAIT_V(6); PG8_BAR; PG8_MMA(1, 1, At, B1); PG8_BAR;
        }
        PG8_STAMP();
        if constexpr (!Epi::AFTER_DRAIN) { E(acc, cur, wr, wc, fr, fq); S.done(cur); }
        PG8_STAMP();
        if (!has_next) break;
#pragma unroll
        for (int a = 0; a < 2; ++a)
#pragma unroll
            for (int b = 0; b < 2; ++b)
#pragma unroll
                for (int m = 0; m < 4; ++m)
#pragma unroll
                    for (int n = 0; n < 2; ++n) acc[a][b][m][n] = (f32x4){0.f, 0.f, 0.f, 0.f};
        cur = nxt; cA = nA; cB = nB; ++ui;
    }
    PG8_WAIT_V(0);
    if (wr == 0) PG8_BAR;
    PG8_BAR;
    if constexpr (Epi::AFTER_DRAIN) { E.fused(acc, cur, wr, wc, fr, fq, lds, wid, lane); S.done(cur); }
    PG8_STAMP();
    if (STAMP && wid == 0) { stamps[lane] = lane < nts ? (((unsigned long long)(unsigned)ts_hi << 32) | (unsigned)ts_lo) : 0ull;
        if (lane == 62) stamps[62] = rt_entry; if (lane == 63) stamps[63] = (unsigned long long)wall_clock64(); }
#undef PG8_STAMP
#undef PG8_SA
#undef PG8_SB
#undef PG8_STAGE
#undef PG8_LDA
#undef PG8_LDB
#undef PG8_MMA
#undef PG8_WAIT_V
#undef PG8_WAIT_L
#undef PG8_BAR
#undef PG8_SCHED
}
}

namespace mk {
#define GAS __attribute__((address_space(1)))
#define LAS __attribute__((address_space(3)))
#define DEV __device__ __forceinline__
typedef unsigned short bf16;
typedef unsigned v4u __attribute__((ext_vector_type(4)));
typedef float f32x4 __attribute__((ext_vector_type(4)));
typedef float f32x2 __attribute__((ext_vector_type(2)));
typedef short bf16x8 __attribute__((ext_vector_type(8)));
typedef float f32x16 __attribute__((ext_vector_type(16)));
typedef __bf16 bf16x2_t __attribute__((ext_vector_type(2)));

#ifndef MK_DUP
#define MK_DUP -1
#endif
#ifndef MK_REPEAT_CONTROL
#define MK_REPEAT_CONTROL 0
#endif
#ifndef MK_N_LAUNCHES
#define MK_N_LAUNCHES 1
#endif

constexpr int D = 2048, SEQ = 4096, M = 8192, NL = 2;
constexpr int LRU_W = 768, SWA_W = 768, SB_W = 512, IN_W = 5376;
constexpr int ZO_XA = 0, ZO_GA = 768, ZO_QB = 1536, ZO_KB = 2304, ZO_VB = 3072, ZO_QC = 3840, ZO_KC = 4352, ZO_VC = 4864;
constexpr int NEXP = 16384, MODW = 12288;
constexpr int MO_SH1 = 0, MO_SC1 = 2048, MO_G1 = 4096, MO_SH2 = 6144, MO_SC2 = 8192, MO_G2 = 10240;
constexpr float EPS = 1e-6f;
constexpr float QSCALE = 0.08838834764831845f;
constexpr float NEGBIG = -3.0e38f;
constexpr int PH_L = 12;
constexpr int NPHASE = 1 + 2 * PH_L;

constexpr size_t MiB = 1u << 20;
constexpr size_t WS_CTL = 0, CTL_ZERO_BYTES = 1 * MiB;
constexpr size_t WS_MOD = 512 * 1024;
constexpr size_t WS_WIN_T = 2 * MiB, WS_WOUT_T = 44 * MiB, WS_WQ_T = 60 * MiB, WS_SUBK = 76 * MiB, WS_U = 80 * MiB, WS_V = 208 * MiB,
                 WS_H = 336 * MiB, WS_Z = 368 * MiB, WS_HLOC = 452 * MiB, WS_P = 476 * MiB, WS_YB = 500 * MiB, WS_YC = 524 * MiB,
                 WS_SUMA = 540 * MiB, WS_SUMB = 541 * MiB, WS_X1 = 544 * MiB, WS_X2 = 608 * MiB, WS_Q = 672 * MiB, WS_IDS = 704 * MiB,
                 WS_G = 708 * MiB, WS_WG_T = 77 * MiB, WS_PART = 712 * MiB, WS_LSE = 784 * MiB, WS_XR = 786 * MiB, WS_PDOT = 820 * MiB, WS_WEXP = 888 * MiB, WS_SCL = 892 * MiB  , WS_END = 893 * MiB;
constexpr int CW_BAR = 4096;

constexpr int LDS_BYTES = 147456;
constexpr int LDS_MISC = 143360;

__device__ const unsigned char T5B[3][132] = {
 {0,1,2,3,4,5,6,7,8,9,10,11,12,13,14,15,16,16,16,16,16,16,17,17,17,17,17,17,17,17,18,18,18,18,18,18,18,18,18,18,19,19,19,19,19,19,19,19,19,19,19,19,19,19,20,20,20,20,20,20,20,20,20,20,20,20,20,20,20,20,20,20,20,21,21,21,21,21,21,21,21,21,21,21,21,21,21,21,21,21,21,21,21,21,21,21,21,21,21,22,22,22,22,22,22,22,22,22,22,22,22,22,22,22,22,22,22,22,22,22,22,22,22,22,22,22,22,22,22,0,0,0},
 {0,4,8,12,16,16,17,17,18,18,19,19,19,19,20,20,20,20,20,21,21,21,21,21,21,22,22,22,22,22,22,22,22,22,23,23,23,23,23,23,23,23,23,23,23,23,24,24,24,24,24,24,24,24,24,24,24,24,24,24,24,24,25,25,25,25,25,25,25,25,25,25,25,25,25,25,25,25,25,25,25,25,25,26,26,26,26,26,26,26,26,26,26,26,26,26,26,26,26,26,26,26,26,26,26,26,26,26,26,26,26,26,26,27,27,27,27,27,27,27,27,27,27,27,27,27,27,27,27,0,0,0},
 {0,16,18,19,20,21,21,22,22,23,23,23,24,24,24,24,25,25,25,25,25,26,26,26,26,26,26,26,26,27,27,27,27,27,27,27,27,27,27,28,28,28,28,28,28,28,28,28,28,28,28,28,29,29,29,29,29,29,29,29,29,29,29,29,29,29,29,29,29,29,30,30,30,30,30,30,30,30,30,30,30,30,30,30,30,30,30,30,30,30,30,30,30,30,30,31,31,31,31,31,31,31,31,31,31,31,31,31,31,31,31,31,31,31,31,31,31,31,31,31,31,31,31,31,31,31,31,31,31,0,0,0}};

#define LDS_WAIT() asm volatile("s_waitcnt lgkmcnt(0)" ::: "memory")
DEV unsigned f2bf(float f) { unsigned u = __builtin_bit_cast(unsigned, f); return (u + 0x7fffu + ((u >> 16) & 1u)) >> 16; }
DEV unsigned pk2(float lo, float hi) { return f2bf(lo) | (f2bf(hi) << 16); }
DEV float bf_lo(unsigned w) { return __builtin_bit_cast(float, w << 16); }
DEV float bf_hi(unsigned w) { return __builtin_bit_cast(float, w & 0xffff0000u); }
DEV float bf1(bf16 h) { return __builtin_bit_cast(float, ((unsigned)h) << 16); }
template <int MSK> DEV float swz_xor(float v) { return __builtin_bit_cast(float, __builtin_amdgcn_ds_swizzle(__builtin_bit_cast(int, v), (MSK << 10) | 0x1F)); }
DEV float part32_(float v) { int ln = (int)__builtin_amdgcn_mbcnt_hi(~0u, __builtin_amdgcn_mbcnt_lo(~0u, 0u)); asm volatile("" : "+v"(ln)); return __builtin_bit_cast(float, __builtin_amdgcn_ds_bpermute((ln ^ 32) << 2, __builtin_bit_cast(int, v))); }
DEV float sum32(float v) { return v + part32_(v); }
DEV float max32(float v) { return fmaxf(v, part32_(v)); }
DEV float partner32(float v, int hh) { (void)hh; return part32_(v); }
DEV float wave_sum(float v) { v += swz_xor<1>(v); v += swz_xor<2>(v); v += swz_xor<4>(v); v += swz_xor<8>(v); v += swz_xor<16>(v); return sum32(v); }
DEV float wave_max(float v) { v = fmaxf(v, swz_xor<1>(v)); v = fmaxf(v, swz_xor<2>(v)); v = fmaxf(v, swz_xor<4>(v)); v = fmaxf(v, swz_xor<8>(v)); v = fmaxf(v, swz_xor<16>(v)); return max32(v); }
DEV float sigmoid_f(float x) { return 1.f / (1.f + __expf(-x)); }
DEV float softplus_f(float x) { return fmaxf(x, 0.f) + log1pf(__expf(-fabsf(x))); }
DEV float gelu_tanh(float x) { const float u = 0.7978845608028654f * (x + 0.044715f * x * x * x); const float t = 1.f - 2.f / (1.f + __expf(2.f * u)); return 0.5f * x * (1.f + t); }
DEV float dot8(const v4u a, const v4u b) {
    float s = bf_lo(a.x) * bf_lo(b.x); s += bf_hi(a.x) * bf_hi(b.x);
    s += bf_lo(a.y) * bf_lo(b.y); s += bf_hi(a.y) * bf_hi(b.y);
    s += bf_lo(a.z) * bf_lo(b.z); s += bf_hi(a.z) * bf_hi(b.z);
    s += bf_lo(a.w) * bf_lo(b.w); s += bf_hi(a.w) * bf_hi(b.w);
    return s;
}

#define XB_TMO      128
#define XB_XCNT(j)  (256  + 64 * (j))
#define XB_XSUB(j)  (1280 + 64 * (j))
#define XB_XGEN(j)  (2304 + 64 * (j))
#define XB_TOP      3328
#define XB_TOPGEN   3392
#define XCD_BAR_WORDS 3456
#define XB_SPIN_CAP (1u << 18)

__device__ __forceinline__ unsigned xb_ld(unsigned* p)              { return __hip_atomic_load(p, __ATOMIC_RELAXED, __HIP_MEMORY_SCOPE_AGENT); }
__device__ __forceinline__ unsigned xb_add(unsigned* p, unsigned v) { return __hip_atomic_fetch_add(p, v, __ATOMIC_RELAXED, __HIP_MEMORY_SCOPE_AGENT); }
__device__ __forceinline__ unsigned xb_xcc_id() { return (unsigned)__builtin_amdgcn_s_getreg((3 << 11) | 20) & 0xFu; }
#define XB_SPIN(cond, bar) do { unsigned _sp = 0; while (cond) { __builtin_amdgcn_s_sleep(1); \
    if ((++_sp & 255u) == 0u) { if (xb_ld(&(bar)[XB_TMO])) break; if (_sp > XB_SPIN_CAP) { atomicAdd(&(bar)[XB_TMO], 1u); break; } } } } while (0)

struct XcdBarrier {
    unsigned* bar; unsigned x;
    volatile LAS unsigned* st;
    int w0;
};
DEV bool xb_lead(int w0) { return w0 == 0 && __builtin_amdgcn_mbcnt_hi(~0u, __builtin_amdgcn_mbcnt_lo(~0u, 0u)) == 0u; }
__device__ __forceinline__ XcdBarrier xcd_barrier_post(unsigned* bar, volatile LAS unsigned* st, int w0) {
    XcdBarrier b; b.bar = bar; b.x = xb_xcc_id(); b.st = st; b.w0 = w0;
    if (xb_lead(w0)) (void)xb_add(&bar[XB_XCNT(b.x)], 1u);
    return b;
}
__device__ __forceinline__ void xcd_barrier_complete(unsigned* bar, unsigned x, unsigned& nloc, unsigned& nx) {
    const unsigned G = gridDim.x * gridDim.y * gridDim.z;
    unsigned sum, cnt, mine, sp = 0u;
    for (;;) {
        sum = 0u; cnt = 0u; mine = 0u;
#pragma unroll
        for (unsigned j = 0; j < 16; ++j) { const unsigned c = xb_ld(&bar[XB_XCNT(j)]); sum += c; cnt += (c > 0u) ? 1u : 0u; mine = (j == x) ? c : mine; }
        if (sum == G) break;
        __builtin_amdgcn_s_sleep(1);
        if ((++sp & 255u) == 0u) { if (xb_ld(&bar[XB_TMO])) break; if (sp > XB_SPIN_CAP) { atomicAdd(&bar[XB_TMO], 1u); break; } }
    }
    nloc = mine > 0u ? mine : 1u; nx = cnt > 0u ? cnt : 1u;
}
__device__ __forceinline__ void xcd_barrier(const XcdBarrier& b) {
    asm volatile("s_waitcnt vmcnt(0)" ::: "memory");
    __syncthreads();
    if (xb_lead(b.w0)) {
        unsigned* bar = b.bar;
        __builtin_amdgcn_s_waitcnt(0);
        unsigned nloc = b.st[0], nx = b.st[1];
        if (nloc == 0u) { xcd_barrier_complete(bar, b.x, nloc, nx); b.st[0] = nloc; b.st[1] = nx; }
        const unsigned old = xb_add(&bar[XB_XSUB(b.x)], 1u);
        const unsigned gen = old / nloc;
        if (old + 1u == (gen + 1u) * nloc) {
            __builtin_amdgcn_fence(__ATOMIC_RELEASE, "agent");
            asm volatile("s_waitcnt vmcnt(0)" ::: "memory");
            const unsigned og = xb_add(&bar[XB_TOP], 1u);
            const unsigned tg = og / nx;
            if (og + 1u == (tg + 1u) * nx) xb_add(&bar[XB_TOPGEN], 1u);
            else XB_SPIN(xb_ld(&bar[XB_TOPGEN]) == tg, bar);
            __builtin_amdgcn_fence(__ATOMIC_ACQUIRE, "agent");
            xb_add(&bar[XB_XGEN(b.x)], 1u);
            asm volatile("s_waitcnt vmcnt(0)" ::: "memory");
        } else {
            XB_SPIN(xb_ld(&bar[XB_XGEN(b.x)]) == gen, bar);
            __builtin_amdgcn_fence(__ATOMIC_ACQUIRE, "agent");
            asm volatile("s_waitcnt vmcnt(0)" ::: "memory");
        }
    }
    __syncthreads();
}

struct EpiResGate {
    static constexpr bool PERM = true, AFTER_DRAIN = false;
    const bf16* X; bf16* O; const float* gate; float gscale;
    __device__ __forceinline__ void operator()(const pg8::f32x4 (&acc)[2][2][4][2], const pg8::Unit& u, int wr, int wc, int fr, int fq) const {
        const int row0 = u.pm * 256 + wr * 64 + fr, col0 = u.pn * 256 + wc * 32 + 8 * fq;
        const float* gp = gate + (size_t)((u.pm * 256) >> 12) * MODW;
        pg8::f32x4 gv[2][2];
#pragma unroll
        for (int bj = 0; bj < 2; ++bj)
#pragma unroll
            for (int n = 0; n < 2; ++n) gv[bj][n] = *(const pg8::f32x4*)(gp + col0 + bj * 128 + 4 * n) * gscale;
#pragma unroll
        for (int ai = 0; ai < 2; ++ai)
#pragma unroll
            for (int m = 0; m < 4; ++m) {
                const size_t ro = (size_t)(row0 + ai * 128 + m * 16) * D + col0;
#pragma unroll
                for (int bj = 0; bj < 2; ++bj) {
                    const v4u xw = *(const v4u*)(X + ro + bj * 128);
                    const pg8::f32x4 x0 = {bf_lo(xw.x), bf_hi(xw.x), bf_lo(xw.y), bf_hi(xw.y)}, x1 = {bf_lo(xw.z), bf_hi(xw.z), bf_lo(xw.w), bf_hi(xw.w)};
                    const pg8::f32x4 o0 = x0 + gv[bj][0] * acc[ai][bj][m][0], o1 = x1 + gv[bj][1] * acc[ai][bj][m][1];
                    *(v4u*)(O + ro + bj * 128) = (v4u){pk2(o0.x, o0.y), pk2(o0.z, o0.w), pk2(o1.x, o1.y), pk2(o1.z, o1.w)};
                }
            }
    }
};

DEV void ph_mod(const float* __restrict__ c, const float* __restrict__ w_mod, const float* __restrict__ b_mod, float* __restrict__ mod, LAS float* lds_f, int vcu, int G, int tid) {
    const int lane = tid & 63, wave = tid >> 6;
    LAS float* cs = lds_f;
    LAS float* red = lds_f + 4096;
    for (int i = tid; i < 2 * D; i += 512) { const float v = c[i]; cs[i] = v * sigmoid_f(v); }
    __syncthreads();
    const int cg = lane & 15, rg = lane >> 4;
    for (int it = vcu; it < 2 * 192 * 2; it += G) {
        const int kh = it & 1, cb = (it >> 1) % 192, l = it / 384;
        const int k0 = kh * 1024 + wave * 128;
        const float* W = w_mod + ((size_t)l * D + k0 + rg) * MODW + cb * 64 + cg * 4;
        f32x4 a0 = {0.f, 0.f, 0.f, 0.f}, a1 = {0.f, 0.f, 0.f, 0.f};
#pragma unroll 16
        for (int i = 0; i < 32; ++i) {
            const f32x4 w = *(const f32x4*)(W + (size_t)(4 * i) * MODW);
            const float c0 = cs[k0 + 4 * i + rg], c1 = cs[D + k0 + 4 * i + rg];
            a0 += w * c0; a1 += w * c1;
        }
#pragma unroll
        for (int e = 0; e < 4; ++e) { a0[e] += swz_xor<16>(a0[e]); a0[e] = sum32(a0[e]); a1[e] += swz_xor<16>(a1[e]); a1[e] = sum32(a1[e]); }
        if (lane < 16) { *(LAS f32x4*)(red + (wave * 2 + 0) * 64 + cg * 4) = a0; *(LAS f32x4*)(red + (wave * 2 + 1) * 64 + cg * 4) = a1; }
        __syncthreads();
        if (tid < 128) {
            const int bq = tid >> 6, ln = tid & 63; float sacc = 0.f;
#pragma unroll
            for (int w = 0; w < 8; ++w) sacc += red[(w * 2 + bq) * 64 + ln];
            const int col = cb * 64 + ln;
            if (kh == 0) sacc += b_mod[l * MODW + col];
            atomicAdd(mod + (size_t)(l * 2 + bq) * MODW + col, sacc);
        }
        __syncthreads();
    }
}
DEV void transpose_item(const float* __restrict__ W, int K, int N, bf16* __restrict__ WT, LAS float* scr, int item, int lane) {
    const int nblk = N / 32, kb = item / nblk, nb = item % nblk, k0 = 64 * kb, n0 = 32 * nb;
#pragma unroll 8
    for (int i = 0; i < 32; ++i) { const int kk = 2 * i + (lane >> 5); scr[kk * 33 + (lane & 31)] = W[(size_t)(k0 + kk) * N + n0 + (lane & 31)]; }
    LDS_WAIT();
    const int c = lane & 7;
#pragma unroll
    for (int j = 0; j < 4; ++j) { const int n = (lane >> 3) + 8 * j; const LAS float* s = scr + (8 * c) * 33 + n;
        v4u o; o.x = pk2(s[0 * 33], s[1 * 33]); o.y = pk2(s[2 * 33], s[3 * 33]); o.z = pk2(s[4 * 33], s[5 * 33]); o.w = pk2(s[6 * 33], s[7 * 33]);
        *(v4u*)(WT + (size_t)(n0 + n) * K + k0 + 8 * c) = o; }
    LDS_WAIT();
}

DEV void transpose_item64(const float* __restrict__ W, int K, int N, bf16* __restrict__ WT, LAS float* scr, int item, int lane) {
    const int nblk = N / 64, kb = item / nblk, nb = item % nblk, k0 = 64 * kb, n0 = 64 * nb;
#pragma unroll 8
    for (int i = 0; i < 16; ++i) { const int kk = 4 * i + (lane >> 4), nn = 4 * (lane & 15);
        const f32x4 w = *(const f32x4*)(W + (size_t)(k0 + kk) * N + n0 + nn);
        LAS float* d = scr + kk * 65 + nn; d[0] = w.x; d[1] = w.y; d[2] = w.z; d[3] = w.w; }
    LDS_WAIT();
#pragma unroll
    for (int jj = 0; jj < 8; ++jj) { const int pz = lane + 64 * jj, n = pz >> 3, c = pz & 7; const LAS float* sp = scr + (8 * c) * 65 + n;
        v4u o; o.x = pk2(sp[0 * 65], sp[1 * 65]); o.y = pk2(sp[2 * 65], sp[3 * 65]); o.z = pk2(sp[4 * 65], sp[5 * 65]); o.w = pk2(sp[6 * 65], sp[7 * 65]);
        *(v4u*)(WT + (size_t)(n0 + n) * K + k0 + 8 * c) = o; }
    LDS_WAIT();
}
DEV void convert_copy(const float* __restrict__ src, bf16* __restrict__ dst, size_t ngroups8, size_t gtid, size_t gstride) {
    for (size_t g = gtid; g < ngroups8; g += gstride) {
        const f32x4 a = *(const f32x4*)(src + g * 8), b = *(const f32x4*)(src + g * 8 + 4);
        v4u o; o.x = pk2(a.x, a.y); o.y = pk2(a.z, a.w); o.z = pk2(b.x, b.y); o.w = pk2(b.z, b.w);
        *(v4u*)(dst + g * 8) = o;
    }
}

DEV void modnorm_rows(const float* __restrict__ X, const float* __restrict__ gain, const float* __restrict__ modl, int sh_off, int sc_off, bf16* __restrict__ H, int gw, int NGW, int lane, bf16* __restrict__ XC = nullptr) {
#pragma unroll 2
    for (int m = gw; m < M; m += NGW) {
        const int b = m >> 12;
        const f32x4* xr = (const f32x4*)(X + (size_t)m * D) + lane;
        f32x4 v[8]; float s = 0.f;
#pragma unroll
        for (int j = 0; j < 8; ++j) { v[j] = xr[64 * j]; s += (v[j].x * v[j].x + v[j].y * v[j].y) + (v[j].z * v[j].z + v[j].w * v[j].w); }
        const float r = rsqrtf(wave_sum(s) * (1.f / D) + EPS);
        const f32x4* g4 = (const f32x4*)gain + lane;
        const f32x4* sc4 = (const f32x4*)(modl + (size_t)b * MODW + sc_off) + lane;
        const f32x4* sh4 = (const f32x4*)(modl + (size_t)b * MODW + sh_off) + lane;
        unsigned long long* o8 = (unsigned long long*)(H + (size_t)m * D) + lane;
#pragma unroll
        for (int j = 0; j < 8; ++j) {
            const f32x4 g = g4[64 * j], sc = sc4[64 * j], sh = sh4[64 * j];
            const f32x4 y = (v[j] * r) * g * (sc + 1.f) + sh;
            o8[64 * j] = (unsigned long long)pk2(y.x, y.y) | ((unsigned long long)pk2(y.z, y.w) << 32);
            if (XC) ((unsigned long long*)(XC + (size_t)m * D) + lane)[64 * j] = (unsigned long long)pk2(v[j].x, v[j].y) | ((unsigned long long)pk2(v[j].z, v[j].w) << 32);
        }
    }
}
DEV void modnorm_rows_h(const bf16* __restrict__ X, const float* __restrict__ gain, const float* __restrict__ modl, int sh_off, int sc_off, bf16* __restrict__ H, int gw, int NGW, int lane) {
#pragma unroll 2
    for (int m = gw; m < M; m += NGW) {
        const int b = m >> 12;
        const v4u* xr = (const v4u*)(X + (size_t)m * D) + lane;
        float v[32]; float s = 0.f;
#pragma unroll
        for (int j = 0; j < 4; ++j) { const v4u w = xr[64 * j];
            v[8 * j + 0] = bf_lo(w.x); v[8 * j + 1] = bf_hi(w.x); v[8 * j + 2] = bf_lo(w.y); v[8 * j + 3] = bf_hi(w.y); v[8 * j + 4] = bf_lo(w.z); v[8 * j + 5] = bf_hi(w.z); v[8 * j + 6] = bf_lo(w.w); v[8 * j + 7] = bf_hi(w.w);
#pragma unroll
            for (int e = 0; e < 8; ++e) s += v[8 * j + e] * v[8 * j + e]; }
        const float r = rsqrtf(wave_sum(s) * (1.f / D) + EPS);
        const float* scp = modl + (size_t)b * MODW + sc_off; const float* shp = modl + (size_t)b * MODW + sh_off;
        v4u* o16 = (v4u*)(H + (size_t)m * D) + lane;
#pragma unroll
        for (int j = 0; j < 4; ++j) { const int col = 8 * (lane + 64 * j);
            const f32x4 g0 = *(const f32x4*)(gain + col), g1 = *(const f32x4*)(gain + col + 4), c0 = *(const f32x4*)(scp + col), c1 = *(const f32x4*)(scp + col + 4), h0 = *(const f32x4*)(shp + col), h1 = *(const f32x4*)(shp + col + 4);
            v4u o;
            o.x = pk2(v[8 * j + 0] * r * g0.x * (c0.x + 1.f) + h0.x, v[8 * j + 1] * r * g0.y * (c0.y + 1.f) + h0.y); o.y = pk2(v[8 * j + 2] * r * g0.z * (c0.z + 1.f) + h0.z, v[8 * j + 3] * r * g0.w * (c0.w + 1.f) + h0.w);
            o.z = pk2(v[8 * j + 4] * r * g1.x * (c1.x + 1.f) + h1.x, v[8 * j + 5] * r * g1.y * (c1.y + 1.f) + h1.y); o.w = pk2(v[8 * j + 6] * r * g1.z * (c1.z + 1.f) + h1.z, v[8 * j + 7] * r * g1.w * (c1.w + 1.f) + h1.w);
            o16[64 * j] = o; }
    }
}


DEV unsigned cvtpk_bf16(float lo, float hi) { f32x2 v = {lo, hi}; bf16x2_t b = __builtin_convertvector(v, bf16x2_t); return __builtin_bit_cast(unsigned, b); }
constexpr int DIL_VSTR = 256;
constexpr int ATT_KOFF = 32 * DIL_VSTR;
constexpr int ATT_BOFF = ATT_KOFF + 8192;
constexpr int DIL_QOFF = ATT_BOFF + 192 * 4;
constexpr int ATT_WLDS = 17920;
static_assert(DIL_QOFF <= ATT_WLDS && 8 * ATT_WLDS <= LDS_MISC, "attention LDS");

DEV unsigned vimg_off(unsigned row, unsigned ch) { return 256u * row + 16u * (ch ^ (((row & 3u) << 2) | ((row >> 2) & 3u))); }
typedef short s16x4 __attribute__((ext_vector_type(4)));
DEV bf16x8 vfrag_tr(LAS unsigned char* img, int lane, int c, int ks) {
    const unsigned h = lane >> 5, blk = (lane >> 4) & 1, qq = (lane & 15) >> 2, pp = lane & 3;
    const s16x4 a = __builtin_amdgcn_ds_read_tr16_b64_v4i16((LAS s16x4*)(img + vimg_off(16 * ks + 8 * h + 0 + qq, 4 * c + 2 * blk + (pp >> 1)) + 8 * (pp & 1)));
    const s16x4 b = __builtin_amdgcn_ds_read_tr16_b64_v4i16((LAS s16x4*)(img + vimg_off(16 * ks + 8 * h + 4 + qq, 4 * c + 2 * blk + (pp >> 1)) + 8 * (pp & 1)));
    return __builtin_shufflevector(a, b, 0, 1, 2, 3, 4, 5, 6, 7);
}
DEV void att_store_rows(LAS unsigned char* img, const f32x16 (&o)[4], float scale, bf16* __restrict__ row0p, size_t rowstride, int lane) {
    const int r = lane & 31, hh = lane >> 5;
#pragma unroll
    for (int dt = 0; dt < 4; ++dt)
#pragma unroll
        for (int g = 0; g < 4; ++g)
            *(LAS unsigned long long*)(img + 256 * r + 16 * ((4 * dt + g) ^ (r & 15)) + 8 * hh) =
                (unsigned long long)pk2(o[dt][4 * g + 0] * scale, o[dt][4 * g + 1] * scale) | ((unsigned long long)pk2(o[dt][4 * g + 2] * scale, o[dt][4 * g + 3] * scale) << 32);
    LDS_WAIT();
#pragma unroll
    for (int q = 0; q < 8; ++q) { const int row = 4 * q + (lane >> 4), ch = (lane & 15) ^ (row & 15);
        const v4u w = *(const LAS v4u*)(img + 1024 * q + 16 * lane);
        *(v4u*)(row0p + (size_t)row * rowstride + 8 * ch) = w; }
}
DEV void dil_mfma_item(int b, int h, int p, int rr, int i0, const bf16* __restrict__ Z, const float* __restrict__ rel_bias, bf16* __restrict__ PART, float* __restrict__ LSE, LAS unsigned char* wl, int lane) {
    asm volatile("" : "+v"(lane));
    const int r = lane & 31, hh = lane >> 5;
    const int d = 1 << (2 * p);
    LAS float* biasL = (LAS float*)(wl + ATT_BOFF);
    for (int dd = lane; dd < 192; dd += 64) { const int k = dd - 32; const int kc = k < 0 ? 0 : (k > 128 ? 128 : k); const float bvv = rel_bias[(int)T5B[p][kc] * 6 + h]; biasL[dd] = (k >= 0 && k <= 128) ? bvv : NEGBIG; }
    const size_t rowq = (size_t)b * SEQ + rr + d * (i0 + r);
    bf16x8 qf[8];
    { const bf16* qrow = Z + rowq * IN_W + ZO_QB + h * 128 + 8 * hh;
#pragma unroll
      for (int ks = 0; ks < 8; ++ks) qf[ks] = *(const bf16x8*)(qrow + 16 * ks); }
    float m_run = NEGBIG, l_run = 0.f;
    f32x16 o[4];
#pragma unroll
    for (int dt = 0; dt < 4; ++dt)
#pragma unroll
        for (int e = 0; e < 16; ++e) o[dt][e] = 0.f;
    const int kap = (r & 0x13) | ((r & 4) << 1) | ((r & 8) >> 1);
    const int kc0 = (lane & 15) ^ (lane >> 4);
    const unsigned kfa = (unsigned)(size_t)(wl + ATT_KOFF) + 256u * (unsigned)kap + 16u * (unsigned)((kap & 15) ^ hh);
    int jt = 4 - (i0 >> 5); jt = jt < 0 ? 0 : jt;
#define DIL_DMA_K(JT) do { const bf16* kb0_ = Z + ((size_t)b * SEQ + rr + d * (i0 - 128 + 32 * (JT) + (lane >> 4))) * IN_W + ZO_KB + h * 128;     \
        _Pragma("unroll") for (int q = 0; q < 8; ++q) __builtin_amdgcn_global_load_lds((const unsigned*)(kb0_ + (size_t)q * 4 * d * IN_W + 8 * (kc0 ^ (4 * (q & 3)))), (LAS unsigned*)(wl + ATT_KOFF + 1024 * q), 16, 0, 0); } while (0)
#define DIL_DMA_V(JT) do { const int j0_ = i0 - 128 + 32 * (JT); _Pragma("unroll") for (int q = 0; q < 8; ++q) { const int pi = lane + 64 * q, kl = pi >> 4, c = (pi & 15) ^ (((kl & 3) << 2) | ((kl >> 2) & 3)); int j = j0_ + kl; j = j < 0 ? 0 : j; \
        __builtin_amdgcn_global_load_lds((const unsigned*)(Z + ((size_t)b * SEQ + rr + d * j) * IN_W + ZO_VB + h * 128 + 8 * c), (LAS unsigned*)(wl + 1024 * q), 16, 0, 0); } } while (0)
    LDS_WAIT();
    DIL_DMA_K(jt); DIL_DMA_V(jt);
    for (; jt < 5; ++jt) {
        const int j0 = i0 - 128 + 32 * jt;
        const int jn = jt < 4 ? jt + 1 : 4;
        asm volatile("s_waitcnt vmcnt(8)" ::: "memory");
        f32x16 sacc, sac2;
#pragma unroll
        for (int e = 0; e < 16; ++e) { sacc[e] = 0.f; sac2[e] = 0.f; }
        {
            bf16x8 kf[8]; unsigned kfo = kfa; asm volatile("" : "+v"(kfo));
#pragma unroll
            for (int ks = 0; ks < 8; ++ks) kf[ks] = *(const LAS bf16x8*)(size_t)(kfo ^ (32u * ks));
#pragma unroll
            for (int ks = 0; ks < 8; ks += 2) { sacc = __builtin_amdgcn_mfma_f32_32x32x16_bf16(kf[ks], qf[ks], sacc, 0, 0, 0); sac2 = __builtin_amdgcn_mfma_f32_32x32x16_bf16(kf[ks + 1], qf[ks + 1], sac2, 0, 0, 0); }
#pragma unroll
            for (int e = 0; e < 16; ++e) sacc[e] += sac2[e];
        }
        LDS_WAIT();
        DIL_DMA_K(jn);
        float tm = NEGBIG;
        {
            const LAS float* bp = biasL + (9 + 128 - 32 * jt + r - 8 * hh);
#pragma unroll
            for (int e = 0; e < 16; ++e) { const float lg = __builtin_fmaf(sacc[e], QSCALE, bp[23 - 16 * (e >> 3) - (e & 7)]); sacc[e] = lg; tm = fmaxf(tm, lg); }
        }
        tm = max32(tm);
        const float m_new = fmaxf(m_run, tm);
        const float alpha = __expf(m_run - m_new);
        float ps = 0.f;
#pragma unroll
        for (int e = 0; e < 16; ++e) { const float pv = (sacc[e] > -1.0e37f) ? __expf(sacc[e] - m_new) : 0.f; sacc[e] = pv; ps += pv; }
        ps = sum32(ps);
        l_run = l_run * alpha + ps; m_run = m_new;
#pragma unroll
        for (int dt = 0; dt < 4; ++dt)
#pragma unroll
            for (int e = 0; e < 16; ++e) o[dt][e] *= alpha;
        bf16x8 pf[2];
#pragma unroll
        for (int s2 = 0; s2 < 2; ++s2) { v4u w; w.x = cvtpk_bf16(sacc[8 * s2 + 0], sacc[8 * s2 + 1]); w.y = cvtpk_bf16(sacc[8 * s2 + 2], sacc[8 * s2 + 3]);
            w.z = cvtpk_bf16(sacc[8 * s2 + 4], sacc[8 * s2 + 5]); w.w = cvtpk_bf16(sacc[8 * s2 + 6], sacc[8 * s2 + 7]); pf[s2] = __builtin_bit_cast(bf16x8, w); }
        asm volatile("s_waitcnt vmcnt(8)" ::: "memory");
#pragma unroll
        for (int dt = 0; dt < 4; ++dt)
#pragma unroll
            for (int s2 = 0; s2 < 2; ++s2) o[dt] = __builtin_amdgcn_mfma_f32_32x32x16_bf16(vfrag_tr(wl, lane, dt, s2), pf[s2], o[dt], 0, 0, 0);
        LDS_WAIT();
        DIL_DMA_V(jn);
    }
    asm volatile("s_waitcnt vmcnt(0)" ::: "memory");
#undef DIL_DMA_V
#undef DIL_DMA_K
    const float inv = 1.f / l_run;
    att_store_rows(wl, o, inv, PART + ((size_t)p * M + (size_t)b * SEQ + rr + d * i0) * SWA_W + h * 128, (size_t)d * SWA_W, lane);
    if (hh == 0) LSE[((size_t)p * M + rowq) * 6 + h] = m_run + __logf(l_run);
}


DEV void lru_item2(int l, int b, int j, int n, const bf16* __restrict__ Z, const float* __restrict__ conv_w, const float* __restrict__ conv_b, const bf16* __restrict__ WGT,
                   const float* __restrict__ b_rec, const float* __restrict__ b_gi, const float* __restrict__ lam,
                   bf16* __restrict__ HLOC, bf16* __restrict__ PP, float* __restrict__ SUMA, float* __restrict__ SUMB, LAS float* xc, LAS float* g0L, LAS float* g1L, int tid) {
    const int ch = tid & 127, tq = tid >> 7, c = n * 128 + ch;
    const float cw0 = conv_w[(l * 4 + 0) * LRU_W + c], cw1 = conv_w[(l * 4 + 1) * LRU_W + c], cw2 = conv_w[(l * 4 + 2) * LRU_W + c], cw3 = conv_w[(l * 4 + 3) * LRU_W + c];
    const float cb = conv_b[l * LRU_W + c];
    const float br = b_rec[l * LRU_W + c], bi = b_gi[l * LRU_W + c], lamv = lam[l * LRU_W + c];
    bf16x8 bfr[8];
    {   const int lane = tid & 63, wave = tid >> 6, r = lane & 31, hh = lane >> 5, g = wave >> 2, ct = wave & 3;
        const bf16* wp = WGT + (((size_t)(l * 6 + n) * 2 + g) * 128 + ct * 32 + r) * 128 + 8 * hh;
#pragma unroll
        for (int ks = 0; ks < 8; ++ks) bfr[ks] = *(const bf16x8*)(wp + 16 * ks); }
    {
        LAS unsigned char* xaL = (LAS unsigned char*)(g1L + 64 * 132);
        const int t0 = j * 64;
#pragma unroll
        for (int i = 0; i < 3; ++i) { const int pz = tid + 512 * i; if (pz < 67 * 16) { const int row = pz >> 4, cc = pz & 15; const int t = t0 - 3 + row;
            v4u w = {0u, 0u, 0u, 0u}; if (t >= 0) w = *(const v4u*)(Z + ((size_t)b * SEQ + t) * IN_W + ZO_XA + n * 128 + 8 * cc);
            *(LAS v4u*)(xaL + row * 256 + cc * 16) = w; } }
        __syncthreads();
        const LAS bf16* xp = (const LAS bf16*)xaL + ch;
#pragma unroll 4
        for (int i = 0; i < 16; ++i) {
            const int tok = tq + 4 * i;
            xc[tok * 132 + ch] = cb + cw0 * bf1(xp[(tok + 0) * 128]) + cw1 * bf1(xp[(tok + 1) * 128]) + cw2 * bf1(xp[(tok + 2) * 128]) + cw3 * bf1(xp[(tok + 3) * 128]);
        }
    }
    __syncthreads();
    {
        const int lane = tid & 63, wave = tid >> 6, r = lane & 31, hh = lane >> 5, g = wave >> 2, ct = wave & 3;
        LAS float* gL = g ? g1L : g0L;
#pragma unroll
        for (int rt = 0; rt < 2; ++rt) {
            f32x16 acc;
#pragma unroll
            for (int e = 0; e < 16; ++e) acc[e] = 0.f;
#pragma unroll
            for (int ks = 0; ks < 8; ++ks) {
                const LAS float* xp = xc + (32 * rt + r) * 132 + 16 * ks + 8 * hh;
                const f32x4 x0 = *(const LAS f32x4*)xp, x1 = *(const LAS f32x4*)(xp + 4);
                v4u w; w.x = cvtpk_bf16(x0.x, x0.y); w.y = cvtpk_bf16(x0.z, x0.w); w.z = cvtpk_bf16(x1.x, x1.y); w.w = cvtpk_bf16(x1.z, x1.w);
                acc = __builtin_amdgcn_mfma_f32_32x32x16_bf16(__builtin_bit_cast(bf16x8, w), bfr[ks], acc, 0, 0, 0);
            }
#pragma unroll
            for (int e = 0; e < 16; ++e) { const int tok = 32 * rt + (e & 3) + 8 * (e >> 2) + 4 * hh; gL[tok * 132 + ct * 32 + r] = acc[e]; }
        }
    }
    __syncthreads();
    {
        const float sp = softplus_f(-lamv);
#pragma unroll 4
        for (int i = 0; i < 16; ++i) {
            const int tok = tq + 4 * i;
            const float rg = __builtin_amdgcn_rcpf(1.f + __expf(-(g0L[tok * 132 + ch] + br))), ig = __builtin_amdgcn_rcpf(1.f + __expf(-(g1L[tok * 132 + ch] + bi)));
            const float log_a = -8.0f * rg * sp;
            const float av = __expf(log_a);
            const float x = xc[tok * 132 + ch];
            const float y = 2.f * log_a;
            const float small = -y * (1.f + y * (0.5f + y * (0.16666667f + y * (0.041666668f + y * 0.0083333338f))));
            const float om = (y > -0.25f) ? small : (1.f - av * av);
            const float uv = __builtin_amdgcn_sqrtf(fmaxf(om, 0.f)) * (ig * x);
            g0L[tok * 132 + ch] = av; g1L[tok * 132 + ch] = uv;
        }
    }
    __syncthreads();
    {
        LAS float* segL = g1L + 64 * 132 + 67 * 64;
        float hl[16], pl[16]; float h = 0.f, P = 1.f;
#pragma unroll
        for (int t = 0; t < 16; ++t) { const int tok = 16 * tq + t; const float av = g0L[tok * 132 + ch]; h = av * h + g1L[tok * 132 + ch]; P *= av; hl[t] = h; pl[t] = P; }
        segL[(tq * 128 + ch) * 2] = P; segL[(tq * 128 + ch) * 2 + 1] = h;
        __syncthreads();
        float Hin = 0.f, Pin = 1.f;
#pragma unroll
        for (int sg = 0; sg < 3; ++sg) if (sg < tq) { const float pa = segL[(sg * 128 + ch) * 2], hb = segL[(sg * 128 + ch) * 2 + 1]; Hin = pa * Hin + hb; Pin *= pa; }
        const size_t rb = ((size_t)b * SEQ + j * 64 + 16 * tq) * LRU_W + n * 128 + ch;
#pragma unroll
        for (int t = 0; t < 16; ++t) { HLOC[rb + (size_t)t * LRU_W] = (bf16)f2bf(hl[t] + pl[t] * Hin); PP[rb + (size_t)t * LRU_W] = (bf16)f2bf(pl[t] * Pin); }
        if (tq == 3) { SUMA[(size_t)(b * 64 + j) * LRU_W + n * 128 + ch] = pl[15] * Pin; SUMB[(size_t)(b * 64 + j) * LRU_W + n * 128 + ch] = hl[15] + pl[15] * Hin; }
    }
    __syncthreads();
}

DEV void sb_mfma_item(int b, int h, int t0, const bf16* __restrict__ Z, bf16* __restrict__ YC, LAS unsigned char* wl, int lane) {
    asm volatile("" : "+v"(lane));
    const int r = lane & 31, hh = lane >> 5;
    const size_t rowq = (size_t)b * SEQ + t0 + r;
    bf16x8 qf[8];
    { const bf16* qrow = Z + rowq * IN_W + ZO_QC + h * 128 + 8 * hh;
#pragma unroll
      for (int ks = 0; ks < 8; ++ks) qf[ks] = *(const bf16x8*)(qrow + 16 * ks); }
    f32x16 o[4];
#pragma unroll
    for (int dt = 0; dt < 4; ++dt)
#pragma unroll
        for (int e = 0; e < 16; ++e) o[dt][e] = 0.f;
    const int kap = (r & 0x13) | ((r & 4) << 1) | ((r & 8) >> 1);
    const int kc0 = (lane & 15) ^ (lane >> 4);
    const unsigned kfa = (unsigned)(size_t)(wl + ATT_KOFF) + 256u * (unsigned)kap + 16u * (unsigned)((kap & 15) ^ hh);
    float carry = 0.f;
#define SB_DMA_K(K0) do { const bf16* kb0_ = Z + ((size_t)b * SEQ + (K0) + (lane >> 4)) * IN_W + ZO_KC + h * 128; \
        _Pragma("unroll") for (int q = 0; q < 8; ++q) __builtin_amdgcn_global_load_lds((const unsigned*)(kb0_ + (size_t)q * 4 * IN_W + 8 * (kc0 ^ (4 * (q & 3)))), (LAS unsigned*)(wl + ATT_KOFF + 1024 * q), 16, 0, 0); } while (0)
#define SB_DMA_V(K0) do { _Pragma("unroll") for (int q = 0; q < 8; ++q) { const int pi = lane + 64 * q, kl = pi >> 4, c = (pi & 15) ^ (((kl & 3) << 2) | ((kl >> 2) & 3)); \
        __builtin_amdgcn_global_load_lds((const unsigned*)(Z + ((size_t)b * SEQ + (K0) + kl) * IN_W + ZO_VC + h * 128 + 8 * c), (LAS unsigned*)(wl + 1024 * q), 16, 0, 0); } } while (0)
    LDS_WAIT();
    SB_DMA_K(t0); SB_DMA_V(t0);
    for (int k0 = t0; k0 >= 0; k0 -= 32) {
        const int kn = k0 >= 32 ? k0 - 32 : 0;
        asm volatile("s_waitcnt vmcnt(8)" ::: "memory");
        f32x16 sacc, sac2;
#pragma unroll
        for (int e = 0; e < 16; ++e) { sacc[e] = 0.f; sac2[e] = 0.f; }
        {
            bf16x8 kf[8]; unsigned kfo = kfa; asm volatile("" : "+v"(kfo));
#pragma unroll
            for (int ks = 0; ks < 8; ++ks) kf[ks] = *(const LAS bf16x8*)(size_t)(kfo ^ (32u * ks));
#pragma unroll
            for (int ks = 0; ks < 8; ks += 2) { sacc = __builtin_amdgcn_mfma_f32_32x32x16_bf16(kf[ks], qf[ks], sacc, 0, 0, 0); sac2 = __builtin_amdgcn_mfma_f32_32x32x16_bf16(kf[ks + 1], qf[ks + 1], sac2, 0, 0, 0); }
#pragma unroll
            for (int e = 0; e < 16; ++e) sacc[e] += sac2[e];
        }
        LDS_WAIT();
        SB_DMA_K(kn);
        float l1[16]; float T0 = 0.f, T1 = 0.f;
#pragma unroll
        for (int e = 0; e < 16; ++e) {
            const int key = k0 + 16 * (e >> 3) + 8 * hh + (e & 7);
            const bool valid = key < t0 + r;
            const float z = sacc[e] * QSCALE;
            sacc[e] = z;
            l1[e] = valid ? -(fmaxf(z, 0.f) + __logf(1.f + __expf(-fabsf(z)))) : 0.f;
        }
#pragma unroll
        for (int e = 0; e < 8; ++e) { T0 += l1[e]; T1 += l1[8 + e]; }
        const float PT0 = partner32(T0, hh), PT1 = partner32(T1, hh);
        const float base1 = carry + (hh ? 0.f : PT1);
        const float base0 = carry + (hh ? (T1 + PT1) : (PT1 + T1 + PT0));
        float run1 = base1, run0 = base0;
#pragma unroll
        for (int e = 7; e >= 0; --e) {
            { const int key = k0 + 16 + 8 * hh + e; const bool valid = key < t0 + r; const float a = valid ? __expf(sacc[8 + e] + l1[8 + e] + run1) : 0.f; run1 += l1[8 + e]; sacc[8 + e] = a; }
            { const int key = k0 + 8 * hh + e; const bool valid = key < t0 + r; const float a = valid ? __expf(sacc[e] + l1[e] + run0) : 0.f; run0 += l1[e]; sacc[e] = a; }
        }
        carry += (T0 + T1) + (PT0 + PT1);
        bf16x8 pf[2];
#pragma unroll
        for (int s2 = 0; s2 < 2; ++s2) { v4u w; w.x = cvtpk_bf16(sacc[8 * s2 + 0], sacc[8 * s2 + 1]); w.y = cvtpk_bf16(sacc[8 * s2 + 2], sacc[8 * s2 + 3]);
            w.z = cvtpk_bf16(sacc[8 * s2 + 4], sacc[8 * s2 + 5]); w.w = cvtpk_bf16(sacc[8 * s2 + 6], sacc[8 * s2 + 7]); pf[s2] = __builtin_bit_cast(bf16x8, w); }
        asm volatile("s_waitcnt vmcnt(8)" ::: "memory");
#pragma unroll
        for (int dt = 0; dt < 4; ++dt)
#pragma unroll
            for (int s2 = 0; s2 < 2; ++s2) o[dt] = __builtin_amdgcn_mfma_f32_32x32x16_bf16(vfrag_tr(wl, lane, dt, s2), pf[s2], o[dt], 0, 0, 0);
        LDS_WAIT();
        SB_DMA_V(kn);
        if (__all(carry < -105.0f)) break;
    }
    asm volatile("s_waitcnt vmcnt(0)" ::: "memory");
#undef SB_DMA_V
#undef SB_DMA_K
    att_store_rows(wl, o, 1.f, YC + ((size_t)b * SEQ + t0) * SB_W + h * 128, (size_t)SB_W, lane);
}

DEV void combine_item(int l, int b, int j, int half, const bf16* __restrict__ Z, const bf16* __restrict__ HLOC, const bf16* __restrict__ PP, const float* __restrict__ SUMA, const float* __restrict__ SUMB,
                      const bf16* __restrict__ PART, const float* __restrict__ LSE, const bf16* __restrict__ YC, const float* __restrict__ g_lru, const float* __restrict__ g_swa, const float* __restrict__ g_sb,
                      bf16* __restrict__ Y, LAS float* carryL, int tid) {
    const int lane = tid & 63, wave = tid >> 6;
    for (int c = tid; c < LRU_W; c += 512) {
        float cr = 0.f;
        for (int i = 0; i < j; i += 16) {
            float av[16], bv[16];
#pragma unroll
            for (int u = 0; u < 16; ++u) { const int q = i + u < j ? i + u : j - 1; av[u] = SUMA[(size_t)(b * 64 + q) * LRU_W + c]; bv[u] = SUMB[(size_t)(b * 64 + q) * LRU_W + c]; }
#pragma unroll
            for (int u = 0; u < 16; ++u) { const bool in = i + u < j; cr = in ? av[u] * cr + bv[u] : cr; }
        }
        carryL[c] = cr;
    }
    __syncthreads();
#pragma unroll 2
    for (int i = 0; i < 4; ++i) {
        const int tok = half * 32 + wave * 4 + i;
        const size_t row = (size_t)b * SEQ + j * 64 + tok;
        bf16* yo = Y + row * D;
        {
            float ya[12]; float ssq = 0.f;
#pragma unroll
            for (int e = 0; e < 6; ++e) { const int c = 2 * lane + 128 * e;
                const unsigned hw = *(const unsigned*)(HLOC + row * LRU_W + c), pw = *(const unsigned*)(PP + row * LRU_W + c), gw2 = *(const unsigned*)(Z + row * IN_W + ZO_GA + c);
                const f32x2 cr = *(const LAS f32x2*)(carryL + c);
                ya[2 * e] = (bf_lo(hw) + bf_lo(pw) * cr.x) * gelu_tanh(bf_lo(gw2)); ya[2 * e + 1] = (bf_hi(hw) + bf_hi(pw) * cr.y) * gelu_tanh(bf_hi(gw2));
                ssq += ya[2 * e] * ya[2 * e] + ya[2 * e + 1] * ya[2 * e + 1]; }
            const float r = rsqrtf(wave_sum(ssq) * (1.f / LRU_W) + EPS);
#pragma unroll
            for (int e = 0; e < 6; ++e) { const int c = 2 * lane + 128 * e; const f32x2 g = *(const f32x2*)(g_lru + l * LRU_W + c);
                *(unsigned*)(yo + c) = pk2(ya[2 * e] * r * g.x, ya[2 * e + 1] * r * g.y); }
        }
        {
            float yb[12]; float ssq = 0.f;
#pragma unroll
            for (int e = 0; e < 6; ++e) { const int c = 2 * lane + 128 * e;
                const float l0 = LSE[((size_t)0 * M + row) * 6 + e], l1 = LSE[((size_t)1 * M + row) * 6 + e], l2 = LSE[((size_t)2 * M + row) * 6 + e];
                const float mx = fmaxf(l0, fmaxf(l1, l2)); const float e0 = __expf(l0 - mx), e1 = __expf(l1 - mx), e2 = __expf(l2 - mx); const float iz = 1.f / (e0 + e1 + e2);
                const unsigned p0 = *(const unsigned*)(PART + ((size_t)0 * M + row) * SWA_W + c), p1 = *(const unsigned*)(PART + ((size_t)1 * M + row) * SWA_W + c), p2 = *(const unsigned*)(PART + ((size_t)2 * M + row) * SWA_W + c);
                yb[2 * e] = (e0 * bf_lo(p0) + e1 * bf_lo(p1) + e2 * bf_lo(p2)) * iz; yb[2 * e + 1] = (e0 * bf_hi(p0) + e1 * bf_hi(p1) + e2 * bf_hi(p2)) * iz;
                ssq += yb[2 * e] * yb[2 * e] + yb[2 * e + 1] * yb[2 * e + 1]; }
            const float r = rsqrtf(wave_sum(ssq) * (1.f / SWA_W) + EPS);
#pragma unroll
            for (int e = 0; e < 6; ++e) { const int c = 2 * lane + 128 * e; const f32x2 g = *(const f32x2*)(g_swa + l * SWA_W + c);
                *(unsigned*)(yo + LRU_W + c) = pk2(yb[2 * e] * r * g.x, yb[2 * e + 1] * r * g.y); }
        }
        {
            float yc[8]; float ssq = 0.f;
#pragma unroll
            for (int e = 0; e < 4; ++e) { const int c = 2 * lane + 128 * e; const unsigned w = *(const unsigned*)(YC + row * SB_W + c); yc[2 * e] = bf_lo(w); yc[2 * e + 1] = bf_hi(w); ssq += yc[2 * e] * yc[2 * e] + yc[2 * e + 1] * yc[2 * e + 1]; }
            const float r = rsqrtf(wave_sum(ssq) * (1.f / SB_W) + EPS);
#pragma unroll
            for (int e = 0; e < 4; ++e) { const int c = 2 * lane + 128 * e; const f32x2 g = *(const f32x2*)(g_sb + l * SB_W + c);
                *(unsigned*)(yo + LRU_W + SWA_W + c) = pk2(yc[2 * e] * r * g.x, yc[2 * e + 1] * r * g.y); }
        }
    }
    __syncthreads();
}


constexpr float U8_SCALE = 64.f;
DEV void convert_fp8(const float* __restrict__ src, unsigned char* __restrict__ dst, size_t ngroups16, size_t gtid, size_t gstride, float scale) {
    for (size_t g = gtid; g < ngroups16; g += gstride) {
        const f32x4 a = *(const f32x4*)(src + g * 16) * scale, b = *(const f32x4*)(src + g * 16 + 4) * scale, c = *(const f32x4*)(src + g * 16 + 8) * scale, d = *(const f32x4*)(src + g * 16 + 12) * scale;
        int w0 = 0, w1 = 0, w2 = 0, w3 = 0;
        w0 = __builtin_amdgcn_cvt_pk_fp8_f32(a.x, a.y, w0, false); w0 = __builtin_amdgcn_cvt_pk_fp8_f32(a.z, a.w, w0, true);
        w1 = __builtin_amdgcn_cvt_pk_fp8_f32(b.x, b.y, w1, false); w1 = __builtin_amdgcn_cvt_pk_fp8_f32(b.z, b.w, w1, true);
        w2 = __builtin_amdgcn_cvt_pk_fp8_f32(c.x, c.y, w2, false); w2 = __builtin_amdgcn_cvt_pk_fp8_f32(c.z, c.w, w2, true);
        w3 = __builtin_amdgcn_cvt_pk_fp8_f32(d.x, d.y, w3, false); w3 = __builtin_amdgcn_cvt_pk_fp8_f32(d.z, d.w, w3, true);
        *(v4u*)(dst + g * 16) = (v4u){(unsigned)w0, (unsigned)w1, (unsigned)w2, (unsigned)w3};
    }
}

constexpr int R2_SC = 0, R2_TV = 128 * 129 * 4, R2_TI = R2_TV + 128 * 16 * 4, R2_END = R2_TI + 128 * 16 * 4, R2_MK = 4 * 16 * 128 * 4  ;
static_assert(R2_END + R2_MK <= LDS_MISC, "routing v2 LDS");
DEV unsigned ord_key(float s) { const unsigned u = __builtin_bit_cast(unsigned, s); return (u & 0x80000000u) ? ~u : (u | 0x80000000u); }

#define KEY_CE(A, B) do { const unsigned hi_ = (A) > (B) ? (A) : (B); const unsigned lo_ = (A) > (B) ? (B) : (A); (A) = hi_; (B) = lo_; } while (0)
DEV void bitonic_sort16_desc(unsigned (&a)[16]) {
#pragma unroll
    for (int k = 2; k <= 16; k <<= 1)
#pragma unroll
        for (int j = k >> 1; j > 0; j >>= 1)
#pragma unroll
            for (int i = 0; i < 16; ++i) { const int m = i ^ j; if (m > i) { if ((i & k) == 0) KEY_CE(a[i], a[m]); else KEY_CE(a[m], a[i]); } }
}
DEV void bitonic_merge16_desc(unsigned (&a)[16]) {
#pragma unroll
    for (int j = 8; j > 0; j >>= 1)
#pragma unroll
        for (int i = 0; i < 16; ++i) { const int m = i ^ j; if (m > i) KEY_CE(a[i], a[m]); }
}
DEV void convert_rows3(int R0, int RS, int RLIM, const float* __restrict__ cv_u, const float* __restrict__ cv_v, unsigned char* __restrict__ cv_u8, unsigned char* __restrict__ cv_v8,
                       float* __restrict__ cv_su, float* __restrict__ cv_sv, int lane) {
    f32x4 v[3][8];
#pragma unroll
    for (int bb = 0; bb < 3; ++bb) { const int R = R0 + RS * bb;
        if (R < RLIM) { const bool isv = R >= NEXP; const int ex = isv ? R - NEXP : R;
            const float* srow = (isv ? cv_v : cv_u) + (size_t)ex * D + 4 * lane;
#pragma unroll
            for (int j = 0; j < 8; ++j) v[bb][j] = __builtin_nontemporal_load((const f32x4*)(srow + 256 * j)); } }
    __builtin_amdgcn_sched_barrier(0);
#pragma unroll
    for (int bb = 0; bb < 3; ++bb) { const int R = R0 + RS * bb;
        if (R < RLIM) { const bool isv = R >= NEXP; const int ex = isv ? R - NEXP : R;
            float am = 0.f;
#pragma unroll
            for (int j = 0; j < 8; ++j) am = fmaxf(am, fmaxf(fmaxf(fabsf(v[bb][j].x), fabsf(v[bb][j].y)), fmaxf(fabsf(v[bb][j].z), fabsf(v[bb][j].w))));
            am = wave_max(am);
            const float scl = am > 0.f ? am * (1.f / 6.f) : 1.f, inv = am > 0.f ? 6.f / am : 1.f;
            unsigned char* drow = (isv ? cv_v8 : cv_u8) + (size_t)ex * 128 + 2 * lane;
#pragma unroll
            for (int j = 0; j < 8; ++j) { unsigned w = 0u;
                w = __builtin_amdgcn_cvt_scalef32_pk_fp4_f32(w, v[bb][j].x * inv, v[bb][j].y * inv, 1.0f, 0); w = __builtin_amdgcn_cvt_scalef32_pk_fp4_f32(w, v[bb][j].z * inv, v[bb][j].w * inv, 1.0f, 1);
                *(unsigned short*)(drow + (size_t)j * NEXP * 128) = (unsigned short)w; }
            if (lane == 0) (isv ? cv_sv : cv_su)[2 * ex] = scl; } }
}
DEV void route_item2(int l, int tile, int h, const bf16* __restrict__ Q, const bf16* __restrict__ SK, int* __restrict__ IDS, float* __restrict__ GG, LAS unsigned char* lds, int tid, int seq,
                        const float* __restrict__ cv_u, const float* __restrict__ cv_v, unsigned char* __restrict__ cv_u8, unsigned char* __restrict__ cv_v8, float* __restrict__ cv_su, float* __restrict__ cv_sv, bool do_conv) {
    LAS float* sc = (LAS float*)(lds + R2_SC); LAS float* tv = (LAS float*)(lds + R2_TV); LAS int* ti = (LAS int*)(lds + R2_TI);
    const int lane = tid & 63, wave = tid >> 6, row0 = tile * 64;
    {
        const int r = lane & 31, hh = lane >> 5, kt = wave & 3, rt = wave >> 2;
        {
            const int rq = lane >> 4, pos = lane & 15;
#pragma unroll 1
            for (int i = 0; i < 12; ++i) { const int q = wave * 12 + i;
                const bool isq = q >= 64; const int qq = isq ? q - 64 : q; const int c = isq ? (qq >> 4) : (qq >> 5); const int rw = isq ? 4 * (qq & 15) + rq : 4 * (qq & 31) + rq;
                const bf16* src = isq ? Q + (size_t)(row0 + rw) * D + h * 256 + c * 128 : SK + ((size_t)(((l * 8 + h) * 2 + c) * 128 + rw)) * 128;
                __builtin_amdgcn_global_load_lds((const unsigned*)(src + 8 * (pos ^ (rw & 15))), (LAS unsigned*)(lds + 1024 * q), 16, 0, 0); }
        }
        asm volatile("s_waitcnt vmcnt(0)" ::: "memory"); __syncthreads();
        f32x16 acc[2];
#pragma unroll
        for (int c = 0; c < 2; ++c) {
            const int krow = 32 * kt + r, trow = 32 * rt + r;
            unsigned ka = (unsigned)(size_t)lds + (unsigned)((c * 128 + krow) * 256 + 16 * ((krow & 15) ^ hh)), qa = (unsigned)(size_t)lds + 65536u + (unsigned)((c * 64 + trow) * 256 + 16 * ((trow & 15) ^ hh));
            asm volatile("" : "+v"(ka), "+v"(qa));
            bf16x8 bfr[8], afr[8];
#pragma unroll
            for (int ks = 0; ks < 8; ++ks) { bfr[ks] = *(const LAS bf16x8*)(size_t)(ka ^ (32u * ks)); afr[ks] = *(const LAS bf16x8*)(size_t)(qa ^ (32u * ks)); }
#pragma unroll
            for (int e = 0; e < 16; ++e) acc[c][e] = 0.f;
#pragma unroll
            for (int ks = 0; ks < 8; ++ks) acc[c] = __builtin_amdgcn_mfma_f32_32x32x16_bf16(afr[ks], bfr[ks], acc[c], 0, 0, 0);
        }
        __syncthreads();
#pragma unroll
        for (int c = 0; c < 2; ++c)
#pragma unroll
            for (int e = 0; e < 16; ++e) { const int tok = 32 * rt + (e & 3) + 8 * (e >> 2) + 4 * hh; sc[(c * 64 + tok) * 129 + 32 * kt + r] = acc[c][e]; }
    }
    __syncthreads();
    {
        const int L = tid & 127, part = tid >> 7;
        LAS unsigned* mk = (LAS unsigned*)(lds + R2_END);
        unsigned t[16], bk[16];
#pragma unroll
        for (int i = 0; i < 16; ++i) { const int k = part * 32 + i; t[i] = (ord_key(sc[L * 129 + k]) & ~127u) | (unsigned)(127 - k); }
        bitonic_sort16_desc(t);
#pragma unroll
        for (int i = 0; i < 16; ++i) { const int k = part * 32 + 16 + i; bk[i] = (ord_key(sc[L * 129 + k]) & ~127u) | (unsigned)(127 - k); }
        bitonic_sort16_desc(bk);
#pragma unroll
        for (int i = 0; i < 16; ++i) t[i] = t[i] > bk[15 - i] ? t[i] : bk[15 - i];
        bitonic_merge16_desc(t);
        if (part & 1) {
#pragma unroll
            for (int q = 0; q < 16; ++q) mk[(part * 16 + q) * 128 + L] = t[q]; }
        __syncthreads();
        if (!(part & 1)) {
#pragma unroll
            for (int i = 0; i < 16; ++i) bk[i] = mk[((part + 1) * 16 + i) * 128 + L];
#pragma unroll
            for (int i = 0; i < 16; ++i) t[i] = t[i] > bk[15 - i] ? t[i] : bk[15 - i];
            bitonic_merge16_desc(t);
            if (part == 2) {
#pragma unroll
                for (int q = 0; q < 16; ++q) mk[(2 * 16 + q) * 128 + L] = t[q]; }
        }
        __syncthreads();
        if (part == 0) {
#pragma unroll
            for (int i = 0; i < 16; ++i) bk[i] = mk[(2 * 16 + i) * 128 + L];
#pragma unroll
            for (int i = 0; i < 16; ++i) t[i] = t[i] > bk[15 - i] ? t[i] : bk[15 - i];
            bitonic_merge16_desc(t);
#pragma unroll
            for (int q = 0; q < 16; ++q) { const int idx = 127 - (int)(t[q] & 127u); tv[L * 16 + q] = sc[L * 129 + idx]; ti[L * 16 + q] = idx; }
        }
    }
    __syncthreads();
    {
        const int tok = tid & 63, part = tid >> 6;
        LAS unsigned* mk = (LAS unsigned*)(lds + R2_END);
        unsigned t[16], bk[16];
#pragma unroll
        for (int q = 0; q < 16; ++q) t[q] = 0u;
        if (part < 4) {
            float a[16], bq[16];
#pragma unroll
            for (int i = 0; i < 16; ++i) { a[i] = tv[tok * 16 + i]; bq[i] = tv[(64 + tok) * 16 + i]; }
#define R3_KEY(I, J) ((ord_key(a[I] + bq[J]) & ~255u) | (unsigned)(255 - ((I) * 16 + (J))))
            if (part == 0) {
#pragma unroll
                for (int j = 0; j < 16; ++j) t[j] = R3_KEY(0, j);
            } else if (part == 1) {
#pragma unroll
                for (int j = 0; j < 8; ++j) t[j] = R3_KEY(1, j);
#pragma unroll
                for (int j = 0; j < 5; ++j) t[8 + j] = R3_KEY(2, j);
                t[13] = R3_KEY(8, 0); t[14] = R3_KEY(9, 0); t[15] = R3_KEY(10, 0);
            } else if (part == 2) {
#pragma unroll
                for (int j = 0; j < 4; ++j) t[j] = R3_KEY(3, j);
#pragma unroll
                for (int j = 0; j < 3; ++j) t[4 + j] = R3_KEY(4, j);
                t[7] = R3_KEY(5, 0); t[8] = R3_KEY(5, 1); t[9] = R3_KEY(6, 0); t[10] = R3_KEY(6, 1); t[11] = R3_KEY(7, 0); t[12] = R3_KEY(7, 1);
                t[13] = R3_KEY(11, 0); t[14] = R3_KEY(12, 0); t[15] = R3_KEY(13, 0);
            } else {
                t[0] = R3_KEY(14, 0); t[1] = R3_KEY(15, 0);
            }
#undef R3_KEY
            bitonic_sort16_desc(t);
            if (part & 1) {
#pragma unroll
                for (int q = 0; q < 16; ++q) mk[(part * 16 + q) * 64 + tok] = t[q]; }
        }
        __syncthreads();
        if (part == 0 || part == 2) {
#pragma unroll
            for (int i = 0; i < 16; ++i) bk[i] = mk[((part + 1) * 16 + i) * 64 + tok];
#pragma unroll
            for (int i = 0; i < 16; ++i) t[i] = t[i] > bk[15 - i] ? t[i] : bk[15 - i];
            bitonic_merge16_desc(t);
            if (part == 2) {
#pragma unroll
                for (int q = 0; q < 16; ++q) mk[(2 * 16 + q) * 64 + tok] = t[q]; }
        }
        __syncthreads();
        if (part == 0) {
#pragma unroll
            for (int i = 0; i < 16; ++i) bk[i] = mk[(2 * 16 + i) * 64 + tok];
#pragma unroll
            for (int i = 0; i < 16; ++i) t[i] = t[i] > bk[15 - i] ? t[i] : bk[15 - i];
            bitonic_merge16_desc(t);
        float scv[16]; int idv[16]; float mx = NEGBIG;
#pragma unroll
        for (int q = 0; q < 16; ++q) { const int ci = 255 - (int)(t[q] & 255u); const int i = ci >> 4, j = ci & 15;
            scv[q] = tv[tok * 16 + i] + tv[(64 + tok) * 16 + j]; idv[q] = ti[tok * 16 + i] * 128 + ti[(64 + tok) * 16 + j]; mx = fmaxf(mx, scv[q]); }
        float sum = 0.f;
#pragma unroll
        for (int q = 0; q < 16; ++q) { scv[q] = __expf(scv[q] - mx); sum += scv[q]; }
        const float inv = 1.f / sum;
        int* ip = IDS + (size_t)(row0 + tok) * 128 + h * 16; float* gp = GG + (size_t)(row0 + tok) * 128 + h * 16;
#pragma unroll
        for (int q4 = 0; q4 < 4; ++q4) {
            *(int4*)(ip + 4 * q4) = make_int4(idv[4 * q4], idv[4 * q4 + 1], idv[4 * q4 + 2], idv[4 * q4 + 3]);
            *(f32x4*)(gp + 4 * q4) = (f32x4){scv[4 * q4] * inv, scv[4 * q4 + 1] * inv, scv[4 * q4 + 2] * inv, scv[4 * q4 + 3] * inv};
        }
        }
    }
    if (do_conv) {
        convert_rows3((tile * 8 + h) * 32 + wave, 8, (tile * 8 + h) * 32 + 32, cv_u, cv_v, cv_u8, cv_v8, cv_su, cv_sv, lane);
        convert_rows3((tile * 8 + h) * 32 + wave + 24, 8, (tile * 8 + h) * 32 + 32, cv_u, cv_v, cv_u8, cv_v8, cv_su, cv_sv, lane);
    }
    __syncthreads();
}


DEV void expert_row8(int l, int row, const bf16* H, const int* __restrict__ IDS, const float* __restrict__ GG, const unsigned char* __restrict__ U8, const unsigned char* __restrict__ V8,
                     const bf16* __restrict__ X1, const float* __restrict__ g2, const float* __restrict__ fnorm, float* __restrict__ XO, bf16* __restrict__ XOH, int lane, float pscale, LAS int* sortL,
                     const float* __restrict__ ngain, const float* __restrict__ nmod, bf16* Hout) {
    f32x2 x[16];
#pragma unroll
    for (int j = 0; j < 2; ++j) {
        const v4u a = *(const v4u*)(H + (size_t)row * D + lane * 16 + 1024 * j), c = *(const v4u*)(H + (size_t)row * D + lane * 16 + 1024 * j + 8);
        x[j * 8 + 0] = (f32x2){bf_lo(a.x), bf_hi(a.x)}; x[j * 8 + 1] = (f32x2){bf_lo(a.y), bf_hi(a.y)}; x[j * 8 + 2] = (f32x2){bf_lo(a.z), bf_hi(a.z)}; x[j * 8 + 3] = (f32x2){bf_lo(a.w), bf_hi(a.w)};
        x[j * 8 + 4] = (f32x2){bf_lo(c.x), bf_hi(c.x)}; x[j * 8 + 5] = (f32x2){bf_lo(c.y), bf_hi(c.y)}; x[j * 8 + 6] = (f32x2){bf_lo(c.z), bf_hi(c.z)}; x[j * 8 + 7] = (f32x2){bf_lo(c.w), bf_hi(c.w)};
    }
    int id0 = IDS[(size_t)row * 128 + lane], id1 = IDS[(size_t)row * 128 + 64 + lane];
    float gg0 = GG[(size_t)row * 128 + lane], gg1 = GG[(size_t)row * 128 + 64 + lane];
    {
        const int w0 = id0 >> 9, w1 = id1 >> 9; int p0 = 0, p1 = 0, base = 0;
        for (int w = 0; w < 32; ++w) {
            const unsigned long long m0 = __ballot(w0 == w), m1 = __ballot(w1 == w);
            const int c0 = __popcll(m0), c1 = __popcll(m1);
            const int b0 = (int)__builtin_amdgcn_mbcnt_hi((unsigned)(m0 >> 32), __builtin_amdgcn_mbcnt_lo((unsigned)m0, 0u));
            const int b1 = (int)__builtin_amdgcn_mbcnt_hi((unsigned)(m1 >> 32), __builtin_amdgcn_mbcnt_lo((unsigned)m1, 0u));
            p0 = (w0 == w) ? base + b0 : p0; p1 = (w1 == w) ? base + c0 + b1 : p1;
            base += c0 + c1;
        }
        sortL[p0] = id0; sortL[p1] = id1; ((LAS float*)sortL)[128 + p0] = gg0; ((LAS float*)sortL)[128 + p1] = gg1;
        LDS_WAIT();
        id0 = sortL[lane]; id1 = sortL[64 + lane]; gg0 = ((LAS float*)sortL)[128 + lane]; gg1 = ((LAS float*)sortL)[192 + lane];
        LDS_WAIT();
    }
    float wv0 = 0.f, wv1 = 0.f;
    const unsigned char* Ul = U8 + (size_t)l * NEXP * D + lane * 16;
    const unsigned char* Vl = V8 + (size_t)l * NEXP * D + lane * 16;
    for (int e0 = 0; e0 < 128; e0 += 8) {
        v4u uu[8][2];
#pragma unroll
        for (int q = 0; q < 8; ++q) { const int e = e0 + q; const int id = (e < 64) ? __builtin_amdgcn_readlane(id0, e & 63) : __builtin_amdgcn_readlane(id1, e & 63);
            uu[q][0] = *(const v4u*)(Ul + (size_t)id * D); uu[q][1] = *(const v4u*)(Ul + (size_t)id * D + 1024); }
        float ds[8];
#pragma unroll
        for (int q = 0; q < 8; ++q) {
            f32x2 acc = {0.f, 0.f};
#pragma unroll
            for (int j = 0; j < 2; ++j) {
                const unsigned wd[4] = {uu[q][j].x, uu[q][j].y, uu[q][j].z, uu[q][j].w};
#pragma unroll
                for (int dw = 0; dw < 4; ++dw) {
                    const f32x2 lo = __builtin_amdgcn_cvt_pk_f32_fp8((int)wd[dw], false), hi = __builtin_amdgcn_cvt_pk_f32_fp8((int)wd[dw], true);
                    acc = __builtin_elementwise_fma(lo, x[j * 8 + 2 * dw], acc); acc = __builtin_elementwise_fma(hi, x[j * 8 + 2 * dw + 1], acc);
                }
            }
            ds[q] = acc.x + acc.y;
        }
#pragma unroll
        for (int q = 0; q < 8; ++q) ds[q] += swz_xor<1>(ds[q]);
#pragma unroll
        for (int q = 0; q < 8; ++q) ds[q] += swz_xor<2>(ds[q]);
#pragma unroll
        for (int q = 0; q < 8; ++q) ds[q] += swz_xor<4>(ds[q]);
#pragma unroll
        for (int q = 0; q < 8; ++q) ds[q] += swz_xor<8>(ds[q]);
#pragma unroll
        for (int q = 0; q < 8; ++q) ds[q] += swz_xor<16>(ds[q]);
#pragma unroll
        for (int q = 0; q < 8; ++q) ds[q] = sum32(ds[q]);
#pragma unroll
        for (int q = 0; q < 8; ++q) { const int e = e0 + q;
            const float gq = (e < 64) ? __builtin_bit_cast(float, __builtin_amdgcn_readlane(__builtin_bit_cast(int, gg0), e & 63)) : __builtin_bit_cast(float, __builtin_amdgcn_readlane(__builtin_bit_cast(int, gg1), e & 63));
            const float w = gq * gelu_tanh(ds[q] * (1.f / U8_SCALE));
            if (e < 64) wv0 = (lane == (e & 63)) ? w : wv0; else wv1 = (lane == (e & 63)) ? w : wv1; }
    }
    f32x2 y[16];
#pragma unroll
    for (int i = 0; i < 16; ++i) y[i] = (f32x2){0.f, 0.f};
    for (int e0 = 0; e0 < 128; e0 += 8) {
        v4u vv[8][2];
#pragma unroll
        for (int q = 0; q < 8; ++q) { const int e = e0 + q; const int id = (e < 64) ? __builtin_amdgcn_readlane(id0, e & 63) : __builtin_amdgcn_readlane(id1, e & 63);
            vv[q][0] = *(const v4u*)(Vl + (size_t)id * D); vv[q][1] = *(const v4u*)(Vl + (size_t)id * D + 1024); }
#pragma unroll
        for (int q = 0; q < 8; ++q) { const int e = e0 + q;
            const float w = (e < 64) ? __builtin_bit_cast(float, __builtin_amdgcn_readlane(__builtin_bit_cast(int, wv0), e & 63)) : __builtin_bit_cast(float, __builtin_amdgcn_readlane(__builtin_bit_cast(int, wv1), e & 63));
            const f32x2 w2 = {w, w};
#pragma unroll
            for (int j = 0; j < 2; ++j) {
                const unsigned wd[4] = {vv[q][j].x, vv[q][j].y, vv[q][j].z, vv[q][j].w};
#pragma unroll
                for (int dw = 0; dw < 4; ++dw) {
                    const f32x2 lo = __builtin_amdgcn_cvt_pk_f32_fp8((int)wd[dw], false), hi = __builtin_amdgcn_cvt_pk_f32_fp8((int)wd[dw], true);
                    y[j * 8 + 2 * dw] = __builtin_elementwise_fma(w2, lo, y[j * 8 + 2 * dw]); y[j * 8 + 2 * dw + 1] = __builtin_elementwise_fma(w2, hi, y[j * 8 + 2 * dw + 1]);
                }
            }
        }
    }
    float ssq = 0.f;
#pragma unroll
    for (int j = 0; j < 2; ++j)
#pragma unroll
        for (int k4 = 0; k4 < 4; ++k4) {
            const int col = lane * 16 + 1024 * j + 4 * k4;
            const unsigned long long xw = *(const unsigned long long*)(X1 + (size_t)row * D + col); const f32x4 xa = {bf_lo((unsigned)xw), bf_hi((unsigned)xw), bf_lo((unsigned)(xw >> 32)), bf_hi((unsigned)(xw >> 32))}; const f32x4 ga = *(const f32x4*)(g2 + col) * pscale;
            f32x2& ya = y[j * 8 + 2 * k4]; f32x2& yb = y[j * 8 + 2 * k4 + 1];
            ya.x = xa.x + ga.x * ya.x; ya.y = xa.y + ga.y * ya.y; yb.x = xa.z + ga.z * yb.x; yb.y = xa.w + ga.w * yb.y;
            ssq += (ya.x * ya.x + ya.y * ya.y) + (yb.x * yb.x + yb.y * yb.y);
        }
    const float r = rsqrtf(wave_sum(ssq) * (1.f / D) + EPS);
#pragma unroll
    for (int j = 0; j < 2; ++j)
#pragma unroll
        for (int k4 = 0; k4 < 4; ++k4) {
            const int col = lane * 16 + 1024 * j + 4 * k4;
            const f32x2 ya = y[j * 8 + 2 * k4], yb = y[j * 8 + 2 * k4 + 1];
            f32x4 ov = {ya.x, ya.y, yb.x, yb.y};
            if (fnorm) *(f32x4*)(XO + (size_t)row * D + col) = ov * r * *(const f32x4*)(fnorm + col);
            else *(unsigned long long*)(XOH + (size_t)row * D + col) = (unsigned long long)pk2(ov.x, ov.y) | ((unsigned long long)pk2(ov.z, ov.w) << 32);
            if (ngain) {
                const f32x4 g = *(const f32x4*)(ngain + col), sc = *(const f32x4*)(nmod + MO_SC1 + col), sh = *(const f32x4*)(nmod + MO_SH1 + col);
                const f32x4 hv = (ov * r) * g * (sc + 1.f) + sh;
                *(unsigned long long*)(Hout + (size_t)row * D + col) = (unsigned long long)pk2(hv.x, hv.y) | ((unsigned long long)pk2(hv.z, hv.w) << 32);
            }
        }
}


DEV int claim_unit(unsigned* cnt, LAS int* claimL, int w0) {
    __syncthreads();
    if (xb_lead(w0)) *claimL = (int)__hip_atomic_fetch_add(cnt, 1u, __ATOMIC_RELAXED, __HIP_MEMORY_SCOPE_AGENT);
    __syncthreads();
    return *(volatile LAS int*)claimL;
}
struct ExIds { int id[16]; };
DEV void ex_load_ids(ExIds& I, int t, const int* __restrict__ IDS, int rg) {
#pragma unroll
    for (int q = 0; q < 4; ++q) { const int4 v = *(const int4*)(IDS + (size_t)t * 128 + 16 * rg + 4 * q); I.id[4 * q] = v.x; I.id[4 * q + 1] = v.y; I.id[4 * q + 2] = v.z; I.id[4 * q + 3] = v.w; }
}
DEV void ex_load_rows(v4u (&r)[16], const ExIds& I, const unsigned char* __restrict__ Tb  , unsigned loff  ) {
#pragma unroll
    for (int i = 0; i < 16; ++i) r[i] = *(const v4u*)(Tb + (((unsigned)I.id[i] << 7) | loff));
}
DEV void exu_compute(const v4u (&uu)[16], const v4u (&xp)[4], float* __restrict__ pp, int cl) {
    f32x2 x[16];
#pragma unroll
    for (int q = 0; q < 4; ++q) { x[4 * q] = (f32x2){bf_lo(xp[q].x), bf_hi(xp[q].x)}; x[4 * q + 1] = (f32x2){bf_lo(xp[q].y), bf_hi(xp[q].y)}; x[4 * q + 2] = (f32x2){bf_lo(xp[q].z), bf_hi(xp[q].z)}; x[4 * q + 3] = (f32x2){bf_lo(xp[q].w), bf_hi(xp[q].w)}; }
    float pd[16];
#pragma unroll
    for (int i = 0; i < 16; ++i) {
        const unsigned uw[4] = {uu[i].x, uu[i].y, uu[i].z, uu[i].w};
        f32x2 a0 = __builtin_amdgcn_cvt_scalef32_pk_f32_fp4(uw[0], 1.0f, 0) * x[0], a1 = __builtin_amdgcn_cvt_scalef32_pk_f32_fp4(uw[0], 1.0f, 1) * x[1];
        a0 = __builtin_elementwise_fma(__builtin_amdgcn_cvt_scalef32_pk_f32_fp4(uw[0], 1.0f, 2), x[2], a0); a1 = __builtin_elementwise_fma(__builtin_amdgcn_cvt_scalef32_pk_f32_fp4(uw[0], 1.0f, 3), x[3], a1);
#pragma unroll
        for (int dw = 1; dw < 4; ++dw) {
            a0 = __builtin_elementwise_fma(__builtin_amdgcn_cvt_scalef32_pk_f32_fp4(uw[dw], 1.0f, 0), x[4 * dw], a0); a1 = __builtin_elementwise_fma(__builtin_amdgcn_cvt_scalef32_pk_f32_fp4(uw[dw], 1.0f, 1), x[4 * dw + 1], a1);
            a0 = __builtin_elementwise_fma(__builtin_amdgcn_cvt_scalef32_pk_f32_fp4(uw[dw], 1.0f, 2), x[4 * dw + 2], a0); a1 = __builtin_elementwise_fma(__builtin_amdgcn_cvt_scalef32_pk_f32_fp4(uw[dw], 1.0f, 3), x[4 * dw + 3], a1); }
        { const f32x2 a = a0 + a1; pd[i] = a.x + a.y; }
    }
    const bool b2 = (cl & 4) != 0, b1 = (cl & 2) != 0, b0 = (cl & 1) != 0;
    float v8[8], v4[4], v2[2];
#pragma unroll
    for (int j = 0; j < 8; ++j) { const float keep = b2 ? pd[8 + j] : pd[j], give = b2 ? pd[j] : pd[8 + j]; v8[j] = keep + swz_xor<4>(give); }
#pragma unroll
    for (int j = 0; j < 4; ++j) { const float keep = b1 ? v8[4 + j] : v8[j], give = b1 ? v8[j] : v8[4 + j]; v4[j] = keep + swz_xor<2>(give); }
#pragma unroll
    for (int j = 0; j < 2; ++j) { const float keep = b0 ? v4[2 + j] : v4[j], give = b0 ? v4[j] : v4[2 + j]; v2[j] = keep + swz_xor<1>(give); }
    *(f32x2*)pp = (f32x2){v2[0], v2[1]};
}
template <int NT>
DEV void exu_unit(int s, int t0, const bf16* __restrict__ H, const int* __restrict__ IDS, const unsigned char* __restrict__ U8l, float* __restrict__ PD, int lane) {
    const int rg = lane >> 3, cl = lane & 7;
    const unsigned char* Ub = U8l + (size_t)s * NEXP * 128; const unsigned loff = (unsigned)cl * 16u;
    ExIds Ia, Ib; v4u ra[16], rb[16]; v4u xa[4], xb[4];
#define EXU_X(XV, T) do { const v4u* xp_ = (const v4u*)(H + (size_t)(T) * D + 256 * s + 32 * cl); XV[0] = xp_[0]; XV[1] = xp_[1]; XV[2] = xp_[2]; XV[3] = xp_[3]; } while (0)
    ex_load_ids(Ia, t0, IDS, rg); EXU_X(xa, t0);
    ex_load_rows(ra, Ia, Ub, loff);
    if (NT > 1) { ex_load_ids(Ib, t0 + 1, IDS, rg); EXU_X(xb, t0 + 1); }
#pragma unroll
    for (int k = 0; k < NT; k += 2) {
        if (k + 1 < NT) ex_load_rows(rb, Ib, Ub, loff);
        if (k + 2 < NT) { ex_load_ids(Ia, t0 + k + 2, IDS, rg); }
        exu_compute(ra, xa, PD + ((size_t)s * M + t0 + k) * 128 + 16 * rg + 2 * cl, cl);
        if (k + 2 < NT) { EXU_X(xa, t0 + k + 2); ex_load_rows(ra, Ia, Ub, loff); }
        if (k + 1 < NT) {
            if (k + 3 < NT) { ex_load_ids(Ib, t0 + k + 3, IDS, rg); }
            exu_compute(rb, xb, PD + ((size_t)s * M + t0 + k + 1) * 128 + 16 * rg + 2 * cl, cl);
            if (k + 3 < NT) { EXU_X(xb, t0 + k + 3); }
        }
    }
#undef EXU_X
}
struct ExW { float w[16]; };
DEV void ex_load_w(ExW& W, int t, const float* __restrict__ WE, int rg) {
#pragma unroll
    for (int q = 0; q < 4; ++q) { const f32x4 w = *(const f32x4*)(WE + (size_t)t * 128 + 16 * rg + 4 * q); W.w[4 * q] = w.x; W.w[4 * q + 1] = w.y; W.w[4 * q + 2] = w.z; W.w[4 * q + 3] = w.w; }
}
DEV void exv_compute(const v4u (&vv)[16], const ExW& W, int s, int t, const bf16* __restrict__ X1, const float* __restrict__ g2, bf16* __restrict__ XO, int rg, int cl) {
    f32x2 y[16];
    {   const unsigned vw[4] = {vv[0].x, vv[0].y, vv[0].z, vv[0].w}; const f32x2 w2 = {W.w[0], W.w[0]};
#pragma unroll
        for (int dw = 0; dw < 4; ++dw) { y[4 * dw] = w2 * __builtin_amdgcn_cvt_scalef32_pk_f32_fp4(vw[dw], 1.0f, 0); y[4 * dw + 1] = w2 * __builtin_amdgcn_cvt_scalef32_pk_f32_fp4(vw[dw], 1.0f, 1);
            y[4 * dw + 2] = w2 * __builtin_amdgcn_cvt_scalef32_pk_f32_fp4(vw[dw], 1.0f, 2); y[4 * dw + 3] = w2 * __builtin_amdgcn_cvt_scalef32_pk_f32_fp4(vw[dw], 1.0f, 3); } }
#pragma unroll
    for (int i = 1; i < 16; ++i) {
        const unsigned vw[4] = {vv[i].x, vv[i].y, vv[i].z, vv[i].w}; const f32x2 w2 = {W.w[i], W.w[i]};
#pragma unroll
        for (int dw = 0; dw < 4; ++dw) {
            y[4 * dw] = __builtin_elementwise_fma(w2, __builtin_amdgcn_cvt_scalef32_pk_f32_fp4(vw[dw], 1.0f, 0), y[4 * dw]); y[4 * dw + 1] = __builtin_elementwise_fma(w2, __builtin_amdgcn_cvt_scalef32_pk_f32_fp4(vw[dw], 1.0f, 1), y[4 * dw + 1]);
            y[4 * dw + 2] = __builtin_elementwise_fma(w2, __builtin_amdgcn_cvt_scalef32_pk_f32_fp4(vw[dw], 1.0f, 2), y[4 * dw + 2]); y[4 * dw + 3] = __builtin_elementwise_fma(w2, __builtin_amdgcn_cvt_scalef32_pk_f32_fp4(vw[dw], 1.0f, 3), y[4 * dw + 3]); }
    }
    const bool c5 = (rg & 4) != 0, c4 = (rg & 2) != 0, c3 = (rg & 1) != 0;
    f32x2 u8[8], u4[4], u2[2];
#pragma unroll
    for (int j = 0; j < 8; ++j) { const f32x2 keep = c5 ? y[8 + j] : y[j], give = c5 ? y[j] : y[8 + j]; u8[j].x = keep.x + part32_(give.x); u8[j].y = keep.y + part32_(give.y); }
#pragma unroll
    for (int j = 0; j < 4; ++j) { const f32x2 keep = c4 ? u8[4 + j] : u8[j], give = c4 ? u8[j] : u8[4 + j]; u4[j].x = keep.x + swz_xor<16>(give.x); u4[j].y = keep.y + swz_xor<16>(give.y); }
#pragma unroll
    for (int j = 0; j < 2; ++j) { const f32x2 keep = c3 ? u4[2 + j] : u4[j], give = c3 ? u4[j] : u4[2 + j]; u2[j].x = keep.x + swz_xor<8>(give.x); u2[j].y = keep.y + swz_xor<8>(give.y); }
    {
        const size_t o = (size_t)t * D + 256 * s + 32 * cl + 4 * rg;
        const unsigned long long xw = *(const unsigned long long*)(X1 + o); const f32x4 gg = *(const f32x4*)(g2 + 256 * s + 32 * cl + 4 * rg);
        const unsigned lo = pk2(bf_lo((unsigned)xw) + gg.x * u2[0].x, bf_hi((unsigned)xw) + gg.y * u2[0].y), hi = pk2(bf_lo((unsigned)(xw >> 32)) + gg.z * u2[1].x, bf_hi((unsigned)(xw >> 32)) + gg.w * u2[1].y);
        *(unsigned long long*)(XO + o) = (unsigned long long)lo | ((unsigned long long)hi << 32);
    }
}
template <int NT>
DEV void exv_unit(int s, int t0, const int* __restrict__ IDS, const float* __restrict__ WE, const unsigned char* __restrict__ V8l, const bf16* __restrict__ X1, const float* __restrict__ g2b  ,
                  bf16* __restrict__ XO, int lane) {
    const int rg = lane >> 3, cl = lane & 7;
    const unsigned char* Vb = V8l + (size_t)s * NEXP * 128; const unsigned loff = (unsigned)cl * 16u;
    ExIds Ia, Ib; ExW Wa, Wb; v4u ra[16], rb[16];
    ex_load_ids(Ia, t0, IDS, rg); ex_load_w(Wa, t0, WE, rg);
    ex_load_rows(ra, Ia, Vb, loff);
    if (NT > 1) { ex_load_ids(Ib, t0 + 1, IDS, rg); ex_load_w(Wb, t0 + 1, WE, rg); }
#pragma unroll
    for (int k = 0; k < NT; k += 2) {
        if (k + 1 < NT) ex_load_rows(rb, Ib, Vb, loff);
        if (k + 2 < NT) ex_load_ids(Ia, t0 + k + 2, IDS, rg);
        exv_compute(ra, Wa, s, t0 + k, X1, g2b + (size_t)((t0 + k) >> 12) * MODW, XO, rg, cl);
        if (k + 2 < NT) { ex_load_w(Wa, t0 + k + 2, WE, rg); ex_load_rows(ra, Ia, Vb, loff); }
        if (k + 1 < NT) {
            if (k + 3 < NT) ex_load_ids(Ib, t0 + k + 3, IDS, rg);
            exv_compute(rb, Wb, s, t0 + k + 1, X1, g2b + (size_t)((t0 + k + 1) >> 12) * MODW, XO, rg, cl);
            if (k + 3 < NT) ex_load_w(Wb, t0 + k + 3, WE, rg);
        }
    }
}
DEV void finalnorm_rows(const bf16* __restrict__ X, const float* __restrict__ gain, float* __restrict__ O, int gw, int NGW, int lane) {
#pragma unroll 2
    for (int m = gw; m < M; m += NGW) {
        const v4u* xr = (const v4u*)(X + (size_t)m * D) + lane;
        float v[32]; float sq = 0.f;
#pragma unroll
        for (int j = 0; j < 4; ++j) { const v4u w = xr[64 * j];
            v[8 * j + 0] = bf_lo(w.x); v[8 * j + 1] = bf_hi(w.x); v[8 * j + 2] = bf_lo(w.y); v[8 * j + 3] = bf_hi(w.y); v[8 * j + 4] = bf_lo(w.z); v[8 * j + 5] = bf_hi(w.z); v[8 * j + 6] = bf_lo(w.w); v[8 * j + 7] = bf_hi(w.w);
#pragma unroll
            for (int e = 0; e < 8; ++e) sq += v[8 * j + e] * v[8 * j + e]; }
        const float r = rsqrtf(wave_sum(sq) * (1.f / D) + EPS);
#pragma unroll
        for (int j = 0; j < 4; ++j) { const int col = 8 * (lane + 64 * j);
            const f32x4 g0 = *(const f32x4*)(gain + col), g1 = *(const f32x4*)(gain + col + 4);
            *(f32x4*)(O + (size_t)m * D + col) = (f32x4){v[8 * j + 0] * r * g0.x, v[8 * j + 1] * r * g0.y, v[8 * j + 2] * r * g0.z, v[8 * j + 3] * r * g0.w};
            *(f32x4*)(O + (size_t)m * D + col + 4) = (f32x4){v[8 * j + 4] * r * g1.x, v[8 * j + 5] * r * g1.y, v[8 * j + 6] * r * g1.z, v[8 * j + 7] * r * g1.w}; }
    }
}

struct Args { const float* in[24]; float* out; unsigned char* ws; int ph_lo, ph_hi, li, pad; };

__global__ void __launch_bounds__(512, 2) fwd(Args a) {
    extern __shared__ __attribute__((aligned(16))) unsigned char lds_raw[];
    LAS unsigned char* lds = (LAS unsigned char*)lds_raw;
#define PHASE_TID() unsigned zz_ = 0u; asm volatile("" : "+v"(zz_));   \
    int tid = wave0 * 64 + (int)__builtin_amdgcn_mbcnt_hi(~0u, __builtin_amdgcn_mbcnt_lo(~0u, zz_)); const int lane = tid & 63; (void)lane; \
    int bx = blockIdx.x, G = gridDim.x; asm volatile("" : "+s"(bx), "+s"(G)); const int wave = __builtin_amdgcn_readfirstlane(tid >> 6); \
    const int vcu = (G % 8 == 0) ? (bx % 8) * (G / 8) + bx / 8 : bx; const int gw = vcu * 8 + wave, NGW = G * 8; (void)gw; (void)NGW; (void)vcu; (void)wave; \
    const __attribute__((address_space(4))) Args* A = (const __attribute__((address_space(4))) Args*)__builtin_amdgcn_kernarg_segment_ptr(); asm volatile("" : "+s"(A))
    unsigned* ctl = (unsigned*)(a.ws + WS_CTL);
    const int lo = a.ph_lo, hi = a.ph_hi;
    const int wave0 = __builtin_amdgcn_readfirstlane((int)threadIdx.x >> 6);
    for (int u = threadIdx.x; u < (LDS_BYTES - LDS_MISC) / 4; u += 512) ((LAS unsigned*)(lds + LDS_MISC))[u] = 0u;
    __syncthreads();
    XcdBarrier bar; bar.bar = ctl + CW_BAR + (a.li & 7) * XCD_BAR_WORDS; bar.x = 0; bar.st = (volatile LAS unsigned*)(lds + LDS_MISC + 64); bar.w0 = wave0;
    if (hi - lo > 1) bar = xcd_barrier_post(ctl + CW_BAR + (a.li & 7) * XCD_BAR_WORDS, (volatile LAS unsigned*)(lds + LDS_MISC + 64), wave0);
#define TAIL_FIRST(G_) ((M / 256) * (IN_W / 256) - 2 * (G_))
#define TAIL_CONV(G_)  (TAIL_FIRST(G_) > 0 && (G_) - TAIL_FIRST(G_) >= 64)
#define IN(k) (lo <= (k) && (k) < hi)
#define SEAM(k) do { if (IN(k) && IN((k) + 1)) xcd_barrier(bar); } while (0)
#if MK_DUP >= 0
#define PH(k) if (IN(pb + (k))) for (int rep_ = 0; rep_ < ((MK_DUP == (k)) ? 2 : 1); ++rep_)
#define PH_SYNC if (rep_) __syncthreads();
#define PH_REP rep_
#define PH_UNIT(k) for (int r2_ = 0; r2_ < ((MK_DUP == (k)) ? 2 : 1); ++r2_)
#else
#define PH(k) if (IN(pb + (k)))
#define PH_SYNC
#define PH_REP 0
#define PH_UNIT(k)
#endif

#define mod   ((float*)(A->ws + WS_MOD))
#define WIN_T ((bf16*)(A->ws + WS_WIN_T))
#define WOUT_T ((bf16*)(A->ws + WS_WOUT_T))
#define WQ_T  ((bf16*)(A->ws + WS_WQ_T))
#define SUBK  ((bf16*)(A->ws + WS_SUBK))
#define UB    ((bf16*)(A->ws + WS_U))
#define VB    ((bf16*)(A->ws + WS_V))
#define H     ((bf16*)(A->ws + WS_H))
#define Z     ((bf16*)(A->ws + WS_Z))
#define HLOC  ((bf16*)(A->ws + WS_HLOC))
#define PP    ((bf16*)(A->ws + WS_P))
#define YB    ((float*)(A->ws + WS_YB))
#define YC    ((bf16*)(A->ws + WS_YC))
#define SUMA  ((float*)(A->ws + WS_SUMA))
#define SUMB  ((float*)(A->ws + WS_SUMB))
#define X1    ((float*)(A->ws + WS_X1))
#define X2    ((float*)(A->ws + WS_X2))
#define QB    ((bf16*)(A->ws + WS_Q))
#define IDS   ((int*)(A->ws + WS_IDS))
#define GG    ((float*)(A->ws + WS_G))
#define PARTB ((bf16*)(A->ws + WS_PART))
#define WG_T  ((bf16*)(A->ws + WS_WG_T))
#define PDOT  ((float*)(A->ws + WS_PDOT))
#define SCL   ((float*)(A->ws + WS_SCL))
#define WEXP  ((float*)(A->ws + WS_WEXP))
#define LSEB  ((float*)(A->ws + WS_LSE))
#define XIN   ((l == 0) ? A->in[0] : (const float*)X2)
#define XR    ((bf16*)(A->ws + WS_XR))
#define X1H   ((bf16*)(A->ws + WS_X1))
#define X2H   ((bf16*)(A->ws + WS_X2))
#define XRES  ((l == 0) ? (const bf16*)XR : (const bf16*)X2H)
#define MODL  (mod + (size_t)l * 2 * MODW)
    if (IN(0)) {
        PHASE_TID();
        ph_mod(A->in[1], A->in[2], A->in[3], mod, (LAS float*)lds, vcu, G, tid);
        {
            LAS float* scr = (LAS float*)(lds + wave * 17408);
            constexpr int I_IN = (D / 64) * (IN_W / 64), I_SQ = (D / 64) * (D / 64), I_L = I_IN + 2 * I_SQ;
            for (int it = gw; it < 2 * I_L; it += NGW) {
                const int l = it / I_L; int r = it % I_L;
                if (r < I_IN) { transpose_item64(A->in[6] + (size_t)l * D * IN_W, D, IN_W, WIN_T + (size_t)l * IN_W * D, scr, r, lane); continue; } r -= I_IN;
                if (r < I_SQ) { transpose_item64(A->in[18] + (size_t)l * D * D, D, D, WOUT_T + (size_t)l * D * D, scr, r, lane); continue; } r -= I_SQ;
                transpose_item64(A->in[19] + (size_t)l * D * D, D, D, WQ_T + (size_t)l * D * D, scr, r, lane);
            }
        }
        {
            LAS float* scr = (LAS float*)(lds + wave * 17408);
            for (int it = gw; it < 2 * 6 * 2 * 8; it += NGW) { const int mi = it >> 3, sub = it & 7; const int ln = mi >> 1, g = mi & 1;
                transpose_item((g ? A->in[11] : A->in[9]) + (size_t)ln * 128 * 128, 128, 128, WG_T + ((size_t)ln * 2 + g) * 128 * 128, scr, sub, lane); }
        }
        const size_t gtid = (size_t)vcu * 512 + tid, gstride = (size_t)G * 512;
        convert_copy(A->in[20], SUBK, (size_t)2 * 8 * 2 * 128 * 128 / 8, gtid, gstride);
    }
    SEAM(0);

    for (int l = 0; l < NL; ++l) {
        const int pb = 1 + PH_L * l;
        if (IN(pb + 0) && l == 0) { PHASE_TID(); modnorm_rows(XIN, A->in[4] + l * D, MODL, MO_SH1, MO_SC1, H, gw, NGW, lane, XR); }
        if (l == 0) SEAM(pb + 0);
        PH(1) { PH_SYNC
            PHASE_TID(); (void)tid;
            pg8::Gemm g{H, WIN_T + (size_t)l * IN_W * D, M, IN_W, D}; pg8::StaticOrder S; S.init(M, IN_W, G, bx);
            pg8::EpiBf16<0> E{Z, IN_W, nullptr, 0, 0};
            pg8::gemm_phase<pg8::EpiBf16<0>, pg8::StaticOrder, false>((PG8_LAS unsigned char*)lds, g, S, E, nullptr, wave0);
            if (TAIL_CONV(G) && bx >= TAIL_FIRST(G)) {
                const int lane_ = (int)__builtin_amdgcn_mbcnt_hi(~0u, __builtin_amdgcn_mbcnt_lo(~0u, 0u));
                const int NW = (G - TAIL_FIRST(G)) * 8, w = (bx - TAIL_FIRST(G)) * 8 + wave0;
#pragma unroll 1
                for (int R = w; R < NEXP; R += 3 * NW) convert_rows3(R, NW, NEXP,        A->in[21] + (size_t)l * NEXP * D, A->in[22] + (size_t)l * NEXP * D, (unsigned char*)UB + (size_t)l * NEXP * D,
                                                                         (unsigned char*)VB + (size_t)l * NEXP * D, SCL + (size_t)(2 * l) * NEXP, SCL + (size_t)(2 * l) * NEXP + 1, lane_);
            }
        }
        SEAM(pb + 1);
        PH(2) { PH_SYNC
            PHASE_TID();
            const bool lru_bal = (G == 256);
            const int it_lo = !lru_bal ? vcu : (vcu < 128 ? 2 * vcu : (vcu < 192 ? 256 + 3 * (vcu - 128) : 448 + 5 * (vcu - 192)));
            const int it_hi = !lru_bal ? 2 * 64 * 6 : (vcu < 128 ? it_lo + 2 : (vcu < 192 ? it_lo + 3 : it_lo + 5)), it_st = lru_bal ? 1 : G;
            for (int it = it_lo; it < it_hi; it += it_st) {
                const int b = it / 384, r = it % 384, j = r / 6, n = r % 6;
                lru_item2(l, b, j, n, Z, A->in[7], A->in[8], WG_T, A->in[10], A->in[12], A->in[13], HLOC, PP, SUMA, SUMB,
                          (LAS float*)lds, (LAS float*)(lds + 34816), (LAS float*)(lds + 69632), tid);
            }
            {
                {
                    LAS unsigned char* wl = lds + wave * ATT_WLDS;
                    for (int it = gw; it < 1024 + 4608; it += NGW) {
                        if (it < 1024) { const int bh = it >> 7, tl = 127 - (it & 127); sb_mfma_item(bh >> 2, bh & 3, 32 * tl, Z, YC, wl, lane); }
                        else { const int i2 = it - 1024; const int tl = i2 & 127, p = (i2 >> 7) % 3, bh = i2 / 384; const int d = 1 << (2 * p);
                            dil_mfma_item(bh / 6, bh % 6, p, tl % d, 32 * (tl / d), Z, A->in[14], PARTB, LSEB, wl, lane); }
                    }
                }
            }
        }
        SEAM(pb + 2);
        PH(3) { PH_SYNC
            PHASE_TID();
            for (int it = vcu; it < 256; it += G) { const int b = it >> 7, j = (it >> 1) & 63, half = it & 1;
                combine_item(l, b, j, half, Z, HLOC, PP, SUMA, SUMB, PARTB, LSEB, YC, A->in[15], A->in[16], A->in[17], H, (LAS float*)lds, tid); }
        }
        SEAM(pb + 3);
        PH(4) { PH_SYNC
            PHASE_TID(); (void)tid;
            pg8::Gemm g{H, WOUT_T + (size_t)l * D * D, M, D, D}; pg8::StaticOrder S; S.init(M, D, G, bx);
            EpiResGate E{XRES, X1H, MODL + MO_G1, 1.f};
            pg8::gemm_phase<EpiResGate, pg8::StaticOrder, false>((PG8_LAS unsigned char*)lds, g, S, E, nullptr, wave0);
        }
        SEAM(pb + 4);
        PH(5) { PH_SYNC PHASE_TID(); modnorm_rows_h(X1H, A->in[5] + l * D, MODL, MO_SH2, MO_SC2, H, gw, NGW, lane); }
        SEAM(pb + 5);
        PH(6) { PH_SYNC
            PHASE_TID(); (void)tid;
            pg8::Gemm g{H, WQ_T + (size_t)l * D * D, M, D, D}; pg8::StaticOrder S; S.init(M, D, G, bx);
            pg8::EpiBf16<0> E{QB, D, nullptr, 0, 0};
            pg8::gemm_phase<pg8::EpiBf16<0>, pg8::StaticOrder, false>((PG8_LAS unsigned char*)lds, g, S, E, nullptr, wave0);
        }
        SEAM(pb + 6);
        PH(7) { PH_SYNC
            PHASE_TID();
            for (int it = vcu; it < 128 * 8; it += G) route_item2(l, it >> 3, it & 7, QB, SUBK, IDS, GG, lds, tid, l * 1024 + it + 1 + PH_REP * 4096, A->in[21] + (size_t)l * NEXP * D, A->in[22] + (size_t)l * NEXP * D,
                                                                                      (unsigned char*)UB + (size_t)l * NEXP * D, (unsigned char*)VB + (size_t)l * NEXP * D, SCL + (size_t)(2 * l) * NEXP, SCL + (size_t)(2 * l) * NEXP + 1, !TAIL_CONV(G) || it >= 512);
        }
        SEAM(pb + 7);
        PH(8) { PH_SYNC
            PHASE_TID();
            LAS int* claimL = (LAS int*)(lds + LDS_MISC + 192);
            const int s0 = (int)xb_xcc_id();
            for (int ds = 0; ds < 8; ++ds) { const int s = (s0 + ds) & 7;
                unsigned* cnt = (unsigned*)(A->ws + WS_CTL) + 45056 + ((l * 2 + 0) * 16 + s) * 64;
                for (;;) { const int c = claim_unit(cnt, claimL, wave0); if (c >= M / 128) break;
                    PH_UNIT(108)
                    exu_unit<16>(s, c * 128 + wave * 16, H, IDS, (const unsigned char*)UB + (size_t)l * NEXP * D, PDOT, lane); } }
        }
        SEAM(pb + 8);
        PH(9) { PH_SYNC
            PHASE_TID();
            const float* suv = SCL + (size_t)(2 * l) * NEXP;
            for (int o = vcu * 512 + tid; o < M * 128; o += G * 512) { float d = 0.f; const int id = IDS[o];
#pragma unroll
                for (int sl = 0; sl < 8; ++sl) d += PDOT[(size_t)sl * M * 128 + o];
                const f32x2 sc2 = *(const f32x2*)(suv + 2 * id);
                WEXP[o] = GG[o] * gelu_tanh(d * sc2.x) * sc2.y; }
        }
        SEAM(pb + 9);
        PH(10) { PH_SYNC
            PHASE_TID();
            LAS int* claimL = (LAS int*)(lds + LDS_MISC + 192);
            const int s0 = (int)xb_xcc_id();
            for (int ds = 0; ds < 8; ++ds) { const int s = (s0 + ds) & 7;
                unsigned* cnt = (unsigned*)(A->ws + WS_CTL) + 45056 + ((l * 2 + 1) * 16 + s) * 64;
                for (;;) { const int c = claim_unit(cnt, claimL, wave0); if (c >= M / 128) break;
                    PH_UNIT(110)
                    exv_unit<16>(s, c * 128 + wave * 16, IDS, WEXP, (const unsigned char*)VB + (size_t)l * NEXP * D, X1H, MODL + MO_G2, X2H, lane); } }
        }
        SEAM(pb + 10);
        PH(11) { PH_SYNC
            PHASE_TID();
            if (l + 1 < NL) modnorm_rows_h(X2H, A->in[4] + (l + 1) * D, mod + (size_t)(l + 1) * 2 * MODW, MO_SH1, MO_SC1, H, gw, NGW, lane);
            else finalnorm_rows(X2H, A->in[23], A->out, gw, NGW, lane);
        }
        if (l + 1 < NL) SEAM(pb + 11);
    }
#undef IN
#undef SEAM
#undef mod
#undef H
#undef Z
#undef X1
#undef X2
}
}

extern "C" void kernel_launch(void* const* d_in, const int* in_sizes, int n_in, void* d_out, int out_size, void* d_ws, size_t ws_size, hipStream_t stream) {
    using namespace mk;
    static int grid = 0;
    if (grid == 0) {
        if (n_in != 24 || out_size != M * D || ws_size < WS_END) { fprintf(stderr, "kernel_launch: unexpected shapes (n_in %d out %d ws %zu)\n", n_in, out_size, ws_size); grid = -1; return; }
        int dev = 0, cus = 0, per_cu = 0;
        if (hipGetDevice(&dev) != hipSuccess || hipDeviceGetAttribute(&cus, hipDeviceAttributeMultiprocessorCount, dev) != hipSuccess) { grid = -1; return; }
        if (hipFuncSetAttribute((const void*)fwd, hipFuncAttributeMaxDynamicSharedMemorySize, LDS_BYTES) != hipSuccess) { fprintf(stderr, "kernel_launch: hipFuncSetAttribute failed\n"); grid = -1; return; }
        if (hipOccupancyMaxActiveBlocksPerMultiprocessor(&per_cu, (const void*)fwd, 512, LDS_BYTES) != hipSuccess || per_cu < 1) fprintf(stderr, "kernel_launch: occupancy query says %d\n", per_cu);
        (void)hipGetLastError();
        grid = cus;
    }
    if (grid < 0) return;
    (void)hipMemsetAsync((char*)d_ws + WS_CTL, 0, CTL_ZERO_BYTES, stream);
    Args a{};
    for (int i = 0; i < 24; ++i) a.in[i] = (const float*)d_in[i];
    a.out = (float*)d_out; a.ws = (unsigned char*)d_ws; a.pad = 0;
#ifdef MK_REPEAT_PHASE
    {   const int P = 1 + (MK_REPEAT_PHASE); const int lo_[5] = {0, P, P + 1, P + 12, P + 13}, hi_[5] = {P + 1, P + 1, P + 13, P + 13, NPHASE};
        for (int li = 0; li < 5; ++li) { a.ph_lo = lo_[li]; a.ph_hi = hi_[li]; a.li = li; if (MK_REPEAT_CONTROL && (li == 1 || li == 3)) continue;
            if (li == 1 || li == 3) (void)hipMemsetAsync((char*)d_ws + WS_CTL + 45056 * 4, 0, 4096 * 4, stream);
            hipLaunchKernelGGL(fwd, dim3(grid), dim3(512), LDS_BYTES, stream, a); }
        return; }
#endif
    constexpr int NLAUNCH = MK_N_LAUNCHES;
    for (int li = 0; li < NLAUNCH; ++li) {
        a.ph_lo = (NLAUNCH == 1) ? 0 : li; a.ph_hi = (NLAUNCH == 1) ? NPHASE : li + 1; a.li = li;
        hipLaunchKernelGGL(fwd, dim3(grid), dim3(512), LDS_BYTES, stream, a);
    }
}
```
